# Optimizing an MI355X kernel written in HIP

```python
import math
import jax
import jax.numpy as jnp
from jax import lax
import numpy as np

D_MODEL = 1024
BATCH = 16
SEQ = 2048
DEPTH = 2

N_BRANCH = 4
BRANCH_WIDTH = D_MODEL // 4
RWKV_HEADS = 4
RWKV_HEAD_DIM = BRANCH_WIDTH // RWKV_HEADS
RWKV_DECAY_RANK = 32
RWKV_ICLR_RANK = 32
RWKV_GATE_RANK = 64
RWKV_GN_EPS = 64e-5
S5_GROUP = 16
S5_GROUPS = BRANCH_WIDTH // S5_GROUP
S5_STATE = 64
S5_DT_MIN = 1e-3
S5_DT_MAX = 1e-1
FOX_HEADS = 4
FOX_HEAD_DIM = BRANCH_WIDTH // FOX_HEADS
FOX_BLOCK = 128
CONV_WIDTH = 31
PEER_HEADS = 8
PEER_KEYS = 128
PEER_EXPERTS = PEER_KEYS * PEER_KEYS
PEER_QUERY_DIM = 256
PEER_HALF = PEER_QUERY_DIM // 2
PEER_TOPK = 16
PEER_CHUNK = 128
PLE_DIM = 256
LN_EPS = 1e-5
DN_ALPHA = (2 * DEPTH) ** 0.25
DN_BETA = (8 * DEPTH) ** -0.25

RWKV_COLS = 3 * BRANCH_WIDTH + RWKV_DECAY_RANK + RWKV_ICLR_RANK + RWKV_GATE_RANK
S5_COLS = BRANCH_WIDTH
FOX_COLS = 3 * BRANCH_WIDTH + FOX_HEADS
CONV_COLS = 2 * BRANCH_WIDTH
GATE_COLS = N_BRANCH * D_MODEL
IN_COLS = RWKV_COLS + S5_COLS + FOX_COLS + CONV_COLS + GATE_COLS
IN_SPLIT = [RWKV_COLS, RWKV_COLS + S5_COLS, RWKV_COLS + S5_COLS + FOX_COLS,
            RWKV_COLS + S5_COLS + FOX_COLS + CONV_COLS]
RWKV_SPLIT = [BRANCH_WIDTH, 2 * BRANCH_WIDTH, 3 * BRANCH_WIDTH,
              3 * BRANCH_WIDTH + RWKV_DECAY_RANK,
              3 * BRANCH_WIDTH + RWKV_DECAY_RANK + RWKV_ICLR_RANK]
FOX_SPLIT = [BRANCH_WIDTH, 2 * BRANCH_WIDTH, 3 * BRANCH_WIDTH]

kernel_name = "hybrid_rwkv7_s5_fox_conformer_peer_trunk"


def layer_norm(z, g, b, eps=LN_EPS):
    zf = z.astype(jnp.float32)
    mu = zf.mean(-1, keepdims=True)
    var = jnp.square(zf - mu).mean(-1, keepdims=True)
    return ((zf - mu) * lax.rsqrt(var + eps) * g.astype(jnp.float32) + b.astype(jnp.float32)).astype(z.dtype)


def token_shift(z):
    return jnp.pad(z, ((0, 0), (1, 0), (0, 0)))[:, :-1]


def rwkv7_recurrence(r, decay, k, v, a_in, b_in):
    bsz, _, nh, hd = r.shape

    def step(state, inp):
        r_t, w_t, k_t, v_t, a_t, b_t = inp
        sa = jnp.einsum('bhij,bhj->bhi', state, a_t)
        state = (state * w_t[:, :, None, :] + sa[..., None] * b_t[:, :, None, :]
                 + v_t[..., None] * k_t[:, :, None, :])
        return state, jnp.einsum('bhij,bhj->bhi', state, r_t)

    xs = tuple(jnp.moveaxis(t, 1, 0) for t in (r, decay, k, v, a_in, b_in))
    s0 = jnp.zeros((bsz, nh, hd, hd), jnp.float32)
    _, y = lax.scan(step, s0, xs)
    return jnp.moveaxis(y, 0, 1)


def rwkv7_mixer(pr, mu, w0, w2, a0, a2, g2, k_k, k_a, r_k, lnx_g, lnx_b):
    bsz, seq, _ = pr.shape
    f32 = jnp.float32
    z = pr.astype(f32)
    z = z + (token_shift(z) - z) * mu.astype(f32)
    r, k, v, hw, ha, hg = jnp.split(z, RWKV_SPLIT, axis=-1)
    w_log = -jax.nn.softplus(-(w0.astype(f32) + jnp.tanh(hw) @ w2.astype(f32))) - 0.5
    decay = jnp.exp(-jnp.exp(w_log))
    a = jax.nn.sigmoid(a0.astype(f32) + ha @ a2.astype(f32))
    g = jax.nn.sigmoid(hg) @ g2.astype(f32)
    heads = lambda t: t.reshape(bsz, seq, RWKV_HEADS, RWKV_HEAD_DIM)
    kk = heads(k * k_k.astype(f32))
    kk = kk * lax.rsqrt(jnp.maximum(jnp.sum(kk * kk, -1, keepdims=True), 1e-24))
    k = k * (1.0 + (a - 1.0) * k_a.astype(f32))
    r_h, k_h, v_h = heads(r), heads(k), heads(v)
    y = rwkv7_recurrence(r_h, heads(decay), k_h, v_h, -kk, kk * heads(a))
    mean = y.mean(-1, keepdims=True)
    var = jnp.square(y - mean).mean(-1, keepdims=True)
    gn_g = lnx_g.astype(f32).reshape(RWKV_HEADS, RWKV_HEAD_DIM)
    gn_b = lnx_b.astype(f32).reshape(RWKV_HEADS, RWKV_HEAD_DIM)
    y = (y - mean) * lax.rsqrt(var + RWKV_GN_EPS) * gn_g + gn_b
    y = y + jnp.sum(r_h * k_h * r_k.astype(f32), -1, keepdims=True) * v_h
    return (y.reshape(bsz, seq, BRANCH_WIDTH) * g).astype(pr.dtype)


def s5_mixer(u, lam_re, lam_im, b_re, b_im, c_re, c_im, d_skip, log_dt, glu_w, glu_b):
    bsz, seq, _ = u.shape
    f32 = jnp.float32
    uf = u.astype(f32).reshape(bsz, seq, S5_GROUPS, S5_GROUP)
    lam = lax.complex(lam_re.astype(f32), lam_im.astype(f32))
    dt = jnp.exp(log_dt.astype(f32))[:, None]
    lam_bar = jnp.exp(lam * dt)
    b_bar = ((lam_bar - 1.0) / lam)[..., None] * lax.complex(b_re.astype(f32), b_im.astype(f32))
    bu = jnp.einsum('bsgc,gpc->sbgp', uf.astype(jnp.complex64), b_bar)
    a_seq = jnp.broadcast_to(lam_bar[None, None], (seq, bsz, S5_GROUPS, S5_STATE))

    def combine(e1, e2):
        a1, x1 = e1
        a2, x2 = e2
        return a1 * a2, a2 * x1 + x2

    _, states = lax.associative_scan(combine, (a_seq, bu), axis=0)
    c_mat = lax.complex(c_re.astype(f32), c_im.astype(f32))
    y = (jnp.einsum('sbgp,gcp->bsgc', states, c_mat).real
         + d_skip.astype(f32).reshape(S5_GROUPS, S5_GROUP) * uf)
    y = jax.nn.gelu(y.reshape(bsz, seq, BRANCH_WIDTH), approximate=False)
    y = y * jax.nn.sigmoid(y @ glu_w.astype(f32) + glu_b.astype(f32))
    return y.astype(u.dtype)


def fox_mixer(pf, b_f):
    bsz, seq, _ = pf.shape
    q, k, v, f_logit = jnp.split(pf, FOX_SPLIT, axis=-1)
    to_heads = lambda t: t.reshape(bsz, seq, FOX_HEADS, FOX_HEAD_DIM).transpose(0, 2, 1, 3)
    q, k, v = to_heads(q), to_heads(k), to_heads(v)
    log_f = jax.nn.log_sigmoid((f_logit + b_f).astype(jnp.float32))
    c = jnp.cumsum(log_f, axis=1).transpose(0, 2, 1)
    scale = FOX_HEAD_DIM ** -0.5
    outs = []
    for blk in range(seq // FOX_BLOCK):
        q0, q1 = blk * FOX_BLOCK, (blk + 1) * FOX_BLOCK
        s = jnp.einsum('bhqd,bhkd->bhqk', q[:, :, q0:q1], k[:, :, :q1]).astype(jnp.float32) * scale
        s = s + c[:, :, q0:q1, None] - c[:, :, None, :q1]
        causal = jnp.arange(q1)[None, :] <= jnp.arange(q0, q1)[:, None]
        s = jnp.where(causal, s, -jnp.inf)
        probs = jax.nn.softmax(s, axis=-1).astype(v.dtype)
        outs.append(jnp.einsum('bhqk,bhkd->bhqd', probs, v[:, :, :q1]))
    o = jnp.concatenate(outs, axis=2)
    return o.transpose(0, 2, 1, 3).reshape(bsz, seq, BRANCH_WIDTH)


def conv_mixer(pc, conv_w, conv_b, ln_g, ln_b):
    val, gate = jnp.split(pc, 2, axis=-1)
    h = val * jax.nn.sigmoid(gate)
    h = lax.conv_general_dilated(h, conv_w[:, None, :].astype(h.dtype), window_strides=(1,),
                                 padding=((CONV_WIDTH - 1, 0),),
                                 dimension_numbers=('NWC', 'WIO', 'NWC'),
                                 feature_group_count=BRANCH_WIDTH) + conv_b
    return jax.nn.silu(layer_norm(h, ln_g, ln_b))


def peer_ffn(h, wq, k1, k2, u_tab, v_tab):
    bsz, seq, dm = h.shape
    ntok = bsz * seq
    xt = h.reshape(ntok, dm)
    q = (xt @ wq).reshape(ntok, PEER_HEADS, 2, PEER_HALF).astype(jnp.float32)
    s1 = jnp.einsum('thd,nd->thn', q[:, :, 0], k1.astype(jnp.float32))
    s2 = jnp.einsum('thd,nd->thn', q[:, :, 1], k2.astype(jnp.float32))
    v1, i1 = lax.top_k(s1, PEER_TOPK)
    v2, i2 = lax.top_k(s2, PEER_TOPK)
    cand = (v1[..., :, None] + v2[..., None, :]).reshape(ntok, PEER_HEADS, PEER_TOPK * PEER_TOPK)
    score, ci = lax.top_k(cand, PEER_TOPK)
    eid = (jnp.take_along_axis(i1, ci // PEER_TOPK, axis=-1) * PEER_KEYS
           + jnp.take_along_axis(i2, ci % PEER_TOPK, axis=-1))
    gate = jax.nn.softmax(score, axis=-1)
    n_sel = PEER_HEADS * PEER_TOPK
    n_chunks = ntok // PEER_CHUNK

    def chunk(args):
        xc, ec, gc = args
        u = jnp.take(u_tab, ec, axis=0)
        act = jax.nn.gelu(jnp.einsum('cd,ced->ce', xc, u), approximate=False)
        w = (gc * act.astype(jnp.float32)).astype(xc.dtype)
        vv = jnp.take(v_tab, ec, axis=0)
        return jnp.einsum('ce,ced->cd', w, vv)

    out = lax.map(chunk, (xt.reshape(n_chunks, PEER_CHUNK, dm),
                          eid.reshape(n_chunks, PEER_CHUNK, n_sel),
                          gate.reshape(n_chunks, PEER_CHUNK, n_sel)))
    return out.reshape(bsz, seq, dm)


def setup_inputs(seed: int = 0) -> dict:
    key = jax.random.key(seed)
    keys = iter(jax.random.split(key, 48))
    f32 = jnp.float32

    def nrm(shape, scale):
        return jax.random.normal(next(keys), shape, f32) * scale

    def unif(shape, lo, hi):
        return jax.random.uniform(next(keys), shape, f32, lo, hi)

    L, W, D = DEPTH, BRANCH_WIDTH, D_MODEL
    G, P, Cg = S5_GROUPS, S5_STATE, S5_GROUP
    return {
        'x': nrm((BATCH, SEQ, D), 1.0),
        'p': nrm((DEPTH, BATCH, SEQ, PLE_DIM), 1.0),
        'ln_in_g': 1.0 + nrm((D,), 0.02),
        'ln_in_b': nrm((D,), 0.02),
        'w_in': nrm((L, D, IN_COLS), D ** -0.5),
        'rwkv_mu': unif((L, RWKV_COLS), 0.0, 1.0),
        'rwkv_w0': unif((L, W), -6.0, 0.0),
        'rwkv_w2': nrm((L, RWKV_DECAY_RANK, W), 0.5 * RWKV_DECAY_RANK ** -0.5),
        'rwkv_a0': nrm((L, W), 0.5),
        'rwkv_a2': nrm((L, RWKV_ICLR_RANK, W), RWKV_ICLR_RANK ** -0.5),
        'rwkv_g2': nrm((L, RWKV_GATE_RANK, W), RWKV_GATE_RANK ** -0.5),
        'rwkv_kk': 0.85 + nrm((L, W), 0.02),
        'rwkv_ka': 1.0 + nrm((L, W), 0.02),
        'rwkv_rk': nrm((L, RWKV_HEADS, RWKV_HEAD_DIM), 0.1),
        'rwkv_lnx_g': 1.0 + nrm((L, W), 0.02),
        'rwkv_lnx_b': nrm((L, W), 0.02),
        's5_lam_re': -0.5 + nrm((L, G, P), 0.01),
        's5_lam_im': math.pi * jnp.arange(P, dtype=f32) + nrm((L, G, P), 0.01),
        's5_b_re': nrm((L, G, P, Cg), Cg ** -0.5),
        's5_b_im': nrm((L, G, P, Cg), Cg ** -0.5),
        's5_c_re': nrm((L, G, Cg, P), P ** -0.5),
        's5_c_im': nrm((L, G, Cg, P), P ** -0.5),
        's5_d': nrm((L, W), 0.5),
        's5_log_dt': unif((L, G), math.log(S5_DT_MIN), math.log(S5_DT_MAX)),
        's5_glu_w': nrm((L, W, W), W ** -0.5),
        's5_glu_b': nrm((L, W), 0.02),
        'fox_bf': unif((L, FOX_HEADS), 2.0, 6.0),
        'conv_w': nrm((L, CONV_WIDTH, W), CONV_WIDTH ** -0.5),
        'conv_b': nrm((L, W), 0.02),
        'conv_ln_g': 1.0 + nrm((L, W), 0.02),
        'conv_ln_b': nrm((L, W), 0.02),
        'w_branch': nrm((L, N_BRANCH, W, D), W ** -0.5),
        'w_out': nrm((L, D, D), DN_BETA * D ** -0.5),
        'ln1_g': 1.0 + nrm((L, D), 0.02),
        'ln1_b': nrm((L, D), 0.02),
        'peer_wq': nrm((L, D, PEER_HEADS * PEER_QUERY_DIM), D ** -0.5),
        'peer_k1': nrm((L, PEER_KEYS, PEER_HALF), PEER_HALF ** -0.5),
        'peer_k2': nrm((L, PEER_KEYS, PEER_HALF), PEER_HALF ** -0.5),
        'peer_u': nrm((L, PEER_EXPERTS, D), D ** -0.5),
        'peer_v': nrm((L, PEER_EXPERTS, D), DN_BETA),
        'ple_w': nrm((L, PLE_DIM, D), DN_BETA * PLE_DIM ** -0.5),
        'ple_gate_w': nrm((L, D, D), D ** -0.5),
        'ln2_g': 1.0 + nrm((L, D), 0.02),
        'ln2_b': nrm((L, D), 0.02),
    }


def reference(x, p, ln_in_g, ln_in_b, w_in, rwkv_mu, rwkv_w0, rwkv_w2, rwkv_a0, rwkv_a2,
              rwkv_g2, rwkv_kk, rwkv_ka, rwkv_rk, rwkv_lnx_g, rwkv_lnx_b, s5_lam_re, s5_lam_im,
              s5_b_re, s5_b_im, s5_c_re, s5_c_im, s5_d, s5_log_dt, s5_glu_w, s5_glu_b, fox_bf,
              conv_w, conv_b, conv_ln_g, conv_ln_b, w_branch, w_out, ln1_g, ln1_b, peer_wq,
              peer_k1, peer_k2, peer_u, peer_v, ple_w, ple_gate_w, ln2_g, ln2_b):
    h = layer_norm(x, ln_in_g, ln_in_b)
    for i in range(DEPTH):
        proj = h @ w_in[i]
        p_rwkv, p_s5, p_fox, p_conv, p_gate = jnp.split(proj, IN_SPLIT, axis=-1)
        branches = (
            rwkv7_mixer(p_rwkv, rwkv_mu[i], rwkv_w0[i], rwkv_w2[i], rwkv_a0[i], rwkv_a2[i],
                        rwkv_g2[i], rwkv_kk[i], rwkv_ka[i], rwkv_rk[i], rwkv_lnx_g[i], rwkv_lnx_b[i]),
            s5_mixer(p_s5, s5_lam_re[i], s5_lam_im[i], s5_b_re[i], s5_b_im[i], s5_c_re[i],
                     s5_c_im[i], s5_d[i], s5_log_dt[i], s5_glu_w[i], s5_glu_b[i]),
            fox_mixer(p_fox, fox_bf[i]),
            conv_mixer(p_conv, conv_w[i], conv_b[i], conv_ln_g[i], conv_ln_b[i]),
        )
        merged = None
        for b, y_b in enumerate(branches):
            gate_b = jax.nn.sigmoid(p_gate[..., b * D_MODEL:(b + 1) * D_MODEL])
            term = gate_b * (y_b @ w_branch[i, b])
            merged = term if merged is None else merged + term
        mix = merged @ w_out[i]
        h = layer_norm(DN_ALPHA * h + mix, ln1_g[i], ln1_b[i])
        ffn = peer_ffn(h, peer_wq[i], peer_k1[i], peer_k2[i], peer_u[i], peer_v[i])
        ple = (p[i] @ ple_w[i]) * jax.nn.sigmoid(h @ ple_gate_w[i])
        h = layer_norm(DN_ALPHA * h + ffn + ple, ln2_g[i], ln2_b[i])
    return h
```

```cpp
#ifdef CPU_EMU
#include "emu.h"
#define LAS
#define GET_LDS() ((unsigned char*)emu::lds())
#define AS_GLOBAL(p) (p)
#define AS_LDS(p) (p)
#define RFL(x) (x)
#define MFMA32(a, b, c) emu_mfma32(a, b, c)
#define MFMA16(a, b, c) emu_mfma16(a, b, c)
#define MFMA16_FP8(a, b, c) emu_mfma16_fp8(a, b, c)
#define FAST_EXP2(x) exp2f(x)
#define FAST_RCP(x) (1.0f / (x))
#define FAST_LOG2(x) log2f(x)
#define FAST_RSQ(x) (1.0f / sqrtf(x))
#define WAVE_SYNC() do { uint32_t _z = 0; (void)emu::wave_xchg(&_z, 1); } while (0)
#define OPAQUE(x) do {} while (0)
#define GLDS16(gp, lp, lane) memcpy((char*)(lp) + 16 * (lane), (const void*)(gp), 16)
#define WAIT_VM(n) do {} while (0)
#define GLOAD16_ASM(dst, ptr) (dst) = *(const u32x4*)(ptr)
#define GLOAD4_ASM(dst, ptr) (dst) = *(const int*)(ptr)
#define PIN4(a, b, c, d) do {} while (0)
#define PIN2I(a, b) do {} while (0)
#define WAIT_LGKM0() do {} while (0)
#define READLANE_I(v, l) __shfl((int)(v), (l))
#define READLANE_F(v, l) __shfl((float)(v), (l))
#define TIDX() ((int)threadIdx.x)
#define XCC_ID() (emu::bid() & 7)
#define GDIM() ((int)gridDim.x)
#define BIDX() ((int)blockIdx.x)
#define OPAQUE_S(x) do {} while (0)
#define MEMFENCE() do {} while (0)
#else
#include <hip/hip_runtime.h>
#include <hip/hip_cooperative_groups.h>
#include <cstdio>
#include <cstdint>
namespace cg = cooperative_groups;
#define LAS __attribute__((address_space(3)))
#define GAS __attribute__((address_space(1)))
#define AS_GLOBAL(p) ((unsigned char*)(GAS unsigned char*)(p))
#define AS_LDS(p) ((unsigned char*)(LAS unsigned char*)(p))
#define RFL(x) __builtin_amdgcn_readfirstlane(x)
#define MFMA32(a, b, c) __builtin_amdgcn_mfma_f32_32x32x16_bf16(a, b, c, 0, 0, 0)
#define MFMA16(a, b, c) __builtin_amdgcn_mfma_f32_16x16x32_bf16(a, b, c, 0, 0, 0)
#define MFMA16_FP8(a, b, c) __builtin_amdgcn_mfma_f32_16x16x32_fp8_fp8((long)(a), (long)(b), c, 0, 0, 0)
#define MFMA16_F8X128(a, b, c) __builtin_amdgcn_mfma_scale_f32_16x16x128_f8f6f4(a, b, c, 0, 0, 0, 0, 0, 0)
#define FAST_EXP2(x) __builtin_amdgcn_exp2f(x)
#define FAST_RCP(x) __builtin_amdgcn_rcpf(x)
#define FAST_LOG2(x) __builtin_amdgcn_logf(x)
#define FAST_RSQ(x) __builtin_amdgcn_rsqf(x)
#define WAVE_SYNC() __builtin_amdgcn_wave_barrier()
#define OPAQUE(x) asm volatile("" : "+v"(x))
#define GLDS16(gp, lp, lane) __builtin_amdgcn_global_load_lds((const unsigned*)(gp), (LAS unsigned*)(lp), 16, 0, 0)
#define WAIT_VM(n) asm volatile("s_waitcnt vmcnt(" #n ")" ::: "memory")
#define GLOAD16_ASM(dst, ptr) asm volatile("global_load_dwordx4 %0, %1, off" : "=v"(dst) : "v"(ptr) : "memory")
#define GLOAD4_ASM(dst, ptr) asm volatile("global_load_dword %0, %1, off" : "=v"(dst) : "v"(ptr) : "memory")
#define PIN4(a, b, c, d) asm volatile("" : "+v"(a), "+v"(b), "+v"(c), "+v"(d) :: "memory")
#define PIN2I(a, b) asm volatile("" : "+v"(a), "+v"(b) :: "memory")
#define WAIT_LGKM0() asm volatile("s_waitcnt lgkmcnt(0)" ::: "memory")
#define READLANE_I(v, l) __builtin_amdgcn_readlane((int)(v), (l))
#define READLANE_F(v, l) __builtin_bit_cast(float, __builtin_amdgcn_readlane(__builtin_bit_cast(int, (float)(v)), (l)))
#define OPAQUE_S(x) asm volatile("" : "+s"(x))
__device__ __forceinline__ int opaque_tid_() { int t = threadIdx.x; asm volatile("" : "+v"(t)); return t; }
#define TIDX() opaque_tid_()
#define XCC_ID() ((int)(__builtin_amdgcn_s_getreg((3 << 11) | 20) & 7u))
__device__ __forceinline__ int opaque_gdim_() { int t = gridDim.x; asm volatile("" : "+s"(t)); return t; }
__device__ __forceinline__ int opaque_bidx_() { int t = blockIdx.x; asm volatile("" : "+s"(t)); return t; }
#define GDIM() opaque_gdim_()
#define BIDX() opaque_bidx_()
#define MEMFENCE() do { asm volatile("" ::: "memory"); __builtin_amdgcn_sched_barrier(0); } while (0)
#endif

#ifndef CFG_B
#define CFG_B 16
#endif
#ifndef CFG_S
#define CFG_S 2048
#endif

typedef unsigned short bf16_t;
typedef short bf16x8 __attribute__((ext_vector_type(8)));
typedef short s16x4 __attribute__((ext_vector_type(4)));
typedef float f32x4 __attribute__((ext_vector_type(4)));
typedef float f32x2 __attribute__((ext_vector_type(2)));
typedef float f32x16 __attribute__((ext_vector_type(16)));
typedef unsigned u32x4 __attribute__((ext_vector_type(4)));
typedef unsigned u32x2 __attribute__((ext_vector_type(2)));
typedef int i32x4 __attribute__((ext_vector_type(4)));
typedef int i32x8 __attribute__((ext_vector_type(8)));

constexpr int NB_ = CFG_B, S_ = CFG_S, T_ = NB_ * S_, D_ = 1024, L_ = 2;
constexpr int NTHR = 512, NWAVE = 8;
constexpr int PJ = 2304;
constexpr int C_R = 0, C_K = 256, C_V = 512, C_HW = 768, C_HA = 800, C_HG = 832, C_S5 = 896, C_FQ = 1152, C_FK = 1408, C_FL = 1664, C_CV = 1792, C_CG = 2048;
constexpr int WIN_ROWS = 6656, WIN_VT = 2304, WIN_GATE = 2560;
constexpr int IN_COLS = 6532;
constexpr float LN_EPS_ = 1e-5f, GN_EPS_ = 64e-5f;
constexpr float DN_ALPHA_ = 1.4142135623730951f;
constexpr int NEXP = 16384;

enum { I_X = 0, I_P, I_LNIN_G, I_LNIN_B, I_WIN, I_MU, I_W0, I_W2, I_A0, I_A2, I_G2, I_KK, I_KA, I_RK, I_LNXG, I_LNXB, I_LRE, I_LIM, I_BRE, I_BIM, I_CRE, I_CIM,
       I_S5D, I_LDT, I_GLUW, I_GLUB, I_BF, I_CONVW, I_CONVB, I_CLNG, I_CLNB, I_WBR, I_WOUT, I_LN1G, I_LN1B, I_WQ, I_K1, I_K2, I_U, I_V, I_PLEW, I_PLEG, I_LN2G, I_LN2B, N_IN };

constexpr size_t al256(size_t x) { return (x + 255) & ~(size_t)255; }
constexpr size_t WS_CTL = 0;
constexpr size_t WS_WIN = 1u << 20;
constexpr size_t WS_WBR = WS_WIN + al256((size_t)L_ * WIN_ROWS * 1024 * 2);
constexpr size_t WS_WOUT = WS_WBR + (size_t)L_ * 1024 * 1024 * 2;
constexpr size_t WS_WQ = WS_WOUT + (size_t)L_ * 1024 * 1024 * 2;
constexpr size_t WS_PLE = WS_WQ + (size_t)L_ * 2048 * 1024 * 2;
constexpr size_t WS_PLEG = WS_PLE + (size_t)L_ * 1024 * 256 * 2;
constexpr size_t WS_GLU = WS_PLEG + (size_t)L_ * 1024 * 1024 * 2;
constexpr size_t WS_K12 = WS_GLU + (size_t)L_ * 256 * 256 * 2;
constexpr size_t WS_S5KC = WS_K12 + (size_t)L_ * 2 * 128 * 128 * 2;
constexpr size_t WS_S5WX = WS_S5KC + (size_t)L_ * 16 * 64 * 256 * 2;
constexpr size_t WS_S5WY = WS_S5WX + (size_t)L_ * 16 * 128 * 1024 * 2;
constexpr size_t WS_S5LL = WS_S5WY + (size_t)L_ * 16 * 1024 * 128 * 2;
constexpr size_t WS_UT = WS_S5LL + al256((size_t)L_ * 16 * 64 * 2 * 4);
constexpr size_t WS_VT = WS_UT + (size_t)NEXP * 1024 * 2;
constexpr size_t WS_RW = WS_VT + (size_t)NEXP * 1024 * 2;
constexpr size_t RW_SZ = (size_t)T_ * 512;
static_assert(2 * RW_SZ <= (size_t)NEXP * 1024 * 2, "RWKV gate / bonus arrays fit the second table region");
constexpr size_t WS_HB = WS_RW + 4 * RW_SZ;
constexpr size_t WS_R1 = WS_HB + (size_t)T_ * 1024 * 2;
constexpr size_t R1_BYTES = (size_t)T_ * 2560 * 2;
constexpr size_t WS_YC = WS_R1 + R1_BYTES;
constexpr size_t WS_VTR = WS_YC + (size_t)T_ * 1024 * 2;
constexpr size_t WS_PB = WS_VTR + (size_t)256 * T_ * 2;
constexpr size_t WS_H8T = WS_PB + (size_t)T_ * 256 * 2;
constexpr int H8_SPLIT = (T_ / 512) * 256;
constexpr size_t WS_END = WS_H8T + (size_t)(T_ - H8_SPLIT) * 1024;
constexpr size_t R1_PROJ = 0;
constexpr size_t R1_H8 = (size_t)T_ * 2304 * 2;
constexpr size_t R1_MERGED = 0;
constexpr size_t R1_STASH = (size_t)T_ * 1024 * 2;
constexpr size_t R1_Q = 0;
constexpr size_t R1_EID = (size_t)T_ * 2048 * 2;
constexpr size_t R1_GATE = R1_EID + (size_t)T_ * 128 * 4;
static_assert(R1_GATE + (size_t)T_ * 128 * 4 <= R1_BYTES, "R1 map");

struct KP { const float* in[N_IN]; float* out; unsigned char* ws; float* dbg; int layer; int phase; };

#ifdef CPU_EMU
__device__ __forceinline__ unsigned f2bf(float f) { unsigned u = __builtin_bit_cast(unsigned, f); return (u + 0x7fffu + ((u >> 16) & 1u)) >> 16; }
__device__ __forceinline__ unsigned pk2(float lo, float hi) { return f2bf(lo) | (f2bf(hi) << 16); }
#else
typedef __bf16 bf16x2_hw __attribute__((ext_vector_type(2)));
__device__ __forceinline__ unsigned pk2(float lo, float hi) { const f32x2 v = {lo, hi}; return __builtin_bit_cast(unsigned, __builtin_convertvector(v, bf16x2_hw)); }
__device__ __forceinline__ unsigned f2bf(float f) { return pk2(f, 0.f) & 0xffffu; }
#endif
__device__ __forceinline__ float bf2f(unsigned h) { return __builtin_bit_cast(float, h << 16); }
__device__ __forceinline__ float bflo(unsigned w) { return __builtin_bit_cast(float, w << 16); }
__device__ __forceinline__ float bfhi(unsigned w) { return __builtin_bit_cast(float, w & 0xffff0000u); }
__device__ __forceinline__ float sigmoidf_(float x) { return FAST_RCP(1.0f + FAST_EXP2(x * -1.4426950408889634f)); }
__device__ __forceinline__ float gelu_erf(float v) { return 0.5f * v * (1.0f + erff(v * 0.70710678118654752f)); }
#ifdef CPU_EMU
inline float fp8_dec_(unsigned b) { const unsigned s = b >> 7, e = (b >> 3) & 15, m = b & 7; float v = (e == 0) ? ldexpf((float)m, -9) : ldexpf(1.f + m * 0.125f, (int)e - 7); return s ? -v : v; }
inline unsigned fp8_enc_(float x) { const unsigned s = x < 0.f ? 0x80u : 0u; float a = fabsf(x); if (!(a > 0.f)) return s; if (a > 448.f) a = 448.f;
    int e; (void)frexpf(a, &e); e -= 1; if (e < -6) e = -6;
    const float q = ldexpf(a, 3 - e); float r = nearbyintf(q);
    unsigned ee, mm; if (e == -6 && r < 8.f) { ee = 0; mm = (unsigned)r; } else { if (r >= 16.f) { r = 8.f; e += 1; } ee = (unsigned)(e + 7); mm = (unsigned)r - 8u; }
    if (ee > 15u || (ee == 15u && mm > 6u)) { ee = 15u; mm = 6u; }
    return s | (ee << 3) | mm; }
inline f32x2 cvt_pk_f32_fp8_(unsigned w, bool hi) { const unsigned h = hi ? (w >> 16) : w; return (f32x2){fp8_dec_(h & 255u), fp8_dec_((h >> 8) & 255u)}; }
inline unsigned cvt_pk_fp8_f32_(float a, float b, unsigned old, bool hi) { const unsigned p = fp8_enc_(a) | (fp8_enc_(b) << 8); return hi ? ((old & 0xffffu) | (p << 16)) : ((old & 0xffff0000u) | p); }
#else
__device__ __forceinline__ f32x2 cvt_pk_f32_fp8_(unsigned w, bool hi) { return hi ? __builtin_amdgcn_cvt_pk_f32_fp8((int)w, true) : __builtin_amdgcn_cvt_pk_f32_fp8((int)w, false); }
__device__ __forceinline__ unsigned cvt_pk_fp8_f32_(float a, float b, unsigned old, bool hi) { return hi ? (unsigned)__builtin_amdgcn_cvt_pk_fp8_f32(a, b, (int)old, true) : (unsigned)__builtin_amdgcn_cvt_pk_fp8_f32(a, b, (int)old, false); }
#endif
__device__ __forceinline__ float wave_max(float v) {
#pragma unroll
  for (int o = 1; o < 64; o <<= 1) v = fmaxf(v, __shfl_xor(v, o));
  return v;
}
template <int N> __device__ __forceinline__ void wave_sum_n(float (&v)[N]) {
#pragma unroll
  for (int o = 1; o < 64; o <<= 1) { float t[N];
#pragma unroll
    for (int i = 0; i < N; ++i) t[i] = __shfl_xor(v[i], o);
#pragma unroll
    for (int i = 0; i < N; ++i) v[i] += t[i]; }
}
__device__ __forceinline__ float wave_sum(float v) {
#pragma unroll
  for (int o = 1; o < 64; o <<= 1) v += __shfl_xor(v, o);
  return v;
}
namespace pg8 {
constexpr int BM = 256, BK = 64, HALF = 128, HTB = HALF * BK * 2, STAGE_BYTES = 8 * HTB;
__host__ __device__ __forceinline__ int lds_byte(int r, int c) { const int st = (r >> 4) * 2 + (c >> 5), rr = r & 15, cc = c & 31, ob = rr * 64 + cc * 2; return st * 1024 + (ob ^ (((ob >> 9) & 1) << 5)); }
__host__ __device__ __forceinline__ void stage_rc(int b, int& R, int& C) { const int st = b / 1024, sb = b % 1024, swz = sb ^ (((sb >> 9) & 1) << 5); R = (st >> 1) * 16 + swz / 64; C = (st & 1) * 32 + (swz % 64) / 2; }
__host__ __device__ __forceinline__ int perm32(int rho) { const int n = rho >> 4, i = rho & 15; return 8 * (i >> 2) + 4 * n + (i & 3); }

struct Unit { const char* a; const char* b; int nt; int kind; int pm; int pn; int aux; int f8; };

#ifndef CPU_EMU
template <int MODE = 0, class Epi, class Sched>
__device__ __forceinline__ void gemm_phase(LAS unsigned char* lds, const int lda, const int ldb, const Sched& S, const Epi& E, const int lda8 = 0) {
    const int tid = TIDX(), wid = __builtin_amdgcn_readfirstlane(tid >> 6), lane = tid & 63, wr = wid >> 2, wc = wid & 3, fr = lane & 15, fq = lane >> 4;
    unsigned voffA[2], voffB[2], voffA8[2];
#pragma unroll
    for (int i = 0; i < 2; ++i) { int R, C; stage_rc(tid * 16 + i * 8192, R, C); const int Rb = (R & ~31) + perm32(R & 31);
        voffA[i] = (unsigned)(R * lda + C) * 2u; voffB[i] = (unsigned)(Rb * ldb + C) * 2u; voffA8[i] = (unsigned)(R * lda8 + C * 2); }
    const size_t kstep = (size_t)(BK * 2);
    const size_t hstepA = (size_t)HALF * lda * 2, hstepB = (size_t)HALF * ldb * 2, hstepA8 = (size_t)HALF * lda8;
    const unsigned ldsw = (unsigned)wid * 1024u;
    const int aoff = lds_byte(wr * 64 + fr, fq * 8), boff = lds_byte(wc * 32 + fr, fq * 8);
#define PG8_SA(b, h) (((b) * 2 + (h)) * HTB)
#define PG8_SB(b, h) ((4 + (b) * 2 + (h)) * HTB)
#define PG8_STAGE(bufoff, gbase, voff) do { _Pragma("unroll") for (int _i = 0; _i < 2; ++_i) \
        __builtin_amdgcn_global_load_lds((const unsigned*)((const char*)(gbase) + (voff)[_i]), (LAS unsigned*)(lds + (bufoff) + ldsw + _i * 8192), 16, 0, 0); } while (0)
#define PG8_LDA(dst, b, h) do { _Pragma("unroll") for (int m = 0; m < 4; ++m) _Pragma("unroll") for (int k = 0; k < 2; ++k) dst[m][k] = *(const LAS bf16x8*)(lds + PG8_SA(b, h) + aoff + m * 2048 + k * 1024); } while (0)
#define PG8_LDB(dst, b, h) do { _Pragma("unroll") for (int n = 0; n < 2; ++n) _Pragma("unroll") for (int k = 0; k < 2; ++k) dst[n][k] = *(const LAS bf16x8*)(lds + PG8_SB(b, h) + boff + n * 2048 + k * 1024); } while (0)
#define PG8_MMA(ai, bj, At, Bt) do { __builtin_amdgcn_s_setprio(1); _Pragma("unroll") for (int m = 0; m < 4; ++m) _Pragma("unroll") for (int n = 0; n < 2; ++n) _Pragma("unroll") for (int k = 0; k < 2; ++k) \
        acc[ai][bj][m][n] = __builtin_amdgcn_mfma_f32_16x16x32_bf16(Bt[n][k], At[m][k], acc[ai][bj][m][n], 0, 0, 0); __builtin_amdgcn_s_setprio(0); } while (0)
#define PG8_CAT(x, y) __builtin_shufflevector(__builtin_bit_cast(i32x4, x), __builtin_bit_cast(i32x4, y), 0, 1, 2, 3, 4, 5, 6, 7)
#define PG8_LDA8(dst, b, h) do { _Pragma("unroll") for (int m = 0; m < 4; ++m) dst[m] = PG8_CAT(*(const LAS bf16x8*)(lds + PG8_SA(b, h) + aoff + m * 2048), *(const LAS bf16x8*)(lds + PG8_SA(b, h) + aoff + m * 2048 + 1024)); } while (0)
#define PG8_LDB8(dst, b, h) do { _Pragma("unroll") for (int n = 0; n < 2; ++n) dst[n] = PG8_CAT(*(const LAS bf16x8*)(lds + PG8_SB(b, h) + boff + n * 2048), *(const LAS bf16x8*)(lds + PG8_SB(b, h) + boff + n * 2048 + 1024)); } while (0)
#define PG8_MMA8(ai, bj, A8, B8) do { __builtin_amdgcn_s_setprio(1); _Pragma("unroll") for (int m = 0; m < 4; ++m) _Pragma("unroll") for (int n = 0; n < 2; ++n) \
        acc[ai][bj][m][n] = MFMA16_F8X128(B8[n], A8[m], acc[ai][bj][m][n]); __builtin_amdgcn_s_setprio(0); } while (0)
#define PG8_WAIT_V(n) asm volatile("s_waitcnt vmcnt(" #n ")" ::: "memory")
#define PG8_WAIT_L(n) asm volatile("s_waitcnt lgkmcnt(" #n ")" ::: "memory")
#define PG8_BAR __builtin_amdgcn_s_barrier()
#define PG8_SCHED __builtin_amdgcn_sched_barrier(0)
    Unit cur, nxt; int ui = 0;
    if (!S.next(0, cur)) return;
    f32x4 acc[2][2][4][2];
#pragma unroll
    for (int a = 0; a < 2; ++a)
#pragma unroll
        for (int b = 0; b < 2; ++b)
#pragma unroll
            for (int m = 0; m < 4; ++m)
#pragma unroll
                for (int n = 0; n < 2; ++n) acc[a][b][m][n] = (f32x4){0.f, 0.f, 0.f, 0.f};
    bf16x8 At[4][2], B0[2][2], B1[2][2];
    const char* cA = cur.a; const char* cB = cur.b; int cf8 = MODE == 2 ? cur.f8 : MODE; size_t chA = cf8 ? hstepA8 : hstepA;
    { unsigned v0[2] = {cf8 ? voffA8[0] : voffA[0], cf8 ? voffA8[1] : voffA[1]};
    PG8_STAGE(PG8_SB(0, 0), cB, voffB); PG8_STAGE(PG8_SB(0, 1), cB + hstepB, voffB); PG8_STAGE(PG8_SA(0, 0), cA, v0); PG8_STAGE(PG8_SA(0, 1), cA + chA, v0);
    if (wr == 1) PG8_BAR;
    PG8_WAIT_V(2); PG8_BAR;
    PG8_STAGE(PG8_SB(1, 0), cB + kstep, voffB); PG8_STAGE(PG8_SA(1, 0), cA + kstep, v0); PG8_STAGE(PG8_SB(1, 1), cB + hstepB + kstep, voffB);
    PG8_WAIT_V(6); PG8_BAR; }
    for (;;) {
        const bool has_next = S.next(ui + 1, nxt);
        const char* nA = has_next ? nxt.a : cA; const char* nB = has_next ? nxt.b : cB; const int nf8 = MODE == 2 ? (has_next ? nxt.f8 : cf8) : MODE;
        int nt = cur.nt; asm volatile("" : "+s"(nt));
#define PG8_KLOOP(LDA_, LDB_, MM_, At_, B0_, B1_, CF8) \
        for (int t = 0; t < nt; t += 2) { \
            const bool last = (t == nt - 2); \
            const char* a1 = cA + (size_t)(t + 1) * kstep; \
            const char* a2 = last ? nA : cA + (size_t)(t + 2) * kstep; const char* b2 = last ? nB : cB + (size_t)(t + 2) * kstep; \
            const char* a3 = a2 + kstep; const char* b3 = b2 + kstep; \
            const int f2 = last ? nf8 : CF8; const size_t h2 = f2 ? hstepA8 : hstepA; \
            OPAQUE_S(a1); OPAQUE_S(a2); OPAQUE_S(a3); OPAQUE_S(b2); OPAQUE_S(b3); \
            const unsigned vA[2] = {CF8 ? voffA8[0] : voffA[0], CF8 ? voffA8[1] : voffA[1]}, vA2[2] = {f2 ? voffA8[0] : voffA[0], f2 ? voffA8[1] : voffA[1]}, vB[2] = {voffB[0], voffB[1]}; \
            LDB_(B0_, 0, 0); LDB_(B1_, 0, 1); PG8_SCHED; LDA_(At_, 0, 0); PG8_STAGE(PG8_SA(1, 1), a1 + (CF8 ? hstepA8 : hstepA), vA); \
            PG8_WAIT_V(8); PG8_WAIT_L(0); PG8_BAR; MM_(0, 0, At_, B0_); MM_(0, 1, At_, B1_); PG8_BAR; PG8_SCHED; \
            LDA_(At_, 0, 1); PG8_STAGE(PG8_SB(0, 0), b2, vB); PG8_STAGE(PG8_SB(0, 1), b2 + hstepB, vB); PG8_STAGE(PG8_SA(0, 0), a2, vA2); \
            PG8_WAIT_V(8); PG8_WAIT_L(0); PG8_BAR; MM_(1, 0, At_, B0_); MM_(1, 1, At_, B1_); PG8_BAR; PG8_SCHED; \
            LDB_(B0_, 1, 0); LDB_(B1_, 1, 1); PG8_SCHED; LDA_(At_, 1, 0); PG8_STAGE(PG8_SA(0, 1), a2 + h2, vA2); \
            PG8_WAIT_V(8); PG8_WAIT_L(0); PG8_BAR; MM_(0, 0, At_, B0_); MM_(0, 1, At_, B1_); PG8_BAR; PG8_SCHED; \
            LDA_(At_, 1, 1); PG8_STAGE(PG8_SB(1, 0), b3, vB); PG8_STAGE(PG8_SB(1, 1), b3 + hstepB, vB); PG8_STAGE(PG8_SA(1, 0), a3, vA2); \
            PG8_WAIT_V(8); PG8_WAIT_L(0); PG8_BAR; MM_(1, 0, At_, B0_); MM_(1, 1, At_, B1_); PG8_BAR; PG8_SCHED; \
        }
        if (MODE == 1 || (MODE == 2 && cf8)) { i32x8 A8[4], B08[2], B18[2]; PG8_KLOOP(PG8_LDA8, PG8_LDB8, PG8_MMA8, A8, B08, B18, 1) }
        else { PG8_KLOOP(PG8_LDA, PG8_LDB, PG8_MMA, At, B0, B1, 0) }
#undef PG8_KLOOP
        if (wr == 0) PG8_BAR;
        E(acc, cur, wr, wc, fr, fq, tid);
        if (!has_next) break;
#pragma unroll
        for (int a = 0; a < 2; ++a)
#pragma unroll
            for (int b = 0; b < 2; ++b)
#pragma unroll
                for (int m = 0; m < 4; ++m)
#pragma unroll
                    for (int n = 0; n < 2; ++n) acc[a][b][m][n] = (f32x4){0.f, 0.f, 0.f, 0.f};
        cur = nxt; cA = nA; cB = nB; cf8 = nf8; ++ui;
        if (wr == 1) PG8_BAR;
    }
    PG8_WAIT_V(0);
    PG8_BAR;
#undef PG8_SA
#undef PG8_SB
#undef PG8_STAGE
#undef PG8_LDA
#undef PG8_LDB
#undef PG8_MMA
#undef PG8_MMA8
#undef PG8_LDA8
#undef PG8_LDB8
#undef PG8_CAT
#undef PG8_WAIT_V
#undef PG8_WAIT_L
#undef PG8_BAR
#undef PG8_SCHED
}
#else
template <int MODE = 0, class Epi, class Sched>
inline void gemm_phase(unsigned char* lds, const int lda, const int ldb, const Sched& S, const Epi& E, const int lda8 = 0) {
    const int tid = TIDX(), wid = tid >> 6, lane = tid & 63, wr = wid >> 2, wc = wid & 3, fr = lane & 15, fq = lane >> 4;
    Unit cur;
    for (int ui = 0; S.next(ui, cur); ++ui) {
        f32x4 acc[2][2][4][2];
        const bf16_t* A = (const bf16_t*)cur.a; const bf16_t* Bt = (const bf16_t*)cur.b; const int K = cur.nt * 64;
        for (int ai = 0; ai < 2; ++ai) for (int bj = 0; bj < 2; ++bj) for (int m = 0; m < 4; ++m) for (int n = 0; n < 2; ++n) for (int e = 0; e < 4; ++e) {
            const int r = 128 * ai + 64 * wr + 16 * m + fr, c = 128 * bj + 32 * wc + 8 * fq + 4 * n + e; float s = 0.f;
            const bf16_t* ar = A + (size_t)r * lda; const bf16_t* br = Bt + (size_t)c * ldb;
            if (cur.f8) { const unsigned char* a8 = (const unsigned char*)cur.a + (size_t)r * lda8; const unsigned char* b8 = (const unsigned char*)cur.b + (size_t)c * ldb * 2;
                for (int k = 0; k < cur.nt * 128; ++k) s += fp8_dec_(a8[k]) * fp8_dec_(b8[k]); }
#ifdef EMU_FP8_A
            else if (cur.aux == 77) { float am = 0.f; for (int k = 0; k < K; ++k) am = fmaxf(am, fabsf(bf2f(br[k]))); const float sc = am > 0.f ? am / 440.f : 1.f;
                for (int k = 0; k < K; ++k) s += fp8_dec_(fp8_enc_(bf2f(ar[k]))) * fp8_dec_(fp8_enc_(bf2f(br[k]) / sc)); s *= sc; }
#endif
            else for (int k = 0; k < K; ++k) s += bf2f(ar[k]) * bf2f(br[k]);
            acc[ai][bj][m][n][e] = s; }
        __syncthreads();
        E(acc, cur, wr, wc, fr, fq, tid);
        __syncthreads();
    }
    __syncthreads();
}
#endif
}
struct Ptrs {
    bf16_t *WinT, *WbrT, *WoutT, *WqT, *PleT, *PleGT, *GluT, *K12, *S5Kc, *S5Wx, *S5Wy, *Ut, *Vt, *hb, *proj, *merged, *q, *ycat, *vtr, *pb;
    float *S5LL, *gate; int* eid; unsigned char* stash; bf16_t *rwPT, *rwG, *rwS0, *rwQ, *rwGt, *rwRKV; unsigned char *U8, *V8; float *su, *sv, *pd; unsigned* qcnt; unsigned char *h8a, *h8b, *h8e; float* gsc;
};
__device__ __forceinline__ Ptrs make_ptrs(unsigned char* ws, int l) {
    Ptrs P; { size_t zoff = 0; OPAQUE_S(zoff); ws += zoff; }
    P.WinT = (bf16_t*)(ws + WS_WIN) + (size_t)l * WIN_ROWS * 1024; P.WbrT = (bf16_t*)(ws + WS_WBR) + (size_t)l * 1024 * 1024; P.WoutT = (bf16_t*)(ws + WS_WOUT) + (size_t)l * 1024 * 1024;
    P.WqT = (bf16_t*)(ws + WS_WQ) + (size_t)l * 2048 * 1024; P.PleT = (bf16_t*)(ws + WS_PLE) + (size_t)l * 1024 * 256; P.PleGT = (bf16_t*)(ws + WS_PLEG) + (size_t)l * 1024 * 1024;
    P.GluT = (bf16_t*)(ws + WS_GLU) + (size_t)l * 256 * 256; P.K12 = (bf16_t*)(ws + WS_K12) + (size_t)l * 2 * 128 * 128;
    P.S5Kc = (bf16_t*)(ws + WS_S5KC) + (size_t)l * 16 * 64 * 256; P.S5Wx = (bf16_t*)(ws + WS_S5WX) + (size_t)l * 16 * 128 * 1024; P.S5Wy = (bf16_t*)(ws + WS_S5WY) + (size_t)l * 16 * 1024 * 128;
    P.S5LL = (float*)(ws + WS_S5LL) + (size_t)l * 16 * 64 * 2;
    P.Ut = (bf16_t*)(ws + WS_UT); P.Vt = (bf16_t*)(ws + WS_VT);
    P.pd = (float*)(ws + WS_R1 + R1_Q); P.qcnt = (unsigned*)(ws + WS_CTL) + 8192 + l * 4 * 8 * 16;
    P.U8 = ws + WS_UT; P.V8 = ws + WS_UT + (size_t)NEXP * 1024; P.su = (float*)(ws + WS_CTL + 131072); P.sv = (float*)(ws + WS_CTL + 131072) + NEXP;
    P.rwGt = (bf16_t*)(ws + WS_VT); P.rwRKV = (bf16_t*)(ws + WS_VT + RW_SZ);
    P.rwPT = (bf16_t*)(ws + WS_RW); P.rwG = (bf16_t*)(ws + WS_RW + RW_SZ); P.rwS0 = (bf16_t*)(ws + WS_RW + 2 * RW_SZ); P.rwQ = (bf16_t*)(ws + WS_RW + 3 * RW_SZ);
    P.hb = (bf16_t*)(ws + WS_HB); P.proj = (bf16_t*)(ws + WS_R1 + R1_PROJ); P.merged = (bf16_t*)(ws + WS_R1 + R1_MERGED); P.q = (bf16_t*)(ws + WS_R1 + R1_Q);
    P.stash = ws + WS_R1 + R1_STASH; P.eid = (int*)(ws + WS_R1 + R1_EID); P.gate = (float*)(ws + WS_R1 + R1_GATE);
    P.ycat = (bf16_t*)(ws + WS_YC); P.vtr = (bf16_t*)(ws + WS_VTR); P.pb = (bf16_t*)(ws + WS_PB);
    P.h8a = ws + WS_R1 + R1_H8; P.h8b = ws + WS_H8T; P.h8e = ws + WS_RW; P.gsc = (float*)(ws + WS_CTL + 262144) + l * 5120;
    return P;
}

__device__ __forceinline__ int win_src_col(int n) {
    if (n < 1152) return n;
    if (n < 1664) return n;
    if (n < 1668) return 1920 + (n - 1664);
    if (n < 1792) return -1;
    if (n < 2304) return 1924 + (n - 1792);
    if (n < 2560) return 1664 + (n - 2304);
    return 2436 + (n - 2560);
}
template <bool WINMAP>
__device__ __forceinline__ void transpose_item(const float* src, int sld, bf16_t* dst, int dld, int dcol0, int kb, int nb, float* scr, int lane) {
    const int k0 = 64 * kb, n0 = 32 * nb;
    const int nn = n0 + (lane & 31); const int sc = WINMAP ? win_src_col(nn) : nn;
#pragma unroll 8
    for (int i = 0; i < 32; ++i) { const int kk = 2 * i + (lane >> 5); scr[kk * 33 + (lane & 31)] = (sc >= 0) ? src[(size_t)(k0 + kk) * sld + sc] : 0.f; }
    WAVE_SYNC();
    const int c = lane & 7;
#pragma unroll
    for (int j = 0; j < 4; ++j) { const int n = (lane >> 3) + 8 * j; const float* s = scr + (8 * c) * 33 + n;
        u32x4 o; o.x = pk2(s[0 * 33], s[1 * 33]); o.y = pk2(s[2 * 33], s[3 * 33]); o.z = pk2(s[4 * 33], s[5 * 33]); o.w = pk2(s[6 * 33], s[7 * 33]);
        *(u32x4*)(dst + (size_t)(n0 + n) * dld + dcol0 + k0 + 8 * c) = o; }
    WAVE_SYNC();
}

__device__ __forceinline__ void s5_tables(const KP& p, int l, int g, unsigned char* lds) {
    float* pw = (float*)lds;
    float* bb = pw + 65 * 128;
    float* cc = bb + 64 * 32;
    const int tid = TIDX();
    const Ptrs P = make_ptrs(p.ws, l);
    const float dt = expf(p.in[I_LDT][l * 16 + g]);
    if (tid < 64) { const int pp = tid; const float lr = p.in[I_LRE][(l * 16 + g) * 64 + pp], li = p.in[I_LIM][(l * 16 + g) * 64 + pp];
        const float mag = expf(lr * dt), ang = li * dt; const float br = mag * cosf(ang), bi = mag * sinf(ang);
        float xr = 1.f, xi = 0.f;
        for (int t = 0; t <= 64; ++t) { pw[(t * 64 + pp) * 2] = xr; pw[(t * 64 + pp) * 2 + 1] = xi; const float nr = xr * br - xi * bi, ni = xr * bi + xi * br; xr = nr; xi = ni; }
        const float nr = br - 1.f, ni = bi, den = lr * lr + li * li; const float cr = (nr * lr + ni * li) / den, ci = (ni * lr - nr * li) / den;
        for (int c = 0; c < 16; ++c) { const float b_r = p.in[I_BRE][((l * 16 + g) * 64 + pp) * 16 + c], b_i = p.in[I_BIM][((l * 16 + g) * 64 + pp) * 16 + c];
            bb[(pp * 16 + c) * 2] = cr * b_r - ci * b_i; bb[(pp * 16 + c) * 2 + 1] = cr * b_i + ci * b_r; }
        P.S5LL[(g * 64 + pp) * 2] = pw[(64 * 64 + pp) * 2]; P.S5LL[(g * 64 + pp) * 2 + 1] = pw[(64 * 64 + pp) * 2 + 1];
    }
    for (int e = tid; e < 1024; e += NTHR) { const int c = e >> 6, pp = e & 63; cc[e * 2] = p.in[I_CRE][((l * 16 + g) * 16 + c) * 64 + pp]; cc[e * 2 + 1] = p.in[I_CIM][((l * 16 + g) * 16 + c) * 64 + pp]; }
    __syncthreads();
    bf16_t* Kc = P.S5Kc + (size_t)g * 64 * 256;
    for (int e = tid; e < 64 * 256; e += NTHR) { const int tau = e >> 8, co = (e >> 4) & 15, ci = e & 15; float s = 0.f;
        for (int pp = 0; pp < 64; ++pp) { const float c_r = cc[(co * 64 + pp) * 2], c_i = cc[(co * 64 + pp) * 2 + 1], w_r = pw[(tau * 64 + pp) * 2], w_i = pw[(tau * 64 + pp) * 2 + 1];
            const float t_r = c_r * w_r - c_i * w_i, t_i = c_r * w_i + c_i * w_r; s += t_r * bb[(pp * 16 + ci) * 2] - t_i * bb[(pp * 16 + ci) * 2 + 1]; }
        Kc[e] = (bf16_t)f2bf(s); }
    bf16_t* Wx = P.S5Wx + (size_t)g * 128 * 1024;
    for (int e = tid; e < 128 * 1024; e += NTHR) { const int n = e >> 10, k = e & 1023, pp = n >> 1, ri = n & 1, s = k >> 4, ci = k & 15;
        const float w_r = pw[((63 - s) * 64 + pp) * 2], w_i = pw[((63 - s) * 64 + pp) * 2 + 1], b_r = bb[(pp * 16 + ci) * 2], b_i = bb[(pp * 16 + ci) * 2 + 1];
        Wx[e] = (bf16_t)f2bf(ri ? (w_r * b_i + w_i * b_r) : (w_r * b_r - w_i * b_i)); }
    bf16_t* Wy = P.S5Wy + (size_t)g * 1024 * 128;
    for (int e = tid; e < 1024 * 128; e += NTHR) { const int n = e >> 7, k = e & 127, t = n >> 4, co = n & 15, pp = k >> 1, ri = k & 1;
        const float c_r = cc[(co * 64 + pp) * 2], c_i = cc[(co * 64 + pp) * 2 + 1], w_r = pw[((t + 1) * 64 + pp) * 2], w_i = pw[((t + 1) * 64 + pp) * 2 + 1];
        Wy[e] = (bf16_t)f2bf(ri ? -(c_r * w_i + c_i * w_r) : (c_r * w_r - c_i * w_i)); }
    __syncthreads();
}

__device__ __forceinline__ void ln_row(const float* src, const float* g, const float* b, float* dst, bf16_t* dstb, int lane) {
    f32x4 v[4]; float s = 0.f;
#pragma unroll
    for (int j = 0; j < 4; ++j) { v[j] = *(const f32x4*)(src + 256 * j + 4 * lane); s += (v[j].x + v[j].y) + (v[j].z + v[j].w); }
    const float mean = wave_sum(s) * (1.f / 1024.f); float s2 = 0.f;
#pragma unroll
    for (int j = 0; j < 4; ++j) { v[j] = v[j] - mean; s2 += (v[j].x * v[j].x + v[j].y * v[j].y) + (v[j].z * v[j].z + v[j].w * v[j].w); }
    const float rstd = 1.f / sqrtf(wave_sum(s2) * (1.f / 1024.f) + LN_EPS_);
#pragma unroll
    for (int j = 0; j < 4; ++j) { const f32x4 gg = *(const f32x4*)(g + 256 * j + 4 * lane), bv = *(const f32x4*)(b + 256 * j + 4 * lane);
        const f32x4 o = v[j] * rstd * gg + bv; *(f32x4*)(dst + 256 * j + 4 * lane) = o;
        if (dstb) { u32x2 w; w.x = pk2(o.x, o.y); w.y = pk2(o.z, o.w); *(u32x2*)(dstb + 256 * j + 4 * lane) = w; } }
}

template <int NR>
__device__ __forceinline__ void ln_rows(const float* src, const float* g, const float* b, float* dst, bf16_t* dstb, unsigned char* d8, int lane) {
    f32x4 v[NR][4]; float s[NR], s2[NR];
#pragma unroll
    for (int r = 0; r < NR; ++r) { s[r] = 0.f;
#pragma unroll
        for (int j = 0; j < 4; ++j) { v[r][j] = *(const f32x4*)(src + (size_t)r * 1024 + 256 * j + 4 * lane); s[r] += (v[r][j].x + v[r][j].y) + (v[r][j].z + v[r][j].w); } }
    wave_sum_n<NR>(s);
#pragma unroll
    for (int r = 0; r < NR; ++r) { const float mean = s[r] * (1.f / 1024.f); s2[r] = 0.f;
#pragma unroll
        for (int j = 0; j < 4; ++j) { v[r][j] = v[r][j] - mean; s2[r] += (v[r][j].x * v[r][j].x + v[r][j].y * v[r][j].y) + (v[r][j].z * v[r][j].z + v[r][j].w * v[r][j].w); } }
    wave_sum_n<NR>(s2);
#pragma unroll
    for (int j = 0; j < 4; ++j) { const f32x4 gg = *(const f32x4*)(g + 256 * j + 4 * lane), bv = *(const f32x4*)(b + 256 * j + 4 * lane);
#pragma unroll
        for (int r = 0; r < NR; ++r) { const float rstd = 1.f / sqrtf(s2[r] * (1.f / 1024.f) + LN_EPS_);
            const f32x4 o = v[r][j] * rstd * gg + bv; *(f32x4*)(dst + (size_t)r * 1024 + 256 * j + 4 * lane) = o;
            if (dstb) { u32x2 w; w.x = pk2(o.x, o.y); w.y = pk2(o.z, o.w); *(u32x2*)(dstb + (size_t)r * 1024 + 256 * j + 4 * lane) = w; }
            if (d8) { unsigned w8 = cvt_pk_fp8_f32_(o.x, o.y, 0u, false); w8 = cvt_pk_fp8_f32_(o.z, o.w, w8, true); *(unsigned*)(d8 + (size_t)r * 1024 + 256 * j + 4 * lane) = w8; } } }
}
__device__ __forceinline__ void phase_prologue(const KP& p, unsigned char* lds) {
    const int tid = TIDX(), lane = tid & 63, wave = tid >> 6;
    int G = GDIM(), bid = BIDX();
    for (int it = bid; it < L_ * 16; it += G) s5_tables(p, it >> 4, it & 15, lds);
    if (G >= 4 * L_ * 16) { if (bid < L_ * 16) return; bid -= L_ * 16; G -= L_ * 16; }
    float* scr = (float*)lds + wave * (64 * 33 + 16);
    const int gw = bid * NWAVE + wave, NGW = G * NWAVE;
    constexpr int I_WINT = (WIN_ROWS / 32) * 16, I_BR = 4 * 4 * 32, I_OUT = 16 * 32, I_Q = 16 * 64, I_PL = 4 * 32, I_PG = 16 * 32, I_GL = 4 * 8;
    constexpr int PER_L = I_WINT + I_BR + I_OUT + I_Q + I_PL + I_PG + I_GL;
    for (int it = gw; it < L_ * PER_L; it += NGW) {
        const int l = it / PER_L; int r = it % PER_L; const Ptrs P = make_ptrs(p.ws, l);
        if (r < I_WINT) { transpose_item<true>(p.in[I_WIN] + (size_t)l * 1024 * IN_COLS, IN_COLS, P.WinT, 1024, 0, r & 15, r >> 4, scr, lane); continue; } r -= I_WINT;
        if (r < I_BR) { const int b = r >> 7, rr = r & 127; transpose_item<false>(p.in[I_WBR] + ((size_t)l * 4 + b) * 256 * 1024, 1024, P.WbrT, 1024, 256 * b, rr & 3, rr >> 2, scr, lane); continue; } r -= I_BR;
        if (r < I_OUT) { transpose_item<false>(p.in[I_WOUT] + (size_t)l * 1024 * 1024, 1024, P.WoutT, 1024, 0, r & 15, r >> 4, scr, lane); continue; } r -= I_OUT;
        if (r < I_Q) { transpose_item<false>(p.in[I_WQ] + (size_t)l * 1024 * 2048, 2048, P.WqT, 1024, 0, r & 15, r >> 4, scr, lane); continue; } r -= I_Q;
        if (r < I_PL) { transpose_item<false>(p.in[I_PLEW] + (size_t)l * 256 * 1024, 1024, P.PleT, 256, 0, r & 3, r >> 2, scr, lane); continue; } r -= I_PL;
        if (r < I_PG) { transpose_item<false>(p.in[I_PLEG] + (size_t)l * 1024 * 1024, 1024, P.PleGT, 1024, 0, r & 15, r >> 4, scr, lane); continue; } r -= I_PG;
        transpose_item<false>(p.in[I_GLUW] + (size_t)l * 256 * 256, 256, P.GluT, 256, 0, r & 3, r >> 2, scr, lane);
    }
    const size_t gt = (size_t)bid * NTHR + tid, NGT = (size_t)G * NTHR;
    { bf16_t* K12 = (bf16_t*)(p.ws + WS_K12);
      for (size_t i = gt; i < (size_t)L_ * 2 * 16384 / 8; i += NGT) { const size_t e = i * 8; const int l = (int)(e / 32768), r = (int)(e % 32768); const float* s = (r < 16384 ? p.in[I_K1] : p.in[I_K2]) + (size_t)l * 16384 + (r & 16383);
        const f32x4 a = *(const f32x4*)s, b = *(const f32x4*)(s + 4); u32x4 o; o.x = pk2(a.x, a.y); o.y = pk2(a.z, a.w); o.z = pk2(b.x, b.y); o.w = pk2(b.z, b.w); *(u32x4*)(K12 + e) = o; } }
    { bf16_t* hb = (bf16_t*)(p.ws + WS_HB);
      unsigned char* h8a = p.ws + WS_R1 + R1_H8; unsigned char* h8b = p.ws + WS_H8T;
      for (int m = 4 * gw; m < T_; m += 4 * NGW) ln_rows<4>(p.in[I_X] + (size_t)m * 1024, p.in[I_LNIN_G], p.in[I_LNIN_B], p.out + (size_t)m * 1024, hb + (size_t)m * 1024, m < H8_SPLIT ? h8a + (size_t)m * 1024 : h8b + (size_t)(m - H8_SPLIT) * 1024, lane); }
}
__device__ __forceinline__ void conv_unit(const KP& p, const Ptrs& P, int l, int unit, unsigned char* lds) {
    bf16_t* hbuf = (bf16_t*)lds;
    float* obuf = (float*)(lds + 94 * 256 * 2);
    const int tid = TIDX(), lane = tid & 63, wave = tid >> 6;
    const int tiles_per_seq = S_ / 64, b = unit / tiles_per_seq, t0 = (unit % tiles_per_seq) * 64;
    for (int e = tid; e < 94 * 32; e += NTHR) { const int r = e >> 5, c8 = (e & 31) * 8; const int t = t0 - 30 + r;
        u32x4 o = (u32x4){0u, 0u, 0u, 0u};
        if (t >= 0) { const bf16_t* row = P.proj + (size_t)(b * S_ + t) * PJ; const u32x4 v = *(const u32x4*)(row + C_CV + c8), g = *(const u32x4*)(row + C_CG + c8);
            o.x = pk2(bflo(v.x) * sigmoidf_(bflo(g.x)), bfhi(v.x) * sigmoidf_(bfhi(g.x))); o.y = pk2(bflo(v.y) * sigmoidf_(bflo(g.y)), bfhi(v.y) * sigmoidf_(bfhi(g.y)));
            o.z = pk2(bflo(v.z) * sigmoidf_(bflo(g.z)), bfhi(v.z) * sigmoidf_(bfhi(g.z))); o.w = pk2(bflo(v.w) * sigmoidf_(bflo(g.w)), bfhi(v.w) * sigmoidf_(bfhi(g.w))); }
        *(u32x4*)(hbuf + r * 256 + c8) = o; }
    __syncthreads();
    { const int c = tid & 255, half = tid >> 8; float w[31], x[62];
#pragma unroll
      for (int j = 0; j < 31; ++j) w[j] = p.in[I_CONVW][(l * 31 + j) * 256 + c];
      const float cb = p.in[I_CONVB][l * 256 + c];
#pragma unroll
      for (int j = 0; j < 62; ++j) x[j] = bf2f(hbuf[(half * 32 + j) * 256 + c]);
#pragma unroll
      for (int tt = 0; tt < 32; ++tt) { float s = cb;
#pragma unroll
          for (int j = 0; j < 31; ++j) s += w[j] * x[tt + j];
          obuf[(half * 32 + tt) * 256 + c] = s; } }
    __syncthreads();
    { const f32x4 g = *(const f32x4*)(p.in[I_CLNG] + l * 256 + 4 * lane), bb = *(const f32x4*)(p.in[I_CLNB] + l * 256 + 4 * lane);
      f32x4 vv[8]; float m1[8], m2[8];
#pragma unroll
      for (int i = 0; i < 8; ++i) { vv[i] = *(const f32x4*)(obuf + (wave * 8 + i) * 256 + 4 * lane); m1[i] = (vv[i].x + vv[i].y) + (vv[i].z + vv[i].w); }
      wave_sum_n<8>(m1);
#pragma unroll
      for (int i = 0; i < 8; ++i) { vv[i] = vv[i] - m1[i] * (1.f / 256.f); m2[i] = (vv[i].x * vv[i].x + vv[i].y * vv[i].y) + (vv[i].z * vv[i].z + vv[i].w * vv[i].w); }
      wave_sum_n<8>(m2);
#pragma unroll
      for (int i = 0; i < 8; ++i) { const int t = wave * 8 + i; const float rstd = 1.f / sqrtf(m2[i] * (1.f / 256.f) + LN_EPS_);
          f32x4 z = vv[i] * rstd * g + bb; u32x2 w; w.x = pk2(z.x * sigmoidf_(z.x), z.y * sigmoidf_(z.y)); w.y = pk2(z.z * sigmoidf_(z.z), z.w * sigmoidf_(z.w));
          *(u32x2*)(P.ycat + (size_t)(b * S_ + t0 + t) * 1024 + 768 + 4 * lane) = w; } }
    __syncthreads();
}

constexpr int S5_NCH = S_ / 64;
constexpr int S5_UPITCH = 1032;
constexpr int S5_XPITCH = 136;
__device__ __forceinline__ void s5_unit(const KP& p, const Ptrs& P, int l, int unit, unsigned char* lds) {
    const int b = unit >> 4, g = unit & 15;
    bf16_t* Uc = (bf16_t*)lds;
    bf16_t* Kc = (bf16_t*)(lds + 66048);
    float* Xe = (float*)(lds + 66048 + 32768);
    bf16_t* Xs = (bf16_t*)(lds + 66048 + 65536);
    const int tid = TIDX(), lane = tid & 63, wave = tid >> 6, r32 = lane & 31, hi = lane >> 5;
    for (int e = tid; e < 32 * 64 * 2; e += NTHR) { const int s = e >> 1, hf = e & 1; u32x4 v = (u32x4){0u, 0u, 0u, 0u};
        if (s < S_) v = *(const u32x4*)(P.proj + (size_t)(b * S_ + s) * PJ + C_S5 + 16 * g + 8 * hf);
        *(u32x4*)(Uc + (s >> 6) * S5_UPITCH + (s & 63) * 16 + 8 * hf) = v; }
    for (int e = tid; e < 2048; e += NTHR) *(u32x4*)(Kc + e * 8) = *(const u32x4*)(P.S5Kc + (size_t)g * 16384 + e * 8);
    __syncthreads();
    { const int ntile = wave & 3, kh = wave >> 2; f32x16 acc = {};
      const bf16_t* wrow = P.S5Wx + ((size_t)g * 128 + ntile * 32 + r32) * 1024 + kh * 512 + 8 * hi;
      const bf16_t* urow = Uc + r32 * S5_UPITCH + kh * 512 + 8 * hi;
      for (int k8 = 0; k8 < 32; k8 += 8) { bf16x8 bw[8];
#pragma unroll
          for (int j = 0; j < 8; ++j) bw[j] = *(const bf16x8*)(wrow + (k8 + j) * 16);
#pragma unroll
          for (int j = 0; j < 8; ++j) { const bf16x8 a = *(const bf16x8*)(urow + (k8 + j) * 16); acc = MFMA32(a, bw[j], acc); } }
#pragma unroll
      for (int r = 0; r < 16; ++r) { const int c = (r & 3) + 8 * (r >> 2) + 4 * hi; Xe[(kh * 32 + c) * 128 + ntile * 32 + r32] = acc[r]; } }
    __syncthreads();
    if (tid < 64) { const float lr = P.S5LL[(g * 64 + tid) * 2], li = P.S5LL[(g * 64 + tid) * 2 + 1]; float xr = 0.f, xi = 0.f;
        for (int c = 0; c < 32; ++c) { Xs[c * S5_XPITCH + 2 * tid] = (bf16_t)f2bf(xr); Xs[c * S5_XPITCH + 2 * tid + 1] = (bf16_t)f2bf(xi);
            const float er = Xe[c * 128 + 2 * tid] + Xe[(32 + c) * 128 + 2 * tid], ei = Xe[c * 128 + 2 * tid + 1] + Xe[(32 + c) * 128 + 2 * tid + 1];
            const float nr = lr * xr - li * xi + er, ni = lr * xi + li * xr + ei; xr = nr; xi = ni; } }
    __syncthreads();
    { const int tt = r32 >> 4, co = r32 & 15; const float dsk = p.in[I_S5D][l * 256 + 16 * g + co];
      for (int q = 0; q < 4; ++q) { const int ntile = wave + 8 * q, t0 = 2 * ntile; f32x16 acc = {};
          const bf16_t* urow = Uc + r32 * S5_UPITCH + 8 * hi;
          for (int s = 0; s <= t0 + 1; ++s) { const int tau = t0 + tt - s; bf16x8 bk = (bf16x8){0, 0, 0, 0, 0, 0, 0, 0};
              if (tau >= 0) bk = *(const bf16x8*)(Kc + (tau * 16 + co) * 16 + 8 * hi);
              const bf16x8 a = *(const bf16x8*)(urow + s * 16); acc = MFMA32(a, bk, acc); }
          const bf16_t* wy = P.S5Wy + ((size_t)g * 1024 + ntile * 32 + r32) * 128 + 8 * hi; const bf16_t* xrow = Xs + r32 * S5_XPITCH + 8 * hi;
#pragma unroll
          for (int ks = 0; ks < 8; ++ks) { const bf16x8 a = *(const bf16x8*)(xrow + ks * 16); const bf16x8 bw = *(const bf16x8*)(wy + ks * 16); acc = MFMA32(a, bw, acc); }
#pragma unroll
          for (int r = 0; r < 16; ++r) { const int c = (r & 3) + 8 * (r >> 2) + 4 * hi; const int s = c * 64 + t0 + tt;
              if (s < S_) { const float uu = bf2f(Uc[c * S5_UPITCH + (t0 + tt) * 16 + co]); const float y = acc[r] + dsk * uu;
                  P.ycat[(size_t)(b * S_ + s) * 1024 + 256 + 16 * g + co] = (bf16_t)f2bf(gelu_erf(y)); } } } }
    __syncthreads();
}
constexpr float LOG2E_ = 1.4426950408889634f;
__device__ __forceinline__ float log_sigmoid_(float x) { return fminf(x, 0.f) - log1pf(__expf(-fabsf(x))); }
__device__ __forceinline__ void fox_unit(const KP& p, const Ptrs& P, int l, int unit, unsigned char* lds) {
    constexpr int NQB = S_ / 256;
    const int bh = unit / NQB, qb = (unit >= (NB_ * 4 * NQB) / 2) ? NQB - 1 - unit % NQB : unit % NQB, b = bh >> 2, h = bh & 3, q0 = qb * 256;
    float* cl = (float*)lds;
    unsigned char* Kt = lds + S_ * 4;
    unsigned char* Vt = Kt + 8192;
    float* wsf = (float*)(Kt + 32768);
    float* sc = wsf + 256;
    const int tid = TIDX(), lane = tid & 63, wave = tid >> 6, r32 = lane & 31, hi = lane >> 5;
    const int qend = q0 + 256;
    { constexpr int PER = (S_ + 511) / 512; const float bf = p.in[I_BF][l * 4 + h]; float loc[PER]; float s = 0.f;
#pragma unroll
      for (int i = 0; i < PER; ++i) { const int t = tid * PER + i; float v = 0.f;
          if (t < qend) v = log_sigmoid_(bf2f(P.proj[(size_t)(b * S_ + t) * PJ + C_FL + h]) + bf) * LOG2E_;
          s += v; loc[i] = s; }
      sc[tid] = s; __syncthreads();
      for (int off = 1; off < 512; off <<= 1) { const float v = sc[tid] + (tid >= off ? sc[tid - off] : 0.f); __syncthreads(); sc[tid] = v; __syncthreads(); }
      const float base = sc[tid] - s;
#pragma unroll
      for (int i = 0; i < PER; ++i) { const int t = tid * PER + i; if (t < S_) cl[t] = base + loc[i]; }
      __syncthreads(); }
    const int qrow = q0 + 32 * wave + r32;
    constexpr float C2 = 0.125f * LOG2E_;
    bf16x8 qr[4];
    { const bf16_t* qp = P.proj + (size_t)(b * S_ + qrow) * PJ + C_FQ + 64 * h + 8 * hi;
#pragma unroll
      for (int d0 = 0; d0 < 4; ++d0) { const u32x4 w = *(const u32x4*)(qp + 16 * d0);
          u32x4 o; o.x = pk2(bflo(w.x) * C2, bfhi(w.x) * C2); o.y = pk2(bflo(w.y) * C2, bfhi(w.y) * C2); o.z = pk2(bflo(w.z) * C2, bfhi(w.z) * C2); o.w = pk2(bflo(w.w) * C2, bfhi(w.w) * C2);
          qr[d0] = __builtin_bit_cast(bf16x8, o); } }
    const float clq = cl[qrow];
    float mrun = -INFINITY, lrun = 0.f; f32x16 o0 = {}, o1 = {};
    const int NT = qend / 64;
    const int srow = tid >> 3, sch = tid & 7;
    const bf16_t* kg = P.proj + (size_t)(b * S_ + srow) * PJ + C_FK + 64 * h + 8 * sch;
    const bf16_t* vg = P.vtr + (size_t)(64 * h + srow) * T_ + (size_t)b * S_ + 8 * sch;
    const int koff = srow * 128 + ((sch ^ ((srow >> 1) & 7)) * 16);
    const int voffa = srow * 128 + (((2 * sch) ^ ((srow >> 1) & 15)) * 8), voffb = srow * 128 + (((2 * sch + 1) ^ ((srow >> 1) & 15)) * 8);
    u32x4 kreg = *(const u32x4*)kg, vreg = *(const u32x4*)vg;
    *(u32x4*)(Kt + koff) = kreg; *(u32x2*)(Vt + voffa) = (u32x2){vreg.x, vreg.y}; *(u32x2*)(Vt + voffb) = (u32x2){vreg.z, vreg.w};
    if (NT > 1) { kreg = *(const u32x4*)(kg + (size_t)64 * PJ); vreg = *(const u32x4*)(vg + 64); }
    __syncthreads();
    for (int jt = 0; jt < NT; ++jt) {
        const int kv0 = jt * 64; const unsigned char* Kb = Kt + (jt & 1) * 16384; const unsigned char* Vb = Vt + (jt & 1) * 16384;
        if (kv0 <= q0 + 32 * wave + 31) {
            f32x16 pt[2];
#pragma unroll
            for (int kvt = 0; kvt < 2; ++kvt) { const int row = 32 * kvt + r32; f32x16 acc;
#pragma unroll
                for (int g4 = 0; g4 < 4; ++g4) { const f32x4 c4 = *(const f32x4*)(cl + kv0 + 32 * kvt + 8 * g4 + 4 * hi);
#pragma unroll
                    for (int e = 0; e < 4; ++e) acc[4 * g4 + e] = clq - c4[e]; }
#pragma unroll
                for (int d0 = 0; d0 < 4; ++d0) { const bf16x8 a = *(const bf16x8*)(Kb + row * 128 + (((2 * d0 + hi) ^ ((row >> 1) & 7)) * 16)); acc = MFMA32(a, qr[d0], acc); }
                pt[kvt] = acc; }
            if (kv0 + 63 > q0 + 32 * wave) {
#pragma unroll
                for (int kvt = 0; kvt < 2; ++kvt)
#pragma unroll
                    for (int r = 0; r < 16; ++r) { const int key = kv0 + 32 * kvt + (r & 3) + 8 * (r >> 2) + 4 * hi; if (key > qrow) pt[kvt][r] = -INFINITY; } }
            float mx = -INFINITY;
#pragma unroll
            for (int kvt = 0; kvt < 2; ++kvt)
#pragma unroll
                for (int r = 0; r < 16; ++r) mx = fmaxf(mx, pt[kvt][r]);
            mx = fmaxf(mx, __shfl_xor(mx, 32));
            const float mnew = fmaxf(mrun, mx), alpha = FAST_EXP2(mrun - mnew); mrun = mnew;
            float ls = 0.f;
#pragma unroll
            for (int kvt = 0; kvt < 2; ++kvt)
#pragma unroll
                for (int r = 0; r < 16; ++r) { const float e = FAST_EXP2(pt[kvt][r] - mnew); pt[kvt][r] = e; ls += e; }
            lrun = lrun * alpha + ls;
            float* wf = wsf + wave * 32;
            WAVE_SYNC(); if (hi == 0) wf[r32] = alpha; WAVE_SYNC();
#pragma unroll
            for (int g4 = 0; g4 < 4; ++g4) { const f32x4 f = *(const f32x4*)(wf + 8 * g4 + 4 * hi);
#pragma unroll
                for (int e = 0; e < 4; ++e) { o0[4 * g4 + e] *= f[e]; o1[4 * g4 + e] *= f[e]; } }
#pragma unroll
            for (int s = 0; s < 4; ++s) { const int kvt = s >> 1, rb = 8 * (s & 1);
                u32x4 pw; pw.x = pk2(pt[kvt][rb + 0], pt[kvt][rb + 1]); pw.y = pk2(pt[kvt][rb + 2], pt[kvt][rb + 3]); pw.z = pk2(pt[kvt][rb + 4], pt[kvt][rb + 5]); pw.w = pk2(pt[kvt][rb + 6], pt[kvt][rb + 7]);
                const bf16x8 pa = __builtin_bit_cast(bf16x8, pw);
#pragma unroll
                for (int dt = 0; dt < 2; ++dt) { const int d = 32 * dt + r32; const int sw = (d >> 1) & 15;
                    const u32x2 va = *(const u32x2*)(Vb + d * 128 + (((4 * s + hi) ^ sw) * 8)), vb = *(const u32x2*)(Vb + d * 128 + (((4 * s + 2 + hi) ^ sw) * 8));
                    const bf16x8 vf = __builtin_bit_cast(bf16x8, (u32x4){va.x, va.y, vb.x, vb.y});
                    if (dt == 0) o0 = MFMA32(pa, vf, o0); else o1 = MFMA32(pa, vf, o1); } }
        }
        if (jt + 1 < NT) { unsigned char* Kn = Kt + ((jt + 1) & 1) * 16384; unsigned char* Vn = Vt + ((jt + 1) & 1) * 16384;
            *(u32x4*)(Kn + koff) = kreg; *(u32x2*)(Vn + voffa) = (u32x2){vreg.x, vreg.y}; *(u32x2*)(Vn + voffb) = (u32x2){vreg.z, vreg.w};
            if (jt + 2 < NT) { kreg = *(const u32x4*)(kg + (size_t)(kv0 + 128) * PJ); vreg = *(const u32x4*)(vg + kv0 + 128); } }
        __syncthreads();
    }
    { const float lt = lrun + __shfl_xor(lrun, 32); float* wf = wsf + wave * 32;
      WAVE_SYNC(); if (hi == 0) wf[r32] = 1.0f / lt; WAVE_SYNC();
      bf16_t* orow = P.ycat + (size_t)(b * S_ + q0 + 32 * wave) * 1024 + 512 + 64 * h + r32;
#pragma unroll
      for (int r = 0; r < 16; ++r) { const int qq = (r & 3) + 8 * (r >> 2) + 4 * hi; const float f = wf[qq];
          orow[(size_t)qq * 1024] = (bf16_t)f2bf(o0[r] * f); orow[(size_t)qq * 1024 + 32] = (bf16_t)f2bf(o1[r] * f); } }
    __syncthreads();
}

constexpr int RW_NCH = S_ / 64;
constexpr int RWP = 72;
constexpr int RW_ARR = 64 * RWP * 2;
constexpr int RW_SCRP = 388;
__device__ __forceinline__ void rw_stage_weights(const KP& p, int l, int h, bf16_t* wb, int tid) {
    for (int e = tid; e < 2048; e += NTHR) { const int m = e >> 4, c4 = (e & 15) * 4;
        if (m < 32) { const f32x4 v = *(const f32x4*)(p.in[I_A2] + (l * 32 + m) * 256 + 64 * h + c4);
#pragma unroll
            for (int q = 0; q < 4; ++q) wb[(c4 + q) * 40 + m] = (bf16_t)f2bf(v[q]); }
        else if (m < 64) { const f32x4 v = *(const f32x4*)(p.in[I_W2] + (l * 32 + m - 32) * 256 + 64 * h + c4);
#pragma unroll
            for (int q = 0; q < 4; ++q) wb[2560 + (c4 + q) * 40 + (m - 32)] = (bf16_t)f2bf(v[q]); }
        else { const f32x4 v = *(const f32x4*)(p.in[I_G2] + (l * 64 + m - 64) * 256 + 64 * h + c4);
#pragma unroll
            for (int q = 0; q < 4; ++q) wb[5120 + (c4 + q) * 72 + (m - 64)] = (bf16_t)f2bf(v[q]); } }
    __syncthreads();
}
__device__ __forceinline__ bf16x8 rw_pack8(const float* q) { const f32x4 a = *(const f32x4*)q, b = *(const f32x4*)(q + 4);
    u32x4 w; w.x = pk2(a.x, a.y); w.y = pk2(a.z, a.w); w.z = pk2(b.x, b.y); w.w = pk2(b.z, b.w); return __builtin_bit_cast(bf16x8, w); }
template <int NT, bool NEED_W, bool NEED_G>
__device__ __forceinline__ void rw_prep(const KP& p, const Ptrs& P, int l, int b, int h, int tpos0, float* scr, const bf16_t* wb, int lane,
                                        float (&r)[NT], float (&lw)[NT], float (&k2)[NT], float (&v)[NT], float (&ain)[NT], float (&bin)[NT], float (&g)[NT], float (&rk)[NT]) {
    constexpr int NIT = (NT * 40 + 63) / 64;
    u32x4 cur[NIT], prv[NIT];
#pragma unroll
    for (int i = 0; i < NIT; ++i) { const int e = lane + 64 * i; const int tt = e / 40, ch = e % 40; const int t = tpos0 + tt;
        const int col = ch < 8 ? C_R + 64 * h + 8 * ch : ch < 16 ? C_K + 64 * h + 8 * (ch - 8) : ch < 24 ? C_V + 64 * h + 8 * (ch - 16) : C_HW + 8 * (ch - 24);
        cur[i] = (u32x4){0u, 0u, 0u, 0u}; prv[i] = (u32x4){0u, 0u, 0u, 0u};
        if (e < NT * 40) { const bf16_t* row = P.proj + (size_t)(b * S_ + t) * PJ + col; cur[i] = *(const u32x4*)row; if (t > 0) prv[i] = *(const u32x4*)(row - PJ); } }
    rw_stage_weights(p, l, h, const_cast<bf16_t*>(wb), TIDX());
#pragma unroll
    for (int i = 0; i < NIT; ++i) { const int e = lane + 64 * i; const int tt = e / 40, ch = e % 40;
        const int col = ch < 8 ? C_R + 64 * h + 8 * ch : ch < 16 ? C_K + 64 * h + 8 * (ch - 8) : ch < 24 ? C_V + 64 * h + 8 * (ch - 16) : C_HW + 8 * (ch - 24);
        const int idx = ch < 24 ? 8 * ch : 192 + 8 * (ch - 24);
        if (e < NT * 40) { const f32x4 m0 = *(const f32x4*)(p.in[I_MU] + l * 896 + col), m1 = *(const f32x4*)(p.in[I_MU] + l * 896 + col + 4);
            float z[8] = {bflo(cur[i].x), bfhi(cur[i].x), bflo(cur[i].y), bfhi(cur[i].y), bflo(cur[i].z), bfhi(cur[i].z), bflo(cur[i].w), bfhi(cur[i].w)};
            const float zp[8] = {bflo(prv[i].x), bfhi(prv[i].x), bflo(prv[i].y), bfhi(prv[i].y), bflo(prv[i].z), bfhi(prv[i].z), bflo(prv[i].w), bfhi(prv[i].w)};
#pragma unroll
            for (int q = 0; q < 8; ++q) { float zs = z[q] + (zp[q] - z[q]) * (q < 4 ? m0[q & 3] : m1[q & 3]);
                if (ch >= 24 && ch < 28) zs = 1.0f - 2.0f * FAST_RCP(1.0f + FAST_EXP2(zs * 2.8853900817779268f));
                else if (ch >= 32) zs = sigmoidf_(zs);
                z[q] = zs; }
            *(f32x4*)(scr + tt * RW_SCRP + idx) = (f32x4){z[0], z[1], z[2], z[3]}; *(f32x4*)(scr + tt * RW_SCRP + idx + 4) = (f32x4){z[4], z[5], z[6], z[7]}; } }
    WAVE_SYNC();
    { const int fr = lane & 15, fq = lane >> 4; const float* hrow = scr + (fr & 7) * RW_SCRP + 192 + 8 * fq;
      const bf16x8 fw = rw_pack8(hrow), fa = rw_pack8(hrow + 32), fg0 = rw_pack8(hrow + 64), fg1 = rw_pack8(hrow + 96);
      WAVE_SYNC();
#pragma unroll
      for (int nt = 0; nt < 4; ++nt) { const f32x4 z4 = (f32x4){0.f, 0.f, 0.f, 0.f};
          const f32x4 da = MFMA16(fa, *(const bf16x8*)(wb + (16 * nt + fr) * 40 + 8 * fq), z4);
          f32x4 dw = z4, dg = z4;
          if (NEED_W) dw = MFMA16(fw, *(const bf16x8*)(wb + 2560 + (16 * nt + fr) * 40 + 8 * fq), z4);
          if (NEED_G) { dg = MFMA16(fg0, *(const bf16x8*)(wb + 5120 + (16 * nt + fr) * 72 + 8 * fq), z4); dg = MFMA16(fg1, *(const bf16x8*)(wb + 5120 + (16 * nt + fr) * 72 + 32 + 8 * fq), dg); }
          if (fq < 2) {
#pragma unroll
              for (int q = 0; q < 4; ++q) { float* o = scr + (4 * fq + q) * RW_SCRP + 16 * nt + fr; o[192] = da[q]; if (NEED_W) o[256] = dw[q]; if (NEED_G) o[320] = dg[q]; } } }
      WAVE_SYNC(); }
    const int j = lane, cj = 64 * h + j; float wl[NT], al[NT], gg[NT];
    const float w0 = p.in[I_W0][l * 256 + cj], a0 = p.in[I_A0][l * 256 + cj];
#pragma unroll
    for (int tt = 0; tt < NT; ++tt) { al[tt] = a0 + scr[tt * RW_SCRP + 192 + j]; wl[tt] = NEED_W ? w0 + scr[tt * RW_SCRP + 256 + j] : w0; gg[tt] = NEED_G ? scr[tt * RW_SCRP + 320 + j] : 0.f; }
    const float kkw = p.in[I_KK][l * 256 + cj], kaw = p.in[I_KA][l * 256 + cj], rkw = p.in[I_RK][l * 256 + cj];
    float ssum[NT], rsum[NT], kkv[NT], av[NT];
#pragma unroll
    for (int tt = 0; tt < NT; ++tt) {
        const float a = sigmoidf_(al[tt]); av[tt] = a;
        const float rr = scr[tt * RW_SCRP + j], k = scr[tt * RW_SCRP + 64 + j], vv = scr[tt * RW_SCRP + 128 + j];
        const float kk2 = k * (1.f + (a - 1.f) * kaw);
        r[tt] = rr; k2[tt] = kk2; v[tt] = vv;
        const float kk = k * kkw; kkv[tt] = kk; ssum[tt] = kk * kk; rsum[tt] = rr * kk2 * rkw; }
    if (NEED_W) wave_sum_n<NT>(ssum);
    if (NEED_G) wave_sum_n<NT>(rsum);
#pragma unroll
    for (int tt = 0; tt < NT; ++tt) {
        if (NEED_W) { const float x = -wl[tt]; const float sp = fmaxf(x, 0.f) + 0.6931471805599453f * FAST_LOG2(1.0f + FAST_EXP2(-1.4426950408889634f * fabsf(x)));
            lw[tt] = -FAST_EXP2(-1.4426950408889634f * (sp + 0.5f));
            const float kkn = kkv[tt] * FAST_RSQ(fmaxf(ssum[tt], 1e-24f));
            ain[tt] = -kkn; bin[tt] = kkn * av[tt]; }
        if (NEED_G) { g[tt] = gg[tt]; rk[tt] = rsum[tt]; }
    }
    WAVE_SYNC();
}
__device__ __forceinline__ bf16x8 ldsb8(const bf16_t* p) { return *(const bf16x8*)p; }
__device__ __forceinline__ f32x16 rw_tile(const bf16_t* X, const bf16_t* Y, int tm, int tn, int r32, int hi, f32x16 acc) {
    const bf16_t* xa = X + (32 * tm + r32) * RWP + 8 * hi; const bf16_t* yb = Y + (32 * tn + r32) * RWP + 8 * hi;
#pragma unroll
    for (int ks = 0; ks < 4; ++ks) acc = MFMA32(ldsb8(xa + 16 * ks), ldsb8(yb + 16 * ks), acc);
    return acc;
}
template <int STOP = 0>
__device__ __forceinline__ void rw_chunk_unit(const KP& p, const Ptrs& P, int l, int unit, unsigned char* lds) {
    MEMFENCE(); OPAQUE_S(unit);
    const int c = unit % RW_NCH, bh = unit / RW_NCH, b = bh >> 2, h = bh & 3, t0 = c * 64;
    bf16_t* AT = (bf16_t*)(lds + 0 * RW_ARR); bf16_t* RT = (bf16_t*)(lds + 1 * RW_ARR); bf16_t* BT = (bf16_t*)(lds + 2 * RW_ARR); bf16_t* KT = (bf16_t*)(lds + 3 * RW_ARR);
    bf16_t* BH = (bf16_t*)(lds + 4 * RW_ARR); bf16_t* KH = (bf16_t*)(lds + 5 * RW_ARR); bf16_t* VT = (bf16_t*)(lds + 6 * RW_ARR);
    bf16_t* AAK = (bf16_t*)(lds + 7 * RW_ARR); bf16_t* ARB = (bf16_t*)(lds + 8 * RW_ARR); bf16_t* ARK = (bf16_t*)(lds + 9 * RW_ARR);
    bf16_t* W1T = (bf16_t*)(lds + 10 * RW_ARR); bf16_t* UVT = (bf16_t*)(lds + 11 * RW_ARR);
    bf16_t* RHT = (bf16_t*)(lds + 12 * RW_ARR);
    float* ADG = (float*)(lds + 14 * RW_ARR);
    bf16_t* ABA = (bf16_t*)(lds + 14 * RW_ARR + 8192);
    float* WT = (float*)(lds + 14 * RW_ARR + 8192 + 32 * RWP * 2);
    float* GC = WT + 512;
    bf16_t* DAB = AT;
    const int tid = TIDX(), lane = tid & 63, wave = tid >> 6, r32 = lane & 31, hi = lane >> 5;
    float r[8], lw[8], k2[8], v[8], ain[8], bin[8], gg[8], rk[8];
    rw_prep<8, true, true>(p, P, l, b, h, t0 + 8 * wave, (float*)lds + wave * (8 * RW_SCRP), (const bf16_t*)(lds + 8 * 8 * RW_SCRP * 4), lane, r, lw, k2, v, ain, bin, gg, rk);
#pragma unroll
    for (int i = 0; i < 8; ++i) { const size_t o = (size_t)(b * S_ + t0 + 8 * wave + i) * 256 + 64 * h + lane; P.rwGt[o] = (bf16_t)f2bf(gg[i]); P.rwRKV[o] = (bf16_t)f2bf(rk[i] * v[i]); }
    float Lloc[8]; { float s = 0.f;
#pragma unroll
      for (int i = 0; i < 8; ++i) { s += lw[i]; Lloc[i] = s; } }
    __syncthreads();
    if (STOP == 1) return;
    WT[wave * 64 + lane] = Lloc[7];
    __syncthreads();
    { float off = 0.f, tot = 0.f;
#pragma unroll
      for (int w = 0; w < 8; ++w) { const float x = WT[w * 64 + lane]; tot += x; if (w < wave) off += x; }
      if (wave == 0) GC[lane] = __expf(tot);
      unsigned bhp[4], khp[4], vtp[4], atp[4]; float pb = 0.f, pk = 0.f, pv = 0.f, pa = 0.f;
#pragma unroll
      for (int i = 0; i < 8; ++i) { const int t = 8 * wave + i; const float Lt = off + Lloc[i], Lp = Lt - lw[i];
          const float eL = __expf(Lt), eLp = __expf(Lp), einv = __expf(-Lt), eh = __expf(tot - Lt);
          const float xa = ain[i] * eLp;
          AT[t * RWP + lane] = (bf16_t)f2bf(xa); RT[t * RWP + lane] = (bf16_t)f2bf(r[i] * eL);
          BT[t * RWP + lane] = (bf16_t)f2bf(bin[i] * einv); KT[t * RWP + lane] = (bf16_t)f2bf(k2[i] * einv);
          const float xb = bin[i] * eh, xk = k2[i] * eh, xv = v[i];
          if (i & 1) { bhp[i >> 1] = pk2(pb, xb); khp[i >> 1] = pk2(pk, xk); vtp[i >> 1] = pk2(pv, xv); atp[i >> 1] = pk2(pa, xa); } else { pb = xb; pk = xk; pv = xv; pa = xa; } }
      *(u32x4*)(BH + lane * RWP + 8 * wave) = (u32x4){bhp[0], bhp[1], bhp[2], bhp[3]};
      *(u32x4*)(KH + lane * RWP + 8 * wave) = (u32x4){khp[0], khp[1], khp[2], khp[3]};
      *(u32x4*)(VT + lane * RWP + 8 * wave) = (u32x4){vtp[0], vtp[1], vtp[2], vtp[3]};
      *(u32x4*)(RHT + (64 + lane) * RWP + 8 * wave) = (u32x4){atp[0], atp[1], atp[2], atp[3]}; }
    __syncthreads();
#pragma unroll
    for (int jj = 0; jj < 2; ++jj) { const int job = wave + 8 * jj, mat = job >> 2, tm = (job >> 1) & 1, tn = job & 1;
        f32x16 acc = {};
        if (!(tm == 0 && tn == 1)) acc = rw_tile((mat & 2) ? RT : AT, (mat & 1) ? KT : BT, tm, tn, r32, hi, acc);
        const int s = 32 * tn + r32;
#pragma unroll
        for (int q = 0; q < 16; ++q) { const int t = 32 * tm + (q & 3) + 8 * (q >> 2) + 4 * hi;
            const bool keep = (mat & 2) ? (s <= t) : (s < t); const float x = keep ? acc[q] : 0.f;
            if (mat == 0) { if (tm == tn) ADG[(tm * 32 + (t & 31)) * 32 + (s & 31)] = x; else if (tm == 1) ABA[(t & 31) * RWP + s] = (bf16_t)f2bf(x); } else { bf16_t* D = (mat == 1) ? AAK : (mat == 2) ? ARB : ARK; D[t * RWP + s] = (bf16_t)f2bf(x); } } }
    __syncthreads();
    if (STOP == 2) return;
    if (wave < 4) { const int tm = wave >> 1, tn = wave & 1; f32x16 acc = {}; acc = rw_tile(VT, AAK, tm, tn, r32, hi, acc);
#pragma unroll
        for (int q = 0; q < 16; ++q) { const int i = 32 * tm + (q & 3) + 8 * (q >> 2) + 4 * hi; RHT[i * RWP + 32 * tn + r32] = (bf16_t)f2bf(acc[q]); } }
    else if (wave == 4) { float d[32]; const LAS float* ab = (const LAS float*)ADG + hi * 1024;
#pragma unroll
        for (int t = 0; t < 32; ++t) d[t] = (t == r32) ? 1.f : 0.f;
#pragma unroll
        for (int t = 1; t < 32; ++t) { float s0 = 0.f, s1 = 0.f;
#pragma unroll
            for (int s4 = 0; s4 < (t + 3) / 4; ++s4) { const f32x4 a4 = *(const LAS f32x4*)(ab + t * 32 + 4 * s4);
                s0 += a4[0] * d[4 * s4]; s1 += a4[1] * d[4 * s4 + 1]; s0 += a4[2] * d[4 * s4 + 2]; s1 += a4[3] * d[4 * s4 + 3]; }
            d[t] += s0 + s1; if ((t & 3) == 3) MEMFENCE(); }
        LAS bf16_t* D = (LAS bf16_t*)DAB + hi * 32 * RWP + r32;
#pragma unroll
        for (int t = 0; t < 32; ++t) D[t * RWP] = (bf16_t)f2bf(d[t]); }
    __syncthreads();
    if (wave < 4) { bf16_t* XT = (wave < 2 ? UVT : W1T) + (32 * (wave & 1)) * RWP;
        const bf16_t* rh = RHT + (32 * wave + r32) * RWP + 8 * hi;
        { f32x16 acc = {}; const bf16_t* da = DAB + r32 * RWP + 8 * hi;
#pragma unroll
          for (int ks = 0; ks < 2; ++ks) acc = MFMA32(ldsb8(rh + 16 * ks), ldsb8(da + 16 * ks), acc);
#pragma unroll
          for (int q = 0; q < 16; ++q) XT[((q & 3) + 8 * (q >> 2) + 4 * hi) * RWP + r32] = (bf16_t)f2bf(acc[q]); }
        WAVE_SYNC();
        { f32x16 acc; const bf16_t* rz = RHT + (32 * wave) * RWP + 32 + r32;
#pragma unroll
          for (int q = 0; q < 16; ++q) acc[q] = bf2f(rz[((q & 3) + 8 * (q >> 2) + 4 * hi) * RWP]);
          const bf16_t* xa = XT + r32 * RWP + 8 * hi; const bf16_t* ba = ABA + r32 * RWP + 8 * hi;
#pragma unroll
          for (int ks = 0; ks < 2; ++ks) acc = MFMA32(ldsb8(xa + 16 * ks), ldsb8(ba + 16 * ks), acc);
#pragma unroll
          for (int q = 0; q < 16; ++q) XT[((q & 3) + 8 * (q >> 2) + 4 * hi) * RWP + 32 + r32] = (bf16_t)f2bf(acc[q]); }
        WAVE_SYNC();
        { f32x16 acc = {}; const bf16_t* xz = XT + r32 * RWP + 32 + 8 * hi; const bf16_t* db = DAB + (32 + r32) * RWP + 8 * hi;
          const bf16x8 z0 = ldsb8(xz), z1 = ldsb8(xz + 16);
          acc = MFMA32(z0, ldsb8(db), acc); acc = MFMA32(z1, ldsb8(db + 16), acc);
          WAVE_SYNC();
#pragma unroll
          for (int q = 0; q < 16; ++q) XT[((q & 3) + 8 * (q >> 2) + 4 * hi) * RWP + 32 + r32] = (bf16_t)f2bf(acc[q]); } }
    __syncthreads();
    if (STOP == 3) return;
    const size_t chunk = (size_t)unit;
#pragma unroll
    for (int jj = 0; jj < 2; ++jj) { const int job = wave + 8 * jj, kind = job >> 2, tm = (job >> 1) & 1, tn = job & 1; f32x16 acc = {};
        const int col = 32 * tn + r32;
        if (kind == 0) { acc = rw_tile(BH, W1T, tm, tn, r32, hi, acc);
            bf16_t* PT = P.rwPT + chunk * 4096;
#pragma unroll
            for (int q = 0; q < 16; ++q) { const int row = 32 * tm + (q & 3) + 8 * (q >> 2) + 4 * hi; const float x = acc[q] + (row == col ? GC[row] : 0.f); PT[row * 64 + col] = (bf16_t)f2bf(x); } }
        else if (kind == 1) { acc = rw_tile(ARB, W1T, tm, tn, r32, hi, acc);
#pragma unroll
            for (int q = 0; q < 16; ++q) { const int t = 32 * tm + (q & 3) + 8 * (q >> 2) + 4 * hi; const float x = acc[q] + bf2f(RT[t * RWP + col]);
                P.rwQ[(size_t)(b * S_ + t0 + t) * 256 + 64 * h + col] = (bf16_t)f2bf(x); } }
        else if (kind == 2) { acc = rw_tile(UVT, BH, tm, tn, r32, hi, acc); acc = rw_tile(VT, KH, tm, tn, r32, hi, acc);
            unsigned* Gg = (unsigned*)(P.rwG + chunk * 4096) + (tm * 2 + tn) * 8 * 64 + lane;
#pragma unroll
            for (int q = 0; q < 8; ++q) Gg[q * 64] = pk2(acc[2 * q], acc[2 * q + 1]); }
        else { acc = rw_tile(ARB, UVT, tm, tn, r32, hi, acc); acc = rw_tile(ARK, VT, tm, tn, r32, hi, acc);
#pragma unroll
            for (int q = 0; q < 16; ++q) { const int t = 32 * tm + (q & 3) + 8 * (q >> 2) + 4 * hi; P.ycat[(size_t)(b * S_ + t0 + t) * 1024 + 64 * h + col] = (bf16_t)f2bf(acc[q]); } } }
    __syncthreads();
}
__device__ __forceinline__ void rw_state_unit(const KP& p, const Ptrs& P, int l, int unit, unsigned char* lds) {
    bf16_t* Sb = (bf16_t*)lds;
    const int tid = TIDX(), lane = tid & 63, wave = tid >> 6, r32 = lane & 31, hi = lane >> 5;
    const int ti = (wave >> 1) & 1, tj = wave & 1;
    f32x16 S = {};
    for (int c = 0; c < RW_NCH; ++c) { const size_t chunk = (size_t)unit * RW_NCH + c;
        if (wave < 4) {
#pragma unroll
            for (int q = 0; q < 16; ++q) Sb[(32 * ti + (q & 3) + 8 * (q >> 2) + 4 * hi) * RWP + 32 * tj + r32] = (bf16_t)f2bf(S[q]); }
        __syncthreads();
        { const int row = tid >> 3, ch = tid & 7; *(u32x4*)(P.rwS0 + chunk * 4096 + row * 64 + ch * 8) = *(const u32x4*)(Sb + row * RWP + ch * 8); }
        if (wave < 4) { f32x16 acc;
            const unsigned* Gg = (const unsigned*)(P.rwG + chunk * 4096) + (ti * 2 + tj) * 8 * 64 + lane;
#pragma unroll
            for (int q = 0; q < 8; ++q) { const unsigned w = Gg[q * 64]; acc[2 * q] = bflo(w); acc[2 * q + 1] = bfhi(w); }
            const bf16_t* pt = P.rwPT + chunk * 4096 + (32 * tj + r32) * 64 + 8 * hi; const bf16_t* sa = Sb + (32 * ti + r32) * RWP + 8 * hi;
#pragma unroll
            for (int ks = 0; ks < 4; ++ks) acc = MFMA32(ldsb8(sa + 16 * ks), *(const bf16x8*)(pt + 16 * ks), acc);
            S = acc; }
        __syncthreads();
    }
}
template <bool DUMMY = false>
__device__ __forceinline__ void rw_out_unit(const KP& p, const Ptrs& P, int l, int unit, unsigned char* lds) {
    MEMFENCE(); OPAQUE_S(unit);
    const int c = unit % RW_NCH, bh = unit / RW_NCH, b = bh >> 2, h = bh & 3, t0 = c * 64;
    float* Yb = (float*)(lds + 81920);
    const int tid = TIDX(), lane = tid & 63, wave = tid >> 6, r32 = lane & 31, hi = lane >> 5;
    float g[8], rkv[8];
#pragma unroll
    for (int i = 0; i < 8; ++i) { const size_t o = (size_t)(b * S_ + t0 + 8 * wave + i) * 256 + 64 * h + lane; g[i] = bf2f(P.rwGt[o]); rkv[i] = bf2f(P.rwRKV[o]); }
    if (wave < 4) { const int tm = wave >> 1, tn = wave & 1; f32x16 acc; const int col = 32 * tn + r32;
        const bf16_t* yl = P.ycat + (size_t)(b * S_ + t0 + 32 * tm) * 1024 + 64 * h + col;
#pragma unroll
        for (int q = 0; q < 16; ++q) acc[q] = bf2f(yl[(size_t)((q & 3) + 8 * (q >> 2) + 4 * hi) * 1024]);
        const bf16_t* qa = P.rwQ + (size_t)(b * S_ + t0 + 32 * tm + r32) * 256 + 64 * h + 8 * hi; const bf16_t* sb = P.rwS0 + (size_t)unit * 4096 + (32 * tn + r32) * 64 + 8 * hi;
#pragma unroll
        for (int ks = 0; ks < 4; ++ks) acc = MFMA32(*(const bf16x8*)(qa + 16 * ks), *(const bf16x8*)(sb + 16 * ks), acc);
#pragma unroll
        for (int q = 0; q < 16; ++q) Yb[(32 * tm + (q & 3) + 8 * (q >> 2) + 4 * hi) * 64 + col] = acc[q]; }
    __syncthreads();
    const float gng = p.in[I_LNXG][l * 256 + 64 * h + lane], gnb = p.in[I_LNXB][l * 256 + 64 * h + lane];
    { float yv[8], m1[8], m2[8];
#pragma unroll
      for (int i = 0; i < 8; ++i) { yv[i] = Yb[(8 * wave + i) * 64 + lane]; m1[i] = yv[i]; }
      wave_sum_n<8>(m1);
#pragma unroll
      for (int i = 0; i < 8; ++i) { yv[i] -= m1[i] * (1.f / 64.f); m2[i] = yv[i] * yv[i]; }
      wave_sum_n<8>(m2);
#pragma unroll
      for (int i = 0; i < 8; ++i) { const int t = 8 * wave + i; const float yn = yv[i] * (1.0f / sqrtf(m2[i] * (1.f / 64.f) + GN_EPS_)) * gng + gnb; const float o = (yn + rkv[i]) * g[i];
        if (DUMMY) P.pb[(size_t)(b * S_ + t0 + t) * 256 + 64 * h + lane] = (bf16_t)f2bf(o);
        else P.ycat[(size_t)(b * S_ + t0 + t) * 1024 + 64 * h + lane] = (bf16_t)f2bf(o); } }
    __syncthreads();
}
#ifdef EMU_FP8_A
#define EMU_AUX77 u.aux = 77;
#else
#define EMU_AUX77
#endif
__device__ __forceinline__ void tile_map(int L, int nM, int nN, int& pm, int& pn) {
    const int nwg = nM * nN, q = nwg / 8, r = nwg % 8, xcd = L % 8, off = L / 8;
    const int wgid = (xcd < r ? xcd * (q + 1) : r * (q + 1) + (xcd - r) * q) + off;
    const int nig = 8 * nN, gid = wgid / nig, fm = gid * 8, gsz = (nM - fm) < 8 ? (nM - fm) : 8;
    pm = fm + ((wgid % nig) % gsz); pn = (wgid % nig) / gsz;
}
struct EpiStoreBf16 {
    bf16_t* base0; int ldc0; bf16_t* base1; int ldc1;
    __device__ __forceinline__ void operator()(const f32x4 (&acc)[2][2][4][2], const pg8::Unit& u, int wr, int wc, int fr, int fq, int tid) const {
        bf16_t* base = u.kind ? base1 : base0; const int ldc = u.kind ? ldc1 : ldc0;
        int row0 = u.pm * 256 + wr * 64 + fr, col0 = u.pn * 256 + wc * 32 + 8 * fq; OPAQUE(row0); OPAQUE(col0);
#pragma unroll
        for (int ai = 0; ai < 2; ++ai)
#pragma unroll
            for (int m = 0; m < 4; ++m) { bf16_t* rowp = base + (size_t)(row0 + ai * 128 + m * 16) * ldc + col0;
#pragma unroll
                for (int bj = 0; bj < 2; ++bj) { const f32x4 v0 = acc[ai][bj][m][0], v1 = acc[ai][bj][m][1];
                    u32x4 w; w.x = pk2(v0[0], v0[1]); w.y = pk2(v0[2], v0[3]); w.z = pk2(v1[0], v1[1]); w.w = pk2(v1[2], v1[3]);
                    *(u32x4*)(rowp + bj * 128) = w; } }
    }
};
struct SchedA { const bf16_t* hb; const bf16_t* WinT; int G, c;
    __device__ __forceinline__ bool next(int i, pg8::Unit& u) const {
        const int nM = T_ / 256, n0 = nM * 9; const int x = i * G + c; if (x >= n0 + nM) return false;
        u.nt = 16; u.aux = 0; u.f8 = 0;
        if (x < n0) { tile_map(x, nM, 9, u.pm, u.pn); u.kind = 0; EMU_AUX77 u.a = (const char*)(hb + (size_t)u.pm * 256 * 1024); u.b = (const char*)(WinT + (size_t)u.pn * 256 * 1024); }
        else { u.pm = 0; u.pn = x - n0; u.kind = 1; u.a = (const char*)(WinT + (size_t)WIN_VT * 1024); u.b = (const char*)(hb + (size_t)u.pn * 256 * 1024); }
        return true; } };
__device__ __forceinline__ void phase_A(const KP& p, int l, unsigned char* lds) {
    const Ptrs P = make_ptrs(p.ws, l);
    SchedA S{P.hb, P.WinT, GDIM(), BIDX()};
    EpiStoreBf16 E{P.proj, PJ, P.vtr, T_};
    pg8::gemm_phase((LAS unsigned char*)lds, 1024, 1024, S, E);
}
#if PROBE_REPEAT >= 40 && PROBE_REPEAT <= 49
struct SchedAP { const bf16_t* hb; const bf16_t* WinT; int G, c, nt, pnmask;
    __device__ __forceinline__ bool next(int i, pg8::Unit& u) const {
        const int nM = T_ / 256, n0 = nM * 9; const int x = i * G + c; if (x >= n0 + nM) return false;
        u.nt = nt; u.aux = 0; u.f8 = 0;
        if (x < n0) { tile_map(x, nM, 9, u.pm, u.pn); u.kind = 0; u.a = (const char*)(hb + (size_t)u.pm * 256 * 1024); u.b = (const char*)(WinT + (size_t)u.pn * 256 * 1024); }
        else { u.pm = 0; u.pn = x - n0; u.kind = 1; u.a = (const char*)(WinT + (size_t)WIN_VT * 1024); u.b = (const char*)(hb + (size_t)u.pn * 256 * 1024); }
        u.pn &= pnmask; return true; } };
struct EpiNull { float* d;
    __device__ __forceinline__ void operator()(const f32x4 (&acc)[2][2][4][2], const pg8::Unit& u, int wr, int wc, int fr, int fq, int tid) const {
        f32x4 s = (f32x4){0.f, 0.f, 0.f, 0.f};
#pragma unroll
        for (int ai = 0; ai < 2; ++ai)
#pragma unroll
            for (int m = 0; m < 4; ++m)
#pragma unroll
                for (int bj = 0; bj < 2; ++bj) s += acc[ai][bj][m][0] + acc[ai][bj][m][1];
        if (s.x + s.y + s.z + s.w == 1.2345e30f) d[tid] = s.x; } };
struct EpiStash { u32x4* stash;
    __device__ __forceinline__ void operator()(const f32x4 (&acc)[2][2][4][2], const pg8::Unit& u, int wr, int wc, int fr, int fq, int tid) const {
        OPAQUE(tid);
#pragma unroll
        for (int ai = 0; ai < 2; ++ai)
#pragma unroll
            for (int m = 0; m < 4; ++m)
#pragma unroll
                for (int bj = 0; bj < 2; ++bj) { const f32x4 v0 = acc[ai][bj][m][0], v1 = acc[ai][bj][m][1];
                    u32x4 w; w.x = pk2(v0[0], v0[1]); w.y = pk2(v0[2], v0[3]); w.z = pk2(v1[0], v1[1]); w.w = pk2(v1[2], v1[3]);
                    stash[((ai * 4 + m) * 2 + bj) * 512 + tid] = w; } } };
template <int V>
__device__ __forceinline__ void phase_Aprobe(const KP& p, int l, unsigned char* lds) {
    const Ptrs P = make_ptrs(p.ws, l);
    SchedAP S{P.hb, P.WinT, GDIM(), BIDX(), V == 1 ? 32 : V == 3 ? 4 : V == 4 ? 8 : V == 5 ? 64 : 16, V == 6 ? 3 : 0xffff};
    if (V == 2) { EpiStash E{(u32x4*)(P.ycat + (size_t)BIDX() * 65536)}; pg8::gemm_phase((LAS unsigned char*)lds, 1024, 1024, S, E); }
    else if (V == 6) { EpiStoreBf16 E{P.ycat, 1024, P.ycat, 1024}; pg8::gemm_phase((LAS unsigned char*)lds, 1024, 1024, S, E); }
    else { EpiNull E{(float*)(P.ycat + (size_t)BIDX() * 65536)}; pg8::gemm_phase((LAS unsigned char*)lds, 1024, 1024, S, E); }
}
#endif
struct SchedGlu { const bf16_t* ycat; const bf16_t* GluT; int G, c;
    __device__ __forceinline__ bool next(int i, pg8::Unit& u) const {
        const int x = i * G + c; if (x >= T_ / 256) return false;
        u.pm = x; u.pn = 0; u.nt = 4; u.kind = 0; u.aux = 0; u.f8 = 0; u.a = (const char*)(ycat + (size_t)x * 256 * 1024 + 256); u.b = (const char*)GluT; return true; } };
struct EpiGlu { bf16_t* ycat; const float* glub;
    __device__ __forceinline__ void operator()(const f32x4 (&acc)[2][2][4][2], const pg8::Unit& u, int wr, int wc, int fr, int fq, int tid) const {
        int row0 = u.pm * 256 + wr * 64 + fr, col0 = wc * 32 + 8 * fq; OPAQUE(row0); OPAQUE(col0);
#pragma unroll
        for (int bj = 0; bj < 2; ++bj) { const f32x4 b0 = *(const f32x4*)(glub + col0 + bj * 128), b1 = *(const f32x4*)(glub + col0 + bj * 128 + 4);
#pragma unroll
            for (int ai = 0; ai < 2; ++ai)
#pragma unroll
                for (int m = 0; m < 4; ++m) { bf16_t* ptr = ycat + (size_t)(row0 + ai * 128 + m * 16) * 1024 + 256 + col0 + bj * 128;
                    const u32x4 y = *(const u32x4*)ptr; const f32x4 v0 = acc[ai][bj][m][0] + b0, v1 = acc[ai][bj][m][1] + b1;
                    u32x4 w; w.x = pk2(bflo(y.x) * sigmoidf_(v0[0]), bfhi(y.x) * sigmoidf_(v0[1])); w.y = pk2(bflo(y.y) * sigmoidf_(v0[2]), bfhi(y.y) * sigmoidf_(v0[3]));
                    w.z = pk2(bflo(y.z) * sigmoidf_(v1[0]), bfhi(y.z) * sigmoidf_(v1[1])); w.w = pk2(bflo(y.w) * sigmoidf_(v1[2]), bfhi(y.w) * sigmoidf_(v1[3]));
                    *(u32x4*)ptr = w; MEMFENCE(); } }
    }
};
__device__ __forceinline__ void convert_tables(const KP& p, const Ptrs& P, int l, unsigned char* lds) {
    const int tid = TIDX(), lane = tid & 63, wave = tid >> 6;
    unsigned* cnt = (unsigned*)(p.ws + WS_CTL) + 10240 + 16 * l; int* slot = (int*)(lds + 65536);
    const float* ps = p.in[I_P] + (size_t)l * T_ * 256;
    constexpr int NG8 = 5120 / 128, NTAB = 2 * NEXP / 128, NPB = (int)(((size_t)T_ * 256 / 8 + 4095) / 4096);
    for (;;) {
        __syncthreads(); if (tid == 0) *slot = (int)atomicAdd(cnt, 1u); __syncthreads();
        int item = *slot; if (item >= NG8 + NTAB + NPB) break;
        if (item < NG8) {
            for (int rr = wave; rr < 128; rr += NWAVE) { const int r5 = item * 128 + rr; bf16_t* row = r5 < 4096 ? P.WinT + (size_t)(WIN_GATE + r5) * 1024 : P.PleGT + (size_t)(r5 - 4096) * 1024;
                const u32x4 a = *(const u32x4*)(row + 16 * lane), b = *(const u32x4*)(row + 16 * lane + 8);
                float v[16] = {bflo(a.x), bfhi(a.x), bflo(a.y), bfhi(a.y), bflo(a.z), bfhi(a.z), bflo(a.w), bfhi(a.w), bflo(b.x), bfhi(b.x), bflo(b.y), bfhi(b.y), bflo(b.z), bfhi(b.z), bflo(b.w), bfhi(b.w)};
                float am = 0.f;
#pragma unroll
                for (int j = 0; j < 16; ++j) am = fmaxf(am, fabsf(v[j]));
                am = wave_max(am); const float sc = am > 0.f ? am * (1.0f / 440.0f) : 1.0f, inv = 1.0f / sc; u32x4 o;
#pragma unroll
                for (int j = 0; j < 4; ++j) { unsigned w = cvt_pk_fp8_f32_(v[4 * j] * inv, v[4 * j + 1] * inv, 0u, false); w = cvt_pk_fp8_f32_(v[4 * j + 2] * inv, v[4 * j + 3] * inv, w, true); o[j] = w; }
                WAVE_SYNC();
                *(u32x4*)((unsigned char*)row + 16 * lane) = o;
                if (lane == 0) P.gsc[r5] = sc; }
            continue; }
        item -= NG8;
        if (item < NTAB) {
            for (int rr = wave; rr < 128; rr += NWAVE) { const int it = item * 128 + rr; const int tb = it >= NEXP, row = tb ? it - NEXP : it;
                const float* src = p.in[tb ? I_V : I_U] + ((size_t)l * NEXP + row) * 1024 + 16 * lane; f32x4 v[4]; float am = 0.f;
#pragma unroll
                for (int j = 0; j < 4; ++j) { v[j] = *(const f32x4*)(src + 4 * j); am = fmaxf(am, fmaxf(fmaxf(fabsf(v[j].x), fabsf(v[j].y)), fmaxf(fabsf(v[j].z), fabsf(v[j].w)))); }
                am = wave_max(am); const float sc = am > 0.f ? am * (1.0f / 440.0f) : 1.0f, inv = 1.0f / sc; u32x4 o;
#pragma unroll
                for (int j = 0; j < 4; ++j) { unsigned w = cvt_pk_fp8_f32_(v[j].x * inv, v[j].y * inv, 0u, false); w = cvt_pk_fp8_f32_(v[j].z * inv, v[j].w * inv, w, true); o[j] = w; }
                *(u32x4*)((tb ? P.V8 : P.U8) + ((size_t)(lane >> 3) * NEXP + row) * 128 + 16 * (lane & 7)) = o;
                if (lane == 0) (tb ? P.sv : P.su)[row] = sc; }
        } else {
            const size_t base = (size_t)(item - NTAB) * 4096;
            for (size_t i = base + tid; i < base + 4096 && i < (size_t)T_ * 256 / 8; i += NTHR) { const size_t e = i * 8;
                const f32x4 a = *(const f32x4*)(ps + e), b = *(const f32x4*)(ps + e + 4); u32x4 o; o.x = pk2(a.x, a.y); o.y = pk2(a.z, a.w); o.z = pk2(b.x, b.y); o.w = pk2(b.z, b.w); *(u32x4*)(P.pb + e) = o; }
        }
    }
}
__device__ __forceinline__ void phase_B2(const KP& p, int l, unsigned char* lds) {
    const Ptrs P = make_ptrs(p.ws, l);
    constexpr int NRW = NB_ * 4; const int G = GDIM(), c = BIDX();
    int gG = G, gc = c;
    if (G > NRW) { if (c < NRW) { rw_state_unit(p, P, l, c, lds);
#if PROBE_REPEAT == 35
        rw_state_unit(p, P, l, c, lds);
#endif
        convert_tables(p, P, l, lds); return; } gG = G - NRW; gc = c - NRW; }
    else { for (int u = c; u < NRW; u += G) rw_state_unit(p, P, l, u, lds); }
    SchedGlu S{P.ycat, P.GluT, gG, gc};
    EpiGlu E{P.ycat, p.in[I_GLUB] + l * 256};
    pg8::gemm_phase((LAS unsigned char*)lds, 1024, 256, S, E);
    convert_tables(p, P, l, lds);
}
struct SchedC { const unsigned char* h8a; const unsigned char* h8b; const bf16_t* ycat; const bf16_t* WinT; const bf16_t* WbrT; int G, c;
    __device__ __forceinline__ bool next(int i, pg8::Unit& u) const {
        const int tile = (i >> 3) * G + c; if (tile >= (T_ / 256) * 4) return false;
        const int j = i & 7, b = j >> 1; tile_map(tile, T_ / 256, 4, u.pm, u.pn); u.aux = b;
        if (!(j & 1)) { u.kind = 0; u.nt = 4; u.f8 = 0; u.a = (const char*)(ycat + (size_t)u.pm * 256 * 1024 + 256 * b); u.b = (const char*)(WbrT + (size_t)u.pn * 256 * 1024 + 256 * b); }
        else { u.kind = 1; u.nt = 8; u.f8 = 1; const int m0 = u.pm * 256;
            u.a = (const char*)(m0 < H8_SPLIT ? h8a + (size_t)m0 * 1024 : h8b + (size_t)(m0 - H8_SPLIT) * 1024); u.b = (const char*)(WinT + (size_t)(WIN_GATE + 1024 * b + 256 * u.pn) * 1024); }
        return true; } };
struct EpiC { u32x4* stash; bf16_t* merged; const float* gsc;
    __device__ __forceinline__ void operator()(const f32x4 (&acc)[2][2][4][2], const pg8::Unit& u, int wr, int wc, int fr, int fq, int tid) const {
        OPAQUE(tid);
        if (u.kind == 0) {
#pragma unroll
            for (int ai = 0; ai < 2; ++ai)
#pragma unroll
                for (int m = 0; m < 4; ++m)
#pragma unroll
                    for (int bj = 0; bj < 2; ++bj) { const f32x4 v0 = acc[ai][bj][m][0], v1 = acc[ai][bj][m][1];
                        u32x4 w; w.x = pk2(v0[0], v0[1]); w.y = pk2(v0[2], v0[3]); w.z = pk2(v1[0], v1[1]); w.w = pk2(v1[2], v1[3]);
                        stash[((ai * 4 + m) * 2 + bj) * 512 + tid] = w; }
        } else {
            int row0 = u.pm * 256 + wr * 64 + fr, col0 = u.pn * 256 + wc * 32 + 8 * fq; OPAQUE(row0); OPAQUE(col0); const bool first = (u.aux == 0);
            f32x4 sc[2][2];
#pragma unroll
            for (int bj = 0; bj < 2; ++bj) { const float* sp = gsc + 1024 * u.aux + col0 + bj * 128; sc[bj][0] = *(const f32x4*)sp; sc[bj][1] = *(const f32x4*)(sp + 4); }
#pragma unroll
            for (int ai = 0; ai < 2; ++ai)
#pragma unroll
                for (int mp = 0; mp < 2; ++mp) { u32x4 y[4], mo[4];
#pragma unroll
                    for (int q = 0; q < 4; ++q) { const int m = 2 * mp + (q >> 1), bj = q & 1;
                        y[q] = stash[((ai * 4 + m) * 2 + bj) * 512 + tid]; mo[q] = (u32x4){0u, 0u, 0u, 0u};
                        if (!first) mo[q] = *(const u32x4*)(merged + (size_t)(row0 + ai * 128 + m * 16) * 1024 + col0 + bj * 128); }
#pragma unroll
                    for (int q = 0; q < 4; ++q) { const int m = 2 * mp + (q >> 1), bj = q & 1; const f32x4 g0 = acc[ai][bj][m][0] * sc[bj][0], g1 = acc[ai][bj][m][1] * sc[bj][1];
                        bf16_t* ptr = merged + (size_t)(row0 + ai * 128 + m * 16) * 1024 + col0 + bj * 128;
                        const float o0 = bflo(y[q].x) * sigmoidf_(g0[0]) + bflo(mo[q].x), o1 = bfhi(y[q].x) * sigmoidf_(g0[1]) + bfhi(mo[q].x), o2 = bflo(y[q].y) * sigmoidf_(g0[2]) + bflo(mo[q].y), o3 = bfhi(y[q].y) * sigmoidf_(g0[3]) + bfhi(mo[q].y);
                        const float o4 = bflo(y[q].z) * sigmoidf_(g1[0]) + bflo(mo[q].z), o5 = bfhi(y[q].z) * sigmoidf_(g1[1]) + bfhi(mo[q].z), o6 = bflo(y[q].w) * sigmoidf_(g1[2]) + bflo(mo[q].w), o7 = bfhi(y[q].w) * sigmoidf_(g1[3]) + bfhi(mo[q].w);
                        u32x4 w; w.x = pk2(o0, o1); w.y = pk2(o2, o3); w.z = pk2(o4, o5); w.w = pk2(o6, o7);
                        *(u32x4*)ptr = w; }
                    MEMFENCE(); }
        }
    }
};
__device__ __forceinline__ void phase_C(const KP& p, int l, unsigned char* lds) {
    const Ptrs P = make_ptrs(p.ws, l);
    SchedC S{P.h8a, P.h8b, P.ycat, P.WinT, P.WbrT, GDIM(), BIDX()};
    EpiC E{(u32x4*)(P.stash + (size_t)BIDX() * 131072), P.merged, P.gsc};
    pg8::gemm_phase<2>((LAS unsigned char*)lds, 1024, 1024, S, E, 1024);
}
struct SchedD { const bf16_t* A; const bf16_t* Bt; int nN, G, c;
    __device__ __forceinline__ bool next(int i, pg8::Unit& u) const {
        const int x = i * G + c; if (x >= (T_ / 256) * nN) return false;
        tile_map(x, T_ / 256, nN, u.pm, u.pn); u.nt = 16; u.kind = 0; u.aux = 0; u.f8 = 0; u.a = (const char*)(A + (size_t)u.pm * 256 * 1024); u.b = (const char*)(Bt + (size_t)u.pn * 256 * 1024); return true; } };
struct EpiResid { float* h;
    __device__ __forceinline__ void operator()(const f32x4 (&acc)[2][2][4][2], const pg8::Unit& u, int wr, int wc, int fr, int fq, int tid) const {
        int row0 = u.pm * 256 + wr * 64 + fr, col0 = u.pn * 256 + wc * 32 + 8 * fq; OPAQUE(row0); OPAQUE(col0);
#pragma unroll
        for (int ai = 0; ai < 2; ++ai)
#pragma unroll
            for (int m = 0; m < 4; ++m)
#pragma unroll
                for (int bj = 0; bj < 2; ++bj) { float* ptr = h + (size_t)(row0 + ai * 128 + m * 16) * 1024 + col0 + bj * 128;
                    const f32x4 h0 = *(const f32x4*)ptr, h1 = *(const f32x4*)(ptr + 4);
                    *(f32x4*)ptr = h0 * DN_ALPHA_ + acc[ai][bj][m][0]; *(f32x4*)(ptr + 4) = h1 * DN_ALPHA_ + acc[ai][bj][m][1]; }
    }
};
__device__ __forceinline__ void phase_D(const KP& p, int l, unsigned char* lds) {
    const Ptrs P = make_ptrs(p.ws, l);
    SchedD S{P.merged, P.WoutT, 4, GDIM(), BIDX()};
    EpiResid E{p.out};
    pg8::gemm_phase((LAS unsigned char*)lds, 1024, 1024, S, E);
}
__device__ __forceinline__ void phase_D2(const KP& p, int l, unsigned char* lds) {
    const Ptrs P = make_ptrs(p.ws, l);
    const int tid = TIDX(), lane = tid & 63, wave = tid >> 6; const int gw = BIDX() * NWAVE + wave, NGW = GDIM() * NWAVE;
    for (int m = 4 * gw; m < T_; m += 4 * NGW) ln_rows<4>(p.out + (size_t)m * 1024, p.in[I_LN1G] + l * 1024, p.in[I_LN1B] + l * 1024, p.out + (size_t)m * 1024, P.hb + (size_t)m * 1024, P.h8e + (size_t)m * 1024, lane);
}
struct SchedE1 { const bf16_t* pb; const bf16_t* PleT; int G, c;
    __device__ __forceinline__ bool next(int i, pg8::Unit& u) const {
        const int x = i * G + c; if (x >= (T_ / 256) * 4) return false;
        tile_map(x, T_ / 256, 4, u.pm, u.pn); u.nt = 4; u.kind = 0; u.aux = 0; u.f8 = 0; u.a = (const char*)(pb + (size_t)u.pm * 256 * 256); u.b = (const char*)(PleT + (size_t)u.pn * 256 * 256); return true; } };
template <int PART>
struct SchedE2 { const bf16_t* hb; const unsigned char* h8e; const bf16_t* PleGT; const bf16_t* WqT; int G, c;
    __device__ __forceinline__ bool next(int i, pg8::Unit& u) const {
        const int n0 = (T_ / 256) * 4; int x = i * G + c + (PART ? n0 : 0); if (x >= (PART ? n0 + (T_ / 256) * 8 : n0)) return false;
        u.aux = 0;
        if (x < n0) { tile_map(x, T_ / 256, 4, u.pm, u.pn); u.kind = 0; u.nt = 8; u.f8 = 1; u.b = (const char*)(PleGT + (size_t)u.pn * 256 * 1024); u.a = (const char*)(h8e + (size_t)u.pm * 256 * 1024); }
        else { x -= n0; tile_map(x, T_ / 256, 8, u.pm, u.pn); u.kind = 1; u.nt = 16; u.f8 = 0; u.b = (const char*)(WqT + (size_t)u.pn * 256 * 1024); u.a = (const char*)(hb + (size_t)u.pm * 256 * 1024); }
        return true; } };
struct EpiE2g { float* h; const bf16_t* Pbuf; const float* gsc;
    __device__ __forceinline__ void operator()(const f32x4 (&acc)[2][2][4][2], const pg8::Unit& u, int wr, int wc, int fr, int fq, int tid) const {
        int row0 = u.pm * 256 + wr * 64 + fr, col0 = u.pn * 256 + wc * 32 + 8 * fq; OPAQUE(row0); OPAQUE(col0);
#pragma unroll
        for (int bj = 0; bj < 2; ++bj) { const float* sp = gsc + 4096 + col0 + bj * 128; const f32x4 s0 = *(const f32x4*)sp, s1 = *(const f32x4*)(sp + 4);
            const size_t cb = (size_t)row0 * 1024 + col0 + bj * 128; float* hp = h + cb; const bf16_t* pp = Pbuf + cb;
#pragma unroll
            for (int ai = 0; ai < 2; ++ai)
#pragma unroll
                for (int m = 0; m < 4; ++m) { const int ro = (ai * 128 + m * 16) * 1024;
                    const u32x4 y = *(const u32x4*)(pp + ro); const f32x4 h0 = *(const f32x4*)(hp + ro), h1 = *(const f32x4*)(hp + ro + 4);
                    const f32x4 v0 = acc[ai][bj][m][0] * s0, v1 = acc[ai][bj][m][1] * s1;
                    f32x4 o0, o1; o0[0] = bflo(y.x) * sigmoidf_(v0[0]); o0[1] = bfhi(y.x) * sigmoidf_(v0[1]); o0[2] = bflo(y.y) * sigmoidf_(v0[2]); o0[3] = bfhi(y.y) * sigmoidf_(v0[3]);
                    o1[0] = bflo(y.z) * sigmoidf_(v1[0]); o1[1] = bfhi(y.z) * sigmoidf_(v1[1]); o1[2] = bflo(y.w) * sigmoidf_(v1[2]); o1[3] = bfhi(y.w) * sigmoidf_(v1[3]);
                    *(f32x4*)(hp + ro) = h0 * DN_ALPHA_ + o0; *(f32x4*)(hp + ro + 4) = h1 * DN_ALPHA_ + o1; } }
    }
};
__device__ __forceinline__ void phase_E(const KP& p, int l, unsigned char* lds) {
    const Ptrs P = make_ptrs(p.ws, l);
    { SchedE1 S{P.pb, P.PleT, GDIM(), BIDX()}; EpiStoreBf16 E{P.ycat, 1024, P.ycat, 1024}; pg8::gemm_phase((LAS unsigned char*)lds, 256, 256, S, E); }
    { SchedE2<0> S{P.hb, P.h8e, P.PleGT, P.WqT, GDIM(), BIDX()}; EpiE2g E{p.out, P.ycat, P.gsc}; pg8::gemm_phase<1>((LAS unsigned char*)lds, 1024, 1024, S, E, 1024); }
    { SchedE2<1> S{P.hb, P.h8e, P.PleGT, P.WqT, GDIM(), BIDX()}; EpiStoreBf16 E{P.q, 2048, P.q, 2048}; pg8::gemm_phase<0>((LAS unsigned char*)lds, 1024, 1024, S, E); }
}
__device__ __forceinline__ unsigned mono_key(float f) { const unsigned u = __builtin_bit_cast(unsigned, f); return (u & 0x80000000u) ? ~u : (u | 0x80000000u); }
__device__ __forceinline__ float unmono_key(unsigned k) { const unsigned u = (k & 0x80000000u) ? (k ^ 0x80000000u) : ~k; return __builtin_bit_cast(float, u); }
struct CandTab { int a[50], b[50]; };
constexpr CandTab make_cand() { CandTab t{}; int n = 0; for (int a = 0; a < 16; ++a) for (int b = 0; b < 16; ++b) if ((a + 1) * (b + 1) <= 16) { t.a[n] = a; t.b[n] = b; ++n; } return t; }
constexpr CandTab CAND = make_cand();
constexpr int PK_PITCH = 136;

#define PK_CE(x, y) do { const unsigned _a = (x), _b = (y); (x) = _a > _b ? _a : _b; (y) = _a > _b ? _b : _a; } while (0)
__device__ __forceinline__ void bitonic_merge16_desc(unsigned (&a)[16]) {
#pragma unroll
    for (int j = 8; j > 0; j >>= 1)
#pragma unroll
        for (int i = 0; i < 16; ++i) { const int l = i ^ j; if (l > i) PK_CE(a[i], a[l]); }
}
__device__ __forceinline__ void bitonic_sort16_desc(unsigned (&a)[16]) {
#pragma unroll
    for (int k = 2; k <= 16; k <<= 1)
#pragma unroll
        for (int j = k >> 1; j > 0; j >>= 1)
#pragma unroll
            for (int i = 0; i < 16; ++i) { const int l = i ^ j; if (l > i) { if ((i & k) == 0 || k == 16) PK_CE(a[i], a[l]); else PK_CE(a[l], a[i]); } }
}
__device__ __forceinline__ void top_half_merge16(unsigned (&a)[16], const unsigned (&b)[16]) {
#pragma unroll
    for (int i = 0; i < 16; ++i) a[i] = a[i] > b[15 - i] ? a[i] : b[15 - i];
    bitonic_merge16_desc(a);
}
__device__ __forceinline__ void top16_keys(const unsigned (&key)[64], unsigned (&top)[16]) {
    unsigned g0[16], g1[16], g2[16], g3[16];
#pragma unroll
    for (int i = 0; i < 16; ++i) { g0[i] = key[i]; g1[i] = key[16 + i]; g2[i] = key[32 + i]; g3[i] = key[48 + i]; }
    bitonic_sort16_desc(g0); bitonic_sort16_desc(g1); bitonic_sort16_desc(g2); bitonic_sort16_desc(g3);
    top_half_merge16(g0, g1); top_half_merge16(g2, g3); top_half_merge16(g0, g2);
    unsigned pr[16];
#pragma unroll
    for (int i = 0; i < 16; ++i) pr[i] = (unsigned)__shfl_xor((int)g0[i], 32);
    top_half_merge16(g0, pr);
#pragma unroll
    for (int i = 0; i < 16; ++i) top[i] = g0[i];
}
__device__ __forceinline__ void peer_route_unit(const KP& p, const Ptrs& P, int l, int unit, unsigned char* lds) {
    const bf16_t* Ks = (const bf16_t*)lds;
    const int tid = TIDX(), lane = tid & 63, wave = tid >> 6, r32 = lane & 31, hi = lane >> 5;
    const int tok = unit * 32 + r32;
    int kbase = r32 * PK_PITCH + 8 * hi; OPAQUE(kbase);
    unsigned top1[16], top2[16];
#pragma unroll 1
    for (int half = 0; half < 2; ++half) {
        const bf16_t* qp = P.q + (size_t)tok * 2048 + wave * 256 + half * 128 + 8 * hi;
        bf16x8 qf[8];
#pragma unroll
        for (int ks = 0; ks < 8; ++ks) qf[ks] = *(const bf16x8*)(qp + 16 * ks);
        unsigned key[64];
#pragma unroll
        for (int kt = 0; kt < 4; ++kt) { f32x16 acc = {}; const bf16_t* kp = Ks + (half * 128 + 32 * kt) * PK_PITCH + kbase;
#pragma unroll
            for (int ks = 0; ks < 8; ++ks) { const bf16x8 a = *(const bf16x8*)(kp + 16 * ks); acc = MFMA32(a, qf[ks], acc); }
#pragma unroll
            for (int r = 0; r < 16; ++r) { const int idx = 32 * kt + (r & 3) + 8 * (r >> 2) + 4 * hi; key[16 * kt + r] = (mono_key(acc[r]) & ~127u) | (unsigned)(127 - idx); } }
        if (half == 0) top16_keys(key, top1); else top16_keys(key, top2);
        MEMFENCE();
    }
    MEMFENCE();
    int* islot = (int*)(lds + 2 * 128 * PK_PITCH * 2) + (wave * 32 + r32) * 33;
    float v1[16], v2[16];
#pragma unroll
    for (int r = 0; r < 16; ++r) { v1[r] = unmono_key(top1[r] & ~127u); v2[r] = unmono_key(top2[r] & ~127u); islot[16 * hi + r] = 127 - (int)((hi ? top2[r] : top1[r]) & 127u); }
    unsigned ka[16], kb[16];
#pragma unroll
    for (int i = 0; i < 25; ++i) { const int c0 = 2 * i, c1 = 2 * i + 1;
        const float s = hi ? (v1[CAND.a[c1]] + v2[CAND.b[c1]]) : (v1[CAND.a[c0]] + v2[CAND.b[c0]]);
        const unsigned k = (mono_key(s) & ~255u) | (unsigned)(255 - (hi ? 16 * CAND.a[c1] + CAND.b[c1] : 16 * CAND.a[c0] + CAND.b[c0]));
        if (i < 16) ka[i] = k; else kb[i - 16] = k; }
#pragma unroll
    for (int i = 9; i < 16; ++i) kb[i] = 0u;
    bitonic_sort16_desc(ka); bitonic_sort16_desc(kb); top_half_merge16(ka, kb);
    { unsigned pr[16];
#pragma unroll
      for (int i = 0; i < 16; ++i) pr[i] = (unsigned)__shfl_xor((int)ka[i], 32);
      top_half_merge16(ka, pr); }
    WAVE_SYNC();
    float sc[16]; int se[16];
#pragma unroll
    for (int r = 0; r < 16; ++r) { sc[r] = unmono_key(ka[r] & ~255u); se[r] = 0; }
#pragma unroll
    for (int r = 0; r < 8; ++r) { unsigned mlo = ka[r], mhi = ka[8 + r]; OPAQUE(mlo); OPAQUE(mhi);
        const unsigned m = hi ? mhi : mlo; const int ab = 255 - (int)(m & 255u); const int e = islot[ab >> 4] * 128 + islot[16 + (ab & 15)];
        if (hi) se[8 + r] = e; else se[r] = e; }
    WAVE_SYNC();
    float g[16]; float sum = 0.f;
#pragma unroll
    for (int r = 0; r < 16; ++r) { g[r] = __expf(sc[r] - sc[0]); sum += g[r]; }
    const float inv = 1.0f / sum;
    const size_t ob = (size_t)tok * 128 + wave * 16 + 8 * hi;
    if (hi == 0) {
        *(u32x4*)(P.eid + ob) = (u32x4){(unsigned)se[0], (unsigned)se[1], (unsigned)se[2], (unsigned)se[3]}; *(u32x4*)(P.eid + ob + 4) = (u32x4){(unsigned)se[4], (unsigned)se[5], (unsigned)se[6], (unsigned)se[7]};
        *(f32x4*)(P.gate + ob) = (f32x4){g[0] * inv, g[1] * inv, g[2] * inv, g[3] * inv}; *(f32x4*)(P.gate + ob + 4) = (f32x4){g[4] * inv, g[5] * inv, g[6] * inv, g[7] * inv};
    } else {
        *(u32x4*)(P.eid + ob) = (u32x4){(unsigned)se[8], (unsigned)se[9], (unsigned)se[10], (unsigned)se[11]}; *(u32x4*)(P.eid + ob + 4) = (u32x4){(unsigned)se[12], (unsigned)se[13], (unsigned)se[14], (unsigned)se[15]};
        *(f32x4*)(P.gate + ob) = (f32x4){g[8] * inv, g[9] * inv, g[10] * inv, g[11] * inv}; *(f32x4*)(P.gate + ob + 4) = (f32x4){g[12] * inv, g[13] * inv, g[14] * inv, g[15] * inv};
    }
}
__device__ __forceinline__ void phase_F(const KP& p, int l, unsigned char* lds) {
    const Ptrs P = make_ptrs(p.ws, l);
    bf16_t* Ks = (bf16_t*)lds; const int tid = TIDX();
    for (int e = tid; e < 2 * 128 * 16; e += NTHR) { const int row = e >> 4, ch = e & 15; *(u32x4*)(Ks + row * PK_PITCH + ch * 8) = *(const u32x4*)(P.K12 + row * 128 + ch * 8); }
    __syncthreads();
    for (int u = BIDX(); u < T_ / 32; u += GDIM()) peer_route_unit(p, P, l, u, lds);
    __syncthreads();
}
constexpr int PG_TB = (T_ >= 4096 ? 128 : 64), PG_NBLK = T_ / PG_TB;
__device__ __forceinline__ int peer_next_item(unsigned* cnt, int* slot, int tid) {
    __syncthreads();
    if (tid == 0) *slot = (int)atomicAdd(cnt, 1u);
    __syncthreads();
    return *slot;
}
constexpr int PG_TPW = PG_TB / NWAVE;
constexpr int PG_WLDS = 6144;
__device__ __forceinline__ void pg_issue_rows(const unsigned char* T8, int x, int c8, int gq, int lane, int e0, int e1, int* E, u32x4 (&rb)[16]) {
    WAVE_SYNC(); E[lane] = e0; E[64 + lane] = e1; WAVE_SYNC();
#pragma unroll
    for (int k = 0; k < 16; ++k) { const unsigned off = ((unsigned)(x * NEXP) + (unsigned)E[gq + 8 * k]) * 128u + 16u * (unsigned)c8; rb[k] = *(const u32x4*)(T8 + off); }
}
__device__ __forceinline__ void pg_dots_compute(const Ptrs& P, int x, int t, const u32x4 (&ub)[16], u32x4 xa, u32x4 xb, float* R, int lane) {
    const f32x2 x0 = (f32x2){bflo(xa.x), bfhi(xa.x)}, x1 = (f32x2){bflo(xa.y), bfhi(xa.y)}, x2 = (f32x2){bflo(xa.z), bfhi(xa.z)}, x3 = (f32x2){bflo(xa.w), bfhi(xa.w)};
    const f32x2 x4 = (f32x2){bflo(xb.x), bfhi(xb.x)}, x5 = (f32x2){bflo(xb.y), bfhi(xb.y)}, x6 = (f32x2){bflo(xb.z), bfhi(xb.z)}, x7 = (f32x2){bflo(xb.w), bfhi(xb.w)};
    WAVE_SYNC();
#pragma unroll
    for (int k = 0; k < 16; ++k) { f32x2 s = cvt_pk_f32_fp8_(ub[k][0], false) * x0; s += cvt_pk_f32_fp8_(ub[k][0], true) * x1; s += cvt_pk_f32_fp8_(ub[k][1], false) * x2; s += cvt_pk_f32_fp8_(ub[k][1], true) * x3;
        s += cvt_pk_f32_fp8_(ub[k][2], false) * x4; s += cvt_pk_f32_fp8_(ub[k][2], true) * x5; s += cvt_pk_f32_fp8_(ub[k][3], false) * x6; s += cvt_pk_f32_fp8_(ub[k][3], true) * x7;
        R[k * 64 + lane] = s.x + s.y; }
    WAVE_SYNC();
    const f32x4 a0 = *(const f32x4*)(R + 8 * lane), a1 = *(const f32x4*)(R + 8 * lane + 4), b0 = *(const f32x4*)(R + 512 + 8 * lane), b1 = *(const f32x4*)(R + 512 + 8 * lane + 4);
    float* pd = P.pd + ((size_t)x * T_ + t) * 128;
    pd[lane] = ((a0[0] + a0[1]) + (a0[2] + a0[3])) + ((a1[0] + a1[1]) + (a1[2] + a1[3]));
    pd[64 + lane] = ((b0[0] + b0[1]) + (b0[2] + b0[3])) + ((b1[0] + b1[1]) + (b1[2] + b1[3]));
}
__device__ __forceinline__ void peer_dots_item(const Ptrs& P, int x, int blk, unsigned char* lds, int lane, int wave) {
    float* R = (float*)(lds + wave * PG_WLDS); int* E = (int*)(lds + wave * PG_WLDS + 4096);
    const int gq = lane >> 3, c8 = lane & 7, tb = blk * PG_TB + PG_TPW * wave;
    u32x4 uA[16], uB[16], xa0, xb0, xa1, xb1;
    const bf16_t* xp = P.hb + (size_t)tb * 1024 + 128 * x + 16 * c8; const int* ep = P.eid + (size_t)tb * 128 + lane;
    int ea0 = ep[0], ea1 = ep[64], eb0 = ep[128], eb1 = ep[192];
    pg_issue_rows(P.U8, x, c8, gq, lane, ea0, ea1, E, uA); xa0 = *(const u32x4*)xp; xb0 = *(const u32x4*)(xp + 8);
#pragma unroll 1
    for (int i = 0; i < PG_TPW; i += 2) {
        pg_issue_rows(P.U8, x, c8, gq, lane, eb0, eb1, E, uB); xa1 = *(const u32x4*)(xp + (size_t)(i + 1) * 1024); xb1 = *(const u32x4*)(xp + (size_t)(i + 1) * 1024 + 8);
        if (i + 2 < PG_TPW) { ea0 = ep[(i + 2) * 128]; ea1 = ep[(i + 2) * 128 + 64]; }
        pg_dots_compute(P, x, tb + i, uA, xa0, xb0, R, lane);
        if (i + 2 < PG_TPW) { pg_issue_rows(P.U8, x, c8, gq, lane, ea0, ea1, E, uA); xa0 = *(const u32x4*)(xp + (size_t)(i + 2) * 1024); xb0 = *(const u32x4*)(xp + (size_t)(i + 2) * 1024 + 8); }
        if (i + 3 < PG_TPW) { eb0 = ep[(i + 3) * 128]; eb1 = ep[(i + 3) * 128 + 64]; }
        pg_dots_compute(P, x, tb + i + 1, uB, xa1, xb1, R, lane);
    }
}
__device__ __forceinline__ void pg_acc_compute(float* outp, int x, int t, const u32x4 (&vb)[16], float w0, float w1, f32x2 oprev, float* C, float* W, int gq, int lane) {
    WAVE_SYNC(); W[lane] = w0; W[64 + lane] = w1; WAVE_SYNC();
    f32x2 acc[8];
#pragma unroll
    for (int q = 0; q < 8; ++q) acc[q] = (f32x2){0.f, 0.f};
#pragma unroll
    for (int k = 0; k < 16; ++k) { const float wk = W[gq + 8 * k];
#pragma unroll
        for (int q = 0; q < 4; ++q) { acc[2 * q] += cvt_pk_f32_fp8_(vb[k][q], false) * wk; acc[2 * q + 1] += cvt_pk_f32_fp8_(vb[k][q], true) * wk; } }
    WAVE_SYNC();
#pragma unroll
    for (int q = 0; q < 4; ++q) *(f32x4*)(C + lane * 16 + 4 * q) = (f32x4){acc[2 * q].x, acc[2 * q].y, acc[2 * q + 1].x, acc[2 * q + 1].y};
    WAVE_SYNC();
    f32x2 s = (f32x2){0.f, 0.f};
#pragma unroll
    for (int g = 0; g < 8; ++g) s += *(const f32x2*)(C + g * 128 + 2 * lane);
    float* o = outp + (size_t)t * 1024 + 128 * x + 2 * lane; *(f32x2*)o = oprev + s;
}
__device__ __forceinline__ void peer_acc_item(float* outp, const Ptrs& P, int x, int blk, unsigned char* lds, int lane, int wave) {
    float* C = (float*)(lds + wave * PG_WLDS); int* E = (int*)(lds + wave * PG_WLDS + 4096); float* W = (float*)(lds + wave * PG_WLDS + 4608);
    const int gq = lane >> 3, c8 = lane & 7, tb = blk * PG_TB + PG_TPW * wave;
    u32x4 vA[16], vB[16]; f32x2 oA, oB;
    const int* ep = P.eid + (size_t)tb * 128 + lane; const float* wp = P.gate + (size_t)tb * 128 + lane; const float* op = outp + (size_t)tb * 1024 + 128 * x + 2 * lane;
    int ea0 = ep[0], ea1 = ep[64], eb0 = ep[128], eb1 = ep[192]; float wa0 = wp[0], wa1 = wp[64], wb0 = wp[128], wb1 = wp[192];
    pg_issue_rows(P.V8, x, c8, gq, lane, ea0, ea1, E, vA); oA = *(const f32x2*)op;
#pragma unroll 1
    for (int i = 0; i < PG_TPW; i += 2) {
        pg_issue_rows(P.V8, x, c8, gq, lane, eb0, eb1, E, vB); oB = *(const f32x2*)(op + (size_t)(i + 1) * 1024);
        if (i + 2 < PG_TPW) { ea0 = ep[(i + 2) * 128]; ea1 = ep[(i + 2) * 128 + 64]; }
        pg_acc_compute(outp, x, tb + i, vA, wa0, wa1, oA, C, W, gq, lane);
        if (i + 2 < PG_TPW) { wa0 = wp[(i + 2) * 128]; wa1 = wp[(i + 2) * 128 + 64]; pg_issue_rows(P.V8, x, c8, gq, lane, ea0, ea1, E, vA); oA = *(const f32x2*)(op + (size_t)(i + 2) * 1024); }
        if (i + 3 < PG_TPW) { eb0 = ep[(i + 3) * 128]; eb1 = ep[(i + 3) * 128 + 64]; }
        pg_acc_compute(outp, x, tb + i + 1, vB, wb0, wb1, oB, C, W, gq, lane);
        if (i + 3 < PG_TPW) { wb0 = wp[(i + 3) * 128]; wb1 = wp[(i + 3) * 128 + 64]; }
    }
}
template <int STAGE, int CSET = STAGE>
__device__ __forceinline__ void phase_G12(const KP& p, int l, unsigned char* lds) {
    const Ptrs P = make_ptrs(p.ws, l);
    const int tid = TIDX(), lane = tid & 63, wave = tid >> 6;
    int* slot = (int*)(lds + 8 * PG_WLDS);
    const int myx = XCC_ID();
    for (int s = 0; s < 8; ++s) { const int x = (myx + s) & 7; unsigned* cnt = P.qcnt + (CSET * 8 + x) * 16;
        for (;;) { const int blk = peer_next_item(cnt, slot, tid); if (blk >= PG_NBLK) break;
            if (STAGE == 0) peer_dots_item(P, x, blk, lds, lane, wave); else peer_acc_item(CSET == 3 ? P.pd : p.out, P, x, blk, lds, lane, wave); } }
    __syncthreads();
}
__device__ __forceinline__ void phase_G1b(const KP& p, int l, unsigned char* lds) {
    const Ptrs P = make_ptrs(p.ws, l);
    for (size_t i = (size_t)BIDX() * NTHR + TIDX(); i < (size_t)T_ * 128; i += (size_t)GDIM() * NTHR) { float d = 0.f;
#pragma unroll
        for (int x = 0; x < 8; ++x) d += P.pd[(size_t)x * T_ * 128 + i];
        const int e = P.eid[i]; P.gate[i] = P.gate[i] * P.sv[e] * gelu_erf(d * P.su[e]); }
#ifdef CPU_EMU
    (void)lds;
#endif
}
__device__ __forceinline__ void phase_G3(const KP& p, int l, unsigned char* lds, bool last) {
    const Ptrs P = make_ptrs(p.ws, l);
    const int tid = TIDX(), lane = tid & 63, wave = tid >> 6; const int gw = BIDX() * NWAVE + wave, NGW = GDIM() * NWAVE;
    for (int m = 4 * gw; m < T_; m += 4 * NGW) ln_rows<4>(p.out + (size_t)m * 1024, p.in[I_LN2G] + l * 1024, p.in[I_LN2B] + l * 1024, p.out + (size_t)m * 1024, last ? (bf16_t*)nullptr : P.hb + (size_t)m * 1024,
                                                           last ? (unsigned char*)nullptr : (m < H8_SPLIT ? P.h8a + (size_t)m * 1024 : P.h8b + (size_t)(m - H8_SPLIT) * 1024), lane);
}
#ifndef PROBE_REPEAT
#define PROBE_REPEAT 0
#endif
constexpr int LDS_BYTES = 147456;
__device__ __forceinline__ void phase_B1(const KP& p, int l, unsigned char* lds) {
    const Ptrs P = make_ptrs(p.ws, l);
    constexpr int NRC = NB_ * 4 * RW_NCH, NS5 = NB_ * 16, NFX = NB_ * 4 * (S_ / 256), NCV = T_ / 64;
    const int G = GDIM(); int it = BIDX();
    for (; it < NRC; it += G) rw_chunk_unit(p, P, l, it, lds);
#if PROBE_REPEAT == 16
    for (int j = BIDX(); j < NRC; j += G) rw_chunk_unit(p, P, l, j, lds);
#endif
#if PROBE_REPEAT >= 161 && PROBE_REPEAT <= 163
    for (int j = BIDX(); j < NRC; j += G) { rw_chunk_unit<PROBE_REPEAT - 160>(p, P, l, j, lds); __syncthreads(); }
#endif
    for (; it < NRC + NFX; it += G) fox_unit(p, P, l, it - NRC, lds);
#if PROBE_REPEAT == 17
    for (int j = BIDX(); j < NFX; j += G) fox_unit(p, P, l, j, lds);
#endif
    for (; it < NRC + NFX + NS5; it += G) s5_unit(p, P, l, it - NRC - NFX, lds);
#if PROBE_REPEAT == 18
    for (int j = BIDX(); j < NS5; j += G) s5_unit(p, P, l, j, lds);
#endif
    for (; it < NRC + NFX + NS5 + NCV; it += G) conv_unit(p, P, l, it - NRC - NFX - NS5, lds);
#if PROBE_REPEAT == 19
    for (int j = BIDX(); j < NCV; j += G) conv_unit(p, P, l, j, lds);
#endif
}
__device__ __forceinline__ void phase_B3(const KP& p, int l, unsigned char* lds) {
    const Ptrs P = make_ptrs(p.ws, l);
#if PROBE_REPEAT == 34
    for (int it = BIDX(); it < NB_ * 4 * RW_NCH; it += GDIM()) rw_out_unit<true>(p, P, l, it, lds);
#endif
    for (int it = BIDX(); it < NB_ * 4 * RW_NCH; it += GDIM()) rw_out_unit<false>(p, P, l, it, lds);
}
enum { PH_PRO = 0, PH_A, PH_B1, PH_B2, PH_B3, PH_C, PH_D, PH_D2, PH_E, PH_F, PH_G, PH_G1B, PH_G2, PH_G3, PH_N };
__device__ __forceinline__ void run_phase(const KP& p, int ph, int l, unsigned char* lds) {
    switch (ph) {
        case PH_PRO: phase_prologue(p, lds); break;
        case PH_A: phase_A(p, l, lds); break;
        case PH_B1: phase_B1(p, l, lds); break;
        case PH_B2: phase_B2(p, l, lds); break;
        case PH_B3: phase_B3(p, l, lds); break;
        case PH_C: phase_C(p, l, lds); break;
        case PH_D: phase_D(p, l, lds); break;
        case PH_D2: phase_D2(p, l, lds); break;
        case PH_E: phase_E(p, l, lds); break;
        case PH_F: phase_F(p, l, lds); break;
        case PH_G: phase_G12<0>(p, l, lds); break;
        case PH_G1B: phase_G1b(p, l, lds); break;
        case PH_G2: phase_G12<1>(p, l, lds); break;
        case PH_G3: phase_G3(p, l, lds, l == L_ - 1); break;
        default: break;
    }
}
#ifndef CPU_EMU
#define XB_TMO      128
#define XB_XCNT(j)  (256  + 64 * (j))
#define XB_XSUB(j)  (1280 + 64 * (j))
#define XB_XGEN(j)  (2304 + 64 * (j))
#define XB_TOP      3328
#define XB_TOPGEN   3392
#define XCD_BAR_WORDS 3456
#define XB_SPIN_CAP (1u << 22)
__device__ __forceinline__ unsigned xb_ld(unsigned* p)              { return __hip_atomic_load(p, __ATOMIC_RELAXED, __HIP_MEMORY_SCOPE_AGENT); }
__device__ __forceinline__ unsigned xb_add(unsigned* p, unsigned v) { return __hip_atomic_fetch_add(p, v, __ATOMIC_RELAXED, __HIP_MEMORY_SCOPE_AGENT); }
__device__ __forceinline__ unsigned xb_xcc_id() { return (unsigned)__builtin_amdgcn_s_getreg((3 << 11) | 20) & 0xFu; }
#define XB_SPIN(cond, bar) do { unsigned _sp = 0; while (cond) { __builtin_amdgcn_s_sleep(1); \
    if ((++_sp & 255u) == 0u) { if (xb_ld(&(bar)[XB_TMO])) break; if (_sp > XB_SPIN_CAP) { atomicAdd(&(bar)[XB_TMO], 1u); break; } } } } while (0)
struct XcdBarrier { unsigned* bar; unsigned x; volatile LAS unsigned* st; };
__device__ __forceinline__ XcdBarrier xcd_barrier_post(unsigned* bar, volatile LAS unsigned* st) {
    XcdBarrier b; b.bar = bar; b.x = xb_xcc_id(); b.st = st;
    if (threadIdx.x == 0) (void)xb_add(&bar[XB_XCNT(b.x)], 1u);
    return b;
}
__device__ __forceinline__ void xcd_barrier_complete(unsigned* bar, unsigned x, unsigned& nloc, unsigned& nx) {
    const unsigned G = gridDim.x * gridDim.y * gridDim.z;
    unsigned sum, cnt, mine, sp = 0u;
    for (;;) {
        sum = 0u; cnt = 0u; mine = 0u;
#pragma unroll
        for (unsigned j = 0; j < 16; ++j) { const unsigned c = xb_ld(&bar[XB_XCNT(j)]); sum += c; cnt += (c > 0u) ? 1u : 0u; mine = (j == x) ? c : mine; }
        if (sum == G) break;
        __builtin_amdgcn_s_sleep(1);
        if ((++sp & 255u) == 0u) { if (xb_ld(&bar[XB_TMO])) break; if (sp > XB_SPIN_CAP) { atomicAdd(&bar[XB_TMO], 1u); break; } }
    }
    nloc = mine > 0u ? mine : 1u; nx = cnt > 0u ? cnt : 1u;
}
__device__ __forceinline__ void xcd_barrier(const XcdBarrier& b) {
    asm volatile("s_waitcnt vmcnt(0)" ::: "memory");
    __syncthreads();
    if (threadIdx.x == 0) {
        unsigned* bar = b.bar;
        __builtin_amdgcn_s_waitcnt(0);
        unsigned nloc = b.st[0], nx = b.st[1];
        if (nloc == 0u) { xcd_barrier_complete(bar, b.x, nloc, nx); b.st[0] = nloc; b.st[1] = nx; }
        const unsigned old = xb_add(&bar[XB_XSUB(b.x)], 1u);
        const unsigned gen = old / nloc;
        if (old + 1u == (gen + 1u) * nloc) {
            __builtin_amdgcn_fence(__ATOMIC_RELEASE, "agent");
            asm volatile("s_waitcnt vmcnt(0)" ::: "memory");
            const unsigned og = xb_add(&bar[XB_TOP], 1u);
            const unsigned tg = og / nx;
            if (og + 1u == (tg + 1u) * nx) xb_add(&bar[XB_TOPGEN], 1u);
            else XB_SPIN(xb_ld(&bar[XB_TOPGEN]) == tg, bar);
            __builtin_amdgcn_fence(__ATOMIC_ACQUIRE, "agent");
            xb_add(&bar[XB_XGEN(b.x)], 1u);
            asm volatile("s_waitcnt vmcnt(0)" ::: "memory");
        } else {
            XB_SPIN(xb_ld(&bar[XB_XGEN(b.x)]) == gen, bar);
            __builtin_amdgcn_fence(__ATOMIC_ACQUIRE, "agent");
            asm volatile("s_waitcnt vmcnt(0)" ::: "memory");
        }
    }
    __syncthreads();
}
#ifndef PROBE_REPEAT
#define PROBE_REPEAT 0
#endif
#ifndef N_LAUNCH_MODE
#define N_LAUNCH_MODE 1
#endif
extern __shared__ __attribute__((aligned(16))) unsigned char lds_dyn[];
#if N_LAUNCH_MODE == 0
template <int PH> __global__ void __launch_bounds__(NTHR, 2) k_phase_t(KP p) { run_phase(p, PH, p.layer, lds_dyn); }
typedef void (*kfn_t)(KP);
static kfn_t phase_fn(int ph) { switch (ph) { case PH_PRO: return k_phase_t<PH_PRO>; case PH_A: return k_phase_t<PH_A>; case PH_B1: return k_phase_t<PH_B1>; case PH_B2: return k_phase_t<PH_B2>; case PH_B3: return k_phase_t<PH_B3>; case PH_C: return k_phase_t<PH_C>;
    case PH_D: return k_phase_t<PH_D>; case PH_D2: return k_phase_t<PH_D2>; case PH_E: return k_phase_t<PH_E>; case PH_F: return k_phase_t<PH_F>; case PH_G: return k_phase_t<PH_G>; case PH_G1B: return k_phase_t<PH_G1B>; case PH_G2: return k_phase_t<PH_G2>; default: return k_phase_t<PH_G3>; } }
#else
#ifndef USE_XCD_BARRIER
#define USE_XCD_BARRIER 1
#endif
constexpr int BAR_LDS_OFF = LDS_BYTES - 64;
#if USE_XCD_BARRIER
#define GSYNC() xcd_barrier(bar)
#define GSYNC_ARG const XcdBarrier& bar
#else
#define GSYNC() grid.sync()
#define GSYNC_ARG cg::grid_group& grid
#endif
template <int l>
__device__ __forceinline__ void mega_layer(const KP& p, GSYNC_ARG) {
        phase_A(p, l, lds_dyn);
#if PROBE_REPEAT == 1
        GSYNC(); phase_A(p, l, lds_dyn);
#endif
#if PROBE_REPEAT >= 40 && PROBE_REPEAT <= 49
        GSYNC(); phase_Aprobe<PROBE_REPEAT - 40>(p, l, lds_dyn);
#endif
        GSYNC(); phase_B1(p, l, lds_dyn);
#if PROBE_REPEAT == 2
        GSYNC(); phase_B1(p, l, lds_dyn);
#endif
        GSYNC(); phase_B2(p, l, lds_dyn);
        GSYNC(); phase_B3(p, l, lds_dyn);
        GSYNC(); phase_C(p, l, lds_dyn);
#if PROBE_REPEAT == 4
        GSYNC(); phase_C(p, l, lds_dyn);
#endif
        GSYNC(); phase_D(p, l, lds_dyn);
        GSYNC(); phase_D2(p, l, lds_dyn);
        GSYNC(); phase_E(p, l, lds_dyn);
        GSYNC(); phase_F(p, l, lds_dyn);
#if PROBE_REPEAT == 8
        GSYNC(); phase_F(p, l, lds_dyn);
#endif
        GSYNC(); phase_G12<0>(p, l, lds_dyn);
#if PROBE_REPEAT == 32
        GSYNC(); phase_G12<0, 2>(p, l, lds_dyn);
#endif
        GSYNC(); phase_G1b(p, l, lds_dyn);
        GSYNC(); phase_G12<1>(p, l, lds_dyn);
#if PROBE_REPEAT == 33
        GSYNC(); phase_G12<1, 3>(p, l, lds_dyn);
#endif
        GSYNC(); phase_G3(p, l, lds_dyn, l == L_ - 1);
}
__global__ void __launch_bounds__(NTHR, 2) k_mega(KP p) {
    cg::grid_group grid = cg::this_grid();
#if USE_XCD_BARRIER
    volatile LAS unsigned* st = (volatile LAS unsigned*)(lds_dyn + BAR_LDS_OFF);
    if (threadIdx.x < 2) st[threadIdx.x] = 0u;
    __syncthreads();
    const XcdBarrier bar = xcd_barrier_post((unsigned*)(p.ws + WS_CTL) + 4096, st);
#define GSYNC_VAL bar
#else
#define GSYNC_VAL grid
#endif
    phase_prologue(p, lds_dyn);
    grid.sync();
    mega_layer<0>(p, GSYNC_VAL);
    static_assert(L_ == 2, "two layers");
    GSYNC();
    mega_layer<1>(p, GSYNC_VAL);
}
#endif
extern "C" void kernel_launch(void* const* d_in, const int* in_sizes, int n_in, void* d_out, int out_size, void* d_ws, size_t ws_size, hipStream_t stream) {
    static int grid = 0;
    if (grid == 0) {
        if (n_in != N_IN || out_size != T_ * 1024 || ws_size < WS_END) { fprintf(stderr, "kernel_launch: unexpected shapes (n_in %d out %d ws %zu need %zu)\n", n_in, out_size, ws_size, (size_t)WS_END); grid = -1; return; }
        int dev = 0, cus = 0, per_cu = 0;
        (void)hipGetDevice(&dev); (void)hipDeviceGetAttribute(&cus, hipDeviceAttributeMultiprocessorCount, dev);
#if N_LAUNCH_MODE == 0
        for (int ph = 0; ph < PH_N; ++ph) (void)hipFuncSetAttribute((const void*)phase_fn(ph), hipFuncAttributeMaxDynamicSharedMemorySize, LDS_BYTES);
        (void)per_cu;
#else
        (void)hipFuncSetAttribute((const void*)k_mega, hipFuncAttributeMaxDynamicSharedMemorySize, LDS_BYTES);
        (void)hipOccupancyMaxActiveBlocksPerMultiprocessor(&per_cu, (const void*)k_mega, NTHR, LDS_BYTES);
        if (per_cu < 1) { fprintf(stderr, "kernel_launch: occupancy query says %d blocks per CU\n", per_cu); grid = -1; return; }
#endif
        grid = cus;
    }
    if (grid < 0) return;
    if (hipMemsetAsync((char*)d_ws + WS_CTL, 0, 65536, stream) != hipSuccess) { fprintf(stderr, "kernel_launch: memset failed\n"); return; }
    KP p{};
    for (int i = 0; i < N_IN; ++i) p.in[i] = (const float*)d_in[i];
    p.out = (float*)d_out; p.ws = (unsigned char*)d_ws;
#if N_LAUNCH_MODE == 1
    void* args[] = {&p};
    hipError_t e = hipLaunchCooperativeKernel((const void*)k_mega, dim3(grid), dim3(NTHR), args, LDS_BYTES, stream);
    if (e != hipSuccess) fprintf(stderr, "cooperative launch failed: %s (grid %d)\n", hipGetErrorString(e), grid);
#else
    p.phase = PH_PRO; p.layer = 0; hipLaunchKernelGGL(phase_fn(PH_PRO), dim3(grid), dim3(NTHR), LDS_BYTES, stream, p);
    for (int l = 0; l < L_; ++l) for (int ph = PH_A; ph < PH_N; ++ph) { p.phase = ph; p.layer = l; hipLaunchKernelGGL(phase_fn(ph), dim3(grid), dim3(NTHR), LDS_BYTES, stream, p); }
#endif
}
#endif
```

```cpp
#ifdef CPU_EMU
#include "emu.h"
#define LAS
#define GET_LDS() ((unsigned char*)emu::lds())
#define AS_GLOBAL(p) (p)
#define AS_LDS(p) (p)
#define RFL(x) (x)
#define MFMA32(a, b, c) emu_mfma32(a, b, c)
#define MFMA16(a, b, c) emu_mfma16(a, b, c)
#define MFMA16_FP8(a, b, c) emu_mfma16_fp8(a, b, c)
#define FAST_EXP2(x) exp2f(x)
#define FAST_RCP(x) (1.0f / (x))
#define FAST_LOG2(x) log2f(x)
#define FAST_RSQ(x) (1.0f / sqrtf(x))
#define WAVE_SYNC() do { uint32_t _z = 0; (void)emu::wave_xchg(&_z, 1); } while (0)
#define OPAQUE(x) do {} while (0)
#define GLDS16(gp, lp, lane) memcpy((char*)(lp) + 16 * (lane), (const void*)(gp), 16)
#define WAIT_VM(n) do {} while (0)
#define GLOAD16_ASM(dst, ptr) (dst) = *(const u32x4*)(ptr)
#define GLOAD4_ASM(dst, ptr) (dst) = *(const int*)(ptr)
#define PIN4(a, b, c, d) do {} while (0)
#define PIN2I(a, b) do {} while (0)
#define WAIT_LGKM0() do {} while (0)
#define READLANE_I(v, l) __shfl((int)(v), (l))
#define READLANE_F(v, l) __shfl((float)(v), (l))
#define TIDX() ((int)threadIdx.x)
#define XCC_ID() (emu::bid() & 7)
#define GDIM() ((int)gridDim.x)
#define BIDX() ((int)blockIdx.x)
#define OPAQUE_S(x) do {} while (0)
#define MEMFENCE() do {} while (0)
#else
#include <hip/hip_runtime.h>
#include <hip/hip_cooperative_groups.h>
#include <cstdio>
#include <cstdint>
namespace cg = cooperative_groups;
#define LAS __attribute__((address_space(3)))
#define GAS __attribute__((address_space(1)))
#define AS_GLOBAL(p) ((unsigned char*)(GAS unsigned char*)(p))
#define AS_LDS(p) ((unsigned char*)(LAS unsigned char*)(p))
#define RFL(x) __builtin_amdgcn_readfirstlane(x)
#define MFMA32(a, b, c) __builtin_amdgcn_mfma_f32_32x32x16_bf16(a, b, c, 0, 0, 0)
#define MFMA16(a, b, c) __builtin_amdgcn_mfma_f32_16x16x32_bf16(a, b, c, 0, 0, 0)
#define MFMA16_FP8(a, b, c) __builtin_amdgcn_mfma_f32_16x16x32_fp8_fp8((long)(a), (long)(b), c, 0, 0, 0)
#define MFMA16_F8X128(a, b, c) __builtin_amdgcn_mfma_scale_f32_16x16x128_f8f6f4(a, b, c, 0, 0, 0, 0, 0, 0)
#define FAST_EXP2(x) __builtin_amdgcn_exp2f(x)
#define FAST_RCP(x) __builtin_amdgcn_rcpf(x)
#define FAST_LOG2(x) __builtin_amdgcn_logf(x)
#define FAST_RSQ(x) __builtin_amdgcn_rsqf(x)
#define WAVE_SYNC() __builtin_amdgcn_wave_barrier()
#define OPAQUE(x) asm volatile("" : "+v"(x))
#define GLDS16(gp, lp, lane) __builtin_amdgcn_global_load_lds((const unsigned*)(gp), (LAS unsigned*)(lp), 16, 0, 0)
#define WAIT_VM(n) asm volatile("s_waitcnt vmcnt(" #n ")" ::: "memory")
#define GLOAD16_ASM(dst, ptr) asm volatile("global_load_dwordx4 %0, %1, off" : "=v"(dst) : "v"(ptr) : "memory")
#define GLOAD4_ASM(dst, ptr) asm volatile("global_load_dword %0, %1, off" : "=v"(dst) : "v"(ptr) : "memory")
#define PIN4(a, b, c, d) asm volatile("" : "+v"(a), "+v"(b), "+v"(c), "+v"(d) :: "memory")
#define PIN2I(a, b) asm volatile("" : "+v"(a), "+v"(b) :: "memory")
#define WAIT_LGKM0() asm volatile("s_waitcnt lgkmcnt(0)" ::: "memory")
#define READLANE_I(v, l) __builtin_amdgcn_readlane((int)(v), (l))
#define READLANE_F(v, l) __builtin_bit_cast(float, __builtin_amdgcn_readlane(__builtin_bit_cast(int, (float)(v)), (l)))
#define OPAQUE_S(x) asm volatile("" : "+s"(x))
__device__ __forceinline__ int opaque_tid_() { int t = threadIdx.x; asm volatile("" : "+v"(t)); return t; }
#define TIDX() opaque_tid_()
#define XCC_ID() ((int)(__builtin_amdgcn_s_getreg((3 << 11) | 20) & 7u))
__device__ __forceinline__ int opaque_gdim_() { int t = gridDim.x; asm volatile("" : "+s"(t)); return t; }
__device__ __forceinline__ int opaque_bidx_() { int t = blockIdx.x; asm volatile("" : "+s"(t)); return t; }
#define GDIM() opaque_gdim_()
#define BIDX() opaque_bidx_()
#define MEMFENCE() do { asm volatile("" ::: "memory"); __builtin_amdgcn_sched_barrier(0); } while (0)
#endif

#ifndef CFG_B
#define CFG_B 16
#endif
#ifndef CFG_S
#define CFG_S 2048
#endif

typedef unsigned short bf16_t;
typedef short bf16x8 __attribute__((ext_vector_type(8)));
typedef short s16x4 __attribute__((ext_vector_type(4)));
typedef float f32x4 __attribute__((ext_vector_type(4)));
typedef float f32x2 __attribute__((ext_vector_type(2)));
typedef float f32x16 __attribute__((ext_vector_type(16)));
typedef unsigned u32x4 __attribute__((ext_vector_type(4)));
typedef unsigned u32x2 __attribute__((ext_vector_type(2)));
typedef int i32x4 __attribute__((ext_vector_type(4)));
typedef int i32x8 __attribute__((ext_vector_type(8)));

constexpr int NB_ = CFG_B, S_ = CFG_S, T_ = NB_ * S_, D_ = 1024, L_ = 2;
constexpr int NTHR = 512, NWAVE = 8;
constexpr int PJ = 2304;
constexpr int C_R = 0, C_K = 256, C_V = 512, C_HW = 768, C_HA = 800, C_HG = 832, C_S5 = 896, C_FQ = 1152, C_FK = 1408, C_FL = 1664, C_CV = 1792, C_CG = 2048;
constexpr int WIN_ROWS = 6656, WIN_VT = 2304, WIN_GATE = 2560;
constexpr int IN_COLS = 6532;
constexpr float LN_EPS_ = 1e-5f, GN_EPS_ = 64e-5f;
constexpr float DN_ALPHA_ = 1.4142135623730951f;
constexpr int NEXP = 16384;

enum { I_X = 0, I_P, I_LNIN_G, I_LNIN_B, I_WIN, I_MU, I_W0, I_W2, I_A0, I_A2, I_G2, I_KK, I_KA, I_RK, I_LNXG, I_LNXB, I_LRE, I_LIM, I_BRE, I_BIM, I_CRE, I_CIM,
       I_S5D, I_LDT, I_GLUW, I_GLUB, I_BF, I_CONVW, I_CONVB, I_CLNG, I_CLNB, I_WBR, I_WOUT, I_LN1G, I_LN1B, I_WQ, I_K1, I_K2, I_U, I_V, I_PLEW, I_PLEG, I_LN2G, I_LN2B, N_IN };

constexpr size_t al256(size_t x) { return (x + 255) & ~(size_t)255; }
constexpr size_t WS_CTL = 0;
constexpr size_t WS_WIN = 1u << 20;
constexpr size_t WS_WBR = WS_WIN + al256((size_t)L_ * WIN_ROWS * 1024 * 2);
constexpr size_t WS_WOUT = WS_WBR + (size_t)L_ * 1024 * 1024 * 2;
constexpr size_t WS_WQ = WS_WOUT + (size_t)L_ * 1024 * 1024 * 2;
constexpr size_t WS_PLE = WS_WQ + (size_t)L_ * 2048 * 1024 * 2;
constexpr size_t WS_PLEG = WS_PLE + (size_t)L_ * 1024 * 256 * 2;
constexpr size_t WS_GLU = WS_PLEG + (size_t)L_ * 1024 * 1024 * 2;
constexpr size_t WS_K12 = WS_GLU + (size_t)L_ * 256 * 256 * 2;
constexpr size_t WS_S5KC = WS_K12 + (size_t)L_ * 2 * 128 * 128 * 2;
constexpr size_t WS_S5WX = WS_S5KC + (size_t)L_ * 16 * 64 * 256 * 2;
constexpr size_t WS_S5WY = WS_S5WX + (size_t)L_ * 16 * 128 * 1024 * 2;
constexpr size_t WS_S5LL = WS_S5WY + (size_t)L_ * 16 * 1024 * 128 * 2;
constexpr size_t WS_UT = WS_S5LL + al256((size_t)L_ * 16 * 64 * 2 * 4);
constexpr size_t WS_VT = WS_UT + (size_t)NEXP * 1024 * 2;
constexpr size_t WS_RW = WS_VT + (size_t)NEXP * 1024 * 2;
constexpr size_t RW_SZ = (size_t)T_ * 512;
static_assert(2 * RW_SZ <= (size_t)NEXP * 1024 * 2, "RWKV gate / bonus arrays fit the second table region");
constexpr size_t WS_HB = WS_RW + 4 * RW_SZ;
constexpr size_t WS_R1 = WS_HB + (size_t)T_ * 1024 * 2;
constexpr size_t R1_BYTES = (size_t)T_ * 2560 * 2;
constexpr size_t WS_YC = WS_R1 + R1_BYTES;
constexpr size_t WS_VTR = WS_YC + (size_t)T_ * 1024 * 2;
constexpr size_t WS_PB = WS_VTR + (size_t)256 * T_ * 2;
constexpr size_t WS_H8T = WS_PB + (size_t)T_ * 256 * 2;
constexpr int H8_SPLIT = (T_ / 512) * 256;
constexpr size_t WS_END = WS_H8T + (size_t)(T_ - H8_SPLIT) * 1024;
constexpr size_t R1_PROJ = 0;
constexpr size_t R1_H8 = (size_t)T_ * 2304 * 2;
constexpr size_t R1_MERGED = 0;
constexpr size_t R1_STASH = (size_t)T_ * 1024 * 2;
constexpr size_t R1_Q = 0;
constexpr size_t R1_EID = (size_t)T_ * 2048 * 2;
constexpr size_t R1_GATE = R1_EID + (size_t)T_ * 128 * 4;
static_assert(R1_GATE + (size_t)T_ * 128 * 4 <= R1_BYTES, "R1 map");

struct KP { const float* in[N_IN]; float* out; unsigned char* ws; float* dbg; int layer; int phase; };

#ifdef CPU_EMU
__device__ __forceinline__ unsigned f2bf(float f) { unsigned u = __builtin_bit_cast(unsigned, f); return (u + 0x7fffu + ((u >> 16) & 1u)) >> 16; }
__device__ __forceinline__ unsigned pk2(float lo, float hi) { return f2bf(lo) | (f2bf(hi) << 16); }
#else
typedef __bf16 bf16x2_hw __attribute__((ext_vector_type(2)));
__device__ __forceinline__ unsigned pk2(float lo, float hi) { const f32x2 v = {lo, hi}; return __builtin_bit_cast(unsigned, __builtin_convertvector(v, bf16x2_hw)); }
__device__ __forceinline__ unsigned f2bf(float f) { return pk2(f, 0.f) & 0xffffu; }
#endif
__device__ __forceinline__ float bf2f(unsigned h) { return __builtin_bit_cast(float, h << 16); }
__device__ __forceinline__ float bflo(unsigned w) { return __builtin_bit_cast(float, w << 16); }
__device__ __forceinline__ float bfhi(unsigned w) { return __builtin_bit_cast(float, w & 0xffff0000u); }
__device__ __forceinline__ float sigmoidf_(float x) { return FAST_RCP(1.0f + FAST_EXP2(x * -1.4426950408889634f)); }
__device__ __forceinline__ float gelu_erf(float v) { return 0.5f * v * (1.0f + erff(v * 0.70710678118654752f)); }
#ifdef CPU_EMU
inline float fp8_dec_(unsigned b) { const unsigned s = b >> 7, e = (b >> 3) & 15, m = b & 7; float v = (e == 0) ? ldexpf((float)m, -9) : ldexpf(1.f + m * 0.125f, (int)e - 7); return s ? -v : v; }
inline unsigned fp8_enc_(float x) { const unsigned s = x < 0.f ? 0x80u : 0u; float a = fabsf(x); if (!(a > 0.f)) return s; if (a > 448.f) a = 448.f;
    int e; (void)frexpf(a, &e); e -= 1; if (e < -6) e = -6;
    const float q = ldexpf(a, 3 - e); float r = nearbyintf(q);
    unsigned ee, mm; if (e == -6 && r < 8.f) { ee = 0; mm = (unsigned)r; } else { if (r >= 16.f) { r = 8.f; e += 1; } ee = (unsigned)(e + 7); mm = (unsigned)r - 8u; }
    if (ee > 15u || (ee == 15u && mm > 6u)) { ee = 15u; mm = 6u; }
    return s | (ee << 3) | mm; }
inline f32x2 cvt_pk_f32_fp8_(unsigned w, bool hi) { const unsigned h = hi ? (w >> 16) : w; return (f32x2){fp8_dec_(h & 255u), fp8_dec_((h >> 8) & 255u)}; }
inline unsigned cvt_pk_fp8_f32_(float a, float b, unsigned old, bool hi) { const unsigned p = fp8_enc_(a) | (fp8_enc_(b) << 8); return hi ? ((old & 0xffffu) | (p << 16)) : ((old & 0xffff0000u) | p); }
#else
__device__ __forceinline__ f32x2 cvt_pk_f32_fp8_(unsigned w, bool hi) { return hi ? __builtin_amdgcn_cvt_pk_f32_fp8((int)w, true) : __builtin_amdgcn_cvt_pk_f32_fp8((int)w, false); }
__device__ __forceinline__ unsigned cvt_pk_fp8_f32_(float a, float b, unsigned old, bool hi) { return hi ? (unsigned)__builtin_amdgcn_cvt_pk_fp8_f32(a, b, (int)old, true) : (unsigned)__builtin_amdgcn_cvt_pk_fp8_f32(a, b, (int)old, false); }
#endif
__device__ __forceinline__ float wave_max(float v) {
#pragma unroll
  for (int o = 1; o < 64; o <<= 1) v = fmaxf(v, __shfl_xor(v, o));
  return v;
}
template <int N> __device__ __forceinline__ void wave_sum_n(float (&v)[N]) {
#pragma unroll
  for (int o = 1; o < 64; o <<= 1) { float t[N];
#pragma unroll
    for (int i = 0; i < N; ++i) t[i] = __shfl_xor(v[i], o);
#pragma unroll
    for (int i = 0; i < N; ++i) v[i] += t[i]; }
}
__device__ __forceinline__ float wave_sum(float v) {
#pragma unroll
  for (int o = 1; o < 64; o <<= 1) v += __shfl_xor(v, o);
  return v;
}
namespace pg8 {
constexpr int BM = 256, BK = 64, HALF = 128, HTB = HALF * BK * 2, STAGE_BYTES = 8 * HTB;
__host__ __device__ __forceinline__ int lds_byte(int r, int c) { const int st = (r >> 4) * 2 + (c >> 5), rr = r & 15, cc = c & 31, ob = rr * 64 + cc * 2; return st * 1024 + (ob ^ (((ob >> 9) & 1) << 5)); }
__host__ __device__ __forceinline__ void stage_rc(int b, int& R, int& C) { const int st = b / 1024, sb = b % 1024, swz = sb ^ (((sb >> 9) & 1) << 5); R = (st >> 1) * 16 + swz / 64; C = (st & 1) * 32 + (swz % 64) / 2; }
__host__ __device__ __forceinline__ int perm32(int rho) { const int n = rho >> 4, i = rho & 15; return 8 * (i >> 2) + 4 * n + (i & 3); }

struct Unit { const char* a; const char* b; int nt; int kind; int pm; int pn; int aux; int f8; };

#ifndef CPU_EMU
template <int MODE = 0, class Epi, class Sched>
__device__ __forceinline__ void gemm_phase(LAS unsigned char* lds, const int lda, const int ldb, const Sched& S, const Epi& E, const int lda8 = 0) {
    const int tid = TIDX(), wid = __builtin_amdgcn_readfirstlane(tid >> 6), lane = tid & 63, wr = wid >> 2, wc = wid & 3, fr = lane & 15, fq = lane >> 4;
    unsigned voffA[2], voffB[2], voffA8[2];
#pragma unroll
    for (int i = 0; i < 2; ++i) { int R, C; stage_rc(tid * 16 + i * 8192, R, C); const int Rb = (R & ~31) + perm32(R & 31);
        voffA[i] = (unsigned)(R * lda + C) * 2u; voffB[i] = (unsigned)(Rb * ldb + C) * 2u; voffA8[i] = (unsigned)(R * lda8 + C * 2); }
    const size_t kstep = (size_t)(BK * 2);
    const size_t hstepA = (size_t)HALF * lda * 2, hstepB = (size_t)HALF * ldb * 2, hstepA8 = (size_t)HALF * lda8;
    const unsigned ldsw = (unsigned)wid * 1024u;
    const int aoff = lds_byte(wr * 64 + fr, fq * 8), boff = lds_byte(wc * 32 + fr, fq * 8);
#define PG8_SA(b, h) (((b) * 2 + (h)) * HTB)
#define PG8_SB(b, h) ((4 + (b) * 2 + (h)) * HTB)
#define PG8_STAGE(bufoff, gbase, voff) do { _Pragma("unroll") for (int _i = 0; _i < 2; ++_i) \
        __builtin_amdgcn_global_load_lds((const unsigned*)((const char*)(gbase) + (voff)[_i]), (LAS unsigned*)(lds + (bufoff) + ldsw + _i * 8192), 16, 0, 0); } while (0)
#define PG8_LDA(dst, b, h) do { _Pragma("unroll") for (int m = 0; m < 4; ++m) _Pragma("unroll") for (int k = 0; k < 2; ++k) dst[m][k] = *(const LAS bf16x8*)(lds + PG8_SA(b, h) + aoff + m * 2048 + k * 1024); } while (0)
#define PG8_LDB(dst, b, h) do { _Pragma("unroll") for (int n = 0; n < 2; ++n) _Pragma("unroll") for (int k = 0; k < 2; ++k) dst[n][k] = *(const LAS bf16x8*)(lds + PG8_SB(b, h) + boff + n * 2048 + k * 1024); } while (0)
#define PG8_MMA(ai, bj, At, Bt) do { __builtin_amdgcn_s_setprio(1); _Pragma("unroll") for (int m = 0; m < 4; ++m) _Pragma("unroll") for (int n = 0; n < 2; ++n) _Pragma("unroll") for (int k = 0; k < 2; ++k) \
        acc[ai][bj][m][n] = __builtin_amdgcn_mfma_f32_16x16x32_bf16(Bt[n][k], At[m][k], acc[ai][bj][m][n], 0, 0, 0); __builtin_amdgcn_s_setprio(0); } while (0)
#define PG8_CAT(x, y) __builtin_shufflevector(__builtin_bit_cast(i32x4, x), __builtin_bit_cast(i32x4, y), 0, 1, 2, 3, 4, 5, 6, 7)
#define PG8_LDA8(dst, b, h) do { _Pragma("unroll") for (int m = 0; m < 4; ++m) dst[m] = PG8_CAT(*(const LAS bf16x8*)(lds + PG8_SA(b, h) + aoff + m * 2048), *(const LAS bf16x8*)(lds + PG8_SA(b, h) + aoff + m * 2048 + 1024)); } while (0)
#define PG8_LDB8(dst, b, h) do { _Pragma("unroll") for (int n = 0; n < 2; ++n) dst[n] = PG8_CAT(*(const LAS bf16x8*)(lds + PG8_SB(b, h) + boff + n * 2048), *(const LAS bf16x8*)(lds + PG8_SB(b, h) + boff + n * 2048 + 1024)); } while (0)
#define PG8_MMA8(ai, bj, A8, B8) do { __builtin_amdgcn_s_setprio(1); _Pragma("unroll") for (int m = 0; m < 4; ++m) _Pragma("unroll") for (int n = 0; n < 2; ++n) \
        acc[ai][bj][m][n] = MFMA16_F8X128(B8[n], A8[m], acc[ai][bj][m][n]); __builtin_amdgcn_s_setprio(0); } while (0)
#define PG8_WAIT_V(n) asm volatile("s_waitcnt vmcnt(" #n ")" ::: "memory")
#define PG8_WAIT_L(n) asm volatile("s_waitcnt lgkmcnt(" #n ")" ::: "memory")
#define PG8_BAR __builtin_amdgcn_s_barrier()
#define PG8_SCHED __builtin_amdgcn_sched_barrier(0)
    Unit cur, nxt; int ui = 0;
    if (!S.next(0, cur)) return;
    f32x4 acc[2][2][4][2];
#pragma unroll
    for (int a = 0; a < 2; ++a)
#pragma unroll
        for (int b = 0; b < 2; ++b)
#pragma unroll
            for (int m = 0; m < 4; ++m)
#pragma unroll
                for (int n = 0; n < 2; ++n) acc[a][b][m][n] = (f32x4){0.f, 0.f, 0.f, 0.f};
    bf16x8 At[4][2], B0[2][2], B1[2][2];
    const char* cA = cur.a; const char* cB = cur.b; int cf8 = MODE == 2 ? cur.f8 : MODE; size_t chA = cf8 ? hstepA8 : hstepA;
    { unsigned v0[2] = {cf8 ? voffA8[0] : voffA[0], cf8 ? voffA8[1] : voffA[1]};
    PG8_STAGE(PG8_SB(0, 0), cB, voffB); PG8_STAGE(PG8_SB(0, 1), cB + hstepB, voffB); PG8_STAGE(PG8_SA(0, 0), cA, v0); PG8_STAGE(PG8_SA(0, 1), cA + chA, v0);
    if (wr == 1) PG8_BAR;
    PG8_WAIT_V(2); PG8_BAR;
    PG8_STAGE(PG8_SB(1, 0), cB + kstep, voffB); PG8_STAGE(PG8_SA(1, 0), cA + kstep, v0); PG8_STAGE(PG8_SB(1, 1), cB + hstepB + kstep, voffB);
    PG8_WAIT_V(6); PG8_BAR; }
    for (;;) {
        const bool has_next = S.next(ui + 1, nxt);
        const char* nA = has_next ? nxt.a : cA; const char* nB = has_next ? nxt.b : cB; const int nf8 = MODE == 2 ? (has_next ? nxt.f8 : cf8) : MODE;
        int nt = cur.nt; asm volatile("" : "+s"(nt));
#define PG8_KLOOP(LDA_, LDB_, MM_, At_, B0_, B1_, CF8) \
        for (int t = 0; t < nt; t += 2) { \
            const bool last = (t == nt - 2); \
            const char* a1 = cA + (size_t)(t + 1) * kstep; \
            const char* a2 = last ? nA : cA + (size_t)(t + 2) * kstep; const char* b2 = last ? nB : cB + (size_t)(t + 2) * kstep; \
            const char* a3 = a2 + kstep; const char* b3 = b2 + kstep; \
            const int f2 = last ? nf8 : CF8; const size_t h2 = f2 ? hstepA8 : hstepA; \
            OPAQUE_S(a1); OPAQUE_S(a2); OPAQUE_S(a3); OPAQUE_S(b2); OPAQUE_S(b3); \
            const unsigned vA[2] = {CF8 ? voffA8[0] : voffA[0], CF8 ? voffA8[1] : voffA[1]}, vA2[2] = {f2 ? voffA8[0] : voffA[0], f2 ? voffA8[1] : voffA[1]}, vB[2] = {voffB[0], voffB[1]}; \
            LDB_(B0_, 0, 0); LDB_(B1_, 0, 1); PG8_SCHED; LDA_(At_, 0, 0); PG8_STAGE(PG8_SA(1, 1), a1 + (CF8 ? hstepA8 : hstepA), vA); \
            PG8_WAIT_V(8); PG8_WAIT_L(0); PG8_BAR; MM_(0, 0, At_, B0_); MM_(0, 1, At_, B1_); PG8_BAR; PG8_SCHED; \
            LDA_(At_, 0, 1); PG8_STAGE(PG8_SB(0, 0), b2, vB); PG8_STAGE(PG8_SB(0, 1), b2 + hstepB, vB); PG8_STAGE(PG8_SA(0, 0), a2, vA2); \
            PG8_WAIT_V(8); PG8_WAIT_L(0); PG8_BAR; MM_(1, 0, At_, B0_); MM_(1, 1, At_, B1_); PG8_BAR; PG8_SCHED; \
            LDB_(B0_, 1, 0); LDB_(B1_, 1, 1); PG8_SCHED; LDA_(At_, 1, 0); PG8_STAGE(PG8_SA(0, 1), a2 + h2, vA2); \
            PG8_WAIT_V(8); PG8_WAIT_L(0); PG8_BAR; MM_(0, 0, At_, B0_); MM_(0, 1, At_, B1_); PG8_BAR; PG8_SCHED; \
            LDA_(At_, 1, 1); PG8_STAGE(PG8_SB(1, 0), b3, vB); PG8_STAGE(PG8_SB(1, 1), b3 + hstepB, vB); PG8_STAGE(PG8_SA(1, 0), a3, vA2); \
            PG8_WAIT_V(8); PG8_WAIT_L(0); PG8_BAR; MM_(1, 0, At_, B0_); MM_(1, 1, At_, B1_); PG8_BAR; PG8_SCHED; \
        }
        if (MODE == 1 || (MODE == 2 && cf8)) { i32x8 A8[4], B08[2], B18[2]; PG8_KLOOP(PG8_LDA8, PG8_LDB8, PG8_MMA8, A8, B08, B18, 1) }
        else { PG8_KLOOP(PG8_LDA, PG8_LDB, PG8_MMA, At, B0, B1, 0) }
#undef PG8_KLOOP
        if (wr == 0) PG8_BAR;
        E(acc, cur, wr, wc, fr, fq, tid);
        if (!has_next) break;
#pragma unroll
        for (int a = 0; a < 2; ++a)
#pragma unroll
            for (int b = 0; b < 2; ++b)
#pragma unroll
                for (int m = 0; m < 4; ++m)
#pragma unroll
                    for (int n = 0; n < 2; ++n) acc[a][b][m][n] = (f32x4){0.f, 0.f, 0.f, 0.f};
        cur = nxt; cA = nA; cB = nB; cf8 = nf8; ++ui;
        if (wr == 1) PG8_BAR;
    }
    PG8_WAIT_V(0);
    PG8_BAR;
#undef PG8_SA
#undef PG8_SB
#undef PG8_STAGE
#undef PG8_LDA
#undef PG8_LDB
#undef PG8_MMA
#undef PG8_MMA8
#undef PG8_LDA8
#undef PG8_LDB8
#undef PG8_CAT
#undef PG8_WAIT_V
#undef PG8_WAIT_L
#undef PG8_BAR
#undef PG8_SCHED
}
#else
template <int MODE = 0, class Epi, class Sched>
inline void gemm_phase(unsigned char* lds, const int lda, const int ldb, const Sched& S, const Epi& E, const int lda8 = 0) {
    const int tid = TIDX(), wid = tid >> 6, lane = tid & 63, wr = wid >> 2, wc = wid & 3, fr = lane & 15, fq = lane >> 4;
    Unit cur;
    for (int ui = 0; S.next(ui, cur); ++ui) {
        f32x4 acc[2][2][4][2];
        const bf16_t* A = (const bf16_t*)cur.a; const bf16_t* Bt = (const bf16_t*)cur.b; const int K = cur.nt * 64;
        for (int ai = 0; ai < 2; ++ai) for (int bj = 0; bj < 2; ++bj) for (int m = 0; m < 4; ++m) for (int n = 0; n < 2; ++n) for (int e = 0; e < 4; ++e) {
            const int r = 128 * ai + 64 * wr + 16 * m + fr, c = 128 * bj + 32 * wc + 8 * fq + 4 * n + e; float s = 0.f;
            const bf16_t* ar = A + (size_t)r * lda; const bf16_t* br = Bt + (size_t)c * ldb;
            if (cur.f8) { const unsigned char* a8 = (const unsigned char*)cur.a + (size_t)r * lda8; const unsigned char* b8 = (const unsigned char*)cur.b + (size_t)c * ldb * 2;
                for (int k = 0; k < cur.nt * 128; ++k) s += fp8_dec_(a8[k]) * fp8_dec_(b8[k]); }
#ifdef EMU_FP8_A
            else if (cur.aux == 77) { float am = 0.f; for (int k = 0; k < K; ++k) am = fmaxf(am, fabsf(bf2f(br[k]))); const float sc = am > 0.f ? am / 440.f : 1.f;
                for (int k = 0; k < K; ++k) s += fp8_dec_(fp8_enc_(bf2f(ar[k]))) * fp8_dec_(fp8_enc_(bf2f(br[k]) / sc)); s *= sc; }
#endif
            else for (int k = 0; k < K; ++k) s += bf2f(ar[k]) * bf2f(br[k]);
            acc[ai][bj][m][n][e] = s; }
        __syncthreads();
        E(acc, cur, wr, wc, fr, fq, tid);
        __syncthreads();
    }
    __syncthreads();
}
#endif
}
struct Ptrs {
    bf16_t *WinT, *WbrT, *WoutT, *WqT, *PleT, *PleGT, *GluT, *K12, *S5Kc, *S5Wx, *S5Wy, *Ut, *Vt, *hb, *proj, *merged, *q, *ycat, *vtr, *pb;
    float *S5LL, *gate; int* eid; unsigned char* stash; bf16_t *rwPT, *rwG, *rwS0, *rwQ, *rwGt, *rwRKV; unsigned char *U8, *V8; float *su, *sv, *pd; unsigned* qcnt; unsigned char *h8a, *h8b, *h8e; float* gsc;
};
__device__ __forceinline__ Ptrs make_ptrs(unsigned char* ws, int l) {
    Ptrs P; { size_t zoff = 0; OPAQUE_S(zoff); ws += zoff; }
    P.WinT = (bf16_t*)(ws + WS_WIN) + (size_t)l * WIN_ROWS * 1024; P.WbrT = (bf16_t*)(ws + WS_WBR) + (size_t)l * 1024 * 1024; P.WoutT = (bf16_t*)(ws + WS_WOUT) + (size_t)l * 1024 * 1024;
    P.WqT = (bf16_t*)(ws + WS_WQ) + (size_t)l * 2048 * 1024; P.PleT = (bf16_t*)(ws + WS_PLE) + (size_t)l * 1024 * 256; P.PleGT = (bf16_t*)(ws + WS_PLEG) + (size_t)l * 1024 * 1024;
    P.GluT = (bf16_t*)(ws + WS_GLU) + (size_t)l * 256 * 256; P.K12 = (bf16_t*)(ws + WS_K12) + (size_t)l * 2 * 128 * 128;
    P.S5Kc = (bf16_t*)(ws + WS_S5KC) + (size_t)l * 16 * 64 * 256; P.S5Wx = (bf16_t*)(ws + WS_S5WX) + (size_t)l * 16 * 128 * 1024; P.S5Wy = (bf16_t*)(ws + WS_S5WY) + (size_t)l * 16 * 1024 * 128;
    P.S5LL = (float*)(ws + WS_S5LL) + (size_t)l * 16 * 64 * 2;
    P.Ut = (bf16_t*)(ws + WS_UT); P.Vt = (bf16_t*)(ws + WS_VT);
    P.pd = (float*)(ws + WS_R1 + R1_Q); P.qcnt = (unsigned*)(ws + WS_CTL) + 8192 + l * 4 * 8 * 16;
    P.U8 = ws + WS_UT; P.V8 = ws + WS_UT + (size_t)NEXP * 1024; P.su = (float*)(ws + WS_CTL + 131072); P.sv = (float*)(ws + WS_CTL + 131072) + NEXP;
    P.rwGt = (bf16_t*)(ws + WS_VT); P.rwRKV = (bf16_t*)(ws + WS_VT + RW_SZ);
    P.rwPT = (bf16_t*)(ws + WS_RW); P.rwG = (bf16_t*)(ws + WS_RW + RW_SZ); P.rwS0 = (bf16_t*)(ws + WS_RW + 2 * RW_SZ); P.rwQ = (bf16_t*)(ws + WS_RW + 3 * RW_SZ);
    P.hb = (bf16_t*)(ws + WS_HB); P.proj = (bf16_t*)(ws + WS_R1 + R1_PROJ); P.merged = (bf16_t*)(ws + WS_R1 + R1_MERGED); P.q = (bf16_t*)(ws + WS_R1 + R1_Q);
    P.stash = ws + WS_R1 + R1_STASH; P.eid = (int*)(ws + WS_R1 + R1_EID); P.gate = (float*)(ws + WS_R1 + R1_GATE);
    P.ycat = (bf16_t*)(ws + WS_YC); P.vtr = (bf16_t*)(ws + WS_VTR); P.pb = (bf16_t*)(ws + WS_PB);
    P.h8a = ws + WS_R1 + R1_H8; P.h8b = ws + WS_H8T; P.h8e = ws + WS_RW; P.gsc = (float*)(ws + WS_CTL + 262144) + l * 5120;
    return P;
}

__device__ __forceinline__ int win_src_col(int n) {
    if (n < 1152) return n;
    if (n < 1664) return n;
    if (n < 1668) return 1920 + (n - 1664);
    if (n < 1792) return -1;
    if (n < 2304) return 1924 + (n - 1792);
    if (n < 2560) return 1664 + (n - 2304);
    return 2436 + (n - 2560);
}
template <bool WINMAP>
__device__ __forceinline__ void transpose_item(const float* src, int sld, bf16_t* dst, int dld, int dcol0, int kb, int nb, float* scr, int lane) {
    const int k0 = 64 * kb, n0 = 32 * nb;
    const int nn = n0 + (lane & 31); const int sc = WINMAP ? win_src_col(nn) : nn;
#pragma unroll 8
    for (int i = 0; i < 32; ++i) { const int kk = 2 * i + (lane >> 5); scr[kk * 33 + (lane & 31)] = (sc >= 0) ? src[(size_t)(k0 + kk) * sld + sc] : 0.f; }
    WAVE_SYNC();
    const int c = lane & 7;
#pragma unroll
    for (int j = 0; j < 4; ++j) { const int n = (lane >> 3) + 8 * j; const float* s = scr + (8 * c) * 33 + n;
        u32x4 o; o.x = pk2(s[0 * 33], s[1 * 33]); o.y = pk2(s[2 * 33], s[3 * 33]); o.z = pk2(s[4 * 33], s[5 * 33]); o.w = pk2(s[6 * 33], s[7 * 33]);
        *(u32x4*)(dst + (size_t)(n0 + n) * dld + dcol0 + k0 + 8 * c) = o; }
    WAVE_SYNC();
}

__device__ __forceinline__ void s5_tables(const KP& p, int l, int g, unsigned char* lds) {
    float* pw = (float*)lds;
    float* bb = pw + 65 * 128;
    float* cc = bb + 64 * 32;
    const int tid = TIDX();
    const Ptrs P = make_ptrs(p.ws, l);
    const float dt = expf(p.in[I_LDT][l * 16 + g]);
    if (tid < 64) { const int pp = tid; const float lr = p.in[I_LRE][(l * 16 + g) * 64 + pp], li = p.in[I_LIM][(l * 16 + g) * 64 + pp];
        const float mag = expf(lr * dt), ang = li * dt; const float br = mag * cosf(ang), bi = mag * sinf(ang);
        float xr = 1.f, xi = 0.f;
        for (int t = 0; t <= 64; ++t) { pw[(t * 64 + pp) * 2] = xr; pw[(t * 64 + pp) * 2 + 1] = xi; const float nr = xr * br - xi * bi, ni = xr * bi + xi * br; xr = nr; xi = ni; }
        const float nr = br - 1.f, ni = bi, den = lr * lr + li * li; const float cr = (nr * lr + ni * li) / den, ci = (ni * lr - nr * li) / den;
        for (int c = 0; c < 16; ++c) { const float b_r = p.in[I_BRE][((l * 16 + g) * 64 + pp) * 16 + c], b_i = p.in[I_BIM][((l * 16 + g) * 64 + pp) * 16 + c];
            bb[(pp * 16 + c) * 2] = cr * b_r - ci * b_i; bb[(pp * 16 + c) * 2 + 1] = cr * b_i + ci * b_r; }
        P.S5LL[(g * 64 + pp) * 2] = pw[(64 * 64 + pp) * 2]; P.S5LL[(g * 64 + pp) * 2 + 1] = pw[(64 * 64 + pp) * 2 + 1];
    }
    for (int e = tid; e < 1024; e += NTHR) { const int c = e >> 6, pp = e & 63; cc[e * 2] = p.in[I_CRE][((l * 16 + g) * 16 + c) * 64 + pp]; cc[e * 2 + 1] = p.in[I_CIM][((l * 16 + g) * 16 + c) * 64 + pp]; }
    __syncthreads();
    bf16_t* Kc = P.S5Kc + (size_t)g * 64 * 256;
    for (int e = tid; e < 64 * 256; e += NTHR) { const int tau = e >> 8, co = (e >> 4) & 15, ci = e & 15; float s = 0.f;
        for (int pp = 0; pp < 64; ++pp) { const float c_r = cc[(co * 64 + pp) * 2], c_i = cc[(co * 64 + pp) * 2 + 1], w_r = pw[(tau * 64 + pp) * 2], w_i = pw[(tau * 64 + pp) * 2 + 1];
            const float t_r = c_r * w_r - c_i * w_i, t_i = c_r * w_i + c_i * w_r; s += t_r * bb[(pp * 16 + ci) * 2] - t_i * bb[(pp * 16 + ci) * 2 + 1]; }
        Kc[e] = (bf16_t)f2bf(s); }
    bf16_t* Wx = P.S5Wx + (size_t)g * 128 * 1024;
    for (int e = tid; e < 128 * 1024; e += NTHR) { const int n = e >> 10, k = e & 1023, pp = n >> 1, ri = n & 1, s = k >> 4, ci = k & 15;
        const float w_r = pw[((63 - s) * 64 + pp) * 2], w_i = pw[((63 - s) * 64 + pp) * 2 + 1], b_r = bb[(pp * 16 + ci) * 2], b_i = bb[(pp * 16 + ci) * 2 + 1];
        Wx[e] = (bf16_t)f2bf(ri ? (w_r * b_i + w_i * b_r) : (w_r * b_r - w_i * b_i)); }
    bf16_t* Wy = P.S5Wy + (size_t)g * 1024 * 128;
    for (int e = tid; e < 1024 * 128; e += NTHR) { const int n = e >> 7, k = e & 127, t = n >> 4, co = n & 15, pp = k >> 1, ri = k & 1;
        const float c_r = cc[(co * 64 + pp) * 2], c_i = cc[(co * 64 + pp) * 2 + 1], w_r = pw[((t + 1) * 64 + pp) * 2], w_i = pw[((t + 1) * 64 + pp) * 2 + 1];
        Wy[e] = (bf16_t)f2bf(ri ? -(c_r * w_i + c_i * w_r) : (c_r * w_r - c_i * w_i)); }
    __syncthreads();
}

__device__ __forceinline__ void ln_row(const float* src, const float* g, const float* b, float* dst, bf16_t* dstb, int lane) {
    f32x4 v[4]; float s = 0.f;
#pragma unroll
    for (int j = 0; j < 4; ++j) { v[j] = *(const f32x4*)(src + 256 * j + 4 * lane); s += (v[j].x + v[j].y) + (v[j].z + v[j].w); }
    const float mean = wave_sum(s) * (1.f / 1024.f); float s2 = 0.f;
#pragma unroll
    for (int j = 0; j < 4; ++j) { v[j] = v[j] - mean; s2 += (v[j].x * v[j].x + v[j].y * v[j].y) + (v[j].z * v[j].z + v[j].w * v[j].w); }
    const float rstd = 1.f / sqrtf(wave_sum(s2) * (1.f / 1024.f) + LN_EPS_);
#pragma unroll
    for (int j = 0; j < 4; ++j) { const f32x4 gg = *(const f32x4*)(g + 256 * j + 4 * lane), bv = *(const f32x4*)(b + 256 * j + 4 * lane);
        const f32x4 o = v[j] * rstd * gg + bv; *(f32x4*)(dst + 256 * j + 4 * lane) = o;
        if (dstb) { u32x2 w; w.x = pk2(o.x, o.y); w.y = pk2(o.z, o.w); *(u32x2*)(dstb + 256 * j + 4 * lane) = w; } }
}

template <int NR>
__device__ __forceinline__ void ln_rows(const float* src, const float* g, const float* b, float* dst, bf16_t* dstb, unsigned char* d8, int lane) {
    f32x4 v[NR][4]; float s[NR], s2[NR];
#pragma unroll
    for (int r = 0; r < NR; ++r) { s[r] = 0.f;
#pragma unroll
        for (int j = 0; j < 4; ++j) { v[r][j] = *(const f32x4*)(src + (size_t)r * 1024 + 256 * j + 4 * lane); s[r] += (v[r][j].x + v[r][j].y) + (v[r][j].z + v[r][j].w); } }
    wave_sum_n<NR>(s);
#pragma unroll
    for (int r = 0; r < NR; ++r) { const float mean = s[r] * (1.f / 1024.f); s2[r] = 0.f;
#pragma unroll
        for (int j = 0; j < 4; ++j) { v[r][j] = v[r][j] - mean; s2[r] += (v[r][j].x * v[r][j].x + v[r][j].y * v[r][j].y) + (v[r][j].z * v[r][j].z + v[r][j].w * v[r][j].w); } }
    wave_sum_n<NR>(s2);
#pragma unroll
    for (int j = 0; j < 4; ++j) { const f32x4 gg = *(const f32x4*)(g + 256 * j + 4 * lane), bv = *(const f32x4*)(b + 256 * j + 4 * lane);
#pragma unroll
        for (int r = 0; r < NR; ++r) { const float rstd = 1.f / sqrtf(s2[r] * (1.f / 1024.f) + LN_EPS_);
            const f32x4 o = v[r][j] * rstd * gg + bv; if (dst) *(f32x4*)(dst + (size_t)r * 1024 + 256 * j + 4 * lane) = o;
            if (dstb) { u32x2 w; w.x = pk2(o.x, o.y); w.y = pk2(o.z, o.w); *(u32x2*)(dstb + (size_t)r * 1024 + 256 * j + 4 * lane) = w; }
            if (d8) { unsigned w8 = cvt_pk_fp8_f32_(o.x, o.y, 0u, false); w8 = cvt_pk_fp8_f32_(o.z, o.w, w8, true); *(unsigned*)(d8 + (size_t)r * 1024 + 256 * j + 4 * lane) = w8; } } }
}
__device__ __forceinline__ void phase_prologue(const KP& p, unsigned char* lds) {
    const int tid = TIDX(), lane = tid & 63, wave = tid >> 6;
    int G = GDIM(), bid = BIDX();
    for (int it = bid; it < L_ * 16; it += G) s5_tables(p, it >> 4, it & 15, lds);
    if (G >= 4 * L_ * 16) { if (bid < L_ * 16) return; bid -= L_ * 16; G -= L_ * 16; }
    float* scr = (float*)lds + wave * (64 * 33 + 16);
    const int gw = bid * NWAVE + wave, NGW = G * NWAVE;
    constexpr int I_WINT = (WIN_ROWS / 32) * 16, I_BR = 4 * 4 * 32, I_OUT = 16 * 32, I_Q = 16 * 64, I_PL = 4 * 32, I_PG = 16 * 32, I_GL = 4 * 8;
    constexpr int PER_L = I_WINT + I_BR + I_OUT + I_Q + I_PL + I_PG + I_GL;
    for (int it = gw; it < L_ * PER_L; it += NGW) {
        const int l = it / PER_L; int r = it % PER_L; const Ptrs P = make_ptrs(p.ws, l);
        if (r < I_WINT) { transpose_item<true>(p.in[I_WIN] + (size_t)l * 1024 * IN_COLS, IN_COLS, P.WinT, 1024, 0, r & 15, r >> 4, scr, lane); continue; } r -= I_WINT;
        if (r < I_BR) { const int b = r >> 7, rr = r & 127; transpose_item<false>(p.in[I_WBR] + ((size_t)l * 4 + b) * 256 * 1024, 1024, P.WbrT, 1024, 256 * b, rr & 3, rr >> 2, scr, lane); continue; } r -= I_BR;
        if (r < I_OUT) { transpose_item<false>(p.in[I_WOUT] + (size_t)l * 1024 * 1024, 1024, P.WoutT, 1024, 0, r & 15, r >> 4, scr, lane); continue; } r -= I_OUT;
        if (r < I_Q) { transpose_item<false>(p.in[I_WQ] + (size_t)l * 1024 * 2048, 2048, P.WqT, 1024, 0, r & 15, r >> 4, scr, lane); continue; } r -= I_Q;
        if (r < I_PL) { transpose_item<false>(p.in[I_PLEW] + (size_t)l * 256 * 1024, 1024, P.PleT, 256, 0, r & 3, r >> 2, scr, lane); continue; } r -= I_PL;
        if (r < I_PG) { transpose_item<false>(p.in[I_PLEG] + (size_t)l * 1024 * 1024, 1024, P.PleGT, 1024, 0, r & 15, r >> 4, scr, lane); continue; } r -= I_PG;
        transpose_item<false>(p.in[I_GLUW] + (size_t)l * 256 * 256, 256, P.GluT, 256, 0, r & 3, r >> 2, scr, lane);
    }
    const size_t gt = (size_t)bid * NTHR + tid, NGT = (size_t)G * NTHR;
    { bf16_t* K12 = (bf16_t*)(p.ws + WS_K12);
      for (size_t i = gt; i < (size_t)L_ * 2 * 16384 / 8; i += NGT) { const size_t e = i * 8; const int l = (int)(e / 32768), r = (int)(e % 32768); const float* s = (r < 16384 ? p.in[I_K1] : p.in[I_K2]) + (size_t)l * 16384 + (r & 16383);
        const f32x4 a = *(const f32x4*)s, b = *(const f32x4*)(s + 4); u32x4 o; o.x = pk2(a.x, a.y); o.y = pk2(a.z, a.w); o.z = pk2(b.x, b.y); o.w = pk2(b.z, b.w); *(u32x4*)(K12 + e) = o; } }
    { bf16_t* hb = (bf16_t*)(p.ws + WS_HB);
      unsigned char* h8a = p.ws + WS_R1 + R1_H8; unsigned char* h8b = p.ws + WS_H8T;
      for (int m = 4 * gw; m < T_; m += 4 * NGW) ln_rows<4>(p.in[I_X] + (size_t)m * 1024, p.in[I_LNIN_G], p.in[I_LNIN_B], (float*)nullptr, hb + (size_t)m * 1024, m < H8_SPLIT ? h8a + (size_t)m * 1024 : h8b + (size_t)(m - H8_SPLIT) * 1024, lane); }
}
__device__ __forceinline__ void conv_unit(const KP& p, const Ptrs& P, int l, int unit, unsigned char* lds) {
    bf16_t* hbuf = (bf16_t*)lds;
    float* obuf = (float*)(lds + 94 * 256 * 2);
    const int tid = TIDX(), lane = tid & 63, wave = tid >> 6;
    const int tiles_per_seq = S_ / 64, b = unit / tiles_per_seq, t0 = (unit % tiles_per_seq) * 64;
    for (int e = tid; e < 94 * 32; e += NTHR) { const int r = e >> 5, c8 = (e & 31) * 8; const int t = t0 - 30 + r;
        u32x4 o = (u32x4){0u, 0u, 0u, 0u};
        if (t >= 0) { const bf16_t* row = P.proj + (size_t)(b * S_ + t) * PJ; const u32x4 v = *(const u32x4*)(row + C_CV + c8), g = *(const u32x4*)(row + C_CG + c8);
            o.x = pk2(bflo(v.x) * sigmoidf_(bflo(g.x)), bfhi(v.x) * sigmoidf_(bfhi(g.x))); o.y = pk2(bflo(v.y) * sigmoidf_(bflo(g.y)), bfhi(v.y) * sigmoidf_(bfhi(g.y)));
            o.z = pk2(bflo(v.z) * sigmoidf_(bflo(g.z)), bfhi(v.z) * sigmoidf_(bfhi(g.z))); o.w = pk2(bflo(v.w) * sigmoidf_(bflo(g.w)), bfhi(v.w) * sigmoidf_(bfhi(g.w))); }
        *(u32x4*)(hbuf + r * 256 + c8) = o; }
    __syncthreads();
    { const int c = tid & 255, half = tid >> 8; float w[31], x[62];
#pragma unroll
      for (int j = 0; j < 31; ++j) w[j] = p.in[I_CONVW][(l * 31 + j) * 256 + c];
      const float cb = p.in[I_CONVB][l * 256 + c];
#pragma unroll
      for (int j = 0; j < 62; ++j) x[j] = bf2f(hbuf[(half * 32 + j) * 256 + c]);
#pragma unroll
      for (int tt = 0; tt < 32; ++tt) { float s = cb;
#pragma unroll
          for (int j = 0; j < 31; ++j) s += w[j] * x[tt + j];
          obuf[(half * 32 + tt) * 256 + c] = s; } }
    __syncthreads();
    { const f32x4 g = *(const f32x4*)(p.in[I_CLNG] + l * 256 + 4 * lane), bb = *(const f32x4*)(p.in[I_CLNB] + l * 256 + 4 * lane);
      f32x4 vv[8]; float m1[8], m2[8];
#pragma unroll
      for (int i = 0; i < 8; ++i) { vv[i] = *(const f32x4*)(obuf + (wave * 8 + i) * 256 + 4 * lane); m1[i] = (vv[i].x + vv[i].y) + (vv[i].z + vv[i].w); }
      wave_sum_n<8>(m1);
#pragma unroll
      for (int i = 0; i < 8; ++i) { vv[i] = vv[i] - m1[i] * (1.f / 256.f); m2[i] = (vv[i].x * vv[i].x + vv[i].y * vv[i].y) + (vv[i].z * vv[i].z + vv[i].w * vv[i].w); }
      wave_sum_n<8>(m2);
#pragma unroll
      for (int i = 0; i < 8; ++i) { const int t = wave * 8 + i; const float rstd = 1.f / sqrtf(m2[i] * (1.f / 256.f) + LN_EPS_);
          f32x4 z = vv[i] * rstd * g + bb; u32x2 w; w.x = pk2(z.x * sigmoidf_(z.x), z.y * sigmoidf_(z.y)); w.y = pk2(z.z * sigmoidf_(z.z), z.w * sigmoidf_(z.w));
          *(u32x2*)(P.ycat + (size_t)(b * S_ + t0 + t) * 1024 + 768 + 4 * lane) = w; } }
    __syncthreads();
}

constexpr int S5_NCH = S_ / 64;
constexpr int S5_UPITCH = 1032;
constexpr int S5_XPITCH = 136;
__device__ __forceinline__ void s5_unit(const KP& p, const Ptrs& P, int l, int unit, unsigned char* lds) {
    const int b = unit >> 4, g = unit & 15;
    bf16_t* Uc = (bf16_t*)lds;
    bf16_t* Kc = (bf16_t*)(lds + 66048);
    float* Xe = (float*)(lds + 66048 + 32768);
    bf16_t* Xs = (bf16_t*)(lds + 66048 + 65536);
    const int tid = TIDX(), lane = tid & 63, wave = tid >> 6, r32 = lane & 31, hi = lane >> 5;
    { u32x4 v[8], kc[4];
#pragma unroll
      for (int j = 0; j < 8; ++j) { const int e = tid + j * NTHR, s = e >> 1, hf = e & 1; v[j] = (u32x4){0u, 0u, 0u, 0u};
          if (s < S_) v[j] = *(const u32x4*)(P.proj + (size_t)(b * S_ + s) * PJ + C_S5 + 16 * g + 8 * hf); }
#pragma unroll
      for (int j = 0; j < 4; ++j) kc[j] = *(const u32x4*)(P.S5Kc + (size_t)g * 16384 + (tid + j * NTHR) * 8);
#pragma unroll
      for (int j = 0; j < 8; ++j) { const int e = tid + j * NTHR, s = e >> 1, hf = e & 1; *(u32x4*)(Uc + (s >> 6) * S5_UPITCH + (s & 63) * 16 + 8 * hf) = v[j]; }
#pragma unroll
      for (int j = 0; j < 4; ++j) *(u32x4*)(Kc + (tid + j * NTHR) * 8) = kc[j]; }
    __syncthreads();
    { const int ntile = wave & 3, kh = wave >> 2; f32x16 acc = {};
      const bf16_t* wrow = P.S5Wx + ((size_t)g * 128 + ntile * 32 + r32) * 1024 + kh * 512 + 8 * hi;
      const bf16_t* urow = Uc + r32 * S5_UPITCH + kh * 512 + 8 * hi;
      for (int k8 = 0; k8 < 32; k8 += 8) { bf16x8 bw[8];
#pragma unroll
          for (int j = 0; j < 8; ++j) bw[j] = *(const bf16x8*)(wrow + (k8 + j) * 16);
#pragma unroll
          for (int j = 0; j < 8; ++j) { const bf16x8 a = *(const bf16x8*)(urow + (k8 + j) * 16); acc = MFMA32(a, bw[j], acc); } }
#pragma unroll
      for (int r = 0; r < 16; ++r) { const int c = (r & 3) + 8 * (r >> 2) + 4 * hi; Xe[(kh * 32 + c) * 128 + ntile * 32 + r32] = acc[r]; } }
    __syncthreads();
    if (tid < 64) { const float lr = P.S5LL[(g * 64 + tid) * 2], li = P.S5LL[(g * 64 + tid) * 2 + 1]; float xr = 0.f, xi = 0.f;
        for (int c = 0; c < 32; ++c) { Xs[c * S5_XPITCH + 2 * tid] = (bf16_t)f2bf(xr); Xs[c * S5_XPITCH + 2 * tid + 1] = (bf16_t)f2bf(xi);
            const float er = Xe[c * 128 + 2 * tid] + Xe[(32 + c) * 128 + 2 * tid], ei = Xe[c * 128 + 2 * tid + 1] + Xe[(32 + c) * 128 + 2 * tid + 1];
            const float nr = lr * xr - li * xi + er, ni = lr * xi + li * xr + ei; xr = nr; xi = ni; } }
    __syncthreads();
    { const int tt = r32 >> 4, co = r32 & 15; const float dsk = p.in[I_S5D][l * 256 + 16 * g + co];
      for (int q = 0; q < 4; ++q) { const int ntile = wave + 8 * q, t0 = 2 * ntile; f32x16 acc = {};
          const bf16_t* urow = Uc + r32 * S5_UPITCH + 8 * hi;
          for (int s = 0; s <= t0 + 1; ++s) { const int tau = t0 + tt - s; bf16x8 bk = (bf16x8){0, 0, 0, 0, 0, 0, 0, 0};
              if (tau >= 0) bk = *(const bf16x8*)(Kc + (tau * 16 + co) * 16 + 8 * hi);
              const bf16x8 a = *(const bf16x8*)(urow + s * 16); acc = MFMA32(a, bk, acc); }
          const bf16_t* wy = P.S5Wy + ((size_t)g * 1024 + ntile * 32 + r32) * 128 + 8 * hi; const bf16_t* xrow = Xs + r32 * S5_XPITCH + 8 * hi;
#pragma unroll
          for (int ks = 0; ks < 8; ++ks) { const bf16x8 a = *(const bf16x8*)(xrow + ks * 16); const bf16x8 bw = *(const bf16x8*)(wy + ks * 16); acc = MFMA32(a, bw, acc); }
#pragma unroll
          for (int r = 0; r < 16; ++r) { const int c = (r & 3) + 8 * (r >> 2) + 4 * hi; const int s = c * 64 + t0 + tt;
              if (s < S_) { const float uu = bf2f(Uc[c * S5_UPITCH + (t0 + tt) * 16 + co]); const float y = acc[r] + dsk * uu;
                  P.ycat[(size_t)(b * S_ + s) * 1024 + 256 + 16 * g + co] = (bf16_t)f2bf(gelu_erf(y)); } } } }
    __syncthreads();
}
constexpr float LOG2E_ = 1.4426950408889634f;
__device__ __forceinline__ float log_sigmoid_(float x) { return fminf(x, 0.f) - log1pf(__expf(-fabsf(x))); }
__device__ __forceinline__ void fox_unit(const KP& p, const Ptrs& P, int l, int unit, unsigned char* lds) {
    constexpr int NQB = S_ / 256;
    const int bh = unit / NQB, qb = (unit >= (NB_ * 4 * NQB) / 2) ? NQB - 1 - unit % NQB : unit % NQB, b = bh >> 2, h = bh & 3, q0 = qb * 256;
    float* cl = (float*)lds;
    unsigned char* Kt = lds + S_ * 4;
    unsigned char* Vt = Kt + 8192;
    float* wsf = (float*)(Kt + 32768);
    float* sc = wsf + 256;
    const int tid = TIDX(), lane = tid & 63, wave = tid >> 6, r32 = lane & 31, hi = lane >> 5;
    const int qend = q0 + 256;
    { constexpr int PER = (S_ + 511) / 512; const float bf = p.in[I_BF][l * 4 + h]; float loc[PER]; float s = 0.f;
#pragma unroll
      for (int i = 0; i < PER; ++i) { const int t = tid * PER + i; float v = 0.f;
          if (t < qend) v = log_sigmoid_(bf2f(P.proj[(size_t)(b * S_ + t) * PJ + C_FL + h]) + bf) * LOG2E_;
          s += v; loc[i] = s; }
      sc[tid] = s; __syncthreads();
      for (int off = 1; off < 512; off <<= 1) { const float v = sc[tid] + (tid >= off ? sc[tid - off] : 0.f); __syncthreads(); sc[tid] = v; __syncthreads(); }
      const float base = sc[tid] - s;
#pragma unroll
      for (int i = 0; i < PER; ++i) { const int t = tid * PER + i; if (t < S_) cl[t] = base + loc[i]; }
      __syncthreads(); }
    const int qrow = q0 + 32 * wave + r32;
    constexpr float C2 = 0.125f * LOG2E_;
    bf16x8 qr[4];
    { const bf16_t* qp = P.proj + (size_t)(b * S_ + qrow) * PJ + C_FQ + 64 * h + 8 * hi;
#pragma unroll
      for (int d0 = 0; d0 < 4; ++d0) { const u32x4 w = *(const u32x4*)(qp + 16 * d0);
          u32x4 o; o.x = pk2(bflo(w.x) * C2, bfhi(w.x) * C2); o.y = pk2(bflo(w.y) * C2, bfhi(w.y) * C2); o.z = pk2(bflo(w.z) * C2, bfhi(w.z) * C2); o.w = pk2(bflo(w.w) * C2, bfhi(w.w) * C2);
          qr[d0] = __builtin_bit_cast(bf16x8, o); } }
    const float clq = cl[qrow];
    float mrun = -INFINITY, lrun = 0.f; f32x16 o0 = {}, o1 = {};
    const int NT = qend / 64;
    const int srow = tid >> 3, sch = tid & 7;
    const bf16_t* kg = P.proj + (size_t)(b * S_ + srow) * PJ + C_FK + 64 * h + 8 * sch;
    const bf16_t* vg = P.vtr + (size_t)(64 * h + srow) * T_ + (size_t)b * S_ + 8 * sch;
    const int koff = srow * 128 + ((sch ^ ((srow >> 1) & 7)) * 16);
    const int voffa = srow * 128 + (((2 * sch) ^ ((srow >> 1) & 15)) * 8), voffb = srow * 128 + (((2 * sch + 1) ^ ((srow >> 1) & 15)) * 8);
    u32x4 kreg = *(const u32x4*)kg, vreg = *(const u32x4*)vg;
    *(u32x4*)(Kt + koff) = kreg; *(u32x2*)(Vt + voffa) = (u32x2){vreg.x, vreg.y}; *(u32x2*)(Vt + voffb) = (u32x2){vreg.z, vreg.w};
    if (NT > 1) { kreg = *(const u32x4*)(kg + (size_t)64 * PJ); vreg = *(const u32x4*)(vg + 64); }
    __syncthreads();
    for (int jt = 0; jt < NT; ++jt) {
        const int kv0 = jt * 64; const unsigned char* Kb = Kt + (jt & 1) * 16384; const unsigned char* Vb = Vt + (jt & 1) * 16384;
        if (kv0 <= q0 + 32 * wave + 31) {
            f32x16 pt[2];
#pragma unroll
            for (int kvt = 0; kvt < 2; ++kvt) { const int row = 32 * kvt + r32; f32x16 acc;
#pragma unroll
                for (int g4 = 0; g4 < 4; ++g4) { const f32x4 c4 = *(const f32x4*)(cl + kv0 + 32 * kvt + 8 * g4 + 4 * hi);
#pragma unroll
                    for (int e = 0; e < 4; ++e) acc[4 * g4 + e] = clq - c4[e]; }
#pragma unroll
                for (int d0 = 0; d0 < 4; ++d0) { const bf16x8 a = *(const bf16x8*)(Kb + row * 128 + (((2 * d0 + hi) ^ ((row >> 1) & 7)) * 16)); acc = MFMA32(a, qr[d0], acc); }
                pt[kvt] = acc; }
            if (kv0 + 63 > q0 + 32 * wave) {
#pragma unroll
                for (int kvt = 0; kvt < 2; ++kvt)
#pragma unroll
                    for (int r = 0; r < 16; ++r) { const int key = kv0 + 32 * kvt + (r & 3) + 8 * (r >> 2) + 4 * hi; if (key > qrow) pt[kvt][r] = -INFINITY; } }
            float mx = -INFINITY;
#pragma unroll
            for (int kvt = 0; kvt < 2; ++kvt)
#pragma unroll
                for (int r = 0; r < 16; ++r) mx = fmaxf(mx, pt[kvt][r]);
            mx = fmaxf(mx, __shfl_xor(mx, 32));
            const float mnew = fmaxf(mrun, mx), alpha = FAST_EXP2(mrun - mnew); mrun = mnew;
            float ls = 0.f;
#pragma unroll
            for (int kvt = 0; kvt < 2; ++kvt)
#pragma unroll
                for (int r = 0; r < 16; ++r) { const float e = FAST_EXP2(pt[kvt][r] - mnew); pt[kvt][r] = e; ls += e; }
            lrun = lrun * alpha + ls;
            float* wf = wsf + wave * 32;
            WAVE_SYNC(); if (hi == 0) wf[r32] = alpha; WAVE_SYNC();
#pragma unroll
            for (int g4 = 0; g4 < 4; ++g4) { const f32x4 f = *(const f32x4*)(wf + 8 * g4 + 4 * hi);
#pragma unroll
                for (int e = 0; e < 4; ++e) { o0[4 * g4 + e] *= f[e]; o1[4 * g4 + e] *= f[e]; } }
#pragma unroll
            for (int s = 0; s < 4; ++s) { const int kvt = s >> 1, rb = 8 * (s & 1);
                u32x4 pw; pw.x = pk2(pt[kvt][rb + 0], pt[kvt][rb + 1]); pw.y = pk2(pt[kvt][rb + 2], pt[kvt][rb + 3]); pw.z = pk2(pt[kvt][rb + 4], pt[kvt][rb + 5]); pw.w = pk2(pt[kvt][rb + 6], pt[kvt][rb + 7]);
                const bf16x8 pa = __builtin_bit_cast(bf16x8, pw);
#pragma unroll
                for (int dt = 0; dt < 2; ++dt) { const int d = 32 * dt + r32; const int sw = (d >> 1) & 15;
                    const u32x2 va = *(const u32x2*)(Vb + d * 128 + (((4 * s + hi) ^ sw) * 8)), vb = *(const u32x2*)(Vb + d * 128 + (((4 * s + 2 + hi) ^ sw) * 8));
                    const bf16x8 vf = __builtin_bit_cast(bf16x8, (u32x4){va.x, va.y, vb.x, vb.y});
                    if (dt == 0) o0 = MFMA32(pa, vf, o0); else o1 = MFMA32(pa, vf, o1); } }
        }
        if (jt + 1 < NT) { unsigned char* Kn = Kt + ((jt + 1) & 1) * 16384; unsigned char* Vn = Vt + ((jt + 1) & 1) * 16384;
            *(u32x4*)(Kn + koff) = kreg; *(u32x2*)(Vn + voffa) = (u32x2){vreg.x, vreg.y}; *(u32x2*)(Vn + voffb) = (u32x2){vreg.z, vreg.w};
            if (jt + 2 < NT) { kreg = *(const u32x4*)(kg + (size_t)(kv0 + 128) * PJ); vreg = *(const u32x4*)(vg + kv0 + 128); } }
        __syncthreads();
    }
    { const float lt = lrun + __shfl_xor(lrun, 32); float* wf = wsf + wave * 32;
      WAVE_SYNC(); if (hi == 0) wf[r32] = 1.0f / lt; WAVE_SYNC();
      bf16_t* orow = P.ycat + (size_t)(b * S_ + q0 + 32 * wave) * 1024 + 512 + 64 * h + r32;
#pragma unroll
      for (int r = 0; r < 16; ++r) { const int qq = (r & 3) + 8 * (r >> 2) + 4 * hi; const float f = wf[qq];
          orow[(size_t)qq * 1024] = (bf16_t)f2bf(o0[r] * f); orow[(size_t)qq * 1024 + 32] = (bf16_t)f2bf(o1[r] * f); } }
    __syncthreads();
}

constexpr int RW_NCH = S_ / 64;
constexpr int RWP = 72;
constexpr int RW_ARR = 64 * RWP * 2;
constexpr int RW_SCRP = 388;
__device__ __forceinline__ void rw_stage_weights(const KP& p, int l, int h, bf16_t* wb, int tid) {
    for (int e = tid; e < 2048; e += NTHR) { const int m = e >> 4, c4 = (e & 15) * 4;
        if (m < 32) { const f32x4 v = *(const f32x4*)(p.in[I_A2] + (l * 32 + m) * 256 + 64 * h + c4);
#pragma unroll
            for (int q = 0; q < 4; ++q) wb[(c4 + q) * 40 + m] = (bf16_t)f2bf(v[q]); }
        else if (m < 64) { const f32x4 v = *(const f32x4*)(p.in[I_W2] + (l * 32 + m - 32) * 256 + 64 * h + c4);
#pragma unroll
            for (int q = 0; q < 4; ++q) wb[2560 + (c4 + q) * 40 + (m - 32)] = (bf16_t)f2bf(v[q]); }
        else { const f32x4 v = *(const f32x4*)(p.in[I_G2] + (l * 64 + m - 64) * 256 + 64 * h + c4);
#pragma unroll
            for (int q = 0; q < 4; ++q) wb[5120 + (c4 + q) * 72 + (m - 64)] = (bf16_t)f2bf(v[q]); } }
    __syncthreads();
}
__device__ __forceinline__ bf16x8 rw_pack8(const float* q) { const f32x4 a = *(const f32x4*)q, b = *(const f32x4*)(q + 4);
    u32x4 w; w.x = pk2(a.x, a.y); w.y = pk2(a.z, a.w); w.z = pk2(b.x, b.y); w.w = pk2(b.z, b.w); return __builtin_bit_cast(bf16x8, w); }
template <int NT, bool NEED_W, bool NEED_G>
__device__ __forceinline__ void rw_prep(const KP& p, const Ptrs& P, int l, int b, int h, int tpos0, float* scr, const bf16_t* wb, int lane,
                                        float (&r)[NT], float (&lw)[NT], float (&k2)[NT], float (&v)[NT], float (&ain)[NT], float (&bin)[NT], float (&g)[NT], float (&rk)[NT]) {
    constexpr int NIT = (NT * 40 + 63) / 64;
    u32x4 cur[NIT], prv[NIT];
#pragma unroll
    for (int i = 0; i < NIT; ++i) { const int e = lane + 64 * i; const int tt = e / 40, ch = e % 40; const int t = tpos0 + tt;
        const int col = ch < 8 ? C_R + 64 * h + 8 * ch : ch < 16 ? C_K + 64 * h + 8 * (ch - 8) : ch < 24 ? C_V + 64 * h + 8 * (ch - 16) : C_HW + 8 * (ch - 24);
        cur[i] = (u32x4){0u, 0u, 0u, 0u}; prv[i] = (u32x4){0u, 0u, 0u, 0u};
        if (e < NT * 40) { const bf16_t* row = P.proj + (size_t)(b * S_ + t) * PJ + col; cur[i] = *(const u32x4*)row; if (t > 0) prv[i] = *(const u32x4*)(row - PJ); } }
#pragma unroll
    for (int i = 0; i < NIT; ++i) { const int e = lane + 64 * i; const int tt = e / 40, ch = e % 40;
        const int col = ch < 8 ? C_R + 64 * h + 8 * ch : ch < 16 ? C_K + 64 * h + 8 * (ch - 8) : ch < 24 ? C_V + 64 * h + 8 * (ch - 16) : C_HW + 8 * (ch - 24);
        const int idx = ch < 24 ? 8 * ch : 192 + 8 * (ch - 24);
        if (e < NT * 40) { const f32x4 m0 = *(const f32x4*)(p.in[I_MU] + l * 896 + col), m1 = *(const f32x4*)(p.in[I_MU] + l * 896 + col + 4);
            float z[8] = {bflo(cur[i].x), bfhi(cur[i].x), bflo(cur[i].y), bfhi(cur[i].y), bflo(cur[i].z), bfhi(cur[i].z), bflo(cur[i].w), bfhi(cur[i].w)};
            const float zp[8] = {bflo(prv[i].x), bfhi(prv[i].x), bflo(prv[i].y), bfhi(prv[i].y), bflo(prv[i].z), bfhi(prv[i].z), bflo(prv[i].w), bfhi(prv[i].w)};
#pragma unroll
            for (int q = 0; q < 8; ++q) { float zs = z[q] + (zp[q] - z[q]) * (q < 4 ? m0[q & 3] : m1[q & 3]);
                if (ch >= 24 && ch < 28) zs = 1.0f - 2.0f * FAST_RCP(1.0f + FAST_EXP2(zs * 2.8853900817779268f));
                else if (ch >= 32) zs = sigmoidf_(zs);
                z[q] = zs; }
            *(f32x4*)(scr + tt * RW_SCRP + idx) = (f32x4){z[0], z[1], z[2], z[3]}; *(f32x4*)(scr + tt * RW_SCRP + idx + 4) = (f32x4){z[4], z[5], z[6], z[7]}; } }
    WAVE_SYNC();
    { const int fr = lane & 15, fq = lane >> 4; const float* hrow = scr + (fr & 7) * RW_SCRP + 192 + 8 * fq;
      const bf16x8 fw = rw_pack8(hrow), fa = rw_pack8(hrow + 32), fg0 = rw_pack8(hrow + 64), fg1 = rw_pack8(hrow + 96);
      WAVE_SYNC();
#pragma unroll
      for (int nt = 0; nt < 4; ++nt) { const f32x4 z4 = (f32x4){0.f, 0.f, 0.f, 0.f};
          const f32x4 da = MFMA16(fa, *(const bf16x8*)(wb + (16 * nt + fr) * 40 + 8 * fq), z4);
          f32x4 dw = z4, dg = z4;
          if (NEED_W) dw = MFMA16(fw, *(const bf16x8*)(wb + 2560 + (16 * nt + fr) * 40 + 8 * fq), z4);
          if (NEED_G) { dg = MFMA16(fg0, *(const bf16x8*)(wb + 5120 + (16 * nt + fr) * 72 + 8 * fq), z4); dg = MFMA16(fg1, *(const bf16x8*)(wb + 5120 + (16 * nt + fr) * 72 + 32 + 8 * fq), dg); }
          if (fq < 2) {
#pragma unroll
              for (int q = 0; q < 4; ++q) { float* o = scr + (4 * fq + q) * RW_SCRP + 16 * nt + fr; o[192] = da[q]; if (NEED_W) o[256] = dw[q]; if (NEED_G) o[320] = dg[q]; } } }
      WAVE_SYNC(); }
    const int j = lane, cj = 64 * h + j; float wl[NT], al[NT], gg[NT];
    const float w0 = p.in[I_W0][l * 256 + cj], a0 = p.in[I_A0][l * 256 + cj];
#pragma unroll
    for (int tt = 0; tt < NT; ++tt) { al[tt] = a0 + scr[tt * RW_SCRP + 192 + j]; wl[tt] = NEED_W ? w0 + scr[tt * RW_SCRP + 256 + j] : w0; gg[tt] = NEED_G ? scr[tt * RW_SCRP + 320 + j] : 0.f; }
    const float kkw = p.in[I_KK][l * 256 + cj], kaw = p.in[I_KA][l * 256 + cj], rkw = p.in[I_RK][l * 256 + cj];
    float ssum[NT], rsum[NT], kkv[NT], av[NT];
#pragma unroll
    for (int tt = 0; tt < NT; ++tt) {
        const float a = sigmoidf_(al[tt]); av[tt] = a;
        const float rr = scr[tt * RW_SCRP + j], k = scr[tt * RW_SCRP + 64 + j], vv = scr[tt * RW_SCRP + 128 + j];
        const float kk2 = k * (1.f + (a - 1.f) * kaw);
        r[tt] = rr; k2[tt] = kk2; v[tt] = vv;
        const float kk = k * kkw; kkv[tt] = kk; ssum[tt] = kk * kk; rsum[tt] = rr * kk2 * rkw; }
    if (NEED_W) wave_sum_n<NT>(ssum);
    if (NEED_G) wave_sum_n<NT>(rsum);
#pragma unroll
    for (int tt = 0; tt < NT; ++tt) {
        if (NEED_W) { const float x = -wl[tt]; const float sp = fmaxf(x, 0.f) + 0.6931471805599453f * FAST_LOG2(1.0f + FAST_EXP2(-1.4426950408889634f * fabsf(x)));
            lw[tt] = -FAST_EXP2(-1.4426950408889634f * (sp + 0.5f));
            const float kkn = kkv[tt] * FAST_RSQ(fmaxf(ssum[tt], 1e-24f));
            ain[tt] = -kkn; bin[tt] = kkn * av[tt]; }
        if (NEED_G) { g[tt] = gg[tt]; rk[tt] = rsum[tt]; }
    }
    WAVE_SYNC();
}
__device__ __forceinline__ bf16x8 ldsb8(const bf16_t* p) { return *(const bf16x8*)p; }
__device__ __forceinline__ f32x16 rw_tile(const bf16_t* X, const bf16_t* Y, int tm, int tn, int r32, int hi, f32x16 acc) {
    const bf16_t* xa = X + (32 * tm + r32) * RWP + 8 * hi; const bf16_t* yb = Y + (32 * tn + r32) * RWP + 8 * hi;
#pragma unroll
    for (int ks = 0; ks < 4; ++ks) acc = MFMA32(ldsb8(xa + 16 * ks), ldsb8(yb + 16 * ks), acc);
    return acc;
}
template <int STOP = 0>
__device__ __forceinline__ void rw_chunk_unit(const KP& p, const Ptrs& P, int l, int unit, unsigned char* lds) {
    MEMFENCE(); OPAQUE_S(unit);
    const int c = unit % RW_NCH, bh = unit / RW_NCH, b = bh >> 2, h = bh & 3, t0 = c * 64;
    bf16_t* AT = (bf16_t*)(lds + 0 * RW_ARR); bf16_t* RT = (bf16_t*)(lds + 1 * RW_ARR); bf16_t* BT = (bf16_t*)(lds + 2 * RW_ARR); bf16_t* KT = (bf16_t*)(lds + 3 * RW_ARR);
    bf16_t* BH = (bf16_t*)(lds + 4 * RW_ARR); bf16_t* KH = (bf16_t*)(lds + 5 * RW_ARR); bf16_t* VT = (bf16_t*)(lds + 6 * RW_ARR);
    bf16_t* AAK = (bf16_t*)(lds + 7 * RW_ARR); bf16_t* ARB = (bf16_t*)(lds + 8 * RW_ARR); bf16_t* ARK = (bf16_t*)(lds + 9 * RW_ARR);
    bf16_t* W1T = (bf16_t*)(lds + 10 * RW_ARR); bf16_t* UVT = (bf16_t*)(lds + 11 * RW_ARR);
    bf16_t* RHT = (bf16_t*)(lds + 12 * RW_ARR);
    float* ADG = (float*)(lds + 14 * RW_ARR);
    bf16_t* ABA = (bf16_t*)(lds + 14 * RW_ARR + 8192);
    float* WT = (float*)(lds + 14 * RW_ARR + 8192 + 32 * RWP * 2);
    float* GC = WT + 512;
    bf16_t* DAB = AT;
    const int tid = TIDX(), lane = tid & 63, wave = tid >> 6, r32 = lane & 31, hi = lane >> 5;
    float r[8], lw[8], k2[8], v[8], ain[8], bin[8], gg[8], rk[8];
    rw_stage_weights(p, l, h, (bf16_t*)(lds + 8 * 8 * RW_SCRP * 4), tid);
    rw_prep<8, true, true>(p, P, l, b, h, t0 + 8 * wave, (float*)lds + wave * (8 * RW_SCRP), (const bf16_t*)(lds + 8 * 8 * RW_SCRP * 4), lane, r, lw, k2, v, ain, bin, gg, rk);
#pragma unroll
    for (int i = 0; i < 8; ++i) { const size_t o = (size_t)(b * S_ + t0 + 8 * wave + i) * 256 + 64 * h + lane; P.rwGt[o] = (bf16_t)f2bf(gg[i]); P.rwRKV[o] = (bf16_t)f2bf(rk[i] * v[i]); }
    float Lloc[8]; { float s = 0.f;
#pragma unroll
      for (int i = 0; i < 8; ++i) { s += lw[i]; Lloc[i] = s; } }
    __syncthreads();
    if (STOP == 1) return;
    WT[wave * 64 + lane] = Lloc[7];
    __syncthreads();
    { float off = 0.f, tot = 0.f;
#pragma unroll
      for (int w = 0; w < 8; ++w) { const float x = WT[w * 64 + lane]; tot += x; if (w < wave) off += x; }
      if (wave == 0) GC[lane] = __expf(tot);
      unsigned bhp[4], khp[4], vtp[4], atp[4]; float pb = 0.f, pk = 0.f, pv = 0.f, pa = 0.f;
#pragma unroll
      for (int i = 0; i < 8; ++i) { const int t = 8 * wave + i; const float Lt = off + Lloc[i], Lp = Lt - lw[i];
          const float eL = __expf(Lt), eLp = __expf(Lp), einv = __expf(-Lt), eh = __expf(tot - Lt);
          const float xa = ain[i] * eLp;
          AT[t * RWP + lane] = (bf16_t)f2bf(xa); RT[t * RWP + lane] = (bf16_t)f2bf(r[i] * eL);
          BT[t * RWP + lane] = (bf16_t)f2bf(bin[i] * einv); KT[t * RWP + lane] = (bf16_t)f2bf(k2[i] * einv);
          const float xb = bin[i] * eh, xk = k2[i] * eh, xv = v[i];
          if (i & 1) { bhp[i >> 1] = pk2(pb, xb); khp[i >> 1] = pk2(pk, xk); vtp[i >> 1] = pk2(pv, xv); atp[i >> 1] = pk2(pa, xa); } else { pb = xb; pk = xk; pv = xv; pa = xa; } }
      *(u32x4*)(BH + lane * RWP + 8 * wave) = (u32x4){bhp[0], bhp[1], bhp[2], bhp[3]};
      *(u32x4*)(KH + lane * RWP + 8 * wave) = (u32x4){khp[0], khp[1], khp[2], khp[3]};
      *(u32x4*)(VT + lane * RWP + 8 * wave) = (u32x4){vtp[0], vtp[1], vtp[2], vtp[3]};
      *(u32x4*)(RHT + (64 + lane) * RWP + 8 * wave) = (u32x4){atp[0], atp[1], atp[2], atp[3]}; }
    __syncthreads();
#pragma unroll
    for (int jj = 0; jj < 2; ++jj) { const int job = wave + 8 * jj, mat = job >> 2, tm = (job >> 1) & 1, tn = job & 1;
        f32x16 acc = {};
        if (!(tm == 0 && tn == 1)) acc = rw_tile((mat & 2) ? RT : AT, (mat & 1) ? KT : BT, tm, tn, r32, hi, acc);
        const int s = 32 * tn + r32;
#pragma unroll
        for (int q = 0; q < 16; ++q) { const int t = 32 * tm + (q & 3) + 8 * (q >> 2) + 4 * hi;
            const bool keep = (mat & 2) ? (s <= t) : (s < t); const float x = keep ? acc[q] : 0.f;
            if (mat == 0) { if (tm == tn) ADG[(tm * 32 + (t & 31)) * 32 + (s & 31)] = x; else if (tm == 1) ABA[(t & 31) * RWP + s] = (bf16_t)f2bf(x); } else { bf16_t* D = (mat == 1) ? AAK : (mat == 2) ? ARB : ARK; D[t * RWP + s] = (bf16_t)f2bf(x); } } }
    __syncthreads();
    if (STOP == 2) return;
    if (wave < 4) { const int tm = wave >> 1, tn = wave & 1; f32x16 acc = {}; acc = rw_tile(VT, AAK, tm, tn, r32, hi, acc);
#pragma unroll
        for (int q = 0; q < 16; ++q) { const int i = 32 * tm + (q & 3) + 8 * (q >> 2) + 4 * hi; RHT[i * RWP + 32 * tn + r32] = (bf16_t)f2bf(acc[q]); } }
    else if (wave == 4) { float d[32]; const LAS float* ab = (const LAS float*)ADG + hi * 1024;
#pragma unroll
        for (int t = 0; t < 32; ++t) d[t] = (t == r32) ? 1.f : 0.f;
#pragma unroll
        for (int t = 1; t < 32; ++t) { float s0 = 0.f, s1 = 0.f;
#pragma unroll
            for (int s4 = 0; s4 < (t + 3) / 4; ++s4) { const f32x4 a4 = *(const LAS f32x4*)(ab + t * 32 + 4 * s4);
                s0 += a4[0] * d[4 * s4]; s1 += a4[1] * d[4 * s4 + 1]; s0 += a4[2] * d[4 * s4 + 2]; s1 += a4[3] * d[4 * s4 + 3]; }
            d[t] += s0 + s1; if ((t & 3) == 3) MEMFENCE(); }
        LAS bf16_t* D = (LAS bf16_t*)DAB + hi * 32 * RWP + r32;
#pragma unroll
        for (int t = 0; t < 32; ++t) D[t * RWP] = (bf16_t)f2bf(d[t]); }
    __syncthreads();
    if (wave < 4) { bf16_t* XT = (wave < 2 ? UVT : W1T) + (32 * (wave & 1)) * RWP;
        const bf16_t* rh = RHT + (32 * wave + r32) * RWP + 8 * hi;
        { f32x16 acc = {}; const bf16_t* da = DAB + r32 * RWP + 8 * hi;
#pragma unroll
          for (int ks = 0; ks < 2; ++ks) acc = MFMA32(ldsb8(rh + 16 * ks), ldsb8(da + 16 * ks), acc);
#pragma unroll
          for (int q = 0; q < 16; ++q) XT[((q & 3) + 8 * (q >> 2) + 4 * hi) * RWP + r32] = (bf16_t)f2bf(acc[q]); }
        WAVE_SYNC();
        { f32x16 acc; const bf16_t* rz = RHT + (32 * wave) * RWP + 32 + r32;
#pragma unroll
          for (int q = 0; q < 16; ++q) acc[q] = bf2f(rz[((q & 3) + 8 * (q >> 2) + 4 * hi) * RWP]);
          const bf16_t* xa = XT + r32 * RWP + 8 * hi; const bf16_t* ba = ABA + r32 * RWP + 8 * hi;
#pragma unroll
          for (int ks = 0; ks < 2; ++ks) acc = MFMA32(ldsb8(xa + 16 * ks), ldsb8(ba + 16 * ks), acc);
#pragma unroll
          for (int q = 0; q < 16; ++q) XT[((q & 3) + 8 * (q >> 2) + 4 * hi) * RWP + 32 + r32] = (bf16_t)f2bf(acc[q]); }
        WAVE_SYNC();
        { f32x16 acc = {}; const bf16_t* xz = XT + r32 * RWP + 32 + 8 * hi; const bf16_t* db = DAB + (32 + r32) * RWP + 8 * hi;
          const bf16x8 z0 = ldsb8(xz), z1 = ldsb8(xz + 16);
          acc = MFMA32(z0, ldsb8(db), acc); acc = MFMA32(z1, ldsb8(db + 16), acc);
          WAVE_SYNC();
#pragma unroll
          for (int q = 0; q < 16; ++q) XT[((q & 3) + 8 * (q >> 2) + 4 * hi) * RWP + 32 + r32] = (bf16_t)f2bf(acc[q]); } }
    __syncthreads();
    if (STOP == 3) return;
    const size_t chunk = (size_t)unit;
#pragma unroll
    for (int jj = 0; jj < 2; ++jj) { const int job = wave + 8 * jj, kind = job >> 2, tm = (job >> 1) & 1, tn = job & 1; f32x16 acc = {};
        const int col = 32 * tn + r32;
        if (kind == 0) { acc = rw_tile(BH, W1T, tm, tn, r32, hi, acc);
            bf16_t* PT = P.rwPT + chunk * 4096;
#pragma unroll
            for (int q = 0; q < 16; ++q) { const int row = 32 * tm + (q & 3) + 8 * (q >> 2) + 4 * hi; const float x = acc[q] + (row == col ? GC[row] : 0.f); PT[row * 64 + col] = (bf16_t)f2bf(x); } }
        else if (kind == 1) { acc = rw_tile(ARB, W1T, tm, tn, r32, hi, acc);
#pragma unroll
            for (int q = 0; q < 16; ++q) { const int t = 32 * tm + (q & 3) + 8 * (q >> 2) + 4 * hi; const float x = acc[q] + bf2f(RT[t * RWP + col]);
                P.rwQ[(size_t)(b * S_ + t0 + t) * 256 + 64 * h + col] = (bf16_t)f2bf(x); } }
        else if (kind == 2) { acc = rw_tile(UVT, BH, tm, tn, r32, hi, acc); acc = rw_tile(VT, KH, tm, tn, r32, hi, acc);
            unsigned* Gg = (unsigned*)(P.rwG + chunk * 4096) + (tm * 2 + tn) * 8 * 64 + lane;
#pragma unroll
            for (int q = 0; q < 8; ++q) Gg[q * 64] = pk2(acc[2 * q], acc[2 * q + 1]); }
        else { acc = rw_tile(ARB, UVT, tm, tn, r32, hi, acc); acc = rw_tile(ARK, VT, tm, tn, r32, hi, acc);
#pragma unroll
            for (int q = 0; q < 16; ++q) { const int t = 32 * tm + (q & 3) + 8 * (q >> 2) + 4 * hi; P.ycat[(size_t)(b * S_ + t0 + t) * 1024 + 64 * h + col] = (bf16_t)f2bf(acc[q]); } } }
    __syncthreads();
}
__device__ __forceinline__ void rw_state_unit(const KP& p, const Ptrs& P, int l, int unit, unsigned char* lds) {
    bf16_t* Sb = (bf16_t*)lds;
    const int tid = TIDX(), lane = tid & 63, wave = tid >> 6, r32 = lane & 31, hi = lane >> 5;
    const int ti = (wave >> 1) & 1, tj = wave & 1;
    f32x16 S = {};
    unsigned gq[8]; bf16x8 pq[4];
    if (wave < 4) { const size_t chunk = (size_t)unit * RW_NCH; const unsigned* Gg = (const unsigned*)(P.rwG + chunk * 4096) + (ti * 2 + tj) * 8 * 64 + lane;
#pragma unroll
        for (int q = 0; q < 8; ++q) gq[q] = Gg[q * 64];
        const bf16_t* pt = P.rwPT + chunk * 4096 + (32 * tj + r32) * 64 + 8 * hi;
#pragma unroll
        for (int ks = 0; ks < 4; ++ks) pq[ks] = *(const bf16x8*)(pt + 16 * ks); }
    for (int c = 0; c < RW_NCH; ++c) { const size_t chunk = (size_t)unit * RW_NCH + c;
        unsigned gn[8]; bf16x8 pn[4];
        if (wave < 4) { const size_t cn = chunk + (c + 1 < RW_NCH ? 1 : 0); const unsigned* Gg = (const unsigned*)(P.rwG + cn * 4096) + (ti * 2 + tj) * 8 * 64 + lane;
#pragma unroll
            for (int q = 0; q < 8; ++q) gn[q] = Gg[q * 64];
            const bf16_t* pt = P.rwPT + cn * 4096 + (32 * tj + r32) * 64 + 8 * hi;
#pragma unroll
            for (int ks = 0; ks < 4; ++ks) pn[ks] = *(const bf16x8*)(pt + 16 * ks);
#pragma unroll
            for (int q = 0; q < 16; ++q) Sb[(32 * ti + (q & 3) + 8 * (q >> 2) + 4 * hi) * RWP + 32 * tj + r32] = (bf16_t)f2bf(S[q]); }
        __syncthreads();
        { const int row = tid >> 3, ch = tid & 7; *(u32x4*)(P.rwS0 + chunk * 4096 + row * 64 + ch * 8) = *(const u32x4*)(Sb + row * RWP + ch * 8); }
        if (wave < 4) { f32x16 acc;
#pragma unroll
            for (int q = 0; q < 8; ++q) { acc[2 * q] = bflo(gq[q]); acc[2 * q + 1] = bfhi(gq[q]); }
            const bf16_t* sa = Sb + (32 * ti + r32) * RWP + 8 * hi;
#pragma unroll
            for (int ks = 0; ks < 4; ++ks) acc = MFMA32(ldsb8(sa + 16 * ks), pq[ks], acc);
            S = acc;
#pragma unroll
            for (int q = 0; q < 8; ++q) gq[q] = gn[q];
#pragma unroll
            for (int ks = 0; ks < 4; ++ks) pq[ks] = pn[ks]; }
        __syncthreads();
    }
}
template <bool DUMMY = false>
__device__ __forceinline__ void rw_out_unit(const KP& p, const Ptrs& P, int l, int unit, unsigned char* lds) {
    MEMFENCE(); OPAQUE_S(unit);
    const int c = unit % RW_NCH, bh = unit / RW_NCH, b = bh >> 2, h = bh & 3, t0 = c * 64;
    float* Yb = (float*)(lds + 81920);
    const int tid = TIDX(), lane = tid & 63, wave = tid >> 6, r32 = lane & 31, hi = lane >> 5;
    float g[8], rkv[8];
#pragma unroll
    for (int i = 0; i < 8; ++i) { const size_t o = (size_t)(b * S_ + t0 + 8 * wave + i) * 256 + 64 * h + lane; g[i] = bf2f(P.rwGt[o]); rkv[i] = bf2f(P.rwRKV[o]); }
    if (wave < 4) { const int tm = wave >> 1, tn = wave & 1; f32x16 acc; const int col = 32 * tn + r32;
        const bf16_t* yl = P.ycat + (size_t)(b * S_ + t0 + 32 * tm) * 1024 + 64 * h + col;
#pragma unroll
        for (int q = 0; q < 16; ++q) acc[q] = bf2f(yl[(size_t)((q & 3) + 8 * (q >> 2) + 4 * hi) * 1024]);
        const bf16_t* qa = P.rwQ + (size_t)(b * S_ + t0 + 32 * tm + r32) * 256 + 64 * h + 8 * hi; const bf16_t* sb = P.rwS0 + (size_t)unit * 4096 + (32 * tn + r32) * 64 + 8 * hi;
#pragma unroll
        for (int ks = 0; ks < 4; ++ks) acc = MFMA32(*(const bf16x8*)(qa + 16 * ks), *(const bf16x8*)(sb + 16 * ks), acc);
#pragma unroll
        for (int q = 0; q < 16; ++q) Yb[(32 * tm + (q & 3) + 8 * (q >> 2) + 4 * hi) * 64 + col] = acc[q]; }
    __syncthreads();
    const float gng = p.in[I_LNXG][l * 256 + 64 * h + lane], gnb = p.in[I_LNXB][l * 256 + 64 * h + lane];
    { float yv[8], m1[8], m2[8];
#pragma unroll
      for (int i = 0; i < 8; ++i) { yv[i] = Yb[(8 * wave + i) * 64 + lane]; m1[i] = yv[i]; }
      wave_sum_n<8>(m1);
#pragma unroll
      for (int i = 0; i < 8; ++i) { yv[i] -= m1[i] * (1.f / 64.f); m2[i] = yv[i] * yv[i]; }
      wave_sum_n<8>(m2);
#pragma unroll
      for (int i = 0; i < 8; ++i) { const int t = 8 * wave + i; const float yn = yv[i] * (1.0f / sqrtf(m2[i] * (1.f / 64.f) + GN_EPS_)) * gng + gnb; const float o = (yn + rkv[i]) * g[i];
        if (DUMMY) P.pb[(size_t)(b * S_ + t0 + t) * 256 + 64 * h + lane] = (bf16_t)f2bf(o);
        else P.ycat[(size_t)(b * S_ + t0 + t) * 1024 + 64 * h + lane] = (bf16_t)f2bf(o); } }
    __syncthreads();
}
#ifdef EMU_FP8_A
#define EMU_AUX77 u.aux = 77;
#else
#define EMU_AUX77
#endif
__device__ __forceinline__ void tile_map(int L, int nM, int nN, int& pm, int& pn) {
    const int nwg = nM * nN, q = nwg / 8, r = nwg % 8, xcd = L % 8, off = L / 8;
    const int wgid = (xcd < r ? xcd * (q + 1) : r * (q + 1) + (xcd - r) * q) + off;
    const int nig = 8 * nN, gid = wgid / nig, fm = gid * 8, gsz = (nM - fm) < 8 ? (nM - fm) : 8;
    pm = fm + ((wgid % nig) % gsz); pn = (wgid % nig) / gsz;
}
struct EpiStoreBf16 {
    bf16_t* base0; int ldc0; bf16_t* base1; int ldc1;
    __device__ __forceinline__ void operator()(const f32x4 (&acc)[2][2][4][2], const pg8::Unit& u, int wr, int wc, int fr, int fq, int tid) const {
        bf16_t* base = u.kind ? base1 : base0; const int ldc = u.kind ? ldc1 : ldc0;
        int row0 = u.pm * 256 + wr * 64 + fr, col0 = u.pn * 256 + wc * 32 + 8 * fq; OPAQUE(row0); OPAQUE(col0);
#pragma unroll
        for (int ai = 0; ai < 2; ++ai)
#pragma unroll
            for (int m = 0; m < 4; ++m) { bf16_t* rowp = base + (size_t)(row0 + ai * 128 + m * 16) * ldc + col0;
#pragma unroll
                for (int bj = 0; bj < 2; ++bj) { const f32x4 v0 = acc[ai][bj][m][0], v1 = acc[ai][bj][m][1];
                    u32x4 w; w.x = pk2(v0[0], v0[1]); w.y = pk2(v0[2], v0[3]); w.z = pk2(v1[0], v1[1]); w.w = pk2(v1[2], v1[3]);
                    *(u32x4*)(rowp + bj * 128) = w; } }
    }
};
struct SchedA { const bf16_t* hb; const bf16_t* WinT; int G, c;
    __device__ __forceinline__ bool next(int i, pg8::Unit& u) const {
        const int nM = T_ / 256, n0 = nM * 9; const int x = i * G + c; if (x >= n0 + nM) return false;
        u.nt = 16; u.aux = 0; u.f8 = 0;
        if (x < n0) { tile_map(x, nM, 9, u.pm, u.pn); u.kind = 0; EMU_AUX77 u.a = (const char*)(hb + (size_t)u.pm * 256 * 1024); u.b = (const char*)(WinT + (size_t)u.pn * 256 * 1024); }
        else { u.pm = 0; u.pn = x - n0; u.kind = 1; u.a = (const char*)(WinT + (size_t)WIN_VT * 1024); u.b = (const char*)(hb + (size_t)u.pn * 256 * 1024); }
        return true; } };
__device__ __forceinline__ void phase_A(const KP& p, int l, unsigned char* lds) {
    const Ptrs P = make_ptrs(p.ws, l);
    SchedA S{P.hb, P.WinT, GDIM(), BIDX()};
    EpiStoreBf16 E{P.proj, PJ, P.vtr, T_};
    pg8::gemm_phase((LAS unsigned char*)lds, 1024, 1024, S, E);
}
#if PROBE_REPEAT >= 40 && PROBE_REPEAT <= 49
struct SchedAP { const bf16_t* hb; const bf16_t* WinT; int G, c, nt, pnmask;
    __device__ __forceinline__ bool next(int i, pg8::Unit& u) const {
        const int nM = T_ / 256, n0 = nM * 9; const int x = i * G + c; if (x >= n0 + nM) return false;
        u.nt = nt; u.aux = 0; u.f8 = 0;
        if (x < n0) { tile_map(x, nM, 9, u.pm, u.pn); u.kind = 0; u.a = (const char*)(hb + (size_t)u.pm * 256 * 1024); u.b = (const char*)(WinT + (size_t)u.pn * 256 * 1024); }
        else { u.pm = 0; u.pn = x - n0; u.kind = 1; u.a = (const char*)(WinT + (size_t)WIN_VT * 1024); u.b = (const char*)(hb + (size_t)u.pn * 256 * 1024); }
        u.pn &= pnmask; return true; } };
struct EpiNull { float* d;
    __device__ __forceinline__ void operator()(const f32x4 (&acc)[2][2][4][2], const pg8::Unit& u, int wr, int wc, int fr, int fq, int tid) const {
        f32x4 s = (f32x4){0.f, 0.f, 0.f, 0.f};
#pragma unroll
        for (int ai = 0; ai < 2; ++ai)
#pragma unroll
            for (int m = 0; m < 4; ++m)
#pragma unroll
                for (int bj = 0; bj < 2; ++bj) s += acc[ai][bj][m][0] + acc[ai][bj][m][1];
        if (s.x + s.y + s.z + s.w == 1.2345e30f) d[tid] = s.x; } };
struct EpiStash { u32x4* stash;
    __device__ __forceinline__ void operator()(const f32x4 (&acc)[2][2][4][2], const pg8::Unit& u, int wr, int wc, int fr, int fq, int tid) const {
        OPAQUE(tid);
#pragma unroll
        for (int ai = 0; ai < 2; ++ai)
#pragma unroll
            for (int m = 0; m < 4; ++m)
#pragma unroll
                for (int bj = 0; bj < 2; ++bj) { const f32x4 v0 = acc[ai][bj][m][0], v1 = acc[ai][bj][m][1];
                    u32x4 w; w.x = pk2(v0[0], v0[1]); w.y = pk2(v0[2], v0[3]); w.z = pk2(v1[0], v1[1]); w.w = pk2(v1[2], v1[3]);
                    stash[((ai * 4 + m) * 2 + bj) * 512 + tid] = w; } } };
template <int V>
__device__ __forceinline__ void phase_Aprobe(const KP& p, int l, unsigned char* lds) {
    const Ptrs P = make_ptrs(p.ws, l);
    SchedAP S{P.hb, P.WinT, GDIM(), BIDX(), V == 1 ? 32 : V == 3 ? 4 : V == 4 ? 8 : V == 5 ? 64 : 16, V == 6 ? 3 : 0xffff};
    if (V == 2) { EpiStash E{(u32x4*)(P.ycat + (size_t)BIDX() * 65536)}; pg8::gemm_phase((LAS unsigned char*)lds, 1024, 1024, S, E); }
    else if (V == 6) { EpiStoreBf16 E{P.ycat, 1024, P.ycat, 1024}; pg8::gemm_phase((LAS unsigned char*)lds, 1024, 1024, S, E); }
    else { EpiNull E{(float*)(P.ycat + (size_t)BIDX() * 65536)}; pg8::gemm_phase((LAS unsigned char*)lds, 1024, 1024, S, E); }
}
#endif
struct SchedGlu { const bf16_t* ycat; const bf16_t* GluT; int G, c;
    __device__ __forceinline__ bool next(int i, pg8::Unit& u) const {
        const int x = i * G + c; if (x >= T_ / 256) return false;
        u.pm = x; u.pn = 0; u.nt = 4; u.kind = 0; u.aux = 0; u.f8 = 0; u.a = (const char*)(ycat + (size_t)x * 256 * 1024 + 256); u.b = (const char*)GluT; return true; } };
struct EpiGlu { bf16_t* ycat; const float* glub;
    __device__ __forceinline__ void operator()(const f32x4 (&acc)[2][2][4][2], const pg8::Unit& u, int wr, int wc, int fr, int fq, int tid) const {
        int row0 = u.pm * 256 + wr * 64 + fr, col0 = wc * 32 + 8 * fq; OPAQUE(row0); OPAQUE(col0);
#pragma unroll
        for (int bj = 0; bj < 2; ++bj) { const f32x4 b0 = *(const f32x4*)(glub + col0 + bj * 128), b1 = *(const f32x4*)(glub + col0 + bj * 128 + 4);
#pragma unroll
            for (int ai = 0; ai < 2; ++ai)
#pragma unroll
                for (int m = 0; m < 4; ++m) { bf16_t* ptr = ycat + (size_t)(row0 + ai * 128 + m * 16) * 1024 + 256 + col0 + bj * 128;
                    const u32x4 y = *(const u32x4*)ptr; const f32x4 v0 = acc[ai][bj][m][0] + b0, v1 = acc[ai][bj][m][1] + b1;
                    u32x4 w; w.x = pk2(bflo(y.x) * sigmoidf_(v0[0]), bfhi(y.x) * sigmoidf_(v0[1])); w.y = pk2(bflo(y.y) * sigmoidf_(v0[2]), bfhi(y.y) * sigmoidf_(v0[3]));
                    w.z = pk2(bflo(y.z) * sigmoidf_(v1[0]), bfhi(y.z) * sigmoidf_(v1[1])); w.w = pk2(bflo(y.w) * sigmoidf_(v1[2]), bfhi(y.w) * sigmoidf_(v1[3]));
                    *(u32x4*)ptr = w; MEMFENCE(); } }
    }
};
__device__ __forceinline__ void convert_tables(const KP& p, const Ptrs& P, int l, unsigned char* lds) {
    const int tid = TIDX(), lane = tid & 63, wave = tid >> 6;
    unsigned* cnt = (unsigned*)(p.ws + WS_CTL) + 10240 + 16 * l; int* slot = (int*)(lds + 65536);
    const float* ps = p.in[I_P] + (size_t)l * T_ * 256;
    constexpr int NG8 = 5120 / 128, NTAB = 2 * NEXP / 128, NPB = (int)(((size_t)T_ * 256 / 8 + 4095) / 4096);
    for (;;) {
        __syncthreads(); if (tid == 0) *slot = (int)atomicAdd(cnt, 1u); __syncthreads();
        int item = *slot; if (item >= NG8 + NTAB + NPB) break;
        if (item < NG8) {
            for (int rr = wave; rr < 128; rr += NWAVE) { const int r5 = item * 128 + rr; bf16_t* row = r5 < 4096 ? P.WinT + (size_t)(WIN_GATE + r5) * 1024 : P.PleGT + (size_t)(r5 - 4096) * 1024;
                const u32x4 a = *(const u32x4*)(row + 16 * lane), b = *(const u32x4*)(row + 16 * lane + 8);
                float v[16] = {bflo(a.x), bfhi(a.x), bflo(a.y), bfhi(a.y), bflo(a.z), bfhi(a.z), bflo(a.w), bfhi(a.w), bflo(b.x), bfhi(b.x), bflo(b.y), bfhi(b.y), bflo(b.z), bfhi(b.z), bflo(b.w), bfhi(b.w)};
                float am = 0.f;
#pragma unroll
                for (int j = 0; j < 16; ++j) am = fmaxf(am, fabsf(v[j]));
                am = wave_max(am); const float sc = am > 0.f ? am * (1.0f / 440.0f) : 1.0f, inv = 1.0f / sc; u32x4 o;
#pragma unroll
                for (int j = 0; j < 4; ++j) { unsigned w = cvt_pk_fp8_f32_(v[4 * j] * inv, v[4 * j + 1] * inv, 0u, false); w = cvt_pk_fp8_f32_(v[4 * j + 2] * inv, v[4 * j + 3] * inv, w, true); o[j] = w; }
                WAVE_SYNC();
                *(u32x4*)((unsigned char*)row + 16 * lane) = o;
                if (lane == 0) P.gsc[r5] = sc; }
            continue; }
        item -= NG8;
        if (item < NTAB) {
            for (int r4 = 0; r4 < 16; r4 += 4) { f32x4 v[4][4]; float am[4];
#pragma unroll
                for (int q = 0; q < 4; ++q) { const int it = item * 128 + wave + 8 * (r4 + q); const int tb = it >= NEXP, row = tb ? it - NEXP : it;
                    const float* src = p.in[tb ? I_V : I_U] + ((size_t)l * NEXP + row) * 1024 + 16 * lane; am[q] = 0.f;
#pragma unroll
                    for (int j = 0; j < 4; ++j) { v[q][j] = *(const f32x4*)(src + 4 * j); am[q] = fmaxf(am[q], fmaxf(fmaxf(fabsf(v[q][j].x), fabsf(v[q][j].y)), fmaxf(fabsf(v[q][j].z), fabsf(v[q][j].w)))); } }
#pragma unroll
                for (int q = 0; q < 4; ++q) { const int it = item * 128 + wave + 8 * (r4 + q); const int tb = it >= NEXP, row = tb ? it - NEXP : it;
                    const float amx = wave_max(am[q]); const float sc = amx > 0.f ? amx * (1.0f / 440.0f) : 1.0f, inv = 1.0f / sc; u32x4 o;
#pragma unroll
                    for (int j = 0; j < 4; ++j) { unsigned w = cvt_pk_fp8_f32_(v[q][j].x * inv, v[q][j].y * inv, 0u, false); w = cvt_pk_fp8_f32_(v[q][j].z * inv, v[q][j].w * inv, w, true); o[j] = w; }
                    *(u32x4*)((tb ? P.V8 : P.U8) + ((size_t)(lane >> 3) * NEXP + row) * 128 + 16 * (lane & 7)) = o;
                    if (lane == 0) (tb ? P.sv : P.su)[row] = sc; } }
        } else {
            const size_t base = (size_t)(item - NTAB) * 4096;
            f32x4 a[8], bq[8];
#pragma unroll
            for (int j = 0; j < 8; ++j) { const size_t i = base + tid + (size_t)j * NTHR; a[j] = (f32x4){0.f, 0.f, 0.f, 0.f}; bq[j] = a[j];
                if (i < (size_t)T_ * 256 / 8) { a[j] = *(const f32x4*)(ps + i * 8); bq[j] = *(const f32x4*)(ps + i * 8 + 4); } }
#pragma unroll
            for (int j = 0; j < 8; ++j) { const size_t i = base + tid + (size_t)j * NTHR;
                if (i < (size_t)T_ * 256 / 8) { u32x4 o; o.x = pk2(a[j].x, a[j].y); o.y = pk2(a[j].z, a[j].w); o.z = pk2(bq[j].x, bq[j].y); o.w = pk2(bq[j].z, bq[j].w); *(u32x4*)(P.pb + i * 8) = o; } }
        }
    }
}
__device__ __forceinline__ void phase_B2(const KP& p, int l, unsigned char* lds) {
    const Ptrs P = make_ptrs(p.ws, l);
    constexpr int NRW = NB_ * 4; const int G = GDIM(), c = BIDX();
    int gG = G, gc = c;
    if (G > NRW) { if (c < NRW) { rw_state_unit(p, P, l, c, lds);
#if PROBE_REPEAT == 35
        rw_state_unit(p, P, l, c, lds);
#endif
        convert_tables(p, P, l, lds); return; } gG = G - NRW; gc = c - NRW; }
    else { for (int u = c; u < NRW; u += G) rw_state_unit(p, P, l, u, lds); }
    SchedGlu S{P.ycat, P.GluT, gG, gc};
    EpiGlu E{P.ycat, p.in[I_GLUB] + l * 256};
    pg8::gemm_phase((LAS unsigned char*)lds, 1024, 256, S, E);
    convert_tables(p, P, l, lds);
}
struct SchedC { const unsigned char* h8a; const unsigned char* h8b; const bf16_t* ycat; const bf16_t* WinT; const bf16_t* WbrT; int G, c;
    __device__ __forceinline__ bool next(int i, pg8::Unit& u) const {
        const int tile = (i >> 3) * G + c; if (tile >= (T_ / 256) * 4) return false;
        const int j = i & 7, b = j >> 1; tile_map(tile, T_ / 256, 4, u.pm, u.pn); u.aux = b;
        if (!(j & 1)) { u.kind = 0; u.nt = 4; u.f8 = 0; u.a = (const char*)(ycat + (size_t)u.pm * 256 * 1024 + 256 * b); u.b = (const char*)(WbrT + (size_t)u.pn * 256 * 1024 + 256 * b); }
        else { u.kind = 1; u.nt = 8; u.f8 = 1; const int m0 = u.pm * 256;
            u.a = (const char*)(m0 < H8_SPLIT ? h8a + (size_t)m0 * 1024 : h8b + (size_t)(m0 - H8_SPLIT) * 1024); u.b = (const char*)(WinT + (size_t)(WIN_GATE + 1024 * b + 256 * u.pn) * 1024); }
        return true; } };
struct EpiC { u32x4* stash; bf16_t* merged; const float* gsc;
    __device__ __forceinline__ void operator()(const f32x4 (&acc)[2][2][4][2], const pg8::Unit& u, int wr, int wc, int fr, int fq, int tid) const {
        OPAQUE(tid);
        if (u.kind == 0) {
#pragma unroll
            for (int ai = 0; ai < 2; ++ai)
#pragma unroll
                for (int m = 0; m < 4; ++m)
#pragma unroll
                    for (int bj = 0; bj < 2; ++bj) { const f32x4 v0 = acc[ai][bj][m][0], v1 = acc[ai][bj][m][1];
                        u32x4 w; w.x = pk2(v0[0], v0[1]); w.y = pk2(v0[2], v0[3]); w.z = pk2(v1[0], v1[1]); w.w = pk2(v1[2], v1[3]);
                        stash[((ai * 4 + m) * 2 + bj) * 512 + tid] = w; }
        } else {
            int row0 = u.pm * 256 + wr * 64 + fr, col0 = u.pn * 256 + wc * 32 + 8 * fq; OPAQUE(row0); OPAQUE(col0); const bool first = (u.aux == 0);
            f32x4 sc[2][2];
#pragma unroll
            for (int bj = 0; bj < 2; ++bj) { const float* sp = gsc + 1024 * u.aux + col0 + bj * 128; sc[bj][0] = *(const f32x4*)sp; sc[bj][1] = *(const f32x4*)(sp + 4); }
#pragma unroll
            for (int ai = 0; ai < 2; ++ai)
#pragma unroll
                for (int mp = 0; mp < 2; ++mp) { u32x4 y[4], mo[4];
#pragma unroll
                    for (int q = 0; q < 4; ++q) { const int m = 2 * mp + (q >> 1), bj = q & 1;
                        y[q] = stash[((ai * 4 + m) * 2 + bj) * 512 + tid]; mo[q] = (u32x4){0u, 0u, 0u, 0u};
                        if (!first) mo[q] = *(const u32x4*)(merged + (size_t)(row0 + ai * 128 + m * 16) * 1024 + col0 + bj * 128); }
#pragma unroll
                    for (int q = 0; q < 4; ++q) { const int m = 2 * mp + (q >> 1), bj = q & 1; const f32x4 g0 = acc[ai][bj][m][0] * sc[bj][0], g1 = acc[ai][bj][m][1] * sc[bj][1];
                        bf16_t* ptr = merged + (size_t)(row0 + ai * 128 + m * 16) * 1024 + col0 + bj * 128;
                        const float o0 = bflo(y[q].x) * sigmoidf_(g0[0]) + bflo(mo[q].x), o1 = bfhi(y[q].x) * sigmoidf_(g0[1]) + bfhi(mo[q].x), o2 = bflo(y[q].y) * sigmoidf_(g0[2]) + bflo(mo[q].y), o3 = bfhi(y[q].y) * sigmoidf_(g0[3]) + bfhi(mo[q].y);
                        const float o4 = bflo(y[q].z) * sigmoidf_(g1[0]) + bflo(mo[q].z), o5 = bfhi(y[q].z) * sigmoidf_(g1[1]) + bfhi(mo[q].z), o6 = bflo(y[q].w) * sigmoidf_(g1[2]) + bflo(mo[q].w), o7 = bfhi(y[q].w) * sigmoidf_(g1[3]) + bfhi(mo[q].w);
                        u32x4 w; w.x = pk2(o0, o1); w.y = pk2(o2, o3); w.z = pk2(o4, o5); w.w = pk2(o6, o7);
                        *(u32x4*)ptr = w; }
                    MEMFENCE(); }
        }
    }
};
__device__ __forceinline__ void phase_C(const KP& p, int l, unsigned char* lds) {
    const Ptrs P = make_ptrs(p.ws, l);
    SchedC S{P.h8a, P.h8b, P.ycat, P.WinT, P.WbrT, GDIM(), BIDX()};
    EpiC E{(u32x4*)(P.stash + (size_t)BIDX() * 131072), P.merged, P.gsc};
    pg8::gemm_phase<2>((LAS unsigned char*)lds, 1024, 1024, S, E, 1024);
}
struct SchedD { const bf16_t* A; const bf16_t* Bt; int nN, G, c;
    __device__ __forceinline__ bool next(int i, pg8::Unit& u) const {
        const int x = i * G + c; if (x >= (T_ / 256) * nN) return false;
        tile_map(x, T_ / 256, nN, u.pm, u.pn); u.nt = 16; u.kind = 0; u.aux = 0; u.f8 = 0; u.a = (const char*)(A + (size_t)u.pm * 256 * 1024); u.b = (const char*)(Bt + (size_t)u.pn * 256 * 1024); return true; } };
struct EpiResid { float* out; const bf16_t* hb;
    __device__ __forceinline__ void operator()(const f32x4 (&acc)[2][2][4][2], const pg8::Unit& u, int wr, int wc, int fr, int fq, int tid) const {
        int row0 = u.pm * 256 + wr * 64 + fr, col0 = u.pn * 256 + wc * 32 + 8 * fq; OPAQUE(row0); OPAQUE(col0);
#pragma unroll
        for (int ai = 0; ai < 2; ++ai)
#pragma unroll
            for (int m = 0; m < 4; ++m)
#pragma unroll
                for (int bj = 0; bj < 2; ++bj) { const size_t o = (size_t)(row0 + ai * 128 + m * 16) * 1024 + col0 + bj * 128; const u32x4 hw = *(const u32x4*)(hb + o);
                    const f32x4 h0 = (f32x4){bflo(hw.x), bfhi(hw.x), bflo(hw.y), bfhi(hw.y)}, h1 = (f32x4){bflo(hw.z), bfhi(hw.z), bflo(hw.w), bfhi(hw.w)};
                    *(f32x4*)(out + o) = h0 * DN_ALPHA_ + acc[ai][bj][m][0]; *(f32x4*)(out + o + 4) = h1 * DN_ALPHA_ + acc[ai][bj][m][1]; }
    }
};
__device__ __forceinline__ void phase_D(const KP& p, int l, unsigned char* lds) {
    const Ptrs P = make_ptrs(p.ws, l);
    SchedD S{P.merged, P.WoutT, 4, GDIM(), BIDX()};
    EpiResid E{p.out, P.hb};
    pg8::gemm_phase((LAS unsigned char*)lds, 1024, 1024, S, E);
}
__device__ __forceinline__ void phase_D2(const KP& p, int l, unsigned char* lds) {
    const Ptrs P = make_ptrs(p.ws, l);
    const int tid = TIDX(), lane = tid & 63, wave = tid >> 6; const int gw = BIDX() * NWAVE + wave, NGW = GDIM() * NWAVE;
    for (int m = 4 * gw; m < T_; m += 4 * NGW) ln_rows<4>(p.out + (size_t)m * 1024, p.in[I_LN1G] + l * 1024, p.in[I_LN1B] + l * 1024, (float*)nullptr, P.hb + (size_t)m * 1024, P.h8e + (size_t)m * 1024, lane);
}
struct SchedE1 { const bf16_t* pb; const bf16_t* PleT; int G, c;
    __device__ __forceinline__ bool next(int i, pg8::Unit& u) const {
        const int x = i * G + c; if (x >= (T_ / 256) * 4) return false;
        tile_map(x, T_ / 256, 4, u.pm, u.pn); u.nt = 4; u.kind = 0; u.aux = 0; u.f8 = 0; u.a = (const char*)(pb + (size_t)u.pm * 256 * 256); u.b = (const char*)(PleT + (size_t)u.pn * 256 * 256); return true; } };
template <int PART>
struct SchedE2 { const bf16_t* hb; const unsigned char* h8e; const bf16_t* PleGT; const bf16_t* WqT; int G, c;
    __device__ __forceinline__ bool next(int i, pg8::Unit& u) const {
        const int n0 = (T_ / 256) * 4; int x = i * G + c + (PART ? n0 : 0); if (x >= (PART ? n0 + (T_ / 256) * 8 : n0)) return false;
        u.aux = 0;
        if (x < n0) { tile_map(x, T_ / 256, 4, u.pm, u.pn); u.kind = 0; u.nt = 8; u.f8 = 1; u.b = (const char*)(PleGT + (size_t)u.pn * 256 * 1024); u.a = (const char*)(h8e + (size_t)u.pm * 256 * 1024); }
        else { x -= n0; tile_map(x, T_ / 256, 8, u.pm, u.pn); u.kind = 1; u.nt = 16; u.f8 = 0; u.b = (const char*)(WqT + (size_t)u.pn * 256 * 1024); u.a = (const char*)(hb + (size_t)u.pm * 256 * 1024); }
        return true; } };
struct EpiE2g { float* out; const bf16_t* hb; const bf16_t* Pbuf; const float* gsc;
    __device__ __forceinline__ void operator()(const f32x4 (&acc)[2][2][4][2], const pg8::Unit& u, int wr, int wc, int fr, int fq, int tid) const {
        int row0 = u.pm * 256 + wr * 64 + fr, col0 = u.pn * 256 + wc * 32 + 8 * fq; OPAQUE(row0); OPAQUE(col0);
#pragma unroll
        for (int bj = 0; bj < 2; ++bj) { const float* sp = gsc + 4096 + col0 + bj * 128; const f32x4 s0 = *(const f32x4*)sp, s1 = *(const f32x4*)(sp + 4);
            const size_t cb = (size_t)row0 * 1024 + col0 + bj * 128; float* op = out + cb; const bf16_t* hp = hb + cb; const bf16_t* pp = Pbuf + cb;
#pragma unroll
            for (int ai = 0; ai < 2; ++ai)
#pragma unroll
                for (int mp = 0; mp < 2; ++mp) { u32x4 y[2], hw[2];
#pragma unroll
                    for (int q = 0; q < 2; ++q) { const int ro = (ai * 128 + (2 * mp + q) * 16) * 1024; y[q] = *(const u32x4*)(pp + ro); hw[q] = *(const u32x4*)(hp + ro); }
#pragma unroll
                    for (int q = 0; q < 2; ++q) { const int m = 2 * mp + q; const int ro = (ai * 128 + m * 16) * 1024; const f32x4 v0 = acc[ai][bj][m][0] * s0, v1 = acc[ai][bj][m][1] * s1;
                        f32x4 o0, o1; o0[0] = bflo(y[q].x) * sigmoidf_(v0[0]); o0[1] = bfhi(y[q].x) * sigmoidf_(v0[1]); o0[2] = bflo(y[q].y) * sigmoidf_(v0[2]); o0[3] = bfhi(y[q].y) * sigmoidf_(v0[3]);
                        o1[0] = bflo(y[q].z) * sigmoidf_(v1[0]); o1[1] = bfhi(y[q].z) * sigmoidf_(v1[1]); o1[2] = bflo(y[q].w) * sigmoidf_(v1[2]); o1[3] = bfhi(y[q].w) * sigmoidf_(v1[3]);
                        const f32x4 h0 = (f32x4){bflo(hw[q].x), bfhi(hw[q].x), bflo(hw[q].y), bfhi(hw[q].y)}, h1 = (f32x4){bflo(hw[q].z), bfhi(hw[q].z), bflo(hw[q].w), bfhi(hw[q].w)};
                        *(f32x4*)(op + ro) = h0 * DN_ALPHA_ + o0; *(f32x4*)(op + ro + 4) = h1 * DN_ALPHA_ + o1; }
                    MEMFENCE(); } }
    }
};
__device__ __forceinline__ void phase_E(const KP& p, int l, unsigned char* lds) {
    const Ptrs P = make_ptrs(p.ws, l);
    { SchedE1 S{P.pb, P.PleT, GDIM(), BIDX()}; EpiStoreBf16 E{P.ycat, 1024, P.ycat, 1024}; pg8::gemm_phase((LAS unsigned char*)lds, 256, 256, S, E); }
    { SchedE2<0> S{P.hb, P.h8e, P.PleGT, P.WqT, GDIM(), BIDX()}; EpiE2g E{p.out, P.hb, P.ycat, P.gsc}; pg8::gemm_phase<1>((LAS unsigned char*)lds, 1024, 1024, S, E, 1024); }
    { SchedE2<1> S{P.hb, P.h8e, P.PleGT, P.WqT, GDIM(), BIDX()}; EpiStoreBf16 E{P.q, 2048, P.q, 2048}; pg8::gemm_phase<0>((LAS unsigned char*)lds, 1024, 1024, S, E); }
}
__device__ __forceinline__ unsigned mono_key(float f) { const unsigned u = __builtin_bit_cast(unsigned, f); return (u & 0x80000000u) ? ~u : (u | 0x80000000u); }
__device__ __forceinline__ float unmono_key(unsigned k) { const unsigned u = (k & 0x80000000u) ? (k ^ 0x80000000u) : ~k; return __builtin_bit_cast(float, u); }
struct CandTab { int a[50], b[50]; };
constexpr CandTab make_cand() { CandTab t{}; int n = 0; for (int a = 0; a < 16; ++a) for (int b = 0; b < 16; ++b) if ((a + 1) * (b + 1) <= 16) { t.a[n] = a; t.b[n] = b; ++n; } return t; }
constexpr CandTab CAND = make_cand();
constexpr int PK_PITCH = 136;

#define PK_CE(x, y) do { const unsigned _a = (x), _b = (y); (x) = _a > _b ? _a : _b; (y) = _a > _b ? _b : _a; } while (0)
__device__ __forceinline__ void bitonic_merge16_desc(unsigned (&a)[16]) {
#pragma unroll
    for (int j = 8; j > 0; j >>= 1)
#pragma unroll
        for (int i = 0; i < 16; ++i) { const int l = i ^ j; if (l > i) PK_CE(a[i], a[l]); }
}
__device__ __forceinline__ void bitonic_sort16_desc(unsigned (&a)[16]) {
#pragma unroll
    for (int k = 2; k <= 16; k <<= 1)
#pragma unroll
        for (int j = k >> 1; j > 0; j >>= 1)
#pragma unroll
            for (int i = 0; i < 16; ++i) { const int l = i ^ j; if (l > i) { if ((i & k) == 0 || k == 16) PK_CE(a[i], a[l]); else PK_CE(a[l], a[i]); } }
}
__device__ __forceinline__ void top_half_merge16(unsigned (&a)[16], const unsigned (&b)[16]) {
#pragma unroll
    for (int i = 0; i < 16; ++i) a[i] = a[i] > b[15 - i] ? a[i] : b[15 - i];
    bitonic_merge16_desc(a);
}
__device__ __forceinline__ void top16_keys(const unsigned (&key)[64], unsigned (&top)[16]) {
    unsigned g0[16], g1[16], g2[16], g3[16];
#pragma unroll
    for (int i = 0; i < 16; ++i) { g0[i] = key[i]; g1[i] = key[16 + i]; g2[i] = key[32 + i]; g3[i] = key[48 + i]; }
    bitonic_sort16_desc(g0); bitonic_sort16_desc(g1); bitonic_sort16_desc(g2); bitonic_sort16_desc(g3);
    top_half_merge16(g0, g1); top_half_merge16(g2, g3); top_half_merge16(g0, g2);
    unsigned pr[16];
#pragma unroll
    for (int i = 0; i < 16; ++i) pr[i] = (unsigned)__shfl_xor((int)g0[i], 32);
    top_half_merge16(g0, pr);
#pragma unroll
    for (int i = 0; i < 16; ++i) top[i] = g0[i];
}
__device__ __forceinline__ void peer_route_unit(const KP& p, const Ptrs& P, int l, int unit, unsigned char* lds) {
    const bf16_t* Ks = (const bf16_t*)lds;
    const int tid = TIDX(), lane = tid & 63, wave = tid >> 6, r32 = lane & 31, hi = lane >> 5;
    const int tok = unit * 32 + r32;
    int kbase = r32 * PK_PITCH + 8 * hi; OPAQUE(kbase);
    unsigned top1[16], top2[16];
#pragma unroll 1
    for (int half = 0; half < 2; ++half) {
        const bf16_t* qp = P.q + (size_t)tok * 2048 + wave * 256 + half * 128 + 8 * hi;
        bf16x8 qf[8];
#pragma unroll
        for (int ks = 0; ks < 8; ++ks) qf[ks] = *(const bf16x8*)(qp + 16 * ks);
        unsigned key[64];
#pragma unroll
        for (int kt = 0; kt < 4; ++kt) { f32x16 acc = {}; const bf16_t* kp = Ks + (half * 128 + 32 * kt) * PK_PITCH + kbase;
#pragma unroll
            for (int ks = 0; ks < 8; ++ks) { const bf16x8 a = *(const bf16x8*)(kp + 16 * ks); acc = MFMA32(a, qf[ks], acc); }
#pragma unroll
            for (int r = 0; r < 16; ++r) { const int idx = 32 * kt + (r & 3) + 8 * (r >> 2) + 4 * hi; key[16 * kt + r] = (mono_key(acc[r]) & ~127u) | (unsigned)(127 - idx); } }
        if (half == 0) top16_keys(key, top1); else top16_keys(key, top2);
        MEMFENCE();
    }
    MEMFENCE();
    int* islot = (int*)(lds + 2 * 128 * PK_PITCH * 2) + (wave * 32 + r32) * 33;
    float v1[16], v2[16];
#pragma unroll
    for (int r = 0; r < 16; ++r) { v1[r] = unmono_key(top1[r] & ~127u); v2[r] = unmono_key(top2[r] & ~127u); islot[16 * hi + r] = 127 - (int)((hi ? top2[r] : top1[r]) & 127u); }
    unsigned ka[16], kb[16];
#pragma unroll
    for (int i = 0; i < 25; ++i) { const int c0 = 2 * i, c1 = 2 * i + 1;
        const float s = hi ? (v1[CAND.a[c1]] + v2[CAND.b[c1]]) : (v1[CAND.a[c0]] + v2[CAND.b[c0]]);
        const unsigned k = (mono_key(s) & ~255u) | (unsigned)(255 - (hi ? 16 * CAND.a[c1] + CAND.b[c1] : 16 * CAND.a[c0] + CAND.b[c0]));
        if (i < 16) ka[i] = k; else kb[i - 16] = k; }
#pragma unroll
    for (int i = 9; i < 16; ++i) kb[i] = 0u;
    bitonic_sort16_desc(ka); bitonic_sort16_desc(kb); top_half_merge16(ka, kb);
    { unsigned pr[16];
#pragma unroll
      for (int i = 0; i < 16; ++i) pr[i] = (unsigned)__shfl_xor((int)ka[i], 32);
      top_half_merge16(ka, pr); }
    WAVE_SYNC();
    float sc[16]; int se[16];
#pragma unroll
    for (int r = 0; r < 16; ++r) { sc[r] = unmono_key(ka[r] & ~255u); se[r] = 0; }
#pragma unroll
    for (int r = 0; r < 8; ++r) { unsigned mlo = ka[r], mhi = ka[8 + r]; OPAQUE(mlo); OPAQUE(mhi);
        const unsigned m = hi ? mhi : mlo; const int ab = 255 - (int)(m & 255u); const int e = islot[ab >> 4] * 128 + islot[16 + (ab & 15)];
        if (hi) se[8 + r] = e; else se[r] = e; }
    WAVE_SYNC();
    float g[16]; float sum = 0.f;
#pragma unroll
    for (int r = 0; r < 16; ++r) { g[r] = __expf(sc[r] - sc[0]); sum += g[r]; }
    const float inv = 1.0f / sum;
    const size_t ob = (size_t)tok * 128 + wave * 16 + 8 * hi;
    if (hi == 0) {
        *(u32x4*)(P.eid + ob) = (u32x4){(unsigned)se[0], (unsigned)se[1], (unsigned)se[2], (unsigned)se[3]}; *(u32x4*)(P.eid + ob + 4) = (u32x4){(unsigned)se[4], (unsigned)se[5], (unsigned)se[6], (unsigned)se[7]};
        *(f32x4*)(P.gate + ob) = (f32x4){g[0] * inv, g[1] * inv, g[2] * inv, g[3] * inv}; *(f32x4*)(P.gate + ob + 4) = (f32x4){g[4] * inv, g[5] * inv, g[6] * inv, g[7] * inv};
    } else {
        *(u32x4*)(P.eid + ob) = (u32x4){(unsigned)se[8], (unsigned)se[9], (unsigned)se[10], (unsigned)se[11]}; *(u32x4*)(P.eid + ob + 4) = (u32x4){(unsigned)se[12], (unsigned)se[13], (unsigned)se[14], (unsigned)se[15]};
        *(f32x4*)(P.gate + ob) = (f32x4){g[8] * inv, g[9] * inv, g[10] * inv, g[11] * inv}; *(f32x4*)(P.gate + ob + 4) = (f32x4){g[12] * inv, g[13] * inv, g[14] * inv, g[15] * inv};
    }
}
__device__ __forceinline__ void phase_F(const KP& p, int l, unsigned char* lds) {
    const Ptrs P = make_ptrs(p.ws, l);
    bf16_t* Ks = (bf16_t*)lds; const int tid = TIDX();
    for (int e = tid; e < 2 * 128 * 16; e += NTHR) { const int row = e >> 4, ch = e & 15; *(u32x4*)(Ks + row * PK_PITCH + ch * 8) = *(const u32x4*)(P.K12 + row * 128 + ch * 8); }
    __syncthreads();
    for (int u = BIDX(); u < T_ / 32; u += GDIM()) peer_route_unit(p, P, l, u, lds);
    __syncthreads();
}
constexpr int PG_TB = (T_ >= 4096 ? 128 : 64), PG_NBLK = T_ / PG_TB;
__device__ __forceinline__ int peer_next_item(unsigned* cnt, int* slot, int tid) {
    __syncthreads();
    if (tid == 0) *slot = (int)atomicAdd(cnt, 1u);
    __syncthreads();
    return *slot;
}
constexpr int PG_TPW = PG_TB / NWAVE;
constexpr int PG_WLDS = 6144;
__device__ __forceinline__ void pg_issue_rows(const unsigned char* T8, int x, int c8, int gq, int lane, int e0, int e1, int* E, u32x4 (&rb)[16]) {
    WAVE_SYNC(); E[lane] = e0; E[64 + lane] = e1; WAVE_SYNC();
#pragma unroll
    for (int k = 0; k < 16; ++k) { const unsigned off = ((unsigned)(x * NEXP) + (unsigned)E[gq + 8 * k]) * 128u + 16u * (unsigned)c8; rb[k] = *(const u32x4*)(T8 + off); }
}
__device__ __forceinline__ void pg_dots_compute(const Ptrs& P, int x, int t, const u32x4 (&ub)[16], u32x4 xa, u32x4 xb, float* R, int lane) {
    const f32x2 x0 = (f32x2){bflo(xa.x), bfhi(xa.x)}, x1 = (f32x2){bflo(xa.y), bfhi(xa.y)}, x2 = (f32x2){bflo(xa.z), bfhi(xa.z)}, x3 = (f32x2){bflo(xa.w), bfhi(xa.w)};
    const f32x2 x4 = (f32x2){bflo(xb.x), bfhi(xb.x)}, x5 = (f32x2){bflo(xb.y), bfhi(xb.y)}, x6 = (f32x2){bflo(xb.z), bfhi(xb.z)}, x7 = (f32x2){bflo(xb.w), bfhi(xb.w)};
    WAVE_SYNC();
#pragma unroll
    for (int k = 0; k < 16; ++k) { f32x2 s = cvt_pk_f32_fp8_(ub[k][0], false) * x0; s += cvt_pk_f32_fp8_(ub[k][0], true) * x1; s += cvt_pk_f32_fp8_(ub[k][1], false) * x2; s += cvt_pk_f32_fp8_(ub[k][1], true) * x3;
        s += cvt_pk_f32_fp8_(ub[k][2], false) * x4; s += cvt_pk_f32_fp8_(ub[k][2], true) * x5; s += cvt_pk_f32_fp8_(ub[k][3], false) * x6; s += cvt_pk_f32_fp8_(ub[k][3], true) * x7;
        R[k * 64 + lane] = s.x + s.y; }
    WAVE_SYNC();
    const f32x4 a0 = *(const f32x4*)(R + 8 * lane), a1 = *(const f32x4*)(R + 8 * lane + 4), b0 = *(const f32x4*)(R + 512 + 8 * lane), b1 = *(const f32x4*)(R + 512 + 8 * lane + 4);
    float* pd = P.pd + ((size_t)x * T_ + t) * 128;
    pd[lane] = ((a0[0] + a0[1]) + (a0[2] + a0[3])) + ((a1[0] + a1[1]) + (a1[2] + a1[3]));
    pd[64 + lane] = ((b0[0] + b0[1]) + (b0[2] + b0[3])) + ((b1[0] + b1[1]) + (b1[2] + b1[3]));
}
__device__ __forceinline__ void peer_dots_item(const Ptrs& P, int x, int blk, unsigned char* lds, int lane, int wave) {
    float* R = (float*)(lds + wave * PG_WLDS); int* E = (int*)(lds + wave * PG_WLDS + 4096);
    const int gq = lane >> 3, c8 = lane & 7, tb = blk * PG_TB + PG_TPW * wave;
    u32x4 uA[16], uB[16], xa0, xb0, xa1, xb1;
    const bf16_t* xp = P.hb + (size_t)tb * 1024 + 128 * x + 16 * c8; const int* ep = P.eid + (size_t)tb * 128 + lane;
    int ea0 = ep[0], ea1 = ep[64], eb0 = ep[128], eb1 = ep[192];
    pg_issue_rows(P.U8, x, c8, gq, lane, ea0, ea1, E, uA); xa0 = *(const u32x4*)xp; xb0 = *(const u32x4*)(xp + 8);
#pragma unroll 1
    for (int i = 0; i < PG_TPW; i += 2) {
        pg_issue_rows(P.U8, x, c8, gq, lane, eb0, eb1, E, uB); xa1 = *(const u32x4*)(xp + (size_t)(i + 1) * 1024); xb1 = *(const u32x4*)(xp + (size_t)(i + 1) * 1024 + 8);
        if (i + 2 < PG_TPW) { ea0 = ep[(i + 2) * 128]; ea1 = ep[(i + 2) * 128 + 64]; }
        pg_dots_compute(P, x, tb + i, uA, xa0, xb0, R, lane);
        if (i + 2 < PG_TPW) { pg_issue_rows(P.U8, x, c8, gq, lane, ea0, ea1, E, uA); xa0 = *(const u32x4*)(xp + (size_t)(i + 2) * 1024); xb0 = *(const u32x4*)(xp + (size_t)(i + 2) * 1024 + 8); }
        if (i + 3 < PG_TPW) { eb0 = ep[(i + 3) * 128]; eb1 = ep[(i + 3) * 128 + 64]; }
        pg_dots_compute(P, x, tb + i + 1, uB, xa1, xb1, R, lane);
    }
}
__device__ __forceinline__ void pg_acc_compute(float* outp, int x, int t, const u32x4 (&vb)[16], float w0, float w1, f32x2 oprev, float* C, float* W, int gq, int lane) {
    WAVE_SYNC(); W[lane] = w0; W[64 + lane] = w1; WAVE_SYNC();
    f32x2 acc[8];
#pragma unroll
    for (int q = 0; q < 8; ++q) acc[q] = (f32x2){0.f, 0.f};
#pragma unroll
    for (int k = 0; k < 16; ++k) { const float wk = W[gq + 8 * k];
#pragma unroll
        for (int q = 0; q < 4; ++q) { acc[2 * q] += cvt_pk_f32_fp8_(vb[k][q], false) * wk; acc[2 * q + 1] += cvt_pk_f32_fp8_(vb[k][q], true) * wk; } }
    WAVE_SYNC();
#pragma unroll
    for (int q = 0; q < 4; ++q) *(f32x4*)(C + lane * 16 + 4 * q) = (f32x4){acc[2 * q].x, acc[2 * q].y, acc[2 * q + 1].x, acc[2 * q + 1].y};
    WAVE_SYNC();
    f32x2 s = (f32x2){0.f, 0.f};
#pragma unroll
    for (int g = 0; g < 8; ++g) s += *(const f32x2*)(C + g * 128 + 2 * lane);
    float* o = outp + (size_t)t * 1024 + 128 * x + 2 * lane; *(f32x2*)o = oprev + s;
}
__device__ __forceinline__ void peer_acc_item(float* outp, const Ptrs& P, int x, int blk, unsigned char* lds, int lane, int wave) {
    float* C = (float*)(lds + wave * PG_WLDS); int* E = (int*)(lds + wave * PG_WLDS + 4096); float* W = (float*)(lds + wave * PG_WLDS + 4608);
    const int gq = lane >> 3, c8 = lane & 7, tb = blk * PG_TB + PG_TPW * wave;
    u32x4 vA[16], vB[16]; f32x2 oA, oB;
    const int* ep = P.eid + (size_t)tb * 128 + lane; const float* wp = P.gate + (size_t)tb * 128 + lane; const float* op = outp + (size_t)tb * 1024 + 128 * x + 2 * lane;
    int ea0 = ep[0], ea1 = ep[64], eb0 = ep[128], eb1 = ep[192]; float wa0 = wp[0], wa1 = wp[64], wb0 = wp[128], wb1 = wp[192];
    pg_issue_rows(P.V8, x, c8, gq, lane, ea0, ea1, E, vA); oA = *(const f32x2*)op;
#pragma unroll 1
    for (int i = 0; i < PG_TPW; i += 2) {
        pg_issue_rows(P.V8, x, c8, gq, lane, eb0, eb1, E, vB); oB = *(const f32x2*)(op + (size_t)(i + 1) * 1024);
        if (i + 2 < PG_TPW) { ea0 = ep[(i + 2) * 128]; ea1 = ep[(i + 2) * 128 + 64]; }
        pg_acc_compute(outp, x, tb + i, vA, wa0, wa1, oA, C, W, gq, lane);
        if (i + 2 < PG_TPW) { wa0 = wp[(i + 2) * 128]; wa1 = wp[(i + 2) * 128 + 64]; pg_issue_rows(P.V8, x, c8, gq, lane, ea0, ea1, E, vA); oA = *(const f32x2*)(op + (size_t)(i + 2) * 1024); }
        if (i + 3 < PG_TPW) { eb0 = ep[(i + 3) * 128]; eb1 = ep[(i + 3) * 128 + 64]; }
        pg_acc_compute(outp, x, tb + i + 1, vB, wb0, wb1, oB, C, W, gq, lane);
        if (i + 3 < PG_TPW) { wb0 = wp[(i + 3) * 128]; wb1 = wp[(i + 3) * 128 + 64]; }
    }
}
template <int STAGE, int CSET = STAGE>
__device__ __forceinline__ void phase_G12(const KP& p, int l, unsigned char* lds) {
    const Ptrs P = make_ptrs(p.ws, l);
    const int tid = TIDX(), lane = tid & 63, wave = tid >> 6;
    int* slot = (int*)(lds + 8 * PG_WLDS);
    const int myx = XCC_ID();
    for (int s = 0; s < 8; ++s) { const int x = (myx + s) & 7; unsigned* cnt = P.qcnt + (CSET * 8 + x) * 16;
        for (;;) { const int blk = peer_next_item(cnt, slot, tid); if (blk >= PG_NBLK) break;
            if (STAGE == 0) peer_dots_item(P, x, blk, lds, lane, wave); else peer_acc_item(CSET == 3 ? P.pd : p.out, P, x, blk, lds, lane, wave); } }
    __syncthreads();
}
__device__ __forceinline__ void phase_G1b(const KP& p, int l, unsigned char* lds) {
    const Ptrs P = make_ptrs(p.ws, l);
    for (size_t i = (size_t)BIDX() * NTHR + TIDX(); i < (size_t)T_ * 128; i += (size_t)GDIM() * NTHR) { float d = 0.f;
#pragma unroll
        for (int x = 0; x < 8; ++x) d += P.pd[(size_t)x * T_ * 128 + i];
        const int e = P.eid[i]; P.gate[i] = P.gate[i] * P.sv[e] * gelu_erf(d * P.su[e]); }
#ifdef CPU_EMU
    (void)lds;
#endif
}
__device__ __forceinline__ void phase_G3(const KP& p, int l, unsigned char* lds, bool last) {
    const Ptrs P = make_ptrs(p.ws, l);
    const int tid = TIDX(), lane = tid & 63, wave = tid >> 6; const int gw = BIDX() * NWAVE + wave, NGW = GDIM() * NWAVE;
    for (int m = 4 * gw; m < T_; m += 4 * NGW) ln_rows<4>(p.out + (size_t)m * 1024, p.in[I_LN2G] + l * 1024, p.in[I_LN2B] + l * 1024, last ? p.out + (size_t)m * 1024 : (float*)nullptr, last ? (bf16_t*)nullptr : P.hb + (size_t)m * 1024,
                                                           last ? (unsigned char*)nullptr : (m < H8_SPLIT ? P.h8a + (size_t)m * 1024 : P.h8b + (size_t)(m - H8_SPLIT) * 1024), lane);
}
#ifndef PROBE_REPEAT
#define PROBE_REPEAT 0
#endif
constexpr int LDS_BYTES = 147456;
__device__ __forceinline__ void phase_B1(const KP& p, int l, unsigned char* lds) {
    const Ptrs P = make_ptrs(p.ws, l);
    constexpr int NRC = NB_ * 4 * RW_NCH, NS5 = NB_ * 16, NFX = NB_ * 4 * (S_ / 256), NCV = T_ / 64;
    const int G = GDIM(); int it = BIDX();
    for (; it < NRC; it += G) rw_chunk_unit(p, P, l, it, lds);
#if PROBE_REPEAT == 16
    for (int j = BIDX(); j < NRC; j += G) rw_chunk_unit(p, P, l, j, lds);
#endif
#if PROBE_REPEAT >= 161 && PROBE_REPEAT <= 163
    for (int j = BIDX(); j < NRC; j += G) { rw_chunk_unit<PROBE_REPEAT - 160>(p, P, l, j, lds); __syncthreads(); }
#endif
    for (; it < NRC + NFX; it += G) fox_unit(p, P, l, it - NRC, lds);
#if PROBE_REPEAT == 17
    for (int j = BIDX(); j < NFX; j += G) fox_unit(p, P, l, j, lds);
#endif
    for (; it < NRC + NFX + NS5; it += G) s5_unit(p, P, l, it - NRC - NFX, lds);
#if PROBE_REPEAT == 18
    for (int j = BIDX(); j < NS5; j += G) s5_unit(p, P, l, j, lds);
#endif
    for (; it < NRC + NFX + NS5 + NCV; it += G) conv_unit(p, P, l, it - NRC - NFX - NS5, lds);
#if PROBE_REPEAT == 19
    for (int j = BIDX(); j < NCV; j += G) conv_unit(p, P, l, j, lds);
#endif
}
__device__ __forceinline__ void phase_B3(const KP& p, int l, unsigned char* lds) {
    const Ptrs P = make_ptrs(p.ws, l);
#if PROBE_REPEAT == 34
    for (int it = BIDX(); it < NB_ * 4 * RW_NCH; it += GDIM()) rw_out_unit<true>(p, P, l, it, lds);
#endif
    for (int it = BIDX(); it < NB_ * 4 * RW_NCH; it += GDIM()) rw_out_unit<false>(p, P, l, it, lds);
}
enum { PH_PRO = 0, PH_A, PH_B1, PH_B2, PH_B3, PH_C, PH_D, PH_D2, PH_E, PH_F, PH_G, PH_G1B, PH_G2, PH_G3, PH_N };
__device__ __forceinline__ void run_phase(const KP& p, int ph, int l, unsigned char* lds) {
    switch (ph) {
        case PH_PRO: phase_prologue(p, lds); break;
        case PH_A: phase_A(p, l, lds); break;
        case PH_B1: phase_B1(p, l, lds); break;
        case PH_B2: phase_B2(p, l, lds); break;
        case PH_B3: phase_B3(p, l, lds); break;
        case PH_C: phase_C(p, l, lds); break;
        case PH_D: phase_D(p, l, lds); break;
        case PH_D2: phase_D2(p, l, lds); break;
        case PH_E: phase_E(p, l, lds); break;
        case PH_F: phase_F(p, l, lds); break;
        case PH_G: phase_G12<0>(p, l, lds); break;
        case PH_G1B: phase_G1b(p, l, lds); break;
        case PH_G2: phase_G12<1>(p, l, lds); break;
        case PH_G3: phase_G3(p, l, lds, l == L_ - 1); break;
        default: break;
    }
}
#ifndef CPU_EMU
#define XB_TMO      128
#define XB_XCNT(j)  (256  + 64 * (j))
#define XB_XSUB(j)  (1280 + 64 * (j))
#define XB_XGEN(j)  (2304 + 64 * (j))
#define XB_TOP      3328
#define XB_TOPGEN   3392
#define XCD_BAR_WORDS 3456
#define XB_SPIN_CAP (1u << 22)
__device__ __forceinline__ unsigned xb_ld(unsigned* p)              { return __hip_atomic_load(p, __ATOMIC_RELAXED, __HIP_MEMORY_SCOPE_AGENT); }
__device__ __forceinline__ unsigned xb_add(unsigned* p, unsigned v) { return __hip_atomic_fetch_add(p, v, __ATOMIC_RELAXED, __HIP_MEMORY_SCOPE_AGENT); }
__device__ __forceinline__ unsigned xb_xcc_id() { return (unsigned)__builtin_amdgcn_s_getreg((3 << 11) | 20) & 0xFu; }
#define XB_SPIN(cond, bar) do { unsigned _sp = 0; while (cond) { __builtin_amdgcn_s_sleep(1); \
    if ((++_sp & 255u) == 0u) { if (xb_ld(&(bar)[XB_TMO])) break; if (_sp > XB_SPIN_CAP) { atomicAdd(&(bar)[XB_TMO], 1u); break; } } } } while (0)
struct XcdBarrier { unsigned* bar; unsigned x; volatile LAS unsigned* st; };
__device__ __forceinline__ XcdBarrier xcd_barrier_post(unsigned* bar, volatile LAS unsigned* st) {
    XcdBarrier b; b.bar = bar; b.x = xb_xcc_id(); b.st = st;
    if (threadIdx.x == 0) (void)xb_add(&bar[XB_XCNT(b.x)], 1u);
    return b;
}
__device__ __forceinline__ void xcd_barrier_complete(unsigned* bar, unsigned x, unsigned& nloc, unsigned& nx) {
    const unsigned G = gridDim.x * gridDim.y * gridDim.z;
    unsigned sum, cnt, mine, sp = 0u;
    for (;;) {
        sum = 0u; cnt = 0u; mine = 0u;
#pragma unroll
        for (unsigned j = 0; j < 16; ++j) { const unsigned c = xb_ld(&bar[XB_XCNT(j)]); sum += c; cnt += (c > 0u) ? 1u : 0u; mine = (j == x) ? c : mine; }
        if (sum == G) break;
        __builtin_amdgcn_s_sleep(1);
        if ((++sp & 255u) == 0u) { if (xb_ld(&bar[XB_TMO])) break; if (sp > XB_SPIN_CAP) { atomicAdd(&bar[XB_TMO], 1u); break; } }
    }
    nloc = mine > 0u ? mine : 1u; nx = cnt > 0u ? cnt : 1u;
}
__device__ __forceinline__ void xcd_barrier(const XcdBarrier& b) {
    asm volatile("s_waitcnt vmcnt(0)" ::: "memory");
    __syncthreads();
    if (threadIdx.x == 0) {
        unsigned* bar = b.bar;
        __builtin_amdgcn_s_waitcnt(0);
        unsigned nloc = b.st[0], nx = b.st[1];
        if (nloc == 0u) { xcd_barrier_complete(bar, b.x, nloc, nx); b.st[0] = nloc; b.st[1] = nx; }
        const unsigned old = xb_add(&bar[XB_XSUB(b.x)], 1u);
        const unsigned gen = old / nloc;
        if (old + 1u == (gen + 1u) * nloc) {
            __builtin_amdgcn_fence(__ATOMIC_RELEASE, "agent");
            asm volatile("s_waitcnt vmcnt(0)" ::: "memory");
            const unsigned og = xb_add(&bar[XB_TOP], 1u);
            const unsigned tg = og / nx;
            if (og + 1u == (tg + 1u) * nx) xb_add(&bar[XB_TOPGEN], 1u);
            else XB_SPIN(xb_ld(&bar[XB_TOPGEN]) == tg, bar);
            __builtin_amdgcn_fence(__ATOMIC_ACQUIRE, "agent");
            xb_add(&bar[XB_XGEN(b.x)], 1u);
            asm volatile("s_waitcnt vmcnt(0)" ::: "memory");
        } else {
            XB_SPIN(xb_ld(&bar[XB_XGEN(b.x)]) == gen, bar);
            __builtin_amdgcn_fence(__ATOMIC_ACQUIRE, "agent");
            asm volatile("s_waitcnt vmcnt(0)" ::: "memory");
        }
    }
    __syncthreads();
}
#ifndef PROBE_REPEAT
#define PROBE_REPEAT 0
#endif
#ifndef N_LAUNCH_MODE
#define N_LAUNCH_MODE 1
#endif
extern __shared__ __attribute__((aligned(16))) unsigned char lds_dyn[];
#if N_LAUNCH_MODE == 0
template <int PH> __global__ void __launch_bounds__(NTHR, 2) k_phase_t(KP p) { run_phase(p, PH, p.layer, lds_dyn); }
typedef void (*kfn_t)(KP);
static kfn_t phase_fn(int ph) { switch (ph) { case PH_PRO: return k_phase_t<PH_PRO>; case PH_A: return k_phase_t<PH_A>; case PH_B1: return k_phase_t<PH_B1>; case PH_B2: return k_phase_t<PH_B2>; case PH_B3: return k_phase_t<PH_B3>; case PH_C: return k_phase_t<PH_C>;
    case PH_D: return k_phase_t<PH_D>; case PH_D2: return k_phase_t<PH_D2>; case PH_E: return k_phase_t<PH_E>; case PH_F: return k_phase_t<PH_F>; case PH_G: return k_phase_t<PH_G>; case PH_G1B: return k_phase_t<PH_G1B>; case PH_G2: return k_phase_t<PH_G2>; default: return k_phase_t<PH_G3>; } }
#else
#ifndef USE_XCD_BARRIER
#define USE_XCD_BARRIER 1
#endif
constexpr int BAR_LDS_OFF = LDS_BYTES - 64;
#if USE_XCD_BARRIER
#define GSYNC() xcd_barrier(bar)
#define GSYNC_ARG const XcdBarrier& bar
#else
#define GSYNC() grid.sync()
#define GSYNC_ARG cg::grid_group& grid
#endif
template <int l>
__device__ __forceinline__ void mega_layer(const KP& p, GSYNC_ARG) {
        phase_A(p, l, lds_dyn);
#if PROBE_REPEAT == 1
        GSYNC(); phase_A(p, l, lds_dyn);
#endif
#if PROBE_REPEAT >= 40 && PROBE_REPEAT <= 49
        GSYNC(); phase_Aprobe<PROBE_REPEAT - 40>(p, l, lds_dyn);
#endif
        GSYNC(); phase_B1(p, l, lds_dyn);
#if PROBE_REPEAT == 2
        GSYNC(); phase_B1(p, l, lds_dyn);
#endif
        GSYNC(); phase_B2(p, l, lds_dyn);
        GSYNC(); phase_B3(p, l, lds_dyn);
        GSYNC(); phase_C(p, l, lds_dyn);
#if PROBE_REPEAT == 4
        GSYNC(); phase_C(p, l, lds_dyn);
#endif
        GSYNC(); phase_D(p, l, lds_dyn);
        GSYNC(); phase_D2(p, l, lds_dyn);
        GSYNC(); phase_E(p, l, lds_dyn);
        GSYNC(); phase_F(p, l, lds_dyn);
#if PROBE_REPEAT == 8
        GSYNC(); phase_F(p, l, lds_dyn);
#endif
        GSYNC(); phase_G12<0>(p, l, lds_dyn);
#if PROBE_REPEAT == 32
        GSYNC(); phase_G12<0, 2>(p, l, lds_dyn);
#endif
        GSYNC(); phase_G1b(p, l, lds_dyn);
        GSYNC(); phase_G12<1>(p, l, lds_dyn);
#if PROBE_REPEAT == 33
        GSYNC(); phase_G12<1, 3>(p, l, lds_dyn);
#endif
        GSYNC(); phase_G3(p, l, lds_dyn, l == L_ - 1);
}
__global__ void __launch_bounds__(NTHR, 2) k_mega(KP p) {
    cg::grid_group grid = cg::this_grid();
#if USE_XCD_BARRIER
    volatile LAS unsigned* st = (volatile LAS unsigned*)(lds_dyn + BAR_LDS_OFF);
    if (threadIdx.x < 2) st[threadIdx.x] = 0u;
    __syncthreads();
    const XcdBarrier bar = xcd_barrier_post((unsigned*)(p.ws + WS_CTL) + 4096, st);
#define GSYNC_VAL bar
#else
#define GSYNC_VAL grid
#endif
    phase_prologue(p, lds_dyn);
    grid.sync();
    mega_layer<0>(p, GSYNC_VAL);
    static_assert(L_ == 2, "two layers");
    GSYNC();
    mega_layer<1>(p, GSYNC_VAL);
}
#endif
extern "C" void kernel_launch(void* const* d_in, const int* in_sizes, int n_in, void* d_out, int out_size, void* d_ws, size_t ws_size, hipStream_t stream) {
    static int grid = 0;
    if (grid == 0) {
        if (n_in != N_IN || out_size != T_ * 1024 || ws_size < WS_END) { fprintf(stderr, "kernel_launch: unexpected shapes (n_in %d out %d ws %zu need %zu)\n", n_in, out_size, ws_size, (size_t)WS_END); grid = -1; return; }
        int dev = 0, cus = 0, per_cu = 0;
        (void)hipGetDevice(&dev); (void)hipDeviceGetAttribute(&cus, hipDeviceAttributeMultiprocessorCount, dev);
#if N_LAUNCH_MODE == 0
        for (int ph = 0; ph < PH_N; ++ph) (void)hipFuncSetAttribute((const void*)phase_fn(ph), hipFuncAttributeMaxDynamicSharedMemorySize, LDS_BYTES);
        (void)per_cu;
#else
        (void)hipFuncSetAttribute((const void*)k_mega, hipFuncAttributeMaxDynamicSharedMemorySize, LDS_BYTES);
        (void)hipOccupancyMaxActiveBlocksPerMultiprocessor(&per_cu, (const void*)k_mega, NTHR, LDS_BYTES);
        if (per_cu < 1) { fprintf(stderr, "kernel_launch: occupancy query says %d blocks per CU\n", per_cu); grid = -1; return; }
#endif
        grid = cus;
    }
    if (grid < 0) return;
    if (hipMemsetAsync((char*)d_ws + WS_CTL, 0, 65536, stream) != hipSuccess) { fprintf(stderr, "kernel_launch: memset failed\n"); return; }
    KP p{};
    for (int i = 0; i < N_IN; ++i) p.in[i] = (const float*)d_in[i];
    p.out = (float*)d_out; p.ws = (unsigned char*)d_ws;
#if N_LAUNCH_MODE == 1
    void* args[] = {&p};
    hipError_t e = hipLaunchCooperativeKernel((const void*)k_mega, dim3(grid), dim3(NTHR), args, LDS_BYTES, stream);
    if (e != hipSuccess) fprintf(stderr, "cooperative launch failed: %s (grid %d)\n", hipGetErrorString(e), grid);
#else
    p.phase = PH_PRO; p.layer = 0; hipLaunchKernelGGL(phase_fn(PH_PRO), dim3(grid), dim3(NTHR), LDS_BYTES, stream, p);
    for (int l = 0; l < L_; ++l) for (int ph = PH_A; ph < PH_N; ++ph) { p.phase = ph; p.layer = l; hipLaunchKernelGGL(phase_fn(ph), dim3(grid), dim3(NTHR), LDS_BYTES, stream, p); }
#endif
}
#endif
```

```cpp
#ifdef CPU_EMU
#include "emu.h"
#define LAS
#define GET_LDS() ((unsigned char*)emu::lds())
#define AS_GLOBAL(p) (p)
#define AS_LDS(p) (p)
#define RFL(x) (x)
#define MFMA32(a, b, c) emu_mfma32(a, b, c)
#define MFMA16(a, b, c) emu_mfma16(a, b, c)
#define MFMA16_FP8(a, b, c) emu_mfma16_fp8(a, b, c)
#define FAST_EXP2(x) exp2f(x)
#define FAST_RCP(x) (1.0f / (x))
#define FAST_LOG2(x) log2f(x)
#define FAST_RSQ(x) (1.0f / sqrtf(x))
#define WAVE_SYNC() do { uint32_t _z = 0; (void)emu::wave_xchg(&_z, 1); } while (0)
#define OPAQUE(x) do {} while (0)
#define GLDS16(gp, lp, lane) memcpy((char*)(lp) + 16 * (lane), (const void*)(gp), 16)
#define WAIT_VM(n) do {} while (0)
#define GLOAD16_ASM(dst, ptr) (dst) = *(const u32x4*)(ptr)
#define GLOAD4_ASM(dst, ptr) (dst) = *(const int*)(ptr)
#define PIN4(a, b, c, d) do {} while (0)
#define PIN2I(a, b) do {} while (0)
#define WAIT_LGKM0() do {} while (0)
#define READLANE_I(v, l) __shfl((int)(v), (l))
#define READLANE_F(v, l) __shfl((float)(v), (l))
#define TIDX() ((int)threadIdx.x)
#define XCC_ID() (emu::bid() & 7)
#define GDIM() ((int)gridDim.x)
#define BIDX() ((int)blockIdx.x)
#define OPAQUE_S(x) do {} while (0)
#define MEMFENCE() do {} while (0)
#else
#include <hip/hip_runtime.h>
#include <hip/hip_cooperative_groups.h>
#include <cstdio>
#include <cstdint>
namespace cg = cooperative_groups;
#define LAS __attribute__((address_space(3)))
#define GAS __attribute__((address_space(1)))
#define AS_GLOBAL(p) ((unsigned char*)(GAS unsigned char*)(p))
#define AS_LDS(p) ((unsigned char*)(LAS unsigned char*)(p))
#define RFL(x) __builtin_amdgcn_readfirstlane(x)
#define MFMA32(a, b, c) __builtin_amdgcn_mfma_f32_32x32x16_bf16(a, b, c, 0, 0, 0)
#define MFMA16(a, b, c) __builtin_amdgcn_mfma_f32_16x16x32_bf16(a, b, c, 0, 0, 0)
#define MFMA16_FP8(a, b, c) __builtin_amdgcn_mfma_f32_16x16x32_fp8_fp8((long)(a), (long)(b), c, 0, 0, 0)
#define MFMA16_F8X128(a, b, c) __builtin_amdgcn_mfma_scale_f32_16x16x128_f8f6f4(a, b, c, 0, 0, 0, 0, 0, 0)
#define FAST_EXP2(x) __builtin_amdgcn_exp2f(x)
#define FAST_RCP(x) __builtin_amdgcn_rcpf(x)
#define FAST_LOG2(x) __builtin_amdgcn_logf(x)
#define FAST_RSQ(x) __builtin_amdgcn_rsqf(x)
#define WAVE_SYNC() __builtin_amdgcn_wave_barrier()
#define OPAQUE(x) asm volatile("" : "+v"(x))
#define GLDS16(gp, lp, lane) __builtin_amdgcn_global_load_lds((const unsigned*)(gp), (LAS unsigned*)(lp), 16, 0, 0)
#define WAIT_VM(n) asm volatile("s_waitcnt vmcnt(" #n ")" ::: "memory")
#define GLOAD16_ASM(dst, ptr) asm volatile("global_load_dwordx4 %0, %1, off" : "=v"(dst) : "v"(ptr) : "memory")
#define GLOAD4_ASM(dst, ptr) asm volatile("global_load_dword %0, %1, off" : "=v"(dst) : "v"(ptr) : "memory")
#define PIN4(a, b, c, d) asm volatile("" : "+v"(a), "+v"(b), "+v"(c), "+v"(d) :: "memory")
#define PIN2I(a, b) asm volatile("" : "+v"(a), "+v"(b) :: "memory")
#define WAIT_LGKM0() asm volatile("s_waitcnt lgkmcnt(0)" ::: "memory")
#define READLANE_I(v, l) __builtin_amdgcn_readlane((int)(v), (l))
#define READLANE_F(v, l) __builtin_bit_cast(float, __builtin_amdgcn_readlane(__builtin_bit_cast(int, (float)(v)), (l)))
#define OPAQUE_S(x) asm volatile("" : "+s"(x))
__device__ __forceinline__ int opaque_tid_() { int t = threadIdx.x; asm volatile("" : "+v"(t)); return t; }
#define TIDX() opaque_tid_()
#define XCC_ID() ((int)(__builtin_amdgcn_s_getreg((3 << 11) | 20) & 7u))
__device__ __forceinline__ int opaque_gdim_() { int t = gridDim.x; asm volatile("" : "+s"(t)); return t; }
__device__ __forceinline__ int opaque_bidx_() { int t = blockIdx.x; asm volatile("" : "+s"(t)); return t; }
#define GDIM() opaque_gdim_()
#define BIDX() opaque_bidx_()
#define MEMFENCE() do { asm volatile("" ::: "memory"); __builtin_amdgcn_sched_barrier(0); } while (0)
#endif

#ifndef CFG_B
#define CFG_B 16
#endif
#ifndef CFG_S
#define CFG_S 2048
#endif

typedef unsigned short bf16_t;
typedef short bf16x8 __attribute__((ext_vector_type(8)));
typedef short s16x4 __attribute__((ext_vector_type(4)));
typedef float f32x4 __attribute__((ext_vector_type(4)));
typedef float f32x2 __attribute__((ext_vector_type(2)));
typedef float f32x16 __attribute__((ext_vector_type(16)));
typedef unsigned u32x4 __attribute__((ext_vector_type(4)));
typedef unsigned u32x2 __attribute__((ext_vector_type(2)));
typedef int i32x4 __attribute__((ext_vector_type(4)));
typedef int i32x8 __attribute__((ext_vector_type(8)));

constexpr int NB_ = CFG_B, S_ = CFG_S, T_ = NB_ * S_, D_ = 1024, L_ = 2;
constexpr int NTHR = 512, NWAVE = 8;
constexpr int PJ = 2304;
constexpr int C_R = 0, C_K = 256, C_V = 512, C_HW = 768, C_HA = 800, C_HG = 832, C_S5 = 896, C_FQ = 1152, C_FK = 1408, C_FL = 1664, C_CV = 1792, C_CG = 2048;
constexpr int WIN_ROWS = 6656, WIN_VT = 2304, WIN_GATE = 2560;
constexpr int IN_COLS = 6532;
constexpr float LN_EPS_ = 1e-5f, GN_EPS_ = 64e-5f;
constexpr float DN_ALPHA_ = 1.4142135623730951f;
constexpr int NEXP = 16384;

enum { I_X = 0, I_P, I_LNIN_G, I_LNIN_B, I_WIN, I_MU, I_W0, I_W2, I_A0, I_A2, I_G2, I_KK, I_KA, I_RK, I_LNXG, I_LNXB, I_LRE, I_LIM, I_BRE, I_BIM, I_CRE, I_CIM,
       I_S5D, I_LDT, I_GLUW, I_GLUB, I_BF, I_CONVW, I_CONVB, I_CLNG, I_CLNB, I_WBR, I_WOUT, I_LN1G, I_LN1B, I_WQ, I_K1, I_K2, I_U, I_V, I_PLEW, I_PLEG, I_LN2G, I_LN2B, N_IN };

constexpr size_t al256(size_t x) { return (x + 255) & ~(size_t)255; }
constexpr size_t WS_CTL = 0;
constexpr size_t WS_WIN = 1u << 20;
constexpr size_t WS_WBR = WS_WIN + al256((size_t)L_ * WIN_ROWS * 1024 * 2);
constexpr size_t WS_WOUT = WS_WBR + (size_t)L_ * 1024 * 1024 * 2;
constexpr size_t WS_WQ = WS_WOUT + (size_t)L_ * 1024 * 1024 * 2;
constexpr size_t WS_PLE = WS_WQ + (size_t)L_ * 2048 * 1024 * 2;
constexpr size_t WS_PLEG = WS_PLE + (size_t)L_ * 1024 * 256 * 2;
constexpr size_t WS_GLU = WS_PLEG + (size_t)L_ * 1024 * 1024 * 2;
constexpr size_t WS_K12 = WS_GLU + (size_t)L_ * 256 * 256 * 2;
constexpr size_t WS_S5KC = WS_K12 + (size_t)L_ * 2 * 128 * 128 * 2;
constexpr size_t WS_S5WX = WS_S5KC + (size_t)L_ * 16 * 64 * 256 * 2;
constexpr size_t WS_S5WY = WS_S5WX + (size_t)L_ * 16 * 128 * 1024 * 2;
constexpr size_t WS_S5LL = WS_S5WY + (size_t)L_ * 16 * 1024 * 128 * 2;
constexpr size_t WS_UT = WS_S5LL + al256((size_t)L_ * 16 * 64 * 2 * 4);
constexpr size_t WS_VT = WS_UT + (size_t)NEXP * 1024 * 2;
constexpr size_t WS_RW = WS_VT + (size_t)NEXP * 1024 * 2;
constexpr size_t RW_SZ = (size_t)T_ * 512;
static_assert(2 * RW_SZ <= (size_t)NEXP * 1024 * 2, "RWKV gate / bonus arrays fit the second table region");
constexpr size_t WS_HB = WS_RW + 4 * RW_SZ;
constexpr size_t WS_R1 = WS_HB + (size_t)T_ * 1024 * 2;
constexpr size_t R1_BYTES = (size_t)T_ * 2560 * 2;
constexpr size_t WS_YC = WS_R1 + R1_BYTES;
constexpr size_t WS_VTR = WS_YC + (size_t)T_ * 1024 * 2;
constexpr size_t WS_PB = WS_VTR + (size_t)256 * T_ * 2;
constexpr size_t WS_H8T = WS_PB + (size_t)T_ * 256 * 2;
constexpr int H8_SPLIT = (T_ / 512) * 256;
constexpr size_t WS_END = WS_H8T + (size_t)(T_ - H8_SPLIT) * 1024;
constexpr size_t R1_PROJ = 0;
constexpr size_t R1_H8 = (size_t)T_ * 2304 * 2;
constexpr size_t R1_MERGED = 0;
constexpr size_t R1_STASH = (size_t)T_ * 1024 * 2;
constexpr size_t R1_Q = 0;
constexpr size_t R1_EID = (size_t)T_ * 2048 * 2;
constexpr size_t R1_GATE = R1_EID + (size_t)T_ * 128 * 4;
static_assert(R1_GATE + (size_t)T_ * 128 * 4 <= R1_BYTES, "R1 map");

struct KP { const float* in[N_IN]; float* out; unsigned char* ws; float* dbg; int layer; int phase; };

#ifdef CPU_EMU
__device__ __forceinline__ unsigned f2bf(float f) { unsigned u = __builtin_bit_cast(unsigned, f); return (u + 0x7fffu + ((u >> 16) & 1u)) >> 16; }
__device__ __forceinline__ unsigned pk2(float lo, float hi) { return f2bf(lo) | (f2bf(hi) << 16); }
#else
typedef __bf16 bf16x2_hw __attribute__((ext_vector_type(2)));
__device__ __forceinline__ unsigned pk2(float lo, float hi) { const f32x2 v = {lo, hi}; return __builtin_bit_cast(unsigned, __builtin_convertvector(v, bf16x2_hw)); }
__device__ __forceinline__ unsigned f2bf(float f) { return pk2(f, 0.f) & 0xffffu; }
#endif
__device__ __forceinline__ float bf2f(unsigned h) { return __builtin_bit_cast(float, h << 16); }
__device__ __forceinline__ float bflo(unsigned w) { return __builtin_bit_cast(float, w << 16); }
__device__ __forceinline__ float bfhi(unsigned w) { return __builtin_bit_cast(float, w & 0xffff0000u); }
__device__ __forceinline__ float sigmoidf_(float x) { return FAST_RCP(1.0f + FAST_EXP2(x * -1.4426950408889634f)); }
__device__ __forceinline__ float gelu_erf(float v) { return 0.5f * v * (1.0f + erff(v * 0.70710678118654752f)); }
#ifdef CPU_EMU
inline float fp8_dec_(unsigned b) { const unsigned s = b >> 7, e = (b >> 3) & 15, m = b & 7; float v = (e == 0) ? ldexpf((float)m, -9) : ldexpf(1.f + m * 0.125f, (int)e - 7); return s ? -v : v; }
inline unsigned fp8_enc_(float x) { const unsigned s = x < 0.f ? 0x80u : 0u; float a = fabsf(x); if (!(a > 0.f)) return s; if (a > 448.f) a = 448.f;
    int e; (void)frexpf(a, &e); e -= 1; if (e < -6) e = -6;
    const float q = ldexpf(a, 3 - e); float r = nearbyintf(q);
    unsigned ee, mm; if (e == -6 && r < 8.f) { ee = 0; mm = (unsigned)r; } else { if (r >= 16.f) { r = 8.f; e += 1; } ee = (unsigned)(e + 7); mm = (unsigned)r - 8u; }
    if (ee > 15u || (ee == 15u && mm > 6u)) { ee = 15u; mm = 6u; }
    return s | (ee << 3) | mm; }
inline f32x2 cvt_pk_f32_fp8_(unsigned w, bool hi) { const unsigned h = hi ? (w >> 16) : w; return (f32x2){fp8_dec_(h & 255u), fp8_dec_((h >> 8) & 255u)}; }
inline unsigned cvt_pk_fp8_f32_(float a, float b, unsigned old, bool hi) { const unsigned p = fp8_enc_(a) | (fp8_enc_(b) << 8); return hi ? ((old & 0xffffu) | (p << 16)) : ((old & 0xffff0000u) | p); }
#else
__device__ __forceinline__ f32x2 cvt_pk_f32_fp8_(unsigned w, bool hi) { return hi ? __builtin_amdgcn_cvt_pk_f32_fp8((int)w, true) : __builtin_amdgcn_cvt_pk_f32_fp8((int)w, false); }
__device__ __forceinline__ unsigned cvt_pk_fp8_f32_(float a, float b, unsigned old, bool hi) { return hi ? (unsigned)__builtin_amdgcn_cvt_pk_fp8_f32(a, b, (int)old, true) : (unsigned)__builtin_amdgcn_cvt_pk_fp8_f32(a, b, (int)old, false); }
#endif
__device__ __forceinline__ float wave_max(float v) {
#pragma unroll
  for (int o = 1; o < 64; o <<= 1) v = fmaxf(v, __shfl_xor(v, o));
  return v;
}
template <int N> __device__ __forceinline__ void wave_sum_n(float (&v)[N]) {
#pragma unroll
  for (int o = 1; o < 64; o <<= 1) { float t[N];
#pragma unroll
    for (int i = 0; i < N; ++i) t[i] = __shfl_xor(v[i], o);
#pragma unroll
    for (int i = 0; i < N; ++i) v[i] += t[i]; }
}
__device__ __forceinline__ float wave_sum(float v) {
#pragma unroll
  for (int o = 1; o < 64; o <<= 1) v += __shfl_xor(v, o);
  return v;
}
namespace pg8 {
constexpr int BM = 256, BK = 64, HALF = 128, HTB = HALF * BK * 2, STAGE_BYTES = 8 * HTB;
__host__ __device__ __forceinline__ int lds_byte(int r, int c) { const int st = (r >> 4) * 2 + (c >> 5), rr = r & 15, cc = c & 31, ob = rr * 64 + cc * 2; return st * 1024 + (ob ^ (((ob >> 9) & 1) << 5)); }
__host__ __device__ __forceinline__ void stage_rc(int b, int& R, int& C) { const int st = b / 1024, sb = b % 1024, swz = sb ^ (((sb >> 9) & 1) << 5); R = (st >> 1) * 16 + swz / 64; C = (st & 1) * 32 + (swz % 64) / 2; }
__host__ __device__ __forceinline__ int perm32(int rho) { const int n = rho >> 4, i = rho & 15; return 8 * (i >> 2) + 4 * n + (i & 3); }

struct Unit { const char* a; const char* b; int nt; int kind; int pm; int pn; int aux; int f8; };

#ifndef CPU_EMU
template <int MODE = 0, class Epi, class Sched>
__device__ __forceinline__ void gemm_phase(LAS unsigned char* lds, const int lda, const int ldb, const Sched& S, const Epi& E, const int lda8 = 0) {
    const int tid = TIDX(), wid = __builtin_amdgcn_readfirstlane(tid >> 6), lane = tid & 63, wr = wid >> 2, wc = wid & 3, fr = lane & 15, fq = lane >> 4;
    unsigned voffA[2], voffB[2], voffA8[2];
#pragma unroll
    for (int i = 0; i < 2; ++i) { int R, C; stage_rc(tid * 16 + i * 8192, R, C); const int Rb = (R & ~31) + perm32(R & 31);
        voffA[i] = (unsigned)(R * lda + C) * 2u; voffB[i] = (unsigned)(Rb * ldb + C) * 2u; voffA8[i] = (unsigned)(R * lda8 + C * 2); }
    const size_t kstep = (size_t)(BK * 2);
    const size_t hstepA = (size_t)HALF * lda * 2, hstepB = (size_t)HALF * ldb * 2, hstepA8 = (size_t)HALF * lda8;
    const unsigned ldsw = (unsigned)wid * 1024u;
    const int aoff = lds_byte(wr * 64 + fr, fq * 8), boff = lds_byte(wc * 32 + fr, fq * 8);
#define PG8_SA(b, h) (((b) * 2 + (h)) * HTB)
#define PG8_SB(b, h) ((4 + (b) * 2 + (h)) * HTB)
#define PG8_STAGE(bufoff, gbase, voff) do { _Pragma("unroll") for (int _i = 0; _i < 2; ++_i) \
        __builtin_amdgcn_global_load_lds((const unsigned*)((const char*)(gbase) + (voff)[_i]), (LAS unsigned*)(lds + (bufoff) + ldsw + _i * 8192), 16, 0, 0); } while (0)
#define PG8_LDA(dst, b, h) do { _Pragma("unroll") for (int m = 0; m < 4; ++m) _Pragma("unroll") for (int k = 0; k < 2; ++k) dst[m][k] = *(const LAS bf16x8*)(lds + PG8_SA(b, h) + aoff + m * 2048 + k * 1024); } while (0)
#define PG8_LDB(dst, b, h) do { _Pragma("unroll") for (int n = 0; n < 2; ++n) _Pragma("unroll") for (int k = 0; k < 2; ++k) dst[n][k] = *(const LAS bf16x8*)(lds + PG8_SB(b, h) + boff + n * 2048 + k * 1024); } while (0)
#define PG8_MMA(ai, bj, At, Bt) do { __builtin_amdgcn_s_setprio(1); _Pragma("unroll") for (int m = 0; m < 4; ++m) _Pragma("unroll") for (int n = 0; n < 2; ++n) _Pragma("unroll") for (int k = 0; k < 2; ++k) \
        acc[ai][bj][m][n] = __builtin_amdgcn_mfma_f32_16x16x32_bf16(Bt[n][k], At[m][k], acc[ai][bj][m][n], 0, 0, 0); __builtin_amdgcn_s_setprio(0); } while (0)
#define PG8_CAT(x, y) __builtin_shufflevector(__builtin_bit_cast(i32x4, x), __builtin_bit_cast(i32x4, y), 0, 1, 2, 3, 4, 5, 6, 7)
#define PG8_LDA8(dst, b, h) do { _Pragma("unroll") for (int m = 0; m < 4; ++m) dst[m] = PG8_CAT(*(const LAS bf16x8*)(lds + PG8_SA(b, h) + aoff + m * 2048), *(const LAS bf16x8*)(lds + PG8_SA(b, h) + aoff + m * 2048 + 1024)); } while (0)
#define PG8_LDB8(dst, b, h) do { _Pragma("unroll") for (int n = 0; n < 2; ++n) dst[n] = PG8_CAT(*(const LAS bf16x8*)(lds + PG8_SB(b, h) + boff + n * 2048), *(const LAS bf16x8*)(lds + PG8_SB(b, h) + boff + n * 2048 + 1024)); } while (0)
#define PG8_MMA8(ai, bj, A8, B8) do { __builtin_amdgcn_s_setprio(1); _Pragma("unroll") for (int m = 0; m < 4; ++m) _Pragma("unroll") for (int n = 0; n < 2; ++n) \
        acc[ai][bj][m][n] = MFMA16_F8X128(B8[n], A8[m], acc[ai][bj][m][n]); __builtin_amdgcn_s_setprio(0); } while (0)
#define PG8_WAIT_V(n) asm volatile("s_waitcnt vmcnt(" #n ")" ::: "memory")
#define PG8_WAIT_L(n) asm volatile("s_waitcnt lgkmcnt(" #n ")" ::: "memory")
#define PG8_BAR __builtin_amdgcn_s_barrier()
#define PG8_SCHED __builtin_amdgcn_sched_barrier(0)
    Unit cur, nxt; int ui = 0;
    if (!S.next(0, cur)) return;
    f32x4 acc[2][2][4][2];
#pragma unroll
    for (int a = 0; a < 2; ++a)
#pragma unroll
        for (int b = 0; b < 2; ++b)
#pragma unroll
            for (int m = 0; m < 4; ++m)
#pragma unroll
                for (int n = 0; n < 2; ++n) acc[a][b][m][n] = (f32x4){0.f, 0.f, 0.f, 0.f};
    bf16x8 At[4][2], B0[2][2], B1[2][2];
    const char* cA = cur.a; const char* cB = cur.b; int cf8 = MODE == 2 ? cur.f8 : MODE; size_t chA = cf8 ? hstepA8 : hstepA;
    { unsigned v0[2] = {cf8 ? voffA8[0] : voffA[0], cf8 ? voffA8[1] : voffA[1]};
    PG8_STAGE(PG8_SB(0, 0), cB, voffB); PG8_STAGE(PG8_SB(0, 1), cB + hstepB, voffB); PG8_STAGE(PG8_SA(0, 0), cA, v0); PG8_STAGE(PG8_SA(0, 1), cA + chA, v0);
    if (wr == 1) PG8_BAR;
    PG8_WAIT_V(2); PG8_BAR;
    PG8_STAGE(PG8_SB(1, 0), cB + kstep, voffB); PG8_STAGE(PG8_SA(1, 0), cA + kstep, v0); PG8_STAGE(PG8_SB(1, 1), cB + hstepB + kstep, voffB);
    PG8_WAIT_V(6); PG8_BAR; }
    for (;;) {
        const bool has_next = S.next(ui + 1, nxt);
        const char* nA = has_next ? nxt.a : cA; const char* nB = has_next ? nxt.b : cB; const int nf8 = MODE == 2 ? (has_next ? nxt.f8 : cf8) : MODE;
        int nt = cur.nt; asm volatile("" : "+s"(nt));
#define PG8_KLOOP(LDA_, LDB_, MM_, At_, B0_, B1_, CF8) \
        for (int t = 0; t < nt; t += 2) { \
            const bool last = (t == nt - 2); \
            const char* a1 = cA + (size_t)(t + 1) * kstep; \
            const char* a2 = last ? nA : cA + (size_t)(t + 2) * kstep; const char* b2 = last ? nB : cB + (size_t)(t + 2) * kstep; \
            const char* a3 = a2 + kstep; const char* b3 = b2 + kstep; \
            const int f2 = last ? nf8 : CF8; const size_t h2 = f2 ? hstepA8 : hstepA; \
            OPAQUE_S(a1); OPAQUE_S(a2); OPAQUE_S(a3); OPAQUE_S(b2); OPAQUE_S(b3); \
            const unsigned vA[2] = {CF8 ? voffA8[0] : voffA[0], CF8 ? voffA8[1] : voffA[1]}, vA2[2] = {f2 ? voffA8[0] : voffA[0], f2 ? voffA8[1] : voffA[1]}, vB[2] = {voffB[0], voffB[1]}; \
            LDB_(B0_, 0, 0); LDB_(B1_, 0, 1); PG8_SCHED; LDA_(At_, 0, 0); PG8_STAGE(PG8_SA(1, 1), a1 + (CF8 ? hstepA8 : hstepA), vA); \
            PG8_WAIT_V(8); PG8_WAIT_L(0); PG8_BAR; MM_(0, 0, At_, B0_); MM_(0, 1, At_, B1_); PG8_BAR; PG8_SCHED; \
            LDA_(At_, 0, 1); PG8_STAGE(PG8_SB(0, 0), b2, vB); PG8_STAGE(PG8_SB(0, 1), b2 + hstepB, vB); PG8_STAGE(PG8_SA(0, 0), a2, vA2); \
            PG8_WAIT_V(8); PG8_WAIT_L(0); PG8_BAR; MM_(1, 0, At_, B0_); MM_(1, 1, At_, B1_); PG8_BAR; PG8_SCHED; \
            LDB_(B0_, 1, 0); LDB_(B1_, 1, 1); PG8_SCHED; LDA_(At_, 1, 0); PG8_STAGE(PG8_SA(0, 1), a2 + h2, vA2); \
            PG8_WAIT_V(8); PG8_WAIT_L(0); PG8_BAR; MM_(0, 0, At_, B0_); MM_(0, 1, At_, B1_); PG8_BAR; PG8_SCHED; \
            LDA_(At_, 1, 1); PG8_STAGE(PG8_SB(1, 0), b3, vB); PG8_STAGE(PG8_SB(1, 1), b3 + hstepB, vB); PG8_STAGE(PG8_SA(1, 0), a3, vA2); \
            PG8_WAIT_V(8); PG8_WAIT_L(0); PG8_BAR; MM_(1, 0, At_, B0_); MM_(1, 1, At_, B1_); PG8_BAR; PG8_SCHED; \
        }
        if (MODE == 1 || (MODE == 2 && cf8)) { i32x8 A8[4], B08[2], B18[2]; PG8_KLOOP(PG8_LDA8, PG8_LDB8, PG8_MMA8, A8, B08, B18, 1) }
        else { PG8_KLOOP(PG8_LDA, PG8_LDB, PG8_MMA, At, B0, B1, 0) }
#undef PG8_KLOOP
        if (wr == 0) PG8_BAR;
        E(acc, cur, wr, wc, fr, fq, tid);
        if (!has_next) break;
#pragma unroll
        for (int a = 0; a < 2; ++a)
#pragma unroll
            for (int b = 0; b < 2; ++b)
#pragma unroll
                for (int m = 0; m < 4; ++m)
#pragma unroll
                    for (int n = 0; n < 2; ++n) acc[a][b][m][n] = (f32x4){0.f, 0.f, 0.f, 0.f};
        cur = nxt; cA = nA; cB = nB; cf8 = nf8; ++ui;
        if (wr == 1) PG8_BAR;
    }
    PG8_WAIT_V(0);
    PG8_BAR;
#undef PG8_SA
#undef PG8_SB
#undef PG8_STAGE
#undef PG8_LDA
#undef PG8_LDB
#undef PG8_MMA
#undef PG8_MMA8
#undef PG8_LDA8
#undef PG8_LDB8
#undef PG8_CAT
#undef PG8_WAIT_V
#undef PG8_WAIT_L
#undef PG8_BAR
#undef PG8_SCHED
}
#else
template <int MODE = 0, class Epi, class Sched>
inline void gemm_phase(unsigned char* lds, const int lda, const int ldb, const Sched& S, const Epi& E, const int lda8 = 0) {
    const int tid = TIDX(), wid = tid >> 6, lane = tid & 63, wr = wid >> 2, wc = wid & 3, fr = lane & 15, fq = lane >> 4;
    Unit cur;
    for (int ui = 0; S.next(ui, cur); ++ui) {
        f32x4 acc[2][2][4][2];
        const bf16_t* A = (const bf16_t*)cur.a; const bf16_t* Bt = (const bf16_t*)cur.b; const int K = cur.nt * 64;
        for (int ai = 0; ai < 2; ++ai) for (int bj = 0; bj < 2; ++bj) for (int m = 0; m < 4; ++m) for (int n = 0; n < 2; ++n) for (int e = 0; e < 4; ++e) {
            const int r = 128 * ai + 64 * wr + 16 * m + fr, c = 128 * bj + 32 * wc + 8 * fq + 4 * n + e; float s = 0.f;
            const bf16_t* ar = A + (size_t)r * lda; const bf16_t* br = Bt + (size_t)c * ldb;
            if (cur.f8) { const unsigned char* a8 = (const unsigned char*)cur.a + (size_t)r * lda8; const unsigned char* b8 = (const unsigned char*)cur.b + (size_t)c * ldb * 2;
                for (int k = 0; k < cur.nt * 128; ++k) s += fp8_dec_(a8[k]) * fp8_dec_(b8[k]); }
#ifdef EMU_FP8_A
            else if (cur.aux == 77) { float am = 0.f; for (int k = 0; k < K; ++k) am = fmaxf(am, fabsf(bf2f(br[k]))); const float sc = am > 0.f ? am / 440.f : 1.f;
                for (int k = 0; k < K; ++k) s += fp8_dec_(fp8_enc_(bf2f(ar[k]))) * fp8_dec_(fp8_enc_(bf2f(br[k]) / sc)); s *= sc; }
#endif
            else for (int k = 0; k < K; ++k) s += bf2f(ar[k]) * bf2f(br[k]);
            acc[ai][bj][m][n][e] = s; }
        __syncthreads();
        E(acc, cur, wr, wc, fr, fq, tid);
        __syncthreads();
    }
    __syncthreads();
}
#endif
}
struct Ptrs {
    bf16_t *WinT, *WbrT, *WoutT, *WqT, *PleT, *PleGT, *GluT, *K12, *S5Kc, *S5Wx, *S5Wy, *Ut, *Vt, *hb, *proj, *merged, *q, *ycat, *vtr, *pb;
    float *S5LL, *gate; int* eid; unsigned char* stash; bf16_t *rwPT, *rwG, *rwS0, *rwQ, *rwGt, *rwRKV; unsigned char *U8, *V8; float *su, *sv, *pd; unsigned* qcnt; unsigned char *h8a, *h8b, *h8e; float *gsc, *gscA;
};
__device__ __forceinline__ Ptrs make_ptrs(unsigned char* ws, int l) {
    Ptrs P; { size_t zoff = 0; OPAQUE_S(zoff); ws += zoff; }
    P.WinT = (bf16_t*)(ws + WS_WIN) + (size_t)l * WIN_ROWS * 1024; P.WbrT = (bf16_t*)(ws + WS_WBR) + (size_t)l * 1024 * 1024; P.WoutT = (bf16_t*)(ws + WS_WOUT) + (size_t)l * 1024 * 1024;
    P.WqT = (bf16_t*)(ws + WS_WQ) + (size_t)l * 2048 * 1024; P.PleT = (bf16_t*)(ws + WS_PLE) + (size_t)l * 1024 * 256; P.PleGT = (bf16_t*)(ws + WS_PLEG) + (size_t)l * 1024 * 1024;
    P.GluT = (bf16_t*)(ws + WS_GLU) + (size_t)l * 256 * 256; P.K12 = (bf16_t*)(ws + WS_K12) + (size_t)l * 2 * 128 * 128;
    P.S5Kc = (bf16_t*)(ws + WS_S5KC) + (size_t)l * 16 * 64 * 256; P.S5Wx = (bf16_t*)(ws + WS_S5WX) + (size_t)l * 16 * 128 * 1024; P.S5Wy = (bf16_t*)(ws + WS_S5WY) + (size_t)l * 16 * 1024 * 128;
    P.S5LL = (float*)(ws + WS_S5LL) + (size_t)l * 16 * 64 * 2;
    P.Ut = (bf16_t*)(ws + WS_UT); P.Vt = (bf16_t*)(ws + WS_VT);
    P.pd = (float*)(ws + WS_R1 + R1_Q); P.qcnt = (unsigned*)(ws + WS_CTL) + 8192 + l * 4 * 8 * 16;
    P.U8 = ws + WS_UT; P.V8 = ws + WS_UT + (size_t)NEXP * 1024; P.su = (float*)(ws + WS_CTL + 131072); P.sv = (float*)(ws + WS_CTL + 131072) + NEXP;
    P.rwGt = (bf16_t*)(ws + WS_VT); P.rwRKV = (bf16_t*)(ws + WS_VT + RW_SZ);
    P.rwPT = (bf16_t*)(ws + WS_RW); P.rwG = (bf16_t*)(ws + WS_RW + RW_SZ); P.rwS0 = (bf16_t*)(ws + WS_RW + 2 * RW_SZ); P.rwQ = (bf16_t*)(ws + WS_RW + 3 * RW_SZ);
    P.hb = (bf16_t*)(ws + WS_HB); P.proj = (bf16_t*)(ws + WS_R1 + R1_PROJ); P.merged = (bf16_t*)(ws + WS_R1 + R1_MERGED); P.q = (bf16_t*)(ws + WS_R1 + R1_Q);
    P.stash = ws + WS_R1 + R1_STASH; P.eid = (int*)(ws + WS_R1 + R1_EID); P.gate = (float*)(ws + WS_R1 + R1_GATE);
    P.ycat = (bf16_t*)(ws + WS_YC); P.vtr = (bf16_t*)(ws + WS_VTR); P.pb = (bf16_t*)(ws + WS_PB);
    P.h8a = ws + WS_R1 + R1_H8; P.h8b = ws + WS_H8T; P.h8e = ws + WS_RW; P.gsc = (float*)(ws + WS_CTL + 262144) + l * 5120; P.gscA = (float*)(ws + WS_CTL + 327680) + l * 2304;
    return P;
}

__device__ __forceinline__ int win_src_col(int n) {
    if (n < 1152) return n;
    if (n < 1664) return n;
    if (n < 1668) return 1920 + (n - 1664);
    if (n < 1792) return -1;
    if (n < 2304) return 1924 + (n - 1792);
    if (n < 2560) return 1664 + (n - 2304);
    return 2436 + (n - 2560);
}
template <bool WINMAP>
__device__ __forceinline__ void transpose_item(const float* src, int sld, bf16_t* dst, int dld, int dcol0, int kb, int nb, float* scr, int lane) {
    const int k0 = 64 * kb, n0 = 32 * nb;
    const int nn = n0 + (lane & 31); const int sc = WINMAP ? win_src_col(nn) : nn;
#pragma unroll 8
    for (int i = 0; i < 32; ++i) { const int kk = 2 * i + (lane >> 5); scr[kk * 33 + (lane & 31)] = (sc >= 0) ? src[(size_t)(k0 + kk) * sld + sc] : 0.f; }
    WAVE_SYNC();
    const int c = lane & 7;
#pragma unroll
    for (int j = 0; j < 4; ++j) { const int n = (lane >> 3) + 8 * j; const float* s = scr + (8 * c) * 33 + n;
        u32x4 o; o.x = pk2(s[0 * 33], s[1 * 33]); o.y = pk2(s[2 * 33], s[3 * 33]); o.z = pk2(s[4 * 33], s[5 * 33]); o.w = pk2(s[6 * 33], s[7 * 33]);
        *(u32x4*)(dst + (size_t)(n0 + n) * dld + dcol0 + k0 + 8 * c) = o; }
    WAVE_SYNC();
}

__device__ __forceinline__ void s5_tables(const KP& p, int l, int g, unsigned char* lds) {
    float* pw = (float*)lds;
    float* bb = pw + 65 * 128;
    float* cc = bb + 64 * 32;
    const int tid = TIDX();
    const Ptrs P = make_ptrs(p.ws, l);
    const float dt = expf(p.in[I_LDT][l * 16 + g]);
    if (tid < 64) { const int pp = tid; const float lr = p.in[I_LRE][(l * 16 + g) * 64 + pp], li = p.in[I_LIM][(l * 16 + g) * 64 + pp];
        const float mag = expf(lr * dt), ang = li * dt; const float br = mag * cosf(ang), bi = mag * sinf(ang);
        float xr = 1.f, xi = 0.f;
        for (int t = 0; t <= 64; ++t) { pw[(t * 64 + pp) * 2] = xr; pw[(t * 64 + pp) * 2 + 1] = xi; const float nr = xr * br - xi * bi, ni = xr * bi + xi * br; xr = nr; xi = ni; }
        const float nr = br - 1.f, ni = bi, den = lr * lr + li * li; const float cr = (nr * lr + ni * li) / den, ci = (ni * lr - nr * li) / den;
        for (int c = 0; c < 16; ++c) { const float b_r = p.in[I_BRE][((l * 16 + g) * 64 + pp) * 16 + c], b_i = p.in[I_BIM][((l * 16 + g) * 64 + pp) * 16 + c];
            bb[(pp * 16 + c) * 2] = cr * b_r - ci * b_i; bb[(pp * 16 + c) * 2 + 1] = cr * b_i + ci * b_r; }
        P.S5LL[(g * 64 + pp) * 2] = pw[(64 * 64 + pp) * 2]; P.S5LL[(g * 64 + pp) * 2 + 1] = pw[(64 * 64 + pp) * 2 + 1];
    }
    for (int e = tid; e < 1024; e += NTHR) { const int c = e >> 6, pp = e & 63; cc[e * 2] = p.in[I_CRE][((l * 16 + g) * 16 + c) * 64 + pp]; cc[e * 2 + 1] = p.in[I_CIM][((l * 16 + g) * 16 + c) * 64 + pp]; }
    __syncthreads();
    bf16_t* Kc = P.S5Kc + (size_t)g * 64 * 256;
    for (int e = tid; e < 64 * 256; e += NTHR) { const int tau = e >> 8, co = (e >> 4) & 15, ci = e & 15; float s = 0.f;
        for (int pp = 0; pp < 64; ++pp) { const float c_r = cc[(co * 64 + pp) * 2], c_i = cc[(co * 64 + pp) * 2 + 1], w_r = pw[(tau * 64 + pp) * 2], w_i = pw[(tau * 64 + pp) * 2 + 1];
            const float t_r = c_r * w_r - c_i * w_i, t_i = c_r * w_i + c_i * w_r; s += t_r * bb[(pp * 16 + ci) * 2] - t_i * bb[(pp * 16 + ci) * 2 + 1]; }
        Kc[e] = (bf16_t)f2bf(s); }
    bf16_t* Wx = P.S5Wx + (size_t)g * 128 * 1024;
    for (int e = tid; e < 128 * 1024; e += NTHR) { const int n = e >> 10, k = e & 1023, pp = n >> 1, ri = n & 1, s = k >> 4, ci = k & 15;
        const float w_r = pw[((63 - s) * 64 + pp) * 2], w_i = pw[((63 - s) * 64 + pp) * 2 + 1], b_r = bb[(pp * 16 + ci) * 2], b_i = bb[(pp * 16 + ci) * 2 + 1];
        Wx[e] = (bf16_t)f2bf(ri ? (w_r * b_i + w_i * b_r) : (w_r * b_r - w_i * b_i)); }
    bf16_t* Wy = P.S5Wy + (size_t)g * 1024 * 128;
    for (int e = tid; e < 1024 * 128; e += NTHR) { const int n = e >> 7, k = e & 127, t = n >> 4, co = n & 15, pp = k >> 1, ri = k & 1;
        const float c_r = cc[(co * 64 + pp) * 2], c_i = cc[(co * 64 + pp) * 2 + 1], w_r = pw[((t + 1) * 64 + pp) * 2], w_i = pw[((t + 1) * 64 + pp) * 2 + 1];
        Wy[e] = (bf16_t)f2bf(ri ? -(c_r * w_i + c_i * w_r) : (c_r * w_r - c_i * w_i)); }
    __syncthreads();
}

__device__ __forceinline__ void ln_row(const float* src, const float* g, const float* b, float* dst, bf16_t* dstb, int lane) {
    f32x4 v[4]; float s = 0.f;
#pragma unroll
    for (int j = 0; j < 4; ++j) { v[j] = *(const f32x4*)(src + 256 * j + 4 * lane); s += (v[j].x + v[j].y) + (v[j].z + v[j].w); }
    const float mean = wave_sum(s) * (1.f / 1024.f); float s2 = 0.f;
#pragma unroll
    for (int j = 0; j < 4; ++j) { v[j] = v[j] - mean; s2 += (v[j].x * v[j].x + v[j].y * v[j].y) + (v[j].z * v[j].z + v[j].w * v[j].w); }
    const float rstd = 1.f / sqrtf(wave_sum(s2) * (1.f / 1024.f) + LN_EPS_);
#pragma unroll
    for (int j = 0; j < 4; ++j) { const f32x4 gg = *(const f32x4*)(g + 256 * j + 4 * lane), bv = *(const f32x4*)(b + 256 * j + 4 * lane);
        const f32x4 o = v[j] * rstd * gg + bv; *(f32x4*)(dst + 256 * j + 4 * lane) = o;
        if (dstb) { u32x2 w; w.x = pk2(o.x, o.y); w.y = pk2(o.z, o.w); *(u32x2*)(dstb + 256 * j + 4 * lane) = w; } }
}

template <int NR, bool SB = false>
__device__ __forceinline__ void ln_rows(const void* srcv, const float* g, const float* b, float* dst, bf16_t* dstb, unsigned char* d8, int lane) {
    f32x4 v[NR][4]; float s[NR], s2[NR];
#pragma unroll
    for (int r = 0; r < NR; ++r) { s[r] = 0.f;
#pragma unroll
        for (int j = 0; j < 4; ++j) {
            if (SB) { const u32x2 w = *(const u32x2*)((const bf16_t*)srcv + (size_t)r * 1024 + 256 * j + 4 * lane); v[r][j] = (f32x4){bflo(w.x), bfhi(w.x), bflo(w.y), bfhi(w.y)}; }
            else v[r][j] = *(const f32x4*)((const float*)srcv + (size_t)r * 1024 + 256 * j + 4 * lane);
            s[r] += (v[r][j].x + v[r][j].y) + (v[r][j].z + v[r][j].w); } }
    wave_sum_n<NR>(s);
#pragma unroll
    for (int r = 0; r < NR; ++r) { const float mean = s[r] * (1.f / 1024.f); s2[r] = 0.f;
#pragma unroll
        for (int j = 0; j < 4; ++j) { v[r][j] = v[r][j] - mean; s2[r] += (v[r][j].x * v[r][j].x + v[r][j].y * v[r][j].y) + (v[r][j].z * v[r][j].z + v[r][j].w * v[r][j].w); } }
    wave_sum_n<NR>(s2);
#pragma unroll
    for (int j = 0; j < 4; ++j) { const f32x4 gg = *(const f32x4*)(g + 256 * j + 4 * lane), bv = *(const f32x4*)(b + 256 * j + 4 * lane);
#pragma unroll
        for (int r = 0; r < NR; ++r) { const float rstd = 1.f / sqrtf(s2[r] * (1.f / 1024.f) + LN_EPS_);
            const f32x4 o = v[r][j] * rstd * gg + bv; if (dst) *(f32x4*)(dst + (size_t)r * 1024 + 256 * j + 4 * lane) = o;
            if (dstb) { u32x2 w; w.x = pk2(o.x, o.y); w.y = pk2(o.z, o.w); *(u32x2*)(dstb + (size_t)r * 1024 + 256 * j + 4 * lane) = w; }
            if (d8) { unsigned w8 = cvt_pk_fp8_f32_(o.x, o.y, 0u, false); w8 = cvt_pk_fp8_f32_(o.z, o.w, w8, true); *(unsigned*)(d8 + (size_t)r * 1024 + 256 * j + 4 * lane) = w8; } } }
}
__device__ __forceinline__ void phase_prologue(const KP& p, unsigned char* lds) {
    const int tid = TIDX(), lane = tid & 63, wave = tid >> 6;
    int G = GDIM(), bid = BIDX();
    for (int it = bid; it < L_ * 16; it += G) s5_tables(p, it >> 4, it & 15, lds);
    if (G >= 4 * L_ * 16) { if (bid < L_ * 16) return; bid -= L_ * 16; G -= L_ * 16; }
    float* scr = (float*)lds + wave * (64 * 33 + 16);
    const int gw = bid * NWAVE + wave, NGW = G * NWAVE;
    constexpr int I_WINT = (WIN_ROWS / 32) * 16, I_BR = 4 * 4 * 32, I_OUT = 16 * 32, I_Q = 16 * 64, I_PL = 4 * 32, I_PG = 16 * 32, I_GL = 4 * 8;
    constexpr int PER_L = I_WINT + I_BR + I_OUT + I_Q + I_PL + I_PG + I_GL;
    for (int it = gw; it < L_ * PER_L; it += NGW) {
        const int l = it / PER_L; int r = it % PER_L; const Ptrs P = make_ptrs(p.ws, l);
        if (r < I_WINT) { transpose_item<true>(p.in[I_WIN] + (size_t)l * 1024 * IN_COLS, IN_COLS, P.WinT, 1024, 0, r & 15, r >> 4, scr, lane); continue; } r -= I_WINT;
        if (r < I_BR) { const int b = r >> 7, rr = r & 127; transpose_item<false>(p.in[I_WBR] + ((size_t)l * 4 + b) * 256 * 1024, 1024, P.WbrT, 1024, 256 * b, rr & 3, rr >> 2, scr, lane); continue; } r -= I_BR;
        if (r < I_OUT) { transpose_item<false>(p.in[I_WOUT] + (size_t)l * 1024 * 1024, 1024, P.WoutT, 1024, 0, r & 15, r >> 4, scr, lane); continue; } r -= I_OUT;
        if (r < I_Q) { transpose_item<false>(p.in[I_WQ] + (size_t)l * 1024 * 2048, 2048, P.WqT, 1024, 0, r & 15, r >> 4, scr, lane); continue; } r -= I_Q;
        if (r < I_PL) { transpose_item<false>(p.in[I_PLEW] + (size_t)l * 256 * 1024, 1024, P.PleT, 256, 0, r & 3, r >> 2, scr, lane); continue; } r -= I_PL;
        if (r < I_PG) { transpose_item<false>(p.in[I_PLEG] + (size_t)l * 1024 * 1024, 1024, P.PleGT, 1024, 0, r & 15, r >> 4, scr, lane); continue; } r -= I_PG;
        transpose_item<false>(p.in[I_GLUW] + (size_t)l * 256 * 256, 256, P.GluT, 256, 0, r & 3, r >> 2, scr, lane);
    }
    const size_t gt = (size_t)bid * NTHR + tid, NGT = (size_t)G * NTHR;
    { bf16_t* K12 = (bf16_t*)(p.ws + WS_K12);
      for (size_t i = gt; i < (size_t)L_ * 2 * 16384 / 8; i += NGT) { const size_t e = i * 8; const int l = (int)(e / 32768), r = (int)(e % 32768); const float* s = (r < 16384 ? p.in[I_K1] : p.in[I_K2]) + (size_t)l * 16384 + (r & 16383);
        const f32x4 a = *(const f32x4*)s, b = *(const f32x4*)(s + 4); u32x4 o; o.x = pk2(a.x, a.y); o.y = pk2(a.z, a.w); o.z = pk2(b.x, b.y); o.w = pk2(b.z, b.w); *(u32x4*)(K12 + e) = o; } }
    { bf16_t* hb = (bf16_t*)(p.ws + WS_HB);
      unsigned char* h8a = p.ws + WS_R1 + R1_H8; unsigned char* h8b = p.ws + WS_H8T;
      for (int m = 4 * gw; m < T_; m += 4 * NGW) ln_rows<4>(p.in[I_X] + (size_t)m * 1024, p.in[I_LNIN_G], p.in[I_LNIN_B], (float*)nullptr, hb + (size_t)m * 1024, m < H8_SPLIT ? h8a + (size_t)m * 1024 : h8b + (size_t)(m - H8_SPLIT) * 1024, lane); }
}
__device__ __forceinline__ void conv_unit(const KP& p, const Ptrs& P, int l, int unit, unsigned char* lds) {
    bf16_t* hbuf = (bf16_t*)lds;
    float* obuf = (float*)(lds + 94 * 256 * 2);
    const int tid = TIDX(), lane = tid & 63, wave = tid >> 6;
    const int tiles_per_seq = S_ / 64, b = unit / tiles_per_seq, t0 = (unit % tiles_per_seq) * 64;
    for (int e = tid; e < 94 * 32; e += NTHR) { const int r = e >> 5, c8 = (e & 31) * 8; const int t = t0 - 30 + r;
        u32x4 o = (u32x4){0u, 0u, 0u, 0u};
        if (t >= 0) { const bf16_t* row = P.proj + (size_t)(b * S_ + t) * PJ; const u32x4 v = *(const u32x4*)(row + C_CV + c8), g = *(const u32x4*)(row + C_CG + c8);
            o.x = pk2(bflo(v.x) * sigmoidf_(bflo(g.x)), bfhi(v.x) * sigmoidf_(bfhi(g.x))); o.y = pk2(bflo(v.y) * sigmoidf_(bflo(g.y)), bfhi(v.y) * sigmoidf_(bfhi(g.y)));
            o.z = pk2(bflo(v.z) * sigmoidf_(bflo(g.z)), bfhi(v.z) * sigmoidf_(bfhi(g.z))); o.w = pk2(bflo(v.w) * sigmoidf_(bflo(g.w)), bfhi(v.w) * sigmoidf_(bfhi(g.w))); }
        *(u32x4*)(hbuf + r * 256 + c8) = o; }
    __syncthreads();
    { const int c = tid & 255, half = tid >> 8; float w[31], x[62];
#pragma unroll
      for (int j = 0; j < 31; ++j) w[j] = p.in[I_CONVW][(l * 31 + j) * 256 + c];
      const float cb = p.in[I_CONVB][l * 256 + c];
#pragma unroll
      for (int j = 0; j < 62; ++j) x[j] = bf2f(hbuf[(half * 32 + j) * 256 + c]);
#pragma unroll
      for (int tt = 0; tt < 32; ++tt) { float s = cb;
#pragma unroll
          for (int j = 0; j < 31; ++j) s += w[j] * x[tt + j];
          obuf[(half * 32 + tt) * 256 + c] = s; } }
    __syncthreads();
    { const f32x4 g = *(const f32x4*)(p.in[I_CLNG] + l * 256 + 4 * lane), bb = *(const f32x4*)(p.in[I_CLNB] + l * 256 + 4 * lane);
      f32x4 vv[8]; float m1[8], m2[8];
#pragma unroll
      for (int i = 0; i < 8; ++i) { vv[i] = *(const f32x4*)(obuf + (wave * 8 + i) * 256 + 4 * lane); m1[i] = (vv[i].x + vv[i].y) + (vv[i].z + vv[i].w); }
      wave_sum_n<8>(m1);
#pragma unroll
      for (int i = 0; i < 8; ++i) { vv[i] = vv[i] - m1[i] * (1.f / 256.f); m2[i] = (vv[i].x * vv[i].x + vv[i].y * vv[i].y) + (vv[i].z * vv[i].z + vv[i].w * vv[i].w); }
      wave_sum_n<8>(m2);
#pragma unroll
      for (int i = 0; i < 8; ++i) { const int t = wave * 8 + i; const float rstd = 1.f / sqrtf(m2[i] * (1.f / 256.f) + LN_EPS_);
          f32x4 z = vv[i] * rstd * g + bb; u32x2 w; w.x = pk2(z.x * sigmoidf_(z.x), z.y * sigmoidf_(z.y)); w.y = pk2(z.z * sigmoidf_(z.z), z.w * sigmoidf_(z.w));
          *(u32x2*)(P.ycat + (size_t)(b * S_ + t0 + t) * 1024 + 768 + 4 * lane) = w; } }
    __syncthreads();
}

constexpr int S5_NCH = S_ / 64;
constexpr int S5_UPITCH = 1032;
constexpr int S5_XPITCH = 136;
__device__ __forceinline__ void s5_unit(const KP& p, const Ptrs& P, int l, int unit, unsigned char* lds) {
    const int b = unit >> 4, g = unit & 15;
    bf16_t* Uc = (bf16_t*)lds;
    bf16_t* Kc = (bf16_t*)(lds + 66048);
    float* Xe = (float*)(lds + 66048 + 32768);
    bf16_t* Xs = (bf16_t*)(lds + 66048 + 65536);
    const int tid = TIDX(), lane = tid & 63, wave = tid >> 6, r32 = lane & 31, hi = lane >> 5;
    { u32x4 v[8], kc[4];
#pragma unroll
      for (int j = 0; j < 8; ++j) { const int e = tid + j * NTHR, s = e >> 1, hf = e & 1; v[j] = (u32x4){0u, 0u, 0u, 0u};
          if (s < S_) v[j] = *(const u32x4*)(P.proj + (size_t)(b * S_ + s) * PJ + C_S5 + 16 * g + 8 * hf); }
#pragma unroll
      for (int j = 0; j < 4; ++j) kc[j] = *(const u32x4*)(P.S5Kc + (size_t)g * 16384 + (tid + j * NTHR) * 8);
#pragma unroll
      for (int j = 0; j < 8; ++j) { const int e = tid + j * NTHR, s = e >> 1, hf = e & 1; *(u32x4*)(Uc + (s >> 6) * S5_UPITCH + (s & 63) * 16 + 8 * hf) = v[j]; }
#pragma unroll
      for (int j = 0; j < 4; ++j) *(u32x4*)(Kc + (tid + j * NTHR) * 8) = kc[j]; }
    __syncthreads();
    { const int ntile = wave & 3, kh = wave >> 2; f32x16 acc = {};
      const bf16_t* wrow = P.S5Wx + ((size_t)g * 128 + ntile * 32 + r32) * 1024 + kh * 512 + 8 * hi;
      const bf16_t* urow = Uc + r32 * S5_UPITCH + kh * 512 + 8 * hi;
      for (int k8 = 0; k8 < 32; k8 += 8) { bf16x8 bw[8];
#pragma unroll
          for (int j = 0; j < 8; ++j) bw[j] = *(const bf16x8*)(wrow + (k8 + j) * 16);
#pragma unroll
          for (int j = 0; j < 8; ++j) { const bf16x8 a = *(const bf16x8*)(urow + (k8 + j) * 16); acc = MFMA32(a, bw[j], acc); } }
#pragma unroll
      for (int r = 0; r < 16; ++r) { const int c = (r & 3) + 8 * (r >> 2) + 4 * hi; Xe[(kh * 32 + c) * 128 + ntile * 32 + r32] = acc[r]; } }
    __syncthreads();
    if (tid < 64) { const float lr = P.S5LL[(g * 64 + tid) * 2], li = P.S5LL[(g * 64 + tid) * 2 + 1]; float xr = 0.f, xi = 0.f;
        for (int c = 0; c < 32; ++c) { Xs[c * S5_XPITCH + 2 * tid] = (bf16_t)f2bf(xr); Xs[c * S5_XPITCH + 2 * tid + 1] = (bf16_t)f2bf(xi);
            const float er = Xe[c * 128 + 2 * tid] + Xe[(32 + c) * 128 + 2 * tid], ei = Xe[c * 128 + 2 * tid + 1] + Xe[(32 + c) * 128 + 2 * tid + 1];
            const float nr = lr * xr - li * xi + er, ni = lr * xi + li * xr + ei; xr = nr; xi = ni; } }
    __syncthreads();
    { const int tt = r32 >> 4, co = r32 & 15; const float dsk = p.in[I_S5D][l * 256 + 16 * g + co];
      for (int q = 0; q < 4; ++q) { const int ntile = wave + 8 * q, t0 = 2 * ntile; f32x16 acc = {};
          const bf16_t* urow = Uc + r32 * S5_UPITCH + 8 * hi;
          for (int s = 0; s <= t0 + 1; ++s) { const int tau = t0 + tt - s; bf16x8 bk = (bf16x8){0, 0, 0, 0, 0, 0, 0, 0};
              if (tau >= 0) bk = *(const bf16x8*)(Kc + (tau * 16 + co) * 16 + 8 * hi);
              const bf16x8 a = *(const bf16x8*)(urow + s * 16); acc = MFMA32(a, bk, acc); }
          const bf16_t* wy = P.S5Wy + ((size_t)g * 1024 + ntile * 32 + r32) * 128 + 8 * hi; const bf16_t* xrow = Xs + r32 * S5_XPITCH + 8 * hi;
#pragma unroll
          for (int ks = 0; ks < 8; ++ks) { const bf16x8 a = *(const bf16x8*)(xrow + ks * 16); const bf16x8 bw = *(const bf16x8*)(wy + ks * 16); acc = MFMA32(a, bw, acc); }
#pragma unroll
          for (int r = 0; r < 16; ++r) { const int c = (r & 3) + 8 * (r >> 2) + 4 * hi; const int s = c * 64 + t0 + tt;
              if (s < S_) { const float uu = bf2f(Uc[c * S5_UPITCH + (t0 + tt) * 16 + co]); const float y = acc[r] + dsk * uu;
                  P.ycat[(size_t)(b * S_ + s) * 1024 + 256 + 16 * g + co] = (bf16_t)f2bf(gelu_erf(y)); } } } }
    __syncthreads();
}
constexpr float LOG2E_ = 1.4426950408889634f;
__device__ __forceinline__ float log_sigmoid_(float x) { return fminf(x, 0.f) - log1pf(__expf(-fabsf(x))); }
__device__ __forceinline__ void fox_unit(const KP& p, const Ptrs& P, int l, int unit, unsigned char* lds) {
    constexpr int NQB = S_ / 256;
    const int bh = unit / NQB, qb = (unit >= (NB_ * 4 * NQB) / 2) ? NQB - 1 - unit % NQB : unit % NQB, b = bh >> 2, h = bh & 3, q0 = qb * 256;
    float* cl = (float*)lds;
    unsigned char* Kt = lds + S_ * 4;
    unsigned char* Vt = Kt + 8192;
    float* wsf = (float*)(Kt + 32768);
    float* sc = wsf + 256;
    const int tid = TIDX(), lane = tid & 63, wave = tid >> 6, r32 = lane & 31, hi = lane >> 5;
    const int qend = q0 + 256;
    { constexpr int PER = (S_ + 511) / 512; const float bf = p.in[I_BF][l * 4 + h]; float loc[PER]; float s = 0.f;
#pragma unroll
      for (int i = 0; i < PER; ++i) { const int t = tid * PER + i; float v = 0.f;
          if (t < qend) v = log_sigmoid_(bf2f(P.proj[(size_t)(b * S_ + t) * PJ + C_FL + h]) + bf) * LOG2E_;
          s += v; loc[i] = s; }
      sc[tid] = s; __syncthreads();
      for (int off = 1; off < 512; off <<= 1) { const float v = sc[tid] + (tid >= off ? sc[tid - off] : 0.f); __syncthreads(); sc[tid] = v; __syncthreads(); }
      const float base = sc[tid] - s;
#pragma unroll
      for (int i = 0; i < PER; ++i) { const int t = tid * PER + i; if (t < S_) cl[t] = base + loc[i]; }
      __syncthreads(); }
    const int qrow = q0 + 32 * wave + r32;
    constexpr float C2 = 0.125f * LOG2E_;
    bf16x8 qr[4];
    { const bf16_t* qp = P.proj + (size_t)(b * S_ + qrow) * PJ + C_FQ + 64 * h + 8 * hi;
#pragma unroll
      for (int d0 = 0; d0 < 4; ++d0) { const u32x4 w = *(const u32x4*)(qp + 16 * d0);
          u32x4 o; o.x = pk2(bflo(w.x) * C2, bfhi(w.x) * C2); o.y = pk2(bflo(w.y) * C2, bfhi(w.y) * C2); o.z = pk2(bflo(w.z) * C2, bfhi(w.z) * C2); o.w = pk2(bflo(w.w) * C2, bfhi(w.w) * C2);
          qr[d0] = __builtin_bit_cast(bf16x8, o); } }
    const float clq = cl[qrow];
    float mrun = -INFINITY, lrun = 0.f; f32x16 o0 = {}, o1 = {};
    const int NT = qend / 64;
    const int srow = tid >> 3, sch = tid & 7;
    const bf16_t* kg = P.proj + (size_t)(b * S_ + srow) * PJ + C_FK + 64 * h + 8 * sch;
    const bf16_t* vg = P.vtr + (size_t)(64 * h + srow) * T_ + (size_t)b * S_ + 8 * sch;
    const int koff = srow * 128 + ((sch ^ ((srow >> 1) & 7)) * 16);
    const int voffa = srow * 128 + (((2 * sch) ^ ((srow >> 1) & 15)) * 8), voffb = srow * 128 + (((2 * sch + 1) ^ ((srow >> 1) & 15)) * 8);
    u32x4 kreg = *(const u32x4*)kg, vreg = *(const u32x4*)vg;
    *(u32x4*)(Kt + koff) = kreg; *(u32x2*)(Vt + voffa) = (u32x2){vreg.x, vreg.y}; *(u32x2*)(Vt + voffb) = (u32x2){vreg.z, vreg.w};
    if (NT > 1) { kreg = *(const u32x4*)(kg + (size_t)64 * PJ); vreg = *(const u32x4*)(vg + 64); }
    __syncthreads();
    for (int jt = 0; jt < NT; ++jt) {
        const int kv0 = jt * 64; const unsigned char* Kb = Kt + (jt & 1) * 16384; const unsigned char* Vb = Vt + (jt & 1) * 16384;
        if (kv0 <= q0 + 32 * wave + 31) {
            f32x16 pt[2];
#pragma unroll
            for (int kvt = 0; kvt < 2; ++kvt) { const int row = 32 * kvt + r32; f32x16 acc;
#pragma unroll
                for (int g4 = 0; g4 < 4; ++g4) { const f32x4 c4 = *(const f32x4*)(cl + kv0 + 32 * kvt + 8 * g4 + 4 * hi);
#pragma unroll
                    for (int e = 0; e < 4; ++e) acc[4 * g4 + e] = clq - c4[e]; }
#pragma unroll
                for (int d0 = 0; d0 < 4; ++d0) { const bf16x8 a = *(const bf16x8*)(Kb + row * 128 + (((2 * d0 + hi) ^ ((row >> 1) & 7)) * 16)); acc = MFMA32(a, qr[d0], acc); }
                pt[kvt] = acc; }
            if (kv0 + 63 > q0 + 32 * wave) {
#pragma unroll
                for (int kvt = 0; kvt < 2; ++kvt)
#pragma unroll
                    for (int r = 0; r < 16; ++r) { const int key = kv0 + 32 * kvt + (r & 3) + 8 * (r >> 2) + 4 * hi; if (key > qrow) pt[kvt][r] = -INFINITY; } }
            float mx = -INFINITY;
#pragma unroll
            for (int kvt = 0; kvt < 2; ++kvt)
#pragma unroll
                for (int r = 0; r < 16; ++r) mx = fmaxf(mx, pt[kvt][r]);
            mx = fmaxf(mx, __shfl_xor(mx, 32));
            const float mnew = fmaxf(mrun, mx), alpha = FAST_EXP2(mrun - mnew); mrun = mnew;
            float ls = 0.f;
#pragma unroll
            for (int kvt = 0; kvt < 2; ++kvt)
#pragma unroll
                for (int r = 0; r < 16; ++r) { const float e = FAST_EXP2(pt[kvt][r] - mnew); pt[kvt][r] = e; ls += e; }
            lrun = lrun * alpha + ls;
            float* wf = wsf + wave * 32;
            WAVE_SYNC(); if (hi == 0) wf[r32] = alpha; WAVE_SYNC();
#pragma unroll
            for (int g4 = 0; g4 < 4; ++g4) { const f32x4 f = *(const f32x4*)(wf + 8 * g4 + 4 * hi);
#pragma unroll
                for (int e = 0; e < 4; ++e) { o0[4 * g4 + e] *= f[e]; o1[4 * g4 + e] *= f[e]; } }
#pragma unroll
            for (int s = 0; s < 4; ++s) { const int kvt = s >> 1, rb = 8 * (s & 1);
                u32x4 pw; pw.x = pk2(pt[kvt][rb + 0], pt[kvt][rb + 1]); pw.y = pk2(pt[kvt][rb + 2], pt[kvt][rb + 3]); pw.z = pk2(pt[kvt][rb + 4], pt[kvt][rb + 5]); pw.w = pk2(pt[kvt][rb + 6], pt[kvt][rb + 7]);
                const bf16x8 pa = __builtin_bit_cast(bf16x8, pw);
#pragma unroll
                for (int dt = 0; dt < 2; ++dt) { const int d = 32 * dt + r32; const int sw = (d >> 1) & 15;
                    const u32x2 va = *(const u32x2*)(Vb + d * 128 + (((4 * s + hi) ^ sw) * 8)), vb = *(const u32x2*)(Vb + d * 128 + (((4 * s + 2 + hi) ^ sw) * 8));
                    const bf16x8 vf = __builtin_bit_cast(bf16x8, (u32x4){va.x, va.y, vb.x, vb.y});
                    if (dt == 0) o0 = MFMA32(pa, vf, o0); else o1 = MFMA32(pa, vf, o1); } }
        }
        if (jt + 1 < NT) { unsigned char* Kn = Kt + ((jt + 1) & 1) * 16384; unsigned char* Vn = Vt + ((jt + 1) & 1) * 16384;
            *(u32x4*)(Kn + koff) = kreg; *(u32x2*)(Vn + voffa) = (u32x2){vreg.x, vreg.y}; *(u32x2*)(Vn + voffb) = (u32x2){vreg.z, vreg.w};
            if (jt + 2 < NT) { kreg = *(const u32x4*)(kg + (size_t)(kv0 + 128) * PJ); vreg = *(const u32x4*)(vg + kv0 + 128); } }
        __syncthreads();
    }
    { const float lt = lrun + __shfl_xor(lrun, 32); float* wf = wsf + wave * 32;
      WAVE_SYNC(); if (hi == 0) wf[r32] = 1.0f / lt; WAVE_SYNC();
      bf16_t* orow = P.ycat + (size_t)(b * S_ + q0 + 32 * wave) * 1024 + 512 + 64 * h + r32;
#pragma unroll
      for (int r = 0; r < 16; ++r) { const int qq = (r & 3) + 8 * (r >> 2) + 4 * hi; const float f = wf[qq];
          orow[(size_t)qq * 1024] = (bf16_t)f2bf(o0[r] * f); orow[(size_t)qq * 1024 + 32] = (bf16_t)f2bf(o1[r] * f); } }
    __syncthreads();
}

constexpr int RW_NCH = S_ / 64;
constexpr int RWP = 72;
constexpr int RW_ARR = 64 * RWP * 2;
constexpr int RW_SCRP = 388;
__device__ __forceinline__ void rw_stage_weights(const KP& p, int l, int h, bf16_t* wb, int tid) {
    for (int e = tid; e < 2048; e += NTHR) { const int m = e >> 4, c4 = (e & 15) * 4;
        if (m < 32) { const f32x4 v = *(const f32x4*)(p.in[I_A2] + (l * 32 + m) * 256 + 64 * h + c4);
#pragma unroll
            for (int q = 0; q < 4; ++q) wb[(c4 + q) * 40 + m] = (bf16_t)f2bf(v[q]); }
        else if (m < 64) { const f32x4 v = *(const f32x4*)(p.in[I_W2] + (l * 32 + m - 32) * 256 + 64 * h + c4);
#pragma unroll
            for (int q = 0; q < 4; ++q) wb[2560 + (c4 + q) * 40 + (m - 32)] = (bf16_t)f2bf(v[q]); }
        else { const f32x4 v = *(const f32x4*)(p.in[I_G2] + (l * 64 + m - 64) * 256 + 64 * h + c4);
#pragma unroll
            for (int q = 0; q < 4; ++q) wb[5120 + (c4 + q) * 72 + (m - 64)] = (bf16_t)f2bf(v[q]); } }
    __syncthreads();
}
__device__ __forceinline__ bf16x8 rw_pack8(const float* q) { const f32x4 a = *(const f32x4*)q, b = *(const f32x4*)(q + 4);
    u32x4 w; w.x = pk2(a.x, a.y); w.y = pk2(a.z, a.w); w.z = pk2(b.x, b.y); w.w = pk2(b.z, b.w); return __builtin_bit_cast(bf16x8, w); }
template <int NT, bool NEED_W, bool NEED_G>
__device__ __forceinline__ void rw_prep(const KP& p, const Ptrs& P, int l, int b, int h, int tpos0, float* scr, const bf16_t* wb, int lane,
                                        float (&r)[NT], float (&lw)[NT], float (&k2)[NT], float (&v)[NT], float (&ain)[NT], float (&bin)[NT], float (&g)[NT], float (&rk)[NT]) {
    constexpr int NIT = (NT * 40 + 63) / 64;
    u32x4 cur[NIT], prv[NIT];
#pragma unroll
    for (int i = 0; i < NIT; ++i) { const int e = lane + 64 * i; const int tt = e / 40, ch = e % 40; const int t = tpos0 + tt;
        const int col = ch < 8 ? C_R + 64 * h + 8 * ch : ch < 16 ? C_K + 64 * h + 8 * (ch - 8) : ch < 24 ? C_V + 64 * h + 8 * (ch - 16) : C_HW + 8 * (ch - 24);
        cur[i] = (u32x4){0u, 0u, 0u, 0u}; prv[i] = (u32x4){0u, 0u, 0u, 0u};
        if (e < NT * 40) { const bf16_t* row = P.proj + (size_t)(b * S_ + t) * PJ + col; cur[i] = *(const u32x4*)row; if (t > 0) prv[i] = *(const u32x4*)(row - PJ); } }
#pragma unroll
    for (int i = 0; i < NIT; ++i) { const int e = lane + 64 * i; const int tt = e / 40, ch = e % 40;
        const int col = ch < 8 ? C_R + 64 * h + 8 * ch : ch < 16 ? C_K + 64 * h + 8 * (ch - 8) : ch < 24 ? C_V + 64 * h + 8 * (ch - 16) : C_HW + 8 * (ch - 24);
        const int idx = ch < 24 ? 8 * ch : 192 + 8 * (ch - 24);
        if (e < NT * 40) { const f32x4 m0 = *(const f32x4*)(p.in[I_MU] + l * 896 + col), m1 = *(const f32x4*)(p.in[I_MU] + l * 896 + col + 4);
            float z[8] = {bflo(cur[i].x), bfhi(cur[i].x), bflo(cur[i].y), bfhi(cur[i].y), bflo(cur[i].z), bfhi(cur[i].z), bflo(cur[i].w), bfhi(cur[i].w)};
            const float zp[8] = {bflo(prv[i].x), bfhi(prv[i].x), bflo(prv[i].y), bfhi(prv[i].y), bflo(prv[i].z), bfhi(prv[i].z), bflo(prv[i].w), bfhi(prv[i].w)};
#pragma unroll
            for (int q = 0; q < 8; ++q) { float zs = z[q] + (zp[q] - z[q]) * (q < 4 ? m0[q & 3] : m1[q & 3]);
                if (ch >= 24 && ch < 28) zs = 1.0f - 2.0f * FAST_RCP(1.0f + FAST_EXP2(zs * 2.8853900817779268f));
                else if (ch >= 32) zs = sigmoidf_(zs);
                z[q] = zs; }
            *(f32x4*)(scr + tt * RW_SCRP + idx) = (f32x4){z[0], z[1], z[2], z[3]}; *(f32x4*)(scr + tt * RW_SCRP + idx + 4) = (f32x4){z[4], z[5], z[6], z[7]}; } }
    WAVE_SYNC();
    { const int fr = lane & 15, fq = lane >> 4; const float* hrow = scr + (fr & 7) * RW_SCRP + 192 + 8 * fq;
      const bf16x8 fw = rw_pack8(hrow), fa = rw_pack8(hrow + 32), fg0 = rw_pack8(hrow + 64), fg1 = rw_pack8(hrow + 96);
      WAVE_SYNC();
#pragma unroll
      for (int nt = 0; nt < 4; ++nt) { const f32x4 z4 = (f32x4){0.f, 0.f, 0.f, 0.f};
          const f32x4 da = MFMA16(fa, *(const bf16x8*)(wb + (16 * nt + fr) * 40 + 8 * fq), z4);
          f32x4 dw = z4, dg = z4;
          if (NEED_W) dw = MFMA16(fw, *(const bf16x8*)(wb + 2560 + (16 * nt + fr) * 40 + 8 * fq), z4);
          if (NEED_G) { dg = MFMA16(fg0, *(const bf16x8*)(wb + 5120 + (16 * nt + fr) * 72 + 8 * fq), z4); dg = MFMA16(fg1, *(const bf16x8*)(wb + 5120 + (16 * nt + fr) * 72 + 32 + 8 * fq), dg); }
          if (fq < 2) {
#pragma unroll
              for (int q = 0; q < 4; ++q) { float* o = scr + (4 * fq + q) * RW_SCRP + 16 * nt + fr; o[192] = da[q]; if (NEED_W) o[256] = dw[q]; if (NEED_G) o[320] = dg[q]; } } }
      WAVE_SYNC(); }
    const int j = lane, cj = 64 * h + j; float wl[NT], al[NT], gg[NT];
    const float w0 = p.in[I_W0][l * 256 + cj], a0 = p.in[I_A0][l * 256 + cj];
#pragma unroll
    for (int tt = 0; tt < NT; ++tt) { al[tt] = a0 + scr[tt * RW_SCRP + 192 + j]; wl[tt] = NEED_W ? w0 + scr[tt * RW_SCRP + 256 + j] : w0; gg[tt] = NEED_G ? scr[tt * RW_SCRP + 320 + j] : 0.f; }
    const float kkw = p.in[I_KK][l * 256 + cj], kaw = p.in[I_KA][l * 256 + cj], rkw = p.in[I_RK][l * 256 + cj];
    float ssum[NT], rsum[NT], kkv[NT], av[NT];
#pragma unroll
    for (int tt = 0; tt < NT; ++tt) {
        const float a = sigmoidf_(al[tt]); av[tt] = a;
        const float rr = scr[tt * RW_SCRP + j], k = scr[tt * RW_SCRP + 64 + j], vv = scr[tt * RW_SCRP + 128 + j];
        const float kk2 = k * (1.f + (a - 1.f) * kaw);
        r[tt] = rr; k2[tt] = kk2; v[tt] = vv;
        const float kk = k * kkw; kkv[tt] = kk; ssum[tt] = kk * kk; rsum[tt] = rr * kk2 * rkw; }
    if (NEED_W) wave_sum_n<NT>(ssum);
    if (NEED_G) wave_sum_n<NT>(rsum);
#pragma unroll
    for (int tt = 0; tt < NT; ++tt) {
        if (NEED_W) { const float x = -wl[tt]; const float sp = fmaxf(x, 0.f) + 0.6931471805599453f * FAST_LOG2(1.0f + FAST_EXP2(-1.4426950408889634f * fabsf(x)));
            lw[tt] = -FAST_EXP2(-1.4426950408889634f * (sp + 0.5f));
            const float kkn = kkv[tt] * FAST_RSQ(fmaxf(ssum[tt], 1e-24f));
            ain[tt] = -kkn; bin[tt] = kkn * av[tt]; }
        if (NEED_G) { g[tt] = gg[tt]; rk[tt] = rsum[tt]; }
    }
    WAVE_SYNC();
}
__device__ __forceinline__ bf16x8 ldsb8(const bf16_t* p) { return *(const bf16x8*)p; }
__device__ __forceinline__ f32x16 rw_tile(const bf16_t* X, const bf16_t* Y, int tm, int tn, int r32, int hi, f32x16 acc) {
    const bf16_t* xa = X + (32 * tm + r32) * RWP + 8 * hi; const bf16_t* yb = Y + (32 * tn + r32) * RWP + 8 * hi;
#pragma unroll
    for (int ks = 0; ks < 4; ++ks) acc = MFMA32(ldsb8(xa + 16 * ks), ldsb8(yb + 16 * ks), acc);
    return acc;
}
template <int STOP = 0>
__device__ __forceinline__ void rw_chunk_unit(const KP& p, const Ptrs& P, int l, int unit, unsigned char* lds) {
    MEMFENCE(); OPAQUE_S(unit);
    const int c = unit % RW_NCH, bh = unit / RW_NCH, b = bh >> 2, h = bh & 3, t0 = c * 64;
    bf16_t* AT = (bf16_t*)(lds + 0 * RW_ARR); bf16_t* RT = (bf16_t*)(lds + 1 * RW_ARR); bf16_t* BT = (bf16_t*)(lds + 2 * RW_ARR); bf16_t* KT = (bf16_t*)(lds + 3 * RW_ARR);
    bf16_t* BH = (bf16_t*)(lds + 4 * RW_ARR); bf16_t* KH = (bf16_t*)(lds + 5 * RW_ARR); bf16_t* VT = (bf16_t*)(lds + 6 * RW_ARR);
    bf16_t* AAK = (bf16_t*)(lds + 7 * RW_ARR); bf16_t* ARB = (bf16_t*)(lds + 8 * RW_ARR); bf16_t* ARK = (bf16_t*)(lds + 9 * RW_ARR);
    bf16_t* W1T = (bf16_t*)(lds + 10 * RW_ARR); bf16_t* UVT = (bf16_t*)(lds + 11 * RW_ARR);
    bf16_t* RHT = (bf16_t*)(lds + 12 * RW_ARR);
    float* ADG = (float*)(lds + 14 * RW_ARR);
    bf16_t* ABA = (bf16_t*)(lds + 14 * RW_ARR + 8192);
    float* WT = (float*)(lds + 14 * RW_ARR + 8192 + 32 * RWP * 2);
    float* GC = WT + 512;
    bf16_t* DAB = AT;
    const int tid = TIDX(), lane = tid & 63, wave = tid >> 6, r32 = lane & 31, hi = lane >> 5;
    float r[8], lw[8], k2[8], v[8], ain[8], bin[8], gg[8], rk[8];
    rw_stage_weights(p, l, h, (bf16_t*)(lds + 8 * 8 * RW_SCRP * 4), tid);
    rw_prep<8, true, true>(p, P, l, b, h, t0 + 8 * wave, (float*)lds + wave * (8 * RW_SCRP), (const bf16_t*)(lds + 8 * 8 * RW_SCRP * 4), lane, r, lw, k2, v, ain, bin, gg, rk);
#pragma unroll
    for (int i = 0; i < 8; ++i) { const size_t o = (size_t)(b * S_ + t0 + 8 * wave + i) * 256 + 64 * h + lane; P.rwGt[o] = (bf16_t)f2bf(gg[i]); P.rwRKV[o] = (bf16_t)f2bf(rk[i] * v[i]); }
    float Lloc[8]; { float s = 0.f;
#pragma unroll
      for (int i = 0; i < 8; ++i) { s += lw[i]; Lloc[i] = s; } }
    __syncthreads();
    if (STOP == 1) return;
    WT[wave * 64 + lane] = Lloc[7];
    __syncthreads();
    { float off = 0.f, tot = 0.f;
#pragma unroll
      for (int w = 0; w < 8; ++w) { const float x = WT[w * 64 + lane]; tot += x; if (w < wave) off += x; }
      if (wave == 0) GC[lane] = __expf(tot);
      unsigned bhp[4], khp[4], vtp[4], atp[4]; float pb = 0.f, pk = 0.f, pv = 0.f, pa = 0.f;
#pragma unroll
      for (int i = 0; i < 8; ++i) { const int t = 8 * wave + i; const float Lt = off + Lloc[i], Lp = Lt - lw[i];
          const float eL = __expf(Lt), eLp = __expf(Lp), einv = __expf(-Lt), eh = __expf(tot - Lt);
          const float xa = ain[i] * eLp;
          AT[t * RWP + lane] = (bf16_t)f2bf(xa); RT[t * RWP + lane] = (bf16_t)f2bf(r[i] * eL);
          BT[t * RWP + lane] = (bf16_t)f2bf(bin[i] * einv); KT[t * RWP + lane] = (bf16_t)f2bf(k2[i] * einv);
          const float xb = bin[i] * eh, xk = k2[i] * eh, xv = v[i];
          if (i & 1) { bhp[i >> 1] = pk2(pb, xb); khp[i >> 1] = pk2(pk, xk); vtp[i >> 1] = pk2(pv, xv); atp[i >> 1] = pk2(pa, xa); } else { pb = xb; pk = xk; pv = xv; pa = xa; } }
      *(u32x4*)(BH + lane * RWP + 8 * wave) = (u32x4){bhp[0], bhp[1], bhp[2], bhp[3]};
      *(u32x4*)(KH + lane * RWP + 8 * wave) = (u32x4){khp[0], khp[1], khp[2], khp[3]};
      *(u32x4*)(VT + lane * RWP + 8 * wave) = (u32x4){vtp[0], vtp[1], vtp[2], vtp[3]};
      *(u32x4*)(RHT + (64 + lane) * RWP + 8 * wave) = (u32x4){atp[0], atp[1], atp[2], atp[3]}; }
    __syncthreads();
#pragma unroll
    for (int jj = 0; jj < 2; ++jj) { const int job = wave + 8 * jj, mat = job >> 2, tm = (job >> 1) & 1, tn = job & 1;
        f32x16 acc = {};
        if (!(tm == 0 && tn == 1)) acc = rw_tile((mat & 2) ? RT : AT, (mat & 1) ? KT : BT, tm, tn, r32, hi, acc);
        const int s = 32 * tn + r32;
#pragma unroll
        for (int q = 0; q < 16; ++q) { const int t = 32 * tm + (q & 3) + 8 * (q >> 2) + 4 * hi;
            const bool keep = (mat & 2) ? (s <= t) : (s < t); const float x = keep ? acc[q] : 0.f;
            if (mat == 0) { if (tm == tn) ADG[(tm * 32 + (t & 31)) * 32 + (s & 31)] = x; else if (tm == 1) ABA[(t & 31) * RWP + s] = (bf16_t)f2bf(x); } else { bf16_t* D = (mat == 1) ? AAK : (mat == 2) ? ARB : ARK; D[t * RWP + s] = (bf16_t)f2bf(x); } } }
    __syncthreads();
    if (STOP == 2) return;
    if (wave < 4) { const int tm = wave >> 1, tn = wave & 1; f32x16 acc = {}; acc = rw_tile(VT, AAK, tm, tn, r32, hi, acc);
#pragma unroll
        for (int q = 0; q < 16; ++q) { const int i = 32 * tm + (q & 3) + 8 * (q >> 2) + 4 * hi; RHT[i * RWP + 32 * tn + r32] = (bf16_t)f2bf(acc[q]); } }
    else if (wave == 4) { float d[32]; const LAS float* ab = (const LAS float*)ADG + hi * 1024;
#pragma unroll
        for (int t = 0; t < 32; ++t) d[t] = (t == r32) ? 1.f : 0.f;
#pragma unroll
        for (int t = 1; t < 32; ++t) { float s0 = 0.f, s1 = 0.f;
#pragma unroll
            for (int s4 = 0; s4 < (t + 3) / 4; ++s4) { const f32x4 a4 = *(const LAS f32x4*)(ab + t * 32 + 4 * s4);
                s0 += a4[0] * d[4 * s4]; s1 += a4[1] * d[4 * s4 + 1]; s0 += a4[2] * d[4 * s4 + 2]; s1 += a4[3] * d[4 * s4 + 3]; }
            d[t] += s0 + s1; if ((t & 3) == 3) MEMFENCE(); }
        LAS bf16_t* D = (LAS bf16_t*)DAB + hi * 32 * RWP + r32;
#pragma unroll
        for (int t = 0; t < 32; ++t) D[t * RWP] = (bf16_t)f2bf(d[t]); }
    __syncthreads();
    if (wave < 4) { bf16_t* XT = (wave < 2 ? UVT : W1T) + (32 * (wave & 1)) * RWP;
        const bf16_t* rh = RHT + (32 * wave + r32) * RWP + 8 * hi;
        { f32x16 acc = {}; const bf16_t* da = DAB + r32 * RWP + 8 * hi;
#pragma unroll
          for (int ks = 0; ks < 2; ++ks) acc = MFMA32(ldsb8(rh + 16 * ks), ldsb8(da + 16 * ks), acc);
#pragma unroll
          for (int q = 0; q < 16; ++q) XT[((q & 3) + 8 * (q >> 2) + 4 * hi) * RWP + r32] = (bf16_t)f2bf(acc[q]); }
        WAVE_SYNC();
        { f32x16 acc; const bf16_t* rz = RHT + (32 * wave) * RWP + 32 + r32;
#pragma unroll
          for (int q = 0; q < 16; ++q) acc[q] = bf2f(rz[((q & 3) + 8 * (q >> 2) + 4 * hi) * RWP]);
          const bf16_t* xa = XT + r32 * RWP + 8 * hi; const bf16_t* ba = ABA + r32 * RWP + 8 * hi;
#pragma unroll
          for (int ks = 0; ks < 2; ++ks) acc = MFMA32(ldsb8(xa + 16 * ks), ldsb8(ba + 16 * ks), acc);
#pragma unroll
          for (int q = 0; q < 16; ++q) XT[((q & 3) + 8 * (q >> 2) + 4 * hi) * RWP + 32 + r32] = (bf16_t)f2bf(acc[q]); }
        WAVE_SYNC();
        { f32x16 acc = {}; const bf16_t* xz = XT + r32 * RWP + 32 + 8 * hi; const bf16_t* db = DAB + (32 + r32) * RWP + 8 * hi;
          const bf16x8 z0 = ldsb8(xz), z1 = ldsb8(xz + 16);
          acc = MFMA32(z0, ldsb8(db), acc); acc = MFMA32(z1, ldsb8(db + 16), acc);
          WAVE_SYNC();
#pragma unroll
          for (int q = 0; q < 16; ++q) XT[((q & 3) + 8 * (q >> 2) + 4 * hi) * RWP + 32 + r32] = (bf16_t)f2bf(acc[q]); } }
    __syncthreads();
    if (STOP == 3) return;
    const size_t chunk = (size_t)unit;
#pragma unroll
    for (int jj = 0; jj < 2; ++jj) { const int job = wave + 8 * jj, kind = job >> 2, tm = (job >> 1) & 1, tn = job & 1; f32x16 acc = {};
        const int col = 32 * tn + r32;
        if (kind == 0) { acc = rw_tile(BH, W1T, tm, tn, r32, hi, acc);
            bf16_t* PT = P.rwPT + chunk * 4096;
#pragma unroll
            for (int q = 0; q < 16; ++q) { const int row = 32 * tm + (q & 3) + 8 * (q >> 2) + 4 * hi; const float x = acc[q] + (row == col ? GC[row] : 0.f); PT[row * 64 + col] = (bf16_t)f2bf(x); } }
        else if (kind == 1) { acc = rw_tile(ARB, W1T, tm, tn, r32, hi, acc);
#pragma unroll
            for (int q = 0; q < 16; ++q) { const int t = 32 * tm + (q & 3) + 8 * (q >> 2) + 4 * hi; const float x = acc[q] + bf2f(RT[t * RWP + col]);
                P.rwQ[(size_t)(b * S_ + t0 + t) * 256 + 64 * h + col] = (bf16_t)f2bf(x); } }
        else if (kind == 2) { acc = rw_tile(UVT, BH, tm, tn, r32, hi, acc); acc = rw_tile(VT, KH, tm, tn, r32, hi, acc);
            unsigned* Gg = (unsigned*)(P.rwG + chunk * 4096) + (tm * 2 + tn) * 8 * 64 + lane;
#pragma unroll
            for (int q = 0; q < 8; ++q) Gg[q * 64] = pk2(acc[2 * q], acc[2 * q + 1]); }
        else { acc = rw_tile(ARB, UVT, tm, tn, r32, hi, acc); acc = rw_tile(ARK, VT, tm, tn, r32, hi, acc);
#pragma unroll
            for (int q = 0; q < 16; ++q) { const int t = 32 * tm + (q & 3) + 8 * (q >> 2) + 4 * hi; P.ycat[(size_t)(b * S_ + t0 + t) * 1024 + 64 * h + col] = (bf16_t)f2bf(acc[q]); } } }
    __syncthreads();
}
__device__ __forceinline__ void rw_state_unit(const KP& p, const Ptrs& P, int l, int unit, unsigned char* lds) {
    bf16_t* Sb = (bf16_t*)lds;
    const int tid = TIDX(), lane = tid & 63, wave = tid >> 6, r32 = lane & 31, hi = lane >> 5;
    const int ti = (wave >> 1) & 1, tj = wave & 1;
    f32x16 S = {};
    unsigned gq[8]; bf16x8 pq[4];
    if (wave < 4) { const size_t chunk = (size_t)unit * RW_NCH; const unsigned* Gg = (const unsigned*)(P.rwG + chunk * 4096) + (ti * 2 + tj) * 8 * 64 + lane;
#pragma unroll
        for (int q = 0; q < 8; ++q) gq[q] = Gg[q * 64];
        const bf16_t* pt = P.rwPT + chunk * 4096 + (32 * tj + r32) * 64 + 8 * hi;
#pragma unroll
        for (int ks = 0; ks < 4; ++ks) pq[ks] = *(const bf16x8*)(pt + 16 * ks); }
    for (int c = 0; c < RW_NCH; ++c) { const size_t chunk = (size_t)unit * RW_NCH + c;
        unsigned gn[8]; bf16x8 pn[4];
        if (wave < 4) { const size_t cn = chunk + (c + 1 < RW_NCH ? 1 : 0); const unsigned* Gg = (const unsigned*)(P.rwG + cn * 4096) + (ti * 2 + tj) * 8 * 64 + lane;
#pragma unroll
            for (int q = 0; q < 8; ++q) gn[q] = Gg[q * 64];
            const bf16_t* pt = P.rwPT + cn * 4096 + (32 * tj + r32) * 64 + 8 * hi;
#pragma unroll
            for (int ks = 0; ks < 4; ++ks) pn[ks] = *(const bf16x8*)(pt + 16 * ks);
#pragma unroll
            for (int q = 0; q < 16; ++q) Sb[(32 * ti + (q & 3) + 8 * (q >> 2) + 4 * hi) * RWP + 32 * tj + r32] = (bf16_t)f2bf(S[q]); }
        __syncthreads();
        { const int row = tid >> 3, ch = tid & 7; *(u32x4*)(P.rwS0 + chunk * 4096 + row * 64 + ch * 8) = *(const u32x4*)(Sb + row * RWP + ch * 8); }
        if (wave < 4) { f32x16 acc;
#pragma unroll
            for (int q = 0; q < 8; ++q) { acc[2 * q] = bflo(gq[q]); acc[2 * q + 1] = bfhi(gq[q]); }
            const bf16_t* sa = Sb + (32 * ti + r32) * RWP + 8 * hi;
#pragma unroll
            for (int ks = 0; ks < 4; ++ks) acc = MFMA32(ldsb8(sa + 16 * ks), pq[ks], acc);
            S = acc;
#pragma unroll
            for (int q = 0; q < 8; ++q) gq[q] = gn[q];
#pragma unroll
            for (int ks = 0; ks < 4; ++ks) pq[ks] = pn[ks]; }
        __syncthreads();
    }
}
template <bool DUMMY = false>
__device__ __forceinline__ void rw_out_unit(const KP& p, const Ptrs& P, int l, int unit, unsigned char* lds) {
    MEMFENCE(); OPAQUE_S(unit);
    const int c = unit % RW_NCH, bh = unit / RW_NCH, b = bh >> 2, h = bh & 3, t0 = c * 64;
    float* Yb = (float*)(lds + 81920);
    const int tid = TIDX(), lane = tid & 63, wave = tid >> 6, r32 = lane & 31, hi = lane >> 5;
    float g[8], rkv[8];
#pragma unroll
    for (int i = 0; i < 8; ++i) { const size_t o = (size_t)(b * S_ + t0 + 8 * wave + i) * 256 + 64 * h + lane; g[i] = bf2f(P.rwGt[o]); rkv[i] = bf2f(P.rwRKV[o]); }
    if (wave < 4) { const int tm = wave >> 1, tn = wave & 1; f32x16 acc; const int col = 32 * tn + r32;
        const bf16_t* yl = P.ycat + (size_t)(b * S_ + t0 + 32 * tm) * 1024 + 64 * h + col;
#pragma unroll
        for (int q = 0; q < 16; ++q) acc[q] = bf2f(yl[(size_t)((q & 3) + 8 * (q >> 2) + 4 * hi) * 1024]);
        const bf16_t* qa = P.rwQ + (size_t)(b * S_ + t0 + 32 * tm + r32) * 256 + 64 * h + 8 * hi; const bf16_t* sb = P.rwS0 + (size_t)unit * 4096 + (32 * tn + r32) * 64 + 8 * hi;
#pragma unroll
        for (int ks = 0; ks < 4; ++ks) acc = MFMA32(*(const bf16x8*)(qa + 16 * ks), *(const bf16x8*)(sb + 16 * ks), acc);
#pragma unroll
        for (int q = 0; q < 16; ++q) Yb[(32 * tm + (q & 3) + 8 * (q >> 2) + 4 * hi) * 64 + col] = acc[q]; }
    __syncthreads();
    const float gng = p.in[I_LNXG][l * 256 + 64 * h + lane], gnb = p.in[I_LNXB][l * 256 + 64 * h + lane];
    { float yv[8], m1[8], m2[8];
#pragma unroll
      for (int i = 0; i < 8; ++i) { yv[i] = Yb[(8 * wave + i) * 64 + lane]; m1[i] = yv[i]; }
      wave_sum_n<8>(m1);
#pragma unroll
      for (int i = 0; i < 8; ++i) { yv[i] -= m1[i] * (1.f / 64.f); m2[i] = yv[i] * yv[i]; }
      wave_sum_n<8>(m2);
#pragma unroll
      for (int i = 0; i < 8; ++i) { const int t = 8 * wave + i; const float yn = yv[i] * (1.0f / sqrtf(m2[i] * (1.f / 64.f) + GN_EPS_)) * gng + gnb; const float o = (yn + rkv[i]) * g[i];
        if (DUMMY) P.pb[(size_t)(b * S_ + t0 + t) * 256 + 64 * h + lane] = (bf16_t)f2bf(o);
        else P.ycat[(size_t)(b * S_ + t0 + t) * 1024 + 64 * h + lane] = (bf16_t)f2bf(o); } }
    __syncthreads();
}
#ifdef EMU_FP8_A
#define EMU_AUX77 u.aux = 77;
#else
#define EMU_AUX77
#endif
__device__ __forceinline__ void tile_map(int L, int nM, int nN, int& pm, int& pn) {
    const int nwg = nM * nN, q = nwg / 8, r = nwg % 8, xcd = L % 8, off = L / 8;
    const int wgid = (xcd < r ? xcd * (q + 1) : r * (q + 1) + (xcd - r) * q) + off;
    const int nig = 8 * nN, gid = wgid / nig, fm = gid * 8, gsz = (nM - fm) < 8 ? (nM - fm) : 8;
    pm = fm + ((wgid % nig) % gsz); pn = (wgid % nig) / gsz;
}
struct EpiStoreBf16 {
    bf16_t* base0; int ldc0; bf16_t* base1; int ldc1;
    __device__ __forceinline__ void operator()(const f32x4 (&acc)[2][2][4][2], const pg8::Unit& u, int wr, int wc, int fr, int fq, int tid) const {
        bf16_t* base = u.kind ? base1 : base0; const int ldc = u.kind ? ldc1 : ldc0;
        int row0 = u.pm * 256 + wr * 64 + fr, col0 = u.pn * 256 + wc * 32 + 8 * fq; OPAQUE(row0); OPAQUE(col0);
#pragma unroll
        for (int ai = 0; ai < 2; ++ai)
#pragma unroll
            for (int m = 0; m < 4; ++m) { bf16_t* rowp = base + (size_t)(row0 + ai * 128 + m * 16) * ldc + col0;
#pragma unroll
                for (int bj = 0; bj < 2; ++bj) { const f32x4 v0 = acc[ai][bj][m][0], v1 = acc[ai][bj][m][1];
                    u32x4 w; w.x = pk2(v0[0], v0[1]); w.y = pk2(v0[2], v0[3]); w.z = pk2(v1[0], v1[1]); w.w = pk2(v1[2], v1[3]);
                    *(u32x4*)(rowp + bj * 128) = w; } }
    }
};
template <int PART>
struct SchedA { const bf16_t* hb; const unsigned char* h8a; const unsigned char* h8b; const bf16_t* WinT; int G, c;
    __device__ __forceinline__ bool next(int i, pg8::Unit& u) const {
        const int nM = T_ / 256, n0 = nM * 9; u.aux = 0;
        if (PART == 0) { const int x = i * G + c; if (x >= n0) return false;
            tile_map(x, nM, 9, u.pm, u.pn); u.kind = 0; u.nt = 8; u.f8 = 1; const int m0 = u.pm * 256;
            u.a = (const char*)(m0 < H8_SPLIT ? h8a + (size_t)m0 * 1024 : h8b + (size_t)(m0 - H8_SPLIT) * 1024); u.b = (const char*)(WinT + (size_t)u.pn * 256 * 1024); }
        else { const int x = i * G + (c + G - n0 % G) % G; if (x >= nM) return false;
            u.pm = 0; u.pn = x; u.kind = 1; u.nt = 16; u.f8 = 0; u.a = (const char*)(WinT + (size_t)WIN_VT * 1024); u.b = (const char*)(hb + (size_t)u.pn * 256 * 1024); }
        return true; } };
struct EpiA { bf16_t* proj; const float* sc;
    __device__ __forceinline__ void operator()(const f32x4 (&acc)[2][2][4][2], const pg8::Unit& u, int wr, int wc, int fr, int fq, int tid) const {
        int row0 = u.pm * 256 + wr * 64 + fr, col0 = u.pn * 256 + wc * 32 + 8 * fq; OPAQUE(row0); OPAQUE(col0);
#pragma unroll
        for (int bj = 0; bj < 2; ++bj) { const f32x4 s0 = *(const f32x4*)(sc + col0 + bj * 128), s1 = *(const f32x4*)(sc + col0 + bj * 128 + 4);
#pragma unroll
            for (int ai = 0; ai < 2; ++ai)
#pragma unroll
                for (int m = 0; m < 4; ++m) { const f32x4 v0 = acc[ai][bj][m][0] * s0, v1 = acc[ai][bj][m][1] * s1;
                    u32x4 w; w.x = pk2(v0[0], v0[1]); w.y = pk2(v0[2], v0[3]); w.z = pk2(v1[0], v1[1]); w.w = pk2(v1[2], v1[3]);
                    *(u32x4*)(proj + (size_t)(row0 + ai * 128 + m * 16) * PJ + col0 + bj * 128) = w; } }
    }
};
__device__ __forceinline__ void phase_A0(const KP& p, unsigned char* lds) {
    const int tid = TIDX(), lane = tid & 63, wave = tid >> 6; const int gw = BIDX() * NWAVE + wave, NGW = GDIM() * NWAVE;
    for (int r = gw; r < L_ * WIN_VT; r += NGW) { const int l = r / WIN_VT, n = r % WIN_VT; const Ptrs P = make_ptrs(p.ws, l); bf16_t* row = P.WinT + (size_t)n * 1024;
        const u32x4 a = *(const u32x4*)(row + 16 * lane), b = *(const u32x4*)(row + 16 * lane + 8);
        float v[16] = {bflo(a.x), bfhi(a.x), bflo(a.y), bfhi(a.y), bflo(a.z), bfhi(a.z), bflo(a.w), bfhi(a.w), bflo(b.x), bfhi(b.x), bflo(b.y), bfhi(b.y), bflo(b.z), bfhi(b.z), bflo(b.w), bfhi(b.w)};
        float am = 0.f;
#pragma unroll
        for (int j = 0; j < 16; ++j) am = fmaxf(am, fabsf(v[j]));
        am = wave_max(am); const float sc = am > 0.f ? am * (1.0f / 440.0f) : 1.0f, inv = 1.0f / sc; u32x4 o;
#pragma unroll
        for (int j = 0; j < 4; ++j) { unsigned w = cvt_pk_fp8_f32_(v[4 * j] * inv, v[4 * j + 1] * inv, 0u, false); w = cvt_pk_fp8_f32_(v[4 * j + 2] * inv, v[4 * j + 3] * inv, w, true); o[j] = w; }
        WAVE_SYNC();
        *(u32x4*)((unsigned char*)row + 16 * lane) = o;
        if (lane == 0) P.gscA[n] = sc; }
#ifdef CPU_EMU
    (void)lds;
#endif
}
__device__ __forceinline__ void phase_A(const KP& p, int l, unsigned char* lds) {
    const Ptrs P = make_ptrs(p.ws, l);
    { SchedA<0> S{P.hb, P.h8a, P.h8b, P.WinT, GDIM(), BIDX()}; EpiA E{P.proj, P.gscA}; pg8::gemm_phase<1>((LAS unsigned char*)lds, 1024, 1024, S, E, 1024); }
    { SchedA<1> S{P.hb, P.h8a, P.h8b, P.WinT, GDIM(), BIDX()}; EpiStoreBf16 E{P.vtr, T_, P.vtr, T_}; pg8::gemm_phase<0>((LAS unsigned char*)lds, 1024, 1024, S, E); }
}
#if PROBE_REPEAT >= 40 && PROBE_REPEAT <= 49
struct SchedAP { const bf16_t* hb; const bf16_t* WinT; int G, c, nt, pnmask;
    __device__ __forceinline__ bool next(int i, pg8::Unit& u) const {
        const int nM = T_ / 256, n0 = nM * 9; const int x = i * G + c; if (x >= n0 + nM) return false;
        u.nt = nt; u.aux = 0; u.f8 = 0;
        if (x < n0) { tile_map(x, nM, 9, u.pm, u.pn); u.kind = 0; u.a = (const char*)(hb + (size_t)u.pm * 256 * 1024); u.b = (const char*)(WinT + (size_t)u.pn * 256 * 1024); }
        else { u.pm = 0; u.pn = x - n0; u.kind = 1; u.a = (const char*)(WinT + (size_t)WIN_VT * 1024); u.b = (const char*)(hb + (size_t)u.pn * 256 * 1024); }
        u.pn &= pnmask; return true; } };
struct EpiNull { float* d;
    __device__ __forceinline__ void operator()(const f32x4 (&acc)[2][2][4][2], const pg8::Unit& u, int wr, int wc, int fr, int fq, int tid) const {
        f32x4 s = (f32x4){0.f, 0.f, 0.f, 0.f};
#pragma unroll
        for (int ai = 0; ai < 2; ++ai)
#pragma unroll
            for (int m = 0; m < 4; ++m)
#pragma unroll
                for (int bj = 0; bj < 2; ++bj) s += acc[ai][bj][m][0] + acc[ai][bj][m][1];
        if (s.x + s.y + s.z + s.w == 1.2345e30f) d[tid] = s.x; } };
struct EpiStash { u32x4* stash;
    __device__ __forceinline__ void operator()(const f32x4 (&acc)[2][2][4][2], const pg8::Unit& u, int wr, int wc, int fr, int fq, int tid) const {
        OPAQUE(tid);
#pragma unroll
        for (int ai = 0; ai < 2; ++ai)
#pragma unroll
            for (int m = 0; m < 4; ++m)
#pragma unroll
                for (int bj = 0; bj < 2; ++bj) { const f32x4 v0 = acc[ai][bj][m][0], v1 = acc[ai][bj][m][1];
                    u32x4 w; w.x = pk2(v0[0], v0[1]); w.y = pk2(v0[2], v0[3]); w.z = pk2(v1[0], v1[1]); w.w = pk2(v1[2], v1[3]);
                    stash[((ai * 4 + m) * 2 + bj) * 512 + tid] = w; } } };
struct EpiFullLine { bf16_t* base;
    __device__ __forceinline__ void operator()(const f32x4 (&acc)[2][2][4][2], const pg8::Unit& u, int wr, int wc, int fr, int fq, int tid) const {
        OPAQUE(tid); if (u.kind) return;
#pragma unroll
        for (int ai = 0; ai < 2; ++ai)
#pragma unroll
            for (int m = 0; m < 4; ++m)
#pragma unroll
                for (int bj = 0; bj < 2; ++bj) { const f32x4 v0 = acc[ai][bj][m][0], v1 = acc[ai][bj][m][1]; const int k = (ai * 4 + m) * 2 + bj, L = k * 512 + tid, row = L >> 5, ch = L & 31;
                    u32x4 w; w.x = pk2(v0[0], v0[1]); w.y = pk2(v0[2], v0[3]); w.z = pk2(v1[0], v1[1]); w.w = pk2(v1[2], v1[3]);
                    *(u32x4*)(base + (size_t)(u.pm * 256 + row) * PJ + u.pn * 256 + ch * 8) = w; } } };
struct EpiProjOnly { bf16_t* base;
    __device__ __forceinline__ void operator()(const f32x4 (&acc)[2][2][4][2], const pg8::Unit& u, int wr, int wc, int fr, int fq, int tid) const {
        if (u.kind) return;
        int row0 = u.pm * 256 + wr * 64 + fr, col0 = u.pn * 256 + wc * 32 + 8 * fq; OPAQUE(row0); OPAQUE(col0);
#pragma unroll
        for (int ai = 0; ai < 2; ++ai)
#pragma unroll
            for (int m = 0; m < 4; ++m) { bf16_t* rowp = base + (size_t)(row0 + ai * 128 + m * 16) * PJ + col0;
#pragma unroll
                for (int bj = 0; bj < 2; ++bj) { const f32x4 v0 = acc[ai][bj][m][0], v1 = acc[ai][bj][m][1];
                    u32x4 w; w.x = pk2(v0[0], v0[1]); w.y = pk2(v0[2], v0[3]); w.z = pk2(v1[0], v1[1]); w.w = pk2(v1[2], v1[3]);
                    *(u32x4*)(rowp + bj * 128) = w; } } } };
template <int V>
__device__ __forceinline__ void phase_Aprobe(const KP& p, int l, unsigned char* lds) {
    const Ptrs P = make_ptrs(p.ws, l);
    SchedAP S{P.hb, P.WinT, GDIM(), BIDX(), V == 1 ? 32 : V == 3 ? 4 : V == 4 ? 8 : V == 5 ? 64 : 16, V == 6 ? 3 : 0xffff};
    if (V == 7) { EpiFullLine E{P.proj}; pg8::gemm_phase((LAS unsigned char*)lds, 1024, 1024, S, E); }
    else if (V == 8) { EpiProjOnly E{P.proj}; pg8::gemm_phase((LAS unsigned char*)lds, 1024, 1024, S, E); }
    else if (V == 2) { EpiStash E{(u32x4*)(P.ycat + (size_t)BIDX() * 65536)}; pg8::gemm_phase((LAS unsigned char*)lds, 1024, 1024, S, E); }
    else if (V == 6) { EpiStoreBf16 E{P.ycat, 1024, P.ycat, 1024}; pg8::gemm_phase((LAS unsigned char*)lds, 1024, 1024, S, E); }
    else { EpiNull E{(float*)(P.ycat + (size_t)BIDX() * 65536)}; pg8::gemm_phase((LAS unsigned char*)lds, 1024, 1024, S, E); }
}
#endif
struct SchedGlu { const bf16_t* ycat; const bf16_t* GluT; int G, c;
    __device__ __forceinline__ bool next(int i, pg8::Unit& u) const {
        const int x = i * G + c; if (x >= T_ / 256) return false;
        u.pm = x; u.pn = 0; u.nt = 4; u.kind = 0; u.aux = 0; u.f8 = 0; u.a = (const char*)(ycat + (size_t)x * 256 * 1024 + 256); u.b = (const char*)GluT; return true; } };
struct EpiGlu { bf16_t* ycat; const float* glub;
    __device__ __forceinline__ void operator()(const f32x4 (&acc)[2][2][4][2], const pg8::Unit& u, int wr, int wc, int fr, int fq, int tid) const {
        int row0 = u.pm * 256 + wr * 64 + fr, col0 = wc * 32 + 8 * fq; OPAQUE(row0); OPAQUE(col0);
#pragma unroll
        for (int bj = 0; bj < 2; ++bj) { const f32x4 b0 = *(const f32x4*)(glub + col0 + bj * 128), b1 = *(const f32x4*)(glub + col0 + bj * 128 + 4);
#pragma unroll
            for (int ai = 0; ai < 2; ++ai)
#pragma unroll
                for (int m = 0; m < 4; ++m) { bf16_t* ptr = ycat + (size_t)(row0 + ai * 128 + m * 16) * 1024 + 256 + col0 + bj * 128;
                    const u32x4 y = *(const u32x4*)ptr; const f32x4 v0 = acc[ai][bj][m][0] + b0, v1 = acc[ai][bj][m][1] + b1;
                    u32x4 w; w.x = pk2(bflo(y.x) * sigmoidf_(v0[0]), bfhi(y.x) * sigmoidf_(v0[1])); w.y = pk2(bflo(y.y) * sigmoidf_(v0[2]), bfhi(y.y) * sigmoidf_(v0[3]));
                    w.z = pk2(bflo(y.z) * sigmoidf_(v1[0]), bfhi(y.z) * sigmoidf_(v1[1])); w.w = pk2(bflo(y.w) * sigmoidf_(v1[2]), bfhi(y.w) * sigmoidf_(v1[3]));
                    *(u32x4*)ptr = w; MEMFENCE(); } }
    }
};
__device__ __forceinline__ void convert_tables(const KP& p, const Ptrs& P, int l, unsigned char* lds) {
    const int tid = TIDX(), lane = tid & 63, wave = tid >> 6;
    unsigned* cnt = (unsigned*)(p.ws + WS_CTL) + 10240 + 16 * l; int* slot = (int*)(lds + 65536);
    const float* ps = p.in[I_P] + (size_t)l * T_ * 256;
    constexpr int NG8 = 5120 / 128, NTAB = 2 * NEXP / 128, NPB = (int)(((size_t)T_ * 256 / 8 + 4095) / 4096);
    for (;;) {
        __syncthreads(); if (tid == 0) *slot = (int)atomicAdd(cnt, 1u); __syncthreads();
        int item = *slot; if (item >= NG8 + NTAB + NPB) break;
        if (item < NG8) {
            for (int rr = wave; rr < 128; rr += NWAVE) { const int r5 = item * 128 + rr; bf16_t* row = r5 < 4096 ? P.WinT + (size_t)(WIN_GATE + r5) * 1024 : P.PleGT + (size_t)(r5 - 4096) * 1024;
                const u32x4 a = *(const u32x4*)(row + 16 * lane), b = *(const u32x4*)(row + 16 * lane + 8);
                float v[16] = {bflo(a.x), bfhi(a.x), bflo(a.y), bfhi(a.y), bflo(a.z), bfhi(a.z), bflo(a.w), bfhi(a.w), bflo(b.x), bfhi(b.x), bflo(b.y), bfhi(b.y), bflo(b.z), bfhi(b.z), bflo(b.w), bfhi(b.w)};
                float am = 0.f;
#pragma unroll
                for (int j = 0; j < 16; ++j) am = fmaxf(am, fabsf(v[j]));
                am = wave_max(am); const float sc = am > 0.f ? am * (1.0f / 440.0f) : 1.0f, inv = 1.0f / sc; u32x4 o;
#pragma unroll
                for (int j = 0; j < 4; ++j) { unsigned w = cvt_pk_fp8_f32_(v[4 * j] * inv, v[4 * j + 1] * inv, 0u, false); w = cvt_pk_fp8_f32_(v[4 * j + 2] * inv, v[4 * j + 3] * inv, w, true); o[j] = w; }
                WAVE_SYNC();
                *(u32x4*)((unsigned char*)row + 16 * lane) = o;
                if (lane == 0) P.gsc[r5] = sc; }
            continue; }
        item -= NG8;
        if (item < NTAB) {
            for (int r4 = 0; r4 < 16; r4 += 4) { f32x4 v[4][4]; float am[4];
#pragma unroll
                for (int q = 0; q < 4; ++q) { const int it = item * 128 + wave + 8 * (r4 + q); const int tb = it >= NEXP, row = tb ? it - NEXP : it;
                    const float* src = p.in[tb ? I_V : I_U] + ((size_t)l * NEXP + row) * 1024 + 16 * lane; am[q] = 0.f;
#pragma unroll
                    for (int j = 0; j < 4; ++j) { v[q][j] = *(const f32x4*)(src + 4 * j); am[q] = fmaxf(am[q], fmaxf(fmaxf(fabsf(v[q][j].x), fabsf(v[q][j].y)), fmaxf(fabsf(v[q][j].z), fabsf(v[q][j].w)))); } }
#pragma unroll
                for (int q = 0; q < 4; ++q) { const int it = item * 128 + wave + 8 * (r4 + q); const int tb = it >= NEXP, row = tb ? it - NEXP : it;
                    const float amx = wave_max(am[q]); const float sc = amx > 0.f ? amx * (1.0f / 440.0f) : 1.0f, inv = 1.0f / sc; u32x4 o;
#pragma unroll
                    for (int j = 0; j < 4; ++j) { unsigned w = cvt_pk_fp8_f32_(v[q][j].x * inv, v[q][j].y * inv, 0u, false); w = cvt_pk_fp8_f32_(v[q][j].z * inv, v[q][j].w * inv, w, true); o[j] = w; }
                    *(u32x4*)((tb ? P.V8 : P.U8) + ((size_t)(lane >> 3) * NEXP + row) * 128 + 16 * (lane & 7)) = o;
                    if (lane == 0) (tb ? P.sv : P.su)[row] = sc; } }
        } else {
            const size_t base = (size_t)(item - NTAB) * 4096;
            f32x4 a[8], bq[8];
#pragma unroll
            for (int j = 0; j < 8; ++j) { const size_t i = base + tid + (size_t)j * NTHR; a[j] = (f32x4){0.f, 0.f, 0.f, 0.f}; bq[j] = a[j];
                if (i < (size_t)T_ * 256 / 8) { a[j] = *(const f32x4*)(ps + i * 8); bq[j] = *(const f32x4*)(ps + i * 8 + 4); } }
#pragma unroll
            for (int j = 0; j < 8; ++j) { const size_t i = base + tid + (size_t)j * NTHR;
                if (i < (size_t)T_ * 256 / 8) { u32x4 o; o.x = pk2(a[j].x, a[j].y); o.y = pk2(a[j].z, a[j].w); o.z = pk2(bq[j].x, bq[j].y); o.w = pk2(bq[j].z, bq[j].w); *(u32x4*)(P.pb + i * 8) = o; } }
        }
    }
}
__device__ __forceinline__ void phase_B2(const KP& p, int l, unsigned char* lds) {
    const Ptrs P = make_ptrs(p.ws, l);
    constexpr int NRW = NB_ * 4; const int G = GDIM(), c = BIDX();
    int gG = G, gc = c;
    if (G > NRW) { if (c < NRW) { rw_state_unit(p, P, l, c, lds);
#if PROBE_REPEAT == 35
        rw_state_unit(p, P, l, c, lds);
#endif
        convert_tables(p, P, l, lds); return; } gG = G - NRW; gc = c - NRW; }
    else { for (int u = c; u < NRW; u += G) rw_state_unit(p, P, l, u, lds); }
    SchedGlu S{P.ycat, P.GluT, gG, gc};
    EpiGlu E{P.ycat, p.in[I_GLUB] + l * 256};
    pg8::gemm_phase((LAS unsigned char*)lds, 1024, 256, S, E);
    convert_tables(p, P, l, lds);
}
struct SchedC { const unsigned char* h8a; const unsigned char* h8b; const bf16_t* ycat; const bf16_t* WinT; const bf16_t* WbrT; int G, c;
    __device__ __forceinline__ bool next(int i, pg8::Unit& u) const {
        const int tile = (i >> 3) * G + c; if (tile >= (T_ / 256) * 4) return false;
        const int j = i & 7, b = j >> 1; tile_map(tile, T_ / 256, 4, u.pm, u.pn); u.aux = b;
        if (!(j & 1)) { u.kind = 0; u.nt = 4; u.f8 = 0; u.a = (const char*)(ycat + (size_t)u.pm * 256 * 1024 + 256 * b); u.b = (const char*)(WbrT + (size_t)u.pn * 256 * 1024 + 256 * b); }
        else { u.kind = 1; u.nt = 8; u.f8 = 1; const int m0 = u.pm * 256;
            u.a = (const char*)(m0 < H8_SPLIT ? h8a + (size_t)m0 * 1024 : h8b + (size_t)(m0 - H8_SPLIT) * 1024); u.b = (const char*)(WinT + (size_t)(WIN_GATE + 1024 * b + 256 * u.pn) * 1024); }
        return true; } };
struct EpiC { u32x4* stash; bf16_t* merged; const float* gsc;
    __device__ __forceinline__ void operator()(const f32x4 (&acc)[2][2][4][2], const pg8::Unit& u, int wr, int wc, int fr, int fq, int tid) const {
        OPAQUE(tid);
        if (u.kind == 0) {
#pragma unroll
            for (int ai = 0; ai < 2; ++ai)
#pragma unroll
                for (int m = 0; m < 4; ++m)
#pragma unroll
                    for (int bj = 0; bj < 2; ++bj) { const f32x4 v0 = acc[ai][bj][m][0], v1 = acc[ai][bj][m][1];
                        u32x4 w; w.x = pk2(v0[0], v0[1]); w.y = pk2(v0[2], v0[3]); w.z = pk2(v1[0], v1[1]); w.w = pk2(v1[2], v1[3]);
                        stash[((ai * 4 + m) * 2 + bj) * 512 + tid] = w; }
        } else {
            int row0 = u.pm * 256 + wr * 64 + fr, col0 = u.pn * 256 + wc * 32 + 8 * fq; OPAQUE(row0); OPAQUE(col0); const bool first = (u.aux == 0);
            f32x4 sc[2][2];
#pragma unroll
            for (int bj = 0; bj < 2; ++bj) { const float* sp = gsc + 1024 * u.aux + col0 + bj * 128; sc[bj][0] = *(const f32x4*)sp; sc[bj][1] = *(const f32x4*)(sp + 4); }
#pragma unroll
            for (int ai = 0; ai < 2; ++ai)
#pragma unroll
                for (int mp = 0; mp < 2; ++mp) { u32x4 y[4], mo[4];
#pragma unroll
                    for (int q = 0; q < 4; ++q) { const int m = 2 * mp + (q >> 1), bj = q & 1;
                        y[q] = stash[((ai * 4 + m) * 2 + bj) * 512 + tid]; mo[q] = (u32x4){0u, 0u, 0u, 0u};
                        if (!first) mo[q] = *(const u32x4*)(merged + (size_t)(row0 + ai * 128 + m * 16) * 1024 + col0 + bj * 128); }
#pragma unroll
                    for (int q = 0; q < 4; ++q) { const int m = 2 * mp + (q >> 1), bj = q & 1; const f32x4 g0 = acc[ai][bj][m][0] * sc[bj][0], g1 = acc[ai][bj][m][1] * sc[bj][1];
                        bf16_t* ptr = merged + (size_t)(row0 + ai * 128 + m * 16) * 1024 + col0 + bj * 128;
                        const float o0 = bflo(y[q].x) * sigmoidf_(g0[0]) + bflo(mo[q].x), o1 = bfhi(y[q].x) * sigmoidf_(g0[1]) + bfhi(mo[q].x), o2 = bflo(y[q].y) * sigmoidf_(g0[2]) + bflo(mo[q].y), o3 = bfhi(y[q].y) * sigmoidf_(g0[3]) + bfhi(mo[q].y);
                        const float o4 = bflo(y[q].z) * sigmoidf_(g1[0]) + bflo(mo[q].z), o5 = bfhi(y[q].z) * sigmoidf_(g1[1]) + bfhi(mo[q].z), o6 = bflo(y[q].w) * sigmoidf_(g1[2]) + bflo(mo[q].w), o7 = bfhi(y[q].w) * sigmoidf_(g1[3]) + bfhi(mo[q].w);
                        u32x4 w; w.x = pk2(o0, o1); w.y = pk2(o2, o3); w.z = pk2(o4, o5); w.w = pk2(o6, o7);
                        *(u32x4*)ptr = w; }
                    MEMFENCE(); }
        }
    }
};
__device__ __forceinline__ void phase_C(const KP& p, int l, unsigned char* lds) {
    const Ptrs P = make_ptrs(p.ws, l);
    SchedC S{P.h8a, P.h8b, P.ycat, P.WinT, P.WbrT, GDIM(), BIDX()};
    EpiC E{(u32x4*)(P.stash + (size_t)BIDX() * 131072), P.merged, P.gsc};
    pg8::gemm_phase<2>((LAS unsigned char*)lds, 1024, 1024, S, E, 1024);
}
struct SchedD { const bf16_t* A; const bf16_t* Bt; int nN, G, c;
    __device__ __forceinline__ bool next(int i, pg8::Unit& u) const {
        const int x = i * G + c; if (x >= (T_ / 256) * nN) return false;
        tile_map(x, T_ / 256, nN, u.pm, u.pn); u.nt = 16; u.kind = 0; u.aux = 0; u.f8 = 0; u.a = (const char*)(A + (size_t)u.pm * 256 * 1024); u.b = (const char*)(Bt + (size_t)u.pn * 256 * 1024); return true; } };
struct EpiResid { bf16_t* ob; const bf16_t* hb;
    __device__ __forceinline__ void operator()(const f32x4 (&acc)[2][2][4][2], const pg8::Unit& u, int wr, int wc, int fr, int fq, int tid) const {
        int row0 = u.pm * 256 + wr * 64 + fr, col0 = u.pn * 256 + wc * 32 + 8 * fq; OPAQUE(row0); OPAQUE(col0);
#pragma unroll
        for (int ai = 0; ai < 2; ++ai)
#pragma unroll
            for (int m = 0; m < 4; ++m)
#pragma unroll
                for (int bj = 0; bj < 2; ++bj) { const size_t o = (size_t)(row0 + ai * 128 + m * 16) * 1024 + col0 + bj * 128; const u32x4 hw = *(const u32x4*)(hb + o);
                    const f32x4 a0 = acc[ai][bj][m][0], a1 = acc[ai][bj][m][1]; u32x4 w;
                    w.x = pk2(bflo(hw.x) * DN_ALPHA_ + a0[0], bfhi(hw.x) * DN_ALPHA_ + a0[1]); w.y = pk2(bflo(hw.y) * DN_ALPHA_ + a0[2], bfhi(hw.y) * DN_ALPHA_ + a0[3]);
                    w.z = pk2(bflo(hw.z) * DN_ALPHA_ + a1[0], bfhi(hw.z) * DN_ALPHA_ + a1[1]); w.w = pk2(bflo(hw.w) * DN_ALPHA_ + a1[2], bfhi(hw.w) * DN_ALPHA_ + a1[3]);
                    *(u32x4*)(ob + o) = w; }
    }
};
__device__ __forceinline__ void phase_D(const KP& p, int l, unsigned char* lds) {
    const Ptrs P = make_ptrs(p.ws, l);
    SchedD S{P.merged, P.WoutT, 4, GDIM(), BIDX()};
    EpiResid E{P.ycat, P.hb};
    pg8::gemm_phase((LAS unsigned char*)lds, 1024, 1024, S, E);
}
__device__ __forceinline__ void phase_D2(const KP& p, int l, unsigned char* lds) {
    const Ptrs P = make_ptrs(p.ws, l);
    const int tid = TIDX(), lane = tid & 63, wave = tid >> 6; const int gw = BIDX() * NWAVE + wave, NGW = GDIM() * NWAVE;
    for (int m = 4 * gw; m < T_; m += 4 * NGW) ln_rows<4, true>(P.ycat + (size_t)m * 1024, p.in[I_LN1G] + l * 1024, p.in[I_LN1B] + l * 1024, (float*)nullptr, P.hb + (size_t)m * 1024, P.h8e + (size_t)m * 1024, lane);
}
struct SchedE1 { const bf16_t* pb; const bf16_t* PleT; int G, c;
    __device__ __forceinline__ bool next(int i, pg8::Unit& u) const {
        const int x = i * G + c; if (x >= (T_ / 256) * 4) return false;
        tile_map(x, T_ / 256, 4, u.pm, u.pn); u.nt = 4; u.kind = 0; u.aux = 0; u.f8 = 0; u.a = (const char*)(pb + (size_t)u.pm * 256 * 256); u.b = (const char*)(PleT + (size_t)u.pn * 256 * 256); return true; } };
template <int PART>
struct SchedE2 { const bf16_t* hb; const unsigned char* h8e; const bf16_t* PleGT; const bf16_t* WqT; int G, c;
    __device__ __forceinline__ bool next(int i, pg8::Unit& u) const {
        const int n0 = (T_ / 256) * 4; int x = i * G + c + (PART ? n0 : 0); if (x >= (PART ? n0 + (T_ / 256) * 8 : n0)) return false;
        u.aux = 0;
        if (x < n0) { tile_map(x, T_ / 256, 4, u.pm, u.pn); u.kind = 0; u.nt = 8; u.f8 = 1; u.b = (const char*)(PleGT + (size_t)u.pn * 256 * 1024); u.a = (const char*)(h8e + (size_t)u.pm * 256 * 1024); }
        else { x -= n0; tile_map(x, T_ / 256, 8, u.pm, u.pn); u.kind = 1; u.nt = 16; u.f8 = 0; u.b = (const char*)(WqT + (size_t)u.pn * 256 * 1024); u.a = (const char*)(hb + (size_t)u.pm * 256 * 1024); }
        return true; } };
struct EpiE2g { const bf16_t* hb; bf16_t* Pbuf; const float* gsc;
    __device__ __forceinline__ void operator()(const f32x4 (&acc)[2][2][4][2], const pg8::Unit& u, int wr, int wc, int fr, int fq, int tid) const {
        int row0 = u.pm * 256 + wr * 64 + fr, col0 = u.pn * 256 + wc * 32 + 8 * fq; OPAQUE(row0); OPAQUE(col0);
#pragma unroll
        for (int bj = 0; bj < 2; ++bj) { const float* sp = gsc + 4096 + col0 + bj * 128; const f32x4 s0 = *(const f32x4*)sp, s1 = *(const f32x4*)(sp + 4);
            const size_t cb = (size_t)row0 * 1024 + col0 + bj * 128; const bf16_t* hp = hb + cb; bf16_t* pp = Pbuf + cb;
#pragma unroll
            for (int ai = 0; ai < 2; ++ai)
#pragma unroll
                for (int mp = 0; mp < 2; ++mp) { u32x4 y[2], hw[2];
#pragma unroll
                    for (int q = 0; q < 2; ++q) { const int ro = (ai * 128 + (2 * mp + q) * 16) * 1024; y[q] = *(const u32x4*)(pp + ro); hw[q] = *(const u32x4*)(hp + ro); }
#pragma unroll
                    for (int q = 0; q < 2; ++q) { const int m = 2 * mp + q; const int ro = (ai * 128 + m * 16) * 1024; const f32x4 v0 = acc[ai][bj][m][0] * s0, v1 = acc[ai][bj][m][1] * s1;
                        u32x4 w;
                        w.x = pk2(bflo(hw[q].x) * DN_ALPHA_ + bflo(y[q].x) * sigmoidf_(v0[0]), bfhi(hw[q].x) * DN_ALPHA_ + bfhi(y[q].x) * sigmoidf_(v0[1]));
                        w.y = pk2(bflo(hw[q].y) * DN_ALPHA_ + bflo(y[q].y) * sigmoidf_(v0[2]), bfhi(hw[q].y) * DN_ALPHA_ + bfhi(y[q].y) * sigmoidf_(v0[3]));
                        w.z = pk2(bflo(hw[q].z) * DN_ALPHA_ + bflo(y[q].z) * sigmoidf_(v1[0]), bfhi(hw[q].z) * DN_ALPHA_ + bfhi(y[q].z) * sigmoidf_(v1[1]));
                        w.w = pk2(bflo(hw[q].w) * DN_ALPHA_ + bflo(y[q].w) * sigmoidf_(v1[2]), bfhi(hw[q].w) * DN_ALPHA_ + bfhi(y[q].w) * sigmoidf_(v1[3]));
                        *(u32x4*)(pp + ro) = w; }
                    MEMFENCE(); } }
    }
};
__device__ __forceinline__ void phase_E(const KP& p, int l, unsigned char* lds) {
    const Ptrs P = make_ptrs(p.ws, l);
    { SchedE1 S{P.pb, P.PleT, GDIM(), BIDX()}; EpiStoreBf16 E{P.ycat, 1024, P.ycat, 1024}; pg8::gemm_phase((LAS unsigned char*)lds, 256, 256, S, E); }
    { SchedE2<0> S{P.hb, P.h8e, P.PleGT, P.WqT, GDIM(), BIDX()}; EpiE2g E{P.hb, P.ycat, P.gsc}; pg8::gemm_phase<1>((LAS unsigned char*)lds, 1024, 1024, S, E, 1024); }
    { SchedE2<1> S{P.hb, P.h8e, P.PleGT, P.WqT, GDIM(), BIDX()}; EpiStoreBf16 E{P.q, 2048, P.q, 2048}; pg8::gemm_phase<0>((LAS unsigned char*)lds, 1024, 1024, S, E); }
}
__device__ __forceinline__ unsigned mono_key(float f) { const unsigned u = __builtin_bit_cast(unsigned, f); return (u & 0x80000000u) ? ~u : (u | 0x80000000u); }
__device__ __forceinline__ float unmono_key(unsigned k) { const unsigned u = (k & 0x80000000u) ? (k ^ 0x80000000u) : ~k; return __builtin_bit_cast(float, u); }
struct CandTab { int a[50], b[50]; };
constexpr CandTab make_cand() { CandTab t{}; int n = 0; for (int a = 0; a < 16; ++a) for (int b = 0; b < 16; ++b) if ((a + 1) * (b + 1) <= 16) { t.a[n] = a; t.b[n] = b; ++n; } return t; }
constexpr CandTab CAND = make_cand();
constexpr int PK_PITCH = 136;

#define PK_CE(x, y) do { const unsigned _a = (x), _b = (y); (x) = _a > _b ? _a : _b; (y) = _a > _b ? _b : _a; } while (0)
__device__ __forceinline__ void bitonic_merge16_desc(unsigned (&a)[16]) {
#pragma unroll
    for (int j = 8; j > 0; j >>= 1)
#pragma unroll
        for (int i = 0; i < 16; ++i) { const int l = i ^ j; if (l > i) PK_CE(a[i], a[l]); }
}
__device__ __forceinline__ void bitonic_sort16_desc(unsigned (&a)[16]) {
#pragma unroll
    for (int k = 2; k <= 16; k <<= 1)
#pragma unroll
        for (int j = k >> 1; j > 0; j >>= 1)
#pragma unroll
            for (int i = 0; i < 16; ++i) { const int l = i ^ j; if (l > i) { if ((i & k) == 0 || k == 16) PK_CE(a[i], a[l]); else PK_CE(a[l], a[i]); } }
}
__device__ __forceinline__ void top_half_merge16(unsigned (&a)[16], const unsigned (&b)[16]) {
#pragma unroll
    for (int i = 0; i < 16; ++i) a[i] = a[i] > b[15 - i] ? a[i] : b[15 - i];
    bitonic_merge16_desc(a);
}
__device__ __forceinline__ void top16_keys(const unsigned (&key)[64], unsigned (&top)[16]) {
    unsigned g0[16], g1[16], g2[16], g3[16];
#pragma unroll
    for (int i = 0; i < 16; ++i) { g0[i] = key[i]; g1[i] = key[16 + i]; g2[i] = key[32 + i]; g3[i] = key[48 + i]; }
    bitonic_sort16_desc(g0); bitonic_sort16_desc(g1); bitonic_sort16_desc(g2); bitonic_sort16_desc(g3);
    top_half_merge16(g0, g1); top_half_merge16(g2, g3); top_half_merge16(g0, g2);
    unsigned pr[16];
#pragma unroll
    for (int i = 0; i < 16; ++i) pr[i] = (unsigned)__shfl_xor((int)g0[i], 32);
    top_half_merge16(g0, pr);
#pragma unroll
    for (int i = 0; i < 16; ++i) top[i] = g0[i];
}
__device__ __forceinline__ void peer_route_unit(const KP& p, const Ptrs& P, int l, int unit, unsigned char* lds) {
    const bf16_t* Ks = (const bf16_t*)lds;
    const int tid = TIDX(), lane = tid & 63, wave = tid >> 6, r32 = lane & 31, hi = lane >> 5;
    const int tok = unit * 32 + r32;
    int kbase = r32 * PK_PITCH + 8 * hi; OPAQUE(kbase);
    unsigned top1[16], top2[16];
#pragma unroll 1
    for (int half = 0; half < 2; ++half) {
        const bf16_t* qp = P.q + (size_t)tok * 2048 + wave * 256 + half * 128 + 8 * hi;
        bf16x8 qf[8];
#pragma unroll
        for (int ks = 0; ks < 8; ++ks) qf[ks] = *(const bf16x8*)(qp + 16 * ks);
        unsigned key[64];
#pragma unroll
        for (int kt = 0; kt < 4; ++kt) { f32x16 acc = {}; const bf16_t* kp = Ks + (half * 128 + 32 * kt) * PK_PITCH + kbase;
#pragma unroll
            for (int ks = 0; ks < 8; ++ks) { const bf16x8 a = *(const bf16x8*)(kp + 16 * ks); acc = MFMA32(a, qf[ks], acc); }
#pragma unroll
            for (int r = 0; r < 16; ++r) { const int idx = 32 * kt + (r & 3) + 8 * (r >> 2) + 4 * hi; key[16 * kt + r] = (mono_key(acc[r]) & ~127u) | (unsigned)(127 - idx); } }
        if (half == 0) top16_keys(key, top1); else top16_keys(key, top2);
        MEMFENCE();
    }
    MEMFENCE();
    int* islot = (int*)(lds + 2 * 128 * PK_PITCH * 2) + (wave * 32 + r32) * 33;
    float v1[16], v2[16];
#pragma unroll
    for (int r = 0; r < 16; ++r) { v1[r] = unmono_key(top1[r] & ~127u); v2[r] = unmono_key(top2[r] & ~127u); islot[16 * hi + r] = 127 - (int)((hi ? top2[r] : top1[r]) & 127u); }
    unsigned ka[16], kb[16];
#pragma unroll
    for (int i = 0; i < 25; ++i) { const int c0 = 2 * i, c1 = 2 * i + 1;
        const float s = hi ? (v1[CAND.a[c1]] + v2[CAND.b[c1]]) : (v1[CAND.a[c0]] + v2[CAND.b[c0]]);
        const unsigned k = (mono_key(s) & ~255u) | (unsigned)(255 - (hi ? 16 * CAND.a[c1] + CAND.b[c1] : 16 * CAND.a[c0] + CAND.b[c0]));
        if (i < 16) ka[i] = k; else kb[i - 16] = k; }
#pragma unroll
    for (int i = 9; i < 16; ++i) kb[i] = 0u;
    bitonic_sort16_desc(ka); bitonic_sort16_desc(kb); top_half_merge16(ka, kb);
    { unsigned pr[16];
#pragma unroll
      for (int i = 0; i < 16; ++i) pr[i] = (unsigned)__shfl_xor((int)ka[i], 32);
      top_half_merge16(ka, pr); }
    WAVE_SYNC();
    float sc[16]; int se[16];
#pragma unroll
    for (int r = 0; r < 16; ++r) { sc[r] = unmono_key(ka[r] & ~255u); se[r] = 0; }
#pragma unroll
    for (int r = 0; r < 8; ++r) { unsigned mlo = ka[r], mhi = ka[8 + r]; OPAQUE(mlo); OPAQUE(mhi);
        const unsigned m = hi ? mhi : mlo; const int ab = 255 - (int)(m & 255u); const int e = islot[ab >> 4] * 128 + islot[16 + (ab & 15)];
        if (hi) se[8 + r] = e; else se[r] = e; }
    WAVE_SYNC();
    float g[16]; float sum = 0.f;
#pragma unroll
    for (int r = 0; r < 16; ++r) { g[r] = __expf(sc[r] - sc[0]); sum += g[r]; }
    const float inv = 1.0f / sum;
    const size_t ob = (size_t)tok * 128 + wave * 16 + 8 * hi;
    if (hi == 0) {
        *(u32x4*)(P.eid + ob) = (u32x4){(unsigned)se[0], (unsigned)se[1], (unsigned)se[2], (unsigned)se[3]}; *(u32x4*)(P.eid + ob + 4) = (u32x4){(unsigned)se[4], (unsigned)se[5], (unsigned)se[6], (unsigned)se[7]};
        *(f32x4*)(P.gate + ob) = (f32x4){g[0] * inv, g[1] * inv, g[2] * inv, g[3] * inv}; *(f32x4*)(P.gate + ob + 4) = (f32x4){g[4] * inv, g[5] * inv, g[6] * inv, g[7] * inv};
    } else {
        *(u32x4*)(P.eid + ob) = (u32x4){(unsigned)se[8], (unsigned)se[9], (unsigned)se[10], (unsigned)se[11]}; *(u32x4*)(P.eid + ob + 4) = (u32x4){(unsigned)se[12], (unsigned)se[13], (unsigned)se[14], (unsigned)se[15]};
        *(f32x4*)(P.gate + ob) = (f32x4){g[8] * inv, g[9] * inv, g[10] * inv, g[11] * inv}; *(f32x4*)(P.gate + ob + 4) = (f32x4){g[12] * inv, g[13] * inv, g[14] * inv, g[15] * inv};
    }
}
__device__ __forceinline__ void phase_F(const KP& p, int l, unsigned char* lds) {
    const Ptrs P = make_ptrs(p.ws, l);
    bf16_t* Ks = (bf16_t*)lds; const int tid = TIDX();
    for (int e = tid; e < 2 * 128 * 16; e += NTHR) { const int row = e >> 4, ch = e & 15; *(u32x4*)(Ks + row * PK_PITCH + ch * 8) = *(const u32x4*)(P.K12 + row * 128 + ch * 8); }
    __syncthreads();
    for (int u = BIDX(); u < T_ / 32; u += GDIM()) peer_route_unit(p, P, l, u, lds);
    __syncthreads();
}
constexpr int PG_TB = (T_ >= 4096 ? 128 : 64), PG_NBLK = T_ / PG_TB;
__device__ __forceinline__ int peer_next_item(unsigned* cnt, int* slot, int tid) {
    __syncthreads();
    if (tid == 0) *slot = (int)atomicAdd(cnt, 1u);
    __syncthreads();
    return *slot;
}
constexpr int PG_TPW = PG_TB / NWAVE;
constexpr int PG_WLDS = 6144;
__device__ __forceinline__ void pg_issue_rows(const unsigned char* T8, int x, int c8, int gq, int lane, int e0, int e1, int* E, u32x4 (&rb)[16]) {
    WAVE_SYNC(); E[lane] = e0; E[64 + lane] = e1; WAVE_SYNC();
#pragma unroll
    for (int k = 0; k < 16; ++k) { const unsigned off = ((unsigned)(x * NEXP) + (unsigned)E[gq + 8 * k]) * 128u + 16u * (unsigned)c8; rb[k] = *(const u32x4*)(T8 + off); }
}
__device__ __forceinline__ void pg_dots_compute(const Ptrs& P, int x, int t, const u32x4 (&ub)[16], u32x4 xa, u32x4 xb, float* R, int lane) {
    const f32x2 x0 = (f32x2){bflo(xa.x), bfhi(xa.x)}, x1 = (f32x2){bflo(xa.y), bfhi(xa.y)}, x2 = (f32x2){bflo(xa.z), bfhi(xa.z)}, x3 = (f32x2){bflo(xa.w), bfhi(xa.w)};
    const f32x2 x4 = (f32x2){bflo(xb.x), bfhi(xb.x)}, x5 = (f32x2){bflo(xb.y), bfhi(xb.y)}, x6 = (f32x2){bflo(xb.z), bfhi(xb.z)}, x7 = (f32x2){bflo(xb.w), bfhi(xb.w)};
    WAVE_SYNC();
#pragma unroll
    for (int k = 0; k < 16; ++k) { f32x2 s = cvt_pk_f32_fp8_(ub[k][0], false) * x0; s += cvt_pk_f32_fp8_(ub[k][0], true) * x1; s += cvt_pk_f32_fp8_(ub[k][1], false) * x2; s += cvt_pk_f32_fp8_(ub[k][1], true) * x3;
        s += cvt_pk_f32_fp8_(ub[k][2], false) * x4; s += cvt_pk_f32_fp8_(ub[k][2], true) * x5; s += cvt_pk_f32_fp8_(ub[k][3], false) * x6; s += cvt_pk_f32_fp8_(ub[k][3], true) * x7;
        R[k * 64 + lane] = s.x + s.y; }
    WAVE_SYNC();
    const f32x4 a0 = *(const f32x4*)(R + 8 * lane), a1 = *(const f32x4*)(R + 8 * lane + 4), b0 = *(const f32x4*)(R + 512 + 8 * lane), b1 = *(const f32x4*)(R + 512 + 8 * lane + 4);
    float* pd = P.pd + ((size_t)x * T_ + t) * 128;
    pd[lane] = ((a0[0] + a0[1]) + (a0[2] + a0[3])) + ((a1[0] + a1[1]) + (a1[2] + a1[3]));
    pd[64 + lane] = ((b0[0] + b0[1]) + (b0[2] + b0[3])) + ((b1[0] + b1[1]) + (b1[2] + b1[3]));
}
__device__ __forceinline__ void peer_dots_item(const Ptrs& P, int x, int blk, unsigned char* lds, int lane, int wave) {
    float* R = (float*)(lds + wave * PG_WLDS); int* E = (int*)(lds + wave * PG_WLDS + 4096);
    const int gq = lane >> 3, c8 = lane & 7, tb = blk * PG_TB + PG_TPW * wave;
    u32x4 uA[16], uB[16], xa0, xb0, xa1, xb1;
    const bf16_t* xp = P.hb + (size_t)tb * 1024 + 128 * x + 16 * c8; const int* ep = P.eid + (size_t)tb * 128 + lane;
    int ea0 = ep[0], ea1 = ep[64], eb0 = ep[128], eb1 = ep[192];
    pg_issue_rows(P.U8, x, c8, gq, lane, ea0, ea1, E, uA); xa0 = *(const u32x4*)xp; xb0 = *(const u32x4*)(xp + 8);
#pragma unroll 1
    for (int i = 0; i < PG_TPW; i += 2) {
        pg_issue_rows(P.U8, x, c8, gq, lane, eb0, eb1, E, uB); xa1 = *(const u32x4*)(xp + (size_t)(i + 1) * 1024); xb1 = *(const u32x4*)(xp + (size_t)(i + 1) * 1024 + 8);
        if (i + 2 < PG_TPW) { ea0 = ep[(i + 2) * 128]; ea1 = ep[(i + 2) * 128 + 64]; }
        pg_dots_compute(P, x, tb + i, uA, xa0, xb0, R, lane);
        if (i + 2 < PG_TPW) { pg_issue_rows(P.U8, x, c8, gq, lane, ea0, ea1, E, uA); xa0 = *(const u32x4*)(xp + (size_t)(i + 2) * 1024); xb0 = *(const u32x4*)(xp + (size_t)(i + 2) * 1024 + 8); }
        if (i + 3 < PG_TPW) { eb0 = ep[(i + 3) * 128]; eb1 = ep[(i + 3) * 128 + 64]; }
        pg_dots_compute(P, x, tb + i + 1, uB, xa1, xb1, R, lane);
    }
}
__device__ __forceinline__ void pg_acc_compute(bf16_t* outp, int x, int t, const u32x4 (&vb)[16], float w0, float w1, unsigned oprev, float* C, float* W, int gq, int lane) {
    WAVE_SYNC(); W[lane] = w0; W[64 + lane] = w1; WAVE_SYNC();
    f32x2 acc[8];
#pragma unroll
    for (int q = 0; q < 8; ++q) acc[q] = (f32x2){0.f, 0.f};
#pragma unroll
    for (int k = 0; k < 16; ++k) { const float wk = W[gq + 8 * k];
#pragma unroll
        for (int q = 0; q < 4; ++q) { acc[2 * q] += cvt_pk_f32_fp8_(vb[k][q], false) * wk; acc[2 * q + 1] += cvt_pk_f32_fp8_(vb[k][q], true) * wk; } }
    WAVE_SYNC();
#pragma unroll
    for (int q = 0; q < 4; ++q) *(f32x4*)(C + lane * 16 + 4 * q) = (f32x4){acc[2 * q].x, acc[2 * q].y, acc[2 * q + 1].x, acc[2 * q + 1].y};
    WAVE_SYNC();
    f32x2 s = (f32x2){0.f, 0.f};
#pragma unroll
    for (int g = 0; g < 8; ++g) s += *(const f32x2*)(C + g * 128 + 2 * lane);
    *(unsigned*)(outp + (size_t)t * 1024 + 128 * x + 2 * lane) = pk2(bflo(oprev) + s.x, bfhi(oprev) + s.y);
}
__device__ __forceinline__ void peer_acc_item(bf16_t* outp, const Ptrs& P, int x, int blk, unsigned char* lds, int lane, int wave) {
    float* C = (float*)(lds + wave * PG_WLDS); int* E = (int*)(lds + wave * PG_WLDS + 4096); float* W = (float*)(lds + wave * PG_WLDS + 4608);
    const int gq = lane >> 3, c8 = lane & 7, tb = blk * PG_TB + PG_TPW * wave;
    u32x4 vA[16], vB[16]; unsigned oA, oB;
    const int* ep = P.eid + (size_t)tb * 128 + lane; const float* wp = P.gate + (size_t)tb * 128 + lane; const bf16_t* op = outp + (size_t)tb * 1024 + 128 * x + 2 * lane;
    int ea0 = ep[0], ea1 = ep[64], eb0 = ep[128], eb1 = ep[192]; float wa0 = wp[0], wa1 = wp[64], wb0 = wp[128], wb1 = wp[192];
    pg_issue_rows(P.V8, x, c8, gq, lane, ea0, ea1, E, vA); oA = *(const unsigned*)op;
#pragma unroll 1
    for (int i = 0; i < PG_TPW; i += 2) {
        pg_issue_rows(P.V8, x, c8, gq, lane, eb0, eb1, E, vB); oB = *(const unsigned*)(op + (size_t)(i + 1) * 1024);
        if (i + 2 < PG_TPW) { ea0 = ep[(i + 2) * 128]; ea1 = ep[(i + 2) * 128 + 64]; }
        pg_acc_compute(outp, x, tb + i, vA, wa0, wa1, oA, C, W, gq, lane);
        if (i + 2 < PG_TPW) { wa0 = wp[(i + 2) * 128]; wa1 = wp[(i + 2) * 128 + 64]; pg_issue_rows(P.V8, x, c8, gq, lane, ea0, ea1, E, vA); oA = *(const unsigned*)(op + (size_t)(i + 2) * 1024); }
        if (i + 3 < PG_TPW) { eb0 = ep[(i + 3) * 128]; eb1 = ep[(i + 3) * 128 + 64]; }
        pg_acc_compute(outp, x, tb + i + 1, vB, wb0, wb1, oB, C, W, gq, lane);
        if (i + 3 < PG_TPW) { wb0 = wp[(i + 3) * 128]; wb1 = wp[(i + 3) * 128 + 64]; }
    }
}
template <int STAGE, int CSET = STAGE>
__device__ __forceinline__ void phase_G12(const KP& p, int l, unsigned char* lds) {
    const Ptrs P = make_ptrs(p.ws, l);
    const int tid = TIDX(), lane = tid & 63, wave = tid >> 6;
    int* slot = (int*)(lds + 8 * PG_WLDS);
    const int myx = XCC_ID();
    for (int s = 0; s < 8; ++s) { const int x = (myx + s) & 7; unsigned* cnt = P.qcnt + (CSET * 8 + x) * 16;
        for (;;) { const int blk = peer_next_item(cnt, slot, tid); if (blk >= PG_NBLK) break;
            if (STAGE == 0) peer_dots_item(P, x, blk, lds, lane, wave); else peer_acc_item(CSET == 3 ? (bf16_t*)P.pd : P.ycat, P, x, blk, lds, lane, wave); } }
    __syncthreads();
}
__device__ __forceinline__ void phase_G1b(const KP& p, int l, unsigned char* lds) {
    const Ptrs P = make_ptrs(p.ws, l);
    for (size_t i = (size_t)BIDX() * NTHR + TIDX(); i < (size_t)T_ * 128; i += (size_t)GDIM() * NTHR) { float d = 0.f;
#pragma unroll
        for (int x = 0; x < 8; ++x) d += P.pd[(size_t)x * T_ * 128 + i];
        const int e = P.eid[i]; P.gate[i] = P.gate[i] * P.sv[e] * gelu_erf(d * P.su[e]); }
#ifdef CPU_EMU
    (void)lds;
#endif
}
__device__ __forceinline__ void phase_G3(const KP& p, int l, unsigned char* lds, bool last) {
    const Ptrs P = make_ptrs(p.ws, l);
    const int tid = TIDX(), lane = tid & 63, wave = tid >> 6; const int gw = BIDX() * NWAVE + wave, NGW = GDIM() * NWAVE;
    for (int m = 4 * gw; m < T_; m += 4 * NGW) ln_rows<4, true>(P.ycat + (size_t)m * 1024, p.in[I_LN2G] + l * 1024, p.in[I_LN2B] + l * 1024, last ? p.out + (size_t)m * 1024 : (float*)nullptr, last ? (bf16_t*)nullptr : P.hb + (size_t)m * 1024,
                                                           last ? (unsigned char*)nullptr : (m < H8_SPLIT ? P.h8a + (size_t)m * 1024 : P.h8b + (size_t)(m - H8_SPLIT) * 1024), lane);
}
#ifndef PROBE_REPEAT
#define PROBE_REPEAT 0
#endif
constexpr int LDS_BYTES = 147456;
__device__ __forceinline__ void phase_B1(const KP& p, int l, unsigned char* lds) {
    const Ptrs P = make_ptrs(p.ws, l);
    constexpr int NRC = NB_ * 4 * RW_NCH, NS5 = NB_ * 16, NFX = NB_ * 4 * (S_ / 256), NCV = T_ / 64;
    const int G = GDIM(); int it = BIDX();
    for (; it < NRC; it += G) rw_chunk_unit(p, P, l, it, lds);
#if PROBE_REPEAT == 16
    for (int j = BIDX(); j < NRC; j += G) rw_chunk_unit(p, P, l, j, lds);
#endif
#if PROBE_REPEAT >= 161 && PROBE_REPEAT <= 163
    for (int j = BIDX(); j < NRC; j += G) { rw_chunk_unit<PROBE_REPEAT - 160>(p, P, l, j, lds); __syncthreads(); }
#endif
    for (; it < NRC + NFX; it += G) fox_unit(p, P, l, it - NRC, lds);
#if PROBE_REPEAT == 17
    for (int j = BIDX(); j < NFX; j += G) fox_unit(p, P, l, j, lds);
#endif
    for (; it < NRC + NFX + NS5; it += G) s5_unit(p, P, l, it - NRC - NFX, lds);
#if PROBE_REPEAT == 18
    for (int j = BIDX(); j < NS5; j += G) s5_unit(p, P, l, j, lds);
#endif
    for (; it < NRC + NFX + NS5 + NCV; it += G) conv_unit(p, P, l, it - NRC - NFX - NS5, lds);
#if PROBE_REPEAT == 19
    for (int j = BIDX(); j < NCV; j += G) conv_unit(p, P, l, j, lds);
#endif
}
__device__ __forceinline__ void phase_B3(const KP& p, int l, unsigned char* lds) {
    const Ptrs P = make_ptrs(p.ws, l);
#if PROBE_REPEAT == 34
    for (int it = BIDX(); it < NB_ * 4 * RW_NCH; it += GDIM()) rw_out_unit<true>(p, P, l, it, lds);
#endif
    for (int it = BIDX(); it < NB_ * 4 * RW_NCH; it += GDIM()) rw_out_unit<false>(p, P, l, it, lds);
}
enum { PH_PRO = 0, PH_A, PH_B1, PH_B2, PH_B3, PH_C, PH_D, PH_D2, PH_E, PH_F, PH_G, PH_G1B, PH_G2, PH_G3, PH_N, PH_A0 };
__device__ __forceinline__ void run_phase(const KP& p, int ph, int l, unsigned char* lds) {
    switch (ph) {
        case PH_PRO: phase_prologue(p, lds); break;
        case PH_A: phase_A(p, l, lds); break;
        case PH_A0: phase_A0(p, lds); break;
        case PH_B1: phase_B1(p, l, lds); break;
        case PH_B2: phase_B2(p, l, lds); break;
        case PH_B3: phase_B3(p, l, lds); break;
        case PH_C: phase_C(p, l, lds); break;
        case PH_D: phase_D(p, l, lds); break;
        case PH_D2: phase_D2(p, l, lds); break;
        case PH_E: phase_E(p, l, lds); break;
        case PH_F: phase_F(p, l, lds); break;
        case PH_G: phase_G12<0>(p, l, lds); break;
        case PH_G1B: phase_G1b(p, l, lds); break;
        case PH_G2: phase_G12<1>(p, l, lds); break;
        case PH_G3: phase_G3(p, l, lds, l == L_ - 1); break;
        default: break;
    }
}
#ifndef CPU_EMU
#define XB_TMO      128
#define XB_XCNT(j)  (256  + 64 * (j))
#define XB_XSUB(j)  (1280 + 64 * (j))
#define XB_XGEN(j)  (2304 + 64 * (j))
#define XB_TOP      3328
#define XB_TOPGEN   3392
#define XCD_BAR_WORDS 3456
#define XB_SPIN_CAP (1u << 22)
__device__ __forceinline__ unsigned xb_ld(unsigned* p)              { return __hip_atomic_load(p, __ATOMIC_RELAXED, __HIP_MEMORY_SCOPE_AGENT); }
__device__ __forceinline__ unsigned xb_add(unsigned* p, unsigned v) { return __hip_atomic_fetch_add(p, v, __ATOMIC_RELAXED, __HIP_MEMORY_SCOPE_AGENT); }
__device__ __forceinline__ unsigned xb_xcc_id() { return (unsigned)__builtin_amdgcn_s_getreg((3 << 11) | 20) & 0xFu; }
#define XB_SPIN(cond, bar) do { unsigned _sp = 0; while (cond) { __builtin_amdgcn_s_sleep(1); \
    if ((++_sp & 255u) == 0u) { if (xb_ld(&(bar)[XB_TMO])) break; if (_sp > XB_SPIN_CAP) { atomicAdd(&(bar)[XB_TMO], 1u); break; } } } } while (0)
struct XcdBarrier { unsigned* bar; unsigned x; volatile LAS unsigned* st; };
__device__ __forceinline__ XcdBarrier xcd_barrier_post(unsigned* bar, volatile LAS unsigned* st) {
    XcdBarrier b; b.bar = bar; b.x = xb_xcc_id(); b.st = st;
    if (threadIdx.x == 0) (void)xb_add(&bar[XB_XCNT(b.x)], 1u);
    return b;
}
__device__ __forceinline__ void xcd_barrier_complete(unsigned* bar, unsigned x, unsigned& nloc, unsigned& nx) {
    const unsigned G = gridDim.x * gridDim.y * gridDim.z;
    unsigned sum, cnt, mine, sp = 0u;
    for (;;) {
        sum = 0u; cnt = 0u; mine = 0u;
#pragma unroll
        for (unsigned j = 0; j < 16; ++j) { const unsigned c = xb_ld(&bar[XB_XCNT(j)]); sum += c; cnt += (c > 0u) ? 1u : 0u; mine = (j == x) ? c : mine; }
        if (sum == G) break;
        __builtin_amdgcn_s_sleep(1);
        if ((++sp & 255u) == 0u) { if (xb_ld(&bar[XB_TMO])) break; if (sp > XB_SPIN_CAP) { atomicAdd(&bar[XB_TMO], 1u); break; } }
    }
    nloc = mine > 0u ? mine : 1u; nx = cnt > 0u ? cnt : 1u;
}
__device__ __forceinline__ void xcd_barrier(const XcdBarrier& b) {
    asm volatile("s_waitcnt vmcnt(0)" ::: "memory");
    __syncthreads();
    if (threadIdx.x == 0) {
        unsigned* bar = b.bar;
        __builtin_amdgcn_s_waitcnt(0);
        unsigned nloc = b.st[0], nx = b.st[1];
        if (nloc == 0u) { xcd_barrier_complete(bar, b.x, nloc, nx); b.st[0] = nloc; b.st[1] = nx; }
        const unsigned old = xb_add(&bar[XB_XSUB(b.x)], 1u);
        const unsigned gen = old / nloc;
        if (old + 1u == (gen + 1u) * nloc) {
            __builtin_amdgcn_fence(__ATOMIC_RELEASE, "agent");
            asm volatile("s_waitcnt vmcnt(0)" ::: "memory");
            const unsigned og = xb_add(&bar[XB_TOP], 1u);
            const unsigned tg = og / nx;
            if (og + 1u == (tg + 1u) * nx) xb_add(&bar[XB_TOPGEN], 1u);
            else XB_SPIN(xb_ld(&bar[XB_TOPGEN]) == tg, bar);
            __builtin_amdgcn_fence(__ATOMIC_ACQUIRE, "agent");
            xb_add(&bar[XB_XGEN(b.x)], 1u);
            asm volatile("s_waitcnt vmcnt(0)" ::: "memory");
        } else {
            XB_SPIN(xb_ld(&bar[XB_XGEN(b.x)]) == gen, bar);
            __builtin_amdgcn_fence(__ATOMIC_ACQUIRE, "agent");
            asm volatile("s_waitcnt vmcnt(0)" ::: "memory");
        }
    }
    __syncthreads();
}
#ifndef PROBE_REPEAT
#define PROBE_REPEAT 0
#endif
#ifndef N_LAUNCH_MODE
#define N_LAUNCH_MODE 1
#endif
extern __shared__ __attribute__((aligned(16))) unsigned char lds_dyn[];
#if N_LAUNCH_MODE == 0
template <int PH> __global__ void __launch_bounds__(NTHR, 2) k_phase_t(KP p) { run_phase(p, PH, p.layer, lds_dyn); }
typedef void (*kfn_t)(KP);
static kfn_t phase_fn(int ph) { switch (ph) { case PH_PRO: return k_phase_t<PH_PRO>; case PH_A: return k_phase_t<PH_A>; case PH_B1: return k_phase_t<PH_B1>; case PH_B2: return k_phase_t<PH_B2>; case PH_B3: return k_phase_t<PH_B3>; case PH_C: return k_phase_t<PH_C>;
    case PH_D: return k_phase_t<PH_D>; case PH_D2: return k_phase_t<PH_D2>; case PH_E: return k_phase_t<PH_E>; case PH_F: return k_phase_t<PH_F>; case PH_G: return k_phase_t<PH_G>; case PH_G1B: return k_phase_t<PH_G1B>; case PH_G2: return k_phase_t<PH_G2>; default: return k_phase_t<PH_G3>; } }
#else
#ifndef USE_XCD_BARRIER
#define USE_XCD_BARRIER 1
#endif
constexpr int BAR_LDS_OFF = LDS_BYTES - 64;
#if USE_XCD_BARRIER
#define GSYNC() xcd_barrier(bar)
#define GSYNC_ARG const XcdBarrier& bar
#else
#define GSYNC() grid.sync()
#define GSYNC_ARG cg::grid_group& grid
#endif
template <int l>
__device__ __forceinline__ void mega_layer(const KP& p, GSYNC_ARG) {
#if PROBE_REPEAT == 47 || PROBE_REPEAT == 48
        phase_Aprobe<PROBE_REPEAT - 40>(p, l, lds_dyn); GSYNC();
#endif
        phase_A(p, l, lds_dyn);
#if PROBE_REPEAT == 1
        GSYNC(); phase_A(p, l, lds_dyn);
#endif
#if PROBE_REPEAT >= 40 && PROBE_REPEAT <= 46
        GSYNC(); phase_Aprobe<PROBE_REPEAT - 40>(p, l, lds_dyn);
#endif
        GSYNC(); phase_B1(p, l, lds_dyn);
#if PROBE_REPEAT == 2
        GSYNC(); phase_B1(p, l, lds_dyn);
#endif
        GSYNC(); phase_B2(p, l, lds_dyn);
        GSYNC(); phase_B3(p, l, lds_dyn);
        GSYNC(); phase_C(p, l, lds_dyn);
#if PROBE_REPEAT == 4
        GSYNC(); phase_C(p, l, lds_dyn);
#endif
        GSYNC(); phase_D(p, l, lds_dyn);
        GSYNC(); phase_D2(p, l, lds_dyn);
        GSYNC(); phase_E(p, l, lds_dyn);
        GSYNC(); phase_F(p, l, lds_dyn);
#if PROBE_REPEAT == 8
        GSYNC(); phase_F(p, l, lds_dyn);
#endif
        GSYNC(); phase_G12<0>(p, l, lds_dyn);
#if PROBE_REPEAT == 32
        GSYNC(); phase_G12<0, 2>(p, l, lds_dyn);
#endif
        GSYNC(); phase_G1b(p, l, lds_dyn);
        GSYNC(); phase_G12<1>(p, l, lds_dyn);
#if PROBE_REPEAT == 33
        GSYNC(); phase_G12<1, 3>(p, l, lds_dyn);
#endif
        GSYNC(); phase_G3(p, l, lds_dyn, l == L_ - 1);
}
__global__ void __launch_bounds__(NTHR, 2) k_mega(KP p) {
    cg::grid_group grid = cg::this_grid();
#if USE_XCD_BARRIER
    volatile LAS unsigned* st = (volatile LAS unsigned*)(lds_dyn + BAR_LDS_OFF);
    if (threadIdx.x < 2) st[threadIdx.x] = 0u;
    __syncthreads();
    const XcdBarrier bar = xcd_barrier_post((unsigned*)(p.ws + WS_CTL) + 4096, st);
#define GSYNC_VAL bar
#else
#define GSYNC_VAL grid
#endif
    phase_prologue(p, lds_dyn);
    grid.sync();
    phase_A0(p, lds_dyn);
    GSYNC();
    mega_layer<0>(p, GSYNC_VAL);
    static_assert(L_ == 2, "two layers");
    GSYNC();
    mega_layer<1>(p, GSYNC_VAL);
}
#endif
extern "C" void kernel_launch(void* const* d_in, const int* in_sizes, int n_in, void* d_out, int out_size, void* d_ws, size_t ws_size, hipStream_t stream) {
    static int grid = 0;
    if (grid == 0) {
        if (n_in != N_IN || out_size != T_ * 1024 || ws_size < WS_END) { fprintf(stderr, "kernel_launch: unexpected shapes (n_in %d out %d ws %zu need %zu)\n", n_in, out_size, ws_size, (size_t)WS_END); grid = -1; return; }
        int dev = 0, cus = 0, per_cu = 0;
        (void)hipGetDevice(&dev); (void)hipDeviceGetAttribute(&cus, hipDeviceAttributeMultiprocessorCount, dev);
#if N_LAUNCH_MODE == 0
        for (int ph = 0; ph < PH_N; ++ph) (void)hipFuncSetAttribute((const void*)phase_fn(ph), hipFuncAttributeMaxDynamicSharedMemorySize, LDS_BYTES);
        (void)per_cu;
#else
        (void)hipFuncSetAttribute((const void*)k_mega, hipFuncAttributeMaxDynamicSharedMemorySize, LDS_BYTES);
        (void)hipOccupancyMaxActiveBlocksPerMultiprocessor(&per_cu, (const void*)k_mega, NTHR, LDS_BYTES);
        if (per_cu < 1) { fprintf(stderr, "kernel_launch: occupancy query says %d blocks per CU\n", per_cu); grid = -1; return; }
#endif
        grid = cus;
    }
    if (grid < 0) return;
    if (hipMemsetAsync((char*)d_ws + WS_CTL, 0, 65536, stream) != hipSuccess) { fprintf(stderr, "kernel_launch: memset failed\n"); return; }
    KP p{};
    for (int i = 0; i < N_IN; ++i) p.in[i] = (const float*)d_in[i];
    p.out = (float*)d_out; p.ws = (unsigned char*)d_ws;
#if N_LAUNCH_MODE == 1
    void* args[] = {&p};
    hipError_t e = hipLaunchCooperativeKernel((const void*)k_mega, dim3(grid), dim3(NTHR), args, LDS_BYTES, stream);
    if (e != hipSuccess) fprintf(stderr, "cooperative launch failed: %s (grid %d)\n", hipGetErrorString(e), grid);
#else
    p.phase = PH_PRO; p.layer = 0; hipLaunchKernelGGL(phase_fn(PH_PRO), dim3(grid), dim3(NTHR), LDS_BYTES, stream, p);
    for (int l = 0; l < L_; ++l) for (int ph = PH_A; ph < PH_N; ++ph) { p.phase = ph; p.layer = l; hipLaunchKernelGGL(phase_fn(ph), dim3(grid), dim3(NTHR), LDS_BYTES, stream, p); }
#endif
}
#endif
```

```cpp
#ifdef CPU_EMU
#include "emu.h"
#define LAS
#define GET_LDS() ((unsigned char*)emu::lds())
#define AS_GLOBAL(p) (p)
#define AS_LDS(p) (p)
#define RFL(x) (x)
#define MFMA32(a, b, c) emu_mfma32(a, b, c)
#define MFMA16(a, b, c) emu_mfma16(a, b, c)
#define MFMA16_FP8(a, b, c) emu_mfma16_fp8(a, b, c)
#define FAST_EXP2(x) exp2f(x)
#define FAST_RCP(x) (1.0f / (x))
#define FAST_LOG2(x) log2f(x)
#define FAST_RSQ(x) (1.0f / sqrtf(x))
#define WAVE_SYNC() do { uint32_t _z = 0; (void)emu::wave_xchg(&_z, 1); } while (0)
#define OPAQUE(x) do {} while (0)
#define GLDS16(gp, lp, lane) memcpy((char*)(lp) + 16 * (lane), (const void*)(gp), 16)
#define WAIT_VM(n) do {} while (0)
#define GLOAD16_ASM(dst, ptr) (dst) = *(const u32x4*)(ptr)
#define GLOAD4_ASM(dst, ptr) (dst) = *(const int*)(ptr)
#define PIN4(a, b, c, d) do {} while (0)
#define PIN2I(a, b) do {} while (0)
#define WAIT_LGKM0() do {} while (0)
#define READLANE_I(v, l) __shfl((int)(v), (l))
#define READLANE_F(v, l) __shfl((float)(v), (l))
#define TIDX() ((int)threadIdx.x)
#define XCC_ID() (emu::bid() & 7)
#define GDIM() ((int)gridDim.x)
#define BIDX() ((int)blockIdx.x)
#define OPAQUE_S(x) do {} while (0)
#define MEMFENCE() do {} while (0)
#else
#include <hip/hip_runtime.h>
#include <hip/hip_cooperative_groups.h>
#include <cstdio>
#include <cstdint>
namespace cg = cooperative_groups;
#define LAS __attribute__((address_space(3)))
#define GAS __attribute__((address_space(1)))
#define AS_GLOBAL(p) ((unsigned char*)(GAS unsigned char*)(p))
#define AS_LDS(p) ((unsigned char*)(LAS unsigned char*)(p))
#define RFL(x) __builtin_amdgcn_readfirstlane(x)
#define MFMA32(a, b, c) __builtin_amdgcn_mfma_f32_32x32x16_bf16(a, b, c, 0, 0, 0)
#define MFMA16(a, b, c) __builtin_amdgcn_mfma_f32_16x16x32_bf16(a, b, c, 0, 0, 0)
#define MFMA16_FP8(a, b, c) __builtin_amdgcn_mfma_f32_16x16x32_fp8_fp8((long)(a), (long)(b), c, 0, 0, 0)
#define MFMA16_F8X128(a, b, c) __builtin_amdgcn_mfma_scale_f32_16x16x128_f8f6f4(a, b, c, 0, 0, 0, 0, 0, 0)
#define FAST_EXP2(x) __builtin_amdgcn_exp2f(x)
#define FAST_RCP(x) __builtin_amdgcn_rcpf(x)
#define FAST_LOG2(x) __builtin_amdgcn_logf(x)
#define FAST_RSQ(x) __builtin_amdgcn_rsqf(x)
#define WAVE_SYNC() __builtin_amdgcn_wave_barrier()
#define OPAQUE(x) asm volatile("" : "+v"(x))
#define GLDS16(gp, lp, lane) __builtin_amdgcn_global_load_lds((const unsigned*)(gp), (LAS unsigned*)(lp), 16, 0, 0)
#define WAIT_VM(n) asm volatile("s_waitcnt vmcnt(" #n ")" ::: "memory")
#define GLOAD16_ASM(dst, ptr) asm volatile("global_load_dwordx4 %0, %1, off" : "=v"(dst) : "v"(ptr) : "memory")
#define GLOAD4_ASM(dst, ptr) asm volatile("global_load_dword %0, %1, off" : "=v"(dst) : "v"(ptr) : "memory")
#define PIN4(a, b, c, d) asm volatile("" : "+v"(a), "+v"(b), "+v"(c), "+v"(d) :: "memory")
#define PIN2I(a, b) asm volatile("" : "+v"(a), "+v"(b) :: "memory")
#define WAIT_LGKM0() asm volatile("s_waitcnt lgkmcnt(0)" ::: "memory")
#define READLANE_I(v, l) __builtin_amdgcn_readlane((int)(v), (l))
#define READLANE_F(v, l) __builtin_bit_cast(float, __builtin_amdgcn_readlane(__builtin_bit_cast(int, (float)(v)), (l)))
#define OPAQUE_S(x) asm volatile("" : "+s"(x))
__device__ __forceinline__ int opaque_tid_() { int t = threadIdx.x; asm volatile("" : "+v"(t)); return t; }
#define TIDX() opaque_tid_()
#define XCC_ID() ((int)(__builtin_amdgcn_s_getreg((3 << 11) | 20) & 7u))
__device__ __forceinline__ int opaque_gdim_() { int t = gridDim.x; asm volatile("" : "+s"(t)); return t; }
__device__ __forceinline__ int opaque_bidx_() { int t = blockIdx.x; asm volatile("" : "+s"(t)); return t; }
#define GDIM() opaque_gdim_()
#define BIDX() opaque_bidx_()
#define MEMFENCE() do { asm volatile("" ::: "memory"); __builtin_amdgcn_sched_barrier(0); } while (0)
#endif

#ifndef CFG_B
#define CFG_B 16
#endif
#ifndef CFG_S
#define CFG_S 2048
#endif

typedef unsigned short bf16_t;
typedef short bf16x8 __attribute__((ext_vector_type(8)));
typedef short s16x4 __attribute__((ext_vector_type(4)));
typedef float f32x4 __attribute__((ext_vector_type(4)));
typedef float f32x2 __attribute__((ext_vector_type(2)));
typedef float f32x16 __attribute__((ext_vector_type(16)));
typedef unsigned u32x4 __attribute__((ext_vector_type(4)));
typedef unsigned u32x2 __attribute__((ext_vector_type(2)));
typedef int i32x4 __attribute__((ext_vector_type(4)));
typedef int i32x8 __attribute__((ext_vector_type(8)));

constexpr int NB_ = CFG_B, S_ = CFG_S, T_ = NB_ * S_, D_ = 1024, L_ = 2;
constexpr int NTHR = 512, NWAVE = 8;
constexpr int PJ = 2304;
constexpr int C_R = 0, C_K = 256, C_V = 512, C_HW = 768, C_HA = 800, C_HG = 832, C_S5 = 896, C_FQ = 1152, C_FK = 1408, C_FL = 1664, C_CV = 1792, C_CG = 2048;
constexpr int WIN_ROWS = 6656, WIN_VT = 2304, WIN_GATE = 2560;
constexpr int IN_COLS = 6532;
constexpr float LN_EPS_ = 1e-5f, GN_EPS_ = 64e-5f;
constexpr float DN_ALPHA_ = 1.4142135623730951f;
constexpr int NEXP = 16384;

enum { I_X = 0, I_P, I_LNIN_G, I_LNIN_B, I_WIN, I_MU, I_W0, I_W2, I_A0, I_A2, I_G2, I_KK, I_KA, I_RK, I_LNXG, I_LNXB, I_LRE, I_LIM, I_BRE, I_BIM, I_CRE, I_CIM,
       I_S5D, I_LDT, I_GLUW, I_GLUB, I_BF, I_CONVW, I_CONVB, I_CLNG, I_CLNB, I_WBR, I_WOUT, I_LN1G, I_LN1B, I_WQ, I_K1, I_K2, I_U, I_V, I_PLEW, I_PLEG, I_LN2G, I_LN2B, N_IN };

constexpr size_t al256(size_t x) { return (x + 255) & ~(size_t)255; }
constexpr size_t WS_CTL = 0;
constexpr size_t WS_WIN = 1u << 20;
constexpr size_t WS_WBR = WS_WIN + al256((size_t)L_ * WIN_ROWS * 1024 * 2);
constexpr size_t WS_WOUT = WS_WBR + (size_t)L_ * 1024 * 1024 * 2;
constexpr size_t WS_WQ = WS_WOUT + (size_t)L_ * 1024 * 1024 * 2;
constexpr size_t WS_PLE = WS_WQ + (size_t)L_ * 2048 * 1024 * 2;
constexpr size_t WS_PLEG = WS_PLE + (size_t)L_ * 1024 * 256 * 2;
constexpr size_t WS_GLU = WS_PLEG + (size_t)L_ * 1024 * 1024 * 2;
constexpr size_t WS_K12 = WS_GLU + (size_t)L_ * 256 * 256 * 2;
constexpr size_t WS_S5KC = WS_K12 + (size_t)L_ * 2 * 128 * 128 * 2;
constexpr size_t WS_S5WX = WS_S5KC + (size_t)L_ * 16 * 64 * 256 * 2;
constexpr size_t WS_S5WY = WS_S5WX + (size_t)L_ * 16 * 128 * 1024 * 2;
constexpr size_t WS_S5LL = WS_S5WY + (size_t)L_ * 16 * 1024 * 128 * 2;
constexpr size_t WS_UT = WS_S5LL + al256((size_t)L_ * 16 * 64 * 2 * 4);
constexpr size_t WS_VT = WS_UT + (size_t)NEXP * 1024 * 2;
constexpr size_t WS_RW = WS_VT + (size_t)NEXP * 1024 * 2;
constexpr size_t RW_SZ = (size_t)T_ * 512;
static_assert(2 * RW_SZ <= (size_t)NEXP * 1024 * 2, "RWKV gate / bonus arrays fit the second table region");
constexpr size_t WS_HB = WS_RW + 4 * RW_SZ;
constexpr size_t WS_R1 = WS_HB + (size_t)T_ * 1024 * 2;
constexpr size_t R1_BYTES = (size_t)T_ * 2560 * 2;
constexpr size_t WS_YC = WS_R1 + R1_BYTES;
constexpr size_t WS_VTR = WS_YC + (size_t)T_ * 1024 * 2;
constexpr size_t WS_PB = WS_VTR + (size_t)256 * T_ * 2;
constexpr size_t WS_H8T = WS_PB + (size_t)T_ * 256 * 2;
constexpr int H8_SPLIT = (T_ / 512) * 256;
constexpr size_t WS_END = WS_H8T + (size_t)(T_ - H8_SPLIT) * 1024;
constexpr size_t R1_PROJ = 0;
constexpr size_t R1_H8 = (size_t)T_ * 2304 * 2;
constexpr size_t R1_MERGED = 0;
constexpr size_t R1_STASH = (size_t)T_ * 1024 * 2;
constexpr size_t R1_Q = 0;
constexpr size_t R1_EID = (size_t)T_ * 2048 * 2;
constexpr size_t R1_GATE = R1_EID + (size_t)T_ * 128 * 4;
static_assert(R1_GATE + (size_t)T_ * 128 * 4 <= R1_BYTES, "R1 map");

struct KP { const float* in[N_IN]; float* out; unsigned char* ws; float* dbg; int layer; int phase; };

#ifdef CPU_EMU
__device__ __forceinline__ unsigned f2bf(float f) { unsigned u = __builtin_bit_cast(unsigned, f); return (u + 0x7fffu + ((u >> 16) & 1u)) >> 16; }
__device__ __forceinline__ unsigned pk2(float lo, float hi) { return f2bf(lo) | (f2bf(hi) << 16); }
#else
typedef __bf16 bf16x2_hw __attribute__((ext_vector_type(2)));
__device__ __forceinline__ unsigned pk2(float lo, float hi) { const f32x2 v = {lo, hi}; return __builtin_bit_cast(unsigned, __builtin_convertvector(v, bf16x2_hw)); }
__device__ __forceinline__ unsigned f2bf(float f) { return pk2(f, 0.f) & 0xffffu; }
#endif
__device__ __forceinline__ float bf2f(unsigned h) { return __builtin_bit_cast(float, h << 16); }
__device__ __forceinline__ float bflo(unsigned w) { return __builtin_bit_cast(float, w << 16); }
__device__ __forceinline__ float bfhi(unsigned w) { return __builtin_bit_cast(float, w & 0xffff0000u); }
__device__ __forceinline__ float sigmoidf_(float x) { return FAST_RCP(1.0f + FAST_EXP2(x * -1.4426950408889634f)); }
__device__ __forceinline__ float gelu_erf(float v) {
    const float t = FAST_RCP(fabsf(v) * 0.2316418882f + 1.0f);
    float q = t * 0.5307027145f + (-0.7265760135f); q = q * t + 0.7107068705f; q = q * t + (-0.142248368f); q = q * t + 0.127414796f; q = q * t;
    const float m = v * (q * FAST_EXP2((v * v) * (-0.72134752044f)));
    return v < 0.f ? m : v - m; }
#ifdef CPU_EMU
inline float fp8_dec_(unsigned b) { const unsigned s = b >> 7, e = (b >> 3) & 15, m = b & 7; float v = (e == 0) ? ldexpf((float)m, -9) : ldexpf(1.f + m * 0.125f, (int)e - 7); return s ? -v : v; }
inline unsigned fp8_enc_(float x) { const unsigned s = x < 0.f ? 0x80u : 0u; float a = fabsf(x); if (!(a > 0.f)) return s; if (a > 448.f) a = 448.f;
    int e; (void)frexpf(a, &e); e -= 1; if (e < -6) e = -6;
    const float q = ldexpf(a, 3 - e); float r = nearbyintf(q);
    unsigned ee, mm; if (e == -6 && r < 8.f) { ee = 0; mm = (unsigned)r; } else { if (r >= 16.f) { r = 8.f; e += 1; } ee = (unsigned)(e + 7); mm = (unsigned)r - 8u; }
    if (ee > 15u || (ee == 15u && mm > 6u)) { ee = 15u; mm = 6u; }
    return s | (ee << 3) | mm; }
inline f32x2 cvt_pk_f32_fp8_(unsigned w, bool hi) { const unsigned h = hi ? (w >> 16) : w; return (f32x2){fp8_dec_(h & 255u), fp8_dec_((h >> 8) & 255u)}; }
inline unsigned cvt_pk_fp8_f32_(float a, float b, unsigned old, bool hi) { const unsigned p = fp8_enc_(a) | (fp8_enc_(b) << 8); return hi ? ((old & 0xffffu) | (p << 16)) : ((old & 0xffff0000u) | p); }
#else
__device__ __forceinline__ f32x2 cvt_pk_f32_fp8_(unsigned w, bool hi) { return hi ? __builtin_amdgcn_cvt_pk_f32_fp8((int)w, true) : __builtin_amdgcn_cvt_pk_f32_fp8((int)w, false); }
__device__ __forceinline__ unsigned cvt_pk_fp8_f32_(float a, float b, unsigned old, bool hi) { return hi ? (unsigned)__builtin_amdgcn_cvt_pk_fp8_f32(a, b, (int)old, true) : (unsigned)__builtin_amdgcn_cvt_pk_fp8_f32(a, b, (int)old, false); }
#endif
__device__ __forceinline__ float wave_max(float v) {
#pragma unroll
  for (int o = 1; o < 64; o <<= 1) v = fmaxf(v, __shfl_xor(v, o));
  return v;
}
template <int N> __device__ __forceinline__ void wave_sum_n(float (&v)[N]) {
#pragma unroll
  for (int o = 1; o < 64; o <<= 1) { float t[N];
#pragma unroll
    for (int i = 0; i < N; ++i) t[i] = __shfl_xor(v[i], o);
#pragma unroll
    for (int i = 0; i < N; ++i) v[i] += t[i]; }
}
__device__ __forceinline__ float wave_sum(float v) {
#pragma unroll
  for (int o = 1; o < 64; o <<= 1) v += __shfl_xor(v, o);
  return v;
}
namespace pg8 {
constexpr int BM = 256, BK = 64, HALF = 128, HTB = HALF * BK * 2, STAGE_BYTES = 8 * HTB;
__host__ __device__ __forceinline__ int lds_byte(int r, int c) { const int st = (r >> 4) * 2 + (c >> 5), rr = r & 15, cc = c & 31, ob = rr * 64 + cc * 2; return st * 1024 + (ob ^ (((ob >> 9) & 1) << 5)); }
__host__ __device__ __forceinline__ void stage_rc(int b, int& R, int& C) { const int st = b / 1024, sb = b % 1024, swz = sb ^ (((sb >> 9) & 1) << 5); R = (st >> 1) * 16 + swz / 64; C = (st & 1) * 32 + (swz % 64) / 2; }
__host__ __device__ __forceinline__ int perm32(int rho) { const int n = rho >> 4, i = rho & 15; return 8 * (i >> 2) + 4 * n + (i & 3); }

struct Unit { const char* a; const char* b; int nt; int kind; int pm; int pn; int aux; int f8; };

#ifndef CPU_EMU
template <int MODE = 0, class Epi, class Sched>
__device__ __forceinline__ void gemm_phase(LAS unsigned char* lds, const int lda, const int ldb, const Sched& S, const Epi& E, const int lda8 = 0) {
    const int tid = TIDX(), wid = __builtin_amdgcn_readfirstlane(tid >> 6), lane = tid & 63, wr = wid >> 2, wc = wid & 3, fr = lane & 15, fq = lane >> 4;
    unsigned voffA[2], voffB[2], voffA8[2];
#pragma unroll
    for (int i = 0; i < 2; ++i) { int R, C; stage_rc(tid * 16 + i * 8192, R, C); const int Rb = (R & ~31) + perm32(R & 31);
        voffA[i] = (unsigned)(R * lda + C) * 2u; voffB[i] = (unsigned)(Rb * ldb + C) * 2u; voffA8[i] = (unsigned)(R * lda8 + C * 2); }
    const size_t kstep = (size_t)(BK * 2);
    const size_t hstepA = (size_t)HALF * lda * 2, hstepB = (size_t)HALF * ldb * 2, hstepA8 = (size_t)HALF * lda8;
    const unsigned ldsw = (unsigned)wid * 1024u;
    const int aoff = lds_byte(wr * 64 + fr, fq * 8), boff = lds_byte(wc * 32 + fr, fq * 8);
#define PG8_SA(b, h) (((b) * 2 + (h)) * HTB)
#define PG8_SB(b, h) ((4 + (b) * 2 + (h)) * HTB)
#define PG8_STAGE(bufoff, gbase, voff) do { _Pragma("unroll") for (int _i = 0; _i < 2; ++_i) \
        __builtin_amdgcn_global_load_lds((const unsigned*)((const char*)(gbase) + (voff)[_i]), (LAS unsigned*)(lds + (bufoff) + ldsw + _i * 8192), 16, 0, 0); } while (0)
#define PG8_LDA(dst, b, h) do { _Pragma("unroll") for (int m = 0; m < 4; ++m) _Pragma("unroll") for (int k = 0; k < 2; ++k) dst[m][k] = *(const LAS bf16x8*)(lds + PG8_SA(b, h) + aoff + m * 2048 + k * 1024); } while (0)
#define PG8_LDB(dst, b, h) do { _Pragma("unroll") for (int n = 0; n < 2; ++n) _Pragma("unroll") for (int k = 0; k < 2; ++k) dst[n][k] = *(const LAS bf16x8*)(lds + PG8_SB(b, h) + boff + n * 2048 + k * 1024); } while (0)
#define PG8_MMA(ai, bj, At, Bt) do { __builtin_amdgcn_s_setprio(1); _Pragma("unroll") for (int m = 0; m < 4; ++m) _Pragma("unroll") for (int n = 0; n < 2; ++n) _Pragma("unroll") for (int k = 0; k < 2; ++k) \
        acc[ai][bj][m][n] = __builtin_amdgcn_mfma_f32_16x16x32_bf16(Bt[n][k], At[m][k], acc[ai][bj][m][n], 0, 0, 0); __builtin_amdgcn_s_setprio(0); } while (0)
#define PG8_CAT(x, y) __builtin_shufflevector(__builtin_bit_cast(i32x4, x), __builtin_bit_cast(i32x4, y), 0, 1, 2, 3, 4, 5, 6, 7)
#define PG8_LDA8(dst, b, h) do { _Pragma("unroll") for (int m = 0; m < 4; ++m) dst[m] = PG8_CAT(*(const LAS bf16x8*)(lds + PG8_SA(b, h) + aoff + m * 2048), *(const LAS bf16x8*)(lds + PG8_SA(b, h) + aoff + m * 2048 + 1024)); } while (0)
#define PG8_LDB8(dst, b, h) do { _Pragma("unroll") for (int n = 0; n < 2; ++n) dst[n] = PG8_CAT(*(const LAS bf16x8*)(lds + PG8_SB(b, h) + boff + n * 2048), *(const LAS bf16x8*)(lds + PG8_SB(b, h) + boff + n * 2048 + 1024)); } while (0)
#define PG8_MMA8(ai, bj, A8, B8) do { __builtin_amdgcn_s_setprio(1); _Pragma("unroll") for (int m = 0; m < 4; ++m) _Pragma("unroll") for (int n = 0; n < 2; ++n) \
        acc[ai][bj][m][n] = MFMA16_F8X128(B8[n], A8[m], acc[ai][bj][m][n]); __builtin_amdgcn_s_setprio(0); } while (0)
#define PG8_WAIT_V(n) asm volatile("s_waitcnt vmcnt(" #n ")" ::: "memory")
#define PG8_WAIT_L(n) asm volatile("s_waitcnt lgkmcnt(" #n ")" ::: "memory")
#define PG8_BAR __builtin_amdgcn_s_barrier()
#define PG8_SCHED __builtin_amdgcn_sched_barrier(0)
    Unit cur, nxt; int ui = 0;
    if (!S.next(0, cur)) return;
    f32x4 acc[2][2][4][2];
#pragma unroll
    for (int a = 0; a < 2; ++a)
#pragma unroll
        for (int b = 0; b < 2; ++b)
#pragma unroll
            for (int m = 0; m < 4; ++m)
#pragma unroll
                for (int n = 0; n < 2; ++n) acc[a][b][m][n] = (f32x4){0.f, 0.f, 0.f, 0.f};
    bf16x8 At[4][2], B0[2][2], B1[2][2];
    const char* cA = cur.a; const char* cB = cur.b; int cf8 = MODE == 2 ? cur.f8 : MODE; size_t chA = cf8 ? hstepA8 : hstepA;
    { unsigned v0[2] = {cf8 ? voffA8[0] : voffA[0], cf8 ? voffA8[1] : voffA[1]};
    PG8_STAGE(PG8_SB(0, 0), cB, voffB); PG8_STAGE(PG8_SB(0, 1), cB + hstepB, voffB); PG8_STAGE(PG8_SA(0, 0), cA, v0); PG8_STAGE(PG8_SA(0, 1), cA + chA, v0);
    if (wr == 1) PG8_BAR;
    PG8_WAIT_V(2); PG8_BAR;
    PG8_STAGE(PG8_SB(1, 0), cB + kstep, voffB); PG8_STAGE(PG8_SA(1, 0), cA + kstep, v0); PG8_STAGE(PG8_SB(1, 1), cB + hstepB + kstep, voffB);
    PG8_WAIT_V(6); PG8_BAR; }
    for (;;) {
        const bool has_next = S.next(ui + 1, nxt);
        const char* nA = has_next ? nxt.a : cA; const char* nB = has_next ? nxt.b : cB; const int nf8 = MODE == 2 ? (has_next ? nxt.f8 : cf8) : MODE;
        int nt = cur.nt; asm volatile("" : "+s"(nt));
#define PG8_KLOOP(LDA_, LDB_, MM_, At_, B0_, B1_, CF8) \
        for (int t = 0; t < nt; t += 2) { \
            const bool last = (t == nt - 2); \
            const char* a1 = cA + (size_t)(t + 1) * kstep; \
            const char* a2 = last ? nA : cA + (size_t)(t + 2) * kstep; const char* b2 = last ? nB : cB + (size_t)(t + 2) * kstep; \
            const char* a3 = a2 + kstep; const char* b3 = b2 + kstep; \
            const int f2 = last ? nf8 : CF8; const size_t h2 = f2 ? hstepA8 : hstepA; \
            OPAQUE_S(a1); OPAQUE_S(a2); OPAQUE_S(a3); OPAQUE_S(b2); OPAQUE_S(b3); \
            const unsigned vA[2] = {CF8 ? voffA8[0] : voffA[0], CF8 ? voffA8[1] : voffA[1]}, vA2[2] = {f2 ? voffA8[0] : voffA[0], f2 ? voffA8[1] : voffA[1]}, vB[2] = {voffB[0], voffB[1]}; \
            LDB_(B0_, 0, 0); LDB_(B1_, 0, 1); PG8_SCHED; LDA_(At_, 0, 0); PG8_STAGE(PG8_SA(1, 1), a1 + (CF8 ? hstepA8 : hstepA), vA); \
            PG8_WAIT_V(8); PG8_WAIT_L(0); PG8_BAR; MM_(0, 0, At_, B0_); MM_(0, 1, At_, B1_); PG8_BAR; PG8_SCHED; \
            LDA_(At_, 0, 1); PG8_STAGE(PG8_SB(0, 0), b2, vB); PG8_STAGE(PG8_SB(0, 1), b2 + hstepB, vB); PG8_STAGE(PG8_SA(0, 0), a2, vA2); \
            PG8_WAIT_V(8); PG8_WAIT_L(0); PG8_BAR; MM_(1, 0, At_, B0_); MM_(1, 1, At_, B1_); PG8_BAR; PG8_SCHED; \
            LDB_(B0_, 1, 0); LDB_(B1_, 1, 1); PG8_SCHED; LDA_(At_, 1, 0); PG8_STAGE(PG8_SA(0, 1), a2 + h2, vA2); \
            PG8_WAIT_V(8); PG8_WAIT_L(0); PG8_BAR; MM_(0, 0, At_, B0_); MM_(0, 1, At_, B1_); PG8_BAR; PG8_SCHED; \
            LDA_(At_, 1, 1); PG8_STAGE(PG8_SB(1, 0), b3, vB); PG8_STAGE(PG8_SB(1, 1), b3 + hstepB, vB); PG8_STAGE(PG8_SA(1, 0), a3, vA2); \
            PG8_WAIT_V(8); PG8_WAIT_L(0); PG8_BAR; MM_(1, 0, At_, B0_); MM_(1, 1, At_, B1_); PG8_BAR; PG8_SCHED; \
        }
        if (MODE == 1 || (MODE == 2 && cf8)) { i32x8 A8[4], B08[2], B18[2]; PG8_KLOOP(PG8_LDA8, PG8_LDB8, PG8_MMA8, A8, B08, B18, 1) }
        else { PG8_KLOOP(PG8_LDA, PG8_LDB, PG8_MMA, At, B0, B1, 0) }
#undef PG8_KLOOP
        if (wr == 0) PG8_BAR;
        E(acc, cur, wr, wc, fr, fq, tid);
        if (!has_next) break;
#pragma unroll
        for (int a = 0; a < 2; ++a)
#pragma unroll
            for (int b = 0; b < 2; ++b)
#pragma unroll
                for (int m = 0; m < 4; ++m)
#pragma unroll
                    for (int n = 0; n < 2; ++n) acc[a][b][m][n] = (f32x4){0.f, 0.f, 0.f, 0.f};
        cur = nxt; cA = nA; cB = nB; cf8 = nf8; ++ui;
        if (wr == 1) PG8_BAR;
    }
    PG8_WAIT_V(0);
    PG8_BAR;
#undef PG8_SA
#undef PG8_SB
#undef PG8_STAGE
#undef PG8_LDA
#undef PG8_LDB
#undef PG8_MMA
#undef PG8_MMA8
#undef PG8_LDA8
#undef PG8_LDB8
#undef PG8_CAT
#undef PG8_WAIT_V
#undef PG8_WAIT_L
#undef PG8_BAR
#undef PG8_SCHED
}
#else
template <int MODE = 0, class Epi, class Sched>
inline void gemm_phase(unsigned char* lds, const int lda, const int ldb, const Sched& S, const Epi& E, const int lda8 = 0) {
    const int tid = TIDX(), wid = tid >> 6, lane = tid & 63, wr = wid >> 2, wc = wid & 3, fr = lane & 15, fq = lane >> 4;
    Unit cur;
    for (int ui = 0; S.next(ui, cur); ++ui) {
        f32x4 acc[2][2][4][2];
        const bf16_t* A = (const bf16_t*)cur.a; const bf16_t* Bt = (const bf16_t*)cur.b; const int K = cur.nt * 64;
        for (int ai = 0; ai < 2; ++ai) for (int bj = 0; bj < 2; ++bj) for (int m = 0; m < 4; ++m) for (int n = 0; n < 2; ++n) for (int e = 0; e < 4; ++e) {
            const int r = 128 * ai + 64 * wr + 16 * m + fr, c = 128 * bj + 32 * wc + 8 * fq + 4 * n + e; float s = 0.f;
            const bf16_t* ar = A + (size_t)r * lda; const bf16_t* br = Bt + (size_t)c * ldb;
            if (cur.f8) { const unsigned char* a8 = (const unsigned char*)cur.a + (size_t)r * lda8; const unsigned char* b8 = (const unsigned char*)cur.b + (size_t)c * ldb * 2;
                for (int k = 0; k < cur.nt * 128; ++k) s += fp8_dec_(a8[k]) * fp8_dec_(b8[k]); }
#ifdef EMU_FP8_A
            else if (cur.aux == 77) { float am = 0.f; for (int k = 0; k < K; ++k) am = fmaxf(am, fabsf(bf2f(br[k]))); const float sc = am > 0.f ? am / 440.f : 1.f;
                for (int k = 0; k < K; ++k) s += fp8_dec_(fp8_enc_(bf2f(ar[k]))) * fp8_dec_(fp8_enc_(bf2f(br[k]) / sc)); s *= sc; }
#endif
            else for (int k = 0; k < K; ++k) s += bf2f(ar[k]) * bf2f(br[k]);
            acc[ai][bj][m][n][e] = s; }
        __syncthreads();
        E(acc, cur, wr, wc, fr, fq, tid);
        __syncthreads();
    }
    __syncthreads();
}
#endif
}
struct Ptrs {
    bf16_t *WinT, *WbrT, *WoutT, *WqT, *PleT, *PleGT, *GluT, *K12, *S5Kc, *S5Wx, *S5Wy, *Ut, *Vt, *hb, *proj, *merged, *q, *ycat, *vtr, *pb;
    float *S5LL, *gate; int* eid; unsigned char* stash; bf16_t *rwPT, *rwG, *rwS0, *rwQ, *rwGt, *rwRKV; unsigned char *U8, *V8; float *su, *sv, *pd; unsigned* qcnt; unsigned char *h8a, *h8b, *h8e; float *gsc, *gscA;
};
__device__ __forceinline__ Ptrs make_ptrs(unsigned char* ws, int l) {
    Ptrs P; { size_t zoff = 0; OPAQUE_S(zoff); ws += zoff; }
    P.WinT = (bf16_t*)(ws + WS_WIN) + (size_t)l * WIN_ROWS * 1024; P.WbrT = (bf16_t*)(ws + WS_WBR) + (size_t)l * 1024 * 1024; P.WoutT = (bf16_t*)(ws + WS_WOUT) + (size_t)l * 1024 * 1024;
    P.WqT = (bf16_t*)(ws + WS_WQ) + (size_t)l * 2048 * 1024; P.PleT = (bf16_t*)(ws + WS_PLE) + (size_t)l * 1024 * 256; P.PleGT = (bf16_t*)(ws + WS_PLEG) + (size_t)l * 1024 * 1024;
    P.GluT = (bf16_t*)(ws + WS_GLU) + (size_t)l * 256 * 256; P.K12 = (bf16_t*)(ws + WS_K12) + (size_t)l * 2 * 128 * 128;
    P.S5Kc = (bf16_t*)(ws + WS_S5KC) + (size_t)l * 16 * 64 * 256; P.S5Wx = (bf16_t*)(ws + WS_S5WX) + (size_t)l * 16 * 128 * 1024; P.S5Wy = (bf16_t*)(ws + WS_S5WY) + (size_t)l * 16 * 1024 * 128;
    P.S5LL = (float*)(ws + WS_S5LL) + (size_t)l * 16 * 64 * 2;
    P.Ut = (bf16_t*)(ws + WS_UT); P.Vt = (bf16_t*)(ws + WS_VT);
    P.pd = (float*)(ws + WS_R1 + R1_Q); P.qcnt = (unsigned*)(ws + WS_CTL) + 8192 + l * 4 * 8 * 16;
    P.U8 = ws + WS_UT; P.V8 = ws + WS_UT + (size_t)NEXP * 1024; P.su = (float*)(ws + WS_CTL + 131072); P.sv = (float*)(ws + WS_CTL + 131072) + NEXP;
    P.rwGt = (bf16_t*)(ws + WS_VT); P.rwRKV = (bf16_t*)(ws + WS_VT + RW_SZ);
    P.rwPT = (bf16_t*)(ws + WS_RW); P.rwG = (bf16_t*)(ws + WS_RW + RW_SZ); P.rwS0 = (bf16_t*)(ws + WS_RW + 2 * RW_SZ); P.rwQ = (bf16_t*)(ws + WS_RW + 3 * RW_SZ);
    P.hb = (bf16_t*)(ws + WS_HB); P.proj = (bf16_t*)(ws + WS_R1 + R1_PROJ); P.merged = (bf16_t*)(ws + WS_R1 + R1_MERGED); P.q = (bf16_t*)(ws + WS_R1 + R1_Q);
    P.stash = ws + WS_R1 + R1_STASH; P.eid = (int*)(ws + WS_R1 + R1_EID); P.gate = (float*)(ws + WS_R1 + R1_GATE);
    P.ycat = (bf16_t*)(ws + WS_YC); P.vtr = (bf16_t*)(ws + WS_VTR); P.pb = (bf16_t*)(ws + WS_PB);
    P.h8a = ws + WS_R1 + R1_H8; P.h8b = ws + WS_H8T; P.h8e = ws + WS_RW; P.gsc = (float*)(ws + WS_CTL + 262144) + l * 6144; P.gscA = (float*)(ws + WS_CTL + 327680) + l * 2304;
    return P;
}

__device__ __forceinline__ int win_src_col(int n) {
    if (n < 1152) return n;
    if (n < 1664) return n;
    if (n < 1668) return 1920 + (n - 1664);
    if (n < 1792) return -1;
    if (n < 2304) return 1924 + (n - 1792);
    if (n < 2560) return 1664 + (n - 2304);
    return 2436 + (n - 2560);
}
template <bool WINMAP>
__device__ __forceinline__ void transpose_item(const float* src, int sld, bf16_t* dst, int dld, int dcol0, int kb, int nb, float* scr, int lane) {
    const int k0 = 64 * kb, n0 = 32 * nb;
    const int nn = n0 + (lane & 31); const int sc = WINMAP ? win_src_col(nn) : nn;
#pragma unroll 8
    for (int i = 0; i < 32; ++i) { const int kk = 2 * i + (lane >> 5); scr[kk * 33 + (lane & 31)] = (sc >= 0) ? src[(size_t)(k0 + kk) * sld + sc] : 0.f; }
    WAVE_SYNC();
    const int c = lane & 7;
#pragma unroll
    for (int j = 0; j < 4; ++j) { const int n = (lane >> 3) + 8 * j; const float* s = scr + (8 * c) * 33 + n;
        u32x4 o; o.x = pk2(s[0 * 33], s[1 * 33]); o.y = pk2(s[2 * 33], s[3 * 33]); o.z = pk2(s[4 * 33], s[5 * 33]); o.w = pk2(s[6 * 33], s[7 * 33]);
        *(u32x4*)(dst + (size_t)(n0 + n) * dld + dcol0 + k0 + 8 * c) = o; }
    WAVE_SYNC();
}

__device__ __forceinline__ void s5_tables(const KP& p, int l, int g, unsigned char* lds) {
    float* pw = (float*)lds;
    float* bb = pw + 65 * 128;
    float* cc = bb + 64 * 32;
    const int tid = TIDX();
    const Ptrs P = make_ptrs(p.ws, l);
    const float dt = expf(p.in[I_LDT][l * 16 + g]);
    if (tid < 64) { const int pp = tid; const float lr = p.in[I_LRE][(l * 16 + g) * 64 + pp], li = p.in[I_LIM][(l * 16 + g) * 64 + pp];
        const float mag = expf(lr * dt), ang = li * dt; const float br = mag * cosf(ang), bi = mag * sinf(ang);
        float xr = 1.f, xi = 0.f;
        for (int t = 0; t <= 64; ++t) { pw[(t * 64 + pp) * 2] = xr; pw[(t * 64 + pp) * 2 + 1] = xi; const float nr = xr * br - xi * bi, ni = xr * bi + xi * br; xr = nr; xi = ni; }
        const float nr = br - 1.f, ni = bi, den = lr * lr + li * li; const float cr = (nr * lr + ni * li) / den, ci = (ni * lr - nr * li) / den;
        for (int c = 0; c < 16; ++c) { const float b_r = p.in[I_BRE][((l * 16 + g) * 64 + pp) * 16 + c], b_i = p.in[I_BIM][((l * 16 + g) * 64 + pp) * 16 + c];
            bb[(pp * 16 + c) * 2] = cr * b_r - ci * b_i; bb[(pp * 16 + c) * 2 + 1] = cr * b_i + ci * b_r; }
        P.S5LL[(g * 64 + pp) * 2] = pw[(64 * 64 + pp) * 2]; P.S5LL[(g * 64 + pp) * 2 + 1] = pw[(64 * 64 + pp) * 2 + 1];
    }
    for (int e = tid; e < 1024; e += NTHR) { const int c = e >> 6, pp = e & 63; cc[e * 2] = p.in[I_CRE][((l * 16 + g) * 16 + c) * 64 + pp]; cc[e * 2 + 1] = p.in[I_CIM][((l * 16 + g) * 16 + c) * 64 + pp]; }
    __syncthreads();
    bf16_t* Kc = P.S5Kc + (size_t)g * 64 * 256;
    for (int e = tid; e < 64 * 256; e += NTHR) { const int tau = e >> 8, co = (e >> 4) & 15, ci = e & 15; float s = 0.f;
        for (int pp = 0; pp < 64; ++pp) { const float c_r = cc[(co * 64 + pp) * 2], c_i = cc[(co * 64 + pp) * 2 + 1], w_r = pw[(tau * 64 + pp) * 2], w_i = pw[(tau * 64 + pp) * 2 + 1];
            const float t_r = c_r * w_r - c_i * w_i, t_i = c_r * w_i + c_i * w_r; s += t_r * bb[(pp * 16 + ci) * 2] - t_i * bb[(pp * 16 + ci) * 2 + 1]; }
        Kc[e] = (bf16_t)f2bf(s); }
    bf16_t* Wx = P.S5Wx + (size_t)g * 128 * 1024;
    for (int e = tid; e < 128 * 1024; e += NTHR) { const int n = e >> 10, k = e & 1023, pp = n >> 1, ri = n & 1, s = k >> 4, ci = k & 15;
        const float w_r = pw[((63 - s) * 64 + pp) * 2], w_i = pw[((63 - s) * 64 + pp) * 2 + 1], b_r = bb[(pp * 16 + ci) * 2], b_i = bb[(pp * 16 + ci) * 2 + 1];
        Wx[e] = (bf16_t)f2bf(ri ? (w_r * b_i + w_i * b_r) : (w_r * b_r - w_i * b_i)); }
    bf16_t* Wy = P.S5Wy + (size_t)g * 1024 * 128;
    for (int e = tid; e < 1024 * 128; e += NTHR) { const int n = e >> 7, k = e & 127, t = n >> 4, co = n & 15, pp = k >> 1, ri = k & 1;
        const float c_r = cc[(co * 64 + pp) * 2], c_i = cc[(co * 64 + pp) * 2 + 1], w_r = pw[((t + 1) * 64 + pp) * 2], w_i = pw[((t + 1) * 64 + pp) * 2 + 1];
        Wy[e] = (bf16_t)f2bf(ri ? -(c_r * w_i + c_i * w_r) : (c_r * w_r - c_i * w_i)); }
    __syncthreads();
}

__device__ __forceinline__ void ln_row(const float* src, const float* g, const float* b, float* dst, bf16_t* dstb, int lane) {
    f32x4 v[4]; float s = 0.f;
#pragma unroll
    for (int j = 0; j < 4; ++j) { v[j] = *(const f32x4*)(src + 256 * j + 4 * lane); s += (v[j].x + v[j].y) + (v[j].z + v[j].w); }
    const float mean = wave_sum(s) * (1.f / 1024.f); float s2 = 0.f;
#pragma unroll
    for (int j = 0; j < 4; ++j) { v[j] = v[j] - mean; s2 += (v[j].x * v[j].x + v[j].y * v[j].y) + (v[j].z * v[j].z + v[j].w * v[j].w); }
    const float rstd = 1.f / sqrtf(wave_sum(s2) * (1.f / 1024.f) + LN_EPS_);
#pragma unroll
    for (int j = 0; j < 4; ++j) { const f32x4 gg = *(const f32x4*)(g + 256 * j + 4 * lane), bv = *(const f32x4*)(b + 256 * j + 4 * lane);
        const f32x4 o = v[j] * rstd * gg + bv; *(f32x4*)(dst + 256 * j + 4 * lane) = o;
        if (dstb) { u32x2 w; w.x = pk2(o.x, o.y); w.y = pk2(o.z, o.w); *(u32x2*)(dstb + 256 * j + 4 * lane) = w; } }
}

template <int NR, bool SB = false>
__device__ __forceinline__ void ln_rows(const void* srcv, const float* g, const float* b, float* dst, bf16_t* dstb, unsigned char* d8, int lane) {
    f32x4 v[NR][4]; float s[NR], s2[NR];
#pragma unroll
    for (int r = 0; r < NR; ++r) { s[r] = 0.f;
#pragma unroll
        for (int j = 0; j < 4; ++j) {
            if (SB) { const u32x2 w = *(const u32x2*)((const bf16_t*)srcv + (size_t)r * 1024 + 256 * j + 4 * lane); v[r][j] = (f32x4){bflo(w.x), bfhi(w.x), bflo(w.y), bfhi(w.y)}; }
            else v[r][j] = *(const f32x4*)((const float*)srcv + (size_t)r * 1024 + 256 * j + 4 * lane);
            s[r] += (v[r][j].x + v[r][j].y) + (v[r][j].z + v[r][j].w); } }
    wave_sum_n<NR>(s);
#pragma unroll
    for (int r = 0; r < NR; ++r) { const float mean = s[r] * (1.f / 1024.f); s2[r] = 0.f;
#pragma unroll
        for (int j = 0; j < 4; ++j) { v[r][j] = v[r][j] - mean; s2[r] += (v[r][j].x * v[r][j].x + v[r][j].y * v[r][j].y) + (v[r][j].z * v[r][j].z + v[r][j].w * v[r][j].w); } }
    wave_sum_n<NR>(s2);
#pragma unroll
    for (int j = 0; j < 4; ++j) { const f32x4 gg = *(const f32x4*)(g + 256 * j + 4 * lane), bv = *(const f32x4*)(b + 256 * j + 4 * lane);
#pragma unroll
        for (int r = 0; r < NR; ++r) { const float rstd = 1.f / sqrtf(s2[r] * (1.f / 1024.f) + LN_EPS_);
            const f32x4 o = v[r][j] * rstd * gg + bv; if (dst) *(f32x4*)(dst + (size_t)r * 1024 + 256 * j + 4 * lane) = o;
            if (dstb) { u32x2 w; w.x = pk2(o.x, o.y); w.y = pk2(o.z, o.w); *(u32x2*)(dstb + (size_t)r * 1024 + 256 * j + 4 * lane) = w; }
            if (d8) { unsigned w8 = cvt_pk_fp8_f32_(o.x, o.y, 0u, false); w8 = cvt_pk_fp8_f32_(o.z, o.w, w8, true); *(unsigned*)(d8 + (size_t)r * 1024 + 256 * j + 4 * lane) = w8; } } }
}
__device__ __forceinline__ void phase_prologue(const KP& p, unsigned char* lds) {
    const int tid = TIDX(), lane = tid & 63, wave = tid >> 6;
    int G = GDIM(), bid = BIDX();
    for (int it = bid; it < L_ * 16; it += G) s5_tables(p, it >> 4, it & 15, lds);
    if (G >= 4 * L_ * 16) { if (bid < L_ * 16) return; bid -= L_ * 16; G -= L_ * 16; }
    float* scr = (float*)lds + wave * (64 * 33 + 16);
    const int gw = bid * NWAVE + wave, NGW = G * NWAVE;
    constexpr int I_WINT = (WIN_ROWS / 32) * 16, I_BR = 4 * 4 * 32, I_OUT = 16 * 32, I_Q = 16 * 64, I_PL = 4 * 32, I_PG = 16 * 32, I_GL = 4 * 8;
    constexpr int PER_L = I_WINT + I_BR + I_OUT + I_Q + I_PL + I_PG + I_GL;
    for (int it = gw; it < L_ * PER_L; it += NGW) {
        const int l = it / PER_L; int r = it % PER_L; const Ptrs P = make_ptrs(p.ws, l);
        if (r < I_WINT) { transpose_item<true>(p.in[I_WIN] + (size_t)l * 1024 * IN_COLS, IN_COLS, P.WinT, 1024, 0, r & 15, r >> 4, scr, lane); continue; } r -= I_WINT;
        if (r < I_BR) { const int b = r >> 7, rr = r & 127; transpose_item<false>(p.in[I_WBR] + ((size_t)l * 4 + b) * 256 * 1024, 1024, P.WbrT, 1024, 256 * b, rr & 3, rr >> 2, scr, lane); continue; } r -= I_BR;
        if (r < I_OUT) { transpose_item<false>(p.in[I_WOUT] + (size_t)l * 1024 * 1024, 1024, P.WoutT, 1024, 0, r & 15, r >> 4, scr, lane); continue; } r -= I_OUT;
        if (r < I_Q) { transpose_item<false>(p.in[I_WQ] + (size_t)l * 1024 * 2048, 2048, P.WqT, 1024, 0, r & 15, r >> 4, scr, lane); continue; } r -= I_Q;
        if (r < I_PL) { transpose_item<false>(p.in[I_PLEW] + (size_t)l * 256 * 1024, 1024, P.PleT, 256, 0, r & 3, r >> 2, scr, lane); continue; } r -= I_PL;
        if (r < I_PG) { transpose_item<false>(p.in[I_PLEG] + (size_t)l * 1024 * 1024, 1024, P.PleGT, 1024, 0, r & 15, r >> 4, scr, lane); continue; } r -= I_PG;
        transpose_item<false>(p.in[I_GLUW] + (size_t)l * 256 * 256, 256, P.GluT, 256, 0, r & 3, r >> 2, scr, lane);
    }
    const size_t gt = (size_t)bid * NTHR + tid, NGT = (size_t)G * NTHR;
    { bf16_t* K12 = (bf16_t*)(p.ws + WS_K12);
      for (size_t i = gt; i < (size_t)L_ * 2 * 16384 / 8; i += NGT) { const size_t e = i * 8; const int l = (int)(e / 32768), r = (int)(e % 32768); const float* s = (r < 16384 ? p.in[I_K1] : p.in[I_K2]) + (size_t)l * 16384 + (r & 16383);
        const f32x4 a = *(const f32x4*)s, b = *(const f32x4*)(s + 4); u32x4 o; o.x = pk2(a.x, a.y); o.y = pk2(a.z, a.w); o.z = pk2(b.x, b.y); o.w = pk2(b.z, b.w); *(u32x4*)(K12 + e) = o; } }
    { bf16_t* hb = (bf16_t*)(p.ws + WS_HB);
      unsigned char* h8a = p.ws + WS_R1 + R1_H8; unsigned char* h8b = p.ws + WS_H8T;
      for (int m = 4 * gw; m < T_; m += 4 * NGW) ln_rows<4>(p.in[I_X] + (size_t)m * 1024, p.in[I_LNIN_G], p.in[I_LNIN_B], (float*)nullptr, hb + (size_t)m * 1024, m < H8_SPLIT ? h8a + (size_t)m * 1024 : h8b + (size_t)(m - H8_SPLIT) * 1024, lane); }
}
__device__ __forceinline__ void conv_unit(const KP& p, const Ptrs& P, int l, int unit, unsigned char* lds) {
    bf16_t* hbuf = (bf16_t*)lds;
    float* obuf = (float*)(lds + 94 * 256 * 2);
    const int tid = TIDX(), lane = tid & 63, wave = tid >> 6;
    const int tiles_per_seq = S_ / 64, b = unit / tiles_per_seq, t0 = (unit % tiles_per_seq) * 64;
    for (int e = tid; e < 94 * 32; e += NTHR) { const int r = e >> 5, c8 = (e & 31) * 8; const int t = t0 - 30 + r;
        u32x4 o = (u32x4){0u, 0u, 0u, 0u};
        if (t >= 0) { const bf16_t* row = P.proj + (size_t)(b * S_ + t) * PJ; const u32x4 v = *(const u32x4*)(row + C_CV + c8), g = *(const u32x4*)(row + C_CG + c8);
            o.x = pk2(bflo(v.x) * sigmoidf_(bflo(g.x)), bfhi(v.x) * sigmoidf_(bfhi(g.x))); o.y = pk2(bflo(v.y) * sigmoidf_(bflo(g.y)), bfhi(v.y) * sigmoidf_(bfhi(g.y)));
            o.z = pk2(bflo(v.z) * sigmoidf_(bflo(g.z)), bfhi(v.z) * sigmoidf_(bfhi(g.z))); o.w = pk2(bflo(v.w) * sigmoidf_(bflo(g.w)), bfhi(v.w) * sigmoidf_(bfhi(g.w))); }
        *(u32x4*)(hbuf + r * 256 + c8) = o; }
    __syncthreads();
    { const int c = tid & 255, half = tid >> 8; float w[31], x[62];
#pragma unroll
      for (int j = 0; j < 31; ++j) w[j] = p.in[I_CONVW][(l * 31 + j) * 256 + c];
      const float cb = p.in[I_CONVB][l * 256 + c];
#pragma unroll
      for (int j = 0; j < 62; ++j) x[j] = bf2f(hbuf[(half * 32 + j) * 256 + c]);
#pragma unroll
      for (int tt = 0; tt < 32; ++tt) { float s = cb;
#pragma unroll
          for (int j = 0; j < 31; ++j) s += w[j] * x[tt + j];
          obuf[(half * 32 + tt) * 256 + c] = s; } }
    __syncthreads();
    { const f32x4 g = *(const f32x4*)(p.in[I_CLNG] + l * 256 + 4 * lane), bb = *(const f32x4*)(p.in[I_CLNB] + l * 256 + 4 * lane);
      f32x4 vv[8]; float m1[8], m2[8];
#pragma unroll
      for (int i = 0; i < 8; ++i) { vv[i] = *(const f32x4*)(obuf + (wave * 8 + i) * 256 + 4 * lane); m1[i] = (vv[i].x + vv[i].y) + (vv[i].z + vv[i].w); }
      wave_sum_n<8>(m1);
#pragma unroll
      for (int i = 0; i < 8; ++i) { vv[i] = vv[i] - m1[i] * (1.f / 256.f); m2[i] = (vv[i].x * vv[i].x + vv[i].y * vv[i].y) + (vv[i].z * vv[i].z + vv[i].w * vv[i].w); }
      wave_sum_n<8>(m2);
#pragma unroll
      for (int i = 0; i < 8; ++i) { const int t = wave * 8 + i; const float rstd = 1.f / sqrtf(m2[i] * (1.f / 256.f) + LN_EPS_);
          f32x4 z = vv[i] * rstd * g + bb; u32x2 w; w.x = pk2(z.x * sigmoidf_(z.x), z.y * sigmoidf_(z.y)); w.y = pk2(z.z * sigmoidf_(z.z), z.w * sigmoidf_(z.w));
          *(u32x2*)(P.ycat + (size_t)(b * S_ + t0 + t) * 1024 + 768 + 4 * lane) = w; } }
    __syncthreads();
}

constexpr int S5_NCH = S_ / 64;
constexpr int S5_UPITCH = 1032;
constexpr int S5_XPITCH = 136;
__device__ __forceinline__ void s5_unit(const KP& p, const Ptrs& P, int l, int unit, unsigned char* lds) {
    const int b = unit >> 4, g = unit & 15;
    bf16_t* Uc = (bf16_t*)lds;
    bf16_t* Kc = (bf16_t*)(lds + 66048);
    float* Xe = (float*)(lds + 66048 + 32768);
    bf16_t* Xs = (bf16_t*)(lds + 66048 + 65536);
    const int tid = TIDX(), lane = tid & 63, wave = tid >> 6, r32 = lane & 31, hi = lane >> 5;
    { u32x4 v[8], kc[4];
#pragma unroll
      for (int j = 0; j < 8; ++j) { const int e = tid + j * NTHR, s = e >> 1, hf = e & 1; v[j] = (u32x4){0u, 0u, 0u, 0u};
          if (s < S_) v[j] = *(const u32x4*)(P.proj + (size_t)(b * S_ + s) * PJ + C_S5 + 16 * g + 8 * hf); }
#pragma unroll
      for (int j = 0; j < 4; ++j) kc[j] = *(const u32x4*)(P.S5Kc + (size_t)g * 16384 + (tid + j * NTHR) * 8);
#pragma unroll
      for (int j = 0; j < 8; ++j) { const int e = tid + j * NTHR, s = e >> 1, hf = e & 1; *(u32x4*)(Uc + (s >> 6) * S5_UPITCH + (s & 63) * 16 + 8 * hf) = v[j]; }
#pragma unroll
      for (int j = 0; j < 4; ++j) *(u32x4*)(Kc + (tid + j * NTHR) * 8) = kc[j]; }
    __syncthreads();
    { const int ntile = wave & 3, kh = wave >> 2; f32x16 acc = {};
      const bf16_t* wrow = P.S5Wx + ((size_t)g * 128 + ntile * 32 + r32) * 1024 + kh * 512 + 8 * hi;
      const bf16_t* urow = Uc + r32 * S5_UPITCH + kh * 512 + 8 * hi;
      for (int k8 = 0; k8 < 32; k8 += 8) { bf16x8 bw[8];
#pragma unroll
          for (int j = 0; j < 8; ++j) bw[j] = *(const bf16x8*)(wrow + (k8 + j) * 16);
#pragma unroll
          for (int j = 0; j < 8; ++j) { const bf16x8 a = *(const bf16x8*)(urow + (k8 + j) * 16); acc = MFMA32(a, bw[j], acc); } }
#pragma unroll
      for (int r = 0; r < 16; ++r) { const int c = (r & 3) + 8 * (r >> 2) + 4 * hi; Xe[(kh * 32 + c) * 128 + ntile * 32 + r32] = acc[r]; } }
    __syncthreads();
    if (tid < 64) { const float lr = P.S5LL[(g * 64 + tid) * 2], li = P.S5LL[(g * 64 + tid) * 2 + 1]; float xr = 0.f, xi = 0.f;
        for (int c = 0; c < 32; ++c) { Xs[c * S5_XPITCH + 2 * tid] = (bf16_t)f2bf(xr); Xs[c * S5_XPITCH + 2 * tid + 1] = (bf16_t)f2bf(xi);
            const float er = Xe[c * 128 + 2 * tid] + Xe[(32 + c) * 128 + 2 * tid], ei = Xe[c * 128 + 2 * tid + 1] + Xe[(32 + c) * 128 + 2 * tid + 1];
            const float nr = lr * xr - li * xi + er, ni = lr * xi + li * xr + ei; xr = nr; xi = ni; } }
    __syncthreads();
    { const int tt = r32 >> 4, co = r32 & 15; const float dsk = p.in[I_S5D][l * 256 + 16 * g + co];
      for (int q = 0; q < 4; ++q) { const int ntile = wave + 8 * q, t0 = 2 * ntile; f32x16 acc = {};
          const bf16_t* urow = Uc + r32 * S5_UPITCH + 8 * hi;
          for (int s = 0; s <= t0 + 1; ++s) { const int tau = t0 + tt - s; bf16x8 bk = (bf16x8){0, 0, 0, 0, 0, 0, 0, 0};
              if (tau >= 0) bk = *(const bf16x8*)(Kc + (tau * 16 + co) * 16 + 8 * hi);
              const bf16x8 a = *(const bf16x8*)(urow + s * 16); acc = MFMA32(a, bk, acc); }
          const bf16_t* wy = P.S5Wy + ((size_t)g * 1024 + ntile * 32 + r32) * 128 + 8 * hi; const bf16_t* xrow = Xs + r32 * S5_XPITCH + 8 * hi;
#pragma unroll
          for (int ks = 0; ks < 8; ++ks) { const bf16x8 a = *(const bf16x8*)(xrow + ks * 16); const bf16x8 bw = *(const bf16x8*)(wy + ks * 16); acc = MFMA32(a, bw, acc); }
#pragma unroll
          for (int r = 0; r < 16; ++r) { const int c = (r & 3) + 8 * (r >> 2) + 4 * hi; const int s = c * 64 + t0 + tt;
              if (s < S_) { const float uu = bf2f(Uc[c * S5_UPITCH + (t0 + tt) * 16 + co]); const float y = acc[r] + dsk * uu;
                  P.ycat[(size_t)(b * S_ + s) * 1024 + 256 + 16 * g + co] = (bf16_t)f2bf(gelu_erf(y)); } } } }
    __syncthreads();
}
constexpr float LOG2E_ = 1.4426950408889634f;
__device__ __forceinline__ float log_sigmoid_(float x) { return fminf(x, 0.f) - log1pf(__expf(-fabsf(x))); }
__device__ __forceinline__ void fox_unit(const KP& p, const Ptrs& P, int l, int unit, unsigned char* lds) {
    constexpr int NQB = S_ / 256;
    const int bh = unit / NQB, qb = (unit >= (NB_ * 4 * NQB) / 2) ? NQB - 1 - unit % NQB : unit % NQB, b = bh >> 2, h = bh & 3, q0 = qb * 256;
    float* cl = (float*)lds;
    unsigned char* Kt = lds + S_ * 4;
    unsigned char* Vt = Kt + 8192;
    float* wsf = (float*)(Kt + 32768);
    float* sc = wsf + 256;
    const int tid = TIDX(), lane = tid & 63, wave = tid >> 6, r32 = lane & 31, hi = lane >> 5;
    const int qend = q0 + 256;
    { constexpr int PER = (S_ + 511) / 512; const float bf = p.in[I_BF][l * 4 + h]; float loc[PER]; float s = 0.f;
#pragma unroll
      for (int i = 0; i < PER; ++i) { const int t = tid * PER + i; float v = 0.f;
          if (t < qend) v = log_sigmoid_(bf2f(P.proj[(size_t)(b * S_ + t) * PJ + C_FL + h]) + bf) * LOG2E_;
          s += v; loc[i] = s; }
      sc[tid] = s; __syncthreads();
      for (int off = 1; off < 512; off <<= 1) { const float v = sc[tid] + (tid >= off ? sc[tid - off] : 0.f); __syncthreads(); sc[tid] = v; __syncthreads(); }
      const float base = sc[tid] - s;
#pragma unroll
      for (int i = 0; i < PER; ++i) { const int t = tid * PER + i; if (t < S_) cl[t] = base + loc[i]; }
      __syncthreads(); }
    const int qrow = q0 + 32 * wave + r32;
    constexpr float C2 = 0.125f * LOG2E_;
    bf16x8 qr[4];
    { const bf16_t* qp = P.proj + (size_t)(b * S_ + qrow) * PJ + C_FQ + 64 * h + 8 * hi;
#pragma unroll
      for (int d0 = 0; d0 < 4; ++d0) { const u32x4 w = *(const u32x4*)(qp + 16 * d0);
          u32x4 o; o.x = pk2(bflo(w.x) * C2, bfhi(w.x) * C2); o.y = pk2(bflo(w.y) * C2, bfhi(w.y) * C2); o.z = pk2(bflo(w.z) * C2, bfhi(w.z) * C2); o.w = pk2(bflo(w.w) * C2, bfhi(w.w) * C2);
          qr[d0] = __builtin_bit_cast(bf16x8, o); } }
    const float clq = cl[qrow];
    float mrun = -INFINITY, lrun = 0.f; f32x16 o0 = {}, o1 = {};
    const int NT = qend / 64;
    const int srow = tid >> 3, sch = tid & 7;
    const bf16_t* kg = P.proj + (size_t)(b * S_ + srow) * PJ + C_FK + 64 * h + 8 * sch;
    const bf16_t* vg = P.vtr + (size_t)(64 * h + srow) * T_ + (size_t)b * S_ + 8 * sch;
    const int koff = srow * 128 + ((sch ^ ((srow >> 1) & 7)) * 16);
    const int voffa = srow * 128 + (((2 * sch) ^ ((srow >> 1) & 15)) * 8), voffb = srow * 128 + (((2 * sch + 1) ^ ((srow >> 1) & 15)) * 8);
    u32x4 kreg = *(const u32x4*)kg, vreg = *(const u32x4*)vg;
    *(u32x4*)(Kt + koff) = kreg; *(u32x2*)(Vt + voffa) = (u32x2){vreg.x, vreg.y}; *(u32x2*)(Vt + voffb) = (u32x2){vreg.z, vreg.w};
    if (NT > 1) { kreg = *(const u32x4*)(kg + (size_t)64 * PJ); vreg = *(const u32x4*)(vg + 64); }
    __syncthreads();
    for (int jt = 0; jt < NT; ++jt) {
        const int kv0 = jt * 64; const unsigned char* Kb = Kt + (jt & 1) * 16384; const unsigned char* Vb = Vt + (jt & 1) * 16384;
        if (kv0 <= q0 + 32 * wave + 31) {
            f32x16 pt[2];
#pragma unroll
            for (int kvt = 0; kvt < 2; ++kvt) { const int row = 32 * kvt + r32; f32x16 acc;
#pragma unroll
                for (int g4 = 0; g4 < 4; ++g4) { const f32x4 c4 = *(const f32x4*)(cl + kv0 + 32 * kvt + 8 * g4 + 4 * hi);
#pragma unroll
                    for (int e = 0; e < 4; ++e) acc[4 * g4 + e] = clq - c4[e]; }
#pragma unroll
                for (int d0 = 0; d0 < 4; ++d0) { const bf16x8 a = *(const bf16x8*)(Kb + row * 128 + (((2 * d0 + hi) ^ ((row >> 1) & 7)) * 16)); acc = MFMA32(a, qr[d0], acc); }
                pt[kvt] = acc; }
            if (kv0 + 63 > q0 + 32 * wave) {
#pragma unroll
                for (int kvt = 0; kvt < 2; ++kvt)
#pragma unroll
                    for (int r = 0; r < 16; ++r) { const int key = kv0 + 32 * kvt + (r & 3) + 8 * (r >> 2) + 4 * hi; if (key > qrow) pt[kvt][r] = -INFINITY; } }
            float mx = -INFINITY;
#pragma unroll
            for (int kvt = 0; kvt < 2; ++kvt)
#pragma unroll
                for (int r = 0; r < 16; ++r) mx = fmaxf(mx, pt[kvt][r]);
            mx = fmaxf(mx, __shfl_xor(mx, 32));
            const float mnew = fmaxf(mrun, mx), alpha = FAST_EXP2(mrun - mnew); mrun = mnew;
            float ls = 0.f;
#pragma unroll
            for (int kvt = 0; kvt < 2; ++kvt)
#pragma unroll
                for (int r = 0; r < 16; ++r) { const float e = FAST_EXP2(pt[kvt][r] - mnew); pt[kvt][r] = e; ls += e; }
            lrun = lrun * alpha + ls;
            float* wf = wsf + wave * 32;
            WAVE_SYNC(); if (hi == 0) wf[r32] = alpha; WAVE_SYNC();
#pragma unroll
            for (int g4 = 0; g4 < 4; ++g4) { const f32x4 f = *(const f32x4*)(wf + 8 * g4 + 4 * hi);
#pragma unroll
                for (int e = 0; e < 4; ++e) { o0[4 * g4 + e] *= f[e]; o1[4 * g4 + e] *= f[e]; } }
#pragma unroll
            for (int s = 0; s < 4; ++s) { const int kvt = s >> 1, rb = 8 * (s & 1);
                u32x4 pw; pw.x = pk2(pt[kvt][rb + 0], pt[kvt][rb + 1]); pw.y = pk2(pt[kvt][rb + 2], pt[kvt][rb + 3]); pw.z = pk2(pt[kvt][rb + 4], pt[kvt][rb + 5]); pw.w = pk2(pt[kvt][rb + 6], pt[kvt][rb + 7]);
                const bf16x8 pa = __builtin_bit_cast(bf16x8, pw);
#pragma unroll
                for (int dt = 0; dt < 2; ++dt) { const int d = 32 * dt + r32; const int sw = (d >> 1) & 15;
                    const u32x2 va = *(const u32x2*)(Vb + d * 128 + (((4 * s + hi) ^ sw) * 8)), vb = *(const u32x2*)(Vb + d * 128 + (((4 * s + 2 + hi) ^ sw) * 8));
                    const bf16x8 vf = __builtin_bit_cast(bf16x8, (u32x4){va.x, va.y, vb.x, vb.y});
                    if (dt == 0) o0 = MFMA32(pa, vf, o0); else o1 = MFMA32(pa, vf, o1); } }
        }
        if (jt + 1 < NT) { unsigned char* Kn = Kt + ((jt + 1) & 1) * 16384; unsigned char* Vn = Vt + ((jt + 1) & 1) * 16384;
            *(u32x4*)(Kn + koff) = kreg; *(u32x2*)(Vn + voffa) = (u32x2){vreg.x, vreg.y}; *(u32x2*)(Vn + voffb) = (u32x2){vreg.z, vreg.w};
            if (jt + 2 < NT) { kreg = *(const u32x4*)(kg + (size_t)(kv0 + 128) * PJ); vreg = *(const u32x4*)(vg + kv0 + 128); } }
        __syncthreads();
    }
    { const float lt = lrun + __shfl_xor(lrun, 32); float* wf = wsf + wave * 32;
      WAVE_SYNC(); if (hi == 0) wf[r32] = 1.0f / lt; WAVE_SYNC();
      bf16_t* orow = P.ycat + (size_t)(b * S_ + q0 + 32 * wave) * 1024 + 512 + 64 * h + r32;
#pragma unroll
      for (int r = 0; r < 16; ++r) { const int qq = (r & 3) + 8 * (r >> 2) + 4 * hi; const float f = wf[qq];
          orow[(size_t)qq * 1024] = (bf16_t)f2bf(o0[r] * f); orow[(size_t)qq * 1024 + 32] = (bf16_t)f2bf(o1[r] * f); } }
    __syncthreads();
}

constexpr int RW_NCH = S_ / 64;
constexpr int RWP = 72;
constexpr int RW_ARR = 64 * RWP * 2;
constexpr int RW_SCRP = 388;
__device__ __forceinline__ void rw_stage_weights(const KP& p, int l, int h, bf16_t* wb, int tid) {
    for (int e = tid; e < 2048; e += NTHR) { const int m = e >> 4, c4 = (e & 15) * 4;
        if (m < 32) { const f32x4 v = *(const f32x4*)(p.in[I_A2] + (l * 32 + m) * 256 + 64 * h + c4);
#pragma unroll
            for (int q = 0; q < 4; ++q) wb[(c4 + q) * 40 + m] = (bf16_t)f2bf(v[q]); }
        else if (m < 64) { const f32x4 v = *(const f32x4*)(p.in[I_W2] + (l * 32 + m - 32) * 256 + 64 * h + c4);
#pragma unroll
            for (int q = 0; q < 4; ++q) wb[2560 + (c4 + q) * 40 + (m - 32)] = (bf16_t)f2bf(v[q]); }
        else { const f32x4 v = *(const f32x4*)(p.in[I_G2] + (l * 64 + m - 64) * 256 + 64 * h + c4);
#pragma unroll
            for (int q = 0; q < 4; ++q) wb[5120 + (c4 + q) * 72 + (m - 64)] = (bf16_t)f2bf(v[q]); } }
    __syncthreads();
}
__device__ __forceinline__ bf16x8 rw_pack8(const float* q) { const f32x4 a = *(const f32x4*)q, b = *(const f32x4*)(q + 4);
    u32x4 w; w.x = pk2(a.x, a.y); w.y = pk2(a.z, a.w); w.z = pk2(b.x, b.y); w.w = pk2(b.z, b.w); return __builtin_bit_cast(bf16x8, w); }
template <int NT, bool NEED_W, bool NEED_G>
__device__ __forceinline__ void rw_prep(const KP& p, const Ptrs& P, int l, int b, int h, int tpos0, float* scr, const bf16_t* wb, int lane,
                                        float (&r)[NT], float (&lw)[NT], float (&k2)[NT], float (&v)[NT], float (&ain)[NT], float (&bin)[NT], float (&g)[NT], float (&rk)[NT]) {
    constexpr int NIT = (NT * 40 + 63) / 64;
    u32x4 cur[NIT], prv[NIT];
#pragma unroll
    for (int i = 0; i < NIT; ++i) { const int e = lane + 64 * i; const int tt = e / 40, ch = e % 40; const int t = tpos0 + tt;
        const int col = ch < 8 ? C_R + 64 * h + 8 * ch : ch < 16 ? C_K + 64 * h + 8 * (ch - 8) : ch < 24 ? C_V + 64 * h + 8 * (ch - 16) : C_HW + 8 * (ch - 24);
        cur[i] = (u32x4){0u, 0u, 0u, 0u}; prv[i] = (u32x4){0u, 0u, 0u, 0u};
        if (e < NT * 40) { const bf16_t* row = P.proj + (size_t)(b * S_ + t) * PJ + col; cur[i] = *(const u32x4*)row; if (t > 0) prv[i] = *(const u32x4*)(row - PJ); } }
#pragma unroll
    for (int i = 0; i < NIT; ++i) { const int e = lane + 64 * i; const int tt = e / 40, ch = e % 40;
        const int col = ch < 8 ? C_R + 64 * h + 8 * ch : ch < 16 ? C_K + 64 * h + 8 * (ch - 8) : ch < 24 ? C_V + 64 * h + 8 * (ch - 16) : C_HW + 8 * (ch - 24);
        const int idx = ch < 24 ? 8 * ch : 192 + 8 * (ch - 24);
        if (e < NT * 40) { const f32x4 m0 = *(const f32x4*)(p.in[I_MU] + l * 896 + col), m1 = *(const f32x4*)(p.in[I_MU] + l * 896 + col + 4);
            float z[8] = {bflo(cur[i].x), bfhi(cur[i].x), bflo(cur[i].y), bfhi(cur[i].y), bflo(cur[i].z), bfhi(cur[i].z), bflo(cur[i].w), bfhi(cur[i].w)};
            const float zp[8] = {bflo(prv[i].x), bfhi(prv[i].x), bflo(prv[i].y), bfhi(prv[i].y), bflo(prv[i].z), bfhi(prv[i].z), bflo(prv[i].w), bfhi(prv[i].w)};
#pragma unroll
            for (int q = 0; q < 8; ++q) { float zs = z[q] + (zp[q] - z[q]) * (q < 4 ? m0[q & 3] : m1[q & 3]);
                if (ch >= 24 && ch < 28) zs = 1.0f - 2.0f * FAST_RCP(1.0f + FAST_EXP2(zs * 2.8853900817779268f));
                else if (ch >= 32) zs = sigmoidf_(zs);
                z[q] = zs; }
            *(f32x4*)(scr + tt * RW_SCRP + idx) = (f32x4){z[0], z[1], z[2], z[3]}; *(f32x4*)(scr + tt * RW_SCRP + idx + 4) = (f32x4){z[4], z[5], z[6], z[7]}; } }
    WAVE_SYNC();
    { const int fr = lane & 15, fq = lane >> 4; const float* hrow = scr + (fr & 7) * RW_SCRP + 192 + 8 * fq;
      const bf16x8 fw = rw_pack8(hrow), fa = rw_pack8(hrow + 32), fg0 = rw_pack8(hrow + 64), fg1 = rw_pack8(hrow + 96);
      WAVE_SYNC();
#pragma unroll
      for (int nt = 0; nt < 4; ++nt) { const f32x4 z4 = (f32x4){0.f, 0.f, 0.f, 0.f};
          const f32x4 da = MFMA16(fa, *(const bf16x8*)(wb + (16 * nt + fr) * 40 + 8 * fq), z4);
          f32x4 dw = z4, dg = z4;
          if (NEED_W) dw = MFMA16(fw, *(const bf16x8*)(wb + 2560 + (16 * nt + fr) * 40 + 8 * fq), z4);
          if (NEED_G) { dg = MFMA16(fg0, *(const bf16x8*)(wb + 5120 + (16 * nt + fr) * 72 + 8 * fq), z4); dg = MFMA16(fg1, *(const bf16x8*)(wb + 5120 + (16 * nt + fr) * 72 + 32 + 8 * fq), dg); }
          if (fq < 2) {
#pragma unroll
              for (int q = 0; q < 4; ++q) { float* o = scr + (4 * fq + q) * RW_SCRP + 16 * nt + fr; o[192] = da[q]; if (NEED_W) o[256] = dw[q]; if (NEED_G) o[320] = dg[q]; } } }
      WAVE_SYNC(); }
    const int j = lane, cj = 64 * h + j; float wl[NT], al[NT], gg[NT];
    const float w0 = p.in[I_W0][l * 256 + cj], a0 = p.in[I_A0][l * 256 + cj];
#pragma unroll
    for (int tt = 0; tt < NT; ++tt) { al[tt] = a0 + scr[tt * RW_SCRP + 192 + j]; wl[tt] = NEED_W ? w0 + scr[tt * RW_SCRP + 256 + j] : w0; gg[tt] = NEED_G ? scr[tt * RW_SCRP + 320 + j] : 0.f; }
    const float kkw = p.in[I_KK][l * 256 + cj], kaw = p.in[I_KA][l * 256 + cj], rkw = p.in[I_RK][l * 256 + cj];
    float ssum[NT], rsum[NT], kkv[NT], av[NT];
#pragma unroll
    for (int tt = 0; tt < NT; ++tt) {
        const float a = sigmoidf_(al[tt]); av[tt] = a;
        const float rr = scr[tt * RW_SCRP + j], k = scr[tt * RW_SCRP + 64 + j], vv = scr[tt * RW_SCRP + 128 + j];
        const float kk2 = k * (1.f + (a - 1.f) * kaw);
        r[tt] = rr; k2[tt] = kk2; v[tt] = vv;
        const float kk = k * kkw; kkv[tt] = kk; ssum[tt] = kk * kk; rsum[tt] = rr * kk2 * rkw; }
    if (NEED_W) wave_sum_n<NT>(ssum);
    if (NEED_G) wave_sum_n<NT>(rsum);
#pragma unroll
    for (int tt = 0; tt < NT; ++tt) {
        if (NEED_W) { const float x = -wl[tt]; const float sp = fmaxf(x, 0.f) + 0.6931471805599453f * FAST_LOG2(1.0f + FAST_EXP2(-1.4426950408889634f * fabsf(x)));
            lw[tt] = -FAST_EXP2(-1.4426950408889634f * (sp + 0.5f));
            const float kkn = kkv[tt] * FAST_RSQ(fmaxf(ssum[tt], 1e-24f));
            ain[tt] = -kkn; bin[tt] = kkn * av[tt]; }
        if (NEED_G) { g[tt] = gg[tt]; rk[tt] = rsum[tt]; }
    }
    WAVE_SYNC();
}
__device__ __forceinline__ bf16x8 ldsb8(const bf16_t* p) { return *(const bf16x8*)p; }
__device__ __forceinline__ f32x16 rw_tile(const bf16_t* X, const bf16_t* Y, int tm, int tn, int r32, int hi, f32x16 acc) {
    const bf16_t* xa = X + (32 * tm + r32) * RWP + 8 * hi; const bf16_t* yb = Y + (32 * tn + r32) * RWP + 8 * hi;
#pragma unroll
    for (int ks = 0; ks < 4; ++ks) acc = MFMA32(ldsb8(xa + 16 * ks), ldsb8(yb + 16 * ks), acc);
    return acc;
}
template <int STOP = 0>
__device__ __forceinline__ void rw_chunk_unit(const KP& p, const Ptrs& P, int l, int unit, unsigned char* lds) {
    MEMFENCE(); OPAQUE_S(unit);
    const int c = unit % RW_NCH, bh = unit / RW_NCH, b = bh >> 2, h = bh & 3, t0 = c * 64;
    bf16_t* AT = (bf16_t*)(lds + 0 * RW_ARR); bf16_t* RT = (bf16_t*)(lds + 1 * RW_ARR); bf16_t* BT = (bf16_t*)(lds + 2 * RW_ARR); bf16_t* KT = (bf16_t*)(lds + 3 * RW_ARR);
    bf16_t* BH = (bf16_t*)(lds + 4 * RW_ARR); bf16_t* KH = (bf16_t*)(lds + 5 * RW_ARR); bf16_t* VT = (bf16_t*)(lds + 6 * RW_ARR);
    bf16_t* AAK = (bf16_t*)(lds + 7 * RW_ARR); bf16_t* ARB = (bf16_t*)(lds + 8 * RW_ARR); bf16_t* ARK = (bf16_t*)(lds + 9 * RW_ARR);
    bf16_t* W1T = (bf16_t*)(lds + 10 * RW_ARR); bf16_t* UVT = (bf16_t*)(lds + 11 * RW_ARR);
    bf16_t* RHT = (bf16_t*)(lds + 12 * RW_ARR);
    float* ADG = (float*)(lds + 14 * RW_ARR);
    bf16_t* ABA = (bf16_t*)(lds + 14 * RW_ARR + 8192);
    float* WT = (float*)(lds + 14 * RW_ARR + 8192 + 32 * RWP * 2);
    float* GC = WT + 512;
    bf16_t* DAB = AT;
    const int tid = TIDX(), lane = tid & 63, wave = tid >> 6, r32 = lane & 31, hi = lane >> 5;
    float r[8], lw[8], k2[8], v[8], ain[8], bin[8], gg[8], rk[8];
    rw_stage_weights(p, l, h, (bf16_t*)(lds + 8 * 8 * RW_SCRP * 4), tid);
    rw_prep<8, true, true>(p, P, l, b, h, t0 + 8 * wave, (float*)lds + wave * (8 * RW_SCRP), (const bf16_t*)(lds + 8 * 8 * RW_SCRP * 4), lane, r, lw, k2, v, ain, bin, gg, rk);
#pragma unroll
    for (int i = 0; i < 8; ++i) { const size_t o = (size_t)(b * S_ + t0 + 8 * wave + i) * 256 + 64 * h + lane; P.rwGt[o] = (bf16_t)f2bf(gg[i]); P.rwRKV[o] = (bf16_t)f2bf(rk[i] * v[i]); }
    float Lloc[8]; { float s = 0.f;
#pragma unroll
      for (int i = 0; i < 8; ++i) { s += lw[i]; Lloc[i] = s; } }
    __syncthreads();
    if (STOP == 1) return;
    WT[wave * 64 + lane] = Lloc[7];
    __syncthreads();
    { float off = 0.f, tot = 0.f;
#pragma unroll
      for (int w = 0; w < 8; ++w) { const float x = WT[w * 64 + lane]; tot += x; if (w < wave) off += x; }
      if (wave == 0) GC[lane] = __expf(tot);
      unsigned bhp[4], khp[4], vtp[4], atp[4]; float pb = 0.f, pk = 0.f, pv = 0.f, pa = 0.f;
#pragma unroll
      for (int i = 0; i < 8; ++i) { const int t = 8 * wave + i; const float Lt = off + Lloc[i], Lp = Lt - lw[i];
          const float eL = __expf(Lt), eLp = __expf(Lp), einv = __expf(-Lt), eh = __expf(tot - Lt);
          const float xa = ain[i] * eLp;
          AT[t * RWP + lane] = (bf16_t)f2bf(xa); RT[t * RWP + lane] = (bf16_t)f2bf(r[i] * eL);
          BT[t * RWP + lane] = (bf16_t)f2bf(bin[i] * einv); KT[t * RWP + lane] = (bf16_t)f2bf(k2[i] * einv);
          const float xb = bin[i] * eh, xk = k2[i] * eh, xv = v[i];
          if (i & 1) { bhp[i >> 1] = pk2(pb, xb); khp[i >> 1] = pk2(pk, xk); vtp[i >> 1] = pk2(pv, xv); atp[i >> 1] = pk2(pa, xa); } else { pb = xb; pk = xk; pv = xv; pa = xa; } }
      *(u32x4*)(BH + lane * RWP + 8 * wave) = (u32x4){bhp[0], bhp[1], bhp[2], bhp[3]};
      *(u32x4*)(KH + lane * RWP + 8 * wave) = (u32x4){khp[0], khp[1], khp[2], khp[3]};
      *(u32x4*)(VT + lane * RWP + 8 * wave) = (u32x4){vtp[0], vtp[1], vtp[2], vtp[3]};
      *(u32x4*)(RHT + (64 + lane) * RWP + 8 * wave) = (u32x4){atp[0], atp[1], atp[2], atp[3]}; }
    __syncthreads();
#pragma unroll
    for (int jj = 0; jj < 2; ++jj) { const int job = wave + 8 * jj, mat = job >> 2, tm = (job >> 1) & 1, tn = job & 1;
        f32x16 acc = {};
        if (!(tm == 0 && tn == 1)) acc = rw_tile((mat & 2) ? RT : AT, (mat & 1) ? KT : BT, tm, tn, r32, hi, acc);
        const int s = 32 * tn + r32;
#pragma unroll
        for (int q = 0; q < 16; ++q) { const int t = 32 * tm + (q & 3) + 8 * (q >> 2) + 4 * hi;
            const bool keep = (mat & 2) ? (s <= t) : (s < t); const float x = keep ? acc[q] : 0.f;
            if (mat == 0) { if (tm == tn) ADG[(tm * 32 + (t & 31)) * 32 + (s & 31)] = x; else if (tm == 1) ABA[(t & 31) * RWP + s] = (bf16_t)f2bf(x); } else { bf16_t* D = (mat == 1) ? AAK : (mat == 2) ? ARB : ARK; D[t * RWP + s] = (bf16_t)f2bf(x); } } }
    __syncthreads();
    if (STOP == 2) return;
    if (wave < 4) { const int tm = wave >> 1, tn = wave & 1; f32x16 acc = {}; acc = rw_tile(VT, AAK, tm, tn, r32, hi, acc);
#pragma unroll
        for (int q = 0; q < 16; ++q) { const int i = 32 * tm + (q & 3) + 8 * (q >> 2) + 4 * hi; RHT[i * RWP + 32 * tn + r32] = (bf16_t)f2bf(acc[q]); } }
    else if (wave == 4) { float d[32]; const LAS float* ab = (const LAS float*)ADG + hi * 1024;
#pragma unroll
        for (int t = 0; t < 32; ++t) d[t] = (t == r32) ? 1.f : 0.f;
#pragma unroll
        for (int t = 1; t < 32; ++t) { float s0 = 0.f, s1 = 0.f;
#pragma unroll
            for (int s4 = 0; s4 < (t + 3) / 4; ++s4) { const f32x4 a4 = *(const LAS f32x4*)(ab + t * 32 + 4 * s4);
                s0 += a4[0] * d[4 * s4]; s1 += a4[1] * d[4 * s4 + 1]; s0 += a4[2] * d[4 * s4 + 2]; s1 += a4[3] * d[4 * s4 + 3]; }
            d[t] += s0 + s1; if ((t & 3) == 3) MEMFENCE(); }
        LAS bf16_t* D = (LAS bf16_t*)DAB + hi * 32 * RWP + r32;
#pragma unroll
        for (int t = 0; t < 32; ++t) D[t * RWP] = (bf16_t)f2bf(d[t]); }
    __syncthreads();
    if (wave < 4) { bf16_t* XT = (wave < 2 ? UVT : W1T) + (32 * (wave & 1)) * RWP;
        const bf16_t* rh = RHT + (32 * wave + r32) * RWP + 8 * hi;
        { f32x16 acc = {}; const bf16_t* da = DAB + r32 * RWP + 8 * hi;
#pragma unroll
          for (int ks = 0; ks < 2; ++ks) acc = MFMA32(ldsb8(rh + 16 * ks), ldsb8(da + 16 * ks), acc);
#pragma unroll
          for (int q = 0; q < 16; ++q) XT[((q & 3) + 8 * (q >> 2) + 4 * hi) * RWP + r32] = (bf16_t)f2bf(acc[q]); }
        WAVE_SYNC();
        { f32x16 acc; const bf16_t* rz = RHT + (32 * wave) * RWP + 32 + r32;
#pragma unroll
          for (int q = 0; q < 16; ++q) acc[q] = bf2f(rz[((q & 3) + 8 * (q >> 2) + 4 * hi) * RWP]);
          const bf16_t* xa = XT + r32 * RWP + 8 * hi; const bf16_t* ba = ABA + r32 * RWP + 8 * hi;
#pragma unroll
          for (int ks = 0; ks < 2; ++ks) acc = MFMA32(ldsb8(xa + 16 * ks), ldsb8(ba + 16 * ks), acc);
#pragma unroll
          for (int q = 0; q < 16; ++q) XT[((q & 3) + 8 * (q >> 2) + 4 * hi) * RWP + 32 + r32] = (bf16_t)f2bf(acc[q]); }
        WAVE_SYNC();
        { f32x16 acc = {}; const bf16_t* xz = XT + r32 * RWP + 32 + 8 * hi; const bf16_t* db = DAB + (32 + r32) * RWP + 8 * hi;
          const bf16x8 z0 = ldsb8(xz), z1 = ldsb8(xz + 16);
          acc = MFMA32(z0, ldsb8(db), acc); acc = MFMA32(z1, ldsb8(db + 16), acc);
          WAVE_SYNC();
#pragma unroll
          for (int q = 0; q < 16; ++q) XT[((q & 3) + 8 * (q >> 2) + 4 * hi) * RWP + 32 + r32] = (bf16_t)f2bf(acc[q]); } }
    __syncthreads();
    if (STOP == 3) return;
    const size_t chunk = (size_t)unit;
#pragma unroll
    for (int jj = 0; jj < 2; ++jj) { const int job = wave + 8 * jj, kind = job >> 2, tm = (job >> 1) & 1, tn = job & 1; f32x16 acc = {};
        const int col = 32 * tn + r32;
        if (kind == 0) { acc = rw_tile(BH, W1T, tm, tn, r32, hi, acc);
            bf16_t* PT = P.rwPT + chunk * 4096;
#pragma unroll
            for (int q = 0; q < 16; ++q) { const int row = 32 * tm + (q & 3) + 8 * (q >> 2) + 4 * hi; const float x = acc[q] + (row == col ? GC[row] : 0.f); PT[row * 64 + col] = (bf16_t)f2bf(x); } }
        else if (kind == 1) { acc = rw_tile(ARB, W1T, tm, tn, r32, hi, acc);
#pragma unroll
            for (int q = 0; q < 16; ++q) { const int t = 32 * tm + (q & 3) + 8 * (q >> 2) + 4 * hi; const float x = acc[q] + bf2f(RT[t * RWP + col]);
                P.rwQ[(size_t)(b * S_ + t0 + t) * 256 + 64 * h + col] = (bf16_t)f2bf(x); } }
        else if (kind == 2) { acc = rw_tile(UVT, BH, tm, tn, r32, hi, acc); acc = rw_tile(VT, KH, tm, tn, r32, hi, acc);
            unsigned* Gg = (unsigned*)(P.rwG + chunk * 4096) + (tm * 2 + tn) * 8 * 64 + lane;
#pragma unroll
            for (int q = 0; q < 8; ++q) Gg[q * 64] = pk2(acc[2 * q], acc[2 * q + 1]); }
        else { acc = rw_tile(ARB, UVT, tm, tn, r32, hi, acc); acc = rw_tile(ARK, VT, tm, tn, r32, hi, acc);
#pragma unroll
            for (int q = 0; q < 16; ++q) { const int t = 32 * tm + (q & 3) + 8 * (q >> 2) + 4 * hi; P.ycat[(size_t)(b * S_ + t0 + t) * 1024 + 64 * h + col] = (bf16_t)f2bf(acc[q]); } } }
    __syncthreads();
}
__device__ __forceinline__ void rw_state_unit(const KP& p, const Ptrs& P, int l, int unit, unsigned char* lds) {
    bf16_t* Sb = (bf16_t*)lds;
    const int tid = TIDX(), lane = tid & 63, wave = tid >> 6, r32 = lane & 31, hi = lane >> 5;
    const int ti = (wave >> 1) & 1, tj = wave & 1;
    f32x16 S = {};
    unsigned gq[8]; bf16x8 pq[4];
    if (wave < 4) { const size_t chunk = (size_t)unit * RW_NCH; const unsigned* Gg = (const unsigned*)(P.rwG + chunk * 4096) + (ti * 2 + tj) * 8 * 64 + lane;
#pragma unroll
        for (int q = 0; q < 8; ++q) gq[q] = Gg[q * 64];
        const bf16_t* pt = P.rwPT + chunk * 4096 + (32 * tj + r32) * 64 + 8 * hi;
#pragma unroll
        for (int ks = 0; ks < 4; ++ks) pq[ks] = *(const bf16x8*)(pt + 16 * ks); }
    for (int c = 0; c < RW_NCH; ++c) { const size_t chunk = (size_t)unit * RW_NCH + c;
        unsigned gn[8]; bf16x8 pn[4];
        if (wave < 4) { const size_t cn = chunk + (c + 1 < RW_NCH ? 1 : 0); const unsigned* Gg = (const unsigned*)(P.rwG + cn * 4096) + (ti * 2 + tj) * 8 * 64 + lane;
#pragma unroll
            for (int q = 0; q < 8; ++q) gn[q] = Gg[q * 64];
            const bf16_t* pt = P.rwPT + cn * 4096 + (32 * tj + r32) * 64 + 8 * hi;
#pragma unroll
            for (int ks = 0; ks < 4; ++ks) pn[ks] = *(const bf16x8*)(pt + 16 * ks);
#pragma unroll
            for (int q = 0; q < 16; ++q) Sb[(32 * ti + (q & 3) + 8 * (q >> 2) + 4 * hi) * RWP + 32 * tj + r32] = (bf16_t)f2bf(S[q]); }
        __syncthreads();
        { const int row = tid >> 3, ch = tid & 7; *(u32x4*)(P.rwS0 + chunk * 4096 + row * 64 + ch * 8) = *(const u32x4*)(Sb + row * RWP + ch * 8); }
        if (wave < 4) { f32x16 acc;
#pragma unroll
            for (int q = 0; q < 8; ++q) { acc[2 * q] = bflo(gq[q]); acc[2 * q + 1] = bfhi(gq[q]); }
            const bf16_t* sa = Sb + (32 * ti + r32) * RWP + 8 * hi;
#pragma unroll
            for (int ks = 0; ks < 4; ++ks) acc = MFMA32(ldsb8(sa + 16 * ks), pq[ks], acc);
            S = acc;
#pragma unroll
            for (int q = 0; q < 8; ++q) gq[q] = gn[q];
#pragma unroll
            for (int ks = 0; ks < 4; ++ks) pq[ks] = pn[ks]; }
        __syncthreads();
    }
}
template <bool DUMMY = false>
__device__ __forceinline__ void rw_out_unit(const KP& p, const Ptrs& P, int l, int unit, unsigned char* lds) {
    MEMFENCE(); OPAQUE_S(unit);
    const int c = unit % RW_NCH, bh = unit / RW_NCH, b = bh >> 2, h = bh & 3, t0 = c * 64;
    float* Yb = (float*)(lds + 81920);
    const int tid = TIDX(), lane = tid & 63, wave = tid >> 6, r32 = lane & 31, hi = lane >> 5;
    float g[8], rkv[8];
#pragma unroll
    for (int i = 0; i < 8; ++i) { const size_t o = (size_t)(b * S_ + t0 + 8 * wave + i) * 256 + 64 * h + lane; g[i] = bf2f(P.rwGt[o]); rkv[i] = bf2f(P.rwRKV[o]); }
    if (wave < 4) { const int tm = wave >> 1, tn = wave & 1; f32x16 acc; const int col = 32 * tn + r32;
        const bf16_t* yl = P.ycat + (size_t)(b * S_ + t0 + 32 * tm) * 1024 + 64 * h + col;
#pragma unroll
        for (int q = 0; q < 16; ++q) acc[q] = bf2f(yl[(size_t)((q & 3) + 8 * (q >> 2) + 4 * hi) * 1024]);
        const bf16_t* qa = P.rwQ + (size_t)(b * S_ + t0 + 32 * tm + r32) * 256 + 64 * h + 8 * hi; const bf16_t* sb = P.rwS0 + (size_t)unit * 4096 + (32 * tn + r32) * 64 + 8 * hi;
#pragma unroll
        for (int ks = 0; ks < 4; ++ks) acc = MFMA32(*(const bf16x8*)(qa + 16 * ks), *(const bf16x8*)(sb + 16 * ks), acc);
#pragma unroll
        for (int q = 0; q < 16; ++q) Yb[(32 * tm + (q & 3) + 8 * (q >> 2) + 4 * hi) * 64 + col] = acc[q]; }
    __syncthreads();
    const float gng = p.in[I_LNXG][l * 256 + 64 * h + lane], gnb = p.in[I_LNXB][l * 256 + 64 * h + lane];
    { float yv[8], m1[8], m2[8];
#pragma unroll
      for (int i = 0; i < 8; ++i) { yv[i] = Yb[(8 * wave + i) * 64 + lane]; m1[i] = yv[i]; }
      wave_sum_n<8>(m1);
#pragma unroll
      for (int i = 0; i < 8; ++i) { yv[i] -= m1[i] * (1.f / 64.f); m2[i] = yv[i] * yv[i]; }
      wave_sum_n<8>(m2);
#pragma unroll
      for (int i = 0; i < 8; ++i) { const int t = 8 * wave + i; const float yn = yv[i] * (1.0f / sqrtf(m2[i] * (1.f / 64.f) + GN_EPS_)) * gng + gnb; const float o = (yn + rkv[i]) * g[i];
        if (DUMMY) P.pb[(size_t)(b * S_ + t0 + t) * 256 + 64 * h + lane] = (bf16_t)f2bf(o);
        else P.ycat[(size_t)(b * S_ + t0 + t) * 1024 + 64 * h + lane] = (bf16_t)f2bf(o); } }
    __syncthreads();
}
#ifdef EMU_FP8_A
#define EMU_AUX77 u.aux = 77;
#else
#define EMU_AUX77
#endif
__device__ __forceinline__ void tile_map(int L, int nM, int nN, int& pm, int& pn) {
    const int nwg = nM * nN, q = nwg / 8, r = nwg % 8, xcd = L % 8, off = L / 8;
    const int wgid = (xcd < r ? xcd * (q + 1) : r * (q + 1) + (xcd - r) * q) + off;
    const int nig = 8 * nN, gid = wgid / nig, fm = gid * 8, gsz = (nM - fm) < 8 ? (nM - fm) : 8;
    pm = fm + ((wgid % nig) % gsz); pn = (wgid % nig) / gsz;
}
struct EpiStoreBf16 {
    bf16_t* base0; int ldc0; bf16_t* base1; int ldc1;
    __device__ __forceinline__ void operator()(const f32x4 (&acc)[2][2][4][2], const pg8::Unit& u, int wr, int wc, int fr, int fq, int tid) const {
        bf16_t* base = u.kind ? base1 : base0; const int ldc = u.kind ? ldc1 : ldc0;
        int row0 = u.pm * 256 + wr * 64 + fr, col0 = u.pn * 256 + wc * 32 + 8 * fq; OPAQUE(row0); OPAQUE(col0);
#pragma unroll
        for (int ai = 0; ai < 2; ++ai)
#pragma unroll
            for (int m = 0; m < 4; ++m) { bf16_t* rowp = base + (size_t)(row0 + ai * 128 + m * 16) * ldc + col0;
#pragma unroll
                for (int bj = 0; bj < 2; ++bj) { const f32x4 v0 = acc[ai][bj][m][0], v1 = acc[ai][bj][m][1];
                    u32x4 w; w.x = pk2(v0[0], v0[1]); w.y = pk2(v0[2], v0[3]); w.z = pk2(v1[0], v1[1]); w.w = pk2(v1[2], v1[3]);
                    *(u32x4*)(rowp + bj * 128) = w; } }
    }
};
template <int PART>
struct SchedA { const bf16_t* hb; const unsigned char* h8a; const unsigned char* h8b; const bf16_t* WinT; int G, c;
    __device__ __forceinline__ bool next(int i, pg8::Unit& u) const {
        const int nM = T_ / 256, n0 = nM * 9; u.aux = 0;
        if (PART == 0) { const int x = i * G + c; if (x >= n0) return false;
            tile_map(x, nM, 9, u.pm, u.pn); u.kind = 0; u.nt = 8; u.f8 = 1; const int m0 = u.pm * 256;
            u.a = (const char*)(m0 < H8_SPLIT ? h8a + (size_t)m0 * 1024 : h8b + (size_t)(m0 - H8_SPLIT) * 1024); u.b = (const char*)(WinT + (size_t)u.pn * 256 * 1024); }
        else { const int x = i * G + (c + G - n0 % G) % G; if (x >= nM) return false;
            u.pm = 0; u.pn = x; u.kind = 1; u.nt = 16; u.f8 = 0; u.a = (const char*)(WinT + (size_t)WIN_VT * 1024); u.b = (const char*)(hb + (size_t)u.pn * 256 * 1024); }
        return true; } };
struct EpiA { bf16_t* proj; const float* sc;
    __device__ __forceinline__ void operator()(const f32x4 (&acc)[2][2][4][2], const pg8::Unit& u, int wr, int wc, int fr, int fq, int tid) const {
        int row0 = u.pm * 256 + wr * 64 + fr, col0 = u.pn * 256 + wc * 32 + 8 * fq; OPAQUE(row0); OPAQUE(col0);
#pragma unroll
        for (int bj = 0; bj < 2; ++bj) { const f32x4 s0 = *(const f32x4*)(sc + col0 + bj * 128), s1 = *(const f32x4*)(sc + col0 + bj * 128 + 4);
#pragma unroll
            for (int ai = 0; ai < 2; ++ai)
#pragma unroll
                for (int m = 0; m < 4; ++m) { const f32x4 v0 = acc[ai][bj][m][0] * s0, v1 = acc[ai][bj][m][1] * s1;
                    u32x4 w; w.x = pk2(v0[0], v0[1]); w.y = pk2(v0[2], v0[3]); w.z = pk2(v1[0], v1[1]); w.w = pk2(v1[2], v1[3]);
                    *(u32x4*)(proj + (size_t)(row0 + ai * 128 + m * 16) * PJ + col0 + bj * 128) = w; } }
    }
};
__device__ __forceinline__ void phase_A0(const KP& p, unsigned char* lds) {
    const int tid = TIDX(), lane = tid & 63, wave = tid >> 6; const int gw = BIDX() * NWAVE + wave, NGW = GDIM() * NWAVE;
    for (int r = gw; r < L_ * WIN_VT; r += NGW) { const int l = r / WIN_VT, n = r % WIN_VT; const Ptrs P = make_ptrs(p.ws, l); bf16_t* row = P.WinT + (size_t)n * 1024;
        const u32x4 a = *(const u32x4*)(row + 16 * lane), b = *(const u32x4*)(row + 16 * lane + 8);
        float v[16] = {bflo(a.x), bfhi(a.x), bflo(a.y), bfhi(a.y), bflo(a.z), bfhi(a.z), bflo(a.w), bfhi(a.w), bflo(b.x), bfhi(b.x), bflo(b.y), bfhi(b.y), bflo(b.z), bfhi(b.z), bflo(b.w), bfhi(b.w)};
        float am = 0.f;
#pragma unroll
        for (int j = 0; j < 16; ++j) am = fmaxf(am, fabsf(v[j]));
        am = wave_max(am); const float sc = am > 0.f ? am * (1.0f / 440.0f) : 1.0f, inv = 1.0f / sc; u32x4 o;
#pragma unroll
        for (int j = 0; j < 4; ++j) { unsigned w = cvt_pk_fp8_f32_(v[4 * j] * inv, v[4 * j + 1] * inv, 0u, false); w = cvt_pk_fp8_f32_(v[4 * j + 2] * inv, v[4 * j + 3] * inv, w, true); o[j] = w; }
        WAVE_SYNC();
        *(u32x4*)((unsigned char*)row + 16 * lane) = o;
        if (lane == 0) P.gscA[n] = sc; }
#ifdef CPU_EMU
    (void)lds;
#endif
}
__device__ __forceinline__ void phase_A(const KP& p, int l, unsigned char* lds) {
    const Ptrs P = make_ptrs(p.ws, l);
    { SchedA<0> S{P.hb, P.h8a, P.h8b, P.WinT, GDIM(), BIDX()}; EpiA E{P.proj, P.gscA}; pg8::gemm_phase<1>((LAS unsigned char*)lds, 1024, 1024, S, E, 1024); }
    { SchedA<1> S{P.hb, P.h8a, P.h8b, P.WinT, GDIM(), BIDX()}; EpiStoreBf16 E{P.vtr, T_, P.vtr, T_}; pg8::gemm_phase<0>((LAS unsigned char*)lds, 1024, 1024, S, E); }
}
#if PROBE_REPEAT >= 40 && PROBE_REPEAT <= 49
struct SchedAP { const bf16_t* hb; const bf16_t* WinT; int G, c, nt, pnmask;
    __device__ __forceinline__ bool next(int i, pg8::Unit& u) const {
        const int nM = T_ / 256, n0 = nM * 9; const int x = i * G + c; if (x >= n0 + nM) return false;
        u.nt = nt; u.aux = 0; u.f8 = 0;
        if (x < n0) { tile_map(x, nM, 9, u.pm, u.pn); u.kind = 0; u.a = (const char*)(hb + (size_t)u.pm * 256 * 1024); u.b = (const char*)(WinT + (size_t)u.pn * 256 * 1024); }
        else { u.pm = 0; u.pn = x - n0; u.kind = 1; u.a = (const char*)(WinT + (size_t)WIN_VT * 1024); u.b = (const char*)(hb + (size_t)u.pn * 256 * 1024); }
        u.pn &= pnmask; return true; } };
struct EpiNull { float* d;
    __device__ __forceinline__ void operator()(const f32x4 (&acc)[2][2][4][2], const pg8::Unit& u, int wr, int wc, int fr, int fq, int tid) const {
        f32x4 s = (f32x4){0.f, 0.f, 0.f, 0.f};
#pragma unroll
        for (int ai = 0; ai < 2; ++ai)
#pragma unroll
            for (int m = 0; m < 4; ++m)
#pragma unroll
                for (int bj = 0; bj < 2; ++bj) s += acc[ai][bj][m][0] + acc[ai][bj][m][1];
        if (s.x + s.y + s.z + s.w == 1.2345e30f) d[tid] = s.x; } };
struct EpiStash { u32x4* stash;
    __device__ __forceinline__ void operator()(const f32x4 (&acc)[2][2][4][2], const pg8::Unit& u, int wr, int wc, int fr, int fq, int tid) const {
        OPAQUE(tid);
#pragma unroll
        for (int ai = 0; ai < 2; ++ai)
#pragma unroll
            for (int m = 0; m < 4; ++m)
#pragma unroll
                for (int bj = 0; bj < 2; ++bj) { const f32x4 v0 = acc[ai][bj][m][0], v1 = acc[ai][bj][m][1];
                    u32x4 w; w.x = pk2(v0[0], v0[1]); w.y = pk2(v0[2], v0[3]); w.z = pk2(v1[0], v1[1]); w.w = pk2(v1[2], v1[3]);
                    stash[((ai * 4 + m) * 2 + bj) * 512 + tid] = w; } } };
struct EpiFullLine { bf16_t* base;
    __device__ __forceinline__ void operator()(const f32x4 (&acc)[2][2][4][2], const pg8::Unit& u, int wr, int wc, int fr, int fq, int tid) const {
        OPAQUE(tid); if (u.kind) return;
#pragma unroll
        for (int ai = 0; ai < 2; ++ai)
#pragma unroll
            for (int m = 0; m < 4; ++m)
#pragma unroll
                for (int bj = 0; bj < 2; ++bj) { const f32x4 v0 = acc[ai][bj][m][0], v1 = acc[ai][bj][m][1]; const int k = (ai * 4 + m) * 2 + bj, L = k * 512 + tid, row = L >> 5, ch = L & 31;
                    u32x4 w; w.x = pk2(v0[0], v0[1]); w.y = pk2(v0[2], v0[3]); w.z = pk2(v1[0], v1[1]); w.w = pk2(v1[2], v1[3]);
                    *(u32x4*)(base + (size_t)(u.pm * 256 + row) * PJ + u.pn * 256 + ch * 8) = w; } } };
struct EpiProjOnly { bf16_t* base;
    __device__ __forceinline__ void operator()(const f32x4 (&acc)[2][2][4][2], const pg8::Unit& u, int wr, int wc, int fr, int fq, int tid) const {
        if (u.kind) return;
        int row0 = u.pm * 256 + wr * 64 + fr, col0 = u.pn * 256 + wc * 32 + 8 * fq; OPAQUE(row0); OPAQUE(col0);
#pragma unroll
        for (int ai = 0; ai < 2; ++ai)
#pragma unroll
            for (int m = 0; m < 4; ++m) { bf16_t* rowp = base + (size_t)(row0 + ai * 128 + m * 16) * PJ + col0;
#pragma unroll
                for (int bj = 0; bj < 2; ++bj) { const f32x4 v0 = acc[ai][bj][m][0], v1 = acc[ai][bj][m][1];
                    u32x4 w; w.x = pk2(v0[0], v0[1]); w.y = pk2(v0[2], v0[3]); w.z = pk2(v1[0], v1[1]); w.w = pk2(v1[2], v1[3]);
                    *(u32x4*)(rowp + bj * 128) = w; } } } };
template <int V>
__device__ __forceinline__ void phase_Aprobe(const KP& p, int l, unsigned char* lds) {
    const Ptrs P = make_ptrs(p.ws, l);
    SchedAP S{P.hb, P.WinT, GDIM(), BIDX(), V == 1 ? 32 : V == 3 ? 4 : V == 4 ? 8 : V == 5 ? 64 : 16, V == 6 ? 3 : 0xffff};
    if (V == 7) { EpiFullLine E{P.proj}; pg8::gemm_phase((LAS unsigned char*)lds, 1024, 1024, S, E); }
    else if (V == 8) { EpiProjOnly E{P.proj}; pg8::gemm_phase((LAS unsigned char*)lds, 1024, 1024, S, E); }
    else if (V == 2) { EpiStash E{(u32x4*)(P.ycat + (size_t)BIDX() * 65536)}; pg8::gemm_phase((LAS unsigned char*)lds, 1024, 1024, S, E); }
    else if (V == 6) { EpiStoreBf16 E{P.ycat, 1024, P.ycat, 1024}; pg8::gemm_phase((LAS unsigned char*)lds, 1024, 1024, S, E); }
    else { EpiNull E{(float*)(P.ycat + (size_t)BIDX() * 65536)}; pg8::gemm_phase((LAS unsigned char*)lds, 1024, 1024, S, E); }
}
#endif
struct SchedGlu { const bf16_t* ycat; const bf16_t* GluT; int G, c;
    __device__ __forceinline__ bool next(int i, pg8::Unit& u) const {
        const int x = i * G + c; if (x >= T_ / 256) return false;
        u.pm = x; u.pn = 0; u.nt = 4; u.kind = 0; u.aux = 0; u.f8 = 0; u.a = (const char*)(ycat + (size_t)x * 256 * 1024 + 256); u.b = (const char*)GluT; return true; } };
struct EpiGlu { bf16_t* ycat; const float* glub;
    __device__ __forceinline__ void operator()(const f32x4 (&acc)[2][2][4][2], const pg8::Unit& u, int wr, int wc, int fr, int fq, int tid) const {
        int row0 = u.pm * 256 + wr * 64 + fr, col0 = wc * 32 + 8 * fq; OPAQUE(row0); OPAQUE(col0);
#pragma unroll
        for (int bj = 0; bj < 2; ++bj) { const f32x4 b0 = *(const f32x4*)(glub + col0 + bj * 128), b1 = *(const f32x4*)(glub + col0 + bj * 128 + 4);
#pragma unroll
            for (int ai = 0; ai < 2; ++ai)
#pragma unroll
                for (int m = 0; m < 4; ++m) { bf16_t* ptr = ycat + (size_t)(row0 + ai * 128 + m * 16) * 1024 + 256 + col0 + bj * 128;
                    const u32x4 y = *(const u32x4*)ptr; const f32x4 v0 = acc[ai][bj][m][0] + b0, v1 = acc[ai][bj][m][1] + b1;
                    u32x4 w; w.x = pk2(bflo(y.x) * sigmoidf_(v0[0]), bfhi(y.x) * sigmoidf_(v0[1])); w.y = pk2(bflo(y.y) * sigmoidf_(v0[2]), bfhi(y.y) * sigmoidf_(v0[3]));
                    w.z = pk2(bflo(y.z) * sigmoidf_(v1[0]), bfhi(y.z) * sigmoidf_(v1[1])); w.w = pk2(bflo(y.w) * sigmoidf_(v1[2]), bfhi(y.w) * sigmoidf_(v1[3]));
                    *(u32x4*)ptr = w; MEMFENCE(); } }
    }
};
__device__ __forceinline__ void convert_tables(const KP& p, const Ptrs& P, int l, unsigned char* lds) {
    const int tid = TIDX(), lane = tid & 63, wave = tid >> 6;
    unsigned* cnt = (unsigned*)(p.ws + WS_CTL) + 10240 + 16 * l; int* slot = (int*)(lds + 65536);
    const float* ps = p.in[I_P] + (size_t)l * T_ * 256;
    constexpr int NG8 = 6144 / 128, NTAB = 2 * NEXP / 128, NPB = (int)(((size_t)T_ * 256 / 8 + 4095) / 4096);
    for (;;) {
        __syncthreads(); if (tid == 0) *slot = (int)atomicAdd(cnt, 1u); __syncthreads();
        int item = *slot; if (item >= NG8 + NTAB + NPB) break;
        if (item < NG8) {
            for (int rr = wave; rr < 128; rr += NWAVE) { const int r5 = item * 128 + rr; bf16_t* row = r5 < 4096 ? P.WinT + (size_t)(WIN_GATE + r5) * 1024 : r5 < 5120 ? P.PleGT + (size_t)(r5 - 4096) * 1024 : P.WoutT + (size_t)(r5 - 5120) * 1024;
                const u32x4 a = *(const u32x4*)(row + 16 * lane), b = *(const u32x4*)(row + 16 * lane + 8);
                float v[16] = {bflo(a.x), bfhi(a.x), bflo(a.y), bfhi(a.y), bflo(a.z), bfhi(a.z), bflo(a.w), bfhi(a.w), bflo(b.x), bfhi(b.x), bflo(b.y), bfhi(b.y), bflo(b.z), bfhi(b.z), bflo(b.w), bfhi(b.w)};
                float am = 0.f;
#pragma unroll
                for (int j = 0; j < 16; ++j) am = fmaxf(am, fabsf(v[j]));
                am = wave_max(am); const float sc = am > 0.f ? am * (1.0f / 440.0f) : 1.0f, inv = 1.0f / sc; u32x4 o;
#pragma unroll
                for (int j = 0; j < 4; ++j) { unsigned w = cvt_pk_fp8_f32_(v[4 * j] * inv, v[4 * j + 1] * inv, 0u, false); w = cvt_pk_fp8_f32_(v[4 * j + 2] * inv, v[4 * j + 3] * inv, w, true); o[j] = w; }
                WAVE_SYNC();
                *(u32x4*)((unsigned char*)row + 16 * lane) = o;
                if (lane == 0) P.gsc[r5] = sc; }
            continue; }
        item -= NG8;
        if (item < NTAB) {
            for (int r4 = 0; r4 < 16; r4 += 4) { f32x4 v[4][4]; float am[4];
#pragma unroll
                for (int q = 0; q < 4; ++q) { const int it = item * 128 + wave + 8 * (r4 + q); const int tb = it >= NEXP, row = tb ? it - NEXP : it;
                    const float* src = p.in[tb ? I_V : I_U] + ((size_t)l * NEXP + row) * 1024 + 16 * lane; am[q] = 0.f;
#pragma unroll
                    for (int j = 0; j < 4; ++j) { v[q][j] = *(const f32x4*)(src + 4 * j); am[q] = fmaxf(am[q], fmaxf(fmaxf(fabsf(v[q][j].x), fabsf(v[q][j].y)), fmaxf(fabsf(v[q][j].z), fabsf(v[q][j].w)))); } }
#pragma unroll
                for (int q = 0; q < 4; ++q) { const int it = item * 128 + wave + 8 * (r4 + q); const int tb = it >= NEXP, row = tb ? it - NEXP : it;
                    const float amx = wave_max(am[q]); const float sc = amx > 0.f ? amx * (1.0f / 440.0f) : 1.0f, inv = 1.0f / sc; u32x4 o;
#pragma unroll
                    for (int j = 0; j < 4; ++j) { unsigned w = cvt_pk_fp8_f32_(v[q][j].x * inv, v[q][j].y * inv, 0u, false); w = cvt_pk_fp8_f32_(v[q][j].z * inv, v[q][j].w * inv, w, true); o[j] = w; }
                    *(u32x4*)((tb ? P.V8 : P.U8) + ((size_t)(lane >> 3) * NEXP + row) * 128 + 16 * (lane & 7)) = o;
                    if (lane == 0) (tb ? P.sv : P.su)[row] = sc; } }
        } else {
            const size_t base = (size_t)(item - NTAB) * 4096;
            f32x4 a[8], bq[8];
#pragma unroll
            for (int j = 0; j < 8; ++j) { const size_t i = base + tid + (size_t)j * NTHR; a[j] = (f32x4){0.f, 0.f, 0.f, 0.f}; bq[j] = a[j];
                if (i < (size_t)T_ * 256 / 8) { a[j] = *(const f32x4*)(ps + i * 8); bq[j] = *(const f32x4*)(ps + i * 8 + 4); } }
#pragma unroll
            for (int j = 0; j < 8; ++j) { const size_t i = base + tid + (size_t)j * NTHR;
                if (i < (size_t)T_ * 256 / 8) { u32x4 o; o.x = pk2(a[j].x, a[j].y); o.y = pk2(a[j].z, a[j].w); o.z = pk2(bq[j].x, bq[j].y); o.w = pk2(bq[j].z, bq[j].w); *(u32x4*)(P.pb + i * 8) = o; } }
        }
    }
}
__device__ __forceinline__ void phase_B2(const KP& p, int l, unsigned char* lds) {
    const Ptrs P = make_ptrs(p.ws, l);
    constexpr int NRW = NB_ * 4; const int G = GDIM(), c = BIDX();
    int gG = G, gc = c;
    if (G > NRW) { if (c < NRW) { rw_state_unit(p, P, l, c, lds);
#if PROBE_REPEAT == 35
        rw_state_unit(p, P, l, c, lds);
#endif
        convert_tables(p, P, l, lds); return; } gG = G - NRW; gc = c - NRW; }
    else { for (int u = c; u < NRW; u += G) rw_state_unit(p, P, l, u, lds); }
    SchedGlu S{P.ycat, P.GluT, gG, gc};
    EpiGlu E{P.ycat, p.in[I_GLUB] + l * 256};
    pg8::gemm_phase((LAS unsigned char*)lds, 1024, 256, S, E);
    convert_tables(p, P, l, lds);
}
struct SchedC { const unsigned char* h8a; const unsigned char* h8b; const bf16_t* ycat; const bf16_t* WinT; const bf16_t* WbrT; int G, c;
    __device__ __forceinline__ bool next(int i, pg8::Unit& u) const {
        const int tile = (i >> 3) * G + c; if (tile >= (T_ / 256) * 4) return false;
        const int j = i & 7, b = j >> 1; tile_map(tile, T_ / 256, 4, u.pm, u.pn); u.aux = b;
        if (!(j & 1)) { u.kind = 0; u.nt = 4; u.f8 = 0; u.a = (const char*)(ycat + (size_t)u.pm * 256 * 1024 + 256 * b); u.b = (const char*)(WbrT + (size_t)u.pn * 256 * 1024 + 256 * b); }
        else { u.kind = 1; u.nt = 8; u.f8 = 1; const int m0 = u.pm * 256;
            u.a = (const char*)(m0 < H8_SPLIT ? h8a + (size_t)m0 * 1024 : h8b + (size_t)(m0 - H8_SPLIT) * 1024); u.b = (const char*)(WinT + (size_t)(WIN_GATE + 1024 * b + 256 * u.pn) * 1024); }
        return true; } };
struct EpiC { u32x4* stash; bf16_t* merged; const float* gsc; unsigned char* m8;
    __device__ __forceinline__ void operator()(const f32x4 (&acc)[2][2][4][2], const pg8::Unit& u, int wr, int wc, int fr, int fq, int tid) const {
        OPAQUE(tid);
        if (u.kind == 0) {
#pragma unroll
            for (int ai = 0; ai < 2; ++ai)
#pragma unroll
                for (int m = 0; m < 4; ++m)
#pragma unroll
                    for (int bj = 0; bj < 2; ++bj) { const f32x4 v0 = acc[ai][bj][m][0], v1 = acc[ai][bj][m][1];
                        u32x4 w; w.x = pk2(v0[0], v0[1]); w.y = pk2(v0[2], v0[3]); w.z = pk2(v1[0], v1[1]); w.w = pk2(v1[2], v1[3]);
                        stash[((ai * 4 + m) * 2 + bj) * 512 + tid] = w; }
        } else {
            int row0 = u.pm * 256 + wr * 64 + fr, col0 = u.pn * 256 + wc * 32 + 8 * fq; OPAQUE(row0); OPAQUE(col0); const bool first = (u.aux == 0);
            f32x4 sc[2][2];
#pragma unroll
            for (int bj = 0; bj < 2; ++bj) { const float* sp = gsc + 1024 * u.aux + col0 + bj * 128; sc[bj][0] = *(const f32x4*)sp; sc[bj][1] = *(const f32x4*)(sp + 4); }
#pragma unroll
            for (int ai = 0; ai < 2; ++ai)
#pragma unroll
                for (int mp = 0; mp < 2; ++mp) { u32x4 y[4], mo[4];
#pragma unroll
                    for (int q = 0; q < 4; ++q) { const int m = 2 * mp + (q >> 1), bj = q & 1;
                        y[q] = stash[((ai * 4 + m) * 2 + bj) * 512 + tid]; mo[q] = (u32x4){0u, 0u, 0u, 0u};
                        if (!first) mo[q] = *(const u32x4*)(merged + (size_t)(row0 + ai * 128 + m * 16) * 1024 + col0 + bj * 128); }
#pragma unroll
                    for (int q = 0; q < 4; ++q) { const int m = 2 * mp + (q >> 1), bj = q & 1; const f32x4 g0 = acc[ai][bj][m][0] * sc[bj][0], g1 = acc[ai][bj][m][1] * sc[bj][1];
                        bf16_t* ptr = merged + (size_t)(row0 + ai * 128 + m * 16) * 1024 + col0 + bj * 128;
                        const float o0 = bflo(y[q].x) * sigmoidf_(g0[0]) + bflo(mo[q].x), o1 = bfhi(y[q].x) * sigmoidf_(g0[1]) + bfhi(mo[q].x), o2 = bflo(y[q].y) * sigmoidf_(g0[2]) + bflo(mo[q].y), o3 = bfhi(y[q].y) * sigmoidf_(g0[3]) + bfhi(mo[q].y);
                        const float o4 = bflo(y[q].z) * sigmoidf_(g1[0]) + bflo(mo[q].z), o5 = bfhi(y[q].z) * sigmoidf_(g1[1]) + bfhi(mo[q].z), o6 = bflo(y[q].w) * sigmoidf_(g1[2]) + bflo(mo[q].w), o7 = bfhi(y[q].w) * sigmoidf_(g1[3]) + bfhi(mo[q].w);
                        u32x4 w; w.x = pk2(o0, o1); w.y = pk2(o2, o3); w.z = pk2(o4, o5); w.w = pk2(o6, o7);
                        *(u32x4*)ptr = w;
                        if (u.aux == 3) { u32x2 w8; w8.x = cvt_pk_fp8_f32_(o0, o1, 0u, false); w8.x = cvt_pk_fp8_f32_(o2, o3, w8.x, true); w8.y = cvt_pk_fp8_f32_(o4, o5, 0u, false); w8.y = cvt_pk_fp8_f32_(o6, o7, w8.y, true);
                            *(u32x2*)(m8 + (size_t)(row0 + ai * 128 + m * 16) * 1024 + col0 + bj * 128) = w8; } }
                    MEMFENCE(); }
        }
    }
};
__device__ __forceinline__ void phase_C(const KP& p, int l, unsigned char* lds) {
    const Ptrs P = make_ptrs(p.ws, l);
    SchedC S{P.h8a, P.h8b, P.ycat, P.WinT, P.WbrT, GDIM(), BIDX()};
    EpiC E{(u32x4*)(P.stash + (size_t)BIDX() * 131072), P.merged, P.gsc, P.h8e};
    pg8::gemm_phase<2>((LAS unsigned char*)lds, 1024, 1024, S, E, 1024);
}
struct SchedD { const unsigned char* A8; const bf16_t* Bt; int nN, G, c;
    __device__ __forceinline__ bool next(int i, pg8::Unit& u) const {
        const int x = i * G + c; if (x >= (T_ / 256) * nN) return false;
        tile_map(x, T_ / 256, nN, u.pm, u.pn); u.nt = 8; u.kind = 0; u.aux = 0; u.f8 = 1; u.a = (const char*)(A8 + (size_t)u.pm * 256 * 1024); u.b = (const char*)(Bt + (size_t)u.pn * 256 * 1024); return true; } };
struct EpiResid { bf16_t* ob; const bf16_t* hb; const float* sc;
    __device__ __forceinline__ void operator()(const f32x4 (&acc)[2][2][4][2], const pg8::Unit& u, int wr, int wc, int fr, int fq, int tid) const {
        int row0 = u.pm * 256 + wr * 64 + fr, col0 = u.pn * 256 + wc * 32 + 8 * fq; OPAQUE(row0); OPAQUE(col0);
#pragma unroll
        for (int ai = 0; ai < 2; ++ai)
#pragma unroll
            for (int m = 0; m < 4; ++m)
#pragma unroll
                for (int bj = 0; bj < 2; ++bj) { const size_t o = (size_t)(row0 + ai * 128 + m * 16) * 1024 + col0 + bj * 128; const u32x4 hw = *(const u32x4*)(hb + o);
                    const f32x4 a0 = acc[ai][bj][m][0] * *(const f32x4*)(sc + col0 + bj * 128), a1 = acc[ai][bj][m][1] * *(const f32x4*)(sc + col0 + bj * 128 + 4); u32x4 w;
                    w.x = pk2(bflo(hw.x) * DN_ALPHA_ + a0[0], bfhi(hw.x) * DN_ALPHA_ + a0[1]); w.y = pk2(bflo(hw.y) * DN_ALPHA_ + a0[2], bfhi(hw.y) * DN_ALPHA_ + a0[3]);
                    w.z = pk2(bflo(hw.z) * DN_ALPHA_ + a1[0], bfhi(hw.z) * DN_ALPHA_ + a1[1]); w.w = pk2(bflo(hw.w) * DN_ALPHA_ + a1[2], bfhi(hw.w) * DN_ALPHA_ + a1[3]);
                    *(u32x4*)(ob + o) = w; }
    }
};
__device__ __forceinline__ void phase_D(const KP& p, int l, unsigned char* lds) {
    const Ptrs P = make_ptrs(p.ws, l);
    SchedD S{P.h8e, P.WoutT, 4, GDIM(), BIDX()};
    EpiResid E{P.ycat, P.hb, P.gsc + 5120};
    pg8::gemm_phase<1>((LAS unsigned char*)lds, 1024, 1024, S, E, 1024);
}
__device__ __forceinline__ void phase_D2(const KP& p, int l, unsigned char* lds) {
    const Ptrs P = make_ptrs(p.ws, l);
    const int tid = TIDX(), lane = tid & 63, wave = tid >> 6; const int gw = BIDX() * NWAVE + wave, NGW = GDIM() * NWAVE;
    for (int m = 4 * gw; m < T_; m += 4 * NGW) ln_rows<4, true>(P.ycat + (size_t)m * 1024, p.in[I_LN1G] + l * 1024, p.in[I_LN1B] + l * 1024, (float*)nullptr, P.hb + (size_t)m * 1024, P.h8e + (size_t)m * 1024, lane);
}
struct SchedE1 { const bf16_t* pb; const bf16_t* PleT; int G, c;
    __device__ __forceinline__ bool next(int i, pg8::Unit& u) const {
        const int x = i * G + c; if (x >= (T_ / 256) * 4) return false;
        tile_map(x, T_ / 256, 4, u.pm, u.pn); u.nt = 4; u.kind = 0; u.aux = 0; u.f8 = 0; u.a = (const char*)(pb + (size_t)u.pm * 256 * 256); u.b = (const char*)(PleT + (size_t)u.pn * 256 * 256); return true; } };
template <int PART>
struct SchedE2 { const bf16_t* hb; const unsigned char* h8e; const bf16_t* PleGT; const bf16_t* WqT; int G, c;
    __device__ __forceinline__ bool next(int i, pg8::Unit& u) const {
        const int n0 = (T_ / 256) * 4; int x = i * G + c + (PART ? n0 : 0); if (x >= (PART ? n0 + (T_ / 256) * 8 : n0)) return false;
        u.aux = 0;
        if (x < n0) { tile_map(x, T_ / 256, 4, u.pm, u.pn); u.kind = 0; u.nt = 8; u.f8 = 1; u.b = (const char*)(PleGT + (size_t)u.pn * 256 * 1024); u.a = (const char*)(h8e + (size_t)u.pm * 256 * 1024); }
        else { x -= n0; tile_map(x, T_ / 256, 8, u.pm, u.pn); u.kind = 1; u.nt = 16; u.f8 = 0; u.b = (const char*)(WqT + (size_t)u.pn * 256 * 1024); u.a = (const char*)(hb + (size_t)u.pm * 256 * 1024); }
        return true; } };
struct EpiE2g { const bf16_t* hb; bf16_t* Pbuf; const float* gsc;
    __device__ __forceinline__ void operator()(const f32x4 (&acc)[2][2][4][2], const pg8::Unit& u, int wr, int wc, int fr, int fq, int tid) const {
        int row0 = u.pm * 256 + wr * 64 + fr, col0 = u.pn * 256 + wc * 32 + 8 * fq; OPAQUE(row0); OPAQUE(col0);
#pragma unroll
        for (int bj = 0; bj < 2; ++bj) { const float* sp = gsc + 4096 + col0 + bj * 128; const f32x4 s0 = *(const f32x4*)sp, s1 = *(const f32x4*)(sp + 4);
            const size_t cb = (size_t)row0 * 1024 + col0 + bj * 128; const bf16_t* hp = hb + cb; bf16_t* pp = Pbuf + cb;
#pragma unroll
            for (int ai = 0; ai < 2; ++ai)
#pragma unroll
                for (int mp = 0; mp < 2; ++mp) { u32x4 y[2], hw[2];
#pragma unroll
                    for (int q = 0; q < 2; ++q) { const int ro = (ai * 128 + (2 * mp + q) * 16) * 1024; y[q] = *(const u32x4*)(pp + ro); hw[q] = *(const u32x4*)(hp + ro); }
#pragma unroll
                    for (int q = 0; q < 2; ++q) { const int m = 2 * mp + q; const int ro = (ai * 128 + m * 16) * 1024; const f32x4 v0 = acc[ai][bj][m][0] * s0, v1 = acc[ai][bj][m][1] * s1;
                        u32x4 w;
                        w.x = pk2(bflo(hw[q].x) * DN_ALPHA_ + bflo(y[q].x) * sigmoidf_(v0[0]), bfhi(hw[q].x) * DN_ALPHA_ + bfhi(y[q].x) * sigmoidf_(v0[1]));
                        w.y = pk2(bflo(hw[q].y) * DN_ALPHA_ + bflo(y[q].y) * sigmoidf_(v0[2]), bfhi(hw[q].y) * DN_ALPHA_ + bfhi(y[q].y) * sigmoidf_(v0[3]));
                        w.z = pk2(bflo(hw[q].z) * DN_ALPHA_ + bflo(y[q].z) * sigmoidf_(v1[0]), bfhi(hw[q].z) * DN_ALPHA_ + bfhi(y[q].z) * sigmoidf_(v1[1]));
                        w.w = pk2(bflo(hw[q].w) * DN_ALPHA_ + bflo(y[q].w) * sigmoidf_(v1[2]), bfhi(hw[q].w) * DN_ALPHA_ + bfhi(y[q].w) * sigmoidf_(v1[3]));
                        *(u32x4*)(pp + ro) = w; }
                    MEMFENCE(); } }
    }
};
__device__ __forceinline__ void phase_E(const KP& p, int l, unsigned char* lds) {
    const Ptrs P = make_ptrs(p.ws, l);
    { SchedE1 S{P.pb, P.PleT, GDIM(), BIDX()}; EpiStoreBf16 E{P.ycat, 1024, P.ycat, 1024}; pg8::gemm_phase((LAS unsigned char*)lds, 256, 256, S, E); }
    { SchedE2<0> S{P.hb, P.h8e, P.PleGT, P.WqT, GDIM(), BIDX()}; EpiE2g E{P.hb, P.ycat, P.gsc}; pg8::gemm_phase<1>((LAS unsigned char*)lds, 1024, 1024, S, E, 1024); }
    { SchedE2<1> S{P.hb, P.h8e, P.PleGT, P.WqT, GDIM(), BIDX()}; EpiStoreBf16 E{P.q, 2048, P.q, 2048}; pg8::gemm_phase<0>((LAS unsigned char*)lds, 1024, 1024, S, E); }
}
__device__ __forceinline__ unsigned mono_key(float f) { const unsigned u = __builtin_bit_cast(unsigned, f); return (u & 0x80000000u) ? ~u : (u | 0x80000000u); }
__device__ __forceinline__ float unmono_key(unsigned k) { const unsigned u = (k & 0x80000000u) ? (k ^ 0x80000000u) : ~k; return __builtin_bit_cast(float, u); }
struct CandTab { int a[50], b[50]; };
constexpr CandTab make_cand() { CandTab t{}; int n = 0; for (int a = 0; a < 16; ++a) for (int b = 0; b < 16; ++b) if ((a + 1) * (b + 1) <= 16) { t.a[n] = a; t.b[n] = b; ++n; } return t; }
constexpr CandTab CAND = make_cand();
constexpr int PK_PITCH = 136;

#define PK_CE(x, y) do { const unsigned _a = (x), _b = (y); (x) = _a > _b ? _a : _b; (y) = _a > _b ? _b : _a; } while (0)
__device__ __forceinline__ void bitonic_merge16_desc(unsigned (&a)[16]) {
#pragma unroll
    for (int j = 8; j > 0; j >>= 1)
#pragma unroll
        for (int i = 0; i < 16; ++i) { const int l = i ^ j; if (l > i) PK_CE(a[i], a[l]); }
}
__device__ __forceinline__ void bitonic_sort16_desc(unsigned (&a)[16]) {
#pragma unroll
    for (int k = 2; k <= 16; k <<= 1)
#pragma unroll
        for (int j = k >> 1; j > 0; j >>= 1)
#pragma unroll
            for (int i = 0; i < 16; ++i) { const int l = i ^ j; if (l > i) { if ((i & k) == 0 || k == 16) PK_CE(a[i], a[l]); else PK_CE(a[l], a[i]); } }
}
__device__ __forceinline__ void top_half_merge16(unsigned (&a)[16], const unsigned (&b)[16]) {
#pragma unroll
    for (int i = 0; i < 16; ++i) a[i] = a[i] > b[15 - i] ? a[i] : b[15 - i];
    bitonic_merge16_desc(a);
}
__device__ __forceinline__ void top16_keys(const unsigned (&key)[64], unsigned (&top)[16]) {
    unsigned g0[16], g1[16], g2[16], g3[16];
#pragma unroll
    for (int i = 0; i < 16; ++i) { g0[i] = key[i]; g1[i] = key[16 + i]; g2[i] = key[32 + i]; g3[i] = key[48 + i]; }
    bitonic_sort16_desc(g0); bitonic_sort16_desc(g1); bitonic_sort16_desc(g2); bitonic_sort16_desc(g3);
    top_half_merge16(g0, g1); top_half_merge16(g2, g3); top_half_merge16(g0, g2);
    unsigned pr[16];
#pragma unroll
    for (int i = 0; i < 16; ++i) pr[i] = (unsigned)__shfl_xor((int)g0[i], 32);
    top_half_merge16(g0, pr);
#pragma unroll
    for (int i = 0; i < 16; ++i) top[i] = g0[i];
}
__device__ __forceinline__ void peer_route_unit(const KP& p, const Ptrs& P, int l, int unit, unsigned char* lds) {
    const bf16_t* Ks = (const bf16_t*)lds;
    const int tid = TIDX(), lane = tid & 63, wave = tid >> 6, r32 = lane & 31, hi = lane >> 5;
    const int tok = unit * 32 + r32;
    int kbase = r32 * PK_PITCH + 8 * hi; OPAQUE(kbase);
    unsigned top1[16], top2[16];
#pragma unroll 1
    for (int half = 0; half < 2; ++half) {
        const bf16_t* qp = P.q + (size_t)tok * 2048 + wave * 256 + half * 128 + 8 * hi;
        bf16x8 qf[8];
#pragma unroll
        for (int ks = 0; ks < 8; ++ks) qf[ks] = *(const bf16x8*)(qp + 16 * ks);
        unsigned key[64];
#pragma unroll
        for (int kt = 0; kt < 4; ++kt) { f32x16 acc = {}; const bf16_t* kp = Ks + (half * 128 + 32 * kt) * PK_PITCH + kbase;
#pragma unroll
            for (int ks = 0; ks < 8; ++ks) { const bf16x8 a = *(const bf16x8*)(kp + 16 * ks); acc = MFMA32(a, qf[ks], acc); }
#pragma unroll
            for (int r = 0; r < 16; ++r) { const int idx = 32 * kt + (r & 3) + 8 * (r >> 2) + 4 * hi; key[16 * kt + r] = (mono_key(acc[r]) & ~127u) | (unsigned)(127 - idx); } }
        if (half == 0) top16_keys(key, top1); else top16_keys(key, top2);
        MEMFENCE();
    }
    MEMFENCE();
    int* islot = (int*)(lds + 2 * 128 * PK_PITCH * 2) + (wave * 32 + r32) * 33;
    float v1[16], v2[16];
#pragma unroll
    for (int r = 0; r < 16; ++r) { v1[r] = unmono_key(top1[r] & ~127u); v2[r] = unmono_key(top2[r] & ~127u); islot[16 * hi + r] = 127 - (int)((hi ? top2[r] : top1[r]) & 127u); }
    unsigned ka[16], kb[16];
#pragma unroll
    for (int i = 0; i < 25; ++i) { const int c0 = 2 * i, c1 = 2 * i + 1;
        const float s = hi ? (v1[CAND.a[c1]] + v2[CAND.b[c1]]) : (v1[CAND.a[c0]] + v2[CAND.b[c0]]);
        const unsigned k = (mono_key(s) & ~255u) | (unsigned)(255 - (hi ? 16 * CAND.a[c1] + CAND.b[c1] : 16 * CAND.a[c0] + CAND.b[c0]));
        if (i < 16) ka[i] = k; else kb[i - 16] = k; }
#pragma unroll
    for (int i = 9; i < 16; ++i) kb[i] = 0u;
    bitonic_sort16_desc(ka); bitonic_sort16_desc(kb); top_half_merge16(ka, kb);
    { unsigned pr[16];
#pragma unroll
      for (int i = 0; i < 16; ++i) pr[i] = (unsigned)__shfl_xor((int)ka[i], 32);
      top_half_merge16(ka, pr); }
    WAVE_SYNC();
    float sc[16]; int se[16];
#pragma unroll
    for (int r = 0; r < 16; ++r) { sc[r] = unmono_key(ka[r] & ~255u); se[r] = 0; }
#pragma unroll
    for (int r = 0; r < 8; ++r) { unsigned mlo = ka[r], mhi = ka[8 + r]; OPAQUE(mlo); OPAQUE(mhi);
        const unsigned m = hi ? mhi : mlo; const int ab = 255 - (int)(m & 255u); const int e = islot[ab >> 4] * 128 + islot[16 + (ab & 15)];
        if (hi) se[8 + r] = e; else se[r] = e; }
    WAVE_SYNC();
    float g[16]; float sum = 0.f;
#pragma unroll
    for (int r = 0; r < 16; ++r) { g[r] = __expf(sc[r] - sc[0]); sum += g[r]; }
    const float inv = 1.0f / sum;
    const size_t ob = (size_t)tok * 128 + wave * 16 + 8 * hi;
    if (hi == 0) {
        *(u32x4*)(P.eid + ob) = (u32x4){(unsigned)se[0], (unsigned)se[1], (unsigned)se[2], (unsigned)se[3]}; *(u32x4*)(P.eid + ob + 4) = (u32x4){(unsigned)se[4], (unsigned)se[5], (unsigned)se[6], (unsigned)se[7]};
        *(f32x4*)(P.gate + ob) = (f32x4){g[0] * inv, g[1] * inv, g[2] * inv, g[3] * inv}; *(f32x4*)(P.gate + ob + 4) = (f32x4){g[4] * inv, g[5] * inv, g[6] * inv, g[7] * inv};
    } else {
        *(u32x4*)(P.eid + ob) = (u32x4){(unsigned)se[8], (unsigned)se[9], (unsigned)se[10], (unsigned)se[11]}; *(u32x4*)(P.eid + ob + 4) = (u32x4){(unsigned)se[12], (unsigned)se[13], (unsigned)se[14], (unsigned)se[15]};
        *(f32x4*)(P.gate + ob) = (f32x4){g[8] * inv, g[9] * inv, g[10] * inv, g[11] * inv}; *(f32x4*)(P.gate + ob + 4) = (f32x4){g[12] * inv, g[13] * inv, g[14] * inv, g[15] * inv};
    }
}
__device__ __forceinline__ void phase_F(const KP& p, int l, unsigned char* lds) {
    const Ptrs P = make_ptrs(p.ws, l);
    bf16_t* Ks = (bf16_t*)lds; const int tid = TIDX();
    for (int e = tid; e < 2 * 128 * 16; e += NTHR) { const int row = e >> 4, ch = e & 15; *(u32x4*)(Ks + row * PK_PITCH + ch * 8) = *(const u32x4*)(P.K12 + row * 128 + ch * 8); }
    __syncthreads();
    for (int u = BIDX(); u < T_ / 32; u += GDIM()) peer_route_unit(p, P, l, u, lds);
    __syncthreads();
}
constexpr int PG_TB = (T_ >= 4096 ? 128 : 64), PG_NBLK = T_ / PG_TB;
__device__ __forceinline__ int peer_next_item(unsigned* cnt, int* slot, int tid) {
    __syncthreads();
    if (tid == 0) *slot = (int)atomicAdd(cnt, 1u);
    __syncthreads();
    return *slot;
}
constexpr int PG_TPW = PG_TB / NWAVE;
constexpr int PG_WLDS = 6144;
__device__ __forceinline__ void pg_issue_rows(const unsigned char* T8, int x, int c8, int gq, int lane, int e0, int e1, int* E, u32x4 (&rb)[16]) {
    WAVE_SYNC(); E[lane] = e0; E[64 + lane] = e1; WAVE_SYNC();
#pragma unroll
    for (int k = 0; k < 16; ++k) { const unsigned off = ((unsigned)(x * NEXP) + (unsigned)E[gq + 8 * k]) * 128u + 16u * (unsigned)c8; rb[k] = *(const u32x4*)(T8 + off); }
}
__device__ __forceinline__ void pg_dots_compute(const Ptrs& P, int x, int t, const u32x4 (&ub)[16], u32x4 xa, u32x4 xb, float* R, int lane) {
    const f32x2 x0 = (f32x2){bflo(xa.x), bfhi(xa.x)}, x1 = (f32x2){bflo(xa.y), bfhi(xa.y)}, x2 = (f32x2){bflo(xa.z), bfhi(xa.z)}, x3 = (f32x2){bflo(xa.w), bfhi(xa.w)};
    const f32x2 x4 = (f32x2){bflo(xb.x), bfhi(xb.x)}, x5 = (f32x2){bflo(xb.y), bfhi(xb.y)}, x6 = (f32x2){bflo(xb.z), bfhi(xb.z)}, x7 = (f32x2){bflo(xb.w), bfhi(xb.w)};
    WAVE_SYNC();
#pragma unroll
    for (int k = 0; k < 16; ++k) { f32x2 s = cvt_pk_f32_fp8_(ub[k][0], false) * x0; s += cvt_pk_f32_fp8_(ub[k][0], true) * x1; s += cvt_pk_f32_fp8_(ub[k][1], false) * x2; s += cvt_pk_f32_fp8_(ub[k][1], true) * x3;
        s += cvt_pk_f32_fp8_(ub[k][2], false) * x4; s += cvt_pk_f32_fp8_(ub[k][2], true) * x5; s += cvt_pk_f32_fp8_(ub[k][3], false) * x6; s += cvt_pk_f32_fp8_(ub[k][3], true) * x7;
        R[k * 64 + lane] = s.x + s.y; }
    WAVE_SYNC();
    const f32x4 a0 = *(const f32x4*)(R + 8 * lane), a1 = *(const f32x4*)(R + 8 * lane + 4), b0 = *(const f32x4*)(R + 512 + 8 * lane), b1 = *(const f32x4*)(R + 512 + 8 * lane + 4);
    float* pd = P.pd + ((size_t)x * T_ + t) * 128;
    pd[lane] = ((a0[0] + a0[1]) + (a0[2] + a0[3])) + ((a1[0] + a1[1]) + (a1[2] + a1[3]));
    pd[64 + lane] = ((b0[0] + b0[1]) + (b0[2] + b0[3])) + ((b1[0] + b1[1]) + (b1[2] + b1[3]));
}
__device__ __forceinline__ void peer_dots_item(const Ptrs& P, int x, int blk, unsigned char* lds, int lane, int wave) {
    float* R = (float*)(lds + wave * PG_WLDS); int* E = (int*)(lds + wave * PG_WLDS + 4096);
    const int gq = lane >> 3, c8 = lane & 7, tb = blk * PG_TB + PG_TPW * wave;
    u32x4 uA[16], uB[16], xa0, xb0, xa1, xb1;
    const bf16_t* xp = P.hb + (size_t)tb * 1024 + 128 * x + 16 * c8; const int* ep = P.eid + (size_t)tb * 128 + lane;
    int ea0 = ep[0], ea1 = ep[64], eb0 = ep[128], eb1 = ep[192];
    pg_issue_rows(P.U8, x, c8, gq, lane, ea0, ea1, E, uA); xa0 = *(const u32x4*)xp; xb0 = *(const u32x4*)(xp + 8);
#pragma unroll 1
    for (int i = 0; i < PG_TPW; i += 2) {
        pg_issue_rows(P.U8, x, c8, gq, lane, eb0, eb1, E, uB); xa1 = *(const u32x4*)(xp + (size_t)(i + 1) * 1024); xb1 = *(const u32x4*)(xp + (size_t)(i + 1) * 1024 + 8);
        if (i + 2 < PG_TPW) { ea0 = ep[(i + 2) * 128]; ea1 = ep[(i + 2) * 128 + 64]; }
        pg_dots_compute(P, x, tb + i, uA, xa0, xb0, R, lane);
        if (i + 2 < PG_TPW) { pg_issue_rows(P.U8, x, c8, gq, lane, ea0, ea1, E, uA); xa0 = *(const u32x4*)(xp + (size_t)(i + 2) * 1024); xb0 = *(const u32x4*)(xp + (size_t)(i + 2) * 1024 + 8); }
        if (i + 3 < PG_TPW) { eb0 = ep[(i + 3) * 128]; eb1 = ep[(i + 3) * 128 + 64]; }
        pg_dots_compute(P, x, tb + i + 1, uB, xa1, xb1, R, lane);
    }
}
__device__ __forceinline__ void pg_acc_compute(bf16_t* outp, int x, int t, const u32x4 (&vb)[16], float w0, float w1, unsigned oprev, float* C, float* W, int gq, int lane) {
    WAVE_SYNC(); W[lane] = w0; W[64 + lane] = w1; WAVE_SYNC();
    f32x2 acc[8];
#pragma unroll
    for (int q = 0; q < 8; ++q) acc[q] = (f32x2){0.f, 0.f};
#pragma unroll
    for (int k = 0; k < 16; ++k) { const float wk = W[gq + 8 * k];
#pragma unroll
        for (int q = 0; q < 4; ++q) { acc[2 * q] += cvt_pk_f32_fp8_(vb[k][q], false) * wk; acc[2 * q + 1] += cvt_pk_f32_fp8_(vb[k][q], true) * wk; } }
    WAVE_SYNC();
#pragma unroll
    for (int q = 0; q < 4; ++q) *(f32x4*)(C + lane * 16 + 4 * q) = (f32x4){acc[2 * q].x, acc[2 * q].y, acc[2 * q + 1].x, acc[2 * q + 1].y};
    WAVE_SYNC();
    f32x2 s = (f32x2){0.f, 0.f};
#pragma unroll
    for (int g = 0; g < 8; ++g) s += *(const f32x2*)(C + g * 128 + 2 * lane);
    *(unsigned*)(outp + (size_t)t * 1024 + 128 * x + 2 * lane) = pk2(bflo(oprev) + s.x, bfhi(oprev) + s.y);
}
__device__ __forceinline__ void peer_acc_item(bf16_t* outp, const Ptrs& P, int x, int blk, unsigned char* lds, int lane, int wave) {
    float* C = (float*)(lds + wave * PG_WLDS); int* E = (int*)(lds + wave * PG_WLDS + 4096); float* W = (float*)(lds + wave * PG_WLDS + 4608);
    const int gq = lane >> 3, c8 = lane & 7, tb = blk * PG_TB + PG_TPW * wave;
    u32x4 vA[16], vB[16]; unsigned oA, oB;
    const int* ep = P.eid + (size_t)tb * 128 + lane; const float* wp = P.gate + (size_t)tb * 128 + lane; const bf16_t* op = outp + (size_t)tb * 1024 + 128 * x + 2 * lane;
    int ea0 = ep[0], ea1 = ep[64], eb0 = ep[128], eb1 = ep[192]; float wa0 = wp[0], wa1 = wp[64], wb0 = wp[128], wb1 = wp[192];
    pg_issue_rows(P.V8, x, c8, gq, lane, ea0, ea1, E, vA); oA = *(const unsigned*)op;
#pragma unroll 1
    for (int i = 0; i < PG_TPW; i += 2) {
        pg_issue_rows(P.V8, x, c8, gq, lane, eb0, eb1, E, vB); oB = *(const unsigned*)(op + (size_t)(i + 1) * 1024);
        if (i + 2 < PG_TPW) { ea0 = ep[(i + 2) * 128]; ea1 = ep[(i + 2) * 128 + 64]; }
        pg_acc_compute(outp, x, tb + i, vA, wa0, wa1, oA, C, W, gq, lane);
        if (i + 2 < PG_TPW) { wa0 = wp[(i + 2) * 128]; wa1 = wp[(i + 2) * 128 + 64]; pg_issue_rows(P.V8, x, c8, gq, lane, ea0, ea1, E, vA); oA = *(const unsigned*)(op + (size_t)(i + 2) * 1024); }
        if (i + 3 < PG_TPW) { eb0 = ep[(i + 3) * 128]; eb1 = ep[(i + 3) * 128 + 64]; }
        pg_acc_compute(outp, x, tb + i + 1, vB, wb0, wb1, oB, C, W, gq, lane);
        if (i + 3 < PG_TPW) { wb0 = wp[(i + 3) * 128]; wb1 = wp[(i + 3) * 128 + 64]; }
    }
}
template <int STAGE, int CSET = STAGE>
__device__ __forceinline__ void phase_G12(const KP& p, int l, unsigned char* lds) {
    const Ptrs P = make_ptrs(p.ws, l);
    const int tid = TIDX(), lane = tid & 63, wave = tid >> 6;
    int* slot = (int*)(lds + 8 * PG_WLDS);
    const int myx = XCC_ID();
    for (int s = 0; s < 8; ++s) { const int x = (myx + s) & 7; unsigned* cnt = P.qcnt + (CSET * 8 + x) * 16;
        for (;;) { const int blk = peer_next_item(cnt, slot, tid); if (blk >= PG_NBLK) break;
            if (STAGE == 0) peer_dots_item(P, x, blk, lds, lane, wave); else peer_acc_item(CSET == 3 ? (bf16_t*)P.pd : P.ycat, P, x, blk, lds, lane, wave); } }
    __syncthreads();
}
__device__ __forceinline__ void phase_G1b(const KP& p, int l, unsigned char* lds) {
    const Ptrs P = make_ptrs(p.ws, l);
    const size_t stride = (size_t)GDIM() * NTHR, n = (size_t)T_ * 128;
    for (size_t i0 = (size_t)BIDX() * NTHR + TIDX(); i0 < n; i0 += 4 * stride) { float d[4], gt[4], su[4], sv[4]; int e[4];
#pragma unroll
        for (int q = 0; q < 4; ++q) { const size_t i = i0 + q * stride; e[q] = 0; gt[q] = 0.f; d[q] = 0.f; if (i < n) { e[q] = P.eid[i]; gt[q] = P.gate[i]; } }
#pragma unroll
        for (int q = 0; q < 4; ++q) { const size_t i = i0 + q * stride; su[q] = P.su[e[q]]; sv[q] = P.sv[e[q]];
            if (i < n) {
#pragma unroll
                for (int x = 0; x < 8; ++x) d[q] += P.pd[(size_t)x * T_ * 128 + i]; } }
#pragma unroll
        for (int q = 0; q < 4; ++q) { const size_t i = i0 + q * stride; if (i < n) P.gate[i] = gt[q] * sv[q] * gelu_erf(d[q] * su[q]); } }
#ifdef CPU_EMU
    (void)lds;
#endif
}
__device__ __forceinline__ void phase_G3(const KP& p, int l, unsigned char* lds, bool last) {
    const Ptrs P = make_ptrs(p.ws, l);
    const int tid = TIDX(), lane = tid & 63, wave = tid >> 6; const int gw = BIDX() * NWAVE + wave, NGW = GDIM() * NWAVE;
    for (int m = 4 * gw; m < T_; m += 4 * NGW) ln_rows<4, true>(P.ycat + (size_t)m * 1024, p.in[I_LN2G] + l * 1024, p.in[I_LN2B] + l * 1024, last ? p.out + (size_t)m * 1024 : (float*)nullptr, last ? (bf16_t*)nullptr : P.hb + (size_t)m * 1024,
                                                           last ? (unsigned char*)nullptr : (m < H8_SPLIT ? P.h8a + (size_t)m * 1024 : P.h8b + (size_t)(m - H8_SPLIT) * 1024), lane);
}
#ifndef PROBE_REPEAT
#define PROBE_REPEAT 0
#endif
constexpr int LDS_BYTES = 147456;
__device__ __forceinline__ void phase_B1(const KP& p, int l, unsigned char* lds) {
    const Ptrs P = make_ptrs(p.ws, l);
    constexpr int NRC = NB_ * 4 * RW_NCH, NS5 = NB_ * 16, NFX = NB_ * 4 * (S_ / 256), NCV = T_ / 64;
    const int G = GDIM(); int it = BIDX();
    for (; it < NRC; it += G) rw_chunk_unit(p, P, l, it, lds);
#if PROBE_REPEAT == 16
    for (int j = BIDX(); j < NRC; j += G) rw_chunk_unit(p, P, l, j, lds);
#endif
#if PROBE_REPEAT >= 161 && PROBE_REPEAT <= 163
    for (int j = BIDX(); j < NRC; j += G) { rw_chunk_unit<PROBE_REPEAT - 160>(p, P, l, j, lds); __syncthreads(); }
#endif
    for (; it < NRC + NFX; it += G) fox_unit(p, P, l, it - NRC, lds);
#if PROBE_REPEAT == 17
    for (int j = BIDX(); j < NFX; j += G) fox_unit(p, P, l, j, lds);
#endif
    for (; it < NRC + NFX + NS5; it += G) s5_unit(p, P, l, it - NRC - NFX, lds);
#if PROBE_REPEAT == 18
    for (int j = BIDX(); j < NS5; j += G) s5_unit(p, P, l, j, lds);
#endif
    for (; it < NRC + NFX + NS5 + NCV; it += G) conv_unit(p, P, l, it - NRC - NFX - NS5, lds);
#if PROBE_REPEAT == 19
    for (int j = BIDX(); j < NCV; j += G) conv_unit(p, P, l, j, lds);
#endif
}
__device__ __forceinline__ void phase_B3(const KP& p, int l, unsigned char* lds) {
    const Ptrs P = make_ptrs(p.ws, l);
#if PROBE_REPEAT == 34
    for (int it = BIDX(); it < NB_ * 4 * RW_NCH; it += GDIM()) rw_out_unit<true>(p, P, l, it, lds);
#endif
    for (int it = BIDX(); it < NB_ * 4 * RW_NCH; it += GDIM()) rw_out_unit<false>(p, P, l, it, lds);
}
enum { PH_PRO = 0, PH_A, PH_B1, PH_B2, PH_B3, PH_C, PH_D, PH_D2, PH_E, PH_F, PH_G, PH_G1B, PH_G2, PH_G3, PH_N, PH_A0 };
__device__ __forceinline__ void run_phase(const KP& p, int ph, int l, unsigned char* lds) {
    switch (ph) {
        case PH_PRO: phase_prologue(p, lds); break;
        case PH_A: phase_A(p, l, lds); break;
        case PH_A0: phase_A0(p, lds); break;
        case PH_B1: phase_B1(p, l, lds); break;
        case PH_B2: phase_B2(p, l, lds); break;
        case PH_B3: phase_B3(p, l, lds); break;
        case PH_C: phase_C(p, l, lds); break;
        case PH_D: phase_D(p, l, lds); break;
        case PH_D2: phase_D2(p, l, lds); break;
        case PH_E: phase_E(p, l, lds); break;
        case PH_F: phase_F(p, l, lds); break;
        case PH_G: phase_G12<0>(p, l, lds); break;
        case PH_G1B: phase_G1b(p, l, lds); break;
        case PH_G2: phase_G12<1>(p, l, lds); break;
        case PH_G3: phase_G3(p, l, lds, l == L_ - 1); break;
        default: break;
    }
}
#ifndef CPU_EMU
#define XB_TMO      128
#define XB_XCNT(j)  (256  + 64 * (j))
#define XB_XSUB(j)  (1280 + 64 * (j))
#define XB_XGEN(j)  (2304 + 64 * (j))
#define XB_TOP      3328
#define XB_TOPGEN   3392
#define XCD_BAR_WORDS 3456
#define XB_SPIN_CAP (1u << 22)
__device__ __forceinline__ unsigned xb_ld(unsigned* p)              { return __hip_atomic_load(p, __ATOMIC_RELAXED, __HIP_MEMORY_SCOPE_AGENT); }
__device__ __forceinline__ unsigned xb_add(unsigned* p, unsigned v) { return __hip_atomic_fetch_add(p, v, __ATOMIC_RELAXED, __HIP_MEMORY_SCOPE_AGENT); }
__device__ __forceinline__ unsigned xb_xcc_id() { return (unsigned)__builtin_amdgcn_s_getreg((3 << 11) | 20) & 0xFu; }
#define XB_SPIN(cond, bar) do { unsigned _sp = 0; while (cond) { __builtin_amdgcn_s_sleep(1); \
    if ((++_sp & 255u) == 0u) { if (xb_ld(&(bar)[XB_TMO])) break; if (_sp > XB_SPIN_CAP) { atomicAdd(&(bar)[XB_TMO], 1u); break; } } } } while (0)
struct XcdBarrier { unsigned* bar; unsigned x; volatile LAS unsigned* st; };
__device__ __forceinline__ XcdBarrier xcd_barrier_post(unsigned* bar, volatile LAS unsigned* st) {
    XcdBarrier b; b.bar = bar; b.x = xb_xcc_id(); b.st = st;
    if (threadIdx.x == 0) (void)xb_add(&bar[XB_XCNT(b.x)], 1u);
    return b;
}
__device__ __forceinline__ void xcd_barrier_complete(unsigned* bar, unsigned x, unsigned& nloc, unsigned& nx) {
    const unsigned G = gridDim.x * gridDim.y * gridDim.z;
    unsigned sum, cnt, mine, sp = 0u;
    for (;;) {
        sum = 0u; cnt = 0u; mine = 0u;
#pragma unroll
        for (unsigned j = 0; j < 16; ++j) { const unsigned c = xb_ld(&bar[XB_XCNT(j)]); sum += c; cnt += (c > 0u) ? 1u : 0u; mine = (j == x) ? c : mine; }
        if (sum == G) break;
        __builtin_amdgcn_s_sleep(1);
        if ((++sp & 255u) == 0u) { if (xb_ld(&bar[XB_TMO])) break; if (sp > XB_SPIN_CAP) { atomicAdd(&bar[XB_TMO], 1u); break; } }
    }
    nloc = mine > 0u ? mine : 1u; nx = cnt > 0u ? cnt : 1u;
}
__device__ __forceinline__ void xcd_barrier(const XcdBarrier& b) {
    asm volatile("s_waitcnt vmcnt(0)" ::: "memory");
    __syncthreads();
    if (threadIdx.x == 0) {
        unsigned* bar = b.bar;
        __builtin_amdgcn_s_waitcnt(0);
        unsigned nloc = b.st[0], nx = b.st[1];
        if (nloc == 0u) { xcd_barrier_complete(bar, b.x, nloc, nx); b.st[0] = nloc; b.st[1] = nx; }
        const unsigned old = xb_add(&bar[XB_XSUB(b.x)], 1u);
        const unsigned gen = old / nloc;
        if (old + 1u == (gen + 1u) * nloc) {
            __builtin_amdgcn_fence(__ATOMIC_RELEASE, "agent");
            asm volatile("s_waitcnt vmcnt(0)" ::: "memory");
            const unsigned og = xb_add(&bar[XB_TOP], 1u);
            const unsigned tg = og / nx;
            if (og + 1u == (tg + 1u) * nx) xb_add(&bar[XB_TOPGEN], 1u);
            else XB_SPIN(xb_ld(&bar[XB_TOPGEN]) == tg, bar);
            __builtin_amdgcn_fence(__ATOMIC_ACQUIRE, "agent");
            xb_add(&bar[XB_XGEN(b.x)], 1u);
            asm volatile("s_waitcnt vmcnt(0)" ::: "memory");
        } else {
            XB_SPIN(xb_ld(&bar[XB_XGEN(b.x)]) == gen, bar);
            __builtin_amdgcn_fence(__ATOMIC_ACQUIRE, "agent");
            asm volatile("s_waitcnt vmcnt(0)" ::: "memory");
        }
    }
    __syncthreads();
}
#ifndef PROBE_REPEAT
#define PROBE_REPEAT 0
#endif
#ifndef N_LAUNCH_MODE
#define N_LAUNCH_MODE 1
#endif
extern __shared__ __attribute__((aligned(16))) unsigned char lds_dyn[];
#if N_LAUNCH_MODE == 0
template <int PH> __global__ void __launch_bounds__(NTHR, 2) k_phase_t(KP p) { run_phase(p, PH, p.layer, lds_dyn); }
typedef void (*kfn_t)(KP);
static kfn_t phase_fn(int ph) { switch (ph) { case PH_PRO: return k_phase_t<PH_PRO>; case PH_A: return k_phase_t<PH_A>; case PH_B1: return k_phase_t<PH_B1>; case PH_B2: return k_phase_t<PH_B2>; case PH_B3: return k_phase_t<PH_B3>; case PH_C: return k_phase_t<PH_C>;
    case PH_D: return k_phase_t<PH_D>; case PH_D2: return k_phase_t<PH_D2>; case PH_E: return k_phase_t<PH_E>; case PH_F: return k_phase_t<PH_F>; case PH_G: return k_phase_t<PH_G>; case PH_G1B: return k_phase_t<PH_G1B>; case PH_G2: return k_phase_t<PH_G2>; default: return k_phase_t<PH_G3>; } }
#else
#ifndef USE_XCD_BARRIER
#define USE_XCD_BARRIER 1
#endif
constexpr int BAR_LDS_OFF = LDS_BYTES - 64;
#if USE_XCD_BARRIER
#define GSYNC() xcd_barrier(bar)
#define GSYNC_ARG const XcdBarrier& bar
#else
#define GSYNC() grid.sync()
#define GSYNC_ARG cg::grid_group& grid
#endif
template <int l>
__device__ __forceinline__ void mega_layer(const KP& p, GSYNC_ARG) {
#if PROBE_REPEAT == 47 || PROBE_REPEAT == 48
        phase_Aprobe<PROBE_REPEAT - 40>(p, l, lds_dyn); GSYNC();
#endif
        phase_A(p, l, lds_dyn);
#if PROBE_REPEAT == 1
        GSYNC(); phase_A(p, l, lds_dyn);
#endif
#if PROBE_REPEAT >= 40 && PROBE_REPEAT <= 46
        GSYNC(); phase_Aprobe<PROBE_REPEAT - 40>(p, l, lds_dyn);
#endif
        GSYNC(); phase_B1(p, l, lds_dyn);
#if PROBE_REPEAT == 2
        GSYNC(); phase_B1(p, l, lds_dyn);
#endif
        GSYNC(); phase_B2(p, l, lds_dyn);
        GSYNC(); phase_B3(p, l, lds_dyn);
        GSYNC(); phase_C(p, l, lds_dyn);
#if PROBE_REPEAT == 4
        GSYNC(); phase_C(p, l, lds_dyn);
#endif
        GSYNC(); phase_D(p, l, lds_dyn);
        GSYNC(); phase_D2(p, l, lds_dyn);
        GSYNC(); phase_E(p, l, lds_dyn);
        GSYNC(); phase_F(p, l, lds_dyn);
#if PROBE_REPEAT == 8
        GSYNC(); phase_F(p, l, lds_dyn);
#endif
        GSYNC(); phase_G12<0>(p, l, lds_dyn);
#if PROBE_REPEAT == 32
        GSYNC(); phase_G12<0, 2>(p, l, lds_dyn);
#endif
        GSYNC(); phase_G1b(p, l, lds_dyn);
        GSYNC(); phase_G12<1>(p, l, lds_dyn);
#if PROBE_REPEAT == 33
        GSYNC(); phase_G12<1, 3>(p, l, lds_dyn);
#endif
        GSYNC(); phase_G3(p, l, lds_dyn, l == L_ - 1);
}
__global__ void __launch_bounds__(NTHR, 2) k_mega(KP p) {
    cg::grid_group grid = cg::this_grid();
#if USE_XCD_BARRIER
    volatile LAS unsigned* st = (volatile LAS unsigned*)(lds_dyn + BAR_LDS_OFF);
    if (threadIdx.x < 2) st[threadIdx.x] = 0u;
    __syncthreads();
    const XcdBarrier bar = xcd_barrier_post((unsigned*)(p.ws + WS_CTL) + 4096, st);
#define GSYNC_VAL bar
#else
#define GSYNC_VAL grid
#endif
    phase_prologue(p, lds_dyn);
#if PROBE_REPEAT == 60
    GSYNC(); phase_prologue(p, lds_dyn);
#endif
    grid.sync();
    phase_A0(p, lds_dyn);
    GSYNC();
    mega_layer<0>(p, GSYNC_VAL);
    static_assert(L_ == 2, "two layers");
    GSYNC();
    mega_layer<1>(p, GSYNC_VAL);
}
#endif
extern "C" void kernel_launch(void* const* d_in, const int* in_sizes, int n_in, void* d_out, int out_size, void* d_ws, size_t ws_size, hipStream_t stream) {
    static int grid = 0;
    if (grid == 0) {
        if (n_in != N_IN || out_size != T_ * 1024 || ws_size < WS_END) { fprintf(stderr, "kernel_launch: unexpected shapes (n_in %d out %d ws %zu need %zu)\n", n_in, out_size, ws_size, (size_t)WS_END); grid = -1; return; }
        int dev = 0, cus = 0, per_cu = 0;
        (void)hipGetDevice(&dev); (void)hipDeviceGetAttribute(&cus, hipDeviceAttributeMultiprocessorCount, dev);
#if N_LAUNCH_MODE == 0
        for (int ph = 0; ph < PH_N; ++ph) (void)hipFuncSetAttribute((const void*)phase_fn(ph), hipFuncAttributeMaxDynamicSharedMemorySize, LDS_BYTES);
        (void)per_cu;
#else
        (void)hipFuncSetAttribute((const void*)k_mega, hipFuncAttributeMaxDynamicSharedMemorySize, LDS_BYTES);
        (void)hipOccupancyMaxActiveBlocksPerMultiprocessor(&per_cu, (const void*)k_mega, NTHR, LDS_BYTES);
        if (per_cu < 1) { fprintf(stderr, "kernel_launch: occupancy query says %d blocks per CU\n", per_cu); grid = -1; return; }
#endif
        grid = cus;
    }
    if (grid < 0) return;
    if (hipMemsetAsync((char*)d_ws + WS_CTL, 0, 65536, stream) != hipSuccess) { fprintf(stderr, "kernel_launch: memset failed\n"); return; }
    KP p{};
    for (int i = 0; i < N_IN; ++i) p.in[i] = (const float*)d_in[i];
    p.out = (float*)d_out; p.ws = (unsigned char*)d_ws;
#if N_LAUNCH_MODE == 1
    void* args[] = {&p};
    hipError_t e = hipLaunchCooperativeKernel((const void*)k_mega, dim3(grid), dim3(NTHR), args, LDS_BYTES, stream);
    if (e != hipSuccess) fprintf(stderr, "cooperative launch failed: %s (grid %d)\n", hipGetErrorString(e), grid);
#else
    p.phase = PH_PRO; p.layer = 0; hipLaunchKernelGGL(phase_fn(PH_PRO), dim3(grid), dim3(NTHR), LDS_BYTES, stream, p);
    for (int l = 0; l < L_; ++l) for (int ph = PH_A; ph < PH_N; ++ph) { p.phase = ph; p.layer = l; hipLaunchKernelGGL(phase_fn(ph), dim3(grid), dim3(NTHR), LDS_BYTES, stream, p); }
#endif
}
#endif
```

```cpp
#ifdef CPU_EMU
#include "emu.h"
#define LAS
#define GET_LDS() ((unsigned char*)emu::lds())
#define AS_GLOBAL(p) (p)
#define AS_LDS(p) (p)
#define RFL(x) (x)
#define MFMA32(a, b, c) emu_mfma32(a, b, c)
#define MFMA16(a, b, c) emu_mfma16(a, b, c)
#define MFMA16_FP8(a, b, c) emu_mfma16_fp8(a, b, c)
#define FAST_EXP2(x) exp2f(x)
#define FAST_RCP(x) (1.0f / (x))
#define FAST_LOG2(x) log2f(x)
#define FAST_RSQ(x) (1.0f / sqrtf(x))
#define WAVE_SYNC() do { uint32_t _z = 0; (void)emu::wave_xchg(&_z, 1); } while (0)
#define OPAQUE(x) do {} while (0)
#define GLDS16(gp, lp, lane) memcpy((char*)(lp) + 16 * (lane), (const void*)(gp), 16)
#define WAIT_VM(n) do {} while (0)
#define GLOAD16_ASM(dst, ptr) (dst) = *(const u32x4*)(ptr)
#define GLOAD16_RW(dst, ptr) (dst) = *(const u32x4*)(ptr)
#define PIN1(a) do {} while (0)
#define GLOAD16_RW_S(dst, base, off) (dst) = *(const u32x4*)((const unsigned char*)(base) + (off))
#define SCHED_FENCE() do {} while (0)
#define TAG_A() do {} while (0)
#define TAG_B() do {} while (0)
#define GLOAD16_S(dst, base, off) (dst) = *(const u32x4*)((const unsigned char*)(base) + (off))
#define GLOAD4_S(dst, base, off) (dst) = *(const int*)((const unsigned char*)(base) + (off))
#define GLOAD4_ASM(dst, ptr) (dst) = *(const int*)(ptr)
#define PIN4(a, b, c, d) do {} while (0)
#define PIN2I(a, b) do {} while (0)
#define WAIT_LGKM0() do {} while (0)
#define READLANE_I(v, l) __shfl((int)(v), (l))
#define READLANE_F(v, l) __shfl((float)(v), (l))
#define TIDX() ((int)threadIdx.x)
#define XCC_ID() (emu::bid() & 7)
#define GDIM() ((int)gridDim.x)
#define BIDX() ((int)blockIdx.x)
#define OPAQUE_S(x) do {} while (0)
#define MEMFENCE() do {} while (0)
#else
#include <hip/hip_runtime.h>
#include <hip/hip_cooperative_groups.h>
#include <cstdio>
#include <cstdint>
namespace cg = cooperative_groups;
#define LAS __attribute__((address_space(3)))
#define GAS __attribute__((address_space(1)))
#define AS_GLOBAL(p) ((unsigned char*)(GAS unsigned char*)(p))
#define AS_LDS(p) ((unsigned char*)(LAS unsigned char*)(p))
#define RFL(x) __builtin_amdgcn_readfirstlane(x)
#define MFMA32(a, b, c) __builtin_amdgcn_mfma_f32_32x32x16_bf16(a, b, c, 0, 0, 0)
#define MFMA16(a, b, c) __builtin_amdgcn_mfma_f32_16x16x32_bf16(a, b, c, 0, 0, 0)
#define MFMA16_FP8(a, b, c) __builtin_amdgcn_mfma_f32_16x16x32_fp8_fp8((long)(a), (long)(b), c, 0, 0, 0)
#define MFMA16_F8X128(a, b, c) __builtin_amdgcn_mfma_scale_f32_16x16x128_f8f6f4(a, b, c, 0, 0, 0, 0, 0, 0)
#define FAST_EXP2(x) __builtin_amdgcn_exp2f(x)
#define FAST_RCP(x) __builtin_amdgcn_rcpf(x)
#define FAST_LOG2(x) __builtin_amdgcn_logf(x)
#define FAST_RSQ(x) __builtin_amdgcn_rsqf(x)
#define WAVE_SYNC() __builtin_amdgcn_wave_barrier()
#define OPAQUE(x) asm volatile("" : "+v"(x))
#define GLDS16(gp, lp, lane) __builtin_amdgcn_global_load_lds((const unsigned*)(gp), (LAS unsigned*)(lp), 16, 0, 0)
#define WAIT_VM(n) asm volatile("s_waitcnt vmcnt(" #n ")" ::: "memory")
#define GLOAD16_ASM(dst, ptr) asm volatile("global_load_dwordx4 %0, %1, off" : "=v"(dst) : "v"(ptr) : "memory")
#define GLOAD4_ASM(dst, ptr) asm volatile("global_load_dword %0, %1, off" : "=v"(dst) : "v"(ptr) : "memory")
#define GLOAD16_RW(dst, ptr) asm volatile("global_load_dwordx4 %0, %1, off" : "+v"(dst) : "v"(ptr) : "memory")
#define PIN1(a) asm volatile("" : "+v"(a) :: "memory")
#define GLOAD16_RW_S(dst, base, off) asm volatile("global_load_dwordx4 %0, %1, %2" : "+v"(dst) : "v"(off), "s"(base) : "memory")
#define SCHED_FENCE() __builtin_amdgcn_sched_barrier(0)
#define TAG_A() asm volatile("; buffer A" ::: "memory")
#define TAG_B() asm volatile("; buffer B" ::: "memory")
#define GLOAD16_S(dst, base, off) asm volatile("global_load_dwordx4 %0, %1, %2" : "=v"(dst) : "v"(off), "s"(base) : "memory")
#define GLOAD4_S(dst, base, off) asm volatile("global_load_dword %0, %1, %2" : "=v"(dst) : "v"(off), "s"(base) : "memory")
#define PIN4(a, b, c, d) asm volatile("" : "+v"(a), "+v"(b), "+v"(c), "+v"(d) :: "memory")
#define PIN2I(a, b) asm volatile("" : "+v"(a), "+v"(b) :: "memory")
#define WAIT_LGKM0() asm volatile("s_waitcnt lgkmcnt(0)" ::: "memory")
#define READLANE_I(v, l) __builtin_amdgcn_readlane((int)(v), (l))
#define READLANE_F(v, l) __builtin_bit_cast(float, __builtin_amdgcn_readlane(__builtin_bit_cast(int, (float)(v)), (l)))
#define OPAQUE_S(x) asm volatile("" : "+s"(x))
__device__ __forceinline__ int opaque_tid_() { int t = threadIdx.x; asm volatile("" : "+v"(t)); return t; }
#define TIDX() opaque_tid_()
#define XCC_ID() ((int)(__builtin_amdgcn_s_getreg((3 << 11) | 20) & 7u))
__device__ __forceinline__ int opaque_gdim_() { int t = gridDim.x; asm volatile("" : "+s"(t)); return t; }
__device__ __forceinline__ int opaque_bidx_() { int t = blockIdx.x; asm volatile("" : "+s"(t)); return t; }
#define GDIM() opaque_gdim_()
#define BIDX() opaque_bidx_()
#define MEMFENCE() do { asm volatile("" ::: "memory"); __builtin_amdgcn_sched_barrier(0); } while (0)
#endif

#ifndef CFG_B
#define CFG_B 16
#endif
#ifndef CFG_S
#define CFG_S 2048
#endif

typedef unsigned short bf16_t;
typedef short bf16x8 __attribute__((ext_vector_type(8)));
typedef short s16x4 __attribute__((ext_vector_type(4)));
typedef float f32x4 __attribute__((ext_vector_type(4)));
typedef float f32x2 __attribute__((ext_vector_type(2)));
typedef float f32x16 __attribute__((ext_vector_type(16)));
typedef unsigned u32x4 __attribute__((ext_vector_type(4)));
typedef unsigned u32x2 __attribute__((ext_vector_type(2)));
typedef int i32x4 __attribute__((ext_vector_type(4)));
typedef int i32x8 __attribute__((ext_vector_type(8)));

constexpr int NB_ = CFG_B, S_ = CFG_S, T_ = NB_ * S_, D_ = 1024, L_ = 2;
constexpr int NTHR = 512, NWAVE = 8;
constexpr int PJ = 2304;
constexpr int C_R = 0, C_K = 256, C_V = 512, C_HW = 768, C_HA = 800, C_HG = 832, C_S5 = 896, C_FQ = 1152, C_FK = 1408, C_FL = 1664, C_CV = 1792, C_CG = 2048;
constexpr int WIN_ROWS = 6656, WIN_VT = 2304, WIN_GATE = 2560;
constexpr int IN_COLS = 6532;
constexpr float LN_EPS_ = 1e-5f, GN_EPS_ = 64e-5f;
constexpr float DN_ALPHA_ = 1.4142135623730951f;
constexpr int NEXP = 16384;

enum { I_X = 0, I_P, I_LNIN_G, I_LNIN_B, I_WIN, I_MU, I_W0, I_W2, I_A0, I_A2, I_G2, I_KK, I_KA, I_RK, I_LNXG, I_LNXB, I_LRE, I_LIM, I_BRE, I_BIM, I_CRE, I_CIM,
       I_S5D, I_LDT, I_GLUW, I_GLUB, I_BF, I_CONVW, I_CONVB, I_CLNG, I_CLNB, I_WBR, I_WOUT, I_LN1G, I_LN1B, I_WQ, I_K1, I_K2, I_U, I_V, I_PLEW, I_PLEG, I_LN2G, I_LN2B, N_IN };

constexpr size_t al256(size_t x) { return (x + 255) & ~(size_t)255; }
constexpr size_t WS_CTL = 0;
constexpr size_t WS_WIN = 1u << 20;
constexpr size_t WS_WBR = WS_WIN + al256((size_t)L_ * WIN_ROWS * 1024 * 2);
constexpr size_t WS_WOUT = WS_WBR + (size_t)L_ * 1024 * 1024 * 2;
constexpr size_t WS_WQ = WS_WOUT + (size_t)L_ * 1024 * 1024 * 2;
constexpr size_t WS_PLE = WS_WQ + (size_t)L_ * 2048 * 1024 * 2;
constexpr size_t WS_PLEG = WS_PLE + (size_t)L_ * 1024 * 256 * 2;
constexpr size_t WS_GLU = WS_PLEG + (size_t)L_ * 1024 * 1024 * 2;
constexpr size_t WS_K12 = WS_GLU + (size_t)L_ * 256 * 256 * 2;
constexpr size_t WS_S5KC = WS_K12 + (size_t)L_ * 2 * 128 * 128 * 2;
constexpr size_t WS_S5WX = WS_S5KC + (size_t)L_ * 16 * 64 * 256 * 2;
constexpr size_t WS_S5WY = WS_S5WX + (size_t)L_ * 16 * 128 * 1024 * 2;
constexpr size_t WS_S5LL = WS_S5WY + (size_t)L_ * 16 * 1024 * 128 * 2;
constexpr size_t WS_UT = WS_S5LL + al256((size_t)L_ * 16 * 64 * 2 * 4);
constexpr size_t WS_VT = WS_UT + (size_t)NEXP * 1024 * 2;
constexpr size_t WS_RW = WS_VT + (size_t)NEXP * 1024 * 2;
constexpr size_t RW_SZ = (size_t)T_ * 512;
static_assert(2 * RW_SZ <= (size_t)NEXP * 1024 * 2, "RWKV gate / bonus arrays fit the second table region");
constexpr size_t WS_HB = WS_RW + 4 * RW_SZ;
constexpr size_t WS_R1 = WS_HB + (size_t)T_ * 1024 * 2;
constexpr size_t R1_BYTES = (size_t)T_ * 2560 * 2;
constexpr size_t WS_YC = WS_R1 + R1_BYTES;
constexpr size_t WS_VTR = WS_YC + (size_t)T_ * 1024 * 2;
constexpr size_t WS_PB = WS_VTR + (size_t)256 * T_ * 2;
constexpr size_t WS_H8T = WS_PB + (size_t)T_ * 256 * 2;
constexpr int H8_SPLIT = (T_ / 512) * 256;
constexpr size_t WS_END = WS_H8T + (size_t)(T_ - H8_SPLIT) * 1024;
constexpr size_t R1_PROJ = 0;
constexpr size_t R1_H8 = (size_t)T_ * 2304 * 2;
constexpr size_t R1_MERGED = 0;
constexpr size_t R1_STASH = (size_t)T_ * 1024 * 2;
constexpr size_t R1_Q = 0;
constexpr size_t R1_EID = (size_t)T_ * 2048 * 2;
constexpr size_t R1_GATE = R1_EID + (size_t)T_ * 128 * 4;
static_assert(R1_GATE + (size_t)T_ * 128 * 4 <= R1_BYTES, "R1 map");

struct KP { const float* in[N_IN]; float* out; unsigned char* ws; float* dbg; int layer; int phase; };

#ifdef CPU_EMU
__device__ __forceinline__ unsigned f2bf(float f) { unsigned u = __builtin_bit_cast(unsigned, f); return (u + 0x7fffu + ((u >> 16) & 1u)) >> 16; }
__device__ __forceinline__ unsigned pk2(float lo, float hi) { return f2bf(lo) | (f2bf(hi) << 16); }
#else
typedef __bf16 bf16x2_hw __attribute__((ext_vector_type(2)));
__device__ __forceinline__ unsigned pk2(float lo, float hi) { const f32x2 v = {lo, hi}; return __builtin_bit_cast(unsigned, __builtin_convertvector(v, bf16x2_hw)); }
__device__ __forceinline__ unsigned f2bf(float f) { return pk2(f, 0.f) & 0xffffu; }
#endif
__device__ __forceinline__ float bf2f(unsigned h) { return __builtin_bit_cast(float, h << 16); }
__device__ __forceinline__ float bflo(unsigned w) { return __builtin_bit_cast(float, w << 16); }
__device__ __forceinline__ float bfhi(unsigned w) { return __builtin_bit_cast(float, w & 0xffff0000u); }
__device__ __forceinline__ float sigmoidf_(float x) { return FAST_RCP(1.0f + FAST_EXP2(x * -1.4426950408889634f)); }
__device__ __forceinline__ float gelu_erf(float v) {
    const float t = FAST_RCP(fabsf(v) * 0.2316418882f + 1.0f);
    float q = t * 0.5307027145f + (-0.7265760135f); q = q * t + 0.7107068705f; q = q * t + (-0.142248368f); q = q * t + 0.127414796f; q = q * t;
    const float m = v * (q * FAST_EXP2((v * v) * (-0.72134752044f)));
    return v < 0.f ? m : v - m; }
#ifdef CPU_EMU
inline float fp8_dec_(unsigned b) { const unsigned s = b >> 7, e = (b >> 3) & 15, m = b & 7; float v = (e == 0) ? ldexpf((float)m, -9) : ldexpf(1.f + m * 0.125f, (int)e - 7); return s ? -v : v; }
inline unsigned fp8_enc_(float x) { const unsigned s = x < 0.f ? 0x80u : 0u; float a = fabsf(x); if (!(a > 0.f)) return s; if (a > 448.f) a = 448.f;
    int e; (void)frexpf(a, &e); e -= 1; if (e < -6) e = -6;
    const float q = ldexpf(a, 3 - e); float r = nearbyintf(q);
    unsigned ee, mm; if (e == -6 && r < 8.f) { ee = 0; mm = (unsigned)r; } else { if (r >= 16.f) { r = 8.f; e += 1; } ee = (unsigned)(e + 7); mm = (unsigned)r - 8u; }
    if (ee > 15u || (ee == 15u && mm > 6u)) { ee = 15u; mm = 6u; }
    return s | (ee << 3) | mm; }
inline f32x2 cvt_pk_f32_fp8_(unsigned w, bool hi) { const unsigned h = hi ? (w >> 16) : w; return (f32x2){fp8_dec_(h & 255u), fp8_dec_((h >> 8) & 255u)}; }
inline unsigned cvt_pk_fp8_f32_(float a, float b, unsigned old, bool hi) { const unsigned p = fp8_enc_(a) | (fp8_enc_(b) << 8); return hi ? ((old & 0xffffu) | (p << 16)) : ((old & 0xffff0000u) | p); }
#else
__device__ __forceinline__ f32x2 cvt_pk_f32_fp8_(unsigned w, bool hi) { return hi ? __builtin_amdgcn_cvt_pk_f32_fp8((int)w, true) : __builtin_amdgcn_cvt_pk_f32_fp8((int)w, false); }
__device__ __forceinline__ unsigned cvt_pk_fp8_f32_(float a, float b, unsigned old, bool hi) { return hi ? (unsigned)__builtin_amdgcn_cvt_pk_fp8_f32(a, b, (int)old, true) : (unsigned)__builtin_amdgcn_cvt_pk_fp8_f32(a, b, (int)old, false); }
#endif
__device__ __forceinline__ float wave_max(float v) {
#pragma unroll
  for (int o = 1; o < 64; o <<= 1) v = fmaxf(v, __shfl_xor(v, o));
  return v;
}
template <int N> __device__ __forceinline__ void wave_sum_n(float (&v)[N]) {
#pragma unroll
  for (int o = 1; o < 64; o <<= 1) { float t[N];
#pragma unroll
    for (int i = 0; i < N; ++i) t[i] = __shfl_xor(v[i], o);
#pragma unroll
    for (int i = 0; i < N; ++i) v[i] += t[i]; }
}
__device__ __forceinline__ float wave_sum(float v) {
#pragma unroll
  for (int o = 1; o < 64; o <<= 1) v += __shfl_xor(v, o);
  return v;
}
namespace pg8 {
constexpr int BM = 256, BK = 64, HALF = 128, HTB = HALF * BK * 2, STAGE_BYTES = 8 * HTB;
__host__ __device__ __forceinline__ int lds_byte(int r, int c) { const int st = (r >> 4) * 2 + (c >> 5), rr = r & 15, cc = c & 31, ob = rr * 64 + cc * 2; return st * 1024 + (ob ^ (((ob >> 9) & 1) << 5)); }
__host__ __device__ __forceinline__ void stage_rc(int b, int& R, int& C) { const int st = b / 1024, sb = b % 1024, swz = sb ^ (((sb >> 9) & 1) << 5); R = (st >> 1) * 16 + swz / 64; C = (st & 1) * 32 + (swz % 64) / 2; }
__host__ __device__ __forceinline__ int perm32(int rho) { const int n = rho >> 4, i = rho & 15; return 8 * (i >> 2) + 4 * n + (i & 3); }

struct Unit { const char* a; const char* b; int nt; int kind; int pm; int pn; int aux; int f8; };

#ifndef CPU_EMU
template <int MODE = 0, class Epi, class Sched>
__device__ __forceinline__ void gemm_phase(LAS unsigned char* lds, const int lda, const int ldb, const Sched& S, const Epi& E, const int lda8 = 0) {
    const int tid = TIDX(), wid = __builtin_amdgcn_readfirstlane(tid >> 6), lane = tid & 63, wr = wid >> 2, wc = wid & 3, fr = lane & 15, fq = lane >> 4;
    unsigned voffA[2], voffB[2], voffA8[2];
#pragma unroll
    for (int i = 0; i < 2; ++i) { int R, C; stage_rc(tid * 16 + i * 8192, R, C); const int Rb = (R & ~31) + perm32(R & 31);
        voffA[i] = (unsigned)(R * lda + C) * 2u; voffB[i] = (unsigned)(Rb * ldb + C) * 2u; voffA8[i] = (unsigned)(R * lda8 + C * 2); }
    const size_t kstep = (size_t)(BK * 2);
    const size_t hstepA = (size_t)HALF * lda * 2, hstepB = (size_t)HALF * ldb * 2, hstepA8 = (size_t)HALF * lda8;
    const unsigned ldsw = (unsigned)wid * 1024u;
    const int aoff = lds_byte(wr * 64 + fr, fq * 8), boff = lds_byte(wc * 32 + fr, fq * 8);
#define PG8_SA(b, h) (((b) * 2 + (h)) * HTB)
#define PG8_SB(b, h) ((4 + (b) * 2 + (h)) * HTB)
#define PG8_STAGE(bufoff, gbase, voff) do { _Pragma("unroll") for (int _i = 0; _i < 2; ++_i) \
        __builtin_amdgcn_global_load_lds((const unsigned*)((const char*)(gbase) + (voff)[_i]), (LAS unsigned*)(lds + (bufoff) + ldsw + _i * 8192), 16, 0, 0); } while (0)
#define PG8_LDA(dst, b, h) do { _Pragma("unroll") for (int m = 0; m < 4; ++m) _Pragma("unroll") for (int k = 0; k < 2; ++k) dst[m][k] = *(const LAS bf16x8*)(lds + PG8_SA(b, h) + aoff + m * 2048 + k * 1024); } while (0)
#define PG8_LDB(dst, b, h) do { _Pragma("unroll") for (int n = 0; n < 2; ++n) _Pragma("unroll") for (int k = 0; k < 2; ++k) dst[n][k] = *(const LAS bf16x8*)(lds + PG8_SB(b, h) + boff + n * 2048 + k * 1024); } while (0)
#define PG8_MMA(ai, bj, At, Bt) do { __builtin_amdgcn_s_setprio(1); _Pragma("unroll") for (int m = 0; m < 4; ++m) _Pragma("unroll") for (int n = 0; n < 2; ++n) _Pragma("unroll") for (int k = 0; k < 2; ++k) \
        acc[ai][bj][m][n] = __builtin_amdgcn_mfma_f32_16x16x32_bf16(Bt[n][k], At[m][k], acc[ai][bj][m][n], 0, 0, 0); __builtin_amdgcn_s_setprio(0); } while (0)
#define PG8_CAT(x, y) __builtin_shufflevector(__builtin_bit_cast(i32x4, x), __builtin_bit_cast(i32x4, y), 0, 1, 2, 3, 4, 5, 6, 7)
#define PG8_LDA8(dst, b, h) do { _Pragma("unroll") for (int m = 0; m < 4; ++m) dst[m] = PG8_CAT(*(const LAS bf16x8*)(lds + PG8_SA(b, h) + aoff + m * 2048), *(const LAS bf16x8*)(lds + PG8_SA(b, h) + aoff + m * 2048 + 1024)); } while (0)
#define PG8_LDB8(dst, b, h) do { _Pragma("unroll") for (int n = 0; n < 2; ++n) dst[n] = PG8_CAT(*(const LAS bf16x8*)(lds + PG8_SB(b, h) + boff + n * 2048), *(const LAS bf16x8*)(lds + PG8_SB(b, h) + boff + n * 2048 + 1024)); } while (0)
#define PG8_MMA8(ai, bj, A8, B8) do { __builtin_amdgcn_s_setprio(1); _Pragma("unroll") for (int m = 0; m < 4; ++m) _Pragma("unroll") for (int n = 0; n < 2; ++n) \
        acc[ai][bj][m][n] = MFMA16_F8X128(B8[n], A8[m], acc[ai][bj][m][n]); __builtin_amdgcn_s_setprio(0); } while (0)
#define PG8_WAIT_V(n) asm volatile("s_waitcnt vmcnt(" #n ")" ::: "memory")
#define PG8_WAIT_L(n) asm volatile("s_waitcnt lgkmcnt(" #n ")" ::: "memory")
#define PG8_BAR __builtin_amdgcn_s_barrier()
#define PG8_SCHED __builtin_amdgcn_sched_barrier(0)
    Unit cur, nxt; int ui = 0;
    if (!S.next(0, cur)) return;
    f32x4 acc[2][2][4][2];
#pragma unroll
    for (int a = 0; a < 2; ++a)
#pragma unroll
        for (int b = 0; b < 2; ++b)
#pragma unroll
            for (int m = 0; m < 4; ++m)
#pragma unroll
                for (int n = 0; n < 2; ++n) acc[a][b][m][n] = (f32x4){0.f, 0.f, 0.f, 0.f};
    bf16x8 At[4][2], B0[2][2], B1[2][2];
    const char* cA = cur.a; const char* cB = cur.b; int cf8 = MODE == 2 ? cur.f8 : MODE; size_t chA = cf8 ? hstepA8 : hstepA;
    { unsigned v0[2] = {cf8 ? voffA8[0] : voffA[0], cf8 ? voffA8[1] : voffA[1]};
    PG8_STAGE(PG8_SB(0, 0), cB, voffB); PG8_STAGE(PG8_SB(0, 1), cB + hstepB, voffB); PG8_STAGE(PG8_SA(0, 0), cA, v0); PG8_STAGE(PG8_SA(0, 1), cA + chA, v0);
    if (wr == 1) PG8_BAR;
    PG8_WAIT_V(2); PG8_BAR;
    PG8_STAGE(PG8_SB(1, 0), cB + kstep, voffB); PG8_STAGE(PG8_SA(1, 0), cA + kstep, v0); PG8_STAGE(PG8_SB(1, 1), cB + hstepB + kstep, voffB);
    PG8_WAIT_V(6); PG8_BAR; }
    for (;;) {
        const bool has_next = S.next(ui + 1, nxt);
        const char* nA = has_next ? nxt.a : cA; const char* nB = has_next ? nxt.b : cB; const int nf8 = MODE == 2 ? (has_next ? nxt.f8 : cf8) : MODE;
        int nt = cur.nt; asm volatile("" : "+s"(nt));
#define PG8_KLOOP(LDA_, LDB_, MM_, At_, B0_, B1_, CF8) \
        for (int t = 0; t < nt; t += 2) { \
            const bool last = (t == nt - 2); \
            const char* a1 = cA + (size_t)(t + 1) * kstep; \
            const char* a2 = last ? nA : cA + (size_t)(t + 2) * kstep; const char* b2 = last ? nB : cB + (size_t)(t + 2) * kstep; \
            const char* a3 = a2 + kstep; const char* b3 = b2 + kstep; \
            const int f2 = last ? nf8 : CF8; const size_t h2 = f2 ? hstepA8 : hstepA; \
            OPAQUE_S(a1); OPAQUE_S(a2); OPAQUE_S(a3); OPAQUE_S(b2); OPAQUE_S(b3); \
            const unsigned vA[2] = {CF8 ? voffA8[0] : voffA[0], CF8 ? voffA8[1] : voffA[1]}, vA2[2] = {f2 ? voffA8[0] : voffA[0], f2 ? voffA8[1] : voffA[1]}, vB[2] = {voffB[0], voffB[1]}; \
            LDB_(B0_, 0, 0); LDB_(B1_, 0, 1); PG8_SCHED; LDA_(At_, 0, 0); PG8_STAGE(PG8_SA(1, 1), a1 + (CF8 ? hstepA8 : hstepA), vA); \
            PG8_WAIT_V(8); PG8_WAIT_L(0); PG8_BAR; MM_(0, 0, At_, B0_); MM_(0, 1, At_, B1_); PG8_BAR; PG8_SCHED; \
            LDA_(At_, 0, 1); PG8_STAGE(PG8_SB(0, 0), b2, vB); PG8_STAGE(PG8_SB(0, 1), b2 + hstepB, vB); PG8_STAGE(PG8_SA(0, 0), a2, vA2); \
            PG8_WAIT_V(8); PG8_WAIT_L(0); PG8_BAR; MM_(1, 0, At_, B0_); MM_(1, 1, At_, B1_); PG8_BAR; PG8_SCHED; \
            LDB_(B0_, 1, 0); LDB_(B1_, 1, 1); PG8_SCHED; LDA_(At_, 1, 0); PG8_STAGE(PG8_SA(0, 1), a2 + h2, vA2); \
            PG8_WAIT_V(8); PG8_WAIT_L(0); PG8_BAR; MM_(0, 0, At_, B0_); MM_(0, 1, At_, B1_); PG8_BAR; PG8_SCHED; \
            LDA_(At_, 1, 1); PG8_STAGE(PG8_SB(1, 0), b3, vB); PG8_STAGE(PG8_SB(1, 1), b3 + hstepB, vB); PG8_STAGE(PG8_SA(1, 0), a3, vA2); \
            PG8_WAIT_V(8); PG8_WAIT_L(0); PG8_BAR; MM_(1, 0, At_, B0_); MM_(1, 1, At_, B1_); PG8_BAR; PG8_SCHED; \
        }
        if (MODE == 1 || (MODE == 2 && cf8)) { i32x8 A8[4], B08[2], B18[2]; PG8_KLOOP(PG8_LDA8, PG8_LDB8, PG8_MMA8, A8, B08, B18, 1) }
        else { PG8_KLOOP(PG8_LDA, PG8_LDB, PG8_MMA, At, B0, B1, 0) }
#undef PG8_KLOOP
        if (wr == 0) PG8_BAR;
        E(acc, cur, wr, wc, fr, fq, tid);
        if (!has_next) break;
#pragma unroll
        for (int a = 0; a < 2; ++a)
#pragma unroll
            for (int b = 0; b < 2; ++b)
#pragma unroll
                for (int m = 0; m < 4; ++m)
#pragma unroll
                    for (int n = 0; n < 2; ++n) acc[a][b][m][n] = (f32x4){0.f, 0.f, 0.f, 0.f};
        cur = nxt; cA = nA; cB = nB; cf8 = nf8; ++ui;
        if (wr == 1) PG8_BAR;
    }
    PG8_WAIT_V(0);
    PG8_BAR;
#undef PG8_SA
#undef PG8_SB
#undef PG8_STAGE
#undef PG8_LDA
#undef PG8_LDB
#undef PG8_MMA
#undef PG8_MMA8
#undef PG8_LDA8
#undef PG8_LDB8
#undef PG8_CAT
#undef PG8_WAIT_V
#undef PG8_WAIT_L
#undef PG8_BAR
#undef PG8_SCHED
}
#else
template <int MODE = 0, class Epi, class Sched>
inline void gemm_phase(unsigned char* lds, const int lda, const int ldb, const Sched& S, const Epi& E, const int lda8 = 0) {
    const int tid = TIDX(), wid = tid >> 6, lane = tid & 63, wr = wid >> 2, wc = wid & 3, fr = lane & 15, fq = lane >> 4;
    Unit cur;
    for (int ui = 0; S.next(ui, cur); ++ui) {
        f32x4 acc[2][2][4][2];
        const bf16_t* A = (const bf16_t*)cur.a; const bf16_t* Bt = (const bf16_t*)cur.b; const int K = cur.nt * 64;
        for (int ai = 0; ai < 2; ++ai) for (int bj = 0; bj < 2; ++bj) for (int m = 0; m < 4; ++m) for (int n = 0; n < 2; ++n) for (int e = 0; e < 4; ++e) {
            const int r = 128 * ai + 64 * wr + 16 * m + fr, c = 128 * bj + 32 * wc + 8 * fq + 4 * n + e; float s = 0.f;
            const bf16_t* ar = A + (size_t)r * lda; const bf16_t* br = Bt + (size_t)c * ldb;
            if (cur.f8) { const unsigned char* a8 = (const unsigned char*)cur.a + (size_t)r * lda8; const unsigned char* b8 = (const unsigned char*)cur.b + (size_t)c * ldb * 2;
                for (int k = 0; k < cur.nt * 128; ++k) s += fp8_dec_(a8[k]) * fp8_dec_(b8[k]); }
#ifdef EMU_FP8_A
            else if (cur.aux == 77) { float am = 0.f; for (int k = 0; k < K; ++k) am = fmaxf(am, fabsf(bf2f(br[k]))); const float sc = am > 0.f ? am / 440.f : 1.f;
                for (int k = 0; k < K; ++k) s += fp8_dec_(fp8_enc_(bf2f(ar[k]))) * fp8_dec_(fp8_enc_(bf2f(br[k]) / sc)); s *= sc; }
#endif
            else for (int k = 0; k < K; ++k) s += bf2f(ar[k]) * bf2f(br[k]);
            acc[ai][bj][m][n][e] = s; }
        __syncthreads();
        E(acc, cur, wr, wc, fr, fq, tid);
        __syncthreads();
    }
    __syncthreads();
}
#endif
}
struct Ptrs {
    bf16_t *WinT, *WbrT, *WoutT, *WqT, *PleT, *PleGT, *GluT, *K12, *S5Kc, *S5Wx, *S5Wy, *Ut, *Vt, *hb, *proj, *merged, *q, *ycat, *vtr, *pb;
    float *S5LL, *gate; int* eid; unsigned char* stash; bf16_t *rwPT, *rwG, *rwS0, *rwQ, *rwGt, *rwRKV; unsigned char *U8, *V8; float *su, *sv, *pd; unsigned* qcnt; unsigned char *h8a, *h8b, *h8e; float *gsc, *gscA;
};
__device__ __forceinline__ Ptrs make_ptrs(unsigned char* ws, int l) {
    Ptrs P; { size_t zoff = 0; OPAQUE_S(zoff); ws += zoff; }
    P.WinT = (bf16_t*)(ws + WS_WIN) + (size_t)l * WIN_ROWS * 1024; P.WbrT = (bf16_t*)(ws + WS_WBR) + (size_t)l * 1024 * 1024; P.WoutT = (bf16_t*)(ws + WS_WOUT) + (size_t)l * 1024 * 1024;
    P.WqT = (bf16_t*)(ws + WS_WQ) + (size_t)l * 2048 * 1024; P.PleT = (bf16_t*)(ws + WS_PLE) + (size_t)l * 1024 * 256; P.PleGT = (bf16_t*)(ws + WS_PLEG) + (size_t)l * 1024 * 1024;
    P.GluT = (bf16_t*)(ws + WS_GLU) + (size_t)l * 256 * 256; P.K12 = (bf16_t*)(ws + WS_K12) + (size_t)l * 2 * 128 * 128;
    P.S5Kc = (bf16_t*)(ws + WS_S5KC) + (size_t)l * 16 * 64 * 256; P.S5Wx = (bf16_t*)(ws + WS_S5WX) + (size_t)l * 16 * 128 * 1024; P.S5Wy = (bf16_t*)(ws + WS_S5WY) + (size_t)l * 16 * 1024 * 128;
    P.S5LL = (float*)(ws + WS_S5LL) + (size_t)l * 16 * 64 * 2;
    P.Ut = (bf16_t*)(ws + WS_UT); P.Vt = (bf16_t*)(ws + WS_VT);
    P.pd = (float*)(ws + WS_R1 + R1_Q); P.qcnt = (unsigned*)(ws + WS_CTL) + 8192 + l * 4 * 8 * 16;
    P.U8 = ws + WS_UT; P.V8 = ws + WS_UT + (size_t)NEXP * 1024; P.su = (float*)(ws + WS_CTL + 131072); P.sv = (float*)(ws + WS_CTL + 131072) + NEXP;
    P.rwGt = (bf16_t*)(ws + WS_VT); P.rwRKV = (bf16_t*)(ws + WS_VT + RW_SZ);
    P.rwPT = (bf16_t*)(ws + WS_RW); P.rwG = (bf16_t*)(ws + WS_RW + RW_SZ); P.rwS0 = (bf16_t*)(ws + WS_RW + 2 * RW_SZ); P.rwQ = (bf16_t*)(ws + WS_RW + 3 * RW_SZ);
    P.hb = (bf16_t*)(ws + WS_HB); P.proj = (bf16_t*)(ws + WS_R1 + R1_PROJ); P.merged = (bf16_t*)(ws + WS_R1 + R1_MERGED); P.q = (bf16_t*)(ws + WS_R1 + R1_Q);
    P.stash = ws + WS_R1 + R1_STASH; P.eid = (int*)(ws + WS_R1 + R1_EID); P.gate = (float*)(ws + WS_R1 + R1_GATE);
    P.ycat = (bf16_t*)(ws + WS_YC); P.vtr = (bf16_t*)(ws + WS_VTR); P.pb = (bf16_t*)(ws + WS_PB);
    P.h8a = ws + WS_R1 + R1_H8; P.h8b = ws + WS_H8T; P.h8e = ws + WS_RW; P.gsc = (float*)(ws + WS_CTL + 262144) + l * 6144; P.gscA = (float*)(ws + WS_CTL + 327680) + l * 2304;
    return P;
}

__device__ __forceinline__ int win_src_col(int n) {
    if (n < 1152) return n;
    if (n < 1664) return n;
    if (n < 1668) return 1920 + (n - 1664);
    if (n < 1792) return -1;
    if (n < 2304) return 1924 + (n - 1792);
    if (n < 2560) return 1664 + (n - 2304);
    return 2436 + (n - 2560);
}
template <bool WINMAP>
__device__ __forceinline__ void transpose_item(const float* src, int sld, bf16_t* dst, int dld, int dcol0, int kb, int nb, float* scr, int lane) {
    const int k0 = 64 * kb, n0 = 32 * nb;
    const int nn = n0 + (lane & 31); const int sc = WINMAP ? win_src_col(nn) : nn;
#pragma unroll 8
    for (int i = 0; i < 32; ++i) { const int kk = 2 * i + (lane >> 5); scr[kk * 33 + (lane & 31)] = (sc >= 0) ? src[(size_t)(k0 + kk) * sld + sc] : 0.f; }
    WAVE_SYNC();
    const int c = lane & 7;
#pragma unroll
    for (int j = 0; j < 4; ++j) { const int n = (lane >> 3) + 8 * j; const float* s = scr + (8 * c) * 33 + n;
        u32x4 o; o.x = pk2(s[0 * 33], s[1 * 33]); o.y = pk2(s[2 * 33], s[3 * 33]); o.z = pk2(s[4 * 33], s[5 * 33]); o.w = pk2(s[6 * 33], s[7 * 33]);
        *(u32x4*)(dst + (size_t)(n0 + n) * dld + dcol0 + k0 + 8 * c) = o; }
    WAVE_SYNC();
}

__device__ __forceinline__ void s5_tables(const KP& p, int l, int g, unsigned char* lds) {
    float* pw = (float*)lds;
    float* bb = pw + 65 * 128;
    float* cc = bb + 64 * 32;
    const int tid = TIDX();
    const Ptrs P = make_ptrs(p.ws, l);
    const float dt = expf(p.in[I_LDT][l * 16 + g]);
    if (tid < 64) { const int pp = tid; const float lr = p.in[I_LRE][(l * 16 + g) * 64 + pp], li = p.in[I_LIM][(l * 16 + g) * 64 + pp];
        const float mag = expf(lr * dt), ang = li * dt; const float br = mag * cosf(ang), bi = mag * sinf(ang);
        float xr = 1.f, xi = 0.f;
        for (int t = 0; t <= 64; ++t) { pw[(t * 64 + pp) * 2] = xr; pw[(t * 64 + pp) * 2 + 1] = xi; const float nr = xr * br - xi * bi, ni = xr * bi + xi * br; xr = nr; xi = ni; }
        const float nr = br - 1.f, ni = bi, den = lr * lr + li * li; const float cr = (nr * lr + ni * li) / den, ci = (ni * lr - nr * li) / den;
        for (int c = 0; c < 16; ++c) { const float b_r = p.in[I_BRE][((l * 16 + g) * 64 + pp) * 16 + c], b_i = p.in[I_BIM][((l * 16 + g) * 64 + pp) * 16 + c];
            bb[(pp * 16 + c) * 2] = cr * b_r - ci * b_i; bb[(pp * 16 + c) * 2 + 1] = cr * b_i + ci * b_r; }
        P.S5LL[(g * 64 + pp) * 2] = pw[(64 * 64 + pp) * 2]; P.S5LL[(g * 64 + pp) * 2 + 1] = pw[(64 * 64 + pp) * 2 + 1];
    }
    for (int e = tid; e < 1024; e += NTHR) { const int c = e >> 6, pp = e & 63; cc[e * 2] = p.in[I_CRE][((l * 16 + g) * 16 + c) * 64 + pp]; cc[e * 2 + 1] = p.in[I_CIM][((l * 16 + g) * 16 + c) * 64 + pp]; }
    __syncthreads();
    bf16_t* Kc = P.S5Kc + (size_t)g * 64 * 256;
    for (int e = tid; e < 64 * 256; e += NTHR) { const int tau = e >> 8, co = (e >> 4) & 15, ci = e & 15; float s = 0.f;
        for (int pp = 0; pp < 64; ++pp) { const float c_r = cc[(co * 64 + pp) * 2], c_i = cc[(co * 64 + pp) * 2 + 1], w_r = pw[(tau * 64 + pp) * 2], w_i = pw[(tau * 64 + pp) * 2 + 1];
            const float t_r = c_r * w_r - c_i * w_i, t_i = c_r * w_i + c_i * w_r; s += t_r * bb[(pp * 16 + ci) * 2] - t_i * bb[(pp * 16 + ci) * 2 + 1]; }
        Kc[e] = (bf16_t)f2bf(s); }
    bf16_t* Wx = P.S5Wx + (size_t)g * 128 * 1024;
    for (int e = tid; e < 128 * 1024; e += NTHR) { const int n = e >> 10, k = e & 1023, pp = n >> 1, ri = n & 1, s = k >> 4, ci = k & 15;
        const float w_r = pw[((63 - s) * 64 + pp) * 2], w_i = pw[((63 - s) * 64 + pp) * 2 + 1], b_r = bb[(pp * 16 + ci) * 2], b_i = bb[(pp * 16 + ci) * 2 + 1];
        Wx[e] = (bf16_t)f2bf(ri ? (w_r * b_i + w_i * b_r) : (w_r * b_r - w_i * b_i)); }
    bf16_t* Wy = P.S5Wy + (size_t)g * 1024 * 128;
    for (int e = tid; e < 1024 * 128; e += NTHR) { const int n = e >> 7, k = e & 127, t = n >> 4, co = n & 15, pp = k >> 1, ri = k & 1;
        const float c_r = cc[(co * 64 + pp) * 2], c_i = cc[(co * 64 + pp) * 2 + 1], w_r = pw[((t + 1) * 64 + pp) * 2], w_i = pw[((t + 1) * 64 + pp) * 2 + 1];
        Wy[e] = (bf16_t)f2bf(ri ? -(c_r * w_i + c_i * w_r) : (c_r * w_r - c_i * w_i)); }
    __syncthreads();
}

__device__ __forceinline__ void ln_row(const float* src, const float* g, const float* b, float* dst, bf16_t* dstb, int lane) {
    f32x4 v[4]; float s = 0.f;
#pragma unroll
    for (int j = 0; j < 4; ++j) { v[j] = *(const f32x4*)(src + 256 * j + 4 * lane); s += (v[j].x + v[j].y) + (v[j].z + v[j].w); }
    const float mean = wave_sum(s) * (1.f / 1024.f); float s2 = 0.f;
#pragma unroll
    for (int j = 0; j < 4; ++j) { v[j] = v[j] - mean; s2 += (v[j].x * v[j].x + v[j].y * v[j].y) + (v[j].z * v[j].z + v[j].w * v[j].w); }
    const float rstd = 1.f / sqrtf(wave_sum(s2) * (1.f / 1024.f) + LN_EPS_);
#pragma unroll
    for (int j = 0; j < 4; ++j) { const f32x4 gg = *(const f32x4*)(g + 256 * j + 4 * lane), bv = *(const f32x4*)(b + 256 * j + 4 * lane);
        const f32x4 o = v[j] * rstd * gg + bv; *(f32x4*)(dst + 256 * j + 4 * lane) = o;
        if (dstb) { u32x2 w; w.x = pk2(o.x, o.y); w.y = pk2(o.z, o.w); *(u32x2*)(dstb + 256 * j + 4 * lane) = w; } }
}

template <int NR, bool SB = false>
__device__ __forceinline__ void ln_rows(const void* srcv, const float* g, const float* b, float* dst, bf16_t* dstb, unsigned char* d8, int lane) {
    f32x4 v[NR][4]; float s[NR], s2[NR];
#pragma unroll
    for (int r = 0; r < NR; ++r) { s[r] = 0.f;
#pragma unroll
        for (int j = 0; j < 4; ++j) {
            if (SB) { const u32x2 w = *(const u32x2*)((const bf16_t*)srcv + (size_t)r * 1024 + 256 * j + 4 * lane); v[r][j] = (f32x4){bflo(w.x), bfhi(w.x), bflo(w.y), bfhi(w.y)}; }
            else v[r][j] = *(const f32x4*)((const float*)srcv + (size_t)r * 1024 + 256 * j + 4 * lane);
            s[r] += (v[r][j].x + v[r][j].y) + (v[r][j].z + v[r][j].w); } }
    wave_sum_n<NR>(s);
#pragma unroll
    for (int r = 0; r < NR; ++r) { const float mean = s[r] * (1.f / 1024.f); s2[r] = 0.f;
#pragma unroll
        for (int j = 0; j < 4; ++j) { v[r][j] = v[r][j] - mean; s2[r] += (v[r][j].x * v[r][j].x + v[r][j].y * v[r][j].y) + (v[r][j].z * v[r][j].z + v[r][j].w * v[r][j].w); } }
    wave_sum_n<NR>(s2);
#pragma unroll
    for (int j = 0; j < 4; ++j) { const f32x4 gg = *(const f32x4*)(g + 256 * j + 4 * lane), bv = *(const f32x4*)(b + 256 * j + 4 * lane);
#pragma unroll
        for (int r = 0; r < NR; ++r) { const float rstd = 1.f / sqrtf(s2[r] * (1.f / 1024.f) + LN_EPS_);
            const f32x4 o = v[r][j] * rstd * gg + bv; if (dst) *(f32x4*)(dst + (size_t)r * 1024 + 256 * j + 4 * lane) = o;
            if (dstb) { u32x2 w; w.x = pk2(o.x, o.y); w.y = pk2(o.z, o.w); *(u32x2*)(dstb + (size_t)r * 1024 + 256 * j + 4 * lane) = w; }
            if (d8) { unsigned w8 = cvt_pk_fp8_f32_(o.x, o.y, 0u, false); w8 = cvt_pk_fp8_f32_(o.z, o.w, w8, true); *(unsigned*)(d8 + (size_t)r * 1024 + 256 * j + 4 * lane) = w8; } } }
}
__device__ __forceinline__ void phase_prologue(const KP& p, unsigned char* lds) {
    const int tid = TIDX(), lane = tid & 63, wave = tid >> 6;
    int G = GDIM(), bid = BIDX();
    for (int it = bid; it < L_ * 16; it += G) s5_tables(p, it >> 4, it & 15, lds);
    if (G >= 4 * L_ * 16) { if (bid < L_ * 16) return; bid -= L_ * 16; G -= L_ * 16; }
    float* scr = (float*)lds + wave * (64 * 33 + 16);
    const int gw = bid * NWAVE + wave, NGW = G * NWAVE;
    constexpr int I_WINT = (WIN_ROWS / 32) * 16, I_BR = 4 * 4 * 32, I_OUT = 16 * 32, I_Q = 16 * 64, I_PL = 4 * 32, I_PG = 16 * 32, I_GL = 4 * 8;
    constexpr int PER_L = I_WINT + I_BR + I_OUT + I_Q + I_PL + I_PG + I_GL;
    for (int it = gw; it < L_ * PER_L; it += NGW) {
        const int l = it / PER_L; int r = it % PER_L; const Ptrs P = make_ptrs(p.ws, l);
        if (r < I_WINT) { transpose_item<true>(p.in[I_WIN] + (size_t)l * 1024 * IN_COLS, IN_COLS, P.WinT, 1024, 0, r & 15, r >> 4, scr, lane); continue; } r -= I_WINT;
        if (r < I_BR) { const int b = r >> 7, rr = r & 127; transpose_item<false>(p.in[I_WBR] + ((size_t)l * 4 + b) * 256 * 1024, 1024, P.WbrT, 1024, 256 * b, rr & 3, rr >> 2, scr, lane); continue; } r -= I_BR;
        if (r < I_OUT) { transpose_item<false>(p.in[I_WOUT] + (size_t)l * 1024 * 1024, 1024, P.WoutT, 1024, 0, r & 15, r >> 4, scr, lane); continue; } r -= I_OUT;
        if (r < I_Q) { transpose_item<false>(p.in[I_WQ] + (size_t)l * 1024 * 2048, 2048, P.WqT, 1024, 0, r & 15, r >> 4, scr, lane); continue; } r -= I_Q;
        if (r < I_PL) { transpose_item<false>(p.in[I_PLEW] + (size_t)l * 256 * 1024, 1024, P.PleT, 256, 0, r & 3, r >> 2, scr, lane); continue; } r -= I_PL;
        if (r < I_PG) { transpose_item<false>(p.in[I_PLEG] + (size_t)l * 1024 * 1024, 1024, P.PleGT, 1024, 0, r & 15, r >> 4, scr, lane); continue; } r -= I_PG;
        transpose_item<false>(p.in[I_GLUW] + (size_t)l * 256 * 256, 256, P.GluT, 256, 0, r & 3, r >> 2, scr, lane);
    }
    const size_t gt = (size_t)bid * NTHR + tid, NGT = (size_t)G * NTHR;
    { bf16_t* K12 = (bf16_t*)(p.ws + WS_K12);
      for (size_t i = gt; i < (size_t)L_ * 2 * 16384 / 8; i += NGT) { const size_t e = i * 8; const int l = (int)(e / 32768), r = (int)(e % 32768); const float* s = (r < 16384 ? p.in[I_K1] : p.in[I_K2]) + (size_t)l * 16384 + (r & 16383);
        const f32x4 a = *(const f32x4*)s, b = *(const f32x4*)(s + 4); u32x4 o; o.x = pk2(a.x, a.y); o.y = pk2(a.z, a.w); o.z = pk2(b.x, b.y); o.w = pk2(b.z, b.w); *(u32x4*)(K12 + e) = o; } }
    { bf16_t* hb = (bf16_t*)(p.ws + WS_HB);
      unsigned char* h8a = p.ws + WS_R1 + R1_H8; unsigned char* h8b = p.ws + WS_H8T;
      for (int m = 4 * gw; m < T_; m += 4 * NGW) ln_rows<4>(p.in[I_X] + (size_t)m * 1024, p.in[I_LNIN_G], p.in[I_LNIN_B], (float*)nullptr, hb + (size_t)m * 1024, m < H8_SPLIT ? h8a + (size_t)m * 1024 : h8b + (size_t)(m - H8_SPLIT) * 1024, lane); }
}
__device__ __forceinline__ void conv_unit(const KP& p, const Ptrs& P, int l, int unit, unsigned char* lds) {
    bf16_t* hbuf = (bf16_t*)lds;
    float* obuf = (float*)(lds + 94 * 256 * 2);
    const int tid = TIDX(), lane = tid & 63, wave = tid >> 6;
    const int tiles_per_seq = S_ / 64, b = unit / tiles_per_seq, t0 = (unit % tiles_per_seq) * 64;
    for (int e = tid; e < 94 * 32; e += NTHR) { const int r = e >> 5, c8 = (e & 31) * 8; const int t = t0 - 30 + r;
        u32x4 o = (u32x4){0u, 0u, 0u, 0u};
        if (t >= 0) { const bf16_t* row = P.proj + (size_t)(b * S_ + t) * PJ; const u32x4 v = *(const u32x4*)(row + C_CV + c8), g = *(const u32x4*)(row + C_CG + c8);
            o.x = pk2(bflo(v.x) * sigmoidf_(bflo(g.x)), bfhi(v.x) * sigmoidf_(bfhi(g.x))); o.y = pk2(bflo(v.y) * sigmoidf_(bflo(g.y)), bfhi(v.y) * sigmoidf_(bfhi(g.y)));
            o.z = pk2(bflo(v.z) * sigmoidf_(bflo(g.z)), bfhi(v.z) * sigmoidf_(bfhi(g.z))); o.w = pk2(bflo(v.w) * sigmoidf_(bflo(g.w)), bfhi(v.w) * sigmoidf_(bfhi(g.w))); }
        *(u32x4*)(hbuf + r * 256 + c8) = o; }
    __syncthreads();
    { const int c = tid & 255, half = tid >> 8; float w[31], x[62];
#pragma unroll
      for (int j = 0; j < 31; ++j) w[j] = p.in[I_CONVW][(l * 31 + j) * 256 + c];
      const float cb = p.in[I_CONVB][l * 256 + c];
#pragma unroll
      for (int j = 0; j < 62; ++j) x[j] = bf2f(hbuf[(half * 32 + j) * 256 + c]);
#pragma unroll
      for (int tt = 0; tt < 32; ++tt) { float s = cb;
#pragma unroll
          for (int j = 0; j < 31; ++j) s += w[j] * x[tt + j];
          obuf[(half * 32 + tt) * 256 + c] = s; } }
    __syncthreads();
    { const f32x4 g = *(const f32x4*)(p.in[I_CLNG] + l * 256 + 4 * lane), bb = *(const f32x4*)(p.in[I_CLNB] + l * 256 + 4 * lane);
      f32x4 vv[8]; float m1[8], m2[8];
#pragma unroll
      for (int i = 0; i < 8; ++i) { vv[i] = *(const f32x4*)(obuf + (wave * 8 + i) * 256 + 4 * lane); m1[i] = (vv[i].x + vv[i].y) + (vv[i].z + vv[i].w); }
      wave_sum_n<8>(m1);
#pragma unroll
      for (int i = 0; i < 8; ++i) { vv[i] = vv[i] - m1[i] * (1.f / 256.f); m2[i] = (vv[i].x * vv[i].x + vv[i].y * vv[i].y) + (vv[i].z * vv[i].z + vv[i].w * vv[i].w); }
      wave_sum_n<8>(m2);
#pragma unroll
      for (int i = 0; i < 8; ++i) { const int t = wave * 8 + i; const float rstd = 1.f / sqrtf(m2[i] * (1.f / 256.f) + LN_EPS_);
          f32x4 z = vv[i] * rstd * g + bb; u32x2 w; w.x = pk2(z.x * sigmoidf_(z.x), z.y * sigmoidf_(z.y)); w.y = pk2(z.z * sigmoidf_(z.z), z.w * sigmoidf_(z.w));
          *(u32x2*)(P.ycat + (size_t)(b * S_ + t0 + t) * 1024 + 768 + 4 * lane) = w; } }
    __syncthreads();
}

constexpr int S5_NCH = S_ / 64;
constexpr int S5_UPITCH = 1032;
constexpr int S5_XPITCH = 136;
__device__ __forceinline__ void s5_unit(const KP& p, const Ptrs& P, int l, int unit, unsigned char* lds) {
    const int b = unit >> 4, g = unit & 15;
    bf16_t* Uc = (bf16_t*)lds;
    bf16_t* Kc = (bf16_t*)(lds + 66048);
    float* Xe = (float*)(lds + 66048 + 32768);
    bf16_t* Xs = (bf16_t*)(lds + 66048 + 65536);
    const int tid = TIDX(), lane = tid & 63, wave = tid >> 6, r32 = lane & 31, hi = lane >> 5;
    { u32x4 v[8], kc[4];
#pragma unroll
      for (int j = 0; j < 8; ++j) { const int e = tid + j * NTHR, s = e >> 1, hf = e & 1; v[j] = (u32x4){0u, 0u, 0u, 0u};
          if (s < S_) v[j] = *(const u32x4*)(P.proj + (size_t)(b * S_ + s) * PJ + C_S5 + 16 * g + 8 * hf); }
#pragma unroll
      for (int j = 0; j < 4; ++j) kc[j] = *(const u32x4*)(P.S5Kc + (size_t)g * 16384 + (tid + j * NTHR) * 8);
#pragma unroll
      for (int j = 0; j < 8; ++j) { const int e = tid + j * NTHR, s = e >> 1, hf = e & 1; *(u32x4*)(Uc + (s >> 6) * S5_UPITCH + (s & 63) * 16 + 8 * hf) = v[j]; }
#pragma unroll
      for (int j = 0; j < 4; ++j) *(u32x4*)(Kc + (tid + j * NTHR) * 8) = kc[j]; }
    __syncthreads();
    { const int ntile = wave & 3, kh = wave >> 2; f32x16 acc = {};
      const bf16_t* wrow = P.S5Wx + ((size_t)g * 128 + ntile * 32 + r32) * 1024 + kh * 512 + 8 * hi;
      const bf16_t* urow = Uc + r32 * S5_UPITCH + kh * 512 + 8 * hi;
      for (int k8 = 0; k8 < 32; k8 += 8) { bf16x8 bw[8];
#pragma unroll
          for (int j = 0; j < 8; ++j) bw[j] = *(const bf16x8*)(wrow + (k8 + j) * 16);
#pragma unroll
          for (int j = 0; j < 8; ++j) { const bf16x8 a = *(const bf16x8*)(urow + (k8 + j) * 16); acc = MFMA32(a, bw[j], acc); } }
#pragma unroll
      for (int r = 0; r < 16; ++r) { const int c = (r & 3) + 8 * (r >> 2) + 4 * hi; Xe[(kh * 32 + c) * 128 + ntile * 32 + r32] = acc[r]; } }
    __syncthreads();
    if (tid < 64) { const float lr = P.S5LL[(g * 64 + tid) * 2], li = P.S5LL[(g * 64 + tid) * 2 + 1]; float xr = 0.f, xi = 0.f;
        for (int c = 0; c < 32; ++c) { Xs[c * S5_XPITCH + 2 * tid] = (bf16_t)f2bf(xr); Xs[c * S5_XPITCH + 2 * tid + 1] = (bf16_t)f2bf(xi);
            const float er = Xe[c * 128 + 2 * tid] + Xe[(32 + c) * 128 + 2 * tid], ei = Xe[c * 128 + 2 * tid + 1] + Xe[(32 + c) * 128 + 2 * tid + 1];
            const float nr = lr * xr - li * xi + er, ni = lr * xi + li * xr + ei; xr = nr; xi = ni; } }
    __syncthreads();
    { const int tt = r32 >> 4, co = r32 & 15; const float dsk = p.in[I_S5D][l * 256 + 16 * g + co];
      for (int q = 0; q < 4; ++q) { const int ntile = wave + 8 * q, t0 = 2 * ntile; f32x16 acc = {};
          const bf16_t* urow = Uc + r32 * S5_UPITCH + 8 * hi;
          for (int s = 0; s <= t0 + 1; ++s) { const int tau = t0 + tt - s; bf16x8 bk = (bf16x8){0, 0, 0, 0, 0, 0, 0, 0};
              if (tau >= 0) bk = *(const bf16x8*)(Kc + (tau * 16 + co) * 16 + 8 * hi);
              const bf16x8 a = *(const bf16x8*)(urow + s * 16); acc = MFMA32(a, bk, acc); }
          const bf16_t* wy = P.S5Wy + ((size_t)g * 1024 + ntile * 32 + r32) * 128 + 8 * hi; const bf16_t* xrow = Xs + r32 * S5_XPITCH + 8 * hi;
#pragma unroll
          for (int ks = 0; ks < 8; ++ks) { const bf16x8 a = *(const bf16x8*)(xrow + ks * 16); const bf16x8 bw = *(const bf16x8*)(wy + ks * 16); acc = MFMA32(a, bw, acc); }
#pragma unroll
          for (int r = 0; r < 16; ++r) { const int c = (r & 3) + 8 * (r >> 2) + 4 * hi; const int s = c * 64 + t0 + tt;
              if (s < S_) { const float uu = bf2f(Uc[c * S5_UPITCH + (t0 + tt) * 16 + co]); const float y = acc[r] + dsk * uu;
                  P.ycat[(size_t)(b * S_ + s) * 1024 + 256 + 16 * g + co] = (bf16_t)f2bf(gelu_erf(y)); } } } }
    __syncthreads();
}
constexpr float LOG2E_ = 1.4426950408889634f;
__device__ __forceinline__ float log_sigmoid_(float x) { return fminf(x, 0.f) - log1pf(__expf(-fabsf(x))); }
__device__ __forceinline__ void fox_unit(const KP& p, const Ptrs& P, int l, int unit, unsigned char* lds) {
    constexpr int NQB = S_ / 256;
    const int bh = unit / NQB, qb = (unit >= (NB_ * 4 * NQB) / 2) ? NQB - 1 - unit % NQB : unit % NQB, b = bh >> 2, h = bh & 3, q0 = qb * 256;
    float* cl = (float*)lds;
    unsigned char* Kt = lds + S_ * 4;
    unsigned char* Vt = Kt + 8192;
    float* wsf = (float*)(Kt + 32768);
    float* sc = wsf + 256;
    const int tid = TIDX(), lane = tid & 63, wave = tid >> 6, r32 = lane & 31, hi = lane >> 5;
    const int qend = q0 + 256;
    { constexpr int PER = (S_ + 511) / 512; const float bf = p.in[I_BF][l * 4 + h]; float loc[PER]; float s = 0.f;
#pragma unroll
      for (int i = 0; i < PER; ++i) { const int t = tid * PER + i; float v = 0.f;
          if (t < qend) v = log_sigmoid_(bf2f(P.proj[(size_t)(b * S_ + t) * PJ + C_FL + h]) + bf) * LOG2E_;
          s += v; loc[i] = s; }
      sc[tid] = s; __syncthreads();
      for (int off = 1; off < 512; off <<= 1) { const float v = sc[tid] + (tid >= off ? sc[tid - off] : 0.f); __syncthreads(); sc[tid] = v; __syncthreads(); }
      const float base = sc[tid] - s;
#pragma unroll
      for (int i = 0; i < PER; ++i) { const int t = tid * PER + i; if (t < S_) cl[t] = base + loc[i]; }
      __syncthreads(); }
    const int qrow = q0 + 32 * wave + r32;
    constexpr float C2 = 0.125f * LOG2E_;
    bf16x8 qr[4];
    { const bf16_t* qp = P.proj + (size_t)(b * S_ + qrow) * PJ + C_FQ + 64 * h + 8 * hi;
#pragma unroll
      for (int d0 = 0; d0 < 4; ++d0) { const u32x4 w = *(const u32x4*)(qp + 16 * d0);
          u32x4 o; o.x = pk2(bflo(w.x) * C2, bfhi(w.x) * C2); o.y = pk2(bflo(w.y) * C2, bfhi(w.y) * C2); o.z = pk2(bflo(w.z) * C2, bfhi(w.z) * C2); o.w = pk2(bflo(w.w) * C2, bfhi(w.w) * C2);
          qr[d0] = __builtin_bit_cast(bf16x8, o); } }
    const float clq = cl[qrow];
    float mrun = -INFINITY, lrun = 0.f; f32x16 o0 = {}, o1 = {};
    const int NT = qend / 64;
    const int srow = tid >> 3, sch = tid & 7;
    const bf16_t* kg = P.proj + (size_t)(b * S_ + srow) * PJ + C_FK + 64 * h + 8 * sch;
    const bf16_t* vg = P.vtr + (size_t)(64 * h + srow) * T_ + (size_t)b * S_ + 8 * sch;
    const int koff = srow * 128 + ((sch ^ ((srow >> 1) & 7)) * 16);
    const int voffa = srow * 128 + (((2 * sch) ^ ((srow >> 1) & 15)) * 8), voffb = srow * 128 + (((2 * sch + 1) ^ ((srow >> 1) & 15)) * 8);
    u32x4 kreg = *(const u32x4*)kg, vreg = *(const u32x4*)vg;
    *(u32x4*)(Kt + koff) = kreg; *(u32x2*)(Vt + voffa) = (u32x2){vreg.x, vreg.y}; *(u32x2*)(Vt + voffb) = (u32x2){vreg.z, vreg.w};
    if (NT > 1) { kreg = *(const u32x4*)(kg + (size_t)64 * PJ); vreg = *(const u32x4*)(vg + 64); }
    __syncthreads();
    for (int jt = 0; jt < NT; ++jt) {
        const int kv0 = jt * 64; const unsigned char* Kb = Kt + (jt & 1) * 16384; const unsigned char* Vb = Vt + (jt & 1) * 16384;
        if (kv0 <= q0 + 32 * wave + 31) {
            f32x16 pt[2];
#pragma unroll
            for (int kvt = 0; kvt < 2; ++kvt) { const int row = 32 * kvt + r32; f32x16 acc;
#pragma unroll
                for (int g4 = 0; g4 < 4; ++g4) { const f32x4 c4 = *(const f32x4*)(cl + kv0 + 32 * kvt + 8 * g4 + 4 * hi);
#pragma unroll
                    for (int e = 0; e < 4; ++e) acc[4 * g4 + e] = clq - c4[e]; }
#pragma unroll
                for (int d0 = 0; d0 < 4; ++d0) { const bf16x8 a = *(const bf16x8*)(Kb + row * 128 + (((2 * d0 + hi) ^ ((row >> 1) & 7)) * 16)); acc = MFMA32(a, qr[d0], acc); }
                pt[kvt] = acc; }
            if (kv0 + 63 > q0 + 32 * wave) {
#pragma unroll
                for (int kvt = 0; kvt < 2; ++kvt)
#pragma unroll
                    for (int r = 0; r < 16; ++r) { const int key = kv0 + 32 * kvt + (r & 3) + 8 * (r >> 2) + 4 * hi; if (key > qrow) pt[kvt][r] = -INFINITY; } }
            float mx = -INFINITY;
#pragma unroll
            for (int kvt = 0; kvt < 2; ++kvt)
#pragma unroll
                for (int r = 0; r < 16; ++r) mx = fmaxf(mx, pt[kvt][r]);
            mx = fmaxf(mx, __shfl_xor(mx, 32));
            const float mnew = fmaxf(mrun, mx), alpha = FAST_EXP2(mrun - mnew); mrun = mnew;
            float ls = 0.f;
#pragma unroll
            for (int kvt = 0; kvt < 2; ++kvt)
#pragma unroll
                for (int r = 0; r < 16; ++r) { const float e = FAST_EXP2(pt[kvt][r] - mnew); pt[kvt][r] = e; ls += e; }
            lrun = lrun * alpha + ls;
            float* wf = wsf + wave * 32;
            WAVE_SYNC(); if (hi == 0) wf[r32] = alpha; WAVE_SYNC();
#pragma unroll
            for (int g4 = 0; g4 < 4; ++g4) { const f32x4 f = *(const f32x4*)(wf + 8 * g4 + 4 * hi);
#pragma unroll
                for (int e = 0; e < 4; ++e) { o0[4 * g4 + e] *= f[e]; o1[4 * g4 + e] *= f[e]; } }
#pragma unroll
            for (int s = 0; s < 4; ++s) { const int kvt = s >> 1, rb = 8 * (s & 1);
                u32x4 pw; pw.x = pk2(pt[kvt][rb + 0], pt[kvt][rb + 1]); pw.y = pk2(pt[kvt][rb + 2], pt[kvt][rb + 3]); pw.z = pk2(pt[kvt][rb + 4], pt[kvt][rb + 5]); pw.w = pk2(pt[kvt][rb + 6], pt[kvt][rb + 7]);
                const bf16x8 pa = __builtin_bit_cast(bf16x8, pw);
#pragma unroll
                for (int dt = 0; dt < 2; ++dt) { const int d = 32 * dt + r32; const int sw = (d >> 1) & 15;
                    const u32x2 va = *(const u32x2*)(Vb + d * 128 + (((4 * s + hi) ^ sw) * 8)), vb = *(const u32x2*)(Vb + d * 128 + (((4 * s + 2 + hi) ^ sw) * 8));
                    const bf16x8 vf = __builtin_bit_cast(bf16x8, (u32x4){va.x, va.y, vb.x, vb.y});
                    if (dt == 0) o0 = MFMA32(pa, vf, o0); else o1 = MFMA32(pa, vf, o1); } }
        }
        if (jt + 1 < NT) { unsigned char* Kn = Kt + ((jt + 1) & 1) * 16384; unsigned char* Vn = Vt + ((jt + 1) & 1) * 16384;
            *(u32x4*)(Kn + koff) = kreg; *(u32x2*)(Vn + voffa) = (u32x2){vreg.x, vreg.y}; *(u32x2*)(Vn + voffb) = (u32x2){vreg.z, vreg.w};
            if (jt + 2 < NT) { kreg = *(const u32x4*)(kg + (size_t)(kv0 + 128) * PJ); vreg = *(const u32x4*)(vg + kv0 + 128); } }
        __syncthreads();
    }
    { const float lt = lrun + __shfl_xor(lrun, 32); float* wf = wsf + wave * 32;
      WAVE_SYNC(); if (hi == 0) wf[r32] = 1.0f / lt; WAVE_SYNC();
      bf16_t* orow = P.ycat + (size_t)(b * S_ + q0 + 32 * wave) * 1024 + 512 + 64 * h + r32;
#pragma unroll
      for (int r = 0; r < 16; ++r) { const int qq = (r & 3) + 8 * (r >> 2) + 4 * hi; const float f = wf[qq];
          orow[(size_t)qq * 1024] = (bf16_t)f2bf(o0[r] * f); orow[(size_t)qq * 1024 + 32] = (bf16_t)f2bf(o1[r] * f); } }
    __syncthreads();
}

constexpr int RW_NCH = S_ / 64;
constexpr int RWP = 72;
constexpr int RW_ARR = 64 * RWP * 2;
constexpr int RW_SCRP = 388;
__device__ __forceinline__ void rw_stage_weights(const KP& p, int l, int h, bf16_t* wb, int tid) {
    for (int e = tid; e < 2048; e += NTHR) { const int m = e >> 4, c4 = (e & 15) * 4;
        if (m < 32) { const f32x4 v = *(const f32x4*)(p.in[I_A2] + (l * 32 + m) * 256 + 64 * h + c4);
#pragma unroll
            for (int q = 0; q < 4; ++q) wb[(c4 + q) * 40 + m] = (bf16_t)f2bf(v[q]); }
        else if (m < 64) { const f32x4 v = *(const f32x4*)(p.in[I_W2] + (l * 32 + m - 32) * 256 + 64 * h + c4);
#pragma unroll
            for (int q = 0; q < 4; ++q) wb[2560 + (c4 + q) * 40 + (m - 32)] = (bf16_t)f2bf(v[q]); }
        else { const f32x4 v = *(const f32x4*)(p.in[I_G2] + (l * 64 + m - 64) * 256 + 64 * h + c4);
#pragma unroll
            for (int q = 0; q < 4; ++q) wb[5120 + (c4 + q) * 72 + (m - 64)] = (bf16_t)f2bf(v[q]); } }
    __syncthreads();
}
__device__ __forceinline__ bf16x8 rw_pack8(const float* q) { const f32x4 a = *(const f32x4*)q, b = *(const f32x4*)(q + 4);
    u32x4 w; w.x = pk2(a.x, a.y); w.y = pk2(a.z, a.w); w.z = pk2(b.x, b.y); w.w = pk2(b.z, b.w); return __builtin_bit_cast(bf16x8, w); }
template <int NT, bool NEED_W, bool NEED_G>
__device__ __forceinline__ void rw_prep(const KP& p, const Ptrs& P, int l, int b, int h, int tpos0, float* scr, const bf16_t* wb, int lane,
                                        float (&r)[NT], float (&lw)[NT], float (&k2)[NT], float (&v)[NT], float (&ain)[NT], float (&bin)[NT], float (&g)[NT], float (&rk)[NT]) {
    constexpr int NIT = (NT * 40 + 63) / 64;
    u32x4 cur[NIT], prv[NIT];
#pragma unroll
    for (int i = 0; i < NIT; ++i) { const int e = lane + 64 * i; const int tt = e / 40, ch = e % 40; const int t = tpos0 + tt;
        const int col = ch < 8 ? C_R + 64 * h + 8 * ch : ch < 16 ? C_K + 64 * h + 8 * (ch - 8) : ch < 24 ? C_V + 64 * h + 8 * (ch - 16) : C_HW + 8 * (ch - 24);
        cur[i] = (u32x4){0u, 0u, 0u, 0u}; prv[i] = (u32x4){0u, 0u, 0u, 0u};
        if (e < NT * 40) { const bf16_t* row = P.proj + (size_t)(b * S_ + t) * PJ + col; cur[i] = *(const u32x4*)row; if (t > 0) prv[i] = *(const u32x4*)(row - PJ); } }
#pragma unroll
    for (int i = 0; i < NIT; ++i) { const int e = lane + 64 * i; const int tt = e / 40, ch = e % 40;
        const int col = ch < 8 ? C_R + 64 * h + 8 * ch : ch < 16 ? C_K + 64 * h + 8 * (ch - 8) : ch < 24 ? C_V + 64 * h + 8 * (ch - 16) : C_HW + 8 * (ch - 24);
        const int idx = ch < 24 ? 8 * ch : 192 + 8 * (ch - 24);
        if (e < NT * 40) { const f32x4 m0 = *(const f32x4*)(p.in[I_MU] + l * 896 + col), m1 = *(const f32x4*)(p.in[I_MU] + l * 896 + col + 4);
            float z[8] = {bflo(cur[i].x), bfhi(cur[i].x), bflo(cur[i].y), bfhi(cur[i].y), bflo(cur[i].z), bfhi(cur[i].z), bflo(cur[i].w), bfhi(cur[i].w)};
            const float zp[8] = {bflo(prv[i].x), bfhi(prv[i].x), bflo(prv[i].y), bfhi(prv[i].y), bflo(prv[i].z), bfhi(prv[i].z), bflo(prv[i].w), bfhi(prv[i].w)};
#pragma unroll
            for (int q = 0; q < 8; ++q) { float zs = z[q] + (zp[q] - z[q]) * (q < 4 ? m0[q & 3] : m1[q & 3]);
                if (ch >= 24 && ch < 28) zs = 1.0f - 2.0f * FAST_RCP(1.0f + FAST_EXP2(zs * 2.8853900817779268f));
                else if (ch >= 32) zs = sigmoidf_(zs);
                z[q] = zs; }
            *(f32x4*)(scr + tt * RW_SCRP + idx) = (f32x4){z[0], z[1], z[2], z[3]}; *(f32x4*)(scr + tt * RW_SCRP + idx + 4) = (f32x4){z[4], z[5], z[6], z[7]}; } }
    WAVE_SYNC();
    { const int fr = lane & 15, fq = lane >> 4; const float* hrow = scr + (fr & 7) * RW_SCRP + 192 + 8 * fq;
      const bf16x8 fw = rw_pack8(hrow), fa = rw_pack8(hrow + 32), fg0 = rw_pack8(hrow + 64), fg1 = rw_pack8(hrow + 96);
      WAVE_SYNC();
#pragma unroll
      for (int nt = 0; nt < 4; ++nt) { const f32x4 z4 = (f32x4){0.f, 0.f, 0.f, 0.f};
          const f32x4 da = MFMA16(fa, *(const bf16x8*)(wb + (16 * nt + fr) * 40 + 8 * fq), z4);
          f32x4 dw = z4, dg = z4;
          if (NEED_W) dw = MFMA16(fw, *(const bf16x8*)(wb + 2560 + (16 * nt + fr) * 40 + 8 * fq), z4);
          if (NEED_G) { dg = MFMA16(fg0, *(const bf16x8*)(wb + 5120 + (16 * nt + fr) * 72 + 8 * fq), z4); dg = MFMA16(fg1, *(const bf16x8*)(wb + 5120 + (16 * nt + fr) * 72 + 32 + 8 * fq), dg); }
          if (fq < 2) {
#pragma unroll
              for (int q = 0; q < 4; ++q) { float* o = scr + (4 * fq + q) * RW_SCRP + 16 * nt + fr; o[192] = da[q]; if (NEED_W) o[256] = dw[q]; if (NEED_G) o[320] = dg[q]; } } }
      WAVE_SYNC(); }
    const int j = lane, cj = 64 * h + j; float wl[NT], al[NT], gg[NT];
    const float w0 = p.in[I_W0][l * 256 + cj], a0 = p.in[I_A0][l * 256 + cj];
#pragma unroll
    for (int tt = 0; tt < NT; ++tt) { al[tt] = a0 + scr[tt * RW_SCRP + 192 + j]; wl[tt] = NEED_W ? w0 + scr[tt * RW_SCRP + 256 + j] : w0; gg[tt] = NEED_G ? scr[tt * RW_SCRP + 320 + j] : 0.f; }
    const float kkw = p.in[I_KK][l * 256 + cj], kaw = p.in[I_KA][l * 256 + cj], rkw = p.in[I_RK][l * 256 + cj];
    float ssum[NT], rsum[NT], kkv[NT], av[NT];
#pragma unroll
    for (int tt = 0; tt < NT; ++tt) {
        const float a = sigmoidf_(al[tt]); av[tt] = a;
        const float rr = scr[tt * RW_SCRP + j], k = scr[tt * RW_SCRP + 64 + j], vv = scr[tt * RW_SCRP + 128 + j];
        const float kk2 = k * (1.f + (a - 1.f) * kaw);
        r[tt] = rr; k2[tt] = kk2; v[tt] = vv;
        const float kk = k * kkw; kkv[tt] = kk; ssum[tt] = kk * kk; rsum[tt] = rr * kk2 * rkw; }
    if (NEED_W) wave_sum_n<NT>(ssum);
    if (NEED_G) wave_sum_n<NT>(rsum);
#pragma unroll
    for (int tt = 0; tt < NT; ++tt) {
        if (NEED_W) { const float x = -wl[tt]; const float sp = fmaxf(x, 0.f) + 0.6931471805599453f * FAST_LOG2(1.0f + FAST_EXP2(-1.4426950408889634f * fabsf(x)));
            lw[tt] = -FAST_EXP2(-1.4426950408889634f * (sp + 0.5f));
            const float kkn = kkv[tt] * FAST_RSQ(fmaxf(ssum[tt], 1e-24f));
            ain[tt] = -kkn; bin[tt] = kkn * av[tt]; }
        if (NEED_G) { g[tt] = gg[tt]; rk[tt] = rsum[tt]; }
    }
    WAVE_SYNC();
}
__device__ __forceinline__ bf16x8 ldsb8(const bf16_t* p) { return *(const bf16x8*)p; }
__device__ __forceinline__ f32x16 rw_tile(const bf16_t* X, const bf16_t* Y, int tm, int tn, int r32, int hi, f32x16 acc) {
    const bf16_t* xa = X + (32 * tm + r32) * RWP + 8 * hi; const bf16_t* yb = Y + (32 * tn + r32) * RWP + 8 * hi;
#pragma unroll
    for (int ks = 0; ks < 4; ++ks) acc = MFMA32(ldsb8(xa + 16 * ks), ldsb8(yb + 16 * ks), acc);
    return acc;
}
template <int STOP = 0>
__device__ __forceinline__ void rw_chunk_unit(const KP& p, const Ptrs& P, int l, int unit, unsigned char* lds) {
    MEMFENCE(); OPAQUE_S(unit);
    const int c = unit % RW_NCH, bh = unit / RW_NCH, b = bh >> 2, h = bh & 3, t0 = c * 64;
    bf16_t* AT = (bf16_t*)(lds + 0 * RW_ARR); bf16_t* RT = (bf16_t*)(lds + 1 * RW_ARR); bf16_t* BT = (bf16_t*)(lds + 2 * RW_ARR); bf16_t* KT = (bf16_t*)(lds + 3 * RW_ARR);
    bf16_t* BH = (bf16_t*)(lds + 4 * RW_ARR); bf16_t* KH = (bf16_t*)(lds + 5 * RW_ARR); bf16_t* VT = (bf16_t*)(lds + 6 * RW_ARR);
    bf16_t* AAK = (bf16_t*)(lds + 7 * RW_ARR); bf16_t* ARB = (bf16_t*)(lds + 8 * RW_ARR); bf16_t* ARK = (bf16_t*)(lds + 9 * RW_ARR);
    bf16_t* W1T = (bf16_t*)(lds + 10 * RW_ARR); bf16_t* UVT = (bf16_t*)(lds + 11 * RW_ARR);
    bf16_t* RHT = (bf16_t*)(lds + 12 * RW_ARR);
    float* ADG = (float*)(lds + 14 * RW_ARR);
    bf16_t* ABA = (bf16_t*)(lds + 14 * RW_ARR + 8192);
    float* WT = (float*)(lds + 14 * RW_ARR + 8192 + 32 * RWP * 2);
    float* GC = WT + 512;
    bf16_t* DAB = AT;
    const int tid = TIDX(), lane = tid & 63, wave = tid >> 6, r32 = lane & 31, hi = lane >> 5;
    float r[8], lw[8], k2[8], v[8], ain[8], bin[8], gg[8], rk[8];
    rw_stage_weights(p, l, h, (bf16_t*)(lds + 8 * 8 * RW_SCRP * 4), tid);
    rw_prep<8, true, true>(p, P, l, b, h, t0 + 8 * wave, (float*)lds + wave * (8 * RW_SCRP), (const bf16_t*)(lds + 8 * 8 * RW_SCRP * 4), lane, r, lw, k2, v, ain, bin, gg, rk);
#pragma unroll
    for (int i = 0; i < 8; ++i) { const size_t o = (size_t)(b * S_ + t0 + 8 * wave + i) * 256 + 64 * h + lane; P.rwGt[o] = (bf16_t)f2bf(gg[i]); P.rwRKV[o] = (bf16_t)f2bf(rk[i] * v[i]); }
    float Lloc[8]; { float s = 0.f;
#pragma unroll
      for (int i = 0; i < 8; ++i) { s += lw[i]; Lloc[i] = s; } }
    __syncthreads();
    if (STOP == 1) return;
    WT[wave * 64 + lane] = Lloc[7];
    __syncthreads();
    { float off = 0.f, tot = 0.f;
#pragma unroll
      for (int w = 0; w < 8; ++w) { const float x = WT[w * 64 + lane]; tot += x; if (w < wave) off += x; }
      if (wave == 0) GC[lane] = __expf(tot);
      unsigned bhp[4], khp[4], vtp[4], atp[4]; float pb = 0.f, pk = 0.f, pv = 0.f, pa = 0.f;
#pragma unroll
      for (int i = 0; i < 8; ++i) { const int t = 8 * wave + i; const float Lt = off + Lloc[i], Lp = Lt - lw[i];
          const float eL = __expf(Lt), eLp = __expf(Lp), einv = __expf(-Lt), eh = __expf(tot - Lt);
          const float xa = ain[i] * eLp;
          AT[t * RWP + lane] = (bf16_t)f2bf(xa); RT[t * RWP + lane] = (bf16_t)f2bf(r[i] * eL);
          BT[t * RWP + lane] = (bf16_t)f2bf(bin[i] * einv); KT[t * RWP + lane] = (bf16_t)f2bf(k2[i] * einv);
          const float xb = bin[i] * eh, xk = k2[i] * eh, xv = v[i];
          if (i & 1) { bhp[i >> 1] = pk2(pb, xb); khp[i >> 1] = pk2(pk, xk); vtp[i >> 1] = pk2(pv, xv); atp[i >> 1] = pk2(pa, xa); } else { pb = xb; pk = xk; pv = xv; pa = xa; } }
      *(u32x4*)(BH + lane * RWP + 8 * wave) = (u32x4){bhp[0], bhp[1], bhp[2], bhp[3]};
      *(u32x4*)(KH + lane * RWP + 8 * wave) = (u32x4){khp[0], khp[1], khp[2], khp[3]};
      *(u32x4*)(VT + lane * RWP + 8 * wave) = (u32x4){vtp[0], vtp[1], vtp[2], vtp[3]};
      *(u32x4*)(RHT + (64 + lane) * RWP + 8 * wave) = (u32x4){atp[0], atp[1], atp[2], atp[3]}; }
    __syncthreads();
#pragma unroll
    for (int jj = 0; jj < 2; ++jj) { const int job = wave + 8 * jj, mat = job >> 2, tm = (job >> 1) & 1, tn = job & 1;
        f32x16 acc = {};
        if (!(tm == 0 && tn == 1)) acc = rw_tile((mat & 2) ? RT : AT, (mat & 1) ? KT : BT, tm, tn, r32, hi, acc);
        const int s = 32 * tn + r32;
#pragma unroll
        for (int q = 0; q < 16; ++q) { const int t = 32 * tm + (q & 3) + 8 * (q >> 2) + 4 * hi;
            const bool keep = (mat & 2) ? (s <= t) : (s < t); const float x = keep ? acc[q] : 0.f;
            if (mat == 0) { if (tm == tn) ADG[(tm * 32 + (t & 31)) * 32 + (s & 31)] = x; else if (tm == 1) ABA[(t & 31) * RWP + s] = (bf16_t)f2bf(x); } else { bf16_t* D = (mat == 1) ? AAK : (mat == 2) ? ARB : ARK; D[t * RWP + s] = (bf16_t)f2bf(x); } } }
    __syncthreads();
    if (STOP == 2) return;
    if (wave < 4) { const int tm = wave >> 1, tn = wave & 1; f32x16 acc = {}; acc = rw_tile(VT, AAK, tm, tn, r32, hi, acc);
#pragma unroll
        for (int q = 0; q < 16; ++q) { const int i = 32 * tm + (q & 3) + 8 * (q >> 2) + 4 * hi; RHT[i * RWP + 32 * tn + r32] = (bf16_t)f2bf(acc[q]); } }
    else if (wave == 4) { float d[32]; const LAS float* ab = (const LAS float*)ADG + hi * 1024;
#pragma unroll
        for (int t = 0; t < 32; ++t) d[t] = (t == r32) ? 1.f : 0.f;
#pragma unroll
        for (int t = 1; t < 32; ++t) { float s0 = 0.f, s1 = 0.f;
#pragma unroll
            for (int s4 = 0; s4 < (t + 3) / 4; ++s4) { const f32x4 a4 = *(const LAS f32x4*)(ab + t * 32 + 4 * s4);
                s0 += a4[0] * d[4 * s4]; s1 += a4[1] * d[4 * s4 + 1]; s0 += a4[2] * d[4 * s4 + 2]; s1 += a4[3] * d[4 * s4 + 3]; }
            d[t] += s0 + s1; if ((t & 3) == 3) MEMFENCE(); }
        LAS bf16_t* D = (LAS bf16_t*)DAB + hi * 32 * RWP + r32;
#pragma unroll
        for (int t = 0; t < 32; ++t) D[t * RWP] = (bf16_t)f2bf(d[t]); }
    __syncthreads();
    if (wave < 4) { bf16_t* XT = (wave < 2 ? UVT : W1T) + (32 * (wave & 1)) * RWP;
        const bf16_t* rh = RHT + (32 * wave + r32) * RWP + 8 * hi;
        { f32x16 acc = {}; const bf16_t* da = DAB + r32 * RWP + 8 * hi;
#pragma unroll
          for (int ks = 0; ks < 2; ++ks) acc = MFMA32(ldsb8(rh + 16 * ks), ldsb8(da + 16 * ks), acc);
#pragma unroll
          for (int q = 0; q < 16; ++q) XT[((q & 3) + 8 * (q >> 2) + 4 * hi) * RWP + r32] = (bf16_t)f2bf(acc[q]); }
        WAVE_SYNC();
        { f32x16 acc; const bf16_t* rz = RHT + (32 * wave) * RWP + 32 + r32;
#pragma unroll
          for (int q = 0; q < 16; ++q) acc[q] = bf2f(rz[((q & 3) + 8 * (q >> 2) + 4 * hi) * RWP]);
          const bf16_t* xa = XT + r32 * RWP + 8 * hi; const bf16_t* ba = ABA + r32 * RWP + 8 * hi;
#pragma unroll
          for (int ks = 0; ks < 2; ++ks) acc = MFMA32(ldsb8(xa + 16 * ks), ldsb8(ba + 16 * ks), acc);
#pragma unroll
          for (int q = 0; q < 16; ++q) XT[((q & 3) + 8 * (q >> 2) + 4 * hi) * RWP + 32 + r32] = (bf16_t)f2bf(acc[q]); }
        WAVE_SYNC();
        { f32x16 acc = {}; const bf16_t* xz = XT + r32 * RWP + 32 + 8 * hi; const bf16_t* db = DAB + (32 + r32) * RWP + 8 * hi;
          const bf16x8 z0 = ldsb8(xz), z1 = ldsb8(xz + 16);
          acc = MFMA32(z0, ldsb8(db), acc); acc = MFMA32(z1, ldsb8(db + 16), acc);
          WAVE_SYNC();
#pragma unroll
          for (int q = 0; q < 16; ++q) XT[((q & 3) + 8 * (q >> 2) + 4 * hi) * RWP + 32 + r32] = (bf16_t)f2bf(acc[q]); } }
    __syncthreads();
    if (STOP == 3) return;
    const size_t chunk = (size_t)unit;
#pragma unroll
    for (int jj = 0; jj < 2; ++jj) { const int job = wave + 8 * jj, kind = job >> 2, tm = (job >> 1) & 1, tn = job & 1; f32x16 acc = {};
        const int col = 32 * tn + r32;
        if (kind == 0) { acc = rw_tile(BH, W1T, tm, tn, r32, hi, acc);
            bf16_t* PT = P.rwPT + chunk * 4096;
#pragma unroll
            for (int q = 0; q < 16; ++q) { const int row = 32 * tm + (q & 3) + 8 * (q >> 2) + 4 * hi; const float x = acc[q] + (row == col ? GC[row] : 0.f); PT[row * 64 + col] = (bf16_t)f2bf(x); } }
        else if (kind == 1) { acc = rw_tile(ARB, W1T, tm, tn, r32, hi, acc);
#pragma unroll
            for (int q = 0; q < 16; ++q) { const int t = 32 * tm + (q & 3) + 8 * (q >> 2) + 4 * hi; const float x = acc[q] + bf2f(RT[t * RWP + col]);
                P.rwQ[(size_t)(b * S_ + t0 + t) * 256 + 64 * h + col] = (bf16_t)f2bf(x); } }
        else if (kind == 2) { acc = rw_tile(UVT, BH, tm, tn, r32, hi, acc); acc = rw_tile(VT, KH, tm, tn, r32, hi, acc);
            unsigned* Gg = (unsigned*)(P.rwG + chunk * 4096) + (tm * 2 + tn) * 8 * 64 + lane;
#pragma unroll
            for (int q = 0; q < 8; ++q) Gg[q * 64] = pk2(acc[2 * q], acc[2 * q + 1]); }
        else { acc = rw_tile(ARB, UVT, tm, tn, r32, hi, acc); acc = rw_tile(ARK, VT, tm, tn, r32, hi, acc);
#pragma unroll
            for (int q = 0; q < 16; ++q) { const int t = 32 * tm + (q & 3) + 8 * (q >> 2) + 4 * hi; P.ycat[(size_t)(b * S_ + t0 + t) * 1024 + 64 * h + col] = (bf16_t)f2bf(acc[q]); } } }
    __syncthreads();
}
__device__ __forceinline__ void rw_state_unit(const KP& p, const Ptrs& P, int l, int unit, unsigned char* lds) {
    bf16_t* Sb = (bf16_t*)lds;
    const int tid = TIDX(), lane = tid & 63, wave = tid >> 6, r32 = lane & 31, hi = lane >> 5;
    const int ti = (wave >> 1) & 1, tj = wave & 1;
    f32x16 S = {};
    unsigned gq[8]; bf16x8 pq[4];
    if (wave < 4) { const size_t chunk = (size_t)unit * RW_NCH; const unsigned* Gg = (const unsigned*)(P.rwG + chunk * 4096) + (ti * 2 + tj) * 8 * 64 + lane;
#pragma unroll
        for (int q = 0; q < 8; ++q) gq[q] = Gg[q * 64];
        const bf16_t* pt = P.rwPT + chunk * 4096 + (32 * tj + r32) * 64 + 8 * hi;
#pragma unroll
        for (int ks = 0; ks < 4; ++ks) pq[ks] = *(const bf16x8*)(pt + 16 * ks); }
    for (int c = 0; c < RW_NCH; ++c) { const size_t chunk = (size_t)unit * RW_NCH + c;
        unsigned gn[8]; bf16x8 pn[4];
        if (wave < 4) { const size_t cn = chunk + (c + 1 < RW_NCH ? 1 : 0); const unsigned* Gg = (const unsigned*)(P.rwG + cn * 4096) + (ti * 2 + tj) * 8 * 64 + lane;
#pragma unroll
            for (int q = 0; q < 8; ++q) gn[q] = Gg[q * 64];
            const bf16_t* pt = P.rwPT + cn * 4096 + (32 * tj + r32) * 64 + 8 * hi;
#pragma unroll
            for (int ks = 0; ks < 4; ++ks) pn[ks] = *(const bf16x8*)(pt + 16 * ks);
#pragma unroll
            for (int q = 0; q < 16; ++q) Sb[(32 * ti + (q & 3) + 8 * (q >> 2) + 4 * hi) * RWP + 32 * tj + r32] = (bf16_t)f2bf(S[q]); }
        __syncthreads();
        { const int row = tid >> 3, ch = tid & 7; *(u32x4*)(P.rwS0 + chunk * 4096 + row * 64 + ch * 8) = *(const u32x4*)(Sb + row * RWP + ch * 8); }
        if (wave < 4) { f32x16 acc;
#pragma unroll
            for (int q = 0; q < 8; ++q) { acc[2 * q] = bflo(gq[q]); acc[2 * q + 1] = bfhi(gq[q]); }
            const bf16_t* sa = Sb + (32 * ti + r32) * RWP + 8 * hi;
#pragma unroll
            for (int ks = 0; ks < 4; ++ks) acc = MFMA32(ldsb8(sa + 16 * ks), pq[ks], acc);
            S = acc;
#pragma unroll
            for (int q = 0; q < 8; ++q) gq[q] = gn[q];
#pragma unroll
            for (int ks = 0; ks < 4; ++ks) pq[ks] = pn[ks]; }
        __syncthreads();
    }
}
template <bool DUMMY = false>
__device__ __forceinline__ void rw_out_unit(const KP& p, const Ptrs& P, int l, int unit, unsigned char* lds) {
    MEMFENCE(); OPAQUE_S(unit);
    const int c = unit % RW_NCH, bh = unit / RW_NCH, b = bh >> 2, h = bh & 3, t0 = c * 64;
    float* Yb = (float*)(lds + 81920);
    const int tid = TIDX(), lane = tid & 63, wave = tid >> 6, r32 = lane & 31, hi = lane >> 5;
    float g[8], rkv[8];
#pragma unroll
    for (int i = 0; i < 8; ++i) { const size_t o = (size_t)(b * S_ + t0 + 8 * wave + i) * 256 + 64 * h + lane; g[i] = bf2f(P.rwGt[o]); rkv[i] = bf2f(P.rwRKV[o]); }
    if (wave < 4) { const int tm = wave >> 1, tn = wave & 1; f32x16 acc; const int col = 32 * tn + r32;
        const bf16_t* yl = P.ycat + (size_t)(b * S_ + t0 + 32 * tm) * 1024 + 64 * h + col;
#pragma unroll
        for (int q = 0; q < 16; ++q) acc[q] = bf2f(yl[(size_t)((q & 3) + 8 * (q >> 2) + 4 * hi) * 1024]);
        const bf16_t* qa = P.rwQ + (size_t)(b * S_ + t0 + 32 * tm + r32) * 256 + 64 * h + 8 * hi; const bf16_t* sb = P.rwS0 + (size_t)unit * 4096 + (32 * tn + r32) * 64 + 8 * hi;
#pragma unroll
        for (int ks = 0; ks < 4; ++ks) acc = MFMA32(*(const bf16x8*)(qa + 16 * ks), *(const bf16x8*)(sb + 16 * ks), acc);
#pragma unroll
        for (int q = 0; q < 16; ++q) Yb[(32 * tm + (q & 3) + 8 * (q >> 2) + 4 * hi) * 64 + col] = acc[q]; }
    __syncthreads();
    const float gng = p.in[I_LNXG][l * 256 + 64 * h + lane], gnb = p.in[I_LNXB][l * 256 + 64 * h + lane];
    { float yv[8], m1[8], m2[8];
#pragma unroll
      for (int i = 0; i < 8; ++i) { yv[i] = Yb[(8 * wave + i) * 64 + lane]; m1[i] = yv[i]; }
      wave_sum_n<8>(m1);
#pragma unroll
      for (int i = 0; i < 8; ++i) { yv[i] -= m1[i] * (1.f / 64.f); m2[i] = yv[i] * yv[i]; }
      wave_sum_n<8>(m2);
#pragma unroll
      for (int i = 0; i < 8; ++i) { const int t = 8 * wave + i; const float yn = yv[i] * (1.0f / sqrtf(m2[i] * (1.f / 64.f) + GN_EPS_)) * gng + gnb; const float o = (yn + rkv[i]) * g[i];
        if (DUMMY) P.pb[(size_t)(b * S_ + t0 + t) * 256 + 64 * h + lane] = (bf16_t)f2bf(o);
        else P.ycat[(size_t)(b * S_ + t0 + t) * 1024 + 64 * h + lane] = (bf16_t)f2bf(o); } }
    __syncthreads();
}
#ifdef EMU_FP8_A
#define EMU_AUX77 u.aux = 77;
#else
#define EMU_AUX77
#endif
__device__ __forceinline__ void tile_map(int L, int nM, int nN, int& pm, int& pn) {
    const int nwg = nM * nN, q = nwg / 8, r = nwg % 8, xcd = L % 8, off = L / 8;
    const int wgid = (xcd < r ? xcd * (q + 1) : r * (q + 1) + (xcd - r) * q) + off;
    const int nig = 8 * nN, gid = wgid / nig, fm = gid * 8, gsz = (nM - fm) < 8 ? (nM - fm) : 8;
    pm = fm + ((wgid % nig) % gsz); pn = (wgid % nig) / gsz;
}
struct EpiStoreBf16 {
    bf16_t* base0; int ldc0; bf16_t* base1; int ldc1;
    __device__ __forceinline__ void operator()(const f32x4 (&acc)[2][2][4][2], const pg8::Unit& u, int wr, int wc, int fr, int fq, int tid) const {
        bf16_t* base = u.kind ? base1 : base0; const int ldc = u.kind ? ldc1 : ldc0;
        int row0 = u.pm * 256 + wr * 64 + fr, col0 = u.pn * 256 + wc * 32 + 8 * fq; OPAQUE(row0); OPAQUE(col0);
#pragma unroll
        for (int ai = 0; ai < 2; ++ai)
#pragma unroll
            for (int m = 0; m < 4; ++m) { bf16_t* rowp = base + (size_t)(row0 + ai * 128 + m * 16) * ldc + col0;
#pragma unroll
                for (int bj = 0; bj < 2; ++bj) { const f32x4 v0 = acc[ai][bj][m][0], v1 = acc[ai][bj][m][1];
                    u32x4 w; w.x = pk2(v0[0], v0[1]); w.y = pk2(v0[2], v0[3]); w.z = pk2(v1[0], v1[1]); w.w = pk2(v1[2], v1[3]);
                    *(u32x4*)(rowp + bj * 128) = w; } }
    }
};
template <int PART>
struct SchedA { const bf16_t* hb; const unsigned char* h8a; const unsigned char* h8b; const bf16_t* WinT; int G, c;
    __device__ __forceinline__ bool next(int i, pg8::Unit& u) const {
        const int nM = T_ / 256, n0 = nM * 9; u.aux = 0;
        if (PART == 0) { const int x = i * G + c; if (x >= n0) return false;
            tile_map(x, nM, 9, u.pm, u.pn); u.kind = 0; u.nt = 8; u.f8 = 1; const int m0 = u.pm * 256;
            u.a = (const char*)(m0 < H8_SPLIT ? h8a + (size_t)m0 * 1024 : h8b + (size_t)(m0 - H8_SPLIT) * 1024); u.b = (const char*)(WinT + (size_t)u.pn * 256 * 1024); }
        else { const int x = i * G + (c + G - n0 % G) % G; if (x >= nM) return false;
            u.pm = 0; u.pn = x; u.kind = 1; u.nt = 16; u.f8 = 0; u.a = (const char*)(WinT + (size_t)WIN_VT * 1024); u.b = (const char*)(hb + (size_t)u.pn * 256 * 1024); }
        return true; } };
struct EpiA { bf16_t* proj; const float* sc;
    __device__ __forceinline__ void operator()(const f32x4 (&acc)[2][2][4][2], const pg8::Unit& u, int wr, int wc, int fr, int fq, int tid) const {
        int row0 = u.pm * 256 + wr * 64 + fr, col0 = u.pn * 256 + wc * 32 + 8 * fq; OPAQUE(row0); OPAQUE(col0);
#pragma unroll
        for (int bj = 0; bj < 2; ++bj) { const f32x4 s0 = *(const f32x4*)(sc + col0 + bj * 128), s1 = *(const f32x4*)(sc + col0 + bj * 128 + 4);
#pragma unroll
            for (int ai = 0; ai < 2; ++ai)
#pragma unroll
                for (int m = 0; m < 4; ++m) { const f32x4 v0 = acc[ai][bj][m][0] * s0, v1 = acc[ai][bj][m][1] * s1;
                    u32x4 w; w.x = pk2(v0[0], v0[1]); w.y = pk2(v0[2], v0[3]); w.z = pk2(v1[0], v1[1]); w.w = pk2(v1[2], v1[3]);
                    *(u32x4*)(proj + (size_t)(row0 + ai * 128 + m * 16) * PJ + col0 + bj * 128) = w; } }
    }
};
__device__ __forceinline__ void phase_A0(const KP& p, unsigned char* lds) {
    const int tid = TIDX(), lane = tid & 63, wave = tid >> 6; const int gw = BIDX() * NWAVE + wave, NGW = GDIM() * NWAVE;
    for (int r = gw; r < L_ * WIN_VT; r += NGW) { const int l = r / WIN_VT, n = r % WIN_VT; const Ptrs P = make_ptrs(p.ws, l); bf16_t* row = P.WinT + (size_t)n * 1024;
        const u32x4 a = *(const u32x4*)(row + 16 * lane), b = *(const u32x4*)(row + 16 * lane + 8);
        float v[16] = {bflo(a.x), bfhi(a.x), bflo(a.y), bfhi(a.y), bflo(a.z), bfhi(a.z), bflo(a.w), bfhi(a.w), bflo(b.x), bfhi(b.x), bflo(b.y), bfhi(b.y), bflo(b.z), bfhi(b.z), bflo(b.w), bfhi(b.w)};
        float am = 0.f;
#pragma unroll
        for (int j = 0; j < 16; ++j) am = fmaxf(am, fabsf(v[j]));
        am = wave_max(am); const float sc = am > 0.f ? am * (1.0f / 440.0f) : 1.0f, inv = 1.0f / sc; u32x4 o;
#pragma unroll
        for (int j = 0; j < 4; ++j) { unsigned w = cvt_pk_fp8_f32_(v[4 * j] * inv, v[4 * j + 1] * inv, 0u, false); w = cvt_pk_fp8_f32_(v[4 * j + 2] * inv, v[4 * j + 3] * inv, w, true); o[j] = w; }
        WAVE_SYNC();
        *(u32x4*)((unsigned char*)row + 16 * lane) = o;
        if (lane == 0) P.gscA[n] = sc; }
#ifdef CPU_EMU
    (void)lds;
#endif
}
__device__ __forceinline__ void phase_A(const KP& p, int l, unsigned char* lds) {
    const Ptrs P = make_ptrs(p.ws, l);
    { SchedA<0> S{P.hb, P.h8a, P.h8b, P.WinT, GDIM(), BIDX()}; EpiA E{P.proj, P.gscA}; pg8::gemm_phase<1>((LAS unsigned char*)lds, 1024, 1024, S, E, 1024); }
    { SchedA<1> S{P.hb, P.h8a, P.h8b, P.WinT, GDIM(), BIDX()}; EpiStoreBf16 E{P.vtr, T_, P.vtr, T_}; pg8::gemm_phase<0>((LAS unsigned char*)lds, 1024, 1024, S, E); }
}
#if PROBE_REPEAT >= 40 && PROBE_REPEAT <= 49
struct SchedAP { const bf16_t* hb; const bf16_t* WinT; int G, c, nt, pnmask;
    __device__ __forceinline__ bool next(int i, pg8::Unit& u) const {
        const int nM = T_ / 256, n0 = nM * 9; const int x = i * G + c; if (x >= n0 + nM) return false;
        u.nt = nt; u.aux = 0; u.f8 = 0;
        if (x < n0) { tile_map(x, nM, 9, u.pm, u.pn); u.kind = 0; u.a = (const char*)(hb + (size_t)u.pm * 256 * 1024); u.b = (const char*)(WinT + (size_t)u.pn * 256 * 1024); }
        else { u.pm = 0; u.pn = x - n0; u.kind = 1; u.a = (const char*)(WinT + (size_t)WIN_VT * 1024); u.b = (const char*)(hb + (size_t)u.pn * 256 * 1024); }
        u.pn &= pnmask; return true; } };
struct EpiNull { float* d;
    __device__ __forceinline__ void operator()(const f32x4 (&acc)[2][2][4][2], const pg8::Unit& u, int wr, int wc, int fr, int fq, int tid) const {
        f32x4 s = (f32x4){0.f, 0.f, 0.f, 0.f};
#pragma unroll
        for (int ai = 0; ai < 2; ++ai)
#pragma unroll
            for (int m = 0; m < 4; ++m)
#pragma unroll
                for (int bj = 0; bj < 2; ++bj) s += acc[ai][bj][m][0] + acc[ai][bj][m][1];
        if (s.x + s.y + s.z + s.w == 1.2345e30f) d[tid] = s.x; } };
struct EpiStash { u32x4* stash;
    __device__ __forceinline__ void operator()(const f32x4 (&acc)[2][2][4][2], const pg8::Unit& u, int wr, int wc, int fr, int fq, int tid) const {
        OPAQUE(tid);
#pragma unroll
        for (int ai = 0; ai < 2; ++ai)
#pragma unroll
            for (int m = 0; m < 4; ++m)
#pragma unroll
                for (int bj = 0; bj < 2; ++bj) { const f32x4 v0 = acc[ai][bj][m][0], v1 = acc[ai][bj][m][1];
                    u32x4 w; w.x = pk2(v0[0], v0[1]); w.y = pk2(v0[2], v0[3]); w.z = pk2(v1[0], v1[1]); w.w = pk2(v1[2], v1[3]);
                    stash[((ai * 4 + m) * 2 + bj) * 512 + tid] = w; } } };
struct EpiFullLine { bf16_t* base;
    __device__ __forceinline__ void operator()(const f32x4 (&acc)[2][2][4][2], const pg8::Unit& u, int wr, int wc, int fr, int fq, int tid) const {
        OPAQUE(tid); if (u.kind) return;
#pragma unroll
        for (int ai = 0; ai < 2; ++ai)
#pragma unroll
            for (int m = 0; m < 4; ++m)
#pragma unroll
                for (int bj = 0; bj < 2; ++bj) { const f32x4 v0 = acc[ai][bj][m][0], v1 = acc[ai][bj][m][1]; const int k = (ai * 4 + m) * 2 + bj, L = k * 512 + tid, row = L >> 5, ch = L & 31;
                    u32x4 w; w.x = pk2(v0[0], v0[1]); w.y = pk2(v0[2], v0[3]); w.z = pk2(v1[0], v1[1]); w.w = pk2(v1[2], v1[3]);
                    *(u32x4*)(base + (size_t)(u.pm * 256 + row) * PJ + u.pn * 256 + ch * 8) = w; } } };
struct EpiProjOnly { bf16_t* base;
    __device__ __forceinline__ void operator()(const f32x4 (&acc)[2][2][4][2], const pg8::Unit& u, int wr, int wc, int fr, int fq, int tid) const {
        if (u.kind) return;
        int row0 = u.pm * 256 + wr * 64 + fr, col0 = u.pn * 256 + wc * 32 + 8 * fq; OPAQUE(row0); OPAQUE(col0);
#pragma unroll
        for (int ai = 0; ai < 2; ++ai)
#pragma unroll
            for (int m = 0; m < 4; ++m) { bf16_t* rowp = base + (size_t)(row0 + ai * 128 + m * 16) * PJ + col0;
#pragma unroll
                for (int bj = 0; bj < 2; ++bj) { const f32x4 v0 = acc[ai][bj][m][0], v1 = acc[ai][bj][m][1];
                    u32x4 w; w.x = pk2(v0[0], v0[1]); w.y = pk2(v0[2], v0[3]); w.z = pk2(v1[0], v1[1]); w.w = pk2(v1[2], v1[3]);
                    *(u32x4*)(rowp + bj * 128) = w; } } } };
template <int V>
__device__ __forceinline__ void phase_Aprobe(const KP& p, int l, unsigned char* lds) {
    const Ptrs P = make_ptrs(p.ws, l);
    SchedAP S{P.hb, P.WinT, GDIM(), BIDX(), V == 1 ? 32 : V == 3 ? 4 : V == 4 ? 8 : V == 5 ? 64 : 16, V == 6 ? 3 : 0xffff};
    if (V == 7) { EpiFullLine E{P.proj}; pg8::gemm_phase((LAS unsigned char*)lds, 1024, 1024, S, E); }
    else if (V == 8) { EpiProjOnly E{P.proj}; pg8::gemm_phase((LAS unsigned char*)lds, 1024, 1024, S, E); }
    else if (V == 2) { EpiStash E{(u32x4*)(P.ycat + (size_t)BIDX() * 65536)}; pg8::gemm_phase((LAS unsigned char*)lds, 1024, 1024, S, E); }
    else if (V == 6) { EpiStoreBf16 E{P.ycat, 1024, P.ycat, 1024}; pg8::gemm_phase((LAS unsigned char*)lds, 1024, 1024, S, E); }
    else { EpiNull E{(float*)(P.ycat + (size_t)BIDX() * 65536)}; pg8::gemm_phase((LAS unsigned char*)lds, 1024, 1024, S, E); }
}
#endif
struct SchedGlu { const bf16_t* ycat; const bf16_t* GluT; int G, c;
    __device__ __forceinline__ bool next(int i, pg8::Unit& u) const {
        const int x = i * G + c; if (x >= T_ / 256) return false;
        u.pm = x; u.pn = 0; u.nt = 4; u.kind = 0; u.aux = 0; u.f8 = 0; u.a = (const char*)(ycat + (size_t)x * 256 * 1024 + 256); u.b = (const char*)GluT; return true; } };
struct EpiGlu { bf16_t* ycat; const float* glub;
    __device__ __forceinline__ void operator()(const f32x4 (&acc)[2][2][4][2], const pg8::Unit& u, int wr, int wc, int fr, int fq, int tid) const {
        int row0 = u.pm * 256 + wr * 64 + fr, col0 = wc * 32 + 8 * fq; OPAQUE(row0); OPAQUE(col0);
#pragma unroll
        for (int bj = 0; bj < 2; ++bj) { const f32x4 b0 = *(const f32x4*)(glub + col0 + bj * 128), b1 = *(const f32x4*)(glub + col0 + bj * 128 + 4);
#pragma unroll
            for (int ai = 0; ai < 2; ++ai)
#pragma unroll
                for (int m = 0; m < 4; ++m) { bf16_t* ptr = ycat + (size_t)(row0 + ai * 128 + m * 16) * 1024 + 256 + col0 + bj * 128;
                    const u32x4 y = *(const u32x4*)ptr; const f32x4 v0 = acc[ai][bj][m][0] + b0, v1 = acc[ai][bj][m][1] + b1;
                    u32x4 w; w.x = pk2(bflo(y.x) * sigmoidf_(v0[0]), bfhi(y.x) * sigmoidf_(v0[1])); w.y = pk2(bflo(y.y) * sigmoidf_(v0[2]), bfhi(y.y) * sigmoidf_(v0[3]));
                    w.z = pk2(bflo(y.z) * sigmoidf_(v1[0]), bfhi(y.z) * sigmoidf_(v1[1])); w.w = pk2(bflo(y.w) * sigmoidf_(v1[2]), bfhi(y.w) * sigmoidf_(v1[3]));
                    *(u32x4*)ptr = w; MEMFENCE(); } }
    }
};
__device__ __forceinline__ void convert_tables(const KP& p, const Ptrs& P, int l, unsigned char* lds) {
    const int tid = TIDX(), lane = tid & 63, wave = tid >> 6;
    unsigned* cnt = (unsigned*)(p.ws + WS_CTL) + 10240 + 16 * l; int* slot = (int*)(lds + 65536);
    const float* ps = p.in[I_P] + (size_t)l * T_ * 256;
    constexpr int NG8 = 6144 / 128, NTAB = 2 * NEXP / 128, NPB = (int)(((size_t)T_ * 256 / 8 + 4095) / 4096);
    for (;;) {
        __syncthreads(); if (tid == 0) *slot = (int)atomicAdd(cnt, 1u); __syncthreads();
        int item = *slot; if (item >= NG8 + NTAB + NPB) break;
        if (item < NG8) {
            for (int rr = wave; rr < 128; rr += NWAVE) { const int r5 = item * 128 + rr; bf16_t* row = r5 < 4096 ? P.WinT + (size_t)(WIN_GATE + r5) * 1024 : r5 < 5120 ? P.PleGT + (size_t)(r5 - 4096) * 1024 : P.WoutT + (size_t)(r5 - 5120) * 1024;
                const u32x4 a = *(const u32x4*)(row + 16 * lane), b = *(const u32x4*)(row + 16 * lane + 8);
                float v[16] = {bflo(a.x), bfhi(a.x), bflo(a.y), bfhi(a.y), bflo(a.z), bfhi(a.z), bflo(a.w), bfhi(a.w), bflo(b.x), bfhi(b.x), bflo(b.y), bfhi(b.y), bflo(b.z), bfhi(b.z), bflo(b.w), bfhi(b.w)};
                float am = 0.f;
#pragma unroll
                for (int j = 0; j < 16; ++j) am = fmaxf(am, fabsf(v[j]));
                am = wave_max(am); const float sc = am > 0.f ? am * (1.0f / 440.0f) : 1.0f, inv = 1.0f / sc; u32x4 o;
#pragma unroll
                for (int j = 0; j < 4; ++j) { unsigned w = cvt_pk_fp8_f32_(v[4 * j] * inv, v[4 * j + 1] * inv, 0u, false); w = cvt_pk_fp8_f32_(v[4 * j + 2] * inv, v[4 * j + 3] * inv, w, true); o[j] = w; }
                WAVE_SYNC();
                *(u32x4*)((unsigned char*)row + 16 * lane) = o;
                if (lane == 0) P.gsc[r5] = sc; }
            continue; }
        item -= NG8;
        if (item < NTAB) {
            for (int r4 = 0; r4 < 16; r4 += 4) { f32x4 v[4][4]; float am[4];
#pragma unroll
                for (int q = 0; q < 4; ++q) { const int it = item * 128 + wave + 8 * (r4 + q); const int tb = it >= NEXP, row = tb ? it - NEXP : it;
                    const float* src = p.in[tb ? I_V : I_U] + ((size_t)l * NEXP + row) * 1024 + 16 * lane; am[q] = 0.f;
#pragma unroll
                    for (int j = 0; j < 4; ++j) { v[q][j] = *(const f32x4*)(src + 4 * j); am[q] = fmaxf(am[q], fmaxf(fmaxf(fabsf(v[q][j].x), fabsf(v[q][j].y)), fmaxf(fabsf(v[q][j].z), fabsf(v[q][j].w)))); } }
#pragma unroll
                for (int q = 0; q < 4; ++q) { const int it = item * 128 + wave + 8 * (r4 + q); const int tb = it >= NEXP, row = tb ? it - NEXP : it;
                    const float amx = wave_max(am[q]); const float sc = amx > 0.f ? amx * (1.0f / 440.0f) : 1.0f, inv = 1.0f / sc; u32x4 o;
#pragma unroll
                    for (int j = 0; j < 4; ++j) { unsigned w = cvt_pk_fp8_f32_(v[q][j].x * inv, v[q][j].y * inv, 0u, false); w = cvt_pk_fp8_f32_(v[q][j].z * inv, v[q][j].w * inv, w, true); o[j] = w; }
                    *(u32x4*)((tb ? P.V8 : P.U8) + ((size_t)(lane >> 3) * NEXP + row) * 128 + 16 * (lane & 7)) = o;
                    if (lane == 0) (tb ? P.sv : P.su)[row] = sc; } }
        } else {
            const size_t base = (size_t)(item - NTAB) * 4096;
            f32x4 a[8], bq[8];
#pragma unroll
            for (int j = 0; j < 8; ++j) { const size_t i = base + tid + (size_t)j * NTHR; a[j] = (f32x4){0.f, 0.f, 0.f, 0.f}; bq[j] = a[j];
                if (i < (size_t)T_ * 256 / 8) { a[j] = *(const f32x4*)(ps + i * 8); bq[j] = *(const f32x4*)(ps + i * 8 + 4); } }
#pragma unroll
            for (int j = 0; j < 8; ++j) { const size_t i = base + tid + (size_t)j * NTHR;
                if (i < (size_t)T_ * 256 / 8) { u32x4 o; o.x = pk2(a[j].x, a[j].y); o.y = pk2(a[j].z, a[j].w); o.z = pk2(bq[j].x, bq[j].y); o.w = pk2(bq[j].z, bq[j].w); *(u32x4*)(P.pb + i * 8) = o; } }
        }
    }
}
__device__ __forceinline__ void phase_B2(const KP& p, int l, unsigned char* lds) {
    const Ptrs P = make_ptrs(p.ws, l);
    constexpr int NRW = NB_ * 4; const int G = GDIM(), c = BIDX();
    int gG = G, gc = c;
    if (G > NRW) { if (c < NRW) { rw_state_unit(p, P, l, c, lds);
#if PROBE_REPEAT == 35
        rw_state_unit(p, P, l, c, lds);
#endif
        convert_tables(p, P, l, lds); return; } gG = G - NRW; gc = c - NRW; }
    else { for (int u = c; u < NRW; u += G) rw_state_unit(p, P, l, u, lds); }
    SchedGlu S{P.ycat, P.GluT, gG, gc};
    EpiGlu E{P.ycat, p.in[I_GLUB] + l * 256};
    pg8::gemm_phase((LAS unsigned char*)lds, 1024, 256, S, E);
    convert_tables(p, P, l, lds);
}
struct SchedC { const unsigned char* h8a; const unsigned char* h8b; const bf16_t* ycat; const bf16_t* WinT; const bf16_t* WbrT; int G, c;
    __device__ __forceinline__ bool next(int i, pg8::Unit& u) const {
        const int tile = (i >> 3) * G + c; if (tile >= (T_ / 256) * 4) return false;
        const int j = i & 7, b = j >> 1; tile_map(tile, T_ / 256, 4, u.pm, u.pn); u.aux = b;
        if (!(j & 1)) { u.kind = 0; u.nt = 4; u.f8 = 0; u.a = (const char*)(ycat + (size_t)u.pm * 256 * 1024 + 256 * b); u.b = (const char*)(WbrT + (size_t)u.pn * 256 * 1024 + 256 * b); }
        else { u.kind = 1; u.nt = 8; u.f8 = 1; const int m0 = u.pm * 256;
            u.a = (const char*)(m0 < H8_SPLIT ? h8a + (size_t)m0 * 1024 : h8b + (size_t)(m0 - H8_SPLIT) * 1024); u.b = (const char*)(WinT + (size_t)(WIN_GATE + 1024 * b + 256 * u.pn) * 1024); }
        return true; } };
struct EpiC { u32x4* stash; bf16_t* merged; const float* gsc; unsigned char* m8;
    __device__ __forceinline__ void operator()(const f32x4 (&acc)[2][2][4][2], const pg8::Unit& u, int wr, int wc, int fr, int fq, int tid) const {
        OPAQUE(tid);
        if (u.kind == 0) {
#pragma unroll
            for (int ai = 0; ai < 2; ++ai)
#pragma unroll
                for (int m = 0; m < 4; ++m)
#pragma unroll
                    for (int bj = 0; bj < 2; ++bj) { const f32x4 v0 = acc[ai][bj][m][0], v1 = acc[ai][bj][m][1];
                        u32x4 w; w.x = pk2(v0[0], v0[1]); w.y = pk2(v0[2], v0[3]); w.z = pk2(v1[0], v1[1]); w.w = pk2(v1[2], v1[3]);
                        stash[((ai * 4 + m) * 2 + bj) * 512 + tid] = w; }
        } else {
            int row0 = u.pm * 256 + wr * 64 + fr, col0 = u.pn * 256 + wc * 32 + 8 * fq; OPAQUE(row0); OPAQUE(col0); const bool first = (u.aux == 0);
            f32x4 sc[2][2];
#pragma unroll
            for (int bj = 0; bj < 2; ++bj) { const float* sp = gsc + 1024 * u.aux + col0 + bj * 128; sc[bj][0] = *(const f32x4*)sp; sc[bj][1] = *(const f32x4*)(sp + 4); }
#pragma unroll
            for (int ai = 0; ai < 2; ++ai)
#pragma unroll
                for (int mp = 0; mp < 2; ++mp) { u32x4 y[4], mo[4];
#pragma unroll
                    for (int q = 0; q < 4; ++q) { const int m = 2 * mp + (q >> 1), bj = q & 1;
                        y[q] = stash[((ai * 4 + m) * 2 + bj) * 512 + tid]; mo[q] = (u32x4){0u, 0u, 0u, 0u};
                        if (!first) mo[q] = *(const u32x4*)(merged + (size_t)(row0 + ai * 128 + m * 16) * 1024 + col0 + bj * 128); }
#pragma unroll
                    for (int q = 0; q < 4; ++q) { const int m = 2 * mp + (q >> 1), bj = q & 1; const f32x4 g0 = acc[ai][bj][m][0] * sc[bj][0], g1 = acc[ai][bj][m][1] * sc[bj][1];
                        bf16_t* ptr = merged + (size_t)(row0 + ai * 128 + m * 16) * 1024 + col0 + bj * 128;
                        const float o0 = bflo(y[q].x) * sigmoidf_(g0[0]) + bflo(mo[q].x), o1 = bfhi(y[q].x) * sigmoidf_(g0[1]) + bfhi(mo[q].x), o2 = bflo(y[q].y) * sigmoidf_(g0[2]) + bflo(mo[q].y), o3 = bfhi(y[q].y) * sigmoidf_(g0[3]) + bfhi(mo[q].y);
                        const float o4 = bflo(y[q].z) * sigmoidf_(g1[0]) + bflo(mo[q].z), o5 = bfhi(y[q].z) * sigmoidf_(g1[1]) + bfhi(mo[q].z), o6 = bflo(y[q].w) * sigmoidf_(g1[2]) + bflo(mo[q].w), o7 = bfhi(y[q].w) * sigmoidf_(g1[3]) + bfhi(mo[q].w);
                        u32x4 w; w.x = pk2(o0, o1); w.y = pk2(o2, o3); w.z = pk2(o4, o5); w.w = pk2(o6, o7);
                        *(u32x4*)ptr = w;
                        if (u.aux == 3) { u32x2 w8; w8.x = cvt_pk_fp8_f32_(o0, o1, 0u, false); w8.x = cvt_pk_fp8_f32_(o2, o3, w8.x, true); w8.y = cvt_pk_fp8_f32_(o4, o5, 0u, false); w8.y = cvt_pk_fp8_f32_(o6, o7, w8.y, true);
                            *(u32x2*)(m8 + (size_t)(row0 + ai * 128 + m * 16) * 1024 + col0 + bj * 128) = w8; } }
                    MEMFENCE(); }
        }
    }
};
__device__ __forceinline__ void phase_C(const KP& p, int l, unsigned char* lds) {
    const Ptrs P = make_ptrs(p.ws, l);
    SchedC S{P.h8a, P.h8b, P.ycat, P.WinT, P.WbrT, GDIM(), BIDX()};
    EpiC E{(u32x4*)(P.stash + (size_t)BIDX() * 131072), P.merged, P.gsc, P.h8e};
    pg8::gemm_phase<2>((LAS unsigned char*)lds, 1024, 1024, S, E, 1024);
}
struct SchedD { const unsigned char* A8; const bf16_t* Bt; int nN, G, c;
    __device__ __forceinline__ bool next(int i, pg8::Unit& u) const {
        const int x = i * G + c; if (x >= (T_ / 256) * nN) return false;
        tile_map(x, T_ / 256, nN, u.pm, u.pn); u.nt = 8; u.kind = 0; u.aux = 0; u.f8 = 1; u.a = (const char*)(A8 + (size_t)u.pm * 256 * 1024); u.b = (const char*)(Bt + (size_t)u.pn * 256 * 1024); return true; } };
struct EpiResid { bf16_t* ob; const bf16_t* hb; const float* sc;
    __device__ __forceinline__ void operator()(const f32x4 (&acc)[2][2][4][2], const pg8::Unit& u, int wr, int wc, int fr, int fq, int tid) const {
        int row0 = u.pm * 256 + wr * 64 + fr, col0 = u.pn * 256 + wc * 32 + 8 * fq; OPAQUE(row0); OPAQUE(col0);
#pragma unroll
        for (int ai = 0; ai < 2; ++ai)
#pragma unroll
            for (int m = 0; m < 4; ++m)
#pragma unroll
                for (int bj = 0; bj < 2; ++bj) { const size_t o = (size_t)(row0 + ai * 128 + m * 16) * 1024 + col0 + bj * 128; const u32x4 hw = *(const u32x4*)(hb + o);
                    const f32x4 a0 = acc[ai][bj][m][0] * *(const f32x4*)(sc + col0 + bj * 128), a1 = acc[ai][bj][m][1] * *(const f32x4*)(sc + col0 + bj * 128 + 4); u32x4 w;
                    w.x = pk2(bflo(hw.x) * DN_ALPHA_ + a0[0], bfhi(hw.x) * DN_ALPHA_ + a0[1]); w.y = pk2(bflo(hw.y) * DN_ALPHA_ + a0[2], bfhi(hw.y) * DN_ALPHA_ + a0[3]);
                    w.z = pk2(bflo(hw.z) * DN_ALPHA_ + a1[0], bfhi(hw.z) * DN_ALPHA_ + a1[1]); w.w = pk2(bflo(hw.w) * DN_ALPHA_ + a1[2], bfhi(hw.w) * DN_ALPHA_ + a1[3]);
                    *(u32x4*)(ob + o) = w; }
    }
};
__device__ __forceinline__ void phase_D(const KP& p, int l, unsigned char* lds) {
    const Ptrs P = make_ptrs(p.ws, l);
    SchedD S{P.h8e, P.WoutT, 4, GDIM(), BIDX()};
    EpiResid E{P.ycat, P.hb, P.gsc + 5120};
    pg8::gemm_phase<1>((LAS unsigned char*)lds, 1024, 1024, S, E, 1024);
}
__device__ __forceinline__ void phase_D2(const KP& p, int l, unsigned char* lds) {
    const Ptrs P = make_ptrs(p.ws, l);
    const int tid = TIDX(), lane = tid & 63, wave = tid >> 6; const int gw = BIDX() * NWAVE + wave, NGW = GDIM() * NWAVE;
    for (int m = 4 * gw; m < T_; m += 4 * NGW) ln_rows<4, true>(P.ycat + (size_t)m * 1024, p.in[I_LN1G] + l * 1024, p.in[I_LN1B] + l * 1024, (float*)nullptr, P.hb + (size_t)m * 1024, P.h8e + (size_t)m * 1024, lane);
}
struct SchedE1 { const bf16_t* pb; const bf16_t* PleT; int G, c;
    __device__ __forceinline__ bool next(int i, pg8::Unit& u) const {
        const int x = i * G + c; if (x >= (T_ / 256) * 4) return false;
        tile_map(x, T_ / 256, 4, u.pm, u.pn); u.nt = 4; u.kind = 0; u.aux = 0; u.f8 = 0; u.a = (const char*)(pb + (size_t)u.pm * 256 * 256); u.b = (const char*)(PleT + (size_t)u.pn * 256 * 256); return true; } };
template <int PART>
struct SchedE2 { const bf16_t* hb; const unsigned char* h8e; const bf16_t* PleGT; const bf16_t* WqT; int G, c;
    __device__ __forceinline__ bool next(int i, pg8::Unit& u) const {
        const int n0 = (T_ / 256) * 4; int x = i * G + c + (PART ? n0 : 0); if (x >= (PART ? n0 + (T_ / 256) * 8 : n0)) return false;
        u.aux = 0;
        if (x < n0) { tile_map(x, T_ / 256, 4, u.pm, u.pn); u.kind = 0; u.nt = 8; u.f8 = 1; u.b = (const char*)(PleGT + (size_t)u.pn * 256 * 1024); u.a = (const char*)(h8e + (size_t)u.pm * 256 * 1024); }
        else { x -= n0; tile_map(x, T_ / 256, 8, u.pm, u.pn); u.kind = 1; u.nt = 16; u.f8 = 0; u.b = (const char*)(WqT + (size_t)u.pn * 256 * 1024); u.a = (const char*)(hb + (size_t)u.pm * 256 * 1024); }
        return true; } };
struct EpiE2g { const bf16_t* hb; bf16_t* Pbuf; const float* gsc;
    __device__ __forceinline__ void operator()(const f32x4 (&acc)[2][2][4][2], const pg8::Unit& u, int wr, int wc, int fr, int fq, int tid) const {
        int row0 = u.pm * 256 + wr * 64 + fr, col0 = u.pn * 256 + wc * 32 + 8 * fq; OPAQUE(row0); OPAQUE(col0);
#pragma unroll
        for (int bj = 0; bj < 2; ++bj) { const float* sp = gsc + 4096 + col0 + bj * 128; const f32x4 s0 = *(const f32x4*)sp, s1 = *(const f32x4*)(sp + 4);
            const size_t cb = (size_t)row0 * 1024 + col0 + bj * 128; const bf16_t* hp = hb + cb; bf16_t* pp = Pbuf + cb;
#pragma unroll
            for (int ai = 0; ai < 2; ++ai)
#pragma unroll
                for (int mp = 0; mp < 2; ++mp) { u32x4 y[2], hw[2];
#pragma unroll
                    for (int q = 0; q < 2; ++q) { const int ro = (ai * 128 + (2 * mp + q) * 16) * 1024; y[q] = *(const u32x4*)(pp + ro); hw[q] = *(const u32x4*)(hp + ro); }
#pragma unroll
                    for (int q = 0; q < 2; ++q) { const int m = 2 * mp + q; const int ro = (ai * 128 + m * 16) * 1024; const f32x4 v0 = acc[ai][bj][m][0] * s0, v1 = acc[ai][bj][m][1] * s1;
                        u32x4 w;
                        w.x = pk2(bflo(hw[q].x) * DN_ALPHA_ + bflo(y[q].x) * sigmoidf_(v0[0]), bfhi(hw[q].x) * DN_ALPHA_ + bfhi(y[q].x) * sigmoidf_(v0[1]));
                        w.y = pk2(bflo(hw[q].y) * DN_ALPHA_ + bflo(y[q].y) * sigmoidf_(v0[2]), bfhi(hw[q].y) * DN_ALPHA_ + bfhi(y[q].y) * sigmoidf_(v0[3]));
                        w.z = pk2(bflo(hw[q].z) * DN_ALPHA_ + bflo(y[q].z) * sigmoidf_(v1[0]), bfhi(hw[q].z) * DN_ALPHA_ + bfhi(y[q].z) * sigmoidf_(v1[1]));
                        w.w = pk2(bflo(hw[q].w) * DN_ALPHA_ + bflo(y[q].w) * sigmoidf_(v1[2]), bfhi(hw[q].w) * DN_ALPHA_ + bfhi(y[q].w) * sigmoidf_(v1[3]));
                        *(u32x4*)(pp + ro) = w; }
                    MEMFENCE(); } }
    }
};
__device__ __forceinline__ void phase_E(const KP& p, int l, unsigned char* lds) {
    const Ptrs P = make_ptrs(p.ws, l);
    { SchedE1 S{P.pb, P.PleT, GDIM(), BIDX()}; EpiStoreBf16 E{P.ycat, 1024, P.ycat, 1024}; pg8::gemm_phase((LAS unsigned char*)lds, 256, 256, S, E); }
    { SchedE2<0> S{P.hb, P.h8e, P.PleGT, P.WqT, GDIM(), BIDX()}; EpiE2g E{P.hb, P.ycat, P.gsc}; pg8::gemm_phase<1>((LAS unsigned char*)lds, 1024, 1024, S, E, 1024); }
    { SchedE2<1> S{P.hb, P.h8e, P.PleGT, P.WqT, GDIM(), BIDX()}; EpiStoreBf16 E{P.q, 2048, P.q, 2048}; pg8::gemm_phase<0>((LAS unsigned char*)lds, 1024, 1024, S, E); }
}
__device__ __forceinline__ unsigned mono_key(float f) { const unsigned u = __builtin_bit_cast(unsigned, f); return (u & 0x80000000u) ? ~u : (u | 0x80000000u); }
__device__ __forceinline__ float unmono_key(unsigned k) { const unsigned u = (k & 0x80000000u) ? (k ^ 0x80000000u) : ~k; return __builtin_bit_cast(float, u); }
struct CandTab { int a[50], b[50]; };
constexpr CandTab make_cand() { CandTab t{}; int n = 0; for (int a = 0; a < 16; ++a) for (int b = 0; b < 16; ++b) if ((a + 1) * (b + 1) <= 16) { t.a[n] = a; t.b[n] = b; ++n; } return t; }
constexpr CandTab CAND = make_cand();
constexpr int PK_PITCH = 136;

#define PK_CE(x, y) do { const unsigned _a = (x), _b = (y); (x) = _a > _b ? _a : _b; (y) = _a > _b ? _b : _a; } while (0)
__device__ __forceinline__ void bitonic_merge16_desc(unsigned (&a)[16]) {
#pragma unroll
    for (int j = 8; j > 0; j >>= 1)
#pragma unroll
        for (int i = 0; i < 16; ++i) { const int l = i ^ j; if (l > i) PK_CE(a[i], a[l]); }
}
__device__ __forceinline__ void bitonic_sort16_desc(unsigned (&a)[16]) {
#pragma unroll
    for (int k = 2; k <= 16; k <<= 1)
#pragma unroll
        for (int j = k >> 1; j > 0; j >>= 1)
#pragma unroll
            for (int i = 0; i < 16; ++i) { const int l = i ^ j; if (l > i) { if ((i & k) == 0 || k == 16) PK_CE(a[i], a[l]); else PK_CE(a[l], a[i]); } }
}
__device__ __forceinline__ void top_half_merge16(unsigned (&a)[16], const unsigned (&b)[16]) {
#pragma unroll
    for (int i = 0; i < 16; ++i) a[i] = a[i] > b[15 - i] ? a[i] : b[15 - i];
    bitonic_merge16_desc(a);
}
__device__ __forceinline__ void top16_keys(const unsigned (&key)[64], unsigned (&top)[16]) {
    unsigned g0[16], g1[16], g2[16], g3[16];
#pragma unroll
    for (int i = 0; i < 16; ++i) { g0[i] = key[i]; g1[i] = key[16 + i]; g2[i] = key[32 + i]; g3[i] = key[48 + i]; }
    bitonic_sort16_desc(g0); bitonic_sort16_desc(g1); bitonic_sort16_desc(g2); bitonic_sort16_desc(g3);
    top_half_merge16(g0, g1); top_half_merge16(g2, g3); top_half_merge16(g0, g2);
    unsigned pr[16];
#pragma unroll
    for (int i = 0; i < 16; ++i) pr[i] = (unsigned)__shfl_xor((int)g0[i], 32);
    top_half_merge16(g0, pr);
#pragma unroll
    for (int i = 0; i < 16; ++i) top[i] = g0[i];
}
__device__ __forceinline__ void peer_route_unit(const KP& p, const Ptrs& P, int l, int unit, unsigned char* lds) {
    const bf16_t* Ks = (const bf16_t*)lds;
    const int tid = TIDX(), lane = tid & 63, wave = tid >> 6, r32 = lane & 31, hi = lane >> 5;
    const int tok = unit * 32 + r32;
    int kbase = r32 * PK_PITCH + 8 * hi; OPAQUE(kbase);
    unsigned top1[16], top2[16];
#pragma unroll 1
    for (int half = 0; half < 2; ++half) {
        const bf16_t* qp = P.q + (size_t)tok * 2048 + wave * 256 + half * 128 + 8 * hi;
        bf16x8 qf[8];
#pragma unroll
        for (int ks = 0; ks < 8; ++ks) qf[ks] = *(const bf16x8*)(qp + 16 * ks);
        unsigned key[64];
#pragma unroll
        for (int kt = 0; kt < 4; ++kt) { f32x16 acc = {}; const bf16_t* kp = Ks + (half * 128 + 32 * kt) * PK_PITCH + kbase;
#pragma unroll
            for (int ks = 0; ks < 8; ++ks) { const bf16x8 a = *(const bf16x8*)(kp + 16 * ks); acc = MFMA32(a, qf[ks], acc); }
#pragma unroll
            for (int r = 0; r < 16; ++r) { const int idx = 32 * kt + (r & 3) + 8 * (r >> 2) + 4 * hi; key[16 * kt + r] = (mono_key(acc[r]) & ~127u) | (unsigned)(127 - idx); } }
        if (half == 0) top16_keys(key, top1); else top16_keys(key, top2);
        MEMFENCE();
    }
    MEMFENCE();
    int* islot = (int*)(lds + 2 * 128 * PK_PITCH * 2) + (wave * 32 + r32) * 33;
    float v1[16], v2[16];
#pragma unroll
    for (int r = 0; r < 16; ++r) { v1[r] = unmono_key(top1[r] & ~127u); v2[r] = unmono_key(top2[r] & ~127u); islot[16 * hi + r] = 127 - (int)((hi ? top2[r] : top1[r]) & 127u); }
    unsigned ka[16], kb[16];
#pragma unroll
    for (int i = 0; i < 25; ++i) { const int c0 = 2 * i, c1 = 2 * i + 1;
        const float s = hi ? (v1[CAND.a[c1]] + v2[CAND.b[c1]]) : (v1[CAND.a[c0]] + v2[CAND.b[c0]]);
        const unsigned k = (mono_key(s) & ~255u) | (unsigned)(255 - (hi ? 16 * CAND.a[c1] + CAND.b[c1] : 16 * CAND.a[c0] + CAND.b[c0]));
        if (i < 16) ka[i] = k; else kb[i - 16] = k; }
#pragma unroll
    for (int i = 9; i < 16; ++i) kb[i] = 0u;
    bitonic_sort16_desc(ka); bitonic_sort16_desc(kb); top_half_merge16(ka, kb);
    { unsigned pr[16];
#pragma unroll
      for (int i = 0; i < 16; ++i) pr[i] = (unsigned)__shfl_xor((int)ka[i], 32);
      top_half_merge16(ka, pr); }
    WAVE_SYNC();
    float sc[16]; int se[16];
#pragma unroll
    for (int r = 0; r < 16; ++r) { sc[r] = unmono_key(ka[r] & ~255u); se[r] = 0; }
#pragma unroll
    for (int r = 0; r < 8; ++r) { unsigned mlo = ka[r], mhi = ka[8 + r]; OPAQUE(mlo); OPAQUE(mhi);
        const unsigned m = hi ? mhi : mlo; const int ab = 255 - (int)(m & 255u); const int e = islot[ab >> 4] * 128 + islot[16 + (ab & 15)];
        if (hi) se[8 + r] = e; else se[r] = e; }
    WAVE_SYNC();
    float g[16]; float sum = 0.f;
#pragma unroll
    for (int r = 0; r < 16; ++r) { g[r] = __expf(sc[r] - sc[0]); sum += g[r]; }
    const float inv = 1.0f / sum;
    const size_t ob = (size_t)tok * 128 + wave * 16 + 8 * hi;
    if (hi == 0) {
        *(u32x4*)(P.eid + ob) = (u32x4){(unsigned)se[0], (unsigned)se[1], (unsigned)se[2], (unsigned)se[3]}; *(u32x4*)(P.eid + ob + 4) = (u32x4){(unsigned)se[4], (unsigned)se[5], (unsigned)se[6], (unsigned)se[7]};
        *(f32x4*)(P.gate + ob) = (f32x4){g[0] * inv, g[1] * inv, g[2] * inv, g[3] * inv}; *(f32x4*)(P.gate + ob + 4) = (f32x4){g[4] * inv, g[5] * inv, g[6] * inv, g[7] * inv};
    } else {
        *(u32x4*)(P.eid + ob) = (u32x4){(unsigned)se[8], (unsigned)se[9], (unsigned)se[10], (unsigned)se[11]}; *(u32x4*)(P.eid + ob + 4) = (u32x4){(unsigned)se[12], (unsigned)se[13], (unsigned)se[14], (unsigned)se[15]};
        *(f32x4*)(P.gate + ob) = (f32x4){g[8] * inv, g[9] * inv, g[10] * inv, g[11] * inv}; *(f32x4*)(P.gate + ob + 4) = (f32x4){g[12] * inv, g[13] * inv, g[14] * inv, g[15] * inv};
    }
}
__device__ __forceinline__ void phase_F(const KP& p, int l, unsigned char* lds) {
    const Ptrs P = make_ptrs(p.ws, l);
    bf16_t* Ks = (bf16_t*)lds; const int tid = TIDX();
    for (int e = tid; e < 2 * 128 * 16; e += NTHR) { const int row = e >> 4, ch = e & 15; *(u32x4*)(Ks + row * PK_PITCH + ch * 8) = *(const u32x4*)(P.K12 + row * 128 + ch * 8); }
    __syncthreads();
    for (int u = BIDX(); u < T_ / 32; u += GDIM()) peer_route_unit(p, P, l, u, lds);
    __syncthreads();
}
constexpr int PG_TB = (T_ >= 4096 ? 128 : 64), PG_NBLK = T_ / PG_TB;
__device__ __forceinline__ int peer_next_item(unsigned* cnt, int* slot, int tid) {
    __syncthreads();
    if (tid == 0) *slot = (int)atomicAdd(cnt, 1u);
    __syncthreads();
    return *slot;
}
constexpr int PG_TPW = PG_TB / NWAVE;
static_assert(PG_TPW >= 4 && PG_TPW % 2 == 0, "token pipeline depth");
constexpr int PG_WLDS = 6144;
__device__ __forceinline__ void pg_issue_rows(const unsigned char* T8, int x, int c8, int gq, int lane, int e0, int e1, int* E, u32x4 (&rb)[16]) {
    WAVE_SYNC(); E[lane] = e0; E[64 + lane] = e1; WAVE_SYNC();
#pragma unroll
    for (int k = 0; k < 16; ++k) { const unsigned off = ((unsigned)(x * NEXP) + (unsigned)E[gq + 8 * k]) * 128u + 16u * (unsigned)c8; rb[k] = *(const u32x4*)(T8 + off); }
}
template <bool REFILL, int TAG>
__device__ __forceinline__ void pg_dots_compute(const Ptrs& P, int x, int t, u32x4 (&ub)[16], u32x4 xa, u32x4 xb, float* R, const int* E, int c8, int gq, int lane) {
    const f32x2 x0 = (f32x2){bflo(xa.x), bfhi(xa.x)}, x1 = (f32x2){bflo(xa.y), bfhi(xa.y)}, x2 = (f32x2){bflo(xa.z), bfhi(xa.z)}, x3 = (f32x2){bflo(xa.w), bfhi(xa.w)};
    const f32x2 x4 = (f32x2){bflo(xb.x), bfhi(xb.x)}, x5 = (f32x2){bflo(xb.y), bfhi(xb.y)}, x6 = (f32x2){bflo(xb.z), bfhi(xb.z)}, x7 = (f32x2){bflo(xb.w), bfhi(xb.w)};
    WAVE_SYNC();
    unsigned off[8];
    const unsigned char* ubase = P.U8;
#pragma unroll
    for (int k = 0; k < 16; ++k) { PIN1(ub[k]);
        if (REFILL && (k & 7) == 0) {
#pragma unroll
            for (int j = 0; j < 8; ++j) off[j] = ((unsigned)(x * NEXP) + (unsigned)E[gq + 8 * (k + j)]) * 128u + 16u * (unsigned)c8; }
        f32x2 s = cvt_pk_f32_fp8_(ub[k][0], false) * x0; s += cvt_pk_f32_fp8_(ub[k][0], true) * x1; s += cvt_pk_f32_fp8_(ub[k][1], false) * x2; s += cvt_pk_f32_fp8_(ub[k][1], true) * x3;
        s += cvt_pk_f32_fp8_(ub[k][2], false) * x4; s += cvt_pk_f32_fp8_(ub[k][2], true) * x5; s += cvt_pk_f32_fp8_(ub[k][3], false) * x6; s += cvt_pk_f32_fp8_(ub[k][3], true) * x7;
        R[k * 64 + lane] = s.x + s.y;
        if (REFILL) { GLOAD16_RW_S(ub[k], ubase, off[k & 7]); }
        if (TAG) TAG_B(); else TAG_A();
        SCHED_FENCE(); }
    WAVE_SYNC();
    const f32x4 a0 = *(const f32x4*)(R + 8 * lane), a1 = *(const f32x4*)(R + 8 * lane + 4), b0 = *(const f32x4*)(R + 512 + 8 * lane), b1 = *(const f32x4*)(R + 512 + 8 * lane + 4);
    float* pd = P.pd + ((size_t)x * T_ + t) * 128;
    pd[lane] = ((a0[0] + a0[1]) + (a0[2] + a0[3])) + ((a1[0] + a1[1]) + (a1[2] + a1[3]));
    pd[64 + lane] = ((b0[0] + b0[1]) + (b0[2] + b0[3])) + ((b1[0] + b1[1]) + (b1[2] + b1[3]));
}
#define PG_PIN16(v) do { _Pragma("unroll") for (int _k = 0; _k < 16; ++_k) PIN1(v[_k]); } while (0)
__device__ __forceinline__ void peer_dots_item(const Ptrs& P, int x, int blk, unsigned char* lds, int lane, int wave) {
    float* R = (float*)(lds + wave * PG_WLDS); int* E = (int*)(lds + wave * PG_WLDS + 4096);
    const int gq = lane >> 3, c8 = lane & 7, tb = blk * PG_TB + PG_TPW * wave;
    u32x4 uA[16], uB[16], xa0, xb0, xa1, xb1;
    const bf16_t* hbase = P.hb; const int* ebase = P.eid; const unsigned char* ubase = P.U8;
    const unsigned xo = (unsigned)((tb * 1024 + 128 * x + 16 * c8) * 2), eo = (unsigned)((tb * 128 + lane) * 4);
    int ea0, ea1, eb0, eb1;
    { const int* ep = P.eid + (size_t)tb * 128 + lane; ea0 = ep[0]; ea1 = ep[64]; eb0 = ep[128]; eb1 = ep[192]; }
    WAVE_SYNC(); E[lane] = ea0; E[64 + lane] = ea1; WAVE_SYNC();
#pragma unroll
    for (int k = 0; k < 16; ++k) { const unsigned off = ((unsigned)(x * NEXP) + (unsigned)E[gq + 8 * k]) * 128u + 16u * (unsigned)c8; GLOAD16_S(uA[k], ubase, off); }
    GLOAD16_S(xa0, hbase, xo); GLOAD16_S(xb0, hbase, xo + 16u); GLOAD4_S(ea0, ebase, eo + 2u * 512u); GLOAD4_S(ea1, ebase, eo + 2u * 512u + 256u);
    WAVE_SYNC(); E[lane] = eb0; E[64 + lane] = eb1; WAVE_SYNC();
#pragma unroll
    for (int k = 0; k < 16; ++k) { const unsigned off = ((unsigned)(x * NEXP) + (unsigned)E[gq + 8 * k]) * 128u + 16u * (unsigned)c8; GLOAD16_S(uB[k], ubase, off); }
    GLOAD16_S(xa1, hbase, xo + 2048u); GLOAD16_S(xb1, hbase, xo + 2048u + 16u); GLOAD4_S(eb0, ebase, eo + 3u * 512u); GLOAD4_S(eb1, ebase, eo + 3u * 512u + 256u);
#pragma unroll
    for (int i = 0; i < PG_TPW; i += 2) {
        if (i == 0) WAIT_VM(20); else WAIT_VM(22);
        PIN4(xa0, xb0, ea0, ea1);
        if (i + 2 < PG_TPW) { WAVE_SYNC(); E[lane] = ea0; E[64 + lane] = ea1; WAVE_SYNC();
            pg_dots_compute<true, 0>(P, x, tb + i, uA, xa0, xb0, R, E, c8, gq, lane);
            const unsigned nx = (unsigned)((i + 4 < PG_TPW) ? i + 4 : PG_TPW - 1), xo2 = xo + (unsigned)(i + 2) * 2048u;
            GLOAD16_S(xa0, hbase, xo2); GLOAD16_S(xb0, hbase, xo2 + 16u); GLOAD4_S(ea0, ebase, eo + nx * 512u); GLOAD4_S(ea1, ebase, eo + nx * 512u + 256u); }
        else pg_dots_compute<false, 0>(P, x, tb + i, uA, xa0, xb0, R, E, c8, gq, lane);
        if (i + 2 < PG_TPW) WAIT_VM(22); else WAIT_VM(0);
        PIN4(xa1, xb1, eb0, eb1);
        if (i + 3 < PG_TPW) { WAVE_SYNC(); E[lane] = eb0; E[64 + lane] = eb1; WAVE_SYNC();
            pg_dots_compute<true, 1>(P, x, tb + i + 1, uB, xa1, xb1, R, E, c8, gq, lane);
            const unsigned nx = (unsigned)((i + 5 < PG_TPW) ? i + 5 : PG_TPW - 1), xo2 = xo + (unsigned)(i + 3) * 2048u;
            GLOAD16_S(xa1, hbase, xo2); GLOAD16_S(xb1, hbase, xo2 + 16u); GLOAD4_S(eb0, ebase, eo + nx * 512u); GLOAD4_S(eb1, ebase, eo + nx * 512u + 256u); }
        else pg_dots_compute<false, 1>(P, x, tb + i + 1, uB, xa1, xb1, R, E, c8, gq, lane);
    }
}
__device__ __forceinline__ void pg_acc_compute(bf16_t* outp, int x, int t, const u32x4 (&vb)[16], float w0, float w1, unsigned oprev, float* C, float* W, int gq, int lane) {
    WAVE_SYNC(); W[lane] = w0; W[64 + lane] = w1; WAVE_SYNC();
    f32x2 acc[8];
#pragma unroll
    for (int q = 0; q < 8; ++q) acc[q] = (f32x2){0.f, 0.f};
#pragma unroll
    for (int k = 0; k < 16; ++k) { const float wk = W[gq + 8 * k];
#pragma unroll
        for (int q = 0; q < 4; ++q) { acc[2 * q] += cvt_pk_f32_fp8_(vb[k][q], false) * wk; acc[2 * q + 1] += cvt_pk_f32_fp8_(vb[k][q], true) * wk; } }
    WAVE_SYNC();
#pragma unroll
    for (int q = 0; q < 4; ++q) *(f32x4*)(C + lane * 16 + 4 * q) = (f32x4){acc[2 * q].x, acc[2 * q].y, acc[2 * q + 1].x, acc[2 * q + 1].y};
    WAVE_SYNC();
    f32x2 s = (f32x2){0.f, 0.f};
#pragma unroll
    for (int g = 0; g < 8; ++g) s += *(const f32x2*)(C + g * 128 + 2 * lane);
    *(unsigned*)(outp + (size_t)t * 1024 + 128 * x + 2 * lane) = pk2(bflo(oprev) + s.x, bfhi(oprev) + s.y);
}
__device__ __forceinline__ void peer_acc_item(bf16_t* outp, const Ptrs& P, int x, int blk, unsigned char* lds, int lane, int wave) {
    float* C = (float*)(lds + wave * PG_WLDS); int* E = (int*)(lds + wave * PG_WLDS + 4096); float* W = (float*)(lds + wave * PG_WLDS + 4608);
    const int gq = lane >> 3, c8 = lane & 7, tb = blk * PG_TB + PG_TPW * wave;
    u32x4 vA[16], vB[16]; unsigned oA, oB;
    const int* ep = P.eid + (size_t)tb * 128 + lane; const float* wp = P.gate + (size_t)tb * 128 + lane; const bf16_t* op = outp + (size_t)tb * 1024 + 128 * x + 2 * lane;
    int ea0 = ep[0], ea1 = ep[64], eb0 = ep[128], eb1 = ep[192]; float wa0 = wp[0], wa1 = wp[64], wb0 = wp[128], wb1 = wp[192];
    pg_issue_rows(P.V8, x, c8, gq, lane, ea0, ea1, E, vA); oA = *(const unsigned*)op;
#pragma unroll 1
    for (int i = 0; i < PG_TPW; i += 2) {
        pg_issue_rows(P.V8, x, c8, gq, lane, eb0, eb1, E, vB); oB = *(const unsigned*)(op + (size_t)(i + 1) * 1024);
        if (i + 2 < PG_TPW) { ea0 = ep[(i + 2) * 128]; ea1 = ep[(i + 2) * 128 + 64]; }
        pg_acc_compute(outp, x, tb + i, vA, wa0, wa1, oA, C, W, gq, lane);
        if (i + 2 < PG_TPW) { wa0 = wp[(i + 2) * 128]; wa1 = wp[(i + 2) * 128 + 64]; pg_issue_rows(P.V8, x, c8, gq, lane, ea0, ea1, E, vA); oA = *(const unsigned*)(op + (size_t)(i + 2) * 1024); }
        if (i + 3 < PG_TPW) { eb0 = ep[(i + 3) * 128]; eb1 = ep[(i + 3) * 128 + 64]; }
        pg_acc_compute(outp, x, tb + i + 1, vB, wb0, wb1, oB, C, W, gq, lane);
        if (i + 3 < PG_TPW) { wb0 = wp[(i + 3) * 128]; wb1 = wp[(i + 3) * 128 + 64]; }
    }
}
template <int STAGE, int CSET = STAGE>
__device__ __forceinline__ void phase_G12(const KP& p, int l, unsigned char* lds) {
    const Ptrs P = make_ptrs(p.ws, l);
    const int tid = TIDX(), lane = tid & 63, wave = tid >> 6;
    int* slot = (int*)(lds + 8 * PG_WLDS);
    const int myx = XCC_ID();
    for (int s = 0; s < 8; ++s) { const int x = (myx + s) & 7; unsigned* cnt = P.qcnt + (CSET * 8 + x) * 16;
        for (;;) { const int blk = peer_next_item(cnt, slot, tid); if (blk >= PG_NBLK) break;
            if (STAGE == 0) peer_dots_item(P, x, blk, lds, lane, wave); else peer_acc_item(CSET == 3 ? (bf16_t*)P.pd : P.ycat, P, x, blk, lds, lane, wave); } }
    __syncthreads();
}
__device__ __forceinline__ void phase_G1b(const KP& p, int l, unsigned char* lds) {
    const Ptrs P = make_ptrs(p.ws, l);
    const size_t stride = (size_t)GDIM() * NTHR, n = (size_t)T_ * 128;
    for (size_t i0 = (size_t)BIDX() * NTHR + TIDX(); i0 < n; i0 += 4 * stride) { float d[4], gt[4], su[4], sv[4]; int e[4];
#pragma unroll
        for (int q = 0; q < 4; ++q) { const size_t i = i0 + q * stride; e[q] = 0; gt[q] = 0.f; d[q] = 0.f; if (i < n) { e[q] = P.eid[i]; gt[q] = P.gate[i]; } }
#pragma unroll
        for (int q = 0; q < 4; ++q) { const size_t i = i0 + q * stride; su[q] = P.su[e[q]]; sv[q] = P.sv[e[q]];
            if (i < n) {
#pragma unroll
                for (int x = 0; x < 8; ++x) d[q] += P.pd[(size_t)x * T_ * 128 + i]; } }
#pragma unroll
        for (int q = 0; q < 4; ++q) { const size_t i = i0 + q * stride; if (i < n) P.gate[i] = gt[q] * sv[q] * gelu_erf(d[q] * su[q]); } }
#ifdef CPU_EMU
    (void)lds;
#endif
}
__device__ __forceinline__ void phase_G3(const KP& p, int l, unsigned char* lds, bool last) {
    const Ptrs P = make_ptrs(p.ws, l);
    const int tid = TIDX(), lane = tid & 63, wave = tid >> 6; const int gw = BIDX() * NWAVE + wave, NGW = GDIM() * NWAVE;
    for (int m = 4 * gw; m < T_; m += 4 * NGW) ln_rows<4, true>(P.ycat + (size_t)m * 1024, p.in[I_LN2G] + l * 1024, p.in[I_LN2B] + l * 1024, last ? p.out + (size_t)m * 1024 : (float*)nullptr, last ? (bf16_t*)nullptr : P.hb + (size_t)m * 1024,
                                                           last ? (unsigned char*)nullptr : (m < H8_SPLIT ? P.h8a + (size_t)m * 1024 : P.h8b + (size_t)(m - H8_SPLIT) * 1024), lane);
}
#ifndef PROBE_REPEAT
#define PROBE_REPEAT 0
#endif
constexpr int LDS_BYTES = 147456;
__device__ __forceinline__ void phase_B1(const KP& p, int l, unsigned char* lds) {
    const Ptrs P = make_ptrs(p.ws, l);
    constexpr int NRC = NB_ * 4 * RW_NCH, NS5 = NB_ * 16, NFX = NB_ * 4 * (S_ / 256), NCV = T_ / 64;
    const int G = GDIM(); int it = BIDX();
    for (; it < NRC; it += G) rw_chunk_unit(p, P, l, it, lds);
#if PROBE_REPEAT == 16
    for (int j = BIDX(); j < NRC; j += G) rw_chunk_unit(p, P, l, j, lds);
#endif
#if PROBE_REPEAT >= 161 && PROBE_REPEAT <= 163
    for (int j = BIDX(); j < NRC; j += G) { rw_chunk_unit<PROBE_REPEAT - 160>(p, P, l, j, lds); __syncthreads(); }
#endif
    for (; it < NRC + NFX; it += G) fox_unit(p, P, l, it - NRC, lds);
#if PROBE_REPEAT == 17
    for (int j = BIDX(); j < NFX; j += G) fox_unit(p, P, l, j, lds);
#endif
    for (; it < NRC + NFX + NS5; it += G) s5_unit(p, P, l, it - NRC - NFX, lds);
#if PROBE_REPEAT == 18
    for (int j = BIDX(); j < NS5; j += G) s5_unit(p, P, l, j, lds);
#endif
    for (; it < NRC + NFX + NS5 + NCV; it += G) conv_unit(p, P, l, it - NRC - NFX - NS5, lds);
#if PROBE_REPEAT == 19
    for (int j = BIDX(); j < NCV; j += G) conv_unit(p, P, l, j, lds);
#endif
}
__device__ __forceinline__ void phase_B3(const KP& p, int l, unsigned char* lds) {
    const Ptrs P = make_ptrs(p.ws, l);
#if PROBE_REPEAT == 34
    for (int it = BIDX(); it < NB_ * 4 * RW_NCH; it += GDIM()) rw_out_unit<true>(p, P, l, it, lds);
#endif
    for (int it = BIDX(); it < NB_ * 4 * RW_NCH; it += GDIM()) rw_out_unit<false>(p, P, l, it, lds);
}
enum { PH_PRO = 0, PH_A, PH_B1, PH_B2, PH_B3, PH_C, PH_D, PH_D2, PH_E, PH_F, PH_G, PH_G1B, PH_G2, PH_G3, PH_N, PH_A0 };
__device__ __forceinline__ void run_phase(const KP& p, int ph, int l, unsigned char* lds) {
    switch (ph) {
        case PH_PRO: phase_prologue(p, lds); break;
        case PH_A: phase_A(p, l, lds); break;
        case PH_A0: phase_A0(p, lds); break;
        case PH_B1: phase_B1(p, l, lds); break;
        case PH_B2: phase_B2(p, l, lds); break;
        case PH_B3: phase_B3(p, l, lds); break;
        case PH_C: phase_C(p, l, lds); break;
        case PH_D: phase_D(p, l, lds); break;
        case PH_D2: phase_D2(p, l, lds); break;
        case PH_E: phase_E(p, l, lds); break;
        case PH_F: phase_F(p, l, lds); break;
        case PH_G: phase_G12<0>(p, l, lds); break;
        case PH_G1B: phase_G1b(p, l, lds); break;
        case PH_G2: phase_G12<1>(p, l, lds); break;
        case PH_G3: phase_G3(p, l, lds, l == L_ - 1); break;
        default: break;
    }
}
#ifndef CPU_EMU
#define XB_TMO      128
#define XB_XCNT(j)  (256  + 64 * (j))
#define XB_XSUB(j)  (1280 + 64 * (j))
#define XB_XGEN(j)  (2304 + 64 * (j))
#define XB_TOP      3328
#define XB_TOPGEN   3392
#define XCD_BAR_WORDS 3456
#define XB_SPIN_CAP (1u << 22)
__device__ __forceinline__ unsigned xb_ld(unsigned* p)              { return __hip_atomic_load(p, __ATOMIC_RELAXED, __HIP_MEMORY_SCOPE_AGENT); }
__device__ __forceinline__ unsigned xb_add(unsigned* p, unsigned v) { return __hip_atomic_fetch_add(p, v, __ATOMIC_RELAXED, __HIP_MEMORY_SCOPE_AGENT); }
__device__ __forceinline__ unsigned xb_xcc_id() { return (unsigned)__builtin_amdgcn_s_getreg((3 << 11) | 20) & 0xFu; }
#define XB_SPIN(cond, bar) do { unsigned _sp = 0; while (cond) { __builtin_amdgcn_s_sleep(1); \
    if ((++_sp & 255u) == 0u) { if (xb_ld(&(bar)[XB_TMO])) break; if (_sp > XB_SPIN_CAP) { atomicAdd(&(bar)[XB_TMO], 1u); break; } } } } while (0)
struct XcdBarrier { unsigned* bar; unsigned x; volatile LAS unsigned* st; };
__device__ __forceinline__ XcdBarrier xcd_barrier_post(unsigned* bar, volatile LAS unsigned* st) {
    XcdBarrier b; b.bar = bar; b.x = xb_xcc_id(); b.st = st;
    if (threadIdx.x == 0) (void)xb_add(&bar[XB_XCNT(b.x)], 1u);
    return b;
}
__device__ __forceinline__ void xcd_barrier_complete(unsigned* bar, unsigned x, unsigned& nloc, unsigned& nx) {
    const unsigned G = gridDim.x * gridDim.y * gridDim.z;
    unsigned sum, cnt, mine, sp = 0u;
    for (;;) {
        sum = 0u; cnt = 0u; mine = 0u;
#pragma unroll
        for (unsigned j = 0; j < 16; ++j) { const unsigned c = xb_ld(&bar[XB_XCNT(j)]); sum += c; cnt += (c > 0u) ? 1u : 0u; mine = (j == x) ? c : mine; }
        if (sum == G) break;
        __builtin_amdgcn_s_sleep(1);
        if ((++sp & 255u) == 0u) { if (xb_ld(&bar[XB_TMO])) break; if (sp > XB_SPIN_CAP) { atomicAdd(&bar[XB_TMO], 1u); break; } }
    }
    nloc = mine > 0u ? mine : 1u; nx = cnt > 0u ? cnt : 1u;
}
__device__ __forceinline__ void xcd_barrier(const XcdBarrier& b) {
    asm volatile("s_waitcnt vmcnt(0)" ::: "memory");
    __syncthreads();
    if (threadIdx.x == 0) {
        unsigned* bar = b.bar;
        __builtin_amdgcn_s_waitcnt(0);
        unsigned nloc = b.st[0], nx = b.st[1];
        if (nloc == 0u) { xcd_barrier_complete(bar, b.x, nloc, nx); b.st[0] = nloc; b.st[1] = nx; }
        const unsigned old = xb_add(&bar[XB_XSUB(b.x)], 1u);
        const unsigned gen = old / nloc;
        if (old + 1u == (gen + 1u) * nloc) {
            __builtin_amdgcn_fence(__ATOMIC_RELEASE, "agent");
            asm volatile("s_waitcnt vmcnt(0)" ::: "memory");
            const unsigned og = xb_add(&bar[XB_TOP], 1u);
            const unsigned tg = og / nx;
            if (og + 1u == (tg + 1u) * nx) xb_add(&bar[XB_TOPGEN], 1u);
            else XB_SPIN(xb_ld(&bar[XB_TOPGEN]) == tg, bar);
            __builtin_amdgcn_fence(__ATOMIC_ACQUIRE, "agent");
            xb_add(&bar[XB_XGEN(b.x)], 1u);
            asm volatile("s_waitcnt vmcnt(0)" ::: "memory");
        } else {
            XB_SPIN(xb_ld(&bar[XB_XGEN(b.x)]) == gen, bar);
            __builtin_amdgcn_fence(__ATOMIC_ACQUIRE, "agent");
            asm volatile("s_waitcnt vmcnt(0)" ::: "memory");
        }
    }
    __syncthreads();
}
#ifndef PROBE_REPEAT
#define PROBE_REPEAT 0
#endif
#ifndef N_LAUNCH_MODE
#define N_LAUNCH_MODE 1
#endif
extern __shared__ __attribute__((aligned(16))) unsigned char lds_dyn[];
#if N_LAUNCH_MODE == 0
template <int PH> __global__ void __launch_bounds__(NTHR, 2) k_phase_t(KP p) { run_phase(p, PH, p.layer, lds_dyn); }
typedef void (*kfn_t)(KP);
static kfn_t phase_fn(int ph) { switch (ph) { case PH_PRO: return k_phase_t<PH_PRO>; case PH_A: return k_phase_t<PH_A>; case PH_B1: return k_phase_t<PH_B1>; case PH_B2: return k_phase_t<PH_B2>; case PH_B3: return k_phase_t<PH_B3>; case PH_C: return k_phase_t<PH_C>;
    case PH_D: return k_phase_t<PH_D>; case PH_D2: return k_phase_t<PH_D2>; case PH_E: return k_phase_t<PH_E>; case PH_F: return k_phase_t<PH_F>; case PH_G: return k_phase_t<PH_G>; case PH_G1B: return k_phase_t<PH_G1B>; case PH_G2: return k_phase_t<PH_G2>; default: return k_phase_t<PH_G3>; } }
#else
#ifndef USE_XCD_BARRIER
#define USE_XCD_BARRIER 1
#endif
constexpr int BAR_LDS_OFF = LDS_BYTES - 64;
#if USE_XCD_BARRIER
#define GSYNC() xcd_barrier(bar)
#define GSYNC_ARG const XcdBarrier& bar
#else
#define GSYNC() grid.sync()
#define GSYNC_ARG cg::grid_group& grid
#endif
template <int l>
__device__ __forceinline__ void mega_layer(const KP& p, GSYNC_ARG) {
#if PROBE_REPEAT == 47 || PROBE_REPEAT == 48
        phase_Aprobe<PROBE_REPEAT - 40>(p, l, lds_dyn); GSYNC();
#endif
        phase_A(p, l, lds_dyn);
#if PROBE_REPEAT == 1
        GSYNC(); phase_A(p, l, lds_dyn);
#endif
#if PROBE_REPEAT >= 40 && PROBE_REPEAT <= 46
        GSYNC(); phase_Aprobe<PROBE_REPEAT - 40>(p, l, lds_dyn);
#endif
        GSYNC(); phase_B1(p, l, lds_dyn);
#if PROBE_REPEAT == 2
        GSYNC(); phase_B1(p, l, lds_dyn);
#endif
        GSYNC(); phase_B2(p, l, lds_dyn);
        GSYNC(); phase_B3(p, l, lds_dyn);
        GSYNC(); phase_C(p, l, lds_dyn);
#if PROBE_REPEAT == 4
        GSYNC(); phase_C(p, l, lds_dyn);
#endif
        GSYNC(); phase_D(p, l, lds_dyn);
        GSYNC(); phase_D2(p, l, lds_dyn);
        GSYNC(); phase_E(p, l, lds_dyn);
        GSYNC(); phase_F(p, l, lds_dyn);
#if PROBE_REPEAT == 8
        GSYNC(); phase_F(p, l, lds_dyn);
#endif
        GSYNC(); phase_G12<0>(p, l, lds_dyn);
#if PROBE_REPEAT == 32
        GSYNC(); phase_G12<0, 2>(p, l, lds_dyn);
#endif
        GSYNC(); phase_G1b(p, l, lds_dyn);
        GSYNC(); phase_G12<1>(p, l, lds_dyn);
#if PROBE_REPEAT == 33
        GSYNC(); phase_G12<1, 3>(p, l, lds_dyn);
#endif
        GSYNC(); phase_G3(p, l, lds_dyn, l == L_ - 1);
}
__global__ void __launch_bounds__(NTHR, 2) k_mega(KP p) {
    cg::grid_group grid = cg::this_grid();
#if USE_XCD_BARRIER
    volatile LAS unsigned* st = (volatile LAS unsigned*)(lds_dyn + BAR_LDS_OFF);
    if (threadIdx.x < 2) st[threadIdx.x] = 0u;
    __syncthreads();
    const XcdBarrier bar = xcd_barrier_post((unsigned*)(p.ws + WS_CTL) + 4096, st);
#define GSYNC_VAL bar
#else
#define GSYNC_VAL grid
#endif
    phase_prologue(p, lds_dyn);
#if PROBE_REPEAT == 60
    GSYNC(); phase_prologue(p, lds_dyn);
#endif
    grid.sync();
    phase_A0(p, lds_dyn);
    GSYNC();
    mega_layer<0>(p, GSYNC_VAL);
    static_assert(L_ == 2, "two layers");
    GSYNC();
    mega_layer<1>(p, GSYNC_VAL);
}
#endif
extern "C" void kernel_launch(void* const* d_in, const int* in_sizes, int n_in, void* d_out, int out_size, void* d_ws, size_t ws_size, hipStream_t stream) {
    static int grid = 0;
    if (grid == 0) {
        if (n_in != N_IN || out_size != T_ * 1024 || ws_size < WS_END) { fprintf(stderr, "kernel_launch: unexpected shapes (n_in %d out %d ws %zu need %zu)\n", n_in, out_size, ws_size, (size_t)WS_END); grid = -1; return; }
        int dev = 0, cus = 0, per_cu = 0;
        (void)hipGetDevice(&dev); (void)hipDeviceGetAttribute(&cus, hipDeviceAttributeMultiprocessorCount, dev);
#if N_LAUNCH_MODE == 0
        for (int ph = 0; ph < PH_N; ++ph) (void)hipFuncSetAttribute((const void*)phase_fn(ph), hipFuncAttributeMaxDynamicSharedMemorySize, LDS_BYTES);
        (void)per_cu;
#else
        (void)hipFuncSetAttribute((const void*)k_mega, hipFuncAttributeMaxDynamicSharedMemorySize, LDS_BYTES);
        (void)hipOccupancyMaxActiveBlocksPerMultiprocessor(&per_cu, (const void*)k_mega, NTHR, LDS_BYTES);
        if (per_cu < 1) { fprintf(stderr, "kernel_launch: occupancy query says %d blocks per CU\n", per_cu); grid = -1; return; }
#endif
        grid = cus;
    }
    if (grid < 0) return;
    if (hipMemsetAsync((char*)d_ws + WS_CTL, 0, 65536, stream) != hipSuccess) { fprintf(stderr, "kernel_launch: memset failed\n"); return; }
    KP p{};
    for (int i = 0; i < N_IN; ++i) p.in[i] = (const float*)d_in[i];
    p.out = (float*)d_out; p.ws = (unsigned char*)d_ws;
#if N_LAUNCH_MODE == 1
    void* args[] = {&p};
    hipError_t e = hipLaunchCooperativeKernel((const void*)k_mega, dim3(grid), dim3(NTHR), args, LDS_BYTES, stream);
    if (e != hipSuccess) fprintf(stderr, "cooperative launch failed: %s (grid %d)\n", hipGetErrorString(e), grid);
#else
    p.phase = PH_PRO; p.layer = 0; hipLaunchKernelGGL(phase_fn(PH_PRO), dim3(grid), dim3(NTHR), LDS_BYTES, stream, p);
    for (int l = 0; l < L_; ++l) for (int ph = PH_A; ph < PH_N; ++ph) { p.phase = ph; p.layer = l; hipLaunchKernelGGL(phase_fn(ph), dim3(grid), dim3(NTHR), LDS_BYTES, stream, p); }
#endif
}
#endif
```

```cpp
#ifdef CPU_EMU
#include "emu.h"
#define LAS
#define GET_LDS() ((unsigned char*)emu::lds())
#define AS_GLOBAL(p) (p)
#define AS_LDS(p) (p)
#define RFL(x) (x)
#define MFMA32(a, b, c) emu_mfma32(a, b, c)
#define MFMA16(a, b, c) emu_mfma16(a, b, c)
#define MFMA16_FP8(a, b, c) emu_mfma16_fp8(a, b, c)
#define FAST_EXP2(x) exp2f(x)
#define FAST_RCP(x) (1.0f / (x))
#define FAST_LOG2(x) log2f(x)
#define FAST_RSQ(x) (1.0f / sqrtf(x))
#define WAVE_SYNC() do { uint32_t _z = 0; (void)emu::wave_xchg(&_z, 1); } while (0)
#define OPAQUE(x) do {} while (0)
#define GLDS16(gp, lp, lane) memcpy((char*)(lp) + 16 * (lane), (const void*)(gp), 16)
#define WAIT_VM(n) do {} while (0)
#define GLOAD16_ASM(dst, ptr) (dst) = *(const u32x4*)(ptr)
#define GLOAD16_RW(dst, ptr) (dst) = *(const u32x4*)(ptr)
#define PIN1(a) do {} while (0)
#define GLOAD16_RW_S(dst, base, off) (dst) = *(const u32x4*)((const unsigned char*)(base) + (off))
#define SCHED_FENCE() do {} while (0)
#define TAG_A() do {} while (0)
#define TAG_B() do {} while (0)
#define GLOAD16_S(dst, base, off) (dst) = *(const u32x4*)((const unsigned char*)(base) + (off))
#define GLOAD4_S(dst, base, off) memcpy(&(dst), (const unsigned char*)(base) + (off), 4)
#define GLOAD4_ASM(dst, ptr) (dst) = *(const int*)(ptr)
#define PIN4(a, b, c, d) do {} while (0)
#define PIN2I(a, b) do {} while (0)
#define WAIT_LGKM0() do {} while (0)
#define READLANE_I(v, l) __shfl((int)(v), (l))
#define READLANE_F(v, l) __shfl((float)(v), (l))
#define TIDX() ((int)threadIdx.x)
#define XCC_ID() (emu::bid() & 7)
#define GDIM() ((int)gridDim.x)
#define BIDX() ((int)blockIdx.x)
#define OPAQUE_S(x) do {} while (0)
#define MEMFENCE() do {} while (0)
#else
#include <hip/hip_runtime.h>
#include <hip/hip_cooperative_groups.h>
#include <cstdio>
#include <cstdint>
namespace cg = cooperative_groups;
#define LAS __attribute__((address_space(3)))
#define GAS __attribute__((address_space(1)))
#define AS_GLOBAL(p) ((unsigned char*)(GAS unsigned char*)(p))
#define AS_LDS(p) ((unsigned char*)(LAS unsigned char*)(p))
#define RFL(x) __builtin_amdgcn_readfirstlane(x)
#define MFMA32(a, b, c) __builtin_amdgcn_mfma_f32_32x32x16_bf16(a, b, c, 0, 0, 0)
#define MFMA16(a, b, c) __builtin_amdgcn_mfma_f32_16x16x32_bf16(a, b, c, 0, 0, 0)
#define MFMA16_FP8(a, b, c) __builtin_amdgcn_mfma_f32_16x16x32_fp8_fp8((long)(a), (long)(b), c, 0, 0, 0)
#define MFMA16_F8X128(a, b, c) __builtin_amdgcn_mfma_scale_f32_16x16x128_f8f6f4(a, b, c, 0, 0, 0, 0, 0, 0)
#define FAST_EXP2(x) __builtin_amdgcn_exp2f(x)
#define FAST_RCP(x) __builtin_amdgcn_rcpf(x)
#define FAST_LOG2(x) __builtin_amdgcn_logf(x)
#define FAST_RSQ(x) __builtin_amdgcn_rsqf(x)
#define WAVE_SYNC() __builtin_amdgcn_wave_barrier()
#define OPAQUE(x) asm volatile("" : "+v"(x))
#define GLDS16(gp, lp, lane) __builtin_amdgcn_global_load_lds((const unsigned*)(gp), (LAS unsigned*)(lp), 16, 0, 0)
#define WAIT_VM(n) asm volatile("s_waitcnt vmcnt(" #n ")" ::: "memory")
#define GLOAD16_ASM(dst, ptr) asm volatile("global_load_dwordx4 %0, %1, off" : "=v"(dst) : "v"(ptr) : "memory")
#define GLOAD4_ASM(dst, ptr) asm volatile("global_load_dword %0, %1, off" : "=v"(dst) : "v"(ptr) : "memory")
#define GLOAD16_RW(dst, ptr) asm volatile("global_load_dwordx4 %0, %1, off" : "+v"(dst) : "v"(ptr) : "memory")
#define PIN1(a) asm volatile("" : "+v"(a) :: "memory")
#define GLOAD16_RW_S(dst, base, off) asm volatile("global_load_dwordx4 %0, %1, %2" : "+v"(dst) : "v"(off), "s"(base) : "memory")
#define SCHED_FENCE() __builtin_amdgcn_sched_barrier(0)
#define TAG_A() asm volatile("; buffer A" ::: "memory")
#define TAG_B() asm volatile("; buffer B" ::: "memory")
#define GLOAD16_S(dst, base, off) asm volatile("global_load_dwordx4 %0, %1, %2" : "=v"(dst) : "v"(off), "s"(base) : "memory")
#define GLOAD4_S(dst, base, off) asm volatile("global_load_dword %0, %1, %2" : "=v"(dst) : "v"(off), "s"(base) : "memory")
#define PIN4(a, b, c, d) asm volatile("" : "+v"(a), "+v"(b), "+v"(c), "+v"(d) :: "memory")
#define PIN2I(a, b) asm volatile("" : "+v"(a), "+v"(b) :: "memory")
#define WAIT_LGKM0() asm volatile("s_waitcnt lgkmcnt(0)" ::: "memory")
#define READLANE_I(v, l) __builtin_amdgcn_readlane((int)(v), (l))
#define READLANE_F(v, l) __builtin_bit_cast(float, __builtin_amdgcn_readlane(__builtin_bit_cast(int, (float)(v)), (l)))
#define OPAQUE_S(x) asm volatile("" : "+s"(x))
__device__ __forceinline__ int opaque_tid_() { int t = threadIdx.x; asm volatile("" : "+v"(t)); return t; }
#define TIDX() opaque_tid_()
#define XCC_ID() ((int)(__builtin_amdgcn_s_getreg((3 << 11) | 20) & 7u))
__device__ __forceinline__ int opaque_gdim_() { int t = gridDim.x; asm volatile("" : "+s"(t)); return t; }
__device__ __forceinline__ int opaque_bidx_() { int t = blockIdx.x; asm volatile("" : "+s"(t)); return t; }
#define GDIM() opaque_gdim_()
#define BIDX() opaque_bidx_()
#define MEMFENCE() do { asm volatile("" ::: "memory"); __builtin_amdgcn_sched_barrier(0); } while (0)
#endif

#ifndef CFG_B
#define CFG_B 16
#endif
#ifndef CFG_S
#define CFG_S 2048
#endif

typedef unsigned short bf16_t;
typedef short bf16x8 __attribute__((ext_vector_type(8)));
typedef short s16x4 __attribute__((ext_vector_type(4)));
typedef float f32x4 __attribute__((ext_vector_type(4)));
typedef float f32x2 __attribute__((ext_vector_type(2)));
typedef float f32x16 __attribute__((ext_vector_type(16)));
typedef unsigned u32x4 __attribute__((ext_vector_type(4)));
typedef unsigned u32x2 __attribute__((ext_vector_type(2)));
typedef int i32x4 __attribute__((ext_vector_type(4)));
typedef int i32x8 __attribute__((ext_vector_type(8)));

constexpr int NB_ = CFG_B, S_ = CFG_S, T_ = NB_ * S_, D_ = 1024, L_ = 2;
constexpr int NTHR = 512, NWAVE = 8;
constexpr int PJ = 2304;
constexpr int C_R = 0, C_K = 256, C_V = 512, C_HW = 768, C_HA = 800, C_HG = 832, C_S5 = 896, C_FQ = 1152, C_FK = 1408, C_FL = 1664, C_CV = 1792, C_CG = 2048;
constexpr int WIN_ROWS = 6656, WIN_VT = 2304, WIN_GATE = 2560;
constexpr int IN_COLS = 6532;
constexpr float LN_EPS_ = 1e-5f, GN_EPS_ = 64e-5f;
constexpr float DN_ALPHA_ = 1.4142135623730951f;
constexpr int NEXP = 16384;

enum { I_X = 0, I_P, I_LNIN_G, I_LNIN_B, I_WIN, I_MU, I_W0, I_W2, I_A0, I_A2, I_G2, I_KK, I_KA, I_RK, I_LNXG, I_LNXB, I_LRE, I_LIM, I_BRE, I_BIM, I_CRE, I_CIM,
       I_S5D, I_LDT, I_GLUW, I_GLUB, I_BF, I_CONVW, I_CONVB, I_CLNG, I_CLNB, I_WBR, I_WOUT, I_LN1G, I_LN1B, I_WQ, I_K1, I_K2, I_U, I_V, I_PLEW, I_PLEG, I_LN2G, I_LN2B, N_IN };

constexpr size_t al256(size_t x) { return (x + 255) & ~(size_t)255; }
constexpr size_t WS_CTL = 0;
constexpr size_t WS_WIN = 1u << 20;
constexpr size_t WS_WBR = WS_WIN + al256((size_t)L_ * WIN_ROWS * 1024 * 2);
constexpr size_t WS_WOUT = WS_WBR + (size_t)L_ * 1024 * 1024 * 2;
constexpr size_t WS_WQ = WS_WOUT + (size_t)L_ * 1024 * 1024 * 2;
constexpr size_t WS_PLE = WS_WQ + (size_t)L_ * 2048 * 1024 * 2;
constexpr size_t WS_PLEG = WS_PLE + (size_t)L_ * 1024 * 256 * 2;
constexpr size_t WS_GLU = WS_PLEG + (size_t)L_ * 1024 * 1024 * 2;
constexpr size_t WS_K12 = WS_GLU + (size_t)L_ * 256 * 256 * 2;
constexpr size_t WS_S5KC = WS_K12 + (size_t)L_ * 2 * 128 * 128 * 2;
constexpr size_t WS_S5WX = WS_S5KC + (size_t)L_ * 16 * 64 * 256 * 2;
constexpr size_t WS_S5WY = WS_S5WX + (size_t)L_ * 16 * 128 * 1024 * 2;
constexpr size_t WS_S5LL = WS_S5WY + (size_t)L_ * 16 * 1024 * 128 * 2;
constexpr size_t WS_UT = WS_S5LL + al256((size_t)L_ * 16 * 64 * 2 * 4);
constexpr size_t WS_VT = WS_UT + (size_t)NEXP * 1024 * 2;
constexpr size_t WS_RW = WS_VT + (size_t)NEXP * 1024 * 2;
constexpr size_t RW_SZ = (size_t)T_ * 512;
static_assert(2 * RW_SZ <= (size_t)NEXP * 1024 * 2, "RWKV gate / bonus arrays fit the second table region");
constexpr size_t WS_HB = WS_RW + 4 * RW_SZ;
constexpr size_t WS_R1 = WS_HB + (size_t)T_ * 1024 * 2;
constexpr size_t R1_BYTES = (size_t)T_ * 2560 * 2;
constexpr size_t WS_YC = WS_R1 + R1_BYTES;
constexpr size_t WS_VTR = WS_YC + (size_t)T_ * 1024 * 2;
constexpr size_t WS_PB = WS_VTR + (size_t)256 * T_ * 2;
constexpr size_t WS_H8T = WS_PB + (size_t)T_ * 256 * 2;
constexpr int H8_SPLIT = (T_ / 512) * 256;
constexpr size_t WS_END = WS_H8T + (size_t)(T_ - H8_SPLIT) * 1024;
constexpr size_t R1_PROJ = 0;
constexpr size_t R1_H8 = (size_t)T_ * 2304 * 2;
constexpr size_t R1_MERGED = 0;
constexpr size_t R1_STASH = (size_t)T_ * 1024 * 2;
constexpr size_t R1_Q = 0;
constexpr size_t R1_EID = (size_t)T_ * 2048 * 2;
constexpr size_t R1_GATE = R1_EID + (size_t)T_ * 128 * 4;
static_assert(R1_GATE + (size_t)T_ * 128 * 4 <= R1_BYTES, "R1 map");

struct KP { const float* in[N_IN]; float* out; unsigned char* ws; float* dbg; int layer; int phase; };

#ifdef CPU_EMU
__device__ __forceinline__ unsigned f2bf(float f) { unsigned u = __builtin_bit_cast(unsigned, f); return (u + 0x7fffu + ((u >> 16) & 1u)) >> 16; }
__device__ __forceinline__ unsigned pk2(float lo, float hi) { return f2bf(lo) | (f2bf(hi) << 16); }
#else
typedef __bf16 bf16x2_hw __attribute__((ext_vector_type(2)));
__device__ __forceinline__ unsigned pk2(float lo, float hi) { const f32x2 v = {lo, hi}; return __builtin_bit_cast(unsigned, __builtin_convertvector(v, bf16x2_hw)); }
__device__ __forceinline__ unsigned f2bf(float f) { return pk2(f, 0.f) & 0xffffu; }
#endif
__device__ __forceinline__ float bf2f(unsigned h) { return __builtin_bit_cast(float, h << 16); }
__device__ __forceinline__ float bflo(unsigned w) { return __builtin_bit_cast(float, w << 16); }
__device__ __forceinline__ float bfhi(unsigned w) { return __builtin_bit_cast(float, w & 0xffff0000u); }
__device__ __forceinline__ float sigmoidf_(float x) { return FAST_RCP(1.0f + FAST_EXP2(x * -1.4426950408889634f)); }
__device__ __forceinline__ float gelu_erf(float v) {
    const float t = FAST_RCP(fabsf(v) * 0.2316418882f + 1.0f);
    float q = t * 0.5307027145f + (-0.7265760135f); q = q * t + 0.7107068705f; q = q * t + (-0.142248368f); q = q * t + 0.127414796f; q = q * t;
    const float m = v * (q * FAST_EXP2((v * v) * (-0.72134752044f)));
    return v < 0.f ? m : v - m; }
#ifdef CPU_EMU
inline float fp8_dec_(unsigned b) { const unsigned s = b >> 7, e = (b >> 3) & 15, m = b & 7; float v = (e == 0) ? ldexpf((float)m, -9) : ldexpf(1.f + m * 0.125f, (int)e - 7); return s ? -v : v; }
inline unsigned fp8_enc_(float x) { const unsigned s = x < 0.f ? 0x80u : 0u; float a = fabsf(x); if (!(a > 0.f)) return s; if (a > 448.f) a = 448.f;
    int e; (void)frexpf(a, &e); e -= 1; if (e < -6) e = -6;
    const float q = ldexpf(a, 3 - e); float r = nearbyintf(q);
    unsigned ee, mm; if (e == -6 && r < 8.f) { ee = 0; mm = (unsigned)r; } else { if (r >= 16.f) { r = 8.f; e += 1; } ee = (unsigned)(e + 7); mm = (unsigned)r - 8u; }
    if (ee > 15u || (ee == 15u && mm > 6u)) { ee = 15u; mm = 6u; }
    return s | (ee << 3) | mm; }
inline f32x2 cvt_pk_f32_fp8_(unsigned w, bool hi) { const unsigned h = hi ? (w >> 16) : w; return (f32x2){fp8_dec_(h & 255u), fp8_dec_((h >> 8) & 255u)}; }
inline unsigned cvt_pk_fp8_f32_(float a, float b, unsigned old, bool hi) { const unsigned p = fp8_enc_(a) | (fp8_enc_(b) << 8); return hi ? ((old & 0xffffu) | (p << 16)) : ((old & 0xffff0000u) | p); }
#else
__device__ __forceinline__ f32x2 cvt_pk_f32_fp8_(unsigned w, bool hi) { return hi ? __builtin_amdgcn_cvt_pk_f32_fp8((int)w, true) : __builtin_amdgcn_cvt_pk_f32_fp8((int)w, false); }
__device__ __forceinline__ unsigned cvt_pk_fp8_f32_(float a, float b, unsigned old, bool hi) { return hi ? (unsigned)__builtin_amdgcn_cvt_pk_fp8_f32(a, b, (int)old, true) : (unsigned)__builtin_amdgcn_cvt_pk_fp8_f32(a, b, (int)old, false); }
#endif
__device__ __forceinline__ float wave_max(float v) {
#pragma unroll
  for (int o = 1; o < 64; o <<= 1) v = fmaxf(v, __shfl_xor(v, o));
  return v;
}
template <int N> __device__ __forceinline__ void wave_sum_n(float (&v)[N]) {
#pragma unroll
  for (int o = 1; o < 64; o <<= 1) { float t[N];
#pragma unroll
    for (int i = 0; i < N; ++i) t[i] = __shfl_xor(v[i], o);
#pragma unroll
    for (int i = 0; i < N; ++i) v[i] += t[i]; }
}
__device__ __forceinline__ float wave_sum(float v) {
#pragma unroll
  for (int o = 1; o < 64; o <<= 1) v += __shfl_xor(v, o);
  return v;
}
namespace pg8 {
constexpr int BM = 256, BK = 64, HALF = 128, HTB = HALF * BK * 2, STAGE_BYTES = 8 * HTB;
__host__ __device__ __forceinline__ int lds_byte(int r, int c) { const int st = (r >> 4) * 2 + (c >> 5), rr = r & 15, cc = c & 31, ob = rr * 64 + cc * 2; return st * 1024 + (ob ^ (((ob >> 9) & 1) << 5)); }
__host__ __device__ __forceinline__ void stage_rc(int b, int& R, int& C) { const int st = b / 1024, sb = b % 1024, swz = sb ^ (((sb >> 9) & 1) << 5); R = (st >> 1) * 16 + swz / 64; C = (st & 1) * 32 + (swz % 64) / 2; }
__host__ __device__ __forceinline__ int perm32(int rho) { const int n = rho >> 4, i = rho & 15; return 8 * (i >> 2) + 4 * n + (i & 3); }

struct Unit { const char* a; const char* b; int nt; int kind; int pm; int pn; int aux; int f8; };

#ifndef CPU_EMU
template <int MODE = 0, class Epi, class Sched>
__device__ __forceinline__ void gemm_phase(LAS unsigned char* lds, const int lda, const int ldb, const Sched& S, const Epi& E, const int lda8 = 0) {
    const int tid = TIDX(), wid = __builtin_amdgcn_readfirstlane(tid >> 6), lane = tid & 63, wr = wid >> 2, wc = wid & 3, fr = lane & 15, fq = lane >> 4;
    unsigned voffA[2], voffB[2], voffA8[2];
#pragma unroll
    for (int i = 0; i < 2; ++i) { int R, C; stage_rc(tid * 16 + i * 8192, R, C); const int Rb = (R & ~31) + perm32(R & 31);
        voffA[i] = (unsigned)(R * lda + C) * 2u; voffB[i] = (unsigned)(Rb * ldb + C) * 2u; voffA8[i] = (unsigned)(R * lda8 + C * 2); }
    const size_t kstep = (size_t)(BK * 2);
    const size_t hstepA = (size_t)HALF * lda * 2, hstepB = (size_t)HALF * ldb * 2, hstepA8 = (size_t)HALF * lda8;
    const unsigned ldsw = (unsigned)wid * 1024u;
    const int aoff = lds_byte(wr * 64 + fr, fq * 8), boff = lds_byte(wc * 32 + fr, fq * 8);
#define PG8_SA(b, h) (((b) * 2 + (h)) * HTB)
#define PG8_SB(b, h) ((4 + (b) * 2 + (h)) * HTB)
#define PG8_STAGE(bufoff, gbase, voff) do { _Pragma("unroll") for (int _i = 0; _i < 2; ++_i) \
        __builtin_amdgcn_global_load_lds((const unsigned*)((const char*)(gbase) + (voff)[_i]), (LAS unsigned*)(lds + (bufoff) + ldsw + _i * 8192), 16, 0, 0); } while (0)
#define PG8_LDA(dst, b, h) do { _Pragma("unroll") for (int m = 0; m < 4; ++m) _Pragma("unroll") for (int k = 0; k < 2; ++k) dst[m][k] = *(const LAS bf16x8*)(lds + PG8_SA(b, h) + aoff + m * 2048 + k * 1024); } while (0)
#define PG8_LDB(dst, b, h) do { _Pragma("unroll") for (int n = 0; n < 2; ++n) _Pragma("unroll") for (int k = 0; k < 2; ++k) dst[n][k] = *(const LAS bf16x8*)(lds + PG8_SB(b, h) + boff + n * 2048 + k * 1024); } while (0)
#define PG8_MMA(ai, bj, At, Bt) do { __builtin_amdgcn_s_setprio(1); _Pragma("unroll") for (int m = 0; m < 4; ++m) _Pragma("unroll") for (int n = 0; n < 2; ++n) _Pragma("unroll") for (int k = 0; k < 2; ++k) \
        acc[ai][bj][m][n] = __builtin_amdgcn_mfma_f32_16x16x32_bf16(Bt[n][k], At[m][k], acc[ai][bj][m][n], 0, 0, 0); __builtin_amdgcn_s_setprio(0); } while (0)
#define PG8_CAT(x, y) __builtin_shufflevector(__builtin_bit_cast(i32x4, x), __builtin_bit_cast(i32x4, y), 0, 1, 2, 3, 4, 5, 6, 7)
#define PG8_LDA8(dst, b, h) do { _Pragma("unroll") for (int m = 0; m < 4; ++m) dst[m] = PG8_CAT(*(const LAS bf16x8*)(lds + PG8_SA(b, h) + aoff + m * 2048), *(const LAS bf16x8*)(lds + PG8_SA(b, h) + aoff + m * 2048 + 1024)); } while (0)
#define PG8_LDB8(dst, b, h) do { _Pragma("unroll") for (int n = 0; n < 2; ++n) dst[n] = PG8_CAT(*(const LAS bf16x8*)(lds + PG8_SB(b, h) + boff + n * 2048), *(const LAS bf16x8*)(lds + PG8_SB(b, h) + boff + n * 2048 + 1024)); } while (0)
#define PG8_MMA8(ai, bj, A8, B8) do { __builtin_amdgcn_s_setprio(1); _Pragma("unroll") for (int m = 0; m < 4; ++m) _Pragma("unroll") for (int n = 0; n < 2; ++n) \
        acc[ai][bj][m][n] = MFMA16_F8X128(B8[n], A8[m], acc[ai][bj][m][n]); __builtin_amdgcn_s_setprio(0); } while (0)
#define PG8_WAIT_V(n) asm volatile("s_waitcnt vmcnt(" #n ")" ::: "memory")
#define PG8_WAIT_L(n) asm volatile("s_waitcnt lgkmcnt(" #n ")" ::: "memory")
#define PG8_BAR __builtin_amdgcn_s_barrier()
#define PG8_SCHED __builtin_amdgcn_sched_barrier(0)
    Unit cur, nxt; int ui = 0;
    if (!S.next(0, cur)) return;
    f32x4 acc[2][2][4][2];
#pragma unroll
    for (int a = 0; a < 2; ++a)
#pragma unroll
        for (int b = 0; b < 2; ++b)
#pragma unroll
            for (int m = 0; m < 4; ++m)
#pragma unroll
                for (int n = 0; n < 2; ++n) acc[a][b][m][n] = (f32x4){0.f, 0.f, 0.f, 0.f};
    bf16x8 At[4][2], B0[2][2], B1[2][2];
    const char* cA = cur.a; const char* cB = cur.b; int cf8 = MODE == 2 ? cur.f8 : MODE; size_t chA = cf8 ? hstepA8 : hstepA;
    { unsigned v0[2] = {cf8 ? voffA8[0] : voffA[0], cf8 ? voffA8[1] : voffA[1]};
    PG8_STAGE(PG8_SB(0, 0), cB, voffB); PG8_STAGE(PG8_SB(0, 1), cB + hstepB, voffB); PG8_STAGE(PG8_SA(0, 0), cA, v0); PG8_STAGE(PG8_SA(0, 1), cA + chA, v0);
    if (wr == 1) PG8_BAR;
    PG8_WAIT_V(2); PG8_BAR;
    PG8_STAGE(PG8_SB(1, 0), cB + kstep, voffB); PG8_STAGE(PG8_SA(1, 0), cA + kstep, v0); PG8_STAGE(PG8_SB(1, 1), cB + hstepB + kstep, voffB);
    PG8_WAIT_V(6); PG8_BAR; }
    for (;;) {
        const bool has_next = S.next(ui + 1, nxt);
        const char* nA = has_next ? nxt.a : cA; const char* nB = has_next ? nxt.b : cB; const int nf8 = MODE == 2 ? (has_next ? nxt.f8 : cf8) : MODE;
        int nt = cur.nt; asm volatile("" : "+s"(nt));
#define PG8_KLOOP(LDA_, LDB_, MM_, At_, B0_, B1_, CF8) \
        for (int t = 0; t < nt; t += 2) { \
            const bool last = (t == nt - 2); \
            const char* a1 = cA + (size_t)(t + 1) * kstep; \
            const char* a2 = last ? nA : cA + (size_t)(t + 2) * kstep; const char* b2 = last ? nB : cB + (size_t)(t + 2) * kstep; \
            const char* a3 = a2 + kstep; const char* b3 = b2 + kstep; \
            const int f2 = last ? nf8 : CF8; const size_t h2 = f2 ? hstepA8 : hstepA; \
            OPAQUE_S(a1); OPAQUE_S(a2); OPAQUE_S(a3); OPAQUE_S(b2); OPAQUE_S(b3); \
            const unsigned vA[2] = {CF8 ? voffA8[0] : voffA[0], CF8 ? voffA8[1] : voffA[1]}, vA2[2] = {f2 ? voffA8[0] : voffA[0], f2 ? voffA8[1] : voffA[1]}, vB[2] = {voffB[0], voffB[1]}; \
            LDB_(B0_, 0, 0); LDB_(B1_, 0, 1); PG8_SCHED; LDA_(At_, 0, 0); PG8_STAGE(PG8_SA(1, 1), a1 + (CF8 ? hstepA8 : hstepA), vA); \
            PG8_WAIT_V(8); PG8_WAIT_L(0); PG8_BAR; MM_(0, 0, At_, B0_); MM_(0, 1, At_, B1_); PG8_BAR; PG8_SCHED; \
            LDA_(At_, 0, 1); PG8_STAGE(PG8_SB(0, 0), b2, vB); PG8_STAGE(PG8_SB(0, 1), b2 + hstepB, vB); PG8_STAGE(PG8_SA(0, 0), a2, vA2); \
            PG8_WAIT_V(8); PG8_WAIT_L(0); PG8_BAR; MM_(1, 0, At_, B0_); MM_(1, 1, At_, B1_); PG8_BAR; PG8_SCHED; \
            LDB_(B0_, 1, 0); LDB_(B1_, 1, 1); PG8_SCHED; LDA_(At_, 1, 0); PG8_STAGE(PG8_SA(0, 1), a2 + h2, vA2); \
            PG8_WAIT_V(8); PG8_WAIT_L(0); PG8_BAR; MM_(0, 0, At_, B0_); MM_(0, 1, At_, B1_); PG8_BAR; PG8_SCHED; \
            LDA_(At_, 1, 1); PG8_STAGE(PG8_SB(1, 0), b3, vB); PG8_STAGE(PG8_SB(1, 1), b3 + hstepB, vB); PG8_STAGE(PG8_SA(1, 0), a3, vA2); \
            PG8_WAIT_V(8); PG8_WAIT_L(0); PG8_BAR; MM_(1, 0, At_, B0_); MM_(1, 1, At_, B1_); PG8_BAR; PG8_SCHED; \
        }
        if (MODE == 1 || (MODE == 2 && cf8)) { i32x8 A8[4], B08[2], B18[2]; PG8_KLOOP(PG8_LDA8, PG8_LDB8, PG8_MMA8, A8, B08, B18, 1) }
        else { PG8_KLOOP(PG8_LDA, PG8_LDB, PG8_MMA, At, B0, B1, 0) }
#undef PG8_KLOOP
        if (wr == 0) PG8_BAR;
        E(acc, cur, wr, wc, fr, fq, tid);
        if (!has_next) break;
#pragma unroll
        for (int a = 0; a < 2; ++a)
#pragma unroll
            for (int b = 0; b < 2; ++b)
#pragma unroll
                for (int m = 0; m < 4; ++m)
#pragma unroll
                    for (int n = 0; n < 2; ++n) acc[a][b][m][n] = (f32x4){0.f, 0.f, 0.f, 0.f};
        cur = nxt; cA = nA; cB = nB; cf8 = nf8; ++ui;
        if (wr == 1) PG8_BAR;
    }
    PG8_WAIT_V(0);
    PG8_BAR;
#undef PG8_SA
#undef PG8_SB
#undef PG8_STAGE
#undef PG8_LDA
#undef PG8_LDB
#undef PG8_MMA
#undef PG8_MMA8
#undef PG8_LDA8
#undef PG8_LDB8
#undef PG8_CAT
#undef PG8_WAIT_V
#undef PG8_WAIT_L
#undef PG8_BAR
#undef PG8_SCHED
}
#else
template <int MODE = 0, class Epi, class Sched>
inline void gemm_phase(unsigned char* lds, const int lda, const int ldb, const Sched& S, const Epi& E, const int lda8 = 0) {
    const int tid = TIDX(), wid = tid >> 6, lane = tid & 63, wr = wid >> 2, wc = wid & 3, fr = lane & 15, fq = lane >> 4;
    Unit cur;
    for (int ui = 0; S.next(ui, cur); ++ui) {
        f32x4 acc[2][2][4][2];
        const bf16_t* A = (const bf16_t*)cur.a; const bf16_t* Bt = (const bf16_t*)cur.b; const int K = cur.nt * 64;
        for (int ai = 0; ai < 2; ++ai) for (int bj = 0; bj < 2; ++bj) for (int m = 0; m < 4; ++m) for (int n = 0; n < 2; ++n) for (int e = 0; e < 4; ++e) {
            const int r = 128 * ai + 64 * wr + 16 * m + fr, c = 128 * bj + 32 * wc + 8 * fq + 4 * n + e; float s = 0.f;
            const bf16_t* ar = A + (size_t)r * lda; const bf16_t* br = Bt + (size_t)c * ldb;
            if (cur.f8) { const unsigned char* a8 = (const unsigned char*)cur.a + (size_t)r * lda8; const unsigned char* b8 = (const unsigned char*)cur.b + (size_t)c * ldb * 2;
                for (int k = 0; k < cur.nt * 128; ++k) s += fp8_dec_(a8[k]) * fp8_dec_(b8[k]); }
#ifdef EMU_FP8_A
            else if (cur.aux == 77) { float am = 0.f; for (int k = 0; k < K; ++k) am = fmaxf(am, fabsf(bf2f(br[k]))); const float sc = am > 0.f ? am / 440.f : 1.f;
                for (int k = 0; k < K; ++k) s += fp8_dec_(fp8_enc_(bf2f(ar[k]))) * fp8_dec_(fp8_enc_(bf2f(br[k]) / sc)); s *= sc; }
#endif
            else for (int k = 0; k < K; ++k) s += bf2f(ar[k]) * bf2f(br[k]);
            acc[ai][bj][m][n][e] = s; }
        __syncthreads();
        E(acc, cur, wr, wc, fr, fq, tid);
        __syncthreads();
    }
    __syncthreads();
}
#endif
}
struct Ptrs {
    bf16_t *WinT, *WbrT, *WoutT, *WqT, *PleT, *PleGT, *GluT, *K12, *S5Kc, *S5Wx, *S5Wy, *Ut, *Vt, *hb, *proj, *merged, *q, *ycat, *vtr, *pb;
    float *S5LL, *gate; int* eid; unsigned char* stash; bf16_t *rwPT, *rwG, *rwS0, *rwQ, *rwGt, *rwRKV; unsigned char *U8, *V8; float *su, *sv, *pd; unsigned* qcnt; unsigned char *h8a, *h8b, *h8e; float *gsc, *gscA;
};
__device__ __forceinline__ Ptrs make_ptrs(unsigned char* ws, int l) {
    Ptrs P; { size_t zoff = 0; OPAQUE_S(zoff); ws += zoff; }
    P.WinT = (bf16_t*)(ws + WS_WIN) + (size_t)l * WIN_ROWS * 1024; P.WbrT = (bf16_t*)(ws + WS_WBR) + (size_t)l * 1024 * 1024; P.WoutT = (bf16_t*)(ws + WS_WOUT) + (size_t)l * 1024 * 1024;
    P.WqT = (bf16_t*)(ws + WS_WQ) + (size_t)l * 2048 * 1024; P.PleT = (bf16_t*)(ws + WS_PLE) + (size_t)l * 1024 * 256; P.PleGT = (bf16_t*)(ws + WS_PLEG) + (size_t)l * 1024 * 1024;
    P.GluT = (bf16_t*)(ws + WS_GLU) + (size_t)l * 256 * 256; P.K12 = (bf16_t*)(ws + WS_K12) + (size_t)l * 2 * 128 * 128;
    P.S5Kc = (bf16_t*)(ws + WS_S5KC) + (size_t)l * 16 * 64 * 256; P.S5Wx = (bf16_t*)(ws + WS_S5WX) + (size_t)l * 16 * 128 * 1024; P.S5Wy = (bf16_t*)(ws + WS_S5WY) + (size_t)l * 16 * 1024 * 128;
    P.S5LL = (float*)(ws + WS_S5LL) + (size_t)l * 16 * 64 * 2;
    P.Ut = (bf16_t*)(ws + WS_UT); P.Vt = (bf16_t*)(ws + WS_VT);
    P.pd = (float*)(ws + WS_R1 + R1_Q); P.qcnt = (unsigned*)(ws + WS_CTL) + 8192 + l * 4 * 8 * 16;
    P.U8 = ws + WS_UT; P.V8 = ws + WS_UT + (size_t)NEXP * 1024; P.su = (float*)(ws + WS_CTL + 131072); P.sv = (float*)(ws + WS_CTL + 131072) + NEXP;
    P.rwGt = (bf16_t*)(ws + WS_VT); P.rwRKV = (bf16_t*)(ws + WS_VT + RW_SZ);
    P.rwPT = (bf16_t*)(ws + WS_RW); P.rwG = (bf16_t*)(ws + WS_RW + RW_SZ); P.rwS0 = (bf16_t*)(ws + WS_RW + 2 * RW_SZ); P.rwQ = (bf16_t*)(ws + WS_RW + 3 * RW_SZ);
    P.hb = (bf16_t*)(ws + WS_HB); P.proj = (bf16_t*)(ws + WS_R1 + R1_PROJ); P.merged = (bf16_t*)(ws + WS_R1 + R1_MERGED); P.q = (bf16_t*)(ws + WS_R1 + R1_Q);
    P.stash = ws + WS_R1 + R1_STASH; P.eid = (int*)(ws + WS_R1 + R1_EID); P.gate = (float*)(ws + WS_R1 + R1_GATE);
    P.ycat = (bf16_t*)(ws + WS_YC); P.vtr = (bf16_t*)(ws + WS_VTR); P.pb = (bf16_t*)(ws + WS_PB);
    P.h8a = ws + WS_R1 + R1_H8; P.h8b = ws + WS_H8T; P.h8e = ws + WS_RW; P.gsc = (float*)(ws + WS_CTL + 262144) + l * 6144; P.gscA = (float*)(ws + WS_CTL + 327680) + l * 2304;
    return P;
}

__device__ __forceinline__ int win_src_col(int n) {
    if (n < 1152) return n;
    if (n < 1664) return n;
    if (n < 1668) return 1920 + (n - 1664);
    if (n < 1792) return -1;
    if (n < 2304) return 1924 + (n - 1792);
    if (n < 2560) return 1664 + (n - 2304);
    return 2436 + (n - 2560);
}
template <bool WINMAP>
__device__ __forceinline__ void transpose_item(const float* src, int sld, bf16_t* dst, int dld, int dcol0, int kb, int nb, float* scr, int lane) {
    const int k0 = 64 * kb, n0 = 32 * nb;
    const int nn = n0 + (lane & 31); const int sc = WINMAP ? win_src_col(nn) : nn;
#pragma unroll 8
    for (int i = 0; i < 32; ++i) { const int kk = 2 * i + (lane >> 5); scr[kk * 33 + (lane & 31)] = (sc >= 0) ? src[(size_t)(k0 + kk) * sld + sc] : 0.f; }
    WAVE_SYNC();
    const int c = lane & 7;
#pragma unroll
    for (int j = 0; j < 4; ++j) { const int n = (lane >> 3) + 8 * j; const float* s = scr + (8 * c) * 33 + n;
        u32x4 o; o.x = pk2(s[0 * 33], s[1 * 33]); o.y = pk2(s[2 * 33], s[3 * 33]); o.z = pk2(s[4 * 33], s[5 * 33]); o.w = pk2(s[6 * 33], s[7 * 33]);
        *(u32x4*)(dst + (size_t)(n0 + n) * dld + dcol0 + k0 + 8 * c) = o; }
    WAVE_SYNC();
}

__device__ __forceinline__ void s5_tables(const KP& p, int l, int g, unsigned char* lds) {
    float* pw = (float*)lds;
    float* bb = pw + 65 * 128;
    float* cc = bb + 64 * 32;
    const int tid = TIDX();
    const Ptrs P = make_ptrs(p.ws, l);
    const float dt = expf(p.in[I_LDT][l * 16 + g]);
    if (tid < 64) { const int pp = tid; const float lr = p.in[I_LRE][(l * 16 + g) * 64 + pp], li = p.in[I_LIM][(l * 16 + g) * 64 + pp];
        const float mag = expf(lr * dt), ang = li * dt; const float br = mag * cosf(ang), bi = mag * sinf(ang);
        float xr = 1.f, xi = 0.f;
        for (int t = 0; t <= 64; ++t) { pw[(t * 64 + pp) * 2] = xr; pw[(t * 64 + pp) * 2 + 1] = xi; const float nr = xr * br - xi * bi, ni = xr * bi + xi * br; xr = nr; xi = ni; }
        const float nr = br - 1.f, ni = bi, den = lr * lr + li * li; const float cr = (nr * lr + ni * li) / den, ci = (ni * lr - nr * li) / den;
        for (int c = 0; c < 16; ++c) { const float b_r = p.in[I_BRE][((l * 16 + g) * 64 + pp) * 16 + c], b_i = p.in[I_BIM][((l * 16 + g) * 64 + pp) * 16 + c];
            bb[(pp * 16 + c) * 2] = cr * b_r - ci * b_i; bb[(pp * 16 + c) * 2 + 1] = cr * b_i + ci * b_r; }
        P.S5LL[(g * 64 + pp) * 2] = pw[(64 * 64 + pp) * 2]; P.S5LL[(g * 64 + pp) * 2 + 1] = pw[(64 * 64 + pp) * 2 + 1];
    }
    for (int e = tid; e < 1024; e += NTHR) { const int c = e >> 6, pp = e & 63; cc[e * 2] = p.in[I_CRE][((l * 16 + g) * 16 + c) * 64 + pp]; cc[e * 2 + 1] = p.in[I_CIM][((l * 16 + g) * 16 + c) * 64 + pp]; }
    __syncthreads();
    bf16_t* Kc = P.S5Kc + (size_t)g * 64 * 256;
    { const int pair = tid & 255, co = pair >> 4, ci = pair & 15, th = tid >> 8; float acc[32];
#pragma unroll
      for (int j = 0; j < 32; ++j) acc[j] = 0.f;
      for (int pp = 0; pp < 64; ++pp) { const float c_r = cc[(co * 64 + pp) * 2], c_i = cc[(co * 64 + pp) * 2 + 1], b_r = bb[(pp * 16 + ci) * 2], b_i = bb[(pp * 16 + ci) * 2 + 1];
          const float d_r = c_r * b_r - c_i * b_i, d_i = c_r * b_i + c_i * b_r;
#pragma unroll
          for (int j = 0; j < 32; ++j) { const f32x2 w = *(const f32x2*)(pw + ((th * 32 + j) * 64 + pp) * 2); acc[j] += d_r * w.x - d_i * w.y; } }
#pragma unroll
      for (int j = 0; j < 32; ++j) Kc[(th * 32 + j) * 256 + pair] = (bf16_t)f2bf(acc[j]); }
    bf16_t* Wx = P.S5Wx + (size_t)g * 128 * 1024;
    for (int e = tid; e < 128 * 1024; e += NTHR) { const int n = e >> 10, k = e & 1023, pp = n >> 1, ri = n & 1, s = k >> 4, ci = k & 15;
        const float w_r = pw[((63 - s) * 64 + pp) * 2], w_i = pw[((63 - s) * 64 + pp) * 2 + 1], b_r = bb[(pp * 16 + ci) * 2], b_i = bb[(pp * 16 + ci) * 2 + 1];
        Wx[e] = (bf16_t)f2bf(ri ? (w_r * b_i + w_i * b_r) : (w_r * b_r - w_i * b_i)); }
    bf16_t* Wy = P.S5Wy + (size_t)g * 1024 * 128;
    for (int e = tid; e < 1024 * 128; e += NTHR) { const int n = e >> 7, k = e & 127, t = n >> 4, co = n & 15, pp = k >> 1, ri = k & 1;
        const float c_r = cc[(co * 64 + pp) * 2], c_i = cc[(co * 64 + pp) * 2 + 1], w_r = pw[((t + 1) * 64 + pp) * 2], w_i = pw[((t + 1) * 64 + pp) * 2 + 1];
        Wy[e] = (bf16_t)f2bf(ri ? -(c_r * w_i + c_i * w_r) : (c_r * w_r - c_i * w_i)); }
    __syncthreads();
}

__device__ __forceinline__ void ln_row(const float* src, const float* g, const float* b, float* dst, bf16_t* dstb, int lane) {
    f32x4 v[4]; float s = 0.f;
#pragma unroll
    for (int j = 0; j < 4; ++j) { v[j] = *(const f32x4*)(src + 256 * j + 4 * lane); s += (v[j].x + v[j].y) + (v[j].z + v[j].w); }
    const float mean = wave_sum(s) * (1.f / 1024.f); float s2 = 0.f;
#pragma unroll
    for (int j = 0; j < 4; ++j) { v[j] = v[j] - mean; s2 += (v[j].x * v[j].x + v[j].y * v[j].y) + (v[j].z * v[j].z + v[j].w * v[j].w); }
    const float rstd = 1.f / sqrtf(wave_sum(s2) * (1.f / 1024.f) + LN_EPS_);
#pragma unroll
    for (int j = 0; j < 4; ++j) { const f32x4 gg = *(const f32x4*)(g + 256 * j + 4 * lane), bv = *(const f32x4*)(b + 256 * j + 4 * lane);
        const f32x4 o = v[j] * rstd * gg + bv; *(f32x4*)(dst + 256 * j + 4 * lane) = o;
        if (dstb) { u32x2 w; w.x = pk2(o.x, o.y); w.y = pk2(o.z, o.w); *(u32x2*)(dstb + 256 * j + 4 * lane) = w; } }
}

template <int NR, bool SB = false>
__device__ __forceinline__ void ln_rows(const void* srcv, const float* g, const float* b, float* dst, bf16_t* dstb, unsigned char* d8, int lane) {
    f32x4 v[NR][4]; float s[NR], s2[NR];
#pragma unroll
    for (int r = 0; r < NR; ++r) { s[r] = 0.f;
#pragma unroll
        for (int j = 0; j < 4; ++j) {
            if (SB) { const u32x2 w = *(const u32x2*)((const bf16_t*)srcv + (size_t)r * 1024 + 256 * j + 4 * lane); v[r][j] = (f32x4){bflo(w.x), bfhi(w.x), bflo(w.y), bfhi(w.y)}; }
            else v[r][j] = *(const f32x4*)((const float*)srcv + (size_t)r * 1024 + 256 * j + 4 * lane);
            s[r] += (v[r][j].x + v[r][j].y) + (v[r][j].z + v[r][j].w); } }
    wave_sum_n<NR>(s);
#pragma unroll
    for (int r = 0; r < NR; ++r) { const float mean = s[r] * (1.f / 1024.f); s2[r] = 0.f;
#pragma unroll
        for (int j = 0; j < 4; ++j) { v[r][j] = v[r][j] - mean; s2[r] += (v[r][j].x * v[r][j].x + v[r][j].y * v[r][j].y) + (v[r][j].z * v[r][j].z + v[r][j].w * v[r][j].w); } }
    wave_sum_n<NR>(s2);
#pragma unroll
    for (int j = 0; j < 4; ++j) { const f32x4 gg = *(const f32x4*)(g + 256 * j + 4 * lane), bv = *(const f32x4*)(b + 256 * j + 4 * lane);
#pragma unroll
        for (int r = 0; r < NR; ++r) { const float rstd = 1.f / sqrtf(s2[r] * (1.f / 1024.f) + LN_EPS_);
            const f32x4 o = v[r][j] * rstd * gg + bv; if (dst) *(f32x4*)(dst + (size_t)r * 1024 + 256 * j + 4 * lane) = o;
            if (dstb) { u32x2 w; w.x = pk2(o.x, o.y); w.y = pk2(o.z, o.w); *(u32x2*)(dstb + (size_t)r * 1024 + 256 * j + 4 * lane) = w; }
            if (d8) { unsigned w8 = cvt_pk_fp8_f32_(o.x, o.y, 0u, false); w8 = cvt_pk_fp8_f32_(o.z, o.w, w8, true); *(unsigned*)(d8 + (size_t)r * 1024 + 256 * j + 4 * lane) = w8; } } }
}
__device__ __forceinline__ void phase_prologue(const KP& p, unsigned char* lds) {
    const int tid = TIDX(), lane = tid & 63, wave = tid >> 6;
    int G = GDIM(), bid = BIDX();
    for (int it = bid; it < L_ * 16; it += G) s5_tables(p, it >> 4, it & 15, lds);
    if (G >= 4 * L_ * 16) { if (bid < L_ * 16) return; bid -= L_ * 16; G -= L_ * 16; }
    float* scr = (float*)lds + wave * (64 * 33 + 16);
    const int gw = bid * NWAVE + wave, NGW = G * NWAVE;
    constexpr int I_WINT = (WIN_ROWS / 32) * 16, I_BR = 4 * 4 * 32, I_OUT = 16 * 32, I_Q = 16 * 64, I_PL = 4 * 32, I_PG = 16 * 32, I_GL = 4 * 8;
    constexpr int PER_L = I_WINT + I_BR + I_OUT + I_Q + I_PL + I_PG + I_GL;
    for (int it = gw; it < L_ * PER_L; it += NGW) {
        const int l = it / PER_L; int r = it % PER_L; const Ptrs P = make_ptrs(p.ws, l);
        if (r < I_WINT) { transpose_item<true>(p.in[I_WIN] + (size_t)l * 1024 * IN_COLS, IN_COLS, P.WinT, 1024, 0, r & 15, r >> 4, scr, lane); continue; } r -= I_WINT;
        if (r < I_BR) { const int b = r >> 7, rr = r & 127; transpose_item<false>(p.in[I_WBR] + ((size_t)l * 4 + b) * 256 * 1024, 1024, P.WbrT, 1024, 256 * b, rr & 3, rr >> 2, scr, lane); continue; } r -= I_BR;
        if (r < I_OUT) { transpose_item<false>(p.in[I_WOUT] + (size_t)l * 1024 * 1024, 1024, P.WoutT, 1024, 0, r & 15, r >> 4, scr, lane); continue; } r -= I_OUT;
        if (r < I_Q) { transpose_item<false>(p.in[I_WQ] + (size_t)l * 1024 * 2048, 2048, P.WqT, 1024, 0, r & 15, r >> 4, scr, lane); continue; } r -= I_Q;
        if (r < I_PL) { transpose_item<false>(p.in[I_PLEW] + (size_t)l * 256 * 1024, 1024, P.PleT, 256, 0, r & 3, r >> 2, scr, lane); continue; } r -= I_PL;
        if (r < I_PG) { transpose_item<false>(p.in[I_PLEG] + (size_t)l * 1024 * 1024, 1024, P.PleGT, 1024, 0, r & 15, r >> 4, scr, lane); continue; } r -= I_PG;
        transpose_item<false>(p.in[I_GLUW] + (size_t)l * 256 * 256, 256, P.GluT, 256, 0, r & 3, r >> 2, scr, lane);
    }
    const size_t gt = (size_t)bid * NTHR + tid, NGT = (size_t)G * NTHR;
    { bf16_t* K12 = (bf16_t*)(p.ws + WS_K12);
      for (size_t i = gt; i < (size_t)L_ * 2 * 16384 / 8; i += NGT) { const size_t e = i * 8; const int l = (int)(e / 32768), r = (int)(e % 32768); const float* s = (r < 16384 ? p.in[I_K1] : p.in[I_K2]) + (size_t)l * 16384 + (r & 16383);
        const f32x4 a = *(const f32x4*)s, b = *(const f32x4*)(s + 4); u32x4 o; o.x = pk2(a.x, a.y); o.y = pk2(a.z, a.w); o.z = pk2(b.x, b.y); o.w = pk2(b.z, b.w); *(u32x4*)(K12 + e) = o; } }
    { bf16_t* hb = (bf16_t*)(p.ws + WS_HB);
      unsigned char* h8a = p.ws + WS_R1 + R1_H8; unsigned char* h8b = p.ws + WS_H8T;
      for (int m = 4 * gw; m < T_; m += 4 * NGW) ln_rows<4>(p.in[I_X] + (size_t)m * 1024, p.in[I_LNIN_G], p.in[I_LNIN_B], (float*)nullptr, hb + (size_t)m * 1024, m < H8_SPLIT ? h8a + (size_t)m * 1024 : h8b + (size_t)(m - H8_SPLIT) * 1024, lane); }
}
__device__ __forceinline__ void conv_unit(const KP& p, const Ptrs& P, int l, int unit, unsigned char* lds) {
    bf16_t* hbuf = (bf16_t*)lds;
    float* obuf = (float*)(lds + 94 * 256 * 2);
    const int tid = TIDX(), lane = tid & 63, wave = tid >> 6;
    const int tiles_per_seq = S_ / 64, b = unit / tiles_per_seq, t0 = (unit % tiles_per_seq) * 64;
    for (int e = tid; e < 94 * 32; e += NTHR) { const int r = e >> 5, c8 = (e & 31) * 8; const int t = t0 - 30 + r;
        u32x4 o = (u32x4){0u, 0u, 0u, 0u};
        if (t >= 0) { const bf16_t* row = P.proj + (size_t)(b * S_ + t) * PJ; const u32x4 v = *(const u32x4*)(row + C_CV + c8), g = *(const u32x4*)(row + C_CG + c8);
            o.x = pk2(bflo(v.x) * sigmoidf_(bflo(g.x)), bfhi(v.x) * sigmoidf_(bfhi(g.x))); o.y = pk2(bflo(v.y) * sigmoidf_(bflo(g.y)), bfhi(v.y) * sigmoidf_(bfhi(g.y)));
            o.z = pk2(bflo(v.z) * sigmoidf_(bflo(g.z)), bfhi(v.z) * sigmoidf_(bfhi(g.z))); o.w = pk2(bflo(v.w) * sigmoidf_(bflo(g.w)), bfhi(v.w) * sigmoidf_(bfhi(g.w))); }
        *(u32x4*)(hbuf + r * 256 + c8) = o; }
    __syncthreads();
    { const int c = tid & 255, half = tid >> 8; float w[31], x[62];
#pragma unroll
      for (int j = 0; j < 31; ++j) w[j] = p.in[I_CONVW][(l * 31 + j) * 256 + c];
      const float cb = p.in[I_CONVB][l * 256 + c];
#pragma unroll
      for (int j = 0; j < 62; ++j) x[j] = bf2f(hbuf[(half * 32 + j) * 256 + c]);
#pragma unroll
      for (int tt = 0; tt < 32; ++tt) { float s = cb;
#pragma unroll
          for (int j = 0; j < 31; ++j) s += w[j] * x[tt + j];
          obuf[(half * 32 + tt) * 256 + c] = s; } }
    __syncthreads();
    { const f32x4 g = *(const f32x4*)(p.in[I_CLNG] + l * 256 + 4 * lane), bb = *(const f32x4*)(p.in[I_CLNB] + l * 256 + 4 * lane);
      f32x4 vv[8]; float m1[8], m2[8];
#pragma unroll
      for (int i = 0; i < 8; ++i) { vv[i] = *(const f32x4*)(obuf + (wave * 8 + i) * 256 + 4 * lane); m1[i] = (vv[i].x + vv[i].y) + (vv[i].z + vv[i].w); }
      wave_sum_n<8>(m1);
#pragma unroll
      for (int i = 0; i < 8; ++i) { vv[i] = vv[i] - m1[i] * (1.f / 256.f); m2[i] = (vv[i].x * vv[i].x + vv[i].y * vv[i].y) + (vv[i].z * vv[i].z + vv[i].w * vv[i].w); }
      wave_sum_n<8>(m2);
#pragma unroll
      for (int i = 0; i < 8; ++i) { const int t = wave * 8 + i; const float rstd = 1.f / sqrtf(m2[i] * (1.f / 256.f) + LN_EPS_);
          f32x4 z = vv[i] * rstd * g + bb; u32x2 w; w.x = pk2(z.x * sigmoidf_(z.x), z.y * sigmoidf_(z.y)); w.y = pk2(z.z * sigmoidf_(z.z), z.w * sigmoidf_(z.w));
          *(u32x2*)(P.ycat + (size_t)(b * S_ + t0 + t) * 1024 + 768 + 4 * lane) = w; } }
    __syncthreads();
}

constexpr int S5_NCH = S_ / 64;
constexpr int S5_UPITCH = 1032;
constexpr int S5_XPITCH = 136;
__device__ __forceinline__ void s5_unit(const KP& p, const Ptrs& P, int l, int unit, unsigned char* lds) {
    const int b = unit >> 4, g = unit & 15;
    bf16_t* Uc = (bf16_t*)lds;
    bf16_t* Kc = (bf16_t*)(lds + 66048);
    float* Xe = (float*)(lds + 66048 + 32768);
    bf16_t* Xs = (bf16_t*)(lds + 66048 + 65536);
    const int tid = TIDX(), lane = tid & 63, wave = tid >> 6, r32 = lane & 31, hi = lane >> 5;
    { u32x4 v[8], kc[4];
#pragma unroll
      for (int j = 0; j < 8; ++j) { const int e = tid + j * NTHR, s = e >> 1, hf = e & 1; v[j] = (u32x4){0u, 0u, 0u, 0u};
          if (s < S_) v[j] = *(const u32x4*)(P.proj + (size_t)(b * S_ + s) * PJ + C_S5 + 16 * g + 8 * hf); }
#pragma unroll
      for (int j = 0; j < 4; ++j) kc[j] = *(const u32x4*)(P.S5Kc + (size_t)g * 16384 + (tid + j * NTHR) * 8);
#pragma unroll
      for (int j = 0; j < 8; ++j) { const int e = tid + j * NTHR, s = e >> 1, hf = e & 1; *(u32x4*)(Uc + (s >> 6) * S5_UPITCH + (s & 63) * 16 + 8 * hf) = v[j]; }
#pragma unroll
      for (int j = 0; j < 4; ++j) *(u32x4*)(Kc + (tid + j * NTHR) * 8) = kc[j]; }
    __syncthreads();
    { const int ntile = wave & 3, kh = wave >> 2; f32x16 acc = {};
      const bf16_t* wrow = P.S5Wx + ((size_t)g * 128 + ntile * 32 + r32) * 1024 + kh * 512 + 8 * hi;
      const bf16_t* urow = Uc + r32 * S5_UPITCH + kh * 512 + 8 * hi;
      for (int k8 = 0; k8 < 32; k8 += 8) { bf16x8 bw[8];
#pragma unroll
          for (int j = 0; j < 8; ++j) bw[j] = *(const bf16x8*)(wrow + (k8 + j) * 16);
#pragma unroll
          for (int j = 0; j < 8; ++j) { const bf16x8 a = *(const bf16x8*)(urow + (k8 + j) * 16); acc = MFMA32(a, bw[j], acc); } }
#pragma unroll
      for (int r = 0; r < 16; ++r) { const int c = (r & 3) + 8 * (r >> 2) + 4 * hi; Xe[(kh * 32 + c) * 128 + ntile * 32 + r32] = acc[r]; } }
    __syncthreads();
    if (tid < 64) { const float lr = P.S5LL[(g * 64 + tid) * 2], li = P.S5LL[(g * 64 + tid) * 2 + 1]; float xr = 0.f, xi = 0.f;
        for (int c = 0; c < 32; ++c) { Xs[c * S5_XPITCH + 2 * tid] = (bf16_t)f2bf(xr); Xs[c * S5_XPITCH + 2 * tid + 1] = (bf16_t)f2bf(xi);
            const float er = Xe[c * 128 + 2 * tid] + Xe[(32 + c) * 128 + 2 * tid], ei = Xe[c * 128 + 2 * tid + 1] + Xe[(32 + c) * 128 + 2 * tid + 1];
            const float nr = lr * xr - li * xi + er, ni = lr * xi + li * xr + ei; xr = nr; xi = ni; } }
    __syncthreads();
    { const int tt = r32 >> 4, co = r32 & 15; const float dsk = p.in[I_S5D][l * 256 + 16 * g + co];
      for (int q = 0; q < 4; ++q) { const int ntile = wave + 8 * q, t0 = 2 * ntile; f32x16 acc = {};
          const bf16_t* urow = Uc + r32 * S5_UPITCH + 8 * hi;
          for (int s = 0; s <= t0 + 1; ++s) { const int tau = t0 + tt - s; bf16x8 bk = (bf16x8){0, 0, 0, 0, 0, 0, 0, 0};
              if (tau >= 0) bk = *(const bf16x8*)(Kc + (tau * 16 + co) * 16 + 8 * hi);
              const bf16x8 a = *(const bf16x8*)(urow + s * 16); acc = MFMA32(a, bk, acc); }
          const bf16_t* wy = P.S5Wy + ((size_t)g * 1024 + ntile * 32 + r32) * 128 + 8 * hi; const bf16_t* xrow = Xs + r32 * S5_XPITCH + 8 * hi;
#pragma unroll
          for (int ks = 0; ks < 8; ++ks) { const bf16x8 a = *(const bf16x8*)(xrow + ks * 16); const bf16x8 bw = *(const bf16x8*)(wy + ks * 16); acc = MFMA32(a, bw, acc); }
#pragma unroll
          for (int r = 0; r < 16; ++r) { const int c = (r & 3) + 8 * (r >> 2) + 4 * hi; const int s = c * 64 + t0 + tt;
              if (s < S_) { const float uu = bf2f(Uc[c * S5_UPITCH + (t0 + tt) * 16 + co]); const float y = acc[r] + dsk * uu;
                  P.ycat[(size_t)(b * S_ + s) * 1024 + 256 + 16 * g + co] = (bf16_t)f2bf(gelu_erf(y)); } } } }
    __syncthreads();
}
constexpr float LOG2E_ = 1.4426950408889634f;
__device__ __forceinline__ float log_sigmoid_(float x) { return fminf(x, 0.f) - log1pf(__expf(-fabsf(x))); }
__device__ __forceinline__ void fox_unit(const KP& p, const Ptrs& P, int l, int unit, unsigned char* lds) {
    constexpr int NQB = S_ / 256;
    const int bh = unit / NQB, qb = (unit >= (NB_ * 4 * NQB) / 2) ? NQB - 1 - unit % NQB : unit % NQB, b = bh >> 2, h = bh & 3, q0 = qb * 256;
    float* cl = (float*)lds;
    unsigned char* Kt = lds + S_ * 4;
    unsigned char* Vt = Kt + 8192;
    float* wsf = (float*)(Kt + 32768);
    float* sc = wsf + 256;
    const int tid = TIDX(), lane = tid & 63, wave = tid >> 6, r32 = lane & 31, hi = lane >> 5;
    const int qend = q0 + 256;
    { constexpr int PER = (S_ + 511) / 512; const float bf = p.in[I_BF][l * 4 + h]; float loc[PER]; float s = 0.f;
#pragma unroll
      for (int i = 0; i < PER; ++i) { const int t = tid * PER + i; float v = 0.f;
          if (t < qend) v = log_sigmoid_(bf2f(P.proj[(size_t)(b * S_ + t) * PJ + C_FL + h]) + bf) * LOG2E_;
          s += v; loc[i] = s; }
      sc[tid] = s; __syncthreads();
      for (int off = 1; off < 512; off <<= 1) { const float v = sc[tid] + (tid >= off ? sc[tid - off] : 0.f); __syncthreads(); sc[tid] = v; __syncthreads(); }
      const float base = sc[tid] - s;
#pragma unroll
      for (int i = 0; i < PER; ++i) { const int t = tid * PER + i; if (t < S_) cl[t] = base + loc[i]; }
      __syncthreads(); }
    const int qrow = q0 + 32 * wave + r32;
    constexpr float C2 = 0.125f * LOG2E_;
    bf16x8 qr[4];
    { const bf16_t* qp = P.proj + (size_t)(b * S_ + qrow) * PJ + C_FQ + 64 * h + 8 * hi;
#pragma unroll
      for (int d0 = 0; d0 < 4; ++d0) { const u32x4 w = *(const u32x4*)(qp + 16 * d0);
          u32x4 o; o.x = pk2(bflo(w.x) * C2, bfhi(w.x) * C2); o.y = pk2(bflo(w.y) * C2, bfhi(w.y) * C2); o.z = pk2(bflo(w.z) * C2, bfhi(w.z) * C2); o.w = pk2(bflo(w.w) * C2, bfhi(w.w) * C2);
          qr[d0] = __builtin_bit_cast(bf16x8, o); } }
    const float clq = cl[qrow];
    float mrun = -INFINITY, lrun = 0.f; f32x16 o0 = {}, o1 = {};
    const int NT = qend / 64;
    const int srow = tid >> 3, sch = tid & 7;
    const bf16_t* kg = P.proj + (size_t)(b * S_ + srow) * PJ + C_FK + 64 * h + 8 * sch;
    const bf16_t* vg = P.vtr + (size_t)(64 * h + srow) * T_ + (size_t)b * S_ + 8 * sch;
    const int koff = srow * 128 + ((sch ^ ((srow >> 1) & 7)) * 16);
    const int voffa = srow * 128 + (((2 * sch) ^ ((srow >> 1) & 15)) * 8), voffb = srow * 128 + (((2 * sch + 1) ^ ((srow >> 1) & 15)) * 8);
    u32x4 kreg = *(const u32x4*)kg, vreg = *(const u32x4*)vg;
    *(u32x4*)(Kt + koff) = kreg; *(u32x2*)(Vt + voffa) = (u32x2){vreg.x, vreg.y}; *(u32x2*)(Vt + voffb) = (u32x2){vreg.z, vreg.w};
    if (NT > 1) { kreg = *(const u32x4*)(kg + (size_t)64 * PJ); vreg = *(const u32x4*)(vg + 64); }
    __syncthreads();
    for (int jt = 0; jt < NT; ++jt) {
        const int kv0 = jt * 64; const unsigned char* Kb = Kt + (jt & 1) * 16384; const unsigned char* Vb = Vt + (jt & 1) * 16384;
        if (kv0 <= q0 + 32 * wave + 31) {
            f32x16 pt[2];
#pragma unroll
            for (int kvt = 0; kvt < 2; ++kvt) { const int row = 32 * kvt + r32; f32x16 acc;
#pragma unroll
                for (int g4 = 0; g4 < 4; ++g4) { const f32x4 c4 = *(const f32x4*)(cl + kv0 + 32 * kvt + 8 * g4 + 4 * hi);
#pragma unroll
                    for (int e = 0; e < 4; ++e) acc[4 * g4 + e] = clq - c4[e]; }
#pragma unroll
                for (int d0 = 0; d0 < 4; ++d0) { const bf16x8 a = *(const bf16x8*)(Kb + row * 128 + (((2 * d0 + hi) ^ ((row >> 1) & 7)) * 16)); acc = MFMA32(a, qr[d0], acc); }
                pt[kvt] = acc; }
            if (kv0 + 63 > q0 + 32 * wave) {
#pragma unroll
                for (int kvt = 0; kvt < 2; ++kvt)
#pragma unroll
                    for (int r = 0; r < 16; ++r) { const int key = kv0 + 32 * kvt + (r & 3) + 8 * (r >> 2) + 4 * hi; if (key > qrow) pt[kvt][r] = -INFINITY; } }
            float mx = -INFINITY;
#pragma unroll
            for (int kvt = 0; kvt < 2; ++kvt)
#pragma unroll
                for (int r = 0; r < 16; ++r) mx = fmaxf(mx, pt[kvt][r]);
            mx = fmaxf(mx, __shfl_xor(mx, 32));
            const float mnew = fmaxf(mrun, mx), alpha = FAST_EXP2(mrun - mnew); mrun = mnew;
            float ls = 0.f;
#pragma unroll
            for (int kvt = 0; kvt < 2; ++kvt)
#pragma unroll
                for (int r = 0; r < 16; ++r) { const float e = FAST_EXP2(pt[kvt][r] - mnew); pt[kvt][r] = e; ls += e; }
            lrun = lrun * alpha + ls;
            float* wf = wsf + wave * 32;
            WAVE_SYNC(); if (hi == 0) wf[r32] = alpha; WAVE_SYNC();
#pragma unroll
            for (int g4 = 0; g4 < 4; ++g4) { const f32x4 f = *(const f32x4*)(wf + 8 * g4 + 4 * hi);
#pragma unroll
                for (int e = 0; e < 4; ++e) { o0[4 * g4 + e] *= f[e]; o1[4 * g4 + e] *= f[e]; } }
#pragma unroll
            for (int s = 0; s < 4; ++s) { const int kvt = s >> 1, rb = 8 * (s & 1);
                u32x4 pw; pw.x = pk2(pt[kvt][rb + 0], pt[kvt][rb + 1]); pw.y = pk2(pt[kvt][rb + 2], pt[kvt][rb + 3]); pw.z = pk2(pt[kvt][rb + 4], pt[kvt][rb + 5]); pw.w = pk2(pt[kvt][rb + 6], pt[kvt][rb + 7]);
                const bf16x8 pa = __builtin_bit_cast(bf16x8, pw);
#pragma unroll
                for (int dt = 0; dt < 2; ++dt) { const int d = 32 * dt + r32; const int sw = (d >> 1) & 15;
                    const u32x2 va = *(const u32x2*)(Vb + d * 128 + (((4 * s + hi) ^ sw) * 8)), vb = *(const u32x2*)(Vb + d * 128 + (((4 * s + 2 + hi) ^ sw) * 8));
                    const bf16x8 vf = __builtin_bit_cast(bf16x8, (u32x4){va.x, va.y, vb.x, vb.y});
                    if (dt == 0) o0 = MFMA32(pa, vf, o0); else o1 = MFMA32(pa, vf, o1); } }
        }
        if (jt + 1 < NT) { unsigned char* Kn = Kt + ((jt + 1) & 1) * 16384; unsigned char* Vn = Vt + ((jt + 1) & 1) * 16384;
            *(u32x4*)(Kn + koff) = kreg; *(u32x2*)(Vn + voffa) = (u32x2){vreg.x, vreg.y}; *(u32x2*)(Vn + voffb) = (u32x2){vreg.z, vreg.w};
            if (jt + 2 < NT) { kreg = *(const u32x4*)(kg + (size_t)(kv0 + 128) * PJ); vreg = *(const u32x4*)(vg + kv0 + 128); } }
        __syncthreads();
    }
    { const float lt = lrun + __shfl_xor(lrun, 32); float* wf = wsf + wave * 32;
      WAVE_SYNC(); if (hi == 0) wf[r32] = 1.0f / lt; WAVE_SYNC();
      bf16_t* orow = P.ycat + (size_t)(b * S_ + q0 + 32 * wave) * 1024 + 512 + 64 * h + r32;
#pragma unroll
      for (int r = 0; r < 16; ++r) { const int qq = (r & 3) + 8 * (r >> 2) + 4 * hi; const float f = wf[qq];
          orow[(size_t)qq * 1024] = (bf16_t)f2bf(o0[r] * f); orow[(size_t)qq * 1024 + 32] = (bf16_t)f2bf(o1[r] * f); } }
    __syncthreads();
}

constexpr int RW_NCH = S_ / 64;
constexpr int RWP = 72;
constexpr int RW_ARR = 64 * RWP * 2;
constexpr int RW_SCRP = 388;
__device__ __forceinline__ void rw_stage_weights(const KP& p, int l, int h, bf16_t* wb, int tid) {
    for (int e = tid; e < 2048; e += NTHR) { const int m = e >> 4, c4 = (e & 15) * 4;
        if (m < 32) { const f32x4 v = *(const f32x4*)(p.in[I_A2] + (l * 32 + m) * 256 + 64 * h + c4);
#pragma unroll
            for (int q = 0; q < 4; ++q) wb[(c4 + q) * 40 + m] = (bf16_t)f2bf(v[q]); }
        else if (m < 64) { const f32x4 v = *(const f32x4*)(p.in[I_W2] + (l * 32 + m - 32) * 256 + 64 * h + c4);
#pragma unroll
            for (int q = 0; q < 4; ++q) wb[2560 + (c4 + q) * 40 + (m - 32)] = (bf16_t)f2bf(v[q]); }
        else { const f32x4 v = *(const f32x4*)(p.in[I_G2] + (l * 64 + m - 64) * 256 + 64 * h + c4);
#pragma unroll
            for (int q = 0; q < 4; ++q) wb[5120 + (c4 + q) * 72 + (m - 64)] = (bf16_t)f2bf(v[q]); } }
    __syncthreads();
}
__device__ __forceinline__ bf16x8 rw_pack8(const float* q) { const f32x4 a = *(const f32x4*)q, b = *(const f32x4*)(q + 4);
    u32x4 w; w.x = pk2(a.x, a.y); w.y = pk2(a.z, a.w); w.z = pk2(b.x, b.y); w.w = pk2(b.z, b.w); return __builtin_bit_cast(bf16x8, w); }
template <int NT, bool NEED_W, bool NEED_G>
__device__ __forceinline__ void rw_prep(const KP& p, const Ptrs& P, int l, int b, int h, int tpos0, float* scr, const bf16_t* wb, int lane,
                                        float (&r)[NT], float (&lw)[NT], float (&k2)[NT], float (&v)[NT], float (&ain)[NT], float (&bin)[NT], float (&g)[NT], float (&rk)[NT]) {
    constexpr int NIT = (NT * 40 + 63) / 64;
    u32x4 cur[NIT], prv[NIT];
#pragma unroll
    for (int i = 0; i < NIT; ++i) { const int e = lane + 64 * i; const int tt = e / 40, ch = e % 40; const int t = tpos0 + tt;
        const int col = ch < 8 ? C_R + 64 * h + 8 * ch : ch < 16 ? C_K + 64 * h + 8 * (ch - 8) : ch < 24 ? C_V + 64 * h + 8 * (ch - 16) : C_HW + 8 * (ch - 24);
        cur[i] = (u32x4){0u, 0u, 0u, 0u}; prv[i] = (u32x4){0u, 0u, 0u, 0u};
        if (e < NT * 40) { const bf16_t* row = P.proj + (size_t)(b * S_ + t) * PJ + col; cur[i] = *(const u32x4*)row; if (t > 0) prv[i] = *(const u32x4*)(row - PJ); } }
#pragma unroll
    for (int i = 0; i < NIT; ++i) { const int e = lane + 64 * i; const int tt = e / 40, ch = e % 40;
        const int col = ch < 8 ? C_R + 64 * h + 8 * ch : ch < 16 ? C_K + 64 * h + 8 * (ch - 8) : ch < 24 ? C_V + 64 * h + 8 * (ch - 16) : C_HW + 8 * (ch - 24);
        const int idx = ch < 24 ? 8 * ch : 192 + 8 * (ch - 24);
        if (e < NT * 40) { const f32x4 m0 = *(const f32x4*)(p.in[I_MU] + l * 896 + col), m1 = *(const f32x4*)(p.in[I_MU] + l * 896 + col + 4);
            float z[8] = {bflo(cur[i].x), bfhi(cur[i].x), bflo(cur[i].y), bfhi(cur[i].y), bflo(cur[i].z), bfhi(cur[i].z), bflo(cur[i].w), bfhi(cur[i].w)};
            const float zp[8] = {bflo(prv[i].x), bfhi(prv[i].x), bflo(prv[i].y), bfhi(prv[i].y), bflo(prv[i].z), bfhi(prv[i].z), bflo(prv[i].w), bfhi(prv[i].w)};
#pragma unroll
            for (int q = 0; q < 8; ++q) { float zs = z[q] + (zp[q] - z[q]) * (q < 4 ? m0[q & 3] : m1[q & 3]);
                if (ch >= 24 && ch < 28) zs = 1.0f - 2.0f * FAST_RCP(1.0f + FAST_EXP2(zs * 2.8853900817779268f));
                else if (ch >= 32) zs = sigmoidf_(zs);
                z[q] = zs; }
            *(f32x4*)(scr + tt * RW_SCRP + idx) = (f32x4){z[0], z[1], z[2], z[3]}; *(f32x4*)(scr + tt * RW_SCRP + idx + 4) = (f32x4){z[4], z[5], z[6], z[7]}; } }
    WAVE_SYNC();
    { const int fr = lane & 15, fq = lane >> 4; const float* hrow = scr + (fr & 7) * RW_SCRP + 192 + 8 * fq;
      const bf16x8 fw = rw_pack8(hrow), fa = rw_pack8(hrow + 32), fg0 = rw_pack8(hrow + 64), fg1 = rw_pack8(hrow + 96);
      WAVE_SYNC();
#pragma unroll
      for (int nt = 0; nt < 4; ++nt) { const f32x4 z4 = (f32x4){0.f, 0.f, 0.f, 0.f};
          const f32x4 da = MFMA16(fa, *(const bf16x8*)(wb + (16 * nt + fr) * 40 + 8 * fq), z4);
          f32x4 dw = z4, dg = z4;
          if (NEED_W) dw = MFMA16(fw, *(const bf16x8*)(wb + 2560 + (16 * nt + fr) * 40 + 8 * fq), z4);
          if (NEED_G) { dg = MFMA16(fg0, *(const bf16x8*)(wb + 5120 + (16 * nt + fr) * 72 + 8 * fq), z4); dg = MFMA16(fg1, *(const bf16x8*)(wb + 5120 + (16 * nt + fr) * 72 + 32 + 8 * fq), dg); }
          if (fq < 2) {
#pragma unroll
              for (int q = 0; q < 4; ++q) { float* o = scr + (4 * fq + q) * RW_SCRP + 16 * nt + fr; o[192] = da[q]; if (NEED_W) o[256] = dw[q]; if (NEED_G) o[320] = dg[q]; } } }
      WAVE_SYNC(); }
    const int j = lane, cj = 64 * h + j; float wl[NT], al[NT], gg[NT];
    const float w0 = p.in[I_W0][l * 256 + cj], a0 = p.in[I_A0][l * 256 + cj];
#pragma unroll
    for (int tt = 0; tt < NT; ++tt) { al[tt] = a0 + scr[tt * RW_SCRP + 192 + j]; wl[tt] = NEED_W ? w0 + scr[tt * RW_SCRP + 256 + j] : w0; gg[tt] = NEED_G ? scr[tt * RW_SCRP + 320 + j] : 0.f; }
    const float kkw = p.in[I_KK][l * 256 + cj], kaw = p.in[I_KA][l * 256 + cj], rkw = p.in[I_RK][l * 256 + cj];
    float ssum[NT], rsum[NT], kkv[NT], av[NT];
#pragma unroll
    for (int tt = 0; tt < NT; ++tt) {
        const float a = sigmoidf_(al[tt]); av[tt] = a;
        const float rr = scr[tt * RW_SCRP + j], k = scr[tt * RW_SCRP + 64 + j], vv = scr[tt * RW_SCRP + 128 + j];
        const float kk2 = k * (1.f + (a - 1.f) * kaw);
        r[tt] = rr; k2[tt] = kk2; v[tt] = vv;
        const float kk = k * kkw; kkv[tt] = kk; ssum[tt] = kk * kk; rsum[tt] = rr * kk2 * rkw; }
    if (NEED_W) wave_sum_n<NT>(ssum);
    if (NEED_G) wave_sum_n<NT>(rsum);
#pragma unroll
    for (int tt = 0; tt < NT; ++tt) {
        if (NEED_W) { const float x = -wl[tt]; const float sp = fmaxf(x, 0.f) + 0.6931471805599453f * FAST_LOG2(1.0f + FAST_EXP2(-1.4426950408889634f * fabsf(x)));
            lw[tt] = -FAST_EXP2(-1.4426950408889634f * (sp + 0.5f));
            const float kkn = kkv[tt] * FAST_RSQ(fmaxf(ssum[tt], 1e-24f));
            ain[tt] = -kkn; bin[tt] = kkn * av[tt]; }
        if (NEED_G) { g[tt] = gg[tt]; rk[tt] = rsum[tt]; }
    }
    WAVE_SYNC();
}
__device__ __forceinline__ bf16x8 ldsb8(const bf16_t* p) { return *(const bf16x8*)p; }
__device__ __forceinline__ f32x16 rw_tile(const bf16_t* X, const bf16_t* Y, int tm, int tn, int r32, int hi, f32x16 acc) {
    const bf16_t* xa = X + (32 * tm + r32) * RWP + 8 * hi; const bf16_t* yb = Y + (32 * tn + r32) * RWP + 8 * hi;
#pragma unroll
    for (int ks = 0; ks < 4; ++ks) acc = MFMA32(ldsb8(xa + 16 * ks), ldsb8(yb + 16 * ks), acc);
    return acc;
}
template <int STOP = 0>
__device__ __forceinline__ void rw_chunk_unit(const KP& p, const Ptrs& P, int l, int unit, unsigned char* lds) {
    MEMFENCE(); OPAQUE_S(unit);
    const int c = unit % RW_NCH, bh = unit / RW_NCH, b = bh >> 2, h = bh & 3, t0 = c * 64;
    bf16_t* AT = (bf16_t*)(lds + 0 * RW_ARR); bf16_t* RT = (bf16_t*)(lds + 1 * RW_ARR); bf16_t* BT = (bf16_t*)(lds + 2 * RW_ARR); bf16_t* KT = (bf16_t*)(lds + 3 * RW_ARR);
    bf16_t* BH = (bf16_t*)(lds + 4 * RW_ARR); bf16_t* KH = (bf16_t*)(lds + 5 * RW_ARR); bf16_t* VT = (bf16_t*)(lds + 6 * RW_ARR);
    bf16_t* AAK = (bf16_t*)(lds + 7 * RW_ARR); bf16_t* ARB = (bf16_t*)(lds + 8 * RW_ARR); bf16_t* ARK = (bf16_t*)(lds + 9 * RW_ARR);
    bf16_t* W1T = (bf16_t*)(lds + 10 * RW_ARR); bf16_t* UVT = (bf16_t*)(lds + 11 * RW_ARR);
    bf16_t* RHT = (bf16_t*)(lds + 12 * RW_ARR);
    float* ADG = (float*)(lds + 14 * RW_ARR);
    bf16_t* ABA = (bf16_t*)(lds + 14 * RW_ARR + 8192);
    float* WT = (float*)(lds + 14 * RW_ARR + 8192 + 32 * RWP * 2);
    float* GC = WT + 512;
    bf16_t* DAB = AT;
    const int tid = TIDX(), lane = tid & 63, wave = tid >> 6, r32 = lane & 31, hi = lane >> 5;
    float r[8], lw[8], k2[8], v[8], ain[8], bin[8], gg[8], rk[8];
    rw_stage_weights(p, l, h, (bf16_t*)(lds + 8 * 8 * RW_SCRP * 4), tid);
    rw_prep<8, true, true>(p, P, l, b, h, t0 + 8 * wave, (float*)lds + wave * (8 * RW_SCRP), (const bf16_t*)(lds + 8 * 8 * RW_SCRP * 4), lane, r, lw, k2, v, ain, bin, gg, rk);
#pragma unroll
    for (int i = 0; i < 8; ++i) { const size_t o = (size_t)(b * S_ + t0 + 8 * wave + i) * 256 + 64 * h + lane; P.rwGt[o] = (bf16_t)f2bf(gg[i]); P.rwRKV[o] = (bf16_t)f2bf(rk[i] * v[i]); }
    float Lloc[8]; { float s = 0.f;
#pragma unroll
      for (int i = 0; i < 8; ++i) { s += lw[i]; Lloc[i] = s; } }
    __syncthreads();
    if (STOP == 1) return;
    WT[wave * 64 + lane] = Lloc[7];
    __syncthreads();
    { float off = 0.f, tot = 0.f;
#pragma unroll
      for (int w = 0; w < 8; ++w) { const float x = WT[w * 64 + lane]; tot += x; if (w < wave) off += x; }
      if (wave == 0) GC[lane] = __expf(tot);
      unsigned bhp[4], khp[4], vtp[4], atp[4]; float pb = 0.f, pk = 0.f, pv = 0.f, pa = 0.f;
#pragma unroll
      for (int i = 0; i < 8; ++i) { const int t = 8 * wave + i; const float Lt = off + Lloc[i], Lp = Lt - lw[i];
          const float eL = __expf(Lt), eLp = __expf(Lp), einv = __expf(-Lt), eh = __expf(tot - Lt);
          const float xa = ain[i] * eLp;
          AT[t * RWP + lane] = (bf16_t)f2bf(xa); RT[t * RWP + lane] = (bf16_t)f2bf(r[i] * eL);
          BT[t * RWP + lane] = (bf16_t)f2bf(bin[i] * einv); KT[t * RWP + lane] = (bf16_t)f2bf(k2[i] * einv);
          const float xb = bin[i] * eh, xk = k2[i] * eh, xv = v[i];
          if (i & 1) { bhp[i >> 1] = pk2(pb, xb); khp[i >> 1] = pk2(pk, xk); vtp[i >> 1] = pk2(pv, xv); atp[i >> 1] = pk2(pa, xa); } else { pb = xb; pk = xk; pv = xv; pa = xa; } }
      *(u32x4*)(BH + lane * RWP + 8 * wave) = (u32x4){bhp[0], bhp[1], bhp[2], bhp[3]};
      *(u32x4*)(KH + lane * RWP + 8 * wave) = (u32x4){khp[0], khp[1], khp[2], khp[3]};
      *(u32x4*)(VT + lane * RWP + 8 * wave) = (u32x4){vtp[0], vtp[1], vtp[2], vtp[3]};
      *(u32x4*)(RHT + (64 + lane) * RWP + 8 * wave) = (u32x4){atp[0], atp[1], atp[2], atp[3]}; }
    __syncthreads();
#pragma unroll
    for (int jj = 0; jj < 2; ++jj) { const int job = wave + 8 * jj, mat = job >> 2, tm = (job >> 1) & 1, tn = job & 1;
        f32x16 acc = {};
        if (!(tm == 0 && tn == 1)) acc = rw_tile((mat & 2) ? RT : AT, (mat & 1) ? KT : BT, tm, tn, r32, hi, acc);
        const int s = 32 * tn + r32;
#pragma unroll
        for (int q = 0; q < 16; ++q) { const int t = 32 * tm + (q & 3) + 8 * (q >> 2) + 4 * hi;
            const bool keep = (mat & 2) ? (s <= t) : (s < t); const float x = keep ? acc[q] : 0.f;
            if (mat == 0) { if (tm == tn) ADG[(tm * 32 + (t & 31)) * 32 + (s & 31)] = x; else if (tm == 1) ABA[(t & 31) * RWP + s] = (bf16_t)f2bf(x); } else { bf16_t* D = (mat == 1) ? AAK : (mat == 2) ? ARB : ARK; D[t * RWP + s] = (bf16_t)f2bf(x); } } }
    __syncthreads();
    if (STOP == 2) return;
    if (wave < 4) { const int tm = wave >> 1, tn = wave & 1; f32x16 acc = {}; acc = rw_tile(VT, AAK, tm, tn, r32, hi, acc);
#pragma unroll
        for (int q = 0; q < 16; ++q) { const int i = 32 * tm + (q & 3) + 8 * (q >> 2) + 4 * hi; RHT[i * RWP + 32 * tn + r32] = (bf16_t)f2bf(acc[q]); } }
    else if (wave == 4) { float d[32]; const LAS float* ab = (const LAS float*)ADG + hi * 1024;
#pragma unroll
        for (int t = 0; t < 32; ++t) d[t] = (t == r32) ? 1.f : 0.f;
#pragma unroll
        for (int t = 1; t < 32; ++t) { float s0 = 0.f, s1 = 0.f;
#pragma unroll
            for (int s4 = 0; s4 < (t + 3) / 4; ++s4) { const f32x4 a4 = *(const LAS f32x4*)(ab + t * 32 + 4 * s4);
                s0 += a4[0] * d[4 * s4]; s1 += a4[1] * d[4 * s4 + 1]; s0 += a4[2] * d[4 * s4 + 2]; s1 += a4[3] * d[4 * s4 + 3]; }
            d[t] += s0 + s1; if ((t & 3) == 3) MEMFENCE(); }
        LAS bf16_t* D = (LAS bf16_t*)DAB + hi * 32 * RWP + r32;
#pragma unroll
        for (int t = 0; t < 32; ++t) D[t * RWP] = (bf16_t)f2bf(d[t]); }
    __syncthreads();
    if (wave < 4) { bf16_t* XT = (wave < 2 ? UVT : W1T) + (32 * (wave & 1)) * RWP;
        const bf16_t* rh = RHT + (32 * wave + r32) * RWP + 8 * hi;
        { f32x16 acc = {}; const bf16_t* da = DAB + r32 * RWP + 8 * hi;
#pragma unroll
          for (int ks = 0; ks < 2; ++ks) acc = MFMA32(ldsb8(rh + 16 * ks), ldsb8(da + 16 * ks), acc);
#pragma unroll
          for (int q = 0; q < 16; ++q) XT[((q & 3) + 8 * (q >> 2) + 4 * hi) * RWP + r32] = (bf16_t)f2bf(acc[q]); }
        WAVE_SYNC();
        { f32x16 acc; const bf16_t* rz = RHT + (32 * wave) * RWP + 32 + r32;
#pragma unroll
          for (int q = 0; q < 16; ++q) acc[q] = bf2f(rz[((q & 3) + 8 * (q >> 2) + 4 * hi) * RWP]);
          const bf16_t* xa = XT + r32 * RWP + 8 * hi; const bf16_t* ba = ABA + r32 * RWP + 8 * hi;
#pragma unroll
          for (int ks = 0; ks < 2; ++ks) acc = MFMA32(ldsb8(xa + 16 * ks), ldsb8(ba + 16 * ks), acc);
#pragma unroll
          for (int q = 0; q < 16; ++q) XT[((q & 3) + 8 * (q >> 2) + 4 * hi) * RWP + 32 + r32] = (bf16_t)f2bf(acc[q]); }
        WAVE_SYNC();
        { f32x16 acc = {}; const bf16_t* xz = XT + r32 * RWP + 32 + 8 * hi; const bf16_t* db = DAB + (32 + r32) * RWP + 8 * hi;
          const bf16x8 z0 = ldsb8(xz), z1 = ldsb8(xz + 16);
          acc = MFMA32(z0, ldsb8(db), acc); acc = MFMA32(z1, ldsb8(db + 16), acc);
          WAVE_SYNC();
#pragma unroll
          for (int q = 0; q < 16; ++q) XT[((q & 3) + 8 * (q >> 2) + 4 * hi) * RWP + 32 + r32] = (bf16_t)f2bf(acc[q]); } }
    __syncthreads();
    if (STOP == 3) return;
    const size_t chunk = (size_t)unit;
#pragma unroll
    for (int jj = 0; jj < 2; ++jj) { const int job = wave + 8 * jj, kind = job >> 2, tm = (job >> 1) & 1, tn = job & 1; f32x16 acc = {};
        const int col = 32 * tn + r32;
        if (kind == 0) { acc = rw_tile(BH, W1T, tm, tn, r32, hi, acc);
            bf16_t* PT = P.rwPT + chunk * 4096;
#pragma unroll
            for (int q = 0; q < 16; ++q) { const int row = 32 * tm + (q & 3) + 8 * (q >> 2) + 4 * hi; const float x = acc[q] + (row == col ? GC[row] : 0.f); PT[row * 64 + col] = (bf16_t)f2bf(x); } }
        else if (kind == 1) { acc = rw_tile(ARB, W1T, tm, tn, r32, hi, acc);
#pragma unroll
            for (int q = 0; q < 16; ++q) { const int t = 32 * tm + (q & 3) + 8 * (q >> 2) + 4 * hi; const float x = acc[q] + bf2f(RT[t * RWP + col]);
                P.rwQ[(size_t)(b * S_ + t0 + t) * 256 + 64 * h + col] = (bf16_t)f2bf(x); } }
        else if (kind == 2) { acc = rw_tile(UVT, BH, tm, tn, r32, hi, acc); acc = rw_tile(VT, KH, tm, tn, r32, hi, acc);
            unsigned* Gg = (unsigned*)(P.rwG + chunk * 4096) + (tm * 2 + tn) * 8 * 64 + lane;
#pragma unroll
            for (int q = 0; q < 8; ++q) Gg[q * 64] = pk2(acc[2 * q], acc[2 * q + 1]); }
        else { acc = rw_tile(ARB, UVT, tm, tn, r32, hi, acc); acc = rw_tile(ARK, VT, tm, tn, r32, hi, acc);
#pragma unroll
            for (int q = 0; q < 16; ++q) { const int t = 32 * tm + (q & 3) + 8 * (q >> 2) + 4 * hi; P.ycat[(size_t)(b * S_ + t0 + t) * 1024 + 64 * h + col] = (bf16_t)f2bf(acc[q]); } } }
    __syncthreads();
}
__device__ __forceinline__ void rw_state_unit(const KP& p, const Ptrs& P, int l, int unit, unsigned char* lds) {
    bf16_t* Sb = (bf16_t*)lds;
    const int tid = TIDX(), lane = tid & 63, wave = tid >> 6, r32 = lane & 31, hi = lane >> 5;
    const int ti = (wave >> 1) & 1, tj = wave & 1;
    f32x16 S = {};
    unsigned gq[8]; bf16x8 pq[4];
    if (wave < 4) { const size_t chunk = (size_t)unit * RW_NCH; const unsigned* Gg = (const unsigned*)(P.rwG + chunk * 4096) + (ti * 2 + tj) * 8 * 64 + lane;
#pragma unroll
        for (int q = 0; q < 8; ++q) gq[q] = Gg[q * 64];
        const bf16_t* pt = P.rwPT + chunk * 4096 + (32 * tj + r32) * 64 + 8 * hi;
#pragma unroll
        for (int ks = 0; ks < 4; ++ks) pq[ks] = *(const bf16x8*)(pt + 16 * ks); }
    for (int c = 0; c < RW_NCH; ++c) { const size_t chunk = (size_t)unit * RW_NCH + c;
        unsigned gn[8]; bf16x8 pn[4];
        if (wave < 4) { const size_t cn = chunk + (c + 1 < RW_NCH ? 1 : 0); const unsigned* Gg = (const unsigned*)(P.rwG + cn * 4096) + (ti * 2 + tj) * 8 * 64 + lane;
#pragma unroll
            for (int q = 0; q < 8; ++q) gn[q] = Gg[q * 64];
            const bf16_t* pt = P.rwPT + cn * 4096 + (32 * tj + r32) * 64 + 8 * hi;
#pragma unroll
            for (int ks = 0; ks < 4; ++ks) pn[ks] = *(const bf16x8*)(pt + 16 * ks);
#pragma unroll
            for (int q = 0; q < 16; ++q) Sb[(32 * ti + (q & 3) + 8 * (q >> 2) + 4 * hi) * RWP + 32 * tj + r32] = (bf16_t)f2bf(S[q]); }
        __syncthreads();
        { const int row = tid >> 3, ch = tid & 7; *(u32x4*)(P.rwS0 + chunk * 4096 + row * 64 + ch * 8) = *(const u32x4*)(Sb + row * RWP + ch * 8); }
        if (wave < 4) { f32x16 acc;
#pragma unroll
            for (int q = 0; q < 8; ++q) { acc[2 * q] = bflo(gq[q]); acc[2 * q + 1] = bfhi(gq[q]); }
            const bf16_t* sa = Sb + (32 * ti + r32) * RWP + 8 * hi;
#pragma unroll
            for (int ks = 0; ks < 4; ++ks) acc = MFMA32(ldsb8(sa + 16 * ks), pq[ks], acc);
            S = acc;
#pragma unroll
            for (int q = 0; q < 8; ++q) gq[q] = gn[q];
#pragma unroll
            for (int ks = 0; ks < 4; ++ks) pq[ks] = pn[ks]; }
        __syncthreads();
    }
}
template <bool DUMMY = false>
__device__ __forceinline__ void rw_out_unit(const KP& p, const Ptrs& P, int l, int unit, unsigned char* lds) {
    MEMFENCE(); OPAQUE_S(unit);
    const int c = unit % RW_NCH, bh = unit / RW_NCH, b = bh >> 2, h = bh & 3, t0 = c * 64;
    float* Yb = (float*)(lds + 81920);
    const int tid = TIDX(), lane = tid & 63, wave = tid >> 6, r32 = lane & 31, hi = lane >> 5;
    float g[8], rkv[8];
#pragma unroll
    for (int i = 0; i < 8; ++i) { const size_t o = (size_t)(b * S_ + t0 + 8 * wave + i) * 256 + 64 * h + lane; g[i] = bf2f(P.rwGt[o]); rkv[i] = bf2f(P.rwRKV[o]); }
    if (wave < 4) { const int tm = wave >> 1, tn = wave & 1; f32x16 acc; const int col = 32 * tn + r32;
        const bf16_t* yl = P.ycat + (size_t)(b * S_ + t0 + 32 * tm) * 1024 + 64 * h + col;
#pragma unroll
        for (int q = 0; q < 16; ++q) acc[q] = bf2f(yl[(size_t)((q & 3) + 8 * (q >> 2) + 4 * hi) * 1024]);
        const bf16_t* qa = P.rwQ + (size_t)(b * S_ + t0 + 32 * tm + r32) * 256 + 64 * h + 8 * hi; const bf16_t* sb = P.rwS0 + (size_t)unit * 4096 + (32 * tn + r32) * 64 + 8 * hi;
#pragma unroll
        for (int ks = 0; ks < 4; ++ks) acc = MFMA32(*(const bf16x8*)(qa + 16 * ks), *(const bf16x8*)(sb + 16 * ks), acc);
#pragma unroll
        for (int q = 0; q < 16; ++q) Yb[(32 * tm + (q & 3) + 8 * (q >> 2) + 4 * hi) * 64 + col] = acc[q]; }
    __syncthreads();
    const float gng = p.in[I_LNXG][l * 256 + 64 * h + lane], gnb = p.in[I_LNXB][l * 256 + 64 * h + lane];
    { float yv[8], m1[8], m2[8];
#pragma unroll
      for (int i = 0; i < 8; ++i) { yv[i] = Yb[(8 * wave + i) * 64 + lane]; m1[i] = yv[i]; }
      wave_sum_n<8>(m1);
#pragma unroll
      for (int i = 0; i < 8; ++i) { yv[i] -= m1[i] * (1.f / 64.f); m2[i] = yv[i] * yv[i]; }
      wave_sum_n<8>(m2);
#pragma unroll
      for (int i = 0; i < 8; ++i) { const int t = 8 * wave + i; const float yn = yv[i] * (1.0f / sqrtf(m2[i] * (1.f / 64.f) + GN_EPS_)) * gng + gnb; const float o = (yn + rkv[i]) * g[i];
        if (DUMMY) P.pb[(size_t)(b * S_ + t0 + t) * 256 + 64 * h + lane] = (bf16_t)f2bf(o);
        else P.ycat[(size_t)(b * S_ + t0 + t) * 1024 + 64 * h + lane] = (bf16_t)f2bf(o); } }
    __syncthreads();
}
#ifdef EMU_FP8_A
#define EMU_AUX77 u.aux = 77;
#else
#define EMU_AUX77
#endif
__device__ __forceinline__ void tile_map(int L, int nM, int nN, int& pm, int& pn) {
    const int nwg = nM * nN, q = nwg / 8, r = nwg % 8, xcd = L % 8, off = L / 8;
    const int wgid = (xcd < r ? xcd * (q + 1) : r * (q + 1) + (xcd - r) * q) + off;
    const int nig = 8 * nN, gid = wgid / nig, fm = gid * 8, gsz = (nM - fm) < 8 ? (nM - fm) : 8;
    pm = fm + ((wgid % nig) % gsz); pn = (wgid % nig) / gsz;
}
struct EpiStoreBf16 {
    bf16_t* base0; int ldc0; bf16_t* base1; int ldc1;
    __device__ __forceinline__ void operator()(const f32x4 (&acc)[2][2][4][2], const pg8::Unit& u, int wr, int wc, int fr, int fq, int tid) const {
        bf16_t* base = u.kind ? base1 : base0; const int ldc = u.kind ? ldc1 : ldc0;
        int row0 = u.pm * 256 + wr * 64 + fr, col0 = u.pn * 256 + wc * 32 + 8 * fq; OPAQUE(row0); OPAQUE(col0);
#pragma unroll
        for (int ai = 0; ai < 2; ++ai)
#pragma unroll
            for (int m = 0; m < 4; ++m) { bf16_t* rowp = base + (size_t)(row0 + ai * 128 + m * 16) * ldc + col0;
#pragma unroll
                for (int bj = 0; bj < 2; ++bj) { const f32x4 v0 = acc[ai][bj][m][0], v1 = acc[ai][bj][m][1];
                    u32x4 w; w.x = pk2(v0[0], v0[1]); w.y = pk2(v0[2], v0[3]); w.z = pk2(v1[0], v1[1]); w.w = pk2(v1[2], v1[3]);
                    *(u32x4*)(rowp + bj * 128) = w; } }
    }
};
template <int PART>
struct SchedA { const bf16_t* hb; const unsigned char* h8a; const unsigned char* h8b; const bf16_t* WinT; int G, c;
    __device__ __forceinline__ bool next(int i, pg8::Unit& u) const {
        const int nM = T_ / 256, n0 = nM * 9; u.aux = 0;
        if (PART == 0) { const int x = i * G + c; if (x >= n0) return false;
            tile_map(x, nM, 9, u.pm, u.pn); u.kind = 0; u.nt = 8; u.f8 = 1; const int m0 = u.pm * 256;
            u.a = (const char*)(m0 < H8_SPLIT ? h8a + (size_t)m0 * 1024 : h8b + (size_t)(m0 - H8_SPLIT) * 1024); u.b = (const char*)(WinT + (size_t)u.pn * 256 * 1024); }
        else { const int x = i * G + (c + G - n0 % G) % G; if (x >= nM) return false;
            u.pm = 0; u.pn = x; u.kind = 1; u.nt = 16; u.f8 = 0; u.a = (const char*)(WinT + (size_t)WIN_VT * 1024); u.b = (const char*)(hb + (size_t)u.pn * 256 * 1024); }
        return true; } };
struct EpiA { bf16_t* proj; const float* sc;
    __device__ __forceinline__ void operator()(const f32x4 (&acc)[2][2][4][2], const pg8::Unit& u, int wr, int wc, int fr, int fq, int tid) const {
        int row0 = u.pm * 256 + wr * 64 + fr, col0 = u.pn * 256 + wc * 32 + 8 * fq; OPAQUE(row0); OPAQUE(col0);
#pragma unroll
        for (int bj = 0; bj < 2; ++bj) { const f32x4 s0 = *(const f32x4*)(sc + col0 + bj * 128), s1 = *(const f32x4*)(sc + col0 + bj * 128 + 4);
#pragma unroll
            for (int ai = 0; ai < 2; ++ai)
#pragma unroll
                for (int m = 0; m < 4; ++m) { const f32x4 v0 = acc[ai][bj][m][0] * s0, v1 = acc[ai][bj][m][1] * s1;
                    u32x4 w; w.x = pk2(v0[0], v0[1]); w.y = pk2(v0[2], v0[3]); w.z = pk2(v1[0], v1[1]); w.w = pk2(v1[2], v1[3]);
                    *(u32x4*)(proj + (size_t)(row0 + ai * 128 + m * 16) * PJ + col0 + bj * 128) = w; } }
    }
};
__device__ __forceinline__ void phase_A0(const KP& p, unsigned char* lds) {
    const int tid = TIDX(), lane = tid & 63, wave = tid >> 6; const int gw = BIDX() * NWAVE + wave, NGW = GDIM() * NWAVE;
    for (int r = gw; r < L_ * WIN_VT; r += NGW) { const int l = r / WIN_VT, n = r % WIN_VT; const Ptrs P = make_ptrs(p.ws, l); bf16_t* row = P.WinT + (size_t)n * 1024;
        const u32x4 a = *(const u32x4*)(row + 16 * lane), b = *(const u32x4*)(row + 16 * lane + 8);
        float v[16] = {bflo(a.x), bfhi(a.x), bflo(a.y), bfhi(a.y), bflo(a.z), bfhi(a.z), bflo(a.w), bfhi(a.w), bflo(b.x), bfhi(b.x), bflo(b.y), bfhi(b.y), bflo(b.z), bfhi(b.z), bflo(b.w), bfhi(b.w)};
        float am = 0.f;
#pragma unroll
        for (int j = 0; j < 16; ++j) am = fmaxf(am, fabsf(v[j]));
        am = wave_max(am); const float sc = am > 0.f ? am * (1.0f / 440.0f) : 1.0f, inv = 1.0f / sc; u32x4 o;
#pragma unroll
        for (int j = 0; j < 4; ++j) { unsigned w = cvt_pk_fp8_f32_(v[4 * j] * inv, v[4 * j + 1] * inv, 0u, false); w = cvt_pk_fp8_f32_(v[4 * j + 2] * inv, v[4 * j + 3] * inv, w, true); o[j] = w; }
        WAVE_SYNC();
        *(u32x4*)((unsigned char*)row + 16 * lane) = o;
        if (lane == 0) P.gscA[n] = sc; }
#ifdef CPU_EMU
    (void)lds;
#endif
}
__device__ __forceinline__ void phase_A(const KP& p, int l, unsigned char* lds) {
    const Ptrs P = make_ptrs(p.ws, l);
    { SchedA<0> S{P.hb, P.h8a, P.h8b, P.WinT, GDIM(), BIDX()}; EpiA E{P.proj, P.gscA}; pg8::gemm_phase<1>((LAS unsigned char*)lds, 1024, 1024, S, E, 1024); }
    { SchedA<1> S{P.hb, P.h8a, P.h8b, P.WinT, GDIM(), BIDX()}; EpiStoreBf16 E{P.vtr, T_, P.vtr, T_}; pg8::gemm_phase<0>((LAS unsigned char*)lds, 1024, 1024, S, E); }
}
#if PROBE_REPEAT >= 40 && PROBE_REPEAT <= 49
struct SchedAP { const bf16_t* hb; const bf16_t* WinT; int G, c, nt, pnmask;
    __device__ __forceinline__ bool next(int i, pg8::Unit& u) const {
        const int nM = T_ / 256, n0 = nM * 9; const int x = i * G + c; if (x >= n0 + nM) return false;
        u.nt = nt; u.aux = 0; u.f8 = 0;
        if (x < n0) { tile_map(x, nM, 9, u.pm, u.pn); u.kind = 0; u.a = (const char*)(hb + (size_t)u.pm * 256 * 1024); u.b = (const char*)(WinT + (size_t)u.pn * 256 * 1024); }
        else { u.pm = 0; u.pn = x - n0; u.kind = 1; u.a = (const char*)(WinT + (size_t)WIN_VT * 1024); u.b = (const char*)(hb + (size_t)u.pn * 256 * 1024); }
        u.pn &= pnmask; return true; } };
struct EpiNull { float* d;
    __device__ __forceinline__ void operator()(const f32x4 (&acc)[2][2][4][2], const pg8::Unit& u, int wr, int wc, int fr, int fq, int tid) const {
        f32x4 s = (f32x4){0.f, 0.f, 0.f, 0.f};
#pragma unroll
        for (int ai = 0; ai < 2; ++ai)
#pragma unroll
            for (int m = 0; m < 4; ++m)
#pragma unroll
                for (int bj = 0; bj < 2; ++bj) s += acc[ai][bj][m][0] + acc[ai][bj][m][1];
        if (s.x + s.y + s.z + s.w == 1.2345e30f) d[tid] = s.x; } };
struct EpiStash { u32x4* stash;
    __device__ __forceinline__ void operator()(const f32x4 (&acc)[2][2][4][2], const pg8::Unit& u, int wr, int wc, int fr, int fq, int tid) const {
        OPAQUE(tid);
#pragma unroll
        for (int ai = 0; ai < 2; ++ai)
#pragma unroll
            for (int m = 0; m < 4; ++m)
#pragma unroll
                for (int bj = 0; bj < 2; ++bj) { const f32x4 v0 = acc[ai][bj][m][0], v1 = acc[ai][bj][m][1];
                    u32x4 w; w.x = pk2(v0[0], v0[1]); w.y = pk2(v0[2], v0[3]); w.z = pk2(v1[0], v1[1]); w.w = pk2(v1[2], v1[3]);
                    stash[((ai * 4 + m) * 2 + bj) * 512 + tid] = w; } } };
struct EpiFullLine { bf16_t* base;
    __device__ __forceinline__ void operator()(const f32x4 (&acc)[2][2][4][2], const pg8::Unit& u, int wr, int wc, int fr, int fq, int tid) const {
        OPAQUE(tid); if (u.kind) return;
#pragma unroll
        for (int ai = 0; ai < 2; ++ai)
#pragma unroll
            for (int m = 0; m < 4; ++m)
#pragma unroll
                for (int bj = 0; bj < 2; ++bj) { const f32x4 v0 = acc[ai][bj][m][0], v1 = acc[ai][bj][m][1]; const int k = (ai * 4 + m) * 2 + bj, L = k * 512 + tid, row = L >> 5, ch = L & 31;
                    u32x4 w; w.x = pk2(v0[0], v0[1]); w.y = pk2(v0[2], v0[3]); w.z = pk2(v1[0], v1[1]); w.w = pk2(v1[2], v1[3]);
                    *(u32x4*)(base + (size_t)(u.pm * 256 + row) * PJ + u.pn * 256 + ch * 8) = w; } } };
struct EpiProjOnly { bf16_t* base;
    __device__ __forceinline__ void operator()(const f32x4 (&acc)[2][2][4][2], const pg8::Unit& u, int wr, int wc, int fr, int fq, int tid) const {
        if (u.kind) return;
        int row0 = u.pm * 256 + wr * 64 + fr, col0 = u.pn * 256 + wc * 32 + 8 * fq; OPAQUE(row0); OPAQUE(col0);
#pragma unroll
        for (int ai = 0; ai < 2; ++ai)
#pragma unroll
            for (int m = 0; m < 4; ++m) { bf16_t* rowp = base + (size_t)(row0 + ai * 128 + m * 16) * PJ + col0;
#pragma unroll
                for (int bj = 0; bj < 2; ++bj) { const f32x4 v0 = acc[ai][bj][m][0], v1 = acc[ai][bj][m][1];
                    u32x4 w; w.x = pk2(v0[0], v0[1]); w.y = pk2(v0[2], v0[3]); w.z = pk2(v1[0], v1[1]); w.w = pk2(v1[2], v1[3]);
                    *(u32x4*)(rowp + bj * 128) = w; } } } };
template <int V>
__device__ __forceinline__ void phase_Aprobe(const KP& p, int l, unsigned char* lds) {
    const Ptrs P = make_ptrs(p.ws, l);
    SchedAP S{P.hb, P.WinT, GDIM(), BIDX(), V == 1 ? 32 : V == 3 ? 4 : V == 4 ? 8 : V == 5 ? 64 : 16, V == 6 ? 3 : 0xffff};
    if (V == 7) { EpiFullLine E{P.proj}; pg8::gemm_phase((LAS unsigned char*)lds, 1024, 1024, S, E); }
    else if (V == 8) { EpiProjOnly E{P.proj}; pg8::gemm_phase((LAS unsigned char*)lds, 1024, 1024, S, E); }
    else if (V == 2) { EpiStash E{(u32x4*)(P.ycat + (size_t)BIDX() * 65536)}; pg8::gemm_phase((LAS unsigned char*)lds, 1024, 1024, S, E); }
    else if (V == 6) { EpiStoreBf16 E{P.ycat, 1024, P.ycat, 1024}; pg8::gemm_phase((LAS unsigned char*)lds, 1024, 1024, S, E); }
    else { EpiNull E{(float*)(P.ycat + (size_t)BIDX() * 65536)}; pg8::gemm_phase((LAS unsigned char*)lds, 1024, 1024, S, E); }
}
#endif
struct SchedGlu { const bf16_t* ycat; const bf16_t* GluT; int G, c;
    __device__ __forceinline__ bool next(int i, pg8::Unit& u) const {
        const int x = i * G + c; if (x >= T_ / 256) return false;
        u.pm = x; u.pn = 0; u.nt = 4; u.kind = 0; u.aux = 0; u.f8 = 0; u.a = (const char*)(ycat + (size_t)x * 256 * 1024 + 256); u.b = (const char*)GluT; return true; } };
struct EpiGlu { bf16_t* ycat; const float* glub;
    __device__ __forceinline__ void operator()(const f32x4 (&acc)[2][2][4][2], const pg8::Unit& u, int wr, int wc, int fr, int fq, int tid) const {
        int row0 = u.pm * 256 + wr * 64 + fr, col0 = wc * 32 + 8 * fq; OPAQUE(row0); OPAQUE(col0);
#pragma unroll
        for (int bj = 0; bj < 2; ++bj) { const f32x4 b0 = *(const f32x4*)(glub + col0 + bj * 128), b1 = *(const f32x4*)(glub + col0 + bj * 128 + 4);
#pragma unroll
            for (int ai = 0; ai < 2; ++ai)
#pragma unroll
                for (int m = 0; m < 4; ++m) { bf16_t* ptr = ycat + (size_t)(row0 + ai * 128 + m * 16) * 1024 + 256 + col0 + bj * 128;
                    const u32x4 y = *(const u32x4*)ptr; const f32x4 v0 = acc[ai][bj][m][0] + b0, v1 = acc[ai][bj][m][1] + b1;
                    u32x4 w; w.x = pk2(bflo(y.x) * sigmoidf_(v0[0]), bfhi(y.x) * sigmoidf_(v0[1])); w.y = pk2(bflo(y.y) * sigmoidf_(v0[2]), bfhi(y.y) * sigmoidf_(v0[3]));
                    w.z = pk2(bflo(y.z) * sigmoidf_(v1[0]), bfhi(y.z) * sigmoidf_(v1[1])); w.w = pk2(bflo(y.w) * sigmoidf_(v1[2]), bfhi(y.w) * sigmoidf_(v1[3]));
                    *(u32x4*)ptr = w; MEMFENCE(); } }
    }
};
__device__ __forceinline__ void convert_tables(const KP& p, const Ptrs& P, int l, unsigned char* lds) {
    const int tid = TIDX(), lane = tid & 63, wave = tid >> 6;
    unsigned* cnt = (unsigned*)(p.ws + WS_CTL) + 10240 + 16 * l; int* slot = (int*)(lds + 65536);
    const float* ps = p.in[I_P] + (size_t)l * T_ * 256;
    constexpr int NG8 = 6144 / 128, NTAB = 2 * NEXP / 128, NPB = (int)(((size_t)T_ * 256 / 8 + 4095) / 4096);
    for (;;) {
        __syncthreads(); if (tid == 0) *slot = (int)atomicAdd(cnt, 1u); __syncthreads();
        int item = *slot; if (item >= NG8 + NTAB + NPB) break;
        if (item < NG8) {
            for (int rr = wave; rr < 128; rr += NWAVE) { const int r5 = item * 128 + rr; bf16_t* row = r5 < 4096 ? P.WinT + (size_t)(WIN_GATE + r5) * 1024 : r5 < 5120 ? P.PleGT + (size_t)(r5 - 4096) * 1024 : P.WoutT + (size_t)(r5 - 5120) * 1024;
                const u32x4 a = *(const u32x4*)(row + 16 * lane), b = *(const u32x4*)(row + 16 * lane + 8);
                float v[16] = {bflo(a.x), bfhi(a.x), bflo(a.y), bfhi(a.y), bflo(a.z), bfhi(a.z), bflo(a.w), bfhi(a.w), bflo(b.x), bfhi(b.x), bflo(b.y), bfhi(b.y), bflo(b.z), bfhi(b.z), bflo(b.w), bfhi(b.w)};
                float am = 0.f;
#pragma unroll
                for (int j = 0; j < 16; ++j) am = fmaxf(am, fabsf(v[j]));
                am = wave_max(am); const float sc = am > 0.f ? am * (1.0f / 440.0f) : 1.0f, inv = 1.0f / sc; u32x4 o;
#pragma unroll
                for (int j = 0; j < 4; ++j) { unsigned w = cvt_pk_fp8_f32_(v[4 * j] * inv, v[4 * j + 1] * inv, 0u, false); w = cvt_pk_fp8_f32_(v[4 * j + 2] * inv, v[4 * j + 3] * inv, w, true); o[j] = w; }
                WAVE_SYNC();
                *(u32x4*)((unsigned char*)row + 16 * lane) = o;
                if (lane == 0) P.gsc[r5] = sc; }
            continue; }
        item -= NG8;
        if (item < NTAB) {
            for (int r4 = 0; r4 < 16; r4 += 4) { f32x4 v[4][4]; float am[4];
#pragma unroll
                for (int q = 0; q < 4; ++q) { const int it = item * 128 + wave + 8 * (r4 + q); const int tb = it >= NEXP, row = tb ? it - NEXP : it;
                    const float* src = p.in[tb ? I_V : I_U] + ((size_t)l * NEXP + row) * 1024 + 16 * lane; am[q] = 0.f;
#pragma unroll
                    for (int j = 0; j < 4; ++j) { v[q][j] = *(const f32x4*)(src + 4 * j); am[q] = fmaxf(am[q], fmaxf(fmaxf(fabsf(v[q][j].x), fabsf(v[q][j].y)), fmaxf(fabsf(v[q][j].z), fabsf(v[q][j].w)))); } }
#pragma unroll
                for (int q = 0; q < 4; ++q) { const int it = item * 128 + wave + 8 * (r4 + q); const int tb = it >= NEXP, row = tb ? it - NEXP : it;
                    const float amx = wave_max(am[q]); const float sc = amx > 0.f ? amx * (1.0f / 440.0f) : 1.0f, inv = 1.0f / sc; u32x4 o;
#pragma unroll
                    for (int j = 0; j < 4; ++j) { unsigned w = cvt_pk_fp8_f32_(v[q][j].x * inv, v[q][j].y * inv, 0u, false); w = cvt_pk_fp8_f32_(v[q][j].z * inv, v[q][j].w * inv, w, true); o[j] = w; }
                    *(u32x4*)((tb ? P.V8 : P.U8) + ((size_t)(lane >> 3) * NEXP + row) * 128 + 16 * (lane & 7)) = o;
                    if (lane == 0) (tb ? P.sv : P.su)[row] = sc; } }
        } else {
            const size_t base = (size_t)(item - NTAB) * 4096;
            f32x4 a[8], bq[8];
#pragma unroll
            for (int j = 0; j < 8; ++j) { const size_t i = base + tid + (size_t)j * NTHR; a[j] = (f32x4){0.f, 0.f, 0.f, 0.f}; bq[j] = a[j];
                if (i < (size_t)T_ * 256 / 8) { a[j] = *(const f32x4*)(ps + i * 8); bq[j] = *(const f32x4*)(ps + i * 8 + 4); } }
#pragma unroll
            for (int j = 0; j < 8; ++j) { const size_t i = base + tid + (size_t)j * NTHR;
                if (i < (size_t)T_ * 256 / 8) { u32x4 o; o.x = pk2(a[j].x, a[j].y); o.y = pk2(a[j].z, a[j].w); o.z = pk2(bq[j].x, bq[j].y); o.w = pk2(bq[j].z, bq[j].w); *(u32x4*)(P.pb + i * 8) = o; } }
        }
    }
}
__device__ __forceinline__ void phase_B2(const KP& p, int l, unsigned char* lds) {
    const Ptrs P = make_ptrs(p.ws, l);
    constexpr int NRW = NB_ * 4; const int G = GDIM(), c = BIDX();
    int gG = G, gc = c;
    if (G > NRW) { if (c < NRW) { rw_state_unit(p, P, l, c, lds);
#if PROBE_REPEAT == 35
        rw_state_unit(p, P, l, c, lds);
#endif
        convert_tables(p, P, l, lds); return; } gG = G - NRW; gc = c - NRW; }
    else { for (int u = c; u < NRW; u += G) rw_state_unit(p, P, l, u, lds); }
    SchedGlu S{P.ycat, P.GluT, gG, gc};
    EpiGlu E{P.ycat, p.in[I_GLUB] + l * 256};
    pg8::gemm_phase((LAS unsigned char*)lds, 1024, 256, S, E);
    convert_tables(p, P, l, lds);
}
struct SchedC { const unsigned char* h8a; const unsigned char* h8b; const bf16_t* ycat; const bf16_t* WinT; const bf16_t* WbrT; int G, c;
    __device__ __forceinline__ bool next(int i, pg8::Unit& u) const {
        const int tile = (i >> 3) * G + c; if (tile >= (T_ / 256) * 4) return false;
        const int j = i & 7, b = j >> 1; tile_map(tile, T_ / 256, 4, u.pm, u.pn); u.aux = b;
        if (!(j & 1)) { u.kind = 0; u.nt = 4; u.f8 = 0; u.a = (const char*)(ycat + (size_t)u.pm * 256 * 1024 + 256 * b); u.b = (const char*)(WbrT + (size_t)u.pn * 256 * 1024 + 256 * b); }
        else { u.kind = 1; u.nt = 8; u.f8 = 1; const int m0 = u.pm * 256;
            u.a = (const char*)(m0 < H8_SPLIT ? h8a + (size_t)m0 * 1024 : h8b + (size_t)(m0 - H8_SPLIT) * 1024); u.b = (const char*)(WinT + (size_t)(WIN_GATE + 1024 * b + 256 * u.pn) * 1024); }
        return true; } };
struct EpiC { u32x4* stash; bf16_t* merged; const float* gsc; unsigned char* m8;
    __device__ __forceinline__ void operator()(const f32x4 (&acc)[2][2][4][2], const pg8::Unit& u, int wr, int wc, int fr, int fq, int tid) const {
        OPAQUE(tid);
        if (u.kind == 0) {
#pragma unroll
            for (int ai = 0; ai < 2; ++ai)
#pragma unroll
                for (int m = 0; m < 4; ++m)
#pragma unroll
                    for (int bj = 0; bj < 2; ++bj) { const f32x4 v0 = acc[ai][bj][m][0], v1 = acc[ai][bj][m][1];
                        u32x4 w; w.x = pk2(v0[0], v0[1]); w.y = pk2(v0[2], v0[3]); w.z = pk2(v1[0], v1[1]); w.w = pk2(v1[2], v1[3]);
                        stash[((ai * 4 + m) * 2 + bj) * 512 + tid] = w; }
        } else {
            int row0 = u.pm * 256 + wr * 64 + fr, col0 = u.pn * 256 + wc * 32 + 8 * fq; OPAQUE(row0); OPAQUE(col0); const bool first = (u.aux == 0);
            f32x4 sc[2][2];
#pragma unroll
            for (int bj = 0; bj < 2; ++bj) { const float* sp = gsc + 1024 * u.aux + col0 + bj * 128; sc[bj][0] = *(const f32x4*)sp; sc[bj][1] = *(const f32x4*)(sp + 4); }
#pragma unroll
            for (int ai = 0; ai < 2; ++ai)
#pragma unroll
                for (int mp = 0; mp < 2; ++mp) { u32x4 y[4], mo[4];
#pragma unroll
                    for (int q = 0; q < 4; ++q) { const int m = 2 * mp + (q >> 1), bj = q & 1;
                        y[q] = stash[((ai * 4 + m) * 2 + bj) * 512 + tid]; mo[q] = (u32x4){0u, 0u, 0u, 0u};
                        if (!first) mo[q] = *(const u32x4*)(merged + (size_t)(row0 + ai * 128 + m * 16) * 1024 + col0 + bj * 128); }
#pragma unroll
                    for (int q = 0; q < 4; ++q) { const int m = 2 * mp + (q >> 1), bj = q & 1; const f32x4 g0 = acc[ai][bj][m][0] * sc[bj][0], g1 = acc[ai][bj][m][1] * sc[bj][1];
                        bf16_t* ptr = merged + (size_t)(row0 + ai * 128 + m * 16) * 1024 + col0 + bj * 128;
                        const float o0 = bflo(y[q].x) * sigmoidf_(g0[0]) + bflo(mo[q].x), o1 = bfhi(y[q].x) * sigmoidf_(g0[1]) + bfhi(mo[q].x), o2 = bflo(y[q].y) * sigmoidf_(g0[2]) + bflo(mo[q].y), o3 = bfhi(y[q].y) * sigmoidf_(g0[3]) + bfhi(mo[q].y);
                        const float o4 = bflo(y[q].z) * sigmoidf_(g1[0]) + bflo(mo[q].z), o5 = bfhi(y[q].z) * sigmoidf_(g1[1]) + bfhi(mo[q].z), o6 = bflo(y[q].w) * sigmoidf_(g1[2]) + bflo(mo[q].w), o7 = bfhi(y[q].w) * sigmoidf_(g1[3]) + bfhi(mo[q].w);
                        u32x4 w; w.x = pk2(o0, o1); w.y = pk2(o2, o3); w.z = pk2(o4, o5); w.w = pk2(o6, o7);
                        *(u32x4*)ptr = w;
                        if (u.aux == 3) { u32x2 w8; w8.x = cvt_pk_fp8_f32_(o0, o1, 0u, false); w8.x = cvt_pk_fp8_f32_(o2, o3, w8.x, true); w8.y = cvt_pk_fp8_f32_(o4, o5, 0u, false); w8.y = cvt_pk_fp8_f32_(o6, o7, w8.y, true);
                            *(u32x2*)(m8 + (size_t)(row0 + ai * 128 + m * 16) * 1024 + col0 + bj * 128) = w8; } }
                    MEMFENCE(); }
        }
    }
};
__device__ __forceinline__ void phase_C(const KP& p, int l, unsigned char* lds) {
    const Ptrs P = make_ptrs(p.ws, l);
    SchedC S{P.h8a, P.h8b, P.ycat, P.WinT, P.WbrT, GDIM(), BIDX()};
    EpiC E{(u32x4*)(P.stash + (size_t)BIDX() * 131072), P.merged, P.gsc, P.h8e};
    pg8::gemm_phase<2>((LAS unsigned char*)lds, 1024, 1024, S, E, 1024);
}
struct SchedD { const unsigned char* A8; const bf16_t* Bt; int nN, G, c;
    __device__ __forceinline__ bool next(int i, pg8::Unit& u) const {
        const int x = i * G + c; if (x >= (T_ / 256) * nN) return false;
        tile_map(x, T_ / 256, nN, u.pm, u.pn); u.nt = 8; u.kind = 0; u.aux = 0; u.f8 = 1; u.a = (const char*)(A8 + (size_t)u.pm * 256 * 1024); u.b = (const char*)(Bt + (size_t)u.pn * 256 * 1024); return true; } };
struct EpiResid { bf16_t* ob; const bf16_t* hb; const float* sc;
    __device__ __forceinline__ void operator()(const f32x4 (&acc)[2][2][4][2], const pg8::Unit& u, int wr, int wc, int fr, int fq, int tid) const {
        int row0 = u.pm * 256 + wr * 64 + fr, col0 = u.pn * 256 + wc * 32 + 8 * fq; OPAQUE(row0); OPAQUE(col0);
#pragma unroll
        for (int ai = 0; ai < 2; ++ai)
#pragma unroll
            for (int m = 0; m < 4; ++m)
#pragma unroll
                for (int bj = 0; bj < 2; ++bj) { const size_t o = (size_t)(row0 + ai * 128 + m * 16) * 1024 + col0 + bj * 128; const u32x4 hw = *(const u32x4*)(hb + o);
                    const f32x4 a0 = acc[ai][bj][m][0] * *(const f32x4*)(sc + col0 + bj * 128), a1 = acc[ai][bj][m][1] * *(const f32x4*)(sc + col0 + bj * 128 + 4); u32x4 w;
                    w.x = pk2(bflo(hw.x) * DN_ALPHA_ + a0[0], bfhi(hw.x) * DN_ALPHA_ + a0[1]); w.y = pk2(bflo(hw.y) * DN_ALPHA_ + a0[2], bfhi(hw.y) * DN_ALPHA_ + a0[3]);
                    w.z = pk2(bflo(hw.z) * DN_ALPHA_ + a1[0], bfhi(hw.z) * DN_ALPHA_ + a1[1]); w.w = pk2(bflo(hw.w) * DN_ALPHA_ + a1[2], bfhi(hw.w) * DN_ALPHA_ + a1[3]);
                    *(u32x4*)(ob + o) = w; }
    }
};
__device__ __forceinline__ void phase_D(const KP& p, int l, unsigned char* lds) {
    const Ptrs P = make_ptrs(p.ws, l);
    SchedD S{P.h8e, P.WoutT, 4, GDIM(), BIDX()};
    EpiResid E{P.ycat, P.hb, P.gsc + 5120};
    pg8::gemm_phase<1>((LAS unsigned char*)lds, 1024, 1024, S, E, 1024);
}
__device__ __forceinline__ void phase_D2(const KP& p, int l, unsigned char* lds) {
    const Ptrs P = make_ptrs(p.ws, l);
    const int tid = TIDX(), lane = tid & 63, wave = tid >> 6; const int gw = BIDX() * NWAVE + wave, NGW = GDIM() * NWAVE;
    for (int m = 4 * gw; m < T_; m += 4 * NGW) ln_rows<4, true>(P.ycat + (size_t)m * 1024, p.in[I_LN1G] + l * 1024, p.in[I_LN1B] + l * 1024, (float*)nullptr, P.hb + (size_t)m * 1024, P.h8e + (size_t)m * 1024, lane);
}
struct SchedE1 { const bf16_t* pb; const bf16_t* PleT; int G, c;
    __device__ __forceinline__ bool next(int i, pg8::Unit& u) const {
        const int x = i * G + c; if (x >= (T_ / 256) * 4) return false;
        tile_map(x, T_ / 256, 4, u.pm, u.pn); u.nt = 4; u.kind = 0; u.aux = 0; u.f8 = 0; u.a = (const char*)(pb + (size_t)u.pm * 256 * 256); u.b = (const char*)(PleT + (size_t)u.pn * 256 * 256); return true; } };
template <int PART>
struct SchedE2 { const bf16_t* hb; const unsigned char* h8e; const bf16_t* PleGT; const bf16_t* WqT; int G, c;
    __device__ __forceinline__ bool next(int i, pg8::Unit& u) const {
        const int n0 = (T_ / 256) * 4; int x = i * G + c + (PART ? n0 : 0); if (x >= (PART ? n0 + (T_ / 256) * 8 : n0)) return false;
        u.aux = 0;
        if (x < n0) { tile_map(x, T_ / 256, 4, u.pm, u.pn); u.kind = 0; u.nt = 8; u.f8 = 1; u.b = (const char*)(PleGT + (size_t)u.pn * 256 * 1024); u.a = (const char*)(h8e + (size_t)u.pm * 256 * 1024); }
        else { x -= n0; tile_map(x, T_ / 256, 8, u.pm, u.pn); u.kind = 1; u.nt = 16; u.f8 = 0; u.b = (const char*)(WqT + (size_t)u.pn * 256 * 1024); u.a = (const char*)(hb + (size_t)u.pm * 256 * 1024); }
        return true; } };
struct EpiE2g { const bf16_t* hb; bf16_t* Pbuf; const float* gsc;
    __device__ __forceinline__ void operator()(const f32x4 (&acc)[2][2][4][2], const pg8::Unit& u, int wr, int wc, int fr, int fq, int tid) const {
        int row0 = u.pm * 256 + wr * 64 + fr, col0 = u.pn * 256 + wc * 32 + 8 * fq; OPAQUE(row0); OPAQUE(col0);
#pragma unroll
        for (int bj = 0; bj < 2; ++bj) { const float* sp = gsc + 4096 + col0 + bj * 128; const f32x4 s0 = *(const f32x4*)sp, s1 = *(const f32x4*)(sp + 4);
            const size_t cb = (size_t)row0 * 1024 + col0 + bj * 128; const bf16_t* hp = hb + cb; bf16_t* pp = Pbuf + cb;
#pragma unroll
            for (int ai = 0; ai < 2; ++ai)
#pragma unroll
                for (int mp = 0; mp < 2; ++mp) { u32x4 y[2], hw[2];
#pragma unroll
                    for (int q = 0; q < 2; ++q) { const int ro = (ai * 128 + (2 * mp + q) * 16) * 1024; y[q] = *(const u32x4*)(pp + ro); hw[q] = *(const u32x4*)(hp + ro); }
#pragma unroll
                    for (int q = 0; q < 2; ++q) { const int m = 2 * mp + q; const int ro = (ai * 128 + m * 16) * 1024; const f32x4 v0 = acc[ai][bj][m][0] * s0, v1 = acc[ai][bj][m][1] * s1;
                        u32x4 w;
                        w.x = pk2(bflo(hw[q].x) * DN_ALPHA_ + bflo(y[q].x) * sigmoidf_(v0[0]), bfhi(hw[q].x) * DN_ALPHA_ + bfhi(y[q].x) * sigmoidf_(v0[1]));
                        w.y = pk2(bflo(hw[q].y) * DN_ALPHA_ + bflo(y[q].y) * sigmoidf_(v0[2]), bfhi(hw[q].y) * DN_ALPHA_ + bfhi(y[q].y) * sigmoidf_(v0[3]));
                        w.z = pk2(bflo(hw[q].z) * DN_ALPHA_ + bflo(y[q].z) * sigmoidf_(v1[0]), bfhi(hw[q].z) * DN_ALPHA_ + bfhi(y[q].z) * sigmoidf_(v1[1]));
                        w.w = pk2(bflo(hw[q].w) * DN_ALPHA_ + bflo(y[q].w) * sigmoidf_(v1[2]), bfhi(hw[q].w) * DN_ALPHA_ + bfhi(y[q].w) * sigmoidf_(v1[3]));
                        *(u32x4*)(pp + ro) = w; }
                    MEMFENCE(); } }
    }
};
__device__ __forceinline__ void phase_E(const KP& p, int l, unsigned char* lds) {
    const Ptrs P = make_ptrs(p.ws, l);
    { SchedE1 S{P.pb, P.PleT, GDIM(), BIDX()}; EpiStoreBf16 E{P.ycat, 1024, P.ycat, 1024}; pg8::gemm_phase((LAS unsigned char*)lds, 256, 256, S, E); }
    { SchedE2<0> S{P.hb, P.h8e, P.PleGT, P.WqT, GDIM(), BIDX()}; EpiE2g E{P.hb, P.ycat, P.gsc}; pg8::gemm_phase<1>((LAS unsigned char*)lds, 1024, 1024, S, E, 1024); }
    { SchedE2<1> S{P.hb, P.h8e, P.PleGT, P.WqT, GDIM(), BIDX()}; EpiStoreBf16 E{P.q, 2048, P.q, 2048}; pg8::gemm_phase<0>((LAS unsigned char*)lds, 1024, 1024, S, E); }
}
__device__ __forceinline__ unsigned mono_key(float f) { const unsigned u = __builtin_bit_cast(unsigned, f); return (u & 0x80000000u) ? ~u : (u | 0x80000000u); }
__device__ __forceinline__ float unmono_key(unsigned k) { const unsigned u = (k & 0x80000000u) ? (k ^ 0x80000000u) : ~k; return __builtin_bit_cast(float, u); }
struct CandTab { int a[50], b[50]; };
constexpr CandTab make_cand() { CandTab t{}; int n = 0; for (int a = 0; a < 16; ++a) for (int b = 0; b < 16; ++b) if ((a + 1) * (b + 1) <= 16) { t.a[n] = a; t.b[n] = b; ++n; } return t; }
constexpr CandTab CAND = make_cand();
constexpr int PK_PITCH = 136;

#define PK_CE(x, y) do { const unsigned _a = (x), _b = (y); (x) = _a > _b ? _a : _b; (y) = _a > _b ? _b : _a; } while (0)
__device__ __forceinline__ void bitonic_merge16_desc(unsigned (&a)[16]) {
#pragma unroll
    for (int j = 8; j > 0; j >>= 1)
#pragma unroll
        for (int i = 0; i < 16; ++i) { const int l = i ^ j; if (l > i) PK_CE(a[i], a[l]); }
}
__device__ __forceinline__ void bitonic_sort16_desc(unsigned (&a)[16]) {
#pragma unroll
    for (int k = 2; k <= 16; k <<= 1)
#pragma unroll
        for (int j = k >> 1; j > 0; j >>= 1)
#pragma unroll
            for (int i = 0; i < 16; ++i) { const int l = i ^ j; if (l > i) { if ((i & k) == 0 || k == 16) PK_CE(a[i], a[l]); else PK_CE(a[l], a[i]); } }
}
__device__ __forceinline__ void top_half_merge16(unsigned (&a)[16], const unsigned (&b)[16]) {
#pragma unroll
    for (int i = 0; i < 16; ++i) a[i] = a[i] > b[15 - i] ? a[i] : b[15 - i];
    bitonic_merge16_desc(a);
}
__device__ __forceinline__ void top16_keys(const unsigned (&key)[64], unsigned (&top)[16]) {
    unsigned g0[16], g1[16], g2[16], g3[16];
#pragma unroll
    for (int i = 0; i < 16; ++i) { g0[i] = key[i]; g1[i] = key[16 + i]; g2[i] = key[32 + i]; g3[i] = key[48 + i]; }
    bitonic_sort16_desc(g0); bitonic_sort16_desc(g1); bitonic_sort16_desc(g2); bitonic_sort16_desc(g3);
    top_half_merge16(g0, g1); top_half_merge16(g2, g3); top_half_merge16(g0, g2);
    unsigned pr[16];
#pragma unroll
    for (int i = 0; i < 16; ++i) pr[i] = (unsigned)__shfl_xor((int)g0[i], 32);
    top_half_merge16(g0, pr);
#pragma unroll
    for (int i = 0; i < 16; ++i) top[i] = g0[i];
}
__device__ __forceinline__ void peer_route_unit(const KP& p, const Ptrs& P, int l, int unit, unsigned char* lds) {
    const bf16_t* Ks = (const bf16_t*)lds;
    const int tid = TIDX(), lane = tid & 63, wave = tid >> 6, r32 = lane & 31, hi = lane >> 5;
    const int tok = unit * 32 + r32;
    int kbase = r32 * PK_PITCH + 8 * hi; OPAQUE(kbase);
    unsigned top1[16], top2[16];
#pragma unroll 1
    for (int half = 0; half < 2; ++half) {
        const bf16_t* qp = P.q + (size_t)tok * 2048 + wave * 256 + half * 128 + 8 * hi;
        bf16x8 qf[8];
#pragma unroll
        for (int ks = 0; ks < 8; ++ks) qf[ks] = *(const bf16x8*)(qp + 16 * ks);
        unsigned key[64];
#pragma unroll
        for (int kt = 0; kt < 4; ++kt) { f32x16 acc = {}; const bf16_t* kp = Ks + (half * 128 + 32 * kt) * PK_PITCH + kbase;
#pragma unroll
            for (int ks = 0; ks < 8; ++ks) { const bf16x8 a = *(const bf16x8*)(kp + 16 * ks); acc = MFMA32(a, qf[ks], acc); }
#pragma unroll
            for (int r = 0; r < 16; ++r) { const int idx = 32 * kt + (r & 3) + 8 * (r >> 2) + 4 * hi; key[16 * kt + r] = (mono_key(acc[r]) & ~127u) | (unsigned)(127 - idx); } }
        if (half == 0) top16_keys(key, top1); else top16_keys(key, top2);
        MEMFENCE();
    }
    MEMFENCE();
    int* islot = (int*)(lds + 2 * 128 * PK_PITCH * 2) + (wave * 32 + r32) * 33;
    float v1[16], v2[16];
#pragma unroll
    for (int r = 0; r < 16; ++r) { v1[r] = unmono_key(top1[r] & ~127u); v2[r] = unmono_key(top2[r] & ~127u); islot[16 * hi + r] = 127 - (int)((hi ? top2[r] : top1[r]) & 127u); }
    unsigned ka[16], kb[16];
#pragma unroll
    for (int i = 0; i < 25; ++i) { const int c0 = 2 * i, c1 = 2 * i + 1;
        const float s = hi ? (v1[CAND.a[c1]] + v2[CAND.b[c1]]) : (v1[CAND.a[c0]] + v2[CAND.b[c0]]);
        const unsigned k = (mono_key(s) & ~255u) | (unsigned)(255 - (hi ? 16 * CAND.a[c1] + CAND.b[c1] : 16 * CAND.a[c0] + CAND.b[c0]));
        if (i < 16) ka[i] = k; else kb[i - 16] = k; }
#pragma unroll
    for (int i = 9; i < 16; ++i) kb[i] = 0u;
    bitonic_sort16_desc(ka); bitonic_sort16_desc(kb); top_half_merge16(ka, kb);
    { unsigned pr[16];
#pragma unroll
      for (int i = 0; i < 16; ++i) pr[i] = (unsigned)__shfl_xor((int)ka[i], 32);
      top_half_merge16(ka, pr); }
    WAVE_SYNC();
    float sc[16]; int se[16];
#pragma unroll
    for (int r = 0; r < 16; ++r) { sc[r] = unmono_key(ka[r] & ~255u); se[r] = 0; }
#pragma unroll
    for (int r = 0; r < 8; ++r) { unsigned mlo = ka[r], mhi = ka[8 + r]; OPAQUE(mlo); OPAQUE(mhi);
        const unsigned m = hi ? mhi : mlo; const int ab = 255 - (int)(m & 255u); const int e = islot[ab >> 4] * 128 + islot[16 + (ab & 15)];
        if (hi) se[8 + r] = e; else se[r] = e; }
    WAVE_SYNC();
    float g[16]; float sum = 0.f;
#pragma unroll
    for (int r = 0; r < 16; ++r) { g[r] = __expf(sc[r] - sc[0]); sum += g[r]; }
    const float inv = 1.0f / sum;
    const size_t ob = (size_t)tok * 128 + wave * 16 + 8 * hi;
    if (hi == 0) {
        *(u32x4*)(P.eid + ob) = (u32x4){(unsigned)se[0], (unsigned)se[1], (unsigned)se[2], (unsigned)se[3]}; *(u32x4*)(P.eid + ob + 4) = (u32x4){(unsigned)se[4], (unsigned)se[5], (unsigned)se[6], (unsigned)se[7]};
        *(f32x4*)(P.gate + ob) = (f32x4){g[0] * inv, g[1] * inv, g[2] * inv, g[3] * inv}; *(f32x4*)(P.gate + ob + 4) = (f32x4){g[4] * inv, g[5] * inv, g[6] * inv, g[7] * inv};
    } else {
        *(u32x4*)(P.eid + ob) = (u32x4){(unsigned)se[8], (unsigned)se[9], (unsigned)se[10], (unsigned)se[11]}; *(u32x4*)(P.eid + ob + 4) = (u32x4){(unsigned)se[12], (unsigned)se[13], (unsigned)se[14], (unsigned)se[15]};
        *(f32x4*)(P.gate + ob) = (f32x4){g[8] * inv, g[9] * inv, g[10] * inv, g[11] * inv}; *(f32x4*)(P.gate + ob + 4) = (f32x4){g[12] * inv, g[13] * inv, g[14] * inv, g[15] * inv};
    }
}
__device__ __forceinline__ void phase_F(const KP& p, int l, unsigned char* lds) {
    const Ptrs P = make_ptrs(p.ws, l);
    bf16_t* Ks = (bf16_t*)lds; const int tid = TIDX();
    for (int e = tid; e < 2 * 128 * 16; e += NTHR) { const int row = e >> 4, ch = e & 15; *(u32x4*)(Ks + row * PK_PITCH + ch * 8) = *(const u32x4*)(P.K12 + row * 128 + ch * 8); }
    __syncthreads();
    for (int u = BIDX(); u < T_ / 32; u += GDIM()) peer_route_unit(p, P, l, u, lds);
    __syncthreads();
}
constexpr int PG_TB = (T_ >= 4096 ? 128 : 64), PG_NBLK = T_ / PG_TB;
__device__ __forceinline__ int peer_next_item(unsigned* cnt, int* slot, int tid) {
    __syncthreads();
    if (tid == 0) *slot = (int)atomicAdd(cnt, 1u);
    __syncthreads();
    return *slot;
}
constexpr int PG_TPW = PG_TB / NWAVE;
static_assert(PG_TPW >= 4 && PG_TPW % 2 == 0, "token pipeline depth");
constexpr int PG_WLDS = 6144;
__device__ __forceinline__ void pg_issue_rows(const unsigned char* T8, int x, int c8, int gq, int lane, int e0, int e1, int* E, u32x4 (&rb)[16]) {
    WAVE_SYNC(); E[lane] = e0; E[64 + lane] = e1; WAVE_SYNC();
#pragma unroll
    for (int k = 0; k < 16; ++k) { const unsigned off = ((unsigned)(x * NEXP) + (unsigned)E[gq + 8 * k]) * 128u + 16u * (unsigned)c8; rb[k] = *(const u32x4*)(T8 + off); }
}
template <bool REFILL, int TAG>
__device__ __forceinline__ void pg_dots_compute(const Ptrs& P, int x, int t, u32x4 (&ub)[16], u32x4 xa, u32x4 xb, float* R, const int* E, int c8, int gq, int lane) {
    const f32x2 x0 = (f32x2){bflo(xa.x), bfhi(xa.x)}, x1 = (f32x2){bflo(xa.y), bfhi(xa.y)}, x2 = (f32x2){bflo(xa.z), bfhi(xa.z)}, x3 = (f32x2){bflo(xa.w), bfhi(xa.w)};
    const f32x2 x4 = (f32x2){bflo(xb.x), bfhi(xb.x)}, x5 = (f32x2){bflo(xb.y), bfhi(xb.y)}, x6 = (f32x2){bflo(xb.z), bfhi(xb.z)}, x7 = (f32x2){bflo(xb.w), bfhi(xb.w)};
    WAVE_SYNC();
    unsigned off[8];
    const unsigned char* ubase = P.U8;
#pragma unroll
    for (int k = 0; k < 16; ++k) { PIN1(ub[k]);
        if (REFILL && (k & 7) == 0) {
#pragma unroll
            for (int j = 0; j < 8; ++j) off[j] = ((unsigned)(x * NEXP) + (unsigned)E[gq + 8 * (k + j)]) * 128u + 16u * (unsigned)c8; }
        f32x2 s = cvt_pk_f32_fp8_(ub[k][0], false) * x0; s += cvt_pk_f32_fp8_(ub[k][0], true) * x1; s += cvt_pk_f32_fp8_(ub[k][1], false) * x2; s += cvt_pk_f32_fp8_(ub[k][1], true) * x3;
        s += cvt_pk_f32_fp8_(ub[k][2], false) * x4; s += cvt_pk_f32_fp8_(ub[k][2], true) * x5; s += cvt_pk_f32_fp8_(ub[k][3], false) * x6; s += cvt_pk_f32_fp8_(ub[k][3], true) * x7;
        R[k * 64 + lane] = s.x + s.y;
        if (REFILL) { GLOAD16_RW_S(ub[k], ubase, off[k & 7]); }
        if (TAG) TAG_B(); else TAG_A();
        SCHED_FENCE(); }
    WAVE_SYNC();
    const f32x4 a0 = *(const f32x4*)(R + 8 * lane), a1 = *(const f32x4*)(R + 8 * lane + 4), b0 = *(const f32x4*)(R + 512 + 8 * lane), b1 = *(const f32x4*)(R + 512 + 8 * lane + 4);
    float* pd = P.pd + ((size_t)x * T_ + t) * 128;
    pd[lane] = ((a0[0] + a0[1]) + (a0[2] + a0[3])) + ((a1[0] + a1[1]) + (a1[2] + a1[3]));
    pd[64 + lane] = ((b0[0] + b0[1]) + (b0[2] + b0[3])) + ((b1[0] + b1[1]) + (b1[2] + b1[3]));
}
#define PG_PIN16(v) do { _Pragma("unroll") for (int _k = 0; _k < 16; ++_k) PIN1(v[_k]); } while (0)
__device__ __forceinline__ void peer_dots_item(const Ptrs& P, int x, int blk, unsigned char* lds, int lane, int wave) {
    float* R = (float*)(lds + wave * PG_WLDS); int* E = (int*)(lds + wave * PG_WLDS + 4096);
    const int gq = lane >> 3, c8 = lane & 7, tb = blk * PG_TB + PG_TPW * wave;
    u32x4 uA[16], uB[16], xa0, xb0, xa1, xb1;
    const bf16_t* hbase = P.hb; const int* ebase = P.eid; const unsigned char* ubase = P.U8;
    const unsigned xo = (unsigned)((tb * 1024 + 128 * x + 16 * c8) * 2), eo = (unsigned)((tb * 128 + lane) * 4);
    int ea0, ea1, eb0, eb1;
    { const int* ep = P.eid + (size_t)tb * 128 + lane; ea0 = ep[0]; ea1 = ep[64]; eb0 = ep[128]; eb1 = ep[192]; }
    WAVE_SYNC(); E[lane] = ea0; E[64 + lane] = ea1; WAVE_SYNC();
#pragma unroll
    for (int k = 0; k < 16; ++k) { const unsigned off = ((unsigned)(x * NEXP) + (unsigned)E[gq + 8 * k]) * 128u + 16u * (unsigned)c8; GLOAD16_S(uA[k], ubase, off); }
    GLOAD16_S(xa0, hbase, xo); GLOAD16_S(xb0, hbase, xo + 16u); GLOAD4_S(ea0, ebase, eo + 2u * 512u); GLOAD4_S(ea1, ebase, eo + 2u * 512u + 256u);
    WAVE_SYNC(); E[lane] = eb0; E[64 + lane] = eb1; WAVE_SYNC();
#pragma unroll
    for (int k = 0; k < 16; ++k) { const unsigned off = ((unsigned)(x * NEXP) + (unsigned)E[gq + 8 * k]) * 128u + 16u * (unsigned)c8; GLOAD16_S(uB[k], ubase, off); }
    GLOAD16_S(xa1, hbase, xo + 2048u); GLOAD16_S(xb1, hbase, xo + 2048u + 16u); GLOAD4_S(eb0, ebase, eo + 3u * 512u); GLOAD4_S(eb1, ebase, eo + 3u * 512u + 256u);
#pragma unroll
    for (int i = 0; i < PG_TPW; i += 2) {
        if (i == 0) WAIT_VM(20); else WAIT_VM(22);
        PIN4(xa0, xb0, ea0, ea1);
        if (i + 2 < PG_TPW) { WAVE_SYNC(); E[lane] = ea0; E[64 + lane] = ea1; WAVE_SYNC();
            pg_dots_compute<true, 0>(P, x, tb + i, uA, xa0, xb0, R, E, c8, gq, lane);
            const unsigned nx = (unsigned)((i + 4 < PG_TPW) ? i + 4 : PG_TPW - 1), xo2 = xo + (unsigned)(i + 2) * 2048u;
            GLOAD16_S(xa0, hbase, xo2); GLOAD16_S(xb0, hbase, xo2 + 16u); GLOAD4_S(ea0, ebase, eo + nx * 512u); GLOAD4_S(ea1, ebase, eo + nx * 512u + 256u); }
        else pg_dots_compute<false, 0>(P, x, tb + i, uA, xa0, xb0, R, E, c8, gq, lane);
        if (i + 2 < PG_TPW) WAIT_VM(22); else WAIT_VM(0);
        PIN4(xa1, xb1, eb0, eb1);
        if (i + 3 < PG_TPW) { WAVE_SYNC(); E[lane] = eb0; E[64 + lane] = eb1; WAVE_SYNC();
            pg_dots_compute<true, 1>(P, x, tb + i + 1, uB, xa1, xb1, R, E, c8, gq, lane);
            const unsigned nx = (unsigned)((i + 5 < PG_TPW) ? i + 5 : PG_TPW - 1), xo2 = xo + (unsigned)(i + 3) * 2048u;
            GLOAD16_S(xa1, hbase, xo2); GLOAD16_S(xb1, hbase, xo2 + 16u); GLOAD4_S(eb0, ebase, eo + nx * 512u); GLOAD4_S(eb1, ebase, eo + nx * 512u + 256u); }
        else pg_dots_compute<false, 1>(P, x, tb + i + 1, uB, xa1, xb1, R, E, c8, gq, lane);
    }
}
template <bool REFILL, int TAG>
__device__ __forceinline__ void pg_acc_compute(const Ptrs& P, bf16_t* outp, int x, int t, u32x4 (&vb)[16], float w0, float w1, unsigned oprev, float* C, float* W, const int* E, int c8, int gq, int lane) {
    WAVE_SYNC(); W[lane] = w0; W[64 + lane] = w1; WAVE_SYNC();
    f32x2 acc[8];
#pragma unroll
    for (int q = 0; q < 8; ++q) acc[q] = (f32x2){0.f, 0.f};
    unsigned off[8]; const unsigned char* vbase = P.V8; float wk[16];
#pragma unroll
    for (int k = 0; k < 16; ++k) wk[k] = W[gq + 8 * k];
#pragma unroll
    for (int k = 0; k < 16; ++k) { PIN1(vb[k]);
        if (REFILL && (k & 7) == 0) {
#pragma unroll
            for (int j = 0; j < 8; ++j) off[j] = ((unsigned)(x * NEXP) + (unsigned)E[gq + 8 * (k + j)]) * 128u + 16u * (unsigned)c8; }
#pragma unroll
        for (int q = 0; q < 4; ++q) { acc[2 * q] += cvt_pk_f32_fp8_(vb[k][q], false) * wk[k]; acc[2 * q + 1] += cvt_pk_f32_fp8_(vb[k][q], true) * wk[k]; }
        if (REFILL) {
#pragma unroll
            for (int q = 0; q < 8; ++q) PIN1(acc[q]);
            GLOAD16_RW_S(vb[k], vbase, off[k & 7]); }
        if (TAG) TAG_B(); else TAG_A();
        SCHED_FENCE(); }
    WAVE_SYNC();
#pragma unroll
    for (int q = 0; q < 4; ++q) *(f32x4*)(C + lane * 16 + 4 * q) = (f32x4){acc[2 * q].x, acc[2 * q].y, acc[2 * q + 1].x, acc[2 * q + 1].y};
    WAVE_SYNC();
    f32x2 s = (f32x2){0.f, 0.f};
#pragma unroll
    for (int g = 0; g < 8; ++g) s += *(const f32x2*)(C + g * 128 + 2 * lane);
    *(unsigned*)(outp + (size_t)t * 1024 + 128 * x + 2 * lane) = pk2(bflo(oprev) + s.x, bfhi(oprev) + s.y);
}
__device__ __forceinline__ void peer_acc_item(bf16_t* outp, const Ptrs& P, int x, int blk, unsigned char* lds, int lane, int wave) {
    float* C = (float*)(lds + wave * PG_WLDS); int* E = (int*)(lds + wave * PG_WLDS + 4096); float* W = (float*)(lds + wave * PG_WLDS + 4608);
    const int gq = lane >> 3, c8 = lane & 7, tb = blk * PG_TB + PG_TPW * wave;
    u32x4 vA[16], vB[16]; unsigned oA, oB; float wa0, wa1, wb0, wb1; int ea0, ea1, eb0, eb1;
    const int* ebase = P.eid; const float* wbase = P.gate; const bf16_t* obase = outp; const unsigned char* vbase = P.V8;
    const unsigned eo = (unsigned)((tb * 128 + lane) * 4), oo = (unsigned)((tb * 1024 + 128 * x + 2 * lane) * 2);
    { const int* ep = P.eid + (size_t)tb * 128 + lane; ea0 = ep[0]; ea1 = ep[64]; eb0 = ep[128]; eb1 = ep[192]; }
    WAVE_SYNC(); E[lane] = ea0; E[64 + lane] = ea1; WAVE_SYNC();
#pragma unroll
    for (int k = 0; k < 16; ++k) { const unsigned off = ((unsigned)(x * NEXP) + (unsigned)E[gq + 8 * k]) * 128u + 16u * (unsigned)c8; GLOAD16_S(vA[k], vbase, off); }
    GLOAD4_S(wa0, wbase, eo); GLOAD4_S(wa1, wbase, eo + 256u); GLOAD4_S(oA, obase, oo); GLOAD4_S(ea0, ebase, eo + 2u * 512u); GLOAD4_S(ea1, ebase, eo + 2u * 512u + 256u);
    WAVE_SYNC(); E[lane] = eb0; E[64 + lane] = eb1; WAVE_SYNC();
#pragma unroll
    for (int k = 0; k < 16; ++k) { const unsigned off = ((unsigned)(x * NEXP) + (unsigned)E[gq + 8 * k]) * 128u + 16u * (unsigned)c8; GLOAD16_S(vB[k], vbase, off); }
    GLOAD4_S(wb0, wbase, eo + 512u); GLOAD4_S(wb1, wbase, eo + 512u + 256u); GLOAD4_S(oB, obase, oo + 2048u); GLOAD4_S(eb0, ebase, eo + 3u * 512u); GLOAD4_S(eb1, ebase, eo + 3u * 512u + 256u);
#pragma unroll
    for (int i = 0; i < PG_TPW; i += 2) {
        if (i == 0) WAIT_VM(21); else WAIT_VM(22);
        PIN4(wa0, wa1, ea0, ea1); PIN1(oA);
        if (i + 2 < PG_TPW) { WAVE_SYNC(); E[lane] = ea0; E[64 + lane] = ea1; WAVE_SYNC();
            pg_acc_compute<true, 0>(P, outp, x, tb + i, vA, wa0, wa1, oA, C, W, E, c8, gq, lane);
            const unsigned nx = (unsigned)((i + 4 < PG_TPW) ? i + 4 : PG_TPW - 1);
            GLOAD4_S(wa0, wbase, eo + (unsigned)(i + 2) * 512u); GLOAD4_S(wa1, wbase, eo + (unsigned)(i + 2) * 512u + 256u); GLOAD4_S(oA, obase, oo + (unsigned)(i + 2) * 2048u);
            GLOAD4_S(ea0, ebase, eo + nx * 512u); GLOAD4_S(ea1, ebase, eo + nx * 512u + 256u); }
        else pg_acc_compute<false, 0>(P, outp, x, tb + i, vA, wa0, wa1, oA, C, W, E, c8, gq, lane);
        if (i + 2 < PG_TPW) WAIT_VM(22); else WAIT_VM(0);
        PIN4(wb0, wb1, eb0, eb1); PIN1(oB);
        if (i + 3 < PG_TPW) { WAVE_SYNC(); E[lane] = eb0; E[64 + lane] = eb1; WAVE_SYNC();
            pg_acc_compute<true, 1>(P, outp, x, tb + i + 1, vB, wb0, wb1, oB, C, W, E, c8, gq, lane);
            const unsigned nx = (unsigned)((i + 5 < PG_TPW) ? i + 5 : PG_TPW - 1);
            GLOAD4_S(wb0, wbase, eo + (unsigned)(i + 3) * 512u); GLOAD4_S(wb1, wbase, eo + (unsigned)(i + 3) * 512u + 256u); GLOAD4_S(oB, obase, oo + (unsigned)(i + 3) * 2048u);
            GLOAD4_S(eb0, ebase, eo + nx * 512u); GLOAD4_S(eb1, ebase, eo + nx * 512u + 256u); }
        else pg_acc_compute<false, 1>(P, outp, x, tb + i + 1, vB, wb0, wb1, oB, C, W, E, c8, gq, lane);
    }
}
template <int STAGE, int CSET = STAGE>
__device__ __forceinline__ void phase_G12(const KP& p, int l, unsigned char* lds) {
    const Ptrs P = make_ptrs(p.ws, l);
    const int tid = TIDX(), lane = tid & 63, wave = tid >> 6;
    int* slot = (int*)(lds + 8 * PG_WLDS);
    const int myx = XCC_ID();
    for (int s = 0; s < 8; ++s) { const int x = (myx + s) & 7; unsigned* cnt = P.qcnt + (CSET * 8 + x) * 16;
        for (;;) { const int blk = peer_next_item(cnt, slot, tid); if (blk >= PG_NBLK) break;
            if (STAGE == 0) peer_dots_item(P, x, blk, lds, lane, wave); else peer_acc_item(CSET == 3 ? (bf16_t*)P.pd : P.ycat, P, x, blk, lds, lane, wave); } }
    __syncthreads();
}
__device__ __forceinline__ void phase_G1b(const KP& p, int l, unsigned char* lds) {
    const Ptrs P = make_ptrs(p.ws, l);
    const size_t stride = (size_t)GDIM() * NTHR, n = (size_t)T_ * 128;
    for (size_t i0 = (size_t)BIDX() * NTHR + TIDX(); i0 < n; i0 += 4 * stride) { float d[4], gt[4], su[4], sv[4]; int e[4];
#pragma unroll
        for (int q = 0; q < 4; ++q) { const size_t i = i0 + q * stride; e[q] = 0; gt[q] = 0.f; d[q] = 0.f; if (i < n) { e[q] = P.eid[i]; gt[q] = P.gate[i]; } }
#pragma unroll
        for (int q = 0; q < 4; ++q) { const size_t i = i0 + q * stride; su[q] = P.su[e[q]]; sv[q] = P.sv[e[q]];
            if (i < n) {
#pragma unroll
                for (int x = 0; x < 8; ++x) d[q] += P.pd[(size_t)x * T_ * 128 + i]; } }
#pragma unroll
        for (int q = 0; q < 4; ++q) { const size_t i = i0 + q * stride; if (i < n) P.gate[i] = gt[q] * sv[q] * gelu_erf(d[q] * su[q]); } }
#ifdef CPU_EMU
    (void)lds;
#endif
}
__device__ __forceinline__ void phase_G3(const KP& p, int l, unsigned char* lds, bool last) {
    const Ptrs P = make_ptrs(p.ws, l);
    const int tid = TIDX(), lane = tid & 63, wave = tid >> 6; const int gw = BIDX() * NWAVE + wave, NGW = GDIM() * NWAVE;
    for (int m = 4 * gw; m < T_; m += 4 * NGW) ln_rows<4, true>(P.ycat + (size_t)m * 1024, p.in[I_LN2G] + l * 1024, p.in[I_LN2B] + l * 1024, last ? p.out + (size_t)m * 1024 : (float*)nullptr, last ? (bf16_t*)nullptr : P.hb + (size_t)m * 1024,
                                                           last ? (unsigned char*)nullptr : (m < H8_SPLIT ? P.h8a + (size_t)m * 1024 : P.h8b + (size_t)(m - H8_SPLIT) * 1024), lane);
}
#ifndef PROBE_REPEAT
#define PROBE_REPEAT 0
#endif
constexpr int LDS_BYTES = 147456;
__device__ __forceinline__ void phase_B1(const KP& p, int l, unsigned char* lds) {
    const Ptrs P = make_ptrs(p.ws, l);
    constexpr int NRC = NB_ * 4 * RW_NCH, NS5 = NB_ * 16, NFX = NB_ * 4 * (S_ / 256), NCV = T_ / 64;
    const int G = GDIM(); int it = BIDX();
    for (; it < NRC; it += G) rw_chunk_unit(p, P, l, it, lds);
#if PROBE_REPEAT == 16
    for (int j = BIDX(); j < NRC; j += G) rw_chunk_unit(p, P, l, j, lds);
#endif
#if PROBE_REPEAT >= 161 && PROBE_REPEAT <= 163
    for (int j = BIDX(); j < NRC; j += G) { rw_chunk_unit<PROBE_REPEAT - 160>(p, P, l, j, lds); __syncthreads(); }
#endif
    for (; it < NRC + NFX; it += G) fox_unit(p, P, l, it - NRC, lds);
#if PROBE_REPEAT == 17
    for (int j = BIDX(); j < NFX; j += G) fox_unit(p, P, l, j, lds);
#endif
    for (; it < NRC + NFX + NS5; it += G) s5_unit(p, P, l, it - NRC - NFX, lds);
#if PROBE_REPEAT == 18
    for (int j = BIDX(); j < NS5; j += G) s5_unit(p, P, l, j, lds);
#endif
    for (; it < NRC + NFX + NS5 + NCV; it += G) conv_unit(p, P, l, it - NRC - NFX - NS5, lds);
#if PROBE_REPEAT == 19
    for (int j = BIDX(); j < NCV; j += G) conv_unit(p, P, l, j, lds);
#endif
}
__device__ __forceinline__ void phase_B3(const KP& p, int l, unsigned char* lds) {
    const Ptrs P = make_ptrs(p.ws, l);
#if PROBE_REPEAT == 34
    for (int it = BIDX(); it < NB_ * 4 * RW_NCH; it += GDIM()) rw_out_unit<true>(p, P, l, it, lds);
#endif
    for (int it = BIDX(); it < NB_ * 4 * RW_NCH; it += GDIM()) rw_out_unit<false>(p, P, l, it, lds);
}
enum { PH_PRO = 0, PH_A, PH_B1, PH_B2, PH_B3, PH_C, PH_D, PH_D2, PH_E, PH_F, PH_G, PH_G1B, PH_G2, PH_G3, PH_N, PH_A0 };
__device__ __forceinline__ void run_phase(const KP& p, int ph, int l, unsigned char* lds) {
    switch (ph) {
        case PH_PRO: phase_prologue(p, lds); break;
        case PH_A: phase_A(p, l, lds); break;
        case PH_A0: phase_A0(p, lds); break;
        case PH_B1: phase_B1(p, l, lds); break;
        case PH_B2: phase_B2(p, l, lds); break;
        case PH_B3: phase_B3(p, l, lds); break;
        case PH_C: phase_C(p, l, lds); break;
        case PH_D: phase_D(p, l, lds); break;
        case PH_D2: phase_D2(p, l, lds); break;
        case PH_E: phase_E(p, l, lds); break;
        case PH_F: phase_F(p, l, lds); break;
        case PH_G: phase_G12<0>(p, l, lds); break;
        case PH_G1B: phase_G1b(p, l, lds); break;
        case PH_G2: phase_G12<1>(p, l, lds); break;
        case PH_G3: phase_G3(p, l, lds, l == L_ - 1); break;
        default: break;
    }
}
#ifndef CPU_EMU
#define XB_TMO      128
#define XB_XCNT(j)  (256  + 64 * (j))
#define XB_XSUB(j)  (1280 + 64 * (j))
#define XB_XGEN(j)  (2304 + 64 * (j))
#define XB_TOP      3328
#define XB_TOPGEN   3392
#define XCD_BAR_WORDS 3456
#define XB_SPIN_CAP (1u << 22)
__device__ __forceinline__ unsigned xb_ld(unsigned* p)              { return __hip_atomic_load(p, __ATOMIC_RELAXED, __HIP_MEMORY_SCOPE_AGENT); }
__device__ __forceinline__ unsigned xb_add(unsigned* p, unsigned v) { return __hip_atomic_fetch_add(p, v, __ATOMIC_RELAXED, __HIP_MEMORY_SCOPE_AGENT); }
__device__ __forceinline__ unsigned xb_xcc_id() { return (unsigned)__builtin_amdgcn_s_getreg((3 << 11) | 20) & 0xFu; }
#define XB_SPIN(cond, bar) do { unsigned _sp = 0; while (cond) { __builtin_amdgcn_s_sleep(1); \
    if ((++_sp & 255u) == 0u) { if (xb_ld(&(bar)[XB_TMO])) break; if (_sp > XB_SPIN_CAP) { atomicAdd(&(bar)[XB_TMO], 1u); break; } } } } while (0)
struct XcdBarrier { unsigned* bar; unsigned x; volatile LAS unsigned* st; };
__device__ __forceinline__ XcdBarrier xcd_barrier_post(unsigned* bar, volatile LAS unsigned* st) {
    XcdBarrier b; b.bar = bar; b.x = xb_xcc_id(); b.st = st;
    if (threadIdx.x == 0) (void)xb_add(&bar[XB_XCNT(b.x)], 1u);
    return b;
}
__device__ __forceinline__ void xcd_barrier_complete(unsigned* bar, unsigned x, unsigned& nloc, unsigned& nx) {
    const unsigned G = gridDim.x * gridDim.y * gridDim.z;
    unsigned sum, cnt, mine, sp = 0u;
    for (;;) {
        sum = 0u; cnt = 0u; mine = 0u;
#pragma unroll
        for (unsigned j = 0; j < 16; ++j) { const unsigned c = xb_ld(&bar[XB_XCNT(j)]); sum += c; cnt += (c > 0u) ? 1u : 0u; mine = (j == x) ? c : mine; }
        if (sum == G) break;
        __builtin_amdgcn_s_sleep(1);
        if ((++sp & 255u) == 0u) { if (xb_ld(&bar[XB_TMO])) break; if (sp > XB_SPIN_CAP) { atomicAdd(&bar[XB_TMO], 1u); break; } }
    }
    nloc = mine > 0u ? mine : 1u; nx = cnt > 0u ? cnt : 1u;
}
__device__ __forceinline__ void xcd_barrier(const XcdBarrier& b) {
    asm volatile("s_waitcnt vmcnt(0)" ::: "memory");
    __syncthreads();
    if (threadIdx.x == 0) {
        unsigned* bar = b.bar;
        __builtin_amdgcn_s_waitcnt(0);
        unsigned nloc = b.st[0], nx = b.st[1];
        if (nloc == 0u) { xcd_barrier_complete(bar, b.x, nloc, nx); b.st[0] = nloc; b.st[1] = nx; }
        const unsigned old = xb_add(&bar[XB_XSUB(b.x)], 1u);
        const unsigned gen = old / nloc;
        if (old + 1u == (gen + 1u) * nloc) {
            __builtin_amdgcn_fence(__ATOMIC_RELEASE, "agent");
            asm volatile("s_waitcnt vmcnt(0)" ::: "memory");
            const unsigned og = xb_add(&bar[XB_TOP], 1u);
            const unsigned tg = og / nx;
            if (og + 1u == (tg + 1u) * nx) xb_add(&bar[XB_TOPGEN], 1u);
            else XB_SPIN(xb_ld(&bar[XB_TOPGEN]) == tg, bar);
            __builtin_amdgcn_fence(__ATOMIC_ACQUIRE, "agent");
            xb_add(&bar[XB_XGEN(b.x)], 1u);
            asm volatile("s_waitcnt vmcnt(0)" ::: "memory");
        } else {
            XB_SPIN(xb_ld(&bar[XB_XGEN(b.x)]) == gen, bar);
            __builtin_amdgcn_fence(__ATOMIC_ACQUIRE, "agent");
            asm volatile("s_waitcnt vmcnt(0)" ::: "memory");
        }
    }
    __syncthreads();
}
#ifndef PROBE_REPEAT
#define PROBE_REPEAT 0
#endif
#ifndef N_LAUNCH_MODE
#define N_LAUNCH_MODE 1
#endif
extern __shared__ __attribute__((aligned(16))) unsigned char lds_dyn[];
#if N_LAUNCH_MODE == 0
template <int PH> __global__ void __launch_bounds__(NTHR, 2) k_phase_t(KP p) { run_phase(p, PH, p.layer, lds_dyn); }
typedef void (*kfn_t)(KP);
static kfn_t phase_fn(int ph) { switch (ph) { case PH_PRO: return k_phase_t<PH_PRO>; case PH_A: return k_phase_t<PH_A>; case PH_B1: return k_phase_t<PH_B1>; case PH_B2: return k_phase_t<PH_B2>; case PH_B3: return k_phase_t<PH_B3>; case PH_C: return k_phase_t<PH_C>;
    case PH_D: return k_phase_t<PH_D>; case PH_D2: return k_phase_t<PH_D2>; case PH_E: return k_phase_t<PH_E>; case PH_F: return k_phase_t<PH_F>; case PH_G: return k_phase_t<PH_G>; case PH_G1B: return k_phase_t<PH_G1B>; case PH_G2: return k_phase_t<PH_G2>; default: return k_phase_t<PH_G3>; } }
#else
#ifndef USE_XCD_BARRIER
#define USE_XCD_BARRIER 1
#endif
constexpr int BAR_LDS_OFF = LDS_BYTES - 64;
#if USE_XCD_BARRIER
#define GSYNC() xcd_barrier(bar)
#define GSYNC_ARG const XcdBarrier& bar
#else
#define GSYNC() grid.sync()
#define GSYNC_ARG cg::grid_group& grid
#endif
template <int l>
__device__ __forceinline__ void mega_layer(const KP& p, GSYNC_ARG) {
#if PROBE_REPEAT == 47 || PROBE_REPEAT == 48
        phase_Aprobe<PROBE_REPEAT - 40>(p, l, lds_dyn); GSYNC();
#endif
        phase_A(p, l, lds_dyn);
#if PROBE_REPEAT == 1
        GSYNC(); phase_A(p, l, lds_dyn);
#endif
#if PROBE_REPEAT >= 40 && PROBE_REPEAT <= 46
        GSYNC(); phase_Aprobe<PROBE_REPEAT - 40>(p, l, lds_dyn);
#endif
        GSYNC(); phase_B1(p, l, lds_dyn);
#if PROBE_REPEAT == 2
        GSYNC(); phase_B1(p, l, lds_dyn);
#endif
        GSYNC(); phase_B2(p, l, lds_dyn);
        GSYNC(); phase_B3(p, l, lds_dyn);
        GSYNC(); phase_C(p, l, lds_dyn);
#if PROBE_REPEAT == 4
        GSYNC(); phase_C(p, l, lds_dyn);
#endif
        GSYNC(); phase_D(p, l, lds_dyn);
        GSYNC(); phase_D2(p, l, lds_dyn);
        GSYNC(); phase_E(p, l, lds_dyn);
        GSYNC(); phase_F(p, l, lds_dyn);
#if PROBE_REPEAT == 8
        GSYNC(); phase_F(p, l, lds_dyn);
#endif
        GSYNC(); phase_G12<0>(p, l, lds_dyn);
#if PROBE_REPEAT == 32
        GSYNC(); phase_G12<0, 2>(p, l, lds_dyn);
#endif
        GSYNC(); phase_G1b(p, l, lds_dyn);
        GSYNC(); phase_G12<1>(p, l, lds_dyn);
#if PROBE_REPEAT == 33
        GSYNC(); phase_G12<1, 3>(p, l, lds_dyn);
#endif
        GSYNC(); phase_G3(p, l, lds_dyn, l == L_ - 1);
}
__global__ void __launch_bounds__(NTHR, 2) k_mega(KP p) {
    cg::grid_group grid = cg::this_grid();
#if USE_XCD_BARRIER
    volatile LAS unsigned* st = (volatile LAS unsigned*)(lds_dyn + BAR_LDS_OFF);
    if (threadIdx.x < 2) st[threadIdx.x] = 0u;
    __syncthreads();
    const XcdBarrier bar = xcd_barrier_post((unsigned*)(p.ws + WS_CTL) + 4096, st);
#define GSYNC_VAL bar
#else
#define GSYNC_VAL grid
#endif
    phase_prologue(p, lds_dyn);
#if PROBE_REPEAT == 60
    GSYNC(); phase_prologue(p, lds_dyn);
#endif
    grid.sync();
    phase_A0(p, lds_dyn);
    GSYNC();
    mega_layer<0>(p, GSYNC_VAL);
    static_assert(L_ == 2, "two layers");
    GSYNC();
    mega_layer<1>(p, GSYNC_VAL);
}
#endif
extern "C" void kernel_launch(void* const* d_in, const int* in_sizes, int n_in, void* d_out, int out_size, void* d_ws, size_t ws_size, hipStream_t stream) {
    static int grid = 0;
    if (grid == 0) {
        if (n_in != N_IN || out_size != T_ * 1024 || ws_size < WS_END) { fprintf(stderr, "kernel_launch: unexpected shapes (n_in %d out %d ws %zu need %zu)\n", n_in, out_size, ws_size, (size_t)WS_END); grid = -1; return; }
        int dev = 0, cus = 0, per_cu = 0;
        (void)hipGetDevice(&dev); (void)hipDeviceGetAttribute(&cus, hipDeviceAttributeMultiprocessorCount, dev);
#if N_LAUNCH_MODE == 0
        for (int ph = 0; ph < PH_N; ++ph) (void)hipFuncSetAttribute((const void*)phase_fn(ph), hipFuncAttributeMaxDynamicSharedMemorySize, LDS_BYTES);
        (void)per_cu;
#else
        (void)hipFuncSetAttribute((const void*)k_mega, hipFuncAttributeMaxDynamicSharedMemorySize, LDS_BYTES);
        (void)hipOccupancyMaxActiveBlocksPerMultiprocessor(&per_cu, (const void*)k_mega, NTHR, LDS_BYTES);
        if (per_cu < 1) { fprintf(stderr, "kernel_launch: occupancy query says %d blocks per CU\n", per_cu); grid = -1; return; }
#endif
        grid = cus;
    }
    if (grid < 0) return;
    if (hipMemsetAsync((char*)d_ws + WS_CTL, 0, 65536, stream) != hipSuccess) { fprintf(stderr, "kernel_launch: memset failed\n"); return; }
    KP p{};
    for (int i = 0; i < N_IN; ++i) p.in[i] = (const float*)d_in[i];
    p.out = (float*)d_out; p.ws = (unsigned char*)d_ws;
#if N_LAUNCH_MODE == 1
    void* args[] = {&p};
    hipError_t e = hipLaunchCooperativeKernel((const void*)k_mega, dim3(grid), dim3(NTHR), args, LDS_BYTES, stream);
    if (e != hipSuccess) fprintf(stderr, "cooperative launch failed: %s (grid %d)\n", hipGetErrorString(e), grid);
#else
    p.phase = PH_PRO; p.layer = 0; hipLaunchKernelGGL(phase_fn(PH_PRO), dim3(grid), dim3(NTHR), LDS_BYTES, stream, p);
    for (int l = 0; l < L_; ++l) for (int ph = PH_A; ph < PH_N; ++ph) { p.phase = ph; p.layer = l; hipLaunchKernelGGL(phase_fn(ph), dim3(grid), dim3(NTHR), LDS_BYTES, stream, p); }
#endif
}
#endif
```

```cpp
#ifdef CPU_EMU
#include "emu.h"
#define LAS
#define GET_LDS() ((unsigned char*)emu::lds())
#define AS_GLOBAL(p) (p)
#define AS_LDS(p) (p)
#define RFL(x) (x)
#define MFMA32(a, b, c) emu_mfma32(a, b, c)
#define MFMA16(a, b, c) emu_mfma16(a, b, c)
#define MFMA16_FP8(a, b, c) emu_mfma16_fp8(a, b, c)
#define FAST_EXP2(x) exp2f(x)
#define FAST_RCP(x) (1.0f / (x))
#define FAST_LOG2(x) log2f(x)
#define FAST_RSQ(x) (1.0f / sqrtf(x))
#define WAVE_SYNC() do { uint32_t _z = 0; (void)emu::wave_xchg(&_z, 1); } while (0)
#define OPAQUE(x) do {} while (0)
#define GLDS16(gp, lp, lane) memcpy((char*)(lp) + 16 * (lane), (const void*)(gp), 16)
#define WAIT_VM(n) do {} while (0)
#define GLOAD16_ASM(dst, ptr) (dst) = *(const u32x4*)(ptr)
#define GLOAD16_RW(dst, ptr) (dst) = *(const u32x4*)(ptr)
#define PIN1(a) do {} while (0)
#define GLOAD16_RW_S(dst, base, off) (dst) = *(const u32x4*)((const unsigned char*)(base) + (off))
#define SCHED_FENCE() do {} while (0)
#define TAG_A() do {} while (0)
#define TAG_B() do {} while (0)
#define GLOAD16_S(dst, base, off) (dst) = *(const u32x4*)((const unsigned char*)(base) + (off))
#define GLOAD4_S(dst, base, off) memcpy(&(dst), (const unsigned char*)(base) + (off), 4)
#define GLOAD4_ASM(dst, ptr) (dst) = *(const int*)(ptr)
#define PIN4(a, b, c, d) do {} while (0)
#define PIN2I(a, b) do {} while (0)
#define WAIT_LGKM0() do {} while (0)
#define READLANE_I(v, l) __shfl((int)(v), (l))
#define READLANE_F(v, l) __shfl((float)(v), (l))
#define TIDX() ((int)threadIdx.x)
#define XCC_ID() (emu::bid() & 7)
#define GDIM() ((int)gridDim.x)
#define BIDX() ((int)blockIdx.x)
#define OPAQUE_S(x) do {} while (0)
#define MEMFENCE() do {} while (0)
#else
#include <hip/hip_runtime.h>
#include <hip/hip_cooperative_groups.h>
#include <cstdio>
#include <cstdint>
namespace cg = cooperative_groups;
#define LAS __attribute__((address_space(3)))
#define GAS __attribute__((address_space(1)))
#define AS_GLOBAL(p) ((unsigned char*)(GAS unsigned char*)(p))
#define AS_LDS(p) ((unsigned char*)(LAS unsigned char*)(p))
#define RFL(x) __builtin_amdgcn_readfirstlane(x)
#define MFMA32(a, b, c) __builtin_amdgcn_mfma_f32_32x32x16_bf16(a, b, c, 0, 0, 0)
#define MFMA16(a, b, c) __builtin_amdgcn_mfma_f32_16x16x32_bf16(a, b, c, 0, 0, 0)
#define MFMA16_FP8(a, b, c) __builtin_amdgcn_mfma_f32_16x16x32_fp8_fp8((long)(a), (long)(b), c, 0, 0, 0)
#define MFMA16_F8X128(a, b, c) __builtin_amdgcn_mfma_scale_f32_16x16x128_f8f6f4(a, b, c, 0, 0, 0, 0, 0, 0)
#define FAST_EXP2(x) __builtin_amdgcn_exp2f(x)
#define FAST_RCP(x) __builtin_amdgcn_rcpf(x)
#define FAST_LOG2(x) __builtin_amdgcn_logf(x)
#define FAST_RSQ(x) __builtin_amdgcn_rsqf(x)
#define WAVE_SYNC() __builtin_amdgcn_wave_barrier()
#define OPAQUE(x) asm volatile("" : "+v"(x))
#define GLDS16(gp, lp, lane) __builtin_amdgcn_global_load_lds((const unsigned*)(gp), (LAS unsigned*)(lp), 16, 0, 0)
#define WAIT_VM(n) asm volatile("s_waitcnt vmcnt(" #n ")" ::: "memory")
#define GLOAD16_ASM(dst, ptr) asm volatile("global_load_dwordx4 %0, %1, off" : "=v"(dst) : "v"(ptr) : "memory")
#define GLOAD4_ASM(dst, ptr) asm volatile("global_load_dword %0, %1, off" : "=v"(dst) : "v"(ptr) : "memory")
#define GLOAD16_RW(dst, ptr) asm volatile("global_load_dwordx4 %0, %1, off" : "+v"(dst) : "v"(ptr) : "memory")
#define PIN1(a) asm volatile("" : "+v"(a) :: "memory")
#define GLOAD16_RW_S(dst, base, off) asm volatile("global_load_dwordx4 %0, %1, %2" : "+v"(dst) : "v"(off), "s"(base) : "memory")
#define SCHED_FENCE() __builtin_amdgcn_sched_barrier(0)
#define TAG_A() asm volatile("; buffer A" ::: "memory")
#define TAG_B() asm volatile("; buffer B" ::: "memory")
#define GLOAD16_S(dst, base, off) asm volatile("global_load_dwordx4 %0, %1, %2" : "=v"(dst) : "v"(off), "s"(base) : "memory")
#define GLOAD4_S(dst, base, off) asm volatile("global_load_dword %0, %1, %2" : "=v"(dst) : "v"(off), "s"(base) : "memory")
#define PIN4(a, b, c, d) asm volatile("" : "+v"(a), "+v"(b), "+v"(c), "+v"(d) :: "memory")
#define PIN2I(a, b) asm volatile("" : "+v"(a), "+v"(b) :: "memory")
#define WAIT_LGKM0() asm volatile("s_waitcnt lgkmcnt(0)" ::: "memory")
#define READLANE_I(v, l) __builtin_amdgcn_readlane((int)(v), (l))
#define READLANE_F(v, l) __builtin_bit_cast(float, __builtin_amdgcn_readlane(__builtin_bit_cast(int, (float)(v)), (l)))
#define OPAQUE_S(x) asm volatile("" : "+s"(x))
__device__ __forceinline__ int opaque_tid_() { int t = threadIdx.x; asm volatile("" : "+v"(t)); return t; }
#define TIDX() opaque_tid_()
#define XCC_ID() ((int)(__builtin_amdgcn_s_getreg((3 << 11) | 20) & 7u))
__device__ __forceinline__ int opaque_gdim_() { int t = gridDim.x; asm volatile("" : "+s"(t)); return t; }
__device__ __forceinline__ int opaque_bidx_() { int t = blockIdx.x; asm volatile("" : "+s"(t)); return t; }
#define GDIM() opaque_gdim_()
#define BIDX() opaque_bidx_()
#define MEMFENCE() do { asm volatile("" ::: "memory"); __builtin_amdgcn_sched_barrier(0); } while (0)
#endif

#ifndef CFG_B
#define CFG_B 16
#endif
#ifndef CFG_S
#define CFG_S 2048
#endif

typedef unsigned short bf16_t;
typedef short bf16x8 __attribute__((ext_vector_type(8)));
typedef short s16x4 __attribute__((ext_vector_type(4)));
typedef float f32x4 __attribute__((ext_vector_type(4)));
typedef float f32x2 __attribute__((ext_vector_type(2)));
typedef float f32x16 __attribute__((ext_vector_type(16)));
typedef unsigned u32x4 __attribute__((ext_vector_type(4)));
typedef unsigned u32x2 __attribute__((ext_vector_type(2)));
typedef int i32x4 __attribute__((ext_vector_type(4)));
typedef int i32x8 __attribute__((ext_vector_type(8)));

constexpr int NB_ = CFG_B, S_ = CFG_S, T_ = NB_ * S_, D_ = 1024, L_ = 2;
constexpr int NTHR = 512, NWAVE = 8;
constexpr int PJ = 2304;
constexpr int C_R = 0, C_K = 256, C_V = 512, C_HW = 768, C_HA = 800, C_HG = 832, C_S5 = 896, C_FQ = 1152, C_FK = 1408, C_FL = 1664, C_CV = 1792, C_CG = 2048;
constexpr int WIN_ROWS = 6656, WIN_VT = 2304, WIN_GATE = 2560;
constexpr int IN_COLS = 6532;
constexpr float LN_EPS_ = 1e-5f, GN_EPS_ = 64e-5f;
constexpr float DN_ALPHA_ = 1.4142135623730951f;
constexpr int NEXP = 16384;

enum { I_X = 0, I_P, I_LNIN_G, I_LNIN_B, I_WIN, I_MU, I_W0, I_W2, I_A0, I_A2, I_G2, I_KK, I_KA, I_RK, I_LNXG, I_LNXB, I_LRE, I_LIM, I_BRE, I_BIM, I_CRE, I_CIM,
       I_S5D, I_LDT, I_GLUW, I_GLUB, I_BF, I_CONVW, I_CONVB, I_CLNG, I_CLNB, I_WBR, I_WOUT, I_LN1G, I_LN1B, I_WQ, I_K1, I_K2, I_U, I_V, I_PLEW, I_PLEG, I_LN2G, I_LN2B, N_IN };

constexpr size_t al256(size_t x) { return (x + 255) & ~(size_t)255; }
constexpr size_t WS_CTL = 0;
constexpr size_t WS_WIN = 1u << 20;
constexpr size_t WS_WBR = WS_WIN + al256((size_t)L_ * WIN_ROWS * 1024 * 2);
constexpr size_t WS_WOUT = WS_WBR + (size_t)L_ * 1024 * 1024 * 2;
constexpr size_t WS_WQ = WS_WOUT + (size_t)L_ * 1024 * 1024 * 2;
constexpr size_t WS_PLE = WS_WQ + (size_t)L_ * 2048 * 1024 * 2;
constexpr size_t WS_PLEG = WS_PLE + (size_t)L_ * 1024 * 256 * 2;
constexpr size_t WS_GLU = WS_PLEG + (size_t)L_ * 1024 * 1024 * 2;
constexpr size_t WS_K12 = WS_GLU + (size_t)L_ * 256 * 256 * 2;
constexpr size_t WS_S5KC = WS_K12 + (size_t)L_ * 2 * 128 * 128 * 2;
constexpr size_t WS_S5WX = WS_S5KC + (size_t)L_ * 16 * 64 * 256 * 2;
constexpr size_t WS_S5WY = WS_S5WX + (size_t)L_ * 16 * 128 * 1024 * 2;
constexpr size_t WS_S5LL = WS_S5WY + (size_t)L_ * 16 * 1024 * 128 * 2;
constexpr size_t WS_UT = WS_S5LL + al256((size_t)L_ * 16 * 64 * 2 * 4);
constexpr size_t WS_VT = WS_UT + (size_t)NEXP * 1024 * 2;
constexpr size_t WS_RW = WS_VT + (size_t)NEXP * 1024 * 2;
constexpr size_t RW_SZ = (size_t)T_ * 512;
static_assert(2 * RW_SZ <= (size_t)NEXP * 1024 * 2, "RWKV gate / bonus arrays fit the second table region");
constexpr size_t WS_HB = WS_RW + 4 * RW_SZ;
constexpr size_t WS_R1 = WS_HB + (size_t)T_ * 1024 * 2;
constexpr size_t R1_BYTES = (size_t)T_ * 2560 * 2;
constexpr size_t WS_YC = WS_R1 + R1_BYTES;
constexpr size_t WS_VTR = WS_YC + (size_t)T_ * 1024 * 2;
constexpr size_t WS_PB = WS_VTR + (size_t)256 * T_ * 2;
constexpr size_t WS_H8T = WS_PB + (size_t)T_ * 256 * 2;
constexpr int H8_SPLIT = (T_ / 512) * 256;
constexpr size_t WS_END = WS_H8T + (size_t)(T_ - H8_SPLIT) * 1024;
constexpr size_t R1_PROJ = 0;
constexpr size_t R1_H8 = (size_t)T_ * 2304 * 2;
constexpr size_t R1_MERGED = 0;
constexpr size_t R1_STASH = (size_t)T_ * 1024 * 2;
constexpr size_t R1_Q = 0;
constexpr size_t R1_EID = (size_t)T_ * 2048 * 2;
constexpr size_t R1_GATE = R1_EID + (size_t)T_ * 128 * 4;
static_assert(R1_GATE + (size_t)T_ * 128 * 4 <= R1_BYTES, "R1 map");

struct KP { const float* in[N_IN]; float* out; unsigned char* ws; float* dbg; int layer; int phase; };

#ifdef CPU_EMU
__device__ __forceinline__ unsigned f2bf(float f) { unsigned u = __builtin_bit_cast(unsigned, f); return (u + 0x7fffu + ((u >> 16) & 1u)) >> 16; }
__device__ __forceinline__ unsigned pk2(float lo, float hi) { return f2bf(lo) | (f2bf(hi) << 16); }
#else
typedef __bf16 bf16x2_hw __attribute__((ext_vector_type(2)));
__device__ __forceinline__ unsigned pk2(float lo, float hi) { const f32x2 v = {lo, hi}; return __builtin_bit_cast(unsigned, __builtin_convertvector(v, bf16x2_hw)); }
__device__ __forceinline__ unsigned f2bf(float f) { return pk2(f, 0.f) & 0xffffu; }
#endif
__device__ __forceinline__ float bf2f(unsigned h) { return __builtin_bit_cast(float, h << 16); }
__device__ __forceinline__ float bflo(unsigned w) { return __builtin_bit_cast(float, w << 16); }
__device__ __forceinline__ float bfhi(unsigned w) { return __builtin_bit_cast(float, w & 0xffff0000u); }
__device__ __forceinline__ float sigmoidf_(float x) { return FAST_RCP(1.0f + FAST_EXP2(x * -1.4426950408889634f)); }
__device__ __forceinline__ float gelu_erf(float v) {
    const float t = FAST_RCP(fabsf(v) * 0.2316418882f + 1.0f);
    float q = t * 0.5307027145f + (-0.7265760135f); q = q * t + 0.7107068705f; q = q * t + (-0.142248368f); q = q * t + 0.127414796f; q = q * t;
    const float m = v * (q * FAST_EXP2((v * v) * (-0.72134752044f)));
    return v < 0.f ? m : v - m; }
#ifdef CPU_EMU
inline float fp8_dec_(unsigned b) { const unsigned s = b >> 7, e = (b >> 3) & 15, m = b & 7; float v = (e == 0) ? ldexpf((float)m, -9) : ldexpf(1.f + m * 0.125f, (int)e - 7); return s ? -v : v; }
inline unsigned fp8_enc_(float x) { const unsigned s = x < 0.f ? 0x80u : 0u; float a = fabsf(x); if (!(a > 0.f)) return s; if (a > 448.f) a = 448.f;
    int e; (void)frexpf(a, &e); e -= 1; if (e < -6) e = -6;
    const float q = ldexpf(a, 3 - e); float r = nearbyintf(q);
    unsigned ee, mm; if (e == -6 && r < 8.f) { ee = 0; mm = (unsigned)r; } else { if (r >= 16.f) { r = 8.f; e += 1; } ee = (unsigned)(e + 7); mm = (unsigned)r - 8u; }
    if (ee > 15u || (ee == 15u && mm > 6u)) { ee = 15u; mm = 6u; }
    return s | (ee << 3) | mm; }
inline f32x2 cvt_pk_f32_fp8_(unsigned w, bool hi) { const unsigned h = hi ? (w >> 16) : w; return (f32x2){fp8_dec_(h & 255u), fp8_dec_((h >> 8) & 255u)}; }
inline unsigned cvt_pk_fp8_f32_(float a, float b, unsigned old, bool hi) { const unsigned p = fp8_enc_(a) | (fp8_enc_(b) << 8); return hi ? ((old & 0xffffu) | (p << 16)) : ((old & 0xffff0000u) | p); }
#else
__device__ __forceinline__ f32x2 cvt_pk_f32_fp8_(unsigned w, bool hi) { return hi ? __builtin_amdgcn_cvt_pk_f32_fp8((int)w, true) : __builtin_amdgcn_cvt_pk_f32_fp8((int)w, false); }
__device__ __forceinline__ unsigned cvt_pk_fp8_f32_(float a, float b, unsigned old, bool hi) { return hi ? (unsigned)__builtin_amdgcn_cvt_pk_fp8_f32(a, b, (int)old, true) : (unsigned)__builtin_amdgcn_cvt_pk_fp8_f32(a, b, (int)old, false); }
#endif
__device__ __forceinline__ float wave_max(float v) {
#pragma unroll
  for (int o = 1; o < 64; o <<= 1) v = fmaxf(v, __shfl_xor(v, o));
  return v;
}
template <int N> __device__ __forceinline__ void wave_sum_n(float (&v)[N]) {
#pragma unroll
  for (int o = 1; o < 64; o <<= 1) { float t[N];
#pragma unroll
    for (int i = 0; i < N; ++i) t[i] = __shfl_xor(v[i], o);
#pragma unroll
    for (int i = 0; i < N; ++i) v[i] += t[i]; }
}
__device__ __forceinline__ float wave_sum(float v) {
#pragma unroll
  for (int o = 1; o < 64; o <<= 1) v += __shfl_xor(v, o);
  return v;
}
namespace pg8 {
constexpr int BM = 256, BK = 64, HALF = 128, HTB = HALF * BK * 2, STAGE_BYTES = 8 * HTB;
__host__ __device__ __forceinline__ int lds_byte(int r, int c) { const int st = (r >> 4) * 2 + (c >> 5), rr = r & 15, cc = c & 31, ob = rr * 64 + cc * 2; return st * 1024 + (ob ^ (((ob >> 9) & 1) << 5)); }
__host__ __device__ __forceinline__ void stage_rc(int b, int& R, int& C) { const int st = b / 1024, sb = b % 1024, swz = sb ^ (((sb >> 9) & 1) << 5); R = (st >> 1) * 16 + swz / 64; C = (st & 1) * 32 + (swz % 64) / 2; }
__host__ __device__ __forceinline__ int perm32(int rho) { const int n = rho >> 4, i = rho & 15; return 8 * (i >> 2) + 4 * n + (i & 3); }

struct Unit { const char* a; const char* b; int nt; int kind; int pm; int pn; int aux; int f8; };

#ifndef CPU_EMU
template <int MODE = 0, class Epi, class Sched>
__device__ __forceinline__ void gemm_phase(LAS unsigned char* lds, const int lda, const int ldb, const Sched& S, const Epi& E, const int lda8 = 0) {
    const int tid = TIDX(), wid = __builtin_amdgcn_readfirstlane(tid >> 6), lane = tid & 63, wr = wid >> 2, wc = wid & 3, fr = lane & 15, fq = lane >> 4;
    unsigned voffA[2], voffB[2], voffA8[2];
#pragma unroll
    for (int i = 0; i < 2; ++i) { int R, C; stage_rc(tid * 16 + i * 8192, R, C); const int Rb = (R & ~31) + perm32(R & 31);
        voffA[i] = (unsigned)(R * lda + C) * 2u; voffB[i] = (unsigned)(Rb * ldb + C) * 2u; voffA8[i] = (unsigned)(R * lda8 + C * 2); }
    const size_t kstep = (size_t)(BK * 2);
    const size_t hstepA = (size_t)HALF * lda * 2, hstepB = (size_t)HALF * ldb * 2, hstepA8 = (size_t)HALF * lda8;
    const unsigned ldsw = (unsigned)wid * 1024u;
    const int aoff = lds_byte(wr * 64 + fr, fq * 8), boff = lds_byte(wc * 32 + fr, fq * 8);
#define PG8_SA(b, h) (((b) * 2 + (h)) * HTB)
#define PG8_SB(b, h) ((4 + (b) * 2 + (h)) * HTB)
#define PG8_STAGE(bufoff, gbase, voff) do { _Pragma("unroll") for (int _i = 0; _i < 2; ++_i) \
        __builtin_amdgcn_global_load_lds((const unsigned*)((const char*)(gbase) + (voff)[_i]), (LAS unsigned*)(lds + (bufoff) + ldsw + _i * 8192), 16, 0, 0); } while (0)
#define PG8_LDA(dst, b, h) do { _Pragma("unroll") for (int m = 0; m < 4; ++m) _Pragma("unroll") for (int k = 0; k < 2; ++k) dst[m][k] = *(const LAS bf16x8*)(lds + PG8_SA(b, h) + aoff + m * 2048 + k * 1024); } while (0)
#define PG8_LDB(dst, b, h) do { _Pragma("unroll") for (int n = 0; n < 2; ++n) _Pragma("unroll") for (int k = 0; k < 2; ++k) dst[n][k] = *(const LAS bf16x8*)(lds + PG8_SB(b, h) + boff + n * 2048 + k * 1024); } while (0)
#define PG8_MMA(ai, bj, At, Bt) do { __builtin_amdgcn_s_setprio(1); _Pragma("unroll") for (int m = 0; m < 4; ++m) _Pragma("unroll") for (int n = 0; n < 2; ++n) _Pragma("unroll") for (int k = 0; k < 2; ++k) \
        acc[ai][bj][m][n] = __builtin_amdgcn_mfma_f32_16x16x32_bf16(Bt[n][k], At[m][k], acc[ai][bj][m][n], 0, 0, 0); __builtin_amdgcn_s_setprio(0); } while (0)
#define PG8_CAT(x, y) __builtin_shufflevector(__builtin_bit_cast(i32x4, x), __builtin_bit_cast(i32x4, y), 0, 1, 2, 3, 4, 5, 6, 7)
#define PG8_LDA8(dst, b, h) do { _Pragma("unroll") for (int m = 0; m < 4; ++m) dst[m] = PG8_CAT(*(const LAS bf16x8*)(lds + PG8_SA(b, h) + aoff + m * 2048), *(const LAS bf16x8*)(lds + PG8_SA(b, h) + aoff + m * 2048 + 1024)); } while (0)
#define PG8_LDB8(dst, b, h) do { _Pragma("unroll") for (int n = 0; n < 2; ++n) dst[n] = PG8_CAT(*(const LAS bf16x8*)(lds + PG8_SB(b, h) + boff + n * 2048), *(const LAS bf16x8*)(lds + PG8_SB(b, h) + boff + n * 2048 + 1024)); } while (0)
#define PG8_MMA8(ai, bj, A8, B8) do { __builtin_amdgcn_s_setprio(1); _Pragma("unroll") for (int m = 0; m < 4; ++m) _Pragma("unroll") for (int n = 0; n < 2; ++n) \
        acc[ai][bj][m][n] = MFMA16_F8X128(B8[n], A8[m], acc[ai][bj][m][n]); __builtin_amdgcn_s_setprio(0); } while (0)
#define PG8_WAIT_V(n) asm volatile("s_waitcnt vmcnt(" #n ")" ::: "memory")
#define PG8_WAIT_L(n) asm volatile("s_waitcnt lgkmcnt(" #n ")" ::: "memory")
#define PG8_BAR __builtin_amdgcn_s_barrier()
#define PG8_SCHED __builtin_amdgcn_sched_barrier(0)
    Unit cur, nxt; int ui = 0;
    if (!S.next(0, cur)) return;
    f32x4 acc[2][2][4][2];
#pragma unroll
    for (int a = 0; a < 2; ++a)
#pragma unroll
        for (int b = 0; b < 2; ++b)
#pragma unroll
            for (int m = 0; m < 4; ++m)
#pragma unroll
                for (int n = 0; n < 2; ++n) acc[a][b][m][n] = (f32x4){0.f, 0.f, 0.f, 0.f};
    bf16x8 At[4][2], B0[2][2], B1[2][2];
    const char* cA = cur.a; const char* cB = cur.b; int cf8 = MODE == 2 ? cur.f8 : MODE; size_t chA = cf8 ? hstepA8 : hstepA;
    { unsigned v0[2] = {cf8 ? voffA8[0] : voffA[0], cf8 ? voffA8[1] : voffA[1]};
    PG8_STAGE(PG8_SB(0, 0), cB, voffB); PG8_STAGE(PG8_SB(0, 1), cB + hstepB, voffB); PG8_STAGE(PG8_SA(0, 0), cA, v0); PG8_STAGE(PG8_SA(0, 1), cA + chA, v0);
    if (wr == 1) PG8_BAR;
    PG8_WAIT_V(2); PG8_BAR;
    PG8_STAGE(PG8_SB(1, 0), cB + kstep, voffB); PG8_STAGE(PG8_SA(1, 0), cA + kstep, v0); PG8_STAGE(PG8_SB(1, 1), cB + hstepB + kstep, voffB);
    PG8_WAIT_V(6); PG8_BAR; }
    for (;;) {
        const bool has_next = S.next(ui + 1, nxt);
        const char* nA = has_next ? nxt.a : cA; const char* nB = has_next ? nxt.b : cB; const int nf8 = MODE == 2 ? (has_next ? nxt.f8 : cf8) : MODE;
        int nt = cur.nt; asm volatile("" : "+s"(nt));
#define PG8_KLOOP(LDA_, LDB_, MM_, At_, B0_, B1_, CF8) \
        for (int t = 0; t < nt; t += 2) { \
            const bool last = (t == nt - 2); \
            const char* a1 = cA + (size_t)(t + 1) * kstep; \
            const char* a2 = last ? nA : cA + (size_t)(t + 2) * kstep; const char* b2 = last ? nB : cB + (size_t)(t + 2) * kstep; \
            const char* a3 = a2 + kstep; const char* b3 = b2 + kstep; \
            const int f2 = last ? nf8 : CF8; const size_t h2 = f2 ? hstepA8 : hstepA; \
            OPAQUE_S(a1); OPAQUE_S(a2); OPAQUE_S(a3); OPAQUE_S(b2); OPAQUE_S(b3); \
            const unsigned vA[2] = {CF8 ? voffA8[0] : voffA[0], CF8 ? voffA8[1] : voffA[1]}, vA2[2] = {f2 ? voffA8[0] : voffA[0], f2 ? voffA8[1] : voffA[1]}, vB[2] = {voffB[0], voffB[1]}; \
            LDB_(B0_, 0, 0); LDB_(B1_, 0, 1); PG8_SCHED; LDA_(At_, 0, 0); PG8_STAGE(PG8_SA(1, 1), a1 + (CF8 ? hstepA8 : hstepA), vA); \
            PG8_WAIT_V(8); PG8_WAIT_L(0); PG8_BAR; MM_(0, 0, At_, B0_); MM_(0, 1, At_, B1_); PG8_BAR; PG8_SCHED; \
            LDA_(At_, 0, 1); PG8_STAGE(PG8_SB(0, 0), b2, vB); PG8_STAGE(PG8_SB(0, 1), b2 + hstepB, vB); PG8_STAGE(PG8_SA(0, 0), a2, vA2); \
            PG8_WAIT_V(8); PG8_WAIT_L(0); PG8_BAR; MM_(1, 0, At_, B0_); MM_(1, 1, At_, B1_); PG8_BAR; PG8_SCHED; \
            LDB_(B0_, 1, 0); LDB_(B1_, 1, 1); PG8_SCHED; LDA_(At_, 1, 0); PG8_STAGE(PG8_SA(0, 1), a2 + h2, vA2); \
            PG8_WAIT_V(8); PG8_WAIT_L(0); PG8_BAR; MM_(0, 0, At_, B0_); MM_(0, 1, At_, B1_); PG8_BAR; PG8_SCHED; \
            LDA_(At_, 1, 1); PG8_STAGE(PG8_SB(1, 0), b3, vB); PG8_STAGE(PG8_SB(1, 1), b3 + hstepB, vB); PG8_STAGE(PG8_SA(1, 0), a3, vA2); \
            PG8_WAIT_V(8); PG8_WAIT_L(0); PG8_BAR; MM_(1, 0, At_, B0_); MM_(1, 1, At_, B1_); PG8_BAR; PG8_SCHED; \
        }
        if (MODE == 1 || (MODE == 2 && cf8)) { i32x8 A8[4], B08[2], B18[2]; PG8_KLOOP(PG8_LDA8, PG8_LDB8, PG8_MMA8, A8, B08, B18, 1) }
        else { PG8_KLOOP(PG8_LDA, PG8_LDB, PG8_MMA, At, B0, B1, 0) }
#undef PG8_KLOOP
        if (wr == 0) PG8_BAR;
        E(acc, cur, wr, wc, fr, fq, tid);
        if (!has_next) break;
#pragma unroll
        for (int a = 0; a < 2; ++a)
#pragma unroll
            for (int b = 0; b < 2; ++b)
#pragma unroll
                for (int m = 0; m < 4; ++m)
#pragma unroll
                    for (int n = 0; n < 2; ++n) acc[a][b][m][n] = (f32x4){0.f, 0.f, 0.f, 0.f};
        cur = nxt; cA = nA; cB = nB; cf8 = nf8; ++ui;
        if (wr == 1) PG8_BAR;
    }
    PG8_WAIT_V(0);
    PG8_BAR;
#undef PG8_SA
#undef PG8_SB
#undef PG8_STAGE
#undef PG8_LDA
#undef PG8_LDB
#undef PG8_MMA
#undef PG8_MMA8
#undef PG8_LDA8
#undef PG8_LDB8
#undef PG8_CAT
#undef PG8_WAIT_V
#undef PG8_WAIT_L
#undef PG8_BAR
#undef PG8_SCHED
}
#else
template <int MODE = 0, class Epi, class Sched>
inline void gemm_phase(unsigned char* lds, const int lda, const int ldb, const Sched& S, const Epi& E, const int lda8 = 0) {
    const int tid = TIDX(), wid = tid >> 6, lane = tid & 63, wr = wid >> 2, wc = wid & 3, fr = lane & 15, fq = lane >> 4;
    Unit cur;
    for (int ui = 0; S.next(ui, cur); ++ui) {
        f32x4 acc[2][2][4][2];
        const bf16_t* A = (const bf16_t*)cur.a; const bf16_t* Bt = (const bf16_t*)cur.b; const int K = cur.nt * 64;
        for (int ai = 0; ai < 2; ++ai) for (int bj = 0; bj < 2; ++bj) for (int m = 0; m < 4; ++m) for (int n = 0; n < 2; ++n) for (int e = 0; e < 4; ++e) {
            const int r = 128 * ai + 64 * wr + 16 * m + fr, c = 128 * bj + 32 * wc + 8 * fq + 4 * n + e; float s = 0.f;
            const bf16_t* ar = A + (size_t)r * lda; const bf16_t* br = Bt + (size_t)c * ldb;
            if (cur.f8) { const unsigned char* a8 = (const unsigned char*)cur.a + (size_t)r * lda8; const unsigned char* b8 = (const unsigned char*)cur.b + (size_t)c * ldb * 2;
                for (int k = 0; k < cur.nt * 128; ++k) s += fp8_dec_(a8[k]) * fp8_dec_(b8[k]); }
#ifdef EMU_FP8_A
            else if (cur.aux == 77) { float am = 0.f; for (int k = 0; k < K; ++k) am = fmaxf(am, fabsf(bf2f(br[k]))); const float sc = am > 0.f ? am / 440.f : 1.f;
                for (int k = 0; k < K; ++k) s += fp8_dec_(fp8_enc_(bf2f(ar[k]))) * fp8_dec_(fp8_enc_(bf2f(br[k]) / sc)); s *= sc; }
#endif
            else for (int k = 0; k < K; ++k) s += bf2f(ar[k]) * bf2f(br[k]);
            acc[ai][bj][m][n][e] = s; }
        __syncthreads();
        E(acc, cur, wr, wc, fr, fq, tid);
        __syncthreads();
    }
    __syncthreads();
}
#endif
}
struct Ptrs {
    bf16_t *WinT, *WbrT, *WoutT, *WqT, *PleT, *PleGT, *GluT, *K12, *S5Kc, *S5Wx, *S5Wy, *Ut, *Vt, *hb, *proj, *merged, *q, *ycat, *vtr, *pb;
    float *S5LL, *gate; int* eid; unsigned char* stash; bf16_t *rwPT, *rwG, *rwS0, *rwQ, *rwGt, *rwRKV; unsigned char *U8, *V8; float *su, *sv, *pd; unsigned* qcnt; unsigned char *h8a, *h8b, *h8e; float *gsc, *gscA;
};
__device__ __forceinline__ Ptrs make_ptrs(unsigned char* ws, int l) {
    Ptrs P; { size_t zoff = 0; OPAQUE_S(zoff); ws += zoff; }
    P.WinT = (bf16_t*)(ws + WS_WIN) + (size_t)l * WIN_ROWS * 1024; P.WbrT = (bf16_t*)(ws + WS_WBR) + (size_t)l * 1024 * 1024; P.WoutT = (bf16_t*)(ws + WS_WOUT) + (size_t)l * 1024 * 1024;
    P.WqT = (bf16_t*)(ws + WS_WQ) + (size_t)l * 2048 * 1024; P.PleT = (bf16_t*)(ws + WS_PLE) + (size_t)l * 1024 * 256; P.PleGT = (bf16_t*)(ws + WS_PLEG) + (size_t)l * 1024 * 1024;
    P.GluT = (bf16_t*)(ws + WS_GLU) + (size_t)l * 256 * 256; P.K12 = (bf16_t*)(ws + WS_K12) + (size_t)l * 2 * 128 * 128;
    P.S5Kc = (bf16_t*)(ws + WS_S5KC) + (size_t)l * 16 * 64 * 256; P.S5Wx = (bf16_t*)(ws + WS_S5WX) + (size_t)l * 16 * 128 * 1024; P.S5Wy = (bf16_t*)(ws + WS_S5WY) + (size_t)l * 16 * 1024 * 128;
    P.S5LL = (float*)(ws + WS_S5LL) + (size_t)l * 16 * 64 * 2;
    P.Ut = (bf16_t*)(ws + WS_UT); P.Vt = (bf16_t*)(ws + WS_VT);
    P.pd = (float*)(ws + WS_R1 + R1_Q); P.qcnt = (unsigned*)(ws + WS_CTL) + 8192 + l * 4 * 8 * 16;
    P.U8 = ws + WS_UT; P.V8 = ws + WS_UT + (size_t)NEXP * 1024; P.su = (float*)(ws + WS_CTL + 131072); P.sv = (float*)(ws + WS_CTL + 131072) + NEXP;
    P.rwGt = (bf16_t*)(ws + WS_VT); P.rwRKV = (bf16_t*)(ws + WS_VT + RW_SZ);
    P.rwPT = (bf16_t*)(ws + WS_RW); P.rwG = (bf16_t*)(ws + WS_RW + RW_SZ); P.rwS0 = (bf16_t*)(ws + WS_RW + 2 * RW_SZ); P.rwQ = (bf16_t*)(ws + WS_RW + 3 * RW_SZ);
    P.hb = (bf16_t*)(ws + WS_HB); P.proj = (bf16_t*)(ws + WS_R1 + R1_PROJ); P.merged = (bf16_t*)(ws + WS_R1 + R1_MERGED); P.q = (bf16_t*)(ws + WS_R1 + R1_Q);
    P.stash = ws + WS_R1 + R1_STASH; P.eid = (int*)(ws + WS_R1 + R1_EID); P.gate = (float*)(ws + WS_R1 + R1_GATE);
    P.ycat = (bf16_t*)(ws + WS_YC); P.vtr = (bf16_t*)(ws + WS_VTR); P.pb = (bf16_t*)(ws + WS_PB);
    P.h8a = ws + WS_R1 + R1_H8; P.h8b = ws + WS_H8T; P.h8e = ws + WS_RW; P.gsc = (float*)(ws + WS_CTL + 262144) + l * 6144; P.gscA = (float*)(ws + WS_CTL + 327680) + l * 2560;
    return P;
}

__device__ __forceinline__ int win_src_col(int n) {
    if (n < 1152) return n;
    if (n < 1664) return n;
    if (n < 1668) return 1920 + (n - 1664);
    if (n < 1792) return -1;
    if (n < 2304) return 1924 + (n - 1792);
    if (n < 2560) return 1664 + (n - 2304);
    return 2436 + (n - 2560);
}
template <bool WINMAP>
__device__ __forceinline__ void transpose_item(const float* src, int sld, bf16_t* dst, int dld, int dcol0, int kb, int nb, float* scr, int lane) {
    const int k0 = 64 * kb, n0 = 32 * nb;
    const int nn = n0 + (lane & 31); const int sc = WINMAP ? win_src_col(nn) : nn;
#pragma unroll 8
    for (int i = 0; i < 32; ++i) { const int kk = 2 * i + (lane >> 5); scr[kk * 33 + (lane & 31)] = (sc >= 0) ? src[(size_t)(k0 + kk) * sld + sc] : 0.f; }
    WAVE_SYNC();
    const int c = lane & 7;
#pragma unroll
    for (int j = 0; j < 4; ++j) { const int n = (lane >> 3) + 8 * j; const float* s = scr + (8 * c) * 33 + n;
        u32x4 o; o.x = pk2(s[0 * 33], s[1 * 33]); o.y = pk2(s[2 * 33], s[3 * 33]); o.z = pk2(s[4 * 33], s[5 * 33]); o.w = pk2(s[6 * 33], s[7 * 33]);
        *(u32x4*)(dst + (size_t)(n0 + n) * dld + dcol0 + k0 + 8 * c) = o; }
    WAVE_SYNC();
}

__device__ __forceinline__ void s5_tables(const KP& p, int l, int g, unsigned char* lds) {
    float* pw = (float*)lds;
    float* bb = pw + 65 * 128;
    float* cc = bb + 64 * 32;
    const int tid = TIDX();
    const Ptrs P = make_ptrs(p.ws, l);
    const float dt = expf(p.in[I_LDT][l * 16 + g]);
    if (tid < 64) { const int pp = tid; const float lr = p.in[I_LRE][(l * 16 + g) * 64 + pp], li = p.in[I_LIM][(l * 16 + g) * 64 + pp];
        const float mag = expf(lr * dt), ang = li * dt; const float br = mag * cosf(ang), bi = mag * sinf(ang);
        float xr = 1.f, xi = 0.f;
        for (int t = 0; t <= 64; ++t) { pw[(t * 64 + pp) * 2] = xr; pw[(t * 64 + pp) * 2 + 1] = xi; const float nr = xr * br - xi * bi, ni = xr * bi + xi * br; xr = nr; xi = ni; }
        const float nr = br - 1.f, ni = bi, den = lr * lr + li * li; const float cr = (nr * lr + ni * li) / den, ci = (ni * lr - nr * li) / den;
        for (int c = 0; c < 16; ++c) { const float b_r = p.in[I_BRE][((l * 16 + g) * 64 + pp) * 16 + c], b_i = p.in[I_BIM][((l * 16 + g) * 64 + pp) * 16 + c];
            bb[(pp * 16 + c) * 2] = cr * b_r - ci * b_i; bb[(pp * 16 + c) * 2 + 1] = cr * b_i + ci * b_r; }
        P.S5LL[(g * 64 + pp) * 2] = pw[(64 * 64 + pp) * 2]; P.S5LL[(g * 64 + pp) * 2 + 1] = pw[(64 * 64 + pp) * 2 + 1];
    }
    for (int e = tid; e < 1024; e += NTHR) { const int c = e >> 6, pp = e & 63; cc[e * 2] = p.in[I_CRE][((l * 16 + g) * 16 + c) * 64 + pp]; cc[e * 2 + 1] = p.in[I_CIM][((l * 16 + g) * 16 + c) * 64 + pp]; }
    __syncthreads();
    bf16_t* Kc = P.S5Kc + (size_t)g * 64 * 256;
    { const int pair = tid & 255, co = pair >> 4, ci = pair & 15, th = tid >> 8; float acc[32];
#pragma unroll
      for (int j = 0; j < 32; ++j) acc[j] = 0.f;
      for (int pp = 0; pp < 64; ++pp) { const float c_r = cc[(co * 64 + pp) * 2], c_i = cc[(co * 64 + pp) * 2 + 1], b_r = bb[(pp * 16 + ci) * 2], b_i = bb[(pp * 16 + ci) * 2 + 1];
          const float d_r = c_r * b_r - c_i * b_i, d_i = c_r * b_i + c_i * b_r;
#pragma unroll
          for (int j = 0; j < 32; ++j) { const f32x2 w = *(const f32x2*)(pw + ((th * 32 + j) * 64 + pp) * 2); acc[j] += d_r * w.x - d_i * w.y; } }
#pragma unroll
      for (int j = 0; j < 32; ++j) Kc[(th * 32 + j) * 256 + pair] = (bf16_t)f2bf(acc[j]); }
    bf16_t* Wx = P.S5Wx + (size_t)g * 128 * 1024;
    for (int e = tid; e < 128 * 1024; e += NTHR) { const int n = e >> 10, k = e & 1023, pp = n >> 1, ri = n & 1, s = k >> 4, ci = k & 15;
        const float w_r = pw[((63 - s) * 64 + pp) * 2], w_i = pw[((63 - s) * 64 + pp) * 2 + 1], b_r = bb[(pp * 16 + ci) * 2], b_i = bb[(pp * 16 + ci) * 2 + 1];
        Wx[e] = (bf16_t)f2bf(ri ? (w_r * b_i + w_i * b_r) : (w_r * b_r - w_i * b_i)); }
    bf16_t* Wy = P.S5Wy + (size_t)g * 1024 * 128;
    for (int e = tid; e < 1024 * 128; e += NTHR) { const int n = e >> 7, k = e & 127, t = n >> 4, co = n & 15, pp = k >> 1, ri = k & 1;
        const float c_r = cc[(co * 64 + pp) * 2], c_i = cc[(co * 64 + pp) * 2 + 1], w_r = pw[((t + 1) * 64 + pp) * 2], w_i = pw[((t + 1) * 64 + pp) * 2 + 1];
        Wy[e] = (bf16_t)f2bf(ri ? -(c_r * w_i + c_i * w_r) : (c_r * w_r - c_i * w_i)); }
    __syncthreads();
}

__device__ __forceinline__ void ln_row(const float* src, const float* g, const float* b, float* dst, bf16_t* dstb, int lane) {
    f32x4 v[4]; float s = 0.f;
#pragma unroll
    for (int j = 0; j < 4; ++j) { v[j] = *(const f32x4*)(src + 256 * j + 4 * lane); s += (v[j].x + v[j].y) + (v[j].z + v[j].w); }
    const float mean = wave_sum(s) * (1.f / 1024.f); float s2 = 0.f;
#pragma unroll
    for (int j = 0; j < 4; ++j) { v[j] = v[j] - mean; s2 += (v[j].x * v[j].x + v[j].y * v[j].y) + (v[j].z * v[j].z + v[j].w * v[j].w); }
    const float rstd = 1.f / sqrtf(wave_sum(s2) * (1.f / 1024.f) + LN_EPS_);
#pragma unroll
    for (int j = 0; j < 4; ++j) { const f32x4 gg = *(const f32x4*)(g + 256 * j + 4 * lane), bv = *(const f32x4*)(b + 256 * j + 4 * lane);
        const f32x4 o = v[j] * rstd * gg + bv; *(f32x4*)(dst + 256 * j + 4 * lane) = o;
        if (dstb) { u32x2 w; w.x = pk2(o.x, o.y); w.y = pk2(o.z, o.w); *(u32x2*)(dstb + 256 * j + 4 * lane) = w; } }
}

template <int NR, bool SB = false>
__device__ __forceinline__ void ln_rows(const void* srcv, const float* g, const float* b, float* dst, bf16_t* dstb, unsigned char* d8, int lane) {
    f32x4 v[NR][4]; float s[NR], s2[NR];
#pragma unroll
    for (int r = 0; r < NR; ++r) { s[r] = 0.f;
#pragma unroll
        for (int j = 0; j < 4; ++j) {
            if (SB) { const u32x2 w = *(const u32x2*)((const bf16_t*)srcv + (size_t)r * 1024 + 256 * j + 4 * lane); v[r][j] = (f32x4){bflo(w.x), bfhi(w.x), bflo(w.y), bfhi(w.y)}; }
            else v[r][j] = *(const f32x4*)((const float*)srcv + (size_t)r * 1024 + 256 * j + 4 * lane);
            s[r] += (v[r][j].x + v[r][j].y) + (v[r][j].z + v[r][j].w); } }
    wave_sum_n<NR>(s);
#pragma unroll
    for (int r = 0; r < NR; ++r) { const float mean = s[r] * (1.f / 1024.f); s2[r] = 0.f;
#pragma unroll
        for (int j = 0; j < 4; ++j) { v[r][j] = v[r][j] - mean; s2[r] += (v[r][j].x * v[r][j].x + v[r][j].y * v[r][j].y) + (v[r][j].z * v[r][j].z + v[r][j].w * v[r][j].w); } }
    wave_sum_n<NR>(s2);
#pragma unroll
    for (int j = 0; j < 4; ++j) { const f32x4 gg = *(const f32x4*)(g + 256 * j + 4 * lane), bv = *(const f32x4*)(b + 256 * j + 4 * lane);
#pragma unroll
        for (int r = 0; r < NR; ++r) { const float rstd = 1.f / sqrtf(s2[r] * (1.f / 1024.f) + LN_EPS_);
            const f32x4 o = v[r][j] * rstd * gg + bv; if (dst) *(f32x4*)(dst + (size_t)r * 1024 + 256 * j + 4 * lane) = o;
            if (dstb) { u32x2 w; w.x = pk2(o.x, o.y); w.y = pk2(o.z, o.w); *(u32x2*)(dstb + (size_t)r * 1024 + 256 * j + 4 * lane) = w; }
            if (d8) { unsigned w8 = cvt_pk_fp8_f32_(o.x, o.y, 0u, false); w8 = cvt_pk_fp8_f32_(o.z, o.w, w8, true); *(unsigned*)(d8 + (size_t)r * 1024 + 256 * j + 4 * lane) = w8; } } }
}
__device__ __forceinline__ void phase_prologue(const KP& p, unsigned char* lds) {
    const int tid = TIDX(), lane = tid & 63, wave = tid >> 6;
    int G = GDIM(), bid = BIDX();
    for (int it = bid; it < L_ * 16; it += G) s5_tables(p, it >> 4, it & 15, lds);
    if (G >= 4 * L_ * 16) { if (bid < L_ * 16) return; bid -= L_ * 16; G -= L_ * 16; }
    float* scr = (float*)lds + wave * (64 * 33 + 16);
    const int gw = bid * NWAVE + wave, NGW = G * NWAVE;
    constexpr int I_WINT = (WIN_ROWS / 32) * 16, I_BR = 4 * 4 * 32, I_OUT = 16 * 32, I_Q = 16 * 64, I_PL = 4 * 32, I_PG = 16 * 32, I_GL = 4 * 8;
    constexpr int PER_L = I_WINT + I_BR + I_OUT + I_Q + I_PL + I_PG + I_GL;
    for (int it = gw; it < L_ * PER_L; it += NGW) {
        const int l = it / PER_L; int r = it % PER_L; const Ptrs P = make_ptrs(p.ws, l);
        if (r < I_WINT) { transpose_item<true>(p.in[I_WIN] + (size_t)l * 1024 * IN_COLS, IN_COLS, P.WinT, 1024, 0, r & 15, r >> 4, scr, lane); continue; } r -= I_WINT;
        if (r < I_BR) { const int b = r >> 7, rr = r & 127; transpose_item<false>(p.in[I_WBR] + ((size_t)l * 4 + b) * 256 * 1024, 1024, P.WbrT, 1024, 256 * b, rr & 3, rr >> 2, scr, lane); continue; } r -= I_BR;
        if (r < I_OUT) { transpose_item<false>(p.in[I_WOUT] + (size_t)l * 1024 * 1024, 1024, P.WoutT, 1024, 0, r & 15, r >> 4, scr, lane); continue; } r -= I_OUT;
        if (r < I_Q) { transpose_item<false>(p.in[I_WQ] + (size_t)l * 1024 * 2048, 2048, P.WqT, 1024, 0, r & 15, r >> 4, scr, lane); continue; } r -= I_Q;
        if (r < I_PL) { transpose_item<false>(p.in[I_PLEW] + (size_t)l * 256 * 1024, 1024, P.PleT, 256, 0, r & 3, r >> 2, scr, lane); continue; } r -= I_PL;
        if (r < I_PG) { transpose_item<false>(p.in[I_PLEG] + (size_t)l * 1024 * 1024, 1024, P.PleGT, 1024, 0, r & 15, r >> 4, scr, lane); continue; } r -= I_PG;
        transpose_item<false>(p.in[I_GLUW] + (size_t)l * 256 * 256, 256, P.GluT, 256, 0, r & 3, r >> 2, scr, lane);
    }
    const size_t gt = (size_t)bid * NTHR + tid, NGT = (size_t)G * NTHR;
    { bf16_t* K12 = (bf16_t*)(p.ws + WS_K12);
      for (size_t i = gt; i < (size_t)L_ * 2 * 16384 / 8; i += NGT) { const size_t e = i * 8; const int l = (int)(e / 32768), r = (int)(e % 32768); const float* s = (r < 16384 ? p.in[I_K1] : p.in[I_K2]) + (size_t)l * 16384 + (r & 16383);
        const f32x4 a = *(const f32x4*)s, b = *(const f32x4*)(s + 4); u32x4 o; o.x = pk2(a.x, a.y); o.y = pk2(a.z, a.w); o.z = pk2(b.x, b.y); o.w = pk2(b.z, b.w); *(u32x4*)(K12 + e) = o; } }
    { bf16_t* hb = (bf16_t*)(p.ws + WS_HB);
      unsigned char* h8a = p.ws + WS_R1 + R1_H8; unsigned char* h8b = p.ws + WS_H8T;
      for (int m = 4 * gw; m < T_; m += 4 * NGW) ln_rows<4>(p.in[I_X] + (size_t)m * 1024, p.in[I_LNIN_G], p.in[I_LNIN_B], (float*)nullptr, hb + (size_t)m * 1024, m < H8_SPLIT ? h8a + (size_t)m * 1024 : h8b + (size_t)(m - H8_SPLIT) * 1024, lane); }
}
__device__ __forceinline__ void conv_unit(const KP& p, const Ptrs& P, int l, int unit, unsigned char* lds) {
    bf16_t* hbuf = (bf16_t*)lds;
    float* obuf = (float*)(lds + 94 * 256 * 2);
    const int tid = TIDX(), lane = tid & 63, wave = tid >> 6;
    const int tiles_per_seq = S_ / 64, b = unit / tiles_per_seq, t0 = (unit % tiles_per_seq) * 64;
    for (int e = tid; e < 94 * 32; e += NTHR) { const int r = e >> 5, c8 = (e & 31) * 8; const int t = t0 - 30 + r;
        u32x4 o = (u32x4){0u, 0u, 0u, 0u};
        if (t >= 0) { const bf16_t* row = P.proj + (size_t)(b * S_ + t) * PJ; const u32x4 v = *(const u32x4*)(row + C_CV + c8), g = *(const u32x4*)(row + C_CG + c8);
            o.x = pk2(bflo(v.x) * sigmoidf_(bflo(g.x)), bfhi(v.x) * sigmoidf_(bfhi(g.x))); o.y = pk2(bflo(v.y) * sigmoidf_(bflo(g.y)), bfhi(v.y) * sigmoidf_(bfhi(g.y)));
            o.z = pk2(bflo(v.z) * sigmoidf_(bflo(g.z)), bfhi(v.z) * sigmoidf_(bfhi(g.z))); o.w = pk2(bflo(v.w) * sigmoidf_(bflo(g.w)), bfhi(v.w) * sigmoidf_(bfhi(g.w))); }
        *(u32x4*)(hbuf + r * 256 + c8) = o; }
    __syncthreads();
    { const int c = tid & 255, half = tid >> 8; float w[31], x[62];
#pragma unroll
      for (int j = 0; j < 31; ++j) w[j] = p.in[I_CONVW][(l * 31 + j) * 256 + c];
      const float cb = p.in[I_CONVB][l * 256 + c];
#pragma unroll
      for (int j = 0; j < 62; ++j) x[j] = bf2f(hbuf[(half * 32 + j) * 256 + c]);
#pragma unroll
      for (int tt = 0; tt < 32; ++tt) { float s = cb;
#pragma unroll
          for (int j = 0; j < 31; ++j) s += w[j] * x[tt + j];
          obuf[(half * 32 + tt) * 256 + c] = s; } }
    __syncthreads();
    { const f32x4 g = *(const f32x4*)(p.in[I_CLNG] + l * 256 + 4 * lane), bb = *(const f32x4*)(p.in[I_CLNB] + l * 256 + 4 * lane);
      f32x4 vv[8]; float m1[8], m2[8];
#pragma unroll
      for (int i = 0; i < 8; ++i) { vv[i] = *(const f32x4*)(obuf + (wave * 8 + i) * 256 + 4 * lane); m1[i] = (vv[i].x + vv[i].y) + (vv[i].z + vv[i].w); }
      wave_sum_n<8>(m1);
#pragma unroll
      for (int i = 0; i < 8; ++i) { vv[i] = vv[i] - m1[i] * (1.f / 256.f); m2[i] = (vv[i].x * vv[i].x + vv[i].y * vv[i].y) + (vv[i].z * vv[i].z + vv[i].w * vv[i].w); }
      wave_sum_n<8>(m2);
#pragma unroll
      for (int i = 0; i < 8; ++i) { const int t = wave * 8 + i; const float rstd = 1.f / sqrtf(m2[i] * (1.f / 256.f) + LN_EPS_);
          f32x4 z = vv[i] * rstd * g + bb; u32x2 w; w.x = pk2(z.x * sigmoidf_(z.x), z.y * sigmoidf_(z.y)); w.y = pk2(z.z * sigmoidf_(z.z), z.w * sigmoidf_(z.w));
          *(u32x2*)(P.ycat + (size_t)(b * S_ + t0 + t) * 1024 + 768 + 4 * lane) = w; } }
    __syncthreads();
}

constexpr int S5_NCH = S_ / 64;
constexpr int S5_UPITCH = 1032;
constexpr int S5_XPITCH = 136;
__device__ __forceinline__ void s5_unit(const KP& p, const Ptrs& P, int l, int unit, unsigned char* lds) {
    const int b = unit >> 4, g = unit & 15;
    bf16_t* Uc = (bf16_t*)lds;
    bf16_t* Kc = (bf16_t*)(lds + 66048);
    float* Xe = (float*)(lds + 66048 + 32768);
    bf16_t* Xs = (bf16_t*)(lds + 66048 + 65536);
    const int tid = TIDX(), lane = tid & 63, wave = tid >> 6, r32 = lane & 31, hi = lane >> 5;
    { u32x4 v[8], kc[4];
#pragma unroll
      for (int j = 0; j < 8; ++j) { const int e = tid + j * NTHR, s = e >> 1, hf = e & 1; v[j] = (u32x4){0u, 0u, 0u, 0u};
          if (s < S_) v[j] = *(const u32x4*)(P.proj + (size_t)(b * S_ + s) * PJ + C_S5 + 16 * g + 8 * hf); }
#pragma unroll
      for (int j = 0; j < 4; ++j) kc[j] = *(const u32x4*)(P.S5Kc + (size_t)g * 16384 + (tid + j * NTHR) * 8);
#pragma unroll
      for (int j = 0; j < 8; ++j) { const int e = tid + j * NTHR, s = e >> 1, hf = e & 1; *(u32x4*)(Uc + (s >> 6) * S5_UPITCH + (s & 63) * 16 + 8 * hf) = v[j]; }
#pragma unroll
      for (int j = 0; j < 4; ++j) *(u32x4*)(Kc + (tid + j * NTHR) * 8) = kc[j]; }
    __syncthreads();
    { const int ntile = wave & 3, kh = wave >> 2; f32x16 acc = {};
      const bf16_t* wrow = P.S5Wx + ((size_t)g * 128 + ntile * 32 + r32) * 1024 + kh * 512 + 8 * hi;
      const bf16_t* urow = Uc + r32 * S5_UPITCH + kh * 512 + 8 * hi;
      for (int k8 = 0; k8 < 32; k8 += 8) { bf16x8 bw[8];
#pragma unroll
          for (int j = 0; j < 8; ++j) bw[j] = *(const bf16x8*)(wrow + (k8 + j) * 16);
#pragma unroll
          for (int j = 0; j < 8; ++j) { const bf16x8 a = *(const bf16x8*)(urow + (k8 + j) * 16); acc = MFMA32(a, bw[j], acc); } }
#pragma unroll
      for (int r = 0; r < 16; ++r) { const int c = (r & 3) + 8 * (r >> 2) + 4 * hi; Xe[(kh * 32 + c) * 128 + ntile * 32 + r32] = acc[r]; } }
    __syncthreads();
    if (tid < 64) { const float lr = P.S5LL[(g * 64 + tid) * 2], li = P.S5LL[(g * 64 + tid) * 2 + 1]; float xr = 0.f, xi = 0.f;
        for (int c = 0; c < 32; ++c) { Xs[c * S5_XPITCH + 2 * tid] = (bf16_t)f2bf(xr); Xs[c * S5_XPITCH + 2 * tid + 1] = (bf16_t)f2bf(xi);
            const float er = Xe[c * 128 + 2 * tid] + Xe[(32 + c) * 128 + 2 * tid], ei = Xe[c * 128 + 2 * tid + 1] + Xe[(32 + c) * 128 + 2 * tid + 1];
            const float nr = lr * xr - li * xi + er, ni = lr * xi + li * xr + ei; xr = nr; xi = ni; } }
    __syncthreads();
    { const int tt = r32 >> 4, co = r32 & 15; const float dsk = p.in[I_S5D][l * 256 + 16 * g + co];
      for (int q = 0; q < 4; ++q) { const int ntile = wave + 8 * q, t0 = 2 * ntile; f32x16 acc = {};
          const bf16_t* urow = Uc + r32 * S5_UPITCH + 8 * hi;
          for (int s = 0; s <= t0 + 1; ++s) { const int tau = t0 + tt - s; bf16x8 bk = (bf16x8){0, 0, 0, 0, 0, 0, 0, 0};
              if (tau >= 0) bk = *(const bf16x8*)(Kc + (tau * 16 + co) * 16 + 8 * hi);
              const bf16x8 a = *(const bf16x8*)(urow + s * 16); acc = MFMA32(a, bk, acc); }
          const bf16_t* wy = P.S5Wy + ((size_t)g * 1024 + ntile * 32 + r32) * 128 + 8 * hi; const bf16_t* xrow = Xs + r32 * S5_XPITCH + 8 * hi;
#pragma unroll
          for (int ks = 0; ks < 8; ++ks) { const bf16x8 a = *(const bf16x8*)(xrow + ks * 16); const bf16x8 bw = *(const bf16x8*)(wy + ks * 16); acc = MFMA32(a, bw, acc); }
#pragma unroll
          for (int r = 0; r < 16; ++r) { const int c = (r & 3) + 8 * (r >> 2) + 4 * hi; const int s = c * 64 + t0 + tt;
              if (s < S_) { const float uu = bf2f(Uc[c * S5_UPITCH + (t0 + tt) * 16 + co]); const float y = acc[r] + dsk * uu;
                  P.ycat[(size_t)(b * S_ + s) * 1024 + 256 + 16 * g + co] = (bf16_t)f2bf(gelu_erf(y)); } } } }
    __syncthreads();
}
constexpr float LOG2E_ = 1.4426950408889634f;
__device__ __forceinline__ float log_sigmoid_(float x) { return fminf(x, 0.f) - log1pf(__expf(-fabsf(x))); }
__device__ __forceinline__ void fox_unit(const KP& p, const Ptrs& P, int l, int unit, unsigned char* lds) {
    constexpr int NQB = S_ / 256;
    const int bh = unit / NQB, qb = (unit >= (NB_ * 4 * NQB) / 2) ? NQB - 1 - unit % NQB : unit % NQB, b = bh >> 2, h = bh & 3, q0 = qb * 256;
    float* cl = (float*)lds;
    unsigned char* Kt = lds + S_ * 4;
    unsigned char* Vt = Kt + 8192;
    float* wsf = (float*)(Kt + 32768);
    float* sc = wsf + 256;
    const int tid = TIDX(), lane = tid & 63, wave = tid >> 6, r32 = lane & 31, hi = lane >> 5;
    const int qend = q0 + 256;
    { constexpr int PER = (S_ + 511) / 512; const float bf = p.in[I_BF][l * 4 + h]; float loc[PER]; float s = 0.f;
#pragma unroll
      for (int i = 0; i < PER; ++i) { const int t = tid * PER + i; float v = 0.f;
          if (t < qend) v = log_sigmoid_(bf2f(P.proj[(size_t)(b * S_ + t) * PJ + C_FL + h]) + bf) * LOG2E_;
          s += v; loc[i] = s; }
      sc[tid] = s; __syncthreads();
      for (int off = 1; off < 512; off <<= 1) { const float v = sc[tid] + (tid >= off ? sc[tid - off] : 0.f); __syncthreads(); sc[tid] = v; __syncthreads(); }
      const float base = sc[tid] - s;
#pragma unroll
      for (int i = 0; i < PER; ++i) { const int t = tid * PER + i; if (t < S_) cl[t] = base + loc[i]; }
      __syncthreads(); }
    const int qrow = q0 + 32 * wave + r32;
    constexpr float C2 = 0.125f * LOG2E_;
    bf16x8 qr[4];
    { const bf16_t* qp = P.proj + (size_t)(b * S_ + qrow) * PJ + C_FQ + 64 * h + 8 * hi;
#pragma unroll
      for (int d0 = 0; d0 < 4; ++d0) { const u32x4 w = *(const u32x4*)(qp + 16 * d0);
          u32x4 o; o.x = pk2(bflo(w.x) * C2, bfhi(w.x) * C2); o.y = pk2(bflo(w.y) * C2, bfhi(w.y) * C2); o.z = pk2(bflo(w.z) * C2, bfhi(w.z) * C2); o.w = pk2(bflo(w.w) * C2, bfhi(w.w) * C2);
          qr[d0] = __builtin_bit_cast(bf16x8, o); } }
    const float clq = cl[qrow];
    float mrun = -INFINITY, lrun = 0.f; f32x16 o0 = {}, o1 = {};
    const int NT = qend / 64;
    const int srow = tid >> 3, sch = tid & 7;
    const bf16_t* kg = P.proj + (size_t)(b * S_ + srow) * PJ + C_FK + 64 * h + 8 * sch;
    const bf16_t* vg = P.vtr + (size_t)(64 * h + srow) * T_ + (size_t)b * S_ + 8 * sch;
    const int koff = srow * 128 + ((sch ^ ((srow >> 1) & 7)) * 16);
    const int voffa = srow * 128 + (((2 * sch) ^ ((srow >> 1) & 15)) * 8), voffb = srow * 128 + (((2 * sch + 1) ^ ((srow >> 1) & 15)) * 8);
    u32x4 kreg = *(const u32x4*)kg, vreg = *(const u32x4*)vg;
    *(u32x4*)(Kt + koff) = kreg; *(u32x2*)(Vt + voffa) = (u32x2){vreg.x, vreg.y}; *(u32x2*)(Vt + voffb) = (u32x2){vreg.z, vreg.w};
    if (NT > 1) { kreg = *(const u32x4*)(kg + (size_t)64 * PJ); vreg = *(const u32x4*)(vg + 64); }
    __syncthreads();
    for (int jt = 0; jt < NT; ++jt) {
        const int kv0 = jt * 64; const unsigned char* Kb = Kt + (jt & 1) * 16384; const unsigned char* Vb = Vt + (jt & 1) * 16384;
        if (kv0 <= q0 + 32 * wave + 31) {
            f32x16 pt[2];
#pragma unroll
            for (int kvt = 0; kvt < 2; ++kvt) { const int row = 32 * kvt + r32; f32x16 acc;
#pragma unroll
                for (int g4 = 0; g4 < 4; ++g4) { const f32x4 c4 = *(const f32x4*)(cl + kv0 + 32 * kvt + 8 * g4 + 4 * hi);
#pragma unroll
                    for (int e = 0; e < 4; ++e) acc[4 * g4 + e] = clq - c4[e]; }
#pragma unroll
                for (int d0 = 0; d0 < 4; ++d0) { const bf16x8 a = *(const bf16x8*)(Kb + row * 128 + (((2 * d0 + hi) ^ ((row >> 1) & 7)) * 16)); acc = MFMA32(a, qr[d0], acc); }
                pt[kvt] = acc; }
            if (kv0 + 63 > q0 + 32 * wave) {
#pragma unroll
                for (int kvt = 0; kvt < 2; ++kvt)
#pragma unroll
                    for (int r = 0; r < 16; ++r) { const int key = kv0 + 32 * kvt + (r & 3) + 8 * (r >> 2) + 4 * hi; if (key > qrow) pt[kvt][r] = -INFINITY; } }
            float mx = -INFINITY;
#pragma unroll
            for (int kvt = 0; kvt < 2; ++kvt)
#pragma unroll
                for (int r = 0; r < 16; ++r) mx = fmaxf(mx, pt[kvt][r]);
            mx = fmaxf(mx, __shfl_xor(mx, 32));
            const float mnew = fmaxf(mrun, mx), alpha = FAST_EXP2(mrun - mnew); mrun = mnew;
            float ls = 0.f;
#pragma unroll
            for (int kvt = 0; kvt < 2; ++kvt)
#pragma unroll
                for (int r = 0; r < 16; ++r) { const float e = FAST_EXP2(pt[kvt][r] - mnew); pt[kvt][r] = e; ls += e; }
            lrun = lrun * alpha + ls;
            float* wf = wsf + wave * 32;
            WAVE_SYNC(); if (hi == 0) wf[r32] = alpha; WAVE_SYNC();
#pragma unroll
            for (int g4 = 0; g4 < 4; ++g4) { const f32x4 f = *(const f32x4*)(wf + 8 * g4 + 4 * hi);
#pragma unroll
                for (int e = 0; e < 4; ++e) { o0[4 * g4 + e] *= f[e]; o1[4 * g4 + e] *= f[e]; } }
#pragma unroll
            for (int s = 0; s < 4; ++s) { const int kvt = s >> 1, rb = 8 * (s & 1);
                u32x4 pw; pw.x = pk2(pt[kvt][rb + 0], pt[kvt][rb + 1]); pw.y = pk2(pt[kvt][rb + 2], pt[kvt][rb + 3]); pw.z = pk2(pt[kvt][rb + 4], pt[kvt][rb + 5]); pw.w = pk2(pt[kvt][rb + 6], pt[kvt][rb + 7]);
                const bf16x8 pa = __builtin_bit_cast(bf16x8, pw);
#pragma unroll
                for (int dt = 0; dt < 2; ++dt) { const int d = 32 * dt + r32; const int sw = (d >> 1) & 15;
                    const u32x2 va = *(const u32x2*)(Vb + d * 128 + (((4 * s + hi) ^ sw) * 8)), vb = *(const u32x2*)(Vb + d * 128 + (((4 * s + 2 + hi) ^ sw) * 8));
                    const bf16x8 vf = __builtin_bit_cast(bf16x8, (u32x4){va.x, va.y, vb.x, vb.y});
                    if (dt == 0) o0 = MFMA32(pa, vf, o0); else o1 = MFMA32(pa, vf, o1); } }
        }
        if (jt + 1 < NT) { unsigned char* Kn = Kt + ((jt + 1) & 1) * 16384; unsigned char* Vn = Vt + ((jt + 1) & 1) * 16384;
            *(u32x4*)(Kn + koff) = kreg; *(u32x2*)(Vn + voffa) = (u32x2){vreg.x, vreg.y}; *(u32x2*)(Vn + voffb) = (u32x2){vreg.z, vreg.w};
            if (jt + 2 < NT) { kreg = *(const u32x4*)(kg + (size_t)(kv0 + 128) * PJ); vreg = *(const u32x4*)(vg + kv0 + 128); } }
        __syncthreads();
    }
    { const float lt = lrun + __shfl_xor(lrun, 32); float* wf = wsf + wave * 32;
      WAVE_SYNC(); if (hi == 0) wf[r32] = 1.0f / lt; WAVE_SYNC();
      bf16_t* orow = P.ycat + (size_t)(b * S_ + q0 + 32 * wave) * 1024 + 512 + 64 * h + r32;
#pragma unroll
      for (int r = 0; r < 16; ++r) { const int qq = (r & 3) + 8 * (r >> 2) + 4 * hi; const float f = wf[qq];
          orow[(size_t)qq * 1024] = (bf16_t)f2bf(o0[r] * f); orow[(size_t)qq * 1024 + 32] = (bf16_t)f2bf(o1[r] * f); } }
    __syncthreads();
}

constexpr int RW_NCH = S_ / 64;
constexpr int RWP = 72;
constexpr int RW_ARR = 64 * RWP * 2;
constexpr int RW_SCRP = 388;
__device__ __forceinline__ void rw_stage_weights(const KP& p, int l, int h, bf16_t* wb, int tid) {
    for (int e = tid; e < 2048; e += NTHR) { const int m = e >> 4, c4 = (e & 15) * 4;
        if (m < 32) { const f32x4 v = *(const f32x4*)(p.in[I_A2] + (l * 32 + m) * 256 + 64 * h + c4);
#pragma unroll
            for (int q = 0; q < 4; ++q) wb[(c4 + q) * 40 + m] = (bf16_t)f2bf(v[q]); }
        else if (m < 64) { const f32x4 v = *(const f32x4*)(p.in[I_W2] + (l * 32 + m - 32) * 256 + 64 * h + c4);
#pragma unroll
            for (int q = 0; q < 4; ++q) wb[2560 + (c4 + q) * 40 + (m - 32)] = (bf16_t)f2bf(v[q]); }
        else { const f32x4 v = *(const f32x4*)(p.in[I_G2] + (l * 64 + m - 64) * 256 + 64 * h + c4);
#pragma unroll
            for (int q = 0; q < 4; ++q) wb[5120 + (c4 + q) * 72 + (m - 64)] = (bf16_t)f2bf(v[q]); } }
    __syncthreads();
}
__device__ __forceinline__ bf16x8 rw_pack8(const float* q) { const f32x4 a = *(const f32x4*)q, b = *(const f32x4*)(q + 4);
    u32x4 w; w.x = pk2(a.x, a.y); w.y = pk2(a.z, a.w); w.z = pk2(b.x, b.y); w.w = pk2(b.z, b.w); return __builtin_bit_cast(bf16x8, w); }
template <int NT, bool NEED_W, bool NEED_G>
__device__ __forceinline__ void rw_prep(const KP& p, const Ptrs& P, int l, int b, int h, int tpos0, float* scr, const bf16_t* wb, int lane,
                                        float (&r)[NT], float (&lw)[NT], float (&k2)[NT], float (&v)[NT], float (&ain)[NT], float (&bin)[NT], float (&g)[NT], float (&rk)[NT]) {
    constexpr int NIT = (NT * 40 + 63) / 64;
    u32x4 cur[NIT], prv[NIT];
#pragma unroll
    for (int i = 0; i < NIT; ++i) { const int e = lane + 64 * i; const int tt = e / 40, ch = e % 40; const int t = tpos0 + tt;
        const int col = ch < 8 ? C_R + 64 * h + 8 * ch : ch < 16 ? C_K + 64 * h + 8 * (ch - 8) : ch < 24 ? C_V + 64 * h + 8 * (ch - 16) : C_HW + 8 * (ch - 24);
        cur[i] = (u32x4){0u, 0u, 0u, 0u}; prv[i] = (u32x4){0u, 0u, 0u, 0u};
        if (e < NT * 40) { const bf16_t* row = P.proj + (size_t)(b * S_ + t) * PJ + col; cur[i] = *(const u32x4*)row; if (t > 0) prv[i] = *(const u32x4*)(row - PJ); } }
#pragma unroll
    for (int i = 0; i < NIT; ++i) { const int e = lane + 64 * i; const int tt = e / 40, ch = e % 40;
        const int col = ch < 8 ? C_R + 64 * h + 8 * ch : ch < 16 ? C_K + 64 * h + 8 * (ch - 8) : ch < 24 ? C_V + 64 * h + 8 * (ch - 16) : C_HW + 8 * (ch - 24);
        const int idx = ch < 24 ? 8 * ch : 192 + 8 * (ch - 24);
        if (e < NT * 40) { const f32x4 m0 = *(const f32x4*)(p.in[I_MU] + l * 896 + col), m1 = *(const f32x4*)(p.in[I_MU] + l * 896 + col + 4);
            float z[8] = {bflo(cur[i].x), bfhi(cur[i].x), bflo(cur[i].y), bfhi(cur[i].y), bflo(cur[i].z), bfhi(cur[i].z), bflo(cur[i].w), bfhi(cur[i].w)};
            const float zp[8] = {bflo(prv[i].x), bfhi(prv[i].x), bflo(prv[i].y), bfhi(prv[i].y), bflo(prv[i].z), bfhi(prv[i].z), bflo(prv[i].w), bfhi(prv[i].w)};
#pragma unroll
            for (int q = 0; q < 8; ++q) { float zs = z[q] + (zp[q] - z[q]) * (q < 4 ? m0[q & 3] : m1[q & 3]);
                if (ch >= 24 && ch < 28) zs = 1.0f - 2.0f * FAST_RCP(1.0f + FAST_EXP2(zs * 2.8853900817779268f));
                else if (ch >= 32) zs = sigmoidf_(zs);
                z[q] = zs; }
            *(f32x4*)(scr + tt * RW_SCRP + idx) = (f32x4){z[0], z[1], z[2], z[3]}; *(f32x4*)(scr + tt * RW_SCRP + idx + 4) = (f32x4){z[4], z[5], z[6], z[7]}; } }
    WAVE_SYNC();
    { const int fr = lane & 15, fq = lane >> 4; const float* hrow = scr + (fr & 7) * RW_SCRP + 192 + 8 * fq;
      const bf16x8 fw = rw_pack8(hrow), fa = rw_pack8(hrow + 32), fg0 = rw_pack8(hrow + 64), fg1 = rw_pack8(hrow + 96);
      WAVE_SYNC();
#pragma unroll
      for (int nt = 0; nt < 4; ++nt) { const f32x4 z4 = (f32x4){0.f, 0.f, 0.f, 0.f};
          const f32x4 da = MFMA16(fa, *(const bf16x8*)(wb + (16 * nt + fr) * 40 + 8 * fq), z4);
          f32x4 dw = z4, dg = z4;
          if (NEED_W) dw = MFMA16(fw, *(const bf16x8*)(wb + 2560 + (16 * nt + fr) * 40 + 8 * fq), z4);
          if (NEED_G) { dg = MFMA16(fg0, *(const bf16x8*)(wb + 5120 + (16 * nt + fr) * 72 + 8 * fq), z4); dg = MFMA16(fg1, *(const bf16x8*)(wb + 5120 + (16 * nt + fr) * 72 + 32 + 8 * fq), dg); }
          if (fq < 2) {
#pragma unroll
              for (int q = 0; q < 4; ++q) { float* o = scr + (4 * fq + q) * RW_SCRP + 16 * nt + fr; o[192] = da[q]; if (NEED_W) o[256] = dw[q]; if (NEED_G) o[320] = dg[q]; } } }
      WAVE_SYNC(); }
    const int j = lane, cj = 64 * h + j; float wl[NT], al[NT], gg[NT];
    const float w0 = p.in[I_W0][l * 256 + cj], a0 = p.in[I_A0][l * 256 + cj];
#pragma unroll
    for (int tt = 0; tt < NT; ++tt) { al[tt] = a0 + scr[tt * RW_SCRP + 192 + j]; wl[tt] = NEED_W ? w0 + scr[tt * RW_SCRP + 256 + j] : w0; gg[tt] = NEED_G ? scr[tt * RW_SCRP + 320 + j] : 0.f; }
    const float kkw = p.in[I_KK][l * 256 + cj], kaw = p.in[I_KA][l * 256 + cj], rkw = p.in[I_RK][l * 256 + cj];
    float ssum[NT], rsum[NT], kkv[NT], av[NT];
#pragma unroll
    for (int tt = 0; tt < NT; ++tt) {
        const float a = sigmoidf_(al[tt]); av[tt] = a;
        const float rr = scr[tt * RW_SCRP + j], k = scr[tt * RW_SCRP + 64 + j], vv = scr[tt * RW_SCRP + 128 + j];
        const float kk2 = k * (1.f + (a - 1.f) * kaw);
        r[tt] = rr; k2[tt] = kk2; v[tt] = vv;
        const float kk = k * kkw; kkv[tt] = kk; ssum[tt] = kk * kk; rsum[tt] = rr * kk2 * rkw; }
    if (NEED_W) wave_sum_n<NT>(ssum);
    if (NEED_G) wave_sum_n<NT>(rsum);
#pragma unroll
    for (int tt = 0; tt < NT; ++tt) {
        if (NEED_W) { const float x = -wl[tt]; const float sp = fmaxf(x, 0.f) + 0.6931471805599453f * FAST_LOG2(1.0f + FAST_EXP2(-1.4426950408889634f * fabsf(x)));
            lw[tt] = -FAST_EXP2(-1.4426950408889634f * (sp + 0.5f));
            const float kkn = kkv[tt] * FAST_RSQ(fmaxf(ssum[tt], 1e-24f));
            ain[tt] = -kkn; bin[tt] = kkn * av[tt]; }
        if (NEED_G) { g[tt] = gg[tt]; rk[tt] = rsum[tt]; }
    }
    WAVE_SYNC();
}
__device__ __forceinline__ bf16x8 ldsb8(const bf16_t* p) { return *(const bf16x8*)p; }
__device__ __forceinline__ f32x16 rw_tile(const bf16_t* X, const bf16_t* Y, int tm, int tn, int r32, int hi, f32x16 acc) {
    const bf16_t* xa = X + (32 * tm + r32) * RWP + 8 * hi; const bf16_t* yb = Y + (32 * tn + r32) * RWP + 8 * hi;
#pragma unroll
    for (int ks = 0; ks < 4; ++ks) acc = MFMA32(ldsb8(xa + 16 * ks), ldsb8(yb + 16 * ks), acc);
    return acc;
}
template <int STOP = 0>
__device__ __forceinline__ void rw_chunk_unit(const KP& p, const Ptrs& P, int l, int unit, unsigned char* lds) {
    MEMFENCE(); OPAQUE_S(unit);
    const int c = unit % RW_NCH, bh = unit / RW_NCH, b = bh >> 2, h = bh & 3, t0 = c * 64;
    bf16_t* AT = (bf16_t*)(lds + 0 * RW_ARR); bf16_t* RT = (bf16_t*)(lds + 1 * RW_ARR); bf16_t* BT = (bf16_t*)(lds + 2 * RW_ARR); bf16_t* KT = (bf16_t*)(lds + 3 * RW_ARR);
    bf16_t* BH = (bf16_t*)(lds + 4 * RW_ARR); bf16_t* KH = (bf16_t*)(lds + 5 * RW_ARR); bf16_t* VT = (bf16_t*)(lds + 6 * RW_ARR);
    bf16_t* AAK = (bf16_t*)(lds + 7 * RW_ARR); bf16_t* ARB = (bf16_t*)(lds + 8 * RW_ARR); bf16_t* ARK = (bf16_t*)(lds + 9 * RW_ARR);
    bf16_t* W1T = (bf16_t*)(lds + 10 * RW_ARR); bf16_t* UVT = (bf16_t*)(lds + 11 * RW_ARR);
    bf16_t* RHT = (bf16_t*)(lds + 12 * RW_ARR);
    float* ADG = (float*)(lds + 14 * RW_ARR);
    bf16_t* ABA = (bf16_t*)(lds + 14 * RW_ARR + 8192);
    float* WT = (float*)(lds + 14 * RW_ARR + 8192 + 32 * RWP * 2);
    float* GC = WT + 512;
    bf16_t* DAB = AT;
    const int tid = TIDX(), lane = tid & 63, wave = tid >> 6, r32 = lane & 31, hi = lane >> 5;
    float r[8], lw[8], k2[8], v[8], ain[8], bin[8], gg[8], rk[8];
    rw_stage_weights(p, l, h, (bf16_t*)(lds + 8 * 8 * RW_SCRP * 4), tid);
    rw_prep<8, true, true>(p, P, l, b, h, t0 + 8 * wave, (float*)lds + wave * (8 * RW_SCRP), (const bf16_t*)(lds + 8 * 8 * RW_SCRP * 4), lane, r, lw, k2, v, ain, bin, gg, rk);
#pragma unroll
    for (int i = 0; i < 8; ++i) { const size_t o = (size_t)(b * S_ + t0 + 8 * wave + i) * 256 + 64 * h + lane; P.rwGt[o] = (bf16_t)f2bf(gg[i]); P.rwRKV[o] = (bf16_t)f2bf(rk[i] * v[i]); }
    float Lloc[8]; { float s = 0.f;
#pragma unroll
      for (int i = 0; i < 8; ++i) { s += lw[i]; Lloc[i] = s; } }
    __syncthreads();
    if (STOP == 1) return;
    WT[wave * 64 + lane] = Lloc[7];
    __syncthreads();
    { float off = 0.f, tot = 0.f;
#pragma unroll
      for (int w = 0; w < 8; ++w) { const float x = WT[w * 64 + lane]; tot += x; if (w < wave) off += x; }
      if (wave == 0) GC[lane] = __expf(tot);
      unsigned bhp[4], khp[4], vtp[4], atp[4]; float pb = 0.f, pk = 0.f, pv = 0.f, pa = 0.f;
#pragma unroll
      for (int i = 0; i < 8; ++i) { const int t = 8 * wave + i; const float Lt = off + Lloc[i], Lp = Lt - lw[i];
          const float eL = __expf(Lt), eLp = __expf(Lp), einv = __expf(-Lt), eh = __expf(tot - Lt);
          const float xa = ain[i] * eLp;
          AT[t * RWP + lane] = (bf16_t)f2bf(xa); RT[t * RWP + lane] = (bf16_t)f2bf(r[i] * eL);
          BT[t * RWP + lane] = (bf16_t)f2bf(bin[i] * einv); KT[t * RWP + lane] = (bf16_t)f2bf(k2[i] * einv);
          const float xb = bin[i] * eh, xk = k2[i] * eh, xv = v[i];
          if (i & 1) { bhp[i >> 1] = pk2(pb, xb); khp[i >> 1] = pk2(pk, xk); vtp[i >> 1] = pk2(pv, xv); atp[i >> 1] = pk2(pa, xa); } else { pb = xb; pk = xk; pv = xv; pa = xa; } }
      *(u32x4*)(BH + lane * RWP + 8 * wave) = (u32x4){bhp[0], bhp[1], bhp[2], bhp[3]};
      *(u32x4*)(KH + lane * RWP + 8 * wave) = (u32x4){khp[0], khp[1], khp[2], khp[3]};
      *(u32x4*)(VT + lane * RWP + 8 * wave) = (u32x4){vtp[0], vtp[1], vtp[2], vtp[3]};
      *(u32x4*)(RHT + (64 + lane) * RWP + 8 * wave) = (u32x4){atp[0], atp[1], atp[2], atp[3]}; }
    __syncthreads();
#pragma unroll
    for (int jj = 0; jj < 2; ++jj) { const int job = wave + 8 * jj, mat = job >> 2, tm = (job >> 1) & 1, tn = job & 1;
        f32x16 acc = {};
        if (!(tm == 0 && tn == 1)) acc = rw_tile((mat & 2) ? RT : AT, (mat & 1) ? KT : BT, tm, tn, r32, hi, acc);
        const int s = 32 * tn + r32;
#pragma unroll
        for (int q = 0; q < 16; ++q) { const int t = 32 * tm + (q & 3) + 8 * (q >> 2) + 4 * hi;
            const bool keep = (mat & 2) ? (s <= t) : (s < t); const float x = keep ? acc[q] : 0.f;
            if (mat == 0) { if (tm == tn) ADG[(tm * 32 + (t & 31)) * 32 + (s & 31)] = x; else if (tm == 1) ABA[(t & 31) * RWP + s] = (bf16_t)f2bf(x); } else { bf16_t* D = (mat == 1) ? AAK : (mat == 2) ? ARB : ARK; D[t * RWP + s] = (bf16_t)f2bf(x); } } }
    __syncthreads();
    if (STOP == 2) return;
    if (wave < 4) { const int tm = wave >> 1, tn = wave & 1; f32x16 acc = {}; acc = rw_tile(VT, AAK, tm, tn, r32, hi, acc);
#pragma unroll
        for (int q = 0; q < 16; ++q) { const int i = 32 * tm + (q & 3) + 8 * (q >> 2) + 4 * hi; RHT[i * RWP + 32 * tn + r32] = (bf16_t)f2bf(acc[q]); } }
    else if (wave == 4) { float d[32]; const LAS float* ab = (const LAS float*)ADG + hi * 1024;
#pragma unroll
        for (int t = 0; t < 32; ++t) d[t] = (t == r32) ? 1.f : 0.f;
#pragma unroll
        for (int t = 1; t < 32; ++t) { float s0 = 0.f, s1 = 0.f;
#pragma unroll
            for (int s4 = 0; s4 < (t + 3) / 4; ++s4) { const f32x4 a4 = *(const LAS f32x4*)(ab + t * 32 + 4 * s4);
                s0 += a4[0] * d[4 * s4]; s1 += a4[1] * d[4 * s4 + 1]; s0 += a4[2] * d[4 * s4 + 2]; s1 += a4[3] * d[4 * s4 + 3]; }
            d[t] += s0 + s1; if ((t & 3) == 3) MEMFENCE(); }
        LAS bf16_t* D = (LAS bf16_t*)DAB + hi * 32 * RWP + r32;
#pragma unroll
        for (int t = 0; t < 32; ++t) D[t * RWP] = (bf16_t)f2bf(d[t]); }
    __syncthreads();
    if (wave < 4) { bf16_t* XT = (wave < 2 ? UVT : W1T) + (32 * (wave & 1)) * RWP;
        const bf16_t* rh = RHT + (32 * wave + r32) * RWP + 8 * hi;
        { f32x16 acc = {}; const bf16_t* da = DAB + r32 * RWP + 8 * hi;
#pragma unroll
          for (int ks = 0; ks < 2; ++ks) acc = MFMA32(ldsb8(rh + 16 * ks), ldsb8(da + 16 * ks), acc);
#pragma unroll
          for (int q = 0; q < 16; ++q) XT[((q & 3) + 8 * (q >> 2) + 4 * hi) * RWP + r32] = (bf16_t)f2bf(acc[q]); }
        WAVE_SYNC();
        { f32x16 acc; const bf16_t* rz = RHT + (32 * wave) * RWP + 32 + r32;
#pragma unroll
          for (int q = 0; q < 16; ++q) acc[q] = bf2f(rz[((q & 3) + 8 * (q >> 2) + 4 * hi) * RWP]);
          const bf16_t* xa = XT + r32 * RWP + 8 * hi; const bf16_t* ba = ABA + r32 * RWP + 8 * hi;
#pragma unroll
          for (int ks = 0; ks < 2; ++ks) acc = MFMA32(ldsb8(xa + 16 * ks), ldsb8(ba + 16 * ks), acc);
#pragma unroll
          for (int q = 0; q < 16; ++q) XT[((q & 3) + 8 * (q >> 2) + 4 * hi) * RWP + 32 + r32] = (bf16_t)f2bf(acc[q]); }
        WAVE_SYNC();
        { f32x16 acc = {}; const bf16_t* xz = XT + r32 * RWP + 32 + 8 * hi; const bf16_t* db = DAB + (32 + r32) * RWP + 8 * hi;
          const bf16x8 z0 = ldsb8(xz), z1 = ldsb8(xz + 16);
          acc = MFMA32(z0, ldsb8(db), acc); acc = MFMA32(z1, ldsb8(db + 16), acc);
          WAVE_SYNC();
#pragma unroll
          for (int q = 0; q < 16; ++q) XT[((q & 3) + 8 * (q >> 2) + 4 * hi) * RWP + 32 + r32] = (bf16_t)f2bf(acc[q]); } }
    __syncthreads();
    if (STOP == 3) return;
    const size_t chunk = (size_t)unit;
#pragma unroll
    for (int jj = 0; jj < 2; ++jj) { const int job = wave + 8 * jj, kind = job >> 2, tm = (job >> 1) & 1, tn = job & 1; f32x16 acc = {};
        const int col = 32 * tn + r32;
        if (kind == 0) { acc = rw_tile(BH, W1T, tm, tn, r32, hi, acc);
            bf16_t* PT = P.rwPT + chunk * 4096;
#pragma unroll
            for (int q = 0; q < 16; ++q) { const int row = 32 * tm + (q & 3) + 8 * (q >> 2) + 4 * hi; const float x = acc[q] + (row == col ? GC[row] : 0.f); PT[row * 64 + col] = (bf16_t)f2bf(x); } }
        else if (kind == 1) { acc = rw_tile(ARB, W1T, tm, tn, r32, hi, acc);
#pragma unroll
            for (int q = 0; q < 16; ++q) { const int t = 32 * tm + (q & 3) + 8 * (q >> 2) + 4 * hi; const float x = acc[q] + bf2f(RT[t * RWP + col]);
                P.rwQ[(size_t)(b * S_ + t0 + t) * 256 + 64 * h + col] = (bf16_t)f2bf(x); } }
        else if (kind == 2) { acc = rw_tile(UVT, BH, tm, tn, r32, hi, acc); acc = rw_tile(VT, KH, tm, tn, r32, hi, acc);
            unsigned* Gg = (unsigned*)(P.rwG + chunk * 4096) + (tm * 2 + tn) * 8 * 64 + lane;
#pragma unroll
            for (int q = 0; q < 8; ++q) Gg[q * 64] = pk2(acc[2 * q], acc[2 * q + 1]); }
        else { acc = rw_tile(ARB, UVT, tm, tn, r32, hi, acc); acc = rw_tile(ARK, VT, tm, tn, r32, hi, acc);
#pragma unroll
            for (int q = 0; q < 16; ++q) { const int t = 32 * tm + (q & 3) + 8 * (q >> 2) + 4 * hi; P.ycat[(size_t)(b * S_ + t0 + t) * 1024 + 64 * h + col] = (bf16_t)f2bf(acc[q]); } } }
    __syncthreads();
}
__device__ __forceinline__ void rw_state_unit(const KP& p, const Ptrs& P, int l, int unit, unsigned char* lds) {
    bf16_t* Sb = (bf16_t*)lds;
    const int tid = TIDX(), lane = tid & 63, wave = tid >> 6, r32 = lane & 31, hi = lane >> 5;
    const int ti = (wave >> 1) & 1, tj = wave & 1;
    f32x16 S = {};
    unsigned gq[8]; bf16x8 pq[4];
    if (wave < 4) { const size_t chunk = (size_t)unit * RW_NCH; const unsigned* Gg = (const unsigned*)(P.rwG + chunk * 4096) + (ti * 2 + tj) * 8 * 64 + lane;
#pragma unroll
        for (int q = 0; q < 8; ++q) gq[q] = Gg[q * 64];
        const bf16_t* pt = P.rwPT + chunk * 4096 + (32 * tj + r32) * 64 + 8 * hi;
#pragma unroll
        for (int ks = 0; ks < 4; ++ks) pq[ks] = *(const bf16x8*)(pt + 16 * ks); }
    for (int c = 0; c < RW_NCH; ++c) { const size_t chunk = (size_t)unit * RW_NCH + c;
        unsigned gn[8]; bf16x8 pn[4];
        if (wave < 4) { const size_t cn = chunk + (c + 1 < RW_NCH ? 1 : 0); const unsigned* Gg = (const unsigned*)(P.rwG + cn * 4096) + (ti * 2 + tj) * 8 * 64 + lane;
#pragma unroll
            for (int q = 0; q < 8; ++q) gn[q] = Gg[q * 64];
            const bf16_t* pt = P.rwPT + cn * 4096 + (32 * tj + r32) * 64 + 8 * hi;
#pragma unroll
            for (int ks = 0; ks < 4; ++ks) pn[ks] = *(const bf16x8*)(pt + 16 * ks);
#pragma unroll
            for (int q = 0; q < 16; ++q) Sb[(32 * ti + (q & 3) + 8 * (q >> 2) + 4 * hi) * RWP + 32 * tj + r32] = (bf16_t)f2bf(S[q]); }
        __syncthreads();
        { const int row = tid >> 3, ch = tid & 7; *(u32x4*)(P.rwS0 + chunk * 4096 + row * 64 + ch * 8) = *(const u32x4*)(Sb + row * RWP + ch * 8); }
        if (wave < 4) { f32x16 acc;
#pragma unroll
            for (int q = 0; q < 8; ++q) { acc[2 * q] = bflo(gq[q]); acc[2 * q + 1] = bfhi(gq[q]); }
            const bf16_t* sa = Sb + (32 * ti + r32) * RWP + 8 * hi;
#pragma unroll
            for (int ks = 0; ks < 4; ++ks) acc = MFMA32(ldsb8(sa + 16 * ks), pq[ks], acc);
            S = acc;
#pragma unroll
            for (int q = 0; q < 8; ++q) gq[q] = gn[q];
#pragma unroll
            for (int ks = 0; ks < 4; ++ks) pq[ks] = pn[ks]; }
        __syncthreads();
    }
}
template <bool DUMMY = false>
__device__ __forceinline__ void rw_out_unit(const KP& p, const Ptrs& P, int l, int unit, unsigned char* lds) {
    MEMFENCE(); OPAQUE_S(unit);
    const int c = unit % RW_NCH, bh = unit / RW_NCH, b = bh >> 2, h = bh & 3, t0 = c * 64;
    float* Yb = (float*)(lds + 81920);
    const int tid = TIDX(), lane = tid & 63, wave = tid >> 6, r32 = lane & 31, hi = lane >> 5;
    float g[8], rkv[8];
#pragma unroll
    for (int i = 0; i < 8; ++i) { const size_t o = (size_t)(b * S_ + t0 + 8 * wave + i) * 256 + 64 * h + lane; g[i] = bf2f(P.rwGt[o]); rkv[i] = bf2f(P.rwRKV[o]); }
    if (wave < 4) { const int tm = wave >> 1, tn = wave & 1; f32x16 acc; const int col = 32 * tn + r32;
        const bf16_t* yl = P.ycat + (size_t)(b * S_ + t0 + 32 * tm) * 1024 + 64 * h + col;
#pragma unroll
        for (int q = 0; q < 16; ++q) acc[q] = bf2f(yl[(size_t)((q & 3) + 8 * (q >> 2) + 4 * hi) * 1024]);
        const bf16_t* qa = P.rwQ + (size_t)(b * S_ + t0 + 32 * tm + r32) * 256 + 64 * h + 8 * hi; const bf16_t* sb = P.rwS0 + (size_t)unit * 4096 + (32 * tn + r32) * 64 + 8 * hi;
#pragma unroll
        for (int ks = 0; ks < 4; ++ks) acc = MFMA32(*(const bf16x8*)(qa + 16 * ks), *(const bf16x8*)(sb + 16 * ks), acc);
#pragma unroll
        for (int q = 0; q < 16; ++q) Yb[(32 * tm + (q & 3) + 8 * (q >> 2) + 4 * hi) * 64 + col] = acc[q]; }
    __syncthreads();
    const float gng = p.in[I_LNXG][l * 256 + 64 * h + lane], gnb = p.in[I_LNXB][l * 256 + 64 * h + lane];
    { float yv[8], m1[8], m2[8];
#pragma unroll
      for (int i = 0; i < 8; ++i) { yv[i] = Yb[(8 * wave + i) * 64 + lane]; m1[i] = yv[i]; }
      wave_sum_n<8>(m1);
#pragma unroll
      for (int i = 0; i < 8; ++i) { yv[i] -= m1[i] * (1.f / 64.f); m2[i] = yv[i] * yv[i]; }
      wave_sum_n<8>(m2);
#pragma unroll
      for (int i = 0; i < 8; ++i) { const int t = 8 * wave + i; const float yn = yv[i] * (1.0f / sqrtf(m2[i] * (1.f / 64.f) + GN_EPS_)) * gng + gnb; const float o = (yn + rkv[i]) * g[i];
        if (DUMMY) P.pb[(size_t)(b * S_ + t0 + t) * 256 + 64 * h + lane] = (bf16_t)f2bf(o);
        else P.ycat[(size_t)(b * S_ + t0 + t) * 1024 + 64 * h + lane] = (bf16_t)f2bf(o); } }
    __syncthreads();
}
#ifdef EMU_FP8_A
#define EMU_AUX77 u.aux = 77;
#else
#define EMU_AUX77
#endif
__device__ __forceinline__ void tile_map(int L, int nM, int nN, int& pm, int& pn) {
    const int nwg = nM * nN, q = nwg / 8, r = nwg % 8, xcd = L % 8, off = L / 8;
    const int wgid = (xcd < r ? xcd * (q + 1) : r * (q + 1) + (xcd - r) * q) + off;
    const int nig = 8 * nN, gid = wgid / nig, fm = gid * 8, gsz = (nM - fm) < 8 ? (nM - fm) : 8;
    pm = fm + ((wgid % nig) % gsz); pn = (wgid % nig) / gsz;
}
struct EpiStoreBf16 {
    bf16_t* base0; int ldc0; bf16_t* base1; int ldc1;
    __device__ __forceinline__ void operator()(const f32x4 (&acc)[2][2][4][2], const pg8::Unit& u, int wr, int wc, int fr, int fq, int tid) const {
        bf16_t* base = u.kind ? base1 : base0; const int ldc = u.kind ? ldc1 : ldc0;
        int row0 = u.pm * 256 + wr * 64 + fr, col0 = u.pn * 256 + wc * 32 + 8 * fq; OPAQUE(row0); OPAQUE(col0);
#pragma unroll
        for (int ai = 0; ai < 2; ++ai)
#pragma unroll
            for (int m = 0; m < 4; ++m) { bf16_t* rowp = base + (size_t)(row0 + ai * 128 + m * 16) * ldc + col0;
#pragma unroll
                for (int bj = 0; bj < 2; ++bj) { const f32x4 v0 = acc[ai][bj][m][0], v1 = acc[ai][bj][m][1];
                    u32x4 w; w.x = pk2(v0[0], v0[1]); w.y = pk2(v0[2], v0[3]); w.z = pk2(v1[0], v1[1]); w.w = pk2(v1[2], v1[3]);
                    *(u32x4*)(rowp + bj * 128) = w; } }
    }
};
template <int PART>
struct SchedA { const bf16_t* hb; const unsigned char* h8a; const unsigned char* h8b; const bf16_t* WinT; int G, c;
    __device__ __forceinline__ bool next(int i, pg8::Unit& u) const {
        const int nM = T_ / 256, n0 = nM * 9; u.aux = 0;
        if (PART == 0) { const int x = i * G + c; if (x >= n0) return false;
            tile_map(x, nM, 9, u.pm, u.pn); u.kind = 0; u.nt = 8; u.f8 = 1; const int m0 = u.pm * 256;
            u.a = (const char*)(m0 < H8_SPLIT ? h8a + (size_t)m0 * 1024 : h8b + (size_t)(m0 - H8_SPLIT) * 1024); u.b = (const char*)(WinT + (size_t)u.pn * 256 * 1024); }
        else { const int x = i * G + (c + G - n0 % G) % G; if (x >= nM) return false;
            u.pm = 0; u.pn = x; u.kind = 1; u.nt = 8; u.f8 = 1; const int m0 = x * 256;
            u.a = (const char*)(WinT + (size_t)WIN_VT * 1024); u.b = (const char*)(m0 < H8_SPLIT ? h8a + (size_t)m0 * 1024 : h8b + (size_t)(m0 - H8_SPLIT) * 1024); }
        return true; } };
struct EpiA { bf16_t* proj; const float* sc;
    __device__ __forceinline__ void operator()(const f32x4 (&acc)[2][2][4][2], const pg8::Unit& u, int wr, int wc, int fr, int fq, int tid) const {
        int row0 = u.pm * 256 + wr * 64 + fr, col0 = u.pn * 256 + wc * 32 + 8 * fq; OPAQUE(row0); OPAQUE(col0);
#pragma unroll
        for (int bj = 0; bj < 2; ++bj) { const f32x4 s0 = *(const f32x4*)(sc + col0 + bj * 128), s1 = *(const f32x4*)(sc + col0 + bj * 128 + 4);
#pragma unroll
            for (int ai = 0; ai < 2; ++ai)
#pragma unroll
                for (int m = 0; m < 4; ++m) { const f32x4 v0 = acc[ai][bj][m][0] * s0, v1 = acc[ai][bj][m][1] * s1;
                    u32x4 w; w.x = pk2(v0[0], v0[1]); w.y = pk2(v0[2], v0[3]); w.z = pk2(v1[0], v1[1]); w.w = pk2(v1[2], v1[3]);
                    *(u32x4*)(proj + (size_t)(row0 + ai * 128 + m * 16) * PJ + col0 + bj * 128) = w; } }
    }
};
struct EpiVt { bf16_t* vtr; const float* sc;
    __device__ __forceinline__ void operator()(const f32x4 (&acc)[2][2][4][2], const pg8::Unit& u, int wr, int wc, int fr, int fq, int tid) const {
        int row0 = wr * 64 + fr, col0 = u.pn * 256 + wc * 32 + 8 * fq; OPAQUE(row0); OPAQUE(col0);
#pragma unroll
        for (int ai = 0; ai < 2; ++ai)
#pragma unroll
            for (int m = 0; m < 4; ++m) { const int row = row0 + ai * 128 + m * 16; const float s = sc[row];
#pragma unroll
                for (int bj = 0; bj < 2; ++bj) { const f32x4 v0 = acc[ai][bj][m][0] * s, v1 = acc[ai][bj][m][1] * s;
                    u32x4 w; w.x = pk2(v0[0], v0[1]); w.y = pk2(v0[2], v0[3]); w.z = pk2(v1[0], v1[1]); w.w = pk2(v1[2], v1[3]);
                    *(u32x4*)(vtr + (size_t)row * T_ + col0 + bj * 128) = w; } }
    }
};
__device__ __forceinline__ void phase_A0(const KP& p, unsigned char* lds) {
    const int tid = TIDX(), lane = tid & 63, wave = tid >> 6; const int gw = BIDX() * NWAVE + wave, NGW = GDIM() * NWAVE;
    for (int r = gw; r < L_ * WIN_GATE; r += NGW) { const int l = r / WIN_GATE, n = r % WIN_GATE; const Ptrs P = make_ptrs(p.ws, l); bf16_t* row = P.WinT + (size_t)n * 1024;
        const u32x4 a = *(const u32x4*)(row + 16 * lane), b = *(const u32x4*)(row + 16 * lane + 8);
        float v[16] = {bflo(a.x), bfhi(a.x), bflo(a.y), bfhi(a.y), bflo(a.z), bfhi(a.z), bflo(a.w), bfhi(a.w), bflo(b.x), bfhi(b.x), bflo(b.y), bfhi(b.y), bflo(b.z), bfhi(b.z), bflo(b.w), bfhi(b.w)};
        float am = 0.f;
#pragma unroll
        for (int j = 0; j < 16; ++j) am = fmaxf(am, fabsf(v[j]));
        am = wave_max(am); const float sc = am > 0.f ? am * (1.0f / 440.0f) : 1.0f, inv = 1.0f / sc; u32x4 o;
#pragma unroll
        for (int j = 0; j < 4; ++j) { unsigned w = cvt_pk_fp8_f32_(v[4 * j] * inv, v[4 * j + 1] * inv, 0u, false); w = cvt_pk_fp8_f32_(v[4 * j + 2] * inv, v[4 * j + 3] * inv, w, true); o[j] = w; }
        WAVE_SYNC();
        *(u32x4*)((unsigned char*)row + 16 * lane) = o;
        if (lane == 0) P.gscA[n] = sc; }
#ifdef CPU_EMU
    (void)lds;
#endif
}
__device__ __forceinline__ void phase_A(const KP& p, int l, unsigned char* lds) {
    const Ptrs P = make_ptrs(p.ws, l);
    { SchedA<0> S{P.hb, P.h8a, P.h8b, P.WinT, GDIM(), BIDX()}; EpiA E{P.proj, P.gscA}; pg8::gemm_phase<1>((LAS unsigned char*)lds, 1024, 1024, S, E, 1024); }
    { SchedA<1> S{P.hb, P.h8a, P.h8b, P.WinT, GDIM(), BIDX()}; EpiVt E{P.vtr, P.gscA + WIN_VT}; pg8::gemm_phase<1>((LAS unsigned char*)lds, 1024, 512, S, E, 2048); }
}
#if PROBE_REPEAT >= 40 && PROBE_REPEAT <= 49
struct SchedAP { const bf16_t* hb; const bf16_t* WinT; int G, c, nt, pnmask;
    __device__ __forceinline__ bool next(int i, pg8::Unit& u) const {
        const int nM = T_ / 256, n0 = nM * 9; const int x = i * G + c; if (x >= n0 + nM) return false;
        u.nt = nt; u.aux = 0; u.f8 = 0;
        if (x < n0) { tile_map(x, nM, 9, u.pm, u.pn); u.kind = 0; u.a = (const char*)(hb + (size_t)u.pm * 256 * 1024); u.b = (const char*)(WinT + (size_t)u.pn * 256 * 1024); }
        else { u.pm = 0; u.pn = x - n0; u.kind = 1; u.a = (const char*)(WinT + (size_t)WIN_VT * 1024); u.b = (const char*)(hb + (size_t)u.pn * 256 * 1024); }
        u.pn &= pnmask; return true; } };
struct EpiNull { float* d;
    __device__ __forceinline__ void operator()(const f32x4 (&acc)[2][2][4][2], const pg8::Unit& u, int wr, int wc, int fr, int fq, int tid) const {
        f32x4 s = (f32x4){0.f, 0.f, 0.f, 0.f};
#pragma unroll
        for (int ai = 0; ai < 2; ++ai)
#pragma unroll
            for (int m = 0; m < 4; ++m)
#pragma unroll
                for (int bj = 0; bj < 2; ++bj) s += acc[ai][bj][m][0] + acc[ai][bj][m][1];
        if (s.x + s.y + s.z + s.w == 1.2345e30f) d[tid] = s.x; } };
struct EpiStash { u32x4* stash;
    __device__ __forceinline__ void operator()(const f32x4 (&acc)[2][2][4][2], const pg8::Unit& u, int wr, int wc, int fr, int fq, int tid) const {
        OPAQUE(tid);
#pragma unroll
        for (int ai = 0; ai < 2; ++ai)
#pragma unroll
            for (int m = 0; m < 4; ++m)
#pragma unroll
                for (int bj = 0; bj < 2; ++bj) { const f32x4 v0 = acc[ai][bj][m][0], v1 = acc[ai][bj][m][1];
                    u32x4 w; w.x = pk2(v0[0], v0[1]); w.y = pk2(v0[2], v0[3]); w.z = pk2(v1[0], v1[1]); w.w = pk2(v1[2], v1[3]);
                    stash[((ai * 4 + m) * 2 + bj) * 512 + tid] = w; } } };
struct EpiFullLine { bf16_t* base;
    __device__ __forceinline__ void operator()(const f32x4 (&acc)[2][2][4][2], const pg8::Unit& u, int wr, int wc, int fr, int fq, int tid) const {
        OPAQUE(tid); if (u.kind) return;
#pragma unroll
        for (int ai = 0; ai < 2; ++ai)
#pragma unroll
            for (int m = 0; m < 4; ++m)
#pragma unroll
                for (int bj = 0; bj < 2; ++bj) { const f32x4 v0 = acc[ai][bj][m][0], v1 = acc[ai][bj][m][1]; const int k = (ai * 4 + m) * 2 + bj, L = k * 512 + tid, row = L >> 5, ch = L & 31;
                    u32x4 w; w.x = pk2(v0[0], v0[1]); w.y = pk2(v0[2], v0[3]); w.z = pk2(v1[0], v1[1]); w.w = pk2(v1[2], v1[3]);
                    *(u32x4*)(base + (size_t)(u.pm * 256 + row) * PJ + u.pn * 256 + ch * 8) = w; } } };
struct EpiProjOnly { bf16_t* base;
    __device__ __forceinline__ void operator()(const f32x4 (&acc)[2][2][4][2], const pg8::Unit& u, int wr, int wc, int fr, int fq, int tid) const {
        if (u.kind) return;
        int row0 = u.pm * 256 + wr * 64 + fr, col0 = u.pn * 256 + wc * 32 + 8 * fq; OPAQUE(row0); OPAQUE(col0);
#pragma unroll
        for (int ai = 0; ai < 2; ++ai)
#pragma unroll
            for (int m = 0; m < 4; ++m) { bf16_t* rowp = base + (size_t)(row0 + ai * 128 + m * 16) * PJ + col0;
#pragma unroll
                for (int bj = 0; bj < 2; ++bj) { const f32x4 v0 = acc[ai][bj][m][0], v1 = acc[ai][bj][m][1];
                    u32x4 w; w.x = pk2(v0[0], v0[1]); w.y = pk2(v0[2], v0[3]); w.z = pk2(v1[0], v1[1]); w.w = pk2(v1[2], v1[3]);
                    *(u32x4*)(rowp + bj * 128) = w; } } } };
template <int V>
__device__ __forceinline__ void phase_Aprobe(const KP& p, int l, unsigned char* lds) {
    const Ptrs P = make_ptrs(p.ws, l);
    SchedAP S{P.hb, P.WinT, GDIM(), BIDX(), V == 1 ? 32 : V == 3 ? 4 : V == 4 ? 8 : V == 5 ? 64 : 16, V == 6 ? 3 : 0xffff};
    if (V == 7) { EpiFullLine E{P.proj}; pg8::gemm_phase((LAS unsigned char*)lds, 1024, 1024, S, E); }
    else if (V == 8) { EpiProjOnly E{P.proj}; pg8::gemm_phase((LAS unsigned char*)lds, 1024, 1024, S, E); }
    else if (V == 2) { EpiStash E{(u32x4*)(P.ycat + (size_t)BIDX() * 65536)}; pg8::gemm_phase((LAS unsigned char*)lds, 1024, 1024, S, E); }
    else if (V == 6) { EpiStoreBf16 E{P.ycat, 1024, P.ycat, 1024}; pg8::gemm_phase((LAS unsigned char*)lds, 1024, 1024, S, E); }
    else { EpiNull E{(float*)(P.ycat + (size_t)BIDX() * 65536)}; pg8::gemm_phase((LAS unsigned char*)lds, 1024, 1024, S, E); }
}
#endif
struct SchedGlu { const bf16_t* ycat; const bf16_t* GluT; int G, c;
    __device__ __forceinline__ bool next(int i, pg8::Unit& u) const {
        const int x = i * G + c; if (x >= T_ / 256) return false;
        u.pm = x; u.pn = 0; u.nt = 4; u.kind = 0; u.aux = 0; u.f8 = 0; u.a = (const char*)(ycat + (size_t)x * 256 * 1024 + 256); u.b = (const char*)GluT; return true; } };
struct EpiGlu { bf16_t* ycat; const float* glub;
    __device__ __forceinline__ void operator()(const f32x4 (&acc)[2][2][4][2], const pg8::Unit& u, int wr, int wc, int fr, int fq, int tid) const {
        int row0 = u.pm * 256 + wr * 64 + fr, col0 = wc * 32 + 8 * fq; OPAQUE(row0); OPAQUE(col0);
#pragma unroll
        for (int bj = 0; bj < 2; ++bj) { const f32x4 b0 = *(const f32x4*)(glub + col0 + bj * 128), b1 = *(const f32x4*)(glub + col0 + bj * 128 + 4);
#pragma unroll
            for (int ai = 0; ai < 2; ++ai)
#pragma unroll
                for (int m = 0; m < 4; ++m) { bf16_t* ptr = ycat + (size_t)(row0 + ai * 128 + m * 16) * 1024 + 256 + col0 + bj * 128;
                    const u32x4 y = *(const u32x4*)ptr; const f32x4 v0 = acc[ai][bj][m][0] + b0, v1 = acc[ai][bj][m][1] + b1;
                    u32x4 w; w.x = pk2(bflo(y.x) * sigmoidf_(v0[0]), bfhi(y.x) * sigmoidf_(v0[1])); w.y = pk2(bflo(y.y) * sigmoidf_(v0[2]), bfhi(y.y) * sigmoidf_(v0[3]));
                    w.z = pk2(bflo(y.z) * sigmoidf_(v1[0]), bfhi(y.z) * sigmoidf_(v1[1])); w.w = pk2(bflo(y.w) * sigmoidf_(v1[2]), bfhi(y.w) * sigmoidf_(v1[3]));
                    *(u32x4*)ptr = w; MEMFENCE(); } }
    }
};
__device__ __forceinline__ void convert_tables(const KP& p, const Ptrs& P, int l, unsigned char* lds) {
    const int tid = TIDX(), lane = tid & 63, wave = tid >> 6;
    unsigned* cnt = (unsigned*)(p.ws + WS_CTL) + 10240 + 16 * l; int* slot = (int*)(lds + 65536);
    const float* ps = p.in[I_P] + (size_t)l * T_ * 256;
    constexpr int NG8 = 6144 / 128, NTAB = 2 * NEXP / 128, NPB = (int)(((size_t)T_ * 256 / 8 + 4095) / 4096);
    for (;;) {
        __syncthreads(); if (tid == 0) *slot = (int)atomicAdd(cnt, 1u); __syncthreads();
        int item = *slot; if (item >= NG8 + NTAB + NPB) break;
        if (item < NG8) {
            for (int rr = wave; rr < 128; rr += NWAVE) { const int r5 = item * 128 + rr; bf16_t* row = r5 < 4096 ? P.WinT + (size_t)(WIN_GATE + r5) * 1024 : r5 < 5120 ? P.PleGT + (size_t)(r5 - 4096) * 1024 : P.WoutT + (size_t)(r5 - 5120) * 1024;
                const u32x4 a = *(const u32x4*)(row + 16 * lane), b = *(const u32x4*)(row + 16 * lane + 8);
                float v[16] = {bflo(a.x), bfhi(a.x), bflo(a.y), bfhi(a.y), bflo(a.z), bfhi(a.z), bflo(a.w), bfhi(a.w), bflo(b.x), bfhi(b.x), bflo(b.y), bfhi(b.y), bflo(b.z), bfhi(b.z), bflo(b.w), bfhi(b.w)};
                float am = 0.f;
#pragma unroll
                for (int j = 0; j < 16; ++j) am = fmaxf(am, fabsf(v[j]));
                am = wave_max(am); const float sc = am > 0.f ? am * (1.0f / 440.0f) : 1.0f, inv = 1.0f / sc; u32x4 o;
#pragma unroll
                for (int j = 0; j < 4; ++j) { unsigned w = cvt_pk_fp8_f32_(v[4 * j] * inv, v[4 * j + 1] * inv, 0u, false); w = cvt_pk_fp8_f32_(v[4 * j + 2] * inv, v[4 * j + 3] * inv, w, true); o[j] = w; }
                WAVE_SYNC();
                *(u32x4*)((unsigned char*)row + 16 * lane) = o;
                if (lane == 0) P.gsc[r5] = sc; }
            continue; }
        item -= NG8;
        if (item < NTAB) {
            for (int r4 = 0; r4 < 16; r4 += 4) { f32x4 v[4][4]; float am[4];
#pragma unroll
                for (int q = 0; q < 4; ++q) { const int it = item * 128 + wave + 8 * (r4 + q); const int tb = it >= NEXP, row = tb ? it - NEXP : it;
                    const float* src = p.in[tb ? I_V : I_U] + ((size_t)l * NEXP + row) * 1024 + 16 * lane; am[q] = 0.f;
#pragma unroll
                    for (int j = 0; j < 4; ++j) { v[q][j] = *(const f32x4*)(src + 4 * j); am[q] = fmaxf(am[q], fmaxf(fmaxf(fabsf(v[q][j].x), fabsf(v[q][j].y)), fmaxf(fabsf(v[q][j].z), fabsf(v[q][j].w)))); } }
#pragma unroll
                for (int q = 0; q < 4; ++q) { const int it = item * 128 + wave + 8 * (r4 + q); const int tb = it >= NEXP, row = tb ? it - NEXP : it;
                    const float amx = wave_max(am[q]); const float sc = amx > 0.f ? amx * (1.0f / 440.0f) : 1.0f, inv = 1.0f / sc; u32x4 o;
#pragma unroll
                    for (int j = 0; j < 4; ++j) { unsigned w = cvt_pk_fp8_f32_(v[q][j].x * inv, v[q][j].y * inv, 0u, false); w = cvt_pk_fp8_f32_(v[q][j].z * inv, v[q][j].w * inv, w, true); o[j] = w; }
                    *(u32x4*)((tb ? P.V8 : P.U8) + ((size_t)(lane >> 3) * NEXP + row) * 128 + 16 * (lane & 7)) = o;
                    if (lane == 0) (tb ? P.sv : P.su)[row] = sc; } }
        } else {
            const size_t base = (size_t)(item - NTAB) * 4096;
            f32x4 a[8], bq[8];
#pragma unroll
            for (int j = 0; j < 8; ++j) { const size_t i = base + tid + (size_t)j * NTHR; a[j] = (f32x4){0.f, 0.f, 0.f, 0.f}; bq[j] = a[j];
                if (i < (size_t)T_ * 256 / 8) { a[j] = *(const f32x4*)(ps + i * 8); bq[j] = *(const f32x4*)(ps + i * 8 + 4); } }
#pragma unroll
            for (int j = 0; j < 8; ++j) { const size_t i = base + tid + (size_t)j * NTHR;
                if (i < (size_t)T_ * 256 / 8) { u32x4 o; o.x = pk2(a[j].x, a[j].y); o.y = pk2(a[j].z, a[j].w); o.z = pk2(bq[j].x, bq[j].y); o.w = pk2(bq[j].z, bq[j].w); *(u32x4*)(P.pb + i * 8) = o; } }
        }
    }
}
__device__ __forceinline__ void phase_B2(const KP& p, int l, unsigned char* lds) {
    const Ptrs P = make_ptrs(p.ws, l);
    constexpr int NRW = NB_ * 4; const int G = GDIM(), c = BIDX();
    int gG = G, gc = c;
    if (G > NRW) { if (c < NRW) { rw_state_unit(p, P, l, c, lds);
#if PROBE_REPEAT == 35
        rw_state_unit(p, P, l, c, lds);
#endif
        convert_tables(p, P, l, lds); return; } gG = G - NRW; gc = c - NRW; }
    else { for (int u = c; u < NRW; u += G) rw_state_unit(p, P, l, u, lds); }
    SchedGlu S{P.ycat, P.GluT, gG, gc};
    EpiGlu E{P.ycat, p.in[I_GLUB] + l * 256};
    pg8::gemm_phase((LAS unsigned char*)lds, 1024, 256, S, E);
    convert_tables(p, P, l, lds);
}
struct SchedC { const unsigned char* h8a; const unsigned char* h8b; const bf16_t* ycat; const bf16_t* WinT; const bf16_t* WbrT; int G, c;
    __device__ __forceinline__ bool next(int i, pg8::Unit& u) const {
        const int tile = (i >> 3) * G + c; if (tile >= (T_ / 256) * 4) return false;
        const int j = i & 7, b = j >> 1; tile_map(tile, T_ / 256, 4, u.pm, u.pn); u.aux = b;
        if (!(j & 1)) { u.kind = 0; u.nt = 4; u.f8 = 0; u.a = (const char*)(ycat + (size_t)u.pm * 256 * 1024 + 256 * b); u.b = (const char*)(WbrT + (size_t)u.pn * 256 * 1024 + 256 * b); }
        else { u.kind = 1; u.nt = 8; u.f8 = 1; const int m0 = u.pm * 256;
            u.a = (const char*)(m0 < H8_SPLIT ? h8a + (size_t)m0 * 1024 : h8b + (size_t)(m0 - H8_SPLIT) * 1024); u.b = (const char*)(WinT + (size_t)(WIN_GATE + 1024 * b + 256 * u.pn) * 1024); }
        return true; } };
struct EpiC { u32x4* stash; bf16_t* merged; const float* gsc; unsigned char* m8;
    __device__ __forceinline__ void operator()(const f32x4 (&acc)[2][2][4][2], const pg8::Unit& u, int wr, int wc, int fr, int fq, int tid) const {
        OPAQUE(tid);
        if (u.kind == 0) {
#pragma unroll
            for (int ai = 0; ai < 2; ++ai)
#pragma unroll
                for (int m = 0; m < 4; ++m)
#pragma unroll
                    for (int bj = 0; bj < 2; ++bj) { const f32x4 v0 = acc[ai][bj][m][0], v1 = acc[ai][bj][m][1];
                        u32x4 w; w.x = pk2(v0[0], v0[1]); w.y = pk2(v0[2], v0[3]); w.z = pk2(v1[0], v1[1]); w.w = pk2(v1[2], v1[3]);
                        stash[((ai * 4 + m) * 2 + bj) * 512 + tid] = w; }
        } else {
            int row0 = u.pm * 256 + wr * 64 + fr, col0 = u.pn * 256 + wc * 32 + 8 * fq; OPAQUE(row0); OPAQUE(col0); const bool first = (u.aux == 0);
            f32x4 sc[2][2];
#pragma unroll
            for (int bj = 0; bj < 2; ++bj) { const float* sp = gsc + 1024 * u.aux + col0 + bj * 128; sc[bj][0] = *(const f32x4*)sp; sc[bj][1] = *(const f32x4*)(sp + 4); }
#pragma unroll
            for (int ai = 0; ai < 2; ++ai)
#pragma unroll
                for (int mp = 0; mp < 2; ++mp) { u32x4 y[4], mo[4];
#pragma unroll
                    for (int q = 0; q < 4; ++q) { const int m = 2 * mp + (q >> 1), bj = q & 1;
                        y[q] = stash[((ai * 4 + m) * 2 + bj) * 512 + tid]; mo[q] = (u32x4){0u, 0u, 0u, 0u};
                        if (!first) mo[q] = *(const u32x4*)(merged + (size_t)(row0 + ai * 128 + m * 16) * 1024 + col0 + bj * 128); }
#pragma unroll
                    for (int q = 0; q < 4; ++q) { const int m = 2 * mp + (q >> 1), bj = q & 1; const f32x4 g0 = acc[ai][bj][m][0] * sc[bj][0], g1 = acc[ai][bj][m][1] * sc[bj][1];
                        bf16_t* ptr = merged + (size_t)(row0 + ai * 128 + m * 16) * 1024 + col0 + bj * 128;
                        const float o0 = bflo(y[q].x) * sigmoidf_(g0[0]) + bflo(mo[q].x), o1 = bfhi(y[q].x) * sigmoidf_(g0[1]) + bfhi(mo[q].x), o2 = bflo(y[q].y) * sigmoidf_(g0[2]) + bflo(mo[q].y), o3 = bfhi(y[q].y) * sigmoidf_(g0[3]) + bfhi(mo[q].y);
                        const float o4 = bflo(y[q].z) * sigmoidf_(g1[0]) + bflo(mo[q].z), o5 = bfhi(y[q].z) * sigmoidf_(g1[1]) + bfhi(mo[q].z), o6 = bflo(y[q].w) * sigmoidf_(g1[2]) + bflo(mo[q].w), o7 = bfhi(y[q].w) * sigmoidf_(g1[3]) + bfhi(mo[q].w);
                        u32x4 w; w.x = pk2(o0, o1); w.y = pk2(o2, o3); w.z = pk2(o4, o5); w.w = pk2(o6, o7);
                        *(u32x4*)ptr = w;
                        if (u.aux == 3) { u32x2 w8; w8.x = cvt_pk_fp8_f32_(o0, o1, 0u, false); w8.x = cvt_pk_fp8_f32_(o2, o3, w8.x, true); w8.y = cvt_pk_fp8_f32_(o4, o5, 0u, false); w8.y = cvt_pk_fp8_f32_(o6, o7, w8.y, true);
                            *(u32x2*)(m8 + (size_t)(row0 + ai * 128 + m * 16) * 1024 + col0 + bj * 128) = w8; } }
                    MEMFENCE(); }
        }
    }
};
__device__ __forceinline__ void phase_C(const KP& p, int l, unsigned char* lds) {
    const Ptrs P = make_ptrs(p.ws, l);
    SchedC S{P.h8a, P.h8b, P.ycat, P.WinT, P.WbrT, GDIM(), BIDX()};
    EpiC E{(u32x4*)(P.stash + (size_t)BIDX() * 131072), P.merged, P.gsc, P.h8e};
    pg8::gemm_phase<2>((LAS unsigned char*)lds, 1024, 1024, S, E, 1024);
}
struct SchedD { const unsigned char* A8; const bf16_t* Bt; int nN, G, c;
    __device__ __forceinline__ bool next(int i, pg8::Unit& u) const {
        const int x = i * G + c; if (x >= (T_ / 256) * nN) return false;
        tile_map(x, T_ / 256, nN, u.pm, u.pn); u.nt = 8; u.kind = 0; u.aux = 0; u.f8 = 1; u.a = (const char*)(A8 + (size_t)u.pm * 256 * 1024); u.b = (const char*)(Bt + (size_t)u.pn * 256 * 1024); return true; } };
struct EpiResid { bf16_t* ob; const bf16_t* hb; const float* sc;
    __device__ __forceinline__ void operator()(const f32x4 (&acc)[2][2][4][2], const pg8::Unit& u, int wr, int wc, int fr, int fq, int tid) const {
        int row0 = u.pm * 256 + wr * 64 + fr, col0 = u.pn * 256 + wc * 32 + 8 * fq; OPAQUE(row0); OPAQUE(col0);
#pragma unroll
        for (int ai = 0; ai < 2; ++ai)
#pragma unroll
            for (int m = 0; m < 4; ++m)
#pragma unroll
                for (int bj = 0; bj < 2; ++bj) { const size_t o = (size_t)(row0 + ai * 128 + m * 16) * 1024 + col0 + bj * 128; const u32x4 hw = *(const u32x4*)(hb + o);
                    const f32x4 a0 = acc[ai][bj][m][0] * *(const f32x4*)(sc + col0 + bj * 128), a1 = acc[ai][bj][m][1] * *(const f32x4*)(sc + col0 + bj * 128 + 4); u32x4 w;
                    w.x = pk2(bflo(hw.x) * DN_ALPHA_ + a0[0], bfhi(hw.x) * DN_ALPHA_ + a0[1]); w.y = pk2(bflo(hw.y) * DN_ALPHA_ + a0[2], bfhi(hw.y) * DN_ALPHA_ + a0[3]);
                    w.z = pk2(bflo(hw.z) * DN_ALPHA_ + a1[0], bfhi(hw.z) * DN_ALPHA_ + a1[1]); w.w = pk2(bflo(hw.w) * DN_ALPHA_ + a1[2], bfhi(hw.w) * DN_ALPHA_ + a1[3]);
                    *(u32x4*)(ob + o) = w; }
    }
};
__device__ __forceinline__ void phase_D(const KP& p, int l, unsigned char* lds) {
    const Ptrs P = make_ptrs(p.ws, l);
    SchedD S{P.h8e, P.WoutT, 4, GDIM(), BIDX()};
    EpiResid E{P.ycat, P.hb, P.gsc + 5120};
    pg8::gemm_phase<1>((LAS unsigned char*)lds, 1024, 1024, S, E, 1024);
}
__device__ __forceinline__ void phase_D2(const KP& p, int l, unsigned char* lds) {
    const Ptrs P = make_ptrs(p.ws, l);
    const int tid = TIDX(), lane = tid & 63, wave = tid >> 6; const int gw = BIDX() * NWAVE + wave, NGW = GDIM() * NWAVE;
    for (int m = 4 * gw; m < T_; m += 4 * NGW) ln_rows<4, true>(P.ycat + (size_t)m * 1024, p.in[I_LN1G] + l * 1024, p.in[I_LN1B] + l * 1024, (float*)nullptr, P.hb + (size_t)m * 1024, P.h8e + (size_t)m * 1024, lane);
}
struct SchedE1 { const bf16_t* pb; const bf16_t* PleT; int G, c;
    __device__ __forceinline__ bool next(int i, pg8::Unit& u) const {
        const int x = i * G + c; if (x >= (T_ / 256) * 4) return false;
        tile_map(x, T_ / 256, 4, u.pm, u.pn); u.nt = 4; u.kind = 0; u.aux = 0; u.f8 = 0; u.a = (const char*)(pb + (size_t)u.pm * 256 * 256); u.b = (const char*)(PleT + (size_t)u.pn * 256 * 256); return true; } };
template <int PART>
struct SchedE2 { const bf16_t* hb; const unsigned char* h8e; const bf16_t* PleGT; const bf16_t* WqT; int G, c;
    __device__ __forceinline__ bool next(int i, pg8::Unit& u) const {
        const int n0 = (T_ / 256) * 4; int x = i * G + c + (PART ? n0 : 0); if (x >= (PART ? n0 + (T_ / 256) * 8 : n0)) return false;
        u.aux = 0;
        if (x < n0) { tile_map(x, T_ / 256, 4, u.pm, u.pn); u.kind = 0; u.nt = 8; u.f8 = 1; u.b = (const char*)(PleGT + (size_t)u.pn * 256 * 1024); u.a = (const char*)(h8e + (size_t)u.pm * 256 * 1024); }
        else { x -= n0; tile_map(x, T_ / 256, 8, u.pm, u.pn); u.kind = 1; u.nt = 16; u.f8 = 0; u.b = (const char*)(WqT + (size_t)u.pn * 256 * 1024); u.a = (const char*)(hb + (size_t)u.pm * 256 * 1024); }
        return true; } };
struct EpiE2g { const bf16_t* hb; bf16_t* Pbuf; const float* gsc;
    __device__ __forceinline__ void operator()(const f32x4 (&acc)[2][2][4][2], const pg8::Unit& u, int wr, int wc, int fr, int fq, int tid) const {
        int row0 = u.pm * 256 + wr * 64 + fr, col0 = u.pn * 256 + wc * 32 + 8 * fq; OPAQUE(row0); OPAQUE(col0);
#pragma unroll
        for (int bj = 0; bj < 2; ++bj) { const float* sp = gsc + 4096 + col0 + bj * 128; const f32x4 s0 = *(const f32x4*)sp, s1 = *(const f32x4*)(sp + 4);
            const size_t cb = (size_t)row0 * 1024 + col0 + bj * 128; const bf16_t* hp = hb + cb; bf16_t* pp = Pbuf + cb;
#pragma unroll
            for (int ai = 0; ai < 2; ++ai)
#pragma unroll
                for (int mp = 0; mp < 2; ++mp) { u32x4 y[2], hw[2];
#pragma unroll
                    for (int q = 0; q < 2; ++q) { const int ro = (ai * 128 + (2 * mp + q) * 16) * 1024; y[q] = *(const u32x4*)(pp + ro); hw[q] = *(const u32x4*)(hp + ro); }
#pragma unroll
                    for (int q = 0; q < 2; ++q) { const int m = 2 * mp + q; const int ro = (ai * 128 + m * 16) * 1024; const f32x4 v0 = acc[ai][bj][m][0] * s0, v1 = acc[ai][bj][m][1] * s1;
                        u32x4 w;
                        w.x = pk2(bflo(hw[q].x) * DN_ALPHA_ + bflo(y[q].x) * sigmoidf_(v0[0]), bfhi(hw[q].x) * DN_ALPHA_ + bfhi(y[q].x) * sigmoidf_(v0[1]));
                        w.y = pk2(bflo(hw[q].y) * DN_ALPHA_ + bflo(y[q].y) * sigmoidf_(v0[2]), bfhi(hw[q].y) * DN_ALPHA_ + bfhi(y[q].y) * sigmoidf_(v0[3]));
                        w.z = pk2(bflo(hw[q].z) * DN_ALPHA_ + bflo(y[q].z) * sigmoidf_(v1[0]), bfhi(hw[q].z) * DN_ALPHA_ + bfhi(y[q].z) * sigmoidf_(v1[1]));
                        w.w = pk2(bflo(hw[q].w) * DN_ALPHA_ + bflo(y[q].w) * sigmoidf_(v1[2]), bfhi(hw[q].w) * DN_ALPHA_ + bfhi(y[q].w) * sigmoidf_(v1[3]));
                        *(u32x4*)(pp + ro) = w; }
                    MEMFENCE(); } }
    }
};
__device__ __forceinline__ void phase_E(const KP& p, int l, unsigned char* lds) {
    const Ptrs P = make_ptrs(p.ws, l);
    { SchedE1 S{P.pb, P.PleT, GDIM(), BIDX()}; EpiStoreBf16 E{P.ycat, 1024, P.ycat, 1024}; pg8::gemm_phase((LAS unsigned char*)lds, 256, 256, S, E); }
    { SchedE2<0> S{P.hb, P.h8e, P.PleGT, P.WqT, GDIM(), BIDX()}; EpiE2g E{P.hb, P.ycat, P.gsc}; pg8::gemm_phase<1>((LAS unsigned char*)lds, 1024, 1024, S, E, 1024); }
    { SchedE2<1> S{P.hb, P.h8e, P.PleGT, P.WqT, GDIM(), BIDX()}; EpiStoreBf16 E{P.q, 2048, P.q, 2048}; pg8::gemm_phase<0>((LAS unsigned char*)lds, 1024, 1024, S, E); }
}
__device__ __forceinline__ unsigned mono_key(float f) { const unsigned u = __builtin_bit_cast(unsigned, f); return (u & 0x80000000u) ? ~u : (u | 0x80000000u); }
__device__ __forceinline__ float unmono_key(unsigned k) { const unsigned u = (k & 0x80000000u) ? (k ^ 0x80000000u) : ~k; return __builtin_bit_cast(float, u); }
struct CandTab { int a[50], b[50]; };
constexpr CandTab make_cand() { CandTab t{}; int n = 0; for (int a = 0; a < 16; ++a) for (int b = 0; b < 16; ++b) if ((a + 1) * (b + 1) <= 16) { t.a[n] = a; t.b[n] = b; ++n; } return t; }
constexpr CandTab CAND = make_cand();
constexpr int PK_PITCH = 136;

#define PK_CE(x, y) do { const unsigned _a = (x), _b = (y); (x) = _a > _b ? _a : _b; (y) = _a > _b ? _b : _a; } while (0)
__device__ __forceinline__ void bitonic_merge16_desc(unsigned (&a)[16]) {
#pragma unroll
    for (int j = 8; j > 0; j >>= 1)
#pragma unroll
        for (int i = 0; i < 16; ++i) { const int l = i ^ j; if (l > i) PK_CE(a[i], a[l]); }
}
__device__ __forceinline__ void bitonic_sort16_desc(unsigned (&a)[16]) {
#pragma unroll
    for (int k = 2; k <= 16; k <<= 1)
#pragma unroll
        for (int j = k >> 1; j > 0; j >>= 1)
#pragma unroll
            for (int i = 0; i < 16; ++i) { const int l = i ^ j; if (l > i) { if ((i & k) == 0 || k == 16) PK_CE(a[i], a[l]); else PK_CE(a[l], a[i]); } }
}
__device__ __forceinline__ void top_half_merge16(unsigned (&a)[16], const unsigned (&b)[16]) {
#pragma unroll
    for (int i = 0; i < 16; ++i) a[i] = a[i] > b[15 - i] ? a[i] : b[15 - i];
    bitonic_merge16_desc(a);
}
__device__ __forceinline__ void top16_keys(const unsigned (&key)[64], unsigned (&top)[16]) {
    unsigned g0[16], g1[16], g2[16], g3[16];
#pragma unroll
    for (int i = 0; i < 16; ++i) { g0[i] = key[i]; g1[i] = key[16 + i]; g2[i] = key[32 + i]; g3[i] = key[48 + i]; }
    bitonic_sort16_desc(g0); bitonic_sort16_desc(g1); bitonic_sort16_desc(g2); bitonic_sort16_desc(g3);
    top_half_merge16(g0, g1); top_half_merge16(g2, g3); top_half_merge16(g0, g2);
    unsigned pr[16];
#pragma unroll
    for (int i = 0; i < 16; ++i) pr[i] = (unsigned)__shfl_xor((int)g0[i], 32);
    top_half_merge16(g0, pr);
#pragma unroll
    for (int i = 0; i < 16; ++i) top[i] = g0[i];
}
__device__ __forceinline__ void peer_route_unit(const KP& p, const Ptrs& P, int l, int unit, unsigned char* lds) {
    const bf16_t* Ks = (const bf16_t*)lds;
    const int tid = TIDX(), lane = tid & 63, wave = tid >> 6, r32 = lane & 31, hi = lane >> 5;
    const int tok = unit * 32 + r32;
    int kbase = r32 * PK_PITCH + 8 * hi; OPAQUE(kbase);
    unsigned top1[16], top2[16];
#pragma unroll 1
    for (int half = 0; half < 2; ++half) {
        const bf16_t* qp = P.q + (size_t)tok * 2048 + wave * 256 + half * 128 + 8 * hi;
        bf16x8 qf[8];
#pragma unroll
        for (int ks = 0; ks < 8; ++ks) qf[ks] = *(const bf16x8*)(qp + 16 * ks);
        unsigned key[64];
#pragma unroll
        for (int kt = 0; kt < 4; ++kt) { f32x16 acc = {}; const bf16_t* kp = Ks + (half * 128 + 32 * kt) * PK_PITCH + kbase;
#pragma unroll
            for (int ks = 0; ks < 8; ++ks) { const bf16x8 a = *(const bf16x8*)(kp + 16 * ks); acc = MFMA32(a, qf[ks], acc); }
#pragma unroll
            for (int r = 0; r < 16; ++r) { const int idx = 32 * kt + (r & 3) + 8 * (r >> 2) + 4 * hi; key[16 * kt + r] = (mono_key(acc[r]) & ~127u) | (unsigned)(127 - idx); } }
        if (half == 0) top16_keys(key, top1); else top16_keys(key, top2);
        MEMFENCE();
    }
    MEMFENCE();
    int* islot = (int*)(lds + 2 * 128 * PK_PITCH * 2) + (wave * 32 + r32) * 33;
    float v1[16], v2[16];
#pragma unroll
    for (int r = 0; r < 16; ++r) { v1[r] = unmono_key(top1[r] & ~127u); v2[r] = unmono_key(top2[r] & ~127u); islot[16 * hi + r] = 127 - (int)((hi ? top2[r] : top1[r]) & 127u); }
    unsigned ka[16], kb[16];
#pragma unroll
    for (int i = 0; i < 25; ++i) { const int c0 = 2 * i, c1 = 2 * i + 1;
        const float s = hi ? (v1[CAND.a[c1]] + v2[CAND.b[c1]]) : (v1[CAND.a[c0]] + v2[CAND.b[c0]]);
        const unsigned k = (mono_key(s) & ~255u) | (unsigned)(255 - (hi ? 16 * CAND.a[c1] + CAND.b[c1] : 16 * CAND.a[c0] + CAND.b[c0]));
        if (i < 16) ka[i] = k; else kb[i - 16] = k; }
#pragma unroll
    for (int i = 9; i < 16; ++i) kb[i] = 0u;
    bitonic_sort16_desc(ka); bitonic_sort16_desc(kb); top_half_merge16(ka, kb);
    { unsigned pr[16];
#pragma unroll
      for (int i = 0; i < 16; ++i) pr[i] = (unsigned)__shfl_xor((int)ka[i], 32);
      top_half_merge16(ka, pr); }
    WAVE_SYNC();
    float sc[16]; int se[16];
#pragma unroll
    for (int r = 0; r < 16; ++r) { sc[r] = unmono_key(ka[r] & ~255u); se[r] = 0; }
#pragma unroll
    for (int r = 0; r < 8; ++r) { unsigned mlo = ka[r], mhi = ka[8 + r]; OPAQUE(mlo); OPAQUE(mhi);
        const unsigned m = hi ? mhi : mlo; const int ab = 255 - (int)(m & 255u); const int e = islot[ab >> 4] * 128 + islot[16 + (ab & 15)];
        if (hi) se[8 + r] = e; else se[r] = e; }
    WAVE_SYNC();
    float g[16]; float sum = 0.f;
#pragma unroll
    for (int r = 0; r < 16; ++r) { g[r] = __expf(sc[r] - sc[0]); sum += g[r]; }
    const float inv = 1.0f / sum;
    const size_t ob = (size_t)tok * 128 + wave * 16 + 8 * hi;
    if (hi == 0) {
        *(u32x4*)(P.eid + ob) = (u32x4){(unsigned)se[0], (unsigned)se[1], (unsigned)se[2], (unsigned)se[3]}; *(u32x4*)(P.eid + ob + 4) = (u32x4){(unsigned)se[4], (unsigned)se[5], (unsigned)se[6], (unsigned)se[7]};
        *(f32x4*)(P.gate + ob) = (f32x4){g[0] * inv, g[1] * inv, g[2] * inv, g[3] * inv}; *(f32x4*)(P.gate + ob + 4) = (f32x4){g[4] * inv, g[5] * inv, g[6] * inv, g[7] * inv};
    } else {
        *(u32x4*)(P.eid + ob) = (u32x4){(unsigned)se[8], (unsigned)se[9], (unsigned)se[10], (unsigned)se[11]}; *(u32x4*)(P.eid + ob + 4) = (u32x4){(unsigned)se[12], (unsigned)se[13], (unsigned)se[14], (unsigned)se[15]};
        *(f32x4*)(P.gate + ob) = (f32x4){g[8] * inv, g[9] * inv, g[10] * inv, g[11] * inv}; *(f32x4*)(P.gate + ob + 4) = (f32x4){g[12] * inv, g[13] * inv, g[14] * inv, g[15] * inv};
    }
}
__device__ __forceinline__ void phase_F(const KP& p, int l, unsigned char* lds) {
    const Ptrs P = make_ptrs(p.ws, l);
    bf16_t* Ks = (bf16_t*)lds; const int tid = TIDX();
    for (int e = tid; e < 2 * 128 * 16; e += NTHR) { const int row = e >> 4, ch = e & 15; *(u32x4*)(Ks + row * PK_PITCH + ch * 8) = *(const u32x4*)(P.K12 + row * 128 + ch * 8); }
    __syncthreads();
    for (int u = BIDX(); u < T_ / 32; u += GDIM()) peer_route_unit(p, P, l, u, lds);
    __syncthreads();
}
constexpr int PG_TB = (T_ >= 4096 ? 128 : 64), PG_NBLK = T_ / PG_TB;
__device__ __forceinline__ int peer_next_item(unsigned* cnt, int* slot, int tid) {
    __syncthreads();
    if (tid == 0) *slot = (int)atomicAdd(cnt, 1u);
    __syncthreads();
    return *slot;
}
constexpr int PG_TPW = PG_TB / NWAVE;
static_assert(PG_TPW >= 4 && PG_TPW % 2 == 0, "token pipeline depth");
constexpr int PG_WLDS = 6144;
__device__ __forceinline__ void pg_issue_rows(const unsigned char* T8, int x, int c8, int gq, int lane, int e0, int e1, int* E, u32x4 (&rb)[16]) {
    WAVE_SYNC(); E[lane] = e0; E[64 + lane] = e1; WAVE_SYNC();
#pragma unroll
    for (int k = 0; k < 16; ++k) { const unsigned off = ((unsigned)(x * NEXP) + (unsigned)E[gq + 8 * k]) * 128u + 16u * (unsigned)c8; rb[k] = *(const u32x4*)(T8 + off); }
}
template <bool REFILL, int TAG>
__device__ __forceinline__ void pg_dots_compute(const Ptrs& P, int x, int t, u32x4 (&ub)[16], u32x4 xa, u32x4 xb, float* R, const int* E, int c8, int gq, int lane) {
    const f32x2 x0 = (f32x2){bflo(xa.x), bfhi(xa.x)}, x1 = (f32x2){bflo(xa.y), bfhi(xa.y)}, x2 = (f32x2){bflo(xa.z), bfhi(xa.z)}, x3 = (f32x2){bflo(xa.w), bfhi(xa.w)};
    const f32x2 x4 = (f32x2){bflo(xb.x), bfhi(xb.x)}, x5 = (f32x2){bflo(xb.y), bfhi(xb.y)}, x6 = (f32x2){bflo(xb.z), bfhi(xb.z)}, x7 = (f32x2){bflo(xb.w), bfhi(xb.w)};
    WAVE_SYNC();
    unsigned off[8];
    const unsigned char* ubase = P.U8;
#pragma unroll
    for (int k = 0; k < 16; ++k) { PIN1(ub[k]);
        if (REFILL && (k & 7) == 0) {
#pragma unroll
            for (int j = 0; j < 8; ++j) off[j] = ((unsigned)(x * NEXP) + (unsigned)E[gq + 8 * (k + j)]) * 128u + 16u * (unsigned)c8; }
        f32x2 s = cvt_pk_f32_fp8_(ub[k][0], false) * x0; s += cvt_pk_f32_fp8_(ub[k][0], true) * x1; s += cvt_pk_f32_fp8_(ub[k][1], false) * x2; s += cvt_pk_f32_fp8_(ub[k][1], true) * x3;
        s += cvt_pk_f32_fp8_(ub[k][2], false) * x4; s += cvt_pk_f32_fp8_(ub[k][2], true) * x5; s += cvt_pk_f32_fp8_(ub[k][3], false) * x6; s += cvt_pk_f32_fp8_(ub[k][3], true) * x7;
        R[k * 64 + lane] = s.x + s.y;
        if (REFILL) { GLOAD16_RW_S(ub[k], ubase, off[k & 7]); }
        if (TAG) TAG_B(); else TAG_A();
        SCHED_FENCE(); }
    WAVE_SYNC();
    const f32x4 a0 = *(const f32x4*)(R + 8 * lane), a1 = *(const f32x4*)(R + 8 * lane + 4), b0 = *(const f32x4*)(R + 512 + 8 * lane), b1 = *(const f32x4*)(R + 512 + 8 * lane + 4);
    float* pd = P.pd + ((size_t)x * T_ + t) * 128;
    pd[lane] = ((a0[0] + a0[1]) + (a0[2] + a0[3])) + ((a1[0] + a1[1]) + (a1[2] + a1[3]));
    pd[64 + lane] = ((b0[0] + b0[1]) + (b0[2] + b0[3])) + ((b1[0] + b1[1]) + (b1[2] + b1[3]));
}
#define PG_PIN16(v) do { _Pragma("unroll") for (int _k = 0; _k < 16; ++_k) PIN1(v[_k]); } while (0)
__device__ __forceinline__ void peer_dots_item(const Ptrs& P, int x, int blk, unsigned char* lds, int lane, int wave) {
    float* R = (float*)(lds + wave * PG_WLDS); int* E = (int*)(lds + wave * PG_WLDS + 4096);
    const int gq = lane >> 3, c8 = lane & 7, tb = blk * PG_TB + PG_TPW * wave;
    u32x4 uA[16], uB[16], xa0, xb0, xa1, xb1;
    const bf16_t* hbase = P.hb; const int* ebase = P.eid; const unsigned char* ubase = P.U8;
    const unsigned xo = (unsigned)((tb * 1024 + 128 * x + 16 * c8) * 2), eo = (unsigned)((tb * 128 + lane) * 4);
    int ea0, ea1, eb0, eb1;
    { const int* ep = P.eid + (size_t)tb * 128 + lane; ea0 = ep[0]; ea1 = ep[64]; eb0 = ep[128]; eb1 = ep[192]; }
    WAVE_SYNC(); E[lane] = ea0; E[64 + lane] = ea1; WAVE_SYNC();
#pragma unroll
    for (int k = 0; k < 16; ++k) { const unsigned off = ((unsigned)(x * NEXP) + (unsigned)E[gq + 8 * k]) * 128u + 16u * (unsigned)c8; GLOAD16_S(uA[k], ubase, off); }
    GLOAD16_S(xa0, hbase, xo); GLOAD16_S(xb0, hbase, xo + 16u); GLOAD4_S(ea0, ebase, eo + 2u * 512u); GLOAD4_S(ea1, ebase, eo + 2u * 512u + 256u);
    WAVE_SYNC(); E[lane] = eb0; E[64 + lane] = eb1; WAVE_SYNC();
#pragma unroll
    for (int k = 0; k < 16; ++k) { const unsigned off = ((unsigned)(x * NEXP) + (unsigned)E[gq + 8 * k]) * 128u + 16u * (unsigned)c8; GLOAD16_S(uB[k], ubase, off); }
    GLOAD16_S(xa1, hbase, xo + 2048u); GLOAD16_S(xb1, hbase, xo + 2048u + 16u); GLOAD4_S(eb0, ebase, eo + 3u * 512u); GLOAD4_S(eb1, ebase, eo + 3u * 512u + 256u);
#pragma unroll
    for (int i = 0; i < PG_TPW; i += 2) {
        if (i == 0) WAIT_VM(20); else WAIT_VM(22);
        PIN4(xa0, xb0, ea0, ea1);
        if (i + 2 < PG_TPW) { WAVE_SYNC(); E[lane] = ea0; E[64 + lane] = ea1; WAVE_SYNC();
            pg_dots_compute<true, 0>(P, x, tb + i, uA, xa0, xb0, R, E, c8, gq, lane);
            const unsigned nx = (unsigned)((i + 4 < PG_TPW) ? i + 4 : PG_TPW - 1), xo2 = xo + (unsigned)(i + 2) * 2048u;
            GLOAD16_S(xa0, hbase, xo2); GLOAD16_S(xb0, hbase, xo2 + 16u); GLOAD4_S(ea0, ebase, eo + nx * 512u); GLOAD4_S(ea1, ebase, eo + nx * 512u + 256u); }
        else pg_dots_compute<false, 0>(P, x, tb + i, uA, xa0, xb0, R, E, c8, gq, lane);
        if (i + 2 < PG_TPW) WAIT_VM(22); else WAIT_VM(0);
        PIN4(xa1, xb1, eb0, eb1);
        if (i + 3 < PG_TPW) { WAVE_SYNC(); E[lane] = eb0; E[64 + lane] = eb1; WAVE_SYNC();
            pg_dots_compute<true, 1>(P, x, tb + i + 1, uB, xa1, xb1, R, E, c8, gq, lane);
            const unsigned nx = (unsigned)((i + 5 < PG_TPW) ? i + 5 : PG_TPW - 1), xo2 = xo + (unsigned)(i + 3) * 2048u;
            GLOAD16_S(xa1, hbase, xo2); GLOAD16_S(xb1, hbase, xo2 + 16u); GLOAD4_S(eb0, ebase, eo + nx * 512u); GLOAD4_S(eb1, ebase, eo + nx * 512u + 256u); }
        else pg_dots_compute<false, 1>(P, x, tb + i + 1, uB, xa1, xb1, R, E, c8, gq, lane);
    }
}
template <bool REFILL, int TAG>
__device__ __forceinline__ void pg_acc_compute(const Ptrs& P, bf16_t* outp, int x, int t, u32x4 (&vb)[16], float w0, float w1, unsigned oprev, float* C, float* W, const int* E, int c8, int gq, int lane) {
    WAVE_SYNC(); W[lane] = w0; W[64 + lane] = w1; WAVE_SYNC();
    f32x2 acc[8];
#pragma unroll
    for (int q = 0; q < 8; ++q) acc[q] = (f32x2){0.f, 0.f};
    unsigned off[8]; const unsigned char* vbase = P.V8; float wk[16];
#pragma unroll
    for (int k = 0; k < 16; ++k) wk[k] = W[gq + 8 * k];
#pragma unroll
    for (int k = 0; k < 16; ++k) { PIN1(vb[k]);
        if (REFILL && (k & 7) == 0) {
#pragma unroll
            for (int j = 0; j < 8; ++j) off[j] = ((unsigned)(x * NEXP) + (unsigned)E[gq + 8 * (k + j)]) * 128u + 16u * (unsigned)c8; }
#pragma unroll
        for (int q = 0; q < 4; ++q) { acc[2 * q] += cvt_pk_f32_fp8_(vb[k][q], false) * wk[k]; acc[2 * q + 1] += cvt_pk_f32_fp8_(vb[k][q], true) * wk[k]; }
        if (REFILL) {
#pragma unroll
            for (int q = 0; q < 8; ++q) PIN1(acc[q]);
            GLOAD16_RW_S(vb[k], vbase, off[k & 7]); }
        if (TAG) TAG_B(); else TAG_A();
        SCHED_FENCE(); }
    WAVE_SYNC();
#pragma unroll
    for (int q = 0; q < 4; ++q) *(f32x4*)(C + lane * 16 + 4 * q) = (f32x4){acc[2 * q].x, acc[2 * q].y, acc[2 * q + 1].x, acc[2 * q + 1].y};
    WAVE_SYNC();
    f32x2 s = (f32x2){0.f, 0.f};
#pragma unroll
    for (int g = 0; g < 8; ++g) s += *(const f32x2*)(C + g * 128 + 2 * lane);
    *(unsigned*)(outp + (size_t)t * 1024 + 128 * x + 2 * lane) = pk2(bflo(oprev) + s.x, bfhi(oprev) + s.y);
}
__device__ __forceinline__ void peer_acc_item(bf16_t* outp, const Ptrs& P, int x, int blk, unsigned char* lds, int lane, int wave) {
    float* C = (float*)(lds + wave * PG_WLDS); int* E = (int*)(lds + wave * PG_WLDS + 4096); float* W = (float*)(lds + wave * PG_WLDS + 4608);
    const int gq = lane >> 3, c8 = lane & 7, tb = blk * PG_TB + PG_TPW * wave;
    u32x4 vA[16], vB[16]; unsigned oA, oB; float wa0, wa1, wb0, wb1; int ea0, ea1, eb0, eb1;
    const int* ebase = P.eid; const float* wbase = P.gate; const bf16_t* obase = outp; const unsigned char* vbase = P.V8;
    const unsigned eo = (unsigned)((tb * 128 + lane) * 4), oo = (unsigned)((tb * 1024 + 128 * x + 2 * lane) * 2);
    { const int* ep = P.eid + (size_t)tb * 128 + lane; ea0 = ep[0]; ea1 = ep[64]; eb0 = ep[128]; eb1 = ep[192]; }
    WAVE_SYNC(); E[lane] = ea0; E[64 + lane] = ea1; WAVE_SYNC();
#pragma unroll
    for (int k = 0; k < 16; ++k) { const unsigned off = ((unsigned)(x * NEXP) + (unsigned)E[gq + 8 * k]) * 128u + 16u * (unsigned)c8; GLOAD16_S(vA[k], vbase, off); }
    GLOAD4_S(wa0, wbase, eo); GLOAD4_S(wa1, wbase, eo + 256u); GLOAD4_S(oA, obase, oo); GLOAD4_S(ea0, ebase, eo + 2u * 512u); GLOAD4_S(ea1, ebase, eo + 2u * 512u + 256u);
    WAVE_SYNC(); E[lane] = eb0; E[64 + lane] = eb1; WAVE_SYNC();
#pragma unroll
    for (int k = 0; k < 16; ++k) { const unsigned off = ((unsigned)(x * NEXP) + (unsigned)E[gq + 8 * k]) * 128u + 16u * (unsigned)c8; GLOAD16_S(vB[k], vbase, off); }
    GLOAD4_S(wb0, wbase, eo + 512u); GLOAD4_S(wb1, wbase, eo + 512u + 256u); GLOAD4_S(oB, obase, oo + 2048u); GLOAD4_S(eb0, ebase, eo + 3u * 512u); GLOAD4_S(eb1, ebase, eo + 3u * 512u + 256u);
#pragma unroll
    for (int i = 0; i < PG_TPW; i += 2) {
        if (i == 0) WAIT_VM(21); else WAIT_VM(22);
        PIN4(wa0, wa1, ea0, ea1); PIN1(oA);
        if (i + 2 < PG_TPW) { WAVE_SYNC(); E[lane] = ea0; E[64 + lane] = ea1; WAVE_SYNC();
            pg_acc_compute<true, 0>(P, outp, x, tb + i, vA, wa0, wa1, oA, C, W, E, c8, gq, lane);
            const unsigned nx = (unsigned)((i + 4 < PG_TPW) ? i + 4 : PG_TPW - 1);
            GLOAD4_S(wa0, wbase, eo + (unsigned)(i + 2) * 512u); GLOAD4_S(wa1, wbase, eo + (unsigned)(i + 2) * 512u + 256u); GLOAD4_S(oA, obase, oo + (unsigned)(i + 2) * 2048u);
            GLOAD4_S(ea0, ebase, eo + nx * 512u); GLOAD4_S(ea1, ebase, eo + nx * 512u + 256u); }
        else pg_acc_compute<false, 0>(P, outp, x, tb + i, vA, wa0, wa1, oA, C, W, E, c8, gq, lane);
        if (i + 2 < PG_TPW) WAIT_VM(22); else WAIT_VM(0);
        PIN4(wb0, wb1, eb0, eb1); PIN1(oB);
        if (i + 3 < PG_TPW) { WAVE_SYNC(); E[lane] = eb0; E[64 + lane] = eb1; WAVE_SYNC();
            pg_acc_compute<true, 1>(P, outp, x, tb + i + 1, vB, wb0, wb1, oB, C, W, E, c8, gq, lane);
            const unsigned nx = (unsigned)((i + 5 < PG_TPW) ? i + 5 : PG_TPW - 1);
            GLOAD4_S(wb0, wbase, eo + (unsigned)(i + 3) * 512u); GLOAD4_S(wb1, wbase, eo + (unsigned)(i + 3) * 512u + 256u); GLOAD4_S(oB, obase, oo + (unsigned)(i + 3) * 2048u);
            GLOAD4_S(eb0, ebase, eo + nx * 512u); GLOAD4_S(eb1, ebase, eo + nx * 512u + 256u); }
        else pg_acc_compute<false, 1>(P, outp, x, tb + i + 1, vB, wb0, wb1, oB, C, W, E, c8, gq, lane);
    }
}
template <int STAGE, int CSET = STAGE>
__device__ __forceinline__ void phase_G12(const KP& p, int l, unsigned char* lds) {
    const Ptrs P = make_ptrs(p.ws, l);
    const int tid = TIDX(), lane = tid & 63, wave = tid >> 6;
    int* slot = (int*)(lds + 8 * PG_WLDS);
    const int myx = XCC_ID();
    for (int s = 0; s < 8; ++s) { const int x = (myx + s) & 7; unsigned* cnt = P.qcnt + (CSET * 8 + x) * 16;
        for (;;) { const int blk = peer_next_item(cnt, slot, tid); if (blk >= PG_NBLK) break;
            if (STAGE == 0) peer_dots_item(P, x, blk, lds, lane, wave); else peer_acc_item(CSET == 3 ? (bf16_t*)P.pd : P.ycat, P, x, blk, lds, lane, wave); } }
    __syncthreads();
}
__device__ __forceinline__ void phase_G1b(const KP& p, int l, unsigned char* lds) {
    const Ptrs P = make_ptrs(p.ws, l);
    const size_t stride = (size_t)GDIM() * NTHR, n = (size_t)T_ * 128;
    for (size_t i0 = (size_t)BIDX() * NTHR + TIDX(); i0 < n; i0 += 4 * stride) { float d[4], gt[4], su[4], sv[4]; int e[4];
#pragma unroll
        for (int q = 0; q < 4; ++q) { const size_t i = i0 + q * stride; e[q] = 0; gt[q] = 0.f; d[q] = 0.f; if (i < n) { e[q] = P.eid[i]; gt[q] = P.gate[i]; } }
#pragma unroll
        for (int q = 0; q < 4; ++q) { const size_t i = i0 + q * stride; su[q] = P.su[e[q]]; sv[q] = P.sv[e[q]];
            if (i < n) {
#pragma unroll
                for (int x = 0; x < 8; ++x) d[q] += P.pd[(size_t)x * T_ * 128 + i]; } }
#pragma unroll
        for (int q = 0; q < 4; ++q) { const size_t i = i0 + q * stride; if (i < n) P.gate[i] = gt[q] * sv[q] * gelu_erf(d[q] * su[q]); } }
#ifdef CPU_EMU
    (void)lds;
#endif
}
__device__ __forceinline__ void phase_G3(const KP& p, int l, unsigned char* lds, bool last) {
    const Ptrs P = make_ptrs(p.ws, l);
    const int tid = TIDX(), lane = tid & 63, wave = tid >> 6; const int gw = BIDX() * NWAVE + wave, NGW = GDIM() * NWAVE;
    for (int m = 4 * gw; m < T_; m += 4 * NGW) ln_rows<4, true>(P.ycat + (size_t)m * 1024, p.in[I_LN2G] + l * 1024, p.in[I_LN2B] + l * 1024, last ? p.out + (size_t)m * 1024 : (float*)nullptr, last ? (bf16_t*)nullptr : P.hb + (size_t)m * 1024,
                                                           last ? (unsigned char*)nullptr : (m < H8_SPLIT ? P.h8a + (size_t)m * 1024 : P.h8b + (size_t)(m - H8_SPLIT) * 1024), lane);
}
#ifndef PROBE_REPEAT
#define PROBE_REPEAT 0
#endif
constexpr int LDS_BYTES = 147456;
__device__ __forceinline__ void phase_B1(const KP& p, int l, unsigned char* lds) {
    const Ptrs P = make_ptrs(p.ws, l);
    constexpr int NRC = NB_ * 4 * RW_NCH, NS5 = NB_ * 16, NFX = NB_ * 4 * (S_ / 256), NCV = T_ / 64;
    const int G = GDIM(); int it = BIDX();
    for (; it < NRC; it += G) rw_chunk_unit(p, P, l, it, lds);
#if PROBE_REPEAT == 16
    for (int j = BIDX(); j < NRC; j += G) rw_chunk_unit(p, P, l, j, lds);
#endif
#if PROBE_REPEAT >= 161 && PROBE_REPEAT <= 163
    for (int j = BIDX(); j < NRC; j += G) { rw_chunk_unit<PROBE_REPEAT - 160>(p, P, l, j, lds); __syncthreads(); }
#endif
    for (; it < NRC + NFX; it += G) fox_unit(p, P, l, it - NRC, lds);
#if PROBE_REPEAT == 17
    for (int j = BIDX(); j < NFX; j += G) fox_unit(p, P, l, j, lds);
#endif
    for (; it < NRC + NFX + NS5; it += G) s5_unit(p, P, l, it - NRC - NFX, lds);
#if PROBE_REPEAT == 18
    for (int j = BIDX(); j < NS5; j += G) s5_unit(p, P, l, j, lds);
#endif
    for (; it < NRC + NFX + NS5 + NCV; it += G) conv_unit(p, P, l, it - NRC - NFX - NS5, lds);
#if PROBE_REPEAT == 19
    for (int j = BIDX(); j < NCV; j += G) conv_unit(p, P, l, j, lds);
#endif
}
__device__ __forceinline__ void phase_B3(const KP& p, int l, unsigned char* lds) {
    const Ptrs P = make_ptrs(p.ws, l);
#if PROBE_REPEAT == 34
    for (int it = BIDX(); it < NB_ * 4 * RW_NCH; it += GDIM()) rw_out_unit<true>(p, P, l, it, lds);
#endif
    for (int it = BIDX(); it < NB_ * 4 * RW_NCH; it += GDIM()) rw_out_unit<false>(p, P, l, it, lds);
}
enum { PH_PRO = 0, PH_A, PH_B1, PH_B2, PH_B3, PH_C, PH_D, PH_D2, PH_E, PH_F, PH_G, PH_G1B, PH_G2, PH_G3, PH_N, PH_A0 };
__device__ __forceinline__ void run_phase(const KP& p, int ph, int l, unsigned char* lds) {
    switch (ph) {
        case PH_PRO: phase_prologue(p, lds); break;
        case PH_A: phase_A(p, l, lds); break;
        case PH_A0: phase_A0(p, lds); break;
        case PH_B1: phase_B1(p, l, lds); break;
        case PH_B2: phase_B2(p, l, lds); break;
        case PH_B3: phase_B3(p, l, lds); break;
        case PH_C: phase_C(p, l, lds); break;
        case PH_D: phase_D(p, l, lds); break;
        case PH_D2: phase_D2(p, l, lds); break;
        case PH_E: phase_E(p, l, lds); break;
        case PH_F: phase_F(p, l, lds); break;
        case PH_G: phase_G12<0>(p, l, lds); break;
        case PH_G1B: phase_G1b(p, l, lds); break;
        case PH_G2: phase_G12<1>(p, l, lds); break;
        case PH_G3: phase_G3(p, l, lds, l == L_ - 1); break;
        default: break;
    }
}
#ifndef CPU_EMU
#define XB_TMO      128
#define XB_XCNT(j)  (256  + 64 * (j))
#define XB_XSUB(j)  (1280 + 64 * (j))
#define XB_XGEN(j)  (2304 + 64 * (j))
#define XB_TOP      3328
#define XB_TOPGEN   3392
#define XCD_BAR_WORDS 3456
#define XB_SPIN_CAP (1u << 22)
__device__ __forceinline__ unsigned xb_ld(unsigned* p)              { return __hip_atomic_load(p, __ATOMIC_RELAXED, __HIP_MEMORY_SCOPE_AGENT); }
__device__ __forceinline__ unsigned xb_add(unsigned* p, unsigned v) { return __hip_atomic_fetch_add(p, v, __ATOMIC_RELAXED, __HIP_MEMORY_SCOPE_AGENT); }
__device__ __forceinline__ unsigned xb_xcc_id() { return (unsigned)__builtin_amdgcn_s_getreg((3 << 11) | 20) & 0xFu; }
#define XB_SPIN(cond, bar) do { unsigned _sp = 0; while (cond) { __builtin_amdgcn_s_sleep(1); \
    if ((++_sp & 255u) == 0u) { if (xb_ld(&(bar)[XB_TMO])) break; if (_sp > XB_SPIN_CAP) { atomicAdd(&(bar)[XB_TMO], 1u); break; } } } } while (0)
struct XcdBarrier { unsigned* bar; unsigned x; volatile LAS unsigned* st; };
__device__ __forceinline__ XcdBarrier xcd_barrier_post(unsigned* bar, volatile LAS unsigned* st) {
    XcdBarrier b; b.bar = bar; b.x = xb_xcc_id(); b.st = st;
    if (threadIdx.x == 0) (void)xb_add(&bar[XB_XCNT(b.x)], 1u);
    return b;
}
__device__ __forceinline__ void xcd_barrier_complete(unsigned* bar, unsigned x, unsigned& nloc, unsigned& nx) {
    const unsigned G = gridDim.x * gridDim.y * gridDim.z;
    unsigned sum, cnt, mine, sp = 0u;
    for (;;) {
        sum = 0u; cnt = 0u; mine = 0u;
#pragma unroll
        for (unsigned j = 0; j < 16; ++j) { const unsigned c = xb_ld(&bar[XB_XCNT(j)]); sum += c; cnt += (c > 0u) ? 1u : 0u; mine = (j == x) ? c : mine; }
        if (sum == G) break;
        __builtin_amdgcn_s_sleep(1);
        if ((++sp & 255u) == 0u) { if (xb_ld(&bar[XB_TMO])) break; if (sp > XB_SPIN_CAP) { atomicAdd(&bar[XB_TMO], 1u); break; } }
    }
    nloc = mine > 0u ? mine : 1u; nx = cnt > 0u ? cnt : 1u;
}
__device__ __forceinline__ void xcd_barrier(const XcdBarrier& b) {
    asm volatile("s_waitcnt vmcnt(0)" ::: "memory");
    __syncthreads();
    if (threadIdx.x == 0) {
        unsigned* bar = b.bar;
        __builtin_amdgcn_s_waitcnt(0);
        unsigned nloc = b.st[0], nx = b.st[1];
        if (nloc == 0u) { xcd_barrier_complete(bar, b.x, nloc, nx); b.st[0] = nloc; b.st[1] = nx; }
        const unsigned old = xb_add(&bar[XB_XSUB(b.x)], 1u);
        const unsigned gen = old / nloc;
        if (old + 1u == (gen + 1u) * nloc) {
            __builtin_amdgcn_fence(__ATOMIC_RELEASE, "agent");
            asm volatile("s_waitcnt vmcnt(0)" ::: "memory");
            const unsigned og = xb_add(&bar[XB_TOP], 1u);
            const unsigned tg = og / nx;
            if (og + 1u == (tg + 1u) * nx) xb_add(&bar[XB_TOPGEN], 1u);
            else XB_SPIN(xb_ld(&bar[XB_TOPGEN]) == tg, bar);
            __builtin_amdgcn_fence(__ATOMIC_ACQUIRE, "agent");
            xb_add(&bar[XB_XGEN(b.x)], 1u);
            asm volatile("s_waitcnt vmcnt(0)" ::: "memory");
        } else {
            XB_SPIN(xb_ld(&bar[XB_XGEN(b.x)]) == gen, bar);
            __builtin_amdgcn_fence(__ATOMIC_ACQUIRE, "agent");
            asm volatile("s_waitcnt vmcnt(0)" ::: "memory");
        }
    }
    __syncthreads();
}
#ifndef PROBE_REPEAT
#define PROBE_REPEAT 0
#endif
#ifndef N_LAUNCH_MODE
#define N_LAUNCH_MODE 1
#endif
extern __shared__ __attribute__((aligned(16))) unsigned char lds_dyn[];
#if N_LAUNCH_MODE == 0
template <int PH> __global__ void __launch_bounds__(NTHR, 2) k_phase_t(KP p) { run_phase(p, PH, p.layer, lds_dyn); }
typedef void (*kfn_t)(KP);
static kfn_t phase_fn(int ph) { switch (ph) { case PH_PRO: return k_phase_t<PH_PRO>; case PH_A: return k_phase_t<PH_A>; case PH_B1: return k_phase_t<PH_B1>; case PH_B2: return k_phase_t<PH_B2>; case PH_B3: return k_phase_t<PH_B3>; case PH_C: return k_phase_t<PH_C>;
    case PH_D: return k_phase_t<PH_D>; case PH_D2: return k_phase_t<PH_D2>; case PH_E: return k_phase_t<PH_E>; case PH_F: return k_phase_t<PH_F>; case PH_G: return k_phase_t<PH_G>; case PH_G1B: return k_phase_t<PH_G1B>; case PH_G2: return k_phase_t<PH_G2>; default: return k_phase_t<PH_G3>; } }
#else
#ifndef USE_XCD_BARRIER
#define USE_XCD_BARRIER 1
#endif
constexpr int BAR_LDS_OFF = LDS_BYTES - 64;
#if USE_XCD_BARRIER
#define GSYNC() xcd_barrier(bar)
#define GSYNC_ARG const XcdBarrier& bar
#else
#define GSYNC() grid.sync()
#define GSYNC_ARG cg::grid_group& grid
#endif
template <int l>
__device__ __forceinline__ void mega_layer(const KP& p, GSYNC_ARG) {
#if PROBE_REPEAT == 47 || PROBE_REPEAT == 48
        phase_Aprobe<PROBE_REPEAT - 40>(p, l, lds_dyn); GSYNC();
#endif
        phase_A(p, l, lds_dyn);
#if PROBE_REPEAT == 1
        GSYNC(); phase_A(p, l, lds_dyn);
#endif
#if PROBE_REPEAT >= 40 && PROBE_REPEAT <= 46
        GSYNC(); phase_Aprobe<PROBE_REPEAT - 40>(p, l, lds_dyn);
#endif
        GSYNC(); phase_B1(p, l, lds_dyn);
#if PROBE_REPEAT == 2
        GSYNC(); phase_B1(p, l, lds_dyn);
#endif
        GSYNC(); phase_B2(p, l, lds_dyn);
        GSYNC(); phase_B3(p, l, lds_dyn);
        GSYNC(); phase_C(p, l, lds_dyn);
#if PROBE_REPEAT == 4
        GSYNC(); phase_C(p, l, lds_dyn);
#endif
        GSYNC(); phase_D(p, l, lds_dyn);
        GSYNC(); phase_D2(p, l, lds_dyn);
        GSYNC(); phase_E(p, l, lds_dyn);
        GSYNC(); phase_F(p, l, lds_dyn);
#if PROBE_REPEAT == 8
        GSYNC(); phase_F(p, l, lds_dyn);
#endif
        GSYNC(); phase_G12<0>(p, l, lds_dyn);
#if PROBE_REPEAT == 32
        GSYNC(); phase_G12<0, 2>(p, l, lds_dyn);
#endif
        GSYNC(); phase_G1b(p, l, lds_dyn);
        GSYNC(); phase_G12<1>(p, l, lds_dyn);
#if PROBE_REPEAT == 33
        GSYNC(); phase_G12<1, 3>(p, l, lds_dyn);
#endif
        GSYNC(); phase_G3(p, l, lds_dyn, l == L_ - 1);
}
__global__ void __launch_bounds__(NTHR, 2) k_mega(KP p) {
    cg::grid_group grid = cg::this_grid();
#if USE_XCD_BARRIER
    volatile LAS unsigned* st = (volatile LAS unsigned*)(lds_dyn + BAR_LDS_OFF);
    if (threadIdx.x < 2) st[threadIdx.x] = 0u;
    __syncthreads();
    const XcdBarrier bar = xcd_barrier_post((unsigned*)(p.ws + WS_CTL) + 4096, st);
#define GSYNC_VAL bar
#else
#define GSYNC_VAL grid
#endif
    phase_prologue(p, lds_dyn);
#if PROBE_REPEAT == 60
    GSYNC(); phase_prologue(p, lds_dyn);
#endif
    grid.sync();
    phase_A0(p, lds_dyn);
    GSYNC();
    mega_layer<0>(p, GSYNC_VAL);
    static_assert(L_ == 2, "two layers");
    GSYNC();
    mega_layer<1>(p, GSYNC_VAL);
}
#endif
extern "C" void kernel_launch(void* const* d_in, const int* in_sizes, int n_in, void* d_out, int out_size, void* d_ws, size_t ws_size, hipStream_t stream) {
    static int grid = 0;
    if (grid == 0) {
        if (n_in != N_IN || out_size != T_ * 1024 || ws_size < WS_END) { fprintf(stderr, "kernel_launch: unexpected shapes (n_in %d out %d ws %zu need %zu)\n", n_in, out_size, ws_size, (size_t)WS_END); grid = -1; return; }
        int dev = 0, cus = 0, per_cu = 0;
        (void)hipGetDevice(&dev); (void)hipDeviceGetAttribute(&cus, hipDeviceAttributeMultiprocessorCount, dev);
#if N_LAUNCH_MODE == 0
        for (int ph = 0; ph < PH_N; ++ph) (void)hipFuncSetAttribute((const void*)phase_fn(ph), hipFuncAttributeMaxDynamicSharedMemorySize, LDS_BYTES);
        (void)per_cu;
#else
        (void)hipFuncSetAttribute((const void*)k_mega, hipFuncAttributeMaxDynamicSharedMemorySize, LDS_BYTES);
        (void)hipOccupancyMaxActiveBlocksPerMultiprocessor(&per_cu, (const void*)k_mega, NTHR, LDS_BYTES);
        if (per_cu < 1) { fprintf(stderr, "kernel_launch: occupancy query says %d blocks per CU\n", per_cu); grid = -1; return; }
#endif
        grid = cus;
    }
    if (grid < 0) return;
    if (hipMemsetAsync((char*)d_ws + WS_CTL, 0, 65536, stream) != hipSuccess) { fprintf(stderr, "kernel_launch: memset failed\n"); return; }
    KP p{};
    for (int i = 0; i < N_IN; ++i) p.in[i] = (const float*)d_in[i];
    p.out = (float*)d_out; p.ws = (unsigned char*)d_ws;
#if N_LAUNCH_MODE == 1
    void* args[] = {&p};
    hipError_t e = hipLaunchCooperativeKernel((const void*)k_mega, dim3(grid), dim3(NTHR), args, LDS_BYTES, stream);
    if (e != hipSuccess) fprintf(stderr, "cooperative launch failed: %s (grid %d)\n", hipGetErrorString(e), grid);
#else
    p.phase = PH_PRO; p.layer = 0; hipLaunchKernelGGL(phase_fn(PH_PRO), dim3(grid), dim3(NTHR), LDS_BYTES, stream, p);
    for (int l = 0; l < L_; ++l) for (int ph = PH_A; ph < PH_N; ++ph) { p.phase = ph; p.layer = l; hipLaunchKernelGGL(phase_fn(ph), dim3(grid), dim3(NTHR), LDS_BYTES, stream, p); }
#endif
}
#endif
```

```cpp
#ifdef CPU_EMU
#include "emu.h"
#define LAS
#define GET_LDS() ((unsigned char*)emu::lds())
#define AS_GLOBAL(p) (p)
#define AS_LDS(p) (p)
#define RFL(x) (x)
#define MFMA32(a, b, c) emu_mfma32(a, b, c)
#define MFMA16(a, b, c) emu_mfma16(a, b, c)
#define MFMA16_FP8(a, b, c) emu_mfma16_fp8(a, b, c)
#define FAST_EXP2(x) exp2f(x)
#define FAST_RCP(x) (1.0f / (x))
#define FAST_LOG2(x) log2f(x)
#define FAST_RSQ(x) (1.0f / sqrtf(x))
#define WAVE_SYNC() do { uint32_t _z = 0; (void)emu::wave_xchg(&_z, 1); } while (0)
#define OPAQUE(x) do {} while (0)
#define GLDS16(gp, lp, lane) memcpy((char*)(lp) + 16 * (lane), (const void*)(gp), 16)
#define WAIT_VM(n) do {} while (0)
#define GLOAD16_ASM(dst, ptr) (dst) = *(const u32x4*)(ptr)
#define GLOAD16_RW(dst, ptr) (dst) = *(const u32x4*)(ptr)
#define PIN1(a) do {} while (0)
#define GLOAD16_RW_S(dst, base, off) (dst) = *(const u32x4*)((const unsigned char*)(base) + (off))
#define SCHED_FENCE() do {} while (0)
#define TAG_A() do {} while (0)
#define TAG_B() do {} while (0)
#define GLOAD16_S(dst, base, off) (dst) = *(const u32x4*)((const unsigned char*)(base) + (off))
#define GLOAD4_S(dst, base, off) memcpy(&(dst), (const unsigned char*)(base) + (off), 4)
#define GLOAD4_ASM(dst, ptr) (dst) = *(const int*)(ptr)
#define PIN4(a, b, c, d) do {} while (0)
#define PIN2I(a, b) do {} while (0)
#define WAIT_LGKM0() do {} while (0)
#define READLANE_I(v, l) __shfl((int)(v), (l))
#define READLANE_F(v, l) __shfl((float)(v), (l))
#define TIDX() ((int)threadIdx.x)
#define XCC_ID() (emu::bid() & 7)
#define GDIM() ((int)gridDim.x)
#define BIDX() ((int)blockIdx.x)
#define OPAQUE_S(x) do {} while (0)
#define MEMFENCE() do {} while (0)
#else
#include <hip/hip_runtime.h>
#include <hip/hip_cooperative_groups.h>
#include <cstdio>
#include <cstdint>
namespace cg = cooperative_groups;
#define LAS __attribute__((address_space(3)))
#define GAS __attribute__((address_space(1)))
#define AS_GLOBAL(p) ((unsigned char*)(GAS unsigned char*)(p))
#define AS_LDS(p) ((unsigned char*)(LAS unsigned char*)(p))
#define RFL(x) __builtin_amdgcn_readfirstlane(x)
#define MFMA32(a, b, c) __builtin_amdgcn_mfma_f32_32x32x16_bf16(a, b, c, 0, 0, 0)
#define MFMA16(a, b, c) __builtin_amdgcn_mfma_f32_16x16x32_bf16(a, b, c, 0, 0, 0)
#define MFMA16_FP8(a, b, c) __builtin_amdgcn_mfma_f32_16x16x32_fp8_fp8((long)(a), (long)(b), c, 0, 0, 0)
#define MFMA16_F8X128(a, b, c) __builtin_amdgcn_mfma_scale_f32_16x16x128_f8f6f4(a, b, c, 0, 0, 0, 0, 0, 0)
#define FAST_EXP2(x) __builtin_amdgcn_exp2f(x)
#define FAST_RCP(x) __builtin_amdgcn_rcpf(x)
#define FAST_LOG2(x) __builtin_amdgcn_logf(x)
#define FAST_RSQ(x) __builtin_amdgcn_rsqf(x)
#define WAVE_SYNC() __builtin_amdgcn_wave_barrier()
#define OPAQUE(x) asm volatile("" : "+v"(x))
#define GLDS16(gp, lp, lane) __builtin_amdgcn_global_load_lds((const unsigned*)(gp), (LAS unsigned*)(lp), 16, 0, 0)
#define WAIT_VM(n) asm volatile("s_waitcnt vmcnt(" #n ")" ::: "memory")
#define GLOAD16_ASM(dst, ptr) asm volatile("global_load_dwordx4 %0, %1, off" : "=v"(dst) : "v"(ptr) : "memory")
#define GLOAD4_ASM(dst, ptr) asm volatile("global_load_dword %0, %1, off" : "=v"(dst) : "v"(ptr) : "memory")
#define GLOAD16_RW(dst, ptr) asm volatile("global_load_dwordx4 %0, %1, off" : "+v"(dst) : "v"(ptr) : "memory")
#define PIN1(a) asm volatile("" : "+v"(a) :: "memory")
#define GLOAD16_RW_S(dst, base, off) asm volatile("global_load_dwordx4 %0, %1, %2" : "+v"(dst) : "v"(off), "s"(base) : "memory")
#define SCHED_FENCE() __builtin_amdgcn_sched_barrier(0)
#define TAG_A() asm volatile("; buffer A" ::: "memory")
#define TAG_B() asm volatile("; buffer B" ::: "memory")
#define GLOAD16_S(dst, base, off) asm volatile("global_load_dwordx4 %0, %1, %2" : "=v"(dst) : "v"(off), "s"(base) : "memory")
#define GLOAD4_S(dst, base, off) asm volatile("global_load_dword %0, %1, %2" : "=v"(dst) : "v"(off), "s"(base) : "memory")
#define PIN4(a, b, c, d) asm volatile("" : "+v"(a), "+v"(b), "+v"(c), "+v"(d) :: "memory")
#define PIN2I(a, b) asm volatile("" : "+v"(a), "+v"(b) :: "memory")
#define WAIT_LGKM0() asm volatile("s_waitcnt lgkmcnt(0)" ::: "memory")
#define READLANE_I(v, l) __builtin_amdgcn_readlane((int)(v), (l))
#define READLANE_F(v, l) __builtin_bit_cast(float, __builtin_amdgcn_readlane(__builtin_bit_cast(int, (float)(v)), (l)))
#define OPAQUE_S(x) asm volatile("" : "+s"(x))
__device__ __forceinline__ int opaque_tid_() { int t = threadIdx.x; asm volatile("" : "+v"(t)); return t; }
#define TIDX() opaque_tid_()
#define XCC_ID() ((int)(__builtin_amdgcn_s_getreg((3 << 11) | 20) & 7u))
__device__ __forceinline__ int opaque_gdim_() { int t = gridDim.x; asm volatile("" : "+s"(t)); return t; }
__device__ __forceinline__ int opaque_bidx_() { int t = blockIdx.x; asm volatile("" : "+s"(t)); return t; }
#define GDIM() opaque_gdim_()
#define BIDX() opaque_bidx_()
#define MEMFENCE() do { asm volatile("" ::: "memory"); __builtin_amdgcn_sched_barrier(0); } while (0)
#endif

#ifndef CFG_B
#define CFG_B 16
#endif
#ifndef CFG_S
#define CFG_S 2048
#endif

typedef unsigned short bf16_t;
typedef short bf16x8 __attribute__((ext_vector_type(8)));
typedef short s16x4 __attribute__((ext_vector_type(4)));
typedef float f32x4 __attribute__((ext_vector_type(4)));
typedef float f32x2 __attribute__((ext_vector_type(2)));
typedef float f32x16 __attribute__((ext_vector_type(16)));
typedef unsigned u32x4 __attribute__((ext_vector_type(4)));
typedef unsigned u32x2 __attribute__((ext_vector_type(2)));
typedef int i32x4 __attribute__((ext_vector_type(4)));
typedef int i32x8 __attribute__((ext_vector_type(8)));

constexpr int NB_ = CFG_B, S_ = CFG_S, T_ = NB_ * S_, D_ = 1024, L_ = 2;
constexpr int NTHR = 512, NWAVE = 8;
constexpr int PJ = 2304;
constexpr int C_R = 0, C_K = 256, C_V = 512, C_HW = 768, C_HA = 800, C_HG = 832, C_S5 = 896, C_FQ = 1152, C_FK = 1408, C_FL = 1664, C_CV = 1792, C_CG = 2048;
constexpr int WIN_ROWS = 6656, WIN_VT = 2304, WIN_GATE = 2560;
constexpr int IN_COLS = 6532;
constexpr float LN_EPS_ = 1e-5f, GN_EPS_ = 64e-5f;
constexpr float DN_ALPHA_ = 1.4142135623730951f;
constexpr int NEXP = 16384;

enum { I_X = 0, I_P, I_LNIN_G, I_LNIN_B, I_WIN, I_MU, I_W0, I_W2, I_A0, I_A2, I_G2, I_KK, I_KA, I_RK, I_LNXG, I_LNXB, I_LRE, I_LIM, I_BRE, I_BIM, I_CRE, I_CIM,
       I_S5D, I_LDT, I_GLUW, I_GLUB, I_BF, I_CONVW, I_CONVB, I_CLNG, I_CLNB, I_WBR, I_WOUT, I_LN1G, I_LN1B, I_WQ, I_K1, I_K2, I_U, I_V, I_PLEW, I_PLEG, I_LN2G, I_LN2B, N_IN };

constexpr size_t al256(size_t x) { return (x + 255) & ~(size_t)255; }
constexpr size_t WS_CTL = 0;
constexpr size_t WS_WIN = 1u << 20;
constexpr size_t WS_WBR = WS_WIN + al256((size_t)L_ * WIN_ROWS * 1024 * 2);
constexpr size_t WS_WOUT = WS_WBR + (size_t)L_ * 1024 * 1024 * 2;
constexpr size_t WS_WQ = WS_WOUT + (size_t)L_ * 1024 * 1024 * 2;
constexpr size_t WS_PLE = WS_WQ + (size_t)L_ * 2048 * 1024 * 2;
constexpr size_t WS_PLEG = WS_PLE + (size_t)L_ * 1024 * 256 * 2;
constexpr size_t WS_GLU = WS_PLEG + (size_t)L_ * 1024 * 1024 * 2;
constexpr size_t WS_K12 = WS_GLU + (size_t)L_ * 256 * 256 * 2;
constexpr size_t WS_S5KC = WS_K12 + (size_t)L_ * 2 * 128 * 128 * 2;
constexpr size_t WS_S5WX = WS_S5KC + (size_t)L_ * 16 * 64 * 256 * 2;
constexpr size_t WS_S5WY = WS_S5WX + (size_t)L_ * 16 * 128 * 1024 * 2;
constexpr size_t WS_S5LL = WS_S5WY + (size_t)L_ * 16 * 1024 * 128 * 2;
constexpr size_t WS_UT = WS_S5LL + al256((size_t)L_ * 16 * 64 * 2 * 4);
constexpr size_t WS_VT = WS_UT + (size_t)NEXP * 1024 * 2;
constexpr size_t WS_RW = WS_VT + (size_t)NEXP * 1024 * 2;
constexpr size_t RW_SZ = (size_t)T_ * 512;
static_assert(2 * RW_SZ <= (size_t)NEXP * 1024 * 2, "RWKV gate / bonus arrays fit the second table region");
constexpr size_t WS_HB = WS_RW + 4 * RW_SZ;
constexpr size_t WS_R1 = WS_HB + (size_t)T_ * 1024 * 2;
constexpr size_t R1_BYTES = (size_t)T_ * 2560 * 2;
constexpr size_t WS_YC = WS_R1 + R1_BYTES;
constexpr size_t WS_VTR = WS_YC + (size_t)T_ * 1024 * 2;
constexpr size_t WS_PB = WS_VTR + (size_t)256 * T_ * 2;
constexpr size_t WS_H8T = WS_PB + (size_t)T_ * 256 * 2;
constexpr int H8_SPLIT = (T_ / 512) * 256;
constexpr size_t WS_END = WS_H8T + (size_t)(T_ - H8_SPLIT) * 1024;
constexpr size_t R1_PROJ = 0;
constexpr size_t R1_H8 = (size_t)T_ * 2304 * 2;
constexpr size_t R1_MERGED = 0;
constexpr size_t R1_STASH = (size_t)T_ * 1024 * 2;
constexpr size_t R1_Q = 0;
constexpr size_t R1_EID = (size_t)T_ * 2048 * 2;
constexpr size_t R1_GATE = R1_EID + (size_t)T_ * 128 * 4;
static_assert(R1_GATE + (size_t)T_ * 128 * 4 <= R1_BYTES, "R1 map");

struct KP { const float* in[N_IN]; float* out; unsigned char* ws; float* dbg; int layer; int phase; };

#ifdef CPU_EMU
__device__ __forceinline__ unsigned f2bf(float f) { unsigned u = __builtin_bit_cast(unsigned, f); return (u + 0x7fffu + ((u >> 16) & 1u)) >> 16; }
__device__ __forceinline__ unsigned pk2(float lo, float hi) { return f2bf(lo) | (f2bf(hi) << 16); }
#else
typedef __bf16 bf16x2_hw __attribute__((ext_vector_type(2)));
__device__ __forceinline__ unsigned pk2(float lo, float hi) { const f32x2 v = {lo, hi}; return __builtin_bit_cast(unsigned, __builtin_convertvector(v, bf16x2_hw)); }
__device__ __forceinline__ unsigned f2bf(float f) { return pk2(f, 0.f) & 0xffffu; }
#endif
__device__ __forceinline__ float bf2f(unsigned h) { return __builtin_bit_cast(float, h << 16); }
__device__ __forceinline__ float bflo(unsigned w) { return __builtin_bit_cast(float, w << 16); }
__device__ __forceinline__ float bfhi(unsigned w) { return __builtin_bit_cast(float, w & 0xffff0000u); }
__device__ __forceinline__ float sigmoidf_(float x) { return FAST_RCP(1.0f + FAST_EXP2(x * -1.4426950408889634f)); }
__device__ __forceinline__ float gelu_erf(float v) {
    const float t = FAST_RCP(fabsf(v) * 0.2316418882f + 1.0f);
    float q = t * 0.5307027145f + (-0.7265760135f); q = q * t + 0.7107068705f; q = q * t + (-0.142248368f); q = q * t + 0.127414796f; q = q * t;
    const float m = v * (q * FAST_EXP2((v * v) * (-0.72134752044f)));
    return v < 0.f ? m : v - m; }
#ifdef CPU_EMU
inline float fp8_dec_(unsigned b) { const unsigned s = b >> 7, e = (b >> 3) & 15, m = b & 7; float v = (e == 0) ? ldexpf((float)m, -9) : ldexpf(1.f + m * 0.125f, (int)e - 7); return s ? -v : v; }
inline unsigned fp8_enc_(float x) { const unsigned s = x < 0.f ? 0x80u : 0u; float a = fabsf(x); if (!(a > 0.f)) return s; if (a > 448.f) a = 448.f;
    int e; (void)frexpf(a, &e); e -= 1; if (e < -6) e = -6;
    const float q = ldexpf(a, 3 - e); float r = nearbyintf(q);
    unsigned ee, mm; if (e == -6 && r < 8.f) { ee = 0; mm = (unsigned)r; } else { if (r >= 16.f) { r = 8.f; e += 1; } ee = (unsigned)(e + 7); mm = (unsigned)r - 8u; }
    if (ee > 15u || (ee == 15u && mm > 6u)) { ee = 15u; mm = 6u; }
    return s | (ee << 3) | mm; }
inline f32x2 cvt_pk_f32_fp8_(unsigned w, bool hi) { const unsigned h = hi ? (w >> 16) : w; return (f32x2){fp8_dec_(h & 255u), fp8_dec_((h >> 8) & 255u)}; }
inline unsigned cvt_pk_fp8_f32_(float a, float b, unsigned old, bool hi) { const unsigned p = fp8_enc_(a) | (fp8_enc_(b) << 8); return hi ? ((old & 0xffffu) | (p << 16)) : ((old & 0xffff0000u) | p); }
#else
__device__ __forceinline__ f32x2 cvt_pk_f32_fp8_(unsigned w, bool hi) { return hi ? __builtin_amdgcn_cvt_pk_f32_fp8((int)w, true) : __builtin_amdgcn_cvt_pk_f32_fp8((int)w, false); }
__device__ __forceinline__ unsigned cvt_pk_fp8_f32_(float a, float b, unsigned old, bool hi) { return hi ? (unsigned)__builtin_amdgcn_cvt_pk_fp8_f32(a, b, (int)old, true) : (unsigned)__builtin_amdgcn_cvt_pk_fp8_f32(a, b, (int)old, false); }
#endif
__device__ __forceinline__ float wave_max(float v) {
#pragma unroll
  for (int o = 1; o < 64; o <<= 1) v = fmaxf(v, __shfl_xor(v, o));
  return v;
}
template <int N> __device__ __forceinline__ void wave_sum_n(float (&v)[N]) {
#pragma unroll
  for (int o = 1; o < 64; o <<= 1) { float t[N];
#pragma unroll
    for (int i = 0; i < N; ++i) t[i] = __shfl_xor(v[i], o);
#pragma unroll
    for (int i = 0; i < N; ++i) v[i] += t[i]; }
}
__device__ __forceinline__ float wave_sum(float v) {
#pragma unroll
  for (int o = 1; o < 64; o <<= 1) v += __shfl_xor(v, o);
  return v;
}
namespace pg8 {
constexpr int BM = 256, BK = 64, HALF = 128, HTB = HALF * BK * 2, STAGE_BYTES = 8 * HTB;
__host__ __device__ __forceinline__ int lds_byte(int r, int c) { const int st = (r >> 4) * 2 + (c >> 5), rr = r & 15, cc = c & 31, ob = rr * 64 + cc * 2; return st * 1024 + (ob ^ (((ob >> 9) & 1) << 5)); }
__host__ __device__ __forceinline__ void stage_rc(int b, int& R, int& C) { const int st = b / 1024, sb = b % 1024, swz = sb ^ (((sb >> 9) & 1) << 5); R = (st >> 1) * 16 + swz / 64; C = (st & 1) * 32 + (swz % 64) / 2; }
__host__ __device__ __forceinline__ int perm32(int rho) { const int n = rho >> 4, i = rho & 15; return 8 * (i >> 2) + 4 * n + (i & 3); }

struct Unit { const char* a; const char* b; int nt; int kind; int pm; int pn; int aux; int f8; };

#ifndef CPU_EMU
template <int MODE = 0, class Epi, class Sched>
__device__ __forceinline__ void gemm_phase(LAS unsigned char* lds, const int lda, const int ldb, const Sched& S, const Epi& E, const int lda8 = 0) {
    const int tid = TIDX(), wid = __builtin_amdgcn_readfirstlane(tid >> 6), lane = tid & 63, wr = wid >> 2, wc = wid & 3, fr = lane & 15, fq = lane >> 4;
    unsigned voffA[2], voffB[2], voffA8[2];
#pragma unroll
    for (int i = 0; i < 2; ++i) { int R, C; stage_rc(tid * 16 + i * 8192, R, C); const int Rb = (R & ~31) + perm32(R & 31);
        voffA[i] = (unsigned)(R * lda + C) * 2u; voffB[i] = (unsigned)(Rb * ldb + C) * 2u; voffA8[i] = (unsigned)(R * lda8 + C * 2); }
    const size_t kstep = (size_t)(BK * 2);
    const size_t hstepA = (size_t)HALF * lda * 2, hstepB = (size_t)HALF * ldb * 2, hstepA8 = (size_t)HALF * lda8;
    const unsigned ldsw = (unsigned)wid * 1024u;
    const int aoff = lds_byte(wr * 64 + fr, fq * 8), boff = lds_byte(wc * 32 + fr, fq * 8);
#define PG8_SA(b, h) (((b) * 2 + (h)) * HTB)
#define PG8_SB(b, h) ((4 + (b) * 2 + (h)) * HTB)
#define PG8_STAGE(bufoff, gbase, voff) do { _Pragma("unroll") for (int _i = 0; _i < 2; ++_i) \
        __builtin_amdgcn_global_load_lds((const unsigned*)((const char*)(gbase) + (voff)[_i]), (LAS unsigned*)(lds + (bufoff) + ldsw + _i * 8192), 16, 0, 0); } while (0)
#define PG8_LDA(dst, b, h) do { _Pragma("unroll") for (int m = 0; m < 4; ++m) _Pragma("unroll") for (int k = 0; k < 2; ++k) dst[m][k] = *(const LAS bf16x8*)(lds + PG8_SA(b, h) + aoff + m * 2048 + k * 1024); } while (0)
#define PG8_LDB(dst, b, h) do { _Pragma("unroll") for (int n = 0; n < 2; ++n) _Pragma("unroll") for (int k = 0; k < 2; ++k) dst[n][k] = *(const LAS bf16x8*)(lds + PG8_SB(b, h) + boff + n * 2048 + k * 1024); } while (0)
#define PG8_MMA(ai, bj, At, Bt) do { __builtin_amdgcn_s_setprio(1); _Pragma("unroll") for (int m = 0; m < 4; ++m) _Pragma("unroll") for (int n = 0; n < 2; ++n) _Pragma("unroll") for (int k = 0; k < 2; ++k) \
        acc[ai][bj][m][n] = __builtin_amdgcn_mfma_f32_16x16x32_bf16(Bt[n][k], At[m][k], acc[ai][bj][m][n], 0, 0, 0); __builtin_amdgcn_s_setprio(0); } while (0)
#define PG8_CAT(x, y) __builtin_shufflevector(__builtin_bit_cast(i32x4, x), __builtin_bit_cast(i32x4, y), 0, 1, 2, 3, 4, 5, 6, 7)
#define PG8_LDA8(dst, b, h) do { _Pragma("unroll") for (int m = 0; m < 4; ++m) dst[m] = PG8_CAT(*(const LAS bf16x8*)(lds + PG8_SA(b, h) + aoff + m * 2048), *(const LAS bf16x8*)(lds + PG8_SA(b, h) + aoff + m * 2048 + 1024)); } while (0)
#define PG8_LDB8(dst, b, h) do { _Pragma("unroll") for (int n = 0; n < 2; ++n) dst[n] = PG8_CAT(*(const LAS bf16x8*)(lds + PG8_SB(b, h) + boff + n * 2048), *(const LAS bf16x8*)(lds + PG8_SB(b, h) + boff + n * 2048 + 1024)); } while (0)
#define PG8_MMA8(ai, bj, A8, B8) do { __builtin_amdgcn_s_setprio(1); _Pragma("unroll") for (int m = 0; m < 4; ++m) _Pragma("unroll") for (int n = 0; n < 2; ++n) \
        acc[ai][bj][m][n] = MFMA16_F8X128(B8[n], A8[m], acc[ai][bj][m][n]); __builtin_amdgcn_s_setprio(0); } while (0)
#define PG8_WAIT_V(n) asm volatile("s_waitcnt vmcnt(" #n ")" ::: "memory")
#define PG8_WAIT_L(n) asm volatile("s_waitcnt lgkmcnt(" #n ")" ::: "memory")
#define PG8_BAR __builtin_amdgcn_s_barrier()
#define PG8_SCHED __builtin_amdgcn_sched_barrier(0)
    Unit cur, nxt; int ui = 0;
    if (!S.next(0, cur)) return;
    f32x4 acc[2][2][4][2];
#pragma unroll
    for (int a = 0; a < 2; ++a)
#pragma unroll
        for (int b = 0; b < 2; ++b)
#pragma unroll
            for (int m = 0; m < 4; ++m)
#pragma unroll
                for (int n = 0; n < 2; ++n) acc[a][b][m][n] = (f32x4){0.f, 0.f, 0.f, 0.f};
    bf16x8 At[4][2], B0[2][2], B1[2][2];
    const char* cA = cur.a; const char* cB = cur.b; int cf8 = MODE == 2 ? cur.f8 : MODE; size_t chA = cf8 ? hstepA8 : hstepA;
    { unsigned v0[2] = {cf8 ? voffA8[0] : voffA[0], cf8 ? voffA8[1] : voffA[1]};
    PG8_STAGE(PG8_SB(0, 0), cB, voffB); PG8_STAGE(PG8_SB(0, 1), cB + hstepB, voffB); PG8_STAGE(PG8_SA(0, 0), cA, v0); PG8_STAGE(PG8_SA(0, 1), cA + chA, v0);
    if (wr == 1) PG8_BAR;
    PG8_WAIT_V(2); PG8_BAR;
    PG8_STAGE(PG8_SB(1, 0), cB + kstep, voffB); PG8_STAGE(PG8_SA(1, 0), cA + kstep, v0); PG8_STAGE(PG8_SB(1, 1), cB + hstepB + kstep, voffB);
    PG8_WAIT_V(6); PG8_BAR; }
    for (;;) {
        const bool has_next = S.next(ui + 1, nxt);
        const char* nA = has_next ? nxt.a : cA; const char* nB = has_next ? nxt.b : cB; const int nf8 = MODE == 2 ? (has_next ? nxt.f8 : cf8) : MODE;
        int nt = cur.nt; asm volatile("" : "+s"(nt));
#define PG8_KLOOP(LDA_, LDB_, MM_, At_, B0_, B1_, CF8) \
        for (int t = 0; t < nt; t += 2) { \
            const bool last = (t == nt - 2); \
            const char* a1 = cA + (size_t)(t + 1) * kstep; \
            const char* a2 = last ? nA : cA + (size_t)(t + 2) * kstep; const char* b2 = last ? nB : cB + (size_t)(t + 2) * kstep; \
            const char* a3 = a2 + kstep; const char* b3 = b2 + kstep; \
            const int f2 = last ? nf8 : CF8; const size_t h2 = f2 ? hstepA8 : hstepA; \
            OPAQUE_S(a1); OPAQUE_S(a2); OPAQUE_S(a3); OPAQUE_S(b2); OPAQUE_S(b3); \
            const unsigned vA[2] = {CF8 ? voffA8[0] : voffA[0], CF8 ? voffA8[1] : voffA[1]}, vA2[2] = {f2 ? voffA8[0] : voffA[0], f2 ? voffA8[1] : voffA[1]}, vB[2] = {voffB[0], voffB[1]}; \
            LDB_(B0_, 0, 0); LDB_(B1_, 0, 1); PG8_SCHED; LDA_(At_, 0, 0); PG8_STAGE(PG8_SA(1, 1), a1 + (CF8 ? hstepA8 : hstepA), vA); \
            PG8_WAIT_V(8); PG8_WAIT_L(0); PG8_BAR; MM_(0, 0, At_, B0_); MM_(0, 1, At_, B1_); PG8_BAR; PG8_SCHED; \
            LDA_(At_, 0, 1); PG8_STAGE(PG8_SB(0, 0), b2, vB); PG8_STAGE(PG8_SB(0, 1), b2 + hstepB, vB); PG8_STAGE(PG8_SA(0, 0), a2, vA2); \
            PG8_WAIT_V(8); PG8_WAIT_L(0); PG8_BAR; MM_(1, 0, At_, B0_); MM_(1, 1, At_, B1_); PG8_BAR; PG8_SCHED; \
            LDB_(B0_, 1, 0); LDB_(B1_, 1, 1); PG8_SCHED; LDA_(At_, 1, 0); PG8_STAGE(PG8_SA(0, 1), a2 + h2, vA2); \
            PG8_WAIT_V(8); PG8_WAIT_L(0); PG8_BAR; MM_(0, 0, At_, B0_); MM_(0, 1, At_, B1_); PG8_BAR; PG8_SCHED; \
            LDA_(At_, 1, 1); PG8_STAGE(PG8_SB(1, 0), b3, vB); PG8_STAGE(PG8_SB(1, 1), b3 + hstepB, vB); PG8_STAGE(PG8_SA(1, 0), a3, vA2); \
            PG8_WAIT_V(8); PG8_WAIT_L(0); PG8_BAR; MM_(1, 0, At_, B0_); MM_(1, 1, At_, B1_); PG8_BAR; PG8_SCHED; \
        }
        if (MODE == 1 || (MODE == 2 && cf8)) { i32x8 A8[4], B08[2], B18[2]; PG8_KLOOP(PG8_LDA8, PG8_LDB8, PG8_MMA8, A8, B08, B18, 1) }
        else { PG8_KLOOP(PG8_LDA, PG8_LDB, PG8_MMA, At, B0, B1, 0) }
#undef PG8_KLOOP
        if (wr == 0) PG8_BAR;
        E(acc, cur, wr, wc, fr, fq, tid);
        if (!has_next) break;
#pragma unroll
        for (int a = 0; a < 2; ++a)
#pragma unroll
            for (int b = 0; b < 2; ++b)
#pragma unroll
                for (int m = 0; m < 4; ++m)
#pragma unroll
                    for (int n = 0; n < 2; ++n) acc[a][b][m][n] = (f32x4){0.f, 0.f, 0.f, 0.f};
        cur = nxt; cA = nA; cB = nB; cf8 = nf8; ++ui;
        if (wr == 1) PG8_BAR;
    }
    PG8_WAIT_V(0);
    PG8_BAR;
#undef PG8_SA
#undef PG8_SB
#undef PG8_STAGE
#undef PG8_LDA
#undef PG8_LDB
#undef PG8_MMA
#undef PG8_MMA8
#undef PG8_LDA8
#undef PG8_LDB8
#undef PG8_CAT
#undef PG8_WAIT_V
#undef PG8_WAIT_L
#undef PG8_BAR
#undef PG8_SCHED
}
#else
template <int MODE = 0, class Epi, class Sched>
inline void gemm_phase(unsigned char* lds, const int lda, const int ldb, const Sched& S, const Epi& E, const int lda8 = 0) {
    const int tid = TIDX(), wid = tid >> 6, lane = tid & 63, wr = wid >> 2, wc = wid & 3, fr = lane & 15, fq = lane >> 4;
    Unit cur;
    for (int ui = 0; S.next(ui, cur); ++ui) {
        f32x4 acc[2][2][4][2];
        const bf16_t* A = (const bf16_t*)cur.a; const bf16_t* Bt = (const bf16_t*)cur.b; const int K = cur.nt * 64;
        for (int ai = 0; ai < 2; ++ai) for (int bj = 0; bj < 2; ++bj) for (int m = 0; m < 4; ++m) for (int n = 0; n < 2; ++n) for (int e = 0; e < 4; ++e) {
            const int r = 128 * ai + 64 * wr + 16 * m + fr, c = 128 * bj + 32 * wc + 8 * fq + 4 * n + e; float s = 0.f;
            const bf16_t* ar = A + (size_t)r * lda; const bf16_t* br = Bt + (size_t)c * ldb;
            if (cur.f8) { const unsigned char* a8 = (const unsigned char*)cur.a + (size_t)r * lda8; const unsigned char* b8 = (const unsigned char*)cur.b + (size_t)c * ldb * 2;
                for (int k = 0; k < cur.nt * 128; ++k) s += fp8_dec_(a8[k]) * fp8_dec_(b8[k]); }
#ifdef EMU_FP8_A
            else if (cur.aux == 77) { float am = 0.f; for (int k = 0; k < K; ++k) am = fmaxf(am, fabsf(bf2f(br[k]))); const float sc = am > 0.f ? am / 440.f : 1.f;
                for (int k = 0; k < K; ++k) s += fp8_dec_(fp8_enc_(bf2f(ar[k]))) * fp8_dec_(fp8_enc_(bf2f(br[k]) / sc)); s *= sc; }
#endif
            else for (int k = 0; k < K; ++k) s += bf2f(ar[k]) * bf2f(br[k]);
            acc[ai][bj][m][n][e] = s; }
        __syncthreads();
        E(acc, cur, wr, wc, fr, fq, tid);
        __syncthreads();
    }
    __syncthreads();
}
#endif
}
struct Ptrs {
    bf16_t *WinT, *WbrT, *WoutT, *WqT, *PleT, *PleGT, *GluT, *K12, *S5Kc, *S5Wx, *S5Wy, *Ut, *Vt, *hb, *proj, *merged, *q, *ycat, *vtr, *pb;
    float *S5LL, *gate; int* eid; unsigned char* stash; bf16_t *rwPT, *rwG, *rwS0, *rwQ, *rwGt, *rwRKV; unsigned char *U8, *V8; float *su, *sv, *pd; unsigned* qcnt; unsigned char *h8a, *h8b, *h8e; float *gsc, *gscA;
};
__device__ __forceinline__ Ptrs make_ptrs(unsigned char* ws, int l) {
    Ptrs P; { size_t zoff = 0; OPAQUE_S(zoff); ws += zoff; }
    P.WinT = (bf16_t*)(ws + WS_WIN) + (size_t)l * WIN_ROWS * 1024; P.WbrT = (bf16_t*)(ws + WS_WBR) + (size_t)l * 1024 * 1024; P.WoutT = (bf16_t*)(ws + WS_WOUT) + (size_t)l * 1024 * 1024;
    P.WqT = (bf16_t*)(ws + WS_WQ) + (size_t)l * 2048 * 1024; P.PleT = (bf16_t*)(ws + WS_PLE) + (size_t)l * 1024 * 256; P.PleGT = (bf16_t*)(ws + WS_PLEG) + (size_t)l * 1024 * 1024;
    P.GluT = (bf16_t*)(ws + WS_GLU) + (size_t)l * 256 * 256; P.K12 = (bf16_t*)(ws + WS_K12) + (size_t)l * 2 * 128 * 128;
    P.S5Kc = (bf16_t*)(ws + WS_S5KC) + (size_t)l * 16 * 64 * 256; P.S5Wx = (bf16_t*)(ws + WS_S5WX) + (size_t)l * 16 * 128 * 1024; P.S5Wy = (bf16_t*)(ws + WS_S5WY) + (size_t)l * 16 * 1024 * 128;
    P.S5LL = (float*)(ws + WS_S5LL) + (size_t)l * 16 * 64 * 2;
    P.Ut = (bf16_t*)(ws + WS_UT); P.Vt = (bf16_t*)(ws + WS_VT);
    P.pd = (float*)(ws + WS_R1 + R1_Q); P.qcnt = (unsigned*)(ws + WS_CTL) + 8192 + l * 4 * 8 * 16;
    P.U8 = ws + WS_UT; P.V8 = ws + WS_UT + (size_t)NEXP * 1024; P.su = (float*)(ws + WS_CTL + 131072); P.sv = (float*)(ws + WS_CTL + 131072) + NEXP;
    P.rwGt = (bf16_t*)(ws + WS_VT); P.rwRKV = (bf16_t*)(ws + WS_VT + RW_SZ);
    P.rwPT = (bf16_t*)(ws + WS_RW); P.rwG = (bf16_t*)(ws + WS_RW + RW_SZ); P.rwS0 = (bf16_t*)(ws + WS_RW + 2 * RW_SZ); P.rwQ = (bf16_t*)(ws + WS_RW + 3 * RW_SZ);
    P.hb = (bf16_t*)(ws + WS_HB); P.proj = (bf16_t*)(ws + WS_R1 + R1_PROJ); P.merged = (bf16_t*)(ws + WS_R1 + R1_MERGED); P.q = (bf16_t*)(ws + WS_R1 + R1_Q);
    P.stash = ws + WS_R1 + R1_STASH; P.eid = (int*)(ws + WS_R1 + R1_EID); P.gate = (float*)(ws + WS_R1 + R1_GATE);
    P.ycat = (bf16_t*)(ws + WS_YC); P.vtr = (bf16_t*)(ws + WS_VTR); P.pb = (bf16_t*)(ws + WS_PB);
    P.h8a = ws + WS_R1 + R1_H8; P.h8b = ws + WS_H8T; P.h8e = ws + WS_RW; P.gsc = (float*)(ws + WS_CTL + 262144) + l * 6144; P.gscA = (float*)(ws + WS_CTL + 327680) + l * 2560;
    return P;
}

__device__ __forceinline__ int win_src_col(int n) {
    if (n < 1152) return n;
    if (n < 1664) return n;
    if (n < 1668) return 1920 + (n - 1664);
    if (n < 1792) return -1;
    if (n < 2304) return 1924 + (n - 1792);
    if (n < 2560) return 1664 + (n - 2304);
    return 2436 + (n - 2560);
}
template <bool WINMAP>
__device__ __forceinline__ void transpose_item(const float* src, int sld, bf16_t* dst, int dld, int dcol0, int kb, int nb, float* scr, int lane) {
    const int k0 = 64 * kb, n0 = 32 * nb;
    const int nn = n0 + (lane & 31); const int sc = WINMAP ? win_src_col(nn) : nn;
#pragma unroll 8
    for (int i = 0; i < 32; ++i) { const int kk = 2 * i + (lane >> 5); scr[kk * 33 + (lane & 31)] = (sc >= 0) ? src[(size_t)(k0 + kk) * sld + sc] : 0.f; }
    WAVE_SYNC();
    const int c = lane & 7;
#pragma unroll
    for (int j = 0; j < 4; ++j) { const int n = (lane >> 3) + 8 * j; const float* s = scr + (8 * c) * 33 + n;
        u32x4 o; o.x = pk2(s[0 * 33], s[1 * 33]); o.y = pk2(s[2 * 33], s[3 * 33]); o.z = pk2(s[4 * 33], s[5 * 33]); o.w = pk2(s[6 * 33], s[7 * 33]);
        *(u32x4*)(dst + (size_t)(n0 + n) * dld + dcol0 + k0 + 8 * c) = o; }
    WAVE_SYNC();
}

__device__ __forceinline__ void s5_tables(const KP& p, int l, int g, unsigned char* lds) {
    float* pw = (float*)lds;
    float* bb = pw + 65 * 128;
    float* cc = bb + 64 * 32;
    const int tid = TIDX();
    const Ptrs P = make_ptrs(p.ws, l);
    const float dt = expf(p.in[I_LDT][l * 16 + g]);
    if (tid < 64) { const int pp = tid; const float lr = p.in[I_LRE][(l * 16 + g) * 64 + pp], li = p.in[I_LIM][(l * 16 + g) * 64 + pp];
        const float mag = expf(lr * dt), ang = li * dt; const float br = mag * cosf(ang), bi = mag * sinf(ang);
        float xr = 1.f, xi = 0.f;
        for (int t = 0; t <= 64; ++t) { pw[(t * 64 + pp) * 2] = xr; pw[(t * 64 + pp) * 2 + 1] = xi; const float nr = xr * br - xi * bi, ni = xr * bi + xi * br; xr = nr; xi = ni; }
        const float nr = br - 1.f, ni = bi, den = lr * lr + li * li; const float cr = (nr * lr + ni * li) / den, ci = (ni * lr - nr * li) / den;
        for (int c = 0; c < 16; ++c) { const float b_r = p.in[I_BRE][((l * 16 + g) * 64 + pp) * 16 + c], b_i = p.in[I_BIM][((l * 16 + g) * 64 + pp) * 16 + c];
            bb[(pp * 16 + c) * 2] = cr * b_r - ci * b_i; bb[(pp * 16 + c) * 2 + 1] = cr * b_i + ci * b_r; }
        P.S5LL[(g * 64 + pp) * 2] = pw[(64 * 64 + pp) * 2]; P.S5LL[(g * 64 + pp) * 2 + 1] = pw[(64 * 64 + pp) * 2 + 1];
    }
    for (int e = tid; e < 1024; e += NTHR) { const int c = e >> 6, pp = e & 63; cc[e * 2] = p.in[I_CRE][((l * 16 + g) * 16 + c) * 64 + pp]; cc[e * 2 + 1] = p.in[I_CIM][((l * 16 + g) * 16 + c) * 64 + pp]; }
    __syncthreads();
    bf16_t* Kc = P.S5Kc + (size_t)g * 64 * 256;
    { const int pair = tid & 255, co = pair >> 4, ci = pair & 15, th = tid >> 8; float acc[32];
#pragma unroll
      for (int j = 0; j < 32; ++j) acc[j] = 0.f;
      for (int pp = 0; pp < 64; ++pp) { const float c_r = cc[(co * 64 + pp) * 2], c_i = cc[(co * 64 + pp) * 2 + 1], b_r = bb[(pp * 16 + ci) * 2], b_i = bb[(pp * 16 + ci) * 2 + 1];
          const float d_r = c_r * b_r - c_i * b_i, d_i = c_r * b_i + c_i * b_r;
#pragma unroll
          for (int j = 0; j < 32; ++j) { const f32x2 w = *(const f32x2*)(pw + ((th * 32 + j) * 64 + pp) * 2); acc[j] += d_r * w.x - d_i * w.y; } }
#pragma unroll
      for (int j = 0; j < 32; ++j) Kc[(th * 32 + j) * 256 + pair] = (bf16_t)f2bf(acc[j]); }
    bf16_t* Wx = P.S5Wx + (size_t)g * 128 * 1024;
    for (int e = tid; e < 128 * 1024; e += NTHR) { const int n = e >> 10, k = e & 1023, pp = n >> 1, ri = n & 1, s = k >> 4, ci = k & 15;
        const float w_r = pw[((63 - s) * 64 + pp) * 2], w_i = pw[((63 - s) * 64 + pp) * 2 + 1], b_r = bb[(pp * 16 + ci) * 2], b_i = bb[(pp * 16 + ci) * 2 + 1];
        Wx[e] = (bf16_t)f2bf(ri ? (w_r * b_i + w_i * b_r) : (w_r * b_r - w_i * b_i)); }
    bf16_t* Wy = P.S5Wy + (size_t)g * 1024 * 128;
    for (int e = tid; e < 1024 * 128; e += NTHR) { const int n = e >> 7, k = e & 127, t = n >> 4, co = n & 15, pp = k >> 1, ri = k & 1;
        const float c_r = cc[(co * 64 + pp) * 2], c_i = cc[(co * 64 + pp) * 2 + 1], w_r = pw[((t + 1) * 64 + pp) * 2], w_i = pw[((t + 1) * 64 + pp) * 2 + 1];
        Wy[e] = (bf16_t)f2bf(ri ? -(c_r * w_i + c_i * w_r) : (c_r * w_r - c_i * w_i)); }
    __syncthreads();
}

__device__ __forceinline__ void ln_row(const float* src, const float* g, const float* b, float* dst, bf16_t* dstb, int lane) {
    f32x4 v[4]; float s = 0.f;
#pragma unroll
    for (int j = 0; j < 4; ++j) { v[j] = *(const f32x4*)(src + 256 * j + 4 * lane); s += (v[j].x + v[j].y) + (v[j].z + v[j].w); }
    const float mean = wave_sum(s) * (1.f / 1024.f); float s2 = 0.f;
#pragma unroll
    for (int j = 0; j < 4; ++j) { v[j] = v[j] - mean; s2 += (v[j].x * v[j].x + v[j].y * v[j].y) + (v[j].z * v[j].z + v[j].w * v[j].w); }
    const float rstd = 1.f / sqrtf(wave_sum(s2) * (1.f / 1024.f) + LN_EPS_);
#pragma unroll
    for (int j = 0; j < 4; ++j) { const f32x4 gg = *(const f32x4*)(g + 256 * j + 4 * lane), bv = *(const f32x4*)(b + 256 * j + 4 * lane);
        const f32x4 o = v[j] * rstd * gg + bv; *(f32x4*)(dst + 256 * j + 4 * lane) = o;
        if (dstb) { u32x2 w; w.x = pk2(o.x, o.y); w.y = pk2(o.z, o.w); *(u32x2*)(dstb + 256 * j + 4 * lane) = w; } }
}

template <int NR, bool SB = false>
__device__ __forceinline__ void ln_rows(const void* srcv, const float* g, const float* b, float* dst, bf16_t* dstb, unsigned char* d8, int lane) {
    f32x4 v[NR][4]; float s[NR], s2[NR];
#pragma unroll
    for (int r = 0; r < NR; ++r) { s[r] = 0.f;
#pragma unroll
        for (int j = 0; j < 4; ++j) {
            if (SB) { const u32x2 w = *(const u32x2*)((const bf16_t*)srcv + (size_t)r * 1024 + 256 * j + 4 * lane); v[r][j] = (f32x4){bflo(w.x), bfhi(w.x), bflo(w.y), bfhi(w.y)}; }
            else v[r][j] = *(const f32x4*)((const float*)srcv + (size_t)r * 1024 + 256 * j + 4 * lane);
            s[r] += (v[r][j].x + v[r][j].y) + (v[r][j].z + v[r][j].w); } }
    wave_sum_n<NR>(s);
#pragma unroll
    for (int r = 0; r < NR; ++r) { const float mean = s[r] * (1.f / 1024.f); s2[r] = 0.f;
#pragma unroll
        for (int j = 0; j < 4; ++j) { v[r][j] = v[r][j] - mean; s2[r] += (v[r][j].x * v[r][j].x + v[r][j].y * v[r][j].y) + (v[r][j].z * v[r][j].z + v[r][j].w * v[r][j].w); } }
    wave_sum_n<NR>(s2);
#pragma unroll
    for (int j = 0; j < 4; ++j) { const f32x4 gg = *(const f32x4*)(g + 256 * j + 4 * lane), bv = *(const f32x4*)(b + 256 * j + 4 * lane);
#pragma unroll
        for (int r = 0; r < NR; ++r) { const float rstd = 1.f / sqrtf(s2[r] * (1.f / 1024.f) + LN_EPS_);
            const f32x4 o = v[r][j] * rstd * gg + bv; if (dst) *(f32x4*)(dst + (size_t)r * 1024 + 256 * j + 4 * lane) = o;
            if (dstb) { u32x2 w; w.x = pk2(o.x, o.y); w.y = pk2(o.z, o.w); *(u32x2*)(dstb + (size_t)r * 1024 + 256 * j + 4 * lane) = w; }
            if (d8) { unsigned w8 = cvt_pk_fp8_f32_(o.x, o.y, 0u, false); w8 = cvt_pk_fp8_f32_(o.z, o.w, w8, true); *(unsigned*)(d8 + (size_t)r * 1024 + 256 * j + 4 * lane) = w8; } } }
}
__device__ __forceinline__ void phase_prologue(const KP& p, unsigned char* lds) {
    const int tid = TIDX(), lane = tid & 63, wave = tid >> 6;
    int G = GDIM(), bid = BIDX();
    for (int it = bid; it < L_ * 16; it += G) s5_tables(p, it >> 4, it & 15, lds);
    if (G >= 4 * L_ * 16) { if (bid < L_ * 16) return; bid -= L_ * 16; G -= L_ * 16; }
    float* scr = (float*)lds + wave * (64 * 33 + 16);
    const int gw = bid * NWAVE + wave, NGW = G * NWAVE;
    constexpr int I_WINT = (WIN_ROWS / 32) * 16, I_BR = 4 * 4 * 32, I_OUT = 16 * 32, I_Q = 16 * 64, I_PL = 4 * 32, I_PG = 16 * 32, I_GL = 4 * 8;
    constexpr int PER_L = I_WINT + I_BR + I_OUT + I_Q + I_PL + I_PG + I_GL;
    for (int it = gw; it < L_ * PER_L; it += NGW) {
        const int l = it / PER_L; int r = it % PER_L; const Ptrs P = make_ptrs(p.ws, l);
        if (r < I_WINT) { transpose_item<true>(p.in[I_WIN] + (size_t)l * 1024 * IN_COLS, IN_COLS, P.WinT, 1024, 0, r & 15, r >> 4, scr, lane); continue; } r -= I_WINT;
        if (r < I_BR) { const int b = r >> 7, rr = r & 127; transpose_item<false>(p.in[I_WBR] + ((size_t)l * 4 + b) * 256 * 1024, 1024, P.WbrT, 1024, 256 * b, rr & 3, rr >> 2, scr, lane); continue; } r -= I_BR;
        if (r < I_OUT) { transpose_item<false>(p.in[I_WOUT] + (size_t)l * 1024 * 1024, 1024, P.WoutT, 1024, 0, r & 15, r >> 4, scr, lane); continue; } r -= I_OUT;
        if (r < I_Q) { transpose_item<false>(p.in[I_WQ] + (size_t)l * 1024 * 2048, 2048, P.WqT, 1024, 0, r & 15, r >> 4, scr, lane); continue; } r -= I_Q;
        if (r < I_PL) { transpose_item<false>(p.in[I_PLEW] + (size_t)l * 256 * 1024, 1024, P.PleT, 256, 0, r & 3, r >> 2, scr, lane); continue; } r -= I_PL;
        if (r < I_PG) { transpose_item<false>(p.in[I_PLEG] + (size_t)l * 1024 * 1024, 1024, P.PleGT, 1024, 0, r & 15, r >> 4, scr, lane); continue; } r -= I_PG;
        transpose_item<false>(p.in[I_GLUW] + (size_t)l * 256 * 256, 256, P.GluT, 256, 0, r & 3, r >> 2, scr, lane);
    }
    const size_t gt = (size_t)bid * NTHR + tid, NGT = (size_t)G * NTHR;
    { bf16_t* K12 = (bf16_t*)(p.ws + WS_K12);
      for (size_t i = gt; i < (size_t)L_ * 2 * 16384 / 8; i += NGT) { const size_t e = i * 8; const int l = (int)(e / 32768), r = (int)(e % 32768); const float* s = (r < 16384 ? p.in[I_K1] : p.in[I_K2]) + (size_t)l * 16384 + (r & 16383);
        const f32x4 a = *(const f32x4*)s, b = *(const f32x4*)(s + 4); u32x4 o; o.x = pk2(a.x, a.y); o.y = pk2(a.z, a.w); o.z = pk2(b.x, b.y); o.w = pk2(b.z, b.w); *(u32x4*)(K12 + e) = o; } }
    { bf16_t* hb = (bf16_t*)(p.ws + WS_HB);
      unsigned char* h8a = p.ws + WS_R1 + R1_H8; unsigned char* h8b = p.ws + WS_H8T;
      for (int m = 4 * gw; m < T_; m += 4 * NGW) ln_rows<4>(p.in[I_X] + (size_t)m * 1024, p.in[I_LNIN_G], p.in[I_LNIN_B], (float*)nullptr, hb + (size_t)m * 1024, m < H8_SPLIT ? h8a + (size_t)m * 1024 : h8b + (size_t)(m - H8_SPLIT) * 1024, lane); }
}
__device__ __forceinline__ void conv_unit(const KP& p, const Ptrs& P, int l, int unit, unsigned char* lds) {
    bf16_t* hbuf = (bf16_t*)lds;
    float* obuf = (float*)(lds + 94 * 256 * 2);
    const int tid = TIDX(), lane = tid & 63, wave = tid >> 6;
    const int tiles_per_seq = S_ / 64, b = unit / tiles_per_seq, t0 = (unit % tiles_per_seq) * 64;
    for (int e = tid; e < 94 * 32; e += NTHR) { const int r = e >> 5, c8 = (e & 31) * 8; const int t = t0 - 30 + r;
        u32x4 o = (u32x4){0u, 0u, 0u, 0u};
        if (t >= 0) { const bf16_t* row = P.proj + (size_t)(b * S_ + t) * PJ; const u32x4 v = *(const u32x4*)(row + C_CV + c8), g = *(const u32x4*)(row + C_CG + c8);
            o.x = pk2(bflo(v.x) * sigmoidf_(bflo(g.x)), bfhi(v.x) * sigmoidf_(bfhi(g.x))); o.y = pk2(bflo(v.y) * sigmoidf_(bflo(g.y)), bfhi(v.y) * sigmoidf_(bfhi(g.y)));
            o.z = pk2(bflo(v.z) * sigmoidf_(bflo(g.z)), bfhi(v.z) * sigmoidf_(bfhi(g.z))); o.w = pk2(bflo(v.w) * sigmoidf_(bflo(g.w)), bfhi(v.w) * sigmoidf_(bfhi(g.w))); }
        *(u32x4*)(hbuf + r * 256 + c8) = o; }
    __syncthreads();
    { const int c = tid & 255, half = tid >> 8; float w[31], x[62];
#pragma unroll
      for (int j = 0; j < 31; ++j) w[j] = p.in[I_CONVW][(l * 31 + j) * 256 + c];
      const float cb = p.in[I_CONVB][l * 256 + c];
#pragma unroll
      for (int j = 0; j < 62; ++j) x[j] = bf2f(hbuf[(half * 32 + j) * 256 + c]);
#pragma unroll
      for (int tt = 0; tt < 32; ++tt) { float s = cb;
#pragma unroll
          for (int j = 0; j < 31; ++j) s += w[j] * x[tt + j];
          obuf[(half * 32 + tt) * 256 + c] = s; } }
    __syncthreads();
    { const f32x4 g = *(const f32x4*)(p.in[I_CLNG] + l * 256 + 4 * lane), bb = *(const f32x4*)(p.in[I_CLNB] + l * 256 + 4 * lane);
      f32x4 vv[8]; float m1[8], m2[8];
#pragma unroll
      for (int i = 0; i < 8; ++i) { vv[i] = *(const f32x4*)(obuf + (wave * 8 + i) * 256 + 4 * lane); m1[i] = (vv[i].x + vv[i].y) + (vv[i].z + vv[i].w); }
      wave_sum_n<8>(m1);
#pragma unroll
      for (int i = 0; i < 8; ++i) { vv[i] = vv[i] - m1[i] * (1.f / 256.f); m2[i] = (vv[i].x * vv[i].x + vv[i].y * vv[i].y) + (vv[i].z * vv[i].z + vv[i].w * vv[i].w); }
      wave_sum_n<8>(m2);
#pragma unroll
      for (int i = 0; i < 8; ++i) { const int t = wave * 8 + i; const float rstd = 1.f / sqrtf(m2[i] * (1.f / 256.f) + LN_EPS_);
          f32x4 z = vv[i] * rstd * g + bb; u32x2 w; w.x = pk2(z.x * sigmoidf_(z.x), z.y * sigmoidf_(z.y)); w.y = pk2(z.z * sigmoidf_(z.z), z.w * sigmoidf_(z.w));
          *(u32x2*)(P.ycat + (size_t)(b * S_ + t0 + t) * 1024 + 768 + 4 * lane) = w; } }
    __syncthreads();
}

constexpr int S5_NCH = S_ / 64;
constexpr int S5_UPITCH = 1032;
constexpr int S5_XPITCH = 136;
__device__ __forceinline__ void s5_unit(const KP& p, const Ptrs& P, int l, int unit, unsigned char* lds) {
    const int b = unit >> 4, g = unit & 15;
    bf16_t* Uc = (bf16_t*)lds;
    bf16_t* Kc = (bf16_t*)(lds + 66048);
    float* Xe = (float*)(lds + 66048 + 32768);
    bf16_t* Xs = (bf16_t*)(lds + 66048 + 65536);
    const int tid = TIDX(), lane = tid & 63, wave = tid >> 6, r32 = lane & 31, hi = lane >> 5;
    { u32x4 v[8], kc[4];
#pragma unroll
      for (int j = 0; j < 8; ++j) { const int e = tid + j * NTHR, s = e >> 1, hf = e & 1; v[j] = (u32x4){0u, 0u, 0u, 0u};
          if (s < S_) v[j] = *(const u32x4*)(P.proj + (size_t)(b * S_ + s) * PJ + C_S5 + 16 * g + 8 * hf); }
#pragma unroll
      for (int j = 0; j < 4; ++j) kc[j] = *(const u32x4*)(P.S5Kc + (size_t)g * 16384 + (tid + j * NTHR) * 8);
#pragma unroll
      for (int j = 0; j < 8; ++j) { const int e = tid + j * NTHR, s = e >> 1, hf = e & 1; *(u32x4*)(Uc + (s >> 6) * S5_UPITCH + (s & 63) * 16 + 8 * hf) = v[j]; }
#pragma unroll
      for (int j = 0; j < 4; ++j) *(u32x4*)(Kc + (tid + j * NTHR) * 8) = kc[j]; }
    __syncthreads();
    { const int ntile = wave & 3, kh = wave >> 2; f32x16 acc = {};
      const bf16_t* wrow = P.S5Wx + ((size_t)g * 128 + ntile * 32 + r32) * 1024 + kh * 512 + 8 * hi;
      const bf16_t* urow = Uc + r32 * S5_UPITCH + kh * 512 + 8 * hi;
      for (int k8 = 0; k8 < 32; k8 += 8) { bf16x8 bw[8];
#pragma unroll
          for (int j = 0; j < 8; ++j) bw[j] = *(const bf16x8*)(wrow + (k8 + j) * 16);
#pragma unroll
          for (int j = 0; j < 8; ++j) { const bf16x8 a = *(const bf16x8*)(urow + (k8 + j) * 16); acc = MFMA32(a, bw[j], acc); } }
#pragma unroll
      for (int r = 0; r < 16; ++r) { const int c = (r & 3) + 8 * (r >> 2) + 4 * hi; Xe[(kh * 32 + c) * 128 + ntile * 32 + r32] = acc[r]; } }
    __syncthreads();
    if (tid < 64) { const float lr = P.S5LL[(g * 64 + tid) * 2], li = P.S5LL[(g * 64 + tid) * 2 + 1]; float xr = 0.f, xi = 0.f;
        for (int c = 0; c < 32; ++c) { Xs[c * S5_XPITCH + 2 * tid] = (bf16_t)f2bf(xr); Xs[c * S5_XPITCH + 2 * tid + 1] = (bf16_t)f2bf(xi);
            const float er = Xe[c * 128 + 2 * tid] + Xe[(32 + c) * 128 + 2 * tid], ei = Xe[c * 128 + 2 * tid + 1] + Xe[(32 + c) * 128 + 2 * tid + 1];
            const float nr = lr * xr - li * xi + er, ni = lr * xi + li * xr + ei; xr = nr; xi = ni; } }
    __syncthreads();
    { const int tt = r32 >> 4, co = r32 & 15; const float dsk = p.in[I_S5D][l * 256 + 16 * g + co];
      for (int q = 0; q < 4; ++q) { const int ntile = wave + 8 * q, t0 = 2 * ntile; f32x16 acc = {};
          const bf16_t* urow = Uc + r32 * S5_UPITCH + 8 * hi;
          for (int s = 0; s <= t0 + 1; ++s) { const int tau = t0 + tt - s; bf16x8 bk = (bf16x8){0, 0, 0, 0, 0, 0, 0, 0};
              if (tau >= 0) bk = *(const bf16x8*)(Kc + (tau * 16 + co) * 16 + 8 * hi);
              const bf16x8 a = *(const bf16x8*)(urow + s * 16); acc = MFMA32(a, bk, acc); }
          const bf16_t* wy = P.S5Wy + ((size_t)g * 1024 + ntile * 32 + r32) * 128 + 8 * hi; const bf16_t* xrow = Xs + r32 * S5_XPITCH + 8 * hi;
#pragma unroll
          for (int ks = 0; ks < 8; ++ks) { const bf16x8 a = *(const bf16x8*)(xrow + ks * 16); const bf16x8 bw = *(const bf16x8*)(wy + ks * 16); acc = MFMA32(a, bw, acc); }
#pragma unroll
          for (int r = 0; r < 16; ++r) { const int c = (r & 3) + 8 * (r >> 2) + 4 * hi; const int s = c * 64 + t0 + tt;
              if (s < S_) { const float uu = bf2f(Uc[c * S5_UPITCH + (t0 + tt) * 16 + co]); const float y = acc[r] + dsk * uu;
                  P.ycat[(size_t)(b * S_ + s) * 1024 + 256 + 16 * g + co] = (bf16_t)f2bf(gelu_erf(y)); } } } }
    __syncthreads();
}
constexpr float LOG2E_ = 1.4426950408889634f;
__device__ __forceinline__ float log_sigmoid_(float x) { return fminf(x, 0.f) - log1pf(__expf(-fabsf(x))); }
__device__ __forceinline__ void fox_unit(const KP& p, const Ptrs& P, int l, int unit, unsigned char* lds) {
    constexpr int NQB = S_ / 256;
    const int bh = unit / NQB, qb = (unit >= (NB_ * 4 * NQB) / 2) ? NQB - 1 - unit % NQB : unit % NQB, b = bh >> 2, h = bh & 3, q0 = qb * 256;
    float* cl = (float*)lds;
    unsigned char* Kt = lds + S_ * 4;
    unsigned char* Vt = Kt + 8192;
    float* wsf = (float*)(Kt + 32768);
    float* sc = wsf + 256;
    const int tid = TIDX(), lane = tid & 63, wave = tid >> 6, r32 = lane & 31, hi = lane >> 5;
    const int qend = q0 + 256;
    { constexpr int PER = (S_ + 511) / 512; const float bf = p.in[I_BF][l * 4 + h]; float loc[PER]; float s = 0.f;
#pragma unroll
      for (int i = 0; i < PER; ++i) { const int t = tid * PER + i; float v = 0.f;
          if (t < qend) v = log_sigmoid_(bf2f(P.proj[(size_t)(b * S_ + t) * PJ + C_FL + h]) + bf) * LOG2E_;
          s += v; loc[i] = s; }
      sc[tid] = s; __syncthreads();
      for (int off = 1; off < 512; off <<= 1) { const float v = sc[tid] + (tid >= off ? sc[tid - off] : 0.f); __syncthreads(); sc[tid] = v; __syncthreads(); }
      const float base = sc[tid] - s;
#pragma unroll
      for (int i = 0; i < PER; ++i) { const int t = tid * PER + i; if (t < S_) cl[t] = base + loc[i]; }
      __syncthreads(); }
    const int qrow = q0 + 32 * wave + r32;
    constexpr float C2 = 0.125f * LOG2E_;
    bf16x8 qr[4];
    { const bf16_t* qp = P.proj + (size_t)(b * S_ + qrow) * PJ + C_FQ + 64 * h + 8 * hi;
#pragma unroll
      for (int d0 = 0; d0 < 4; ++d0) { const u32x4 w = *(const u32x4*)(qp + 16 * d0);
          u32x4 o; o.x = pk2(bflo(w.x) * C2, bfhi(w.x) * C2); o.y = pk2(bflo(w.y) * C2, bfhi(w.y) * C2); o.z = pk2(bflo(w.z) * C2, bfhi(w.z) * C2); o.w = pk2(bflo(w.w) * C2, bfhi(w.w) * C2);
          qr[d0] = __builtin_bit_cast(bf16x8, o); } }
    const float clq = cl[qrow];
    float mrun = -INFINITY, lrun = 0.f; f32x16 o0 = {}, o1 = {};
    const int NT = qend / 64;
    const int srow = tid >> 3, sch = tid & 7;
    const bf16_t* kg = P.proj + (size_t)(b * S_ + srow) * PJ + C_FK + 64 * h + 8 * sch;
    const bf16_t* vg = P.vtr + (size_t)(64 * h + srow) * T_ + (size_t)b * S_ + 8 * sch;
    const int koff = srow * 128 + ((sch ^ ((srow >> 1) & 7)) * 16);
    const int voffa = srow * 128 + (((2 * sch) ^ ((srow >> 1) & 15)) * 8), voffb = srow * 128 + (((2 * sch + 1) ^ ((srow >> 1) & 15)) * 8);
    u32x4 kreg = *(const u32x4*)kg, vreg = *(const u32x4*)vg;
    *(u32x4*)(Kt + koff) = kreg; *(u32x2*)(Vt + voffa) = (u32x2){vreg.x, vreg.y}; *(u32x2*)(Vt + voffb) = (u32x2){vreg.z, vreg.w};
    if (NT > 1) { kreg = *(const u32x4*)(kg + (size_t)64 * PJ); vreg = *(const u32x4*)(vg + 64); }
    __syncthreads();
    for (int jt = 0; jt < NT; ++jt) {
        const int kv0 = jt * 64; const unsigned char* Kb = Kt + (jt & 1) * 16384; const unsigned char* Vb = Vt + (jt & 1) * 16384;
        if (kv0 <= q0 + 32 * wave + 31) {
            f32x16 pt[2];
#pragma unroll
            for (int kvt = 0; kvt < 2; ++kvt) { const int row = 32 * kvt + r32; f32x16 acc;
#pragma unroll
                for (int g4 = 0; g4 < 4; ++g4) { const f32x4 c4 = *(const f32x4*)(cl + kv0 + 32 * kvt + 8 * g4 + 4 * hi);
#pragma unroll
                    for (int e = 0; e < 4; ++e) acc[4 * g4 + e] = clq - c4[e]; }
#pragma unroll
                for (int d0 = 0; d0 < 4; ++d0) { const bf16x8 a = *(const bf16x8*)(Kb + row * 128 + (((2 * d0 + hi) ^ ((row >> 1) & 7)) * 16)); acc = MFMA32(a, qr[d0], acc); }
                pt[kvt] = acc; }
            if (kv0 + 63 > q0 + 32 * wave) {
#pragma unroll
                for (int kvt = 0; kvt < 2; ++kvt)
#pragma unroll
                    for (int r = 0; r < 16; ++r) { const int key = kv0 + 32 * kvt + (r & 3) + 8 * (r >> 2) + 4 * hi; if (key > qrow) pt[kvt][r] = -INFINITY; } }
            float mx = -INFINITY;
#pragma unroll
            for (int kvt = 0; kvt < 2; ++kvt)
#pragma unroll
                for (int r = 0; r < 16; ++r) mx = fmaxf(mx, pt[kvt][r]);
            mx = fmaxf(mx, __shfl_xor(mx, 32));
            const float mnew = fmaxf(mrun, mx), alpha = FAST_EXP2(mrun - mnew); mrun = mnew;
            float ls = 0.f;
#pragma unroll
            for (int kvt = 0; kvt < 2; ++kvt)
#pragma unroll
                for (int r = 0; r < 16; ++r) { const float e = FAST_EXP2(pt[kvt][r] - mnew); pt[kvt][r] = e; ls += e; }
            lrun = lrun * alpha + ls;
            float* wf = wsf + wave * 32;
            WAVE_SYNC(); if (hi == 0) wf[r32] = alpha; WAVE_SYNC();
#pragma unroll
            for (int g4 = 0; g4 < 4; ++g4) { const f32x4 f = *(const f32x4*)(wf + 8 * g4 + 4 * hi);
#pragma unroll
                for (int e = 0; e < 4; ++e) { o0[4 * g4 + e] *= f[e]; o1[4 * g4 + e] *= f[e]; } }
#pragma unroll
            for (int s = 0; s < 4; ++s) { const int kvt = s >> 1, rb = 8 * (s & 1);
                u32x4 pw; pw.x = pk2(pt[kvt][rb + 0], pt[kvt][rb + 1]); pw.y = pk2(pt[kvt][rb + 2], pt[kvt][rb + 3]); pw.z = pk2(pt[kvt][rb + 4], pt[kvt][rb + 5]); pw.w = pk2(pt[kvt][rb + 6], pt[kvt][rb + 7]);
                const bf16x8 pa = __builtin_bit_cast(bf16x8, pw);
#pragma unroll
                for (int dt = 0; dt < 2; ++dt) { const int d = 32 * dt + r32; const int sw = (d >> 1) & 15;
                    const u32x2 va = *(const u32x2*)(Vb + d * 128 + (((4 * s + hi) ^ sw) * 8)), vb = *(const u32x2*)(Vb + d * 128 + (((4 * s + 2 + hi) ^ sw) * 8));
                    const bf16x8 vf = __builtin_bit_cast(bf16x8, (u32x4){va.x, va.y, vb.x, vb.y});
                    if (dt == 0) o0 = MFMA32(pa, vf, o0); else o1 = MFMA32(pa, vf, o1); } }
        }
        if (jt + 1 < NT) { unsigned char* Kn = Kt + ((jt + 1) & 1) * 16384; unsigned char* Vn = Vt + ((jt + 1) & 1) * 16384;
            *(u32x4*)(Kn + koff) = kreg; *(u32x2*)(Vn + voffa) = (u32x2){vreg.x, vreg.y}; *(u32x2*)(Vn + voffb) = (u32x2){vreg.z, vreg.w};
            if (jt + 2 < NT) { kreg = *(const u32x4*)(kg + (size_t)(kv0 + 128) * PJ); vreg = *(const u32x4*)(vg + kv0 + 128); } }
        __syncthreads();
    }
    { const float lt = lrun + __shfl_xor(lrun, 32); float* wf = wsf + wave * 32;
      WAVE_SYNC(); if (hi == 0) wf[r32] = 1.0f / lt; WAVE_SYNC();
      bf16_t* orow = P.ycat + (size_t)(b * S_ + q0 + 32 * wave) * 1024 + 512 + 64 * h + r32;
#pragma unroll
      for (int r = 0; r < 16; ++r) { const int qq = (r & 3) + 8 * (r >> 2) + 4 * hi; const float f = wf[qq];
          orow[(size_t)qq * 1024] = (bf16_t)f2bf(o0[r] * f); orow[(size_t)qq * 1024 + 32] = (bf16_t)f2bf(o1[r] * f); } }
    __syncthreads();
}

constexpr int RW_NCH = S_ / 64;
constexpr int RWP = 72;
constexpr int RW_ARR = 64 * RWP * 2;
constexpr int RW_SCRP = 388;
__device__ __forceinline__ void rw_stage_weights(const KP& p, int l, int h, bf16_t* wb, int tid) {
    for (int e = tid; e < 2048; e += NTHR) { const int m = e >> 4, c4 = (e & 15) * 4;
        if (m < 32) { const f32x4 v = *(const f32x4*)(p.in[I_A2] + (l * 32 + m) * 256 + 64 * h + c4);
#pragma unroll
            for (int q = 0; q < 4; ++q) wb[(c4 + q) * 40 + m] = (bf16_t)f2bf(v[q]); }
        else if (m < 64) { const f32x4 v = *(const f32x4*)(p.in[I_W2] + (l * 32 + m - 32) * 256 + 64 * h + c4);
#pragma unroll
            for (int q = 0; q < 4; ++q) wb[2560 + (c4 + q) * 40 + (m - 32)] = (bf16_t)f2bf(v[q]); }
        else { const f32x4 v = *(const f32x4*)(p.in[I_G2] + (l * 64 + m - 64) * 256 + 64 * h + c4);
#pragma unroll
            for (int q = 0; q < 4; ++q) wb[5120 + (c4 + q) * 72 + (m - 64)] = (bf16_t)f2bf(v[q]); } }
    __syncthreads();
}
__device__ __forceinline__ bf16x8 rw_pack8(const float* q) { const f32x4 a = *(const f32x4*)q, b = *(const f32x4*)(q + 4);
    u32x4 w; w.x = pk2(a.x, a.y); w.y = pk2(a.z, a.w); w.z = pk2(b.x, b.y); w.w = pk2(b.z, b.w); return __builtin_bit_cast(bf16x8, w); }
template <int NT, bool NEED_W, bool NEED_G>
__device__ __forceinline__ void rw_prep(const KP& p, const Ptrs& P, int l, int b, int h, int tpos0, float* scr, const bf16_t* wb, int lane,
                                        float (&r)[NT], float (&lw)[NT], float (&k2)[NT], float (&v)[NT], float (&ain)[NT], float (&bin)[NT], float (&g)[NT], float (&rk)[NT]) {
    constexpr int NIT = (NT * 40 + 63) / 64;
    u32x4 cur[NIT], prv[NIT];
#pragma unroll
    for (int i = 0; i < NIT; ++i) { const int e = lane + 64 * i; const int tt = e / 40, ch = e % 40; const int t = tpos0 + tt;
        const int col = ch < 8 ? C_R + 64 * h + 8 * ch : ch < 16 ? C_K + 64 * h + 8 * (ch - 8) : ch < 24 ? C_V + 64 * h + 8 * (ch - 16) : C_HW + 8 * (ch - 24);
        cur[i] = (u32x4){0u, 0u, 0u, 0u}; prv[i] = (u32x4){0u, 0u, 0u, 0u};
        if (e < NT * 40) { const bf16_t* row = P.proj + (size_t)(b * S_ + t) * PJ + col; cur[i] = *(const u32x4*)row; if (t > 0) prv[i] = *(const u32x4*)(row - PJ); } }
#pragma unroll
    for (int i = 0; i < NIT; ++i) { const int e = lane + 64 * i; const int tt = e / 40, ch = e % 40;
        const int col = ch < 8 ? C_R + 64 * h + 8 * ch : ch < 16 ? C_K + 64 * h + 8 * (ch - 8) : ch < 24 ? C_V + 64 * h + 8 * (ch - 16) : C_HW + 8 * (ch - 24);
        const int idx = ch < 24 ? 8 * ch : 192 + 8 * (ch - 24);
        if (e < NT * 40) { const f32x4 m0 = *(const f32x4*)(p.in[I_MU] + l * 896 + col), m1 = *(const f32x4*)(p.in[I_MU] + l * 896 + col + 4);
            float z[8] = {bflo(cur[i].x), bfhi(cur[i].x), bflo(cur[i].y), bfhi(cur[i].y), bflo(cur[i].z), bfhi(cur[i].z), bflo(cur[i].w), bfhi(cur[i].w)};
            const float zp[8] = {bflo(prv[i].x), bfhi(prv[i].x), bflo(prv[i].y), bfhi(prv[i].y), bflo(prv[i].z), bfhi(prv[i].z), bflo(prv[i].w), bfhi(prv[i].w)};
#pragma unroll
            for (int q = 0; q < 8; ++q) { float zs = z[q] + (zp[q] - z[q]) * (q < 4 ? m0[q & 3] : m1[q & 3]);
                if (ch >= 24 && ch < 28) zs = 1.0f - 2.0f * FAST_RCP(1.0f + FAST_EXP2(zs * 2.8853900817779268f));
                else if (ch >= 32) zs = sigmoidf_(zs);
                z[q] = zs; }
            *(f32x4*)(scr + tt * RW_SCRP + idx) = (f32x4){z[0], z[1], z[2], z[3]}; *(f32x4*)(scr + tt * RW_SCRP + idx + 4) = (f32x4){z[4], z[5], z[6], z[7]}; } }
    WAVE_SYNC();
    { const int fr = lane & 15, fq = lane >> 4; const float* hrow = scr + (fr & 7) * RW_SCRP + 192 + 8 * fq;
      const bf16x8 fw = rw_pack8(hrow), fa = rw_pack8(hrow + 32), fg0 = rw_pack8(hrow + 64), fg1 = rw_pack8(hrow + 96);
      WAVE_SYNC();
#pragma unroll
      for (int nt = 0; nt < 4; ++nt) { const f32x4 z4 = (f32x4){0.f, 0.f, 0.f, 0.f};
          const f32x4 da = MFMA16(fa, *(const bf16x8*)(wb + (16 * nt + fr) * 40 + 8 * fq), z4);
          f32x4 dw = z4, dg = z4;
          if (NEED_W) dw = MFMA16(fw, *(const bf16x8*)(wb + 2560 + (16 * nt + fr) * 40 + 8 * fq), z4);
          if (NEED_G) { dg = MFMA16(fg0, *(const bf16x8*)(wb + 5120 + (16 * nt + fr) * 72 + 8 * fq), z4); dg = MFMA16(fg1, *(const bf16x8*)(wb + 5120 + (16 * nt + fr) * 72 + 32 + 8 * fq), dg); }
          if (fq < 2) {
#pragma unroll
              for (int q = 0; q < 4; ++q) { float* o = scr + (4 * fq + q) * RW_SCRP + 16 * nt + fr; o[192] = da[q]; if (NEED_W) o[256] = dw[q]; if (NEED_G) o[320] = dg[q]; } } }
      WAVE_SYNC(); }
    const int j = lane, cj = 64 * h + j; float wl[NT], al[NT], gg[NT];
    const float w0 = p.in[I_W0][l * 256 + cj], a0 = p.in[I_A0][l * 256 + cj];
#pragma unroll
    for (int tt = 0; tt < NT; ++tt) { al[tt] = a0 + scr[tt * RW_SCRP + 192 + j]; wl[tt] = NEED_W ? w0 + scr[tt * RW_SCRP + 256 + j] : w0; gg[tt] = NEED_G ? scr[tt * RW_SCRP + 320 + j] : 0.f; }
    const float kkw = p.in[I_KK][l * 256 + cj], kaw = p.in[I_KA][l * 256 + cj], rkw = p.in[I_RK][l * 256 + cj];
    float ssum[NT], rsum[NT], kkv[NT], av[NT];
#pragma unroll
    for (int tt = 0; tt < NT; ++tt) {
        const float a = sigmoidf_(al[tt]); av[tt] = a;
        const float rr = scr[tt * RW_SCRP + j], k = scr[tt * RW_SCRP + 64 + j], vv = scr[tt * RW_SCRP + 128 + j];
        const float kk2 = k * (1.f + (a - 1.f) * kaw);
        r[tt] = rr; k2[tt] = kk2; v[tt] = vv;
        const float kk = k * kkw; kkv[tt] = kk; ssum[tt] = kk * kk; rsum[tt] = rr * kk2 * rkw; }
    if (NEED_W) wave_sum_n<NT>(ssum);
    if (NEED_G) wave_sum_n<NT>(rsum);
#pragma unroll
    for (int tt = 0; tt < NT; ++tt) {
        if (NEED_W) { const float x = -wl[tt]; const float sp = fmaxf(x, 0.f) + 0.6931471805599453f * FAST_LOG2(1.0f + FAST_EXP2(-1.4426950408889634f * fabsf(x)));
            lw[tt] = -FAST_EXP2(-1.4426950408889634f * (sp + 0.5f));
            const float kkn = kkv[tt] * FAST_RSQ(fmaxf(ssum[tt], 1e-24f));
            ain[tt] = -kkn; bin[tt] = kkn * av[tt]; }
        if (NEED_G) { g[tt] = gg[tt]; rk[tt] = rsum[tt]; }
    }
    WAVE_SYNC();
}
__device__ __forceinline__ bf16x8 ldsb8(const bf16_t* p) { return *(const bf16x8*)p; }
__device__ __forceinline__ f32x16 rw_tile(const bf16_t* X, const bf16_t* Y, int tm, int tn, int r32, int hi, f32x16 acc) {
    const bf16_t* xa = X + (32 * tm + r32) * RWP + 8 * hi; const bf16_t* yb = Y + (32 * tn + r32) * RWP + 8 * hi;
#pragma unroll
    for (int ks = 0; ks < 4; ++ks) acc = MFMA32(ldsb8(xa + 16 * ks), ldsb8(yb + 16 * ks), acc);
    return acc;
}
template <int STOP = 0>
__device__ __forceinline__ void rw_chunk_unit(const KP& p, const Ptrs& P, int l, int unit, unsigned char* lds) {
    MEMFENCE(); OPAQUE_S(unit);
    const int c = unit % RW_NCH, bh = unit / RW_NCH, b = bh >> 2, h = bh & 3, t0 = c * 64;
    bf16_t* AT = (bf16_t*)(lds + 0 * RW_ARR); bf16_t* RT = (bf16_t*)(lds + 1 * RW_ARR); bf16_t* BT = (bf16_t*)(lds + 2 * RW_ARR); bf16_t* KT = (bf16_t*)(lds + 3 * RW_ARR);
    bf16_t* BH = (bf16_t*)(lds + 4 * RW_ARR); bf16_t* KH = (bf16_t*)(lds + 5 * RW_ARR); bf16_t* VT = (bf16_t*)(lds + 6 * RW_ARR);
    bf16_t* AAK = (bf16_t*)(lds + 7 * RW_ARR); bf16_t* ARB = (bf16_t*)(lds + 8 * RW_ARR); bf16_t* ARK = (bf16_t*)(lds + 9 * RW_ARR);
    bf16_t* W1T = (bf16_t*)(lds + 10 * RW_ARR); bf16_t* UVT = (bf16_t*)(lds + 11 * RW_ARR);
    bf16_t* RHT = (bf16_t*)(lds + 12 * RW_ARR);
    float* ADG = (float*)(lds + 14 * RW_ARR);
    bf16_t* ABA = (bf16_t*)(lds + 14 * RW_ARR + 8192);
    float* WT = (float*)(lds + 14 * RW_ARR + 8192 + 32 * RWP * 2);
    float* GC = WT + 512;
    bf16_t* DAB = AT;
    const int tid = TIDX(), lane = tid & 63, wave = tid >> 6, r32 = lane & 31, hi = lane >> 5;
    float r[8], lw[8], k2[8], v[8], ain[8], bin[8], gg[8], rk[8];
    rw_stage_weights(p, l, h, (bf16_t*)(lds + 8 * 8 * RW_SCRP * 4), tid);
    rw_prep<8, true, true>(p, P, l, b, h, t0 + 8 * wave, (float*)lds + wave * (8 * RW_SCRP), (const bf16_t*)(lds + 8 * 8 * RW_SCRP * 4), lane, r, lw, k2, v, ain, bin, gg, rk);
#pragma unroll
    for (int i = 0; i < 8; ++i) { const size_t o = (size_t)(b * S_ + t0 + 8 * wave + i) * 256 + 64 * h + lane; P.rwGt[o] = (bf16_t)f2bf(gg[i]); P.rwRKV[o] = (bf16_t)f2bf(rk[i] * v[i]); }
    float Lloc[8]; { float s = 0.f;
#pragma unroll
      for (int i = 0; i < 8; ++i) { s += lw[i]; Lloc[i] = s; } }
    __syncthreads();
    if (STOP == 1) return;
    WT[wave * 64 + lane] = Lloc[7];
    __syncthreads();
    { float off = 0.f, tot = 0.f;
#pragma unroll
      for (int w = 0; w < 8; ++w) { const float x = WT[w * 64 + lane]; tot += x; if (w < wave) off += x; }
      if (wave == 0) GC[lane] = __expf(tot);
      unsigned bhp[4], khp[4], vtp[4], atp[4]; float pb = 0.f, pk = 0.f, pv = 0.f, pa = 0.f;
#pragma unroll
      for (int i = 0; i < 8; ++i) { const int t = 8 * wave + i; const float Lt = off + Lloc[i], Lp = Lt - lw[i];
          const float eL = __expf(Lt), eLp = __expf(Lp), einv = __expf(-Lt), eh = __expf(tot - Lt);
          const float xa = ain[i] * eLp;
          AT[t * RWP + lane] = (bf16_t)f2bf(xa); RT[t * RWP + lane] = (bf16_t)f2bf(r[i] * eL);
          BT[t * RWP + lane] = (bf16_t)f2bf(bin[i] * einv); KT[t * RWP + lane] = (bf16_t)f2bf(k2[i] * einv);
          const float xb = bin[i] * eh, xk = k2[i] * eh, xv = v[i];
          if (i & 1) { bhp[i >> 1] = pk2(pb, xb); khp[i >> 1] = pk2(pk, xk); vtp[i >> 1] = pk2(pv, xv); atp[i >> 1] = pk2(pa, xa); } else { pb = xb; pk = xk; pv = xv; pa = xa; } }
      *(u32x4*)(BH + lane * RWP + 8 * wave) = (u32x4){bhp[0], bhp[1], bhp[2], bhp[3]};
      *(u32x4*)(KH + lane * RWP + 8 * wave) = (u32x4){khp[0], khp[1], khp[2], khp[3]};
      *(u32x4*)(VT + lane * RWP + 8 * wave) = (u32x4){vtp[0], vtp[1], vtp[2], vtp[3]};
      *(u32x4*)(RHT + (64 + lane) * RWP + 8 * wave) = (u32x4){atp[0], atp[1], atp[2], atp[3]}; }
    __syncthreads();
#pragma unroll
    for (int jj = 0; jj < 2; ++jj) { const int job = wave + 8 * jj, mat = job >> 2, tm = (job >> 1) & 1, tn = job & 1;
        f32x16 acc = {};
        if (!(tm == 0 && tn == 1)) acc = rw_tile((mat & 2) ? RT : AT, (mat & 1) ? KT : BT, tm, tn, r32, hi, acc);
        const int s = 32 * tn + r32;
#pragma unroll
        for (int q = 0; q < 16; ++q) { const int t = 32 * tm + (q & 3) + 8 * (q >> 2) + 4 * hi;
            const bool keep = (mat & 2) ? (s <= t) : (s < t); const float x = keep ? acc[q] : 0.f;
            if (mat == 0) { if (tm == tn) ADG[(tm * 32 + (t & 31)) * 32 + (s & 31)] = x; else if (tm == 1) ABA[(t & 31) * RWP + s] = (bf16_t)f2bf(x); } else { bf16_t* D = (mat == 1) ? AAK : (mat == 2) ? ARB : ARK; D[t * RWP + s] = (bf16_t)f2bf(x); } } }
    __syncthreads();
    if (STOP == 2) return;
    if (wave < 4) { const int tm = wave >> 1, tn = wave & 1; f32x16 acc = {}; acc = rw_tile(VT, AAK, tm, tn, r32, hi, acc);
#pragma unroll
        for (int q = 0; q < 16; ++q) { const int i = 32 * tm + (q & 3) + 8 * (q >> 2) + 4 * hi; RHT[i * RWP + 32 * tn + r32] = (bf16_t)f2bf(acc[q]); } }
    else if (wave == 4) { float d[32]; const LAS float* ab = (const LAS float*)ADG + hi * 1024;
#pragma unroll
        for (int t = 0; t < 32; ++t) d[t] = (t == r32) ? 1.f : 0.f;
#pragma unroll
        for (int t = 1; t < 32; ++t) { float s0 = 0.f, s1 = 0.f;
#pragma unroll
            for (int s4 = 0; s4 < (t + 3) / 4; ++s4) { const f32x4 a4 = *(const LAS f32x4*)(ab + t * 32 + 4 * s4);
                s0 += a4[0] * d[4 * s4]; s1 += a4[1] * d[4 * s4 + 1]; s0 += a4[2] * d[4 * s4 + 2]; s1 += a4[3] * d[4 * s4 + 3]; }
            d[t] += s0 + s1; if ((t & 3) == 3) MEMFENCE(); }
        LAS bf16_t* D = (LAS bf16_t*)DAB + hi * 32 * RWP + r32;
#pragma unroll
        for (int t = 0; t < 32; ++t) D[t * RWP] = (bf16_t)f2bf(d[t]); }
    __syncthreads();
    if (wave < 4) { bf16_t* XT = (wave < 2 ? UVT : W1T) + (32 * (wave & 1)) * RWP;
        const bf16_t* rh = RHT + (32 * wave + r32) * RWP + 8 * hi;
        { f32x16 acc = {}; const bf16_t* da = DAB + r32 * RWP + 8 * hi;
#pragma unroll
          for (int ks = 0; ks < 2; ++ks) acc = MFMA32(ldsb8(rh + 16 * ks), ldsb8(da + 16 * ks), acc);
#pragma unroll
          for (int q = 0; q < 16; ++q) XT[((q & 3) + 8 * (q >> 2) + 4 * hi) * RWP + r32] = (bf16_t)f2bf(acc[q]); }
        WAVE_SYNC();
        { f32x16 acc; const bf16_t* rz = RHT + (32 * wave) * RWP + 32 + r32;
#pragma unroll
          for (int q = 0; q < 16; ++q) acc[q] = bf2f(rz[((q & 3) + 8 * (q >> 2) + 4 * hi) * RWP]);
          const bf16_t* xa = XT + r32 * RWP + 8 * hi; const bf16_t* ba = ABA + r32 * RWP + 8 * hi;
#pragma unroll
          for (int ks = 0; ks < 2; ++ks) acc = MFMA32(ldsb8(xa + 16 * ks), ldsb8(ba + 16 * ks), acc);
#pragma unroll
          for (int q = 0; q < 16; ++q) XT[((q & 3) + 8 * (q >> 2) + 4 * hi) * RWP + 32 + r32] = (bf16_t)f2bf(acc[q]); }
        WAVE_SYNC();
        { f32x16 acc = {}; const bf16_t* xz = XT + r32 * RWP + 32 + 8 * hi; const bf16_t* db = DAB + (32 + r32) * RWP + 8 * hi;
          const bf16x8 z0 = ldsb8(xz), z1 = ldsb8(xz + 16);
          acc = MFMA32(z0, ldsb8(db), acc); acc = MFMA32(z1, ldsb8(db + 16), acc);
          WAVE_SYNC();
#pragma unroll
          for (int q = 0; q < 16; ++q) XT[((q & 3) + 8 * (q >> 2) + 4 * hi) * RWP + 32 + r32] = (bf16_t)f2bf(acc[q]); } }
    __syncthreads();
    if (STOP == 3) return;
    const size_t chunk = (size_t)unit;
#pragma unroll
    for (int jj = 0; jj < 2; ++jj) { const int job = wave + 8 * jj, kind = job >> 2, tm = (job >> 1) & 1, tn = job & 1; f32x16 acc = {};
        const int col = 32 * tn + r32;
        if (kind == 0) { acc = rw_tile(BH, W1T, tm, tn, r32, hi, acc);
            bf16_t* PT = P.rwPT + chunk * 4096;
#pragma unroll
            for (int q = 0; q < 16; ++q) { const int row = 32 * tm + (q & 3) + 8 * (q >> 2) + 4 * hi; const float x = acc[q] + (row == col ? GC[row] : 0.f); PT[row * 64 + col] = (bf16_t)f2bf(x); } }
        else if (kind == 1) { acc = rw_tile(ARB, W1T, tm, tn, r32, hi, acc);
#pragma unroll
            for (int q = 0; q < 16; ++q) { const int t = 32 * tm + (q & 3) + 8 * (q >> 2) + 4 * hi; const float x = acc[q] + bf2f(RT[t * RWP + col]);
                P.rwQ[(size_t)(b * S_ + t0 + t) * 256 + 64 * h + col] = (bf16_t)f2bf(x); } }
        else if (kind == 2) { acc = rw_tile(UVT, BH, tm, tn, r32, hi, acc); acc = rw_tile(VT, KH, tm, tn, r32, hi, acc);
            unsigned* Gg = (unsigned*)(P.rwG + chunk * 4096) + (tm * 2 + tn) * 8 * 64 + lane;
#pragma unroll
            for (int q = 0; q < 8; ++q) Gg[q * 64] = pk2(acc[2 * q], acc[2 * q + 1]); }
        else { acc = rw_tile(ARB, UVT, tm, tn, r32, hi, acc); acc = rw_tile(ARK, VT, tm, tn, r32, hi, acc);
#pragma unroll
            for (int q = 0; q < 16; ++q) { const int t = 32 * tm + (q & 3) + 8 * (q >> 2) + 4 * hi; P.ycat[(size_t)(b * S_ + t0 + t) * 1024 + 64 * h + col] = (bf16_t)f2bf(acc[q]); } } }
    __syncthreads();
}
__device__ __forceinline__ void rw_state_unit(const KP& p, const Ptrs& P, int l, int unit, unsigned char* lds) {
    bf16_t* Sb = (bf16_t*)lds;
    const int tid = TIDX(), lane = tid & 63, wave = tid >> 6, r32 = lane & 31, hi = lane >> 5;
    const int ti = (wave >> 1) & 1, tj = wave & 1;
    f32x16 S = {};
    unsigned gq[8]; bf16x8 pq[4];
    if (wave < 4) { const size_t chunk = (size_t)unit * RW_NCH; const unsigned* Gg = (const unsigned*)(P.rwG + chunk * 4096) + (ti * 2 + tj) * 8 * 64 + lane;
#pragma unroll
        for (int q = 0; q < 8; ++q) gq[q] = Gg[q * 64];
        const bf16_t* pt = P.rwPT + chunk * 4096 + (32 * tj + r32) * 64 + 8 * hi;
#pragma unroll
        for (int ks = 0; ks < 4; ++ks) pq[ks] = *(const bf16x8*)(pt + 16 * ks); }
    for (int c = 0; c < RW_NCH; ++c) { const size_t chunk = (size_t)unit * RW_NCH + c;
        unsigned gn[8]; bf16x8 pn[4];
        if (wave < 4) { const size_t cn = chunk + (c + 1 < RW_NCH ? 1 : 0); const unsigned* Gg = (const unsigned*)(P.rwG + cn * 4096) + (ti * 2 + tj) * 8 * 64 + lane;
#pragma unroll
            for (int q = 0; q < 8; ++q) gn[q] = Gg[q * 64];
            const bf16_t* pt = P.rwPT + cn * 4096 + (32 * tj + r32) * 64 + 8 * hi;
#pragma unroll
            for (int ks = 0; ks < 4; ++ks) pn[ks] = *(const bf16x8*)(pt + 16 * ks);
#pragma unroll
            for (int q = 0; q < 16; ++q) Sb[(32 * ti + (q & 3) + 8 * (q >> 2) + 4 * hi) * RWP + 32 * tj + r32] = (bf16_t)f2bf(S[q]); }
        __syncthreads();
        { const int row = tid >> 3, ch = tid & 7; *(u32x4*)(P.rwS0 + chunk * 4096 + row * 64 + ch * 8) = *(const u32x4*)(Sb + row * RWP + ch * 8); }
        if (wave < 4) { f32x16 acc;
#pragma unroll
            for (int q = 0; q < 8; ++q) { acc[2 * q] = bflo(gq[q]); acc[2 * q + 1] = bfhi(gq[q]); }
            const bf16_t* sa = Sb + (32 * ti + r32) * RWP + 8 * hi;
#pragma unroll
            for (int ks = 0; ks < 4; ++ks) acc = MFMA32(ldsb8(sa + 16 * ks), pq[ks], acc);
            S = acc;
#pragma unroll
            for (int q = 0; q < 8; ++q) gq[q] = gn[q];
#pragma unroll
            for (int ks = 0; ks < 4; ++ks) pq[ks] = pn[ks]; }
        __syncthreads();
    }
}
template <bool DUMMY = false>
__device__ __forceinline__ void rw_out_unit(const KP& p, const Ptrs& P, int l, int unit, unsigned char* lds) {
    MEMFENCE(); OPAQUE_S(unit);
    const int c = unit % RW_NCH, bh = unit / RW_NCH, b = bh >> 2, h = bh & 3, t0 = c * 64;
    float* Yb = (float*)(lds + 81920);
    const int tid = TIDX(), lane = tid & 63, wave = tid >> 6, r32 = lane & 31, hi = lane >> 5;
    float g[8], rkv[8];
#pragma unroll
    for (int i = 0; i < 8; ++i) { const size_t o = (size_t)(b * S_ + t0 + 8 * wave + i) * 256 + 64 * h + lane; g[i] = bf2f(P.rwGt[o]); rkv[i] = bf2f(P.rwRKV[o]); }
    if (wave < 4) { const int tm = wave >> 1, tn = wave & 1; f32x16 acc; const int col = 32 * tn + r32;
        const bf16_t* yl = P.ycat + (size_t)(b * S_ + t0 + 32 * tm) * 1024 + 64 * h + col;
#pragma unroll
        for (int q = 0; q < 16; ++q) acc[q] = bf2f(yl[(size_t)((q & 3) + 8 * (q >> 2) + 4 * hi) * 1024]);
        const bf16_t* qa = P.rwQ + (size_t)(b * S_ + t0 + 32 * tm + r32) * 256 + 64 * h + 8 * hi; const bf16_t* sb = P.rwS0 + (size_t)unit * 4096 + (32 * tn + r32) * 64 + 8 * hi;
#pragma unroll
        for (int ks = 0; ks < 4; ++ks) acc = MFMA32(*(const bf16x8*)(qa + 16 * ks), *(const bf16x8*)(sb + 16 * ks), acc);
#pragma unroll
        for (int q = 0; q < 16; ++q) Yb[(32 * tm + (q & 3) + 8 * (q >> 2) + 4 * hi) * 64 + col] = acc[q]; }
    __syncthreads();
    const float gng = p.in[I_LNXG][l * 256 + 64 * h + lane], gnb = p.in[I_LNXB][l * 256 + 64 * h + lane];
    { float yv[8], m1[8], m2[8];
#pragma unroll
      for (int i = 0; i < 8; ++i) { yv[i] = Yb[(8 * wave + i) * 64 + lane]; m1[i] = yv[i]; }
      wave_sum_n<8>(m1);
#pragma unroll
      for (int i = 0; i < 8; ++i) { yv[i] -= m1[i] * (1.f / 64.f); m2[i] = yv[i] * yv[i]; }
      wave_sum_n<8>(m2);
#pragma unroll
      for (int i = 0; i < 8; ++i) { const int t = 8 * wave + i; const float yn = yv[i] * (1.0f / sqrtf(m2[i] * (1.f / 64.f) + GN_EPS_)) * gng + gnb; const float o = (yn + rkv[i]) * g[i];
        if (DUMMY) P.pb[(size_t)(b * S_ + t0 + t) * 256 + 64 * h + lane] = (bf16_t)f2bf(o);
        else P.ycat[(size_t)(b * S_ + t0 + t) * 1024 + 64 * h + lane] = (bf16_t)f2bf(o); } }
    __syncthreads();
}
#ifdef EMU_FP8_A
#define EMU_AUX77 u.aux = 77;
#else
#define EMU_AUX77
#endif
__device__ __forceinline__ void tile_map(int L, int nM, int nN, int& pm, int& pn) {
    const int nwg = nM * nN, q = nwg / 8, r = nwg % 8, xcd = L % 8, off = L / 8;
    const int wgid = (xcd < r ? xcd * (q + 1) : r * (q + 1) + (xcd - r) * q) + off;
    const int nig = 8 * nN, gid = wgid / nig, fm = gid * 8, gsz = (nM - fm) < 8 ? (nM - fm) : 8;
    pm = fm + ((wgid % nig) % gsz); pn = (wgid % nig) / gsz;
}
struct EpiStoreBf16 {
    bf16_t* base0; int ldc0; bf16_t* base1; int ldc1;
    __device__ __forceinline__ void operator()(const f32x4 (&acc)[2][2][4][2], const pg8::Unit& u, int wr, int wc, int fr, int fq, int tid) const {
        bf16_t* base = u.kind ? base1 : base0; const int ldc = u.kind ? ldc1 : ldc0;
        int row0 = u.pm * 256 + wr * 64 + fr, col0 = u.pn * 256 + wc * 32 + 8 * fq; OPAQUE(row0); OPAQUE(col0);
#pragma unroll
        for (int ai = 0; ai < 2; ++ai)
#pragma unroll
            for (int m = 0; m < 4; ++m) { bf16_t* rowp = base + (size_t)(row0 + ai * 128 + m * 16) * ldc + col0;
#pragma unroll
                for (int bj = 0; bj < 2; ++bj) { const f32x4 v0 = acc[ai][bj][m][0], v1 = acc[ai][bj][m][1];
                    u32x4 w; w.x = pk2(v0[0], v0[1]); w.y = pk2(v0[2], v0[3]); w.z = pk2(v1[0], v1[1]); w.w = pk2(v1[2], v1[3]);
                    *(u32x4*)(rowp + bj * 128) = w; } }
    }
};
template <int PART>
struct SchedA { const bf16_t* hb; const unsigned char* h8a; const unsigned char* h8b; const bf16_t* WinT; int G, c;
    __device__ __forceinline__ bool next(int i, pg8::Unit& u) const {
        const int nM = T_ / 256, n0 = nM * 9; u.aux = 0;
        if (PART == 0) { const int x = i * G + c; if (x >= n0) return false;
            tile_map(x, nM, 9, u.pm, u.pn); u.kind = 0; u.nt = 8; u.f8 = 1; const int m0 = u.pm * 256;
            u.a = (const char*)(m0 < H8_SPLIT ? h8a + (size_t)m0 * 1024 : h8b + (size_t)(m0 - H8_SPLIT) * 1024); u.b = (const char*)(WinT + (size_t)u.pn * 256 * 1024); }
        else { const int x = i * G + (c + G - n0 % G) % G; if (x >= nM) return false;
            u.pm = 0; u.pn = x; u.kind = 1; u.nt = 8; u.f8 = 1; const int m0 = x * 256;
            u.a = (const char*)(WinT + (size_t)WIN_VT * 1024); u.b = (const char*)(m0 < H8_SPLIT ? h8a + (size_t)m0 * 1024 : h8b + (size_t)(m0 - H8_SPLIT) * 1024); }
        return true; } };
struct EpiA { bf16_t* proj; const float* sc;
    __device__ __forceinline__ void operator()(const f32x4 (&acc)[2][2][4][2], const pg8::Unit& u, int wr, int wc, int fr, int fq, int tid) const {
        int row0 = u.pm * 256 + wr * 64 + fr, col0 = u.pn * 256 + wc * 32 + 8 * fq; OPAQUE(row0); OPAQUE(col0);
#pragma unroll
        for (int bj = 0; bj < 2; ++bj) { const f32x4 s0 = *(const f32x4*)(sc + col0 + bj * 128), s1 = *(const f32x4*)(sc + col0 + bj * 128 + 4);
#pragma unroll
            for (int ai = 0; ai < 2; ++ai)
#pragma unroll
                for (int m = 0; m < 4; ++m) { const f32x4 v0 = acc[ai][bj][m][0] * s0, v1 = acc[ai][bj][m][1] * s1;
                    u32x4 w; w.x = pk2(v0[0], v0[1]); w.y = pk2(v0[2], v0[3]); w.z = pk2(v1[0], v1[1]); w.w = pk2(v1[2], v1[3]);
                    *(u32x4*)(proj + (size_t)(row0 + ai * 128 + m * 16) * PJ + col0 + bj * 128) = w; } }
    }
};
struct EpiVt { bf16_t* vtr; const float* sc;
    __device__ __forceinline__ void operator()(const f32x4 (&acc)[2][2][4][2], const pg8::Unit& u, int wr, int wc, int fr, int fq, int tid) const {
        int row0 = wr * 64 + fr, col0 = u.pn * 256 + wc * 32 + 8 * fq; OPAQUE(row0); OPAQUE(col0);
#pragma unroll
        for (int ai = 0; ai < 2; ++ai)
#pragma unroll
            for (int m = 0; m < 4; ++m) { const int row = row0 + ai * 128 + m * 16; const float s = sc[row];
#pragma unroll
                for (int bj = 0; bj < 2; ++bj) { const f32x4 v0 = acc[ai][bj][m][0] * s, v1 = acc[ai][bj][m][1] * s;
                    u32x4 w; w.x = pk2(v0[0], v0[1]); w.y = pk2(v0[2], v0[3]); w.z = pk2(v1[0], v1[1]); w.w = pk2(v1[2], v1[3]);
                    *(u32x4*)(vtr + (size_t)row * T_ + col0 + bj * 128) = w; } }
    }
};
__device__ __forceinline__ void phase_A0(const KP& p, unsigned char* lds) {
    const int tid = TIDX(), lane = tid & 63, wave = tid >> 6; const int gw = BIDX() * NWAVE + wave, NGW = GDIM() * NWAVE;
    for (int r = gw; r < L_ * WIN_GATE; r += NGW) { const int l = r / WIN_GATE, n = r % WIN_GATE; const Ptrs P = make_ptrs(p.ws, l); bf16_t* row = P.WinT + (size_t)n * 1024;
        const u32x4 a = *(const u32x4*)(row + 16 * lane), b = *(const u32x4*)(row + 16 * lane + 8);
        float v[16] = {bflo(a.x), bfhi(a.x), bflo(a.y), bfhi(a.y), bflo(a.z), bfhi(a.z), bflo(a.w), bfhi(a.w), bflo(b.x), bfhi(b.x), bflo(b.y), bfhi(b.y), bflo(b.z), bfhi(b.z), bflo(b.w), bfhi(b.w)};
        float am = 0.f;
#pragma unroll
        for (int j = 0; j < 16; ++j) am = fmaxf(am, fabsf(v[j]));
        am = wave_max(am); const float sc = am > 0.f ? am * (1.0f / 440.0f) : 1.0f, inv = 1.0f / sc; u32x4 o;
#pragma unroll
        for (int j = 0; j < 4; ++j) { unsigned w = cvt_pk_fp8_f32_(v[4 * j] * inv, v[4 * j + 1] * inv, 0u, false); w = cvt_pk_fp8_f32_(v[4 * j + 2] * inv, v[4 * j + 3] * inv, w, true); o[j] = w; }
        WAVE_SYNC();
        *(u32x4*)((unsigned char*)row + 16 * lane) = o;
        if (lane == 0) P.gscA[n] = sc; }
#ifdef CPU_EMU
    (void)lds;
#endif
}
__device__ __forceinline__ void phase_A(const KP& p, int l, unsigned char* lds) {
    const Ptrs P = make_ptrs(p.ws, l);
    { SchedA<0> S{P.hb, P.h8a, P.h8b, P.WinT, GDIM(), BIDX()}; EpiA E{P.proj, P.gscA}; pg8::gemm_phase<1>((LAS unsigned char*)lds, 1024, 1024, S, E, 1024); }
    { SchedA<1> S{P.hb, P.h8a, P.h8b, P.WinT, GDIM(), BIDX()}; EpiVt E{P.vtr, P.gscA + WIN_VT}; pg8::gemm_phase<1>((LAS unsigned char*)lds, 1024, 512, S, E, 2048); }
}
#if PROBE_REPEAT >= 40 && PROBE_REPEAT <= 49
struct SchedAP { const bf16_t* hb; const bf16_t* WinT; int G, c, nt, pnmask;
    __device__ __forceinline__ bool next(int i, pg8::Unit& u) const {
        const int nM = T_ / 256, n0 = nM * 9; const int x = i * G + c; if (x >= n0 + nM) return false;
        u.nt = nt; u.aux = 0; u.f8 = 0;
        if (x < n0) { tile_map(x, nM, 9, u.pm, u.pn); u.kind = 0; u.a = (const char*)(hb + (size_t)u.pm * 256 * 1024); u.b = (const char*)(WinT + (size_t)u.pn * 256 * 1024); }
        else { u.pm = 0; u.pn = x - n0; u.kind = 1; u.a = (const char*)(WinT + (size_t)WIN_VT * 1024); u.b = (const char*)(hb + (size_t)u.pn * 256 * 1024); }
        u.pn &= pnmask; return true; } };
struct EpiNull { float* d;
    __device__ __forceinline__ void operator()(const f32x4 (&acc)[2][2][4][2], const pg8::Unit& u, int wr, int wc, int fr, int fq, int tid) const {
        f32x4 s = (f32x4){0.f, 0.f, 0.f, 0.f};
#pragma unroll
        for (int ai = 0; ai < 2; ++ai)
#pragma unroll
            for (int m = 0; m < 4; ++m)
#pragma unroll
                for (int bj = 0; bj < 2; ++bj) s += acc[ai][bj][m][0] + acc[ai][bj][m][1];
        if (s.x + s.y + s.z + s.w == 1.2345e30f) d[tid] = s.x; } };
struct EpiStash { u32x4* stash;
    __device__ __forceinline__ void operator()(const f32x4 (&acc)[2][2][4][2], const pg8::Unit& u, int wr, int wc, int fr, int fq, int tid) const {
        OPAQUE(tid);
#pragma unroll
        for (int ai = 0; ai < 2; ++ai)
#pragma unroll
            for (int m = 0; m < 4; ++m)
#pragma unroll
                for (int bj = 0; bj < 2; ++bj) { const f32x4 v0 = acc[ai][bj][m][0], v1 = acc[ai][bj][m][1];
                    u32x4 w; w.x = pk2(v0[0], v0[1]); w.y = pk2(v0[2], v0[3]); w.z = pk2(v1[0], v1[1]); w.w = pk2(v1[2], v1[3]);
                    stash[((ai * 4 + m) * 2 + bj) * 512 + tid] = w; } } };
struct EpiFullLine { bf16_t* base;
    __device__ __forceinline__ void operator()(const f32x4 (&acc)[2][2][4][2], const pg8::Unit& u, int wr, int wc, int fr, int fq, int tid) const {
        OPAQUE(tid); if (u.kind) return;
#pragma unroll
        for (int ai = 0; ai < 2; ++ai)
#pragma unroll
            for (int m = 0; m < 4; ++m)
#pragma unroll
                for (int bj = 0; bj < 2; ++bj) { const f32x4 v0 = acc[ai][bj][m][0], v1 = acc[ai][bj][m][1]; const int k = (ai * 4 + m) * 2 + bj, L = k * 512 + tid, row = L >> 5, ch = L & 31;
                    u32x4 w; w.x = pk2(v0[0], v0[1]); w.y = pk2(v0[2], v0[3]); w.z = pk2(v1[0], v1[1]); w.w = pk2(v1[2], v1[3]);
                    *(u32x4*)(base + (size_t)(u.pm * 256 + row) * PJ + u.pn * 256 + ch * 8) = w; } } };
struct EpiProjOnly { bf16_t* base;
    __device__ __forceinline__ void operator()(const f32x4 (&acc)[2][2][4][2], const pg8::Unit& u, int wr, int wc, int fr, int fq, int tid) const {
        if (u.kind) return;
        int row0 = u.pm * 256 + wr * 64 + fr, col0 = u.pn * 256 + wc * 32 + 8 * fq; OPAQUE(row0); OPAQUE(col0);
#pragma unroll
        for (int ai = 0; ai < 2; ++ai)
#pragma unroll
            for (int m = 0; m < 4; ++m) { bf16_t* rowp = base + (size_t)(row0 + ai * 128 + m * 16) * PJ + col0;
#pragma unroll
                for (int bj = 0; bj < 2; ++bj) { const f32x4 v0 = acc[ai][bj][m][0], v1 = acc[ai][bj][m][1];
                    u32x4 w; w.x = pk2(v0[0], v0[1]); w.y = pk2(v0[2], v0[3]); w.z = pk2(v1[0], v1[1]); w.w = pk2(v1[2], v1[3]);
                    *(u32x4*)(rowp + bj * 128) = w; } } } };
template <int V>
__device__ __forceinline__ void phase_Aprobe(const KP& p, int l, unsigned char* lds) {
    const Ptrs P = make_ptrs(p.ws, l);
    SchedAP S{P.hb, P.WinT, GDIM(), BIDX(), V == 1 ? 32 : V == 3 ? 4 : V == 4 ? 8 : V == 5 ? 64 : 16, V == 6 ? 3 : 0xffff};
    if (V == 7) { EpiFullLine E{P.proj}; pg8::gemm_phase((LAS unsigned char*)lds, 1024, 1024, S, E); }
    else if (V == 8) { EpiProjOnly E{P.proj}; pg8::gemm_phase((LAS unsigned char*)lds, 1024, 1024, S, E); }
    else if (V == 2) { EpiStash E{(u32x4*)(P.ycat + (size_t)BIDX() * 65536)}; pg8::gemm_phase((LAS unsigned char*)lds, 1024, 1024, S, E); }
    else if (V == 6) { EpiStoreBf16 E{P.ycat, 1024, P.ycat, 1024}; pg8::gemm_phase((LAS unsigned char*)lds, 1024, 1024, S, E); }
    else { EpiNull E{(float*)(P.ycat + (size_t)BIDX() * 65536)}; pg8::gemm_phase((LAS unsigned char*)lds, 1024, 1024, S, E); }
}
#endif
struct SchedGlu { const bf16_t* ycat; const bf16_t* GluT; int G, c;
    __device__ __forceinline__ bool next(int i, pg8::Unit& u) const {
        const int x = i * G + c; if (x >= T_ / 256) return false;
        u.pm = x; u.pn = 0; u.nt = 4; u.kind = 0; u.aux = 0; u.f8 = 0; u.a = (const char*)(ycat + (size_t)x * 256 * 1024 + 256); u.b = (const char*)GluT; return true; } };
struct EpiGlu { bf16_t* ycat; const float* glub;
    __device__ __forceinline__ void operator()(const f32x4 (&acc)[2][2][4][2], const pg8::Unit& u, int wr, int wc, int fr, int fq, int tid) const {
        int row0 = u.pm * 256 + wr * 64 + fr, col0 = wc * 32 + 8 * fq; OPAQUE(row0); OPAQUE(col0);
#pragma unroll
        for (int bj = 0; bj < 2; ++bj) { const f32x4 b0 = *(const f32x4*)(glub + col0 + bj * 128), b1 = *(const f32x4*)(glub + col0 + bj * 128 + 4);
#pragma unroll
            for (int ai = 0; ai < 2; ++ai)
#pragma unroll
                for (int m = 0; m < 4; ++m) { bf16_t* ptr = ycat + (size_t)(row0 + ai * 128 + m * 16) * 1024 + 256 + col0 + bj * 128;
                    const u32x4 y = *(const u32x4*)ptr; const f32x4 v0 = acc[ai][bj][m][0] + b0, v1 = acc[ai][bj][m][1] + b1;
                    u32x4 w; w.x = pk2(bflo(y.x) * sigmoidf_(v0[0]), bfhi(y.x) * sigmoidf_(v0[1])); w.y = pk2(bflo(y.y) * sigmoidf_(v0[2]), bfhi(y.y) * sigmoidf_(v0[3]));
                    w.z = pk2(bflo(y.z) * sigmoidf_(v1[0]), bfhi(y.z) * sigmoidf_(v1[1])); w.w = pk2(bflo(y.w) * sigmoidf_(v1[2]), bfhi(y.w) * sigmoidf_(v1[3]));
                    *(u32x4*)ptr = w; MEMFENCE(); } }
    }
};
__device__ __forceinline__ void convert_tables(const KP& p, const Ptrs& P, int l, unsigned char* lds) {
    const int tid = TIDX(), lane = tid & 63, wave = tid >> 6;
    unsigned* cnt = (unsigned*)(p.ws + WS_CTL) + 10240 + 16 * l; int* slot = (int*)(lds + 65536);
    const float* ps = p.in[I_P] + (size_t)l * T_ * 256;
    constexpr int NG8 = 6144 / 128, NTAB = 2 * NEXP / 128, NPB = (int)(((size_t)T_ * 256 / 8 + 4095) / 4096);
    for (;;) {
        __syncthreads(); if (tid == 0) *slot = (int)atomicAdd(cnt, 1u); __syncthreads();
        int item = *slot; if (item >= NG8 + NTAB + NPB) break;
        if (item < NG8) {
            for (int rr = wave; rr < 128; rr += NWAVE) { const int r5 = item * 128 + rr; bf16_t* row = r5 < 4096 ? P.WinT + (size_t)(WIN_GATE + r5) * 1024 : r5 < 5120 ? P.PleGT + (size_t)(r5 - 4096) * 1024 : P.WoutT + (size_t)(r5 - 5120) * 1024;
                const u32x4 a = *(const u32x4*)(row + 16 * lane), b = *(const u32x4*)(row + 16 * lane + 8);
                float v[16] = {bflo(a.x), bfhi(a.x), bflo(a.y), bfhi(a.y), bflo(a.z), bfhi(a.z), bflo(a.w), bfhi(a.w), bflo(b.x), bfhi(b.x), bflo(b.y), bfhi(b.y), bflo(b.z), bfhi(b.z), bflo(b.w), bfhi(b.w)};
                float am = 0.f;
#pragma unroll
                for (int j = 0; j < 16; ++j) am = fmaxf(am, fabsf(v[j]));
                am = wave_max(am); const float sc = am > 0.f ? am * (1.0f / 440.0f) : 1.0f, inv = 1.0f / sc; u32x4 o;
#pragma unroll
                for (int j = 0; j < 4; ++j) { unsigned w = cvt_pk_fp8_f32_(v[4 * j] * inv, v[4 * j + 1] * inv, 0u, false); w = cvt_pk_fp8_f32_(v[4 * j + 2] * inv, v[4 * j + 3] * inv, w, true); o[j] = w; }
                WAVE_SYNC();
                *(u32x4*)((unsigned char*)row + 16 * lane) = o;
                if (lane == 0) P.gsc[r5] = sc; }
            continue; }
        item -= NG8;
        if (item < NTAB) {
            for (int r4 = 0; r4 < 16; r4 += 4) { f32x4 v[4][4]; float am[4];
#pragma unroll
                for (int q = 0; q < 4; ++q) { const int it = item * 128 + wave + 8 * (r4 + q); const int tb = it >= NEXP, row = tb ? it - NEXP : it;
                    const float* src = p.in[tb ? I_V : I_U] + ((size_t)l * NEXP + row) * 1024 + 16 * lane; am[q] = 0.f;
#pragma unroll
                    for (int j = 0; j < 4; ++j) { v[q][j] = *(const f32x4*)(src + 4 * j); am[q] = fmaxf(am[q], fmaxf(fmaxf(fabsf(v[q][j].x), fabsf(v[q][j].y)), fmaxf(fabsf(v[q][j].z), fabsf(v[q][j].w)))); } }
#pragma unroll
                for (int q = 0; q < 4; ++q) { const int it = item * 128 + wave + 8 * (r4 + q); const int tb = it >= NEXP, row = tb ? it - NEXP : it;
                    const float amx = wave_max(am[q]); const float sc = amx > 0.f ? amx * (1.0f / 440.0f) : 1.0f, inv = 1.0f / sc; u32x4 o;
#pragma unroll
                    for (int j = 0; j < 4; ++j) { unsigned w = cvt_pk_fp8_f32_(v[q][j].x * inv, v[q][j].y * inv, 0u, false); w = cvt_pk_fp8_f32_(v[q][j].z * inv, v[q][j].w * inv, w, true); o[j] = w; }
                    *(u32x4*)((tb ? P.V8 : P.U8) + ((size_t)(lane >> 3) * NEXP + row) * 128 + 16 * (lane & 7)) = o;
                    if (lane == 0) (tb ? P.sv : P.su)[row] = sc; } }
        } else {
            const size_t base = (size_t)(item - NTAB) * 4096;
            f32x4 a[8], bq[8];
#pragma unroll
            for (int j = 0; j < 8; ++j) { const size_t i = base + tid + (size_t)j * NTHR; a[j] = (f32x4){0.f, 0.f, 0.f, 0.f}; bq[j] = a[j];
                if (i < (size_t)T_ * 256 / 8) { a[j] = *(const f32x4*)(ps + i * 8); bq[j] = *(const f32x4*)(ps + i * 8 + 4); } }
#pragma unroll
            for (int j = 0; j < 8; ++j) { const size_t i = base + tid + (size_t)j * NTHR;
                if (i < (size_t)T_ * 256 / 8) { u32x4 o; o.x = pk2(a[j].x, a[j].y); o.y = pk2(a[j].z, a[j].w); o.z = pk2(bq[j].x, bq[j].y); o.w = pk2(bq[j].z, bq[j].w); *(u32x4*)(P.pb + i * 8) = o; } }
        }
    }
}
__device__ __forceinline__ void phase_B2(const KP& p, int l, unsigned char* lds) {
    const Ptrs P = make_ptrs(p.ws, l);
    constexpr int NRW = NB_ * 4; const int G = GDIM(), c = BIDX();
    int gG = G, gc = c;
    if (G > NRW) { if (c < NRW) { rw_state_unit(p, P, l, c, lds);
#if PROBE_REPEAT == 35
        rw_state_unit(p, P, l, c, lds);
#endif
        convert_tables(p, P, l, lds); return; } gG = G - NRW; gc = c - NRW; }
    else { for (int u = c; u < NRW; u += G) rw_state_unit(p, P, l, u, lds); }
    SchedGlu S{P.ycat, P.GluT, gG, gc};
    EpiGlu E{P.ycat, p.in[I_GLUB] + l * 256};
    pg8::gemm_phase((LAS unsigned char*)lds, 1024, 256, S, E);
    convert_tables(p, P, l, lds);
}
struct SchedC { const unsigned char* h8a; const unsigned char* h8b; const bf16_t* ycat; const bf16_t* WinT; const bf16_t* WbrT; int G, c;
    __device__ __forceinline__ bool next(int i, pg8::Unit& u) const {
        const int tile = (i >> 3) * G + c; if (tile >= (T_ / 256) * 4) return false;
        const int j = i & 7, b = j >> 1; tile_map(tile, T_ / 256, 4, u.pm, u.pn); u.aux = b;
        if (!(j & 1)) { u.kind = 0; u.nt = 4; u.f8 = 0; u.a = (const char*)(ycat + (size_t)u.pm * 256 * 1024 + 256 * b); u.b = (const char*)(WbrT + (size_t)u.pn * 256 * 1024 + 256 * b); }
        else { u.kind = 1; u.nt = 8; u.f8 = 1; const int m0 = u.pm * 256;
            u.a = (const char*)(m0 < H8_SPLIT ? h8a + (size_t)m0 * 1024 : h8b + (size_t)(m0 - H8_SPLIT) * 1024); u.b = (const char*)(WinT + (size_t)(WIN_GATE + 1024 * b + 256 * u.pn) * 1024); }
        return true; } };
struct EpiC { u32x2* stash; bf16_t* merged; const float* gsc; unsigned char* m8;
    __device__ __forceinline__ void operator()(const f32x4 (&acc)[2][2][4][2], const pg8::Unit& u, int wr, int wc, int fr, int fq, int tid) const {
        OPAQUE(tid);
        if (u.kind == 0) {
#pragma unroll
            for (int ai = 0; ai < 2; ++ai)
#pragma unroll
                for (int m = 0; m < 4; ++m)
#pragma unroll
                    for (int bj = 0; bj < 2; ++bj) { const f32x4 v0 = acc[ai][bj][m][0], v1 = acc[ai][bj][m][1];
                        u32x2 w; w.x = cvt_pk_fp8_f32_(v0[0], v0[1], 0u, false); w.x = cvt_pk_fp8_f32_(v0[2], v0[3], w.x, true); w.y = cvt_pk_fp8_f32_(v1[0], v1[1], 0u, false); w.y = cvt_pk_fp8_f32_(v1[2], v1[3], w.y, true);
                        stash[((ai * 4 + m) * 2 + bj) * 512 + tid] = w; }
        } else {
            int row0 = u.pm * 256 + wr * 64 + fr, col0 = u.pn * 256 + wc * 32 + 8 * fq; OPAQUE(row0); OPAQUE(col0); const bool first = (u.aux == 0);
            f32x4 sc[2][2];
#pragma unroll
            for (int bj = 0; bj < 2; ++bj) { const float* sp = gsc + 1024 * u.aux + col0 + bj * 128; sc[bj][0] = *(const f32x4*)sp; sc[bj][1] = *(const f32x4*)(sp + 4); }
#pragma unroll
            for (int ai = 0; ai < 2; ++ai)
#pragma unroll
                for (int mp = 0; mp < 2; ++mp) { u32x2 y[4]; u32x4 mo[4];
#pragma unroll
                    for (int q = 0; q < 4; ++q) { const int m = 2 * mp + (q >> 1), bj = q & 1;
                        y[q] = stash[((ai * 4 + m) * 2 + bj) * 512 + tid]; mo[q] = (u32x4){0u, 0u, 0u, 0u};
                        if (!first) mo[q] = *(const u32x4*)(merged + (size_t)(row0 + ai * 128 + m * 16) * 1024 + col0 + bj * 128); }
#pragma unroll
                    for (int q = 0; q < 4; ++q) { const int m = 2 * mp + (q >> 1), bj = q & 1; const f32x4 g0 = acc[ai][bj][m][0] * sc[bj][0], g1 = acc[ai][bj][m][1] * sc[bj][1];
                        bf16_t* ptr = merged + (size_t)(row0 + ai * 128 + m * 16) * 1024 + col0 + bj * 128;
                        const f32x2 ya = cvt_pk_f32_fp8_(y[q].x, false), yb = cvt_pk_f32_fp8_(y[q].x, true), yc = cvt_pk_f32_fp8_(y[q].y, false), yd = cvt_pk_f32_fp8_(y[q].y, true);
                        const float o0 = ya.x * sigmoidf_(g0[0]) + bflo(mo[q].x), o1 = ya.y * sigmoidf_(g0[1]) + bfhi(mo[q].x), o2 = yb.x * sigmoidf_(g0[2]) + bflo(mo[q].y), o3 = yb.y * sigmoidf_(g0[3]) + bfhi(mo[q].y);
                        const float o4 = yc.x * sigmoidf_(g1[0]) + bflo(mo[q].z), o5 = yc.y * sigmoidf_(g1[1]) + bfhi(mo[q].z), o6 = yd.x * sigmoidf_(g1[2]) + bflo(mo[q].w), o7 = yd.y * sigmoidf_(g1[3]) + bfhi(mo[q].w);
                        u32x4 w; w.x = pk2(o0, o1); w.y = pk2(o2, o3); w.z = pk2(o4, o5); w.w = pk2(o6, o7);
                        *(u32x4*)ptr = w;
                        if (u.aux == 3) { u32x2 w8; w8.x = cvt_pk_fp8_f32_(o0, o1, 0u, false); w8.x = cvt_pk_fp8_f32_(o2, o3, w8.x, true); w8.y = cvt_pk_fp8_f32_(o4, o5, 0u, false); w8.y = cvt_pk_fp8_f32_(o6, o7, w8.y, true);
                            *(u32x2*)(m8 + (size_t)(row0 + ai * 128 + m * 16) * 1024 + col0 + bj * 128) = w8; } }
                    MEMFENCE(); }
        }
    }
};
__device__ __forceinline__ void phase_C(const KP& p, int l, unsigned char* lds) {
    const Ptrs P = make_ptrs(p.ws, l);
    SchedC S{P.h8a, P.h8b, P.ycat, P.WinT, P.WbrT, GDIM(), BIDX()};
    EpiC E{(u32x2*)(P.stash + (size_t)BIDX() * 65536), P.merged, P.gsc, P.h8e};
    pg8::gemm_phase<2>((LAS unsigned char*)lds, 1024, 1024, S, E, 1024);
}
struct SchedD { const unsigned char* A8; const bf16_t* Bt; int nN, G, c;
    __device__ __forceinline__ bool next(int i, pg8::Unit& u) const {
        const int x = i * G + c; if (x >= (T_ / 256) * nN) return false;
        tile_map(x, T_ / 256, nN, u.pm, u.pn); u.nt = 8; u.kind = 0; u.aux = 0; u.f8 = 1; u.a = (const char*)(A8 + (size_t)u.pm * 256 * 1024); u.b = (const char*)(Bt + (size_t)u.pn * 256 * 1024); return true; } };
struct EpiResid { bf16_t* ob; const bf16_t* hb; const float* sc;
    __device__ __forceinline__ void operator()(const f32x4 (&acc)[2][2][4][2], const pg8::Unit& u, int wr, int wc, int fr, int fq, int tid) const {
        int row0 = u.pm * 256 + wr * 64 + fr, col0 = u.pn * 256 + wc * 32 + 8 * fq; OPAQUE(row0); OPAQUE(col0);
#pragma unroll
        for (int ai = 0; ai < 2; ++ai)
#pragma unroll
            for (int m = 0; m < 4; ++m)
#pragma unroll
                for (int bj = 0; bj < 2; ++bj) { const size_t o = (size_t)(row0 + ai * 128 + m * 16) * 1024 + col0 + bj * 128; const u32x4 hw = *(const u32x4*)(hb + o);
                    const f32x4 a0 = acc[ai][bj][m][0] * *(const f32x4*)(sc + col0 + bj * 128), a1 = acc[ai][bj][m][1] * *(const f32x4*)(sc + col0 + bj * 128 + 4); u32x4 w;
                    w.x = pk2(bflo(hw.x) * DN_ALPHA_ + a0[0], bfhi(hw.x) * DN_ALPHA_ + a0[1]); w.y = pk2(bflo(hw.y) * DN_ALPHA_ + a0[2], bfhi(hw.y) * DN_ALPHA_ + a0[3]);
                    w.z = pk2(bflo(hw.z) * DN_ALPHA_ + a1[0], bfhi(hw.z) * DN_ALPHA_ + a1[1]); w.w = pk2(bflo(hw.w) * DN_ALPHA_ + a1[2], bfhi(hw.w) * DN_ALPHA_ + a1[3]);
                    *(u32x4*)(ob + o) = w; }
    }
};
__device__ __forceinline__ void phase_D(const KP& p, int l, unsigned char* lds) {
    const Ptrs P = make_ptrs(p.ws, l);
    SchedD S{P.h8e, P.WoutT, 4, GDIM(), BIDX()};
    EpiResid E{P.ycat, P.hb, P.gsc + 5120};
    pg8::gemm_phase<1>((LAS unsigned char*)lds, 1024, 1024, S, E, 1024);
}
__device__ __forceinline__ void phase_D2(const KP& p, int l, unsigned char* lds) {
    const Ptrs P = make_ptrs(p.ws, l);
    const int tid = TIDX(), lane = tid & 63, wave = tid >> 6; const int gw = BIDX() * NWAVE + wave, NGW = GDIM() * NWAVE;
    for (int m = 4 * gw; m < T_; m += 4 * NGW) ln_rows<4, true>(P.ycat + (size_t)m * 1024, p.in[I_LN1G] + l * 1024, p.in[I_LN1B] + l * 1024, (float*)nullptr, P.hb + (size_t)m * 1024, P.h8e + (size_t)m * 1024, lane);
}
struct SchedE1 { const bf16_t* pb; const bf16_t* PleT; int G, c;
    __device__ __forceinline__ bool next(int i, pg8::Unit& u) const {
        const int x = i * G + c; if (x >= (T_ / 256) * 4) return false;
        tile_map(x, T_ / 256, 4, u.pm, u.pn); u.nt = 4; u.kind = 0; u.aux = 0; u.f8 = 0; u.a = (const char*)(pb + (size_t)u.pm * 256 * 256); u.b = (const char*)(PleT + (size_t)u.pn * 256 * 256); return true; } };
template <int PART>
struct SchedE2 { const bf16_t* hb; const unsigned char* h8e; const bf16_t* PleGT; const bf16_t* WqT; int G, c;
    __device__ __forceinline__ bool next(int i, pg8::Unit& u) const {
        const int n0 = (T_ / 256) * 4; int x = i * G + c + (PART ? n0 : 0); if (x >= (PART ? n0 + (T_ / 256) * 8 : n0)) return false;
        u.aux = 0;
        if (x < n0) { tile_map(x, T_ / 256, 4, u.pm, u.pn); u.kind = 0; u.nt = 8; u.f8 = 1; u.b = (const char*)(PleGT + (size_t)u.pn * 256 * 1024); u.a = (const char*)(h8e + (size_t)u.pm * 256 * 1024); }
        else { x -= n0; tile_map(x, T_ / 256, 8, u.pm, u.pn); u.kind = 1; u.nt = 16; u.f8 = 0; u.b = (const char*)(WqT + (size_t)u.pn * 256 * 1024); u.a = (const char*)(hb + (size_t)u.pm * 256 * 1024); }
        return true; } };
struct EpiE2g { const bf16_t* hb; bf16_t* Pbuf; const float* gsc;
    __device__ __forceinline__ void operator()(const f32x4 (&acc)[2][2][4][2], const pg8::Unit& u, int wr, int wc, int fr, int fq, int tid) const {
        int row0 = u.pm * 256 + wr * 64 + fr, col0 = u.pn * 256 + wc * 32 + 8 * fq; OPAQUE(row0); OPAQUE(col0);
#pragma unroll
        for (int bj = 0; bj < 2; ++bj) { const float* sp = gsc + 4096 + col0 + bj * 128; const f32x4 s0 = *(const f32x4*)sp, s1 = *(const f32x4*)(sp + 4);
            const size_t cb = (size_t)row0 * 1024 + col0 + bj * 128; const bf16_t* hp = hb + cb; bf16_t* pp = Pbuf + cb;
#pragma unroll
            for (int ai = 0; ai < 2; ++ai)
#pragma unroll
                for (int mp = 0; mp < 2; ++mp) { u32x4 y[2], hw[2];
#pragma unroll
                    for (int q = 0; q < 2; ++q) { const int ro = (ai * 128 + (2 * mp + q) * 16) * 1024; y[q] = *(const u32x4*)(pp + ro); hw[q] = *(const u32x4*)(hp + ro); }
#pragma unroll
                    for (int q = 0; q < 2; ++q) { const int m = 2 * mp + q; const int ro = (ai * 128 + m * 16) * 1024; const f32x4 v0 = acc[ai][bj][m][0] * s0, v1 = acc[ai][bj][m][1] * s1;
                        u32x4 w;
                        w.x = pk2(bflo(hw[q].x) * DN_ALPHA_ + bflo(y[q].x) * sigmoidf_(v0[0]), bfhi(hw[q].x) * DN_ALPHA_ + bfhi(y[q].x) * sigmoidf_(v0[1]));
                        w.y = pk2(bflo(hw[q].y) * DN_ALPHA_ + bflo(y[q].y) * sigmoidf_(v0[2]), bfhi(hw[q].y) * DN_ALPHA_ + bfhi(y[q].y) * sigmoidf_(v0[3]));
                        w.z = pk2(bflo(hw[q].z) * DN_ALPHA_ + bflo(y[q].z) * sigmoidf_(v1[0]), bfhi(hw[q].z) * DN_ALPHA_ + bfhi(y[q].z) * sigmoidf_(v1[1]));
                        w.w = pk2(bflo(hw[q].w) * DN_ALPHA_ + bflo(y[q].w) * sigmoidf_(v1[2]), bfhi(hw[q].w) * DN_ALPHA_ + bfhi(y[q].w) * sigmoidf_(v1[3]));
                        *(u32x4*)(pp + ro) = w; }
                    MEMFENCE(); } }
    }
};
__device__ __forceinline__ void phase_E(const KP& p, int l, unsigned char* lds) {
    const Ptrs P = make_ptrs(p.ws, l);
    { SchedE1 S{P.pb, P.PleT, GDIM(), BIDX()}; EpiStoreBf16 E{P.ycat, 1024, P.ycat, 1024}; pg8::gemm_phase((LAS unsigned char*)lds, 256, 256, S, E); }
    { SchedE2<0> S{P.hb, P.h8e, P.PleGT, P.WqT, GDIM(), BIDX()}; EpiE2g E{P.hb, P.ycat, P.gsc}; pg8::gemm_phase<1>((LAS unsigned char*)lds, 1024, 1024, S, E, 1024); }
    { SchedE2<1> S{P.hb, P.h8e, P.PleGT, P.WqT, GDIM(), BIDX()}; EpiStoreBf16 E{P.q, 2048, P.q, 2048}; pg8::gemm_phase<0>((LAS unsigned char*)lds, 1024, 1024, S, E); }
}
__device__ __forceinline__ unsigned mono_key(float f) { const unsigned u = __builtin_bit_cast(unsigned, f); return (u & 0x80000000u) ? ~u : (u | 0x80000000u); }
__device__ __forceinline__ float unmono_key(unsigned k) { const unsigned u = (k & 0x80000000u) ? (k ^ 0x80000000u) : ~k; return __builtin_bit_cast(float, u); }
struct CandTab { int a[50], b[50]; };
constexpr CandTab make_cand() { CandTab t{}; int n = 0; for (int a = 0; a < 16; ++a) for (int b = 0; b < 16; ++b) if ((a + 1) * (b + 1) <= 16) { t.a[n] = a; t.b[n] = b; ++n; } return t; }
constexpr CandTab CAND = make_cand();
constexpr int PK_PITCH = 136;

#define PK_CE(x, y) do { const unsigned _a = (x), _b = (y); (x) = _a > _b ? _a : _b; (y) = _a > _b ? _b : _a; } while (0)
__device__ __forceinline__ void bitonic_merge16_desc(unsigned (&a)[16]) {
#pragma unroll
    for (int j = 8; j > 0; j >>= 1)
#pragma unroll
        for (int i = 0; i < 16; ++i) { const int l = i ^ j; if (l > i) PK_CE(a[i], a[l]); }
}
__device__ __forceinline__ void bitonic_sort16_desc(unsigned (&a)[16]) {
#pragma unroll
    for (int k = 2; k <= 16; k <<= 1)
#pragma unroll
        for (int j = k >> 1; j > 0; j >>= 1)
#pragma unroll
            for (int i = 0; i < 16; ++i) { const int l = i ^ j; if (l > i) { if ((i & k) == 0 || k == 16) PK_CE(a[i], a[l]); else PK_CE(a[l], a[i]); } }
}
__device__ __forceinline__ void top_half_merge16(unsigned (&a)[16], const unsigned (&b)[16]) {
#pragma unroll
    for (int i = 0; i < 16; ++i) a[i] = a[i] > b[15 - i] ? a[i] : b[15 - i];
    bitonic_merge16_desc(a);
}
__device__ __forceinline__ void top16_keys(const unsigned (&key)[64], unsigned (&top)[16]) {
    unsigned g0[16], g1[16], g2[16], g3[16];
#pragma unroll
    for (int i = 0; i < 16; ++i) { g0[i] = key[i]; g1[i] = key[16 + i]; g2[i] = key[32 + i]; g3[i] = key[48 + i]; }
    bitonic_sort16_desc(g0); bitonic_sort16_desc(g1); bitonic_sort16_desc(g2); bitonic_sort16_desc(g3);
    top_half_merge16(g0, g1); top_half_merge16(g2, g3); top_half_merge16(g0, g2);
    unsigned pr[16];
#pragma unroll
    for (int i = 0; i < 16; ++i) pr[i] = (unsigned)__shfl_xor((int)g0[i], 32);
    top_half_merge16(g0, pr);
#pragma unroll
    for (int i = 0; i < 16; ++i) top[i] = g0[i];
}
__device__ __forceinline__ void peer_route_unit(const KP& p, const Ptrs& P, int l, int unit, unsigned char* lds) {
    const bf16_t* Ks = (const bf16_t*)lds;
    const int tid = TIDX(), lane = tid & 63, wave = tid >> 6, r32 = lane & 31, hi = lane >> 5;
    const int tok = unit * 32 + r32;
    int kbase = r32 * PK_PITCH + 8 * hi; OPAQUE(kbase);
    unsigned top1[16], top2[16];
#pragma unroll 1
    for (int half = 0; half < 2; ++half) {
        const bf16_t* qp = P.q + (size_t)tok * 2048 + wave * 256 + half * 128 + 8 * hi;
        bf16x8 qf[8];
#pragma unroll
        for (int ks = 0; ks < 8; ++ks) qf[ks] = *(const bf16x8*)(qp + 16 * ks);
        unsigned key[64];
#pragma unroll
        for (int kt = 0; kt < 4; ++kt) { f32x16 acc = {}; const bf16_t* kp = Ks + (half * 128 + 32 * kt) * PK_PITCH + kbase;
#pragma unroll
            for (int ks = 0; ks < 8; ++ks) { const bf16x8 a = *(const bf16x8*)(kp + 16 * ks); acc = MFMA32(a, qf[ks], acc); }
#pragma unroll
            for (int r = 0; r < 16; ++r) { const int idx = 32 * kt + (r & 3) + 8 * (r >> 2) + 4 * hi; key[16 * kt + r] = (mono_key(acc[r]) & ~127u) | (unsigned)(127 - idx); } }
        if (half == 0) top16_keys(key, top1); else top16_keys(key, top2);
        MEMFENCE();
    }
    MEMFENCE();
    int* islot = (int*)(lds + 2 * 128 * PK_PITCH * 2) + (wave * 32 + r32) * 33;
    float v1[16], v2[16];
#pragma unroll
    for (int r = 0; r < 16; ++r) { v1[r] = unmono_key(top1[r] & ~127u); v2[r] = unmono_key(top2[r] & ~127u); islot[16 * hi + r] = 127 - (int)((hi ? top2[r] : top1[r]) & 127u); }
    unsigned ka[16], kb[16];
#pragma unroll
    for (int i = 0; i < 25; ++i) { const int c0 = 2 * i, c1 = 2 * i + 1;
        const float s = hi ? (v1[CAND.a[c1]] + v2[CAND.b[c1]]) : (v1[CAND.a[c0]] + v2[CAND.b[c0]]);
        const unsigned k = (mono_key(s) & ~255u) | (unsigned)(255 - (hi ? 16 * CAND.a[c1] + CAND.b[c1] : 16 * CAND.a[c0] + CAND.b[c0]));
        if (i < 16) ka[i] = k; else kb[i - 16] = k; }
#pragma unroll
    for (int i = 9; i < 16; ++i) kb[i] = 0u;
    bitonic_sort16_desc(ka); bitonic_sort16_desc(kb); top_half_merge16(ka, kb);
    { unsigned pr[16];
#pragma unroll
      for (int i = 0; i < 16; ++i) pr[i] = (unsigned)__shfl_xor((int)ka[i], 32);
      top_half_merge16(ka, pr); }
    WAVE_SYNC();
    float sc[16]; int se[16];
#pragma unroll
    for (int r = 0; r < 16; ++r) { sc[r] = unmono_key(ka[r] & ~255u); se[r] = 0; }
#pragma unroll
    for (int r = 0; r < 8; ++r) { unsigned mlo = ka[r], mhi = ka[8 + r]; OPAQUE(mlo); OPAQUE(mhi);
        const unsigned m = hi ? mhi : mlo; const int ab = 255 - (int)(m & 255u); const int e = islot[ab >> 4] * 128 + islot[16 + (ab & 15)];
        if (hi) se[8 + r] = e; else se[r] = e; }
    WAVE_SYNC();
    float g[16]; float sum = 0.f;
#pragma unroll
    for (int r = 0; r < 16; ++r) { g[r] = __expf(sc[r] - sc[0]); sum += g[r]; }
    const float inv = 1.0f / sum;
    const size_t ob = (size_t)tok * 128 + wave * 16 + 8 * hi;
    if (hi == 0) {
        *(u32x4*)(P.eid + ob) = (u32x4){(unsigned)se[0], (unsigned)se[1], (unsigned)se[2], (unsigned)se[3]}; *(u32x4*)(P.eid + ob + 4) = (u32x4){(unsigned)se[4], (unsigned)se[5], (unsigned)se[6], (unsigned)se[7]};
        *(f32x4*)(P.gate + ob) = (f32x4){g[0] * inv, g[1] * inv, g[2] * inv, g[3] * inv}; *(f32x4*)(P.gate + ob + 4) = (f32x4){g[4] * inv, g[5] * inv, g[6] * inv, g[7] * inv};
    } else {
        *(u32x4*)(P.eid + ob) = (u32x4){(unsigned)se[8], (unsigned)se[9], (unsigned)se[10], (unsigned)se[11]}; *(u32x4*)(P.eid + ob + 4) = (u32x4){(unsigned)se[12], (unsigned)se[13], (unsigned)se[14], (unsigned)se[15]};
        *(f32x4*)(P.gate + ob) = (f32x4){g[8] * inv, g[9] * inv, g[10] * inv, g[11] * inv}; *(f32x4*)(P.gate + ob + 4) = (f32x4){g[12] * inv, g[13] * inv, g[14] * inv, g[15] * inv};
    }
}
__device__ __forceinline__ void phase_F(const KP& p, int l, unsigned char* lds) {
    const Ptrs P = make_ptrs(p.ws, l);
    bf16_t* Ks = (bf16_t*)lds; const int tid = TIDX();
    for (int e = tid; e < 2 * 128 * 16; e += NTHR) { const int row = e >> 4, ch = e & 15; *(u32x4*)(Ks + row * PK_PITCH + ch * 8) = *(const u32x4*)(P.K12 + row * 128 + ch * 8); }
    __syncthreads();
    for (int u = BIDX(); u < T_ / 32; u += GDIM()) peer_route_unit(p, P, l, u, lds);
    __syncthreads();
}
constexpr int PG_TB = (T_ >= 4096 ? 128 : 64), PG_NBLK = T_ / PG_TB;
__device__ __forceinline__ int peer_next_item(unsigned* cnt, int* slot, int tid) {
    __syncthreads();
    if (tid == 0) *slot = (int)atomicAdd(cnt, 1u);
    __syncthreads();
    return *slot;
}
constexpr int PG_TPW = PG_TB / NWAVE;
static_assert(PG_TPW >= 4 && PG_TPW % 2 == 0, "token pipeline depth");
constexpr int PG_WLDS = 6144;
__device__ __forceinline__ void pg_issue_rows(const unsigned char* T8, int x, int c8, int gq, int lane, int e0, int e1, int* E, u32x4 (&rb)[16]) {
    WAVE_SYNC(); E[lane] = e0; E[64 + lane] = e1; WAVE_SYNC();
#pragma unroll
    for (int k = 0; k < 16; ++k) { const unsigned off = ((unsigned)(x * NEXP) + (unsigned)E[gq + 8 * k]) * 128u + 16u * (unsigned)c8; rb[k] = *(const u32x4*)(T8 + off); }
}
template <bool REFILL, int TAG>
__device__ __forceinline__ void pg_dots_compute(const Ptrs& P, int x, int t, u32x4 (&ub)[16], u32x4 xa, u32x4 xb, float* R, const int* E, int c8, int gq, int lane) {
    const f32x2 x0 = (f32x2){bflo(xa.x), bfhi(xa.x)}, x1 = (f32x2){bflo(xa.y), bfhi(xa.y)}, x2 = (f32x2){bflo(xa.z), bfhi(xa.z)}, x3 = (f32x2){bflo(xa.w), bfhi(xa.w)};
    const f32x2 x4 = (f32x2){bflo(xb.x), bfhi(xb.x)}, x5 = (f32x2){bflo(xb.y), bfhi(xb.y)}, x6 = (f32x2){bflo(xb.z), bfhi(xb.z)}, x7 = (f32x2){bflo(xb.w), bfhi(xb.w)};
    WAVE_SYNC();
    unsigned off[8];
    const unsigned char* ubase = P.U8;
#pragma unroll
    for (int k = 0; k < 16; ++k) { PIN1(ub[k]);
        if (REFILL && (k & 7) == 0) {
#pragma unroll
            for (int j = 0; j < 8; ++j) off[j] = ((unsigned)(x * NEXP) + (unsigned)E[gq + 8 * (k + j)]) * 128u + 16u * (unsigned)c8; }
        f32x2 s = cvt_pk_f32_fp8_(ub[k][0], false) * x0; s += cvt_pk_f32_fp8_(ub[k][0], true) * x1; s += cvt_pk_f32_fp8_(ub[k][1], false) * x2; s += cvt_pk_f32_fp8_(ub[k][1], true) * x3;
        s += cvt_pk_f32_fp8_(ub[k][2], false) * x4; s += cvt_pk_f32_fp8_(ub[k][2], true) * x5; s += cvt_pk_f32_fp8_(ub[k][3], false) * x6; s += cvt_pk_f32_fp8_(ub[k][3], true) * x7;
        R[k * 64 + lane] = s.x + s.y;
        if (REFILL) { GLOAD16_RW_S(ub[k], ubase, off[k & 7]); }
        if (TAG) TAG_B(); else TAG_A();
        SCHED_FENCE(); }
    WAVE_SYNC();
    const f32x4 a0 = *(const f32x4*)(R + 8 * lane), a1 = *(const f32x4*)(R + 8 * lane + 4), b0 = *(const f32x4*)(R + 512 + 8 * lane), b1 = *(const f32x4*)(R + 512 + 8 * lane + 4);
    float* pd = P.pd + ((size_t)x * T_ + t) * 128;
    pd[lane] = ((a0[0] + a0[1]) + (a0[2] + a0[3])) + ((a1[0] + a1[1]) + (a1[2] + a1[3]));
    pd[64 + lane] = ((b0[0] + b0[1]) + (b0[2] + b0[3])) + ((b1[0] + b1[1]) + (b1[2] + b1[3]));
}
#define PG_PIN16(v) do { _Pragma("unroll") for (int _k = 0; _k < 16; ++_k) PIN1(v[_k]); } while (0)
__device__ __forceinline__ void peer_dots_item(const Ptrs& P, int x, int blk, unsigned char* lds, int lane, int wave) {
    float* R = (float*)(lds + wave * PG_WLDS); int* E = (int*)(lds + wave * PG_WLDS + 4096);
    const int gq = lane >> 3, c8 = lane & 7, tb = blk * PG_TB + PG_TPW * wave;
    u32x4 uA[16], uB[16], xa0, xb0, xa1, xb1;
    const bf16_t* hbase = P.hb; const int* ebase = P.eid; const unsigned char* ubase = P.U8;
    const unsigned xo = (unsigned)((tb * 1024 + 128 * x + 16 * c8) * 2), eo = (unsigned)((tb * 128 + lane) * 4);
    int ea0, ea1, eb0, eb1;
    { const int* ep = P.eid + (size_t)tb * 128 + lane; ea0 = ep[0]; ea1 = ep[64]; eb0 = ep[128]; eb1 = ep[192]; }
    WAVE_SYNC(); E[lane] = ea0; E[64 + lane] = ea1; WAVE_SYNC();
#pragma unroll
    for (int k = 0; k < 16; ++k) { const unsigned off = ((unsigned)(x * NEXP) + (unsigned)E[gq + 8 * k]) * 128u + 16u * (unsigned)c8; GLOAD16_S(uA[k], ubase, off); }
    GLOAD16_S(xa0, hbase, xo); GLOAD16_S(xb0, hbase, xo + 16u); GLOAD4_S(ea0, ebase, eo + 2u * 512u); GLOAD4_S(ea1, ebase, eo + 2u * 512u + 256u);
    WAVE_SYNC(); E[lane] = eb0; E[64 + lane] = eb1; WAVE_SYNC();
#pragma unroll
    for (int k = 0; k < 16; ++k) { const unsigned off = ((unsigned)(x * NEXP) + (unsigned)E[gq + 8 * k]) * 128u + 16u * (unsigned)c8; GLOAD16_S(uB[k], ubase, off); }
    GLOAD16_S(xa1, hbase, xo + 2048u); GLOAD16_S(xb1, hbase, xo + 2048u + 16u); GLOAD4_S(eb0, ebase, eo + 3u * 512u); GLOAD4_S(eb1, ebase, eo + 3u * 512u + 256u);
#pragma unroll
    for (int i = 0; i < PG_TPW; i += 2) {
        if (i == 0) WAIT_VM(20); else WAIT_VM(22);
        PIN4(xa0, xb0, ea0, ea1);
        if (i + 2 < PG_TPW) { WAVE_SYNC(); E[lane] = ea0; E[64 + lane] = ea1; WAVE_SYNC();
            pg_dots_compute<true, 0>(P, x, tb + i, uA, xa0, xb0, R, E, c8, gq, lane);
            const unsigned nx = (unsigned)((i + 4 < PG_TPW) ? i + 4 : PG_TPW - 1), xo2 = xo + (unsigned)(i + 2) * 2048u;
            GLOAD16_S(xa0, hbase, xo2); GLOAD16_S(xb0, hbase, xo2 + 16u); GLOAD4_S(ea0, ebase, eo + nx * 512u); GLOAD4_S(ea1, ebase, eo + nx * 512u + 256u); }
        else pg_dots_compute<false, 0>(P, x, tb + i, uA, xa0, xb0, R, E, c8, gq, lane);
        if (i + 2 < PG_TPW) WAIT_VM(22); else WAIT_VM(0);
        PIN4(xa1, xb1, eb0, eb1);
        if (i + 3 < PG_TPW) { WAVE_SYNC(); E[lane] = eb0; E[64 + lane] = eb1; WAVE_SYNC();
            pg_dots_compute<true, 1>(P, x, tb + i + 1, uB, xa1, xb1, R, E, c8, gq, lane);
            const unsigned nx = (unsigned)((i + 5 < PG_TPW) ? i + 5 : PG_TPW - 1), xo2 = xo + (unsigned)(i + 3) * 2048u;
            GLOAD16_S(xa1, hbase, xo2); GLOAD16_S(xb1, hbase, xo2 + 16u); GLOAD4_S(eb0, ebase, eo + nx * 512u); GLOAD4_S(eb1, ebase, eo + nx * 512u + 256u); }
        else pg_dots_compute<false, 1>(P, x, tb + i + 1, uB, xa1, xb1, R, E, c8, gq, lane);
    }
}
template <bool REFILL, int TAG>
__device__ __forceinline__ void pg_acc_compute(const Ptrs& P, bf16_t* outp, int x, int t, u32x4 (&vb)[16], float w0, float w1, unsigned oprev, float* C, float* W, const int* E, int c8, int gq, int lane) {
    WAVE_SYNC(); W[lane] = w0; W[64 + lane] = w1; WAVE_SYNC();
    f32x2 acc[8];
#pragma unroll
    for (int q = 0; q < 8; ++q) acc[q] = (f32x2){0.f, 0.f};
    unsigned off[8]; const unsigned char* vbase = P.V8; float wk[16];
#pragma unroll
    for (int k = 0; k < 16; ++k) wk[k] = W[gq + 8 * k];
#pragma unroll
    for (int k = 0; k < 16; ++k) { PIN1(vb[k]);
        if (REFILL && (k & 7) == 0) {
#pragma unroll
            for (int j = 0; j < 8; ++j) off[j] = ((unsigned)(x * NEXP) + (unsigned)E[gq + 8 * (k + j)]) * 128u + 16u * (unsigned)c8; }
#pragma unroll
        for (int q = 0; q < 4; ++q) { acc[2 * q] += cvt_pk_f32_fp8_(vb[k][q], false) * wk[k]; acc[2 * q + 1] += cvt_pk_f32_fp8_(vb[k][q], true) * wk[k]; }
        if (REFILL) {
#pragma unroll
            for (int q = 0; q < 8; ++q) PIN1(acc[q]);
            GLOAD16_RW_S(vb[k], vbase, off[k & 7]); }
        if (TAG) TAG_B(); else TAG_A();
        SCHED_FENCE(); }
    WAVE_SYNC();
#pragma unroll
    for (int q = 0; q < 4; ++q) *(f32x4*)(C + lane * 16 + 4 * q) = (f32x4){acc[2 * q].x, acc[2 * q].y, acc[2 * q + 1].x, acc[2 * q + 1].y};
    WAVE_SYNC();
    f32x2 s = (f32x2){0.f, 0.f};
#pragma unroll
    for (int g = 0; g < 8; ++g) s += *(const f32x2*)(C + g * 128 + 2 * lane);
    *(unsigned*)(outp + (size_t)t * 1024 + 128 * x + 2 * lane) = pk2(bflo(oprev) + s.x, bfhi(oprev) + s.y);
}
__device__ __forceinline__ void peer_acc_item(bf16_t* outp, const Ptrs& P, int x, int blk, unsigned char* lds, int lane, int wave) {
    float* C = (float*)(lds + wave * PG_WLDS); int* E = (int*)(lds + wave * PG_WLDS + 4096); float* W = (float*)(lds + wave * PG_WLDS + 4608);
    const int gq = lane >> 3, c8 = lane & 7, tb = blk * PG_TB + PG_TPW * wave;
    u32x4 vA[16], vB[16]; unsigned oA, oB; float wa0, wa1, wb0, wb1; int ea0, ea1, eb0, eb1;
    const int* ebase = P.eid; const float* wbase = P.gate; const bf16_t* obase = outp; const unsigned char* vbase = P.V8;
    const unsigned eo = (unsigned)((tb * 128 + lane) * 4), oo = (unsigned)((tb * 1024 + 128 * x + 2 * lane) * 2);
    { const int* ep = P.eid + (size_t)tb * 128 + lane; ea0 = ep[0]; ea1 = ep[64]; eb0 = ep[128]; eb1 = ep[192]; }
    WAVE_SYNC(); E[lane] = ea0; E[64 + lane] = ea1; WAVE_SYNC();
#pragma unroll
    for (int k = 0; k < 16; ++k) { const unsigned off = ((unsigned)(x * NEXP) + (unsigned)E[gq + 8 * k]) * 128u + 16u * (unsigned)c8; GLOAD16_S(vA[k], vbase, off); }
    GLOAD4_S(wa0, wbase, eo); GLOAD4_S(wa1, wbase, eo + 256u); GLOAD4_S(oA, obase, oo); GLOAD4_S(ea0, ebase, eo + 2u * 512u); GLOAD4_S(ea1, ebase, eo + 2u * 512u + 256u);
    WAVE_SYNC(); E[lane] = eb0; E[64 + lane] = eb1; WAVE_SYNC();
#pragma unroll
    for (int k = 0; k < 16; ++k) { const unsigned off = ((unsigned)(x * NEXP) + (unsigned)E[gq + 8 * k]) * 128u + 16u * (unsigned)c8; GLOAD16_S(vB[k], vbase, off); }
    GLOAD4_S(wb0, wbase, eo + 512u); GLOAD4_S(wb1, wbase, eo + 512u + 256u); GLOAD4_S(oB, obase, oo + 2048u); GLOAD4_S(eb0, ebase, eo + 3u * 512u); GLOAD4_S(eb1, ebase, eo + 3u * 512u + 256u);
#pragma unroll
    for (int i = 0; i < PG_TPW; i += 2) {
        if (i == 0) WAIT_VM(21); else WAIT_VM(22);
        PIN4(wa0, wa1, ea0, ea1); PIN1(oA);
        if (i + 2 < PG_TPW) { WAVE_SYNC(); E[lane] = ea0; E[64 + lane] = ea1; WAVE_SYNC();
            pg_acc_compute<true, 0>(P, outp, x, tb + i, vA, wa0, wa1, oA, C, W, E, c8, gq, lane);
            const unsigned nx = (unsigned)((i + 4 < PG_TPW) ? i + 4 : PG_TPW - 1);
            GLOAD4_S(wa0, wbase, eo + (unsigned)(i + 2) * 512u); GLOAD4_S(wa1, wbase, eo + (unsigned)(i + 2) * 512u + 256u); GLOAD4_S(oA, obase, oo + (unsigned)(i + 2) * 2048u);
            GLOAD4_S(ea0, ebase, eo + nx * 512u); GLOAD4_S(ea1, ebase, eo + nx * 512u + 256u); }
        else pg_acc_compute<false, 0>(P, outp, x, tb + i, vA, wa0, wa1, oA, C, W, E, c8, gq, lane);
        if (i + 2 < PG_TPW) WAIT_VM(22); else WAIT_VM(0);
        PIN4(wb0, wb1, eb0, eb1); PIN1(oB);
        if (i + 3 < PG_TPW) { WAVE_SYNC(); E[lane] = eb0; E[64 + lane] = eb1; WAVE_SYNC();
            pg_acc_compute<true, 1>(P, outp, x, tb + i + 1, vB, wb0, wb1, oB, C, W, E, c8, gq, lane);
            const unsigned nx = (unsigned)((i + 5 < PG_TPW) ? i + 5 : PG_TPW - 1);
            GLOAD4_S(wb0, wbase, eo + (unsigned)(i + 3) * 512u); GLOAD4_S(wb1, wbase, eo + (unsigned)(i + 3) * 512u + 256u); GLOAD4_S(oB, obase, oo + (unsigned)(i + 3) * 2048u);
            GLOAD4_S(eb0, ebase, eo + nx * 512u); GLOAD4_S(eb1, ebase, eo + nx * 512u + 256u); }
        else pg_acc_compute<false, 1>(P, outp, x, tb + i + 1, vB, wb0, wb1, oB, C, W, E, c8, gq, lane);
    }
}
template <int STAGE, int CSET = STAGE>
__device__ __forceinline__ void phase_G12(const KP& p, int l, unsigned char* lds) {
    const Ptrs P = make_ptrs(p.ws, l);
    const int tid = TIDX(), lane = tid & 63, wave = tid >> 6;
    int* slot = (int*)(lds + 8 * PG_WLDS);
    const int myx = XCC_ID();
    for (int s = 0; s < 8; ++s) { const int x = (myx + s) & 7; unsigned* cnt = P.qcnt + (CSET * 8 + x) * 16;
        for (;;) { const int blk = peer_next_item(cnt, slot, tid); if (blk >= PG_NBLK) break;
            if (STAGE == 0) peer_dots_item(P, x, blk, lds, lane, wave); else peer_acc_item(CSET == 3 ? (bf16_t*)P.pd : P.ycat, P, x, blk, lds, lane, wave); } }
    __syncthreads();
}
__device__ __forceinline__ void phase_G1b(const KP& p, int l, unsigned char* lds) {
    const Ptrs P = make_ptrs(p.ws, l);
    const size_t stride = (size_t)GDIM() * NTHR, n = (size_t)T_ * 128;
    for (size_t i0 = (size_t)BIDX() * NTHR + TIDX(); i0 < n; i0 += 4 * stride) { float d[4], gt[4], su[4], sv[4]; int e[4];
#pragma unroll
        for (int q = 0; q < 4; ++q) { const size_t i = i0 + q * stride; e[q] = 0; gt[q] = 0.f; d[q] = 0.f; if (i < n) { e[q] = P.eid[i]; gt[q] = P.gate[i]; } }
#pragma unroll
        for (int q = 0; q < 4; ++q) { const size_t i = i0 + q * stride; su[q] = P.su[e[q]]; sv[q] = P.sv[e[q]];
            if (i < n) {
#pragma unroll
                for (int x = 0; x < 8; ++x) d[q] += P.pd[(size_t)x * T_ * 128 + i]; } }
#pragma unroll
        for (int q = 0; q < 4; ++q) { const size_t i = i0 + q * stride; if (i < n) P.gate[i] = gt[q] * sv[q] * gelu_erf(d[q] * su[q]); } }
#ifdef CPU_EMU
    (void)lds;
#endif
}
__device__ __forceinline__ void phase_G3(const KP& p, int l, unsigned char* lds, bool last) {
    const Ptrs P = make_ptrs(p.ws, l);
    const int tid = TIDX(), lane = tid & 63, wave = tid >> 6; const int gw = BIDX() * NWAVE + wave, NGW = GDIM() * NWAVE;
    for (int m = 4 * gw; m < T_; m += 4 * NGW) ln_rows<4, true>(P.ycat + (size_t)m * 1024, p.in[I_LN2G] + l * 1024, p.in[I_LN2B] + l * 1024, last ? p.out + (size_t)m * 1024 : (float*)nullptr, last ? (bf16_t*)nullptr : P.hb + (size_t)m * 1024,
                                                           last ? (unsigned char*)nullptr : (m < H8_SPLIT ? P.h8a + (size_t)m * 1024 : P.h8b + (size_t)(m - H8_SPLIT) * 1024), lane);
}
#ifndef PROBE_REPEAT
#define PROBE_REPEAT 0
#endif
constexpr int LDS_BYTES = 147456;
__device__ __forceinline__ void phase_B1(const KP& p, int l, unsigned char* lds) {
    const Ptrs P = make_ptrs(p.ws, l);
    constexpr int NRC = NB_ * 4 * RW_NCH, NS5 = NB_ * 16, NFX = NB_ * 4 * (S_ / 256), NCV = T_ / 64;
    const int G = GDIM(); int it = BIDX();
    for (; it < NRC; it += G) rw_chunk_unit(p, P, l, it, lds);
#if PROBE_REPEAT == 16
    for (int j = BIDX(); j < NRC; j += G) rw_chunk_unit(p, P, l, j, lds);
#endif
#if PROBE_REPEAT >= 161 && PROBE_REPEAT <= 163
    for (int j = BIDX(); j < NRC; j += G) { rw_chunk_unit<PROBE_REPEAT - 160>(p, P, l, j, lds); __syncthreads(); }
#endif
    for (; it < NRC + NFX; it += G) fox_unit(p, P, l, it - NRC, lds);
#if PROBE_REPEAT == 17
    for (int j = BIDX(); j < NFX; j += G) fox_unit(p, P, l, j, lds);
#endif
    for (; it < NRC + NFX + NS5; it += G) s5_unit(p, P, l, it - NRC - NFX, lds);
#if PROBE_REPEAT == 18
    for (int j = BIDX(); j < NS5; j += G) s5_unit(p, P, l, j, lds);
#endif
    for (; it < NRC + NFX + NS5 + NCV; it += G) conv_unit(p, P, l, it - NRC - NFX - NS5, lds);
#if PROBE_REPEAT == 19
    for (int j = BIDX(); j < NCV; j += G) conv_unit(p, P, l, j, lds);
#endif
}
__device__ __forceinline__ void phase_B3(const KP& p, int l, unsigned char* lds) {
    const Ptrs P = make_ptrs(p.ws, l);
#if PROBE_REPEAT == 34
    for (int it = BIDX(); it < NB_ * 4 * RW_NCH; it += GDIM()) rw_out_unit<true>(p, P, l, it, lds);
#endif
    for (int it = BIDX(); it < NB_ * 4 * RW_NCH; it += GDIM()) rw_out_unit<false>(p, P, l, it, lds);
}
enum { PH_PRO = 0, PH_A, PH_B1, PH_B2, PH_B3, PH_C, PH_D, PH_D2, PH_E, PH_F, PH_G, PH_G1B, PH_G2, PH_G3, PH_N, PH_A0 };
__device__ __forceinline__ void run_phase(const KP& p, int ph, int l, unsigned char* lds) {
    switch (ph) {
        case PH_PRO: phase_prologue(p, lds); break;
        case PH_A: phase_A(p, l, lds); break;
        case PH_A0: phase_A0(p, lds); break;
        case PH_B1: phase_B1(p, l, lds); break;
        case PH_B2: phase_B2(p, l, lds); break;
        case PH_B3: phase_B3(p, l, lds); break;
        case PH_C: phase_C(p, l, lds); break;
        case PH_D: phase_D(p, l, lds); break;
        case PH_D2: phase_D2(p, l, lds); break;
        case PH_E: phase_E(p, l, lds); break;
        case PH_F: phase_F(p, l, lds); break;
        case PH_G: phase_G12<0>(p, l, lds); break;
        case PH_G1B: phase_G1b(p, l, lds); break;
        case PH_G2: phase_G12<1>(p, l, lds); break;
        case PH_G3: phase_G3(p, l, lds, l == L_ - 1); break;
        default: break;
    }
}
#ifndef CPU_EMU
#define XB_TMO      128
#define XB_XCNT(j)  (256  + 64 * (j))
#define XB_XSUB(j)  (1280 + 64 * (j))
#define XB_XGEN(j)  (2304 + 64 * (j))
#define XB_TOP      3328
#define XB_TOPGEN   3392
#define XCD_BAR_WORDS 3456
#define XB_SPIN_CAP (1u << 22)
__device__ __forceinline__ unsigned xb_ld(unsigned* p)              { return __hip_atomic_load(p, __ATOMIC_RELAXED, __HIP_MEMORY_SCOPE_AGENT); }
__device__ __forceinline__ unsigned xb_add(unsigned* p, unsigned v) { return __hip_atomic_fetch_add(p, v, __ATOMIC_RELAXED, __HIP_MEMORY_SCOPE_AGENT); }
__device__ __forceinline__ unsigned xb_xcc_id() { return (unsigned)__builtin_amdgcn_s_getreg((3 << 11) | 20) & 0xFu; }
#define XB_SPIN(cond, bar) do { unsigned _sp = 0; while (cond) { __builtin_amdgcn_s_sleep(1); \
    if ((++_sp & 255u) == 0u) { if (xb_ld(&(bar)[XB_TMO])) break; if (_sp > XB_SPIN_CAP) { atomicAdd(&(bar)[XB_TMO], 1u); break; } } } } while (0)
struct XcdBarrier { unsigned* bar; unsigned x; volatile LAS unsigned* st; };
__device__ __forceinline__ XcdBarrier xcd_barrier_post(unsigned* bar, volatile LAS unsigned* st) {
    XcdBarrier b; b.bar = bar; b.x = xb_xcc_id(); b.st = st;
    if (threadIdx.x == 0) (void)xb_add(&bar[XB_XCNT(b.x)], 1u);
    return b;
}
__device__ __forceinline__ void xcd_barrier_complete(unsigned* bar, unsigned x, unsigned& nloc, unsigned& nx) {
    const unsigned G = gridDim.x * gridDim.y * gridDim.z;
    unsigned sum, cnt, mine, sp = 0u;
    for (;;) {
        sum = 0u; cnt = 0u; mine = 0u;
#pragma unroll
        for (unsigned j = 0; j < 16; ++j) { const unsigned c = xb_ld(&bar[XB_XCNT(j)]); sum += c; cnt += (c > 0u) ? 1u : 0u; mine = (j == x) ? c : mine; }
        if (sum == G) break;
        __builtin_amdgcn_s_sleep(1);
        if ((++sp & 255u) == 0u) { if (xb_ld(&bar[XB_TMO])) break; if (sp > XB_SPIN_CAP) { atomicAdd(&bar[XB_TMO], 1u); break; } }
    }
    nloc = mine > 0u ? mine : 1u; nx = cnt > 0u ? cnt : 1u;
}
__device__ __forceinline__ void xcd_barrier(const XcdBarrier& b) {
    asm volatile("s_waitcnt vmcnt(0)" ::: "memory");
    __syncthreads();
    if (threadIdx.x == 0) {
        unsigned* bar = b.bar;
        __builtin_amdgcn_s_waitcnt(0);
        unsigned nloc = b.st[0], nx = b.st[1];
        if (nloc == 0u) { xcd_barrier_complete(bar, b.x, nloc, nx); b.st[0] = nloc; b.st[1] = nx; }
        const unsigned old = xb_add(&bar[XB_XSUB(b.x)], 1u);
        const unsigned gen = old / nloc;
        if (old + 1u == (gen + 1u) * nloc) {
            __builtin_amdgcn_fence(__ATOMIC_RELEASE, "agent");
            asm volatile("s_waitcnt vmcnt(0)" ::: "memory");
            const unsigned og = xb_add(&bar[XB_TOP], 1u);
            const unsigned tg = og / nx;
            if (og + 1u == (tg + 1u) * nx) xb_add(&bar[XB_TOPGEN], 1u);
            else XB_SPIN(xb_ld(&bar[XB_TOPGEN]) == tg, bar);
            __builtin_amdgcn_fence(__ATOMIC_ACQUIRE, "agent");
            xb_add(&bar[XB_XGEN(b.x)], 1u);
            asm volatile("s_waitcnt vmcnt(0)" ::: "memory");
        } else {
            XB_SPIN(xb_ld(&bar[XB_XGEN(b.x)]) == gen, bar);
            __builtin_amdgcn_fence(__ATOMIC_ACQUIRE, "agent");
            asm volatile("s_waitcnt vmcnt(0)" ::: "memory");
        }
    }
    __syncthreads();
}
#ifndef PROBE_REPEAT
#define PROBE_REPEAT 0
#endif
#ifndef N_LAUNCH_MODE
#define N_LAUNCH_MODE 1
#endif
extern __shared__ __attribute__((aligned(16))) unsigned char lds_dyn[];
#if N_LAUNCH_MODE == 0
template <int PH> __global__ void __launch_bounds__(NTHR, 2) k_phase_t(KP p) { run_phase(p, PH, p.layer, lds_dyn); }
typedef void (*kfn_t)(KP);
static kfn_t phase_fn(int ph) { switch (ph) { case PH_PRO: return k_phase_t<PH_PRO>; case PH_A: return k_phase_t<PH_A>; case PH_B1: return k_phase_t<PH_B1>; case PH_B2: return k_phase_t<PH_B2>; case PH_B3: return k_phase_t<PH_B3>; case PH_C: return k_phase_t<PH_C>;
    case PH_D: return k_phase_t<PH_D>; case PH_D2: return k_phase_t<PH_D2>; case PH_E: return k_phase_t<PH_E>; case PH_F: return k_phase_t<PH_F>; case PH_G: return k_phase_t<PH_G>; case PH_G1B: return k_phase_t<PH_G1B>; case PH_G2: return k_phase_t<PH_G2>; default: return k_phase_t<PH_G3>; } }
#else
#ifndef USE_XCD_BARRIER
#define USE_XCD_BARRIER 1
#endif
constexpr int BAR_LDS_OFF = LDS_BYTES - 64;
#if USE_XCD_BARRIER
#define GSYNC() xcd_barrier(bar)
#define GSYNC_ARG const XcdBarrier& bar
#else
#define GSYNC() grid.sync()
#define GSYNC_ARG cg::grid_group& grid
#endif
template <int l>
__device__ __forceinline__ void mega_layer(const KP& p, GSYNC_ARG) {
#if PROBE_REPEAT == 47 || PROBE_REPEAT == 48
        phase_Aprobe<PROBE_REPEAT - 40>(p, l, lds_dyn); GSYNC();
#endif
        phase_A(p, l, lds_dyn);
#if PROBE_REPEAT == 1
        GSYNC(); phase_A(p, l, lds_dyn);
#endif
#if PROBE_REPEAT >= 40 && PROBE_REPEAT <= 46
        GSYNC(); phase_Aprobe<PROBE_REPEAT - 40>(p, l, lds_dyn);
#endif
        GSYNC(); phase_B1(p, l, lds_dyn);
#if PROBE_REPEAT == 2
        GSYNC(); phase_B1(p, l, lds_dyn);
#endif
        GSYNC(); phase_B2(p, l, lds_dyn);
        GSYNC(); phase_B3(p, l, lds_dyn);
        GSYNC(); phase_C(p, l, lds_dyn);
#if PROBE_REPEAT == 4
        GSYNC(); phase_C(p, l, lds_dyn);
#endif
        GSYNC(); phase_D(p, l, lds_dyn);
        GSYNC(); phase_D2(p, l, lds_dyn);
        GSYNC(); phase_E(p, l, lds_dyn);
        GSYNC(); phase_F(p, l, lds_dyn);
#if PROBE_REPEAT == 8
        GSYNC(); phase_F(p, l, lds_dyn);
#endif
        GSYNC(); phase_G12<0>(p, l, lds_dyn);
#if PROBE_REPEAT == 32
        GSYNC(); phase_G12<0, 2>(p, l, lds_dyn);
#endif
        GSYNC(); phase_G1b(p, l, lds_dyn);
        GSYNC(); phase_G12<1>(p, l, lds_dyn);
#if PROBE_REPEAT == 33
        GSYNC(); phase_G12<1, 3>(p, l, lds_dyn);
#endif
        GSYNC(); phase_G3(p, l, lds_dyn, l == L_ - 1);
}
__global__ void __launch_bounds__(NTHR, 2) k_mega(KP p) {
    cg::grid_group grid = cg::this_grid();
#if USE_XCD_BARRIER
    volatile LAS unsigned* st = (volatile LAS unsigned*)(lds_dyn + BAR_LDS_OFF);
    if (threadIdx.x < 2) st[threadIdx.x] = 0u;
    __syncthreads();
    const XcdBarrier bar = xcd_barrier_post((unsigned*)(p.ws + WS_CTL) + 4096, st);
#define GSYNC_VAL bar
#else
#define GSYNC_VAL grid
#endif
    phase_prologue(p, lds_dyn);
#if PROBE_REPEAT == 60
    GSYNC(); phase_prologue(p, lds_dyn);
#endif
    grid.sync();
    phase_A0(p, lds_dyn);
    GSYNC();
    mega_layer<0>(p, GSYNC_VAL);
    static_assert(L_ == 2, "two layers");
    GSYNC();
    mega_layer<1>(p, GSYNC_VAL);
}
#endif
extern "C" void kernel_launch(void* const* d_in, const int* in_sizes, int n_in, void* d_out, int out_size, void* d_ws, size_t ws_size, hipStream_t stream) {
    static int grid = 0;
    if (grid == 0) {
        if (n_in != N_IN || out_size != T_ * 1024 || ws_size < WS_END) { fprintf(stderr, "kernel_launch: unexpected shapes (n_in %d out %d ws %zu need %zu)\n", n_in, out_size, ws_size, (size_t)WS_END); grid = -1; return; }
        int dev = 0, cus = 0, per_cu = 0;
        (void)hipGetDevice(&dev); (void)hipDeviceGetAttribute(&cus, hipDeviceAttributeMultiprocessorCount, dev);
#if N_LAUNCH_MODE == 0
        for (int ph = 0; ph < PH_N; ++ph) (void)hipFuncSetAttribute((const void*)phase_fn(ph), hipFuncAttributeMaxDynamicSharedMemorySize, LDS_BYTES);
        (void)per_cu;
#else
        (void)hipFuncSetAttribute((const void*)k_mega, hipFuncAttributeMaxDynamicSharedMemorySize, LDS_BYTES);
        (void)hipOccupancyMaxActiveBlocksPerMultiprocessor(&per_cu, (const void*)k_mega, NTHR, LDS_BYTES);
        if (per_cu < 1) { fprintf(stderr, "kernel_launch: occupancy query says %d blocks per CU\n", per_cu); grid = -1; return; }
#endif
        grid = cus;
    }
    if (grid < 0) return;
    if (hipMemsetAsync((char*)d_ws + WS_CTL, 0, 65536, stream) != hipSuccess) { fprintf(stderr, "kernel_launch: memset failed\n"); return; }
    KP p{};
    for (int i = 0; i < N_IN; ++i) p.in[i] = (const float*)d_in[i];
    p.out = (float*)d_out; p.ws = (unsigned char*)d_ws;
#if N_LAUNCH_MODE == 1
    void* args[] = {&p};
    hipError_t e = hipLaunchCooperativeKernel((const void*)k_mega, dim3(grid), dim3(NTHR), args, LDS_BYTES, stream);
    if (e != hipSuccess) fprintf(stderr, "cooperative launch failed: %s (grid %d)\n", hipGetErrorString(e), grid);
#else
    p.phase = PH_PRO; p.layer = 0; hipLaunchKernelGGL(phase_fn(PH_PRO), dim3(grid), dim3(NTHR), LDS_BYTES, stream, p);
    for (int l = 0; l < L_; ++l) for (int ph = PH_A; ph < PH_N; ++ph) { p.phase = ph; p.layer = l; hipLaunchKernelGGL(phase_fn(ph), dim3(grid), dim3(NTHR), LDS_BYTES, stream, p); }
#endif
}
#endif
```

```cpp
#ifdef CPU_EMU
#include "emu.h"
#define LAS
#define GET_LDS() ((unsigned char*)emu::lds())
#define AS_GLOBAL(p) (p)
#define AS_LDS(p) (p)
#define RFL(x) (x)
#define MFMA32(a, b, c) emu_mfma32(a, b, c)
#define MFMA16(a, b, c) emu_mfma16(a, b, c)
#define MFMA16_FP8(a, b, c) emu_mfma16_fp8(a, b, c)
#define FAST_EXP2(x) exp2f(x)
#define FAST_RCP(x) (1.0f / (x))
#define FAST_LOG2(x) log2f(x)
#define FAST_RSQ(x) (1.0f / sqrtf(x))
#define WAVE_SYNC() do { uint32_t _z = 0; (void)emu::wave_xchg(&_z, 1); } while (0)
#define OPAQUE(x) do {} while (0)
#define GLDS16(gp, lp, lane) memcpy((char*)(lp) + 16 * (lane), (const void*)(gp), 16)
#define WAIT_VM(n) do {} while (0)
#define GLOAD16_ASM(dst, ptr) (dst) = *(const u32x4*)(ptr)
#define GLOAD16_RW(dst, ptr) (dst) = *(const u32x4*)(ptr)
#define PIN1(a) do {} while (0)
#define GLOAD16_RW_S(dst, base, off) (dst) = *(const u32x4*)((const unsigned char*)(base) + (off))
#define SCHED_FENCE() do {} while (0)
#define TAG_A() do {} while (0)
#define TAG_B() do {} while (0)
#define GLOAD16_S(dst, base, off) (dst) = *(const u32x4*)((const unsigned char*)(base) + (off))
#define GLOAD4_S(dst, base, off) memcpy(&(dst), (const unsigned char*)(base) + (off), 4)
#define GLOAD4_ASM(dst, ptr) (dst) = *(const int*)(ptr)
#define PIN4(a, b, c, d) do {} while (0)
#define PIN2I(a, b) do {} while (0)
#define WAIT_LGKM0() do {} while (0)
#define READLANE_I(v, l) __shfl((int)(v), (l))
#define READLANE_F(v, l) __shfl((float)(v), (l))
#define TIDX() ((int)threadIdx.x)
#define XCC_ID() (emu::bid() & 7)
#define GDIM() ((int)gridDim.x)
#define BIDX() ((int)blockIdx.x)
#define OPAQUE_S(x) do {} while (0)
#define MEMFENCE() do {} while (0)
#else
#include <hip/hip_runtime.h>
#include <hip/hip_cooperative_groups.h>
#include <cstdio>
#include <cstdint>
namespace cg = cooperative_groups;
#define LAS __attribute__((address_space(3)))
#define GAS __attribute__((address_space(1)))
#define AS_GLOBAL(p) ((unsigned char*)(GAS unsigned char*)(p))
#define AS_LDS(p) ((unsigned char*)(LAS unsigned char*)(p))
#define RFL(x) __builtin_amdgcn_readfirstlane(x)
#define MFMA32(a, b, c) __builtin_amdgcn_mfma_f32_32x32x16_bf16(a, b, c, 0, 0, 0)
#define MFMA16(a, b, c) __builtin_amdgcn_mfma_f32_16x16x32_bf16(a, b, c, 0, 0, 0)
#define MFMA16_FP8(a, b, c) __builtin_amdgcn_mfma_f32_16x16x32_fp8_fp8((long)(a), (long)(b), c, 0, 0, 0)
#define MFMA16_F8X128(a, b, c) __builtin_amdgcn_mfma_scale_f32_16x16x128_f8f6f4(a, b, c, 0, 0, 0, 0, 0, 0)
#define FAST_EXP2(x) __builtin_amdgcn_exp2f(x)
#define FAST_RCP(x) __builtin_amdgcn_rcpf(x)
#define FAST_LOG2(x) __builtin_amdgcn_logf(x)
#define FAST_RSQ(x) __builtin_amdgcn_rsqf(x)
#define WAVE_SYNC() __builtin_amdgcn_wave_barrier()
#define OPAQUE(x) asm volatile("" : "+v"(x))
#define GLDS16(gp, lp, lane) __builtin_amdgcn_global_load_lds((const unsigned*)(gp), (LAS unsigned*)(lp), 16, 0, 0)
#define WAIT_VM(n) asm volatile("s_waitcnt vmcnt(" #n ")" ::: "memory")
#define GLOAD16_ASM(dst, ptr) asm volatile("global_load_dwordx4 %0, %1, off" : "=v"(dst) : "v"(ptr) : "memory")
#define GLOAD4_ASM(dst, ptr) asm volatile("global_load_dword %0, %1, off" : "=v"(dst) : "v"(ptr) : "memory")
#define GLOAD16_RW(dst, ptr) asm volatile("global_load_dwordx4 %0, %1, off" : "+v"(dst) : "v"(ptr) : "memory")
#define PIN1(a) asm volatile("" : "+v"(a) :: "memory")
#define GLOAD16_RW_S(dst, base, off) asm volatile("global_load_dwordx4 %0, %1, %2" : "+v"(dst) : "v"(off), "s"(base) : "memory")
#define SCHED_FENCE() __builtin_amdgcn_sched_barrier(0)
#define TAG_A() asm volatile("; buffer A" ::: "memory")
#define TAG_B() asm volatile("; buffer B" ::: "memory")
#define GLOAD16_S(dst, base, off) asm volatile("global_load_dwordx4 %0, %1, %2" : "=v"(dst) : "v"(off), "s"(base) : "memory")
#define GLOAD4_S(dst, base, off) asm volatile("global_load_dword %0, %1, %2" : "=v"(dst) : "v"(off), "s"(base) : "memory")
#define PIN4(a, b, c, d) asm volatile("" : "+v"(a), "+v"(b), "+v"(c), "+v"(d) :: "memory")
#define PIN2I(a, b) asm volatile("" : "+v"(a), "+v"(b) :: "memory")
#define WAIT_LGKM0() asm volatile("s_waitcnt lgkmcnt(0)" ::: "memory")
#define READLANE_I(v, l) __builtin_amdgcn_readlane((int)(v), (l))
#define READLANE_F(v, l) __builtin_bit_cast(float, __builtin_amdgcn_readlane(__builtin_bit_cast(int, (float)(v)), (l)))
#define OPAQUE_S(x) asm volatile("" : "+s"(x))
__device__ __forceinline__ int opaque_tid_() { int t = threadIdx.x; asm volatile("" : "+v"(t)); return t; }
#define TIDX() opaque_tid_()
#define XCC_ID() ((int)(__builtin_amdgcn_s_getreg((3 << 11) | 20) & 7u))
__device__ __forceinline__ int opaque_gdim_() { int t = gridDim.x; asm volatile("" : "+s"(t)); return t; }
__device__ __forceinline__ int opaque_bidx_() { int t = blockIdx.x; asm volatile("" : "+s"(t)); return t; }
#define GDIM() opaque_gdim_()
#define BIDX() opaque_bidx_()
#define MEMFENCE() do { asm volatile("" ::: "memory"); __builtin_amdgcn_sched_barrier(0); } while (0)
#endif

#ifndef CFG_B
#define CFG_B 16
#endif
#ifndef CFG_S
#define CFG_S 2048
#endif

typedef unsigned short bf16_t;
typedef short bf16x8 __attribute__((ext_vector_type(8)));
typedef short s16x4 __attribute__((ext_vector_type(4)));
typedef float f32x4 __attribute__((ext_vector_type(4)));
typedef float f32x2 __attribute__((ext_vector_type(2)));
typedef float f32x16 __attribute__((ext_vector_type(16)));
typedef unsigned u32x4 __attribute__((ext_vector_type(4)));
typedef unsigned u32x2 __attribute__((ext_vector_type(2)));
typedef int i32x4 __attribute__((ext_vector_type(4)));
typedef int i32x8 __attribute__((ext_vector_type(8)));

constexpr int NB_ = CFG_B, S_ = CFG_S, T_ = NB_ * S_, D_ = 1024, L_ = 2;
constexpr int NTHR = 512, NWAVE = 8;
constexpr int PJ = 2304;
constexpr int C_R = 0, C_K = 256, C_V = 512, C_HW = 768, C_HA = 800, C_HG = 832, C_S5 = 896, C_FQ = 1152, C_FK = 1408, C_FL = 1664, C_CV = 1792, C_CG = 2048;
constexpr int WIN_ROWS = 6656, WIN_VT = 2304, WIN_GATE = 2560;
constexpr int IN_COLS = 6532;
constexpr float LN_EPS_ = 1e-5f, GN_EPS_ = 64e-5f;
constexpr float DN_ALPHA_ = 1.4142135623730951f;
constexpr int NEXP = 16384;

enum { I_X = 0, I_P, I_LNIN_G, I_LNIN_B, I_WIN, I_MU, I_W0, I_W2, I_A0, I_A2, I_G2, I_KK, I_KA, I_RK, I_LNXG, I_LNXB, I_LRE, I_LIM, I_BRE, I_BIM, I_CRE, I_CIM,
       I_S5D, I_LDT, I_GLUW, I_GLUB, I_BF, I_CONVW, I_CONVB, I_CLNG, I_CLNB, I_WBR, I_WOUT, I_LN1G, I_LN1B, I_WQ, I_K1, I_K2, I_U, I_V, I_PLEW, I_PLEG, I_LN2G, I_LN2B, N_IN };

constexpr size_t al256(size_t x) { return (x + 255) & ~(size_t)255; }
constexpr size_t WS_CTL = 0;
constexpr size_t WS_WIN = 1u << 20;
constexpr size_t WS_WBR = WS_WIN + al256((size_t)L_ * WIN_ROWS * 1024 * 2);
constexpr size_t WS_WOUT = WS_WBR + (size_t)L_ * 1024 * 1024 * 2;
constexpr size_t WS_WQ = WS_WOUT + (size_t)L_ * 1024 * 1024 * 2;
constexpr size_t WS_PLE = WS_WQ + (size_t)L_ * 2048 * 1024 * 2;
constexpr size_t WS_PLEG = WS_PLE + (size_t)L_ * 1024 * 256 * 2;
constexpr size_t WS_GLU = WS_PLEG + (size_t)L_ * 1024 * 1024 * 2;
constexpr size_t WS_K12 = WS_GLU + (size_t)L_ * 256 * 256 * 2;
constexpr size_t WS_S5KC = WS_K12 + (size_t)L_ * 2 * 128 * 128 * 2;
constexpr size_t WS_S5WX = WS_S5KC + (size_t)L_ * 16 * 64 * 256 * 2;
constexpr size_t WS_S5WY = WS_S5WX + (size_t)L_ * 16 * 128 * 1024 * 2;
constexpr size_t WS_S5LL = WS_S5WY + (size_t)L_ * 16 * 1024 * 128 * 2;
constexpr size_t WS_UT = WS_S5LL + al256((size_t)L_ * 16 * 64 * 2 * 4);
constexpr size_t WS_VT = WS_UT + (size_t)NEXP * 1024 * 2;
constexpr size_t WS_RW = WS_VT + (size_t)NEXP * 1024 * 2;
constexpr size_t RW_SZ = (size_t)T_ * 512;
static_assert(2 * RW_SZ <= (size_t)NEXP * 1024 * 2, "RWKV gate / bonus arrays fit the second table region");
constexpr size_t WS_HB = WS_RW + 4 * RW_SZ;
constexpr size_t WS_R1 = WS_HB + (size_t)T_ * 1024 * 2;
constexpr size_t R1_BYTES = (size_t)T_ * 2560 * 2;
constexpr size_t WS_YC = WS_R1 + R1_BYTES;
constexpr size_t WS_VTR = WS_YC + (size_t)T_ * 1024 * 2;
constexpr size_t WS_PB = WS_VTR + (size_t)256 * T_ * 2;
constexpr size_t WS_H8T = WS_PB + (size_t)T_ * 256 * 2;
constexpr int H8_SPLIT = (T_ / 512) * 256;
constexpr size_t WS_END = WS_H8T + (size_t)(T_ - H8_SPLIT) * 1024;
constexpr size_t R1_PROJ = 0;
constexpr size_t R1_H8 = (size_t)T_ * 2304 * 2;
constexpr size_t R1_MERGED = 0;
constexpr size_t R1_STASH = (size_t)T_ * 1024 * 2;
constexpr size_t R1_Q = 0;
constexpr size_t R1_EID = (size_t)T_ * 2048 * 2;
constexpr size_t R1_GATE = R1_EID + (size_t)T_ * 128 * 4;
static_assert(R1_GATE + (size_t)T_ * 128 * 4 <= R1_BYTES, "R1 map");

struct KP { const float* in[N_IN]; float* out; unsigned char* ws; float* dbg; int layer; int phase; };

#ifdef CPU_EMU
__device__ __forceinline__ unsigned f2bf(float f) { unsigned u = __builtin_bit_cast(unsigned, f); return (u + 0x7fffu + ((u >> 16) & 1u)) >> 16; }
__device__ __forceinline__ unsigned pk2(float lo, float hi) { return f2bf(lo) | (f2bf(hi) << 16); }
#else
typedef __bf16 bf16x2_hw __attribute__((ext_vector_type(2)));
__device__ __forceinline__ unsigned pk2(float lo, float hi) { const f32x2 v = {lo, hi}; return __builtin_bit_cast(unsigned, __builtin_convertvector(v, bf16x2_hw)); }
__device__ __forceinline__ unsigned f2bf(float f) { return pk2(f, 0.f) & 0xffffu; }
#endif
__device__ __forceinline__ float bf2f(unsigned h) { return __builtin_bit_cast(float, h << 16); }
__device__ __forceinline__ float bflo(unsigned w) { return __builtin_bit_cast(float, w << 16); }
__device__ __forceinline__ float bfhi(unsigned w) { return __builtin_bit_cast(float, w & 0xffff0000u); }
__device__ __forceinline__ float sigmoidf_(float x) { return FAST_RCP(1.0f + FAST_EXP2(x * -1.4426950408889634f)); }
__device__ __forceinline__ float gelu_erf(float v) {
    const float t = FAST_RCP(fabsf(v) * 0.2316418882f + 1.0f);
    float q = t * 0.5307027145f + (-0.7265760135f); q = q * t + 0.7107068705f; q = q * t + (-0.142248368f); q = q * t + 0.127414796f; q = q * t;
    const float m = v * (q * FAST_EXP2((v * v) * (-0.72134752044f)));
    return v < 0.f ? m : v - m; }
#ifdef CPU_EMU
inline float fp8_dec_(unsigned b) { const unsigned s = b >> 7, e = (b >> 3) & 15, m = b & 7; float v = (e == 0) ? ldexpf((float)m, -9) : ldexpf(1.f + m * 0.125f, (int)e - 7); return s ? -v : v; }
inline unsigned fp8_enc_(float x) { const unsigned s = x < 0.f ? 0x80u : 0u; float a = fabsf(x); if (!(a > 0.f)) return s; if (a > 448.f) a = 448.f;
    int e; (void)frexpf(a, &e); e -= 1; if (e < -6) e = -6;
    const float q = ldexpf(a, 3 - e); float r = nearbyintf(q);
    unsigned ee, mm; if (e == -6 && r < 8.f) { ee = 0; mm = (unsigned)r; } else { if (r >= 16.f) { r = 8.f; e += 1; } ee = (unsigned)(e + 7); mm = (unsigned)r - 8u; }
    if (ee > 15u || (ee == 15u && mm > 6u)) { ee = 15u; mm = 6u; }
    return s | (ee << 3) | mm; }
inline f32x2 cvt_pk_f32_fp8_(unsigned w, bool hi) { const unsigned h = hi ? (w >> 16) : w; return (f32x2){fp8_dec_(h & 255u), fp8_dec_((h >> 8) & 255u)}; }
inline unsigned cvt_pk_fp8_f32_(float a, float b, unsigned old, bool hi) { const unsigned p = fp8_enc_(a) | (fp8_enc_(b) << 8); return hi ? ((old & 0xffffu) | (p << 16)) : ((old & 0xffff0000u) | p); }
#else
__device__ __forceinline__ f32x2 cvt_pk_f32_fp8_(unsigned w, bool hi) { return hi ? __builtin_amdgcn_cvt_pk_f32_fp8((int)w, true) : __builtin_amdgcn_cvt_pk_f32_fp8((int)w, false); }
__device__ __forceinline__ unsigned cvt_pk_fp8_f32_(float a, float b, unsigned old, bool hi) { return hi ? (unsigned)__builtin_amdgcn_cvt_pk_fp8_f32(a, b, (int)old, true) : (unsigned)__builtin_amdgcn_cvt_pk_fp8_f32(a, b, (int)old, false); }
#endif
__device__ __forceinline__ float wave_max(float v) {
#pragma unroll
  for (int o = 1; o < 64; o <<= 1) v = fmaxf(v, __shfl_xor(v, o));
  return v;
}
template <int N> __device__ __forceinline__ void wave_sum_n(float (&v)[N]) {
#pragma unroll
  for (int o = 1; o < 64; o <<= 1) { float t[N];
#pragma unroll
    for (int i = 0; i < N; ++i) t[i] = __shfl_xor(v[i], o);
#pragma unroll
    for (int i = 0; i < N; ++i) v[i] += t[i]; }
}
__device__ __forceinline__ float wave_sum(float v) {
#pragma unroll
  for (int o = 1; o < 64; o <<= 1) v += __shfl_xor(v, o);
  return v;
}
namespace pg8 {
constexpr int BM = 256, BK = 64, HALF = 128, HTB = HALF * BK * 2, STAGE_BYTES = 8 * HTB;
__host__ __device__ __forceinline__ int lds_byte(int r, int c) { const int st = (r >> 4) * 2 + (c >> 5), rr = r & 15, cc = c & 31, ob = rr * 64 + cc * 2; return st * 1024 + (ob ^ (((ob >> 9) & 1) << 5)); }
__host__ __device__ __forceinline__ void stage_rc(int b, int& R, int& C) { const int st = b / 1024, sb = b % 1024, swz = sb ^ (((sb >> 9) & 1) << 5); R = (st >> 1) * 16 + swz / 64; C = (st & 1) * 32 + (swz % 64) / 2; }
__host__ __device__ __forceinline__ int perm32(int rho) { const int n = rho >> 4, i = rho & 15; return 8 * (i >> 2) + 4 * n + (i & 3); }

struct Unit { const char* a; const char* b; int nt; int kind; int pm; int pn; int aux; int f8; };

#ifndef CPU_EMU
template <int MODE = 0, class Epi, class Sched>
__device__ __forceinline__ void gemm_phase(LAS unsigned char* lds, const int lda, const int ldb, const Sched& S, const Epi& E, const int lda8 = 0) {
    const int tid = TIDX(), wid = __builtin_amdgcn_readfirstlane(tid >> 6), lane = tid & 63, wr = wid >> 2, wc = wid & 3, fr = lane & 15, fq = lane >> 4;
    unsigned voffA[2], voffB[2], voffA8[2];
#pragma unroll
    for (int i = 0; i < 2; ++i) { int R, C; stage_rc(tid * 16 + i * 8192, R, C); const int Rb = (R & ~31) + perm32(R & 31);
        voffA[i] = (unsigned)(R * lda + C) * 2u; voffB[i] = (unsigned)(Rb * ldb + C) * 2u; voffA8[i] = (unsigned)(R * lda8 + C * 2); }
    const size_t kstep = (size_t)(BK * 2);
    const size_t hstepA = (size_t)HALF * lda * 2, hstepB = (size_t)HALF * ldb * 2, hstepA8 = (size_t)HALF * lda8;
    const unsigned ldsw = (unsigned)wid * 1024u;
    const int aoff = lds_byte(wr * 64 + fr, fq * 8), boff = lds_byte(wc * 32 + fr, fq * 8);
#define PG8_SA(b, h) (((b) * 2 + (h)) * HTB)
#define PG8_SB(b, h) ((4 + (b) * 2 + (h)) * HTB)
#define PG8_STAGE(bufoff, gbase, voff) do { _Pragma("unroll") for (int _i = 0; _i < 2; ++_i) \
        __builtin_amdgcn_global_load_lds((const unsigned*)((const char*)(gbase) + (voff)[_i]), (LAS unsigned*)(lds + (bufoff) + ldsw + _i * 8192), 16, 0, 0); } while (0)
#define PG8_LDA(dst, b, h) do { _Pragma("unroll") for (int m = 0; m < 4; ++m) _Pragma("unroll") for (int k = 0; k < 2; ++k) dst[m][k] = *(const LAS bf16x8*)(lds + PG8_SA(b, h) + aoff + m * 2048 + k * 1024); } while (0)
#define PG8_LDB(dst, b, h) do { _Pragma("unroll") for (int n = 0; n < 2; ++n) _Pragma("unroll") for (int k = 0; k < 2; ++k) dst[n][k] = *(const LAS bf16x8*)(lds + PG8_SB(b, h) + boff + n * 2048 + k * 1024); } while (0)
#define PG8_MMA(ai, bj, At, Bt) do { __builtin_amdgcn_s_setprio(1); _Pragma("unroll") for (int m = 0; m < 4; ++m) _Pragma("unroll") for (int n = 0; n < 2; ++n) _Pragma("unroll") for (int k = 0; k < 2; ++k) \
        acc[ai][bj][m][n] = __builtin_amdgcn_mfma_f32_16x16x32_bf16(Bt[n][k], At[m][k], acc[ai][bj][m][n], 0, 0, 0); __builtin_amdgcn_s_setprio(0); } while (0)
#define PG8_CAT(x, y) __builtin_shufflevector(__builtin_bit_cast(i32x4, x), __builtin_bit_cast(i32x4, y), 0, 1, 2, 3, 4, 5, 6, 7)
#define PG8_LDA8(dst, b, h) do { _Pragma("unroll") for (int m = 0; m < 4; ++m) dst[m] = PG8_CAT(*(const LAS bf16x8*)(lds + PG8_SA(b, h) + aoff + m * 2048), *(const LAS bf16x8*)(lds + PG8_SA(b, h) + aoff + m * 2048 + 1024)); } while (0)
#define PG8_LDB8(dst, b, h) do { _Pragma("unroll") for (int n = 0; n < 2; ++n) dst[n] = PG8_CAT(*(const LAS bf16x8*)(lds + PG8_SB(b, h) + boff + n * 2048), *(const LAS bf16x8*)(lds + PG8_SB(b, h) + boff + n * 2048 + 1024)); } while (0)
#define PG8_MMA8(ai, bj, A8, B8) do { __builtin_amdgcn_s_setprio(1); _Pragma("unroll") for (int m = 0; m < 4; ++m) _Pragma("unroll") for (int n = 0; n < 2; ++n) \
        acc[ai][bj][m][n] = MFMA16_F8X128(B8[n], A8[m], acc[ai][bj][m][n]); __builtin_amdgcn_s_setprio(0); } while (0)
#define PG8_WAIT_V(n) asm volatile("s_waitcnt vmcnt(" #n ")" ::: "memory")
#define PG8_WAIT_L(n) asm volatile("s_waitcnt lgkmcnt(" #n ")" ::: "memory")
#define PG8_BAR __builtin_amdgcn_s_barrier()
#define PG8_SCHED __builtin_amdgcn_sched_barrier(0)
    Unit cur, nxt; int ui = 0;
    if (!S.next(0, cur)) return;
    f32x4 acc[2][2][4][2];
#pragma unroll
    for (int a = 0; a < 2; ++a)
#pragma unroll
        for (int b = 0; b < 2; ++b)
#pragma unroll
            for (int m = 0; m < 4; ++m)
#pragma unroll
                for (int n = 0; n < 2; ++n) acc[a][b][m][n] = (f32x4){0.f, 0.f, 0.f, 0.f};
    bf16x8 At[4][2], B0[2][2], B1[2][2];
    const char* cA = cur.a; const char* cB = cur.b; int cf8 = MODE == 2 ? cur.f8 : MODE; size_t chA = cf8 ? hstepA8 : hstepA;
    { unsigned v0[2] = {cf8 ? voffA8[0] : voffA[0], cf8 ? voffA8[1] : voffA[1]};
    PG8_STAGE(PG8_SB(0, 0), cB, voffB); PG8_STAGE(PG8_SB(0, 1), cB + hstepB, voffB); PG8_STAGE(PG8_SA(0, 0), cA, v0); PG8_STAGE(PG8_SA(0, 1), cA + chA, v0);
    if (wr == 1) PG8_BAR;
    PG8_WAIT_V(2); PG8_BAR;
    PG8_STAGE(PG8_SB(1, 0), cB + kstep, voffB); PG8_STAGE(PG8_SA(1, 0), cA + kstep, v0); PG8_STAGE(PG8_SB(1, 1), cB + hstepB + kstep, voffB);
    PG8_WAIT_V(6); PG8_BAR; }
    for (;;) {
        const bool has_next = S.next(ui + 1, nxt);
        const char* nA = has_next ? nxt.a : cA; const char* nB = has_next ? nxt.b : cB; const int nf8 = MODE == 2 ? (has_next ? nxt.f8 : cf8) : MODE;
        int nt = cur.nt; asm volatile("" : "+s"(nt));
#define PG8_KLOOP(LDA_, LDB_, MM_, At_, B0_, B1_, CF8) \
        for (int t = 0; t < nt; t += 2) { \
            const bool last = (t == nt - 2); \
            const char* a1 = cA + (size_t)(t + 1) * kstep; \
            const char* a2 = last ? nA : cA + (size_t)(t + 2) * kstep; const char* b2 = last ? nB : cB + (size_t)(t + 2) * kstep; \
            const char* a3 = a2 + kstep; const char* b3 = b2 + kstep; \
            const int f2 = last ? nf8 : CF8; const size_t h2 = f2 ? hstepA8 : hstepA; \
            OPAQUE_S(a1); OPAQUE_S(a2); OPAQUE_S(a3); OPAQUE_S(b2); OPAQUE_S(b3); \
            const unsigned vA[2] = {CF8 ? voffA8[0] : voffA[0], CF8 ? voffA8[1] : voffA[1]}, vA2[2] = {f2 ? voffA8[0] : voffA[0], f2 ? voffA8[1] : voffA[1]}, vB[2] = {voffB[0], voffB[1]}; \
            LDB_(B0_, 0, 0); LDB_(B1_, 0, 1); PG8_SCHED; LDA_(At_, 0, 0); PG8_STAGE(PG8_SA(1, 1), a1 + (CF8 ? hstepA8 : hstepA), vA); \
            PG8_WAIT_V(8); PG8_WAIT_L(0); PG8_BAR; MM_(0, 0, At_, B0_); MM_(0, 1, At_, B1_); PG8_BAR; PG8_SCHED; \
            LDA_(At_, 0, 1); PG8_STAGE(PG8_SB(0, 0), b2, vB); PG8_STAGE(PG8_SB(0, 1), b2 + hstepB, vB); PG8_STAGE(PG8_SA(0, 0), a2, vA2); \
            PG8_WAIT_V(8); PG8_WAIT_L(0); PG8_BAR; MM_(1, 0, At_, B0_); MM_(1, 1, At_, B1_); PG8_BAR; PG8_SCHED; \
            LDB_(B0_, 1, 0); LDB_(B1_, 1, 1); PG8_SCHED; LDA_(At_, 1, 0); PG8_STAGE(PG8_SA(0, 1), a2 + h2, vA2); \
            PG8_WAIT_V(8); PG8_WAIT_L(0); PG8_BAR; MM_(0, 0, At_, B0_); MM_(0, 1, At_, B1_); PG8_BAR; PG8_SCHED; \
            LDA_(At_, 1, 1); PG8_STAGE(PG8_SB(1, 0), b3, vB); PG8_STAGE(PG8_SB(1, 1), b3 + hstepB, vB); PG8_STAGE(PG8_SA(1, 0), a3, vA2); \
            PG8_WAIT_V(8); PG8_WAIT_L(0); PG8_BAR; MM_(1, 0, At_, B0_); MM_(1, 1, At_, B1_); PG8_BAR; PG8_SCHED; \
        }
        if (MODE == 1 || (MODE == 2 && cf8)) { i32x8 A8[4], B08[2], B18[2]; PG8_KLOOP(PG8_LDA8, PG8_LDB8, PG8_MMA8, A8, B08, B18, 1) }
        else { PG8_KLOOP(PG8_LDA, PG8_LDB, PG8_MMA, At, B0, B1, 0) }
#undef PG8_KLOOP
        if (wr == 0) PG8_BAR;
        E(acc, cur, wr, wc, fr, fq, tid);
        if (!has_next) break;
#pragma unroll
        for (int a = 0; a < 2; ++a)
#pragma unroll
            for (int b = 0; b < 2; ++b)
#pragma unroll
                for (int m = 0; m < 4; ++m)
#pragma unroll
                    for (int n = 0; n < 2; ++n) acc[a][b][m][n] = (f32x4){0.f, 0.f, 0.f, 0.f};
        cur = nxt; cA = nA; cB = nB; cf8 = nf8; ++ui;
        if (wr == 1) PG8_BAR;
    }
    PG8_WAIT_V(0);
    PG8_BAR;
#undef PG8_SA
#undef PG8_SB
#undef PG8_STAGE
#undef PG8_LDA
#undef PG8_LDB
#undef PG8_MMA
#undef PG8_MMA8
#undef PG8_LDA8
#undef PG8_LDB8
#undef PG8_CAT
#undef PG8_WAIT_V
#undef PG8_WAIT_L
#undef PG8_BAR
#undef PG8_SCHED
}
#else
template <int MODE = 0, class Epi, class Sched>
inline void gemm_phase(unsigned char* lds, const int lda, const int ldb, const Sched& S, const Epi& E, const int lda8 = 0) {
    const int tid = TIDX(), wid = tid >> 6, lane = tid & 63, wr = wid >> 2, wc = wid & 3, fr = lane & 15, fq = lane >> 4;
    Unit cur;
    for (int ui = 0; S.next(ui, cur); ++ui) {
        f32x4 acc[2][2][4][2];
        const bf16_t* A = (const bf16_t*)cur.a; const bf16_t* Bt = (const bf16_t*)cur.b; const int K = cur.nt * 64;
        for (int ai = 0; ai < 2; ++ai) for (int bj = 0; bj < 2; ++bj) for (int m = 0; m < 4; ++m) for (int n = 0; n < 2; ++n) for (int e = 0; e < 4; ++e) {
            const int r = 128 * ai + 64 * wr + 16 * m + fr, c = 128 * bj + 32 * wc + 8 * fq + 4 * n + e; float s = 0.f;
            const bf16_t* ar = A + (size_t)r * lda; const bf16_t* br = Bt + (size_t)c * ldb;
            if (cur.f8) { const unsigned char* a8 = (const unsigned char*)cur.a + (size_t)r * lda8; const unsigned char* b8 = (const unsigned char*)cur.b + (size_t)c * ldb * 2;
                for (int k = 0; k < cur.nt * 128; ++k) s += fp8_dec_(a8[k]) * fp8_dec_(b8[k]); }
#ifdef EMU_FP8_A
            else if (cur.aux == 77) { float am = 0.f; for (int k = 0; k < K; ++k) am = fmaxf(am, fabsf(bf2f(br[k]))); const float sc = am > 0.f ? am / 440.f : 1.f;
                for (int k = 0; k < K; ++k) s += fp8_dec_(fp8_enc_(bf2f(ar[k]))) * fp8_dec_(fp8_enc_(bf2f(br[k]) / sc)); s *= sc; }
#endif
            else for (int k = 0; k < K; ++k) s += bf2f(ar[k]) * bf2f(br[k]);
            acc[ai][bj][m][n][e] = s; }
        __syncthreads();
        E(acc, cur, wr, wc, fr, fq, tid);
        __syncthreads();
    }
    __syncthreads();
}
#endif
}
struct Ptrs {
    bf16_t *WinT, *WbrT, *WoutT, *WqT, *PleT, *PleGT, *GluT, *K12, *S5Kc, *S5Wx, *S5Wy, *Ut, *Vt, *hb, *proj, *merged, *q, *ycat, *vtr, *pb;
    float *S5LL, *gate; int* eid; unsigned char* stash; bf16_t *rwPT, *rwG, *rwS0, *rwQ, *rwGt, *rwRKV; unsigned char *U8, *V8; float *su, *sv, *pd; unsigned* qcnt; unsigned char *h8a, *h8b, *h8e; float *gsc, *gscA;
};
__device__ __forceinline__ Ptrs make_ptrs(unsigned char* ws, int l) {
    Ptrs P; { size_t zoff = 0; OPAQUE_S(zoff); ws += zoff; }
    P.WinT = (bf16_t*)(ws + WS_WIN) + (size_t)l * WIN_ROWS * 1024; P.WbrT = (bf16_t*)(ws + WS_WBR) + (size_t)l * 1024 * 1024; P.WoutT = (bf16_t*)(ws + WS_WOUT) + (size_t)l * 1024 * 1024;
    P.WqT = (bf16_t*)(ws + WS_WQ) + (size_t)l * 2048 * 1024; P.PleT = (bf16_t*)(ws + WS_PLE) + (size_t)l * 1024 * 256; P.PleGT = (bf16_t*)(ws + WS_PLEG) + (size_t)l * 1024 * 1024;
    P.GluT = (bf16_t*)(ws + WS_GLU) + (size_t)l * 256 * 256; P.K12 = (bf16_t*)(ws + WS_K12) + (size_t)l * 2 * 128 * 128;
    P.S5Kc = (bf16_t*)(ws + WS_S5KC) + (size_t)l * 16 * 64 * 256; P.S5Wx = (bf16_t*)(ws + WS_S5WX) + (size_t)l * 16 * 128 * 1024; P.S5Wy = (bf16_t*)(ws + WS_S5WY) + (size_t)l * 16 * 1024 * 128;
    P.S5LL = (float*)(ws + WS_S5LL) + (size_t)l * 16 * 64 * 2;
    P.Ut = (bf16_t*)(ws + WS_UT); P.Vt = (bf16_t*)(ws + WS_VT);
    P.pd = (float*)(ws + WS_R1 + R1_Q); P.qcnt = (unsigned*)(ws + WS_CTL) + 8192 + l * 4 * 8 * 16;
    P.U8 = ws + WS_UT; P.V8 = ws + WS_UT + (size_t)NEXP * 1024; P.su = (float*)(ws + WS_CTL + 131072); P.sv = (float*)(ws + WS_CTL + 131072) + NEXP;
    P.rwGt = (bf16_t*)(ws + WS_VT); P.rwRKV = (bf16_t*)(ws + WS_VT + RW_SZ);
    P.rwPT = (bf16_t*)(ws + WS_RW); P.rwG = (bf16_t*)(ws + WS_RW + RW_SZ); P.rwS0 = (bf16_t*)(ws + WS_RW + 2 * RW_SZ); P.rwQ = (bf16_t*)(ws + WS_RW + 3 * RW_SZ);
    P.hb = (bf16_t*)(ws + WS_HB); P.proj = (bf16_t*)(ws + WS_R1 + R1_PROJ); P.merged = (bf16_t*)(ws + WS_R1 + R1_MERGED); P.q = (bf16_t*)(ws + WS_R1 + R1_Q);
    P.stash = ws + WS_R1 + R1_STASH; P.eid = (int*)(ws + WS_R1 + R1_EID); P.gate = (float*)(ws + WS_R1 + R1_GATE);
    P.ycat = (bf16_t*)(ws + WS_YC); P.vtr = (bf16_t*)(ws + WS_VTR); P.pb = (bf16_t*)(ws + WS_PB);
    P.h8a = ws + WS_R1 + R1_H8; P.h8b = ws + WS_H8T; P.h8e = ws + WS_RW; P.gsc = (float*)(ws + WS_CTL + 262144) + l * 6144; P.gscA = (float*)(ws + WS_CTL + 327680) + l * 2560;
    return P;
}

__device__ __forceinline__ int win_src_col(int n) {
    if (n < 1152) return n;
    if (n < 1664) return n;
    if (n < 1668) return 1920 + (n - 1664);
    if (n < 1792) return -1;
    if (n < 2304) return 1924 + (n - 1792);
    if (n < 2560) return 1664 + (n - 2304);
    return 2436 + (n - 2560);
}
template <bool WINMAP>
__device__ __forceinline__ void transpose_item(const float* src, int sld, bf16_t* dst, int dld, int dcol0, int kb, int nb, float* scr, int lane) {
    const int k0 = 64 * kb, n0 = 32 * nb;
    const int nn = n0 + (lane & 31); const int sc = WINMAP ? win_src_col(nn) : nn;
#pragma unroll 8
    for (int i = 0; i < 32; ++i) { const int kk = 2 * i + (lane >> 5); scr[kk * 33 + (lane & 31)] = (sc >= 0) ? src[(size_t)(k0 + kk) * sld + sc] : 0.f; }
    WAVE_SYNC();
    const int c = lane & 7;
#pragma unroll
    for (int j = 0; j < 4; ++j) { const int n = (lane >> 3) + 8 * j; const float* s = scr + (8 * c) * 33 + n;
        u32x4 o; o.x = pk2(s[0 * 33], s[1 * 33]); o.y = pk2(s[2 * 33], s[3 * 33]); o.z = pk2(s[4 * 33], s[5 * 33]); o.w = pk2(s[6 * 33], s[7 * 33]);
        *(u32x4*)(dst + (size_t)(n0 + n) * dld + dcol0 + k0 + 8 * c) = o; }
    WAVE_SYNC();
}

__device__ __forceinline__ void s5_tables(const KP& p, int l, int g, unsigned char* lds) {
    float* pw = (float*)lds;
    float* bb = pw + 65 * 128;
    float* cc = bb + 64 * 32;
    const int tid = TIDX();
    const Ptrs P = make_ptrs(p.ws, l);
    const float dt = expf(p.in[I_LDT][l * 16 + g]);
    if (tid < 64) { const int pp = tid; const float lr = p.in[I_LRE][(l * 16 + g) * 64 + pp], li = p.in[I_LIM][(l * 16 + g) * 64 + pp];
        const float mag = expf(lr * dt), ang = li * dt; const float br = mag * cosf(ang), bi = mag * sinf(ang);
        float xr = 1.f, xi = 0.f;
        for (int t = 0; t <= 64; ++t) { pw[(t * 64 + pp) * 2] = xr; pw[(t * 64 + pp) * 2 + 1] = xi; const float nr = xr * br - xi * bi, ni = xr * bi + xi * br; xr = nr; xi = ni; }
        const float nr = br - 1.f, ni = bi, den = lr * lr + li * li; const float cr = (nr * lr + ni * li) / den, ci = (ni * lr - nr * li) / den;
        for (int c = 0; c < 16; ++c) { const float b_r = p.in[I_BRE][((l * 16 + g) * 64 + pp) * 16 + c], b_i = p.in[I_BIM][((l * 16 + g) * 64 + pp) * 16 + c];
            bb[(pp * 16 + c) * 2] = cr * b_r - ci * b_i; bb[(pp * 16 + c) * 2 + 1] = cr * b_i + ci * b_r; }
        P.S5LL[(g * 64 + pp) * 2] = pw[(64 * 64 + pp) * 2]; P.S5LL[(g * 64 + pp) * 2 + 1] = pw[(64 * 64 + pp) * 2 + 1];
    }
    for (int e = tid; e < 1024; e += NTHR) { const int c = e >> 6, pp = e & 63; cc[e * 2] = p.in[I_CRE][((l * 16 + g) * 16 + c) * 64 + pp]; cc[e * 2 + 1] = p.in[I_CIM][((l * 16 + g) * 16 + c) * 64 + pp]; }
    __syncthreads();
    bf16_t* Kc = P.S5Kc + (size_t)g * 64 * 256;
    { const int pair = tid & 255, co = pair >> 4, ci = pair & 15, th = tid >> 8; float acc[32];
#pragma unroll
      for (int j = 0; j < 32; ++j) acc[j] = 0.f;
      for (int pp = 0; pp < 64; ++pp) { const float c_r = cc[(co * 64 + pp) * 2], c_i = cc[(co * 64 + pp) * 2 + 1], b_r = bb[(pp * 16 + ci) * 2], b_i = bb[(pp * 16 + ci) * 2 + 1];
          const float d_r = c_r * b_r - c_i * b_i, d_i = c_r * b_i + c_i * b_r;
#pragma unroll
          for (int j = 0; j < 32; ++j) { const f32x2 w = *(const f32x2*)(pw + ((th * 32 + j) * 64 + pp) * 2); acc[j] += d_r * w.x - d_i * w.y; } }
#pragma unroll
      for (int j = 0; j < 32; ++j) Kc[(th * 32 + j) * 256 + pair] = (bf16_t)f2bf(acc[j]); }
    bf16_t* Wx = P.S5Wx + (size_t)g * 128 * 1024;
    for (int e = tid; e < 128 * 1024; e += NTHR) { const int n = e >> 10, k = e & 1023, pp = n >> 1, ri = n & 1, s = k >> 4, ci = k & 15;
        const float w_r = pw[((63 - s) * 64 + pp) * 2], w_i = pw[((63 - s) * 64 + pp) * 2 + 1], b_r = bb[(pp * 16 + ci) * 2], b_i = bb[(pp * 16 + ci) * 2 + 1];
        Wx[e] = (bf16_t)f2bf(ri ? (w_r * b_i + w_i * b_r) : (w_r * b_r - w_i * b_i)); }
    bf16_t* Wy = P.S5Wy + (size_t)g * 1024 * 128;
    for (int e = tid; e < 1024 * 128; e += NTHR) { const int n = e >> 7, k = e & 127, t = n >> 4, co = n & 15, pp = k >> 1, ri = k & 1;
        const float c_r = cc[(co * 64 + pp) * 2], c_i = cc[(co * 64 + pp) * 2 + 1], w_r = pw[((t + 1) * 64 + pp) * 2], w_i = pw[((t + 1) * 64 + pp) * 2 + 1];
        Wy[e] = (bf16_t)f2bf(ri ? -(c_r * w_i + c_i * w_r) : (c_r * w_r - c_i * w_i)); }
    __syncthreads();
}

__device__ __forceinline__ void ln_row(const float* src, const float* g, const float* b, float* dst, bf16_t* dstb, int lane) {
    f32x4 v[4]; float s = 0.f;
#pragma unroll
    for (int j = 0; j < 4; ++j) { v[j] = *(const f32x4*)(src + 256 * j + 4 * lane); s += (v[j].x + v[j].y) + (v[j].z + v[j].w); }
    const float mean = wave_sum(s) * (1.f / 1024.f); float s2 = 0.f;
#pragma unroll
    for (int j = 0; j < 4; ++j) { v[j] = v[j] - mean; s2 += (v[j].x * v[j].x + v[j].y * v[j].y) + (v[j].z * v[j].z + v[j].w * v[j].w); }
    const float rstd = 1.f / sqrtf(wave_sum(s2) * (1.f / 1024.f) + LN_EPS_);
#pragma unroll
    for (int j = 0; j < 4; ++j) { const f32x4 gg = *(const f32x4*)(g + 256 * j + 4 * lane), bv = *(const f32x4*)(b + 256 * j + 4 * lane);
        const f32x4 o = v[j] * rstd * gg + bv; *(f32x4*)(dst + 256 * j + 4 * lane) = o;
        if (dstb) { u32x2 w; w.x = pk2(o.x, o.y); w.y = pk2(o.z, o.w); *(u32x2*)(dstb + 256 * j + 4 * lane) = w; } }
}

template <int NR, bool SB = false>
__device__ __forceinline__ void ln_rows(const void* srcv, const float* g, const float* b, float* dst, bf16_t* dstb, unsigned char* d8, int lane) {
    f32x4 v[NR][4]; float s[NR], s2[NR];
#pragma unroll
    for (int r = 0; r < NR; ++r) { s[r] = 0.f;
#pragma unroll
        for (int j = 0; j < 4; ++j) {
            if (SB) { const u32x2 w = *(const u32x2*)((const bf16_t*)srcv + (size_t)r * 1024 + 256 * j + 4 * lane); v[r][j] = (f32x4){bflo(w.x), bfhi(w.x), bflo(w.y), bfhi(w.y)}; }
            else v[r][j] = *(const f32x4*)((const float*)srcv + (size_t)r * 1024 + 256 * j + 4 * lane);
            s[r] += (v[r][j].x + v[r][j].y) + (v[r][j].z + v[r][j].w); } }
    wave_sum_n<NR>(s);
#pragma unroll
    for (int r = 0; r < NR; ++r) { const float mean = s[r] * (1.f / 1024.f); s2[r] = 0.f;
#pragma unroll
        for (int j = 0; j < 4; ++j) { v[r][j] = v[r][j] - mean; s2[r] += (v[r][j].x * v[r][j].x + v[r][j].y * v[r][j].y) + (v[r][j].z * v[r][j].z + v[r][j].w * v[r][j].w); } }
    wave_sum_n<NR>(s2);
#pragma unroll
    for (int j = 0; j < 4; ++j) { const f32x4 gg = *(const f32x4*)(g + 256 * j + 4 * lane), bv = *(const f32x4*)(b + 256 * j + 4 * lane);
#pragma unroll
        for (int r = 0; r < NR; ++r) { const float rstd = 1.f / sqrtf(s2[r] * (1.f / 1024.f) + LN_EPS_);
            const f32x4 o = v[r][j] * rstd * gg + bv; if (dst) *(f32x4*)(dst + (size_t)r * 1024 + 256 * j + 4 * lane) = o;
            if (dstb) { u32x2 w; w.x = pk2(o.x, o.y); w.y = pk2(o.z, o.w); *(u32x2*)(dstb + (size_t)r * 1024 + 256 * j + 4 * lane) = w; }
            if (d8) { unsigned w8 = cvt_pk_fp8_f32_(o.x, o.y, 0u, false); w8 = cvt_pk_fp8_f32_(o.z, o.w, w8, true); *(unsigned*)(d8 + (size_t)r * 1024 + 256 * j + 4 * lane) = w8; } } }
}
__device__ __forceinline__ void phase_prologue(const KP& p, unsigned char* lds) {
    const int tid = TIDX(), lane = tid & 63, wave = tid >> 6;
    int G = GDIM(), bid = BIDX();
    for (int it = bid; it < L_ * 16; it += G) s5_tables(p, it >> 4, it & 15, lds);
    if (G >= 4 * L_ * 16) { if (bid < L_ * 16) return; bid -= L_ * 16; G -= L_ * 16; }
    float* scr = (float*)lds + wave * (64 * 33 + 16);
    const int gw = bid * NWAVE + wave, NGW = G * NWAVE;
    constexpr int I_WINT = (WIN_ROWS / 32) * 16, I_BR = 4 * 4 * 32, I_OUT = 16 * 32, I_Q = 16 * 64, I_PL = 4 * 32, I_PG = 16 * 32, I_GL = 4 * 8;
    constexpr int PER_L = I_WINT + I_BR + I_OUT + I_Q + I_PL + I_PG + I_GL;
    for (int it = gw; it < L_ * PER_L; it += NGW) {
        const int l = it / PER_L; int r = it % PER_L; const Ptrs P = make_ptrs(p.ws, l);
        if (r < I_WINT) { transpose_item<true>(p.in[I_WIN] + (size_t)l * 1024 * IN_COLS, IN_COLS, P.WinT, 1024, 0, r & 15, r >> 4, scr, lane); continue; } r -= I_WINT;
        if (r < I_BR) { const int b = r >> 7, rr = r & 127; transpose_item<false>(p.in[I_WBR] + ((size_t)l * 4 + b) * 256 * 1024, 1024, P.WbrT, 1024, 256 * b, rr & 3, rr >> 2, scr, lane); continue; } r -= I_BR;
        if (r < I_OUT) { transpose_item<false>(p.in[I_WOUT] + (size_t)l * 1024 * 1024, 1024, P.WoutT, 1024, 0, r & 15, r >> 4, scr, lane); continue; } r -= I_OUT;
        if (r < I_Q) { transpose_item<false>(p.in[I_WQ] + (size_t)l * 1024 * 2048, 2048, P.WqT, 1024, 0, r & 15, r >> 4, scr, lane); continue; } r -= I_Q;
        if (r < I_PL) { transpose_item<false>(p.in[I_PLEW] + (size_t)l * 256 * 1024, 1024, P.PleT, 256, 0, r & 3, r >> 2, scr, lane); continue; } r -= I_PL;
        if (r < I_PG) { transpose_item<false>(p.in[I_PLEG] + (size_t)l * 1024 * 1024, 1024, P.PleGT, 1024, 0, r & 15, r >> 4, scr, lane); continue; } r -= I_PG;
        transpose_item<false>(p.in[I_GLUW] + (size_t)l * 256 * 256, 256, P.GluT, 256, 0, r & 3, r >> 2, scr, lane);
    }
    const size_t gt = (size_t)bid * NTHR + tid, NGT = (size_t)G * NTHR;
    { bf16_t* K12 = (bf16_t*)(p.ws + WS_K12);
      for (size_t i = gt; i < (size_t)L_ * 2 * 16384 / 8; i += NGT) { const size_t e = i * 8; const int l = (int)(e / 32768), r = (int)(e % 32768); const float* s = (r < 16384 ? p.in[I_K1] : p.in[I_K2]) + (size_t)l * 16384 + (r & 16383);
        const f32x4 a = *(const f32x4*)s, b = *(const f32x4*)(s + 4); u32x4 o; o.x = pk2(a.x, a.y); o.y = pk2(a.z, a.w); o.z = pk2(b.x, b.y); o.w = pk2(b.z, b.w); *(u32x4*)(K12 + e) = o; } }
    { bf16_t* hb = (bf16_t*)(p.ws + WS_HB);
      unsigned char* h8a = p.ws + WS_R1 + R1_H8; unsigned char* h8b = p.ws + WS_H8T;
      for (int m = 4 * gw; m < T_; m += 4 * NGW) ln_rows<4>(p.in[I_X] + (size_t)m * 1024, p.in[I_LNIN_G], p.in[I_LNIN_B], (float*)nullptr, hb + (size_t)m * 1024, m < H8_SPLIT ? h8a + (size_t)m * 1024 : h8b + (size_t)(m - H8_SPLIT) * 1024, lane); }
}
__device__ __forceinline__ void conv_unit(const KP& p, const Ptrs& P, int l, int unit, unsigned char* lds) {
    bf16_t* hbuf = (bf16_t*)lds;
    float* obuf = (float*)(lds + 94 * 256 * 2);
    const int tid = TIDX(), lane = tid & 63, wave = tid >> 6;
    const int tiles_per_seq = S_ / 64, b = unit / tiles_per_seq, t0 = (unit % tiles_per_seq) * 64;
    for (int e = tid; e < 94 * 32; e += NTHR) { const int r = e >> 5, c8 = (e & 31) * 8; const int t = t0 - 30 + r;
        u32x4 o = (u32x4){0u, 0u, 0u, 0u};
        if (t >= 0) { const bf16_t* row = P.proj + (size_t)(b * S_ + t) * PJ; const u32x4 v = *(const u32x4*)(row + C_CV + c8), g = *(const u32x4*)(row + C_CG + c8);
            o.x = pk2(bflo(v.x) * sigmoidf_(bflo(g.x)), bfhi(v.x) * sigmoidf_(bfhi(g.x))); o.y = pk2(bflo(v.y) * sigmoidf_(bflo(g.y)), bfhi(v.y) * sigmoidf_(bfhi(g.y)));
            o.z = pk2(bflo(v.z) * sigmoidf_(bflo(g.z)), bfhi(v.z) * sigmoidf_(bfhi(g.z))); o.w = pk2(bflo(v.w) * sigmoidf_(bflo(g.w)), bfhi(v.w) * sigmoidf_(bfhi(g.w))); }
        *(u32x4*)(hbuf + r * 256 + c8) = o; }
    __syncthreads();
    { const int c = tid & 255, half = tid >> 8; float w[31], x[62];
#pragma unroll
      for (int j = 0; j < 31; ++j) w[j] = p.in[I_CONVW][(l * 31 + j) * 256 + c];
      const float cb = p.in[I_CONVB][l * 256 + c];
#pragma unroll
      for (int j = 0; j < 62; ++j) x[j] = bf2f(hbuf[(half * 32 + j) * 256 + c]);
#pragma unroll
      for (int tt = 0; tt < 32; ++tt) { float s = cb;
#pragma unroll
          for (int j = 0; j < 31; ++j) s += w[j] * x[tt + j];
          obuf[(half * 32 + tt) * 256 + c] = s; } }
    __syncthreads();
    { const f32x4 g = *(const f32x4*)(p.in[I_CLNG] + l * 256 + 4 * lane), bb = *(const f32x4*)(p.in[I_CLNB] + l * 256 + 4 * lane);
      f32x4 vv[8]; float m1[8], m2[8];
#pragma unroll
      for (int i = 0; i < 8; ++i) { vv[i] = *(const f32x4*)(obuf + (wave * 8 + i) * 256 + 4 * lane); m1[i] = (vv[i].x + vv[i].y) + (vv[i].z + vv[i].w); }
      wave_sum_n<8>(m1);
#pragma unroll
      for (int i = 0; i < 8; ++i) { vv[i] = vv[i] - m1[i] * (1.f / 256.f); m2[i] = (vv[i].x * vv[i].x + vv[i].y * vv[i].y) + (vv[i].z * vv[i].z + vv[i].w * vv[i].w); }
      wave_sum_n<8>(m2);
#pragma unroll
      for (int i = 0; i < 8; ++i) { const int t = wave * 8 + i; const float rstd = 1.f / sqrtf(m2[i] * (1.f / 256.f) + LN_EPS_);
          f32x4 z = vv[i] * rstd * g + bb; u32x2 w; w.x = pk2(z.x * sigmoidf_(z.x), z.y * sigmoidf_(z.y)); w.y = pk2(z.z * sigmoidf_(z.z), z.w * sigmoidf_(z.w));
          *(u32x2*)(P.ycat + (size_t)(b * S_ + t0 + t) * 1024 + 768 + 4 * lane) = w; } }
    __syncthreads();
}

constexpr int S5_NCH = S_ / 64;
constexpr int S5_UPITCH = 1032;
constexpr int S5_XPITCH = 136;
__device__ __forceinline__ void s5_unit(const KP& p, const Ptrs& P, int l, int unit, unsigned char* lds) {
    const int b = unit >> 4, g = unit & 15;
    bf16_t* Uc = (bf16_t*)lds;
    bf16_t* Kc = (bf16_t*)(lds + 66048);
    float* Xe = (float*)(lds + 66048 + 32768);
    bf16_t* Xs = (bf16_t*)(lds + 66048 + 65536);
    const int tid = TIDX(), lane = tid & 63, wave = tid >> 6, r32 = lane & 31, hi = lane >> 5;
    { u32x4 v[8], kc[4];
#pragma unroll
      for (int j = 0; j < 8; ++j) { const int e = tid + j * NTHR, s = e >> 1, hf = e & 1; v[j] = (u32x4){0u, 0u, 0u, 0u};
          if (s < S_) v[j] = *(const u32x4*)(P.proj + (size_t)(b * S_ + s) * PJ + C_S5 + 16 * g + 8 * hf); }
#pragma unroll
      for (int j = 0; j < 4; ++j) kc[j] = *(const u32x4*)(P.S5Kc + (size_t)g * 16384 + (tid + j * NTHR) * 8);
#pragma unroll
      for (int j = 0; j < 8; ++j) { const int e = tid + j * NTHR, s = e >> 1, hf = e & 1; *(u32x4*)(Uc + (s >> 6) * S5_UPITCH + (s & 63) * 16 + 8 * hf) = v[j]; }
#pragma unroll
      for (int j = 0; j < 4; ++j) *(u32x4*)(Kc + (tid + j * NTHR) * 8) = kc[j]; }
    __syncthreads();
    { const int ntile = wave & 3, kh = wave >> 2; f32x16 acc = {};
      const bf16_t* wrow = P.S5Wx + ((size_t)g * 128 + ntile * 32 + r32) * 1024 + kh * 512 + 8 * hi;
      const bf16_t* urow = Uc + r32 * S5_UPITCH + kh * 512 + 8 * hi;
      for (int k8 = 0; k8 < 32; k8 += 8) { bf16x8 bw[8];
#pragma unroll
          for (int j = 0; j < 8; ++j) bw[j] = *(const bf16x8*)(wrow + (k8 + j) * 16);
#pragma unroll
          for (int j = 0; j < 8; ++j) { const bf16x8 a = *(const bf16x8*)(urow + (k8 + j) * 16); acc = MFMA32(a, bw[j], acc); } }
#pragma unroll
      for (int r = 0; r < 16; ++r) { const int c = (r & 3) + 8 * (r >> 2) + 4 * hi; Xe[(kh * 32 + c) * 128 + ntile * 32 + r32] = acc[r]; } }
    __syncthreads();
    if (tid < 64) { const float lr = P.S5LL[(g * 64 + tid) * 2], li = P.S5LL[(g * 64 + tid) * 2 + 1]; float xr = 0.f, xi = 0.f;
        for (int c = 0; c < 32; ++c) { Xs[c * S5_XPITCH + 2 * tid] = (bf16_t)f2bf(xr); Xs[c * S5_XPITCH + 2 * tid + 1] = (bf16_t)f2bf(xi);
            const float er = Xe[c * 128 + 2 * tid] + Xe[(32 + c) * 128 + 2 * tid], ei = Xe[c * 128 + 2 * tid + 1] + Xe[(32 + c) * 128 + 2 * tid + 1];
            const float nr = lr * xr - li * xi + er, ni = lr * xi + li * xr + ei; xr = nr; xi = ni; } }
    __syncthreads();
    { const int tt = r32 >> 4, co = r32 & 15; const float dsk = p.in[I_S5D][l * 256 + 16 * g + co];
      for (int q = 0; q < 4; ++q) { const int ntile = wave + 8 * q, t0 = 2 * ntile; f32x16 acc = {};
          const bf16_t* urow = Uc + r32 * S5_UPITCH + 8 * hi;
          for (int s = 0; s <= t0 + 1; ++s) { const int tau = t0 + tt - s; bf16x8 bk = (bf16x8){0, 0, 0, 0, 0, 0, 0, 0};
              if (tau >= 0) bk = *(const bf16x8*)(Kc + (tau * 16 + co) * 16 + 8 * hi);
              const bf16x8 a = *(const bf16x8*)(urow + s * 16); acc = MFMA32(a, bk, acc); }
          const bf16_t* wy = P.S5Wy + ((size_t)g * 1024 + ntile * 32 + r32) * 128 + 8 * hi; const bf16_t* xrow = Xs + r32 * S5_XPITCH + 8 * hi;
#pragma unroll
          for (int ks = 0; ks < 8; ++ks) { const bf16x8 a = *(const bf16x8*)(xrow + ks * 16); const bf16x8 bw = *(const bf16x8*)(wy + ks * 16); acc = MFMA32(a, bw, acc); }
#pragma unroll
          for (int r = 0; r < 16; ++r) { const int c = (r & 3) + 8 * (r >> 2) + 4 * hi; const int s = c * 64 + t0 + tt;
              if (s < S_) { const float uu = bf2f(Uc[c * S5_UPITCH + (t0 + tt) * 16 + co]); const float y = acc[r] + dsk * uu;
                  P.ycat[(size_t)(b * S_ + s) * 1024 + 256 + 16 * g + co] = (bf16_t)f2bf(gelu_erf(y)); } } } }
    __syncthreads();
}
constexpr float LOG2E_ = 1.4426950408889634f;
__device__ __forceinline__ float log_sigmoid_(float x) { return fminf(x, 0.f) - log1pf(__expf(-fabsf(x))); }
__device__ __forceinline__ void fox_unit(const KP& p, const Ptrs& P, int l, int unit, unsigned char* lds) {
    constexpr int NQB = S_ / 256;
    const int bh = unit / NQB, qb = (unit >= (NB_ * 4 * NQB) / 2) ? NQB - 1 - unit % NQB : unit % NQB, b = bh >> 2, h = bh & 3, q0 = qb * 256;
    float* cl = (float*)lds;
    unsigned char* Kt = lds + S_ * 4;
    unsigned char* Vt = Kt + 8192;
    float* wsf = (float*)(Kt + 32768);
    float* sc = wsf + 256;
    const int tid = TIDX(), lane = tid & 63, wave = tid >> 6, r32 = lane & 31, hi = lane >> 5;
    const int qend = q0 + 256;
    { constexpr int PER = (S_ + 511) / 512; const float bf = p.in[I_BF][l * 4 + h]; float loc[PER]; float s = 0.f;
#pragma unroll
      for (int i = 0; i < PER; ++i) { const int t = tid * PER + i; float v = 0.f;
          if (t < qend) v = log_sigmoid_(bf2f(P.proj[(size_t)(b * S_ + t) * PJ + C_FL + h]) + bf) * LOG2E_;
          s += v; loc[i] = s; }
      sc[tid] = s; __syncthreads();
      for (int off = 1; off < 512; off <<= 1) { const float v = sc[tid] + (tid >= off ? sc[tid - off] : 0.f); __syncthreads(); sc[tid] = v; __syncthreads(); }
      const float base = sc[tid] - s;
#pragma unroll
      for (int i = 0; i < PER; ++i) { const int t = tid * PER + i; if (t < S_) cl[t] = base + loc[i]; }
      __syncthreads(); }
    const int qrow = q0 + 32 * wave + r32;
    constexpr float C2 = 0.125f * LOG2E_;
    bf16x8 qr[4];
    { const bf16_t* qp = P.proj + (size_t)(b * S_ + qrow) * PJ + C_FQ + 64 * h + 8 * hi;
#pragma unroll
      for (int d0 = 0; d0 < 4; ++d0) { const u32x4 w = *(const u32x4*)(qp + 16 * d0);
          u32x4 o; o.x = pk2(bflo(w.x) * C2, bfhi(w.x) * C2); o.y = pk2(bflo(w.y) * C2, bfhi(w.y) * C2); o.z = pk2(bflo(w.z) * C2, bfhi(w.z) * C2); o.w = pk2(bflo(w.w) * C2, bfhi(w.w) * C2);
          qr[d0] = __builtin_bit_cast(bf16x8, o); } }
    const float clq = cl[qrow];
    float mrun = -INFINITY, lrun = 0.f; f32x16 o0 = {}, o1 = {};
    const int NT = qend / 64;
    const int srow = tid >> 3, sch = tid & 7;
    const bf16_t* kg = P.proj + (size_t)(b * S_ + srow) * PJ + C_FK + 64 * h + 8 * sch;
    const bf16_t* vg = P.vtr + (size_t)(64 * h + srow) * T_ + (size_t)b * S_ + 8 * sch;
    const int koff = srow * 128 + ((sch ^ ((srow >> 1) & 7)) * 16);
    const int voffa = srow * 128 + (((2 * sch) ^ ((srow >> 1) & 15)) * 8), voffb = srow * 128 + (((2 * sch + 1) ^ ((srow >> 1) & 15)) * 8);
    u32x4 kreg = *(const u32x4*)kg, vreg = *(const u32x4*)vg;
    *(u32x4*)(Kt + koff) = kreg; *(u32x2*)(Vt + voffa) = (u32x2){vreg.x, vreg.y}; *(u32x2*)(Vt + voffb) = (u32x2){vreg.z, vreg.w};
    if (NT > 1) { kreg = *(const u32x4*)(kg + (size_t)64 * PJ); vreg = *(const u32x4*)(vg + 64); }
    __syncthreads();
    for (int jt = 0; jt < NT; ++jt) {
        const int kv0 = jt * 64; const unsigned char* Kb = Kt + (jt & 1) * 16384; const unsigned char* Vb = Vt + (jt & 1) * 16384;
        if (kv0 <= q0 + 32 * wave + 31) {
            f32x16 pt[2];
#pragma unroll
            for (int kvt = 0; kvt < 2; ++kvt) { const int row = 32 * kvt + r32; f32x16 acc;
#pragma unroll
                for (int g4 = 0; g4 < 4; ++g4) { const f32x4 c4 = *(const f32x4*)(cl + kv0 + 32 * kvt + 8 * g4 + 4 * hi);
#pragma unroll
                    for (int e = 0; e < 4; ++e) acc[4 * g4 + e] = clq - c4[e]; }
#pragma unroll
                for (int d0 = 0; d0 < 4; ++d0) { const bf16x8 a = *(const bf16x8*)(Kb + row * 128 + (((2 * d0 + hi) ^ ((row >> 1) & 7)) * 16)); acc = MFMA32(a, qr[d0], acc); }
                pt[kvt] = acc; }
            if (kv0 + 63 > q0 + 32 * wave) {
#pragma unroll
                for (int kvt = 0; kvt < 2; ++kvt)
#pragma unroll
                    for (int r = 0; r < 16; ++r) { const int key = kv0 + 32 * kvt + (r & 3) + 8 * (r >> 2) + 4 * hi; if (key > qrow) pt[kvt][r] = -INFINITY; } }
            float mx = -INFINITY;
#pragma unroll
            for (int kvt = 0; kvt < 2; ++kvt)
#pragma unroll
                for (int r = 0; r < 16; ++r) mx = fmaxf(mx, pt[kvt][r]);
            mx = fmaxf(mx, __shfl_xor(mx, 32));
            const float mnew = fmaxf(mrun, mx), alpha = FAST_EXP2(mrun - mnew); mrun = mnew;
            float ls = 0.f;
#pragma unroll
            for (int kvt = 0; kvt < 2; ++kvt)
#pragma unroll
                for (int r = 0; r < 16; ++r) { const float e = FAST_EXP2(pt[kvt][r] - mnew); pt[kvt][r] = e; ls += e; }
            lrun = lrun * alpha + ls;
            float* wf = wsf + wave * 32;
            WAVE_SYNC(); if (hi == 0) wf[r32] = alpha; WAVE_SYNC();
#pragma unroll
            for (int g4 = 0; g4 < 4; ++g4) { const f32x4 f = *(const f32x4*)(wf + 8 * g4 + 4 * hi);
#pragma unroll
                for (int e = 0; e < 4; ++e) { o0[4 * g4 + e] *= f[e]; o1[4 * g4 + e] *= f[e]; } }
#pragma unroll
            for (int s = 0; s < 4; ++s) { const int kvt = s >> 1, rb = 8 * (s & 1);
                u32x4 pw; pw.x = pk2(pt[kvt][rb + 0], pt[kvt][rb + 1]); pw.y = pk2(pt[kvt][rb + 2], pt[kvt][rb + 3]); pw.z = pk2(pt[kvt][rb + 4], pt[kvt][rb + 5]); pw.w = pk2(pt[kvt][rb + 6], pt[kvt][rb + 7]);
                const bf16x8 pa = __builtin_bit_cast(bf16x8, pw);
#pragma unroll
                for (int dt = 0; dt < 2; ++dt) { const int d = 32 * dt + r32; const int sw = (d >> 1) & 15;
                    const u32x2 va = *(const u32x2*)(Vb + d * 128 + (((4 * s + hi) ^ sw) * 8)), vb = *(const u32x2*)(Vb + d * 128 + (((4 * s + 2 + hi) ^ sw) * 8));
                    const bf16x8 vf = __builtin_bit_cast(bf16x8, (u32x4){va.x, va.y, vb.x, vb.y});
                    if (dt == 0) o0 = MFMA32(pa, vf, o0); else o1 = MFMA32(pa, vf, o1); } }
        }
        if (jt + 1 < NT) { unsigned char* Kn = Kt + ((jt + 1) & 1) * 16384; unsigned char* Vn = Vt + ((jt + 1) & 1) * 16384;
            *(u32x4*)(Kn + koff) = kreg; *(u32x2*)(Vn + voffa) = (u32x2){vreg.x, vreg.y}; *(u32x2*)(Vn + voffb) = (u32x2){vreg.z, vreg.w};
            if (jt + 2 < NT) { kreg = *(const u32x4*)(kg + (size_t)(kv0 + 128) * PJ); vreg = *(const u32x4*)(vg + kv0 + 128); } }
        __syncthreads();
    }
    { const float lt = lrun + __shfl_xor(lrun, 32); float* wf = wsf + wave * 32;
      WAVE_SYNC(); if (hi == 0) wf[r32] = 1.0f / lt; WAVE_SYNC();
      bf16_t* orow = P.ycat + (size_t)(b * S_ + q0 + 32 * wave) * 1024 + 512 + 64 * h + r32;
#pragma unroll
      for (int r = 0; r < 16; ++r) { const int qq = (r & 3) + 8 * (r >> 2) + 4 * hi; const float f = wf[qq];
          orow[(size_t)qq * 1024] = (bf16_t)f2bf(o0[r] * f); orow[(size_t)qq * 1024 + 32] = (bf16_t)f2bf(o1[r] * f); } }
    __syncthreads();
}

constexpr int RW_NCH = S_ / 64;
constexpr int RWP = 72;
constexpr int RW_ARR = 64 * RWP * 2;
constexpr int RW_SCRP = 388;
__device__ __forceinline__ void rw_stage_weights(const KP& p, int l, int h, bf16_t* wb, int tid) {
    for (int e = tid; e < 2048; e += NTHR) { const int m = e >> 4, c4 = (e & 15) * 4;
        if (m < 32) { const f32x4 v = *(const f32x4*)(p.in[I_A2] + (l * 32 + m) * 256 + 64 * h + c4);
#pragma unroll
            for (int q = 0; q < 4; ++q) wb[(c4 + q) * 40 + m] = (bf16_t)f2bf(v[q]); }
        else if (m < 64) { const f32x4 v = *(const f32x4*)(p.in[I_W2] + (l * 32 + m - 32) * 256 + 64 * h + c4);
#pragma unroll
            for (int q = 0; q < 4; ++q) wb[2560 + (c4 + q) * 40 + (m - 32)] = (bf16_t)f2bf(v[q]); }
        else { const f32x4 v = *(const f32x4*)(p.in[I_G2] + (l * 64 + m - 64) * 256 + 64 * h + c4);
#pragma unroll
            for (int q = 0; q < 4; ++q) wb[5120 + (c4 + q) * 72 + (m - 64)] = (bf16_t)f2bf(v[q]); } }
    __syncthreads();
}
__device__ __forceinline__ bf16x8 rw_pack8(const float* q) { const f32x4 a = *(const f32x4*)q, b = *(const f32x4*)(q + 4);
    u32x4 w; w.x = pk2(a.x, a.y); w.y = pk2(a.z, a.w); w.z = pk2(b.x, b.y); w.w = pk2(b.z, b.w); return __builtin_bit_cast(bf16x8, w); }
template <int NT, bool NEED_W, bool NEED_G>
__device__ __forceinline__ void rw_prep(const KP& p, const Ptrs& P, int l, int b, int h, int tpos0, float* scr, const bf16_t* wb, int lane,
                                        float (&r)[NT], float (&lw)[NT], float (&k2)[NT], float (&v)[NT], float (&ain)[NT], float (&bin)[NT], float (&g)[NT], float (&rk)[NT]) {
    constexpr int NIT = (NT * 40 + 63) / 64;
    u32x4 cur[NIT], prv[NIT];
#pragma unroll
    for (int i = 0; i < NIT; ++i) { const int e = lane + 64 * i; const int tt = e / 40, ch = e % 40; const int t = tpos0 + tt;
        const int col = ch < 8 ? C_R + 64 * h + 8 * ch : ch < 16 ? C_K + 64 * h + 8 * (ch - 8) : ch < 24 ? C_V + 64 * h + 8 * (ch - 16) : C_HW + 8 * (ch - 24);
        cur[i] = (u32x4){0u, 0u, 0u, 0u}; prv[i] = (u32x4){0u, 0u, 0u, 0u};
        if (e < NT * 40) { const bf16_t* row = P.proj + (size_t)(b * S_ + t) * PJ + col; cur[i] = *(const u32x4*)row; if (t > 0) prv[i] = *(const u32x4*)(row - PJ); } }
#pragma unroll
    for (int i = 0; i < NIT; ++i) { const int e = lane + 64 * i; const int tt = e / 40, ch = e % 40;
        const int col = ch < 8 ? C_R + 64 * h + 8 * ch : ch < 16 ? C_K + 64 * h + 8 * (ch - 8) : ch < 24 ? C_V + 64 * h + 8 * (ch - 16) : C_HW + 8 * (ch - 24);
        const int idx = ch < 24 ? 8 * ch : 192 + 8 * (ch - 24);
        if (e < NT * 40) { const f32x4 m0 = *(const f32x4*)(p.in[I_MU] + l * 896 + col), m1 = *(const f32x4*)(p.in[I_MU] + l * 896 + col + 4);
            float z[8] = {bflo(cur[i].x), bfhi(cur[i].x), bflo(cur[i].y), bfhi(cur[i].y), bflo(cur[i].z), bfhi(cur[i].z), bflo(cur[i].w), bfhi(cur[i].w)};
            const float zp[8] = {bflo(prv[i].x), bfhi(prv[i].x), bflo(prv[i].y), bfhi(prv[i].y), bflo(prv[i].z), bfhi(prv[i].z), bflo(prv[i].w), bfhi(prv[i].w)};
#pragma unroll
            for (int q = 0; q < 8; ++q) { float zs = z[q] + (zp[q] - z[q]) * (q < 4 ? m0[q & 3] : m1[q & 3]);
                if (ch >= 24 && ch < 28) zs = 1.0f - 2.0f * FAST_RCP(1.0f + FAST_EXP2(zs * 2.8853900817779268f));
                else if (ch >= 32) zs = sigmoidf_(zs);
                z[q] = zs; }
            *(f32x4*)(scr + tt * RW_SCRP + idx) = (f32x4){z[0], z[1], z[2], z[3]}; *(f32x4*)(scr + tt * RW_SCRP + idx + 4) = (f32x4){z[4], z[5], z[6], z[7]}; } }
    WAVE_SYNC();
    { const int fr = lane & 15, fq = lane >> 4; const float* hrow = scr + (fr & 7) * RW_SCRP + 192 + 8 * fq;
      const bf16x8 fw = rw_pack8(hrow), fa = rw_pack8(hrow + 32), fg0 = rw_pack8(hrow + 64), fg1 = rw_pack8(hrow + 96);
      WAVE_SYNC();
#pragma unroll
      for (int nt = 0; nt < 4; ++nt) { const f32x4 z4 = (f32x4){0.f, 0.f, 0.f, 0.f};
          const f32x4 da = MFMA16(fa, *(const bf16x8*)(wb + (16 * nt + fr) * 40 + 8 * fq), z4);
          f32x4 dw = z4, dg = z4;
          if (NEED_W) dw = MFMA16(fw, *(const bf16x8*)(wb + 2560 + (16 * nt + fr) * 40 + 8 * fq), z4);
          if (NEED_G) { dg = MFMA16(fg0, *(const bf16x8*)(wb + 5120 + (16 * nt + fr) * 72 + 8 * fq), z4); dg = MFMA16(fg1, *(const bf16x8*)(wb + 5120 + (16 * nt + fr) * 72 + 32 + 8 * fq), dg); }
          if (fq < 2) {
#pragma unroll
              for (int q = 0; q < 4; ++q) { float* o = scr + (4 * fq + q) * RW_SCRP + 16 * nt + fr; o[192] = da[q]; if (NEED_W) o[256] = dw[q]; if (NEED_G) o[320] = dg[q]; } } }
      WAVE_SYNC(); }
    const int j = lane, cj = 64 * h + j; float wl[NT], al[NT], gg[NT];
    const float w0 = p.in[I_W0][l * 256 + cj], a0 = p.in[I_A0][l * 256 + cj];
#pragma unroll
    for (int tt = 0; tt < NT; ++tt) { al[tt] = a0 + scr[tt * RW_SCRP + 192 + j]; wl[tt] = NEED_W ? w0 + scr[tt * RW_SCRP + 256 + j] : w0; gg[tt] = NEED_G ? scr[tt * RW_SCRP + 320 + j] : 0.f; }
    const float kkw = p.in[I_KK][l * 256 + cj], kaw = p.in[I_KA][l * 256 + cj], rkw = p.in[I_RK][l * 256 + cj];
    float ssum[NT], rsum[NT], kkv[NT], av[NT];
#pragma unroll
    for (int tt = 0; tt < NT; ++tt) {
        const float a = sigmoidf_(al[tt]); av[tt] = a;
        const float rr = scr[tt * RW_SCRP + j], k = scr[tt * RW_SCRP + 64 + j], vv = scr[tt * RW_SCRP + 128 + j];
        const float kk2 = k * (1.f + (a - 1.f) * kaw);
        r[tt] = rr; k2[tt] = kk2; v[tt] = vv;
        const float kk = k * kkw; kkv[tt] = kk; ssum[tt] = kk * kk; rsum[tt] = rr * kk2 * rkw; }
    if (NEED_W) wave_sum_n<NT>(ssum);
    if (NEED_G) wave_sum_n<NT>(rsum);
#pragma unroll
    for (int tt = 0; tt < NT; ++tt) {
        if (NEED_W) { const float x = -wl[tt]; const float sp = fmaxf(x, 0.f) + 0.6931471805599453f * FAST_LOG2(1.0f + FAST_EXP2(-1.4426950408889634f * fabsf(x)));
            lw[tt] = -FAST_EXP2(-1.4426950408889634f * (sp + 0.5f));
            const float kkn = kkv[tt] * FAST_RSQ(fmaxf(ssum[tt], 1e-24f));
            ain[tt] = -kkn; bin[tt] = kkn * av[tt]; }
        if (NEED_G) { g[tt] = gg[tt]; rk[tt] = rsum[tt]; }
    }
    WAVE_SYNC();
}
__device__ __forceinline__ bf16x8 ldsb8(const bf16_t* p) { return *(const bf16x8*)p; }
__device__ __forceinline__ f32x16 rw_tile(const bf16_t* X, const bf16_t* Y, int tm, int tn, int r32, int hi, f32x16 acc) {
    const bf16_t* xa = X + (32 * tm + r32) * RWP + 8 * hi; const bf16_t* yb = Y + (32 * tn + r32) * RWP + 8 * hi;
#pragma unroll
    for (int ks = 0; ks < 4; ++ks) acc = MFMA32(ldsb8(xa + 16 * ks), ldsb8(yb + 16 * ks), acc);
    return acc;
}
template <int STOP = 0>
__device__ __forceinline__ void rw_chunk_unit(const KP& p, const Ptrs& P, int l, int unit, unsigned char* lds) {
    MEMFENCE(); OPAQUE_S(unit);
    const int c = unit % RW_NCH, bh = unit / RW_NCH, b = bh >> 2, h = bh & 3, t0 = c * 64;
    bf16_t* AT = (bf16_t*)(lds + 0 * RW_ARR); bf16_t* RT = (bf16_t*)(lds + 1 * RW_ARR); bf16_t* BT = (bf16_t*)(lds + 2 * RW_ARR); bf16_t* KT = (bf16_t*)(lds + 3 * RW_ARR);
    bf16_t* BH = (bf16_t*)(lds + 4 * RW_ARR); bf16_t* KH = (bf16_t*)(lds + 5 * RW_ARR); bf16_t* VT = (bf16_t*)(lds + 6 * RW_ARR);
    bf16_t* AAK = (bf16_t*)(lds + 7 * RW_ARR); bf16_t* ARB = (bf16_t*)(lds + 8 * RW_ARR); bf16_t* ARK = (bf16_t*)(lds + 9 * RW_ARR);
    bf16_t* W1T = (bf16_t*)(lds + 10 * RW_ARR); bf16_t* UVT = (bf16_t*)(lds + 11 * RW_ARR);
    bf16_t* RHT = (bf16_t*)(lds + 12 * RW_ARR);
    float* ADG = (float*)(lds + 14 * RW_ARR);
    bf16_t* ABA = (bf16_t*)(lds + 14 * RW_ARR + 8192);
    float* WT = (float*)(lds + 14 * RW_ARR + 8192 + 32 * RWP * 2);
    float* GC = WT + 512;
    bf16_t* DAB = AT;
    const int tid = TIDX(), lane = tid & 63, wave = tid >> 6, r32 = lane & 31, hi = lane >> 5;
    float r[8], lw[8], k2[8], v[8], ain[8], bin[8], gg[8], rk[8];
    rw_stage_weights(p, l, h, (bf16_t*)(lds + 8 * 8 * RW_SCRP * 4), tid);
    rw_prep<8, true, true>(p, P, l, b, h, t0 + 8 * wave, (float*)lds + wave * (8 * RW_SCRP), (const bf16_t*)(lds + 8 * 8 * RW_SCRP * 4), lane, r, lw, k2, v, ain, bin, gg, rk);
#pragma unroll
    for (int i = 0; i < 8; ++i) { const size_t o = (size_t)(b * S_ + t0 + 8 * wave + i) * 256 + 64 * h + lane; P.rwGt[o] = (bf16_t)f2bf(gg[i]); P.rwRKV[o] = (bf16_t)f2bf(rk[i] * v[i]); }
    float Lloc[8]; { float s = 0.f;
#pragma unroll
      for (int i = 0; i < 8; ++i) { s += lw[i]; Lloc[i] = s; } }
    __syncthreads();
    if (STOP == 1) return;
    WT[wave * 64 + lane] = Lloc[7];
    __syncthreads();
    { float off = 0.f, tot = 0.f;
#pragma unroll
      for (int w = 0; w < 8; ++w) { const float x = WT[w * 64 + lane]; tot += x; if (w < wave) off += x; }
      if (wave == 0) GC[lane] = __expf(tot);
      unsigned bhp[4], khp[4], vtp[4], atp[4]; float pb = 0.f, pk = 0.f, pv = 0.f, pa = 0.f;
#pragma unroll
      for (int i = 0; i < 8; ++i) { const int t = 8 * wave + i; const float Lt = off + Lloc[i], Lp = Lt - lw[i];
          const float eL = __expf(Lt), eLp = __expf(Lp), einv = __expf(-Lt), eh = __expf(tot - Lt);
          const float xa = ain[i] * eLp;
          AT[t * RWP + lane] = (bf16_t)f2bf(xa); RT[t * RWP + lane] = (bf16_t)f2bf(r[i] * eL);
          BT[t * RWP + lane] = (bf16_t)f2bf(bin[i] * einv); KT[t * RWP + lane] = (bf16_t)f2bf(k2[i] * einv);
          const float xb = bin[i] * eh, xk = k2[i] * eh, xv = v[i];
          if (i & 1) { bhp[i >> 1] = pk2(pb, xb); khp[i >> 1] = pk2(pk, xk); vtp[i >> 1] = pk2(pv, xv); atp[i >> 1] = pk2(pa, xa); } else { pb = xb; pk = xk; pv = xv; pa = xa; } }
      *(u32x4*)(BH + lane * RWP + 8 * wave) = (u32x4){bhp[0], bhp[1], bhp[2], bhp[3]};
      *(u32x4*)(KH + lane * RWP + 8 * wave) = (u32x4){khp[0], khp[1], khp[2], khp[3]};
      *(u32x4*)(VT + lane * RWP + 8 * wave) = (u32x4){vtp[0], vtp[1], vtp[2], vtp[3]};
      *(u32x4*)(RHT + (64 + lane) * RWP + 8 * wave) = (u32x4){atp[0], atp[1], atp[2], atp[3]}; }
    __syncthreads();
#pragma unroll
    for (int jj = 0; jj < 2; ++jj) { const int job = wave + 8 * jj, mat = job >> 2, tm = (job >> 1) & 1, tn = job & 1;
        f32x16 acc = {};
        if (!(tm == 0 && tn == 1)) acc = rw_tile((mat & 2) ? RT : AT, (mat & 1) ? KT : BT, tm, tn, r32, hi, acc);
        const int s = 32 * tn + r32;
#pragma unroll
        for (int q = 0; q < 16; ++q) { const int t = 32 * tm + (q & 3) + 8 * (q >> 2) + 4 * hi;
            const bool keep = (mat & 2) ? (s <= t) : (s < t); const float x = keep ? acc[q] : 0.f;
            if (mat == 0) { if (tm == tn) ADG[(tm * 32 + (t & 31)) * 32 + (s & 31)] = x; else if (tm == 1) ABA[(t & 31) * RWP + s] = (bf16_t)f2bf(x); } else { bf16_t* D = (mat == 1) ? AAK : (mat == 2) ? ARB : ARK; D[t * RWP + s] = (bf16_t)f2bf(x); } } }
    __syncthreads();
    if (STOP == 2) return;
    if (wave < 4) { const int tm = wave >> 1, tn = wave & 1; f32x16 acc = {}; acc = rw_tile(VT, AAK, tm, tn, r32, hi, acc);
#pragma unroll
        for (int q = 0; q < 16; ++q) { const int i = 32 * tm + (q & 3) + 8 * (q >> 2) + 4 * hi; RHT[i * RWP + 32 * tn + r32] = (bf16_t)f2bf(acc[q]); } }
    else if (wave == 4) { float d[32]; const LAS float* ab = (const LAS float*)ADG + hi * 1024;
#pragma unroll
        for (int t = 0; t < 32; ++t) d[t] = (t == r32) ? 1.f : 0.f;
#pragma unroll
        for (int t = 1; t < 32; ++t) { float s0 = 0.f, s1 = 0.f;
#pragma unroll
            for (int s4 = 0; s4 < (t + 3) / 4; ++s4) { const f32x4 a4 = *(const LAS f32x4*)(ab + t * 32 + 4 * s4);
                s0 += a4[0] * d[4 * s4]; s1 += a4[1] * d[4 * s4 + 1]; s0 += a4[2] * d[4 * s4 + 2]; s1 += a4[3] * d[4 * s4 + 3]; }
            d[t] += s0 + s1; if ((t & 3) == 3) MEMFENCE(); }
        LAS bf16_t* D = (LAS bf16_t*)DAB + hi * 32 * RWP + r32;
#pragma unroll
        for (int t = 0; t < 32; ++t) D[t * RWP] = (bf16_t)f2bf(d[t]); }
    __syncthreads();
    if (wave < 4) { bf16_t* XT = (wave < 2 ? UVT : W1T) + (32 * (wave & 1)) * RWP;
        const bf16_t* rh = RHT + (32 * wave + r32) * RWP + 8 * hi;
        { f32x16 acc = {}; const bf16_t* da = DAB + r32 * RWP + 8 * hi;
#pragma unroll
          for (int ks = 0; ks < 2; ++ks) acc = MFMA32(ldsb8(rh + 16 * ks), ldsb8(da + 16 * ks), acc);
#pragma unroll
          for (int q = 0; q < 16; ++q) XT[((q & 3) + 8 * (q >> 2) + 4 * hi) * RWP + r32] = (bf16_t)f2bf(acc[q]); }
        WAVE_SYNC();
        { f32x16 acc; const bf16_t* rz = RHT + (32 * wave) * RWP + 32 + r32;
#pragma unroll
          for (int q = 0; q < 16; ++q) acc[q] = bf2f(rz[((q & 3) + 8 * (q >> 2) + 4 * hi) * RWP]);
          const bf16_t* xa = XT + r32 * RWP + 8 * hi; const bf16_t* ba = ABA + r32 * RWP + 8 * hi;
#pragma unroll
          for (int ks = 0; ks < 2; ++ks) acc = MFMA32(ldsb8(xa + 16 * ks), ldsb8(ba + 16 * ks), acc);
#pragma unroll
          for (int q = 0; q < 16; ++q) XT[((q & 3) + 8 * (q >> 2) + 4 * hi) * RWP + 32 + r32] = (bf16_t)f2bf(acc[q]); }
        WAVE_SYNC();
        { f32x16 acc = {}; const bf16_t* xz = XT + r32 * RWP + 32 + 8 * hi; const bf16_t* db = DAB + (32 + r32) * RWP + 8 * hi;
          const bf16x8 z0 = ldsb8(xz), z1 = ldsb8(xz + 16);
          acc = MFMA32(z0, ldsb8(db), acc); acc = MFMA32(z1, ldsb8(db + 16), acc);
          WAVE_SYNC();
#pragma unroll
          for (int q = 0; q < 16; ++q) XT[((q & 3) + 8 * (q >> 2) + 4 * hi) * RWP + 32 + r32] = (bf16_t)f2bf(acc[q]); } }
    __syncthreads();
    if (STOP == 3) return;
    const size_t chunk = (size_t)unit;
#pragma unroll
    for (int jj = 0; jj < 2; ++jj) { const int job = wave + 8 * jj, kind = job >> 2, tm = (job >> 1) & 1, tn = job & 1; f32x16 acc = {};
        const int col = 32 * tn + r32;
        if (kind == 0) { acc = rw_tile(BH, W1T, tm, tn, r32, hi, acc);
            bf16_t* PT = P.rwPT + chunk * 4096;
#pragma unroll
            for (int q = 0; q < 16; ++q) { const int row = 32 * tm + (q & 3) + 8 * (q >> 2) + 4 * hi; const float x = acc[q] + (row == col ? GC[row] : 0.f); PT[row * 64 + col] = (bf16_t)f2bf(x); } }
        else if (kind == 1) { acc = rw_tile(ARB, W1T, tm, tn, r32, hi, acc);
#pragma unroll
            for (int q = 0; q < 16; ++q) { const int t = 32 * tm + (q & 3) + 8 * (q >> 2) + 4 * hi; const float x = acc[q] + bf2f(RT[t * RWP + col]);
                P.rwQ[(size_t)(b * S_ + t0 + t) * 256 + 64 * h + col] = (bf16_t)f2bf(x); } }
        else if (kind == 2) { acc = rw_tile(UVT, BH, tm, tn, r32, hi, acc); acc = rw_tile(VT, KH, tm, tn, r32, hi, acc);
            unsigned* Gg = (unsigned*)(P.rwG + chunk * 4096) + (tm * 2 + tn) * 8 * 64 + lane;
#pragma unroll
            for (int q = 0; q < 8; ++q) Gg[q * 64] = pk2(acc[2 * q], acc[2 * q + 1]); }
        else { acc = rw_tile(ARB, UVT, tm, tn, r32, hi, acc); acc = rw_tile(ARK, VT, tm, tn, r32, hi, acc);
#pragma unroll
            for (int q = 0; q < 16; ++q) { const int t = 32 * tm + (q & 3) + 8 * (q >> 2) + 4 * hi; P.ycat[(size_t)(b * S_ + t0 + t) * 1024 + 64 * h + col] = (bf16_t)f2bf(acc[q]); } } }
    __syncthreads();
}
__device__ __forceinline__ void rw_state_unit(const KP& p, const Ptrs& P, int l, int unit, unsigned char* lds) {
    bf16_t* Sb = (bf16_t*)lds;
    const int tid = TIDX(), lane = tid & 63, wave = tid >> 6, r32 = lane & 31, hi = lane >> 5;
    const int ti = (wave >> 1) & 1, tj = wave & 1;
    f32x16 S = {};
    unsigned gq[8]; bf16x8 pq[4];
    if (wave < 4) { const size_t chunk = (size_t)unit * RW_NCH; const unsigned* Gg = (const unsigned*)(P.rwG + chunk * 4096) + (ti * 2 + tj) * 8 * 64 + lane;
#pragma unroll
        for (int q = 0; q < 8; ++q) gq[q] = Gg[q * 64];
        const bf16_t* pt = P.rwPT + chunk * 4096 + (32 * tj + r32) * 64 + 8 * hi;
#pragma unroll
        for (int ks = 0; ks < 4; ++ks) pq[ks] = *(const bf16x8*)(pt + 16 * ks); }
    for (int c = 0; c < RW_NCH; ++c) { const size_t chunk = (size_t)unit * RW_NCH + c;
        unsigned gn[8]; bf16x8 pn[4];
        if (wave < 4) { const size_t cn = chunk + (c + 1 < RW_NCH ? 1 : 0); const unsigned* Gg = (const unsigned*)(P.rwG + cn * 4096) + (ti * 2 + tj) * 8 * 64 + lane;
#pragma unroll
            for (int q = 0; q < 8; ++q) gn[q] = Gg[q * 64];
            const bf16_t* pt = P.rwPT + cn * 4096 + (32 * tj + r32) * 64 + 8 * hi;
#pragma unroll
            for (int ks = 0; ks < 4; ++ks) pn[ks] = *(const bf16x8*)(pt + 16 * ks);
#pragma unroll
            for (int q = 0; q < 16; ++q) Sb[(32 * ti + (q & 3) + 8 * (q >> 2) + 4 * hi) * RWP + 32 * tj + r32] = (bf16_t)f2bf(S[q]); }
        __syncthreads();
        { const int row = tid >> 3, ch = tid & 7; *(u32x4*)(P.rwS0 + chunk * 4096 + row * 64 + ch * 8) = *(const u32x4*)(Sb + row * RWP + ch * 8); }
        if (wave < 4) { f32x16 acc;
#pragma unroll
            for (int q = 0; q < 8; ++q) { acc[2 * q] = bflo(gq[q]); acc[2 * q + 1] = bfhi(gq[q]); }
            const bf16_t* sa = Sb + (32 * ti + r32) * RWP + 8 * hi;
#pragma unroll
            for (int ks = 0; ks < 4; ++ks) acc = MFMA32(ldsb8(sa + 16 * ks), pq[ks], acc);
            S = acc;
#pragma unroll
            for (int q = 0; q < 8; ++q) gq[q] = gn[q];
#pragma unroll
            for (int ks = 0; ks < 4; ++ks) pq[ks] = pn[ks]; }
        __syncthreads();
    }
}
template <bool DUMMY = false>
__device__ __forceinline__ void rw_out_unit(const KP& p, const Ptrs& P, int l, int unit, unsigned char* lds) {
    MEMFENCE(); OPAQUE_S(unit);
    const int c = unit % RW_NCH, bh = unit / RW_NCH, b = bh >> 2, h = bh & 3, t0 = c * 64;
    float* Yb = (float*)(lds + 81920);
    const int tid = TIDX(), lane = tid & 63, wave = tid >> 6, r32 = lane & 31, hi = lane >> 5;
    float g[8], rkv[8];
#pragma unroll
    for (int i = 0; i < 8; ++i) { const size_t o = (size_t)(b * S_ + t0 + 8 * wave + i) * 256 + 64 * h + lane; g[i] = bf2f(P.rwGt[o]); rkv[i] = bf2f(P.rwRKV[o]); }
    if (wave < 4) { const int tm = wave >> 1, tn = wave & 1; f32x16 acc; const int col = 32 * tn + r32;
        const bf16_t* yl = P.ycat + (size_t)(b * S_ + t0 + 32 * tm) * 1024 + 64 * h + col;
#pragma unroll
        for (int q = 0; q < 16; ++q) acc[q] = bf2f(yl[(size_t)((q & 3) + 8 * (q >> 2) + 4 * hi) * 1024]);
        const bf16_t* qa = P.rwQ + (size_t)(b * S_ + t0 + 32 * tm + r32) * 256 + 64 * h + 8 * hi; const bf16_t* sb = P.rwS0 + (size_t)unit * 4096 + (32 * tn + r32) * 64 + 8 * hi;
#pragma unroll
        for (int ks = 0; ks < 4; ++ks) acc = MFMA32(*(const bf16x8*)(qa + 16 * ks), *(const bf16x8*)(sb + 16 * ks), acc);
#pragma unroll
        for (int q = 0; q < 16; ++q) Yb[(32 * tm + (q & 3) + 8 * (q >> 2) + 4 * hi) * 64 + col] = acc[q]; }
    __syncthreads();
    const float gng = p.in[I_LNXG][l * 256 + 64 * h + lane], gnb = p.in[I_LNXB][l * 256 + 64 * h + lane];
    { float yv[8], m1[8], m2[8];
#pragma unroll
      for (int i = 0; i < 8; ++i) { yv[i] = Yb[(8 * wave + i) * 64 + lane]; m1[i] = yv[i]; }
      wave_sum_n<8>(m1);
#pragma unroll
      for (int i = 0; i < 8; ++i) { yv[i] -= m1[i] * (1.f / 64.f); m2[i] = yv[i] * yv[i]; }
      wave_sum_n<8>(m2);
#pragma unroll
      for (int i = 0; i < 8; ++i) { const int t = 8 * wave + i; const float yn = yv[i] * (1.0f / sqrtf(m2[i] * (1.f / 64.f) + GN_EPS_)) * gng + gnb; const float o = (yn + rkv[i]) * g[i];
        if (DUMMY) P.pb[(size_t)(b * S_ + t0 + t) * 256 + 64 * h + lane] = (bf16_t)f2bf(o);
        else P.ycat[(size_t)(b * S_ + t0 + t) * 1024 + 64 * h + lane] = (bf16_t)f2bf(o); } }
    __syncthreads();
}
#ifdef EMU_FP8_A
#define EMU_AUX77 u.aux = 77;
#else
#define EMU_AUX77
#endif
__device__ __forceinline__ void tile_map(int L, int nM, int nN, int& pm, int& pn) {
    const int nwg = nM * nN, q = nwg / 8, r = nwg % 8, xcd = L % 8, off = L / 8;
    const int wgid = (xcd < r ? xcd * (q + 1) : r * (q + 1) + (xcd - r) * q) + off;
    const int nig = 8 * nN, gid = wgid / nig, fm = gid * 8, gsz = (nM - fm) < 8 ? (nM - fm) : 8;
    pm = fm + ((wgid % nig) % gsz); pn = (wgid % nig) / gsz;
}
struct EpiStoreBf16 {
    bf16_t* base0; int ldc0; bf16_t* base1; int ldc1;
    __device__ __forceinline__ void operator()(const f32x4 (&acc)[2][2][4][2], const pg8::Unit& u, int wr, int wc, int fr, int fq, int tid) const {
        bf16_t* base = u.kind ? base1 : base0; const int ldc = u.kind ? ldc1 : ldc0;
        int row0 = u.pm * 256 + wr * 64 + fr, col0 = u.pn * 256 + wc * 32 + 8 * fq; OPAQUE(row0); OPAQUE(col0);
#pragma unroll
        for (int ai = 0; ai < 2; ++ai)
#pragma unroll
            for (int m = 0; m < 4; ++m) { bf16_t* rowp = base + (size_t)(row0 + ai * 128 + m * 16) * ldc + col0;
#pragma unroll
                for (int bj = 0; bj < 2; ++bj) { const f32x4 v0 = acc[ai][bj][m][0], v1 = acc[ai][bj][m][1];
                    u32x4 w; w.x = pk2(v0[0], v0[1]); w.y = pk2(v0[2], v0[3]); w.z = pk2(v1[0], v1[1]); w.w = pk2(v1[2], v1[3]);
                    *(u32x4*)(rowp + bj * 128) = w; } }
    }
};
template <int PART>
struct SchedA { const bf16_t* hb; const unsigned char* h8a; const unsigned char* h8b; const bf16_t* WinT; int G, c;
    __device__ __forceinline__ bool next(int i, pg8::Unit& u) const {
        const int nM = T_ / 256, n0 = nM * 9; u.aux = 0;
        if (PART == 0) { const int x = i * G + c; if (x >= n0) return false;
            tile_map(x, nM, 9, u.pm, u.pn); u.kind = 0; u.nt = 8; u.f8 = 1; const int m0 = u.pm * 256;
            u.a = (const char*)(m0 < H8_SPLIT ? h8a + (size_t)m0 * 1024 : h8b + (size_t)(m0 - H8_SPLIT) * 1024); u.b = (const char*)(WinT + (size_t)u.pn * 256 * 1024); }
        else { const int x = i * G + (c + G - n0 % G) % G; if (x >= nM) return false;
            u.pm = 0; u.pn = x; u.kind = 1; u.nt = 8; u.f8 = 1; const int m0 = x * 256;
            u.a = (const char*)(WinT + (size_t)WIN_VT * 1024); u.b = (const char*)(m0 < H8_SPLIT ? h8a + (size_t)m0 * 1024 : h8b + (size_t)(m0 - H8_SPLIT) * 1024); }
        return true; } };
struct EpiA { bf16_t* proj; const float* sc;
    __device__ __forceinline__ void operator()(const f32x4 (&acc)[2][2][4][2], const pg8::Unit& u, int wr, int wc, int fr, int fq, int tid) const {
        int row0 = u.pm * 256 + wr * 64 + fr, col0 = u.pn * 256 + wc * 32 + 8 * fq; OPAQUE(row0); OPAQUE(col0);
#pragma unroll
        for (int bj = 0; bj < 2; ++bj) { const f32x4 s0 = *(const f32x4*)(sc + col0 + bj * 128), s1 = *(const f32x4*)(sc + col0 + bj * 128 + 4);
#pragma unroll
            for (int ai = 0; ai < 2; ++ai)
#pragma unroll
                for (int m = 0; m < 4; ++m) { const f32x4 v0 = acc[ai][bj][m][0] * s0, v1 = acc[ai][bj][m][1] * s1;
                    u32x4 w; w.x = pk2(v0[0], v0[1]); w.y = pk2(v0[2], v0[3]); w.z = pk2(v1[0], v1[1]); w.w = pk2(v1[2], v1[3]);
                    *(u32x4*)(proj + (size_t)(row0 + ai * 128 + m * 16) * PJ + col0 + bj * 128) = w; } }
    }
};
struct EpiVt { bf16_t* vtr; const float* sc;
    __device__ __forceinline__ void operator()(const f32x4 (&acc)[2][2][4][2], const pg8::Unit& u, int wr, int wc, int fr, int fq, int tid) const {
        int row0 = wr * 64 + fr, col0 = u.pn * 256 + wc * 32 + 8 * fq; OPAQUE(row0); OPAQUE(col0);
#pragma unroll
        for (int ai = 0; ai < 2; ++ai)
#pragma unroll
            for (int m = 0; m < 4; ++m) { const int row = row0 + ai * 128 + m * 16; const float s = sc[row];
#pragma unroll
                for (int bj = 0; bj < 2; ++bj) { const f32x4 v0 = acc[ai][bj][m][0] * s, v1 = acc[ai][bj][m][1] * s;
                    u32x4 w; w.x = pk2(v0[0], v0[1]); w.y = pk2(v0[2], v0[3]); w.z = pk2(v1[0], v1[1]); w.w = pk2(v1[2], v1[3]);
                    *(u32x4*)(vtr + (size_t)row * T_ + col0 + bj * 128) = w; } }
    }
};
__device__ __forceinline__ void phase_A0(const KP& p, unsigned char* lds) {
    const int tid = TIDX(), lane = tid & 63, wave = tid >> 6; const int gw = BIDX() * NWAVE + wave, NGW = GDIM() * NWAVE;
    for (int r = gw; r < L_ * WIN_GATE; r += NGW) { const int l = r / WIN_GATE, n = r % WIN_GATE; const Ptrs P = make_ptrs(p.ws, l); bf16_t* row = P.WinT + (size_t)n * 1024;
        const u32x4 a = *(const u32x4*)(row + 16 * lane), b = *(const u32x4*)(row + 16 * lane + 8);
        float v[16] = {bflo(a.x), bfhi(a.x), bflo(a.y), bfhi(a.y), bflo(a.z), bfhi(a.z), bflo(a.w), bfhi(a.w), bflo(b.x), bfhi(b.x), bflo(b.y), bfhi(b.y), bflo(b.z), bfhi(b.z), bflo(b.w), bfhi(b.w)};
        float am = 0.f;
#pragma unroll
        for (int j = 0; j < 16; ++j) am = fmaxf(am, fabsf(v[j]));
        am = wave_max(am); const float sc = am > 0.f ? am * (1.0f / 440.0f) : 1.0f, inv = 1.0f / sc; u32x4 o;
#pragma unroll
        for (int j = 0; j < 4; ++j) { unsigned w = cvt_pk_fp8_f32_(v[4 * j] * inv, v[4 * j + 1] * inv, 0u, false); w = cvt_pk_fp8_f32_(v[4 * j + 2] * inv, v[4 * j + 3] * inv, w, true); o[j] = w; }
        WAVE_SYNC();
        *(u32x4*)((unsigned char*)row + 16 * lane) = o;
        if (lane == 0) P.gscA[n] = sc; }
#ifdef CPU_EMU
    (void)lds;
#endif
}
__device__ __forceinline__ void phase_A(const KP& p, int l, unsigned char* lds) {
    const Ptrs P = make_ptrs(p.ws, l);
    { SchedA<0> S{P.hb, P.h8a, P.h8b, P.WinT, GDIM(), BIDX()}; EpiA E{P.proj, P.gscA}; pg8::gemm_phase<1>((LAS unsigned char*)lds, 1024, 1024, S, E, 1024); }
    { SchedA<1> S{P.hb, P.h8a, P.h8b, P.WinT, GDIM(), BIDX()}; EpiVt E{P.vtr, P.gscA + WIN_VT}; pg8::gemm_phase<1>((LAS unsigned char*)lds, 1024, 512, S, E, 2048); }
}
#if PROBE_REPEAT >= 40 && PROBE_REPEAT <= 49
struct SchedAP { const bf16_t* hb; const bf16_t* WinT; int G, c, nt, pnmask;
    __device__ __forceinline__ bool next(int i, pg8::Unit& u) const {
        const int nM = T_ / 256, n0 = nM * 9; const int x = i * G + c; if (x >= n0 + nM) return false;
        u.nt = nt; u.aux = 0; u.f8 = 0;
        if (x < n0) { tile_map(x, nM, 9, u.pm, u.pn); u.kind = 0; u.a = (const char*)(hb + (size_t)u.pm * 256 * 1024); u.b = (const char*)(WinT + (size_t)u.pn * 256 * 1024); }
        else { u.pm = 0; u.pn = x - n0; u.kind = 1; u.a = (const char*)(WinT + (size_t)WIN_VT * 1024); u.b = (const char*)(hb + (size_t)u.pn * 256 * 1024); }
        u.pn &= pnmask; return true; } };
struct EpiNull { float* d;
    __device__ __forceinline__ void operator()(const f32x4 (&acc)[2][2][4][2], const pg8::Unit& u, int wr, int wc, int fr, int fq, int tid) const {
        f32x4 s = (f32x4){0.f, 0.f, 0.f, 0.f};
#pragma unroll
        for (int ai = 0; ai < 2; ++ai)
#pragma unroll
            for (int m = 0; m < 4; ++m)
#pragma unroll
                for (int bj = 0; bj < 2; ++bj) s += acc[ai][bj][m][0] + acc[ai][bj][m][1];
        if (s.x + s.y + s.z + s.w == 1.2345e30f) d[tid] = s.x; } };
struct EpiStash { u32x4* stash;
    __device__ __forceinline__ void operator()(const f32x4 (&acc)[2][2][4][2], const pg8::Unit& u, int wr, int wc, int fr, int fq, int tid) const {
        OPAQUE(tid);
#pragma unroll
        for (int ai = 0; ai < 2; ++ai)
#pragma unroll
            for (int m = 0; m < 4; ++m)
#pragma unroll
                for (int bj = 0; bj < 2; ++bj) { const f32x4 v0 = acc[ai][bj][m][0], v1 = acc[ai][bj][m][1];
                    u32x4 w; w.x = pk2(v0[0], v0[1]); w.y = pk2(v0[2], v0[3]); w.z = pk2(v1[0], v1[1]); w.w = pk2(v1[2], v1[3]);
                    stash[((ai * 4 + m) * 2 + bj) * 512 + tid] = w; } } };
struct EpiFullLine { bf16_t* base;
    __device__ __forceinline__ void operator()(const f32x4 (&acc)[2][2][4][2], const pg8::Unit& u, int wr, int wc, int fr, int fq, int tid) const {
        OPAQUE(tid); if (u.kind) return;
#pragma unroll
        for (int ai = 0; ai < 2; ++ai)
#pragma unroll
            for (int m = 0; m < 4; ++m)
#pragma unroll
                for (int bj = 0; bj < 2; ++bj) { const f32x4 v0 = acc[ai][bj][m][0], v1 = acc[ai][bj][m][1]; const int k = (ai * 4 + m) * 2 + bj, L = k * 512 + tid, row = L >> 5, ch = L & 31;
                    u32x4 w; w.x = pk2(v0[0], v0[1]); w.y = pk2(v0[2], v0[3]); w.z = pk2(v1[0], v1[1]); w.w = pk2(v1[2], v1[3]);
                    *(u32x4*)(base + (size_t)(u.pm * 256 + row) * PJ + u.pn * 256 + ch * 8) = w; } } };
struct EpiProjOnly { bf16_t* base;
    __device__ __forceinline__ void operator()(const f32x4 (&acc)[2][2][4][2], const pg8::Unit& u, int wr, int wc, int fr, int fq, int tid) const {
        if (u.kind) return;
        int row0 = u.pm * 256 + wr * 64 + fr, col0 = u.pn * 256 + wc * 32 + 8 * fq; OPAQUE(row0); OPAQUE(col0);
#pragma unroll
        for (int ai = 0; ai < 2; ++ai)
#pragma unroll
            for (int m = 0; m < 4; ++m) { bf16_t* rowp = base + (size_t)(row0 + ai * 128 + m * 16) * PJ + col0;
#pragma unroll
                for (int bj = 0; bj < 2; ++bj) { const f32x4 v0 = acc[ai][bj][m][0], v1 = acc[ai][bj][m][1];
                    u32x4 w; w.x = pk2(v0[0], v0[1]); w.y = pk2(v0[2], v0[3]); w.z = pk2(v1[0], v1[1]); w.w = pk2(v1[2], v1[3]);
                    *(u32x4*)(rowp + bj * 128) = w; } } } };
template <int V>
__device__ __forceinline__ void phase_Aprobe(const KP& p, int l, unsigned char* lds) {
    const Ptrs P = make_ptrs(p.ws, l);
    SchedAP S{P.hb, P.WinT, GDIM(), BIDX(), V == 1 ? 32 : V == 3 ? 4 : V == 4 ? 8 : V == 5 ? 64 : 16, V == 6 ? 3 : 0xffff};
    if (V == 7) { EpiFullLine E{P.proj}; pg8::gemm_phase((LAS unsigned char*)lds, 1024, 1024, S, E); }
    else if (V == 8) { EpiProjOnly E{P.proj}; pg8::gemm_phase((LAS unsigned char*)lds, 1024, 1024, S, E); }
    else if (V == 2) { EpiStash E{(u32x4*)(P.ycat + (size_t)BIDX() * 65536)}; pg8::gemm_phase((LAS unsigned char*)lds, 1024, 1024, S, E); }
    else if (V == 6) { EpiStoreBf16 E{P.ycat, 1024, P.ycat, 1024}; pg8::gemm_phase((LAS unsigned char*)lds, 1024, 1024, S, E); }
    else { EpiNull E{(float*)(P.ycat + (size_t)BIDX() * 65536)}; pg8::gemm_phase((LAS unsigned char*)lds, 1024, 1024, S, E); }
}
#endif
struct SchedGlu { const bf16_t* ycat; const bf16_t* GluT; int G, c;
    __device__ __forceinline__ bool next(int i, pg8::Unit& u) const {
        const int x = i * G + c; if (x >= T_ / 256) return false;
        u.pm = x; u.pn = 0; u.nt = 4; u.kind = 0; u.aux = 0; u.f8 = 0; u.a = (const char*)(ycat + (size_t)x * 256 * 1024 + 256); u.b = (const char*)GluT; return true; } };
struct EpiGlu { bf16_t* ycat; const float* glub;
    __device__ __forceinline__ void operator()(const f32x4 (&acc)[2][2][4][2], const pg8::Unit& u, int wr, int wc, int fr, int fq, int tid) const {
        int row0 = u.pm * 256 + wr * 64 + fr, col0 = wc * 32 + 8 * fq; OPAQUE(row0); OPAQUE(col0);
#pragma unroll
        for (int bj = 0; bj < 2; ++bj) { const f32x4 b0 = *(const f32x4*)(glub + col0 + bj * 128), b1 = *(const f32x4*)(glub + col0 + bj * 128 + 4);
#pragma unroll
            for (int ai = 0; ai < 2; ++ai)
#pragma unroll
                for (int m = 0; m < 4; ++m) { bf16_t* ptr = ycat + (size_t)(row0 + ai * 128 + m * 16) * 1024 + 256 + col0 + bj * 128;
                    const u32x4 y = *(const u32x4*)ptr; const f32x4 v0 = acc[ai][bj][m][0] + b0, v1 = acc[ai][bj][m][1] + b1;
                    u32x4 w; w.x = pk2(bflo(y.x) * sigmoidf_(v0[0]), bfhi(y.x) * sigmoidf_(v0[1])); w.y = pk2(bflo(y.y) * sigmoidf_(v0[2]), bfhi(y.y) * sigmoidf_(v0[3]));
                    w.z = pk2(bflo(y.z) * sigmoidf_(v1[0]), bfhi(y.z) * sigmoidf_(v1[1])); w.w = pk2(bflo(y.w) * sigmoidf_(v1[2]), bfhi(y.w) * sigmoidf_(v1[3]));
                    *(u32x4*)ptr = w; MEMFENCE(); } }
    }
};
__device__ __forceinline__ void convert_tables(const KP& p, const Ptrs& P, int l, unsigned char* lds) {
    const int tid = TIDX(), lane = tid & 63, wave = tid >> 6;
    unsigned* cnt = (unsigned*)(p.ws + WS_CTL) + 10240 + 16 * l; int* slot = (int*)(lds + 65536);
    const float* ps = p.in[I_P] + (size_t)l * T_ * 256;
    constexpr int NG8 = 6144 / 128, NTAB = 2 * NEXP / 128, NPB = (int)(((size_t)T_ * 256 / 8 + 4095) / 4096);
    for (;;) {
        __syncthreads(); if (tid == 0) *slot = (int)atomicAdd(cnt, 1u); __syncthreads();
        int item = *slot; if (item >= NG8 + NTAB + NPB) break;
        if (item < NG8) {
            for (int rr = wave; rr < 128; rr += NWAVE) { const int r5 = item * 128 + rr; bf16_t* row = r5 < 4096 ? P.WinT + (size_t)(WIN_GATE + r5) * 1024 : r5 < 5120 ? P.PleGT + (size_t)(r5 - 4096) * 1024 : P.WoutT + (size_t)(r5 - 5120) * 1024;
                const u32x4 a = *(const u32x4*)(row + 16 * lane), b = *(const u32x4*)(row + 16 * lane + 8);
                float v[16] = {bflo(a.x), bfhi(a.x), bflo(a.y), bfhi(a.y), bflo(a.z), bfhi(a.z), bflo(a.w), bfhi(a.w), bflo(b.x), bfhi(b.x), bflo(b.y), bfhi(b.y), bflo(b.z), bfhi(b.z), bflo(b.w), bfhi(b.w)};
                float am = 0.f;
#pragma unroll
                for (int j = 0; j < 16; ++j) am = fmaxf(am, fabsf(v[j]));
                am = wave_max(am); const float sc = am > 0.f ? am * (1.0f / 440.0f) : 1.0f, inv = 1.0f / sc; u32x4 o;
#pragma unroll
                for (int j = 0; j < 4; ++j) { unsigned w = cvt_pk_fp8_f32_(v[4 * j] * inv, v[4 * j + 1] * inv, 0u, false); w = cvt_pk_fp8_f32_(v[4 * j + 2] * inv, v[4 * j + 3] * inv, w, true); o[j] = w; }
                WAVE_SYNC();
                *(u32x4*)((unsigned char*)row + 16 * lane) = o;
                if (lane == 0) P.gsc[r5] = sc; }
            continue; }
        item -= NG8;
        if (item < NTAB) {
            for (int r4 = 0; r4 < 16; r4 += 4) { f32x4 v[4][4]; float am[4];
#pragma unroll
                for (int q = 0; q < 4; ++q) { const int it = item * 128 + wave + 8 * (r4 + q); const int tb = it >= NEXP, row = tb ? it - NEXP : it;
                    const float* src = p.in[tb ? I_V : I_U] + ((size_t)l * NEXP + row) * 1024 + 16 * lane; am[q] = 0.f;
#pragma unroll
                    for (int j = 0; j < 4; ++j) { v[q][j] = *(const f32x4*)(src + 4 * j); am[q] = fmaxf(am[q], fmaxf(fmaxf(fabsf(v[q][j].x), fabsf(v[q][j].y)), fmaxf(fabsf(v[q][j].z), fabsf(v[q][j].w)))); } }
#pragma unroll
                for (int q = 0; q < 4; ++q) { const int it = item * 128 + wave + 8 * (r4 + q); const int tb = it >= NEXP, row = tb ? it - NEXP : it;
                    const float amx = wave_max(am[q]); const float sc = amx > 0.f ? amx * (1.0f / 440.0f) : 1.0f, inv = 1.0f / sc; u32x4 o;
#pragma unroll
                    for (int j = 0; j < 4; ++j) { unsigned w = cvt_pk_fp8_f32_(v[q][j].x * inv, v[q][j].y * inv, 0u, false); w = cvt_pk_fp8_f32_(v[q][j].z * inv, v[q][j].w * inv, w, true); o[j] = w; }
                    *(u32x4*)((tb ? P.V8 : P.U8) + ((size_t)(lane >> 3) * NEXP + row) * 128 + 16 * (lane & 7)) = o;
                    if (lane == 0) (tb ? P.sv : P.su)[row] = sc; } }
        } else {
            const size_t base = (size_t)(item - NTAB) * 4096;
            f32x4 a[8], bq[8];
#pragma unroll
            for (int j = 0; j < 8; ++j) { const size_t i = base + tid + (size_t)j * NTHR; a[j] = (f32x4){0.f, 0.f, 0.f, 0.f}; bq[j] = a[j];
                if (i < (size_t)T_ * 256 / 8) { a[j] = *(const f32x4*)(ps + i * 8); bq[j] = *(const f32x4*)(ps + i * 8 + 4); } }
#pragma unroll
            for (int j = 0; j < 8; ++j) { const size_t i = base + tid + (size_t)j * NTHR;
                if (i < (size_t)T_ * 256 / 8) { u32x4 o; o.x = pk2(a[j].x, a[j].y); o.y = pk2(a[j].z, a[j].w); o.z = pk2(bq[j].x, bq[j].y); o.w = pk2(bq[j].z, bq[j].w); *(u32x4*)(P.pb + i * 8) = o; } }
        }
    }
}
__device__ __forceinline__ void phase_B2(const KP& p, int l, unsigned char* lds) {
    const Ptrs P = make_ptrs(p.ws, l);
    constexpr int NRW = NB_ * 4; const int G = GDIM(), c = BIDX();
    int gG = G, gc = c;
    if (G > NRW) { if (c < NRW) { rw_state_unit(p, P, l, c, lds);
#if PROBE_REPEAT == 35
        rw_state_unit(p, P, l, c, lds);
#endif
        convert_tables(p, P, l, lds); return; } gG = G - NRW; gc = c - NRW; }
    else { for (int u = c; u < NRW; u += G) rw_state_unit(p, P, l, u, lds); }
    SchedGlu S{P.ycat, P.GluT, gG, gc};
    EpiGlu E{P.ycat, p.in[I_GLUB] + l * 256};
    pg8::gemm_phase((LAS unsigned char*)lds, 1024, 256, S, E);
    convert_tables(p, P, l, lds);
}
struct SchedC { const unsigned char* h8a; const unsigned char* h8b; const bf16_t* ycat; const bf16_t* WinT; const bf16_t* WbrT; int G, c;
    __device__ __forceinline__ bool next(int i, pg8::Unit& u) const {
        const int tile = (i >> 3) * G + c; if (tile >= (T_ / 256) * 4) return false;
        const int j = i & 7, b = j >> 1; tile_map(tile, T_ / 256, 4, u.pm, u.pn); u.aux = b;
        if (!(j & 1)) { u.kind = 0; u.nt = 4; u.f8 = 0; u.a = (const char*)(ycat + (size_t)u.pm * 256 * 1024 + 256 * b); u.b = (const char*)(WbrT + (size_t)u.pn * 256 * 1024 + 256 * b); }
        else { u.kind = 1; u.nt = 8; u.f8 = 1; const int m0 = u.pm * 256;
            u.a = (const char*)(m0 < H8_SPLIT ? h8a + (size_t)m0 * 1024 : h8b + (size_t)(m0 - H8_SPLIT) * 1024); u.b = (const char*)(WinT + (size_t)(WIN_GATE + 1024 * b + 256 * u.pn) * 1024); }
        return true; } };
struct EpiC { u32x2* stash; bf16_t* merged; const float* gsc; unsigned char* m8;
    __device__ __forceinline__ void operator()(const f32x4 (&acc)[2][2][4][2], const pg8::Unit& u, int wr, int wc, int fr, int fq, int tid) const {
        OPAQUE(tid);
        if (u.kind == 0) {
#pragma unroll
            for (int ai = 0; ai < 2; ++ai)
#pragma unroll
                for (int m = 0; m < 4; ++m)
#pragma unroll
                    for (int bj = 0; bj < 2; ++bj) { const f32x4 v0 = acc[ai][bj][m][0], v1 = acc[ai][bj][m][1];
                        u32x2 w; w.x = cvt_pk_fp8_f32_(v0[0], v0[1], 0u, false); w.x = cvt_pk_fp8_f32_(v0[2], v0[3], w.x, true); w.y = cvt_pk_fp8_f32_(v1[0], v1[1], 0u, false); w.y = cvt_pk_fp8_f32_(v1[2], v1[3], w.y, true);
                        stash[((ai * 4 + m) * 2 + bj) * 512 + tid] = w; }
        } else {
            int row0 = u.pm * 256 + wr * 64 + fr, col0 = u.pn * 256 + wc * 32 + 8 * fq; OPAQUE(row0); OPAQUE(col0); const bool first = (u.aux == 0);
            f32x4 sc[2][2];
#pragma unroll
            for (int bj = 0; bj < 2; ++bj) { const float* sp = gsc + 1024 * u.aux + col0 + bj * 128; sc[bj][0] = *(const f32x4*)sp; sc[bj][1] = *(const f32x4*)(sp + 4); }
#pragma unroll
            for (int ai = 0; ai < 2; ++ai)
#pragma unroll
                for (int mp = 0; mp < 2; ++mp) { u32x2 y[4]; u32x4 mo[4];
#pragma unroll
                    for (int q = 0; q < 4; ++q) { const int m = 2 * mp + (q >> 1), bj = q & 1;
                        y[q] = stash[((ai * 4 + m) * 2 + bj) * 512 + tid]; mo[q] = (u32x4){0u, 0u, 0u, 0u};
                        if (!first) mo[q] = *(const u32x4*)(merged + (size_t)(row0 + ai * 128 + m * 16) * 1024 + col0 + bj * 128); }
#pragma unroll
                    for (int q = 0; q < 4; ++q) { const int m = 2 * mp + (q >> 1), bj = q & 1; const f32x4 g0 = acc[ai][bj][m][0] * sc[bj][0], g1 = acc[ai][bj][m][1] * sc[bj][1];
                        bf16_t* ptr = merged + (size_t)(row0 + ai * 128 + m * 16) * 1024 + col0 + bj * 128;
                        const f32x2 ya = cvt_pk_f32_fp8_(y[q].x, false), yb = cvt_pk_f32_fp8_(y[q].x, true), yc = cvt_pk_f32_fp8_(y[q].y, false), yd = cvt_pk_f32_fp8_(y[q].y, true);
                        const float o0 = ya.x * sigmoidf_(g0[0]) + bflo(mo[q].x), o1 = ya.y * sigmoidf_(g0[1]) + bfhi(mo[q].x), o2 = yb.x * sigmoidf_(g0[2]) + bflo(mo[q].y), o3 = yb.y * sigmoidf_(g0[3]) + bfhi(mo[q].y);
                        const float o4 = yc.x * sigmoidf_(g1[0]) + bflo(mo[q].z), o5 = yc.y * sigmoidf_(g1[1]) + bfhi(mo[q].z), o6 = yd.x * sigmoidf_(g1[2]) + bflo(mo[q].w), o7 = yd.y * sigmoidf_(g1[3]) + bfhi(mo[q].w);
                        u32x4 w; w.x = pk2(o0, o1); w.y = pk2(o2, o3); w.z = pk2(o4, o5); w.w = pk2(o6, o7);
                        if (u.aux != 3) *(u32x4*)ptr = w;
                        else { u32x2 w8; w8.x = cvt_pk_fp8_f32_(o0, o1, 0u, false); w8.x = cvt_pk_fp8_f32_(o2, o3, w8.x, true); w8.y = cvt_pk_fp8_f32_(o4, o5, 0u, false); w8.y = cvt_pk_fp8_f32_(o6, o7, w8.y, true);
                            *(u32x2*)(m8 + (size_t)(row0 + ai * 128 + m * 16) * 1024 + col0 + bj * 128) = w8; } }
                    MEMFENCE(); }
        }
    }
};
__device__ __forceinline__ void phase_C(const KP& p, int l, unsigned char* lds) {
    const Ptrs P = make_ptrs(p.ws, l);
    SchedC S{P.h8a, P.h8b, P.ycat, P.WinT, P.WbrT, GDIM(), BIDX()};
    EpiC E{(u32x2*)(P.stash + (size_t)BIDX() * 65536), P.merged, P.gsc, P.h8e};
    pg8::gemm_phase<2>((LAS unsigned char*)lds, 1024, 1024, S, E, 1024);
}
struct SchedD { const unsigned char* A8; const bf16_t* Bt; int nN, G, c;
    __device__ __forceinline__ bool next(int i, pg8::Unit& u) const {
        const int x = i * G + c; if (x >= (T_ / 256) * nN) return false;
        tile_map(x, T_ / 256, nN, u.pm, u.pn); u.nt = 8; u.kind = 0; u.aux = 0; u.f8 = 1; u.a = (const char*)(A8 + (size_t)u.pm * 256 * 1024); u.b = (const char*)(Bt + (size_t)u.pn * 256 * 1024); return true; } };
struct EpiResid { bf16_t* ob; const bf16_t* hb; const float* sc;
    __device__ __forceinline__ void operator()(const f32x4 (&acc)[2][2][4][2], const pg8::Unit& u, int wr, int wc, int fr, int fq, int tid) const {
        int row0 = u.pm * 256 + wr * 64 + fr, col0 = u.pn * 256 + wc * 32 + 8 * fq; OPAQUE(row0); OPAQUE(col0);
#pragma unroll
        for (int ai = 0; ai < 2; ++ai)
#pragma unroll
            for (int m = 0; m < 4; ++m)
#pragma unroll
                for (int bj = 0; bj < 2; ++bj) { const size_t o = (size_t)(row0 + ai * 128 + m * 16) * 1024 + col0 + bj * 128; const u32x4 hw = *(const u32x4*)(hb + o);
                    const f32x4 a0 = acc[ai][bj][m][0] * *(const f32x4*)(sc + col0 + bj * 128), a1 = acc[ai][bj][m][1] * *(const f32x4*)(sc + col0 + bj * 128 + 4); u32x4 w;
                    w.x = pk2(bflo(hw.x) * DN_ALPHA_ + a0[0], bfhi(hw.x) * DN_ALPHA_ + a0[1]); w.y = pk2(bflo(hw.y) * DN_ALPHA_ + a0[2], bfhi(hw.y) * DN_ALPHA_ + a0[3]);
                    w.z = pk2(bflo(hw.z) * DN_ALPHA_ + a1[0], bfhi(hw.z) * DN_ALPHA_ + a1[1]); w.w = pk2(bflo(hw.w) * DN_ALPHA_ + a1[2], bfhi(hw.w) * DN_ALPHA_ + a1[3]);
                    *(u32x4*)(ob + o) = w; }
    }
};
__device__ __forceinline__ void phase_D(const KP& p, int l, unsigned char* lds) {
    const Ptrs P = make_ptrs(p.ws, l);
    SchedD S{P.h8e, P.WoutT, 4, GDIM(), BIDX()};
    EpiResid E{P.ycat, P.hb, P.gsc + 5120};
    pg8::gemm_phase<1>((LAS unsigned char*)lds, 1024, 1024, S, E, 1024);
}
__device__ __forceinline__ void phase_D2(const KP& p, int l, unsigned char* lds) {
    const Ptrs P = make_ptrs(p.ws, l);
    const int tid = TIDX(), lane = tid & 63, wave = tid >> 6; const int gw = BIDX() * NWAVE + wave, NGW = GDIM() * NWAVE;
    for (int m = 4 * gw; m < T_; m += 4 * NGW) ln_rows<4, true>(P.ycat + (size_t)m * 1024, p.in[I_LN1G] + l * 1024, p.in[I_LN1B] + l * 1024, (float*)nullptr, P.hb + (size_t)m * 1024, P.h8e + (size_t)m * 1024, lane);
}
struct SchedE1 { const bf16_t* pb; const bf16_t* PleT; int G, c;
    __device__ __forceinline__ bool next(int i, pg8::Unit& u) const {
        const int x = i * G + c; if (x >= (T_ / 256) * 4) return false;
        tile_map(x, T_ / 256, 4, u.pm, u.pn); u.nt = 4; u.kind = 0; u.aux = 0; u.f8 = 0; u.a = (const char*)(pb + (size_t)u.pm * 256 * 256); u.b = (const char*)(PleT + (size_t)u.pn * 256 * 256); return true; } };
template <int PART>
struct SchedE2 { const bf16_t* hb; const unsigned char* h8e; const bf16_t* PleGT; const bf16_t* WqT; int G, c;
    __device__ __forceinline__ bool next(int i, pg8::Unit& u) const {
        const int n0 = (T_ / 256) * 4; int x = i * G + c + (PART ? n0 : 0); if (x >= (PART ? n0 + (T_ / 256) * 8 : n0)) return false;
        u.aux = 0;
        if (x < n0) { tile_map(x, T_ / 256, 4, u.pm, u.pn); u.kind = 0; u.nt = 8; u.f8 = 1; u.b = (const char*)(PleGT + (size_t)u.pn * 256 * 1024); u.a = (const char*)(h8e + (size_t)u.pm * 256 * 1024); }
        else { x -= n0; tile_map(x, T_ / 256, 8, u.pm, u.pn); u.kind = 1; u.nt = 16; u.f8 = 0; u.b = (const char*)(WqT + (size_t)u.pn * 256 * 1024); u.a = (const char*)(hb + (size_t)u.pm * 256 * 1024); }
        return true; } };
struct EpiE2g { const bf16_t* hb; bf16_t* Pbuf; const float* gsc;
    __device__ __forceinline__ void operator()(const f32x4 (&acc)[2][2][4][2], const pg8::Unit& u, int wr, int wc, int fr, int fq, int tid) const {
        int row0 = u.pm * 256 + wr * 64 + fr, col0 = u.pn * 256 + wc * 32 + 8 * fq; OPAQUE(row0); OPAQUE(col0);
#pragma unroll
        for (int bj = 0; bj < 2; ++bj) { const float* sp = gsc + 4096 + col0 + bj * 128; const f32x4 s0 = *(const f32x4*)sp, s1 = *(const f32x4*)(sp + 4);
            const size_t cb = (size_t)row0 * 1024 + col0 + bj * 128; const bf16_t* hp = hb + cb; bf16_t* pp = Pbuf + cb;
#pragma unroll
            for (int ai = 0; ai < 2; ++ai)
#pragma unroll
                for (int mp = 0; mp < 2; ++mp) { u32x4 y[2], hw[2];
#pragma unroll
                    for (int q = 0; q < 2; ++q) { const int ro = (ai * 128 + (2 * mp + q) * 16) * 1024; y[q] = *(const u32x4*)(pp + ro); hw[q] = *(const u32x4*)(hp + ro); }
#pragma unroll
                    for (int q = 0; q < 2; ++q) { const int m = 2 * mp + q; const int ro = (ai * 128 + m * 16) * 1024; const f32x4 v0 = acc[ai][bj][m][0] * s0, v1 = acc[ai][bj][m][1] * s1;
                        u32x4 w;
                        w.x = pk2(bflo(hw[q].x) * DN_ALPHA_ + bflo(y[q].x) * sigmoidf_(v0[0]), bfhi(hw[q].x) * DN_ALPHA_ + bfhi(y[q].x) * sigmoidf_(v0[1]));
                        w.y = pk2(bflo(hw[q].y) * DN_ALPHA_ + bflo(y[q].y) * sigmoidf_(v0[2]), bfhi(hw[q].y) * DN_ALPHA_ + bfhi(y[q].y) * sigmoidf_(v0[3]));
                        w.z = pk2(bflo(hw[q].z) * DN_ALPHA_ + bflo(y[q].z) * sigmoidf_(v1[0]), bfhi(hw[q].z) * DN_ALPHA_ + bfhi(y[q].z) * sigmoidf_(v1[1]));
                        w.w = pk2(bflo(hw[q].w) * DN_ALPHA_ + bflo(y[q].w) * sigmoidf_(v1[2]), bfhi(hw[q].w) * DN_ALPHA_ + bfhi(y[q].w) * sigmoidf_(v1[3]));
                        *(u32x4*)(pp + ro) = w; }
                    MEMFENCE(); } }
    }
};
__device__ __forceinline__ void phase_E(const KP& p, int l, unsigned char* lds) {
    const Ptrs P = make_ptrs(p.ws, l);
    { SchedE1 S{P.pb, P.PleT, GDIM(), BIDX()}; EpiStoreBf16 E{P.ycat, 1024, P.ycat, 1024}; pg8::gemm_phase((LAS unsigned char*)lds, 256, 256, S, E); }
    { SchedE2<0> S{P.hb, P.h8e, P.PleGT, P.WqT, GDIM(), BIDX()}; EpiE2g E{P.hb, P.ycat, P.gsc}; pg8::gemm_phase<1>((LAS unsigned char*)lds, 1024, 1024, S, E, 1024); }
    { SchedE2<1> S{P.hb, P.h8e, P.PleGT, P.WqT, GDIM(), BIDX()}; EpiStoreBf16 E{P.q, 2048, P.q, 2048}; pg8::gemm_phase<0>((LAS unsigned char*)lds, 1024, 1024, S, E); }
}
__device__ __forceinline__ unsigned mono_key(float f) { const unsigned u = __builtin_bit_cast(unsigned, f); return (u & 0x80000000u) ? ~u : (u | 0x80000000u); }
__device__ __forceinline__ float unmono_key(unsigned k) { const unsigned u = (k & 0x80000000u) ? (k ^ 0x80000000u) : ~k; return __builtin_bit_cast(float, u); }
struct CandTab { int a[50], b[50]; };
constexpr CandTab make_cand() { CandTab t{}; int n = 0; for (int a = 0; a < 16; ++a) for (int b = 0; b < 16; ++b) if ((a + 1) * (b + 1) <= 16) { t.a[n] = a; t.b[n] = b; ++n; } return t; }
constexpr CandTab CAND = make_cand();
constexpr int PK_PITCH = 136;

#define PK_CE(x, y) do { const unsigned _a = (x), _b = (y); (x) = _a > _b ? _a : _b; (y) = _a > _b ? _b : _a; } while (0)
__device__ __forceinline__ void bitonic_merge16_desc(unsigned (&a)[16]) {
#pragma unroll
    for (int j = 8; j > 0; j >>= 1)
#pragma unroll
        for (int i = 0; i < 16; ++i) { const int l = i ^ j; if (l > i) PK_CE(a[i], a[l]); }
}
__device__ __forceinline__ void bitonic_sort16_desc(unsigned (&a)[16]) {
#pragma unroll
    for (int k = 2; k <= 16; k <<= 1)
#pragma unroll
        for (int j = k >> 1; j > 0; j >>= 1)
#pragma unroll
            for (int i = 0; i < 16; ++i) { const int l = i ^ j; if (l > i) { if ((i & k) == 0 || k == 16) PK_CE(a[i], a[l]); else PK_CE(a[l], a[i]); } }
}
__device__ __forceinline__ void top_half_merge16(unsigned (&a)[16], const unsigned (&b)[16]) {
#pragma unroll
    for (int i = 0; i < 16; ++i) a[i] = a[i] > b[15 - i] ? a[i] : b[15 - i];
    bitonic_merge16_desc(a);
}
__device__ __forceinline__ void top16_keys(const unsigned (&key)[64], unsigned (&top)[16]) {
    unsigned g0[16], g1[16], g2[16], g3[16];
#pragma unroll
    for (int i = 0; i < 16; ++i) { g0[i] = key[i]; g1[i] = key[16 + i]; g2[i] = key[32 + i]; g3[i] = key[48 + i]; }
    bitonic_sort16_desc(g0); bitonic_sort16_desc(g1); bitonic_sort16_desc(g2); bitonic_sort16_desc(g3);
    top_half_merge16(g0, g1); top_half_merge16(g2, g3); top_half_merge16(g0, g2);
    unsigned pr[16];
#pragma unroll
    for (int i = 0; i < 16; ++i) pr[i] = (unsigned)__shfl_xor((int)g0[i], 32);
    top_half_merge16(g0, pr);
#pragma unroll
    for (int i = 0; i < 16; ++i) top[i] = g0[i];
}
__device__ __forceinline__ void peer_route_unit(const KP& p, const Ptrs& P, int l, int unit, unsigned char* lds) {
    const bf16_t* Ks = (const bf16_t*)lds;
    const int tid = TIDX(), lane = tid & 63, wave = tid >> 6, r32 = lane & 31, hi = lane >> 5;
    const int tok = unit * 32 + r32;
    int kbase = r32 * PK_PITCH + 8 * hi; OPAQUE(kbase);
    unsigned top1[16], top2[16];
#pragma unroll 1
    for (int half = 0; half < 2; ++half) {
        const bf16_t* qp = P.q + (size_t)tok * 2048 + wave * 256 + half * 128 + 8 * hi;
        bf16x8 qf[8];
#pragma unroll
        for (int ks = 0; ks < 8; ++ks) qf[ks] = *(const bf16x8*)(qp + 16 * ks);
        unsigned key[64];
#pragma unroll
        for (int kt = 0; kt < 4; ++kt) { f32x16 acc = {}; const bf16_t* kp = Ks + (half * 128 + 32 * kt) * PK_PITCH + kbase;
#pragma unroll
            for (int ks = 0; ks < 8; ++ks) { const bf16x8 a = *(const bf16x8*)(kp + 16 * ks); acc = MFMA32(a, qf[ks], acc); }
#pragma unroll
            for (int r = 0; r < 16; ++r) { const int idx = 32 * kt + (r & 3) + 8 * (r >> 2) + 4 * hi; key[16 * kt + r] = (mono_key(acc[r]) & ~127u) | (unsigned)(127 - idx); } }
        if (half == 0) top16_keys(key, top1); else top16_keys(key, top2);
        MEMFENCE();
    }
    MEMFENCE();
    int* islot = (int*)(lds + 2 * 128 * PK_PITCH * 2) + (wave * 32 + r32) * 33;
    float v1[16], v2[16];
#pragma unroll
    for (int r = 0; r < 16; ++r) { v1[r] = unmono_key(top1[r] & ~127u); v2[r] = unmono_key(top2[r] & ~127u); islot[16 * hi + r] = 127 - (int)((hi ? top2[r] : top1[r]) & 127u); }
    unsigned ka[16], kb[16];
#pragma unroll
    for (int i = 0; i < 25; ++i) { const int c0 = 2 * i, c1 = 2 * i + 1;
        const float s = hi ? (v1[CAND.a[c1]] + v2[CAND.b[c1]]) : (v1[CAND.a[c0]] + v2[CAND.b[c0]]);
        const unsigned k = (mono_key(s) & ~255u) | (unsigned)(255 - (hi ? 16 * CAND.a[c1] + CAND.b[c1] : 16 * CAND.a[c0] + CAND.b[c0]));
        if (i < 16) ka[i] = k; else kb[i - 16] = k; }
#pragma unroll
    for (int i = 9; i < 16; ++i) kb[i] = 0u;
    bitonic_sort16_desc(ka); bitonic_sort16_desc(kb); top_half_merge16(ka, kb);
    { unsigned pr[16];
#pragma unroll
      for (int i = 0; i < 16; ++i) pr[i] = (unsigned)__shfl_xor((int)ka[i], 32);
      top_half_merge16(ka, pr); }
    WAVE_SYNC();
    float sc[16]; int se[16];
#pragma unroll
    for (int r = 0; r < 16; ++r) { sc[r] = unmono_key(ka[r] & ~255u); se[r] = 0; }
#pragma unroll
    for (int r = 0; r < 8; ++r) { unsigned mlo = ka[r], mhi = ka[8 + r]; OPAQUE(mlo); OPAQUE(mhi);
        const unsigned m = hi ? mhi : mlo; const int ab = 255 - (int)(m & 255u); const int e = islot[ab >> 4] * 128 + islot[16 + (ab & 15)];
        if (hi) se[8 + r] = e; else se[r] = e; }
    WAVE_SYNC();
    float g[16]; float sum = 0.f;
#pragma unroll
    for (int r = 0; r < 16; ++r) { g[r] = __expf(sc[r] - sc[0]); sum += g[r]; }
    const float inv = 1.0f / sum;
    const size_t ob = (size_t)tok * 128 + wave * 16 + 8 * hi;
    if (hi == 0) {
        *(u32x4*)(P.eid + ob) = (u32x4){(unsigned)se[0], (unsigned)se[1], (unsigned)se[2], (unsigned)se[3]}; *(u32x4*)(P.eid + ob + 4) = (u32x4){(unsigned)se[4], (unsigned)se[5], (unsigned)se[6], (unsigned)se[7]};
        *(f32x4*)(P.gate + ob) = (f32x4){g[0] * inv, g[1] * inv, g[2] * inv, g[3] * inv}; *(f32x4*)(P.gate + ob + 4) = (f32x4){g[4] * inv, g[5] * inv, g[6] * inv, g[7] * inv};
    } else {
        *(u32x4*)(P.eid + ob) = (u32x4){(unsigned)se[8], (unsigned)se[9], (unsigned)se[10], (unsigned)se[11]}; *(u32x4*)(P.eid + ob + 4) = (u32x4){(unsigned)se[12], (unsigned)se[13], (unsigned)se[14], (unsigned)se[15]};
        *(f32x4*)(P.gate + ob) = (f32x4){g[8] * inv, g[9] * inv, g[10] * inv, g[11] * inv}; *(f32x4*)(P.gate + ob + 4) = (f32x4){g[12] * inv, g[13] * inv, g[14] * inv, g[15] * inv};
    }
}
__device__ __forceinline__ void phase_F(const KP& p, int l, unsigned char* lds) {
    const Ptrs P = make_ptrs(p.ws, l);
    bf16_t* Ks = (bf16_t*)lds; const int tid = TIDX();
    for (int e = tid; e < 2 * 128 * 16; e += NTHR) { const int row = e >> 4, ch = e & 15; *(u32x4*)(Ks + row * PK_PITCH + ch * 8) = *(const u32x4*)(P.K12 + row * 128 + ch * 8); }
    __syncthreads();
    for (int u = BIDX(); u < T_ / 32; u += GDIM()) peer_route_unit(p, P, l, u, lds);
    __syncthreads();
}
constexpr int PG_TB = (T_ >= 4096 ? 128 : 64), PG_NBLK = T_ / PG_TB;
__device__ __forceinline__ int peer_next_item(unsigned* cnt, int* slot, int tid) {
    __syncthreads();
    if (tid == 0) *slot = (int)atomicAdd(cnt, 1u);
    __syncthreads();
    return *slot;
}
constexpr int PG_TPW = PG_TB / NWAVE;
static_assert(PG_TPW >= 4 && PG_TPW % 2 == 0, "token pipeline depth");
constexpr int PG_WLDS = 6144;
__device__ __forceinline__ void pg_issue_rows(const unsigned char* T8, int x, int c8, int gq, int lane, int e0, int e1, int* E, u32x4 (&rb)[16]) {
    WAVE_SYNC(); E[lane] = e0; E[64 + lane] = e1; WAVE_SYNC();
#pragma unroll
    for (int k = 0; k < 16; ++k) { const unsigned off = ((unsigned)(x * NEXP) + (unsigned)E[gq + 8 * k]) * 128u + 16u * (unsigned)c8; rb[k] = *(const u32x4*)(T8 + off); }
}
template <bool REFILL, int TAG>
__device__ __forceinline__ void pg_dots_compute(const Ptrs& P, int x, int t, u32x4 (&ub)[16], u32x4 xa, u32x4 xb, float* R, const int* E, int c8, int gq, int lane) {
    const f32x2 x0 = (f32x2){bflo(xa.x), bfhi(xa.x)}, x1 = (f32x2){bflo(xa.y), bfhi(xa.y)}, x2 = (f32x2){bflo(xa.z), bfhi(xa.z)}, x3 = (f32x2){bflo(xa.w), bfhi(xa.w)};
    const f32x2 x4 = (f32x2){bflo(xb.x), bfhi(xb.x)}, x5 = (f32x2){bflo(xb.y), bfhi(xb.y)}, x6 = (f32x2){bflo(xb.z), bfhi(xb.z)}, x7 = (f32x2){bflo(xb.w), bfhi(xb.w)};
    WAVE_SYNC();
    unsigned off[8];
    const unsigned char* ubase = P.U8;
#pragma unroll
    for (int k = 0; k < 16; ++k) { PIN1(ub[k]);
        if (REFILL && (k & 7) == 0) {
#pragma unroll
            for (int j = 0; j < 8; ++j) off[j] = ((unsigned)(x * NEXP) + (unsigned)E[gq + 8 * (k + j)]) * 128u + 16u * (unsigned)c8; }
        f32x2 s = cvt_pk_f32_fp8_(ub[k][0], false) * x0; s += cvt_pk_f32_fp8_(ub[k][0], true) * x1; s += cvt_pk_f32_fp8_(ub[k][1], false) * x2; s += cvt_pk_f32_fp8_(ub[k][1], true) * x3;
        s += cvt_pk_f32_fp8_(ub[k][2], false) * x4; s += cvt_pk_f32_fp8_(ub[k][2], true) * x5; s += cvt_pk_f32_fp8_(ub[k][3], false) * x6; s += cvt_pk_f32_fp8_(ub[k][3], true) * x7;
        R[k * 64 + lane] = s.x + s.y;
        if (REFILL) { GLOAD16_RW_S(ub[k], ubase, off[k & 7]); }
        if (TAG) TAG_B(); else TAG_A();
        SCHED_FENCE(); }
    WAVE_SYNC();
    const f32x4 a0 = *(const f32x4*)(R + 8 * lane), a1 = *(const f32x4*)(R + 8 * lane + 4), b0 = *(const f32x4*)(R + 512 + 8 * lane), b1 = *(const f32x4*)(R + 512 + 8 * lane + 4);
    float* pd = P.pd + ((size_t)x * T_ + t) * 128;
    pd[lane] = ((a0[0] + a0[1]) + (a0[2] + a0[3])) + ((a1[0] + a1[1]) + (a1[2] + a1[3]));
    pd[64 + lane] = ((b0[0] + b0[1]) + (b0[2] + b0[3])) + ((b1[0] + b1[1]) + (b1[2] + b1[3]));
}
#define PG_PIN16(v) do { _Pragma("unroll") for (int _k = 0; _k < 16; ++_k) PIN1(v[_k]); } while (0)
__device__ __forceinline__ void peer_dots_item(const Ptrs& P, int x, int blk, unsigned char* lds, int lane, int wave) {
    float* R = (float*)(lds + wave * PG_WLDS); int* E = (int*)(lds + wave * PG_WLDS + 4096);
    const int gq = lane >> 3, c8 = lane & 7, tb = blk * PG_TB + PG_TPW * wave;
    u32x4 uA[16], uB[16], xa0, xb0, xa1, xb1;
    const bf16_t* hbase = P.hb; const int* ebase = P.eid; const unsigned char* ubase = P.U8;
    const unsigned xo = (unsigned)((tb * 1024 + 128 * x + 16 * c8) * 2), eo = (unsigned)((tb * 128 + lane) * 4);
    int ea0, ea1, eb0, eb1;
    { const int* ep = P.eid + (size_t)tb * 128 + lane; ea0 = ep[0]; ea1 = ep[64]; eb0 = ep[128]; eb1 = ep[192]; }
    WAVE_SYNC(); E[lane] = ea0; E[64 + lane] = ea1; WAVE_SYNC();
#pragma unroll
    for (int k = 0; k < 16; ++k) { const unsigned off = ((unsigned)(x * NEXP) + (unsigned)E[gq + 8 * k]) * 128u + 16u * (unsigned)c8; GLOAD16_S(uA[k], ubase, off); }
    GLOAD16_S(xa0, hbase, xo); GLOAD16_S(xb0, hbase, xo + 16u); GLOAD4_S(ea0, ebase, eo + 2u * 512u); GLOAD4_S(ea1, ebase, eo + 2u * 512u + 256u);
    WAVE_SYNC(); E[lane] = eb0; E[64 + lane] = eb1; WAVE_SYNC();
#pragma unroll
    for (int k = 0; k < 16; ++k) { const unsigned off = ((unsigned)(x * NEXP) + (unsigned)E[gq + 8 * k]) * 128u + 16u * (unsigned)c8; GLOAD16_S(uB[k], ubase, off); }
    GLOAD16_S(xa1, hbase, xo + 2048u); GLOAD16_S(xb1, hbase, xo + 2048u + 16u); GLOAD4_S(eb0, ebase, eo + 3u * 512u); GLOAD4_S(eb1, ebase, eo + 3u * 512u + 256u);
#pragma unroll
    for (int i = 0; i < PG_TPW; i += 2) {
        if (i == 0) WAIT_VM(20); else WAIT_VM(22);
        PIN4(xa0, xb0, ea0, ea1);
        if (i + 2 < PG_TPW) { WAVE_SYNC(); E[lane] = ea0; E[64 + lane] = ea1; WAVE_SYNC();
            pg_dots_compute<true, 0>(P, x, tb + i, uA, xa0, xb0, R, E, c8, gq, lane);
            const unsigned nx = (unsigned)((i + 4 < PG_TPW) ? i + 4 : PG_TPW - 1), xo2 = xo + (unsigned)(i + 2) * 2048u;
            GLOAD16_S(xa0, hbase, xo2); GLOAD16_S(xb0, hbase, xo2 + 16u); GLOAD4_S(ea0, ebase, eo + nx * 512u); GLOAD4_S(ea1, ebase, eo + nx * 512u + 256u); }
        else pg_dots_compute<false, 0>(P, x, tb + i, uA, xa0, xb0, R, E, c8, gq, lane);
        if (i + 2 < PG_TPW) WAIT_VM(22); else WAIT_VM(0);
        PIN4(xa1, xb1, eb0, eb1);
        if (i + 3 < PG_TPW) { WAVE_SYNC(); E[lane] = eb0; E[64 + lane] = eb1; WAVE_SYNC();
            pg_dots_compute<true, 1>(P, x, tb + i + 1, uB, xa1, xb1, R, E, c8, gq, lane);
            const unsigned nx = (unsigned)((i + 5 < PG_TPW) ? i + 5 : PG_TPW - 1), xo2 = xo + (unsigned)(i + 3) * 2048u;
            GLOAD16_S(xa1, hbase, xo2); GLOAD16_S(xb1, hbase, xo2 + 16u); GLOAD4_S(eb0, ebase, eo + nx * 512u); GLOAD4_S(eb1, ebase, eo + nx * 512u + 256u); }
        else pg_dots_compute<false, 1>(P, x, tb + i + 1, uB, xa1, xb1, R, E, c8, gq, lane);
    }
}
template <bool REFILL, int TAG>
__device__ __forceinline__ void pg_acc_compute(const Ptrs& P, bf16_t* outp, int x, int t, u32x4 (&vb)[16], float w0, float w1, unsigned oprev, float* C, float* W, const int* E, int c8, int gq, int lane) {
    WAVE_SYNC(); W[lane] = w0; W[64 + lane] = w1; WAVE_SYNC();
    f32x2 acc[8];
#pragma unroll
    for (int q = 0; q < 8; ++q) acc[q] = (f32x2){0.f, 0.f};
    unsigned off[8]; const unsigned char* vbase = P.V8; float wk[16];
#pragma unroll
    for (int k = 0; k < 16; ++k) wk[k] = W[gq + 8 * k];
#pragma unroll
    for (int k = 0; k < 16; ++k) { PIN1(vb[k]);
        if (REFILL && (k & 7) == 0) {
#pragma unroll
            for (int j = 0; j < 8; ++j) off[j] = ((unsigned)(x * NEXP) + (unsigned)E[gq + 8 * (k + j)]) * 128u + 16u * (unsigned)c8; }
#pragma unroll
        for (int q = 0; q < 4; ++q) { acc[2 * q] += cvt_pk_f32_fp8_(vb[k][q], false) * wk[k]; acc[2 * q + 1] += cvt_pk_f32_fp8_(vb[k][q], true) * wk[k]; }
        if (REFILL) {
#pragma unroll
            for (int q = 0; q < 8; ++q) PIN1(acc[q]);
            GLOAD16_RW_S(vb[k], vbase, off[k & 7]); }
        if (TAG) TAG_B(); else TAG_A();
        SCHED_FENCE(); }
    WAVE_SYNC();
#pragma unroll
    for (int q = 0; q < 4; ++q) *(f32x4*)(C + lane * 16 + 4 * q) = (f32x4){acc[2 * q].x, acc[2 * q].y, acc[2 * q + 1].x, acc[2 * q + 1].y};
    WAVE_SYNC();
    f32x2 s = (f32x2){0.f, 0.f};
#pragma unroll
    for (int g = 0; g < 8; ++g) s += *(const f32x2*)(C + g * 128 + 2 * lane);
    *(unsigned*)(outp + (size_t)t * 1024 + 128 * x + 2 * lane) = pk2(bflo(oprev) + s.x, bfhi(oprev) + s.y);
}
__device__ __forceinline__ void peer_acc_item(bf16_t* outp, const Ptrs& P, int x, int blk, unsigned char* lds, int lane, int wave) {
    float* C = (float*)(lds + wave * PG_WLDS); int* E = (int*)(lds + wave * PG_WLDS + 4096); float* W = (float*)(lds + wave * PG_WLDS + 4608);
    const int gq = lane >> 3, c8 = lane & 7, tb = blk * PG_TB + PG_TPW * wave;
    u32x4 vA[16], vB[16]; unsigned oA, oB; float wa0, wa1, wb0, wb1; int ea0, ea1, eb0, eb1;
    const int* ebase = P.eid; const float* wbase = P.gate; const bf16_t* obase = outp; const unsigned char* vbase = P.V8;
    const unsigned eo = (unsigned)((tb * 128 + lane) * 4), oo = (unsigned)((tb * 1024 + 128 * x + 2 * lane) * 2);
    { const int* ep = P.eid + (size_t)tb * 128 + lane; ea0 = ep[0]; ea1 = ep[64]; eb0 = ep[128]; eb1 = ep[192]; }
    WAVE_SYNC(); E[lane] = ea0; E[64 + lane] = ea1; WAVE_SYNC();
#pragma unroll
    for (int k = 0; k < 16; ++k) { const unsigned off = ((unsigned)(x * NEXP) + (unsigned)E[gq + 8 * k]) * 128u + 16u * (unsigned)c8; GLOAD16_S(vA[k], vbase, off); }
    GLOAD4_S(wa0, wbase, eo); GLOAD4_S(wa1, wbase, eo + 256u); GLOAD4_S(oA, obase, oo); GLOAD4_S(ea0, ebase, eo + 2u * 512u); GLOAD4_S(ea1, ebase, eo + 2u * 512u + 256u);
    WAVE_SYNC(); E[lane] = eb0; E[64 + lane] = eb1; WAVE_SYNC();
#pragma unroll
    for (int k = 0; k < 16; ++k) { const unsigned off = ((unsigned)(x * NEXP) + (unsigned)E[gq + 8 * k]) * 128u + 16u * (unsigned)c8; GLOAD16_S(vB[k], vbase, off); }
    GLOAD4_S(wb0, wbase, eo + 512u); GLOAD4_S(wb1, wbase, eo + 512u + 256u); GLOAD4_S(oB, obase, oo + 2048u); GLOAD4_S(eb0, ebase, eo + 3u * 512u); GLOAD4_S(eb1, ebase, eo + 3u * 512u + 256u);
#pragma unroll
    for (int i = 0; i < PG_TPW; i += 2) {
        if (i == 0) WAIT_VM(21); else WAIT_VM(22);
        PIN4(wa0, wa1, ea0, ea1); PIN1(oA);
        if (i + 2 < PG_TPW) { WAVE_SYNC(); E[lane] = ea0; E[64 + lane] = ea1; WAVE_SYNC();
            pg_acc_compute<true, 0>(P, outp, x, tb + i, vA, wa0, wa1, oA, C, W, E, c8, gq, lane);
            const unsigned nx = (unsigned)((i + 4 < PG_TPW) ? i + 4 : PG_TPW - 1);
            GLOAD4_S(wa0, wbase, eo + (unsigned)(i + 2) * 512u); GLOAD4_S(wa1, wbase, eo + (unsigned)(i + 2) * 512u + 256u); GLOAD4_S(oA, obase, oo + (unsigned)(i + 2) * 2048u);
            GLOAD4_S(ea0, ebase, eo + nx * 512u); GLOAD4_S(ea1, ebase, eo + nx * 512u + 256u); }
        else pg_acc_compute<false, 0>(P, outp, x, tb + i, vA, wa0, wa1, oA, C, W, E, c8, gq, lane);
        if (i + 2 < PG_TPW) WAIT_VM(22); else WAIT_VM(0);
        PIN4(wb0, wb1, eb0, eb1); PIN1(oB);
        if (i + 3 < PG_TPW) { WAVE_SYNC(); E[lane] = eb0; E[64 + lane] = eb1; WAVE_SYNC();
            pg_acc_compute<true, 1>(P, outp, x, tb + i + 1, vB, wb0, wb1, oB, C, W, E, c8, gq, lane);
            const unsigned nx = (unsigned)((i + 5 < PG_TPW) ? i + 5 : PG_TPW - 1);
            GLOAD4_S(wb0, wbase, eo + (unsigned)(i + 3) * 512u); GLOAD4_S(wb1, wbase, eo + (unsigned)(i + 3) * 512u + 256u); GLOAD4_S(oB, obase, oo + (unsigned)(i + 3) * 2048u);
            GLOAD4_S(eb0, ebase, eo + nx * 512u); GLOAD4_S(eb1, ebase, eo + nx * 512u + 256u); }
        else pg_acc_compute<false, 1>(P, outp, x, tb + i + 1, vB, wb0, wb1, oB, C, W, E, c8, gq, lane);
    }
}
template <int STAGE, int CSET = STAGE>
__device__ __forceinline__ void phase_G12(const KP& p, int l, unsigned char* lds) {
    const Ptrs P = make_ptrs(p.ws, l);
    const int tid = TIDX(), lane = tid & 63, wave = tid >> 6;
    int* slot = (int*)(lds + 8 * PG_WLDS);
    const int myx = XCC_ID();
    for (int s = 0; s < 8; ++s) { const int x = (myx + s) & 7; unsigned* cnt = P.qcnt + (CSET * 8 + x) * 16;
        for (;;) { const int blk = peer_next_item(cnt, slot, tid); if (blk >= PG_NBLK) break;
            if (STAGE == 0) peer_dots_item(P, x, blk, lds, lane, wave); else peer_acc_item(CSET == 3 ? (bf16_t*)P.pd : P.ycat, P, x, blk, lds, lane, wave); } }
    __syncthreads();
}
__device__ __forceinline__ void phase_G1b(const KP& p, int l, unsigned char* lds) {
    const Ptrs P = make_ptrs(p.ws, l);
    const size_t stride = (size_t)GDIM() * NTHR, n = (size_t)T_ * 128;
    for (size_t i0 = (size_t)BIDX() * NTHR + TIDX(); i0 < n; i0 += 4 * stride) { float d[4], gt[4], su[4], sv[4]; int e[4];
#pragma unroll
        for (int q = 0; q < 4; ++q) { const size_t i = i0 + q * stride; e[q] = 0; gt[q] = 0.f; d[q] = 0.f; if (i < n) { e[q] = P.eid[i]; gt[q] = P.gate[i]; } }
#pragma unroll
        for (int q = 0; q < 4; ++q) { const size_t i = i0 + q * stride; su[q] = P.su[e[q]]; sv[q] = P.sv[e[q]];
            if (i < n) {
#pragma unroll
                for (int x = 0; x < 8; ++x) d[q] += P.pd[(size_t)x * T_ * 128 + i]; } }
#pragma unroll
        for (int q = 0; q < 4; ++q) { const size_t i = i0 + q * stride; if (i < n) P.gate[i] = gt[q] * sv[q] * gelu_erf(d[q] * su[q]); } }
#ifdef CPU_EMU
    (void)lds;
#endif
}
__device__ __forceinline__ void phase_G3(const KP& p, int l, unsigned char* lds, bool last) {
    const Ptrs P = make_ptrs(p.ws, l);
    const int tid = TIDX(), lane = tid & 63, wave = tid >> 6; const int gw = BIDX() * NWAVE + wave, NGW = GDIM() * NWAVE;
    for (int m = 4 * gw; m < T_; m += 4 * NGW) ln_rows<4, true>(P.ycat + (size_t)m * 1024, p.in[I_LN2G] + l * 1024, p.in[I_LN2B] + l * 1024, last ? p.out + (size_t)m * 1024 : (float*)nullptr, last ? (bf16_t*)nullptr : P.hb + (size_t)m * 1024,
                                                           last ? (unsigned char*)nullptr : (m < H8_SPLIT ? P.h8a + (size_t)m * 1024 : P.h8b + (size_t)(m - H8_SPLIT) * 1024), lane);
}
#ifndef PROBE_REPEAT
#define PROBE_REPEAT 0
#endif
constexpr int LDS_BYTES = 147456;
__device__ __forceinline__ void phase_B1(const KP& p, int l, unsigned char* lds) {
    const Ptrs P = make_ptrs(p.ws, l);
    constexpr int NRC = NB_ * 4 * RW_NCH, NS5 = NB_ * 16, NFX = NB_ * 4 * (S_ / 256), NCV = T_ / 64;
    const int G = GDIM(); int it = BIDX();
    for (; it < NRC; it += G) rw_chunk_unit(p, P, l, it, lds);
#if PROBE_REPEAT == 16
    for (int j = BIDX(); j < NRC; j += G) rw_chunk_unit(p, P, l, j, lds);
#endif
#if PROBE_REPEAT >= 161 && PROBE_REPEAT <= 163
    for (int j = BIDX(); j < NRC; j += G) { rw_chunk_unit<PROBE_REPEAT - 160>(p, P, l, j, lds); __syncthreads(); }
#endif
    for (; it < NRC + NFX; it += G) fox_unit(p, P, l, it - NRC, lds);
#if PROBE_REPEAT == 17
    for (int j = BIDX(); j < NFX; j += G) fox_unit(p, P, l, j, lds);
#endif
    for (; it < NRC + NFX + NS5; it += G) s5_unit(p, P, l, it - NRC - NFX, lds);
#if PROBE_REPEAT == 18
    for (int j = BIDX(); j < NS5; j += G) s5_unit(p, P, l, j, lds);
#endif
    for (; it < NRC + NFX + NS5 + NCV; it += G) conv_unit(p, P, l, it - NRC - NFX - NS5, lds);
#if PROBE_REPEAT == 19
    for (int j = BIDX(); j < NCV; j += G) conv_unit(p, P, l, j, lds);
#endif
}
__device__ __forceinline__ void phase_B3(const KP& p, int l, unsigned char* lds) {
    const Ptrs P = make_ptrs(p.ws, l);
#if PROBE_REPEAT == 34
    for (int it = BIDX(); it < NB_ * 4 * RW_NCH; it += GDIM()) rw_out_unit<true>(p, P, l, it, lds);
#endif
    for (int it = BIDX(); it < NB_ * 4 * RW_NCH; it += GDIM()) rw_out_unit<false>(p, P, l, it, lds);
}
enum { PH_PRO = 0, PH_A, PH_B1, PH_B2, PH_B3, PH_C, PH_D, PH_D2, PH_E, PH_F, PH_G, PH_G1B, PH_G2, PH_G3, PH_N, PH_A0 };
__device__ __forceinline__ void run_phase(const KP& p, int ph, int l, unsigned char* lds) {
    switch (ph) {
        case PH_PRO: phase_prologue(p, lds); break;
        case PH_A: phase_A(p, l, lds); break;
        case PH_A0: phase_A0(p, lds); break;
        case PH_B1: phase_B1(p, l, lds); break;
        case PH_B2: phase_B2(p, l, lds); break;
        case PH_B3: phase_B3(p, l, lds); break;
        case PH_C: phase_C(p, l, lds); break;
        case PH_D: phase_D(p, l, lds); break;
        case PH_D2: phase_D2(p, l, lds); break;
        case PH_E: phase_E(p, l, lds); break;
        case PH_F: phase_F(p, l, lds); break;
        case PH_G: phase_G12<0>(p, l, lds); break;
        case PH_G1B: phase_G1b(p, l, lds); break;
        case PH_G2: phase_G12<1>(p, l, lds); break;
        case PH_G3: phase_G3(p, l, lds, l == L_ - 1); break;
        default: break;
    }
}
#ifndef CPU_EMU
#define XB_TMO      128
#define XB_XCNT(j)  (256  + 64 * (j))
#define XB_XSUB(j)  (1280 + 64 * (j))
#define XB_XGEN(j)  (2304 + 64 * (j))
#define XB_TOP      3328
#define XB_TOPGEN   3392
#define XCD_BAR_WORDS 3456
#define XB_SPIN_CAP (1u << 22)
__device__ __forceinline__ unsigned xb_ld(unsigned* p)              { return __hip_atomic_load(p, __ATOMIC_RELAXED, __HIP_MEMORY_SCOPE_AGENT); }
__device__ __forceinline__ unsigned xb_add(unsigned* p, unsigned v) { return __hip_atomic_fetch_add(p, v, __ATOMIC_RELAXED, __HIP_MEMORY_SCOPE_AGENT); }
__device__ __forceinline__ unsigned xb_xcc_id() { return (unsigned)__builtin_amdgcn_s_getreg((3 << 11) | 20) & 0xFu; }
#define XB_SPIN(cond, bar) do { unsigned _sp = 0; while (cond) { __builtin_amdgcn_s_sleep(1); \
    if ((++_sp & 255u) == 0u) { if (xb_ld(&(bar)[XB_TMO])) break; if (_sp > XB_SPIN_CAP) { atomicAdd(&(bar)[XB_TMO], 1u); break; } } } } while (0)
struct XcdBarrier { unsigned* bar; unsigned x; volatile LAS unsigned* st; };
__device__ __forceinline__ XcdBarrier xcd_barrier_post(unsigned* bar, volatile LAS unsigned* st) {
    XcdBarrier b; b.bar = bar; b.x = xb_xcc_id(); b.st = st;
    if (threadIdx.x == 0) (void)xb_add(&bar[XB_XCNT(b.x)], 1u);
    return b;
}
__device__ __forceinline__ void xcd_barrier_complete(unsigned* bar, unsigned x, unsigned& nloc, unsigned& nx) {
    const unsigned G = gridDim.x * gridDim.y * gridDim.z;
    unsigned sum, cnt, mine, sp = 0u;
    for (;;) {
        sum = 0u; cnt = 0u; mine = 0u;
#pragma unroll
        for (unsigned j = 0; j < 16; ++j) { const unsigned c = xb_ld(&bar[XB_XCNT(j)]); sum += c; cnt += (c > 0u) ? 1u : 0u; mine = (j == x) ? c : mine; }
        if (sum == G) break;
        __builtin_amdgcn_s_sleep(1);
        if ((++sp & 255u) == 0u) { if (xb_ld(&bar[XB_TMO])) break; if (sp > XB_SPIN_CAP) { atomicAdd(&bar[XB_TMO], 1u); break; } }
    }
    nloc = mine > 0u ? mine : 1u; nx = cnt > 0u ? cnt : 1u;
}
__device__ __forceinline__ void xcd_barrier(const XcdBarrier& b) {
    asm volatile("s_waitcnt vmcnt(0)" ::: "memory");
    __syncthreads();
    if (threadIdx.x == 0) {
        unsigned* bar = b.bar;
        __builtin_amdgcn_s_waitcnt(0);
        unsigned nloc = b.st[0], nx = b.st[1];
        if (nloc == 0u) { xcd_barrier_complete(bar, b.x, nloc, nx); b.st[0] = nloc; b.st[1] = nx; }
        const unsigned old = xb_add(&bar[XB_XSUB(b.x)], 1u);
        const unsigned gen = old / nloc;
        if (old + 1u == (gen + 1u) * nloc) {
            __builtin_amdgcn_fence(__ATOMIC_RELEASE, "agent");
            asm volatile("s_waitcnt vmcnt(0)" ::: "memory");
            const unsigned og = xb_add(&bar[XB_TOP], 1u);
            const unsigned tg = og / nx;
            if (og + 1u == (tg + 1u) * nx) xb_add(&bar[XB_TOPGEN], 1u);
            else XB_SPIN(xb_ld(&bar[XB_TOPGEN]) == tg, bar);
            __builtin_amdgcn_fence(__ATOMIC_ACQUIRE, "agent");
            xb_add(&bar[XB_XGEN(b.x)], 1u);
            asm volatile("s_waitcnt vmcnt(0)" ::: "memory");
        } else {
            XB_SPIN(xb_ld(&bar[XB_XGEN(b.x)]) == gen, bar);
            __builtin_amdgcn_fence(__ATOMIC_ACQUIRE, "agent");
            asm volatile("s_waitcnt vmcnt(0)" ::: "memory");
        }
    }
    __syncthreads();
}
#ifndef PROBE_REPEAT
#define PROBE_REPEAT 0
#endif
#ifndef N_LAUNCH_MODE
#define N_LAUNCH_MODE 1
#endif
extern __shared__ __attribute__((aligned(16))) unsigned char lds_dyn[];
#if N_LAUNCH_MODE == 0
template <int PH> __global__ void __launch_bounds__(NTHR, 2) k_phase_t(KP p) { run_phase(p, PH, p.layer, lds_dyn); }
typedef void (*kfn_t)(KP);
static kfn_t phase_fn(int ph) { switch (ph) { case PH_PRO: return k_phase_t<PH_PRO>; case PH_A: return k_phase_t<PH_A>; case PH_B1: return k_phase_t<PH_B1>; case PH_B2: return k_phase_t<PH_B2>; case PH_B3: return k_phase_t<PH_B3>; case PH_C: return k_phase_t<PH_C>;
    case PH_D: return k_phase_t<PH_D>; case PH_D2: return k_phase_t<PH_D2>; case PH_E: return k_phase_t<PH_E>; case PH_F: return k_phase_t<PH_F>; case PH_G: return k_phase_t<PH_G>; case PH_G1B: return k_phase_t<PH_G1B>; case PH_G2: return k_phase_t<PH_G2>; default: return k_phase_t<PH_G3>; } }
#else
#ifndef USE_XCD_BARRIER
#define USE_XCD_BARRIER 1
#endif
constexpr int BAR_LDS_OFF = LDS_BYTES - 64;
#if USE_XCD_BARRIER
#define GSYNC() xcd_barrier(bar)
#define GSYNC_ARG const XcdBarrier& bar
#else
#define GSYNC() grid.sync()
#define GSYNC_ARG cg::grid_group& grid
#endif
template <int l>
__device__ __forceinline__ void mega_layer(const KP& p, GSYNC_ARG) {
#if PROBE_REPEAT == 47 || PROBE_REPEAT == 48
        phase_Aprobe<PROBE_REPEAT - 40>(p, l, lds_dyn); GSYNC();
#endif
        phase_A(p, l, lds_dyn);
#if PROBE_REPEAT == 1
        GSYNC(); phase_A(p, l, lds_dyn);
#endif
#if PROBE_REPEAT >= 40 && PROBE_REPEAT <= 46
        GSYNC(); phase_Aprobe<PROBE_REPEAT - 40>(p, l, lds_dyn);
#endif
        GSYNC(); phase_B1(p, l, lds_dyn);
#if PROBE_REPEAT == 2
        GSYNC(); phase_B1(p, l, lds_dyn);
#endif
        GSYNC(); phase_B2(p, l, lds_dyn);
        GSYNC(); phase_B3(p, l, lds_dyn);
        GSYNC(); phase_C(p, l, lds_dyn);
#if PROBE_REPEAT == 4
        GSYNC(); phase_C(p, l, lds_dyn);
#endif
        GSYNC(); phase_D(p, l, lds_dyn);
        GSYNC(); phase_D2(p, l, lds_dyn);
        GSYNC(); phase_E(p, l, lds_dyn);
        GSYNC(); phase_F(p, l, lds_dyn);
#if PROBE_REPEAT == 8
        GSYNC(); phase_F(p, l, lds_dyn);
#endif
        GSYNC(); phase_G12<0>(p, l, lds_dyn);
#if PROBE_REPEAT == 32
        GSYNC(); phase_G12<0, 2>(p, l, lds_dyn);
#endif
        GSYNC(); phase_G1b(p, l, lds_dyn);
        GSYNC(); phase_G12<1>(p, l, lds_dyn);
#if PROBE_REPEAT == 33
        GSYNC(); phase_G12<1, 3>(p, l, lds_dyn);
#endif
        GSYNC(); phase_G3(p, l, lds_dyn, l == L_ - 1);
}
__global__ void __launch_bounds__(NTHR, 2) k_mega(KP p) {
    cg::grid_group grid = cg::this_grid();
#if USE_XCD_BARRIER
    volatile LAS unsigned* st = (volatile LAS unsigned*)(lds_dyn + BAR_LDS_OFF);
    if (threadIdx.x < 2) st[threadIdx.x] = 0u;
    __syncthreads();
    const XcdBarrier bar = xcd_barrier_post((unsigned*)(p.ws + WS_CTL) + 4096, st);
#define GSYNC_VAL bar
#else
#define GSYNC_VAL grid
#endif
    phase_prologue(p, lds_dyn);
#if PROBE_REPEAT == 60
    GSYNC(); phase_prologue(p, lds_dyn);
#endif
    grid.sync();
    phase_A0(p, lds_dyn);
    GSYNC();
    mega_layer<0>(p, GSYNC_VAL);
    static_assert(L_ == 2, "two layers");
    GSYNC();
    mega_layer<1>(p, GSYNC_VAL);
}
#endif
extern "C" void kernel_launch(void* const* d_in, const int* in_sizes, int n_in, void* d_out, int out_size, void* d_ws, size_t ws_size, hipStream_t stream) {
    static int grid = 0;
    if (grid == 0) {
        if (n_in != N_IN || out_size != T_ * 1024 || ws_size < WS_END) { fprintf(stderr, "kernel_launch: unexpected shapes (n_in %d out %d ws %zu need %zu)\n", n_in, out_size, ws_size, (size_t)WS_END); grid = -1; return; }
        int dev = 0, cus = 0, per_cu = 0;
        (void)hipGetDevice(&dev); (void)hipDeviceGetAttribute(&cus, hipDeviceAttributeMultiprocessorCount, dev);
#if N_LAUNCH_MODE == 0
        for (int ph = 0; ph < PH_N; ++ph) (void)hipFuncSetAttribute((const void*)phase_fn(ph), hipFuncAttributeMaxDynamicSharedMemorySize, LDS_BYTES);
        (void)per_cu;
#else
        (void)hipFuncSetAttribute((const void*)k_mega, hipFuncAttributeMaxDynamicSharedMemorySize, LDS_BYTES);
        (void)hipOccupancyMaxActiveBlocksPerMultiprocessor(&per_cu, (const void*)k_mega, NTHR, LDS_BYTES);
        if (per_cu < 1) { fprintf(stderr, "kernel_launch: occupancy query says %d blocks per CU\n", per_cu); grid = -1; return; }
#endif
        grid = cus;
    }
    if (grid < 0) return;
    if (hipMemsetAsync((char*)d_ws + WS_CTL, 0, 65536, stream) != hipSuccess) { fprintf(stderr, "kernel_launch: memset failed\n"); return; }
    KP p{};
    for (int i = 0; i < N_IN; ++i) p.in[i] = (const float*)d_in[i];
    p.out = (float*)d_out; p.ws = (unsigned char*)d_ws;
#if N_LAUNCH_MODE == 1
    void* args[] = {&p};
    hipError_t e = hipLaunchCooperativeKernel((const void*)k_mega, dim3(grid), dim3(NTHR), args, LDS_BYTES, stream);
    if (e != hipSuccess) fprintf(stderr, "cooperative launch failed: %s (grid %d)\n", hipGetErrorString(e), grid);
#else
    p.phase = PH_PRO; p.layer = 0; hipLaunchKernelGGL(phase_fn(PH_PRO), dim3(grid), dim3(NTHR), LDS_BYTES, stream, p);
    for (int l = 0; l < L_; ++l) for (int ph = PH_A; ph < PH_N; ++ph) { p.phase = ph; p.layer = l; hipLaunchKernelGGL(phase_fn(ph), dim3(grid), dim3(NTHR), LDS_BYTES, stream, p); }
#endif
}
#endif
```

```cpp
#ifdef CPU_EMU
#include "emu.h"
#define LAS
#define GET_LDS() ((unsigned char*)emu::lds())
#define AS_GLOBAL(p) (p)
#define AS_LDS(p) (p)
#define RFL(x) (x)
#define MFMA32(a, b, c) emu_mfma32(a, b, c)
#define MFMA16(a, b, c) emu_mfma16(a, b, c)
#define MFMA16_FP8(a, b, c) emu_mfma16_fp8(a, b, c)
#define FAST_EXP2(x) exp2f(x)
#define FAST_RCP(x) (1.0f / (x))
#define FAST_LOG2(x) log2f(x)
#define FAST_RSQ(x) (1.0f / sqrtf(x))
#define WAVE_SYNC() do { uint32_t _z = 0; (void)emu::wave_xchg(&_z, 1); } while (0)
#define OPAQUE(x) do {} while (0)
#define GLDS16(gp, lp, lane) memcpy((char*)(lp) + 16 * (lane), (const void*)(gp), 16)
#define WAIT_VM(n) do {} while (0)
#define GLOAD16_ASM(dst, ptr) (dst) = *(const u32x4*)(ptr)
#define GLOAD16_RW(dst, ptr) (dst) = *(const u32x4*)(ptr)
#define PIN1(a) do {} while (0)
#define GLOAD16_RW_S(dst, base, off) (dst) = *(const u32x4*)((const unsigned char*)(base) + (off))
#define SCHED_FENCE() do {} while (0)
#define TAG_A() do {} while (0)
#define TAG_B() do {} while (0)
#define GLOAD16_S(dst, base, off) (dst) = *(const u32x4*)((const unsigned char*)(base) + (off))
#define GLOAD4_S(dst, base, off) memcpy(&(dst), (const unsigned char*)(base) + (off), 4)
#define GLOAD4_ASM(dst, ptr) (dst) = *(const int*)(ptr)
#define PIN4(a, b, c, d) do {} while (0)
#define PIN2I(a, b) do {} while (0)
#define WAIT_LGKM0() do {} while (0)
#define READLANE_I(v, l) __shfl((int)(v), (l))
#define READLANE_F(v, l) __shfl((float)(v), (l))
#define TIDX() ((int)threadIdx.x)
#define XCC_ID() (emu::bid() & 7)
#define GDIM() ((int)gridDim.x)
#define BIDX() ((int)blockIdx.x)
#define OPAQUE_S(x) do {} while (0)
#define MEMFENCE() do {} while (0)
#else
#include <hip/hip_runtime.h>
#include <hip/hip_cooperative_groups.h>
#include <cstdio>
#include <cstdint>
namespace cg = cooperative_groups;
#define LAS __attribute__((address_space(3)))
#define GAS __attribute__((address_space(1)))
#define AS_GLOBAL(p) ((unsigned char*)(GAS unsigned char*)(p))
#define AS_LDS(p) ((unsigned char*)(LAS unsigned char*)(p))
#define RFL(x) __builtin_amdgcn_readfirstlane(x)
#define MFMA32(a, b, c) __builtin_amdgcn_mfma_f32_32x32x16_bf16(a, b, c, 0, 0, 0)
#define MFMA16(a, b, c) __builtin_amdgcn_mfma_f32_16x16x32_bf16(a, b, c, 0, 0, 0)
#define MFMA16_FP8(a, b, c) __builtin_amdgcn_mfma_f32_16x16x32_fp8_fp8((long)(a), (long)(b), c, 0, 0, 0)
#define MFMA16_F8X128(a, b, c) __builtin_amdgcn_mfma_scale_f32_16x16x128_f8f6f4(a, b, c, 0, 0, 0, 0, 0, 0)
#define FAST_EXP2(x) __builtin_amdgcn_exp2f(x)
#define FAST_RCP(x) __builtin_amdgcn_rcpf(x)
#define FAST_LOG2(x) __builtin_amdgcn_logf(x)
#define FAST_RSQ(x) __builtin_amdgcn_rsqf(x)
#define WAVE_SYNC() __builtin_amdgcn_wave_barrier()
#define OPAQUE(x) asm volatile("" : "+v"(x))
#define GLDS16(gp, lp, lane) __builtin_amdgcn_global_load_lds((const unsigned*)(gp), (LAS unsigned*)(lp), 16, 0, 0)
#define WAIT_VM(n) asm volatile("s_waitcnt vmcnt(" #n ")" ::: "memory")
#define GLOAD16_ASM(dst, ptr) asm volatile("global_load_dwordx4 %0, %1, off" : "=v"(dst) : "v"(ptr) : "memory")
#define GLOAD4_ASM(dst, ptr) asm volatile("global_load_dword %0, %1, off" : "=v"(dst) : "v"(ptr) : "memory")
#define GLOAD16_RW(dst, ptr) asm volatile("global_load_dwordx4 %0, %1, off" : "+v"(dst) : "v"(ptr) : "memory")
#define PIN1(a) asm volatile("" : "+v"(a) :: "memory")
#define GLOAD16_RW_S(dst, base, off) asm volatile("global_load_dwordx4 %0, %1, %2" : "+v"(dst) : "v"(off), "s"(base) : "memory")
#define SCHED_FENCE() __builtin_amdgcn_sched_barrier(0)
#define TAG_A() asm volatile("; buffer A" ::: "memory")
#define TAG_B() asm volatile("; buffer B" ::: "memory")
#define GLOAD16_S(dst, base, off) asm volatile("global_load_dwordx4 %0, %1, %2" : "=v"(dst) : "v"(off), "s"(base) : "memory")
#define GLOAD4_S(dst, base, off) asm volatile("global_load_dword %0, %1, %2" : "=v"(dst) : "v"(off), "s"(base) : "memory")
#define PIN4(a, b, c, d) asm volatile("" : "+v"(a), "+v"(b), "+v"(c), "+v"(d) :: "memory")
#define PIN2I(a, b) asm volatile("" : "+v"(a), "+v"(b) :: "memory")
#define WAIT_LGKM0() asm volatile("s_waitcnt lgkmcnt(0)" ::: "memory")
#define READLANE_I(v, l) __builtin_amdgcn_readlane((int)(v), (l))
#define READLANE_F(v, l) __builtin_bit_cast(float, __builtin_amdgcn_readlane(__builtin_bit_cast(int, (float)(v)), (l)))
#define OPAQUE_S(x) asm volatile("" : "+s"(x))
__device__ __forceinline__ int opaque_tid_() { int t = threadIdx.x; asm volatile("" : "+v"(t)); return t; }
#define TIDX() opaque_tid_()
#define XCC_ID() ((int)(__builtin_amdgcn_s_getreg((3 << 11) | 20) & 7u))
__device__ __forceinline__ int opaque_gdim_() { int t = gridDim.x; asm volatile("" : "+s"(t)); return t; }
__device__ __forceinline__ int opaque_bidx_() { int t = blockIdx.x; asm volatile("" : "+s"(t)); return t; }
#define GDIM() opaque_gdim_()
#define BIDX() opaque_bidx_()
#define MEMFENCE() do { asm volatile("" ::: "memory"); __builtin_amdgcn_sched_barrier(0); } while (0)
#endif

#ifndef CFG_B
#define CFG_B 16
#endif
#ifndef CFG_S
#define CFG_S 2048
#endif

typedef unsigned short bf16_t;
typedef short bf16x8 __attribute__((ext_vector_type(8)));
typedef short s16x4 __attribute__((ext_vector_type(4)));
typedef float f32x4 __attribute__((ext_vector_type(4)));
typedef float f32x2 __attribute__((ext_vector_type(2)));
typedef float f32x16 __attribute__((ext_vector_type(16)));
typedef unsigned u32x4 __attribute__((ext_vector_type(4)));
typedef unsigned u32x2 __attribute__((ext_vector_type(2)));
typedef int i32x4 __attribute__((ext_vector_type(4)));
typedef int i32x8 __attribute__((ext_vector_type(8)));

constexpr int NB_ = CFG_B, S_ = CFG_S, T_ = NB_ * S_, D_ = 1024, L_ = 2;
constexpr int NTHR = 512, NWAVE = 8;
constexpr int PJ = 2304;
constexpr int C_R = 0, C_K = 256, C_V = 512, C_HW = 768, C_HA = 800, C_HG = 832, C_S5 = 896, C_FQ = 1152, C_FK = 1408, C_FL = 1664, C_CV = 1792, C_CG = 2048;
constexpr int WIN_ROWS = 6656, WIN_VT = 2304, WIN_GATE = 2560;
constexpr int IN_COLS = 6532;
constexpr float LN_EPS_ = 1e-5f, GN_EPS_ = 64e-5f;
constexpr float DN_ALPHA_ = 1.4142135623730951f;
constexpr int NEXP = 16384;

enum { I_X = 0, I_P, I_LNIN_G, I_LNIN_B, I_WIN, I_MU, I_W0, I_W2, I_A0, I_A2, I_G2, I_KK, I_KA, I_RK, I_LNXG, I_LNXB, I_LRE, I_LIM, I_BRE, I_BIM, I_CRE, I_CIM,
       I_S5D, I_LDT, I_GLUW, I_GLUB, I_BF, I_CONVW, I_CONVB, I_CLNG, I_CLNB, I_WBR, I_WOUT, I_LN1G, I_LN1B, I_WQ, I_K1, I_K2, I_U, I_V, I_PLEW, I_PLEG, I_LN2G, I_LN2B, N_IN };

constexpr size_t al256(size_t x) { return (x + 255) & ~(size_t)255; }
constexpr size_t WS_CTL = 0;
constexpr size_t WS_WIN = 1u << 20;
constexpr size_t WS_WBR = WS_WIN + al256((size_t)L_ * WIN_ROWS * 1024 * 2);
constexpr size_t WS_WOUT = WS_WBR + (size_t)L_ * 1024 * 1024 * 2;
constexpr size_t WS_WQ = WS_WOUT + (size_t)L_ * 1024 * 1024 * 2;
constexpr size_t WS_PLE = WS_WQ + (size_t)L_ * 2048 * 1024 * 2;
constexpr size_t WS_PLEG = WS_PLE + (size_t)L_ * 1024 * 256 * 2;
constexpr size_t WS_GLU = WS_PLEG + (size_t)L_ * 1024 * 1024 * 2;
constexpr size_t WS_K12 = WS_GLU + (size_t)L_ * 256 * 256 * 2;
constexpr size_t WS_S5KC = WS_K12 + (size_t)L_ * 2 * 128 * 128 * 2;
constexpr size_t WS_S5WX = WS_S5KC + (size_t)L_ * 16 * 64 * 256 * 2;
constexpr size_t WS_S5WY = WS_S5WX + (size_t)L_ * 16 * 128 * 1024 * 2;
constexpr size_t WS_S5LL = WS_S5WY + (size_t)L_ * 16 * 1024 * 128 * 2;
constexpr size_t WS_UT = WS_S5LL + al256((size_t)L_ * 16 * 64 * 2 * 4);
constexpr size_t WS_VT = WS_UT + (size_t)NEXP * 1024 * 2;
constexpr size_t WS_RW = WS_VT + (size_t)NEXP * 1024 * 2;
constexpr size_t RW_SZ = (size_t)T_ * 512;
static_assert(2 * RW_SZ <= (size_t)NEXP * 1024 * 2, "RWKV gate / bonus arrays fit the second table region");
constexpr size_t WS_HB = WS_RW + 4 * RW_SZ;
constexpr size_t WS_R1 = WS_HB + (size_t)T_ * 1024 * 2;
constexpr size_t R1_BYTES = (size_t)T_ * 2560 * 2;
constexpr size_t WS_YC = WS_R1 + R1_BYTES;
constexpr size_t WS_VTR = WS_YC + (size_t)T_ * 1024 * 2;
constexpr size_t WS_PB = WS_VTR + (size_t)256 * T_ * 2;
constexpr size_t WS_H8T = WS_PB + (size_t)T_ * 256 * 2;
constexpr int H8_SPLIT = (T_ / 512) * 256;
constexpr size_t WS_END = WS_H8T + (size_t)(T_ - H8_SPLIT) * 1024;
constexpr size_t R1_PROJ = 0;
constexpr size_t R1_H8 = (size_t)T_ * 2304 * 2;
constexpr size_t R1_MERGED = 0;
constexpr size_t R1_STASH = (size_t)T_ * 1024 * 2;
constexpr size_t R1_Q = 0;
constexpr size_t R1_EID = (size_t)T_ * 2048 * 2;
constexpr size_t R1_GATE = R1_EID + (size_t)T_ * 128 * 4;
static_assert(R1_GATE + (size_t)T_ * 128 * 4 <= R1_BYTES, "R1 map");

struct KP { const float* in[N_IN]; float* out; unsigned char* ws; float* dbg; int layer; int phase; };

#ifdef CPU_EMU
__device__ __forceinline__ unsigned f2bf(float f) { unsigned u = __builtin_bit_cast(unsigned, f); return (u + 0x7fffu + ((u >> 16) & 1u)) >> 16; }
__device__ __forceinline__ unsigned pk2(float lo, float hi) { return f2bf(lo) | (f2bf(hi) << 16); }
#else
typedef __bf16 bf16x2_hw __attribute__((ext_vector_type(2)));
__device__ __forceinline__ unsigned pk2(float lo, float hi) { const f32x2 v = {lo, hi}; return __builtin_bit_cast(unsigned, __builtin_convertvector(v, bf16x2_hw)); }
__device__ __forceinline__ unsigned f2bf(float f) { return pk2(f, 0.f) & 0xffffu; }
#endif
__device__ __forceinline__ float bf2f(unsigned h) { return __builtin_bit_cast(float, h << 16); }
__device__ __forceinline__ float bflo(unsigned w) { return __builtin_bit_cast(float, w << 16); }
__device__ __forceinline__ float bfhi(unsigned w) { return __builtin_bit_cast(float, w & 0xffff0000u); }
__device__ __forceinline__ float sigmoidf_(float x) { return FAST_RCP(1.0f + FAST_EXP2(x * -1.4426950408889634f)); }
__device__ __forceinline__ float gelu_erf(float v) {
    const float t = FAST_RCP(fabsf(v) * 0.2316418882f + 1.0f);
    float q = t * 0.5307027145f + (-0.7265760135f); q = q * t + 0.7107068705f; q = q * t + (-0.142248368f); q = q * t + 0.127414796f; q = q * t;
    const float m = v * (q * FAST_EXP2((v * v) * (-0.72134752044f)));
    return v < 0.f ? m : v - m; }
#ifdef CPU_EMU
inline float fp8_dec_(unsigned b) { const unsigned s = b >> 7, e = (b >> 3) & 15, m = b & 7; float v = (e == 0) ? ldexpf((float)m, -9) : ldexpf(1.f + m * 0.125f, (int)e - 7); return s ? -v : v; }
inline unsigned fp8_enc_(float x) { const unsigned s = x < 0.f ? 0x80u : 0u; float a = fabsf(x); if (!(a > 0.f)) return s; if (a > 448.f) a = 448.f;
    int e; (void)frexpf(a, &e); e -= 1; if (e < -6) e = -6;
    const float q = ldexpf(a, 3 - e); float r = nearbyintf(q);
    unsigned ee, mm; if (e == -6 && r < 8.f) { ee = 0; mm = (unsigned)r; } else { if (r >= 16.f) { r = 8.f; e += 1; } ee = (unsigned)(e + 7); mm = (unsigned)r - 8u; }
    if (ee > 15u || (ee == 15u && mm > 6u)) { ee = 15u; mm = 6u; }
    return s | (ee << 3) | mm; }
inline f32x2 cvt_pk_f32_fp8_(unsigned w, bool hi) { const unsigned h = hi ? (w >> 16) : w; return (f32x2){fp8_dec_(h & 255u), fp8_dec_((h >> 8) & 255u)}; }
inline unsigned cvt_pk_fp8_f32_(float a, float b, unsigned old, bool hi) { const unsigned p = fp8_enc_(a) | (fp8_enc_(b) << 8); return hi ? ((old & 0xffffu) | (p << 16)) : ((old & 0xffff0000u) | p); }
#else
__device__ __forceinline__ f32x2 cvt_pk_f32_fp8_(unsigned w, bool hi) { return hi ? __builtin_amdgcn_cvt_pk_f32_fp8((int)w, true) : __builtin_amdgcn_cvt_pk_f32_fp8((int)w, false); }
__device__ __forceinline__ unsigned cvt_pk_fp8_f32_(float a, float b, unsigned old, bool hi) { return hi ? (unsigned)__builtin_amdgcn_cvt_pk_fp8_f32(a, b, (int)old, true) : (unsigned)__builtin_amdgcn_cvt_pk_fp8_f32(a, b, (int)old, false); }
#endif
__device__ __forceinline__ float wave_max(float v) {
#pragma unroll
  for (int o = 1; o < 64; o <<= 1) v = fmaxf(v, __shfl_xor(v, o));
  return v;
}
template <int N> __device__ __forceinline__ void wave_sum_n(float (&v)[N]) {
#pragma unroll
  for (int o = 1; o < 64; o <<= 1) { float t[N];
#pragma unroll
    for (int i = 0; i < N; ++i) t[i] = __shfl_xor(v[i], o);
#pragma unroll
    for (int i = 0; i < N; ++i) v[i] += t[i]; }
}
__device__ __forceinline__ float wave_sum(float v) {
#pragma unroll
  for (int o = 1; o < 64; o <<= 1) v += __shfl_xor(v, o);
  return v;
}
namespace pg8 {
constexpr int BM = 256, BK = 64, HALF = 128, HTB = HALF * BK * 2, STAGE_BYTES = 8 * HTB;
__host__ __device__ __forceinline__ int lds_byte(int r, int c) { const int st = (r >> 4) * 2 + (c >> 5), rr = r & 15, cc = c & 31, ob = rr * 64 + cc * 2; return st * 1024 + (ob ^ (((ob >> 9) & 1) << 5)); }
__host__ __device__ __forceinline__ void stage_rc(int b, int& R, int& C) { const int st = b / 1024, sb = b % 1024, swz = sb ^ (((sb >> 9) & 1) << 5); R = (st >> 1) * 16 + swz / 64; C = (st & 1) * 32 + (swz % 64) / 2; }
__host__ __device__ __forceinline__ int perm32(int rho) { const int n = rho >> 4, i = rho & 15; return 8 * (i >> 2) + 4 * n + (i & 3); }

struct Unit { const char* a; const char* b; int nt; int kind; int pm; int pn; int aux; int f8; };

#ifndef CPU_EMU
template <int MODE = 0, class Epi, class Sched>
__device__ __forceinline__ void gemm_phase(LAS unsigned char* lds, const int lda, const int ldb, const Sched& S, const Epi& E, const int lda8 = 0) {
    const int tid = TIDX(), wid = __builtin_amdgcn_readfirstlane(tid >> 6), lane = tid & 63, wr = wid >> 2, wc = wid & 3, fr = lane & 15, fq = lane >> 4;
    unsigned voffA[2], voffB[2], voffA8[2];
#pragma unroll
    for (int i = 0; i < 2; ++i) { int R, C; stage_rc(tid * 16 + i * 8192, R, C); const int Rb = (R & ~31) + perm32(R & 31);
        voffA[i] = (unsigned)(R * lda + C) * 2u; voffB[i] = (unsigned)(Rb * ldb + C) * 2u; voffA8[i] = (unsigned)(R * lda8 + C * 2); }
    const size_t kstep = (size_t)(BK * 2);
    const size_t hstepA = (size_t)HALF * lda * 2, hstepB = (size_t)HALF * ldb * 2, hstepA8 = (size_t)HALF * lda8;
    const unsigned ldsw = (unsigned)wid * 1024u;
    const int aoff = lds_byte(wr * 64 + fr, fq * 8), boff = lds_byte(wc * 32 + fr, fq * 8);
#define PG8_SA(b, h) (((b) * 2 + (h)) * HTB)
#define PG8_SB(b, h) ((4 + (b) * 2 + (h)) * HTB)
#define PG8_STAGE(bufoff, gbase, voff) do { _Pragma("unroll") for (int _i = 0; _i < 2; ++_i) \
        __builtin_amdgcn_global_load_lds((const unsigned*)((const char*)(gbase) + (voff)[_i]), (LAS unsigned*)(lds + (bufoff) + ldsw + _i * 8192), 16, 0, 0); } while (0)
#define PG8_LDA(dst, b, h) do { _Pragma("unroll") for (int m = 0; m < 4; ++m) _Pragma("unroll") for (int k = 0; k < 2; ++k) dst[m][k] = *(const LAS bf16x8*)(lds + PG8_SA(b, h) + aoff + m * 2048 + k * 1024); } while (0)
#define PG8_LDB(dst, b, h) do { _Pragma("unroll") for (int n = 0; n < 2; ++n) _Pragma("unroll") for (int k = 0; k < 2; ++k) dst[n][k] = *(const LAS bf16x8*)(lds + PG8_SB(b, h) + boff + n * 2048 + k * 1024); } while (0)
#define PG8_MMA(ai, bj, At, Bt) do { __builtin_amdgcn_s_setprio(1); _Pragma("unroll") for (int m = 0; m < 4; ++m) _Pragma("unroll") for (int n = 0; n < 2; ++n) _Pragma("unroll") for (int k = 0; k < 2; ++k) \
        acc[ai][bj][m][n] = __builtin_amdgcn_mfma_f32_16x16x32_bf16(Bt[n][k], At[m][k], acc[ai][bj][m][n], 0, 0, 0); __builtin_amdgcn_s_setprio(0); } while (0)
#define PG8_CAT(x, y) __builtin_shufflevector(__builtin_bit_cast(i32x4, x), __builtin_bit_cast(i32x4, y), 0, 1, 2, 3, 4, 5, 6, 7)
#define PG8_LDA8(dst, b, h) do { _Pragma("unroll") for (int m = 0; m < 4; ++m) dst[m] = PG8_CAT(*(const LAS bf16x8*)(lds + PG8_SA(b, h) + aoff + m * 2048), *(const LAS bf16x8*)(lds + PG8_SA(b, h) + aoff + m * 2048 + 1024)); } while (0)
#define PG8_LDB8(dst, b, h) do { _Pragma("unroll") for (int n = 0; n < 2; ++n) dst[n] = PG8_CAT(*(const LAS bf16x8*)(lds + PG8_SB(b, h) + boff + n * 2048), *(const LAS bf16x8*)(lds + PG8_SB(b, h) + boff + n * 2048 + 1024)); } while (0)
#define PG8_MMA8(ai, bj, A8, B8) do { __builtin_amdgcn_s_setprio(1); _Pragma("unroll") for (int m = 0; m < 4; ++m) _Pragma("unroll") for (int n = 0; n < 2; ++n) \
        acc[ai][bj][m][n] = MFMA16_F8X128(B8[n], A8[m], acc[ai][bj][m][n]); __builtin_amdgcn_s_setprio(0); } while (0)
#define PG8_WAIT_V(n) asm volatile("s_waitcnt vmcnt(" #n ")" ::: "memory")
#define PG8_WAIT_L(n) asm volatile("s_waitcnt lgkmcnt(" #n ")" ::: "memory")
#define PG8_BAR __builtin_amdgcn_s_barrier()
#define PG8_SCHED __builtin_amdgcn_sched_barrier(0)
    Unit cur, nxt; int ui = 0;
    if (!S.next(0, cur)) return;
    f32x4 acc[2][2][4][2];
#pragma unroll
    for (int a = 0; a < 2; ++a)
#pragma unroll
        for (int b = 0; b < 2; ++b)
#pragma unroll
            for (int m = 0; m < 4; ++m)
#pragma unroll
                for (int n = 0; n < 2; ++n) acc[a][b][m][n] = (f32x4){0.f, 0.f, 0.f, 0.f};
    bf16x8 At[4][2], B0[2][2], B1[2][2];
    const char* cA = cur.a; const char* cB = cur.b; int cf8 = MODE == 2 ? cur.f8 : MODE; size_t chA = cf8 ? hstepA8 : hstepA;
    { unsigned v0[2] = {cf8 ? voffA8[0] : voffA[0], cf8 ? voffA8[1] : voffA[1]};
    PG8_STAGE(PG8_SB(0, 0), cB, voffB); PG8_STAGE(PG8_SB(0, 1), cB + hstepB, voffB); PG8_STAGE(PG8_SA(0, 0), cA, v0); PG8_STAGE(PG8_SA(0, 1), cA + chA, v0);
    if (wr == 1) PG8_BAR;
    PG8_WAIT_V(2); PG8_BAR;
    PG8_STAGE(PG8_SB(1, 0), cB + kstep, voffB); PG8_STAGE(PG8_SA(1, 0), cA + kstep, v0); PG8_STAGE(PG8_SB(1, 1), cB + hstepB + kstep, voffB);
    PG8_WAIT_V(6); PG8_BAR; }
    for (;;) {
        const bool has_next = S.next(ui + 1, nxt);
        const char* nA = has_next ? nxt.a : cA; const char* nB = has_next ? nxt.b : cB; const int nf8 = MODE == 2 ? (has_next ? nxt.f8 : cf8) : MODE;
        int nt = cur.nt; asm volatile("" : "+s"(nt));
#define PG8_KLOOP(LDA_, LDB_, MM_, At_, B0_, B1_, CF8) \
        for (int t = 0; t < nt; t += 2) { \
            const bool last = (t == nt - 2); \
            const char* a1 = cA + (size_t)(t + 1) * kstep; \
            const char* a2 = last ? nA : cA + (size_t)(t + 2) * kstep; const char* b2 = last ? nB : cB + (size_t)(t + 2) * kstep; \
            const char* a3 = a2 + kstep; const char* b3 = b2 + kstep; \
            const int f2 = last ? nf8 : CF8; const size_t h2 = f2 ? hstepA8 : hstepA; \
            OPAQUE_S(a1); OPAQUE_S(a2); OPAQUE_S(a3); OPAQUE_S(b2); OPAQUE_S(b3); \
            const unsigned vA[2] = {CF8 ? voffA8[0] : voffA[0], CF8 ? voffA8[1] : voffA[1]}, vA2[2] = {f2 ? voffA8[0] : voffA[0], f2 ? voffA8[1] : voffA[1]}, vB[2] = {voffB[0], voffB[1]}; \
            LDB_(B0_, 0, 0); LDB_(B1_, 0, 1); PG8_SCHED; LDA_(At_, 0, 0); PG8_STAGE(PG8_SA(1, 1), a1 + (CF8 ? hstepA8 : hstepA), vA); \
            PG8_WAIT_V(8); PG8_WAIT_L(0); PG8_BAR; MM_(0, 0, At_, B0_); MM_(0, 1, At_, B1_); PG8_BAR; PG8_SCHED; \
            LDA_(At_, 0, 1); PG8_STAGE(PG8_SB(0, 0), b2, vB); PG8_STAGE(PG8_SB(0, 1), b2 + hstepB, vB); PG8_STAGE(PG8_SA(0, 0), a2, vA2); \
            PG8_WAIT_V(8); PG8_WAIT_L(0); PG8_BAR; MM_(1, 0, At_, B0_); MM_(1, 1, At_, B1_); PG8_BAR; PG8_SCHED; \
            LDB_(B0_, 1, 0); LDB_(B1_, 1, 1); PG8_SCHED; LDA_(At_, 1, 0); PG8_STAGE(PG8_SA(0, 1), a2 + h2, vA2); \
            PG8_WAIT_V(8); PG8_WAIT_L(0); PG8_BAR; MM_(0, 0, At_, B0_); MM_(0, 1, At_, B1_); PG8_BAR; PG8_SCHED; \
            LDA_(At_, 1, 1); PG8_STAGE(PG8_SB(1, 0), b3, vB); PG8_STAGE(PG8_SB(1, 1), b3 + hstepB, vB); PG8_STAGE(PG8_SA(1, 0), a3, vA2); \
            PG8_WAIT_V(8); PG8_WAIT_L(0); PG8_BAR; MM_(1, 0, At_, B0_); MM_(1, 1, At_, B1_); PG8_BAR; PG8_SCHED; \
        }
        if (MODE == 1 || (MODE == 2 && cf8)) { i32x8 A8[4], B08[2], B18[2]; PG8_KLOOP(PG8_LDA8, PG8_LDB8, PG8_MMA8, A8, B08, B18, 1) }
        else { PG8_KLOOP(PG8_LDA, PG8_LDB, PG8_MMA, At, B0, B1, 0) }
#undef PG8_KLOOP
        if (wr == 0) PG8_BAR;
        E(acc, cur, wr, wc, fr, fq, tid);
        if (!has_next) break;
#pragma unroll
        for (int a = 0; a < 2; ++a)
#pragma unroll
            for (int b = 0; b < 2; ++b)
#pragma unroll
                for (int m = 0; m < 4; ++m)
#pragma unroll
                    for (int n = 0; n < 2; ++n) acc[a][b][m][n] = (f32x4){0.f, 0.f, 0.f, 0.f};
        cur = nxt; cA = nA; cB = nB; cf8 = nf8; ++ui;
        if (wr == 1) PG8_BAR;
    }
    PG8_WAIT_V(0);
    PG8_BAR;
#undef PG8_SA
#undef PG8_SB
#undef PG8_STAGE
#undef PG8_LDA
#undef PG8_LDB
#undef PG8_MMA
#undef PG8_MMA8
#undef PG8_LDA8
#undef PG8_LDB8
#undef PG8_CAT
#undef PG8_WAIT_V
#undef PG8_WAIT_L
#undef PG8_BAR
#undef PG8_SCHED
}
#else
template <int MODE = 0, class Epi, class Sched>
inline void gemm_phase(unsigned char* lds, const int lda, const int ldb, const Sched& S, const Epi& E, const int lda8 = 0) {
    const int tid = TIDX(), wid = tid >> 6, lane = tid & 63, wr = wid >> 2, wc = wid & 3, fr = lane & 15, fq = lane >> 4;
    Unit cur;
    for (int ui = 0; S.next(ui, cur); ++ui) {
        f32x4 acc[2][2][4][2];
        const bf16_t* A = (const bf16_t*)cur.a; const bf16_t* Bt = (const bf16_t*)cur.b; const int K = cur.nt * 64;
        for (int ai = 0; ai < 2; ++ai) for (int bj = 0; bj < 2; ++bj) for (int m = 0; m < 4; ++m) for (int n = 0; n < 2; ++n) for (int e = 0; e < 4; ++e) {
            const int r = 128 * ai + 64 * wr + 16 * m + fr, c = 128 * bj + 32 * wc + 8 * fq + 4 * n + e; float s = 0.f;
            const bf16_t* ar = A + (size_t)r * lda; const bf16_t* br = Bt + (size_t)c * ldb;
            if (cur.f8) { const unsigned char* a8 = (const unsigned char*)cur.a + (size_t)r * lda8; const unsigned char* b8 = (const unsigned char*)cur.b + (size_t)c * ldb * 2;
                for (int k = 0; k < cur.nt * 128; ++k) s += fp8_dec_(a8[k]) * fp8_dec_(b8[k]); }
#ifdef EMU_FP8_A
            else if (cur.aux == 77) { float am = 0.f; for (int k = 0; k < K; ++k) am = fmaxf(am, fabsf(bf2f(br[k]))); const float sc = am > 0.f ? am / 440.f : 1.f;
                for (int k = 0; k < K; ++k) s += fp8_dec_(fp8_enc_(bf2f(ar[k]))) * fp8_dec_(fp8_enc_(bf2f(br[k]) / sc)); s *= sc; }
#endif
            else for (int k = 0; k < K; ++k) s += bf2f(ar[k]) * bf2f(br[k]);
            acc[ai][bj][m][n][e] = s; }
        __syncthreads();
        E(acc, cur, wr, wc, fr, fq, tid);
        __syncthreads();
    }
    __syncthreads();
}
#endif
}
struct Ptrs {
    bf16_t *WinT, *WbrT, *WoutT, *WqT, *PleT, *PleGT, *GluT, *K12, *S5Kc, *S5Wx, *S5Wy, *Ut, *Vt, *hb, *proj, *merged, *q, *ycat, *vtr, *pb;
    float *S5LL, *gate; int* eid; unsigned char* stash; bf16_t *rwPT, *rwG, *rwS0, *rwQ, *rwGt, *rwRKV; unsigned char *U8, *V8; float *su, *sv; bf16_t* pd; unsigned* qcnt; unsigned char *h8a, *h8b, *h8e; float *gsc, *gscA;
};
__device__ __forceinline__ Ptrs make_ptrs(unsigned char* ws, int l) {
    Ptrs P; { size_t zoff = 0; OPAQUE_S(zoff); ws += zoff; }
    P.WinT = (bf16_t*)(ws + WS_WIN) + (size_t)l * WIN_ROWS * 1024; P.WbrT = (bf16_t*)(ws + WS_WBR) + (size_t)l * 1024 * 1024; P.WoutT = (bf16_t*)(ws + WS_WOUT) + (size_t)l * 1024 * 1024;
    P.WqT = (bf16_t*)(ws + WS_WQ) + (size_t)l * 2048 * 1024; P.PleT = (bf16_t*)(ws + WS_PLE) + (size_t)l * 1024 * 256; P.PleGT = (bf16_t*)(ws + WS_PLEG) + (size_t)l * 1024 * 1024;
    P.GluT = (bf16_t*)(ws + WS_GLU) + (size_t)l * 256 * 256; P.K12 = (bf16_t*)(ws + WS_K12) + (size_t)l * 2 * 128 * 128;
    P.S5Kc = (bf16_t*)(ws + WS_S5KC) + (size_t)l * 16 * 64 * 256; P.S5Wx = (bf16_t*)(ws + WS_S5WX) + (size_t)l * 16 * 128 * 1024; P.S5Wy = (bf16_t*)(ws + WS_S5WY) + (size_t)l * 16 * 1024 * 128;
    P.S5LL = (float*)(ws + WS_S5LL) + (size_t)l * 16 * 64 * 2;
    P.Ut = (bf16_t*)(ws + WS_UT); P.Vt = (bf16_t*)(ws + WS_VT);
    P.pd = (bf16_t*)(ws + WS_R1 + R1_Q); P.qcnt = (unsigned*)(ws + WS_CTL) + 8192 + l * 4 * 8 * 16;
    P.U8 = ws + WS_UT; P.V8 = ws + WS_UT + (size_t)NEXP * 1024; P.su = (float*)(ws + WS_CTL + 131072); P.sv = (float*)(ws + WS_CTL + 131072) + NEXP;
    P.rwGt = (bf16_t*)(ws + WS_VT); P.rwRKV = (bf16_t*)(ws + WS_VT + RW_SZ);
    P.rwPT = (bf16_t*)(ws + WS_RW); P.rwG = (bf16_t*)(ws + WS_RW + RW_SZ); P.rwS0 = (bf16_t*)(ws + WS_RW + 2 * RW_SZ); P.rwQ = (bf16_t*)(ws + WS_RW + 3 * RW_SZ);
    P.hb = (bf16_t*)(ws + WS_HB); P.proj = (bf16_t*)(ws + WS_R1 + R1_PROJ); P.merged = (bf16_t*)(ws + WS_R1 + R1_MERGED); P.q = (bf16_t*)(ws + WS_R1 + R1_Q);
    P.stash = ws + WS_R1 + R1_STASH; P.eid = (int*)(ws + WS_R1 + R1_EID); P.gate = (float*)(ws + WS_R1 + R1_GATE);
    P.ycat = (bf16_t*)(ws + WS_YC); P.vtr = (bf16_t*)(ws + WS_VTR); P.pb = (bf16_t*)(ws + WS_PB);
    P.h8a = ws + WS_R1 + R1_H8; P.h8b = ws + WS_H8T; P.h8e = ws + WS_RW; P.gsc = (float*)(ws + WS_CTL + 262144) + l * 6144; P.gscA = (float*)(ws + WS_CTL + 327680) + l * 2560;
    return P;
}

__device__ __forceinline__ int win_src_col(int n) {
    if (n < 1152) return n;
    if (n < 1664) return n;
    if (n < 1668) return 1920 + (n - 1664);
    if (n < 1792) return -1;
    if (n < 2304) return 1924 + (n - 1792);
    if (n < 2560) return 1664 + (n - 2304);
    return 2436 + (n - 2560);
}
template <bool WINMAP>
__device__ __forceinline__ void transpose_item(const float* src, int sld, bf16_t* dst, int dld, int dcol0, int kb, int nb, float* scr, int lane) {
    const int k0 = 64 * kb, n0 = 32 * nb;
    const int nn = n0 + (lane & 31); const int sc = WINMAP ? win_src_col(nn) : nn;
#pragma unroll 8
    for (int i = 0; i < 32; ++i) { const int kk = 2 * i + (lane >> 5); scr[kk * 33 + (lane & 31)] = (sc >= 0) ? src[(size_t)(k0 + kk) * sld + sc] : 0.f; }
    WAVE_SYNC();
    const int c = lane & 7;
#pragma unroll
    for (int j = 0; j < 4; ++j) { const int n = (lane >> 3) + 8 * j; const float* s = scr + (8 * c) * 33 + n;
        u32x4 o; o.x = pk2(s[0 * 33], s[1 * 33]); o.y = pk2(s[2 * 33], s[3 * 33]); o.z = pk2(s[4 * 33], s[5 * 33]); o.w = pk2(s[6 * 33], s[7 * 33]);
        *(u32x4*)(dst + (size_t)(n0 + n) * dld + dcol0 + k0 + 8 * c) = o; }
    WAVE_SYNC();
}

__device__ __forceinline__ void s5_tables(const KP& p, int l, int g, unsigned char* lds) {
    float* pw = (float*)lds;
    float* bb = pw + 65 * 128;
    float* cc = bb + 64 * 32;
    const int tid = TIDX();
    const Ptrs P = make_ptrs(p.ws, l);
    const float dt = expf(p.in[I_LDT][l * 16 + g]);
    if (tid < 64) { const int pp = tid; const float lr = p.in[I_LRE][(l * 16 + g) * 64 + pp], li = p.in[I_LIM][(l * 16 + g) * 64 + pp];
        const float mag = expf(lr * dt), ang = li * dt; const float br = mag * cosf(ang), bi = mag * sinf(ang);
        float xr = 1.f, xi = 0.f;
        for (int t = 0; t <= 64; ++t) { pw[(t * 64 + pp) * 2] = xr; pw[(t * 64 + pp) * 2 + 1] = xi; const float nr = xr * br - xi * bi, ni = xr * bi + xi * br; xr = nr; xi = ni; }
        const float nr = br - 1.f, ni = bi, den = lr * lr + li * li; const float cr = (nr * lr + ni * li) / den, ci = (ni * lr - nr * li) / den;
        for (int c = 0; c < 16; ++c) { const float b_r = p.in[I_BRE][((l * 16 + g) * 64 + pp) * 16 + c], b_i = p.in[I_BIM][((l * 16 + g) * 64 + pp) * 16 + c];
            bb[(pp * 16 + c) * 2] = cr * b_r - ci * b_i; bb[(pp * 16 + c) * 2 + 1] = cr * b_i + ci * b_r; }
        P.S5LL[(g * 64 + pp) * 2] = pw[(64 * 64 + pp) * 2]; P.S5LL[(g * 64 + pp) * 2 + 1] = pw[(64 * 64 + pp) * 2 + 1];
    }
    for (int e = tid; e < 1024; e += NTHR) { const int c = e >> 6, pp = e & 63; cc[e * 2] = p.in[I_CRE][((l * 16 + g) * 16 + c) * 64 + pp]; cc[e * 2 + 1] = p.in[I_CIM][((l * 16 + g) * 16 + c) * 64 + pp]; }
    __syncthreads();
    bf16_t* Kc = P.S5Kc + (size_t)g * 64 * 256;
    { const int pair = tid & 255, co = pair >> 4, ci = pair & 15, th = tid >> 8; float acc[32];
#pragma unroll
      for (int j = 0; j < 32; ++j) acc[j] = 0.f;
      for (int pp = 0; pp < 64; ++pp) { const float c_r = cc[(co * 64 + pp) * 2], c_i = cc[(co * 64 + pp) * 2 + 1], b_r = bb[(pp * 16 + ci) * 2], b_i = bb[(pp * 16 + ci) * 2 + 1];
          const float d_r = c_r * b_r - c_i * b_i, d_i = c_r * b_i + c_i * b_r;
#pragma unroll
          for (int j = 0; j < 32; ++j) { const f32x2 w = *(const f32x2*)(pw + ((th * 32 + j) * 64 + pp) * 2); acc[j] += d_r * w.x - d_i * w.y; } }
#pragma unroll
      for (int j = 0; j < 32; ++j) Kc[(th * 32 + j) * 256 + pair] = (bf16_t)f2bf(acc[j]); }
    bf16_t* Wx = P.S5Wx + (size_t)g * 128 * 1024;
    for (int e = tid; e < 128 * 1024; e += NTHR) { const int n = e >> 10, k = e & 1023, pp = n >> 1, ri = n & 1, s = k >> 4, ci = k & 15;
        const float w_r = pw[((63 - s) * 64 + pp) * 2], w_i = pw[((63 - s) * 64 + pp) * 2 + 1], b_r = bb[(pp * 16 + ci) * 2], b_i = bb[(pp * 16 + ci) * 2 + 1];
        Wx[e] = (bf16_t)f2bf(ri ? (w_r * b_i + w_i * b_r) : (w_r * b_r - w_i * b_i)); }
    bf16_t* Wy = P.S5Wy + (size_t)g * 1024 * 128;
    for (int e = tid; e < 1024 * 128; e += NTHR) { const int n = e >> 7, k = e & 127, t = n >> 4, co = n & 15, pp = k >> 1, ri = k & 1;
        const float c_r = cc[(co * 64 + pp) * 2], c_i = cc[(co * 64 + pp) * 2 + 1], w_r = pw[((t + 1) * 64 + pp) * 2], w_i = pw[((t + 1) * 64 + pp) * 2 + 1];
        Wy[e] = (bf16_t)f2bf(ri ? -(c_r * w_i + c_i * w_r) : (c_r * w_r - c_i * w_i)); }
    __syncthreads();
}

__device__ __forceinline__ void ln_row(const float* src, const float* g, const float* b, float* dst, bf16_t* dstb, int lane) {
    f32x4 v[4]; float s = 0.f;
#pragma unroll
    for (int j = 0; j < 4; ++j) { v[j] = *(const f32x4*)(src + 256 * j + 4 * lane); s += (v[j].x + v[j].y) + (v[j].z + v[j].w); }
    const float mean = wave_sum(s) * (1.f / 1024.f); float s2 = 0.f;
#pragma unroll
    for (int j = 0; j < 4; ++j) { v[j] = v[j] - mean; s2 += (v[j].x * v[j].x + v[j].y * v[j].y) + (v[j].z * v[j].z + v[j].w * v[j].w); }
    const float rstd = 1.f / sqrtf(wave_sum(s2) * (1.f / 1024.f) + LN_EPS_);
#pragma unroll
    for (int j = 0; j < 4; ++j) { const f32x4 gg = *(const f32x4*)(g + 256 * j + 4 * lane), bv = *(const f32x4*)(b + 256 * j + 4 * lane);
        const f32x4 o = v[j] * rstd * gg + bv; *(f32x4*)(dst + 256 * j + 4 * lane) = o;
        if (dstb) { u32x2 w; w.x = pk2(o.x, o.y); w.y = pk2(o.z, o.w); *(u32x2*)(dstb + 256 * j + 4 * lane) = w; } }
}

template <int NR, bool SB = false>
__device__ __forceinline__ void ln_rows(const void* srcv, const float* g, const float* b, float* dst, bf16_t* dstb, unsigned char* d8, int lane) {
    f32x4 v[NR][4]; float s[NR], s2[NR];
#pragma unroll
    for (int r = 0; r < NR; ++r) { s[r] = 0.f;
#pragma unroll
        for (int j = 0; j < 4; ++j) {
            if (SB) { const u32x2 w = *(const u32x2*)((const bf16_t*)srcv + (size_t)r * 1024 + 256 * j + 4 * lane); v[r][j] = (f32x4){bflo(w.x), bfhi(w.x), bflo(w.y), bfhi(w.y)}; }
            else v[r][j] = *(const f32x4*)((const float*)srcv + (size_t)r * 1024 + 256 * j + 4 * lane);
            s[r] += (v[r][j].x + v[r][j].y) + (v[r][j].z + v[r][j].w); } }
    wave_sum_n<NR>(s);
#pragma unroll
    for (int r = 0; r < NR; ++r) { const float mean = s[r] * (1.f / 1024.f); s2[r] = 0.f;
#pragma unroll
        for (int j = 0; j < 4; ++j) { v[r][j] = v[r][j] - mean; s2[r] += (v[r][j].x * v[r][j].x + v[r][j].y * v[r][j].y) + (v[r][j].z * v[r][j].z + v[r][j].w * v[r][j].w); } }
    wave_sum_n<NR>(s2);
#pragma unroll
    for (int j = 0; j < 4; ++j) { const f32x4 gg = *(const f32x4*)(g + 256 * j + 4 * lane), bv = *(const f32x4*)(b + 256 * j + 4 * lane);
#pragma unroll
        for (int r = 0; r < NR; ++r) { const float rstd = 1.f / sqrtf(s2[r] * (1.f / 1024.f) + LN_EPS_);
            const f32x4 o = v[r][j] * rstd * gg + bv; if (dst) *(f32x4*)(dst + (size_t)r * 1024 + 256 * j + 4 * lane) = o;
            if (dstb) { u32x2 w; w.x = pk2(o.x, o.y); w.y = pk2(o.z, o.w); *(u32x2*)(dstb + (size_t)r * 1024 + 256 * j + 4 * lane) = w; }
            if (d8) { unsigned w8 = cvt_pk_fp8_f32_(o.x, o.y, 0u, false); w8 = cvt_pk_fp8_f32_(o.z, o.w, w8, true); *(unsigned*)(d8 + (size_t)r * 1024 + 256 * j + 4 * lane) = w8; } } }
}
__device__ __forceinline__ void phase_prologue(const KP& p, unsigned char* lds) {
    const int tid = TIDX(), lane = tid & 63, wave = tid >> 6;
    int G = GDIM(), bid = BIDX();
    for (int it = bid; it < L_ * 16; it += G) s5_tables(p, it >> 4, it & 15, lds);
    if (G >= 4 * L_ * 16) { if (bid < L_ * 16) return; bid -= L_ * 16; G -= L_ * 16; }
    float* scr = (float*)lds + wave * (64 * 33 + 16);
    const int gw = bid * NWAVE + wave, NGW = G * NWAVE;
    constexpr int I_WINT = (WIN_ROWS / 32) * 16, I_BR = 4 * 4 * 32, I_OUT = 16 * 32, I_Q = 16 * 64, I_PL = 4 * 32, I_PG = 16 * 32, I_GL = 4 * 8;
    constexpr int PER_L = I_WINT + I_BR + I_OUT + I_Q + I_PL + I_PG + I_GL;
    for (int it = gw; it < L_ * PER_L; it += NGW) {
        const int l = it / PER_L; int r = it % PER_L; const Ptrs P = make_ptrs(p.ws, l);
        if (r < I_WINT) { transpose_item<true>(p.in[I_WIN] + (size_t)l * 1024 * IN_COLS, IN_COLS, P.WinT, 1024, 0, r & 15, r >> 4, scr, lane); continue; } r -= I_WINT;
        if (r < I_BR) { const int b = r >> 7, rr = r & 127; transpose_item<false>(p.in[I_WBR] + ((size_t)l * 4 + b) * 256 * 1024, 1024, P.WbrT, 1024, 256 * b, rr & 3, rr >> 2, scr, lane); continue; } r -= I_BR;
        if (r < I_OUT) { transpose_item<false>(p.in[I_WOUT] + (size_t)l * 1024 * 1024, 1024, P.WoutT, 1024, 0, r & 15, r >> 4, scr, lane); continue; } r -= I_OUT;
        if (r < I_Q) { transpose_item<false>(p.in[I_WQ] + (size_t)l * 1024 * 2048, 2048, P.WqT, 1024, 0, r & 15, r >> 4, scr, lane); continue; } r -= I_Q;
        if (r < I_PL) { transpose_item<false>(p.in[I_PLEW] + (size_t)l * 256 * 1024, 1024, P.PleT, 256, 0, r & 3, r >> 2, scr, lane); continue; } r -= I_PL;
        if (r < I_PG) { transpose_item<false>(p.in[I_PLEG] + (size_t)l * 1024 * 1024, 1024, P.PleGT, 1024, 0, r & 15, r >> 4, scr, lane); continue; } r -= I_PG;
        transpose_item<false>(p.in[I_GLUW] + (size_t)l * 256 * 256, 256, P.GluT, 256, 0, r & 3, r >> 2, scr, lane);
    }
    const size_t gt = (size_t)bid * NTHR + tid, NGT = (size_t)G * NTHR;
    { bf16_t* K12 = (bf16_t*)(p.ws + WS_K12);
      for (size_t i = gt; i < (size_t)L_ * 2 * 16384 / 8; i += NGT) { const size_t e = i * 8; const int l = (int)(e / 32768), r = (int)(e % 32768); const float* s = (r < 16384 ? p.in[I_K1] : p.in[I_K2]) + (size_t)l * 16384 + (r & 16383);
        const f32x4 a = *(const f32x4*)s, b = *(const f32x4*)(s + 4); u32x4 o; o.x = pk2(a.x, a.y); o.y = pk2(a.z, a.w); o.z = pk2(b.x, b.y); o.w = pk2(b.z, b.w); *(u32x4*)(K12 + e) = o; } }
    { bf16_t* hb = (bf16_t*)(p.ws + WS_HB);
      unsigned char* h8a = p.ws + WS_R1 + R1_H8; unsigned char* h8b = p.ws + WS_H8T;
      for (int m = 4 * gw; m < T_; m += 4 * NGW) ln_rows<4>(p.in[I_X] + (size_t)m * 1024, p.in[I_LNIN_G], p.in[I_LNIN_B], (float*)nullptr, hb + (size_t)m * 1024, m < H8_SPLIT ? h8a + (size_t)m * 1024 : h8b + (size_t)(m - H8_SPLIT) * 1024, lane); }
}
__device__ __forceinline__ void conv_unit(const KP& p, const Ptrs& P, int l, int unit, unsigned char* lds) {
    bf16_t* hbuf = (bf16_t*)lds;
    float* obuf = (float*)(lds + 94 * 256 * 2);
    const int tid = TIDX(), lane = tid & 63, wave = tid >> 6;
    const int tiles_per_seq = S_ / 64, b = unit / tiles_per_seq, t0 = (unit % tiles_per_seq) * 64;
    for (int e = tid; e < 94 * 32; e += NTHR) { const int r = e >> 5, c8 = (e & 31) * 8; const int t = t0 - 30 + r;
        u32x4 o = (u32x4){0u, 0u, 0u, 0u};
        if (t >= 0) { const bf16_t* row = P.proj + (size_t)(b * S_ + t) * PJ; const u32x4 v = *(const u32x4*)(row + C_CV + c8), g = *(const u32x4*)(row + C_CG + c8);
            o.x = pk2(bflo(v.x) * sigmoidf_(bflo(g.x)), bfhi(v.x) * sigmoidf_(bfhi(g.x))); o.y = pk2(bflo(v.y) * sigmoidf_(bflo(g.y)), bfhi(v.y) * sigmoidf_(bfhi(g.y)));
            o.z = pk2(bflo(v.z) * sigmoidf_(bflo(g.z)), bfhi(v.z) * sigmoidf_(bfhi(g.z))); o.w = pk2(bflo(v.w) * sigmoidf_(bflo(g.w)), bfhi(v.w) * sigmoidf_(bfhi(g.w))); }
        *(u32x4*)(hbuf + r * 256 + c8) = o; }
    __syncthreads();
    { const int c = tid & 255, half = tid >> 8; float w[31], x[62];
#pragma unroll
      for (int j = 0; j < 31; ++j) w[j] = p.in[I_CONVW][(l * 31 + j) * 256 + c];
      const float cb = p.in[I_CONVB][l * 256 + c];
#pragma unroll
      for (int j = 0; j < 62; ++j) x[j] = bf2f(hbuf[(half * 32 + j) * 256 + c]);
#pragma unroll
      for (int tt = 0; tt < 32; ++tt) { float s = cb;
#pragma unroll
          for (int j = 0; j < 31; ++j) s += w[j] * x[tt + j];
          obuf[(half * 32 + tt) * 256 + c] = s; } }
    __syncthreads();
    { const f32x4 g = *(const f32x4*)(p.in[I_CLNG] + l * 256 + 4 * lane), bb = *(const f32x4*)(p.in[I_CLNB] + l * 256 + 4 * lane);
      f32x4 vv[8]; float m1[8], m2[8];
#pragma unroll
      for (int i = 0; i < 8; ++i) { vv[i] = *(const f32x4*)(obuf + (wave * 8 + i) * 256 + 4 * lane); m1[i] = (vv[i].x + vv[i].y) + (vv[i].z + vv[i].w); }
      wave_sum_n<8>(m1);
#pragma unroll
      for (int i = 0; i < 8; ++i) { vv[i] = vv[i] - m1[i] * (1.f / 256.f); m2[i] = (vv[i].x * vv[i].x + vv[i].y * vv[i].y) + (vv[i].z * vv[i].z + vv[i].w * vv[i].w); }
      wave_sum_n<8>(m2);
#pragma unroll
      for (int i = 0; i < 8; ++i) { const int t = wave * 8 + i; const float rstd = 1.f / sqrtf(m2[i] * (1.f / 256.f) + LN_EPS_);
          f32x4 z = vv[i] * rstd * g + bb; u32x2 w; w.x = pk2(z.x * sigmoidf_(z.x), z.y * sigmoidf_(z.y)); w.y = pk2(z.z * sigmoidf_(z.z), z.w * sigmoidf_(z.w));
          *(u32x2*)(P.ycat + (size_t)(b * S_ + t0 + t) * 1024 + 768 + 4 * lane) = w; } }
    __syncthreads();
}

constexpr int S5_NCH = S_ / 64;
constexpr int S5_UPITCH = 1032;
constexpr int S5_XPITCH = 136;
__device__ __forceinline__ void s5_unit(const KP& p, const Ptrs& P, int l, int unit, unsigned char* lds) {
    const int b = unit >> 4, g = unit & 15;
    bf16_t* Uc = (bf16_t*)lds;
    bf16_t* Kc = (bf16_t*)(lds + 66048);
    float* Xe = (float*)(lds + 66048 + 32768);
    bf16_t* Xs = (bf16_t*)(lds + 66048 + 65536);
    const int tid = TIDX(), lane = tid & 63, wave = tid >> 6, r32 = lane & 31, hi = lane >> 5;
    { u32x4 v[8], kc[4];
#pragma unroll
      for (int j = 0; j < 8; ++j) { const int e = tid + j * NTHR, s = e >> 1, hf = e & 1; v[j] = (u32x4){0u, 0u, 0u, 0u};
          if (s < S_) v[j] = *(const u32x4*)(P.proj + (size_t)(b * S_ + s) * PJ + C_S5 + 16 * g + 8 * hf); }
#pragma unroll
      for (int j = 0; j < 4; ++j) kc[j] = *(const u32x4*)(P.S5Kc + (size_t)g * 16384 + (tid + j * NTHR) * 8);
#pragma unroll
      for (int j = 0; j < 8; ++j) { const int e = tid + j * NTHR, s = e >> 1, hf = e & 1; *(u32x4*)(Uc + (s >> 6) * S5_UPITCH + (s & 63) * 16 + 8 * hf) = v[j]; }
#pragma unroll
      for (int j = 0; j < 4; ++j) *(u32x4*)(Kc + (tid + j * NTHR) * 8) = kc[j]; }
    __syncthreads();
    { const int ntile = wave & 3, kh = wave >> 2; f32x16 acc = {};
      const bf16_t* wrow = P.S5Wx + ((size_t)g * 128 + ntile * 32 + r32) * 1024 + kh * 512 + 8 * hi;
      const bf16_t* urow = Uc + r32 * S5_UPITCH + kh * 512 + 8 * hi;
      for (int k8 = 0; k8 < 32; k8 += 8) { bf16x8 bw[8];
#pragma unroll
          for (int j = 0; j < 8; ++j) bw[j] = *(const bf16x8*)(wrow + (k8 + j) * 16);
#pragma unroll
          for (int j = 0; j < 8; ++j) { const bf16x8 a = *(const bf16x8*)(urow + (k8 + j) * 16); acc = MFMA32(a, bw[j], acc); } }
#pragma unroll
      for (int r = 0; r < 16; ++r) { const int c = (r & 3) + 8 * (r >> 2) + 4 * hi; Xe[(kh * 32 + c) * 128 + ntile * 32 + r32] = acc[r]; } }
    __syncthreads();
    if (tid < 64) { const float lr = P.S5LL[(g * 64 + tid) * 2], li = P.S5LL[(g * 64 + tid) * 2 + 1]; float xr = 0.f, xi = 0.f;
        for (int c = 0; c < 32; ++c) { Xs[c * S5_XPITCH + 2 * tid] = (bf16_t)f2bf(xr); Xs[c * S5_XPITCH + 2 * tid + 1] = (bf16_t)f2bf(xi);
            const float er = Xe[c * 128 + 2 * tid] + Xe[(32 + c) * 128 + 2 * tid], ei = Xe[c * 128 + 2 * tid + 1] + Xe[(32 + c) * 128 + 2 * tid + 1];
            const float nr = lr * xr - li * xi + er, ni = lr * xi + li * xr + ei; xr = nr; xi = ni; } }
    __syncthreads();
    { const int tt = r32 >> 4, co = r32 & 15; const float dsk = p.in[I_S5D][l * 256 + 16 * g + co];
      for (int q = 0; q < 4; ++q) { const int ntile = wave + 8 * q, t0 = 2 * ntile; f32x16 acc = {};
          const bf16_t* urow = Uc + r32 * S5_UPITCH + 8 * hi;
          for (int s = 0; s <= t0 + 1; ++s) { const int tau = t0 + tt - s; bf16x8 bk = (bf16x8){0, 0, 0, 0, 0, 0, 0, 0};
              if (tau >= 0) bk = *(const bf16x8*)(Kc + (tau * 16 + co) * 16 + 8 * hi);
              const bf16x8 a = *(const bf16x8*)(urow + s * 16); acc = MFMA32(a, bk, acc); }
          const bf16_t* wy = P.S5Wy + ((size_t)g * 1024 + ntile * 32 + r32) * 128 + 8 * hi; const bf16_t* xrow = Xs + r32 * S5_XPITCH + 8 * hi;
#pragma unroll
          for (int ks = 0; ks < 8; ++ks) { const bf16x8 a = *(const bf16x8*)(xrow + ks * 16); const bf16x8 bw = *(const bf16x8*)(wy + ks * 16); acc = MFMA32(a, bw, acc); }
#pragma unroll
          for (int r = 0; r < 16; ++r) { const int c = (r & 3) + 8 * (r >> 2) + 4 * hi; const int s = c * 64 + t0 + tt;
              if (s < S_) { const float uu = bf2f(Uc[c * S5_UPITCH + (t0 + tt) * 16 + co]); const float y = acc[r] + dsk * uu;
                  P.ycat[(size_t)(b * S_ + s) * 1024 + 256 + 16 * g + co] = (bf16_t)f2bf(gelu_erf(y)); } } } }
    __syncthreads();
}
constexpr float LOG2E_ = 1.4426950408889634f;
__device__ __forceinline__ float log_sigmoid_(float x) { return fminf(x, 0.f) - log1pf(__expf(-fabsf(x))); }
__device__ __forceinline__ void fox_unit(const KP& p, const Ptrs& P, int l, int unit, unsigned char* lds) {
    constexpr int NQB = S_ / 256;
    const int bh = unit / NQB, qb = (unit >= (NB_ * 4 * NQB) / 2) ? NQB - 1 - unit % NQB : unit % NQB, b = bh >> 2, h = bh & 3, q0 = qb * 256;
    float* cl = (float*)lds;
    unsigned char* Kt = lds + S_ * 4;
    unsigned char* Vt = Kt + 8192;
    float* wsf = (float*)(Kt + 32768);
    float* sc = wsf + 256;
    const int tid = TIDX(), lane = tid & 63, wave = tid >> 6, r32 = lane & 31, hi = lane >> 5;
    const int qend = q0 + 256;
    { constexpr int PER = (S_ + 511) / 512; const float bf = p.in[I_BF][l * 4 + h]; float loc[PER]; float s = 0.f;
#pragma unroll
      for (int i = 0; i < PER; ++i) { const int t = tid * PER + i; float v = 0.f;
          if (t < qend) v = log_sigmoid_(bf2f(P.proj[(size_t)(b * S_ + t) * PJ + C_FL + h]) + bf) * LOG2E_;
          s += v; loc[i] = s; }
      sc[tid] = s; __syncthreads();
      for (int off = 1; off < 512; off <<= 1) { const float v = sc[tid] + (tid >= off ? sc[tid - off] : 0.f); __syncthreads(); sc[tid] = v; __syncthreads(); }
      const float base = sc[tid] - s;
#pragma unroll
      for (int i = 0; i < PER; ++i) { const int t = tid * PER + i; if (t < S_) cl[t] = base + loc[i]; }
      __syncthreads(); }
    const int qrow = q0 + 32 * wave + r32;
    constexpr float C2 = 0.125f * LOG2E_;
    bf16x8 qr[4];
    { const bf16_t* qp = P.proj + (size_t)(b * S_ + qrow) * PJ + C_FQ + 64 * h + 8 * hi;
#pragma unroll
      for (int d0 = 0; d0 < 4; ++d0) { const u32x4 w = *(const u32x4*)(qp + 16 * d0);
          u32x4 o; o.x = pk2(bflo(w.x) * C2, bfhi(w.x) * C2); o.y = pk2(bflo(w.y) * C2, bfhi(w.y) * C2); o.z = pk2(bflo(w.z) * C2, bfhi(w.z) * C2); o.w = pk2(bflo(w.w) * C2, bfhi(w.w) * C2);
          qr[d0] = __builtin_bit_cast(bf16x8, o); } }
    const float clq = cl[qrow];
    float mrun = -INFINITY, lrun = 0.f; f32x16 o0 = {}, o1 = {};
    const int NT = qend / 64;
    const int srow = tid >> 3, sch = tid & 7;
    const bf16_t* kg = P.proj + (size_t)(b * S_ + srow) * PJ + C_FK + 64 * h + 8 * sch;
    const bf16_t* vg = P.vtr + (size_t)(64 * h + srow) * T_ + (size_t)b * S_ + 8 * sch;
    const int koff = srow * 128 + ((sch ^ ((srow >> 1) & 7)) * 16);
    const int voffa = srow * 128 + (((2 * sch) ^ ((srow >> 1) & 15)) * 8), voffb = srow * 128 + (((2 * sch + 1) ^ ((srow >> 1) & 15)) * 8);
    u32x4 kreg = *(const u32x4*)kg, vreg = *(const u32x4*)vg;
    *(u32x4*)(Kt + koff) = kreg; *(u32x2*)(Vt + voffa) = (u32x2){vreg.x, vreg.y}; *(u32x2*)(Vt + voffb) = (u32x2){vreg.z, vreg.w};
    if (NT > 1) { kreg = *(const u32x4*)(kg + (size_t)64 * PJ); vreg = *(const u32x4*)(vg + 64); }
    __syncthreads();
    for (int jt = 0; jt < NT; ++jt) {
        const int kv0 = jt * 64; const unsigned char* Kb = Kt + (jt & 1) * 16384; const unsigned char* Vb = Vt + (jt & 1) * 16384;
        if (kv0 <= q0 + 32 * wave + 31) {
            f32x16 pt[2];
#pragma unroll
            for (int kvt = 0; kvt < 2; ++kvt) { const int row = 32 * kvt + r32; f32x16 acc;
#pragma unroll
                for (int g4 = 0; g4 < 4; ++g4) { const f32x4 c4 = *(const f32x4*)(cl + kv0 + 32 * kvt + 8 * g4 + 4 * hi);
#pragma unroll
                    for (int e = 0; e < 4; ++e) acc[4 * g4 + e] = clq - c4[e]; }
#pragma unroll
                for (int d0 = 0; d0 < 4; ++d0) { const bf16x8 a = *(const bf16x8*)(Kb + row * 128 + (((2 * d0 + hi) ^ ((row >> 1) & 7)) * 16)); acc = MFMA32(a, qr[d0], acc); }
                pt[kvt] = acc; }
            if (kv0 + 63 > q0 + 32 * wave) {
#pragma unroll
                for (int kvt = 0; kvt < 2; ++kvt)
#pragma unroll
                    for (int r = 0; r < 16; ++r) { const int key = kv0 + 32 * kvt + (r & 3) + 8 * (r >> 2) + 4 * hi; if (key > qrow) pt[kvt][r] = -INFINITY; } }
            float mx = -INFINITY;
#pragma unroll
            for (int kvt = 0; kvt < 2; ++kvt)
#pragma unroll
                for (int r = 0; r < 16; ++r) mx = fmaxf(mx, pt[kvt][r]);
            mx = fmaxf(mx, __shfl_xor(mx, 32));
            const float mnew = fmaxf(mrun, mx), alpha = FAST_EXP2(mrun - mnew); mrun = mnew;
            float ls = 0.f;
#pragma unroll
            for (int kvt = 0; kvt < 2; ++kvt)
#pragma unroll
                for (int r = 0; r < 16; ++r) { const float e = FAST_EXP2(pt[kvt][r] - mnew); pt[kvt][r] = e; ls += e; }
            lrun = lrun * alpha + ls;
            float* wf = wsf + wave * 32;
            WAVE_SYNC(); if (hi == 0) wf[r32] = alpha; WAVE_SYNC();
#pragma unroll
            for (int g4 = 0; g4 < 4; ++g4) { const f32x4 f = *(const f32x4*)(wf + 8 * g4 + 4 * hi);
#pragma unroll
                for (int e = 0; e < 4; ++e) { o0[4 * g4 + e] *= f[e]; o1[4 * g4 + e] *= f[e]; } }
#pragma unroll
            for (int s = 0; s < 4; ++s) { const int kvt = s >> 1, rb = 8 * (s & 1);
                u32x4 pw; pw.x = pk2(pt[kvt][rb + 0], pt[kvt][rb + 1]); pw.y = pk2(pt[kvt][rb + 2], pt[kvt][rb + 3]); pw.z = pk2(pt[kvt][rb + 4], pt[kvt][rb + 5]); pw.w = pk2(pt[kvt][rb + 6], pt[kvt][rb + 7]);
                const bf16x8 pa = __builtin_bit_cast(bf16x8, pw);
#pragma unroll
                for (int dt = 0; dt < 2; ++dt) { const int d = 32 * dt + r32; const int sw = (d >> 1) & 15;
                    const u32x2 va = *(const u32x2*)(Vb + d * 128 + (((4 * s + hi) ^ sw) * 8)), vb = *(const u32x2*)(Vb + d * 128 + (((4 * s + 2 + hi) ^ sw) * 8));
                    const bf16x8 vf = __builtin_bit_cast(bf16x8, (u32x4){va.x, va.y, vb.x, vb.y});
                    if (dt == 0) o0 = MFMA32(pa, vf, o0); else o1 = MFMA32(pa, vf, o1); } }
        }
        if (jt + 1 < NT) { unsigned char* Kn = Kt + ((jt + 1) & 1) * 16384; unsigned char* Vn = Vt + ((jt + 1) & 1) * 16384;
            *(u32x4*)(Kn + koff) = kreg; *(u32x2*)(Vn + voffa) = (u32x2){vreg.x, vreg.y}; *(u32x2*)(Vn + voffb) = (u32x2){vreg.z, vreg.w};
            if (jt + 2 < NT) { kreg = *(const u32x4*)(kg + (size_t)(kv0 + 128) * PJ); vreg = *(const u32x4*)(vg + kv0 + 128); } }
        __syncthreads();
    }
    { const float lt = lrun + __shfl_xor(lrun, 32); float* wf = wsf + wave * 32;
      WAVE_SYNC(); if (hi == 0) wf[r32] = 1.0f / lt; WAVE_SYNC();
      bf16_t* orow = P.ycat + (size_t)(b * S_ + q0 + 32 * wave) * 1024 + 512 + 64 * h + r32;
#pragma unroll
      for (int r = 0; r < 16; ++r) { const int qq = (r & 3) + 8 * (r >> 2) + 4 * hi; const float f = wf[qq];
          orow[(size_t)qq * 1024] = (bf16_t)f2bf(o0[r] * f); orow[(size_t)qq * 1024 + 32] = (bf16_t)f2bf(o1[r] * f); } }
    __syncthreads();
}

constexpr int RW_NCH = S_ / 64;
constexpr int RWP = 72;
constexpr int RW_ARR = 64 * RWP * 2;
constexpr int RW_SCRP = 388;
__device__ __forceinline__ void rw_stage_weights(const KP& p, int l, int h, bf16_t* wb, int tid) {
    for (int e = tid; e < 2048; e += NTHR) { const int m = e >> 4, c4 = (e & 15) * 4;
        if (m < 32) { const f32x4 v = *(const f32x4*)(p.in[I_A2] + (l * 32 + m) * 256 + 64 * h + c4);
#pragma unroll
            for (int q = 0; q < 4; ++q) wb[(c4 + q) * 40 + m] = (bf16_t)f2bf(v[q]); }
        else if (m < 64) { const f32x4 v = *(const f32x4*)(p.in[I_W2] + (l * 32 + m - 32) * 256 + 64 * h + c4);
#pragma unroll
            for (int q = 0; q < 4; ++q) wb[2560 + (c4 + q) * 40 + (m - 32)] = (bf16_t)f2bf(v[q]); }
        else { const f32x4 v = *(const f32x4*)(p.in[I_G2] + (l * 64 + m - 64) * 256 + 64 * h + c4);
#pragma unroll
            for (int q = 0; q < 4; ++q) wb[5120 + (c4 + q) * 72 + (m - 64)] = (bf16_t)f2bf(v[q]); } }
    __syncthreads();
}
__device__ __forceinline__ bf16x8 rw_pack8(const float* q) { const f32x4 a = *(const f32x4*)q, b = *(const f32x4*)(q + 4);
    u32x4 w; w.x = pk2(a.x, a.y); w.y = pk2(a.z, a.w); w.z = pk2(b.x, b.y); w.w = pk2(b.z, b.w); return __builtin_bit_cast(bf16x8, w); }
template <int NT, bool NEED_W, bool NEED_G>
__device__ __forceinline__ void rw_prep(const KP& p, const Ptrs& P, int l, int b, int h, int tpos0, float* scr, const bf16_t* wb, int lane,
                                        float (&r)[NT], float (&lw)[NT], float (&k2)[NT], float (&v)[NT], float (&ain)[NT], float (&bin)[NT], float (&g)[NT], float (&rk)[NT]) {
    constexpr int NIT = (NT * 40 + 63) / 64;
    u32x4 cur[NIT], prv[NIT];
#pragma unroll
    for (int i = 0; i < NIT; ++i) { const int e = lane + 64 * i; const int tt = e / 40, ch = e % 40; const int t = tpos0 + tt;
        const int col = ch < 8 ? C_R + 64 * h + 8 * ch : ch < 16 ? C_K + 64 * h + 8 * (ch - 8) : ch < 24 ? C_V + 64 * h + 8 * (ch - 16) : C_HW + 8 * (ch - 24);
        cur[i] = (u32x4){0u, 0u, 0u, 0u}; prv[i] = (u32x4){0u, 0u, 0u, 0u};
        if (e < NT * 40) { const bf16_t* row = P.proj + (size_t)(b * S_ + t) * PJ + col; cur[i] = *(const u32x4*)row; if (t > 0) prv[i] = *(const u32x4*)(row - PJ); } }
#pragma unroll
    for (int i = 0; i < NIT; ++i) { const int e = lane + 64 * i; const int tt = e / 40, ch = e % 40;
        const int col = ch < 8 ? C_R + 64 * h + 8 * ch : ch < 16 ? C_K + 64 * h + 8 * (ch - 8) : ch < 24 ? C_V + 64 * h + 8 * (ch - 16) : C_HW + 8 * (ch - 24);
        const int idx = ch < 24 ? 8 * ch : 192 + 8 * (ch - 24);
        if (e < NT * 40) { const f32x4 m0 = *(const f32x4*)(p.in[I_MU] + l * 896 + col), m1 = *(const f32x4*)(p.in[I_MU] + l * 896 + col + 4);
            float z[8] = {bflo(cur[i].x), bfhi(cur[i].x), bflo(cur[i].y), bfhi(cur[i].y), bflo(cur[i].z), bfhi(cur[i].z), bflo(cur[i].w), bfhi(cur[i].w)};
            const float zp[8] = {bflo(prv[i].x), bfhi(prv[i].x), bflo(prv[i].y), bfhi(prv[i].y), bflo(prv[i].z), bfhi(prv[i].z), bflo(prv[i].w), bfhi(prv[i].w)};
#pragma unroll
            for (int q = 0; q < 8; ++q) { float zs = z[q] + (zp[q] - z[q]) * (q < 4 ? m0[q & 3] : m1[q & 3]);
                if (ch >= 24 && ch < 28) zs = 1.0f - 2.0f * FAST_RCP(1.0f + FAST_EXP2(zs * 2.8853900817779268f));
                else if (ch >= 32) zs = sigmoidf_(zs);
                z[q] = zs; }
            *(f32x4*)(scr + tt * RW_SCRP + idx) = (f32x4){z[0], z[1], z[2], z[3]}; *(f32x4*)(scr + tt * RW_SCRP + idx + 4) = (f32x4){z[4], z[5], z[6], z[7]}; } }
    WAVE_SYNC();
    { const int fr = lane & 15, fq = lane >> 4; const float* hrow = scr + (fr & 7) * RW_SCRP + 192 + 8 * fq;
      const bf16x8 fw = rw_pack8(hrow), fa = rw_pack8(hrow + 32), fg0 = rw_pack8(hrow + 64), fg1 = rw_pack8(hrow + 96);
      WAVE_SYNC();
#pragma unroll
      for (int nt = 0; nt < 4; ++nt) { const f32x4 z4 = (f32x4){0.f, 0.f, 0.f, 0.f};
          const f32x4 da = MFMA16(fa, *(const bf16x8*)(wb + (16 * nt + fr) * 40 + 8 * fq), z4);
          f32x4 dw = z4, dg = z4;
          if (NEED_W) dw = MFMA16(fw, *(const bf16x8*)(wb + 2560 + (16 * nt + fr) * 40 + 8 * fq), z4);
          if (NEED_G) { dg = MFMA16(fg0, *(const bf16x8*)(wb + 5120 + (16 * nt + fr) * 72 + 8 * fq), z4); dg = MFMA16(fg1, *(const bf16x8*)(wb + 5120 + (16 * nt + fr) * 72 + 32 + 8 * fq), dg); }
          if (fq < 2) {
#pragma unroll
              for (int q = 0; q < 4; ++q) { float* o = scr + (4 * fq + q) * RW_SCRP + 16 * nt + fr; o[192] = da[q]; if (NEED_W) o[256] = dw[q]; if (NEED_G) o[320] = dg[q]; } } }
      WAVE_SYNC(); }
    const int j = lane, cj = 64 * h + j; float wl[NT], al[NT], gg[NT];
    const float w0 = p.in[I_W0][l * 256 + cj], a0 = p.in[I_A0][l * 256 + cj];
#pragma unroll
    for (int tt = 0; tt < NT; ++tt) { al[tt] = a0 + scr[tt * RW_SCRP + 192 + j]; wl[tt] = NEED_W ? w0 + scr[tt * RW_SCRP + 256 + j] : w0; gg[tt] = NEED_G ? scr[tt * RW_SCRP + 320 + j] : 0.f; }
    const float kkw = p.in[I_KK][l * 256 + cj], kaw = p.in[I_KA][l * 256 + cj], rkw = p.in[I_RK][l * 256 + cj];
    float ssum[NT], rsum[NT], kkv[NT], av[NT];
#pragma unroll
    for (int tt = 0; tt < NT; ++tt) {
        const float a = sigmoidf_(al[tt]); av[tt] = a;
        const float rr = scr[tt * RW_SCRP + j], k = scr[tt * RW_SCRP + 64 + j], vv = scr[tt * RW_SCRP + 128 + j];
        const float kk2 = k * (1.f + (a - 1.f) * kaw);
        r[tt] = rr; k2[tt] = kk2; v[tt] = vv;
        const float kk = k * kkw; kkv[tt] = kk; ssum[tt] = kk * kk; rsum[tt] = rr * kk2 * rkw; }
    if (NEED_W) wave_sum_n<NT>(ssum);
    if (NEED_G) wave_sum_n<NT>(rsum);
#pragma unroll
    for (int tt = 0; tt < NT; ++tt) {
        if (NEED_W) { const float x = -wl[tt]; const float sp = fmaxf(x, 0.f) + 0.6931471805599453f * FAST_LOG2(1.0f + FAST_EXP2(-1.4426950408889634f * fabsf(x)));
            lw[tt] = -FAST_EXP2(-1.4426950408889634f * (sp + 0.5f));
            const float kkn = kkv[tt] * FAST_RSQ(fmaxf(ssum[tt], 1e-24f));
            ain[tt] = -kkn; bin[tt] = kkn * av[tt]; }
        if (NEED_G) { g[tt] = gg[tt]; rk[tt] = rsum[tt]; }
    }
    WAVE_SYNC();
}
__device__ __forceinline__ bf16x8 ldsb8(const bf16_t* p) { return *(const bf16x8*)p; }
__device__ __forceinline__ f32x16 rw_tile(const bf16_t* X, const bf16_t* Y, int tm, int tn, int r32, int hi, f32x16 acc) {
    const bf16_t* xa = X + (32 * tm + r32) * RWP + 8 * hi; const bf16_t* yb = Y + (32 * tn + r32) * RWP + 8 * hi;
#pragma unroll
    for (int ks = 0; ks < 4; ++ks) acc = MFMA32(ldsb8(xa + 16 * ks), ldsb8(yb + 16 * ks), acc);
    return acc;
}
template <int STOP = 0>
__device__ __forceinline__ void rw_chunk_unit(const KP& p, const Ptrs& P, int l, int unit, unsigned char* lds) {
    MEMFENCE(); OPAQUE_S(unit);
    const int c = unit % RW_NCH, bh = unit / RW_NCH, b = bh >> 2, h = bh & 3, t0 = c * 64;
    bf16_t* AT = (bf16_t*)(lds + 0 * RW_ARR); bf16_t* RT = (bf16_t*)(lds + 1 * RW_ARR); bf16_t* BT = (bf16_t*)(lds + 2 * RW_ARR); bf16_t* KT = (bf16_t*)(lds + 3 * RW_ARR);
    bf16_t* BH = (bf16_t*)(lds + 4 * RW_ARR); bf16_t* KH = (bf16_t*)(lds + 5 * RW_ARR); bf16_t* VT = (bf16_t*)(lds + 6 * RW_ARR);
    bf16_t* AAK = (bf16_t*)(lds + 7 * RW_ARR); bf16_t* ARB = (bf16_t*)(lds + 8 * RW_ARR); bf16_t* ARK = (bf16_t*)(lds + 9 * RW_ARR);
    bf16_t* W1T = (bf16_t*)(lds + 10 * RW_ARR); bf16_t* UVT = (bf16_t*)(lds + 11 * RW_ARR);
    bf16_t* RHT = (bf16_t*)(lds + 12 * RW_ARR);
    float* ADG = (float*)(lds + 14 * RW_ARR);
    bf16_t* ABA = (bf16_t*)(lds + 14 * RW_ARR + 8192);
    float* WT = (float*)(lds + 14 * RW_ARR + 8192 + 32 * RWP * 2);
    float* GC = WT + 512;
    bf16_t* DAB = AT;
    const int tid = TIDX(), lane = tid & 63, wave = tid >> 6, r32 = lane & 31, hi = lane >> 5;
    float r[8], lw[8], k2[8], v[8], ain[8], bin[8], gg[8], rk[8];
    rw_stage_weights(p, l, h, (bf16_t*)(lds + 8 * 8 * RW_SCRP * 4), tid);
    rw_prep<8, true, true>(p, P, l, b, h, t0 + 8 * wave, (float*)lds + wave * (8 * RW_SCRP), (const bf16_t*)(lds + 8 * 8 * RW_SCRP * 4), lane, r, lw, k2, v, ain, bin, gg, rk);
#pragma unroll
    for (int i = 0; i < 8; ++i) { const size_t o = (size_t)(b * S_ + t0 + 8 * wave + i) * 256 + 64 * h + lane; P.rwGt[o] = (bf16_t)f2bf(gg[i]); P.rwRKV[o] = (bf16_t)f2bf(rk[i] * v[i]); }
    float Lloc[8]; { float s = 0.f;
#pragma unroll
      for (int i = 0; i < 8; ++i) { s += lw[i]; Lloc[i] = s; } }
    __syncthreads();
    if (STOP == 1) return;
    WT[wave * 64 + lane] = Lloc[7];
    __syncthreads();
    { float off = 0.f, tot = 0.f;
#pragma unroll
      for (int w = 0; w < 8; ++w) { const float x = WT[w * 64 + lane]; tot += x; if (w < wave) off += x; }
      if (wave == 0) GC[lane] = __expf(tot);
      unsigned bhp[4], khp[4], vtp[4], atp[4]; float pb = 0.f, pk = 0.f, pv = 0.f, pa = 0.f;
#pragma unroll
      for (int i = 0; i < 8; ++i) { const int t = 8 * wave + i; const float Lt = off + Lloc[i], Lp = Lt - lw[i];
          const float eL = __expf(Lt), eLp = __expf(Lp), einv = __expf(-Lt), eh = __expf(tot - Lt);
          const float xa = ain[i] * eLp;
          AT[t * RWP + lane] = (bf16_t)f2bf(xa); RT[t * RWP + lane] = (bf16_t)f2bf(r[i] * eL);
          BT[t * RWP + lane] = (bf16_t)f2bf(bin[i] * einv); KT[t * RWP + lane] = (bf16_t)f2bf(k2[i] * einv);
          const float xb = bin[i] * eh, xk = k2[i] * eh, xv = v[i];
          if (i & 1) { bhp[i >> 1] = pk2(pb, xb); khp[i >> 1] = pk2(pk, xk); vtp[i >> 1] = pk2(pv, xv); atp[i >> 1] = pk2(pa, xa); } else { pb = xb; pk = xk; pv = xv; pa = xa; } }
      *(u32x4*)(BH + lane * RWP + 8 * wave) = (u32x4){bhp[0], bhp[1], bhp[2], bhp[3]};
      *(u32x4*)(KH + lane * RWP + 8 * wave) = (u32x4){khp[0], khp[1], khp[2], khp[3]};
      *(u32x4*)(VT + lane * RWP + 8 * wave) = (u32x4){vtp[0], vtp[1], vtp[2], vtp[3]};
      *(u32x4*)(RHT + (64 + lane) * RWP + 8 * wave) = (u32x4){atp[0], atp[1], atp[2], atp[3]}; }
    __syncthreads();
#pragma unroll
    for (int jj = 0; jj < 2; ++jj) { const int job = wave + 8 * jj, mat = job >> 2, tm = (job >> 1) & 1, tn = job & 1;
        f32x16 acc = {};
        if (!(tm == 0 && tn == 1)) acc = rw_tile((mat & 2) ? RT : AT, (mat & 1) ? KT : BT, tm, tn, r32, hi, acc);
        const int s = 32 * tn + r32;
#pragma unroll
        for (int q = 0; q < 16; ++q) { const int t = 32 * tm + (q & 3) + 8 * (q >> 2) + 4 * hi;
            const bool keep = (mat & 2) ? (s <= t) : (s < t); const float x = keep ? acc[q] : 0.f;
            if (mat == 0) { if (tm == tn) ADG[(tm * 32 + (t & 31)) * 32 + (s & 31)] = x; else if (tm == 1) ABA[(t & 31) * RWP + s] = (bf16_t)f2bf(x); } else { bf16_t* D = (mat == 1) ? AAK : (mat == 2) ? ARB : ARK; D[t * RWP + s] = (bf16_t)f2bf(x); } } }
    __syncthreads();
    if (STOP == 2) return;
    if (wave < 4) { const int tm = wave >> 1, tn = wave & 1; f32x16 acc = {}; acc = rw_tile(VT, AAK, tm, tn, r32, hi, acc);
#pragma unroll
        for (int q = 0; q < 16; ++q) { const int i = 32 * tm + (q & 3) + 8 * (q >> 2) + 4 * hi; RHT[i * RWP + 32 * tn + r32] = (bf16_t)f2bf(acc[q]); } }
    else if (wave == 4) { float d[32]; const LAS float* ab = (const LAS float*)ADG + hi * 1024;
#pragma unroll
        for (int t = 0; t < 32; ++t) d[t] = (t == r32) ? 1.f : 0.f;
#pragma unroll
        for (int t = 1; t < 32; ++t) { float s0 = 0.f, s1 = 0.f;
#pragma unroll
            for (int s4 = 0; s4 < (t + 3) / 4; ++s4) { const f32x4 a4 = *(const LAS f32x4*)(ab + t * 32 + 4 * s4);
                s0 += a4[0] * d[4 * s4]; s1 += a4[1] * d[4 * s4 + 1]; s0 += a4[2] * d[4 * s4 + 2]; s1 += a4[3] * d[4 * s4 + 3]; }
            d[t] += s0 + s1; if ((t & 3) == 3) MEMFENCE(); }
        LAS bf16_t* D = (LAS bf16_t*)DAB + hi * 32 * RWP + r32;
#pragma unroll
        for (int t = 0; t < 32; ++t) D[t * RWP] = (bf16_t)f2bf(d[t]); }
    __syncthreads();
    if (wave < 4) { bf16_t* XT = (wave < 2 ? UVT : W1T) + (32 * (wave & 1)) * RWP;
        const bf16_t* rh = RHT + (32 * wave + r32) * RWP + 8 * hi;
        { f32x16 acc = {}; const bf16_t* da = DAB + r32 * RWP + 8 * hi;
#pragma unroll
          for (int ks = 0; ks < 2; ++ks) acc = MFMA32(ldsb8(rh + 16 * ks), ldsb8(da + 16 * ks), acc);
#pragma unroll
          for (int q = 0; q < 16; ++q) XT[((q & 3) + 8 * (q >> 2) + 4 * hi) * RWP + r32] = (bf16_t)f2bf(acc[q]); }
        WAVE_SYNC();
        { f32x16 acc; const bf16_t* rz = RHT + (32 * wave) * RWP + 32 + r32;
#pragma unroll
          for (int q = 0; q < 16; ++q) acc[q] = bf2f(rz[((q & 3) + 8 * (q >> 2) + 4 * hi) * RWP]);
          const bf16_t* xa = XT + r32 * RWP + 8 * hi; const bf16_t* ba = ABA + r32 * RWP + 8 * hi;
#pragma unroll
          for (int ks = 0; ks < 2; ++ks) acc = MFMA32(ldsb8(xa + 16 * ks), ldsb8(ba + 16 * ks), acc);
#pragma unroll
          for (int q = 0; q < 16; ++q) XT[((q & 3) + 8 * (q >> 2) + 4 * hi) * RWP + 32 + r32] = (bf16_t)f2bf(acc[q]); }
        WAVE_SYNC();
        { f32x16 acc = {}; const bf16_t* xz = XT + r32 * RWP + 32 + 8 * hi; const bf16_t* db = DAB + (32 + r32) * RWP + 8 * hi;
          const bf16x8 z0 = ldsb8(xz), z1 = ldsb8(xz + 16);
          acc = MFMA32(z0, ldsb8(db), acc); acc = MFMA32(z1, ldsb8(db + 16), acc);
          WAVE_SYNC();
#pragma unroll
          for (int q = 0; q < 16; ++q) XT[((q & 3) + 8 * (q >> 2) + 4 * hi) * RWP + 32 + r32] = (bf16_t)f2bf(acc[q]); } }
    __syncthreads();
    if (STOP == 3) return;
    const size_t chunk = (size_t)unit;
#pragma unroll
    for (int jj = 0; jj < 2; ++jj) { const int job = wave + 8 * jj, kind = job >> 2, tm = (job >> 1) & 1, tn = job & 1; f32x16 acc = {};
        const int col = 32 * tn + r32;
        if (kind == 0) { acc = rw_tile(BH, W1T, tm, tn, r32, hi, acc);
            bf16_t* PT = P.rwPT + chunk * 4096;
#pragma unroll
            for (int q = 0; q < 16; ++q) { const int row = 32 * tm + (q & 3) + 8 * (q >> 2) + 4 * hi; const float x = acc[q] + (row == col ? GC[row] : 0.f); PT[row * 64 + col] = (bf16_t)f2bf(x); } }
        else if (kind == 1) { acc = rw_tile(ARB, W1T, tm, tn, r32, hi, acc);
#pragma unroll
            for (int q = 0; q < 16; ++q) { const int t = 32 * tm + (q & 3) + 8 * (q >> 2) + 4 * hi; const float x = acc[q] + bf2f(RT[t * RWP + col]);
                P.rwQ[(size_t)(b * S_ + t0 + t) * 256 + 64 * h + col] = (bf16_t)f2bf(x); } }
        else if (kind == 2) { acc = rw_tile(UVT, BH, tm, tn, r32, hi, acc); acc = rw_tile(VT, KH, tm, tn, r32, hi, acc);
            unsigned* Gg = (unsigned*)(P.rwG + chunk * 4096) + (tm * 2 + tn) * 8 * 64 + lane;
#pragma unroll
            for (int q = 0; q < 8; ++q) Gg[q * 64] = pk2(acc[2 * q], acc[2 * q + 1]); }
        else { acc = rw_tile(ARB, UVT, tm, tn, r32, hi, acc); acc = rw_tile(ARK, VT, tm, tn, r32, hi, acc);
#pragma unroll
            for (int q = 0; q < 16; ++q) { const int t = 32 * tm + (q & 3) + 8 * (q >> 2) + 4 * hi; P.ycat[(size_t)(b * S_ + t0 + t) * 1024 + 64 * h + col] = (bf16_t)f2bf(acc[q]); } } }
    __syncthreads();
}
__device__ __forceinline__ void rw_state_unit(const KP& p, const Ptrs& P, int l, int unit, unsigned char* lds) {
    bf16_t* Sb = (bf16_t*)lds;
    const int tid = TIDX(), lane = tid & 63, wave = tid >> 6, r32 = lane & 31, hi = lane >> 5;
    const int ti = (wave >> 1) & 1, tj = wave & 1;
    f32x16 S = {};
    unsigned gq[8]; bf16x8 pq[4];
    if (wave < 4) { const size_t chunk = (size_t)unit * RW_NCH; const unsigned* Gg = (const unsigned*)(P.rwG + chunk * 4096) + (ti * 2 + tj) * 8 * 64 + lane;
#pragma unroll
        for (int q = 0; q < 8; ++q) gq[q] = Gg[q * 64];
        const bf16_t* pt = P.rwPT + chunk * 4096 + (32 * tj + r32) * 64 + 8 * hi;
#pragma unroll
        for (int ks = 0; ks < 4; ++ks) pq[ks] = *(const bf16x8*)(pt + 16 * ks); }
    for (int c = 0; c < RW_NCH; ++c) { const size_t chunk = (size_t)unit * RW_NCH + c;
        unsigned gn[8]; bf16x8 pn[4];
        if (wave < 4) { const size_t cn = chunk + (c + 1 < RW_NCH ? 1 : 0); const unsigned* Gg = (const unsigned*)(P.rwG + cn * 4096) + (ti * 2 + tj) * 8 * 64 + lane;
#pragma unroll
            for (int q = 0; q < 8; ++q) gn[q] = Gg[q * 64];
            const bf16_t* pt = P.rwPT + cn * 4096 + (32 * tj + r32) * 64 + 8 * hi;
#pragma unroll
            for (int ks = 0; ks < 4; ++ks) pn[ks] = *(const bf16x8*)(pt + 16 * ks);
#pragma unroll
            for (int q = 0; q < 16; ++q) Sb[(32 * ti + (q & 3) + 8 * (q >> 2) + 4 * hi) * RWP + 32 * tj + r32] = (bf16_t)f2bf(S[q]); }
        __syncthreads();
        { const int row = tid >> 3, ch = tid & 7; *(u32x4*)(P.rwS0 + chunk * 4096 + row * 64 + ch * 8) = *(const u32x4*)(Sb + row * RWP + ch * 8); }
        if (wave < 4) { f32x16 acc;
#pragma unroll
            for (int q = 0; q < 8; ++q) { acc[2 * q] = bflo(gq[q]); acc[2 * q + 1] = bfhi(gq[q]); }
            const bf16_t* sa = Sb + (32 * ti + r32) * RWP + 8 * hi;
#pragma unroll
            for (int ks = 0; ks < 4; ++ks) acc = MFMA32(ldsb8(sa + 16 * ks), pq[ks], acc);
            S = acc;
#pragma unroll
            for (int q = 0; q < 8; ++q) gq[q] = gn[q];
#pragma unroll
            for (int ks = 0; ks < 4; ++ks) pq[ks] = pn[ks]; }
        __syncthreads();
    }
}
template <bool DUMMY = false>
__device__ __forceinline__ void rw_out_unit(const KP& p, const Ptrs& P, int l, int unit, unsigned char* lds) {
    MEMFENCE(); OPAQUE_S(unit);
    const int c = unit % RW_NCH, bh = unit / RW_NCH, b = bh >> 2, h = bh & 3, t0 = c * 64;
    float* Yb = (float*)(lds + 81920);
    const int tid = TIDX(), lane = tid & 63, wave = tid >> 6, r32 = lane & 31, hi = lane >> 5;
    float g[8], rkv[8];
#pragma unroll
    for (int i = 0; i < 8; ++i) { const size_t o = (size_t)(b * S_ + t0 + 8 * wave + i) * 256 + 64 * h + lane; g[i] = bf2f(P.rwGt[o]); rkv[i] = bf2f(P.rwRKV[o]); }
    if (wave < 4) { const int tm = wave >> 1, tn = wave & 1; f32x16 acc; const int col = 32 * tn + r32;
        const bf16_t* yl = P.ycat + (size_t)(b * S_ + t0 + 32 * tm) * 1024 + 64 * h + col;
#pragma unroll
        for (int q = 0; q < 16; ++q) acc[q] = bf2f(yl[(size_t)((q & 3) + 8 * (q >> 2) + 4 * hi) * 1024]);
        const bf16_t* qa = P.rwQ + (size_t)(b * S_ + t0 + 32 * tm + r32) * 256 + 64 * h + 8 * hi; const bf16_t* sb = P.rwS0 + (size_t)unit * 4096 + (32 * tn + r32) * 64 + 8 * hi;
#pragma unroll
        for (int ks = 0; ks < 4; ++ks) acc = MFMA32(*(const bf16x8*)(qa + 16 * ks), *(const bf16x8*)(sb + 16 * ks), acc);
#pragma unroll
        for (int q = 0; q < 16; ++q) Yb[(32 * tm + (q & 3) + 8 * (q >> 2) + 4 * hi) * 64 + col] = acc[q]; }
    __syncthreads();
    const float gng = p.in[I_LNXG][l * 256 + 64 * h + lane], gnb = p.in[I_LNXB][l * 256 + 64 * h + lane];
    { float yv[8], m1[8], m2[8];
#pragma unroll
      for (int i = 0; i < 8; ++i) { yv[i] = Yb[(8 * wave + i) * 64 + lane]; m1[i] = yv[i]; }
      wave_sum_n<8>(m1);
#pragma unroll
      for (int i = 0; i < 8; ++i) { yv[i] -= m1[i] * (1.f / 64.f); m2[i] = yv[i] * yv[i]; }
      wave_sum_n<8>(m2);
#pragma unroll
      for (int i = 0; i < 8; ++i) { const int t = 8 * wave + i; const float yn = yv[i] * (1.0f / sqrtf(m2[i] * (1.f / 64.f) + GN_EPS_)) * gng + gnb; const float o = (yn + rkv[i]) * g[i];
        if (DUMMY) P.pb[(size_t)(b * S_ + t0 + t) * 256 + 64 * h + lane] = (bf16_t)f2bf(o);
        else P.ycat[(size_t)(b * S_ + t0 + t) * 1024 + 64 * h + lane] = (bf16_t)f2bf(o); } }
    __syncthreads();
}
#ifdef EMU_FP8_A
#define EMU_AUX77 u.aux = 77;
#else
#define EMU_AUX77
#endif
__device__ __forceinline__ void tile_map(int L, int nM, int nN, int& pm, int& pn) {
    const int nwg = nM * nN, q = nwg / 8, r = nwg % 8, xcd = L % 8, off = L / 8;
    const int wgid = (xcd < r ? xcd * (q + 1) : r * (q + 1) + (xcd - r) * q) + off;
    const int nig = 8 * nN, gid = wgid / nig, fm = gid * 8, gsz = (nM - fm) < 8 ? (nM - fm) : 8;
    pm = fm + ((wgid % nig) % gsz); pn = (wgid % nig) / gsz;
}
struct EpiStoreBf16 {
    bf16_t* base0; int ldc0; bf16_t* base1; int ldc1;
    __device__ __forceinline__ void operator()(const f32x4 (&acc)[2][2][4][2], const pg8::Unit& u, int wr, int wc, int fr, int fq, int tid) const {
        bf16_t* base = u.kind ? base1 : base0; const int ldc = u.kind ? ldc1 : ldc0;
        int row0 = u.pm * 256 + wr * 64 + fr, col0 = u.pn * 256 + wc * 32 + 8 * fq; OPAQUE(row0); OPAQUE(col0);
#pragma unroll
        for (int ai = 0; ai < 2; ++ai)
#pragma unroll
            for (int m = 0; m < 4; ++m) { bf16_t* rowp = base + (size_t)(row0 + ai * 128 + m * 16) * ldc + col0;
#pragma unroll
                for (int bj = 0; bj < 2; ++bj) { const f32x4 v0 = acc[ai][bj][m][0], v1 = acc[ai][bj][m][1];
                    u32x4 w; w.x = pk2(v0[0], v0[1]); w.y = pk2(v0[2], v0[3]); w.z = pk2(v1[0], v1[1]); w.w = pk2(v1[2], v1[3]);
                    *(u32x4*)(rowp + bj * 128) = w; } }
    }
};
template <int PART>
struct SchedA { const bf16_t* hb; const unsigned char* h8a; const unsigned char* h8b; const bf16_t* WinT; int G, c;
    __device__ __forceinline__ bool next(int i, pg8::Unit& u) const {
        const int nM = T_ / 256, n0 = nM * 9; u.aux = 0;
        if (PART == 0) { const int x = i * G + c; if (x >= n0) return false;
            tile_map(x, nM, 9, u.pm, u.pn); u.kind = 0; u.nt = 8; u.f8 = 1; const int m0 = u.pm * 256;
            u.a = (const char*)(m0 < H8_SPLIT ? h8a + (size_t)m0 * 1024 : h8b + (size_t)(m0 - H8_SPLIT) * 1024); u.b = (const char*)(WinT + (size_t)u.pn * 256 * 1024); }
        else { const int x = i * G + (c + G - n0 % G) % G; if (x >= nM) return false;
            u.pm = 0; u.pn = x; u.kind = 1; u.nt = 8; u.f8 = 1; const int m0 = x * 256;
            u.a = (const char*)(WinT + (size_t)WIN_VT * 1024); u.b = (const char*)(m0 < H8_SPLIT ? h8a + (size_t)m0 * 1024 : h8b + (size_t)(m0 - H8_SPLIT) * 1024); }
        return true; } };
struct EpiA { bf16_t* proj; const float* sc;
    __device__ __forceinline__ void operator()(const f32x4 (&acc)[2][2][4][2], const pg8::Unit& u, int wr, int wc, int fr, int fq, int tid) const {
        int row0 = u.pm * 256 + wr * 64 + fr, col0 = u.pn * 256 + wc * 32 + 8 * fq; OPAQUE(row0); OPAQUE(col0);
#pragma unroll
        for (int bj = 0; bj < 2; ++bj) { const f32x4 s0 = *(const f32x4*)(sc + col0 + bj * 128), s1 = *(const f32x4*)(sc + col0 + bj * 128 + 4);
#pragma unroll
            for (int ai = 0; ai < 2; ++ai)
#pragma unroll
                for (int m = 0; m < 4; ++m) { const f32x4 v0 = acc[ai][bj][m][0] * s0, v1 = acc[ai][bj][m][1] * s1;
                    u32x4 w; w.x = pk2(v0[0], v0[1]); w.y = pk2(v0[2], v0[3]); w.z = pk2(v1[0], v1[1]); w.w = pk2(v1[2], v1[3]);
                    *(u32x4*)(proj + (size_t)(row0 + ai * 128 + m * 16) * PJ + col0 + bj * 128) = w; } }
    }
};
struct EpiVt { bf16_t* vtr; const float* sc;
    __device__ __forceinline__ void operator()(const f32x4 (&acc)[2][2][4][2], const pg8::Unit& u, int wr, int wc, int fr, int fq, int tid) const {
        int row0 = wr * 64 + fr, col0 = u.pn * 256 + wc * 32 + 8 * fq; OPAQUE(row0); OPAQUE(col0);
#pragma unroll
        for (int ai = 0; ai < 2; ++ai)
#pragma unroll
            for (int m = 0; m < 4; ++m) { const int row = row0 + ai * 128 + m * 16; const float s = sc[row];
#pragma unroll
                for (int bj = 0; bj < 2; ++bj) { const f32x4 v0 = acc[ai][bj][m][0] * s, v1 = acc[ai][bj][m][1] * s;
                    u32x4 w; w.x = pk2(v0[0], v0[1]); w.y = pk2(v0[2], v0[3]); w.z = pk2(v1[0], v1[1]); w.w = pk2(v1[2], v1[3]);
                    *(u32x4*)(vtr + (size_t)row * T_ + col0 + bj * 128) = w; } }
    }
};
__device__ __forceinline__ void phase_A0(const KP& p, unsigned char* lds) {
    const int tid = TIDX(), lane = tid & 63, wave = tid >> 6; const int gw = BIDX() * NWAVE + wave, NGW = GDIM() * NWAVE;
    for (int r = gw; r < L_ * WIN_GATE; r += NGW) { const int l = r / WIN_GATE, n = r % WIN_GATE; const Ptrs P = make_ptrs(p.ws, l); bf16_t* row = P.WinT + (size_t)n * 1024;
        const u32x4 a = *(const u32x4*)(row + 16 * lane), b = *(const u32x4*)(row + 16 * lane + 8);
        float v[16] = {bflo(a.x), bfhi(a.x), bflo(a.y), bfhi(a.y), bflo(a.z), bfhi(a.z), bflo(a.w), bfhi(a.w), bflo(b.x), bfhi(b.x), bflo(b.y), bfhi(b.y), bflo(b.z), bfhi(b.z), bflo(b.w), bfhi(b.w)};
        float am = 0.f;
#pragma unroll
        for (int j = 0; j < 16; ++j) am = fmaxf(am, fabsf(v[j]));
        am = wave_max(am); const float sc = am > 0.f ? am * (1.0f / 440.0f) : 1.0f, inv = 1.0f / sc; u32x4 o;
#pragma unroll
        for (int j = 0; j < 4; ++j) { unsigned w = cvt_pk_fp8_f32_(v[4 * j] * inv, v[4 * j + 1] * inv, 0u, false); w = cvt_pk_fp8_f32_(v[4 * j + 2] * inv, v[4 * j + 3] * inv, w, true); o[j] = w; }
        WAVE_SYNC();
        *(u32x4*)((unsigned char*)row + 16 * lane) = o;
        if (lane == 0) P.gscA[n] = sc; }
#ifdef CPU_EMU
    (void)lds;
#endif
}
__device__ __forceinline__ void phase_A(const KP& p, int l, unsigned char* lds) {
    const Ptrs P = make_ptrs(p.ws, l);
    { SchedA<0> S{P.hb, P.h8a, P.h8b, P.WinT, GDIM(), BIDX()}; EpiA E{P.proj, P.gscA}; pg8::gemm_phase<1>((LAS unsigned char*)lds, 1024, 1024, S, E, 1024); }
    { SchedA<1> S{P.hb, P.h8a, P.h8b, P.WinT, GDIM(), BIDX()}; EpiVt E{P.vtr, P.gscA + WIN_VT}; pg8::gemm_phase<1>((LAS unsigned char*)lds, 1024, 512, S, E, 2048); }
}
#if PROBE_REPEAT >= 40 && PROBE_REPEAT <= 49
struct SchedAP { const bf16_t* hb; const bf16_t* WinT; int G, c, nt, pnmask;
    __device__ __forceinline__ bool next(int i, pg8::Unit& u) const {
        const int nM = T_ / 256, n0 = nM * 9; const int x = i * G + c; if (x >= n0 + nM) return false;
        u.nt = nt; u.aux = 0; u.f8 = 0;
        if (x < n0) { tile_map(x, nM, 9, u.pm, u.pn); u.kind = 0; u.a = (const char*)(hb + (size_t)u.pm * 256 * 1024); u.b = (const char*)(WinT + (size_t)u.pn * 256 * 1024); }
        else { u.pm = 0; u.pn = x - n0; u.kind = 1; u.a = (const char*)(WinT + (size_t)WIN_VT * 1024); u.b = (const char*)(hb + (size_t)u.pn * 256 * 1024); }
        u.pn &= pnmask; return true; } };
struct EpiNull { float* d;
    __device__ __forceinline__ void operator()(const f32x4 (&acc)[2][2][4][2], const pg8::Unit& u, int wr, int wc, int fr, int fq, int tid) const {
        f32x4 s = (f32x4){0.f, 0.f, 0.f, 0.f};
#pragma unroll
        for (int ai = 0; ai < 2; ++ai)
#pragma unroll
            for (int m = 0; m < 4; ++m)
#pragma unroll
                for (int bj = 0; bj < 2; ++bj) s += acc[ai][bj][m][0] + acc[ai][bj][m][1];
        if (s.x + s.y + s.z + s.w == 1.2345e30f) d[tid] = s.x; } };
struct EpiStash { u32x4* stash;
    __device__ __forceinline__ void operator()(const f32x4 (&acc)[2][2][4][2], const pg8::Unit& u, int wr, int wc, int fr, int fq, int tid) const {
        OPAQUE(tid);
#pragma unroll
        for (int ai = 0; ai < 2; ++ai)
#pragma unroll
            for (int m = 0; m < 4; ++m)
#pragma unroll
                for (int bj = 0; bj < 2; ++bj) { const f32x4 v0 = acc[ai][bj][m][0], v1 = acc[ai][bj][m][1];
                    u32x4 w; w.x = pk2(v0[0], v0[1]); w.y = pk2(v0[2], v0[3]); w.z = pk2(v1[0], v1[1]); w.w = pk2(v1[2], v1[3]);
                    stash[((ai * 4 + m) * 2 + bj) * 512 + tid] = w; } } };
struct EpiFullLine { bf16_t* base;
    __device__ __forceinline__ void operator()(const f32x4 (&acc)[2][2][4][2], const pg8::Unit& u, int wr, int wc, int fr, int fq, int tid) const {
        OPAQUE(tid); if (u.kind) return;
#pragma unroll
        for (int ai = 0; ai < 2; ++ai)
#pragma unroll
            for (int m = 0; m < 4; ++m)
#pragma unroll
                for (int bj = 0; bj < 2; ++bj) { const f32x4 v0 = acc[ai][bj][m][0], v1 = acc[ai][bj][m][1]; const int k = (ai * 4 + m) * 2 + bj, L = k * 512 + tid, row = L >> 5, ch = L & 31;
                    u32x4 w; w.x = pk2(v0[0], v0[1]); w.y = pk2(v0[2], v0[3]); w.z = pk2(v1[0], v1[1]); w.w = pk2(v1[2], v1[3]);
                    *(u32x4*)(base + (size_t)(u.pm * 256 + row) * PJ + u.pn * 256 + ch * 8) = w; } } };
struct EpiProjOnly { bf16_t* base;
    __device__ __forceinline__ void operator()(const f32x4 (&acc)[2][2][4][2], const pg8::Unit& u, int wr, int wc, int fr, int fq, int tid) const {
        if (u.kind) return;
        int row0 = u.pm * 256 + wr * 64 + fr, col0 = u.pn * 256 + wc * 32 + 8 * fq; OPAQUE(row0); OPAQUE(col0);
#pragma unroll
        for (int ai = 0; ai < 2; ++ai)
#pragma unroll
            for (int m = 0; m < 4; ++m) { bf16_t* rowp = base + (size_t)(row0 + ai * 128 + m * 16) * PJ + col0;
#pragma unroll
                for (int bj = 0; bj < 2; ++bj) { const f32x4 v0 = acc[ai][bj][m][0], v1 = acc[ai][bj][m][1];
                    u32x4 w; w.x = pk2(v0[0], v0[1]); w.y = pk2(v0[2], v0[3]); w.z = pk2(v1[0], v1[1]); w.w = pk2(v1[2], v1[3]);
                    *(u32x4*)(rowp + bj * 128) = w; } } } };
template <int V>
__device__ __forceinline__ void phase_Aprobe(const KP& p, int l, unsigned char* lds) {
    const Ptrs P = make_ptrs(p.ws, l);
    SchedAP S{P.hb, P.WinT, GDIM(), BIDX(), V == 1 ? 32 : V == 3 ? 4 : V == 4 ? 8 : V == 5 ? 64 : 16, V == 6 ? 3 : 0xffff};
    if (V == 7) { EpiFullLine E{P.proj}; pg8::gemm_phase((LAS unsigned char*)lds, 1024, 1024, S, E); }
    else if (V == 8) { EpiProjOnly E{P.proj}; pg8::gemm_phase((LAS unsigned char*)lds, 1024, 1024, S, E); }
    else if (V == 2) { EpiStash E{(u32x4*)(P.ycat + (size_t)BIDX() * 65536)}; pg8::gemm_phase((LAS unsigned char*)lds, 1024, 1024, S, E); }
    else if (V == 6) { EpiStoreBf16 E{P.ycat, 1024, P.ycat, 1024}; pg8::gemm_phase((LAS unsigned char*)lds, 1024, 1024, S, E); }
    else { EpiNull E{(float*)(P.ycat + (size_t)BIDX() * 65536)}; pg8::gemm_phase((LAS unsigned char*)lds, 1024, 1024, S, E); }
}
#endif
struct SchedGlu { const bf16_t* ycat; const bf16_t* GluT; int G, c;
    __device__ __forceinline__ bool next(int i, pg8::Unit& u) const {
        const int x = i * G + c; if (x >= T_ / 256) return false;
        u.pm = x; u.pn = 0; u.nt = 4; u.kind = 0; u.aux = 0; u.f8 = 0; u.a = (const char*)(ycat + (size_t)x * 256 * 1024 + 256); u.b = (const char*)GluT; return true; } };
struct EpiGlu { bf16_t* ycat; const float* glub;
    __device__ __forceinline__ void operator()(const f32x4 (&acc)[2][2][4][2], const pg8::Unit& u, int wr, int wc, int fr, int fq, int tid) const {
        int row0 = u.pm * 256 + wr * 64 + fr, col0 = wc * 32 + 8 * fq; OPAQUE(row0); OPAQUE(col0);
#pragma unroll
        for (int bj = 0; bj < 2; ++bj) { const f32x4 b0 = *(const f32x4*)(glub + col0 + bj * 128), b1 = *(const f32x4*)(glub + col0 + bj * 128 + 4);
#pragma unroll
            for (int ai = 0; ai < 2; ++ai)
#pragma unroll
                for (int m = 0; m < 4; ++m) { bf16_t* ptr = ycat + (size_t)(row0 + ai * 128 + m * 16) * 1024 + 256 + col0 + bj * 128;
                    const u32x4 y = *(const u32x4*)ptr; const f32x4 v0 = acc[ai][bj][m][0] + b0, v1 = acc[ai][bj][m][1] + b1;
                    u32x4 w; w.x = pk2(bflo(y.x) * sigmoidf_(v0[0]), bfhi(y.x) * sigmoidf_(v0[1])); w.y = pk2(bflo(y.y) * sigmoidf_(v0[2]), bfhi(y.y) * sigmoidf_(v0[3]));
                    w.z = pk2(bflo(y.z) * sigmoidf_(v1[0]), bfhi(y.z) * sigmoidf_(v1[1])); w.w = pk2(bflo(y.w) * sigmoidf_(v1[2]), bfhi(y.w) * sigmoidf_(v1[3]));
                    *(u32x4*)ptr = w; MEMFENCE(); } }
    }
};
__device__ __forceinline__ void convert_tables(const KP& p, const Ptrs& P, int l, unsigned char* lds) {
    const int tid = TIDX(), lane = tid & 63, wave = tid >> 6;
    unsigned* cnt = (unsigned*)(p.ws + WS_CTL) + 10240 + 16 * l; int* slot = (int*)(lds + 65536);
    const float* ps = p.in[I_P] + (size_t)l * T_ * 256;
    constexpr int NG8 = 6144 / 128, NTAB = 2 * NEXP / 128, NPB = (int)(((size_t)T_ * 256 / 8 + 4095) / 4096);
    for (;;) {
        __syncthreads(); if (tid == 0) *slot = (int)atomicAdd(cnt, 1u); __syncthreads();
        int item = *slot; if (item >= NG8 + NTAB + NPB) break;
        if (item < NG8) {
            for (int rr = wave; rr < 128; rr += NWAVE) { const int r5 = item * 128 + rr; bf16_t* row = r5 < 4096 ? P.WinT + (size_t)(WIN_GATE + r5) * 1024 : r5 < 5120 ? P.PleGT + (size_t)(r5 - 4096) * 1024 : P.WoutT + (size_t)(r5 - 5120) * 1024;
                const u32x4 a = *(const u32x4*)(row + 16 * lane), b = *(const u32x4*)(row + 16 * lane + 8);
                float v[16] = {bflo(a.x), bfhi(a.x), bflo(a.y), bfhi(a.y), bflo(a.z), bfhi(a.z), bflo(a.w), bfhi(a.w), bflo(b.x), bfhi(b.x), bflo(b.y), bfhi(b.y), bflo(b.z), bfhi(b.z), bflo(b.w), bfhi(b.w)};
                float am = 0.f;
#pragma unroll
                for (int j = 0; j < 16; ++j) am = fmaxf(am, fabsf(v[j]));
                am = wave_max(am); const float sc = am > 0.f ? am * (1.0f / 440.0f) : 1.0f, inv = 1.0f / sc; u32x4 o;
#pragma unroll
                for (int j = 0; j < 4; ++j) { unsigned w = cvt_pk_fp8_f32_(v[4 * j] * inv, v[4 * j + 1] * inv, 0u, false); w = cvt_pk_fp8_f32_(v[4 * j + 2] * inv, v[4 * j + 3] * inv, w, true); o[j] = w; }
                WAVE_SYNC();
                *(u32x4*)((unsigned char*)row + 16 * lane) = o;
                if (lane == 0) P.gsc[r5] = sc; }
            continue; }
        item -= NG8;
        if (item < NTAB) {
            for (int r4 = 0; r4 < 16; r4 += 4) { f32x4 v[4][4]; float am[4];
#pragma unroll
                for (int q = 0; q < 4; ++q) { const int it = item * 128 + wave + 8 * (r4 + q); const int tb = it >= NEXP, row = tb ? it - NEXP : it;
                    const float* src = p.in[tb ? I_V : I_U] + ((size_t)l * NEXP + row) * 1024 + 16 * lane; am[q] = 0.f;
#pragma unroll
                    for (int j = 0; j < 4; ++j) { v[q][j] = *(const f32x4*)(src + 4 * j); am[q] = fmaxf(am[q], fmaxf(fmaxf(fabsf(v[q][j].x), fabsf(v[q][j].y)), fmaxf(fabsf(v[q][j].z), fabsf(v[q][j].w)))); } }
#pragma unroll
                for (int q = 0; q < 4; ++q) { const int it = item * 128 + wave + 8 * (r4 + q); const int tb = it >= NEXP, row = tb ? it - NEXP : it;
                    const float amx = wave_max(am[q]); const float sc = amx > 0.f ? amx * (1.0f / 440.0f) : 1.0f, inv = 1.0f / sc; u32x4 o;
#pragma unroll
                    for (int j = 0; j < 4; ++j) { unsigned w = cvt_pk_fp8_f32_(v[q][j].x * inv, v[q][j].y * inv, 0u, false); w = cvt_pk_fp8_f32_(v[q][j].z * inv, v[q][j].w * inv, w, true); o[j] = w; }
                    *(u32x4*)((tb ? P.V8 : P.U8) + ((size_t)(lane >> 3) * NEXP + row) * 128 + 16 * (lane & 7)) = o;
                    if (lane == 0) (tb ? P.sv : P.su)[row] = sc; } }
        } else {
            const size_t base = (size_t)(item - NTAB) * 4096;
            f32x4 a[8], bq[8];
#pragma unroll
            for (int j = 0; j < 8; ++j) { const size_t i = base + tid + (size_t)j * NTHR; a[j] = (f32x4){0.f, 0.f, 0.f, 0.f}; bq[j] = a[j];
                if (i < (size_t)T_ * 256 / 8) { a[j] = *(const f32x4*)(ps + i * 8); bq[j] = *(const f32x4*)(ps + i * 8 + 4); } }
#pragma unroll
            for (int j = 0; j < 8; ++j) { const size_t i = base + tid + (size_t)j * NTHR;
                if (i < (size_t)T_ * 256 / 8) { u32x4 o; o.x = pk2(a[j].x, a[j].y); o.y = pk2(a[j].z, a[j].w); o.z = pk2(bq[j].x, bq[j].y); o.w = pk2(bq[j].z, bq[j].w); *(u32x4*)(P.pb + i * 8) = o; } }
        }
    }
}
__device__ __forceinline__ void phase_B2(const KP& p, int l, unsigned char* lds) {
    const Ptrs P = make_ptrs(p.ws, l);
    constexpr int NRW = NB_ * 4; const int G = GDIM(), c = BIDX();
    int gG = G, gc = c;
    if (G > NRW) { if (c < NRW) { rw_state_unit(p, P, l, c, lds);
#if PROBE_REPEAT == 35
        rw_state_unit(p, P, l, c, lds);
#endif
        convert_tables(p, P, l, lds); return; } gG = G - NRW; gc = c - NRW; }
    else { for (int u = c; u < NRW; u += G) rw_state_unit(p, P, l, u, lds); }
    SchedGlu S{P.ycat, P.GluT, gG, gc};
    EpiGlu E{P.ycat, p.in[I_GLUB] + l * 256};
    pg8::gemm_phase((LAS unsigned char*)lds, 1024, 256, S, E);
    convert_tables(p, P, l, lds);
}
struct SchedC { const unsigned char* h8a; const unsigned char* h8b; const bf16_t* ycat; const bf16_t* WinT; const bf16_t* WbrT; int G, c;
    __device__ __forceinline__ bool next(int i, pg8::Unit& u) const {
        const int tile = (i >> 3) * G + c; if (tile >= (T_ / 256) * 4) return false;
        const int j = i & 7, b = j >> 1; tile_map(tile, T_ / 256, 4, u.pm, u.pn); u.aux = b;
        if (!(j & 1)) { u.kind = 0; u.nt = 4; u.f8 = 0; u.a = (const char*)(ycat + (size_t)u.pm * 256 * 1024 + 256 * b); u.b = (const char*)(WbrT + (size_t)u.pn * 256 * 1024 + 256 * b); }
        else { u.kind = 1; u.nt = 8; u.f8 = 1; const int m0 = u.pm * 256;
            u.a = (const char*)(m0 < H8_SPLIT ? h8a + (size_t)m0 * 1024 : h8b + (size_t)(m0 - H8_SPLIT) * 1024); u.b = (const char*)(WinT + (size_t)(WIN_GATE + 1024 * b + 256 * u.pn) * 1024); }
        return true; } };
struct EpiC { u32x2* stash; bf16_t* merged; const float* gsc; unsigned char* m8;
    __device__ __forceinline__ void operator()(const f32x4 (&acc)[2][2][4][2], const pg8::Unit& u, int wr, int wc, int fr, int fq, int tid) const {
        OPAQUE(tid);
        if (u.kind == 0) {
#pragma unroll
            for (int ai = 0; ai < 2; ++ai)
#pragma unroll
                for (int m = 0; m < 4; ++m)
#pragma unroll
                    for (int bj = 0; bj < 2; ++bj) { const f32x4 v0 = acc[ai][bj][m][0], v1 = acc[ai][bj][m][1];
                        u32x2 w; w.x = cvt_pk_fp8_f32_(v0[0], v0[1], 0u, false); w.x = cvt_pk_fp8_f32_(v0[2], v0[3], w.x, true); w.y = cvt_pk_fp8_f32_(v1[0], v1[1], 0u, false); w.y = cvt_pk_fp8_f32_(v1[2], v1[3], w.y, true);
                        stash[((ai * 4 + m) * 2 + bj) * 512 + tid] = w; }
        } else {
            int row0 = u.pm * 256 + wr * 64 + fr, col0 = u.pn * 256 + wc * 32 + 8 * fq; OPAQUE(row0); OPAQUE(col0); const bool first = (u.aux == 0);
            f32x4 sc[2][2];
#pragma unroll
            for (int bj = 0; bj < 2; ++bj) { const float* sp = gsc + 1024 * u.aux + col0 + bj * 128; sc[bj][0] = *(const f32x4*)sp; sc[bj][1] = *(const f32x4*)(sp + 4); }
#pragma unroll
            for (int ai = 0; ai < 2; ++ai)
#pragma unroll
                for (int mp = 0; mp < 2; ++mp) { u32x2 y[4]; u32x4 mo[4];
#pragma unroll
                    for (int q = 0; q < 4; ++q) { const int m = 2 * mp + (q >> 1), bj = q & 1;
                        y[q] = stash[((ai * 4 + m) * 2 + bj) * 512 + tid]; mo[q] = (u32x4){0u, 0u, 0u, 0u};
                        if (!first) mo[q] = *(const u32x4*)(merged + (size_t)(row0 + ai * 128 + m * 16) * 1024 + col0 + bj * 128); }
#pragma unroll
                    for (int q = 0; q < 4; ++q) { const int m = 2 * mp + (q >> 1), bj = q & 1; const f32x4 g0 = acc[ai][bj][m][0] * sc[bj][0], g1 = acc[ai][bj][m][1] * sc[bj][1];
                        bf16_t* ptr = merged + (size_t)(row0 + ai * 128 + m * 16) * 1024 + col0 + bj * 128;
                        const f32x2 ya = cvt_pk_f32_fp8_(y[q].x, false), yb = cvt_pk_f32_fp8_(y[q].x, true), yc = cvt_pk_f32_fp8_(y[q].y, false), yd = cvt_pk_f32_fp8_(y[q].y, true);
                        const float o0 = ya.x * sigmoidf_(g0[0]) + bflo(mo[q].x), o1 = ya.y * sigmoidf_(g0[1]) + bfhi(mo[q].x), o2 = yb.x * sigmoidf_(g0[2]) + bflo(mo[q].y), o3 = yb.y * sigmoidf_(g0[3]) + bfhi(mo[q].y);
                        const float o4 = yc.x * sigmoidf_(g1[0]) + bflo(mo[q].z), o5 = yc.y * sigmoidf_(g1[1]) + bfhi(mo[q].z), o6 = yd.x * sigmoidf_(g1[2]) + bflo(mo[q].w), o7 = yd.y * sigmoidf_(g1[3]) + bfhi(mo[q].w);
                        u32x4 w; w.x = pk2(o0, o1); w.y = pk2(o2, o3); w.z = pk2(o4, o5); w.w = pk2(o6, o7);
                        if (u.aux != 3) *(u32x4*)ptr = w;
                        else { u32x2 w8; w8.x = cvt_pk_fp8_f32_(o0, o1, 0u, false); w8.x = cvt_pk_fp8_f32_(o2, o3, w8.x, true); w8.y = cvt_pk_fp8_f32_(o4, o5, 0u, false); w8.y = cvt_pk_fp8_f32_(o6, o7, w8.y, true);
                            *(u32x2*)(m8 + (size_t)(row0 + ai * 128 + m * 16) * 1024 + col0 + bj * 128) = w8; } }
                    MEMFENCE(); }
        }
    }
};
__device__ __forceinline__ void phase_C(const KP& p, int l, unsigned char* lds) {
    const Ptrs P = make_ptrs(p.ws, l);
    SchedC S{P.h8a, P.h8b, P.ycat, P.WinT, P.WbrT, GDIM(), BIDX()};
    EpiC E{(u32x2*)(P.stash + (size_t)BIDX() * 65536), P.merged, P.gsc, P.h8e};
    pg8::gemm_phase<2>((LAS unsigned char*)lds, 1024, 1024, S, E, 1024);
}
struct SchedD { const unsigned char* A8; const bf16_t* Bt; int nN, G, c;
    __device__ __forceinline__ bool next(int i, pg8::Unit& u) const {
        const int x = i * G + c; if (x >= (T_ / 256) * nN) return false;
        tile_map(x, T_ / 256, nN, u.pm, u.pn); u.nt = 8; u.kind = 0; u.aux = 0; u.f8 = 1; u.a = (const char*)(A8 + (size_t)u.pm * 256 * 1024); u.b = (const char*)(Bt + (size_t)u.pn * 256 * 1024); return true; } };
struct EpiResid { bf16_t* ob; const bf16_t* hb; const float* sc;
    __device__ __forceinline__ void operator()(const f32x4 (&acc)[2][2][4][2], const pg8::Unit& u, int wr, int wc, int fr, int fq, int tid) const {
        int row0 = u.pm * 256 + wr * 64 + fr, col0 = u.pn * 256 + wc * 32 + 8 * fq; OPAQUE(row0); OPAQUE(col0);
#pragma unroll
        for (int ai = 0; ai < 2; ++ai)
#pragma unroll
            for (int m = 0; m < 4; ++m)
#pragma unroll
                for (int bj = 0; bj < 2; ++bj) { const size_t o = (size_t)(row0 + ai * 128 + m * 16) * 1024 + col0 + bj * 128; const u32x4 hw = *(const u32x4*)(hb + o);
                    const f32x4 a0 = acc[ai][bj][m][0] * *(const f32x4*)(sc + col0 + bj * 128), a1 = acc[ai][bj][m][1] * *(const f32x4*)(sc + col0 + bj * 128 + 4); u32x4 w;
                    w.x = pk2(bflo(hw.x) * DN_ALPHA_ + a0[0], bfhi(hw.x) * DN_ALPHA_ + a0[1]); w.y = pk2(bflo(hw.y) * DN_ALPHA_ + a0[2], bfhi(hw.y) * DN_ALPHA_ + a0[3]);
                    w.z = pk2(bflo(hw.z) * DN_ALPHA_ + a1[0], bfhi(hw.z) * DN_ALPHA_ + a1[1]); w.w = pk2(bflo(hw.w) * DN_ALPHA_ + a1[2], bfhi(hw.w) * DN_ALPHA_ + a1[3]);
                    *(u32x4*)(ob + o) = w; }
    }
};
__device__ __forceinline__ void phase_D(const KP& p, int l, unsigned char* lds) {
    const Ptrs P = make_ptrs(p.ws, l);
    SchedD S{P.h8e, P.WoutT, 4, GDIM(), BIDX()};
    EpiResid E{P.ycat, P.hb, P.gsc + 5120};
    pg8::gemm_phase<1>((LAS unsigned char*)lds, 1024, 1024, S, E, 1024);
}
__device__ __forceinline__ void phase_D2(const KP& p, int l, unsigned char* lds) {
    const Ptrs P = make_ptrs(p.ws, l);
    const int tid = TIDX(), lane = tid & 63, wave = tid >> 6; const int gw = BIDX() * NWAVE + wave, NGW = GDIM() * NWAVE;
    for (int m = 4 * gw; m < T_; m += 4 * NGW) ln_rows<4, true>(P.ycat + (size_t)m * 1024, p.in[I_LN1G] + l * 1024, p.in[I_LN1B] + l * 1024, (float*)nullptr, P.hb + (size_t)m * 1024, P.h8e + (size_t)m * 1024, lane);
}
struct SchedE1 { const bf16_t* pb; const bf16_t* PleT; int G, c;
    __device__ __forceinline__ bool next(int i, pg8::Unit& u) const {
        const int x = i * G + c; if (x >= (T_ / 256) * 4) return false;
        tile_map(x, T_ / 256, 4, u.pm, u.pn); u.nt = 4; u.kind = 0; u.aux = 0; u.f8 = 0; u.a = (const char*)(pb + (size_t)u.pm * 256 * 256); u.b = (const char*)(PleT + (size_t)u.pn * 256 * 256); return true; } };
template <int PART>
struct SchedE2 { const bf16_t* hb; const unsigned char* h8e; const bf16_t* PleGT; const bf16_t* WqT; int G, c;
    __device__ __forceinline__ bool next(int i, pg8::Unit& u) const {
        const int n0 = (T_ / 256) * 4; int x = i * G + c + (PART ? n0 : 0); if (x >= (PART ? n0 + (T_ / 256) * 8 : n0)) return false;
        u.aux = 0;
        if (x < n0) { tile_map(x, T_ / 256, 4, u.pm, u.pn); u.kind = 0; u.nt = 8; u.f8 = 1; u.b = (const char*)(PleGT + (size_t)u.pn * 256 * 1024); u.a = (const char*)(h8e + (size_t)u.pm * 256 * 1024); }
        else { x -= n0; tile_map(x, T_ / 256, 8, u.pm, u.pn); u.kind = 1; u.nt = 16; u.f8 = 0; u.b = (const char*)(WqT + (size_t)u.pn * 256 * 1024); u.a = (const char*)(hb + (size_t)u.pm * 256 * 1024); }
        return true; } };
struct EpiE2g { const bf16_t* hb; bf16_t* Pbuf; const float* gsc;
    __device__ __forceinline__ void operator()(const f32x4 (&acc)[2][2][4][2], const pg8::Unit& u, int wr, int wc, int fr, int fq, int tid) const {
        int row0 = u.pm * 256 + wr * 64 + fr, col0 = u.pn * 256 + wc * 32 + 8 * fq; OPAQUE(row0); OPAQUE(col0);
#pragma unroll
        for (int bj = 0; bj < 2; ++bj) { const float* sp = gsc + 4096 + col0 + bj * 128; const f32x4 s0 = *(const f32x4*)sp, s1 = *(const f32x4*)(sp + 4);
            const size_t cb = (size_t)row0 * 1024 + col0 + bj * 128; const bf16_t* hp = hb + cb; bf16_t* pp = Pbuf + cb;
#pragma unroll
            for (int ai = 0; ai < 2; ++ai)
#pragma unroll
                for (int mp = 0; mp < 2; ++mp) { u32x4 y[2], hw[2];
#pragma unroll
                    for (int q = 0; q < 2; ++q) { const int ro = (ai * 128 + (2 * mp + q) * 16) * 1024; y[q] = *(const u32x4*)(pp + ro); hw[q] = *(const u32x4*)(hp + ro); }
#pragma unroll
                    for (int q = 0; q < 2; ++q) { const int m = 2 * mp + q; const int ro = (ai * 128 + m * 16) * 1024; const f32x4 v0 = acc[ai][bj][m][0] * s0, v1 = acc[ai][bj][m][1] * s1;
                        u32x4 w;
                        w.x = pk2(bflo(hw[q].x) * DN_ALPHA_ + bflo(y[q].x) * sigmoidf_(v0[0]), bfhi(hw[q].x) * DN_ALPHA_ + bfhi(y[q].x) * sigmoidf_(v0[1]));
                        w.y = pk2(bflo(hw[q].y) * DN_ALPHA_ + bflo(y[q].y) * sigmoidf_(v0[2]), bfhi(hw[q].y) * DN_ALPHA_ + bfhi(y[q].y) * sigmoidf_(v0[3]));
                        w.z = pk2(bflo(hw[q].z) * DN_ALPHA_ + bflo(y[q].z) * sigmoidf_(v1[0]), bfhi(hw[q].z) * DN_ALPHA_ + bfhi(y[q].z) * sigmoidf_(v1[1]));
                        w.w = pk2(bflo(hw[q].w) * DN_ALPHA_ + bflo(y[q].w) * sigmoidf_(v1[2]), bfhi(hw[q].w) * DN_ALPHA_ + bfhi(y[q].w) * sigmoidf_(v1[3]));
                        *(u32x4*)(pp + ro) = w; }
                    MEMFENCE(); } }
    }
};
__device__ __forceinline__ void phase_E(const KP& p, int l, unsigned char* lds) {
    const Ptrs P = make_ptrs(p.ws, l);
    { SchedE1 S{P.pb, P.PleT, GDIM(), BIDX()}; EpiStoreBf16 E{P.ycat, 1024, P.ycat, 1024}; pg8::gemm_phase((LAS unsigned char*)lds, 256, 256, S, E); }
    { SchedE2<0> S{P.hb, P.h8e, P.PleGT, P.WqT, GDIM(), BIDX()}; EpiE2g E{P.hb, P.ycat, P.gsc}; pg8::gemm_phase<1>((LAS unsigned char*)lds, 1024, 1024, S, E, 1024); }
    { SchedE2<1> S{P.hb, P.h8e, P.PleGT, P.WqT, GDIM(), BIDX()}; EpiStoreBf16 E{P.q, 2048, P.q, 2048}; pg8::gemm_phase<0>((LAS unsigned char*)lds, 1024, 1024, S, E); }
}
__device__ __forceinline__ unsigned mono_key(float f) { const unsigned u = __builtin_bit_cast(unsigned, f); return (u & 0x80000000u) ? ~u : (u | 0x80000000u); }
__device__ __forceinline__ float unmono_key(unsigned k) { const unsigned u = (k & 0x80000000u) ? (k ^ 0x80000000u) : ~k; return __builtin_bit_cast(float, u); }
struct CandTab { int a[50], b[50]; };
constexpr CandTab make_cand() { CandTab t{}; int n = 0; for (int a = 0; a < 16; ++a) for (int b = 0; b < 16; ++b) if ((a + 1) * (b + 1) <= 16) { t.a[n] = a; t.b[n] = b; ++n; } return t; }
constexpr CandTab CAND = make_cand();
constexpr int PK_PITCH = 136;

#define PK_CE(x, y) do { const unsigned _a = (x), _b = (y); (x) = _a > _b ? _a : _b; (y) = _a > _b ? _b : _a; } while (0)
__device__ __forceinline__ void bitonic_merge16_desc(unsigned (&a)[16]) {
#pragma unroll
    for (int j = 8; j > 0; j >>= 1)
#pragma unroll
        for (int i = 0; i < 16; ++i) { const int l = i ^ j; if (l > i) PK_CE(a[i], a[l]); }
}
__device__ __forceinline__ void bitonic_sort16_desc(unsigned (&a)[16]) {
#pragma unroll
    for (int k = 2; k <= 16; k <<= 1)
#pragma unroll
        for (int j = k >> 1; j > 0; j >>= 1)
#pragma unroll
            for (int i = 0; i < 16; ++i) { const int l = i ^ j; if (l > i) { if ((i & k) == 0 || k == 16) PK_CE(a[i], a[l]); else PK_CE(a[l], a[i]); } }
}
__device__ __forceinline__ void top_half_merge16(unsigned (&a)[16], const unsigned (&b)[16]) {
#pragma unroll
    for (int i = 0; i < 16; ++i) a[i] = a[i] > b[15 - i] ? a[i] : b[15 - i];
    bitonic_merge16_desc(a);
}
__device__ __forceinline__ void top16_keys(const unsigned (&key)[64], unsigned (&top)[16]) {
    unsigned g0[16], g1[16], g2[16], g3[16];
#pragma unroll
    for (int i = 0; i < 16; ++i) { g0[i] = key[i]; g1[i] = key[16 + i]; g2[i] = key[32 + i]; g3[i] = key[48 + i]; }
    bitonic_sort16_desc(g0); bitonic_sort16_desc(g1); bitonic_sort16_desc(g2); bitonic_sort16_desc(g3);
    top_half_merge16(g0, g1); top_half_merge16(g2, g3); top_half_merge16(g0, g2);
    unsigned pr[16];
#pragma unroll
    for (int i = 0; i < 16; ++i) pr[i] = (unsigned)__shfl_xor((int)g0[i], 32);
    top_half_merge16(g0, pr);
#pragma unroll
    for (int i = 0; i < 16; ++i) top[i] = g0[i];
}
__device__ __forceinline__ void peer_route_unit(const KP& p, const Ptrs& P, int l, int unit, unsigned char* lds) {
    const bf16_t* Ks = (const bf16_t*)lds;
    const int tid = TIDX(), lane = tid & 63, wave = tid >> 6, r32 = lane & 31, hi = lane >> 5;
    const int tok = unit * 32 + r32;
    int kbase = r32 * PK_PITCH + 8 * hi; OPAQUE(kbase);
    unsigned top1[16], top2[16];
#pragma unroll 1
    for (int half = 0; half < 2; ++half) {
        const bf16_t* qp = P.q + (size_t)tok * 2048 + wave * 256 + half * 128 + 8 * hi;
        bf16x8 qf[8];
#pragma unroll
        for (int ks = 0; ks < 8; ++ks) qf[ks] = *(const bf16x8*)(qp + 16 * ks);
        unsigned key[64];
#pragma unroll
        for (int kt = 0; kt < 4; ++kt) { f32x16 acc = {}; const bf16_t* kp = Ks + (half * 128 + 32 * kt) * PK_PITCH + kbase;
#pragma unroll
            for (int ks = 0; ks < 8; ++ks) { const bf16x8 a = *(const bf16x8*)(kp + 16 * ks); acc = MFMA32(a, qf[ks], acc); }
#pragma unroll
            for (int r = 0; r < 16; ++r) { const int idx = 32 * kt + (r & 3) + 8 * (r >> 2) + 4 * hi; key[16 * kt + r] = (mono_key(acc[r]) & ~127u) | (unsigned)(127 - idx); } }
        if (half == 0) top16_keys(key, top1); else top16_keys(key, top2);
        MEMFENCE();
    }
    MEMFENCE();
    int* islot = (int*)(lds + 2 * 128 * PK_PITCH * 2) + (wave * 32 + r32) * 33;
    float v1[16], v2[16];
#pragma unroll
    for (int r = 0; r < 16; ++r) { v1[r] = unmono_key(top1[r] & ~127u); v2[r] = unmono_key(top2[r] & ~127u); islot[16 * hi + r] = 127 - (int)((hi ? top2[r] : top1[r]) & 127u); }
    unsigned ka[16], kb[16];
#pragma unroll
    for (int i = 0; i < 25; ++i) { const int c0 = 2 * i, c1 = 2 * i + 1;
        const float s = hi ? (v1[CAND.a[c1]] + v2[CAND.b[c1]]) : (v1[CAND.a[c0]] + v2[CAND.b[c0]]);
        const unsigned k = (mono_key(s) & ~255u) | (unsigned)(255 - (hi ? 16 * CAND.a[c1] + CAND.b[c1] : 16 * CAND.a[c0] + CAND.b[c0]));
        if (i < 16) ka[i] = k; else kb[i - 16] = k; }
#pragma unroll
    for (int i = 9; i < 16; ++i) kb[i] = 0u;
    bitonic_sort16_desc(ka); bitonic_sort16_desc(kb); top_half_merge16(ka, kb);
    { unsigned pr[16];
#pragma unroll
      for (int i = 0; i < 16; ++i) pr[i] = (unsigned)__shfl_xor((int)ka[i], 32);
      top_half_merge16(ka, pr); }
    WAVE_SYNC();
    float sc[16]; int se[16];
#pragma unroll
    for (int r = 0; r < 16; ++r) { sc[r] = unmono_key(ka[r] & ~255u); se[r] = 0; }
#pragma unroll
    for (int r = 0; r < 8; ++r) { unsigned mlo = ka[r], mhi = ka[8 + r]; OPAQUE(mlo); OPAQUE(mhi);
        const unsigned m = hi ? mhi : mlo; const int ab = 255 - (int)(m & 255u); const int e = islot[ab >> 4] * 128 + islot[16 + (ab & 15)];
        if (hi) se[8 + r] = e; else se[r] = e; }
    WAVE_SYNC();
    float g[16]; float sum = 0.f;
#pragma unroll
    for (int r = 0; r < 16; ++r) { g[r] = __expf(sc[r] - sc[0]); sum += g[r]; }
    const float inv = 1.0f / sum;
    const size_t ob = (size_t)tok * 128 + wave * 16 + 8 * hi;
    if (hi == 0) {
        *(u32x4*)(P.eid + ob) = (u32x4){(unsigned)se[0], (unsigned)se[1], (unsigned)se[2], (unsigned)se[3]}; *(u32x4*)(P.eid + ob + 4) = (u32x4){(unsigned)se[4], (unsigned)se[5], (unsigned)se[6], (unsigned)se[7]};
        *(f32x4*)(P.gate + ob) = (f32x4){g[0] * inv, g[1] * inv, g[2] * inv, g[3] * inv}; *(f32x4*)(P.gate + ob + 4) = (f32x4){g[4] * inv, g[5] * inv, g[6] * inv, g[7] * inv};
    } else {
        *(u32x4*)(P.eid + ob) = (u32x4){(unsigned)se[8], (unsigned)se[9], (unsigned)se[10], (unsigned)se[11]}; *(u32x4*)(P.eid + ob + 4) = (u32x4){(unsigned)se[12], (unsigned)se[13], (unsigned)se[14], (unsigned)se[15]};
        *(f32x4*)(P.gate + ob) = (f32x4){g[8] * inv, g[9] * inv, g[10] * inv, g[11] * inv}; *(f32x4*)(P.gate + ob + 4) = (f32x4){g[12] * inv, g[13] * inv, g[14] * inv, g[15] * inv};
    }
}
__device__ __forceinline__ void phase_F(const KP& p, int l, unsigned char* lds) {
    const Ptrs P = make_ptrs(p.ws, l);
    bf16_t* Ks = (bf16_t*)lds; const int tid = TIDX();
    for (int e = tid; e < 2 * 128 * 16; e += NTHR) { const int row = e >> 4, ch = e & 15; *(u32x4*)(Ks + row * PK_PITCH + ch * 8) = *(const u32x4*)(P.K12 + row * 128 + ch * 8); }
    __syncthreads();
    for (int u = BIDX(); u < T_ / 32; u += GDIM()) peer_route_unit(p, P, l, u, lds);
    __syncthreads();
}
constexpr int PG_TB = (T_ >= 4096 ? 128 : 64), PG_NBLK = T_ / PG_TB;
__device__ __forceinline__ int peer_next_item(unsigned* cnt, int* slot, int tid) {
    __syncthreads();
    if (tid == 0) *slot = (int)atomicAdd(cnt, 1u);
    __syncthreads();
    return *slot;
}
constexpr int PG_TPW = PG_TB / NWAVE;
static_assert(PG_TPW >= 4 && PG_TPW % 2 == 0, "token pipeline depth");
constexpr int PG_WLDS = 6144;
__device__ __forceinline__ void pg_issue_rows(const unsigned char* T8, int x, int c8, int gq, int lane, int e0, int e1, int* E, u32x4 (&rb)[16]) {
    WAVE_SYNC(); E[lane] = e0; E[64 + lane] = e1; WAVE_SYNC();
#pragma unroll
    for (int k = 0; k < 16; ++k) { const unsigned off = ((unsigned)(x * NEXP) + (unsigned)E[gq + 8 * k]) * 128u + 16u * (unsigned)c8; rb[k] = *(const u32x4*)(T8 + off); }
}
template <bool REFILL, int TAG>
__device__ __forceinline__ void pg_dots_compute(const Ptrs& P, int x, int t, u32x4 (&ub)[16], u32x4 xa, u32x4 xb, float* R, const int* E, int c8, int gq, int lane) {
    const f32x2 x0 = (f32x2){bflo(xa.x), bfhi(xa.x)}, x1 = (f32x2){bflo(xa.y), bfhi(xa.y)}, x2 = (f32x2){bflo(xa.z), bfhi(xa.z)}, x3 = (f32x2){bflo(xa.w), bfhi(xa.w)};
    const f32x2 x4 = (f32x2){bflo(xb.x), bfhi(xb.x)}, x5 = (f32x2){bflo(xb.y), bfhi(xb.y)}, x6 = (f32x2){bflo(xb.z), bfhi(xb.z)}, x7 = (f32x2){bflo(xb.w), bfhi(xb.w)};
    WAVE_SYNC();
    unsigned off[8];
    const unsigned char* ubase = P.U8;
#pragma unroll
    for (int k = 0; k < 16; ++k) { PIN1(ub[k]);
        if (REFILL && (k & 7) == 0) {
#pragma unroll
            for (int j = 0; j < 8; ++j) off[j] = ((unsigned)(x * NEXP) + (unsigned)E[gq + 8 * (k + j)]) * 128u + 16u * (unsigned)c8; }
        f32x2 s = cvt_pk_f32_fp8_(ub[k][0], false) * x0; s += cvt_pk_f32_fp8_(ub[k][0], true) * x1; s += cvt_pk_f32_fp8_(ub[k][1], false) * x2; s += cvt_pk_f32_fp8_(ub[k][1], true) * x3;
        s += cvt_pk_f32_fp8_(ub[k][2], false) * x4; s += cvt_pk_f32_fp8_(ub[k][2], true) * x5; s += cvt_pk_f32_fp8_(ub[k][3], false) * x6; s += cvt_pk_f32_fp8_(ub[k][3], true) * x7;
        R[k * 64 + lane] = s.x + s.y;
        if (REFILL) { GLOAD16_RW_S(ub[k], ubase, off[k & 7]); }
        if (TAG) TAG_B(); else TAG_A();
        SCHED_FENCE(); }
    WAVE_SYNC();
    const f32x4 a0 = *(const f32x4*)(R + 8 * lane), a1 = *(const f32x4*)(R + 8 * lane + 4), b0 = *(const f32x4*)(R + 512 + 8 * lane), b1 = *(const f32x4*)(R + 512 + 8 * lane + 4);
    bf16_t* pd = P.pd + ((size_t)x * T_ + t) * 128;
    pd[lane] = (bf16_t)f2bf(((a0[0] + a0[1]) + (a0[2] + a0[3])) + ((a1[0] + a1[1]) + (a1[2] + a1[3])));
    pd[64 + lane] = (bf16_t)f2bf(((b0[0] + b0[1]) + (b0[2] + b0[3])) + ((b1[0] + b1[1]) + (b1[2] + b1[3])));
}
#define PG_PIN16(v) do { _Pragma("unroll") for (int _k = 0; _k < 16; ++_k) PIN1(v[_k]); } while (0)
__device__ __forceinline__ void peer_dots_item(const Ptrs& P, int x, int blk, unsigned char* lds, int lane, int wave) {
    float* R = (float*)(lds + wave * PG_WLDS); int* E = (int*)(lds + wave * PG_WLDS + 4096);
    const int gq = lane >> 3, c8 = lane & 7, tb = blk * PG_TB + PG_TPW * wave;
    u32x4 uA[16], uB[16], xa0, xb0, xa1, xb1;
    const bf16_t* hbase = P.hb; const int* ebase = P.eid; const unsigned char* ubase = P.U8;
    const unsigned xo = (unsigned)((tb * 1024 + 128 * x + 16 * c8) * 2), eo = (unsigned)((tb * 128 + lane) * 4);
    int ea0, ea1, eb0, eb1;
    { const int* ep = P.eid + (size_t)tb * 128 + lane; ea0 = ep[0]; ea1 = ep[64]; eb0 = ep[128]; eb1 = ep[192]; }
    WAVE_SYNC(); E[lane] = ea0; E[64 + lane] = ea1; WAVE_SYNC();
#pragma unroll
    for (int k = 0; k < 16; ++k) { const unsigned off = ((unsigned)(x * NEXP) + (unsigned)E[gq + 8 * k]) * 128u + 16u * (unsigned)c8; GLOAD16_S(uA[k], ubase, off); }
    GLOAD16_S(xa0, hbase, xo); GLOAD16_S(xb0, hbase, xo + 16u); GLOAD4_S(ea0, ebase, eo + 2u * 512u); GLOAD4_S(ea1, ebase, eo + 2u * 512u + 256u);
    WAVE_SYNC(); E[lane] = eb0; E[64 + lane] = eb1; WAVE_SYNC();
#pragma unroll
    for (int k = 0; k < 16; ++k) { const unsigned off = ((unsigned)(x * NEXP) + (unsigned)E[gq + 8 * k]) * 128u + 16u * (unsigned)c8; GLOAD16_S(uB[k], ubase, off); }
    GLOAD16_S(xa1, hbase, xo + 2048u); GLOAD16_S(xb1, hbase, xo + 2048u + 16u); GLOAD4_S(eb0, ebase, eo + 3u * 512u); GLOAD4_S(eb1, ebase, eo + 3u * 512u + 256u);
#pragma unroll
    for (int i = 0; i < PG_TPW; i += 2) {
        if (i == 0) WAIT_VM(20); else WAIT_VM(22);
        PIN4(xa0, xb0, ea0, ea1);
        if (i + 2 < PG_TPW) { WAVE_SYNC(); E[lane] = ea0; E[64 + lane] = ea1; WAVE_SYNC();
            pg_dots_compute<true, 0>(P, x, tb + i, uA, xa0, xb0, R, E, c8, gq, lane);
            const unsigned nx = (unsigned)((i + 4 < PG_TPW) ? i + 4 : PG_TPW - 1), xo2 = xo + (unsigned)(i + 2) * 2048u;
            GLOAD16_S(xa0, hbase, xo2); GLOAD16_S(xb0, hbase, xo2 + 16u); GLOAD4_S(ea0, ebase, eo + nx * 512u); GLOAD4_S(ea1, ebase, eo + nx * 512u + 256u); }
        else pg_dots_compute<false, 0>(P, x, tb + i, uA, xa0, xb0, R, E, c8, gq, lane);
        if (i + 2 < PG_TPW) WAIT_VM(22); else WAIT_VM(0);
        PIN4(xa1, xb1, eb0, eb1);
        if (i + 3 < PG_TPW) { WAVE_SYNC(); E[lane] = eb0; E[64 + lane] = eb1; WAVE_SYNC();
            pg_dots_compute<true, 1>(P, x, tb + i + 1, uB, xa1, xb1, R, E, c8, gq, lane);
            const unsigned nx = (unsigned)((i + 5 < PG_TPW) ? i + 5 : PG_TPW - 1), xo2 = xo + (unsigned)(i + 3) * 2048u;
            GLOAD16_S(xa1, hbase, xo2); GLOAD16_S(xb1, hbase, xo2 + 16u); GLOAD4_S(eb0, ebase, eo + nx * 512u); GLOAD4_S(eb1, ebase, eo + nx * 512u + 256u); }
        else pg_dots_compute<false, 1>(P, x, tb + i + 1, uB, xa1, xb1, R, E, c8, gq, lane);
    }
}
template <bool REFILL, int TAG>
__device__ __forceinline__ void pg_acc_compute(const Ptrs& P, bf16_t* outp, int x, int t, u32x4 (&vb)[16], float w0, float w1, unsigned oprev, float* C, float* W, const int* E, int c8, int gq, int lane) {
    WAVE_SYNC(); W[lane] = w0; W[64 + lane] = w1; WAVE_SYNC();
    f32x2 acc[8];
#pragma unroll
    for (int q = 0; q < 8; ++q) acc[q] = (f32x2){0.f, 0.f};
    unsigned off[8]; const unsigned char* vbase = P.V8; float wk[16];
#pragma unroll
    for (int k = 0; k < 16; ++k) wk[k] = W[gq + 8 * k];
#pragma unroll
    for (int k = 0; k < 16; ++k) { PIN1(vb[k]);
        if (REFILL && (k & 7) == 0) {
#pragma unroll
            for (int j = 0; j < 8; ++j) off[j] = ((unsigned)(x * NEXP) + (unsigned)E[gq + 8 * (k + j)]) * 128u + 16u * (unsigned)c8; }
#pragma unroll
        for (int q = 0; q < 4; ++q) { acc[2 * q] += cvt_pk_f32_fp8_(vb[k][q], false) * wk[k]; acc[2 * q + 1] += cvt_pk_f32_fp8_(vb[k][q], true) * wk[k]; }
        if (REFILL) {
#pragma unroll
            for (int q = 0; q < 8; ++q) PIN1(acc[q]);
            GLOAD16_RW_S(vb[k], vbase, off[k & 7]); }
        if (TAG) TAG_B(); else TAG_A();
        SCHED_FENCE(); }
    WAVE_SYNC();
#pragma unroll
    for (int q = 0; q < 4; ++q) *(f32x4*)(C + lane * 16 + 4 * q) = (f32x4){acc[2 * q].x, acc[2 * q].y, acc[2 * q + 1].x, acc[2 * q + 1].y};
    WAVE_SYNC();
    f32x2 s = (f32x2){0.f, 0.f};
#pragma unroll
    for (int g = 0; g < 8; ++g) s += *(const f32x2*)(C + g * 128 + 2 * lane);
    *(unsigned*)(outp + (size_t)t * 1024 + 128 * x + 2 * lane) = pk2(bflo(oprev) + s.x, bfhi(oprev) + s.y);
}
__device__ __forceinline__ void peer_acc_item(bf16_t* outp, const Ptrs& P, int x, int blk, unsigned char* lds, int lane, int wave) {
    float* C = (float*)(lds + wave * PG_WLDS); int* E = (int*)(lds + wave * PG_WLDS + 4096); float* W = (float*)(lds + wave * PG_WLDS + 4608);
    const int gq = lane >> 3, c8 = lane & 7, tb = blk * PG_TB + PG_TPW * wave;
    u32x4 vA[16], vB[16]; unsigned oA, oB; float wa0, wa1, wb0, wb1; int ea0, ea1, eb0, eb1;
    const int* ebase = P.eid; const float* wbase = P.gate; const bf16_t* obase = outp; const unsigned char* vbase = P.V8;
    const unsigned eo = (unsigned)((tb * 128 + lane) * 4), oo = (unsigned)((tb * 1024 + 128 * x + 2 * lane) * 2);
    { const int* ep = P.eid + (size_t)tb * 128 + lane; ea0 = ep[0]; ea1 = ep[64]; eb0 = ep[128]; eb1 = ep[192]; }
    WAVE_SYNC(); E[lane] = ea0; E[64 + lane] = ea1; WAVE_SYNC();
#pragma unroll
    for (int k = 0; k < 16; ++k) { const unsigned off = ((unsigned)(x * NEXP) + (unsigned)E[gq + 8 * k]) * 128u + 16u * (unsigned)c8; GLOAD16_S(vA[k], vbase, off); }
    GLOAD4_S(wa0, wbase, eo); GLOAD4_S(wa1, wbase, eo + 256u); GLOAD4_S(oA, obase, oo); GLOAD4_S(ea0, ebase, eo + 2u * 512u); GLOAD4_S(ea1, ebase, eo + 2u * 512u + 256u);
    WAVE_SYNC(); E[lane] = eb0; E[64 + lane] = eb1; WAVE_SYNC();
#pragma unroll
    for (int k = 0; k < 16; ++k) { const unsigned off = ((unsigned)(x * NEXP) + (unsigned)E[gq + 8 * k]) * 128u + 16u * (unsigned)c8; GLOAD16_S(vB[k], vbase, off); }
    GLOAD4_S(wb0, wbase, eo + 512u); GLOAD4_S(wb1, wbase, eo + 512u + 256u); GLOAD4_S(oB, obase, oo + 2048u); GLOAD4_S(eb0, ebase, eo + 3u * 512u); GLOAD4_S(eb1, ebase, eo + 3u * 512u + 256u);
#pragma unroll
    for (int i = 0; i < PG_TPW; i += 2) {
        if (i == 0) WAIT_VM(21); else WAIT_VM(22);
        PIN4(wa0, wa1, ea0, ea1); PIN1(oA);
        if (i + 2 < PG_TPW) { WAVE_SYNC(); E[lane] = ea0; E[64 + lane] = ea1; WAVE_SYNC();
            pg_acc_compute<true, 0>(P, outp, x, tb + i, vA, wa0, wa1, oA, C, W, E, c8, gq, lane);
            const unsigned nx = (unsigned)((i + 4 < PG_TPW) ? i + 4 : PG_TPW - 1);
            GLOAD4_S(wa0, wbase, eo + (unsigned)(i + 2) * 512u); GLOAD4_S(wa1, wbase, eo + (unsigned)(i + 2) * 512u + 256u); GLOAD4_S(oA, obase, oo + (unsigned)(i + 2) * 2048u);
            GLOAD4_S(ea0, ebase, eo + nx * 512u); GLOAD4_S(ea1, ebase, eo + nx * 512u + 256u); }
        else pg_acc_compute<false, 0>(P, outp, x, tb + i, vA, wa0, wa1, oA, C, W, E, c8, gq, lane);
        if (i + 2 < PG_TPW) WAIT_VM(22); else WAIT_VM(0);
        PIN4(wb0, wb1, eb0, eb1); PIN1(oB);
        if (i + 3 < PG_TPW) { WAVE_SYNC(); E[lane] = eb0; E[64 + lane] = eb1; WAVE_SYNC();
            pg_acc_compute<true, 1>(P, outp, x, tb + i + 1, vB, wb0, wb1, oB, C, W, E, c8, gq, lane);
            const unsigned nx = (unsigned)((i + 5 < PG_TPW) ? i + 5 : PG_TPW - 1);
            GLOAD4_S(wb0, wbase, eo + (unsigned)(i + 3) * 512u); GLOAD4_S(wb1, wbase, eo + (unsigned)(i + 3) * 512u + 256u); GLOAD4_S(oB, obase, oo + (unsigned)(i + 3) * 2048u);
            GLOAD4_S(eb0, ebase, eo + nx * 512u); GLOAD4_S(eb1, ebase, eo + nx * 512u + 256u); }
        else pg_acc_compute<false, 1>(P, outp, x, tb + i + 1, vB, wb0, wb1, oB, C, W, E, c8, gq, lane);
    }
}
template <int STAGE, int CSET = STAGE>
__device__ __forceinline__ void phase_G12(const KP& p, int l, unsigned char* lds) {
    const Ptrs P = make_ptrs(p.ws, l);
    const int tid = TIDX(), lane = tid & 63, wave = tid >> 6;
    int* slot = (int*)(lds + 8 * PG_WLDS);
    const int myx = XCC_ID();
    for (int s = 0; s < 8; ++s) { const int x = (myx + s) & 7; unsigned* cnt = P.qcnt + (CSET * 8 + x) * 16;
        for (;;) { const int blk = peer_next_item(cnt, slot, tid); if (blk >= PG_NBLK) break;
            if (STAGE == 0) peer_dots_item(P, x, blk, lds, lane, wave); else peer_acc_item(CSET == 3 ? P.pd : P.ycat, P, x, blk, lds, lane, wave); } }
    __syncthreads();
}
__device__ __forceinline__ void phase_G1b(const KP& p, int l, unsigned char* lds) {
    const Ptrs P = make_ptrs(p.ws, l);
    const size_t stride = (size_t)GDIM() * NTHR, n = (size_t)T_ * 128;
    for (size_t i0 = (size_t)BIDX() * NTHR + TIDX(); i0 < n; i0 += 4 * stride) { float d[4], gt[4], su[4], sv[4]; int e[4];
#pragma unroll
        for (int q = 0; q < 4; ++q) { const size_t i = i0 + q * stride; e[q] = 0; gt[q] = 0.f; d[q] = 0.f; if (i < n) { e[q] = P.eid[i]; gt[q] = P.gate[i]; } }
#pragma unroll
        for (int q = 0; q < 4; ++q) { const size_t i = i0 + q * stride; su[q] = P.su[e[q]]; sv[q] = P.sv[e[q]];
            if (i < n) {
#pragma unroll
                for (int x = 0; x < 8; ++x) d[q] += bf2f(P.pd[(size_t)x * T_ * 128 + i]); } }
#pragma unroll
        for (int q = 0; q < 4; ++q) { const size_t i = i0 + q * stride; if (i < n) P.gate[i] = gt[q] * sv[q] * gelu_erf(d[q] * su[q]); } }
#ifdef CPU_EMU
    (void)lds;
#endif
}
__device__ __forceinline__ void phase_G3(const KP& p, int l, unsigned char* lds, bool last) {
    const Ptrs P = make_ptrs(p.ws, l);
    const int tid = TIDX(), lane = tid & 63, wave = tid >> 6; const int gw = BIDX() * NWAVE + wave, NGW = GDIM() * NWAVE;
    for (int m = 4 * gw; m < T_; m += 4 * NGW) ln_rows<4, true>(P.ycat + (size_t)m * 1024, p.in[I_LN2G] + l * 1024, p.in[I_LN2B] + l * 1024, last ? p.out + (size_t)m * 1024 : (float*)nullptr, last ? (bf16_t*)nullptr : P.hb + (size_t)m * 1024,
                                                           last ? (unsigned char*)nullptr : (m < H8_SPLIT ? P.h8a + (size_t)m * 1024 : P.h8b + (size_t)(m - H8_SPLIT) * 1024), lane);
}
#ifndef PROBE_REPEAT
#define PROBE_REPEAT 0
#endif
constexpr int LDS_BYTES = 147456;
__device__ __forceinline__ void phase_B1(const KP& p, int l, unsigned char* lds) {
    const Ptrs P = make_ptrs(p.ws, l);
    constexpr int NRC = NB_ * 4 * RW_NCH, NS5 = NB_ * 16, NFX = NB_ * 4 * (S_ / 256), NCV = T_ / 64;
    const int G = GDIM(); int it = BIDX();
    for (; it < NRC; it += G) rw_chunk_unit(p, P, l, it, lds);
#if PROBE_REPEAT == 16
    for (int j = BIDX(); j < NRC; j += G) rw_chunk_unit(p, P, l, j, lds);
#endif
#if PROBE_REPEAT >= 161 && PROBE_REPEAT <= 163
    for (int j = BIDX(); j < NRC; j += G) { rw_chunk_unit<PROBE_REPEAT - 160>(p, P, l, j, lds); __syncthreads(); }
#endif
    for (; it < NRC + NFX; it += G) fox_unit(p, P, l, it - NRC, lds);
#if PROBE_REPEAT == 17
    for (int j = BIDX(); j < NFX; j += G) fox_unit(p, P, l, j, lds);
#endif
    for (; it < NRC + NFX + NS5; it += G) s5_unit(p, P, l, it - NRC - NFX, lds);
#if PROBE_REPEAT == 18
    for (int j = BIDX(); j < NS5; j += G) s5_unit(p, P, l, j, lds);
#endif
    for (; it < NRC + NFX + NS5 + NCV; it += G) conv_unit(p, P, l, it - NRC - NFX - NS5, lds);
#if PROBE_REPEAT == 19
    for (int j = BIDX(); j < NCV; j += G) conv_unit(p, P, l, j, lds);
#endif
}
__device__ __forceinline__ void phase_B3(const KP& p, int l, unsigned char* lds) {
    const Ptrs P = make_ptrs(p.ws, l);
#if PROBE_REPEAT == 34
    for (int it = BIDX(); it < NB_ * 4 * RW_NCH; it += GDIM()) rw_out_unit<true>(p, P, l, it, lds);
#endif
    for (int it = BIDX(); it < NB_ * 4 * RW_NCH; it += GDIM()) rw_out_unit<false>(p, P, l, it, lds);
}
enum { PH_PRO = 0, PH_A, PH_B1, PH_B2, PH_B3, PH_C, PH_D, PH_D2, PH_E, PH_F, PH_G, PH_G1B, PH_G2, PH_G3, PH_N, PH_A0 };
__device__ __forceinline__ void run_phase(const KP& p, int ph, int l, unsigned char* lds) {
    switch (ph) {
        case PH_PRO: phase_prologue(p, lds); break;
        case PH_A: phase_A(p, l, lds); break;
        case PH_A0: phase_A0(p, lds); break;
        case PH_B1: phase_B1(p, l, lds); break;
        case PH_B2: phase_B2(p, l, lds); break;
        case PH_B3: phase_B3(p, l, lds); break;
        case PH_C: phase_C(p, l, lds); break;
        case PH_D: phase_D(p, l, lds); break;
        case PH_D2: phase_D2(p, l, lds); break;
        case PH_E: phase_E(p, l, lds); break;
        case PH_F: phase_F(p, l, lds); break;
        case PH_G: phase_G12<0>(p, l, lds); break;
        case PH_G1B: phase_G1b(p, l, lds); break;
        case PH_G2: phase_G12<1>(p, l, lds); break;
        case PH_G3: phase_G3(p, l, lds, l == L_ - 1); break;
        default: break;
    }
}
#ifndef CPU_EMU
#define XB_TMO      128
#define XB_XCNT(j)  (256  + 64 * (j))
#define XB_XSUB(j)  (1280 + 64 * (j))
#define XB_XGEN(j)  (2304 + 64 * (j))
#define XB_TOP      3328
#define XB_TOPGEN   3392
#define XCD_BAR_WORDS 3456
#define XB_SPIN_CAP (1u << 22)
__device__ __forceinline__ unsigned xb_ld(unsigned* p)              { return __hip_atomic_load(p, __ATOMIC_RELAXED, __HIP_MEMORY_SCOPE_AGENT); }
__device__ __forceinline__ unsigned xb_add(unsigned* p, unsigned v) { return __hip_atomic_fetch_add(p, v, __ATOMIC_RELAXED, __HIP_MEMORY_SCOPE_AGENT); }
__device__ __forceinline__ unsigned xb_xcc_id() { return (unsigned)__builtin_amdgcn_s_getreg((3 << 11) | 20) & 0xFu; }
#define XB_SPIN(cond, bar) do { unsigned _sp = 0; while (cond) { __builtin_amdgcn_s_sleep(1); \
    if ((++_sp & 255u) == 0u) { if (xb_ld(&(bar)[XB_TMO])) break; if (_sp > XB_SPIN_CAP) { atomicAdd(&(bar)[XB_TMO], 1u); break; } } } } while (0)
struct XcdBarrier { unsigned* bar; unsigned x; volatile LAS unsigned* st; };
__device__ __forceinline__ XcdBarrier xcd_barrier_post(unsigned* bar, volatile LAS unsigned* st) {
    XcdBarrier b; b.bar = bar; b.x = xb_xcc_id(); b.st = st;
    if (threadIdx.x == 0) (void)xb_add(&bar[XB_XCNT(b.x)], 1u);
    return b;
}
__device__ __forceinline__ void xcd_barrier_complete(unsigned* bar, unsigned x, unsigned& nloc, unsigned& nx) {
    const unsigned G = gridDim.x * gridDim.y * gridDim.z;
    unsigned sum, cnt, mine, sp = 0u;
    for (;;) {
        sum = 0u; cnt = 0u; mine = 0u;
#pragma unroll
        for (unsigned j = 0; j < 16; ++j) { const unsigned c = xb_ld(&bar[XB_XCNT(j)]); sum += c; cnt += (c > 0u) ? 1u : 0u; mine = (j == x) ? c : mine; }
        if (sum == G) break;
        __builtin_amdgcn_s_sleep(1);
        if ((++sp & 255u) == 0u) { if (xb_ld(&bar[XB_TMO])) break; if (sp > XB_SPIN_CAP) { atomicAdd(&bar[XB_TMO], 1u); break; } }
    }
    nloc = mine > 0u ? mine : 1u; nx = cnt > 0u ? cnt : 1u;
}
__device__ __forceinline__ void xcd_barrier(const XcdBarrier& b) {
    asm volatile("s_waitcnt vmcnt(0)" ::: "memory");
    __syncthreads();
    if (threadIdx.x == 0) {
        unsigned* bar = b.bar;
        __builtin_amdgcn_s_waitcnt(0);
        unsigned nloc = b.st[0], nx = b.st[1];
        if (nloc == 0u) { xcd_barrier_complete(bar, b.x, nloc, nx); b.st[0] = nloc; b.st[1] = nx; }
        const unsigned old = xb_add(&bar[XB_XSUB(b.x)], 1u);
        const unsigned gen = old / nloc;
        if (old + 1u == (gen + 1u) * nloc) {
            __builtin_amdgcn_fence(__ATOMIC_RELEASE, "agent");
            asm volatile("s_waitcnt vmcnt(0)" ::: "memory");
            const unsigned og = xb_add(&bar[XB_TOP], 1u);
            const unsigned tg = og / nx;
            if (og + 1u == (tg + 1u) * nx) xb_add(&bar[XB_TOPGEN], 1u);
            else XB_SPIN(xb_ld(&bar[XB_TOPGEN]) == tg, bar);
            __builtin_amdgcn_fence(__ATOMIC_ACQUIRE, "agent");
            xb_add(&bar[XB_XGEN(b.x)], 1u);
            asm volatile("s_waitcnt vmcnt(0)" ::: "memory");
        } else {
            XB_SPIN(xb_ld(&bar[XB_XGEN(b.x)]) == gen, bar);
            __builtin_amdgcn_fence(__ATOMIC_ACQUIRE, "agent");
            asm volatile("s_waitcnt vmcnt(0)" ::: "memory");
        }
    }
    __syncthreads();
}
#ifndef PROBE_REPEAT
#define PROBE_REPEAT 0
#endif
#ifndef N_LAUNCH_MODE
#define N_LAUNCH_MODE 1
#endif
extern __shared__ __attribute__((aligned(16))) unsigned char lds_dyn[];
#if N_LAUNCH_MODE == 0
template <int PH> __global__ void __launch_bounds__(NTHR, 2) k_phase_t(KP p) { run_phase(p, PH, p.layer, lds_dyn); }
typedef void (*kfn_t)(KP);
static kfn_t phase_fn(int ph) { switch (ph) { case PH_PRO: return k_phase_t<PH_PRO>; case PH_A: return k_phase_t<PH_A>; case PH_B1: return k_phase_t<PH_B1>; case PH_B2: return k_phase_t<PH_B2>; case PH_B3: return k_phase_t<PH_B3>; case PH_C: return k_phase_t<PH_C>;
    case PH_D: return k_phase_t<PH_D>; case PH_D2: return k_phase_t<PH_D2>; case PH_E: return k_phase_t<PH_E>; case PH_F: return k_phase_t<PH_F>; case PH_G: return k_phase_t<PH_G>; case PH_G1B: return k_phase_t<PH_G1B>; case PH_G2: return k_phase_t<PH_G2>; default: return k_phase_t<PH_G3>; } }
#else
#ifndef USE_XCD_BARRIER
#define USE_XCD_BARRIER 1
#endif
constexpr int BAR_LDS_OFF = LDS_BYTES - 64;
#if USE_XCD_BARRIER
#define GSYNC() xcd_barrier(bar)
#define GSYNC_ARG const XcdBarrier& bar
#else
#define GSYNC() grid.sync()
#define GSYNC_ARG cg::grid_group& grid
#endif
template <int l>
__device__ __forceinline__ void mega_layer(const KP& p, GSYNC_ARG) {
#if PROBE_REPEAT == 47 || PROBE_REPEAT == 48
        phase_Aprobe<PROBE_REPEAT - 40>(p, l, lds_dyn); GSYNC();
#endif
        phase_A(p, l, lds_dyn);
#if PROBE_REPEAT == 1
        GSYNC(); phase_A(p, l, lds_dyn);
#endif
#if PROBE_REPEAT >= 40 && PROBE_REPEAT <= 46
        GSYNC(); phase_Aprobe<PROBE_REPEAT - 40>(p, l, lds_dyn);
#endif
        GSYNC(); phase_B1(p, l, lds_dyn);
#if PROBE_REPEAT == 2
        GSYNC(); phase_B1(p, l, lds_dyn);
#endif
        GSYNC(); phase_B2(p, l, lds_dyn);
        GSYNC(); phase_B3(p, l, lds_dyn);
        GSYNC(); phase_C(p, l, lds_dyn);
#if PROBE_REPEAT == 4
        GSYNC(); phase_C(p, l, lds_dyn);
#endif
        GSYNC(); phase_D(p, l, lds_dyn);
        GSYNC(); phase_D2(p, l, lds_dyn);
        GSYNC(); phase_E(p, l, lds_dyn);
        GSYNC(); phase_F(p, l, lds_dyn);
#if PROBE_REPEAT == 8
        GSYNC(); phase_F(p, l, lds_dyn);
#endif
        GSYNC(); phase_G12<0>(p, l, lds_dyn);
#if PROBE_REPEAT == 32
        GSYNC(); phase_G12<0, 2>(p, l, lds_dyn);
#endif
        GSYNC(); phase_G1b(p, l, lds_dyn);
        GSYNC(); phase_G12<1>(p, l, lds_dyn);
#if PROBE_REPEAT == 33
        GSYNC(); phase_G12<1, 3>(p, l, lds_dyn);
#endif
        GSYNC(); phase_G3(p, l, lds_dyn, l == L_ - 1);
}
__global__ void __launch_bounds__(NTHR, 2) k_mega(KP p) {
    cg::grid_group grid = cg::this_grid();
#if USE_XCD_BARRIER
    volatile LAS unsigned* st = (volatile LAS unsigned*)(lds_dyn + BAR_LDS_OFF);
    if (threadIdx.x < 2) st[threadIdx.x] = 0u;
    __syncthreads();
    const XcdBarrier bar = xcd_barrier_post((unsigned*)(p.ws + WS_CTL) + 4096, st);
#define GSYNC_VAL bar
#else
#define GSYNC_VAL grid
#endif
    phase_prologue(p, lds_dyn);
#if PROBE_REPEAT == 60
    GSYNC(); phase_prologue(p, lds_dyn);
#endif
    grid.sync();
    phase_A0(p, lds_dyn);
    GSYNC();
    mega_layer<0>(p, GSYNC_VAL);
    static_assert(L_ == 2, "two layers");
    GSYNC();
    mega_layer<1>(p, GSYNC_VAL);
}
#endif
extern "C" void kernel_launch(void* const* d_in, const int* in_sizes, int n_in, void* d_out, int out_size, void* d_ws, size_t ws_size, hipStream_t stream) {
    static int grid = 0;
    if (grid == 0) {
        if (n_in != N_IN || out_size != T_ * 1024 || ws_size < WS_END) { fprintf(stderr, "kernel_launch: unexpected shapes (n_in %d out %d ws %zu need %zu)\n", n_in, out_size, ws_size, (size_t)WS_END); grid = -1; return; }
        int dev = 0, cus = 0, per_cu = 0;
        (void)hipGetDevice(&dev); (void)hipDeviceGetAttribute(&cus, hipDeviceAttributeMultiprocessorCount, dev);
#if N_LAUNCH_MODE == 0
        for (int ph = 0; ph < PH_N; ++ph) (void)hipFuncSetAttribute((const void*)phase_fn(ph), hipFuncAttributeMaxDynamicSharedMemorySize, LDS_BYTES);
        (void)per_cu;
#else
        (void)hipFuncSetAttribute((const void*)k_mega, hipFuncAttributeMaxDynamicSharedMemorySize, LDS_BYTES);
        (void)hipOccupancyMaxActiveBlocksPerMultiprocessor(&per_cu, (const void*)k_mega, NTHR, LDS_BYTES);
        if (per_cu < 1) { fprintf(stderr, "kernel_launch: occupancy query says %d blocks per CU\n", per_cu); grid = -1; return; }
#endif
        grid = cus;
    }
    if (grid < 0) return;
    if (hipMemsetAsync((char*)d_ws + WS_CTL, 0, 65536, stream) != hipSuccess) { fprintf(stderr, "kernel_launch: memset failed\n"); return; }
    KP p{};
    for (int i = 0; i < N_IN; ++i) p.in[i] = (const float*)d_in[i];
    p.out = (float*)d_out; p.ws = (unsigned char*)d_ws;
#if N_LAUNCH_MODE == 1
    void* args[] = {&p};
    hipError_t e = hipLaunchCooperativeKernel((const void*)k_mega, dim3(grid), dim3(NTHR), args, LDS_BYTES, stream);
    if (e != hipSuccess) fprintf(stderr, "cooperative launch failed: %s (grid %d)\n", hipGetErrorString(e), grid);
#else
    p.phase = PH_PRO; p.layer = 0; hipLaunchKernelGGL(phase_fn(PH_PRO), dim3(grid), dim3(NTHR), LDS_BYTES, stream, p);
    for (int l = 0; l < L_; ++l) for (int ph = PH_A; ph < PH_N; ++ph) { p.phase = ph; p.layer = l; hipLaunchKernelGGL(phase_fn(ph), dim3(grid), dim3(NTHR), LDS_BYTES, stream, p); }
#endif
}
#endif
```

```cpp
#ifdef CPU_EMU
#include "emu.h"
#define LAS
#define GET_LDS() ((unsigned char*)emu::lds())
#define AS_GLOBAL(p) (p)
#define AS_LDS(p) (p)
#define RFL(x) (x)
#define MFMA32(a, b, c) emu_mfma32(a, b, c)
#define MFMA16(a, b, c) emu_mfma16(a, b, c)
#define MFMA16_FP8(a, b, c) emu_mfma16_fp8(a, b, c)
#define FAST_EXP2(x) exp2f(x)
#define FAST_RCP(x) (1.0f / (x))
#define FAST_LOG2(x) log2f(x)
#define FAST_RSQ(x) (1.0f / sqrtf(x))
#define WAVE_SYNC() do { uint32_t _z = 0; (void)emu::wave_xchg(&_z, 1); } while (0)
#define OPAQUE(x) do {} while (0)
#define GLDS16(gp, lp, lane) memcpy((char*)(lp) + 16 * (lane), (const void*)(gp), 16)
#define WAIT_VM(n) do {} while (0)
#define GLOAD16_ASM(dst, ptr) (dst) = *(const u32x4*)(ptr)
#define GLOAD16_RW(dst, ptr) (dst) = *(const u32x4*)(ptr)
#define PIN1(a) do {} while (0)
#define GLOAD16_RW_S(dst, base, off) (dst) = *(const u32x4*)((const unsigned char*)(base) + (off))
#define SCHED_FENCE() do {} while (0)
#define TAG_A() do {} while (0)
#define TAG_B() do {} while (0)
#define GLOAD16_S(dst, base, off) (dst) = *(const u32x4*)((const unsigned char*)(base) + (off))
#define GLOAD4_S(dst, base, off) memcpy(&(dst), (const unsigned char*)(base) + (off), 4)
#define GLOAD4_ASM(dst, ptr) (dst) = *(const int*)(ptr)
#define PIN4(a, b, c, d) do {} while (0)
#define PIN2I(a, b) do {} while (0)
#define WAIT_LGKM0() do {} while (0)
#define READLANE_I(v, l) __shfl((int)(v), (l))
#define READLANE_F(v, l) __shfl((float)(v), (l))
#define TIDX() ((int)threadIdx.x)
#define XCC_ID() (emu::bid() & 7)
#define GDIM() ((int)gridDim.x)
#define BIDX() ((int)blockIdx.x)
#define OPAQUE_S(x) do {} while (0)
#define MEMFENCE() do {} while (0)
#else
#include <hip/hip_runtime.h>
#include <hip/hip_cooperative_groups.h>
#include <cstdio>
#include <cstdint>
namespace cg = cooperative_groups;
#define LAS __attribute__((address_space(3)))
#define GAS __attribute__((address_space(1)))
#define AS_GLOBAL(p) ((unsigned char*)(GAS unsigned char*)(p))
#define AS_LDS(p) ((unsigned char*)(LAS unsigned char*)(p))
#define RFL(x) __builtin_amdgcn_readfirstlane(x)
#define MFMA32(a, b, c) __builtin_amdgcn_mfma_f32_32x32x16_bf16(a, b, c, 0, 0, 0)
#define MFMA16(a, b, c) __builtin_amdgcn_mfma_f32_16x16x32_bf16(a, b, c, 0, 0, 0)
#define MFMA16_FP8(a, b, c) __builtin_amdgcn_mfma_f32_16x16x32_fp8_fp8((long)(a), (long)(b), c, 0, 0, 0)
#define MFMA16_F8X128(a, b, c) __builtin_amdgcn_mfma_scale_f32_16x16x128_f8f6f4(a, b, c, 0, 0, 0, 0, 0, 0)
#define FAST_EXP2(x) __builtin_amdgcn_exp2f(x)
#define FAST_RCP(x) __builtin_amdgcn_rcpf(x)
#define FAST_LOG2(x) __builtin_amdgcn_logf(x)
#define FAST_RSQ(x) __builtin_amdgcn_rsqf(x)
#define WAVE_SYNC() __builtin_amdgcn_wave_barrier()
#define OPAQUE(x) asm volatile("" : "+v"(x))
#define GLDS16(gp, lp, lane) __builtin_amdgcn_global_load_lds((const unsigned*)(gp), (LAS unsigned*)(lp), 16, 0, 0)
#define WAIT_VM(n) asm volatile("s_waitcnt vmcnt(" #n ")" ::: "memory")
#define GLOAD16_ASM(dst, ptr) asm volatile("global_load_dwordx4 %0, %1, off" : "=v"(dst) : "v"(ptr) : "memory")
#define GLOAD4_ASM(dst, ptr) asm volatile("global_load_dword %0, %1, off" : "=v"(dst) : "v"(ptr) : "memory")
#define GLOAD16_RW(dst, ptr) asm volatile("global_load_dwordx4 %0, %1, off" : "+v"(dst) : "v"(ptr) : "memory")
#define PIN1(a) asm volatile("" : "+v"(a) :: "memory")
#define GLOAD16_RW_S(dst, base, off) asm volatile("global_load_dwordx4 %0, %1, %2" : "+v"(dst) : "v"(off), "s"(base) : "memory")
#define SCHED_FENCE() __builtin_amdgcn_sched_barrier(0)
#define TAG_A() asm volatile("; buffer A" ::: "memory")
#define TAG_B() asm volatile("; buffer B" ::: "memory")
#define GLOAD16_S(dst, base, off) asm volatile("global_load_dwordx4 %0, %1, %2" : "=v"(dst) : "v"(off), "s"(base) : "memory")
#define GLOAD4_S(dst, base, off) asm volatile("global_load_dword %0, %1, %2" : "=v"(dst) : "v"(off), "s"(base) : "memory")
#define PIN4(a, b, c, d) asm volatile("" : "+v"(a), "+v"(b), "+v"(c), "+v"(d) :: "memory")
#define PIN2I(a, b) asm volatile("" : "+v"(a), "+v"(b) :: "memory")
#define WAIT_LGKM0() asm volatile("s_waitcnt lgkmcnt(0)" ::: "memory")
#define READLANE_I(v, l) __builtin_amdgcn_readlane((int)(v), (l))
#define READLANE_F(v, l) __builtin_bit_cast(float, __builtin_amdgcn_readlane(__builtin_bit_cast(int, (float)(v)), (l)))
#define OPAQUE_S(x) asm volatile("" : "+s"(x))
__device__ __forceinline__ int opaque_tid_() { int t = threadIdx.x; asm volatile("" : "+v"(t)); return t; }
#define TIDX() opaque_tid_()
#define XCC_ID() ((int)(__builtin_amdgcn_s_getreg((3 << 11) | 20) & 7u))
__device__ __forceinline__ int opaque_gdim_() { int t = gridDim.x; asm volatile("" : "+s"(t)); return t; }
__device__ __forceinline__ int opaque_bidx_() { int t = blockIdx.x; asm volatile("" : "+s"(t)); return t; }
#define GDIM() opaque_gdim_()
#define BIDX() opaque_bidx_()
#define MEMFENCE() do { asm volatile("" ::: "memory"); __builtin_amdgcn_sched_barrier(0); } while (0)
#endif

#ifndef CFG_B
#define CFG_B 16
#endif
#ifndef CFG_S
#define CFG_S 2048
#endif

typedef unsigned short bf16_t;
typedef short bf16x8 __attribute__((ext_vector_type(8)));
typedef short s16x4 __attribute__((ext_vector_type(4)));
typedef float f32x4 __attribute__((ext_vector_type(4)));
typedef float f32x2 __attribute__((ext_vector_type(2)));
typedef float f32x16 __attribute__((ext_vector_type(16)));
typedef unsigned u32x4 __attribute__((ext_vector_type(4)));
typedef unsigned u32x2 __attribute__((ext_vector_type(2)));
typedef int i32x4 __attribute__((ext_vector_type(4)));
typedef int i32x8 __attribute__((ext_vector_type(8)));

constexpr int NB_ = CFG_B, S_ = CFG_S, T_ = NB_ * S_, D_ = 1024, L_ = 2;
constexpr int NTHR = 512, NWAVE = 8;
constexpr int PJ = 2304;
constexpr int C_R = 0, C_K = 256, C_V = 512, C_HW = 768, C_HA = 800, C_HG = 832, C_S5 = 896, C_FQ = 1152, C_FK = 1408, C_FL = 1664, C_CV = 1792, C_CG = 2048;
constexpr int WIN_ROWS = 6656, WIN_VT = 2304, WIN_GATE = 2560;
constexpr int IN_COLS = 6532;
constexpr float LN_EPS_ = 1e-5f, GN_EPS_ = 64e-5f;
constexpr float DN_ALPHA_ = 1.4142135623730951f;
constexpr int NEXP = 16384;

enum { I_X = 0, I_P, I_LNIN_G, I_LNIN_B, I_WIN, I_MU, I_W0, I_W2, I_A0, I_A2, I_G2, I_KK, I_KA, I_RK, I_LNXG, I_LNXB, I_LRE, I_LIM, I_BRE, I_BIM, I_CRE, I_CIM,
       I_S5D, I_LDT, I_GLUW, I_GLUB, I_BF, I_CONVW, I_CONVB, I_CLNG, I_CLNB, I_WBR, I_WOUT, I_LN1G, I_LN1B, I_WQ, I_K1, I_K2, I_U, I_V, I_PLEW, I_PLEG, I_LN2G, I_LN2B, N_IN };

constexpr size_t al256(size_t x) { return (x + 255) & ~(size_t)255; }
constexpr size_t WS_CTL = 0;
constexpr size_t WS_WIN = 1u << 20;
constexpr size_t WS_WBR = WS_WIN + al256((size_t)L_ * WIN_ROWS * 1024 * 2);
constexpr size_t WS_WOUT = WS_WBR + (size_t)L_ * 1024 * 1024 * 2;
constexpr size_t WS_WQ = WS_WOUT + (size_t)L_ * 1024 * 1024 * 2;
constexpr size_t WS_PLE = WS_WQ + (size_t)L_ * 2048 * 1024 * 2;
constexpr size_t WS_PLEG = WS_PLE + (size_t)L_ * 1024 * 256 * 2;
constexpr size_t WS_GLU = WS_PLEG + (size_t)L_ * 1024 * 1024 * 2;
constexpr size_t WS_K12 = WS_GLU + (size_t)L_ * 256 * 256 * 2;
constexpr size_t WS_S5KC = WS_K12 + (size_t)L_ * 2 * 128 * 128 * 2;
constexpr size_t WS_S5WX = WS_S5KC + (size_t)L_ * 16 * 64 * 256 * 2;
constexpr size_t WS_S5WY = WS_S5WX + (size_t)L_ * 16 * 128 * 1024 * 2;
constexpr size_t WS_S5LL = WS_S5WY + (size_t)L_ * 16 * 1024 * 128 * 2;
constexpr size_t WS_UT = WS_S5LL + al256((size_t)L_ * 16 * 64 * 2 * 4);
constexpr size_t WS_VT = WS_UT + (size_t)NEXP * 1024 * 2;
constexpr size_t WS_RW = WS_VT + (size_t)NEXP * 1024 * 2;
constexpr size_t RW_SZ = (size_t)T_ * 512;
static_assert(2 * RW_SZ <= (size_t)NEXP * 1024 * 2, "RWKV gate / bonus arrays fit the second table region");
constexpr size_t WS_HB = WS_RW + 4 * RW_SZ;
constexpr size_t WS_R1 = WS_HB + (size_t)T_ * 1024 * 2;
constexpr size_t R1_BYTES = (size_t)T_ * 2560 * 2;
constexpr size_t WS_YC = WS_R1 + R1_BYTES;
constexpr size_t WS_VTR = WS_YC + (size_t)T_ * 1024 * 2;
constexpr size_t WS_PB = WS_VTR + (size_t)256 * T_ * 2;
constexpr size_t WS_H8T = WS_PB + (size_t)T_ * 256 * 2;
constexpr int H8_SPLIT = (T_ / 512) * 256;
constexpr size_t WS_END = WS_H8T + (size_t)(T_ - H8_SPLIT) * 1024;
constexpr size_t R1_PROJ = 0;
constexpr size_t R1_H8 = (size_t)T_ * 2304 * 2;
constexpr size_t R1_MERGED = 0;
constexpr size_t R1_STASH = (size_t)T_ * 1024 * 2;
constexpr size_t R1_Q = 0;
constexpr size_t R1_EID = (size_t)T_ * 2048 * 2;
constexpr size_t R1_GATE = R1_EID + (size_t)T_ * 128 * 4;
static_assert(R1_GATE + (size_t)T_ * 128 * 4 <= R1_BYTES, "R1 map");

struct KP { const float* in[N_IN]; float* out; unsigned char* ws; float* dbg; int layer; int phase; };

#ifdef CPU_EMU
__device__ __forceinline__ unsigned f2bf(float f) { unsigned u = __builtin_bit_cast(unsigned, f); return (u + 0x7fffu + ((u >> 16) & 1u)) >> 16; }
__device__ __forceinline__ unsigned pk2(float lo, float hi) { return f2bf(lo) | (f2bf(hi) << 16); }
#else
typedef __bf16 bf16x2_hw __attribute__((ext_vector_type(2)));
__device__ __forceinline__ unsigned pk2(float lo, float hi) { const f32x2 v = {lo, hi}; return __builtin_bit_cast(unsigned, __builtin_convertvector(v, bf16x2_hw)); }
__device__ __forceinline__ unsigned f2bf(float f) { return pk2(f, 0.f) & 0xffffu; }
#endif
__device__ __forceinline__ float bf2f(unsigned h) { return __builtin_bit_cast(float, h << 16); }
__device__ __forceinline__ float bflo(unsigned w) { return __builtin_bit_cast(float, w << 16); }
__device__ __forceinline__ float bfhi(unsigned w) { return __builtin_bit_cast(float, w & 0xffff0000u); }
__device__ __forceinline__ float sigmoidf_(float x) { return FAST_RCP(1.0f + FAST_EXP2(x * -1.4426950408889634f)); }
__device__ __forceinline__ float gelu_erf(float v) {
    const float t = FAST_RCP(fabsf(v) * 0.2316418882f + 1.0f);
    float q = t * 0.5307027145f + (-0.7265760135f); q = q * t + 0.7107068705f; q = q * t + (-0.142248368f); q = q * t + 0.127414796f; q = q * t;
    const float m = v * (q * FAST_EXP2((v * v) * (-0.72134752044f)));
    return v < 0.f ? m : v - m; }
#ifdef CPU_EMU
inline float fp8_dec_(unsigned b) { const unsigned s = b >> 7, e = (b >> 3) & 15, m = b & 7; float v = (e == 0) ? ldexpf((float)m, -9) : ldexpf(1.f + m * 0.125f, (int)e - 7); return s ? -v : v; }
inline unsigned fp8_enc_(float x) { const unsigned s = x < 0.f ? 0x80u : 0u; float a = fabsf(x); if (!(a > 0.f)) return s; if (a > 448.f) a = 448.f;
    int e; (void)frexpf(a, &e); e -= 1; if (e < -6) e = -6;
    const float q = ldexpf(a, 3 - e); float r = nearbyintf(q);
    unsigned ee, mm; if (e == -6 && r < 8.f) { ee = 0; mm = (unsigned)r; } else { if (r >= 16.f) { r = 8.f; e += 1; } ee = (unsigned)(e + 7); mm = (unsigned)r - 8u; }
    if (ee > 15u || (ee == 15u && mm > 6u)) { ee = 15u; mm = 6u; }
    return s | (ee << 3) | mm; }
inline f32x2 cvt_pk_f32_fp8_(unsigned w, bool hi) { const unsigned h = hi ? (w >> 16) : w; return (f32x2){fp8_dec_(h & 255u), fp8_dec_((h >> 8) & 255u)}; }
inline unsigned cvt_pk_fp8_f32_(float a, float b, unsigned old, bool hi) { const unsigned p = fp8_enc_(a) | (fp8_enc_(b) << 8); return hi ? ((old & 0xffffu) | (p << 16)) : ((old & 0xffff0000u) | p); }
#else
__device__ __forceinline__ f32x2 cvt_pk_f32_fp8_(unsigned w, bool hi) { return hi ? __builtin_amdgcn_cvt_pk_f32_fp8((int)w, true) : __builtin_amdgcn_cvt_pk_f32_fp8((int)w, false); }
__device__ __forceinline__ unsigned cvt_pk_fp8_f32_(float a, float b, unsigned old, bool hi) { return hi ? (unsigned)__builtin_amdgcn_cvt_pk_fp8_f32(a, b, (int)old, true) : (unsigned)__builtin_amdgcn_cvt_pk_fp8_f32(a, b, (int)old, false); }
#endif
__device__ __forceinline__ float wave_max(float v) {
#pragma unroll
  for (int o = 1; o < 64; o <<= 1) v = fmaxf(v, __shfl_xor(v, o));
  return v;
}
template <int N> __device__ __forceinline__ void wave_sum_n(float (&v)[N]) {
#pragma unroll
  for (int o = 1; o < 64; o <<= 1) { float t[N];
#pragma unroll
    for (int i = 0; i < N; ++i) t[i] = __shfl_xor(v[i], o);
#pragma unroll
    for (int i = 0; i < N; ++i) v[i] += t[i]; }
}
__device__ __forceinline__ float wave_sum(float v) {
#pragma unroll
  for (int o = 1; o < 64; o <<= 1) v += __shfl_xor(v, o);
  return v;
}
namespace pg8 {
constexpr int BM = 256, BK = 64, HALF = 128, HTB = HALF * BK * 2, STAGE_BYTES = 8 * HTB;
__host__ __device__ __forceinline__ int lds_byte(int r, int c) { const int st = (r >> 4) * 2 + (c >> 5), rr = r & 15, cc = c & 31, ob = rr * 64 + cc * 2; return st * 1024 + (ob ^ (((ob >> 9) & 1) << 5)); }
__host__ __device__ __forceinline__ void stage_rc(int b, int& R, int& C) { const int st = b / 1024, sb = b % 1024, swz = sb ^ (((sb >> 9) & 1) << 5); R = (st >> 1) * 16 + swz / 64; C = (st & 1) * 32 + (swz % 64) / 2; }
__host__ __device__ __forceinline__ int perm32(int rho) { const int n = rho >> 4, i = rho & 15; return 8 * (i >> 2) + 4 * n + (i & 3); }

struct Unit { const char* a; const char* b; int nt; int kind; int pm; int pn; int aux; int f8; };

#ifndef CPU_EMU
template <int MODE = 0, class Epi, class Sched>
__device__ __forceinline__ void gemm_phase(LAS unsigned char* lds, const int lda, const int ldb, const Sched& S, const Epi& E, const int lda8 = 0) {
    const int tid = TIDX(), wid = __builtin_amdgcn_readfirstlane(tid >> 6), lane = tid & 63, wr = wid >> 2, wc = wid & 3, fr = lane & 15, fq = lane >> 4;
    unsigned voffA[2], voffB[2], voffA8[2];
#pragma unroll
    for (int i = 0; i < 2; ++i) { int R, C; stage_rc(tid * 16 + i * 8192, R, C); const int Rb = (R & ~31) + perm32(R & 31);
        voffA[i] = (unsigned)(R * lda + C) * 2u; voffB[i] = (unsigned)(Rb * ldb + C) * 2u; voffA8[i] = (unsigned)(R * lda8 + C * 2); }
    const size_t kstep = (size_t)(BK * 2);
    const size_t hstepA = (size_t)HALF * lda * 2, hstepB = (size_t)HALF * ldb * 2, hstepA8 = (size_t)HALF * lda8;
    const unsigned ldsw = (unsigned)wid * 1024u;
    const int aoff = lds_byte(wr * 64 + fr, fq * 8), boff = lds_byte(wc * 32 + fr, fq * 8);
#define PG8_SA(b, h) (((b) * 2 + (h)) * HTB)
#define PG8_SB(b, h) ((4 + (b) * 2 + (h)) * HTB)
#define PG8_STAGE(bufoff, gbase, voff) do { _Pragma("unroll") for (int _i = 0; _i < 2; ++_i) \
        __builtin_amdgcn_global_load_lds((const unsigned*)((const char*)(gbase) + (voff)[_i]), (LAS unsigned*)(lds + (bufoff) + ldsw + _i * 8192), 16, 0, 0); } while (0)
#define PG8_LDA(dst, b, h) do { _Pragma("unroll") for (int m = 0; m < 4; ++m) _Pragma("unroll") for (int k = 0; k < 2; ++k) dst[m][k] = *(const LAS bf16x8*)(lds + PG8_SA(b, h) + aoff + m * 2048 + k * 1024); } while (0)
#define PG8_LDB(dst, b, h) do { _Pragma("unroll") for (int n = 0; n < 2; ++n) _Pragma("unroll") for (int k = 0; k < 2; ++k) dst[n][k] = *(const LAS bf16x8*)(lds + PG8_SB(b, h) + boff + n * 2048 + k * 1024); } while (0)
#define PG8_MMA(ai, bj, At, Bt) do { __builtin_amdgcn_s_setprio(1); _Pragma("unroll") for (int m = 0; m < 4; ++m) _Pragma("unroll") for (int n = 0; n < 2; ++n) _Pragma("unroll") for (int k = 0; k < 2; ++k) \
        acc[ai][bj][m][n] = __builtin_amdgcn_mfma_f32_16x16x32_bf16(Bt[n][k], At[m][k], acc[ai][bj][m][n], 0, 0, 0); __builtin_amdgcn_s_setprio(0); } while (0)
#define PG8_CAT(x, y) __builtin_shufflevector(__builtin_bit_cast(i32x4, x), __builtin_bit_cast(i32x4, y), 0, 1, 2, 3, 4, 5, 6, 7)
#define PG8_LDA8(dst, b, h) do { _Pragma("unroll") for (int m = 0; m < 4; ++m) dst[m] = PG8_CAT(*(const LAS bf16x8*)(lds + PG8_SA(b, h) + aoff + m * 2048), *(const LAS bf16x8*)(lds + PG8_SA(b, h) + aoff + m * 2048 + 1024)); } while (0)
#define PG8_LDB8(dst, b, h) do { _Pragma("unroll") for (int n = 0; n < 2; ++n) dst[n] = PG8_CAT(*(const LAS bf16x8*)(lds + PG8_SB(b, h) + boff + n * 2048), *(const LAS bf16x8*)(lds + PG8_SB(b, h) + boff + n * 2048 + 1024)); } while (0)
#define PG8_MMA8(ai, bj, A8, B8) do { __builtin_amdgcn_s_setprio(1); _Pragma("unroll") for (int m = 0; m < 4; ++m) _Pragma("unroll") for (int n = 0; n < 2; ++n) \
        acc[ai][bj][m][n] = MFMA16_F8X128(B8[n], A8[m], acc[ai][bj][m][n]); __builtin_amdgcn_s_setprio(0); } while (0)
#define PG8_WAIT_V(n) asm volatile("s_waitcnt vmcnt(" #n ")" ::: "memory")
#define PG8_WAIT_L(n) asm volatile("s_waitcnt lgkmcnt(" #n ")" ::: "memory")
#define PG8_BAR __builtin_amdgcn_s_barrier()
#define PG8_SCHED __builtin_amdgcn_sched_barrier(0)
    Unit cur, nxt; int ui = 0;
    if (!S.next(0, cur)) return;
    f32x4 acc[2][2][4][2];
#pragma unroll
    for (int a = 0; a < 2; ++a)
#pragma unroll
        for (int b = 0; b < 2; ++b)
#pragma unroll
            for (int m = 0; m < 4; ++m)
#pragma unroll
                for (int n = 0; n < 2; ++n) acc[a][b][m][n] = (f32x4){0.f, 0.f, 0.f, 0.f};
    bf16x8 At[4][2], B0[2][2], B1[2][2];
    const char* cA = cur.a; const char* cB = cur.b; int cf8 = MODE == 2 ? cur.f8 : MODE; size_t chA = cf8 ? hstepA8 : hstepA;
    { unsigned v0[2] = {cf8 ? voffA8[0] : voffA[0], cf8 ? voffA8[1] : voffA[1]};
    PG8_STAGE(PG8_SB(0, 0), cB, voffB); PG8_STAGE(PG8_SB(0, 1), cB + hstepB, voffB); PG8_STAGE(PG8_SA(0, 0), cA, v0); PG8_STAGE(PG8_SA(0, 1), cA + chA, v0);
    if (wr == 1) PG8_BAR;
    PG8_WAIT_V(2); PG8_BAR;
    PG8_STAGE(PG8_SB(1, 0), cB + kstep, voffB); PG8_STAGE(PG8_SA(1, 0), cA + kstep, v0); PG8_STAGE(PG8_SB(1, 1), cB + hstepB + kstep, voffB);
    PG8_WAIT_V(6); PG8_BAR; }
    for (;;) {
        const bool has_next = S.next(ui + 1, nxt);
        const char* nA = has_next ? nxt.a : cA; const char* nB = has_next ? nxt.b : cB; const int nf8 = MODE == 2 ? (has_next ? nxt.f8 : cf8) : MODE;
        int nt = cur.nt; asm volatile("" : "+s"(nt));
#define PG8_KLOOP(LDA_, LDB_, MM_, At_, B0_, B1_, CF8) \
        for (int t = 0; t < nt; t += 2) { \
            const bool last = (t == nt - 2); \
            const char* a1 = cA + (size_t)(t + 1) * kstep; \
            const char* a2 = last ? nA : cA + (size_t)(t + 2) * kstep; const char* b2 = last ? nB : cB + (size_t)(t + 2) * kstep; \
            const char* a3 = a2 + kstep; const char* b3 = b2 + kstep; \
            const int f2 = last ? nf8 : CF8; const size_t h2 = f2 ? hstepA8 : hstepA; \
            OPAQUE_S(a1); OPAQUE_S(a2); OPAQUE_S(a3); OPAQUE_S(b2); OPAQUE_S(b3); \
            const unsigned vA[2] = {CF8 ? voffA8[0] : voffA[0], CF8 ? voffA8[1] : voffA[1]}, vA2[2] = {f2 ? voffA8[0] : voffA[0], f2 ? voffA8[1] : voffA[1]}, vB[2] = {voffB[0], voffB[1]}; \
            LDB_(B0_, 0, 0); LDB_(B1_, 0, 1); PG8_SCHED; LDA_(At_, 0, 0); PG8_STAGE(PG8_SA(1, 1), a1 + (CF8 ? hstepA8 : hstepA), vA); \
            PG8_WAIT_V(8); PG8_WAIT_L(0); PG8_BAR; MM_(0, 0, At_, B0_); MM_(0, 1, At_, B1_); PG8_BAR; PG8_SCHED; \
            LDA_(At_, 0, 1); PG8_STAGE(PG8_SB(0, 0), b2, vB); PG8_STAGE(PG8_SB(0, 1), b2 + hstepB, vB); PG8_STAGE(PG8_SA(0, 0), a2, vA2); \
            PG8_WAIT_V(8); PG8_WAIT_L(0); PG8_BAR; MM_(1, 0, At_, B0_); MM_(1, 1, At_, B1_); PG8_BAR; PG8_SCHED; \
            LDB_(B0_, 1, 0); LDB_(B1_, 1, 1); PG8_SCHED; LDA_(At_, 1, 0); PG8_STAGE(PG8_SA(0, 1), a2 + h2, vA2); \
            PG8_WAIT_V(8); PG8_WAIT_L(0); PG8_BAR; MM_(0, 0, At_, B0_); MM_(0, 1, At_, B1_); PG8_BAR; PG8_SCHED; \
            LDA_(At_, 1, 1); PG8_STAGE(PG8_SB(1, 0), b3, vB); PG8_STAGE(PG8_SB(1, 1), b3 + hstepB, vB); PG8_STAGE(PG8_SA(1, 0), a3, vA2); \
            PG8_WAIT_V(8); PG8_WAIT_L(0); PG8_BAR; MM_(1, 0, At_, B0_); MM_(1, 1, At_, B1_); PG8_BAR; PG8_SCHED; \
        }
        if (MODE == 1 || (MODE == 2 && cf8)) { i32x8 A8[4], B08[2], B18[2]; PG8_KLOOP(PG8_LDA8, PG8_LDB8, PG8_MMA8, A8, B08, B18, 1) }
        else { PG8_KLOOP(PG8_LDA, PG8_LDB, PG8_MMA, At, B0, B1, 0) }
#undef PG8_KLOOP
        if (wr == 0) PG8_BAR;
        E(acc, cur, wr, wc, fr, fq, tid);
        if (!has_next) break;
#pragma unroll
        for (int a = 0; a < 2; ++a)
#pragma unroll
            for (int b = 0; b < 2; ++b)
#pragma unroll
                for (int m = 0; m < 4; ++m)
#pragma unroll
                    for (int n = 0; n < 2; ++n) acc[a][b][m][n] = (f32x4){0.f, 0.f, 0.f, 0.f};
        cur = nxt; cA = nA; cB = nB; cf8 = nf8; ++ui;
        if (wr == 1) PG8_BAR;
    }
    PG8_WAIT_V(0);
    PG8_BAR;
#undef PG8_SA
#undef PG8_SB
#undef PG8_STAGE
#undef PG8_LDA
#undef PG8_LDB
#undef PG8_MMA
#undef PG8_MMA8
#undef PG8_LDA8
#undef PG8_LDB8
#undef PG8_CAT
#undef PG8_WAIT_V
#undef PG8_WAIT_L
#undef PG8_BAR
#undef PG8_SCHED
}
#else
template <int MODE = 0, class Epi, class Sched>
inline void gemm_phase(unsigned char* lds, const int lda, const int ldb, const Sched& S, const Epi& E, const int lda8 = 0) {
    const int tid = TIDX(), wid = tid >> 6, lane = tid & 63, wr = wid >> 2, wc = wid & 3, fr = lane & 15, fq = lane >> 4;
    Unit cur;
    for (int ui = 0; S.next(ui, cur); ++ui) {
        f32x4 acc[2][2][4][2];
        const bf16_t* A = (const bf16_t*)cur.a; const bf16_t* Bt = (const bf16_t*)cur.b; const int K = cur.nt * 64;
        for (int ai = 0; ai < 2; ++ai) for (int bj = 0; bj < 2; ++bj) for (int m = 0; m < 4; ++m) for (int n = 0; n < 2; ++n) for (int e = 0; e < 4; ++e) {
            const int r = 128 * ai + 64 * wr + 16 * m + fr, c = 128 * bj + 32 * wc + 8 * fq + 4 * n + e; float s = 0.f;
            const bf16_t* ar = A + (size_t)r * lda; const bf16_t* br = Bt + (size_t)c * ldb;
            if (cur.f8) { const unsigned char* a8 = (const unsigned char*)cur.a + (size_t)r * lda8; const unsigned char* b8 = (const unsigned char*)cur.b + (size_t)c * ldb * 2;
                for (int k = 0; k < cur.nt * 128; ++k) s += fp8_dec_(a8[k]) * fp8_dec_(b8[k]); }
#ifdef EMU_FP8_A
            else if (cur.aux == 77) { float am = 0.f; for (int k = 0; k < K; ++k) am = fmaxf(am, fabsf(bf2f(br[k]))); const float sc = am > 0.f ? am / 440.f : 1.f;
                for (int k = 0; k < K; ++k) s += fp8_dec_(fp8_enc_(bf2f(ar[k]))) * fp8_dec_(fp8_enc_(bf2f(br[k]) / sc)); s *= sc; }
#endif
            else for (int k = 0; k < K; ++k) s += bf2f(ar[k]) * bf2f(br[k]);
            acc[ai][bj][m][n][e] = s; }
        __syncthreads();
        E(acc, cur, wr, wc, fr, fq, tid);
        __syncthreads();
    }
    __syncthreads();
}
#endif
}
struct Ptrs {
    bf16_t *WinT, *WbrT, *WoutT, *WqT, *PleT, *PleGT, *GluT, *K12, *S5Kc, *S5Wx, *S5Wy, *Ut, *Vt, *hb, *proj, *merged, *q, *ycat, *vtr, *pb;
    float *S5LL, *gate; int* eid; unsigned char* stash; bf16_t *rwPT, *rwG, *rwS0, *rwQ, *rwGt, *rwRKV; unsigned char *U8, *V8; float *su, *sv; bf16_t* pd; unsigned* qcnt; unsigned char *h8a, *h8b, *h8e; float *gsc, *gscA;
};
__device__ __forceinline__ Ptrs make_ptrs(unsigned char* ws, int l) {
    Ptrs P; { size_t zoff = 0; OPAQUE_S(zoff); ws += zoff; }
    P.WinT = (bf16_t*)(ws + WS_WIN) + (size_t)l * WIN_ROWS * 1024; P.WbrT = (bf16_t*)(ws + WS_WBR) + (size_t)l * 1024 * 1024; P.WoutT = (bf16_t*)(ws + WS_WOUT) + (size_t)l * 1024 * 1024;
    P.WqT = (bf16_t*)(ws + WS_WQ) + (size_t)l * 2048 * 1024; P.PleT = (bf16_t*)(ws + WS_PLE) + (size_t)l * 1024 * 256; P.PleGT = (bf16_t*)(ws + WS_PLEG) + (size_t)l * 1024 * 1024;
    P.GluT = (bf16_t*)(ws + WS_GLU) + (size_t)l * 256 * 256; P.K12 = (bf16_t*)(ws + WS_K12) + (size_t)l * 2 * 128 * 128;
    P.S5Kc = (bf16_t*)(ws + WS_S5KC) + (size_t)l * 16 * 64 * 256; P.S5Wx = (bf16_t*)(ws + WS_S5WX) + (size_t)l * 16 * 128 * 1024; P.S5Wy = (bf16_t*)(ws + WS_S5WY) + (size_t)l * 16 * 1024 * 128;
    P.S5LL = (float*)(ws + WS_S5LL) + (size_t)l * 16 * 64 * 2;
    P.Ut = (bf16_t*)(ws + WS_UT); P.Vt = (bf16_t*)(ws + WS_VT);
    P.pd = (bf16_t*)(ws + WS_R1 + R1_Q); P.qcnt = (unsigned*)(ws + WS_CTL) + 8192 + l * 4 * 8 * 16;
    P.U8 = ws + WS_UT; P.V8 = ws + WS_UT + (size_t)NEXP * 1024; P.su = (float*)(ws + WS_CTL + 131072); P.sv = (float*)(ws + WS_CTL + 131072) + NEXP;
    P.rwGt = (bf16_t*)(ws + WS_VT); P.rwRKV = (bf16_t*)(ws + WS_VT + RW_SZ);
    P.rwPT = (bf16_t*)(ws + WS_RW); P.rwG = (bf16_t*)(ws + WS_RW + RW_SZ); P.rwS0 = (bf16_t*)(ws + WS_RW + 2 * RW_SZ); P.rwQ = (bf16_t*)(ws + WS_RW + 3 * RW_SZ);
    P.hb = (bf16_t*)(ws + WS_HB); P.proj = (bf16_t*)(ws + WS_R1 + R1_PROJ); P.merged = (bf16_t*)(ws + WS_R1 + R1_MERGED); P.q = (bf16_t*)(ws + WS_R1 + R1_Q);
    P.stash = ws + WS_R1 + R1_STASH; P.eid = (int*)(ws + WS_R1 + R1_EID); P.gate = (float*)(ws + WS_R1 + R1_GATE);
    P.ycat = (bf16_t*)(ws + WS_YC); P.vtr = (bf16_t*)(ws + WS_VTR); P.pb = (bf16_t*)(ws + WS_PB);
    P.h8a = ws + WS_R1 + R1_H8; P.h8b = ws + WS_H8T; P.h8e = ws + WS_RW; P.gsc = (float*)(ws + WS_CTL + 262144) + l * 6144; P.gscA = (float*)(ws + WS_CTL + 327680) + l * 2560;
    return P;
}

__device__ __forceinline__ int win_src_col(int n) {
    if (n < 1152) return n;
    if (n < 1664) return n;
    if (n < 1668) return 1920 + (n - 1664);
    if (n < 1792) return -1;
    if (n < 2304) return 1924 + (n - 1792);
    if (n < 2560) return 1664 + (n - 2304);
    return 2436 + (n - 2560);
}
template <bool WINMAP>
__device__ __forceinline__ void transpose_item(const float* src, int sld, bf16_t* dst, int dld, int dcol0, int kb, int nb, float* scr, int lane) {
    const int k0 = 64 * kb, n0 = 32 * nb;
    const int nn = n0 + (lane & 31); const int sc = WINMAP ? win_src_col(nn) : nn;
#pragma unroll 8
    for (int i = 0; i < 32; ++i) { const int kk = 2 * i + (lane >> 5); scr[kk * 33 + (lane & 31)] = (sc >= 0) ? src[(size_t)(k0 + kk) * sld + sc] : 0.f; }
    WAVE_SYNC();
    const int c = lane & 7;
#pragma unroll
    for (int j = 0; j < 4; ++j) { const int n = (lane >> 3) + 8 * j; const float* s = scr + (8 * c) * 33 + n;
        u32x4 o; o.x = pk2(s[0 * 33], s[1 * 33]); o.y = pk2(s[2 * 33], s[3 * 33]); o.z = pk2(s[4 * 33], s[5 * 33]); o.w = pk2(s[6 * 33], s[7 * 33]);
        *(u32x4*)(dst + (size_t)(n0 + n) * dld + dcol0 + k0 + 8 * c) = o; }
    WAVE_SYNC();
}

__device__ __forceinline__ void s5_tables(const KP& p, int l, int g, unsigned char* lds) {
    float* pw = (float*)lds;
    float* bb = pw + 65 * 128;
    float* cc = bb + 64 * 32;
    const int tid = TIDX();
    const Ptrs P = make_ptrs(p.ws, l);
    const float dt = expf(p.in[I_LDT][l * 16 + g]);
    if (tid < 64) { const int pp = tid; const float lr = p.in[I_LRE][(l * 16 + g) * 64 + pp], li = p.in[I_LIM][(l * 16 + g) * 64 + pp];
        const float mag = expf(lr * dt), ang = li * dt; const float br = mag * cosf(ang), bi = mag * sinf(ang);
        float xr = 1.f, xi = 0.f;
        for (int t = 0; t <= 64; ++t) { pw[(t * 64 + pp) * 2] = xr; pw[(t * 64 + pp) * 2 + 1] = xi; const float nr = xr * br - xi * bi, ni = xr * bi + xi * br; xr = nr; xi = ni; }
        const float nr = br - 1.f, ni = bi, den = lr * lr + li * li; const float cr = (nr * lr + ni * li) / den, ci = (ni * lr - nr * li) / den;
        for (int c = 0; c < 16; ++c) { const float b_r = p.in[I_BRE][((l * 16 + g) * 64 + pp) * 16 + c], b_i = p.in[I_BIM][((l * 16 + g) * 64 + pp) * 16 + c];
            bb[(pp * 16 + c) * 2] = cr * b_r - ci * b_i; bb[(pp * 16 + c) * 2 + 1] = cr * b_i + ci * b_r; }
        P.S5LL[(g * 64 + pp) * 2] = pw[(64 * 64 + pp) * 2]; P.S5LL[(g * 64 + pp) * 2 + 1] = pw[(64 * 64 + pp) * 2 + 1];
    }
    for (int e = tid; e < 1024; e += NTHR) { const int c = e >> 6, pp = e & 63; cc[e * 2] = p.in[I_CRE][((l * 16 + g) * 16 + c) * 64 + pp]; cc[e * 2 + 1] = p.in[I_CIM][((l * 16 + g) * 16 + c) * 64 + pp]; }
    __syncthreads();
    bf16_t* Kc = P.S5Kc + (size_t)g * 64 * 256;
    { const int pair = tid & 255, co = pair >> 4, ci = pair & 15, th = tid >> 8; float acc[32];
#pragma unroll
      for (int j = 0; j < 32; ++j) acc[j] = 0.f;
      for (int pp = 0; pp < 64; ++pp) { const float c_r = cc[(co * 64 + pp) * 2], c_i = cc[(co * 64 + pp) * 2 + 1], b_r = bb[(pp * 16 + ci) * 2], b_i = bb[(pp * 16 + ci) * 2 + 1];
          const float d_r = c_r * b_r - c_i * b_i, d_i = c_r * b_i + c_i * b_r;
#pragma unroll
          for (int j = 0; j < 32; ++j) { const f32x2 w = *(const f32x2*)(pw + ((th * 32 + j) * 64 + pp) * 2); acc[j] += d_r * w.x - d_i * w.y; } }
#pragma unroll
      for (int j = 0; j < 32; ++j) Kc[(th * 32 + j) * 256 + pair] = (bf16_t)f2bf(acc[j]); }
    bf16_t* Wx = P.S5Wx + (size_t)g * 128 * 1024;
    for (int e = tid; e < 128 * 1024; e += NTHR) { const int n = e >> 10, k = e & 1023, pp = n >> 1, ri = n & 1, s = k >> 4, ci = k & 15;
        const float w_r = pw[((63 - s) * 64 + pp) * 2], w_i = pw[((63 - s) * 64 + pp) * 2 + 1], b_r = bb[(pp * 16 + ci) * 2], b_i = bb[(pp * 16 + ci) * 2 + 1];
        Wx[e] = (bf16_t)f2bf(ri ? (w_r * b_i + w_i * b_r) : (w_r * b_r - w_i * b_i)); }
    bf16_t* Wy = P.S5Wy + (size_t)g * 1024 * 128;
    for (int e = tid; e < 1024 * 128; e += NTHR) { const int n = e >> 7, k = e & 127, t = n >> 4, co = n & 15, pp = k >> 1, ri = k & 1;
        const float c_r = cc[(co * 64 + pp) * 2], c_i = cc[(co * 64 + pp) * 2 + 1], w_r = pw[((t + 1) * 64 + pp) * 2], w_i = pw[((t + 1) * 64 + pp) * 2 + 1];
        Wy[e] = (bf16_t)f2bf(ri ? -(c_r * w_i + c_i * w_r) : (c_r * w_r - c_i * w_i)); }
    __syncthreads();
}

__device__ __forceinline__ void ln_row(const float* src, const float* g, const float* b, float* dst, bf16_t* dstb, int lane) {
    f32x4 v[4]; float s = 0.f;
#pragma unroll
    for (int j = 0; j < 4; ++j) { v[j] = *(const f32x4*)(src + 256 * j + 4 * lane); s += (v[j].x + v[j].y) + (v[j].z + v[j].w); }
    const float mean = wave_sum(s) * (1.f / 1024.f); float s2 = 0.f;
#pragma unroll
    for (int j = 0; j < 4; ++j) { v[j] = v[j] - mean; s2 += (v[j].x * v[j].x + v[j].y * v[j].y) + (v[j].z * v[j].z + v[j].w * v[j].w); }
    const float rstd = 1.f / sqrtf(wave_sum(s2) * (1.f / 1024.f) + LN_EPS_);
#pragma unroll
    for (int j = 0; j < 4; ++j) { const f32x4 gg = *(const f32x4*)(g + 256 * j + 4 * lane), bv = *(const f32x4*)(b + 256 * j + 4 * lane);
        const f32x4 o = v[j] * rstd * gg + bv; *(f32x4*)(dst + 256 * j + 4 * lane) = o;
        if (dstb) { u32x2 w; w.x = pk2(o.x, o.y); w.y = pk2(o.z, o.w); *(u32x2*)(dstb + 256 * j + 4 * lane) = w; } }
}

template <int NR, bool SB = false>
__device__ __forceinline__ void ln_rows(const void* srcv, const float* g, const float* b, float* dst, bf16_t* dstb, unsigned char* d8, int lane) {
    f32x4 v[NR][4]; float s[NR], s2[NR];
#pragma unroll
    for (int r = 0; r < NR; ++r) { s[r] = 0.f;
#pragma unroll
        for (int j = 0; j < 4; ++j) {
            if (SB) { const u32x2 w = *(const u32x2*)((const bf16_t*)srcv + (size_t)r * 1024 + 256 * j + 4 * lane); v[r][j] = (f32x4){bflo(w.x), bfhi(w.x), bflo(w.y), bfhi(w.y)}; }
            else v[r][j] = *(const f32x4*)((const float*)srcv + (size_t)r * 1024 + 256 * j + 4 * lane);
            s[r] += (v[r][j].x + v[r][j].y) + (v[r][j].z + v[r][j].w); } }
    wave_sum_n<NR>(s);
#pragma unroll
    for (int r = 0; r < NR; ++r) { const float mean = s[r] * (1.f / 1024.f); s2[r] = 0.f;
#pragma unroll
        for (int j = 0; j < 4; ++j) { v[r][j] = v[r][j] - mean; s2[r] += (v[r][j].x * v[r][j].x + v[r][j].y * v[r][j].y) + (v[r][j].z * v[r][j].z + v[r][j].w * v[r][j].w); } }
    wave_sum_n<NR>(s2);
#pragma unroll
    for (int j = 0; j < 4; ++j) { const f32x4 gg = *(const f32x4*)(g + 256 * j + 4 * lane), bv = *(const f32x4*)(b + 256 * j + 4 * lane);
#pragma unroll
        for (int r = 0; r < NR; ++r) { const float rstd = 1.f / sqrtf(s2[r] * (1.f / 1024.f) + LN_EPS_);
            const f32x4 o = v[r][j] * rstd * gg + bv; if (dst) *(f32x4*)(dst + (size_t)r * 1024 + 256 * j + 4 * lane) = o;
            if (dstb) { u32x2 w; w.x = pk2(o.x, o.y); w.y = pk2(o.z, o.w); *(u32x2*)(dstb + (size_t)r * 1024 + 256 * j + 4 * lane) = w; }
            if (d8) { unsigned w8 = cvt_pk_fp8_f32_(o.x, o.y, 0u, false); w8 = cvt_pk_fp8_f32_(o.z, o.w, w8, true); *(unsigned*)(d8 + (size_t)r * 1024 + 256 * j + 4 * lane) = w8; } } }
}
__device__ __forceinline__ void phase_prologue(const KP& p, unsigned char* lds) {
    const int tid = TIDX(), lane = tid & 63, wave = tid >> 6;
    int G = GDIM(), bid = BIDX();
    for (int it = bid; it < L_ * 16; it += G) s5_tables(p, it >> 4, it & 15, lds);
    if (G >= 4 * L_ * 16) { if (bid < L_ * 16) return; bid -= L_ * 16; G -= L_ * 16; }
    float* scr = (float*)lds + wave * (64 * 33 + 16);
    const int gw = bid * NWAVE + wave, NGW = G * NWAVE;
    constexpr int I_WINT = (WIN_ROWS / 32) * 16, I_BR = 4 * 4 * 32, I_OUT = 16 * 32, I_Q = 16 * 64, I_PL = 4 * 32, I_PG = 16 * 32, I_GL = 4 * 8;
    constexpr int PER_L = I_WINT + I_BR + I_OUT + I_Q + I_PL + I_PG + I_GL;
    for (int it = gw; it < L_ * PER_L; it += NGW) {
        const int l = it / PER_L; int r = it % PER_L; const Ptrs P = make_ptrs(p.ws, l);
        if (r < I_WINT) { transpose_item<true>(p.in[I_WIN] + (size_t)l * 1024 * IN_COLS, IN_COLS, P.WinT, 1024, 0, r & 15, r >> 4, scr, lane); continue; } r -= I_WINT;
        if (r < I_BR) { const int b = r >> 7, rr = r & 127; transpose_item<false>(p.in[I_WBR] + ((size_t)l * 4 + b) * 256 * 1024, 1024, P.WbrT, 1024, 256 * b, rr & 3, rr >> 2, scr, lane); continue; } r -= I_BR;
        if (r < I_OUT) { transpose_item<false>(p.in[I_WOUT] + (size_t)l * 1024 * 1024, 1024, P.WoutT, 1024, 0, r & 15, r >> 4, scr, lane); continue; } r -= I_OUT;
        if (r < I_Q) { transpose_item<false>(p.in[I_WQ] + (size_t)l * 1024 * 2048, 2048, P.WqT, 1024, 0, r & 15, r >> 4, scr, lane); continue; } r -= I_Q;
        if (r < I_PL) { transpose_item<false>(p.in[I_PLEW] + (size_t)l * 256 * 1024, 1024, P.PleT, 256, 0, r & 3, r >> 2, scr, lane); continue; } r -= I_PL;
        if (r < I_PG) { transpose_item<false>(p.in[I_PLEG] + (size_t)l * 1024 * 1024, 1024, P.PleGT, 1024, 0, r & 15, r >> 4, scr, lane); continue; } r -= I_PG;
        transpose_item<false>(p.in[I_GLUW] + (size_t)l * 256 * 256, 256, P.GluT, 256, 0, r & 3, r >> 2, scr, lane);
    }
    const size_t gt = (size_t)bid * NTHR + tid, NGT = (size_t)G * NTHR;
    { bf16_t* K12 = (bf16_t*)(p.ws + WS_K12);
      for (size_t i = gt; i < (size_t)L_ * 2 * 16384 / 8; i += NGT) { const size_t e = i * 8; const int l = (int)(e / 32768), r = (int)(e % 32768); const float* s = (r < 16384 ? p.in[I_K1] : p.in[I_K2]) + (size_t)l * 16384 + (r & 16383);
        const f32x4 a = *(const f32x4*)s, b = *(const f32x4*)(s + 4); u32x4 o; o.x = pk2(a.x, a.y); o.y = pk2(a.z, a.w); o.z = pk2(b.x, b.y); o.w = pk2(b.z, b.w); *(u32x4*)(K12 + e) = o; } }
    { bf16_t* hb = (bf16_t*)(p.ws + WS_HB);
      unsigned char* h8a = p.ws + WS_R1 + R1_H8; unsigned char* h8b = p.ws + WS_H8T;
      for (int m = 4 * gw; m < T_; m += 4 * NGW) ln_rows<4>(p.in[I_X] + (size_t)m * 1024, p.in[I_LNIN_G], p.in[I_LNIN_B], (float*)nullptr, hb + (size_t)m * 1024, m < H8_SPLIT ? h8a + (size_t)m * 1024 : h8b + (size_t)(m - H8_SPLIT) * 1024, lane); }
}
__device__ __forceinline__ void conv_unit(const KP& p, const Ptrs& P, int l, int unit, unsigned char* lds) {
    bf16_t* hbuf = (bf16_t*)lds;
    float* obuf = (float*)(lds + 94 * 256 * 2);
    const int tid = TIDX(), lane = tid & 63, wave = tid >> 6;
    const int tiles_per_seq = S_ / 64, b = unit / tiles_per_seq, t0 = (unit % tiles_per_seq) * 64;
    for (int e = tid; e < 94 * 32; e += NTHR) { const int r = e >> 5, c8 = (e & 31) * 8; const int t = t0 - 30 + r;
        u32x4 o = (u32x4){0u, 0u, 0u, 0u};
        if (t >= 0) { const bf16_t* row = P.proj + (size_t)(b * S_ + t) * PJ; const u32x4 v = *(const u32x4*)(row + C_CV + c8), g = *(const u32x4*)(row + C_CG + c8);
            o.x = pk2(bflo(v.x) * sigmoidf_(bflo(g.x)), bfhi(v.x) * sigmoidf_(bfhi(g.x))); o.y = pk2(bflo(v.y) * sigmoidf_(bflo(g.y)), bfhi(v.y) * sigmoidf_(bfhi(g.y)));
            o.z = pk2(bflo(v.z) * sigmoidf_(bflo(g.z)), bfhi(v.z) * sigmoidf_(bfhi(g.z))); o.w = pk2(bflo(v.w) * sigmoidf_(bflo(g.w)), bfhi(v.w) * sigmoidf_(bfhi(g.w))); }
        *(u32x4*)(hbuf + r * 256 + c8) = o; }
    __syncthreads();
    { const int c = tid & 255, half = tid >> 8; float w[31], x[62];
#pragma unroll
      for (int j = 0; j < 31; ++j) w[j] = p.in[I_CONVW][(l * 31 + j) * 256 + c];
      const float cb = p.in[I_CONVB][l * 256 + c];
#pragma unroll
      for (int j = 0; j < 62; ++j) x[j] = bf2f(hbuf[(half * 32 + j) * 256 + c]);
#pragma unroll
      for (int tt = 0; tt < 32; ++tt) { float s = cb;
#pragma unroll
          for (int j = 0; j < 31; ++j) s += w[j] * x[tt + j];
          obuf[(half * 32 + tt) * 256 + c] = s; } }
    __syncthreads();
    { const f32x4 g = *(const f32x4*)(p.in[I_CLNG] + l * 256 + 4 * lane), bb = *(const f32x4*)(p.in[I_CLNB] + l * 256 + 4 * lane);
      f32x4 vv[8]; float m1[8], m2[8];
#pragma unroll
      for (int i = 0; i < 8; ++i) { vv[i] = *(const f32x4*)(obuf + (wave * 8 + i) * 256 + 4 * lane); m1[i] = (vv[i].x + vv[i].y) + (vv[i].z + vv[i].w); }
      wave_sum_n<8>(m1);
#pragma unroll
      for (int i = 0; i < 8; ++i) { vv[i] = vv[i] - m1[i] * (1.f / 256.f); m2[i] = (vv[i].x * vv[i].x + vv[i].y * vv[i].y) + (vv[i].z * vv[i].z + vv[i].w * vv[i].w); }
      wave_sum_n<8>(m2);
#pragma unroll
      for (int i = 0; i < 8; ++i) { const int t = wave * 8 + i; const float rstd = 1.f / sqrtf(m2[i] * (1.f / 256.f) + LN_EPS_);
          f32x4 z = vv[i] * rstd * g + bb; u32x2 w; w.x = pk2(z.x * sigmoidf_(z.x), z.y * sigmoidf_(z.y)); w.y = pk2(z.z * sigmoidf_(z.z), z.w * sigmoidf_(z.w));
          *(u32x2*)(P.ycat + (size_t)(b * S_ + t0 + t) * 1024 + 768 + 4 * lane) = w; } }
    __syncthreads();
}

constexpr int S5_NCH = S_ / 64;
constexpr int S5_UPITCH = 1032;
constexpr int S5_XPITCH = 136;
__device__ __forceinline__ void s5_unit(const KP& p, const Ptrs& P, int l, int unit, unsigned char* lds) {
    const int b = unit >> 4, g = unit & 15;
    bf16_t* Uc = (bf16_t*)lds;
    bf16_t* Kc = (bf16_t*)(lds + 66048);
    float* Xe = (float*)(lds + 66048 + 32768);
    bf16_t* Xs = (bf16_t*)(lds + 66048 + 65536);
    const int tid = TIDX(), lane = tid & 63, wave = tid >> 6, r32 = lane & 31, hi = lane >> 5;
    { u32x4 v[8], kc[4];
#pragma unroll
      for (int j = 0; j < 8; ++j) { const int e = tid + j * NTHR, s = e >> 1, hf = e & 1; v[j] = (u32x4){0u, 0u, 0u, 0u};
          if (s < S_) v[j] = *(const u32x4*)(P.proj + (size_t)(b * S_ + s) * PJ + C_S5 + 16 * g + 8 * hf); }
#pragma unroll
      for (int j = 0; j < 4; ++j) kc[j] = *(const u32x4*)(P.S5Kc + (size_t)g * 16384 + (tid + j * NTHR) * 8);
#pragma unroll
      for (int j = 0; j < 8; ++j) { const int e = tid + j * NTHR, s = e >> 1, hf = e & 1; *(u32x4*)(Uc + (s >> 6) * S5_UPITCH + (s & 63) * 16 + 8 * hf) = v[j]; }
#pragma unroll
      for (int j = 0; j < 4; ++j) *(u32x4*)(Kc + (tid + j * NTHR) * 8) = kc[j]; }
    __syncthreads();
    { const int ntile = wave & 3, kh = wave >> 2; f32x16 acc = {};
      const bf16_t* wrow = P.S5Wx + ((size_t)g * 128 + ntile * 32 + r32) * 1024 + kh * 512 + 8 * hi;
      const bf16_t* urow = Uc + r32 * S5_UPITCH + kh * 512 + 8 * hi;
      for (int k8 = 0; k8 < 32; k8 += 8) { bf16x8 bw[8];
#pragma unroll
          for (int j = 0; j < 8; ++j) bw[j] = *(const bf16x8*)(wrow + (k8 + j) * 16);
#pragma unroll
          for (int j = 0; j < 8; ++j) { const bf16x8 a = *(const bf16x8*)(urow + (k8 + j) * 16); acc = MFMA32(a, bw[j], acc); } }
#pragma unroll
      for (int r = 0; r < 16; ++r) { const int c = (r & 3) + 8 * (r >> 2) + 4 * hi; Xe[(kh * 32 + c) * 128 + ntile * 32 + r32] = acc[r]; } }
    __syncthreads();
    if (tid < 64) { const float lr = P.S5LL[(g * 64 + tid) * 2], li = P.S5LL[(g * 64 + tid) * 2 + 1]; float xr = 0.f, xi = 0.f;
        for (int c = 0; c < 32; ++c) { Xs[c * S5_XPITCH + 2 * tid] = (bf16_t)f2bf(xr); Xs[c * S5_XPITCH + 2 * tid + 1] = (bf16_t)f2bf(xi);
            const float er = Xe[c * 128 + 2 * tid] + Xe[(32 + c) * 128 + 2 * tid], ei = Xe[c * 128 + 2 * tid + 1] + Xe[(32 + c) * 128 + 2 * tid + 1];
            const float nr = lr * xr - li * xi + er, ni = lr * xi + li * xr + ei; xr = nr; xi = ni; } }
    __syncthreads();
    { const int tt = r32 >> 4, co = r32 & 15; const float dsk = p.in[I_S5D][l * 256 + 16 * g + co];
      for (int q = 0; q < 4; ++q) { const int ntile = wave + 8 * q, t0 = 2 * ntile; f32x16 acc = {};
          const bf16_t* urow = Uc + r32 * S5_UPITCH + 8 * hi;
          for (int s = 0; s <= t0 + 1; ++s) { const int tau = t0 + tt - s; bf16x8 bk = (bf16x8){0, 0, 0, 0, 0, 0, 0, 0};
              if (tau >= 0) bk = *(const bf16x8*)(Kc + (tau * 16 + co) * 16 + 8 * hi);
              const bf16x8 a = *(const bf16x8*)(urow + s * 16); acc = MFMA32(a, bk, acc); }
          const bf16_t* wy = P.S5Wy + ((size_t)g * 1024 + ntile * 32 + r32) * 128 + 8 * hi; const bf16_t* xrow = Xs + r32 * S5_XPITCH + 8 * hi;
#pragma unroll
          for (int ks = 0; ks < 8; ++ks) { const bf16x8 a = *(const bf16x8*)(xrow + ks * 16); const bf16x8 bw = *(const bf16x8*)(wy + ks * 16); acc = MFMA32(a, bw, acc); }
#pragma unroll
          for (int r = 0; r < 16; ++r) { const int c = (r & 3) + 8 * (r >> 2) + 4 * hi; const int s = c * 64 + t0 + tt;
              if (s < S_) { const float uu = bf2f(Uc[c * S5_UPITCH + (t0 + tt) * 16 + co]); const float y = acc[r] + dsk * uu;
                  P.ycat[(size_t)(b * S_ + s) * 1024 + 256 + 16 * g + co] = (bf16_t)f2bf(gelu_erf(y)); } } } }
    __syncthreads();
}
constexpr float LOG2E_ = 1.4426950408889634f;
__device__ __forceinline__ float log_sigmoid_(float x) { return fminf(x, 0.f) - log1pf(__expf(-fabsf(x))); }
__device__ __forceinline__ void fox_unit(const KP& p, const Ptrs& P, int l, int unit, unsigned char* lds) {
    constexpr int NQB = S_ / 256;
    const int bh = unit / NQB, qb = (unit >= (NB_ * 4 * NQB) / 2) ? NQB - 1 - unit % NQB : unit % NQB, b = bh >> 2, h = bh & 3, q0 = qb * 256;
    float* cl = (float*)lds;
    unsigned char* Kt = lds + S_ * 4;
    unsigned char* Vt = Kt + 8192;
    float* wsf = (float*)(Kt + 32768);
    float* sc = wsf + 256;
    const int tid = TIDX(), lane = tid & 63, wave = tid >> 6, r32 = lane & 31, hi = lane >> 5;
    const int qend = q0 + 256;
    { constexpr int PER = (S_ + 511) / 512; const float bf = p.in[I_BF][l * 4 + h]; float loc[PER]; float s = 0.f;
#pragma unroll
      for (int i = 0; i < PER; ++i) { const int t = tid * PER + i; float v = 0.f;
          if (t < qend) v = log_sigmoid_(bf2f(P.proj[(size_t)(b * S_ + t) * PJ + C_FL + h]) + bf) * LOG2E_;
          s += v; loc[i] = s; }
      sc[tid] = s; __syncthreads();
      for (int off = 1; off < 512; off <<= 1) { const float v = sc[tid] + (tid >= off ? sc[tid - off] : 0.f); __syncthreads(); sc[tid] = v; __syncthreads(); }
      const float base = sc[tid] - s;
#pragma unroll
      for (int i = 0; i < PER; ++i) { const int t = tid * PER + i; if (t < S_) cl[t] = base + loc[i]; }
      __syncthreads(); }
    const int qrow = q0 + 32 * wave + r32;
    constexpr float C2 = 0.125f * LOG2E_;
    bf16x8 qr[4];
    { const bf16_t* qp = P.proj + (size_t)(b * S_ + qrow) * PJ + C_FQ + 64 * h + 8 * hi;
#pragma unroll
      for (int d0 = 0; d0 < 4; ++d0) { const u32x4 w = *(const u32x4*)(qp + 16 * d0);
          u32x4 o; o.x = pk2(bflo(w.x) * C2, bfhi(w.x) * C2); o.y = pk2(bflo(w.y) * C2, bfhi(w.y) * C2); o.z = pk2(bflo(w.z) * C2, bfhi(w.z) * C2); o.w = pk2(bflo(w.w) * C2, bfhi(w.w) * C2);
          qr[d0] = __builtin_bit_cast(bf16x8, o); } }
    const float clq = cl[qrow];
    float mrun = -INFINITY, lrun = 0.f; f32x16 o0 = {}, o1 = {};
    const int NT = qend / 64;
    const int srow = tid >> 3, sch = tid & 7;
    const bf16_t* kg = P.proj + (size_t)(b * S_ + srow) * PJ + C_FK + 64 * h + 8 * sch;
    const bf16_t* vg = P.vtr + (size_t)(64 * h + srow) * T_ + (size_t)b * S_ + 8 * sch;
    const int koff = srow * 128 + ((sch ^ ((srow >> 1) & 7)) * 16);
    const int voffa = srow * 128 + (((2 * sch) ^ ((srow >> 1) & 15)) * 8), voffb = srow * 128 + (((2 * sch + 1) ^ ((srow >> 1) & 15)) * 8);
    u32x4 kreg = *(const u32x4*)kg, vreg = *(const u32x4*)vg;
    *(u32x4*)(Kt + koff) = kreg; *(u32x2*)(Vt + voffa) = (u32x2){vreg.x, vreg.y}; *(u32x2*)(Vt + voffb) = (u32x2){vreg.z, vreg.w};
    if (NT > 1) { kreg = *(const u32x4*)(kg + (size_t)64 * PJ); vreg = *(const u32x4*)(vg + 64); }
    __syncthreads();
    for (int jt = 0; jt < NT; ++jt) {
        const int kv0 = jt * 64; const unsigned char* Kb = Kt + (jt & 1) * 16384; const unsigned char* Vb = Vt + (jt & 1) * 16384;
        if (kv0 <= q0 + 32 * wave + 31) {
            f32x16 pt[2];
#pragma unroll
            for (int kvt = 0; kvt < 2; ++kvt) { const int row = 32 * kvt + r32; f32x16 acc;
#pragma unroll
                for (int g4 = 0; g4 < 4; ++g4) { const f32x4 c4 = *(const f32x4*)(cl + kv0 + 32 * kvt + 8 * g4 + 4 * hi);
#pragma unroll
                    for (int e = 0; e < 4; ++e) acc[4 * g4 + e] = clq - c4[e]; }
#pragma unroll
                for (int d0 = 0; d0 < 4; ++d0) { const bf16x8 a = *(const bf16x8*)(Kb + row * 128 + (((2 * d0 + hi) ^ ((row >> 1) & 7)) * 16)); acc = MFMA32(a, qr[d0], acc); }
                pt[kvt] = acc; }
            if (kv0 + 63 > q0 + 32 * wave) {
#pragma unroll
                for (int kvt = 0; kvt < 2; ++kvt)
#pragma unroll
                    for (int r = 0; r < 16; ++r) { const int key = kv0 + 32 * kvt + (r & 3) + 8 * (r >> 2) + 4 * hi; if (key > qrow) pt[kvt][r] = -INFINITY; } }
            float mx = -INFINITY;
#pragma unroll
            for (int kvt = 0; kvt < 2; ++kvt)
#pragma unroll
                for (int r = 0; r < 16; ++r) mx = fmaxf(mx, pt[kvt][r]);
            mx = fmaxf(mx, __shfl_xor(mx, 32));
            const float mnew = fmaxf(mrun, mx), alpha = FAST_EXP2(mrun - mnew); mrun = mnew;
            float ls = 0.f;
#pragma unroll
            for (int kvt = 0; kvt < 2; ++kvt)
#pragma unroll
                for (int r = 0; r < 16; ++r) { const float e = FAST_EXP2(pt[kvt][r] - mnew); pt[kvt][r] = e; ls += e; }
            lrun = lrun * alpha + ls;
            float* wf = wsf + wave * 32;
            WAVE_SYNC(); if (hi == 0) wf[r32] = alpha; WAVE_SYNC();
#pragma unroll
            for (int g4 = 0; g4 < 4; ++g4) { const f32x4 f = *(const f32x4*)(wf + 8 * g4 + 4 * hi);
#pragma unroll
                for (int e = 0; e < 4; ++e) { o0[4 * g4 + e] *= f[e]; o1[4 * g4 + e] *= f[e]; } }
#pragma unroll
            for (int s = 0; s < 4; ++s) { const int kvt = s >> 1, rb = 8 * (s & 1);
                u32x4 pw; pw.x = pk2(pt[kvt][rb + 0], pt[kvt][rb + 1]); pw.y = pk2(pt[kvt][rb + 2], pt[kvt][rb + 3]); pw.z = pk2(pt[kvt][rb + 4], pt[kvt][rb + 5]); pw.w = pk2(pt[kvt][rb + 6], pt[kvt][rb + 7]);
                const bf16x8 pa = __builtin_bit_cast(bf16x8, pw);
#pragma unroll
                for (int dt = 0; dt < 2; ++dt) { const int d = 32 * dt + r32; const int sw = (d >> 1) & 15;
                    const u32x2 va = *(const u32x2*)(Vb + d * 128 + (((4 * s + hi) ^ sw) * 8)), vb = *(const u32x2*)(Vb + d * 128 + (((4 * s + 2 + hi) ^ sw) * 8));
                    const bf16x8 vf = __builtin_bit_cast(bf16x8, (u32x4){va.x, va.y, vb.x, vb.y});
                    if (dt == 0) o0 = MFMA32(pa, vf, o0); else o1 = MFMA32(pa, vf, o1); } }
        }
        if (jt + 1 < NT) { unsigned char* Kn = Kt + ((jt + 1) & 1) * 16384; unsigned char* Vn = Vt + ((jt + 1) & 1) * 16384;
            *(u32x4*)(Kn + koff) = kreg; *(u32x2*)(Vn + voffa) = (u32x2){vreg.x, vreg.y}; *(u32x2*)(Vn + voffb) = (u32x2){vreg.z, vreg.w};
            if (jt + 2 < NT) { kreg = *(const u32x4*)(kg + (size_t)(kv0 + 128) * PJ); vreg = *(const u32x4*)(vg + kv0 + 128); } }
        __syncthreads();
    }
    { const float lt = lrun + __shfl_xor(lrun, 32); float* wf = wsf + wave * 32;
      WAVE_SYNC(); if (hi == 0) wf[r32] = 1.0f / lt; WAVE_SYNC();
      bf16_t* orow = P.ycat + (size_t)(b * S_ + q0 + 32 * wave) * 1024 + 512 + 64 * h + r32;
#pragma unroll
      for (int r = 0; r < 16; ++r) { const int qq = (r & 3) + 8 * (r >> 2) + 4 * hi; const float f = wf[qq];
          orow[(size_t)qq * 1024] = (bf16_t)f2bf(o0[r] * f); orow[(size_t)qq * 1024 + 32] = (bf16_t)f2bf(o1[r] * f); } }
    __syncthreads();
}

constexpr int RW_NCH = S_ / 64;
constexpr int RWP = 72;
constexpr int RW_ARR = 64 * RWP * 2;
constexpr int RW_SCRP = 388;
__device__ __forceinline__ void rw_stage_weights(const KP& p, int l, int h, bf16_t* wb, int tid) {
    for (int e = tid; e < 2048; e += NTHR) { const int m = e >> 4, c4 = (e & 15) * 4;
        if (m < 32) { const f32x4 v = *(const f32x4*)(p.in[I_A2] + (l * 32 + m) * 256 + 64 * h + c4);
#pragma unroll
            for (int q = 0; q < 4; ++q) wb[(c4 + q) * 40 + m] = (bf16_t)f2bf(v[q]); }
        else if (m < 64) { const f32x4 v = *(const f32x4*)(p.in[I_W2] + (l * 32 + m - 32) * 256 + 64 * h + c4);
#pragma unroll
            for (int q = 0; q < 4; ++q) wb[2560 + (c4 + q) * 40 + (m - 32)] = (bf16_t)f2bf(v[q]); }
        else { const f32x4 v = *(const f32x4*)(p.in[I_G2] + (l * 64 + m - 64) * 256 + 64 * h + c4);
#pragma unroll
            for (int q = 0; q < 4; ++q) wb[5120 + (c4 + q) * 72 + (m - 64)] = (bf16_t)f2bf(v[q]); } }
    __syncthreads();
}
__device__ __forceinline__ bf16x8 rw_pack8(const float* q) { const f32x4 a = *(const f32x4*)q, b = *(const f32x4*)(q + 4);
    u32x4 w; w.x = pk2(a.x, a.y); w.y = pk2(a.z, a.w); w.z = pk2(b.x, b.y); w.w = pk2(b.z, b.w); return __builtin_bit_cast(bf16x8, w); }
template <int NT, bool NEED_W, bool NEED_G>
__device__ __forceinline__ void rw_prep(const KP& p, const Ptrs& P, int l, int b, int h, int tpos0, float* scr, const bf16_t* wb, int lane,
                                        float (&r)[NT], float (&lw)[NT], float (&k2)[NT], float (&v)[NT], float (&ain)[NT], float (&bin)[NT], float (&g)[NT], float (&rk)[NT]) {
    constexpr int NIT = (NT * 40 + 63) / 64;
    u32x4 cur[NIT], prv[NIT];
#pragma unroll
    for (int i = 0; i < NIT; ++i) { const int e = lane + 64 * i; const int tt = e / 40, ch = e % 40; const int t = tpos0 + tt;
        const int col = ch < 8 ? C_R + 64 * h + 8 * ch : ch < 16 ? C_K + 64 * h + 8 * (ch - 8) : ch < 24 ? C_V + 64 * h + 8 * (ch - 16) : C_HW + 8 * (ch - 24);
        cur[i] = (u32x4){0u, 0u, 0u, 0u}; prv[i] = (u32x4){0u, 0u, 0u, 0u};
        if (e < NT * 40) { const bf16_t* row = P.proj + (size_t)(b * S_ + t) * PJ + col; cur[i] = *(const u32x4*)row; if (t > 0) prv[i] = *(const u32x4*)(row - PJ); } }
#pragma unroll
    for (int i = 0; i < NIT; ++i) { const int e = lane + 64 * i; const int tt = e / 40, ch = e % 40;
        const int col = ch < 8 ? C_R + 64 * h + 8 * ch : ch < 16 ? C_K + 64 * h + 8 * (ch - 8) : ch < 24 ? C_V + 64 * h + 8 * (ch - 16) : C_HW + 8 * (ch - 24);
        const int idx = ch < 24 ? 8 * ch : 192 + 8 * (ch - 24);
        if (e < NT * 40) { const f32x4 m0 = *(const f32x4*)(p.in[I_MU] + l * 896 + col), m1 = *(const f32x4*)(p.in[I_MU] + l * 896 + col + 4);
            float z[8] = {bflo(cur[i].x), bfhi(cur[i].x), bflo(cur[i].y), bfhi(cur[i].y), bflo(cur[i].z), bfhi(cur[i].z), bflo(cur[i].w), bfhi(cur[i].w)};
            const float zp[8] = {bflo(prv[i].x), bfhi(prv[i].x), bflo(prv[i].y), bfhi(prv[i].y), bflo(prv[i].z), bfhi(prv[i].z), bflo(prv[i].w), bfhi(prv[i].w)};
#pragma unroll
            for (int q = 0; q < 8; ++q) { float zs = z[q] + (zp[q] - z[q]) * (q < 4 ? m0[q & 3] : m1[q & 3]);
                if (ch >= 24 && ch < 28) zs = 1.0f - 2.0f * FAST_RCP(1.0f + FAST_EXP2(zs * 2.8853900817779268f));
                else if (ch >= 32) zs = sigmoidf_(zs);
                z[q] = zs; }
            *(f32x4*)(scr + tt * RW_SCRP + idx) = (f32x4){z[0], z[1], z[2], z[3]}; *(f32x4*)(scr + tt * RW_SCRP + idx + 4) = (f32x4){z[4], z[5], z[6], z[7]}; } }
    WAVE_SYNC();
    { const int fr = lane & 15, fq = lane >> 4; const float* hrow = scr + (fr & 7) * RW_SCRP + 192 + 8 * fq;
      const bf16x8 fw = rw_pack8(hrow), fa = rw_pack8(hrow + 32), fg0 = rw_pack8(hrow + 64), fg1 = rw_pack8(hrow + 96);
      WAVE_SYNC();
#pragma unroll
      for (int nt = 0; nt < 4; ++nt) { const f32x4 z4 = (f32x4){0.f, 0.f, 0.f, 0.f};
          const f32x4 da = MFMA16(fa, *(const bf16x8*)(wb + (16 * nt + fr) * 40 + 8 * fq), z4);
          f32x4 dw = z4, dg = z4;
          if (NEED_W) dw = MFMA16(fw, *(const bf16x8*)(wb + 2560 + (16 * nt + fr) * 40 + 8 * fq), z4);
          if (NEED_G) { dg = MFMA16(fg0, *(const bf16x8*)(wb + 5120 + (16 * nt + fr) * 72 + 8 * fq), z4); dg = MFMA16(fg1, *(const bf16x8*)(wb + 5120 + (16 * nt + fr) * 72 + 32 + 8 * fq), dg); }
          if (fq < 2) {
#pragma unroll
              for (int q = 0; q < 4; ++q) { float* o = scr + (4 * fq + q) * RW_SCRP + 16 * nt + fr; o[192] = da[q]; if (NEED_W) o[256] = dw[q]; if (NEED_G) o[320] = dg[q]; } } }
      WAVE_SYNC(); }
    const int j = lane, cj = 64 * h + j; float wl[NT], al[NT], gg[NT];
    const float w0 = p.in[I_W0][l * 256 + cj], a0 = p.in[I_A0][l * 256 + cj];
#pragma unroll
    for (int tt = 0; tt < NT; ++tt) { al[tt] = a0 + scr[tt * RW_SCRP + 192 + j]; wl[tt] = NEED_W ? w0 + scr[tt * RW_SCRP + 256 + j] : w0; gg[tt] = NEED_G ? scr[tt * RW_SCRP + 320 + j] : 0.f; }
    const float kkw = p.in[I_KK][l * 256 + cj], kaw = p.in[I_KA][l * 256 + cj], rkw = p.in[I_RK][l * 256 + cj];
    float ssum[NT], rsum[NT], kkv[NT], av[NT];
#pragma unroll
    for (int tt = 0; tt < NT; ++tt) {
        const float a = sigmoidf_(al[tt]); av[tt] = a;
        const float rr = scr[tt * RW_SCRP + j], k = scr[tt * RW_SCRP + 64 + j], vv = scr[tt * RW_SCRP + 128 + j];
        const float kk2 = k * (1.f + (a - 1.f) * kaw);
        r[tt] = rr; k2[tt] = kk2; v[tt] = vv;
        const float kk = k * kkw; kkv[tt] = kk; ssum[tt] = kk * kk; rsum[tt] = rr * kk2 * rkw; }
    if (NEED_W) wave_sum_n<NT>(ssum);
    if (NEED_G) wave_sum_n<NT>(rsum);
#pragma unroll
    for (int tt = 0; tt < NT; ++tt) {
        if (NEED_W) { const float x = -wl[tt]; const float sp = fmaxf(x, 0.f) + 0.6931471805599453f * FAST_LOG2(1.0f + FAST_EXP2(-1.4426950408889634f * fabsf(x)));
            lw[tt] = -FAST_EXP2(-1.4426950408889634f * (sp + 0.5f));
            const float kkn = kkv[tt] * FAST_RSQ(fmaxf(ssum[tt], 1e-24f));
            ain[tt] = -kkn; bin[tt] = kkn * av[tt]; }
        if (NEED_G) { g[tt] = gg[tt]; rk[tt] = rsum[tt]; }
    }
    WAVE_SYNC();
}
__device__ __forceinline__ bf16x8 ldsb8(const bf16_t* p) { return *(const bf16x8*)p; }
__device__ __forceinline__ f32x16 rw_tile(const bf16_t* X, const bf16_t* Y, int tm, int tn, int r32, int hi, f32x16 acc) {
    const bf16_t* xa = X + (32 * tm + r32) * RWP + 8 * hi; const bf16_t* yb = Y + (32 * tn + r32) * RWP + 8 * hi;
#pragma unroll
    for (int ks = 0; ks < 4; ++ks) acc = MFMA32(ldsb8(xa + 16 * ks), ldsb8(yb + 16 * ks), acc);
    return acc;
}
template <int STOP = 0>
__device__ __forceinline__ void rw_chunk_unit(const KP& p, const Ptrs& P, int l, int unit, unsigned char* lds) {
    MEMFENCE(); OPAQUE_S(unit);
    const int c = unit % RW_NCH, bh = unit / RW_NCH, b = bh >> 2, h = bh & 3, t0 = c * 64;
    bf16_t* AT = (bf16_t*)(lds + 0 * RW_ARR); bf16_t* RT = (bf16_t*)(lds + 1 * RW_ARR); bf16_t* BT = (bf16_t*)(lds + 2 * RW_ARR); bf16_t* KT = (bf16_t*)(lds + 3 * RW_ARR);
    bf16_t* BH = (bf16_t*)(lds + 4 * RW_ARR); bf16_t* KH = (bf16_t*)(lds + 5 * RW_ARR); bf16_t* VT = (bf16_t*)(lds + 6 * RW_ARR);
    bf16_t* AAK = (bf16_t*)(lds + 7 * RW_ARR); bf16_t* ARB = (bf16_t*)(lds + 8 * RW_ARR); bf16_t* ARK = (bf16_t*)(lds + 9 * RW_ARR);
    bf16_t* W1T = (bf16_t*)(lds + 10 * RW_ARR); bf16_t* UVT = (bf16_t*)(lds + 11 * RW_ARR);
    bf16_t* RHT = (bf16_t*)(lds + 12 * RW_ARR);
    float* ADG = (float*)(lds + 14 * RW_ARR);
    bf16_t* ABA = (bf16_t*)(lds + 14 * RW_ARR + 8192);
    float* WT = (float*)(lds + 14 * RW_ARR + 8192 + 32 * RWP * 2);
    float* GC = WT + 512;
    bf16_t* DAB = AT;
    const int tid = TIDX(), lane = tid & 63, wave = tid >> 6, r32 = lane & 31, hi = lane >> 5;
    float r[8], lw[8], k2[8], v[8], ain[8], bin[8], gg[8], rk[8];
    rw_stage_weights(p, l, h, (bf16_t*)(lds + 8 * 8 * RW_SCRP * 4), tid);
    rw_prep<8, true, true>(p, P, l, b, h, t0 + 8 * wave, (float*)lds + wave * (8 * RW_SCRP), (const bf16_t*)(lds + 8 * 8 * RW_SCRP * 4), lane, r, lw, k2, v, ain, bin, gg, rk);
#pragma unroll
    for (int i = 0; i < 8; ++i) { const size_t o = (size_t)(b * S_ + t0 + 8 * wave + i) * 256 + 64 * h + lane; P.rwGt[o] = (bf16_t)f2bf(gg[i]); P.rwRKV[o] = (bf16_t)f2bf(rk[i] * v[i]); }
    float Lloc[8]; { float s = 0.f;
#pragma unroll
      for (int i = 0; i < 8; ++i) { s += lw[i]; Lloc[i] = s; } }
    __syncthreads();
    if (STOP == 1) return;
    WT[wave * 64 + lane] = Lloc[7];
    __syncthreads();
    { float off = 0.f, tot = 0.f;
#pragma unroll
      for (int w = 0; w < 8; ++w) { const float x = WT[w * 64 + lane]; tot += x; if (w < wave) off += x; }
      if (wave == 0) GC[lane] = __expf(tot);
      unsigned bhp[4], khp[4], vtp[4], atp[4]; float pb = 0.f, pk = 0.f, pv = 0.f, pa = 0.f;
#pragma unroll
      for (int i = 0; i < 8; ++i) { const int t = 8 * wave + i; const float Lt = off + Lloc[i], Lp = Lt - lw[i];
          const float eL = __expf(Lt), eLp = __expf(Lp), einv = __expf(-Lt), eh = __expf(tot - Lt);
          const float xa = ain[i] * eLp;
          AT[t * RWP + lane] = (bf16_t)f2bf(xa); RT[t * RWP + lane] = (bf16_t)f2bf(r[i] * eL);
          BT[t * RWP + lane] = (bf16_t)f2bf(bin[i] * einv); KT[t * RWP + lane] = (bf16_t)f2bf(k2[i] * einv);
          const float xb = bin[i] * eh, xk = k2[i] * eh, xv = v[i];
          if (i & 1) { bhp[i >> 1] = pk2(pb, xb); khp[i >> 1] = pk2(pk, xk); vtp[i >> 1] = pk2(pv, xv); atp[i >> 1] = pk2(pa, xa); } else { pb = xb; pk = xk; pv = xv; pa = xa; } }
      *(u32x4*)(BH + lane * RWP + 8 * wave) = (u32x4){bhp[0], bhp[1], bhp[2], bhp[3]};
      *(u32x4*)(KH + lane * RWP + 8 * wave) = (u32x4){khp[0], khp[1], khp[2], khp[3]};
      *(u32x4*)(VT + lane * RWP + 8 * wave) = (u32x4){vtp[0], vtp[1], vtp[2], vtp[3]};
      *(u32x4*)(RHT + (64 + lane) * RWP + 8 * wave) = (u32x4){atp[0], atp[1], atp[2], atp[3]}; }
    __syncthreads();
#pragma unroll
    for (int jj = 0; jj < 2; ++jj) { const int job = wave + 8 * jj, mat = job >> 2, tm = (job >> 1) & 1, tn = job & 1;
        f32x16 acc = {};
        if (!(tm == 0 && tn == 1)) acc = rw_tile((mat & 2) ? RT : AT, (mat & 1) ? KT : BT, tm, tn, r32, hi, acc);
        const int s = 32 * tn + r32;
#pragma unroll
        for (int q = 0; q < 16; ++q) { const int t = 32 * tm + (q & 3) + 8 * (q >> 2) + 4 * hi;
            const bool keep = (mat & 2) ? (s <= t) : (s < t); const float x = keep ? acc[q] : 0.f;
            if (mat == 0) { if (tm == tn) ADG[(tm * 32 + (t & 31)) * 32 + (s & 31)] = x; else if (tm == 1) ABA[(t & 31) * RWP + s] = (bf16_t)f2bf(x); } else { bf16_t* D = (mat == 1) ? AAK : (mat == 2) ? ARB : ARK; D[t * RWP + s] = (bf16_t)f2bf(x); } } }
    __syncthreads();
    if (STOP == 2) return;
    if (wave < 4) { const int tm = wave >> 1, tn = wave & 1; f32x16 acc = {}; acc = rw_tile(VT, AAK, tm, tn, r32, hi, acc);
#pragma unroll
        for (int q = 0; q < 16; ++q) { const int i = 32 * tm + (q & 3) + 8 * (q >> 2) + 4 * hi; RHT[i * RWP + 32 * tn + r32] = (bf16_t)f2bf(acc[q]); } }
    else if (wave == 4) { float d[32]; const LAS float* ab = (const LAS float*)ADG + hi * 1024;
#pragma unroll
        for (int t = 0; t < 32; ++t) d[t] = (t == r32) ? 1.f : 0.f;
#pragma unroll
        for (int t = 1; t < 32; ++t) { float s0 = 0.f, s1 = 0.f;
#pragma unroll
            for (int s4 = 0; s4 < (t + 3) / 4; ++s4) { const f32x4 a4 = *(const LAS f32x4*)(ab + t * 32 + 4 * s4);
                s0 += a4[0] * d[4 * s4]; s1 += a4[1] * d[4 * s4 + 1]; s0 += a4[2] * d[4 * s4 + 2]; s1 += a4[3] * d[4 * s4 + 3]; }
            d[t] += s0 + s1; if ((t & 3) == 3) MEMFENCE(); }
        LAS bf16_t* D = (LAS bf16_t*)DAB + hi * 32 * RWP + r32;
#pragma unroll
        for (int t = 0; t < 32; ++t) D[t * RWP] = (bf16_t)f2bf(d[t]); }
    __syncthreads();
    if (wave < 4) { bf16_t* XT = (wave < 2 ? UVT : W1T) + (32 * (wave & 1)) * RWP;
        const bf16_t* rh = RHT + (32 * wave + r32) * RWP + 8 * hi;
        { f32x16 acc = {}; const bf16_t* da = DAB + r32 * RWP + 8 * hi;
#pragma unroll
          for (int ks = 0; ks < 2; ++ks) acc = MFMA32(ldsb8(rh + 16 * ks), ldsb8(da + 16 * ks), acc);
#pragma unroll
          for (int q = 0; q < 16; ++q) XT[((q & 3) + 8 * (q >> 2) + 4 * hi) * RWP + r32] = (bf16_t)f2bf(acc[q]); }
        WAVE_SYNC();
        { f32x16 acc; const bf16_t* rz = RHT + (32 * wave) * RWP + 32 + r32;
#pragma unroll
          for (int q = 0; q < 16; ++q) acc[q] = bf2f(rz[((q & 3) + 8 * (q >> 2) + 4 * hi) * RWP]);
          const bf16_t* xa = XT + r32 * RWP + 8 * hi; const bf16_t* ba = ABA + r32 * RWP + 8 * hi;
#pragma unroll
          for (int ks = 0; ks < 2; ++ks) acc = MFMA32(ldsb8(xa + 16 * ks), ldsb8(ba + 16 * ks), acc);
#pragma unroll
          for (int q = 0; q < 16; ++q) XT[((q & 3) + 8 * (q >> 2) + 4 * hi) * RWP + 32 + r32] = (bf16_t)f2bf(acc[q]); }
        WAVE_SYNC();
        { f32x16 acc = {}; const bf16_t* xz = XT + r32 * RWP + 32 + 8 * hi; const bf16_t* db = DAB + (32 + r32) * RWP + 8 * hi;
          const bf16x8 z0 = ldsb8(xz), z1 = ldsb8(xz + 16);
          acc = MFMA32(z0, ldsb8(db), acc); acc = MFMA32(z1, ldsb8(db + 16), acc);
          WAVE_SYNC();
#pragma unroll
          for (int q = 0; q < 16; ++q) XT[((q & 3) + 8 * (q >> 2) + 4 * hi) * RWP + 32 + r32] = (bf16_t)f2bf(acc[q]); } }
    __syncthreads();
    if (STOP == 3) return;
    const size_t chunk = (size_t)unit;
#pragma unroll
    for (int jj = 0; jj < 2; ++jj) { const int job = wave + 8 * jj, kind = job >> 2, tm = (job >> 1) & 1, tn = job & 1; f32x16 acc = {};
        const int col = 32 * tn + r32;
        if (kind == 0) { acc = rw_tile(BH, W1T, tm, tn, r32, hi, acc);
            bf16_t* PT = P.rwPT + chunk * 4096;
#pragma unroll
            for (int q = 0; q < 16; ++q) { const int row = 32 * tm + (q & 3) + 8 * (q >> 2) + 4 * hi; const float x = acc[q] + (row == col ? GC[row] : 0.f); PT[row * 64 + col] = (bf16_t)f2bf(x); } }
        else if (kind == 1) { acc = rw_tile(ARB, W1T, tm, tn, r32, hi, acc);
#pragma unroll
            for (int q = 0; q < 16; ++q) { const int t = 32 * tm + (q & 3) + 8 * (q >> 2) + 4 * hi; const float x = acc[q] + bf2f(RT[t * RWP + col]);
                P.rwQ[(size_t)(b * S_ + t0 + t) * 256 + 64 * h + col] = (bf16_t)f2bf(x); } }
        else if (kind == 2) { acc = rw_tile(UVT, BH, tm, tn, r32, hi, acc); acc = rw_tile(VT, KH, tm, tn, r32, hi, acc);
            unsigned* Gg = (unsigned*)(P.rwG + chunk * 4096) + (tm * 2 + tn) * 8 * 64 + lane;
#pragma unroll
            for (int q = 0; q < 8; ++q) Gg[q * 64] = pk2(acc[2 * q], acc[2 * q + 1]); }
        else { acc = rw_tile(ARB, UVT, tm, tn, r32, hi, acc); acc = rw_tile(ARK, VT, tm, tn, r32, hi, acc);
#pragma unroll
            for (int q = 0; q < 16; ++q) { const int t = 32 * tm + (q & 3) + 8 * (q >> 2) + 4 * hi; P.ycat[(size_t)(b * S_ + t0 + t) * 1024 + 64 * h + col] = (bf16_t)f2bf(acc[q]); } } }
    __syncthreads();
}
__device__ __forceinline__ void rw_state_unit(const KP& p, const Ptrs& P, int l, int unit, unsigned char* lds) {
    bf16_t* Sb = (bf16_t*)lds;
    const int tid = TIDX(), lane = tid & 63, wave = tid >> 6, r32 = lane & 31, hi = lane >> 5;
    const int ti = (wave >> 1) & 1, tj = wave & 1;
    f32x16 S = {};
    unsigned gq[8]; bf16x8 pq[4];
    if (wave < 4) { const size_t chunk = (size_t)unit * RW_NCH; const unsigned* Gg = (const unsigned*)(P.rwG + chunk * 4096) + (ti * 2 + tj) * 8 * 64 + lane;
#pragma unroll
        for (int q = 0; q < 8; ++q) gq[q] = Gg[q * 64];
        const bf16_t* pt = P.rwPT + chunk * 4096 + (32 * tj + r32) * 64 + 8 * hi;
#pragma unroll
        for (int ks = 0; ks < 4; ++ks) pq[ks] = *(const bf16x8*)(pt + 16 * ks); }
    for (int c = 0; c < RW_NCH; ++c) { const size_t chunk = (size_t)unit * RW_NCH + c;
        unsigned gn[8]; bf16x8 pn[4];
        if (wave < 4) { const size_t cn = chunk + (c + 1 < RW_NCH ? 1 : 0); const unsigned* Gg = (const unsigned*)(P.rwG + cn * 4096) + (ti * 2 + tj) * 8 * 64 + lane;
#pragma unroll
            for (int q = 0; q < 8; ++q) gn[q] = Gg[q * 64];
            const bf16_t* pt = P.rwPT + cn * 4096 + (32 * tj + r32) * 64 + 8 * hi;
#pragma unroll
            for (int ks = 0; ks < 4; ++ks) pn[ks] = *(const bf16x8*)(pt + 16 * ks);
#pragma unroll
            for (int q = 0; q < 16; ++q) Sb[(32 * ti + (q & 3) + 8 * (q >> 2) + 4 * hi) * RWP + 32 * tj + r32] = (bf16_t)f2bf(S[q]); }
        __syncthreads();
        { const int row = tid >> 3, ch = tid & 7; *(u32x4*)(P.rwS0 + chunk * 4096 + row * 64 + ch * 8) = *(const u32x4*)(Sb + row * RWP + ch * 8); }
        if (wave < 4) { f32x16 acc;
#pragma unroll
            for (int q = 0; q < 8; ++q) { acc[2 * q] = bflo(gq[q]); acc[2 * q + 1] = bfhi(gq[q]); }
            const bf16_t* sa = Sb + (32 * ti + r32) * RWP + 8 * hi;
#pragma unroll
            for (int ks = 0; ks < 4; ++ks) acc = MFMA32(ldsb8(sa + 16 * ks), pq[ks], acc);
            S = acc;
#pragma unroll
            for (int q = 0; q < 8; ++q) gq[q] = gn[q];
#pragma unroll
            for (int ks = 0; ks < 4; ++ks) pq[ks] = pn[ks]; }
        __syncthreads();
    }
}
template <bool DUMMY = false>
__device__ __forceinline__ void rw_out_unit(const KP& p, const Ptrs& P, int l, int unit, unsigned char* lds) {
    MEMFENCE(); OPAQUE_S(unit);
    const int c = unit % RW_NCH, bh = unit / RW_NCH, b = bh >> 2, h = bh & 3, t0 = c * 64;
    float* Yb = (float*)(lds + 81920);
    const int tid = TIDX(), lane = tid & 63, wave = tid >> 6, r32 = lane & 31, hi = lane >> 5;
    float g[8], rkv[8];
#pragma unroll
    for (int i = 0; i < 8; ++i) { const size_t o = (size_t)(b * S_ + t0 + 8 * wave + i) * 256 + 64 * h + lane; g[i] = bf2f(P.rwGt[o]); rkv[i] = bf2f(P.rwRKV[o]); }
    if (wave < 4) { const int tm = wave >> 1, tn = wave & 1; f32x16 acc; const int col = 32 * tn + r32;
        const bf16_t* yl = P.ycat + (size_t)(b * S_ + t0 + 32 * tm) * 1024 + 64 * h + col;
#pragma unroll
        for (int q = 0; q < 16; ++q) acc[q] = bf2f(yl[(size_t)((q & 3) + 8 * (q >> 2) + 4 * hi) * 1024]);
        const bf16_t* qa = P.rwQ + (size_t)(b * S_ + t0 + 32 * tm + r32) * 256 + 64 * h + 8 * hi; const bf16_t* sb = P.rwS0 + (size_t)unit * 4096 + (32 * tn + r32) * 64 + 8 * hi;
#pragma unroll
        for (int ks = 0; ks < 4; ++ks) acc = MFMA32(*(const bf16x8*)(qa + 16 * ks), *(const bf16x8*)(sb + 16 * ks), acc);
#pragma unroll
        for (int q = 0; q < 16; ++q) Yb[(32 * tm + (q & 3) + 8 * (q >> 2) + 4 * hi) * 64 + col] = acc[q]; }
    __syncthreads();
    const float gng = p.in[I_LNXG][l * 256 + 64 * h + lane], gnb = p.in[I_LNXB][l * 256 + 64 * h + lane];
    { float yv[8], m1[8], m2[8];
#pragma unroll
      for (int i = 0; i < 8; ++i) { yv[i] = Yb[(8 * wave + i) * 64 + lane]; m1[i] = yv[i]; }
      wave_sum_n<8>(m1);
#pragma unroll
      for (int i = 0; i < 8; ++i) { yv[i] -= m1[i] * (1.f / 64.f); m2[i] = yv[i] * yv[i]; }
      wave_sum_n<8>(m2);
#pragma unroll
      for (int i = 0; i < 8; ++i) { const int t = 8 * wave + i; const float yn = yv[i] * (1.0f / sqrtf(m2[i] * (1.f / 64.f) + GN_EPS_)) * gng + gnb; const float o = (yn + rkv[i]) * g[i];
        if (DUMMY) P.pb[(size_t)(b * S_ + t0 + t) * 256 + 64 * h + lane] = (bf16_t)f2bf(o);
        else P.ycat[(size_t)(b * S_ + t0 + t) * 1024 + 64 * h + lane] = (bf16_t)f2bf(o); } }
    __syncthreads();
}
#ifdef EMU_FP8_A
#define EMU_AUX77 u.aux = 77;
#else
#define EMU_AUX77
#endif
__device__ __forceinline__ void tile_map(int L, int nM, int nN, int& pm, int& pn) {
    const int nwg = nM * nN, q = nwg / 8, r = nwg % 8, xcd = L % 8, off = L / 8;
    const int wgid = (xcd < r ? xcd * (q + 1) : r * (q + 1) + (xcd - r) * q) + off;
    const int nig = 8 * nN, gid = wgid / nig, fm = gid * 8, gsz = (nM - fm) < 8 ? (nM - fm) : 8;
    pm = fm + ((wgid % nig) % gsz); pn = (wgid % nig) / gsz;
}
struct EpiStoreBf16 {
    bf16_t* base0; int ldc0; bf16_t* base1; int ldc1;
    __device__ __forceinline__ void operator()(const f32x4 (&acc)[2][2][4][2], const pg8::Unit& u, int wr, int wc, int fr, int fq, int tid) const {
        bf16_t* base = u.kind ? base1 : base0; const int ldc = u.kind ? ldc1 : ldc0;
        int row0 = u.pm * 256 + wr * 64 + fr, col0 = u.pn * 256 + wc * 32 + 8 * fq; OPAQUE(row0); OPAQUE(col0);
#pragma unroll
        for (int ai = 0; ai < 2; ++ai)
#pragma unroll
            for (int m = 0; m < 4; ++m) { bf16_t* rowp = base + (size_t)(row0 + ai * 128 + m * 16) * ldc + col0;
#pragma unroll
                for (int bj = 0; bj < 2; ++bj) { const f32x4 v0 = acc[ai][bj][m][0], v1 = acc[ai][bj][m][1];
                    u32x4 w; w.x = pk2(v0[0], v0[1]); w.y = pk2(v0[2], v0[3]); w.z = pk2(v1[0], v1[1]); w.w = pk2(v1[2], v1[3]);
                    *(u32x4*)(rowp + bj * 128) = w; } }
    }
};
template <int PART>
struct SchedA { const bf16_t* hb; const unsigned char* h8a; const unsigned char* h8b; const bf16_t* WinT; int G, c;
    __device__ __forceinline__ bool next(int i, pg8::Unit& u) const {
        const int nM = T_ / 256, n0 = nM * 9; u.aux = 0;
        if (PART == 0) { const int x = i * G + c; if (x >= n0) return false;
            tile_map(x, nM, 9, u.pm, u.pn); u.kind = 0; u.nt = 8; u.f8 = 1; const int m0 = u.pm * 256;
            u.a = (const char*)(m0 < H8_SPLIT ? h8a + (size_t)m0 * 1024 : h8b + (size_t)(m0 - H8_SPLIT) * 1024); u.b = (const char*)(WinT + (size_t)u.pn * 256 * 1024); }
        else { const int x = i * G + (c + G - n0 % G) % G; if (x >= nM) return false;
            u.pm = 0; u.pn = x; u.kind = 1; u.nt = 8; u.f8 = 1; const int m0 = x * 256;
            u.a = (const char*)(WinT + (size_t)WIN_VT * 1024); u.b = (const char*)(m0 < H8_SPLIT ? h8a + (size_t)m0 * 1024 : h8b + (size_t)(m0 - H8_SPLIT) * 1024); }
        return true; } };
struct EpiA { bf16_t* proj; const float* sc;
    __device__ __forceinline__ void operator()(const f32x4 (&acc)[2][2][4][2], const pg8::Unit& u, int wr, int wc, int fr, int fq, int tid) const {
        int row0 = u.pm * 256 + wr * 64 + fr, col0 = u.pn * 256 + wc * 32 + 8 * fq; OPAQUE(row0); OPAQUE(col0);
#pragma unroll
        for (int bj = 0; bj < 2; ++bj) { const f32x4 s0 = *(const f32x4*)(sc + col0 + bj * 128), s1 = *(const f32x4*)(sc + col0 + bj * 128 + 4);
#pragma unroll
            for (int ai = 0; ai < 2; ++ai)
#pragma unroll
                for (int m = 0; m < 4; ++m) { const f32x4 v0 = acc[ai][bj][m][0] * s0, v1 = acc[ai][bj][m][1] * s1;
                    u32x4 w; w.x = pk2(v0[0], v0[1]); w.y = pk2(v0[2], v0[3]); w.z = pk2(v1[0], v1[1]); w.w = pk2(v1[2], v1[3]);
                    *(u32x4*)(proj + (size_t)(row0 + ai * 128 + m * 16) * PJ + col0 + bj * 128) = w; } }
    }
};
struct EpiVt { bf16_t* vtr; const float* sc;
    __device__ __forceinline__ void operator()(const f32x4 (&acc)[2][2][4][2], const pg8::Unit& u, int wr, int wc, int fr, int fq, int tid) const {
        int row0 = wr * 64 + fr, col0 = u.pn * 256 + wc * 32 + 8 * fq; OPAQUE(row0); OPAQUE(col0);
#pragma unroll
        for (int ai = 0; ai < 2; ++ai)
#pragma unroll
            for (int m = 0; m < 4; ++m) { const int row = row0 + ai * 128 + m * 16; const float s = sc[row];
#pragma unroll
                for (int bj = 0; bj < 2; ++bj) { const f32x4 v0 = acc[ai][bj][m][0] * s, v1 = acc[ai][bj][m][1] * s;
                    u32x4 w; w.x = pk2(v0[0], v0[1]); w.y = pk2(v0[2], v0[3]); w.z = pk2(v1[0], v1[1]); w.w = pk2(v1[2], v1[3]);
                    *(u32x4*)(vtr + (size_t)row * T_ + col0 + bj * 128) = w; } }
    }
};
__device__ __forceinline__ void phase_A0(const KP& p, unsigned char* lds) {
    const int tid = TIDX(), lane = tid & 63, wave = tid >> 6; const int gw = BIDX() * NWAVE + wave, NGW = GDIM() * NWAVE;
    for (int r = gw; r < L_ * WIN_GATE; r += NGW) { const int l = r / WIN_GATE, n = r % WIN_GATE; const Ptrs P = make_ptrs(p.ws, l); bf16_t* row = P.WinT + (size_t)n * 1024;
        const u32x4 a = *(const u32x4*)(row + 16 * lane), b = *(const u32x4*)(row + 16 * lane + 8);
        float v[16] = {bflo(a.x), bfhi(a.x), bflo(a.y), bfhi(a.y), bflo(a.z), bfhi(a.z), bflo(a.w), bfhi(a.w), bflo(b.x), bfhi(b.x), bflo(b.y), bfhi(b.y), bflo(b.z), bfhi(b.z), bflo(b.w), bfhi(b.w)};
        float am = 0.f;
#pragma unroll
        for (int j = 0; j < 16; ++j) am = fmaxf(am, fabsf(v[j]));
        am = wave_max(am); const float sc = am > 0.f ? am * (1.0f / 440.0f) : 1.0f, inv = 1.0f / sc; u32x4 o;
#pragma unroll
        for (int j = 0; j < 4; ++j) { unsigned w = cvt_pk_fp8_f32_(v[4 * j] * inv, v[4 * j + 1] * inv, 0u, false); w = cvt_pk_fp8_f32_(v[4 * j + 2] * inv, v[4 * j + 3] * inv, w, true); o[j] = w; }
        WAVE_SYNC();
        *(u32x4*)((unsigned char*)row + 16 * lane) = o;
        if (lane == 0) P.gscA[n] = sc; }
#ifdef CPU_EMU
    (void)lds;
#endif
}
__device__ __forceinline__ void phase_A(const KP& p, int l, unsigned char* lds) {
    const Ptrs P = make_ptrs(p.ws, l);
    { SchedA<0> S{P.hb, P.h8a, P.h8b, P.WinT, GDIM(), BIDX()}; EpiA E{P.proj, P.gscA}; pg8::gemm_phase<1>((LAS unsigned char*)lds, 1024, 1024, S, E, 1024); }
    { SchedA<1> S{P.hb, P.h8a, P.h8b, P.WinT, GDIM(), BIDX()}; EpiVt E{P.vtr, P.gscA + WIN_VT}; pg8::gemm_phase<1>((LAS unsigned char*)lds, 1024, 512, S, E, 2048); }
}
#if PROBE_REPEAT >= 40 && PROBE_REPEAT <= 49
struct SchedAP { const bf16_t* hb; const bf16_t* WinT; int G, c, nt, pnmask;
    __device__ __forceinline__ bool next(int i, pg8::Unit& u) const {
        const int nM = T_ / 256, n0 = nM * 9; const int x = i * G + c; if (x >= n0 + nM) return false;
        u.nt = nt; u.aux = 0; u.f8 = 0;
        if (x < n0) { tile_map(x, nM, 9, u.pm, u.pn); u.kind = 0; u.a = (const char*)(hb + (size_t)u.pm * 256 * 1024); u.b = (const char*)(WinT + (size_t)u.pn * 256 * 1024); }
        else { u.pm = 0; u.pn = x - n0; u.kind = 1; u.a = (const char*)(WinT + (size_t)WIN_VT * 1024); u.b = (const char*)(hb + (size_t)u.pn * 256 * 1024); }
        u.pn &= pnmask; return true; } };
struct EpiNull { float* d;
    __device__ __forceinline__ void operator()(const f32x4 (&acc)[2][2][4][2], const pg8::Unit& u, int wr, int wc, int fr, int fq, int tid) const {
        f32x4 s = (f32x4){0.f, 0.f, 0.f, 0.f};
#pragma unroll
        for (int ai = 0; ai < 2; ++ai)
#pragma unroll
            for (int m = 0; m < 4; ++m)
#pragma unroll
                for (int bj = 0; bj < 2; ++bj) s += acc[ai][bj][m][0] + acc[ai][bj][m][1];
        if (s.x + s.y + s.z + s.w == 1.2345e30f) d[tid] = s.x; } };
struct EpiStash { u32x4* stash;
    __device__ __forceinline__ void operator()(const f32x4 (&acc)[2][2][4][2], const pg8::Unit& u, int wr, int wc, int fr, int fq, int tid) const {
        OPAQUE(tid);
#pragma unroll
        for (int ai = 0; ai < 2; ++ai)
#pragma unroll
            for (int m = 0; m < 4; ++m)
#pragma unroll
                for (int bj = 0; bj < 2; ++bj) { const f32x4 v0 = acc[ai][bj][m][0], v1 = acc[ai][bj][m][1];
                    u32x4 w; w.x = pk2(v0[0], v0[1]); w.y = pk2(v0[2], v0[3]); w.z = pk2(v1[0], v1[1]); w.w = pk2(v1[2], v1[3]);
                    stash[((ai * 4 + m) * 2 + bj) * 512 + tid] = w; } } };
struct EpiFullLine { bf16_t* base;
    __device__ __forceinline__ void operator()(const f32x4 (&acc)[2][2][4][2], const pg8::Unit& u, int wr, int wc, int fr, int fq, int tid) const {
        OPAQUE(tid); if (u.kind) return;
#pragma unroll
        for (int ai = 0; ai < 2; ++ai)
#pragma unroll
            for (int m = 0; m < 4; ++m)
#pragma unroll
                for (int bj = 0; bj < 2; ++bj) { const f32x4 v0 = acc[ai][bj][m][0], v1 = acc[ai][bj][m][1]; const int k = (ai * 4 + m) * 2 + bj, L = k * 512 + tid, row = L >> 5, ch = L & 31;
                    u32x4 w; w.x = pk2(v0[0], v0[1]); w.y = pk2(v0[2], v0[3]); w.z = pk2(v1[0], v1[1]); w.w = pk2(v1[2], v1[3]);
                    *(u32x4*)(base + (size_t)(u.pm * 256 + row) * PJ + u.pn * 256 + ch * 8) = w; } } };
struct EpiProjOnly { bf16_t* base;
    __device__ __forceinline__ void operator()(const f32x4 (&acc)[2][2][4][2], const pg8::Unit& u, int wr, int wc, int fr, int fq, int tid) const {
        if (u.kind) return;
        int row0 = u.pm * 256 + wr * 64 + fr, col0 = u.pn * 256 + wc * 32 + 8 * fq; OPAQUE(row0); OPAQUE(col0);
#pragma unroll
        for (int ai = 0; ai < 2; ++ai)
#pragma unroll
            for (int m = 0; m < 4; ++m) { bf16_t* rowp = base + (size_t)(row0 + ai * 128 + m * 16) * PJ + col0;
#pragma unroll
                for (int bj = 0; bj < 2; ++bj) { const f32x4 v0 = acc[ai][bj][m][0], v1 = acc[ai][bj][m][1];
                    u32x4 w; w.x = pk2(v0[0], v0[1]); w.y = pk2(v0[2], v0[3]); w.z = pk2(v1[0], v1[1]); w.w = pk2(v1[2], v1[3]);
                    *(u32x4*)(rowp + bj * 128) = w; } } } };
template <int V>
__device__ __forceinline__ void phase_Aprobe(const KP& p, int l, unsigned char* lds) {
    const Ptrs P = make_ptrs(p.ws, l);
    SchedAP S{P.hb, P.WinT, GDIM(), BIDX(), V == 1 ? 32 : V == 3 ? 4 : V == 4 ? 8 : V == 5 ? 64 : 16, V == 6 ? 3 : 0xffff};
    if (V == 7) { EpiFullLine E{P.proj}; pg8::gemm_phase((LAS unsigned char*)lds, 1024, 1024, S, E); }
    else if (V == 8) { EpiProjOnly E{P.proj}; pg8::gemm_phase((LAS unsigned char*)lds, 1024, 1024, S, E); }
    else if (V == 2) { EpiStash E{(u32x4*)(P.ycat + (size_t)BIDX() * 65536)}; pg8::gemm_phase((LAS unsigned char*)lds, 1024, 1024, S, E); }
    else if (V == 6) { EpiStoreBf16 E{P.ycat, 1024, P.ycat, 1024}; pg8::gemm_phase((LAS unsigned char*)lds, 1024, 1024, S, E); }
    else { EpiNull E{(float*)(P.ycat + (size_t)BIDX() * 65536)}; pg8::gemm_phase((LAS unsigned char*)lds, 1024, 1024, S, E); }
}
#endif
struct SchedGlu { const bf16_t* ycat; const bf16_t* GluT; int G, c;
    __device__ __forceinline__ bool next(int i, pg8::Unit& u) const {
        const int x = i * G + c; if (x >= T_ / 256) return false;
        u.pm = x; u.pn = 0; u.nt = 4; u.kind = 0; u.aux = 0; u.f8 = 0; u.a = (const char*)(ycat + (size_t)x * 256 * 1024 + 256); u.b = (const char*)GluT; return true; } };
struct EpiGlu { bf16_t* ycat; const float* glub;
    __device__ __forceinline__ void operator()(const f32x4 (&acc)[2][2][4][2], const pg8::Unit& u, int wr, int wc, int fr, int fq, int tid) const {
        int row0 = u.pm * 256 + wr * 64 + fr, col0 = wc * 32 + 8 * fq; OPAQUE(row0); OPAQUE(col0);
#pragma unroll
        for (int bj = 0; bj < 2; ++bj) { const f32x4 b0 = *(const f32x4*)(glub + col0 + bj * 128), b1 = *(const f32x4*)(glub + col0 + bj * 128 + 4);
#pragma unroll
            for (int ai = 0; ai < 2; ++ai)
#pragma unroll
                for (int m = 0; m < 4; ++m) { bf16_t* ptr = ycat + (size_t)(row0 + ai * 128 + m * 16) * 1024 + 256 + col0 + bj * 128;
                    const u32x4 y = *(const u32x4*)ptr; const f32x4 v0 = acc[ai][bj][m][0] + b0, v1 = acc[ai][bj][m][1] + b1;
                    u32x4 w; w.x = pk2(bflo(y.x) * sigmoidf_(v0[0]), bfhi(y.x) * sigmoidf_(v0[1])); w.y = pk2(bflo(y.y) * sigmoidf_(v0[2]), bfhi(y.y) * sigmoidf_(v0[3]));
                    w.z = pk2(bflo(y.z) * sigmoidf_(v1[0]), bfhi(y.z) * sigmoidf_(v1[1])); w.w = pk2(bflo(y.w) * sigmoidf_(v1[2]), bfhi(y.w) * sigmoidf_(v1[3]));
                    *(u32x4*)ptr = w; MEMFENCE(); } }
    }
};
__device__ __forceinline__ void convert_tables(const KP& p, const Ptrs& P, int l, unsigned char* lds) {
    const int tid = TIDX(), lane = tid & 63, wave = tid >> 6;
    unsigned* cnt = (unsigned*)(p.ws + WS_CTL) + 10240 + 16 * l; int* slot = (int*)(lds + 65536);
    const float* ps = p.in[I_P] + (size_t)l * T_ * 256;
    constexpr int NG8 = 6144 / 128, NTAB = 2 * NEXP / 128, NPB = (int)(((size_t)T_ * 256 / 8 + 4095) / 4096);
    for (;;) {
        __syncthreads(); if (tid == 0) *slot = (int)atomicAdd(cnt, 1u); __syncthreads();
        int item = *slot; if (item >= NG8 + NTAB + NPB) break;
        if (item < NG8) {
            for (int rr = wave; rr < 128; rr += NWAVE) { const int r5 = item * 128 + rr; bf16_t* row = r5 < 4096 ? P.WinT + (size_t)(WIN_GATE + r5) * 1024 : r5 < 5120 ? P.PleGT + (size_t)(r5 - 4096) * 1024 : P.WoutT + (size_t)(r5 - 5120) * 1024;
                const u32x4 a = *(const u32x4*)(row + 16 * lane), b = *(const u32x4*)(row + 16 * lane + 8);
                float v[16] = {bflo(a.x), bfhi(a.x), bflo(a.y), bfhi(a.y), bflo(a.z), bfhi(a.z), bflo(a.w), bfhi(a.w), bflo(b.x), bfhi(b.x), bflo(b.y), bfhi(b.y), bflo(b.z), bfhi(b.z), bflo(b.w), bfhi(b.w)};
                float am = 0.f;
#pragma unroll
                for (int j = 0; j < 16; ++j) am = fmaxf(am, fabsf(v[j]));
                am = wave_max(am); const float sc = am > 0.f ? am * (1.0f / 440.0f) : 1.0f, inv = 1.0f / sc; u32x4 o;
#pragma unroll
                for (int j = 0; j < 4; ++j) { unsigned w = cvt_pk_fp8_f32_(v[4 * j] * inv, v[4 * j + 1] * inv, 0u, false); w = cvt_pk_fp8_f32_(v[4 * j + 2] * inv, v[4 * j + 3] * inv, w, true); o[j] = w; }
                WAVE_SYNC();
                *(u32x4*)((unsigned char*)row + 16 * lane) = o;
                if (lane == 0) P.gsc[r5] = sc; }
            continue; }
        item -= NG8;
        if (item < NTAB) {
            for (int r4 = 0; r4 < 16; r4 += 4) { f32x4 v[4][4]; float am[4];
#pragma unroll
                for (int q = 0; q < 4; ++q) { const int it = item * 128 + wave + 8 * (r4 + q); const int tb = it >= NEXP, row = tb ? it - NEXP : it;
                    const float* src = p.in[tb ? I_V : I_U] + ((size_t)l * NEXP + row) * 1024 + 16 * lane; am[q] = 0.f;
#pragma unroll
                    for (int j = 0; j < 4; ++j) { v[q][j] = *(const f32x4*)(src + 4 * j); am[q] = fmaxf(am[q], fmaxf(fmaxf(fabsf(v[q][j].x), fabsf(v[q][j].y)), fmaxf(fabsf(v[q][j].z), fabsf(v[q][j].w)))); } }
#pragma unroll
                for (int q = 0; q < 4; ++q) { const int it = item * 128 + wave + 8 * (r4 + q); const int tb = it >= NEXP, row = tb ? it - NEXP : it;
                    const float amx = wave_max(am[q]); const float sc = amx > 0.f ? amx * (1.0f / 440.0f) : 1.0f, inv = 1.0f / sc; u32x4 o;
#pragma unroll
                    for (int j = 0; j < 4; ++j) { unsigned w = cvt_pk_fp8_f32_(v[q][j].x * inv, v[q][j].y * inv, 0u, false); w = cvt_pk_fp8_f32_(v[q][j].z * inv, v[q][j].w * inv, w, true); o[j] = w; }
                    *(u32x4*)((tb ? P.V8 : P.U8) + ((size_t)(lane >> 3) * NEXP + row) * 128 + 16 * (lane & 7)) = o;
                    if (lane == 0) (tb ? P.sv : P.su)[row] = sc; } }
        } else {
            const size_t base = (size_t)(item - NTAB) * 4096;
            f32x4 a[8], bq[8];
#pragma unroll
            for (int j = 0; j < 8; ++j) { const size_t i = base + tid + (size_t)j * NTHR; a[j] = (f32x4){0.f, 0.f, 0.f, 0.f}; bq[j] = a[j];
                if (i < (size_t)T_ * 256 / 8) { a[j] = *(const f32x4*)(ps + i * 8); bq[j] = *(const f32x4*)(ps + i * 8 + 4); } }
#pragma unroll
            for (int j = 0; j < 8; ++j) { const size_t i = base + tid + (size_t)j * NTHR;
                if (i < (size_t)T_ * 256 / 8) { u32x4 o; o.x = pk2(a[j].x, a[j].y); o.y = pk2(a[j].z, a[j].w); o.z = pk2(bq[j].x, bq[j].y); o.w = pk2(bq[j].z, bq[j].w); *(u32x4*)(P.pb + i * 8) = o; } }
        }
    }
}
__device__ __forceinline__ void phase_B2(const KP& p, int l, unsigned char* lds) {
    const Ptrs P = make_ptrs(p.ws, l);
    constexpr int NRW = NB_ * 4; const int G = GDIM(), c = BIDX();
    int gG = G, gc = c;
    if (G > NRW) { if (c < NRW) { rw_state_unit(p, P, l, c, lds);
#if PROBE_REPEAT == 35
        rw_state_unit(p, P, l, c, lds);
#endif
        convert_tables(p, P, l, lds); return; } gG = G - NRW; gc = c - NRW; }
    else { for (int u = c; u < NRW; u += G) rw_state_unit(p, P, l, u, lds); }
    SchedGlu S{P.ycat, P.GluT, gG, gc};
    EpiGlu E{P.ycat, p.in[I_GLUB] + l * 256};
    pg8::gemm_phase((LAS unsigned char*)lds, 1024, 256, S, E);
    convert_tables(p, P, l, lds);
}
struct SchedC { const unsigned char* h8a; const unsigned char* h8b; const bf16_t* ycat; const bf16_t* WinT; const bf16_t* WbrT; int G, c;
    __device__ __forceinline__ bool next(int i, pg8::Unit& u) const {
        const int tile = (i >> 3) * G + c; if (tile >= (T_ / 256) * 4) return false;
        const int j = i & 7, b = j >> 1; tile_map(tile, T_ / 256, 4, u.pm, u.pn); u.aux = b;
        if (!(j & 1)) { u.kind = 0; u.nt = 4; u.f8 = 0; u.a = (const char*)(ycat + (size_t)u.pm * 256 * 1024 + 256 * b); u.b = (const char*)(WbrT + (size_t)u.pn * 256 * 1024 + 256 * b); }
        else { u.kind = 1; u.nt = 8; u.f8 = 1; const int m0 = u.pm * 256;
            u.a = (const char*)(m0 < H8_SPLIT ? h8a + (size_t)m0 * 1024 : h8b + (size_t)(m0 - H8_SPLIT) * 1024); u.b = (const char*)(WinT + (size_t)(WIN_GATE + 1024 * b + 256 * u.pn) * 1024); }
        return true; } };
constexpr int EPIC_LDS_FR = 7;
struct EpiC { u32x2* stash; bf16_t* merged; const float* gsc; unsigned char* m8; LAS unsigned char* sl;
    __device__ __forceinline__ void operator()(const f32x4 (&acc)[2][2][4][2], const pg8::Unit& u, int wr, int wc, int fr, int fq, int tid) const {
        OPAQUE(tid);
        if (u.kind == 0) {
#pragma unroll
            for (int ai = 0; ai < 2; ++ai)
#pragma unroll
                for (int m = 0; m < 4; ++m)
#pragma unroll
                    for (int bj = 0; bj < 2; ++bj) { const f32x4 v0 = acc[ai][bj][m][0], v1 = acc[ai][bj][m][1];
                        u32x2 w; w.x = cvt_pk_fp8_f32_(v0[0], v0[1], 0u, false); w.x = cvt_pk_fp8_f32_(v0[2], v0[3], w.x, true); w.y = cvt_pk_fp8_f32_(v1[0], v1[1], 0u, false); w.y = cvt_pk_fp8_f32_(v1[2], v1[3], w.y, true);
                        if ((ai * 4 + m) * 2 + bj < EPIC_LDS_FR) *(LAS u32x2*)(sl + ((ai * 4 + m) * 2 + bj) * 4096 + tid * 8) = w; else stash[((ai * 4 + m) * 2 + bj) * 512 + tid] = w; }
        } else {
            int row0 = u.pm * 256 + wr * 64 + fr, col0 = u.pn * 256 + wc * 32 + 8 * fq; OPAQUE(row0); OPAQUE(col0); const bool first = (u.aux == 0);
            f32x4 sc[2][2];
#pragma unroll
            for (int bj = 0; bj < 2; ++bj) { const float* sp = gsc + 1024 * u.aux + col0 + bj * 128; sc[bj][0] = *(const f32x4*)sp; sc[bj][1] = *(const f32x4*)(sp + 4); }
#pragma unroll
            for (int ai = 0; ai < 2; ++ai)
#pragma unroll
                for (int mp = 0; mp < 2; ++mp) { u32x2 y[4]; u32x4 mo[4];
#pragma unroll
                    for (int q = 0; q < 4; ++q) { const int m = 2 * mp + (q >> 1), bj = q & 1;
                        if ((ai * 4 + m) * 2 + bj < EPIC_LDS_FR) y[q] = *(const LAS u32x2*)(sl + ((ai * 4 + m) * 2 + bj) * 4096 + tid * 8); else y[q] = stash[((ai * 4 + m) * 2 + bj) * 512 + tid];
                        mo[q] = (u32x4){0u, 0u, 0u, 0u};
                        if (!first) mo[q] = *(const u32x4*)(merged + (size_t)(row0 + ai * 128 + m * 16) * 1024 + col0 + bj * 128); }
#pragma unroll
                    for (int q = 0; q < 4; ++q) { const int m = 2 * mp + (q >> 1), bj = q & 1; const f32x4 g0 = acc[ai][bj][m][0] * sc[bj][0], g1 = acc[ai][bj][m][1] * sc[bj][1];
                        bf16_t* ptr = merged + (size_t)(row0 + ai * 128 + m * 16) * 1024 + col0 + bj * 128;
                        const f32x2 ya = cvt_pk_f32_fp8_(y[q].x, false), yb = cvt_pk_f32_fp8_(y[q].x, true), yc = cvt_pk_f32_fp8_(y[q].y, false), yd = cvt_pk_f32_fp8_(y[q].y, true);
                        const float o0 = ya.x * sigmoidf_(g0[0]) + bflo(mo[q].x), o1 = ya.y * sigmoidf_(g0[1]) + bfhi(mo[q].x), o2 = yb.x * sigmoidf_(g0[2]) + bflo(mo[q].y), o3 = yb.y * sigmoidf_(g0[3]) + bfhi(mo[q].y);
                        const float o4 = yc.x * sigmoidf_(g1[0]) + bflo(mo[q].z), o5 = yc.y * sigmoidf_(g1[1]) + bfhi(mo[q].z), o6 = yd.x * sigmoidf_(g1[2]) + bflo(mo[q].w), o7 = yd.y * sigmoidf_(g1[3]) + bfhi(mo[q].w);
                        u32x4 w; w.x = pk2(o0, o1); w.y = pk2(o2, o3); w.z = pk2(o4, o5); w.w = pk2(o6, o7);
                        if (u.aux != 3) *(u32x4*)ptr = w;
                        else { u32x2 w8; w8.x = cvt_pk_fp8_f32_(o0, o1, 0u, false); w8.x = cvt_pk_fp8_f32_(o2, o3, w8.x, true); w8.y = cvt_pk_fp8_f32_(o4, o5, 0u, false); w8.y = cvt_pk_fp8_f32_(o6, o7, w8.y, true);
                            *(u32x2*)(m8 + (size_t)(row0 + ai * 128 + m * 16) * 1024 + col0 + bj * 128) = w8; } }
                    MEMFENCE(); }
        }
    }
};
__device__ __forceinline__ void phase_C(const KP& p, int l, unsigned char* lds) {
    const Ptrs P = make_ptrs(p.ws, l);
    SchedC S{P.h8a, P.h8b, P.ycat, P.WinT, P.WbrT, GDIM(), BIDX()};
    EpiC E{(u32x2*)(P.stash + (size_t)BIDX() * 65536), P.merged, P.gsc, P.h8e, (LAS unsigned char*)lds + 131072};
    pg8::gemm_phase<2>((LAS unsigned char*)lds, 1024, 1024, S, E, 1024);
}
struct SchedD { const unsigned char* A8; const bf16_t* Bt; int nN, G, c;
    __device__ __forceinline__ bool next(int i, pg8::Unit& u) const {
        const int x = i * G + c; if (x >= (T_ / 256) * nN) return false;
        tile_map(x, T_ / 256, nN, u.pm, u.pn); u.nt = 8; u.kind = 0; u.aux = 0; u.f8 = 1; u.a = (const char*)(A8 + (size_t)u.pm * 256 * 1024); u.b = (const char*)(Bt + (size_t)u.pn * 256 * 1024); return true; } };
struct EpiResid { bf16_t* ob; const bf16_t* hb; const float* sc;
    __device__ __forceinline__ void operator()(const f32x4 (&acc)[2][2][4][2], const pg8::Unit& u, int wr, int wc, int fr, int fq, int tid) const {
        int row0 = u.pm * 256 + wr * 64 + fr, col0 = u.pn * 256 + wc * 32 + 8 * fq; OPAQUE(row0); OPAQUE(col0);
#pragma unroll
        for (int ai = 0; ai < 2; ++ai)
#pragma unroll
            for (int m = 0; m < 4; ++m)
#pragma unroll
                for (int bj = 0; bj < 2; ++bj) { const size_t o = (size_t)(row0 + ai * 128 + m * 16) * 1024 + col0 + bj * 128; const u32x4 hw = *(const u32x4*)(hb + o);
                    const f32x4 a0 = acc[ai][bj][m][0] * *(const f32x4*)(sc + col0 + bj * 128), a1 = acc[ai][bj][m][1] * *(const f32x4*)(sc + col0 + bj * 128 + 4); u32x4 w;
                    w.x = pk2(bflo(hw.x) * DN_ALPHA_ + a0[0], bfhi(hw.x) * DN_ALPHA_ + a0[1]); w.y = pk2(bflo(hw.y) * DN_ALPHA_ + a0[2], bfhi(hw.y) * DN_ALPHA_ + a0[3]);
                    w.z = pk2(bflo(hw.z) * DN_ALPHA_ + a1[0], bfhi(hw.z) * DN_ALPHA_ + a1[1]); w.w = pk2(bflo(hw.w) * DN_ALPHA_ + a1[2], bfhi(hw.w) * DN_ALPHA_ + a1[3]);
                    *(u32x4*)(ob + o) = w; }
    }
};
__device__ __forceinline__ void phase_D(const KP& p, int l, unsigned char* lds) {
    const Ptrs P = make_ptrs(p.ws, l);
    SchedD S{P.h8e, P.WoutT, 4, GDIM(), BIDX()};
    EpiResid E{P.ycat, P.hb, P.gsc + 5120};
    pg8::gemm_phase<1>((LAS unsigned char*)lds, 1024, 1024, S, E, 1024);
}
__device__ __forceinline__ void phase_D2(const KP& p, int l, unsigned char* lds) {
    const Ptrs P = make_ptrs(p.ws, l);
    const int tid = TIDX(), lane = tid & 63, wave = tid >> 6; const int gw = BIDX() * NWAVE + wave, NGW = GDIM() * NWAVE;
    for (int m = 4 * gw; m < T_; m += 4 * NGW) ln_rows<4, true>(P.ycat + (size_t)m * 1024, p.in[I_LN1G] + l * 1024, p.in[I_LN1B] + l * 1024, (float*)nullptr, P.hb + (size_t)m * 1024, P.h8e + (size_t)m * 1024, lane);
}
struct SchedE1 { const bf16_t* pb; const bf16_t* PleT; int G, c;
    __device__ __forceinline__ bool next(int i, pg8::Unit& u) const {
        const int x = i * G + c; if (x >= (T_ / 256) * 4) return false;
        tile_map(x, T_ / 256, 4, u.pm, u.pn); u.nt = 4; u.kind = 0; u.aux = 0; u.f8 = 0; u.a = (const char*)(pb + (size_t)u.pm * 256 * 256); u.b = (const char*)(PleT + (size_t)u.pn * 256 * 256); return true; } };
template <int PART>
struct SchedE2 { const bf16_t* hb; const unsigned char* h8e; const bf16_t* PleGT; const bf16_t* WqT; int G, c;
    __device__ __forceinline__ bool next(int i, pg8::Unit& u) const {
        const int n0 = (T_ / 256) * 4; int x = i * G + c + (PART ? n0 : 0); if (x >= (PART ? n0 + (T_ / 256) * 8 : n0)) return false;
        u.aux = 0;
        if (x < n0) { tile_map(x, T_ / 256, 4, u.pm, u.pn); u.kind = 0; u.nt = 8; u.f8 = 1; u.b = (const char*)(PleGT + (size_t)u.pn * 256 * 1024); u.a = (const char*)(h8e + (size_t)u.pm * 256 * 1024); }
        else { x -= n0; tile_map(x, T_ / 256, 8, u.pm, u.pn); u.kind = 1; u.nt = 16; u.f8 = 0; u.b = (const char*)(WqT + (size_t)u.pn * 256 * 1024); u.a = (const char*)(hb + (size_t)u.pm * 256 * 1024); }
        return true; } };
struct EpiE2g { const bf16_t* hb; bf16_t* Pbuf; const float* gsc;
    __device__ __forceinline__ void operator()(const f32x4 (&acc)[2][2][4][2], const pg8::Unit& u, int wr, int wc, int fr, int fq, int tid) const {
        int row0 = u.pm * 256 + wr * 64 + fr, col0 = u.pn * 256 + wc * 32 + 8 * fq; OPAQUE(row0); OPAQUE(col0);
#pragma unroll
        for (int bj = 0; bj < 2; ++bj) { const float* sp = gsc + 4096 + col0 + bj * 128; const f32x4 s0 = *(const f32x4*)sp, s1 = *(const f32x4*)(sp + 4);
            const size_t cb = (size_t)row0 * 1024 + col0 + bj * 128; const bf16_t* hp = hb + cb; bf16_t* pp = Pbuf + cb;
#pragma unroll
            for (int ai = 0; ai < 2; ++ai)
#pragma unroll
                for (int mp = 0; mp < 2; ++mp) { u32x4 y[2], hw[2];
#pragma unroll
                    for (int q = 0; q < 2; ++q) { const int ro = (ai * 128 + (2 * mp + q) * 16) * 1024; y[q] = *(const u32x4*)(pp + ro); hw[q] = *(const u32x4*)(hp + ro); }
#pragma unroll
                    for (int q = 0; q < 2; ++q) { const int m = 2 * mp + q; const int ro = (ai * 128 + m * 16) * 1024; const f32x4 v0 = acc[ai][bj][m][0] * s0, v1 = acc[ai][bj][m][1] * s1;
                        u32x4 w;
                        w.x = pk2(bflo(hw[q].x) * DN_ALPHA_ + bflo(y[q].x) * sigmoidf_(v0[0]), bfhi(hw[q].x) * DN_ALPHA_ + bfhi(y[q].x) * sigmoidf_(v0[1]));
                        w.y = pk2(bflo(hw[q].y) * DN_ALPHA_ + bflo(y[q].y) * sigmoidf_(v0[2]), bfhi(hw[q].y) * DN_ALPHA_ + bfhi(y[q].y) * sigmoidf_(v0[3]));
                        w.z = pk2(bflo(hw[q].z) * DN_ALPHA_ + bflo(y[q].z) * sigmoidf_(v1[0]), bfhi(hw[q].z) * DN_ALPHA_ + bfhi(y[q].z) * sigmoidf_(v1[1]));
                        w.w = pk2(bflo(hw[q].w) * DN_ALPHA_ + bflo(y[q].w) * sigmoidf_(v1[2]), bfhi(hw[q].w) * DN_ALPHA_ + bfhi(y[q].w) * sigmoidf_(v1[3]));
                        *(u32x4*)(pp + ro) = w; }
                    MEMFENCE(); } }
    }
};
__device__ __forceinline__ void phase_E(const KP& p, int l, unsigned char* lds) {
    const Ptrs P = make_ptrs(p.ws, l);
    { SchedE1 S{P.pb, P.PleT, GDIM(), BIDX()}; EpiStoreBf16 E{P.ycat, 1024, P.ycat, 1024}; pg8::gemm_phase((LAS unsigned char*)lds, 256, 256, S, E); }
    { SchedE2<0> S{P.hb, P.h8e, P.PleGT, P.WqT, GDIM(), BIDX()}; EpiE2g E{P.hb, P.ycat, P.gsc}; pg8::gemm_phase<1>((LAS unsigned char*)lds, 1024, 1024, S, E, 1024); }
    { SchedE2<1> S{P.hb, P.h8e, P.PleGT, P.WqT, GDIM(), BIDX()}; EpiStoreBf16 E{P.q, 2048, P.q, 2048}; pg8::gemm_phase<0>((LAS unsigned char*)lds, 1024, 1024, S, E); }
}
__device__ __forceinline__ unsigned mono_key(float f) { const unsigned u = __builtin_bit_cast(unsigned, f); return (u & 0x80000000u) ? ~u : (u | 0x80000000u); }
__device__ __forceinline__ float unmono_key(unsigned k) { const unsigned u = (k & 0x80000000u) ? (k ^ 0x80000000u) : ~k; return __builtin_bit_cast(float, u); }
struct CandTab { int a[50], b[50]; };
constexpr CandTab make_cand() { CandTab t{}; int n = 0; for (int a = 0; a < 16; ++a) for (int b = 0; b < 16; ++b) if ((a + 1) * (b + 1) <= 16) { t.a[n] = a; t.b[n] = b; ++n; } return t; }
constexpr CandTab CAND = make_cand();
constexpr int PK_PITCH = 136;

#define PK_CE(x, y) do { const unsigned _a = (x), _b = (y); (x) = _a > _b ? _a : _b; (y) = _a > _b ? _b : _a; } while (0)
__device__ __forceinline__ void bitonic_merge16_desc(unsigned (&a)[16]) {
#pragma unroll
    for (int j = 8; j > 0; j >>= 1)
#pragma unroll
        for (int i = 0; i < 16; ++i) { const int l = i ^ j; if (l > i) PK_CE(a[i], a[l]); }
}
__device__ __forceinline__ void bitonic_sort16_desc(unsigned (&a)[16]) {
#pragma unroll
    for (int k = 2; k <= 16; k <<= 1)
#pragma unroll
        for (int j = k >> 1; j > 0; j >>= 1)
#pragma unroll
            for (int i = 0; i < 16; ++i) { const int l = i ^ j; if (l > i) { if ((i & k) == 0 || k == 16) PK_CE(a[i], a[l]); else PK_CE(a[l], a[i]); } }
}
__device__ __forceinline__ void top_half_merge16(unsigned (&a)[16], const unsigned (&b)[16]) {
#pragma unroll
    for (int i = 0; i < 16; ++i) a[i] = a[i] > b[15 - i] ? a[i] : b[15 - i];
    bitonic_merge16_desc(a);
}
__device__ __forceinline__ void top16_keys(const unsigned (&key)[64], unsigned (&top)[16]) {
    unsigned g0[16], g1[16], g2[16], g3[16];
#pragma unroll
    for (int i = 0; i < 16; ++i) { g0[i] = key[i]; g1[i] = key[16 + i]; g2[i] = key[32 + i]; g3[i] = key[48 + i]; }
    bitonic_sort16_desc(g0); bitonic_sort16_desc(g1); bitonic_sort16_desc(g2); bitonic_sort16_desc(g3);
    top_half_merge16(g0, g1); top_half_merge16(g2, g3); top_half_merge16(g0, g2);
    unsigned pr[16];
#pragma unroll
    for (int i = 0; i < 16; ++i) pr[i] = (unsigned)__shfl_xor((int)g0[i], 32);
    top_half_merge16(g0, pr);
#pragma unroll
    for (int i = 0; i < 16; ++i) top[i] = g0[i];
}
__device__ __forceinline__ void peer_route_unit(const KP& p, const Ptrs& P, int l, int unit, unsigned char* lds) {
    const bf16_t* Ks = (const bf16_t*)lds;
    const int tid = TIDX(), lane = tid & 63, wave = tid >> 6, r32 = lane & 31, hi = lane >> 5;
    const int tok = unit * 32 + r32;
    int kbase = r32 * PK_PITCH + 8 * hi; OPAQUE(kbase);
    unsigned top1[16], top2[16];
#pragma unroll 1
    for (int half = 0; half < 2; ++half) {
        const bf16_t* qp = P.q + (size_t)tok * 2048 + wave * 256 + half * 128 + 8 * hi;
        bf16x8 qf[8];
#pragma unroll
        for (int ks = 0; ks < 8; ++ks) qf[ks] = *(const bf16x8*)(qp + 16 * ks);
        unsigned key[64];
#pragma unroll
        for (int kt = 0; kt < 4; ++kt) { f32x16 acc = {}; const bf16_t* kp = Ks + (half * 128 + 32 * kt) * PK_PITCH + kbase;
#pragma unroll
            for (int ks = 0; ks < 8; ++ks) { const bf16x8 a = *(const bf16x8*)(kp + 16 * ks); acc = MFMA32(a, qf[ks], acc); }
#pragma unroll
            for (int r = 0; r < 16; ++r) { const int idx = 32 * kt + (r & 3) + 8 * (r >> 2) + 4 * hi; key[16 * kt + r] = (mono_key(acc[r]) & ~127u) | (unsigned)(127 - idx); } }
        if (half == 0) top16_keys(key, top1); else top16_keys(key, top2);
        MEMFENCE();
    }
    MEMFENCE();
    int* islot = (int*)(lds + 2 * 128 * PK_PITCH * 2) + (wave * 32 + r32) * 33;
    float v1[16], v2[16];
#pragma unroll
    for (int r = 0; r < 16; ++r) { v1[r] = unmono_key(top1[r] & ~127u); v2[r] = unmono_key(top2[r] & ~127u); islot[16 * hi + r] = 127 - (int)((hi ? top2[r] : top1[r]) & 127u); }
    unsigned ka[16], kb[16];
#pragma unroll
    for (int i = 0; i < 25; ++i) { const int c0 = 2 * i, c1 = 2 * i + 1;
        const float s = hi ? (v1[CAND.a[c1]] + v2[CAND.b[c1]]) : (v1[CAND.a[c0]] + v2[CAND.b[c0]]);
        const unsigned k = (mono_key(s) & ~255u) | (unsigned)(255 - (hi ? 16 * CAND.a[c1] + CAND.b[c1] : 16 * CAND.a[c0] + CAND.b[c0]));
        if (i < 16) ka[i] = k; else kb[i - 16] = k; }
#pragma unroll
    for (int i = 9; i < 16; ++i) kb[i] = 0u;
    bitonic_sort16_desc(ka); bitonic_sort16_desc(kb); top_half_merge16(ka, kb);
    { unsigned pr[16];
#pragma unroll
      for (int i = 0; i < 16; ++i) pr[i] = (unsigned)__shfl_xor((int)ka[i], 32);
      top_half_merge16(ka, pr); }
    WAVE_SYNC();
    float sc[16]; int se[16];
#pragma unroll
    for (int r = 0; r < 16; ++r) { sc[r] = unmono_key(ka[r] & ~255u); se[r] = 0; }
#pragma unroll
    for (int r = 0; r < 8; ++r) { unsigned mlo = ka[r], mhi = ka[8 + r]; OPAQUE(mlo); OPAQUE(mhi);
        const unsigned m = hi ? mhi : mlo; const int ab = 255 - (int)(m & 255u); const int e = islot[ab >> 4] * 128 + islot[16 + (ab & 15)];
        if (hi) se[8 + r] = e; else se[r] = e; }
    WAVE_SYNC();
    float g[16]; float sum = 0.f;
#pragma unroll
    for (int r = 0; r < 16; ++r) { g[r] = __expf(sc[r] - sc[0]); sum += g[r]; }
    const float inv = 1.0f / sum;
    const size_t ob = (size_t)tok * 128 + wave * 16 + 8 * hi;
    if (hi == 0) {
        *(u32x4*)(P.eid + ob) = (u32x4){(unsigned)se[0], (unsigned)se[1], (unsigned)se[2], (unsigned)se[3]}; *(u32x4*)(P.eid + ob + 4) = (u32x4){(unsigned)se[4], (unsigned)se[5], (unsigned)se[6], (unsigned)se[7]};
        *(f32x4*)(P.gate + ob) = (f32x4){g[0] * inv, g[1] * inv, g[2] * inv, g[3] * inv}; *(f32x4*)(P.gate + ob + 4) = (f32x4){g[4] * inv, g[5] * inv, g[6] * inv, g[7] * inv};
    } else {
        *(u32x4*)(P.eid + ob) = (u32x4){(unsigned)se[8], (unsigned)se[9], (unsigned)se[10], (unsigned)se[11]}; *(u32x4*)(P.eid + ob + 4) = (u32x4){(unsigned)se[12], (unsigned)se[13], (unsigned)se[14], (unsigned)se[15]};
        *(f32x4*)(P.gate + ob) = (f32x4){g[8] * inv, g[9] * inv, g[10] * inv, g[11] * inv}; *(f32x4*)(P.gate + ob + 4) = (f32x4){g[12] * inv, g[13] * inv, g[14] * inv, g[15] * inv};
    }
}
__device__ __forceinline__ void phase_F(const KP& p, int l, unsigned char* lds) {
    const Ptrs P = make_ptrs(p.ws, l);
    bf16_t* Ks = (bf16_t*)lds; const int tid = TIDX();
    for (int e = tid; e < 2 * 128 * 16; e += NTHR) { const int row = e >> 4, ch = e & 15; *(u32x4*)(Ks + row * PK_PITCH + ch * 8) = *(const u32x4*)(P.K12 + row * 128 + ch * 8); }
    __syncthreads();
    for (int u = BIDX(); u < T_ / 32; u += GDIM()) peer_route_unit(p, P, l, u, lds);
    __syncthreads();
}
constexpr int PG_TB = (T_ >= 4096 ? 128 : 64), PG_NBLK = T_ / PG_TB;
__device__ __forceinline__ int peer_next_item(unsigned* cnt, int* slot, int tid) {
    __syncthreads();
    if (tid == 0) *slot = (int)atomicAdd(cnt, 1u);
    __syncthreads();
    return *slot;
}
constexpr int PG_TPW = PG_TB / NWAVE;
static_assert(PG_TPW >= 4 && PG_TPW % 2 == 0, "token pipeline depth");
constexpr int PG_WLDS = 6144;
__device__ __forceinline__ void pg_issue_rows(const unsigned char* T8, int x, int c8, int gq, int lane, int e0, int e1, int* E, u32x4 (&rb)[16]) {
    WAVE_SYNC(); E[lane] = e0; E[64 + lane] = e1; WAVE_SYNC();
#pragma unroll
    for (int k = 0; k < 16; ++k) { const unsigned off = ((unsigned)(x * NEXP) + (unsigned)E[gq + 8 * k]) * 128u + 16u * (unsigned)c8; rb[k] = *(const u32x4*)(T8 + off); }
}
template <bool REFILL, int TAG>
__device__ __forceinline__ void pg_dots_compute(const Ptrs& P, int x, int t, u32x4 (&ub)[16], u32x4 xa, u32x4 xb, float* R, const int* E, int c8, int gq, int lane) {
    const f32x2 x0 = (f32x2){bflo(xa.x), bfhi(xa.x)}, x1 = (f32x2){bflo(xa.y), bfhi(xa.y)}, x2 = (f32x2){bflo(xa.z), bfhi(xa.z)}, x3 = (f32x2){bflo(xa.w), bfhi(xa.w)};
    const f32x2 x4 = (f32x2){bflo(xb.x), bfhi(xb.x)}, x5 = (f32x2){bflo(xb.y), bfhi(xb.y)}, x6 = (f32x2){bflo(xb.z), bfhi(xb.z)}, x7 = (f32x2){bflo(xb.w), bfhi(xb.w)};
    WAVE_SYNC();
    unsigned off[8];
    const unsigned char* ubase = P.U8;
#pragma unroll
    for (int k = 0; k < 16; ++k) { PIN1(ub[k]);
        if (REFILL && (k & 7) == 0) {
#pragma unroll
            for (int j = 0; j < 8; ++j) off[j] = ((unsigned)(x * NEXP) + (unsigned)E[gq + 8 * (k + j)]) * 128u + 16u * (unsigned)c8; }
        f32x2 s = cvt_pk_f32_fp8_(ub[k][0], false) * x0; s += cvt_pk_f32_fp8_(ub[k][0], true) * x1; s += cvt_pk_f32_fp8_(ub[k][1], false) * x2; s += cvt_pk_f32_fp8_(ub[k][1], true) * x3;
        s += cvt_pk_f32_fp8_(ub[k][2], false) * x4; s += cvt_pk_f32_fp8_(ub[k][2], true) * x5; s += cvt_pk_f32_fp8_(ub[k][3], false) * x6; s += cvt_pk_f32_fp8_(ub[k][3], true) * x7;
        R[k * 64 + lane] = s.x + s.y;
        if (REFILL) { GLOAD16_RW_S(ub[k], ubase, off[k & 7]); }
        if (TAG) TAG_B(); else TAG_A();
        SCHED_FENCE(); }
    WAVE_SYNC();
    const f32x4 a0 = *(const f32x4*)(R + 8 * lane), a1 = *(const f32x4*)(R + 8 * lane + 4), b0 = *(const f32x4*)(R + 512 + 8 * lane), b1 = *(const f32x4*)(R + 512 + 8 * lane + 4);
    bf16_t* pd = P.pd + ((size_t)x * T_ + t) * 128;
    pd[lane] = (bf16_t)f2bf(((a0[0] + a0[1]) + (a0[2] + a0[3])) + ((a1[0] + a1[1]) + (a1[2] + a1[3])));
    pd[64 + lane] = (bf16_t)f2bf(((b0[0] + b0[1]) + (b0[2] + b0[3])) + ((b1[0] + b1[1]) + (b1[2] + b1[3])));
}
#define PG_PIN16(v) do { _Pragma("unroll") for (int _k = 0; _k < 16; ++_k) PIN1(v[_k]); } while (0)
__device__ __forceinline__ void peer_dots_item(const Ptrs& P, int x, int blk, unsigned char* lds, int lane, int wave) {
    float* R = (float*)(lds + wave * PG_WLDS); int* E = (int*)(lds + wave * PG_WLDS + 4096);
    const int gq = lane >> 3, c8 = lane & 7, tb = blk * PG_TB + PG_TPW * wave;
    u32x4 uA[16], uB[16], xa0, xb0, xa1, xb1;
    const bf16_t* hbase = P.hb; const int* ebase = P.eid; const unsigned char* ubase = P.U8;
    const unsigned xo = (unsigned)((tb * 1024 + 128 * x + 16 * c8) * 2), eo = (unsigned)((tb * 128 + lane) * 4);
    int ea0, ea1, eb0, eb1;
    { const int* ep = P.eid + (size_t)tb * 128 + lane; ea0 = ep[0]; ea1 = ep[64]; eb0 = ep[128]; eb1 = ep[192]; }
    WAVE_SYNC(); E[lane] = ea0; E[64 + lane] = ea1; WAVE_SYNC();
#pragma unroll
    for (int k = 0; k < 16; ++k) { const unsigned off = ((unsigned)(x * NEXP) + (unsigned)E[gq + 8 * k]) * 128u + 16u * (unsigned)c8; GLOAD16_S(uA[k], ubase, off); }
    GLOAD16_S(xa0, hbase, xo); GLOAD16_S(xb0, hbase, xo + 16u); GLOAD4_S(ea0, ebase, eo + 2u * 512u); GLOAD4_S(ea1, ebase, eo + 2u * 512u + 256u);
    WAVE_SYNC(); E[lane] = eb0; E[64 + lane] = eb1; WAVE_SYNC();
#pragma unroll
    for (int k = 0; k < 16; ++k) { const unsigned off = ((unsigned)(x * NEXP) + (unsigned)E[gq + 8 * k]) * 128u + 16u * (unsigned)c8; GLOAD16_S(uB[k], ubase, off); }
    GLOAD16_S(xa1, hbase, xo + 2048u); GLOAD16_S(xb1, hbase, xo + 2048u + 16u); GLOAD4_S(eb0, ebase, eo + 3u * 512u); GLOAD4_S(eb1, ebase, eo + 3u * 512u + 256u);
#pragma unroll
    for (int i = 0; i < PG_TPW; i += 2) {
        if (i == 0) WAIT_VM(20); else WAIT_VM(22);
        PIN4(xa0, xb0, ea0, ea1);
        if (i + 2 < PG_TPW) { WAVE_SYNC(); E[lane] = ea0; E[64 + lane] = ea1; WAVE_SYNC();
            pg_dots_compute<true, 0>(P, x, tb + i, uA, xa0, xb0, R, E, c8, gq, lane);
            const unsigned nx = (unsigned)((i + 4 < PG_TPW) ? i + 4 : PG_TPW - 1), xo2 = xo + (unsigned)(i + 2) * 2048u;
            GLOAD16_S(xa0, hbase, xo2); GLOAD16_S(xb0, hbase, xo2 + 16u); GLOAD4_S(ea0, ebase, eo + nx * 512u); GLOAD4_S(ea1, ebase, eo + nx * 512u + 256u); }
        else pg_dots_compute<false, 0>(P, x, tb + i, uA, xa0, xb0, R, E, c8, gq, lane);
        if (i + 2 < PG_TPW) WAIT_VM(22); else WAIT_VM(0);
        PIN4(xa1, xb1, eb0, eb1);
        if (i + 3 < PG_TPW) { WAVE_SYNC(); E[lane] = eb0; E[64 + lane] = eb1; WAVE_SYNC();
            pg_dots_compute<true, 1>(P, x, tb + i + 1, uB, xa1, xb1, R, E, c8, gq, lane);
            const unsigned nx = (unsigned)((i + 5 < PG_TPW) ? i + 5 : PG_TPW - 1), xo2 = xo + (unsigned)(i + 3) * 2048u;
            GLOAD16_S(xa1, hbase, xo2); GLOAD16_S(xb1, hbase, xo2 + 16u); GLOAD4_S(eb0, ebase, eo + nx * 512u); GLOAD4_S(eb1, ebase, eo + nx * 512u + 256u); }
        else pg_dots_compute<false, 1>(P, x, tb + i + 1, uB, xa1, xb1, R, E, c8, gq, lane);
    }
}
template <bool REFILL, int TAG>
__device__ __forceinline__ void pg_acc_compute(const Ptrs& P, bf16_t* outp, int x, int t, u32x4 (&vb)[16], float w0, float w1, unsigned oprev, float* C, float* W, const int* E, int c8, int gq, int lane) {
    WAVE_SYNC(); W[lane] = w0; W[64 + lane] = w1; WAVE_SYNC();
    f32x2 acc[8];
#pragma unroll
    for (int q = 0; q < 8; ++q) acc[q] = (f32x2){0.f, 0.f};
    unsigned off[8]; const unsigned char* vbase = P.V8; float wk[16];
#pragma unroll
    for (int k = 0; k < 16; ++k) wk[k] = W[gq + 8 * k];
#pragma unroll
    for (int k = 0; k < 16; ++k) { PIN1(vb[k]);
        if (REFILL && (k & 7) == 0) {
#pragma unroll
            for (int j = 0; j < 8; ++j) off[j] = ((unsigned)(x * NEXP) + (unsigned)E[gq + 8 * (k + j)]) * 128u + 16u * (unsigned)c8; }
#pragma unroll
        for (int q = 0; q < 4; ++q) { acc[2 * q] += cvt_pk_f32_fp8_(vb[k][q], false) * wk[k]; acc[2 * q + 1] += cvt_pk_f32_fp8_(vb[k][q], true) * wk[k]; }
        if (REFILL) {
#pragma unroll
            for (int q = 0; q < 8; ++q) PIN1(acc[q]);
            GLOAD16_RW_S(vb[k], vbase, off[k & 7]); }
        if (TAG) TAG_B(); else TAG_A();
        SCHED_FENCE(); }
    WAVE_SYNC();
#pragma unroll
    for (int q = 0; q < 4; ++q) *(f32x4*)(C + lane * 16 + 4 * q) = (f32x4){acc[2 * q].x, acc[2 * q].y, acc[2 * q + 1].x, acc[2 * q + 1].y};
    WAVE_SYNC();
    f32x2 s = (f32x2){0.f, 0.f};
#pragma unroll
    for (int g = 0; g < 8; ++g) s += *(const f32x2*)(C + g * 128 + 2 * lane);
    *(unsigned*)(outp + (size_t)t * 1024 + 128 * x + 2 * lane) = pk2(bflo(oprev) + s.x, bfhi(oprev) + s.y);
}
__device__ __forceinline__ void peer_acc_item(bf16_t* outp, const Ptrs& P, int x, int blk, unsigned char* lds, int lane, int wave) {
    float* C = (float*)(lds + wave * PG_WLDS); int* E = (int*)(lds + wave * PG_WLDS + 4096); float* W = (float*)(lds + wave * PG_WLDS + 4608);
    const int gq = lane >> 3, c8 = lane & 7, tb = blk * PG_TB + PG_TPW * wave;
    u32x4 vA[16], vB[16]; unsigned oA, oB; float wa0, wa1, wb0, wb1; int ea0, ea1, eb0, eb1;
    const int* ebase = P.eid; const float* wbase = P.gate; const bf16_t* obase = outp; const unsigned char* vbase = P.V8;
    const unsigned eo = (unsigned)((tb * 128 + lane) * 4), oo = (unsigned)((tb * 1024 + 128 * x + 2 * lane) * 2);
    { const int* ep = P.eid + (size_t)tb * 128 + lane; ea0 = ep[0]; ea1 = ep[64]; eb0 = ep[128]; eb1 = ep[192]; }
    WAVE_SYNC(); E[lane] = ea0; E[64 + lane] = ea1; WAVE_SYNC();
#pragma unroll
    for (int k = 0; k < 16; ++k) { const unsigned off = ((unsigned)(x * NEXP) + (unsigned)E[gq + 8 * k]) * 128u + 16u * (unsigned)c8; GLOAD16_S(vA[k], vbase, off); }
    GLOAD4_S(wa0, wbase, eo); GLOAD4_S(wa1, wbase, eo + 256u); GLOAD4_S(oA, obase, oo); GLOAD4_S(ea0, ebase, eo + 2u * 512u); GLOAD4_S(ea1, ebase, eo + 2u * 512u + 256u);
    WAVE_SYNC(); E[lane] = eb0; E[64 + lane] = eb1; WAVE_SYNC();
#pragma unroll
    for (int k = 0; k < 16; ++k) { const unsigned off = ((unsigned)(x * NEXP) + (unsigned)E[gq + 8 * k]) * 128u + 16u * (unsigned)c8; GLOAD16_S(vB[k], vbase, off); }
    GLOAD4_S(wb0, wbase, eo + 512u); GLOAD4_S(wb1, wbase, eo + 512u + 256u); GLOAD4_S(oB, obase, oo + 2048u); GLOAD4_S(eb0, ebase, eo + 3u * 512u); GLOAD4_S(eb1, ebase, eo + 3u * 512u + 256u);
#pragma unroll
    for (int i = 0; i < PG_TPW; i += 2) {
        if (i == 0) WAIT_VM(21); else WAIT_VM(22);
        PIN4(wa0, wa1, ea0, ea1); PIN1(oA);
        if (i + 2 < PG_TPW) { WAVE_SYNC(); E[lane] = ea0; E[64 + lane] = ea1; WAVE_SYNC();
            pg_acc_compute<true, 0>(P, outp, x, tb + i, vA, wa0, wa1, oA, C, W, E, c8, gq, lane);
            const unsigned nx = (unsigned)((i + 4 < PG_TPW) ? i + 4 : PG_TPW - 1);
            GLOAD4_S(wa0, wbase, eo + (unsigned)(i + 2) * 512u); GLOAD4_S(wa1, wbase, eo + (unsigned)(i + 2) * 512u + 256u); GLOAD4_S(oA, obase, oo + (unsigned)(i + 2) * 2048u);
            GLOAD4_S(ea0, ebase, eo + nx * 512u); GLOAD4_S(ea1, ebase, eo + nx * 512u + 256u); }
        else pg_acc_compute<false, 0>(P, outp, x, tb + i, vA, wa0, wa1, oA, C, W, E, c8, gq, lane);
        if (i + 2 < PG_TPW) WAIT_VM(22); else WAIT_VM(0);
        PIN4(wb0, wb1, eb0, eb1); PIN1(oB);
        if (i + 3 < PG_TPW) { WAVE_SYNC(); E[lane] = eb0; E[64 + lane] = eb1; WAVE_SYNC();
            pg_acc_compute<true, 1>(P, outp, x, tb + i + 1, vB, wb0, wb1, oB, C, W, E, c8, gq, lane);
            const unsigned nx = (unsigned)((i + 5 < PG_TPW) ? i + 5 : PG_TPW - 1);
            GLOAD4_S(wb0, wbase, eo + (unsigned)(i + 3) * 512u); GLOAD4_S(wb1, wbase, eo + (unsigned)(i + 3) * 512u + 256u); GLOAD4_S(oB, obase, oo + (unsigned)(i + 3) * 2048u);
            GLOAD4_S(eb0, ebase, eo + nx * 512u); GLOAD4_S(eb1, ebase, eo + nx * 512u + 256u); }
        else pg_acc_compute<false, 1>(P, outp, x, tb + i + 1, vB, wb0, wb1, oB, C, W, E, c8, gq, lane);
    }
}
template <int STAGE, int CSET = STAGE>
__device__ __forceinline__ void phase_G12(const KP& p, int l, unsigned char* lds) {
    const Ptrs P = make_ptrs(p.ws, l);
    const int tid = TIDX(), lane = tid & 63, wave = tid >> 6;
    int* slot = (int*)(lds + 8 * PG_WLDS);
    const int myx = XCC_ID();
    for (int s = 0; s < 8; ++s) { const int x = (myx + s) & 7; unsigned* cnt = P.qcnt + (CSET * 8 + x) * 16;
        for (;;) { const int blk = peer_next_item(cnt, slot, tid); if (blk >= PG_NBLK) break;
            if (STAGE == 0) peer_dots_item(P, x, blk, lds, lane, wave); else peer_acc_item(CSET == 3 ? P.pd : P.ycat, P, x, blk, lds, lane, wave); } }
    __syncthreads();
}
__device__ __forceinline__ void phase_G1b(const KP& p, int l, unsigned char* lds) {
    const Ptrs P = make_ptrs(p.ws, l);
    const size_t stride = (size_t)GDIM() * NTHR, n = (size_t)T_ * 128;
    for (size_t i0 = (size_t)BIDX() * NTHR + TIDX(); i0 < n; i0 += 4 * stride) { float d[4], gt[4], su[4], sv[4]; int e[4];
#pragma unroll
        for (int q = 0; q < 4; ++q) { const size_t i = i0 + q * stride; e[q] = 0; gt[q] = 0.f; d[q] = 0.f; if (i < n) { e[q] = P.eid[i]; gt[q] = P.gate[i]; } }
#pragma unroll
        for (int q = 0; q < 4; ++q) { const size_t i = i0 + q * stride; su[q] = P.su[e[q]]; sv[q] = P.sv[e[q]];
            if (i < n) {
#pragma unroll
                for (int x = 0; x < 8; ++x) d[q] += bf2f(P.pd[(size_t)x * T_ * 128 + i]); } }
#pragma unroll
        for (int q = 0; q < 4; ++q) { const size_t i = i0 + q * stride; if (i < n) P.gate[i] = gt[q] * sv[q] * gelu_erf(d[q] * su[q]); } }
#ifdef CPU_EMU
    (void)lds;
#endif
}
__device__ __forceinline__ void phase_G3(const KP& p, int l, unsigned char* lds, bool last) {
    const Ptrs P = make_ptrs(p.ws, l);
    const int tid = TIDX(), lane = tid & 63, wave = tid >> 6; const int gw = BIDX() * NWAVE + wave, NGW = GDIM() * NWAVE;
    for (int m = 4 * gw; m < T_; m += 4 * NGW) ln_rows<4, true>(P.ycat + (size_t)m * 1024, p.in[I_LN2G] + l * 1024, p.in[I_LN2B] + l * 1024, last ? p.out + (size_t)m * 1024 : (float*)nullptr, last ? (bf16_t*)nullptr : P.hb + (size_t)m * 1024,
                                                           last ? (unsigned char*)nullptr : (m < H8_SPLIT ? P.h8a + (size_t)m * 1024 : P.h8b + (size_t)(m - H8_SPLIT) * 1024), lane);
}
#ifndef PROBE_REPEAT
#define PROBE_REPEAT 0
#endif
constexpr int LDS_BYTES = 163840;
__device__ __forceinline__ void phase_B1(const KP& p, int l, unsigned char* lds) {
    const Ptrs P = make_ptrs(p.ws, l);
    constexpr int NRC = NB_ * 4 * RW_NCH, NS5 = NB_ * 16, NFX = NB_ * 4 * (S_ / 256), NCV = T_ / 64;
    const int G = GDIM(); int it = BIDX();
    for (; it < NRC; it += G) rw_chunk_unit(p, P, l, it, lds);
#if PROBE_REPEAT == 16
    for (int j = BIDX(); j < NRC; j += G) rw_chunk_unit(p, P, l, j, lds);
#endif
#if PROBE_REPEAT >= 161 && PROBE_REPEAT <= 163
    for (int j = BIDX(); j < NRC; j += G) { rw_chunk_unit<PROBE_REPEAT - 160>(p, P, l, j, lds); __syncthreads(); }
#endif
    for (; it < NRC + NFX; it += G) fox_unit(p, P, l, it - NRC, lds);
#if PROBE_REPEAT == 17
    for (int j = BIDX(); j < NFX; j += G) fox_unit(p, P, l, j, lds);
#endif
    for (; it < NRC + NFX + NS5; it += G) s5_unit(p, P, l, it - NRC - NFX, lds);
#if PROBE_REPEAT == 18
    for (int j = BIDX(); j < NS5; j += G) s5_unit(p, P, l, j, lds);
#endif
    for (; it < NRC + NFX + NS5 + NCV; it += G) conv_unit(p, P, l, it - NRC - NFX - NS5, lds);
#if PROBE_REPEAT == 19
    for (int j = BIDX(); j < NCV; j += G) conv_unit(p, P, l, j, lds);
#endif
}
__device__ __forceinline__ void phase_B3(const KP& p, int l, unsigned char* lds) {
    const Ptrs P = make_ptrs(p.ws, l);
#if PROBE_REPEAT == 34
    for (int it = BIDX(); it < NB_ * 4 * RW_NCH; it += GDIM()) rw_out_unit<true>(p, P, l, it, lds);
#endif
    for (int it = BIDX(); it < NB_ * 4 * RW_NCH; it += GDIM()) rw_out_unit<false>(p, P, l, it, lds);
}
enum { PH_PRO = 0, PH_A, PH_B1, PH_B2, PH_B3, PH_C, PH_D, PH_D2, PH_E, PH_F, PH_G, PH_G1B, PH_G2, PH_G3, PH_N, PH_A0 };
__device__ __forceinline__ void run_phase(const KP& p, int ph, int l, unsigned char* lds) {
    switch (ph) {
        case PH_PRO: phase_prologue(p, lds); break;
        case PH_A: phase_A(p, l, lds); break;
        case PH_A0: phase_A0(p, lds); break;
        case PH_B1: phase_B1(p, l, lds); break;
        case PH_B2: phase_B2(p, l, lds); break;
        case PH_B3: phase_B3(p, l, lds); break;
        case PH_C: phase_C(p, l, lds); break;
        case PH_D: phase_D(p, l, lds); break;
        case PH_D2: phase_D2(p, l, lds); break;
        case PH_E: phase_E(p, l, lds); break;
        case PH_F: phase_F(p, l, lds); break;
        case PH_G: phase_G12<0>(p, l, lds); break;
        case PH_G1B: phase_G1b(p, l, lds); break;
        case PH_G2: phase_G12<1>(p, l, lds); break;
        case PH_G3: phase_G3(p, l, lds, l == L_ - 1); break;
        default: break;
    }
}
#ifndef CPU_EMU
#define XB_TMO      128
#define XB_XCNT(j)  (256  + 64 * (j))
#define XB_XSUB(j)  (1280 + 64 * (j))
#define XB_XGEN(j)  (2304 + 64 * (j))
#define XB_TOP      3328
#define XB_TOPGEN   3392
#define XCD_BAR_WORDS 3456
#define XB_SPIN_CAP (1u << 22)
__device__ __forceinline__ unsigned xb_ld(unsigned* p)              { return __hip_atomic_load(p, __ATOMIC_RELAXED, __HIP_MEMORY_SCOPE_AGENT); }
__device__ __forceinline__ unsigned xb_add(unsigned* p, unsigned v) { return __hip_atomic_fetch_add(p, v, __ATOMIC_RELAXED, __HIP_MEMORY_SCOPE_AGENT); }
__device__ __forceinline__ unsigned xb_xcc_id() { return (unsigned)__builtin_amdgcn_s_getreg((3 << 11) | 20) & 0xFu; }
#define XB_SPIN(cond, bar) do { unsigned _sp = 0; while (cond) { __builtin_amdgcn_s_sleep(1); \
    if ((++_sp & 255u) == 0u) { if (xb_ld(&(bar)[XB_TMO])) break; if (_sp > XB_SPIN_CAP) { atomicAdd(&(bar)[XB_TMO], 1u); break; } } } } while (0)
struct XcdBarrier { unsigned* bar; unsigned x; volatile LAS unsigned* st; };
__device__ __forceinline__ XcdBarrier xcd_barrier_post(unsigned* bar, volatile LAS unsigned* st) {
    XcdBarrier b; b.bar = bar; b.x = xb_xcc_id(); b.st = st;
    if (threadIdx.x == 0) (void)xb_add(&bar[XB_XCNT(b.x)], 1u);
    return b;
}
__device__ __forceinline__ void xcd_barrier_complete(unsigned* bar, unsigned x, unsigned& nloc, unsigned& nx) {
    const unsigned G = gridDim.x * gridDim.y * gridDim.z;
    unsigned sum, cnt, mine, sp = 0u;
    for (;;) {
        sum = 0u; cnt = 0u; mine = 0u;
#pragma unroll
        for (unsigned j = 0; j < 16; ++j) { const unsigned c = xb_ld(&bar[XB_XCNT(j)]); sum += c; cnt += (c > 0u) ? 1u : 0u; mine = (j == x) ? c : mine; }
        if (sum == G) break;
        __builtin_amdgcn_s_sleep(1);
        if ((++sp & 255u) == 0u) { if (xb_ld(&bar[XB_TMO])) break; if (sp > XB_SPIN_CAP) { atomicAdd(&bar[XB_TMO], 1u); break; } }
    }
    nloc = mine > 0u ? mine : 1u; nx = cnt > 0u ? cnt : 1u;
}
__device__ __forceinline__ void xcd_barrier(const XcdBarrier& b) {
    asm volatile("s_waitcnt vmcnt(0)" ::: "memory");
    __syncthreads();
    if (threadIdx.x == 0) {
        unsigned* bar = b.bar;
        __builtin_amdgcn_s_waitcnt(0);
        unsigned nloc = b.st[0], nx = b.st[1];
        if (nloc == 0u) { xcd_barrier_complete(bar, b.x, nloc, nx); b.st[0] = nloc; b.st[1] = nx; }
        const unsigned old = xb_add(&bar[XB_XSUB(b.x)], 1u);
        const unsigned gen = old / nloc;
        if (old + 1u == (gen + 1u) * nloc) {
            __builtin_amdgcn_fence(__ATOMIC_RELEASE, "agent");
            asm volatile("s_waitcnt vmcnt(0)" ::: "memory");
            const unsigned og = xb_add(&bar[XB_TOP], 1u);
            const unsigned tg = og / nx;
            if (og + 1u == (tg + 1u) * nx) xb_add(&bar[XB_TOPGEN], 1u);
            else XB_SPIN(xb_ld(&bar[XB_TOPGEN]) == tg, bar);
            __builtin_amdgcn_fence(__ATOMIC_ACQUIRE, "agent");
            xb_add(&bar[XB_XGEN(b.x)], 1u);
            asm volatile("s_waitcnt vmcnt(0)" ::: "memory");
        } else {
            XB_SPIN(xb_ld(&bar[XB_XGEN(b.x)]) == gen, bar);
            __builtin_amdgcn_fence(__ATOMIC_ACQUIRE, "agent");
            asm volatile("s_waitcnt vmcnt(0)" ::: "memory");
        }
    }
    __syncthreads();
}
#ifndef PROBE_REPEAT
#define PROBE_REPEAT 0
#endif
#ifndef N_LAUNCH_MODE
#define N_LAUNCH_MODE 1
#endif
extern __shared__ __attribute__((aligned(16))) unsigned char lds_dyn[];
#if N_LAUNCH_MODE == 0
template <int PH> __global__ void __launch_bounds__(NTHR, 2) k_phase_t(KP p) { run_phase(p, PH, p.layer, lds_dyn); }
typedef void (*kfn_t)(KP);
static kfn_t phase_fn(int ph) { switch (ph) { case PH_PRO: return k_phase_t<PH_PRO>; case PH_A: return k_phase_t<PH_A>; case PH_B1: return k_phase_t<PH_B1>; case PH_B2: return k_phase_t<PH_B2>; case PH_B3: return k_phase_t<PH_B3>; case PH_C: return k_phase_t<PH_C>;
    case PH_D: return k_phase_t<PH_D>; case PH_D2: return k_phase_t<PH_D2>; case PH_E: return k_phase_t<PH_E>; case PH_F: return k_phase_t<PH_F>; case PH_G: return k_phase_t<PH_G>; case PH_G1B: return k_phase_t<PH_G1B>; case PH_G2: return k_phase_t<PH_G2>; default: return k_phase_t<PH_G3>; } }
#else
#ifndef USE_XCD_BARRIER
#define USE_XCD_BARRIER 1
#endif
constexpr int BAR_LDS_OFF = LDS_BYTES - 64;
#if USE_XCD_BARRIER
#define GSYNC() xcd_barrier(bar)
#define GSYNC_ARG const XcdBarrier& bar
#else
#define GSYNC() grid.sync()
#define GSYNC_ARG cg::grid_group& grid
#endif
template <int l>
__device__ __forceinline__ void mega_layer(const KP& p, GSYNC_ARG) {
#if PROBE_REPEAT == 47 || PROBE_REPEAT == 48
        phase_Aprobe<PROBE_REPEAT - 40>(p, l, lds_dyn); GSYNC();
#endif
        phase_A(p, l, lds_dyn);
#if PROBE_REPEAT == 1
        GSYNC(); phase_A(p, l, lds_dyn);
#endif
#if PROBE_REPEAT >= 40 && PROBE_REPEAT <= 46
        GSYNC(); phase_Aprobe<PROBE_REPEAT - 40>(p, l, lds_dyn);
#endif
        GSYNC(); phase_B1(p, l, lds_dyn);
#if PROBE_REPEAT == 2
        GSYNC(); phase_B1(p, l, lds_dyn);
#endif
        GSYNC(); phase_B2(p, l, lds_dyn);
        GSYNC(); phase_B3(p, l, lds_dyn);
        GSYNC(); phase_C(p, l, lds_dyn);
#if PROBE_REPEAT == 4
        GSYNC(); phase_C(p, l, lds_dyn);
#endif
        GSYNC(); phase_D(p, l, lds_dyn);
        GSYNC(); phase_D2(p, l, lds_dyn);
        GSYNC(); phase_E(p, l, lds_dyn);
        GSYNC(); phase_F(p, l, lds_dyn);
#if PROBE_REPEAT == 8
        GSYNC(); phase_F(p, l, lds_dyn);
#endif
        GSYNC(); phase_G12<0>(p, l, lds_dyn);
#if PROBE_REPEAT == 32
        GSYNC(); phase_G12<0, 2>(p, l, lds_dyn);
#endif
        GSYNC(); phase_G1b(p, l, lds_dyn);
        GSYNC(); phase_G12<1>(p, l, lds_dyn);
#if PROBE_REPEAT == 33
        GSYNC(); phase_G12<1, 3>(p, l, lds_dyn);
#endif
        GSYNC(); phase_G3(p, l, lds_dyn, l == L_ - 1);
}
__global__ void __launch_bounds__(NTHR, 2) k_mega(KP p) {
    cg::grid_group grid = cg::this_grid();
#if USE_XCD_BARRIER
    volatile LAS unsigned* st = (volatile LAS unsigned*)(lds_dyn + BAR_LDS_OFF);
    if (threadIdx.x < 2) st[threadIdx.x] = 0u;
    __syncthreads();
    const XcdBarrier bar = xcd_barrier_post((unsigned*)(p.ws + WS_CTL) + 4096, st);
#define GSYNC_VAL bar
#else
#define GSYNC_VAL grid
#endif
    phase_prologue(p, lds_dyn);
#if PROBE_REPEAT == 60
    GSYNC(); phase_prologue(p, lds_dyn);
#endif
    grid.sync();
    phase_A0(p, lds_dyn);
    GSYNC();
    mega_layer<0>(p, GSYNC_VAL);
    static_assert(L_ == 2, "two layers");
    GSYNC();
    mega_layer<1>(p, GSYNC_VAL);
}
#endif
extern "C" void kernel_launch(void* const* d_in, const int* in_sizes, int n_in, void* d_out, int out_size, void* d_ws, size_t ws_size, hipStream_t stream) {
    static int grid = 0;
    if (grid == 0) {
        if (n_in != N_IN || out_size != T_ * 1024 || ws_size < WS_END) { fprintf(stderr, "kernel_launch: unexpected shapes (n_in %d out %d ws %zu need %zu)\n", n_in, out_size, ws_size, (size_t)WS_END); grid = -1; return; }
        int dev = 0, cus = 0, per_cu = 0;
        (void)hipGetDevice(&dev); (void)hipDeviceGetAttribute(&cus, hipDeviceAttributeMultiprocessorCount, dev);
#if N_LAUNCH_MODE == 0
        for (int ph = 0; ph < PH_N; ++ph) (void)hipFuncSetAttribute((const void*)phase_fn(ph), hipFuncAttributeMaxDynamicSharedMemorySize, LDS_BYTES);
        (void)per_cu;
#else
        (void)hipFuncSetAttribute((const void*)k_mega, hipFuncAttributeMaxDynamicSharedMemorySize, LDS_BYTES);
        (void)hipOccupancyMaxActiveBlocksPerMultiprocessor(&per_cu, (const void*)k_mega, NTHR, LDS_BYTES);
        if (per_cu < 1) { fprintf(stderr, "kernel_launch: occupancy query says %d blocks per CU\n", per_cu); grid = -1; return; }
#endif
        grid = cus;
    }
    if (grid < 0) return;
    if (hipMemsetAsync((char*)d_ws + WS_CTL, 0, 65536, stream) != hipSuccess) { fprintf(stderr, "kernel_launch: memset failed\n"); return; }
    KP p{};
    for (int i = 0; i < N_IN; ++i) p.in[i] = (const float*)d_in[i];
    p.out = (float*)d_out; p.ws = (unsigned char*)d_ws;
#if N_LAUNCH_MODE == 1
    void* args[] = {&p};
    hipError_t e = hipLaunchCooperativeKernel((const void*)k_mega, dim3(grid), dim3(NTHR), args, LDS_BYTES, stream);
    if (e != hipSuccess) fprintf(stderr, "cooperative launch failed: %s (grid %d)\n", hipGetErrorString(e), grid);
#else
    p.phase = PH_PRO; p.layer = 0; hipLaunchKernelGGL(phase_fn(PH_PRO), dim3(grid), dim3(NTHR), LDS_BYTES, stream, p);
    for (int l = 0; l < L_; ++l) for (int ph = PH_A; ph < PH_N; ++ph) { p.phase = ph; p.layer = l; hipLaunchKernelGGL(phase_fn(ph), dim3(grid), dim3(NTHR), LDS_BYTES, stream, p); }
#endif
}
#endif
```
